# Optimizing an MI355X kernel written in HIP

```python
import jax
import jax.numpy as jnp
from jax import lax
import numpy as np

D_MODEL = 1024
BATCH = 16
SEQ = 2048
DEPTH = 2

MEM_LEN = 256
EPS = 1e-6
FOX_HEADS = 8
FOX_HEAD_DIM = 64
FOX_WIDTH = FOX_HEADS * FOX_HEAD_DIM
FOX_BLOCK = 128
FORGET_BIAS_INIT = 3.0
GLA_HEADS = 4
GLA_KEY_DIM = 64
GLA_VAL_DIM = 128
GLA_QK_WIDTH = GLA_HEADS * GLA_KEY_DIM
GLA_V_WIDTH = GLA_HEADS * GLA_VAL_DIM
GLA_GATE_RANK = 16
GLA_GATE_TAU = 16.0
GLA_CHUNK = 64
MIX_WIDTH = FOX_WIDTH + GLA_V_WIDTH
IN_WIDTHS = (FOX_WIDTH, FOX_WIDTH, FOX_WIDTH, FOX_HEADS, GLA_QK_WIDTH, GLA_QK_WIDTH, GLA_V_WIDTH, GLA_V_WIDTH, GLA_GATE_RANK)
IN_PROJ_WIDTH = 3096
X_HEADS = 4
X_HEAD_DIM = 128
X_WIDTH = X_HEADS * X_HEAD_DIM
N_GROUPS = 4
EXPERTS_PER_GROUP = 4
N_EXPERTS = N_GROUPS * EXPERTS_PER_GROUP
TOP_K = 2
D_EXPERT = 512
MOE_BLOCK = 128
RESID_SCALE = 0.5

kernel_name = 'hybrid_fox_gla_hmoe_block'


def rms_norm(x, gain):
    xf = x.astype(jnp.float32)
    y = xf * lax.rsqrt(jnp.mean(xf * xf, axis=-1, keepdims=True) + EPS)
    return (y * gain.astype(jnp.float32)).astype(x.dtype)


def forgetting_attention(q, k, v, f_logit):
    B, S, H, d = q.shape
    q = q.transpose(0, 2, 1, 3)
    k = k.transpose(0, 2, 1, 3)
    v = v.transpose(0, 2, 1, 3)
    log_f = jax.nn.log_sigmoid(f_logit.astype(jnp.float32)).transpose(0, 2, 1)
    c = jnp.cumsum(log_f, axis=-1)
    scale = d ** -0.5
    outs = []
    for blk in range(S // FOX_BLOCK):
        q0 = blk * FOX_BLOCK
        q1 = q0 + FOX_BLOCK
        s = jnp.einsum('bhqd,bhkd->bhqk', q[:, :, q0:q1], k[:, :, :q1], preferred_element_type=jnp.float32) * scale
        s = s + c[:, :, q0:q1, None] - c[:, :, None, :q1]
        causal = jnp.arange(q0, q1)[:, None] >= jnp.arange(q1)[None, :]
        p = jax.nn.softmax(jnp.where(causal, s, -jnp.inf), axis=-1)
        outs.append(jnp.einsum('bhqk,bhkd->bhqd', p.astype(v.dtype), v[:, :, :q1]))
    return jnp.concatenate(outs, axis=2).transpose(0, 2, 1, 3)


def gla_chunked(q, k, v, log_a):
    B, S, H, dk = q.shape
    dv = v.shape[-1]
    C = GLA_CHUNK
    nc = S // C

    def to_chunks(t):
        return t.astype(jnp.float32).reshape(B, nc, C, H, t.shape[-1]).transpose(1, 0, 3, 2, 4)

    qc = to_chunks(q) * (dk ** -0.5)
    kc = to_chunks(k)
    vc = to_chunks(v)
    gc = to_chunks(log_a)
    causal = jnp.tril(jnp.ones((C, C), dtype=bool))[:, :, None]

    def step(state, inp):
        qi, ki, vi, gi = inp
        b = jnp.cumsum(gi, axis=2)
        b_last = b[:, :, -1:, :]
        o_inter = jnp.einsum('bhtd,bhdv->bhtv', qi * jnp.exp(b), state)
        diff = b[:, :, :, None, :] - b[:, :, None, :, :]
        decay = jnp.exp(jnp.where(causal, diff, -jnp.inf))
        attn = jnp.einsum('bhtd,bhsd,bhtsd->bhts', qi, ki, decay)
        o_intra = jnp.einsum('bhts,bhsv->bhtv', attn, vi)
        new_state = jnp.exp(b_last[:, :, 0, :])[..., None] * state + jnp.einsum('bhsd,bhsv->bhdv', ki * jnp.exp(b_last - b), vi)
        return new_state, o_inter + o_intra

    state0 = jnp.zeros((B, H, dk, dv), jnp.float32)
    _, o = lax.scan(step, state0, (qc, kc, vc, gc))
    return o.transpose(1, 0, 3, 2, 4).reshape(B, S, H, dv).astype(v.dtype)


def hybrid_mixer(h, w_in, b_forget, w_alpha_up, b_alpha, fox_out_gain, gla_out_gain, w_out):
    B, S, _ = h.shape
    offsets = [int(o) for o in np.cumsum(IN_WIDTHS)[:-1]]
    fq, fk, fv, ff, gq, gk, gv, gg, ga = jnp.split(h @ w_in, offsets, axis=-1)
    fox = forgetting_attention(
        fq.reshape(B, S, FOX_HEADS, FOX_HEAD_DIM),
        fk.reshape(B, S, FOX_HEADS, FOX_HEAD_DIM),
        fv.reshape(B, S, FOX_HEADS, FOX_HEAD_DIM),
        ff + b_forget)
    fox = rms_norm(fox, fox_out_gain.reshape(FOX_HEADS, FOX_HEAD_DIM))
    log_a = jax.nn.log_sigmoid((ga @ w_alpha_up + b_alpha).astype(jnp.float32)) / GLA_GATE_TAU
    gla = gla_chunked(
        gq.reshape(B, S, GLA_HEADS, GLA_KEY_DIM),
        gk.reshape(B, S, GLA_HEADS, GLA_KEY_DIM),
        gv.reshape(B, S, GLA_HEADS, GLA_VAL_DIM),
        log_a.reshape(B, S, GLA_HEADS, GLA_KEY_DIM))
    gla = rms_norm(gla, gla_out_gain.reshape(GLA_HEADS, GLA_VAL_DIM)) * jax.nn.silu(gg.reshape(B, S, GLA_HEADS, GLA_VAL_DIM))
    y = jnp.concatenate([fox.reshape(B, S, FOX_WIDTH), gla.reshape(B, S, GLA_V_WIDTH)], axis=-1)
    return y @ w_out


def memory_cross_attention(h, mem_n, w_xq, w_xk, w_xv, w_xo):
    B, S, _ = h.shape
    M = mem_n.shape[1]
    q = (h @ w_xq).reshape(B, S, X_HEADS, X_HEAD_DIM)
    k = (mem_n @ w_xk).reshape(B, M, X_HEADS, X_HEAD_DIM)
    v = (mem_n @ w_xv).reshape(B, M, X_HEADS, X_HEAD_DIM)
    s = jnp.einsum('bqhd,bkhd->bhqk', q, k, preferred_element_type=jnp.float32) * (X_HEAD_DIM ** -0.5)
    p = jax.nn.softmax(s, axis=-1)
    o = jnp.einsum('bhqk,bkhd->bqhd', p.astype(v.dtype), v).reshape(B, S, X_WIDTH)
    return o @ w_xo


def hierarchical_moe(h, w_rg, b_rg, w_re, b_re, w_e_gate, w_e_up, w_e_down):
    B, S, D = h.shape
    N = B * S
    hf = h.reshape(N, D)
    g_prob = jax.nn.softmax((hf @ w_rg).astype(jnp.float32) + b_rg.astype(jnp.float32), axis=-1)
    grp = jnp.argmax(g_prob, axis=-1)
    p_grp = jnp.take_along_axis(g_prob, grp[:, None], axis=-1)
    e_logits = ((hf @ w_re).astype(jnp.float32) + b_re.astype(jnp.float32)).reshape(N, N_GROUPS, EXPERTS_PER_GROUP)
    e_logits = jnp.take_along_axis(e_logits, grp[:, None, None], axis=1)[:, 0]
    top_p, top_i = lax.top_k(jax.nn.softmax(e_logits, axis=-1), TOP_K)
    gate = p_grp * top_p / jnp.sum(top_p, axis=-1, keepdims=True)
    expert = grp[:, None].astype(jnp.int32) * EXPERTS_PER_GROUP + top_i.astype(jnp.int32)
    Mrows = N * TOP_K
    flat_e = expert.reshape(Mrows)
    flat_g = gate.reshape(Mrows)
    flat_tok = jnp.repeat(jnp.arange(N, dtype=jnp.int32), TOP_K)
    order = jnp.argsort(flat_e)
    sorted_e = flat_e[order]
    counts = jnp.bincount(flat_e, length=N_EXPERTS)
    padded = (counts + MOE_BLOCK - 1) // MOE_BLOCK * MOE_BLOCK
    starts = jnp.cumsum(counts) - counts
    pad_ends = jnp.cumsum(padded)
    pad_starts = pad_ends - padded
    dest = pad_starts[sorted_e] + jnp.arange(Mrows, dtype=jnp.int32) - starts[sorted_e]
    R = Mrows + N_EXPERTS * MOE_BLOCK
    n_blocks = R // MOE_BLOCK
    row_tok = jnp.full((R,), N, dtype=jnp.int32).at[dest].set(flat_tok[order])
    row_gate = jnp.zeros((R,), jnp.float32).at[dest].set(flat_g[order])
    block_e = jnp.minimum(jnp.searchsorted(pad_ends, jnp.arange(n_blocks) * MOE_BLOCK, side='right'), N_EXPERTS - 1)
    x_rows = jnp.concatenate([hf, jnp.zeros((1, D), hf.dtype)], axis=0)[row_tok].reshape(n_blocks, MOE_BLOCK, D)

    def expert_block(args):
        xb, e = args
        u = jax.nn.silu(xb @ w_e_gate[e]) * (xb @ w_e_up[e])
        return u @ w_e_down[e]

    y_rows = lax.map(expert_block, (x_rows, block_e)).reshape(R, D)
    y = jax.ops.segment_sum(y_rows.astype(jnp.float32) * row_gate[:, None], row_tok, num_segments=N + 1)[:N]
    return y.reshape(B, S, D).astype(h.dtype)


def setup_inputs(seed: int = 0) -> dict:
    key = jax.random.key(seed)
    ks = jax.random.split(key, 26)
    f32 = jnp.float32
    L = DEPTH

    def w(k, shape, fan_in, scale=1.0):
        return jax.random.normal(k, shape, f32) * (scale * fan_in ** -0.5)

    def gain(k, shape):
        return 1.0 + 0.02 * jax.random.normal(k, shape, f32)

    def small(k, shape, scale):
        return scale * jax.random.normal(k, shape, f32)

    return {
        'x': jax.random.normal(ks[0], (BATCH, SEQ, D_MODEL), f32),
        'mem': jax.random.normal(ks[1], (BATCH, MEM_LEN, D_MODEL), f32),
        'mem_norm': gain(ks[2], (D_MODEL,)),
        'mix_norm': gain(ks[3], (L, D_MODEL)),
        'w_in': w(ks[4], (L, D_MODEL, IN_PROJ_WIDTH), D_MODEL),
        'b_forget': FORGET_BIAS_INIT + small(ks[5], (L, FOX_HEADS), 0.1),
        'w_alpha_up': w(ks[6], (L, GLA_GATE_RANK, GLA_QK_WIDTH), GLA_GATE_RANK),
        'b_alpha': small(ks[7], (L, GLA_QK_WIDTH), 0.1),
        'fox_out_gain': gain(ks[8], (L, FOX_WIDTH)),
        'gla_out_gain': gain(ks[9], (L, GLA_V_WIDTH)),
        'w_out': w(ks[10], (L, MIX_WIDTH, D_MODEL), MIX_WIDTH, RESID_SCALE),
        'cross_norm': gain(ks[11], (L, D_MODEL)),
        'w_xq': w(ks[12], (L, D_MODEL, X_WIDTH), D_MODEL),
        'w_xk': w(ks[13], (L, D_MODEL, X_WIDTH), D_MODEL),
        'w_xv': w(ks[14], (L, D_MODEL, X_WIDTH), D_MODEL),
        'w_xo': w(ks[15], (L, X_WIDTH, D_MODEL), X_WIDTH, RESID_SCALE),
        'moe_norm': gain(ks[16], (L, D_MODEL)),
        'w_router_group': w(ks[17], (L, D_MODEL, N_GROUPS), D_MODEL),
        'b_router_group': small(ks[18], (L, N_GROUPS), 0.01),
        'w_router_expert': w(ks[19], (L, D_MODEL, N_EXPERTS), D_MODEL),
        'b_router_expert': small(ks[20], (L, N_EXPERTS), 0.01),
        'w_expert_gate': w(ks[21], (L, N_EXPERTS, D_MODEL, D_EXPERT), D_MODEL),
        'w_expert_up': w(ks[22], (L, N_EXPERTS, D_MODEL, D_EXPERT), D_MODEL),
        'w_expert_down': w(ks[23], (L, N_EXPERTS, D_EXPERT, D_MODEL), D_EXPERT, RESID_SCALE),
        'final_norm': gain(ks[24], (D_MODEL,)),
    }


def reference(x, mem, mem_norm, mix_norm, w_in, b_forget, w_alpha_up, b_alpha, fox_out_gain, gla_out_gain, w_out,
              cross_norm, w_xq, w_xk, w_xv, w_xo, moe_norm, w_router_group, b_router_group, w_router_expert,
              b_router_expert, w_expert_gate, w_expert_up, w_expert_down, final_norm):
    mem_n = rms_norm(mem, mem_norm)
    h = x
    for l in range(DEPTH):
        h = h + hybrid_mixer(rms_norm(h, mix_norm[l]), w_in[l], b_forget[l], w_alpha_up[l], b_alpha[l],
                             fox_out_gain[l], gla_out_gain[l], w_out[l])
        h = h + memory_cross_attention(rms_norm(h, cross_norm[l]), mem_n, w_xq[l], w_xk[l], w_xv[l], w_xo[l])
        h = h + hierarchical_moe(rms_norm(h, moe_norm[l]), w_router_group[l], b_router_group[l],
                                 w_router_expert[l], b_router_expert[l], w_expert_gate[l], w_expert_up[l],
                                 w_expert_down[l])
    return rms_norm(h, final_norm)
```

```cpp
#include <hip/hip_runtime.h>
#include <cstdio>
#include <cstdint>

constexpr int NTOK = 32768, DM = 1024, NBATCH = 16, SEQ = 2048, NLAYER = 2, MEML = 256;
constexpr int PW = 3072;
constexpr int C_FQ = 0, C_FK = 512, C_FV = 1024, C_GQ = 1536, C_GK = 1792, C_GV = 2048, C_GG = 2560;
constexpr int INW = 3096;
constexpr float EPS = 1e-6f, LOG2E = 1.4426950408889634f;
constexpr int MAXTILES = 288;
constexpr int MAXROWS = MAXTILES * 256;

typedef unsigned short bf16;
__device__ __forceinline__ unsigned f2bf(float f) { unsigned u = __builtin_bit_cast(unsigned, f); return (u + 0x7fffu + ((u >> 16) & 1u)) >> 16; }
__device__ __forceinline__ float bf2f(bf16 b) { return __builtin_bit_cast(float, ((unsigned)b) << 16); }

constexpr size_t MiB = 1u << 20;
constexpr size_t WS_CTL = 0;
constexpr size_t WS_W = 1 * MiB;
constexpr size_t WS_WLAYER = 59 * MiB;
constexpr size_t WS_WXKV = WS_W + 2 * WS_WLAYER;
constexpr size_t WS_HB = WS_WXKV + 4 * MiB;
constexpr size_t WS_PROJ = WS_HB + 64 * MiB;
constexpr size_t WS_XQ = WS_PROJ;
constexpr size_t WS_U = WS_PROJ + 32 * MiB;
constexpr size_t WS_SM = WS_PROJ + 192 * MiB;
constexpr size_t WS_CB = WS_SM + 4 * MiB;
constexpr size_t WS_Y = WS_CB + 1 * MiB;
constexpr size_t WS_XKV = WS_Y + 64 * MiB;
constexpr size_t WS_MEMN = WS_XKV + 16 * MiB;
constexpr size_t WS_SSQ = WS_MEMN + 8 * MiB;
constexpr size_t WS_MOE = WS_SSQ + 2 * MiB;
constexpr size_t WS_END = WS_MOE + 2 * MiB;
static_assert(WS_END <= 512 * MiB, "workspace map");
constexpr size_t MO_TOKE = 0;
constexpr size_t MO_TOKG = 256 * 1024;
constexpr size_t MO_ROWTOK = 512 * 1024;
constexpr size_t MO_ROWGATE = 832 * 1024;
constexpr size_t MO_TILEE = 1152 * 1024;
constexpr size_t MO_NT = 1156 * 1024;
constexpr size_t MO_HIST = 1160 * 1024;

struct P {
    const float *x, *mem, *mem_norm, *mix_norm, *w_in, *b_forget, *w_alpha_up, *b_alpha, *fox_gain, *gla_gain, *w_out, *cross_norm, *w_xq, *w_xk, *w_xv, *w_xo,
        *moe_norm, *w_rg, *b_rg, *w_re, *b_re, *w_eg, *w_eu, *w_ed, *final_norm;
    float* out; unsigned char* ws;
};
#define WSP(T, off) ((T*)(p.ws + (off)))

__device__ __forceinline__ float wave_sum(float v) {
#pragma unroll
    for (int o = 1; o < 64; o <<= 1) v += __shfl_xor(v, o);
    return v;
}
__device__ __forceinline__ float wave_max(float v) {
#pragma unroll
    for (int o = 1; o < 64; o <<= 1) v = fmaxf(v, __shfl_xor(v, o));
    return v;
}
__device__ __forceinline__ float row_rs(const float* ssq, int row) {
    const float4* s = (const float4*)(ssq + (size_t)row * 16);
    float4 a = s[0], b = s[1], c = s[2], d = s[3];
    float t = ((a.x + a.y) + (a.z + a.w)) + ((b.x + b.y) + (b.z + b.w)) + ((c.x + c.y) + (c.z + c.w)) + ((d.x + d.y) + (d.z + d.w));
    return rsqrtf(t * (1.0f / DM) + EPS);
}
__device__ __forceinline__ float log_sigmoid(float z) { return fminf(z, 0.f) - log1pf(expf(-fabsf(z))); }
__device__ __forceinline__ float silu(float z) { return z / (1.f + expf(-z)); }

__global__ void __launch_bounds__(256) k_rowprep(const float* src, bf16* dst, float* ssq, const float* gain, int rows, int mode) {
    const int lane = threadIdx.x & 63, row = blockIdx.x * 4 + (threadIdx.x >> 6);
    if (row >= rows) return;
    const float4* s = (const float4*)(src + (size_t)row * DM) + lane;
    float4 v[4]; float q = 0.f;
#pragma unroll
    for (int j = 0; j < 4; ++j) { v[j] = s[64 * j]; q += (v[j].x * v[j].x + v[j].y * v[j].y) + (v[j].z * v[j].z + v[j].w * v[j].w); }
    q = wave_sum(q);
    float sc = 1.f;
    if (mode == 1) sc = rsqrtf(q * (1.0f / DM) + EPS);
    else if (lane < 16) ssq[(size_t)row * 16 + lane] = lane == 0 ? q : 0.f;
    uint2* d = (uint2*)(dst + (size_t)row * DM) + lane;
#pragma unroll
    for (int j = 0; j < 4; ++j) {
        float4 g = mode == 1 ? ((const float4*)gain)[lane + 64 * j] : make_float4(1.f, 1.f, 1.f, 1.f);
        d[64 * j] = make_uint2(f2bf(v[j].x * sc * g.x) | (f2bf(v[j].y * sc * g.y) << 16), f2bf(v[j].z * sc * g.z) | (f2bf(v[j].w * sc * g.w) << 16));
    }
}
__global__ void __launch_bounds__(256) k_final(float* io, const float* gain) {
    const int lane = threadIdx.x & 63, row = blockIdx.x * 4 + (threadIdx.x >> 6);
    float4* s = (float4*)(io + (size_t)row * DM) + lane;
    float4 v[4]; float q = 0.f;
#pragma unroll
    for (int j = 0; j < 4; ++j) { v[j] = s[64 * j]; q += (v[j].x * v[j].x + v[j].y * v[j].y) + (v[j].z * v[j].z + v[j].w * v[j].w); }
    q = wave_sum(q);
    const float sc = rsqrtf(q * (1.0f / DM) + EPS);
#pragma unroll
    for (int j = 0; j < 4; ++j) { float4 g = ((const float4*)gain)[lane + 64 * j]; s[64 * j] = make_float4(v[j].x * sc * g.x, v[j].y * sc * g.y, v[j].z * sc * g.z, v[j].w * sc * g.w); }
}

template <class C> __global__ void __launch_bounds__(256) k_ngemm(C c) {
    __shared__ float As[16][65];
    __shared__ float Bs[C::NB][16][65];
    const int M = c.rows();
    const int row0 = blockIdx.y * 64, col0 = blockIdx.x * 64;
    if (row0 >= M || row0 < c.row_lo()) return;
    const int tx = threadIdx.x & 15, ty = threadIdx.x >> 4;
    float acc[C::NB][4][4];
#pragma unroll
    for (int n = 0; n < C::NB; ++n)
#pragma unroll
        for (int i = 0; i < 4; ++i)
#pragma unroll
            for (int j = 0; j < 4; ++j) acc[n][i][j] = 0.f;
    for (int k0 = 0; k0 < c.K; k0 += 16) {
#pragma unroll
        for (int i = 0; i < 4; ++i) { const int idx = threadIdx.x + 256 * i, r = idx >> 4, kk = idx & 15; As[kk][r] = c.a(row0 + r, k0 + kk); }
#pragma unroll
        for (int n = 0; n < C::NB; ++n)
#pragma unroll
            for (int i = 0; i < 4; ++i) { const int idx = threadIdx.x + 256 * i, kk = idx >> 6, cc = idx & 63; Bs[n][kk][cc] = c.b(n, k0 + kk, col0 + cc, row0); }
        __syncthreads();
#pragma unroll
        for (int kk = 0; kk < 16; ++kk) {
            float a[4];
#pragma unroll
            for (int i = 0; i < 4; ++i) a[i] = As[kk][ty * 4 + i];
#pragma unroll
            for (int n = 0; n < C::NB; ++n) {
                float b[4];
#pragma unroll
                for (int j = 0; j < 4; ++j) b[j] = Bs[n][kk][tx * 4 + j];
#pragma unroll
                for (int i = 0; i < 4; ++i)
#pragma unroll
                    for (int j = 0; j < 4; ++j) acc[n][i][j] += a[i] * b[j];
            }
        }
        __syncthreads();
    }
#pragma unroll
    for (int i = 0; i < 4; ++i)
#pragma unroll
        for (int j = 0; j < 4; ++j) c.epi(row0 + ty * 4 + i, col0 + tx * 4 + j, acc[0][i][j], acc[C::NB - 1][i][j]);
}

struct CfgXKV {
    __device__ int row_lo() const { return 0; }
    static constexpr int NB = 1; int K; const bf16* A; const float *wk, *wv; bf16* O; int l;
    __device__ int rows() const { return 4096; }
    __device__ float a(int r, int k) const { return bf2f(A[(size_t)r * DM + k]); }
    __device__ float b(int, int k, int c, int) const { return c < 512 ? wk[(size_t)k * 512 + c] : wv[(size_t)k * 512 + c - 512]; }
    __device__ void epi(int r, int c, float v, float) const { O[(size_t)r * 2048 + l * 1024 + c] = (bf16)f2bf(v); }
};
struct CfgInProj {
    __device__ int row_lo() const { return 0; }
    static constexpr int NB = 1; int K; const bf16* A; const float *w, *gain, *ssq; bf16* proj; float* sm;
    __device__ int rows() const { return NTOK; }
    __device__ float a(int r, int k) const { return bf2f(A[(size_t)r * DM + k]); }
    __device__ float b(int, int k, int c, int) const { return c < INW ? gain[k] * w[(size_t)k * INW + c] : 0.f; }
    __device__ void epi(int r, int c, float v, float) const {
        if (c >= INW) return;
        v *= row_rs(ssq, r);
        if (c < 1536) { if (c < 512) v *= 0.125f * LOG2E; proj[(size_t)r * PW + c] = (bf16)f2bf(v); }
        else if (c < 1544) sm[(size_t)r * 32 + (c - 1536)] = v;
        else if (c < 3080) { if (c < 1800) v *= 0.125f; proj[(size_t)r * PW + (c - 8)] = (bf16)f2bf(v); }
        else sm[(size_t)r * 32 + 8 + (c - 3080)] = v;
    }
};
struct CfgRes {
    __device__ int row_lo() const { return 0; }
    static constexpr int NB = 1; int K; const bf16* A; const float* w; const float* base; float* out;
    __device__ int rows() const { return NTOK; }
    __device__ float a(int r, int k) const { return bf2f(A[(size_t)r * K + k]); }
    __device__ float b(int, int k, int c, int) const { return w[(size_t)k * DM + c]; }
    __device__ void epi(int r, int c, float v, float) const { out[(size_t)r * DM + c] = base[(size_t)r * DM + c] + v; }
};
struct CfgXQ {
    __device__ int row_lo() const { return 0; }
    static constexpr int NB = 1; int K; const bf16* A; const float *w, *gain, *ssq; bf16* O;
    __device__ int rows() const { return NTOK; }
    __device__ float a(int r, int k) const { return bf2f(A[(size_t)r * DM + k]); }
    __device__ float b(int, int k, int c, int) const { return gain[k] * w[(size_t)k * 512 + c]; }
    __device__ void epi(int r, int c, float v, float) const { O[(size_t)r * 512 + c] = (bf16)f2bf(v * row_rs(ssq, r) * (0.08838834764831845f * LOG2E)); }
};
struct CfgGU {
    __device__ int row_lo() const { return 0; }
    static constexpr int NB = 2; int K; const bf16* A; const float *wg, *wu, *gain, *ssq; const int *rowtok, *tilee, *nt; bf16* U;
    __device__ int rows() const { return nt[1] * 256; }
    __device__ float a(int r, int k) const { int t = rowtok[r]; t = t < 0 ? 0 : t; return bf2f(A[(size_t)t * DM + k]); }
    __device__ float b(int n, int k, int c, int row0) const { const int e = tilee[row0 >> 8]; const size_t o = ((size_t)e * DM + k) * 512 + c; return n == 0 ? gain[k] * wg[o] : gain[k] * wu[o]; }
    __device__ void epi(int r, int c, float g, float u) const {
        const int t = rowtok[r]; float v = 0.f;
        if (t >= 0) { const float rs = row_rs(ssq, t); v = silu(g * rs) * (u * rs); }
        U[(size_t)r * 512 + c] = (bf16)f2bf(v);
    }
};
struct CfgDown {
    static constexpr int NB = 1; int K; const bf16* U; const float* wd; const int *rowtok, *tilee, *nt; const float* rowgate; float* out; int which;
    __device__ int rows() const { return nt[which] * 256; }
    __device__ int row_lo() const { return which == 1 ? nt[0] * 256 : 0; }
    __device__ float a(int r, int k) const { return bf2f(U[(size_t)r * 512 + k]); }
    __device__ float b(int, int k, int c, int row0) const { const int e = tilee[row0 >> 8]; return wd[((size_t)e * 512 + k) * DM + c]; }
    __device__ void epi(int r, int c, float v, float) const {
        if (which == 1 && r < nt[0] * 256) return;
        const int t = rowtok[r]; if (t >= 0) out[(size_t)t * DM + c] += rowgate[r] * v;
    }
};

__global__ void __launch_bounds__(64) k_fox_cumsum(const float* sm, const float* bfor, float* cb) {
    const int b = blockIdx.x >> 3, h = blockIdx.x & 7, lane = threadIdx.x;
    const float bias = bfor[h];
    float v[32]; float run = 0.f;
#pragma unroll
    for (int j = 0; j < 32; ++j) { const int s = lane * 32 + j; run += log_sigmoid(sm[((size_t)b * SEQ + s) * 32 + h] + bias); v[j] = run; }
    float tot = run, pre = run;
#pragma unroll
    for (int o = 1; o < 64; o <<= 1) { const float t = __shfl_up(pre, o); if (lane >= o) pre += t; }
    pre -= tot;
#pragma unroll
    for (int j = 0; j < 32; ++j) cb[((size_t)b * 8 + h) * SEQ + lane * 32 + j] = -(v[j] + pre) * LOG2E;
}
__global__ void __launch_bounds__(256) k_fox_attn(const bf16* proj, const float* cb, const float* gain, bf16* y) {
    __shared__ float pbuf[4][SEQ];
    __shared__ float qbuf[4][64];
    const int w = threadIdx.x >> 6, lane = threadIdx.x & 63;
    const int gq = blockIdx.x * 4 + w;
    const int q = gq % SEQ, h = (gq / SEQ) % 8, b = gq / (SEQ * 8);
    const size_t tok = (size_t)b * SEQ + q;
    qbuf[w][lane] = bf2f(proj[tok * PW + C_FQ + h * 64 + lane]);
    __syncthreads();
    const float* cbp = cb + ((size_t)b * 8 + h) * SEQ;
    float s[32]; float mx = -INFINITY;
#pragma unroll
    for (int j = 0; j < 32; ++j) {
        const int key = lane + 64 * j; float v = -INFINITY;
        if (key <= q) {
            const uint4* kr = (const uint4*)(proj + ((size_t)b * SEQ + key) * PW + C_FK + h * 64);
            float d = 0.f;
#pragma unroll
            for (int c8 = 0; c8 < 8; ++c8) { const uint4 u = kr[c8]; const unsigned ww[4] = {u.x, u.y, u.z, u.w};
#pragma unroll
                for (int e = 0; e < 4; ++e) { d += qbuf[w][c8 * 8 + 2 * e] * bf2f((bf16)(ww[e] & 0xffff)); d += qbuf[w][c8 * 8 + 2 * e + 1] * bf2f((bf16)(ww[e] >> 16)); } }
            v = d + cbp[key];
        }
        s[j] = v; mx = fmaxf(mx, v);
    }
    mx = wave_max(mx);
    float l = 0.f;
#pragma unroll
    for (int j = 0; j < 32; ++j) { const float pv = (lane + 64 * j <= q) ? exp2f(s[j] - mx) : 0.f; l += pv; pbuf[w][lane + 64 * j] = pv; }
    l = wave_sum(l);
    __syncthreads();
    float o = 0.f;
    for (int key = 0; key <= q; ++key) o += pbuf[w][key] * bf2f(proj[((size_t)b * SEQ + key) * PW + C_FV + h * 64 + lane]);
    o /= l;
    const float ms = wave_sum(o * o) * (1.0f / 64.0f);
    y[tok * DM + h * 64 + lane] = (bf16)f2bf(o * rsqrtf(ms + EPS) * gain[h * 64 + lane]);
}
__global__ void __launch_bounds__(256) k_gla_la(const float* sm, const float* wup, const float* balpha, float* la) {
    const int tok = blockIdx.x, c = threadIdx.x;
    float z = balpha[c];
#pragma unroll
    for (int r = 0; r < 16; ++r) z += sm[(size_t)tok * 32 + 8 + r] * wup[r * 256 + c];
    la[(size_t)tok * 256 + c] = log_sigmoid(z) * (1.0f / 16.0f);
}
__global__ void __launch_bounds__(128) k_gla_rec(const bf16* proj, const float* la, const float* gain, bf16* y) {
    __shared__ float sh_a[64], sh_k[64], sh_q[64], red[2];
    const int b = blockIdx.x >> 2, h = blockIdx.x & 3, dv = threadIdx.x;
    float st[64];
#pragma unroll
    for (int i = 0; i < 64; ++i) st[i] = 0.f;
    const float g = gain[h * 128 + dv];
    for (int t = 0; t < SEQ; ++t) {
        const size_t tok = (size_t)b * SEQ + t;
        __syncthreads();
        if (dv < 64) { sh_a[dv] = expf(la[tok * 256 + h * 64 + dv]); sh_k[dv] = bf2f(proj[tok * PW + C_GK + h * 64 + dv]); }
        else sh_q[dv - 64] = bf2f(proj[tok * PW + C_GQ + h * 64 + dv - 64]);
        __syncthreads();
        const float v = bf2f(proj[tok * PW + C_GV + h * 128 + dv]);
        float o = 0.f;
#pragma unroll
        for (int i = 0; i < 64; ++i) { st[i] = sh_a[i] * st[i] + sh_k[i] * v; o += sh_q[i] * st[i]; }
        const float ss = wave_sum(o * o);
        if ((dv & 63) == 0) red[dv >> 6] = ss;
        __syncthreads();
        const float ms = (red[0] + red[1]) * (1.0f / 128.0f);
        const float gg = bf2f(proj[tok * PW + C_GG + h * 128 + dv]);
        y[tok * DM + 512 + h * 128 + dv] = (bf16)f2bf(o * rsqrtf(ms + EPS) * g * silu(gg));
    }
}
__global__ void __launch_bounds__(256) k_xattn(bf16* xq, const bf16* xkv, int l) {
    __shared__ float pbuf[4][256];
    __shared__ float qbuf[4][128];
    const int w = threadIdx.x >> 6, lane = threadIdx.x & 63;
    const int gq = blockIdx.x * 4 + w;
    const int q = gq % SEQ, h = (gq / SEQ) % 4, b = gq / (SEQ * 4);
    const size_t tok = (size_t)b * SEQ + q;
    qbuf[w][lane] = bf2f(xq[tok * 512 + h * 128 + lane]); qbuf[w][lane + 64] = bf2f(xq[tok * 512 + h * 128 + lane + 64]);
    __syncthreads();
    float s[4]; float mx = -INFINITY;
#pragma unroll
    for (int j = 0; j < 4; ++j) {
        const int key = lane + 64 * j;
        const uint4* kr = (const uint4*)(xkv + ((size_t)b * MEML + key) * 2048 + l * 1024 + h * 128);
        float d = 0.f;
#pragma unroll
        for (int c8 = 0; c8 < 16; ++c8) { const uint4 u = kr[c8]; const unsigned ww[4] = {u.x, u.y, u.z, u.w};
#pragma unroll
            for (int e = 0; e < 4; ++e) { d += qbuf[w][c8 * 8 + 2 * e] * bf2f((bf16)(ww[e] & 0xffff)); d += qbuf[w][c8 * 8 + 2 * e + 1] * bf2f((bf16)(ww[e] >> 16)); } }
        s[j] = d; mx = fmaxf(mx, d);
    }
    mx = wave_max(mx);
    float lsum = 0.f;
#pragma unroll
    for (int j = 0; j < 4; ++j) { const float pv = exp2f(s[j] - mx); lsum += pv; pbuf[w][lane + 64 * j] = pv; }
    lsum = wave_sum(lsum);
    __syncthreads();
    float o0 = 0.f, o1 = 0.f;
    for (int key = 0; key < 256; ++key) { const bf16* vr = xkv + ((size_t)b * MEML + key) * 2048 + l * 1024 + 512 + h * 128; const float pv = pbuf[w][key]; o0 += pv * bf2f(vr[lane]); o1 += pv * bf2f(vr[lane + 64]); }
    xq[tok * 512 + h * 128 + lane] = (bf16)f2bf(o0 / lsum); xq[tok * 512 + h * 128 + lane + 64] = (bf16)f2bf(o1 / lsum);
}
__global__ void __launch_bounds__(256) k_router(const float* h, const float* gain, const float* wrg, const float* brg, const float* wre, const float* bre, int2* toke, float2* tokg) {
    const int lane = threadIdx.x & 63, tok = blockIdx.x * 4 + (threadIdx.x >> 6);
    const float* hr = h + (size_t)tok * DM;
    float hv[16]; float q = 0.f;
#pragma unroll
    for (int j = 0; j < 16; ++j) { hv[j] = hr[lane + 64 * j]; q += hv[j] * hv[j]; }
    q = wave_sum(q);
    const float rs = rsqrtf(q * (1.0f / DM) + EPS);
#pragma unroll
    for (int j = 0; j < 16; ++j) hv[j] = hv[j] * rs * gain[lane + 64 * j];
    float lg[20];
#pragma unroll
    for (int o = 0; o < 20; ++o) {
        float d = 0.f;
#pragma unroll
        for (int j = 0; j < 16; ++j) { const int k = lane + 64 * j; d += hv[j] * (o < 4 ? wrg[k * 4 + o] : wre[k * 16 + (o - 4)]); }
        lg[o] = wave_sum(d) + (o < 4 ? brg[o] : bre[o - 4]);
    }
    if (lane == 0) {
        int g = 0; float gm = lg[0];
#pragma unroll
        for (int i = 1; i < 4; ++i) if (lg[i] > gm) { gm = lg[i]; g = i; }
        float den = 0.f;
#pragma unroll
        for (int i = 0; i < 4; ++i) den += expf(lg[i] - gm);
        const float pg = 1.0f / den;
        float el[4];
#pragma unroll
        for (int i = 0; i < 4; ++i) { float v = lg[4];
#pragma unroll
            for (int gg = 0; gg < 4; ++gg) if (gg == g) v = lg[4 + gg * 4 + i];
            el[i] = v; }
        int i0 = 0; float m0 = el[0];
#pragma unroll
        for (int i = 1; i < 4; ++i) if (el[i] > m0) { m0 = el[i]; i0 = i; }
        int i1 = -1; float m1 = -INFINITY;
#pragma unroll
        for (int i = 0; i < 4; ++i) if (i != i0 && el[i] > m1) { m1 = el[i]; i1 = i; }
        const float e1 = expf(m1 - m0), inv = 1.0f / (1.0f + e1);
        toke[tok] = make_int2(g * 4 + i0, g * 4 + i1);
        tokg[tok] = make_float2(pg * inv, pg * e1 * inv);
    }
}
__global__ void k_sort(const int2* toke, const float2* tokg, int* rowtok, float* rowgate, int* tilee, int* nt) {
    __shared__ int cnt[32], base[32];
    if (threadIdx.x != 0 || blockIdx.x != 0) return;
    for (int i = 0; i < 32; ++i) cnt[i] = 0;
    for (int t = 0; t < NTOK; ++t) { const int2 e = toke[t]; cnt[e.x]++; cnt[16 + e.y]++; }
    int tile = 0;
    for (int k = 0; k < 2; ++k) { for (int e = 0; e < 16; ++e) { base[k * 16 + e] = tile * 256; const int n = (cnt[k * 16 + e] + 255) / 256; for (int i = 0; i < n; ++i) tilee[tile + i] = e; tile += n; } nt[k] = tile; }
    for (int r = 0; r < tile * 256; ++r) { rowtok[r] = -1; rowgate[r] = 0.f; }
    for (int t = 0; t < NTOK; ++t) {
        const int2 e = toke[t]; const float2 g = tokg[t];
        { const int pos = base[e.x]++; rowtok[pos] = t; rowgate[pos] = g.x; }
        { const int pos = base[16 + e.y]++; rowtok[pos] = t; rowgate[pos] = g.y; }
    }
}

extern "C" void kernel_launch(void* const* d_in, const int* in_sizes, int n_in, void* d_out, int out_size, void* d_ws, size_t ws_size, hipStream_t stream) {
    if (n_in != 25 || out_size != NTOK * DM || ws_size < WS_END) { fprintf(stderr, "kernel_launch: unexpected sizes n_in %d out %d ws %zu (need %zu)\n", n_in, out_size, ws_size, (size_t)WS_END); return; }
    P p{};
    const float** pp = (const float**)&p;
    for (int i = 0; i < 25; ++i) pp[i] = (const float*)d_in[i];
    p.out = (float*)d_out; p.ws = (unsigned char*)d_ws;
    bf16* HB = WSP(bf16, WS_HB); bf16* PROJ = WSP(bf16, WS_PROJ); float* SM = WSP(float, WS_SM); float* CB = WSP(float, WS_CB); bf16* Y = WSP(bf16, WS_Y);
    bf16* XKV = WSP(bf16, WS_XKV); bf16* MEMN = WSP(bf16, WS_MEMN); float* SSQ = WSP(float, WS_SSQ); bf16* XQ = WSP(bf16, WS_XQ); bf16* U = WSP(bf16, WS_U);
    float* LA = WSP(float, WS_HB);
    int2* TOKE = WSP(int2, WS_MOE + MO_TOKE); float2* TOKG = WSP(float2, WS_MOE + MO_TOKG); int* ROWTOK = WSP(int, WS_MOE + MO_ROWTOK); float* ROWGATE = WSP(float, WS_MOE + MO_ROWGATE);
    int* TILEE = WSP(int, WS_MOE + MO_TILEE); int* NT = WSP(int, WS_MOE + MO_NT);
    float* H = p.out;

    k_rowprep<<<4096 / 4, 256, 0, stream>>>(p.mem, MEMN, nullptr, p.mem_norm, 4096, 1);
    for (int l = 0; l < NLAYER; ++l) {
        CfgXKV c{DM, MEMN, p.w_xk + (size_t)l * DM * 512, p.w_xv + (size_t)l * DM * 512, XKV, l};
        k_ngemm<<<dim3(1024 / 64, 4096 / 64), 256, 0, stream>>>(c);
    }
    k_rowprep<<<NTOK / 4, 256, 0, stream>>>(p.x, HB, SSQ, nullptr, NTOK, 0);
    for (int l = 0; l < NLAYER; ++l) {
        const float* base = l == 0 ? p.x : H;
        { CfgInProj c{DM, HB, p.w_in + (size_t)l * DM * INW, p.mix_norm + l * DM, SSQ, PROJ, SM};
          k_ngemm<<<dim3((INW + 63) / 64, NTOK / 64), 256, 0, stream>>>(c); }
        k_fox_cumsum<<<NBATCH * 8, 64, 0, stream>>>(SM, p.b_forget + l * 8, CB);
        k_gla_la<<<NTOK, 256, 0, stream>>>(SM, p.w_alpha_up + l * 16 * 256, p.b_alpha + l * 256, LA);
        k_fox_attn<<<NBATCH * 8 * SEQ / 4, 256, 0, stream>>>(PROJ, CB, p.fox_gain + l * 512, Y);
        k_gla_rec<<<NBATCH * 4, 128, 0, stream>>>(PROJ, LA, p.gla_gain + l * 512, Y);
        { CfgRes c{DM, Y, p.w_out + (size_t)l * DM * DM, base, H};
          k_ngemm<<<dim3(DM / 64, NTOK / 64), 256, 0, stream>>>(c); }
        k_rowprep<<<NTOK / 4, 256, 0, stream>>>(H, HB, SSQ, nullptr, NTOK, 0);
        { CfgXQ c{DM, HB, p.w_xq + (size_t)l * DM * 512, p.cross_norm + l * DM, SSQ, XQ};
          k_ngemm<<<dim3(512 / 64, NTOK / 64), 256, 0, stream>>>(c); }
        k_xattn<<<NBATCH * 4 * SEQ / 4, 256, 0, stream>>>(XQ, XKV, l);
        { CfgRes c{512, XQ, p.w_xo + (size_t)l * 512 * DM, H, H};
          k_ngemm<<<dim3(DM / 64, NTOK / 64), 256, 0, stream>>>(c); }
        k_rowprep<<<NTOK / 4, 256, 0, stream>>>(H, HB, SSQ, nullptr, NTOK, 0);
        k_router<<<NTOK / 4, 256, 0, stream>>>(H, p.moe_norm + l * DM, p.w_rg + l * DM * 4, p.b_rg + l * 4, p.w_re + l * DM * 16, p.b_re + l * 16, TOKE, TOKG);
        k_sort<<<1, 64, 0, stream>>>(TOKE, TOKG, ROWTOK, ROWGATE, TILEE, NT);
        { CfgGU c{DM, HB, p.w_eg + (size_t)l * 16 * DM * 512, p.w_eu + (size_t)l * 16 * DM * 512, p.moe_norm + l * DM, SSQ, ROWTOK, TILEE, NT, U};
          k_ngemm<<<dim3(512 / 64, MAXROWS / 64), 256, 0, stream>>>(c); }
        for (int k = 0; k < 2; ++k) {
            CfgDown c{512, U, p.w_ed + (size_t)l * 16 * 512 * DM, ROWTOK, TILEE, NT, ROWGATE, H, k};
            k_ngemm<<<dim3(DM / 64, MAXROWS / 64), 256, 0, stream>>>(c);
        }
        if (l + 1 < NLAYER) k_rowprep<<<NTOK / 4, 256, 0, stream>>>(H, HB, SSQ, nullptr, NTOK, 0);
    }
    k_final<<<NTOK / 4, 256, 0, stream>>>(H, p.final_norm);
}
```

```cpp
#include <hip/hip_runtime.h>
#include <cstdio>
#include <cstdint>

constexpr int NTOK = 32768, DM = 1024, NBATCH = 16, SEQ = 2048, NLAYER = 2, MEML = 256;
constexpr int PW = 3072;
constexpr int C_FQ = 0, C_FK = 512, C_FV = 1024, C_GQ = 1536, C_GK = 1792, C_GV = 2048, C_GG = 2560;
constexpr int INW = 3096;
constexpr float EPS = 1e-6f, LOG2E = 1.4426950408889634f;
constexpr int MAXTILES = 288;
constexpr int MAXROWS = MAXTILES * 256;

typedef unsigned short bf16;
__device__ __forceinline__ unsigned f2bf(float f) { unsigned u = __builtin_bit_cast(unsigned, f); return (u + 0x7fffu + ((u >> 16) & 1u)) >> 16; }
__device__ __forceinline__ float bf2f(bf16 b) { return __builtin_bit_cast(float, ((unsigned)b) << 16); }

constexpr size_t MiB = 1u << 20;
constexpr size_t WS_CTL = 0;
constexpr size_t WS_W = 1 * MiB;
constexpr size_t WS_WLAYER = 59 * MiB;
constexpr size_t WS_WXKV = WS_W + 2 * WS_WLAYER;
constexpr size_t WS_HB = WS_WXKV + 4 * MiB;
constexpr size_t WS_PROJ = WS_HB + 64 * MiB;
constexpr size_t WS_XQ = WS_PROJ;
constexpr size_t WS_U = WS_PROJ + 32 * MiB;
constexpr size_t WS_SM = WS_PROJ + 192 * MiB;
constexpr size_t WS_CB = WS_SM + 4 * MiB;
constexpr size_t WS_Y = WS_CB + 1 * MiB;
constexpr size_t WS_XKV = WS_Y + 64 * MiB;
constexpr size_t WS_MEMN = WS_XKV + 16 * MiB;
constexpr size_t WS_SSQ = WS_MEMN + 8 * MiB;
constexpr size_t WS_MOE = WS_SSQ + 2 * MiB;
constexpr size_t WS_END = WS_MOE + 2 * MiB;
static_assert(WS_END <= 512 * MiB, "workspace map");
constexpr size_t MO_TOKE = 0;
constexpr size_t MO_TOKG = 256 * 1024;
constexpr size_t MO_ROWTOK = 512 * 1024;
constexpr size_t MO_ROWGATE = 832 * 1024;
constexpr size_t MO_TILEE = 1152 * 1024;
constexpr size_t MO_NT = 1156 * 1024;
constexpr size_t MO_HIST = 1160 * 1024;

struct P {
    const float *x, *mem, *mem_norm, *mix_norm, *w_in, *b_forget, *w_alpha_up, *b_alpha, *fox_gain, *gla_gain, *w_out, *cross_norm, *w_xq, *w_xk, *w_xv, *w_xo,
        *moe_norm, *w_rg, *b_rg, *w_re, *b_re, *w_eg, *w_eu, *w_ed, *final_norm;
    float* out; unsigned char* ws;
};
__host__ __device__ __forceinline__ unsigned char* ws_base(unsigned char* w) {
#if defined(__HIP_DEVICE_COMPILE__)
    asm volatile("" : "+s"(w));
#endif
    return w; }
#define WSP(T, off) ((T*)(ws_base(p.ws) + (off)))

__device__ __forceinline__ float wave_sum(float v) {
#pragma unroll
    for (int o = 1; o < 64; o <<= 1) v += __shfl_xor(v, o);
    return v;
}
__device__ __forceinline__ float wave_max(float v) {
#pragma unroll
    for (int o = 1; o < 64; o <<= 1) v = fmaxf(v, __shfl_xor(v, o));
    return v;
}
__device__ __forceinline__ float row_rs(const float* ssq, int row) {
    const float4* s = (const float4*)(ssq + (size_t)row * 16);
    float4 a = s[0], b = s[1], c = s[2], d = s[3];
    float t = ((a.x + a.y) + (a.z + a.w)) + ((b.x + b.y) + (b.z + b.w)) + ((c.x + c.y) + (c.z + c.w)) + ((d.x + d.y) + (d.z + d.w));
    return rsqrtf(t * (1.0f / DM) + EPS);
}
__device__ __forceinline__ float log_sigmoid(float z) { return fminf(z, 0.f) - log1pf(expf(-fabsf(z))); }
__device__ __forceinline__ float silu(float z) { return z / (1.f + expf(-z)); }

__global__ void __launch_bounds__(256) k_rowprep(const float* src, bf16* dst, float* ssq, const float* gain, int rows, int mode) {
    const int lane = threadIdx.x & 63, row = blockIdx.x * 4 + (threadIdx.x >> 6);
    if (row >= rows) return;
    const float4* s = (const float4*)(src + (size_t)row * DM) + lane;
    float4 v[4]; float q = 0.f;
#pragma unroll
    for (int j = 0; j < 4; ++j) { v[j] = s[64 * j]; q += (v[j].x * v[j].x + v[j].y * v[j].y) + (v[j].z * v[j].z + v[j].w * v[j].w); }
    q = wave_sum(q);
    float sc = 1.f;
    if (mode == 1) sc = rsqrtf(q * (1.0f / DM) + EPS);
    else if (lane < 16) ssq[(size_t)row * 16 + lane] = lane == 0 ? q : 0.f;
    uint2* d = (uint2*)(dst + (size_t)row * DM) + lane;
#pragma unroll
    for (int j = 0; j < 4; ++j) {
        float4 g = mode == 1 ? ((const float4*)gain)[lane + 64 * j] : make_float4(1.f, 1.f, 1.f, 1.f);
        d[64 * j] = make_uint2(f2bf(v[j].x * sc * g.x) | (f2bf(v[j].y * sc * g.y) << 16), f2bf(v[j].z * sc * g.z) | (f2bf(v[j].w * sc * g.w) << 16));
    }
}
__global__ void __launch_bounds__(256) k_final(float* io, const float* gain) {
    const int lane = threadIdx.x & 63, row = blockIdx.x * 4 + (threadIdx.x >> 6);
    float4* s = (float4*)(io + (size_t)row * DM) + lane;
    float4 v[4]; float q = 0.f;
#pragma unroll
    for (int j = 0; j < 4; ++j) { v[j] = s[64 * j]; q += (v[j].x * v[j].x + v[j].y * v[j].y) + (v[j].z * v[j].z + v[j].w * v[j].w); }
    q = wave_sum(q);
    const float sc = rsqrtf(q * (1.0f / DM) + EPS);
#pragma unroll
    for (int j = 0; j < 4; ++j) { float4 g = ((const float4*)gain)[lane + 64 * j]; s[64 * j] = make_float4(v[j].x * sc * g.x, v[j].y * sc * g.y, v[j].z * sc * g.z, v[j].w * sc * g.w); }
}

template <class C> __global__ void __launch_bounds__(256) k_ngemm(C c) {
    __shared__ float As[16][65];
    __shared__ float Bs[C::NB][16][65];
    const int M = c.rows();
    const int row0 = blockIdx.y * 64, col0 = blockIdx.x * 64;
    if (row0 >= M || row0 < c.row_lo()) return;
    const int tx = threadIdx.x & 15, ty = threadIdx.x >> 4;
    float acc[C::NB][4][4];
#pragma unroll
    for (int n = 0; n < C::NB; ++n)
#pragma unroll
        for (int i = 0; i < 4; ++i)
#pragma unroll
            for (int j = 0; j < 4; ++j) acc[n][i][j] = 0.f;
    for (int k0 = 0; k0 < c.K; k0 += 16) {
#pragma unroll
        for (int i = 0; i < 4; ++i) { const int idx = threadIdx.x + 256 * i, r = idx >> 4, kk = idx & 15; As[kk][r] = c.a(row0 + r, k0 + kk); }
#pragma unroll
        for (int n = 0; n < C::NB; ++n)
#pragma unroll
            for (int i = 0; i < 4; ++i) { const int idx = threadIdx.x + 256 * i, kk = idx >> 6, cc = idx & 63; Bs[n][kk][cc] = c.b(n, k0 + kk, col0 + cc, row0); }
        __syncthreads();
#pragma unroll
        for (int kk = 0; kk < 16; ++kk) {
            float a[4];
#pragma unroll
            for (int i = 0; i < 4; ++i) a[i] = As[kk][ty * 4 + i];
#pragma unroll
            for (int n = 0; n < C::NB; ++n) {
                float b[4];
#pragma unroll
                for (int j = 0; j < 4; ++j) b[j] = Bs[n][kk][tx * 4 + j];
#pragma unroll
                for (int i = 0; i < 4; ++i)
#pragma unroll
                    for (int j = 0; j < 4; ++j) acc[n][i][j] += a[i] * b[j];
            }
        }
        __syncthreads();
    }
#pragma unroll
    for (int i = 0; i < 4; ++i)
#pragma unroll
        for (int j = 0; j < 4; ++j) c.epi(row0 + ty * 4 + i, col0 + tx * 4 + j, acc[0][i][j], acc[C::NB - 1][i][j]);
}

struct CfgXKV {
    __device__ int row_lo() const { return 0; }
    static constexpr int NB = 1; int K; const bf16* A; const float *wk, *wv; bf16* O; int l;
    __device__ int rows() const { return 4096; }
    __device__ float a(int r, int k) const { return bf2f(A[(size_t)r * DM + k]); }
    __device__ float b(int, int k, int c, int) const { return c < 512 ? wk[(size_t)k * 512 + c] : wv[(size_t)k * 512 + c - 512]; }
    __device__ void epi(int r, int c, float v, float) const { O[(size_t)r * 2048 + l * 1024 + c] = (bf16)f2bf(v); }
};
struct CfgInProj {
    __device__ int row_lo() const { return 0; }
    static constexpr int NB = 1; int K; const bf16* A; const float *w, *gain, *ssq; bf16* proj; float* sm;
    __device__ int rows() const { return NTOK; }
    __device__ float a(int r, int k) const { return bf2f(A[(size_t)r * DM + k]); }
    __device__ float b(int, int k, int c, int) const { return c < INW ? gain[k] * w[(size_t)k * INW + c] : 0.f; }
    __device__ void epi(int r, int c, float v, float) const {
        if (c >= INW) return;
        v *= row_rs(ssq, r);
        if (c < 1536) { if (c < 512) v *= 0.125f * LOG2E; proj[(size_t)r * PW + c] = (bf16)f2bf(v); }
        else if (c < 1544) sm[(size_t)r * 32 + (c - 1536)] = v;
        else if (c < 3080) { if (c < 1800) v *= 0.125f; proj[(size_t)r * PW + (c - 8)] = (bf16)f2bf(v); }
        else sm[(size_t)r * 32 + 8 + (c - 3080)] = v;
    }
};
struct CfgRes {
    __device__ int row_lo() const { return 0; }
    static constexpr int NB = 1; int K; const bf16* A; const float* w; const float* base; float* out;
    __device__ int rows() const { return NTOK; }
    __device__ float a(int r, int k) const { return bf2f(A[(size_t)r * K + k]); }
    __device__ float b(int, int k, int c, int) const { return w[(size_t)k * DM + c]; }
    __device__ void epi(int r, int c, float v, float) const { out[(size_t)r * DM + c] = base[(size_t)r * DM + c] + v; }
};
struct CfgXQ {
    __device__ int row_lo() const { return 0; }
    static constexpr int NB = 1; int K; const bf16* A; const float *w, *gain, *ssq; bf16* O;
    __device__ int rows() const { return NTOK; }
    __device__ float a(int r, int k) const { return bf2f(A[(size_t)r * DM + k]); }
    __device__ float b(int, int k, int c, int) const { return gain[k] * w[(size_t)k * 512 + c]; }
    __device__ void epi(int r, int c, float v, float) const { O[(size_t)r * 512 + c] = (bf16)f2bf(v * row_rs(ssq, r) * (0.08838834764831845f * LOG2E)); }
};
struct CfgGU {
    __device__ int row_lo() const { return 0; }
    static constexpr int NB = 2; int K; const bf16* A; const float *wg, *wu, *gain, *ssq; const int *rowtok, *tilee, *nt; bf16* U;
    __device__ int rows() const { return nt[1] * 256; }
    __device__ float a(int r, int k) const { int t = rowtok[r]; t = t < 0 ? 0 : t; return bf2f(A[(size_t)t * DM + k]); }
    __device__ float b(int n, int k, int c, int row0) const { const int e = tilee[row0 >> 8]; const size_t o = ((size_t)e * DM + k) * 512 + c; return n == 0 ? gain[k] * wg[o] : gain[k] * wu[o]; }
    __device__ void epi(int r, int c, float g, float u) const {
        const int t = rowtok[r]; float v = 0.f;
        if (t >= 0) { const float rs = row_rs(ssq, t); v = silu(g * rs) * (u * rs); }
        U[(size_t)r * 512 + c] = (bf16)f2bf(v);
    }
};
struct CfgDown {
    static constexpr int NB = 1; int K; const bf16* U; const float* wd; const int *rowtok, *tilee, *nt; const float* rowgate; float* out; int which;
    __device__ int rows() const { return nt[which] * 256; }
    __device__ int row_lo() const { return which == 1 ? nt[0] * 256 : 0; }
    __device__ float a(int r, int k) const { return bf2f(U[(size_t)r * 512 + k]); }
    __device__ float b(int, int k, int c, int row0) const { const int e = tilee[row0 >> 8]; return wd[((size_t)e * 512 + k) * DM + c]; }
    __device__ void epi(int r, int c, float v, float) const {
        if (which == 1 && r < nt[0] * 256) return;
        const int t = rowtok[r]; if (t >= 0) out[(size_t)t * DM + c] += rowgate[r] * v;
    }
};

__global__ void __launch_bounds__(64) k_fox_cumsum(const float* sm, const float* bfor, float* cb) {
    const int b = blockIdx.x >> 3, h = blockIdx.x & 7, lane = threadIdx.x;
    const float bias = bfor[h];
    float v[32]; float run = 0.f;
#pragma unroll
    for (int j = 0; j < 32; ++j) { const int s = lane * 32 + j; run += log_sigmoid(sm[((size_t)b * SEQ + s) * 32 + h] + bias); v[j] = run; }
    float tot = run, pre = run;
#pragma unroll
    for (int o = 1; o < 64; o <<= 1) { const float t = __shfl_up(pre, o); if (lane >= o) pre += t; }
    pre -= tot;
#pragma unroll
    for (int j = 0; j < 32; ++j) cb[((size_t)b * 8 + h) * SEQ + lane * 32 + j] = -(v[j] + pre) * LOG2E;
}
__global__ void __launch_bounds__(256) k_fox_attn(const bf16* proj, const float* cb, const float* gain, bf16* y) {
    __shared__ float pbuf[4][SEQ];
    __shared__ float qbuf[4][64];
    const int w = threadIdx.x >> 6, lane = threadIdx.x & 63;
    const int gq = blockIdx.x * 4 + w;
    const int q = gq % SEQ, h = (gq / SEQ) % 8, b = gq / (SEQ * 8);
    const size_t tok = (size_t)b * SEQ + q;
    qbuf[w][lane] = bf2f(proj[tok * PW + C_FQ + h * 64 + lane]);
    __syncthreads();
    const float* cbp = cb + ((size_t)b * 8 + h) * SEQ;
    float s[32]; float mx = -INFINITY;
#pragma unroll
    for (int j = 0; j < 32; ++j) {
        const int key = lane + 64 * j; float v = -INFINITY;
        if (key <= q) {
            const uint4* kr = (const uint4*)(proj + ((size_t)b * SEQ + key) * PW + C_FK + h * 64);
            float d = 0.f;
#pragma unroll
            for (int c8 = 0; c8 < 8; ++c8) { const uint4 u = kr[c8]; const unsigned ww[4] = {u.x, u.y, u.z, u.w};
#pragma unroll
                for (int e = 0; e < 4; ++e) { d += qbuf[w][c8 * 8 + 2 * e] * bf2f((bf16)(ww[e] & 0xffff)); d += qbuf[w][c8 * 8 + 2 * e + 1] * bf2f((bf16)(ww[e] >> 16)); } }
            v = d + cbp[key];
        }
        s[j] = v; mx = fmaxf(mx, v);
    }
    mx = wave_max(mx);
    float l = 0.f;
#pragma unroll
    for (int j = 0; j < 32; ++j) { const float pv = (lane + 64 * j <= q) ? exp2f(s[j] - mx) : 0.f; l += pv; pbuf[w][lane + 64 * j] = pv; }
    l = wave_sum(l);
    __syncthreads();
    float o = 0.f;
    for (int key = 0; key <= q; ++key) o += pbuf[w][key] * bf2f(proj[((size_t)b * SEQ + key) * PW + C_FV + h * 64 + lane]);
    o /= l;
    const float ms = wave_sum(o * o) * (1.0f / 64.0f);
    y[tok * DM + h * 64 + lane] = (bf16)f2bf(o * rsqrtf(ms + EPS) * gain[h * 64 + lane]);
}
__global__ void __launch_bounds__(256) k_gla_la(const float* sm, const float* wup, const float* balpha, float* la) {
    const int tok = blockIdx.x, c = threadIdx.x;
    float z = balpha[c];
#pragma unroll
    for (int r = 0; r < 16; ++r) z += sm[(size_t)tok * 32 + 8 + r] * wup[r * 256 + c];
    la[(size_t)tok * 256 + c] = log_sigmoid(z) * (1.0f / 16.0f);
}
__global__ void __launch_bounds__(128) k_gla_rec(const bf16* proj, const float* la, const float* gain, bf16* y) {
    __shared__ float sh_a[64], sh_k[64], sh_q[64], red[2];
    const int b = blockIdx.x >> 2, h = blockIdx.x & 3, dv = threadIdx.x;
    float st[64];
#pragma unroll
    for (int i = 0; i < 64; ++i) st[i] = 0.f;
    const float g = gain[h * 128 + dv];
    for (int t = 0; t < SEQ; ++t) {
        const size_t tok = (size_t)b * SEQ + t;
        __syncthreads();
        if (dv < 64) { sh_a[dv] = expf(la[tok * 256 + h * 64 + dv]); sh_k[dv] = bf2f(proj[tok * PW + C_GK + h * 64 + dv]); }
        else sh_q[dv - 64] = bf2f(proj[tok * PW + C_GQ + h * 64 + dv - 64]);
        __syncthreads();
        const float v = bf2f(proj[tok * PW + C_GV + h * 128 + dv]);
        float o = 0.f;
#pragma unroll
        for (int i = 0; i < 64; ++i) { st[i] = sh_a[i] * st[i] + sh_k[i] * v; o += sh_q[i] * st[i]; }
        const float ss = wave_sum(o * o);
        if ((dv & 63) == 0) red[dv >> 6] = ss;
        __syncthreads();
        const float ms = (red[0] + red[1]) * (1.0f / 128.0f);
        const float gg = bf2f(proj[tok * PW + C_GG + h * 128 + dv]);
        y[tok * DM + 512 + h * 128 + dv] = (bf16)f2bf(o * rsqrtf(ms + EPS) * g * silu(gg));
    }
}
__global__ void __launch_bounds__(256) k_xattn(bf16* xq, const bf16* xkv, int l) {
    __shared__ float pbuf[4][256];
    __shared__ float qbuf[4][128];
    const int w = threadIdx.x >> 6, lane = threadIdx.x & 63;
    const int gq = blockIdx.x * 4 + w;
    const int q = gq % SEQ, h = (gq / SEQ) % 4, b = gq / (SEQ * 4);
    const size_t tok = (size_t)b * SEQ + q;
    qbuf[w][lane] = bf2f(xq[tok * 512 + h * 128 + lane]); qbuf[w][lane + 64] = bf2f(xq[tok * 512 + h * 128 + lane + 64]);
    __syncthreads();
    float s[4]; float mx = -INFINITY;
#pragma unroll
    for (int j = 0; j < 4; ++j) {
        const int key = lane + 64 * j;
        const uint4* kr = (const uint4*)(xkv + ((size_t)b * MEML + key) * 2048 + l * 1024 + h * 128);
        float d = 0.f;
#pragma unroll
        for (int c8 = 0; c8 < 16; ++c8) { const uint4 u = kr[c8]; const unsigned ww[4] = {u.x, u.y, u.z, u.w};
#pragma unroll
            for (int e = 0; e < 4; ++e) { d += qbuf[w][c8 * 8 + 2 * e] * bf2f((bf16)(ww[e] & 0xffff)); d += qbuf[w][c8 * 8 + 2 * e + 1] * bf2f((bf16)(ww[e] >> 16)); } }
        s[j] = d; mx = fmaxf(mx, d);
    }
    mx = wave_max(mx);
    float lsum = 0.f;
#pragma unroll
    for (int j = 0; j < 4; ++j) { const float pv = exp2f(s[j] - mx); lsum += pv; pbuf[w][lane + 64 * j] = pv; }
    lsum = wave_sum(lsum);
    __syncthreads();
    float o0 = 0.f, o1 = 0.f;
    for (int key = 0; key < 256; ++key) { const bf16* vr = xkv + ((size_t)b * MEML + key) * 2048 + l * 1024 + 512 + h * 128; const float pv = pbuf[w][key]; o0 += pv * bf2f(vr[lane]); o1 += pv * bf2f(vr[lane + 64]); }
    xq[tok * 512 + h * 128 + lane] = (bf16)f2bf(o0 / lsum); xq[tok * 512 + h * 128 + lane + 64] = (bf16)f2bf(o1 / lsum);
}
__global__ void __launch_bounds__(256) k_router(const float* h, const float* gain, const float* wrg, const float* brg, const float* wre, const float* bre, int2* toke, float2* tokg) {
    const int lane = threadIdx.x & 63, tok = blockIdx.x * 4 + (threadIdx.x >> 6);
    const float* hr = h + (size_t)tok * DM;
    float hv[16]; float q = 0.f;
#pragma unroll
    for (int j = 0; j < 16; ++j) { hv[j] = hr[lane + 64 * j]; q += hv[j] * hv[j]; }
    q = wave_sum(q);
    const float rs = rsqrtf(q * (1.0f / DM) + EPS);
#pragma unroll
    for (int j = 0; j < 16; ++j) hv[j] = hv[j] * rs * gain[lane + 64 * j];
    float lg[20];
#pragma unroll
    for (int o = 0; o < 20; ++o) {
        float d = 0.f;
#pragma unroll
        for (int j = 0; j < 16; ++j) { const int k = lane + 64 * j; d += hv[j] * (o < 4 ? wrg[k * 4 + o] : wre[k * 16 + (o - 4)]); }
        lg[o] = wave_sum(d) + (o < 4 ? brg[o] : bre[o - 4]);
    }
    if (lane == 0) {
        int g = 0; float gm = lg[0];
#pragma unroll
        for (int i = 1; i < 4; ++i) if (lg[i] > gm) { gm = lg[i]; g = i; }
        float den = 0.f;
#pragma unroll
        for (int i = 0; i < 4; ++i) den += expf(lg[i] - gm);
        const float pg = 1.0f / den;
        float el[4];
#pragma unroll
        for (int i = 0; i < 4; ++i) { float v = lg[4];
#pragma unroll
            for (int gg = 0; gg < 4; ++gg) if (gg == g) v = lg[4 + gg * 4 + i];
            el[i] = v; }
        int i0 = 0; float m0 = el[0];
#pragma unroll
        for (int i = 1; i < 4; ++i) if (el[i] > m0) { m0 = el[i]; i0 = i; }
        int i1 = -1; float m1 = -INFINITY;
#pragma unroll
        for (int i = 0; i < 4; ++i) if (i != i0 && el[i] > m1) { m1 = el[i]; i1 = i; }
        const float e1 = expf(m1 - m0), inv = 1.0f / (1.0f + e1);
        toke[tok] = make_int2(g * 4 + i0, g * 4 + i1);
        tokg[tok] = make_float2(pg * inv, pg * e1 * inv);
    }
}
__global__ void k_sort(const int2* toke, const float2* tokg, int* rowtok, float* rowgate, int* tilee, int* nt) {
    __shared__ int cnt[32], base[32];
    if (threadIdx.x != 0 || blockIdx.x != 0) return;
    for (int i = 0; i < 32; ++i) cnt[i] = 0;
    for (int t = 0; t < NTOK; ++t) { const int2 e = toke[t]; cnt[e.x]++; cnt[16 + e.y]++; }
    int tile = 0;
    for (int k = 0; k < 2; ++k) { for (int e = 0; e < 16; ++e) { base[k * 16 + e] = tile * 256; const int n = (cnt[k * 16 + e] + 255) / 256; for (int i = 0; i < n; ++i) tilee[tile + i] = e; tile += n; } nt[k] = tile; }
    for (int r = 0; r < tile * 256; ++r) { rowtok[r] = -1; rowgate[r] = 0.f; }
    for (int t = 0; t < NTOK; ++t) {
        const int2 e = toke[t]; const float2 g = tokg[t];
        { const int pos = base[e.x]++; rowtok[pos] = t; rowgate[pos] = g.x; }
        { const int pos = base[16 + e.y]++; rowtok[pos] = t; rowgate[pos] = g.y; }
    }
}

#define XB_TMO      128
#define XB_XCNT(j)  (256  + 64 * (j))
#define XB_XSUB(j)  (1280 + 64 * (j))
#define XB_XGEN(j)  (2304 + 64 * (j))
#define XB_TOP      3328
#define XB_TOPGEN   3392
#define XCD_BAR_WORDS 3456
#define XB_SPIN_CAP (1u << 18)
#define LAS __attribute__((address_space(3)))

__device__ __forceinline__ unsigned xb_ld(unsigned* p)              { return __hip_atomic_load(p, __ATOMIC_RELAXED, __HIP_MEMORY_SCOPE_AGENT); }
__device__ __forceinline__ unsigned xb_add(unsigned* p, unsigned v) { return __hip_atomic_fetch_add(p, v, __ATOMIC_RELAXED, __HIP_MEMORY_SCOPE_AGENT); }
__device__ __forceinline__ unsigned xb_xcc_id() { return (unsigned)__builtin_amdgcn_s_getreg((3 << 11) | 20) & 0xFu; }
#define XB_SPIN(cond, bar) do { unsigned _sp = 0; while (cond) { __builtin_amdgcn_s_sleep(1); \
    if ((++_sp & 255u) == 0u) { if (xb_ld(&(bar)[XB_TMO])) break; if (_sp > XB_SPIN_CAP) { atomicAdd(&(bar)[XB_TMO], 1u); break; } } } } while (0)

struct XcdBarrier {
    unsigned* bar; unsigned x;
    volatile LAS unsigned* st;
};

__device__ __forceinline__ XcdBarrier xcd_barrier_post(unsigned* bar, volatile LAS unsigned* st) {
    XcdBarrier b; b.bar = bar; b.x = xb_xcc_id(); b.st = st;
    if (threadIdx.x == 0) (void)xb_add(&bar[XB_XCNT(b.x)], 1u);
    return b;
}
__device__ __forceinline__ void xcd_barrier_complete(unsigned* bar, unsigned x, unsigned& nloc, unsigned& nx) {
    const unsigned G = gridDim.x * gridDim.y * gridDim.z;
    unsigned sum, cnt, mine, sp = 0u;
    for (;;) {
        sum = 0u; cnt = 0u; mine = 0u;
#pragma unroll
        for (unsigned j = 0; j < 16; ++j) { const unsigned c = xb_ld(&bar[XB_XCNT(j)]); sum += c; cnt += (c > 0u) ? 1u : 0u; mine = (j == x) ? c : mine; }
        if (sum == G) break;
        __builtin_amdgcn_s_sleep(1);
        if ((++sp & 255u) == 0u) { if (xb_ld(&bar[XB_TMO])) break; if (sp > XB_SPIN_CAP) { atomicAdd(&bar[XB_TMO], 1u); break; } }
    }
    nloc = mine > 0u ? mine : 1u; nx = cnt > 0u ? cnt : 1u;
}

__device__ __forceinline__ void xcd_barrier(const XcdBarrier& b) {
    asm volatile("s_waitcnt vmcnt(0)" ::: "memory");
    __syncthreads();
    if (threadIdx.x == 0) {
        unsigned* bar = b.bar;
        __builtin_amdgcn_s_waitcnt(0);
        unsigned nloc = b.st[0], nx = b.st[1];
        if (nloc == 0u) { xcd_barrier_complete(bar, b.x, nloc, nx); b.st[0] = nloc; b.st[1] = nx; }
        const unsigned old = xb_add(&bar[XB_XSUB(b.x)], 1u);
        const unsigned gen = old / nloc;
        if (old + 1u == (gen + 1u) * nloc) {
            __builtin_amdgcn_fence(__ATOMIC_RELEASE, "agent");
            asm volatile("s_waitcnt vmcnt(0)" ::: "memory");
            const unsigned og = xb_add(&bar[XB_TOP], 1u);
            const unsigned tg = og / nx;
            if (og + 1u == (tg + 1u) * nx) xb_add(&bar[XB_TOPGEN], 1u);
            else XB_SPIN(xb_ld(&bar[XB_TOPGEN]) == tg, bar);
            __builtin_amdgcn_fence(__ATOMIC_ACQUIRE, "agent");
            xb_add(&bar[XB_XGEN(b.x)], 1u);
            asm volatile("s_waitcnt vmcnt(0)" ::: "memory");
        } else {
            XB_SPIN(xb_ld(&bar[XB_XGEN(b.x)]) == gen, bar);
            __builtin_amdgcn_fence(__ATOMIC_ACQUIRE, "agent");
            asm volatile("s_waitcnt vmcnt(0)" ::: "memory");
        }
    }
    __syncthreads();
}

namespace pg8 {
#define PG8_LAS __attribute__((address_space(3)))
typedef unsigned short bf16_t;
typedef short bf16x8 __attribute__((ext_vector_type(8)));
typedef float f32x4 __attribute__((ext_vector_type(4)));
typedef unsigned u32x4 __attribute__((ext_vector_type(4)));
typedef unsigned u32x2 __attribute__((ext_vector_type(2)));
constexpr int BM = 256, BK = 64, HALF = 128, HTB = HALF * BK * 2, STAGE_BYTES = 8 * HTB, NXCD = 8, WGM = 8;

__host__ __device__ __forceinline__ int lds_byte(int r, int c) { const int st = (r >> 4) * 2 + (c >> 5), rr = r & 15, cc = c & 31, ob = rr * 64 + cc * 2; return st * 1024 + (ob ^ (((ob >> 9) & 1) << 5)); }
__host__ __device__ __forceinline__ void stage_rc(int b, int& R, int& C) { const int st = b / 1024, sb = b % 1024, swz = sb ^ (((sb >> 9) & 1) << 5); R = (st >> 1) * 16 + swz / 64; C = (st & 1) * 32 + (swz % 64) / 2; }
__host__ __device__ __forceinline__ int perm32(int rho) { const int n = rho >> 4, i = rho & 15; return 8 * (i >> 2) + 4 * n + (i & 3); }

struct Unit { int pm, pn, e; };

struct StaticOrder {
    static constexpr bool GATHER = false;
    const char* A; const char* Bt; int K; int nM, nN, nwg, G, c;
    __device__ void init(const void* A_, const void* Bt_, int M, int N, int K_, int G_, int c_) { A = (const char*)A_; Bt = (const char*)Bt_; K = K_; nM = M / BM; nN = N / BM; nwg = nM * nN; G = G_; c = c_; }
    __device__ bool next(int i, Unit& u) const {
        const long L = (long)i * G + c; if (L >= nwg) return false;
        int wgid = (int)L; { const int q = nwg / NXCD, r = nwg % NXCD, xcd = wgid % NXCD, off = wgid / NXCD; wgid = (xcd < r ? xcd * (q + 1) : r * (q + 1) + (xcd - r) * q) + off; }
        const int nig = WGM * nN, gid = wgid / nig, fm = gid * WGM, gsz = (nM - fm) < WGM ? (nM - fm) : WGM;
        u.pm = fm + ((wgid % nig) % gsz); u.pn = (wgid % nig) / gsz; u.e = 0; return true;
    }
    __device__ __forceinline__ const char* a_base(const Unit& u) const { return A + (size_t)u.pm * (size_t)(BM * 2) * K; }
    __device__ __forceinline__ const char* b_base(const Unit& u) const { return Bt + (size_t)u.pn * (size_t)(BM * 2) * K; }
    __device__ __forceinline__ void a_voff(int, int, int, int, unsigned (&)[2]) const {}
};

__device__ __forceinline__ unsigned cvt_pk_bf16(float lo, float hi) { unsigned r; asm volatile("v_cvt_pk_bf16_f32 %0, %1, %2" : "=v"(r) : "v"(lo), "v"(hi)); return r; }

template <int K, class Epi, class Sched, bool ALIGN_EPI>
__device__ __forceinline__ void gemm_phase(PG8_LAS unsigned char* lds, const Sched& S, const Epi& E) {
    int tid_ = threadIdx.x; asm volatile("" : "+v"(tid_));
    const int tid = tid_, wid = __builtin_amdgcn_readfirstlane(tid >> 6), lane = tid & 63, wr = wid >> 2, wc = wid & 3, fr = lane & 15, fq = lane >> 4;
    constexpr int nt = K / BK;
    int sR[2], sC[2];
    constexpr int NH = Sched::GATHER ? 2 : 1;
    unsigned voffB[2], cvA[NH][2], nvA[NH][2];
#pragma unroll
    for (int i = 0; i < 2; ++i) { int R, C; stage_rc(tid * 16 + i * 8192, R, C); sR[i] = R; sC[i] = C; const int Rb = Epi::PERM ? ((R & ~31) + perm32(R & 31)) : R;
        voffB[i] = (unsigned)(Rb * K + C) * 2u;
        cvA[0][i] = nvA[0][i] = (unsigned)(R * K + C) * 2u; if constexpr (NH == 2) { cvA[NH - 1][i] = nvA[NH - 1][i] = cvA[0][i]; } }
    constexpr size_t kstep = (size_t)(BK * 2);
    constexpr size_t hstep = (size_t)HALF * K * 2;
    constexpr size_t hstepA = Sched::GATHER ? (size_t)0 : hstep;
    const unsigned ldsw = (unsigned)wid * 1024u;
    const int aoff = lds_byte(wr * 64 + fr, fq * 8), boff = lds_byte(wc * 32 + fr, fq * 8);
#define PG8_SA(b, h) (((b) * 2 + (h)) * HTB)
#define PG8_SB(b, h) ((4 + (b) * 2 + (h)) * HTB)
#define PG8_STAGE(bufoff, gbase, voff) do { _Pragma("unroll") for (int _i = 0; _i < 2; ++_i) \
        __builtin_amdgcn_global_load_lds((const unsigned*)((const char*)(gbase) + (voff)[_i]), (PG8_LAS unsigned*)(lds + (bufoff) + ldsw + _i * 8192), 16, 0, 0); } while (0)
#define PG8_LDA(dst, b, h) do { _Pragma("unroll") for (int m = 0; m < 4; ++m) _Pragma("unroll") for (int k = 0; k < 2; ++k) dst[m][k] = *(const PG8_LAS bf16x8*)(lds + PG8_SA(b, h) + aoff + m * 2048 + k * 1024); } while (0)
#define PG8_LDB(dst, b, h) do { _Pragma("unroll") for (int n = 0; n < 2; ++n) _Pragma("unroll") for (int k = 0; k < 2; ++k) dst[n][k] = *(const PG8_LAS bf16x8*)(lds + PG8_SB(b, h) + boff + n * 2048 + k * 1024); } while (0)
#define PG8_MMA(ai, bj, At, Bt) do { __builtin_amdgcn_s_setprio(1); _Pragma("unroll") for (int m = 0; m < 4; ++m) _Pragma("unroll") for (int n = 0; n < 2; ++n) _Pragma("unroll") for (int k = 0; k < 2; ++k) \
        acc[ai][bj][m][n] = __builtin_amdgcn_mfma_f32_16x16x32_bf16(Bt[n][k], At[m][k], acc[ai][bj][m][n], 0, 0, 0); __builtin_amdgcn_s_setprio(0); } while (0)
#define PG8_WAIT_V(n) asm volatile("s_waitcnt vmcnt(" #n ")" ::: "memory")
#define PG8_WAIT_L(n) asm volatile("s_waitcnt lgkmcnt(" #n ")" ::: "memory")
#define PG8_BAR __builtin_amdgcn_s_barrier()
#define PG8_SCHED __builtin_amdgcn_sched_barrier(0)
    Unit cur, nxt; int ui = 0;
    if (!S.next(0, cur)) return;
    f32x4 acc[2][2][4][2];
#pragma unroll
    for (int a = 0; a < 2; ++a)
#pragma unroll
        for (int b = 0; b < 2; ++b)
#pragma unroll
            for (int m = 0; m < 4; ++m)
#pragma unroll
                for (int n = 0; n < 2; ++n) acc[a][b][m][n] = (f32x4){0.f, 0.f, 0.f, 0.f};
    bf16x8 At[4][2], B0[2][2], B1[2][2];
    const char* cA = S.a_base(cur); const char* cB = S.b_base(cur);
    if constexpr (Sched::GATHER) {
#pragma unroll
        for (int h = 0; h < 2; ++h) { unsigned v[2]; S.a_voff(0, h, sR[0], sR[1], v); cvA[h][0] = v[0] + (unsigned)sC[0] * 2u; cvA[h][1] = v[1] + (unsigned)sC[1] * 2u; }
    }
    PG8_STAGE(PG8_SB(0, 0), cB, voffB); PG8_STAGE(PG8_SB(0, 1), cB + hstep, voffB); PG8_STAGE(PG8_SA(0, 0), cA, cvA[0]); PG8_STAGE(PG8_SA(0, 1), cA + hstepA, cvA[NH - 1]);
    if (wr == 1) PG8_BAR;
    PG8_WAIT_V(2); PG8_BAR;
    PG8_STAGE(PG8_SB(1, 0), cB + kstep, voffB); PG8_STAGE(PG8_SA(1, 0), cA + kstep, cvA[0]); PG8_STAGE(PG8_SB(1, 1), cB + hstep + kstep, voffB);
    PG8_WAIT_V(6); PG8_BAR;
    for (;;) {
        const bool has_next = S.next(ui + 1, nxt);
        const char* nA = has_next ? S.a_base(nxt) : cA; const char* nB = has_next ? S.b_base(nxt) : cB;
        if constexpr (Sched::GATHER) {
            if (has_next) {
#pragma unroll
                for (int h = 0; h < 2; ++h) { unsigned v[2]; S.a_voff(ui + 1, h, sR[0], sR[1], v); nvA[h][0] = v[0] + (unsigned)sC[0] * 2u; nvA[h][1] = v[1] + (unsigned)sC[1] * 2u; }
            } else {
#pragma unroll
                for (int h = 0; h < 2; ++h) { nvA[h][0] = cvA[h][0]; nvA[h][1] = cvA[h][1]; }
            }
        }
        for (int t = 0; t < nt; t += 2) {
            const bool last = (t == nt - 2);
            const char* a1 = cA + (size_t)(t + 1) * kstep;
            const char* a2 = last ? nA : cA + (size_t)(t + 2) * kstep; const char* b2 = last ? nB : cB + (size_t)(t + 2) * kstep;
            const char* a3 = a2 + kstep; const char* b3 = b2 + kstep;
            unsigned v2[NH][2];
#pragma unroll
            for (int h = 0; h < NH; ++h) { if constexpr (Sched::GATHER) { v2[h][0] = last ? nvA[h][0] : cvA[h][0]; v2[h][1] = last ? nvA[h][1] : cvA[h][1]; } else { v2[h][0] = cvA[h][0]; v2[h][1] = cvA[h][1]; } }
            PG8_LDB(B0, 0, 0); PG8_LDB(B1, 0, 1); PG8_SCHED; PG8_LDA(At, 0, 0); PG8_STAGE(PG8_SA(1, 1), a1 + hstepA, cvA[NH - 1]);
            PG8_WAIT_V(8); PG8_WAIT_L(0); PG8_BAR; PG8_MMA(0, 0, At, B0); PG8_MMA(0, 1, At, B1); PG8_BAR; PG8_SCHED;
            PG8_LDA(At, 0, 1); PG8_STAGE(PG8_SB(0, 0), b2, voffB); PG8_STAGE(PG8_SB(0, 1), b2 + hstep, voffB); PG8_STAGE(PG8_SA(0, 0), a2, v2[0]);
            PG8_WAIT_V(8); PG8_WAIT_L(0); PG8_BAR; PG8_MMA(1, 0, At, B0); PG8_MMA(1, 1, At, B1); PG8_BAR; PG8_SCHED;
            PG8_LDB(B0, 1, 0); PG8_LDB(B1, 1, 1); PG8_SCHED; PG8_LDA(At, 1, 0); PG8_STAGE(PG8_SA(0, 1), a2 + hstepA, v2[NH - 1]);
            PG8_WAIT_V(8); PG8_WAIT_L(0); PG8_BAR; PG8_MMA(0, 0, At, B0); PG8_MMA(0, 1, At, B1); PG8_BAR; PG8_SCHED;
            PG8_LDA(At, 1, 1); PG8_STAGE(PG8_SB(1, 0), b3, voffB); PG8_STAGE(PG8_SB(1, 1), b3 + hstep, voffB); PG8_STAGE(PG8_SA(1, 0), a3, v2[0]);
            PG8_WAIT_V(8); PG8_WAIT_L(0); PG8_BAR; PG8_MMA(1, 0, At, B0); PG8_MMA(1, 1, At, B1); PG8_BAR; PG8_SCHED;
        }
        if constexpr (ALIGN_EPI) { if (wr == 0) PG8_BAR; }
        E(acc, cur, ui, wr, wc, fr, fq);
        if (!has_next) break;
#pragma unroll
        for (int a = 0; a < 2; ++a)
#pragma unroll
            for (int b = 0; b < 2; ++b)
#pragma unroll
                for (int m = 0; m < 4; ++m)
#pragma unroll
                    for (int n = 0; n < 2; ++n) acc[a][b][m][n] = (f32x4){0.f, 0.f, 0.f, 0.f};
        cur = nxt; cA = nA; cB = nB; ++ui;
        if constexpr (Sched::GATHER) {
#pragma unroll
            for (int h = 0; h < NH; ++h) { cvA[h][0] = nvA[h][0]; cvA[h][1] = nvA[h][1]; }
        }
        if constexpr (ALIGN_EPI) { if (wr == 1) PG8_BAR; }
    }
    PG8_WAIT_V(0);
    if constexpr (!ALIGN_EPI) { if (wr == 0) PG8_BAR; }
    PG8_BAR;
#undef PG8_SA
#undef PG8_SB
#undef PG8_STAGE
#undef PG8_LDA
#undef PG8_LDB
#undef PG8_MMA
#undef PG8_WAIT_V
#undef PG8_WAIT_L
#undef PG8_BAR
#undef PG8_SCHED
}
}
#define GAS __attribute__((address_space(1)))
typedef float f32x4 __attribute__((ext_vector_type(4)));
typedef float f32x16 __attribute__((ext_vector_type(16)));
typedef short bf16x8 __attribute__((ext_vector_type(8)));
typedef unsigned v4u __attribute__((ext_vector_type(4)));
typedef unsigned v2u __attribute__((ext_vector_type(2)));
#define LDS_WAIT() asm volatile("s_waitcnt lgkmcnt(0)" ::: "memory")
#define VM_WAIT() asm volatile("s_waitcnt vmcnt(0)" ::: "memory")
__device__ __forceinline__ unsigned pk2(float lo, float hi) { return f2bf(lo) | (f2bf(hi) << 16); }

constexpr int NWAVES = 8, NTHR = 512;
constexpr int LDS_STAGE = 0;
constexpr int LDS_RS = 131072;
constexpr int LDS_ROWTOK = LDS_RS + 8192;
constexpr int LDS_GATE = LDS_ROWTOK + 8192;
constexpr int LDS_MISC = LDS_GATE + 8192;
constexpr int LDS_BYTES = LDS_MISC + 256;
constexpr size_t WO_IN = 0, WO_SM = 6 * MiB, WO_RHI = 6 * MiB + 65536, WO_RLO = 6 * MiB + 131072, WO_OUT = 7 * MiB, WO_XQ = 9 * MiB, WO_XO = 10 * MiB, WO_GU = 11 * MiB, WO_D = 43 * MiB;
static_assert(WO_D + 16 * MiB <= WS_WLAYER, "weight block");
constexpr int CW_BAR = 4096;
constexpr int MAX_LAUNCH = 40;
static_assert((CW_BAR + MAX_LAUNCH * XCD_BAR_WORDS) * 4 <= (int)(1 * MiB), "ctl");

enum { PH_PRO = 0, PH_XKV = 1, PH_L0 = 2, NPH = 13, PH_FINAL = PH_L0 + NLAYER * NPH, PH_END = PH_FINAL + 1 };
enum { LP_INPROJ = 0, LP_MIXA, LP_MIXB, LP_MIXC, LP_WOUT, LP_XQ, LP_XATTN, LP_XO, LP_ROUTE, LP_SORT, LP_GU, LP_DOWN0, LP_DOWN1 };

struct Args { P p; int ph_lo, ph_hi, li, pad; };

template <bool HAS_RS> struct EpiBf16 {
    static constexpr bool PERM = true;
    bf16* O; int ldc; const LAS float* rstab;
    __device__ __forceinline__ void operator()(const pg8::f32x4 (&acc)[2][2][4][2], const pg8::Unit& u, int iu, int wr, int wc, int fr, int fq) const {
#pragma unroll
        for (int ai = 0; ai < 2; ++ai)
#pragma unroll
            for (int m = 0; m < 4; ++m) {
                const int lrow = ai * 128 + wr * 64 + m * 16 + fr;
                float sc = 1.f; if (HAS_RS) sc = rstab[iu * 256 + lrow];
                bf16* rowp = O + (size_t)(u.pm * 256 + lrow) * ldc + u.pn * 256 + wc * 32 + 8 * fq;
#pragma unroll
                for (int bj = 0; bj < 2; ++bj) { const pg8::f32x4 v0 = acc[ai][bj][m][0] * sc, v1 = acc[ai][bj][m][1] * sc;
                    pg8::u32x4 w; w.x = pg8::cvt_pk_bf16(v0[0], v0[1]); w.y = pg8::cvt_pk_bf16(v0[2], v0[3]); w.z = pg8::cvt_pk_bf16(v1[0], v1[1]); w.w = pg8::cvt_pk_bf16(v1[2], v1[3]);
                    *(pg8::u32x4*)(rowp + bj * 128) = w; }
            }
    }
};
struct EpiGU {
    static constexpr bool PERM = true;
    bf16* U; const LAS float* rstab;
    __device__ __forceinline__ void operator()(const pg8::f32x4 (&acc)[2][2][4][2], const pg8::Unit& u, int iu, int wr, int wc, int fr, int fq) const {
#pragma unroll
        for (int ai = 0; ai < 2; ++ai)
#pragma unroll
            for (int m = 0; m < 4; ++m) {
                const int lrow = ai * 128 + wr * 64 + m * 16 + fr;
                const float sc = rstab[iu * 256 + lrow];
                float o[8];
#pragma unroll
                for (int n = 0; n < 2; ++n)
#pragma unroll
                    for (int j = 0; j < 4; ++j) { const float g = acc[ai][0][m][n][j] * sc, uu = acc[ai][1][m][n][j] * sc; o[n * 4 + j] = g * uu * __builtin_amdgcn_rcpf(1.f + __expf(-g)); }
                pg8::u32x4 w; w.x = pg8::cvt_pk_bf16(o[0], o[1]); w.y = pg8::cvt_pk_bf16(o[2], o[3]); w.z = pg8::cvt_pk_bf16(o[4], o[5]); w.w = pg8::cvt_pk_bf16(o[6], o[7]);
                *(pg8::u32x4*)(U + (size_t)(u.pm * 256 + lrow) * 512 + u.pn * 128 + wc * 32 + 8 * fq) = w;
            }
    }
};
template <bool MOE, bool WRITE_HB> struct EpiRes {
    static constexpr bool PERM = false;
    const float* base; float* out; bf16* hb; float* ssq; const LAS int* rowtab; const LAS float* gatetab;
    __device__ __forceinline__ void operator()(const pg8::f32x4 (&acc)[2][2][4][2], const pg8::Unit& u, int iu, int wr, int wc, int fr, int fq) const {
#pragma unroll
        for (int ai = 0; ai < 2; ++ai)
#pragma unroll
            for (int m = 0; m < 4; ++m) {
                const int lrow = ai * 128 + wr * 64 + m * 16 + fr;
                int row = u.pm * 256 + lrow; float g = 1.f;
                if (MOE) { row = rowtab[iu * 256 + lrow]; g = gatetab[iu * 256 + lrow]; }
                const bool ok = !MOE || row >= 0;
                const size_t off = (size_t)(ok ? row : 0) * DM + u.pn * 256 + wc * 32 + 4 * fq;
                float q = 0.f;
                if (ok) {
#pragma unroll
                    for (int bj = 0; bj < 2; ++bj)
#pragma unroll
                        for (int n = 0; n < 2; ++n) { const pg8::f32x4 bs = *(const pg8::f32x4*)(base + off + bj * 128 + n * 16); const pg8::f32x4 o = bs + acc[ai][bj][m][n] * g;
                            *(pg8::f32x4*)(out + off + bj * 128 + n * 16) = o;
                            if (WRITE_HB) { q += (o[0] * o[0] + o[1] * o[1]) + (o[2] * o[2] + o[3] * o[3]); pg8::u32x2 w; w.x = pg8::cvt_pk_bf16(o[0], o[1]); w.y = pg8::cvt_pk_bf16(o[2], o[3]); *(pg8::u32x2*)(hb + off + bj * 128 + n * 16) = w; } }
                }
                if (WRITE_HB) { q += __shfl_xor(q, 16); q += __shfl_xor(q, 32); if (fq == 0 && ok) ssq[(size_t)row * 16 + u.pn * 4 + wc] = q; }
            }
    }
};
template <bool GATH> struct MoeOrder {
    static constexpr bool GATHER = GATH;
    const char* A; const char* Bt; int K; size_t estride; int lo, hi, G, c; const int* tilee; const LAS int* rowtab;
    __device__ bool next(int i, pg8::Unit& u) const { const int L = i * G + c, t = lo + (L >> 2); if (t >= hi) return false; u.pm = t; u.pn = L & 3; u.e = tilee[t]; return true; }
    __device__ __forceinline__ const char* a_base(const pg8::Unit& u) const { return GATH ? A : A + (size_t)u.pm * (size_t)512 * K; }
    __device__ __forceinline__ const char* b_base(const pg8::Unit& u) const { return Bt + (size_t)u.e * estride + (size_t)u.pn * (size_t)512 * K; }
    __device__ __forceinline__ void a_voff(int iu, int h, int R0, int R1, unsigned (&v)[2]) const { v[0] = (unsigned)rowtab[iu * 256 + h * 128 + R0] * (unsigned)(K * 2); v[1] = (unsigned)rowtab[iu * 256 + h * 128 + R1] * (unsigned)(K * 2); }
};

__device__ __forceinline__ void router_weights(const P& p, int gtid, int gstride);
__device__ __forceinline__ void tr_item(const float* W, int N, int K, int k0, int n0, const float* gain, float scale, bf16* dst, LAS float* scr, int lane) {
#pragma unroll 8
    for (int i = 0; i < 32; ++i) { const int kk = 2 * i + (lane >> 5); float v = W[(size_t)(k0 + kk) * N + n0 + (lane & 31)]; if (gain) v *= gain[k0 + kk]; scr[kk * 33 + (lane & 31)] = v * scale; }
    LDS_WAIT();
    const int c = lane & 7;
#pragma unroll
    for (int j = 0; j < 4; ++j) { const int n = (lane >> 3) + 8 * j; const LAS float* s = scr + (8 * c) * 33 + n;
        v4u o; o.x = pk2(s[0 * 33], s[1 * 33]); o.y = pk2(s[2 * 33], s[3 * 33]); o.z = pk2(s[4 * 33], s[5 * 33]); o.w = pk2(s[6 * 33], s[7 * 33]);
        *(v4u*)(dst + (size_t)n * K + k0 + 8 * c) = o; }
    LDS_WAIT();
}
constexpr int IT_LAYER = 15360;
__device__ __forceinline__ void prologue_item(const P& p, int it, LAS float* scr, int lane) {
    const int l = it / IT_LAYER; int r = it % IT_LAYER;
    unsigned char* wl = ws_base(p.ws) + WS_W + (size_t)l * WS_WLAYER;
    if (r < 1536) {
        const int seg = r / 768; r %= 768; const int kb = r / 48, nb = r % 48; const int n0 = (seg ? 1544 : 0) + 32 * nb, drow = seg * 1536 + 32 * nb;
        const float sc = drow < 512 ? 0.125f * LOG2E : ((drow >= C_GQ && drow < C_GK) ? 0.125f : 1.f);
        tr_item(p.w_in + (size_t)l * DM * INW, INW, DM, 64 * kb, n0, p.mix_norm + l * DM, sc, (bf16*)(wl + WO_IN) + (size_t)drow * DM, scr, lane); return; }
    r -= 1536;
    if (r < 512) { const int kb = r / 32, nb = r % 32; tr_item(p.w_out + (size_t)l * DM * DM, DM, DM, 64 * kb, 32 * nb, nullptr, 1.f, (bf16*)(wl + WO_OUT) + (size_t)(32 * nb) * DM, scr, lane); return; }
    r -= 512;
    if (r < 256) { const int kb = r / 16, nb = r % 16; tr_item(p.w_xq + (size_t)l * DM * 512, 512, DM, 64 * kb, 32 * nb, p.cross_norm + l * DM, 0.08838834764831845f * LOG2E, (bf16*)(wl + WO_XQ) + (size_t)(32 * nb) * DM, scr, lane); return; }
    r -= 256;
    if (r < 256) { const int kb = r / 32, nb = r % 32; tr_item(p.w_xo + (size_t)l * 512 * DM, DM, 512, 64 * kb, 32 * nb, nullptr, 1.f, (bf16*)(wl + WO_XO) + (size_t)(32 * nb) * 512, scr, lane); return; }
    r -= 256;
    if (r < 512) { const int kv = r / 256; r %= 256; const int kb = r / 16, nb = r % 16;
        tr_item((kv ? p.w_xv : p.w_xk) + (size_t)l * DM * 512, 512, DM, 64 * kb, 32 * nb, nullptr, 1.f, (bf16*)(ws_base(p.ws) + WS_WXKV) + (size_t)(l * 1024 + kv * 512 + 32 * nb) * DM, scr, lane); return; }
    r -= 512;
    if (r < 8192) { const int up = r / 4096; r %= 4096; const int e = r / 256; r %= 256; const int kb = r / 16, nb = r % 16; const int c0 = 32 * nb, drow = (c0 >> 7) * 256 + up * 128 + (c0 & 127);
        tr_item((up ? p.w_eu : p.w_eg) + ((size_t)l * 16 + e) * DM * 512, 512, DM, 64 * kb, c0, p.moe_norm + l * DM, 1.f, (bf16*)(wl + WO_GU) + ((size_t)e * 1024 + drow) * DM, scr, lane); return; }
    r -= 8192;
    { const int e = r / 256; r %= 256; const int kb = r / 32, nb = r % 32;
      tr_item(p.w_ed + ((size_t)l * 16 + e) * 512 * DM, DM, 512, 64 * kb, 32 * nb, nullptr, 1.f, (bf16*)(wl + WO_D) + ((size_t)e * 1024 + 32 * nb) * 512, scr, lane); }
}
__device__ __forceinline__ void row_to_bf16(const float* src, bf16* dst, float* ssq, const float* gain, int lane, int mode) {
    const f32x4* s = (const f32x4*)src + lane;
    f32x4 v[4]; float q = 0.f;
#pragma unroll
    for (int j = 0; j < 4; ++j) { v[j] = s[64 * j]; q += (v[j].x * v[j].x + v[j].y * v[j].y) + (v[j].z * v[j].z + v[j].w * v[j].w); }
    q = wave_sum(q);
    float sc = 1.f;
    if (mode == 1) sc = rsqrtf(q * (1.0f / DM) + EPS);
    else if (lane < 16) ssq[lane] = lane == 0 ? q : 0.f;
    v2u* d = (v2u*)dst + lane;
#pragma unroll
    for (int j = 0; j < 4; ++j) {
        f32x4 g = (f32x4){1.f, 1.f, 1.f, 1.f}; if (mode == 1) g = ((const f32x4*)gain)[lane + 64 * j];
        v2u o; o.x = pk2(v[j].x * sc * g.x, v[j].y * sc * g.y); o.y = pk2(v[j].z * sc * g.z, v[j].w * sc * g.w); d[64 * j] = o; }
}
__device__ __forceinline__ void prologue(const P& p, LAS unsigned char* lds, int vcu, int G, int wave, int lane) {
    asm volatile("" : "+v"(lane));
    LAS float* scr = (LAS float*)(lds + LDS_STAGE + wave * 16384);
    const int gw = vcu * NWAVES + wave, NGW = G * NWAVES;
    for (int it = gw; it < NLAYER * IT_LAYER; it += NGW) prologue_item(p, it, scr, lane);
    for (int idx = gw * 64 + lane; idx < NLAYER * 2 * 32768; idx += NGW * 64) {
        const int l = idx / 65536, r = idx % 65536, which = r / 32768, e = r % 32768, row = e / 1024, k = e % 1024;
        unsigned char* wl = ws_base(p.ws) + WS_W + (size_t)l * WS_WLAYER;
        if (which == 0) {
            float v = 0.f;
            if (row < 8) v = p.w_in[((size_t)l * DM + k) * INW + 1536 + row]; else if (row < 24) v = p.w_in[((size_t)l * DM + k) * INW + 3080 + (row - 8)];
            ((bf16*)(wl + WO_SM))[row * 1024 + k] = (bf16)f2bf(v * p.mix_norm[l * DM + k]);
        }
    }
    router_weights(p, gw * 64 + lane, NGW * 64);
    for (int m = gw; m < 4096; m += NGW) row_to_bf16(p.mem + (size_t)m * DM, WSP(bf16, WS_MEMN) + (size_t)m * DM, nullptr, p.mem_norm, lane, 1);
    for (int m = gw; m < NTOK; m += NGW) row_to_bf16(p.x + (size_t)m * DM, WSP(bf16, WS_HB) + (size_t)m * DM, WSP(float, WS_SSQ) + (size_t)m * 16, nullptr, lane, 0);
}
__device__ __forceinline__ void small_proj(const P& p, int l, int vcu, int G, int wave, int lane) {
    asm volatile("" : "+v"(lane));
    const int gw = vcu * NWAVES + wave, NGW = G * NWAVES;
    const bf16* wsm = (const bf16*)(ws_base(p.ws) + WS_W + (size_t)l * WS_WLAYER + WO_SM);
    const bf16* hb = WSP(bf16, WS_HB); const float* ssq = WSP(float, WS_SSQ); float* sm = WSP(float, WS_SM);
    const int r = lane & 31, hh = lane >> 5;
    for (int blk = gw; blk < NTOK / 32; blk += NGW) {
        const int tok0 = blk * 32;
        const bf16x8* ap = (const bf16x8*)(hb + (size_t)(tok0 + r) * DM + hh * 32);
        const bf16x8* bp = (const bf16x8*)(wsm + (size_t)r * DM + hh * 32);
        f32x16 acc = {};
#pragma unroll 2
        for (int s = 0; s < 16; ++s) {
#pragma unroll
            for (int j = 0; j < 4; ++j) acc = __builtin_amdgcn_mfma_f32_32x32x16_bf16(ap[s * 8 + j], bp[s * 8 + j], acc, 0, 0, 0);
        }
        const float rsv = row_rs(ssq, tok0 + r);
#pragma unroll
        for (int g = 0; g < 16; ++g) { const int trow = (g & 3) + 8 * (g >> 2) + 4 * hh; const float rs = __shfl(rsv, trow); if (r < 24) sm[(size_t)(tok0 + trow) * 32 + r] = acc[g] * rs; }
    }
}
typedef short v4i16_t __attribute__((ext_vector_type(4)));
typedef __bf16 bf16x2_t __attribute__((ext_vector_type(2)));
typedef float f32x2_t __attribute__((ext_vector_type(2)));
__device__ __forceinline__ unsigned cvtpk(float lo, float hi) { f32x2_t v = {lo, hi}; bf16x2_t b = __builtin_convertvector(v, bf16x2_t); return __builtin_bit_cast(unsigned, b); }
__device__ __forceinline__ bf16x8 pack8(const f32x16& p, int o) {
    v4u w; w.x = cvtpk(p[o], p[o + 1]); w.y = cvtpk(p[o + 2], p[o + 3]); w.z = cvtpk(p[o + 4], p[o + 5]); w.w = cvtpk(p[o + 6], p[o + 7]);
    return __builtin_bit_cast(bf16x8, w);
}
template <int D, bool FOX>
__device__ __forceinline__ void attn_unit(LAS unsigned char* lds, const bf16* Qg, int qpitch, const bf16* Kg, const bf16* Vg, int kvpitch, int NT,
                                          const float* cb, int q0, bf16* Og, int opitch, const float* gain) {
    constexpr int KS = D * 2 + 16, VS = D * 2 + 64;
    constexpr int KBYTES = 64 * KS, VBYTES = 64 * VS;
    constexpr int CPR = D / 8, NCH = 64 * CPR / NTHR, NS = D / 16, NDB = D / 32;
    constexpr int OFF_K = 0, OFF_V = 2 * KBYTES, OFF_CB = 2 * KBYTES + 2 * VBYTES;
    int tid = threadIdx.x; asm volatile("" : "+v"(tid));
    const int lane = tid & 63, wave = __builtin_amdgcn_readfirstlane(tid >> 6), r32 = lane & 31, hh = lane >> 5;
    bf16x8 qf[NS];
    { const bf16* qrow = Qg + (size_t)(wave * 32 + r32) * qpitch;
#pragma unroll
      for (int s = 0; s < NS; ++s) qf[s] = *(const bf16x8*)(qrow + 16 * s + 8 * hh); }
    v4u kreg[NCH], vreg[NCH]; f32x4 cbreg = {0.f, 0.f, 0.f, 0.f};
#define AT_GLOAD(t) do { _Pragma("unroll") for (int i_ = 0; i_ < NCH; ++i_) { const int idx_ = tid + NTHR * i_, key_ = idx_ / CPR, c_ = idx_ % CPR; \
        kreg[i_] = *(const v4u*)(Kg + (size_t)((t) * 64 + key_) * kvpitch + c_ * 8); vreg[i_] = *(const v4u*)(Vg + (size_t)((t) * 64 + key_) * kvpitch + c_ * 8); } \
        if (FOX && tid < 16) cbreg = *(const f32x4*)(cb + (t) * 64 + tid * 4); } while (0)
#define AT_LSTORE(b) do { _Pragma("unroll") for (int i_ = 0; i_ < NCH; ++i_) { const int idx_ = tid + NTHR * i_, key_ = idx_ / CPR, c_ = idx_ % CPR; \
        *(LAS v4u*)(lds + OFF_K + (b) * KBYTES + key_ * KS + c_ * 16) = kreg[i_]; *(LAS v4u*)(lds + OFF_V + (b) * VBYTES + key_ * VS + c_ * 16) = vreg[i_]; } \
        if (FOX && tid < 16) *(LAS f32x4*)(lds + OFF_CB + (b) * 256 + tid * 16) = cbreg; } while (0)
    float m = -INFINITY, l = 0.f;
    f32x16 o[NDB];
#pragma unroll
    for (int d = 0; d < NDB; ++d) o[d] = f32x16{};
    const int qlo = q0 + wave * 32, qabs = qlo + r32;
    AT_GLOAD(0); AT_LSTORE(0);
    __syncthreads();
#pragma unroll 1
    for (int t = 0; t < NT; ++t) {
        const int b = t & 1;
        if (t + 1 < NT) AT_GLOAD(t + 1);
        const int kt0 = t * 64;
        if (!FOX || kt0 <= qlo + 31) {
            f32x16 p[2];
#pragma unroll
            for (int kb = 0; kb < 2; ++kb) {
                if (FOX) {
#pragma unroll
                    for (int g = 0; g < 4; ++g) { const f32x4 c4 = *(const LAS f32x4*)(lds + OFF_CB + b * 256 + (kb * 32 + 8 * g + 4 * hh) * 4); p[kb][4 * g] = c4.x; p[kb][4 * g + 1] = c4.y; p[kb][4 * g + 2] = c4.z; p[kb][4 * g + 3] = c4.w; }
                } else p[kb] = f32x16{};
                const LAS unsigned char* kp = lds + OFF_K + b * KBYTES + (kb * 32 + r32) * KS + hh * 16;
#pragma unroll
                for (int s = 0; s < NS; ++s) { const bf16x8 kf = *(const LAS bf16x8*)(kp + s * 32); p[kb] = __builtin_amdgcn_mfma_f32_32x32x16_bf16(kf, qf[s], p[kb], 0, 0, 0); }
            }
            if (FOX && kt0 + 63 > qlo) {
#pragma unroll
                for (int kb = 0; kb < 2; ++kb)
#pragma unroll
                    for (int r = 0; r < 16; ++r) { const int key = kt0 + kb * 32 + (r & 3) + 8 * (r >> 2) + 4 * hh; if (key > qabs) p[kb][r] = -INFINITY; }
            }
            float mt = fmaxf(p[0][0], p[1][0]);
#pragma unroll
            for (int r = 1; r < 16; ++r) mt = fmaxf(mt, fmaxf(p[0][r], p[1][r]));
            mt = fmaxf(mt, __shfl_xor(mt, 32));
            const float mnew = fmaxf(m, mt);
            const float alpha = __builtin_amdgcn_exp2f(m - mnew);
            float ls = 0.f;
#pragma unroll
            for (int kb = 0; kb < 2; ++kb)
#pragma unroll
                for (int r = 0; r < 16; ++r) { const float e = __builtin_amdgcn_exp2f(p[kb][r] - mnew); p[kb][r] = e; ls += e; }
            m = mnew; l = l * alpha + ls;
#pragma unroll
            for (int d = 0; d < NDB; ++d)
#pragma unroll
                for (int r = 0; r < 16; ++r) o[d][r] *= alpha;
            bf16x8 pa[2][2];
#pragma unroll
            for (int kb = 0; kb < 2; ++kb) { pa[kb][0] = pack8(p[kb], 0); pa[kb][1] = pack8(p[kb], 8); }
            const LAS unsigned char* vp = lds + OFF_V + b * VBYTES + (4 * hh + ((lane & 15) >> 2)) * VS + (16 * ((lane >> 4) & 1) + 4 * (lane & 3)) * 2;
#pragma unroll
            for (int d = 0; d < NDB; ++d) {
#pragma unroll
                for (int kb = 0; kb < 2; ++kb)
#pragma unroll
                    for (int ks = 0; ks < 2; ++ks) {
                        const LAS unsigned char* a0 = vp + (kb * 32 + 16 * ks) * VS + d * 64;
                        const v4i16_t lo = __builtin_amdgcn_ds_read_tr16_b64_v4i16((LAS v4i16_t*)a0);
                        const v4i16_t hi = __builtin_amdgcn_ds_read_tr16_b64_v4i16((LAS v4i16_t*)(a0 + 8 * VS));
                        const bf16x8 vf = (bf16x8){lo[0], lo[1], lo[2], lo[3], hi[0], hi[1], hi[2], hi[3]};
                        o[d] = __builtin_amdgcn_mfma_f32_32x32x16_bf16(vf, pa[kb][ks], o[d], 0, 0, 0);
                    }
            }
        }
        if (t + 1 < NT) AT_LSTORE(b ^ 1);
        __syncthreads();
    }
#undef AT_GLOAD
#undef AT_LSTORE
    l += __shfl_xor(l, 32);
    const float inv = 1.0f / l;
    float rs = inv;
    if (FOX) {
        float ss = 0.f;
#pragma unroll
        for (int d = 0; d < NDB; ++d)
#pragma unroll
            for (int r = 0; r < 16; ++r) { const float v = o[d][r] * inv; ss += v * v; }
        ss += __shfl_xor(ss, 32);
        rs = inv * rsqrtf(ss * (1.0f / D) + EPS);
    }
    bf16* orow = Og + (size_t)(wave * 32 + r32) * opitch;
#pragma unroll
    for (int d = 0; d < NDB; ++d)
#pragma unroll
        for (int g = 0; g < 4; ++g) {
            f32x4 gn = {1.f, 1.f, 1.f, 1.f}; if (FOX) gn = *(const f32x4*)(gain + 32 * d + 8 * g + 4 * hh);
            v2u w; w.x = cvtpk(o[d][4 * g] * rs * gn.x, o[d][4 * g + 1] * rs * gn.y); w.y = cvtpk(o[d][4 * g + 2] * rs * gn.z, o[d][4 * g + 3] * rs * gn.w);
            *(v2u*)(orow + 32 * d + 8 * g + 4 * hh) = w;
        }
}
__device__ __forceinline__ void fox_phase(const P& p, int l, LAS unsigned char* lds, int vcu, int G) {
    const bf16* proj = WSP(bf16, WS_PROJ); const float* cb = WSP(float, WS_CB); bf16* y = WSP(bf16, WS_Y);
    for (int pu = vcu; pu < 512; pu += G) {
        const int bh = pu >> 2, pr = pu & 3, b = bh >> 3, h = bh & 7;
        for (int half = 0; half < 2; ++half) {
            const int qb = half ? pr : 7 - pr;
            const size_t row0 = (size_t)b * SEQ;
            attn_unit<64, true>(lds, proj + (row0 + qb * 256) * PW + C_FQ + h * 64, PW, proj + row0 * PW + C_FK + h * 64, proj + row0 * PW + C_FV + h * 64, PW, 4 * (qb + 1),
                                cb + ((size_t)b * 8 + h) * SEQ, qb * 256, y + (row0 + qb * 256) * DM + h * 64, DM, p.fox_gain + l * 512 + h * 64);
        }
    }
}
__device__ __forceinline__ void xattn_phase(const P& p, int l, LAS unsigned char* lds, int vcu, int G) {
    bf16* xq = WSP(bf16, WS_XQ); const bf16* xkv = WSP(bf16, WS_XKV);
    for (int u = vcu; u < 512; u += G) {
        const int b = u >> 5, h = (u >> 3) & 3, qb = u & 7;
        bf16* qp = xq + ((size_t)b * SEQ + qb * 256) * 512 + h * 128;
        const bf16* kp = xkv + (size_t)b * MEML * 2048 + l * 1024 + h * 128;
        attn_unit<128, false>(lds, qp, 512, kp, kp + 512, 2048, 4, nullptr, 0, qp, 512, nullptr);
    }
}
constexpr size_t WS_GLOC = WS_HB;
constexpr size_t WS_GS = WS_END;
constexpr size_t WS_GDEC = WS_GS + 32 * MiB;
constexpr size_t WS_END2 = WS_GDEC + 1 * MiB;
static_assert(WS_END2 <= 512 * MiB, "workspace map 2");
constexpr int GL_B = 0;
constexpr int GL_TOT = 16384;
constexpr int GL_Q1 = 18432, GL_Q2 = GL_Q1 + 64 * 144, GL_K2 = GL_Q2 + 64 * 144;
constexpr int GL_KD = GL_K2 + 64 * 144;
constexpr int GL_V = GL_KD + 64 * 192;
constexpr int GL_SSQ = GL_V + 64 * 320;
constexpr int GL_END = GL_SSQ + 1024;
static_assert(GL_END <= 131072, "gla lds");

__device__ __forceinline__ float fast_log_sigmoid(float z) { return fminf(z, 0.f) - __logf(1.f + __expf(-fabsf(z))); }
__device__ __forceinline__ void gla_decay(const P& p, int l, int h, size_t tok0, LAS unsigned char* lds, int lane, int wave) {
    const float* sm = WSP(float, WS_SM);
    float w[16];
#pragma unroll
    for (int r = 0; r < 16; ++r) w[r] = p.w_alpha_up[((size_t)l * 16 + r) * 256 + h * 64 + lane];
    const float bias = p.b_alpha[l * 256 + h * 64 + lane];
    float bl[8]; float run = 0.f;
#pragma unroll
    for (int j = 0; j < 8; ++j) {
        const float* ga = sm + (tok0 + wave * 8 + j) * 32 + 8;
        float z = bias;
#pragma unroll
        for (int r = 0; r < 16; ++r) z += ga[r] * w[r];
        run += fast_log_sigmoid(z) * (1.0f / 16.0f); bl[j] = run;
    }
    LAS float* tot = (LAS float*)(lds + GL_TOT);
    tot[wave * 64 + lane] = run;
    __syncthreads();
    float pre = 0.f;
#pragma unroll
    for (int g = 0; g < 8; ++g) { const float t = tot[g * 64 + lane]; if (g < wave) pre += t; }
    LAS float* Bm = (LAS float*)(lds + GL_B);
#pragma unroll
    for (int j = 0; j < 8; ++j) Bm[(wave * 8 + j) * 64 + lane] = bl[j] + pre;
    __syncthreads();
}
__device__ __forceinline__ void gla_load_v(const bf16* proj, size_t tok0, int h, LAS unsigned char* lds, int tid) {
#pragma unroll
    for (int i = 0; i < 2; ++i) { const int idx = tid + NTHR * i, t = idx >> 4, c = idx & 15;
        *(LAS v4u*)(lds + GL_V + t * 320 + c * 16) = *(const v4u*)(proj + (tok0 + t) * PW + C_GV + h * 128 + c * 8); }
}
__device__ __forceinline__ bf16x8 tr_frag(const LAS unsigned char* a0, int rowstride4) {
    const v4i16_t lo = __builtin_amdgcn_ds_read_tr16_b64_v4i16((LAS v4i16_t*)a0);
    const v4i16_t hi = __builtin_amdgcn_ds_read_tr16_b64_v4i16((LAS v4i16_t*)(a0 + rowstride4));
    return (bf16x8){lo[0], lo[1], lo[2], lo[3], hi[0], hi[1], hi[2], hi[3]};
}
__device__ __forceinline__ void gla_phase_a(const P& p, int l, LAS unsigned char* lds, int vcu, int G) {
    int tid = threadIdx.x; asm volatile("" : "+v"(tid));
    const int lane = tid & 63, wave = __builtin_amdgcn_readfirstlane(tid >> 6), hh = lane >> 5;
    const bf16* proj = WSP(bf16, WS_PROJ); float* loc = WSP(float, WS_GLOC); float* dec = WSP(float, WS_GDEC);
    for (int u = vcu; u < 2048; u += G) {
        const int c = u & 31, h = (u >> 5) & 3, b = u >> 7;
        const size_t tok0 = (size_t)b * SEQ + c * 64;
        gla_decay(p, l, h, tok0, lds, lane, wave);
        gla_load_v(proj, tok0, h, lds, tid);
        const LAS float* Bm = (const LAS float*)(lds + GL_B);
        const float blast = Bm[63 * 64 + lane];
#pragma unroll
        for (int j = 0; j < 8; ++j) { const int t = wave * 8 + j;
            const float kv = bf2f(proj[(tok0 + t) * PW + C_GK + h * 64 + lane]) * __expf(blast - Bm[t * 64 + lane]);
            *(LAS bf16*)(lds + GL_KD + t * 192 + lane * 2) = (bf16)f2bf(kv); }
        if (wave == 0) dec[(size_t)u * 64 + lane] = __expf(blast);
        __syncthreads();
        const int dvb = wave >> 1, dkb = wave & 1;
        const int trow = (lane & 15) >> 2, tcol = 16 * ((lane >> 4) & 1) + 4 * (lane & 3);
        f32x16 acc = {};
#pragma unroll
        for (int s = 0; s < 4; ++s) {
            const bf16x8 af = tr_frag(lds + GL_V + (16 * s + 8 * hh + trow) * 320 + (32 * dvb + tcol) * 2, 4 * 320);
            const bf16x8 bf = tr_frag(lds + GL_KD + (16 * s + 8 * hh + trow) * 192 + (32 * dkb + tcol) * 2, 4 * 192);
            acc = __builtin_amdgcn_mfma_f32_32x32x16_bf16(af, bf, acc, 0, 0, 0);
        }
        float* lo = loc + (size_t)u * 8192 + 32 * dkb + (lane & 31);
#pragma unroll
        for (int r = 0; r < 16; ++r) lo[(size_t)(32 * dvb + (r & 3) + 8 * (r >> 2) + 4 * hh) * 64] = acc[r];
        __syncthreads();
    }
}
__device__ __forceinline__ void gla_phase_b(const P& p, int vcu, int G) {
    int tid = threadIdx.x; asm volatile("" : "+v"(tid));
    const float* loc = WSP(float, WS_GLOC); const float* dec = WSP(float, WS_GDEC); bf16* gs = WSP(bf16, WS_GS);
    for (int u = vcu; u < 256; u += G) {
        const int bh = u >> 2, q4 = u & 3;
        const int e = q4 * 2048 + tid * 4, dk = e & 63;
        f32x4 st = {0.f, 0.f, 0.f, 0.f};
#pragma unroll 4
        for (int c = 0; c < 32; ++c) {
            const size_t cu = (size_t)bh * 32 + c;
            const f32x4 lv = *(const f32x4*)(loc + cu * 8192 + e);
            const f32x4 dv = *(const f32x4*)(dec + cu * 64 + dk);
            v2u w; w.x = pk2(st.x, st.y); w.y = pk2(st.z, st.w);
            *(v2u*)(gs + cu * 8192 + e) = w;
            st = dv * st + lv;
        }
    }
}
__device__ __forceinline__ void gla_phase_c(const P& p, int l, LAS unsigned char* lds, int vcu, int G) {
    int tid = threadIdx.x; asm volatile("" : "+v"(tid));
    const int lane = tid & 63, wave = __builtin_amdgcn_readfirstlane(tid >> 6), hh = lane >> 5, r32 = lane & 31;
    const bf16* proj = WSP(bf16, WS_PROJ); const bf16* gs = WSP(bf16, WS_GS); bf16* y = WSP(bf16, WS_Y);
    for (int u = vcu; u < 2048; u += G) {
        const int c = u & 31, h = (u >> 5) & 3, b = u >> 7;
        const size_t tok0 = (size_t)b * SEQ + c * 64;
        gla_decay(p, l, h, tok0, lds, lane, wave);
        gla_load_v(proj, tok0, h, lds, tid);
        const LAS float* Bm = (const LAS float*)(lds + GL_B);
        const float rref = Bm[31 * 64 + lane];
#pragma unroll
        for (int j = 0; j < 8; ++j) { const int t = wave * 8 + j; const float bt = Bm[t * 64 + lane];
            const float qv = bf2f(proj[(tok0 + t) * PW + C_GQ + h * 64 + lane]), kv = bf2f(proj[(tok0 + t) * PW + C_GK + h * 64 + lane]);
            *(LAS bf16*)(lds + GL_Q1 + t * 144 + lane * 2) = (bf16)f2bf(qv * __expf(bt));
            *(LAS bf16*)(lds + GL_Q2 + t * 144 + lane * 2) = (bf16)f2bf(qv * __expf(bt - rref));
            *(LAS bf16*)(lds + GL_K2 + t * 144 + lane * 2) = (bf16)f2bf(kv * __expf(rref - bt)); }
        __syncthreads();
        const int dvb = wave >> 1, tb = wave & 1;
        const int trow = (lane & 15) >> 2, tcol = 16 * ((lane >> 4) & 1) + 4 * (lane & 3);
        f32x16 o = {};
        { const bf16* sp = gs + (size_t)u * 8192 + (size_t)(32 * dvb + r32) * 64 + 8 * hh;
#pragma unroll
          for (int s = 0; s < 4; ++s) { const bf16x8 af = *(const bf16x8*)(sp + 16 * s); const bf16x8 bq = *(const LAS bf16x8*)(lds + GL_Q1 + (32 * tb + r32) * 144 + (16 * s + 8 * hh) * 2);
              o = __builtin_amdgcn_mfma_f32_32x32x16_bf16(af, bq, o, 0, 0, 0); } }
#pragma unroll
        for (int sb = 0; sb < 2; ++sb) {
            if (sb <= tb) {
                f32x16 pt = {};
#pragma unroll
                for (int s = 0; s < 4; ++s) { const bf16x8 ak = *(const LAS bf16x8*)(lds + GL_K2 + (32 * sb + r32) * 144 + (16 * s + 8 * hh) * 2); const bf16x8 bq = *(const LAS bf16x8*)(lds + GL_Q2 + (32 * tb + r32) * 144 + (16 * s + 8 * hh) * 2);
                    pt = __builtin_amdgcn_mfma_f32_32x32x16_bf16(ak, bq, pt, 0, 0, 0); }
                if (sb == tb) {
#pragma unroll
                    for (int r = 0; r < 16; ++r) { const int s_ = (r & 3) + 8 * (r >> 2) + 4 * hh; if (s_ > r32) pt[r] = 0.f; }
                }
#pragma unroll
                for (int ks = 0; ks < 2; ++ks) {
                    const bf16x8 pa = pack8(pt, 8 * ks);
                    const bf16x8 vf = tr_frag(lds + GL_V + (32 * sb + 16 * ks + 4 * hh + trow) * 320 + (32 * dvb + tcol) * 2, 8 * 320);
                    o = __builtin_amdgcn_mfma_f32_32x32x16_bf16(vf, pa, o, 0, 0, 0);
                }
            }
        }
        float ss = 0.f;
#pragma unroll
        for (int r = 0; r < 16; ++r) ss += o[r] * o[r];
        ss += __shfl_xor(ss, 32);
        LAS float* sq = (LAS float*)(lds + GL_SSQ);
        if (hh == 0) sq[dvb * 64 + 32 * tb + r32] = ss;
        __syncthreads();
        const int t = 32 * tb + r32;
        const float tot = (sq[t] + sq[64 + t]) + (sq[128 + t] + sq[192 + t]);
        const float rs = rsqrtf(tot * (1.0f / 128.0f) + EPS);
        const size_t tok = tok0 + t;
#pragma unroll
        for (int g = 0; g < 4; ++g) {
            const int dv = 32 * dvb + 8 * g + 4 * hh;
            const f32x4 gn = *(const f32x4*)(p.gla_gain + l * 512 + h * 128 + dv);
            const v2u gg = *(const v2u*)(proj + tok * PW + C_GG + h * 128 + dv);
            const float g0 = bf2f((bf16)(gg.x & 0xffff)), g1 = bf2f((bf16)(gg.x >> 16)), g2 = bf2f((bf16)(gg.y & 0xffff)), g3 = bf2f((bf16)(gg.y >> 16));
            const float v0 = o[4 * g] * rs * gn.x * g0 * __builtin_amdgcn_rcpf(1.f + __expf(-g0)), v1 = o[4 * g + 1] * rs * gn.y * g1 * __builtin_amdgcn_rcpf(1.f + __expf(-g1));
            const float v2 = o[4 * g + 2] * rs * gn.z * g2 * __builtin_amdgcn_rcpf(1.f + __expf(-g2)), v3 = o[4 * g + 3] * rs * gn.w * g3 * __builtin_amdgcn_rcpf(1.f + __expf(-g3));
            v2u w; w.x = cvtpk(v0, v1); w.y = cvtpk(v2, v3);
            *(v2u*)(y + tok * DM + 512 + h * 128 + dv) = w;
        }
        __syncthreads();
    }
}
__device__ __forceinline__ void fox_cumsum_phase(const P& p, int l, int vcu, int G) {
    int tid = threadIdx.x; asm volatile("" : "+v"(tid));
    const int lane = tid & 63, wave = __builtin_amdgcn_readfirstlane(tid >> 6);
    const float* sm = WSP(float, WS_SM); float* cb = WSP(float, WS_CB);
    for (int u = vcu * NWAVES + wave; u < NBATCH * 8; u += G * NWAVES) {
        const int b = u >> 3, h = u & 7;
        const float bias = p.b_forget[l * 8 + h];
        float v[32]; float run = 0.f;
#pragma unroll
        for (int j = 0; j < 32; ++j) { run += fast_log_sigmoid(sm[((size_t)b * SEQ + lane * 32 + j) * 32 + h] + bias); v[j] = run; }
        float pre = run;
#pragma unroll
        for (int o = 1; o < 64; o <<= 1) { const float t = __shfl_up(pre, o); if (lane >= o) pre += t; }
        pre -= run;
#pragma unroll
        for (int j = 0; j < 32; ++j) cb[((size_t)b * 8 + h) * SEQ + lane * 32 + j] = -(v[j] + pre) * LOG2E;
    }
}
__device__ __forceinline__ void router_weights(const P& p, int gtid, int gstride) {
    for (int idx = gtid; idx < NLAYER * 32768; idx += gstride) {
        const int l = idx >> 15, r = idx & 32767, k = r >> 5, n = r & 31;
        float v = 0.f;
        if (n < 16) v = p.w_re[((size_t)l * DM + k) * 16 + n]; else if (n < 20) v = p.w_rg[((size_t)l * DM + k) * 4 + (n - 16)];
        v *= p.moe_norm[l * DM + k];
        float* wr = (float*)(ws_base(p.ws) + WS_W + (size_t)l * WS_WLAYER + WO_RHI);
        wr[(((k >> 4) * 4 + ((k >> 2) & 3)) * 32 + n) * 4 + (k & 3)] = v;
    }
}
__device__ __forceinline__ void route_phase(const P& p, int l, LAS unsigned char* lds, int vcu, int G) {
    int tid = threadIdx.x; asm volatile("" : "+v"(tid));
    const int lane = tid & 63, wave = __builtin_amdgcn_readfirstlane(tid >> 6);
    { const v4u* src = (const v4u*)(ws_base(p.ws) + WS_W + (size_t)l * WS_WLAYER + WO_RHI);
#pragma unroll 4
      for (int i = 0; i < 16; ++i) *(LAS v4u*)(lds + LDS_STAGE + (tid + NTHR * i) * 16) = src[tid + NTHR * i]; }
    LAS int* hist = (LAS int*)(lds + LDS_GATE);
    if (tid < 32) hist[tid] = 0;
    __syncthreads();
    const float* H = p.out;
    int2* toke = WSP(int2, WS_MOE + MO_TOKE); float2* tokg = WSP(float2, WS_MOE + MO_TOKG);
    LAS float* lgb = (LAS float*)(lds + LDS_RS + wave * 2048);
    const int r = lane & 15, kq = lane >> 4;
    for (int task = vcu * NWAVES + wave; task < NTOK / 16; task += G * NWAVES) {
        const int tok0 = task * 16;
        const f32x4* hp = (const f32x4*)(H + (size_t)(tok0 + r) * DM + 4 * kq);
        f32x4 acc0 = {0.f, 0.f, 0.f, 0.f}, acc1 = {0.f, 0.f, 0.f, 0.f}; float q = 0.f;
#pragma unroll 8
        for (int s = 0; s < 64; ++s) {
            const f32x4 a = hp[4 * s];
            const f32x4 b0 = *(const LAS f32x4*)(lds + LDS_STAGE + ((s * 4 + kq) * 32 + r) * 16);
            const f32x4 b1 = *(const LAS f32x4*)(lds + LDS_STAGE + ((s * 4 + kq) * 32 + 16 + r) * 16);
            q += (a.x * a.x + a.y * a.y) + (a.z * a.z + a.w * a.w);
            acc0 = __builtin_amdgcn_mfma_f32_16x16x4f32(a.x, b0.x, acc0, 0, 0, 0); acc1 = __builtin_amdgcn_mfma_f32_16x16x4f32(a.x, b1.x, acc1, 0, 0, 0);
            acc0 = __builtin_amdgcn_mfma_f32_16x16x4f32(a.y, b0.y, acc0, 0, 0, 0); acc1 = __builtin_amdgcn_mfma_f32_16x16x4f32(a.y, b1.y, acc1, 0, 0, 0);
            acc0 = __builtin_amdgcn_mfma_f32_16x16x4f32(a.z, b0.z, acc0, 0, 0, 0); acc1 = __builtin_amdgcn_mfma_f32_16x16x4f32(a.z, b1.z, acc1, 0, 0, 0);
            acc0 = __builtin_amdgcn_mfma_f32_16x16x4f32(a.w, b0.w, acc0, 0, 0, 0); acc1 = __builtin_amdgcn_mfma_f32_16x16x4f32(a.w, b1.w, acc1, 0, 0, 0);
        }
        q += __shfl_xor(q, 16); q += __shfl_xor(q, 32);
        const float rsv = rsqrtf(q * (1.0f / DM) + EPS);
        const float bias0 = p.b_re[l * 16 + r], bias1 = r < 4 ? p.b_rg[l * 4 + r] : 0.f;
#pragma unroll
        for (int g = 0; g < 4; ++g) { const int row = 4 * kq + g; const float rs = __shfl(rsv, row);
            lgb[row * 32 + r] = acc0[g] * rs + bias0; lgb[row * 32 + 16 + r] = acc1[g] * rs + bias1; }
        LDS_WAIT();
        if (lane < 16) {
            const int tok = tok0 + lane;
            const LAS f32x4* lr = (const LAS f32x4*)(lgb + lane * 32);
            const f32x4 e0 = lr[0], e1 = lr[1], e2 = lr[2], e3 = lr[3], gl = lr[4];
            int g = 0; float gm = gl.x;
            if (gl.y > gm) { gm = gl.y; g = 1; } if (gl.z > gm) { gm = gl.z; g = 2; } if (gl.w > gm) { gm = gl.w; g = 3; }
            const float den = (expf(gl.x - gm) + expf(gl.y - gm)) + (expf(gl.z - gm) + expf(gl.w - gm));
            const float pg = 1.0f / den;
            const f32x4 el = g == 0 ? e0 : (g == 1 ? e1 : (g == 2 ? e2 : e3));
            int i0 = 0; float m0 = el.x;
            if (el.y > m0) { m0 = el.y; i0 = 1; } if (el.z > m0) { m0 = el.z; i0 = 2; } if (el.w > m0) { m0 = el.w; i0 = 3; }
            int i1 = -1; float m1 = -INFINITY;
            if (i0 != 0 && el.x > m1) { m1 = el.x; i1 = 0; } if (i0 != 1 && el.y > m1) { m1 = el.y; i1 = 1; }
            if (i0 != 2 && el.z > m1) { m1 = el.z; i1 = 2; } if (i0 != 3 && el.w > m1) { m1 = el.w; i1 = 3; }
            const float ex = expf(m1 - m0), inv = 1.0f / (1.0f + ex);
            const int ea = g * 4 + i0, eb = g * 4 + i1;
            toke[tok] = make_int2(ea, eb); tokg[tok] = make_float2(pg * inv, pg * ex * inv);
            atomicAdd((int*)&hist[ea], 1); atomicAdd((int*)&hist[16 + eb], 1);
        }
        LDS_WAIT();
    }
    __syncthreads();
    if (tid < 32) WSP(int, WS_MOE + MO_HIST)[vcu * 32 + tid] = hist[tid];
}
__device__ __forceinline__ void sort_phase(const P& p, LAS unsigned char* lds, int vcu, int G) {
    int tid = threadIdx.x; asm volatile("" : "+v"(tid));
    const int lane = tid & 63, wave = __builtin_amdgcn_readfirstlane(tid >> 6);
    LAS int* cnt = (LAS int*)(lds + LDS_GATE); LAS int* pre = cnt + 32; LAS int* base = cnt + 64; LAS int* ntl = cnt + 96;
    const int* histg = WSP(const int, WS_MOE + MO_HIST);
    int* rowtok = WSP(int, WS_MOE + MO_ROWTOK); float* rowgate = WSP(float, WS_MOE + MO_ROWGATE); int* tilee = WSP(int, WS_MOE + MO_TILEE); int* nt = WSP(int, WS_MOE + MO_NT);
    const int2* toke = WSP(const int2, WS_MOE + MO_TOKE); const float2* tokg = WSP(const float2, WS_MOE + MO_TOKG);
    if (tid < 32) { int c = 0, pr = 0; for (int w = 0; w < G; ++w) { const int v = histg[w * 32 + tid]; if (w < vcu) pr += v; c += v; } cnt[tid] = c; pre[tid] = pr; }
    __syncthreads();
    if (tid == 0) { int t = 0; for (int j = 0; j < 32; ++j) { base[j] = t * 256; const int n = (cnt[j] + 255) >> 8; ntl[j] = n; t += n; if (j == 15 && vcu == 0) nt[0] = t; } if (vcu == 0) nt[1] = t; }
    __syncthreads();
    if (vcu == 0 && tid < 32) { const int t0 = base[tid] >> 8; for (int i = 0; i < ntl[tid]; ++i) tilee[t0 + i] = tid & 15; }
    if (vcu < 32) { const int j = vcu, lo = base[j] + cnt[j], hi = base[j] + 256 * ntl[j]; for (int r = lo + tid; r < hi; r += NTHR) { rowtok[r] = -1; rowgate[r] = 0.f; } }
    if (wave < 2) {
        const int k = wave;
        int run[16];
#pragma unroll
        for (int e = 0; e < 16; ++e) run[e] = 0;
        for (int task0 = vcu * NWAVES; task0 < NTOK / 16; task0 += G * NWAVES) {
#pragma unroll 1
            for (int half = 0; half < 2; ++half) {
                const int tok = task0 * 16 + half * 64 + lane;
                const int2 ee = toke[tok]; const float2 gg = tokg[tok];
                const int e = k ? ee.y : ee.x; const float gt = k ? gg.y : gg.x;
                int rank = 0;
#pragma unroll
                for (int x = 0; x < 16; ++x) { const unsigned long long m = __ballot(e == x); if (e == x) rank = run[x] + __popcll(m & ((1ull << lane) - 1ull)); run[x] += __popcll(m); }
                const int pos = base[k * 16 + e] + pre[k * 16 + e] + rank;
                rowtok[pos] = tok; rowgate[pos] = gt;
            }
        }
    }
}
__device__ __forceinline__ void final_phase(const P& p, int vcu, int G) {
    int tid = threadIdx.x; asm volatile("" : "+v"(tid));
    const int lane = tid & 63, wave = __builtin_amdgcn_readfirstlane(tid >> 6);
    const float* ssq = WSP(const float, WS_SSQ);
    for (int m = vcu * NWAVES + wave; m < NTOK; m += G * NWAVES) {
        f32x4* s = (f32x4*)(p.out + (size_t)m * DM) + lane;
        const float rs = row_rs(ssq, m);
#pragma unroll
        for (int j = 0; j < 4; ++j) { const f32x4 g = ((const f32x4*)p.final_norm)[lane + 64 * j]; const f32x4 v = s[64 * j]; s[64 * j] = v * rs * g; }
    }
}
#ifndef ENMASK
#define ENMASK 0xffffffffu
#endif
#define EN(b) (((ENMASK) >> (b)) & 1u)
__device__ __attribute__((noinline)) void grid_barrier(unsigned* barw, unsigned x, volatile LAS unsigned* st) { XcdBarrier b; b.bar = barw; b.x = x; b.st = st; xcd_barrier(b); }
__global__ void __launch_bounds__(NTHR, 2) fwd(Args args) {
    extern __shared__ __attribute__((aligned(16))) unsigned char lds_raw[];
    LAS unsigned char* lds = (LAS unsigned char*)lds_raw;
    const P& p = args.p;
    const int tid = threadIdx.x, lane = tid & 63, wave = __builtin_amdgcn_readfirstlane(tid >> 6);
    const int G = gridDim.x; const int bx = blockIdx.x; const int vcu = (G % 8 == 0) ? (bx % 8) * (G / 8) + bx / 8 : bx;
    volatile LAS unsigned* MISC = (volatile LAS unsigned*)(lds + LDS_MISC);
    if (tid < 64) MISC[tid] = 0u;
    __syncthreads();
    unsigned* ctl = (unsigned*)(p.ws + WS_CTL);
    const int lo = args.ph_lo, hi = args.ph_hi;
    XcdBarrier bar; bar.bar = ctl + CW_BAR + args.li * XCD_BAR_WORDS; bar.x = 0; bar.st = nullptr;
    if (hi - lo > 1) bar = xcd_barrier_post(ctl + CW_BAR + args.li * XCD_BAR_WORDS, MISC);
#define IN(k) (lo <= (k) && (k) < hi)
#define PHL int vcuL = vcu, GL = G, bxL = bx, tidL = tid; asm volatile("" : "+s"(vcuL), "+s"(GL), "+s"(bxL), "+v"(tidL)); (void)vcuL; (void)GL; (void)bxL; (void)tidL;
#define SEAM(k) do { if (IN(k) && IN((k) + 1)) grid_barrier(bar.bar, bar.x, bar.st); } while (0)
    LAS float* rstab = (LAS float*)(lds + LDS_RS); LAS int* rowtab = (LAS int*)(lds + LDS_ROWTOK); LAS float* gatetab = (LAS float*)(lds + LDS_GATE);
#define HB WSP(bf16, WS_HB)
#define PROJ WSP(bf16, WS_PROJ)
#define Y WSP(bf16, WS_Y)
#define XKV WSP(bf16, WS_XKV)
#define MEMN WSP(bf16, WS_MEMN)
#define SSQ WSP(float, WS_SSQ)
#define XQ WSP(bf16, WS_XQ)
#define U WSP(bf16, WS_U)
#define ROWTOK WSP(const int, WS_MOE + MO_ROWTOK)
#define ROWGATE WSP(const float, WS_MOE + MO_ROWGATE)
#define TILEE WSP(const int, WS_MOE + MO_TILEE)
#define NT WSP(const int, WS_MOE + MO_NT)
#define H (p.out)

    if (EN(0) && IN(PH_PRO)) { PHL prologue(p, lds, vcuL, GL, wave, lane); }
    SEAM(PH_PRO);
    if (EN(1) && IN(PH_XKV)) { PHL
        pg8::StaticOrder S; S.init(MEMN, ws_base(p.ws) + WS_WXKV, 4096, 2048, DM, GL, bxL);
        EpiBf16<false> E{XKV, 2048, rstab};
        pg8::gemm_phase<DM, EpiBf16<false>, pg8::StaticOrder, true>(lds + LDS_STAGE, S, E);
    }
    SEAM(PH_XKV);
    for (int l = 0; l < NLAYER; ++l) {
        const int pb = PH_L0 + l * NPH;
        unsigned char* wl = ws_base(p.ws) + WS_W + (size_t)l * WS_WLAYER;
        if (EN(2) && IN(pb + LP_INPROJ)) { PHL
            pg8::StaticOrder S; S.init(HB, wl + WO_IN, NTOK, 3072, DM, GL, bxL);
            { pg8::Unit u; for (int iu = 0; S.next(iu, u); ++iu) if (tidL < 256) rstab[iu * 256 + tidL] = row_rs(SSQ, u.pm * 256 + tidL); }
            __syncthreads();
            EpiBf16<true> E{PROJ, PW, rstab};
            pg8::gemm_phase<DM, EpiBf16<true>, pg8::StaticOrder, true>(lds + LDS_STAGE, S, E);
            small_proj(p, l, vcuL, GL, wave, lane);
        }
        SEAM(pb + LP_INPROJ);
        if (EN(11) && IN(pb + LP_MIXA)) { PHL gla_phase_a(p, l, lds + LDS_STAGE, vcuL, GL); fox_cumsum_phase(p, l, vcuL, GL); }
        SEAM(pb + LP_MIXA);
        if (EN(12) && IN(pb + LP_MIXB)) { PHL gla_phase_b(p, vcuL, GL); }
        SEAM(pb + LP_MIXB);
        if (EN(9) && IN(pb + LP_MIXC)) { PHL fox_phase(p, l, lds + LDS_STAGE, vcuL, GL); gla_phase_c(p, l, lds + LDS_STAGE, vcuL, GL); }
        SEAM(pb + LP_MIXC);
        if (EN(3) && IN(pb + LP_WOUT)) { PHL
            pg8::StaticOrder S; S.init(Y, wl + WO_OUT, NTOK, DM, DM, GL, bxL);
            EpiRes<false, true> E{l == 0 ? p.x : H, H, HB, SSQ, rowtab, gatetab};
            pg8::gemm_phase<DM, EpiRes<false, true>, pg8::StaticOrder, true>(lds + LDS_STAGE, S, E);
        }
        SEAM(pb + LP_WOUT);
        if (EN(4) && IN(pb + LP_XQ)) { PHL
            pg8::StaticOrder S; S.init(HB, wl + WO_XQ, NTOK, 512, DM, GL, bxL);
            { pg8::Unit u; for (int iu = 0; S.next(iu, u); ++iu) if (tidL < 256) rstab[iu * 256 + tidL] = row_rs(SSQ, u.pm * 256 + tidL); }
            __syncthreads();
            EpiBf16<true> E{XQ, 512, rstab};
            pg8::gemm_phase<DM, EpiBf16<true>, pg8::StaticOrder, true>(lds + LDS_STAGE, S, E);
        }
        SEAM(pb + LP_XQ);
        if (EN(10) && IN(pb + LP_XATTN)) { PHL xattn_phase(p, l, lds + LDS_STAGE, vcuL, GL); }
        SEAM(pb + LP_XATTN);
        if (EN(5) && IN(pb + LP_XO)) { PHL
            pg8::StaticOrder S; S.init(XQ, wl + WO_XO, NTOK, DM, 512, GL, bxL);
            EpiRes<false, true> E{H, H, HB, SSQ, rowtab, gatetab};
            pg8::gemm_phase<512, EpiRes<false, true>, pg8::StaticOrder, true>(lds + LDS_STAGE, S, E);
        }
        SEAM(pb + LP_XO);
        if (EN(13) && IN(pb + LP_ROUTE)) { PHL route_phase(p, l, lds, vcuL, GL); }
        SEAM(pb + LP_ROUTE);
        if (EN(14) && IN(pb + LP_SORT)) { PHL sort_phase(p, lds, vcuL, GL); }
        SEAM(pb + LP_SORT);
        if (EN(6) && IN(pb + LP_GU)) { PHL
            MoeOrder<true> S{(const char*)HB, (const char*)(wl + WO_GU), DM, (size_t)1024 * DM * 2, 0, NT[1], GL, vcuL, TILEE, rowtab};
            { pg8::Unit u; for (int iu = 0; S.next(iu, u); ++iu) if (tidL < 256) { int t = ROWTOK[u.pm * 256 + tidL]; t = t < 0 ? 0 : t; rowtab[iu * 256 + tidL] = t; rstab[iu * 256 + tidL] = row_rs(SSQ, t); } }
            __syncthreads();
            EpiGU E{U, rstab};
            pg8::gemm_phase<DM, EpiGU, MoeOrder<true>, true>(lds + LDS_STAGE, S, E);
        }
        SEAM(pb + LP_GU);
        if (EN(7) && IN(pb + LP_DOWN0)) { PHL
            MoeOrder<false> S{(const char*)U, (const char*)(wl + WO_D), 512, (size_t)1024 * 512 * 2, 0, NT[0], GL, vcuL, TILEE, rowtab};
            __syncthreads();
            { pg8::Unit u; for (int iu = 0; S.next(iu, u); ++iu) if (tidL < 256) { rowtab[iu * 256 + tidL] = ROWTOK[u.pm * 256 + tidL]; gatetab[iu * 256 + tidL] = ROWGATE[u.pm * 256 + tidL]; } }
            __syncthreads();
            EpiRes<true, false> E{H, H, HB, SSQ, rowtab, gatetab};
            pg8::gemm_phase<512, EpiRes<true, false>, MoeOrder<false>, true>(lds + LDS_STAGE, S, E);
        }
        SEAM(pb + LP_DOWN0);
        if (EN(8) && IN(pb + LP_DOWN1)) { PHL
            MoeOrder<false> S{(const char*)U, (const char*)(wl + WO_D), 512, (size_t)1024 * 512 * 2, NT[0], NT[1], GL, vcuL, TILEE, rowtab};
            __syncthreads();
            { pg8::Unit u; for (int iu = 0; S.next(iu, u); ++iu) if (tidL < 256) { rowtab[iu * 256 + tidL] = ROWTOK[u.pm * 256 + tidL]; gatetab[iu * 256 + tidL] = ROWGATE[u.pm * 256 + tidL]; } }
            __syncthreads();
            EpiRes<true, true> E{H, H, HB, SSQ, rowtab, gatetab};
            pg8::gemm_phase<512, EpiRes<true, true>, MoeOrder<false>, true>(lds + LDS_STAGE, S, E);
        }
        SEAM(pb + LP_DOWN1);
    }
    if (EN(15) && IN(PH_FINAL)) { PHL final_phase(p, vcuL, GL); }
#undef IN
#undef SEAM
#undef HB
#undef PROJ
#undef Y
#undef XKV
#undef MEMN
#undef SSQ
#undef XQ
#undef U
#undef ROWTOK
#undef ROWGATE
#undef TILEE
#undef NT
#undef H
}

static int g_grid = 0;
static void launch_fast(const P& p, int lo, int hi, int& li, hipStream_t stream) {
    Args a{}; a.p = p; a.ph_lo = lo; a.ph_hi = hi; a.li = li++; a.pad = 0;
    hipLaunchKernelGGL(fwd, dim3(g_grid), dim3(NTHR), LDS_BYTES, stream, a);
    const hipError_t le = hipPeekAtLastError();
    if (le != hipSuccess) fprintf(stderr, "kernel_launch: fwd launch [%d,%d) failed: %s\n", lo, hi, hipGetErrorName(le));
}
extern "C" void kernel_launch(void* const* d_in, const int* in_sizes, int n_in, void* d_out, int out_size, void* d_ws, size_t ws_size, hipStream_t stream) {
    if (n_in != 25 || out_size != NTOK * DM || ws_size < WS_END2) { fprintf(stderr, "kernel_launch: unexpected sizes n_in %d out %d ws %zu (need %zu)\n", n_in, out_size, ws_size, (size_t)WS_END2); return; }
    if (g_grid == 0) {
        int dev = 0, cus = 0, per_cu = 0;
        if (hipGetDevice(&dev) != hipSuccess || hipDeviceGetAttribute(&cus, hipDeviceAttributeMultiprocessorCount, dev) != hipSuccess) { g_grid = -1; return; }
        if (hipFuncSetAttribute((const void*)fwd, hipFuncAttributeMaxDynamicSharedMemorySize, LDS_BYTES) != hipSuccess) { fprintf(stderr, "kernel_launch: hipFuncSetAttribute failed\n"); g_grid = -1; return; }
        if (hipOccupancyMaxActiveBlocksPerMultiprocessor(&per_cu, (const void*)fwd, NTHR, LDS_BYTES) != hipSuccess || per_cu < 1) { fprintf(stderr, "kernel_launch: occupancy query says %d\n", per_cu); }
        (void)hipGetLastError();
        g_grid = cus;
    }
    if (g_grid < 0) return;
    P p{};
    const float** pp = (const float**)&p;
    for (int i = 0; i < 25; ++i) pp[i] = (const float*)d_in[i];
    p.out = (float*)d_out; p.ws = (unsigned char*)d_ws;
    hipMemsetAsync((char*)d_ws + WS_CTL, 0, 1 * MiB, stream);
    bf16* HB = WSP(bf16, WS_HB); bf16* PROJ = WSP(bf16, WS_PROJ); float* SM = WSP(float, WS_SM); float* CB = WSP(float, WS_CB); bf16* Y = WSP(bf16, WS_Y);
    bf16* XKV = WSP(bf16, WS_XKV); float* SSQ = WSP(float, WS_SSQ); bf16* XQ = WSP(bf16, WS_XQ);
    float* LA = WSP(float, WS_HB);
    int2* TOKE = WSP(int2, WS_MOE + MO_TOKE); float2* TOKG = WSP(float2, WS_MOE + MO_TOKG); int* ROWTOK = WSP(int, WS_MOE + MO_ROWTOK); float* ROWGATE = WSP(float, WS_MOE + MO_ROWGATE);
    int* TILEE = WSP(int, WS_MOE + MO_TILEE); int* NT = WSP(int, WS_MOE + MO_NT);
    float* H = p.out;
    (void)HB; (void)SSQ; (void)XQ;
    int li = 0;
    launch_fast(p, PH_PRO, PH_END, li, stream);
}
```

```cpp
#define REPMASK 0x0
#include <hip/hip_runtime.h>
#include <cstdio>
#include <cstdint>

constexpr int NTOK = 32768, DM = 1024, NBATCH = 16, SEQ = 2048, NLAYER = 2, MEML = 256;
constexpr int PW = 3072;
constexpr int C_FQ = 0, C_FK = 512, C_FV = 1024, C_GQ = 1536, C_GK = 1792, C_GV = 2048, C_GG = 2560;
constexpr int INW = 3096;
constexpr float EPS = 1e-6f, LOG2E = 1.4426950408889634f;
constexpr int MAXTILES = 288;
constexpr int MAXROWS = MAXTILES * 256;

typedef unsigned short bf16;
__device__ __forceinline__ unsigned f2bf(float f) { unsigned u = __builtin_bit_cast(unsigned, f); return (u + 0x7fffu + ((u >> 16) & 1u)) >> 16; }
__device__ __forceinline__ float bf2f(bf16 b) { return __builtin_bit_cast(float, ((unsigned)b) << 16); }

constexpr size_t MiB = 1u << 20;
constexpr size_t WS_CTL = 0;
constexpr size_t WS_W = 1 * MiB;
constexpr size_t WS_WLAYER = 59 * MiB;
constexpr size_t WS_WXKV = WS_W + 2 * WS_WLAYER;
constexpr size_t WS_HB = WS_WXKV + 4 * MiB;
constexpr size_t WS_PROJ = WS_HB + 64 * MiB;
constexpr size_t WS_XQ = WS_PROJ;
constexpr size_t WS_U = WS_PROJ + 32 * MiB;
constexpr size_t WS_SM = WS_PROJ + 192 * MiB;
constexpr size_t WS_CB = WS_SM + 4 * MiB;
constexpr size_t WS_Y = WS_CB + 1 * MiB;
constexpr size_t WS_XKV = WS_Y + 64 * MiB;
constexpr size_t WS_MEMN = WS_XKV + 16 * MiB;
constexpr size_t WS_SSQ = WS_MEMN + 8 * MiB;
constexpr size_t WS_MOE = WS_SSQ + 2 * MiB;
constexpr size_t WS_END = WS_MOE + 2 * MiB;
static_assert(WS_END <= 512 * MiB, "workspace map");
constexpr size_t MO_TOKE = 0;
constexpr size_t MO_TOKG = 256 * 1024;
constexpr size_t MO_ROWTOK = 512 * 1024;
constexpr size_t MO_ROWGATE = 832 * 1024;
constexpr size_t MO_TILEE = 1152 * 1024;
constexpr size_t MO_NT = 1156 * 1024;
constexpr size_t MO_HIST = 1160 * 1024;

struct P {
    const float *x, *mem, *mem_norm, *mix_norm, *w_in, *b_forget, *w_alpha_up, *b_alpha, *fox_gain, *gla_gain, *w_out, *cross_norm, *w_xq, *w_xk, *w_xv, *w_xo,
        *moe_norm, *w_rg, *b_rg, *w_re, *b_re, *w_eg, *w_eu, *w_ed, *final_norm;
    float* out; unsigned char* ws;
};
__host__ __device__ __forceinline__ unsigned char* ws_base(unsigned char* w) {
#if defined(__HIP_DEVICE_COMPILE__)
    asm volatile("" : "+s"(w));
#endif
    return w; }
#define WSP(T, off) ((T*)(ws_base(p.ws) + (off)))

__device__ __forceinline__ float wave_sum(float v) {
#pragma unroll
    for (int o = 1; o < 64; o <<= 1) v += __shfl_xor(v, o);
    return v;
}
__device__ __forceinline__ float wave_max(float v) {
#pragma unroll
    for (int o = 1; o < 64; o <<= 1) v = fmaxf(v, __shfl_xor(v, o));
    return v;
}
__device__ __forceinline__ float row_rs(const float* ssq, int row) {
    const float4* s = (const float4*)(ssq + (size_t)row * 16);
    float4 a = s[0], b = s[1], c = s[2], d = s[3];
    float t = ((a.x + a.y) + (a.z + a.w)) + ((b.x + b.y) + (b.z + b.w)) + ((c.x + c.y) + (c.z + c.w)) + ((d.x + d.y) + (d.z + d.w));
    return rsqrtf(t * (1.0f / DM) + EPS);
}
__device__ __forceinline__ float log_sigmoid(float z) { return fminf(z, 0.f) - log1pf(expf(-fabsf(z))); }
__device__ __forceinline__ float silu(float z) { return z / (1.f + expf(-z)); }

typedef unsigned st_v4u __attribute__((ext_vector_type(4)));
typedef unsigned st_v2u __attribute__((ext_vector_type(2)));
#ifndef WT_STORES
#define WT_STORES 0
#endif
__device__ __forceinline__ void st_b128(void* p, st_v4u v) {
#if WT_STORES
    asm volatile("global_store_dwordx4 %0, %1, off sc1\n\ts_nop 1" :: "v"(p), "v"(v) : "memory");
#else
    *(st_v4u*)p = v;
#endif
}
__device__ __forceinline__ void st_b64(void* p, st_v2u v) {
#if WT_STORES
    asm volatile("global_store_dwordx2 %0, %1, off sc1" :: "v"(p), "v"(v) : "memory");
#else
    *(st_v2u*)p = v;
#endif
}
__global__ void __launch_bounds__(256) k_rowprep(const float* src, bf16* dst, float* ssq, const float* gain, int rows, int mode) {
    const int lane = threadIdx.x & 63, row = blockIdx.x * 4 + (threadIdx.x >> 6);
    if (row >= rows) return;
    const float4* s = (const float4*)(src + (size_t)row * DM) + lane;
    float4 v[4]; float q = 0.f;
#pragma unroll
    for (int j = 0; j < 4; ++j) { v[j] = s[64 * j]; q += (v[j].x * v[j].x + v[j].y * v[j].y) + (v[j].z * v[j].z + v[j].w * v[j].w); }
    q = wave_sum(q);
    float sc = 1.f;
    if (mode == 1) sc = rsqrtf(q * (1.0f / DM) + EPS);
    else if (lane < 16) ssq[(size_t)row * 16 + lane] = lane == 0 ? q : 0.f;
    uint2* d = (uint2*)(dst + (size_t)row * DM) + lane;
#pragma unroll
    for (int j = 0; j < 4; ++j) {
        float4 g = mode == 1 ? ((const float4*)gain)[lane + 64 * j] : make_float4(1.f, 1.f, 1.f, 1.f);
        d[64 * j] = make_uint2(f2bf(v[j].x * sc * g.x) | (f2bf(v[j].y * sc * g.y) << 16), f2bf(v[j].z * sc * g.z) | (f2bf(v[j].w * sc * g.w) << 16));
    }
}
__global__ void __launch_bounds__(256) k_final(float* io, const float* gain) {
    const int lane = threadIdx.x & 63, row = blockIdx.x * 4 + (threadIdx.x >> 6);
    float4* s = (float4*)(io + (size_t)row * DM) + lane;
    float4 v[4]; float q = 0.f;
#pragma unroll
    for (int j = 0; j < 4; ++j) { v[j] = s[64 * j]; q += (v[j].x * v[j].x + v[j].y * v[j].y) + (v[j].z * v[j].z + v[j].w * v[j].w); }
    q = wave_sum(q);
    const float sc = rsqrtf(q * (1.0f / DM) + EPS);
#pragma unroll
    for (int j = 0; j < 4; ++j) { float4 g = ((const float4*)gain)[lane + 64 * j]; s[64 * j] = make_float4(v[j].x * sc * g.x, v[j].y * sc * g.y, v[j].z * sc * g.z, v[j].w * sc * g.w); }
}

template <class C> __global__ void __launch_bounds__(256) k_ngemm(C c) {
    __shared__ float As[16][65];
    __shared__ float Bs[C::NB][16][65];
    const int M = c.rows();
    const int row0 = blockIdx.y * 64, col0 = blockIdx.x * 64;
    if (row0 >= M || row0 < c.row_lo()) return;
    const int tx = threadIdx.x & 15, ty = threadIdx.x >> 4;
    float acc[C::NB][4][4];
#pragma unroll
    for (int n = 0; n < C::NB; ++n)
#pragma unroll
        for (int i = 0; i < 4; ++i)
#pragma unroll
            for (int j = 0; j < 4; ++j) acc[n][i][j] = 0.f;
    for (int k0 = 0; k0 < c.K; k0 += 16) {
#pragma unroll
        for (int i = 0; i < 4; ++i) { const int idx = threadIdx.x + 256 * i, r = idx >> 4, kk = idx & 15; As[kk][r] = c.a(row0 + r, k0 + kk); }
#pragma unroll
        for (int n = 0; n < C::NB; ++n)
#pragma unroll
            for (int i = 0; i < 4; ++i) { const int idx = threadIdx.x + 256 * i, kk = idx >> 6, cc = idx & 63; Bs[n][kk][cc] = c.b(n, k0 + kk, col0 + cc, row0); }
        __syncthreads();
#pragma unroll
        for (int kk = 0; kk < 16; ++kk) {
            float a[4];
#pragma unroll
            for (int i = 0; i < 4; ++i) a[i] = As[kk][ty * 4 + i];
#pragma unroll
            for (int n = 0; n < C::NB; ++n) {
                float b[4];
#pragma unroll
                for (int j = 0; j < 4; ++j) b[j] = Bs[n][kk][tx * 4 + j];
#pragma unroll
                for (int i = 0; i < 4; ++i)
#pragma unroll
                    for (int j = 0; j < 4; ++j) acc[n][i][j] += a[i] * b[j];
            }
        }
        __syncthreads();
    }
#pragma unroll
    for (int i = 0; i < 4; ++i)
#pragma unroll
        for (int j = 0; j < 4; ++j) c.epi(row0 + ty * 4 + i, col0 + tx * 4 + j, acc[0][i][j], acc[C::NB - 1][i][j]);
}

struct CfgXKV {
    __device__ int row_lo() const { return 0; }
    static constexpr int NB = 1; int K; const bf16* A; const float *wk, *wv; bf16* O; int l;
    __device__ int rows() const { return 4096; }
    __device__ float a(int r, int k) const { return bf2f(A[(size_t)r * DM + k]); }
    __device__ float b(int, int k, int c, int) const { return c < 512 ? wk[(size_t)k * 512 + c] : wv[(size_t)k * 512 + c - 512]; }
    __device__ void epi(int r, int c, float v, float) const { O[(size_t)r * 2048 + l * 1024 + c] = (bf16)f2bf(v); }
};
struct CfgInProj {
    __device__ int row_lo() const { return 0; }
    static constexpr int NB = 1; int K; const bf16* A; const float *w, *gain, *ssq; bf16* proj; float* sm;
    __device__ int rows() const { return NTOK; }
    __device__ float a(int r, int k) const { return bf2f(A[(size_t)r * DM + k]); }
    __device__ float b(int, int k, int c, int) const { return c < INW ? gain[k] * w[(size_t)k * INW + c] : 0.f; }
    __device__ void epi(int r, int c, float v, float) const {
        if (c >= INW) return;
        v *= row_rs(ssq, r);
        if (c < 1536) { if (c < 512) v *= 0.125f * LOG2E; proj[(size_t)r * PW + c] = (bf16)f2bf(v); }
        else if (c < 1544) sm[(size_t)r * 32 + (c - 1536)] = v;
        else if (c < 3080) { if (c < 1800) v *= 0.125f; proj[(size_t)r * PW + (c - 8)] = (bf16)f2bf(v); }
        else sm[(size_t)r * 32 + 8 + (c - 3080)] = v;
    }
};
struct CfgRes {
    __device__ int row_lo() const { return 0; }
    static constexpr int NB = 1; int K; const bf16* A; const float* w; const float* base; float* out;
    __device__ int rows() const { return NTOK; }
    __device__ float a(int r, int k) const { return bf2f(A[(size_t)r * K + k]); }
    __device__ float b(int, int k, int c, int) const { return w[(size_t)k * DM + c]; }
    __device__ void epi(int r, int c, float v, float) const { out[(size_t)r * DM + c] = base[(size_t)r * DM + c] + v; }
};
struct CfgXQ {
    __device__ int row_lo() const { return 0; }
    static constexpr int NB = 1; int K; const bf16* A; const float *w, *gain, *ssq; bf16* O;
    __device__ int rows() const { return NTOK; }
    __device__ float a(int r, int k) const { return bf2f(A[(size_t)r * DM + k]); }
    __device__ float b(int, int k, int c, int) const { return gain[k] * w[(size_t)k * 512 + c]; }
    __device__ void epi(int r, int c, float v, float) const { O[(size_t)r * 512 + c] = (bf16)f2bf(v * row_rs(ssq, r) * (0.08838834764831845f * LOG2E)); }
};
struct CfgGU {
    __device__ int row_lo() const { return 0; }
    static constexpr int NB = 2; int K; const bf16* A; const float *wg, *wu, *gain, *ssq; const int *rowtok, *tilee, *nt; bf16* U;
    __device__ int rows() const { return nt[1] * 256; }
    __device__ float a(int r, int k) const { int t = rowtok[r]; t = t < 0 ? 0 : t; return bf2f(A[(size_t)t * DM + k]); }
    __device__ float b(int n, int k, int c, int row0) const { const int e = tilee[row0 >> 8]; const size_t o = ((size_t)e * DM + k) * 512 + c; return n == 0 ? gain[k] * wg[o] : gain[k] * wu[o]; }
    __device__ void epi(int r, int c, float g, float u) const {
        const int t = rowtok[r]; float v = 0.f;
        if (t >= 0) { const float rs = row_rs(ssq, t); v = silu(g * rs) * (u * rs); }
        U[(size_t)r * 512 + c] = (bf16)f2bf(v);
    }
};
struct CfgDown {
    static constexpr int NB = 1; int K; const bf16* U; const float* wd; const int *rowtok, *tilee, *nt; const float* rowgate; float* out; int which;
    __device__ int rows() const { return nt[which] * 256; }
    __device__ int row_lo() const { return which == 1 ? nt[0] * 256 : 0; }
    __device__ float a(int r, int k) const { return bf2f(U[(size_t)r * 512 + k]); }
    __device__ float b(int, int k, int c, int row0) const { const int e = tilee[row0 >> 8]; return wd[((size_t)e * 512 + k) * DM + c]; }
    __device__ void epi(int r, int c, float v, float) const {
        if (which == 1 && r < nt[0] * 256) return;
        const int t = rowtok[r]; if (t >= 0) out[(size_t)t * DM + c] += rowgate[r] * v;
    }
};

__global__ void __launch_bounds__(64) k_fox_cumsum(const float* sm, const float* bfor, float* cb) {
    const int b = blockIdx.x >> 3, h = blockIdx.x & 7, lane = threadIdx.x;
    const float bias = bfor[h];
    float v[32]; float run = 0.f;
#pragma unroll
    for (int j = 0; j < 32; ++j) { const int s = lane * 32 + j; run += log_sigmoid(sm[((size_t)b * SEQ + s) * 32 + h] + bias); v[j] = run; }
    float tot = run, pre = run;
#pragma unroll
    for (int o = 1; o < 64; o <<= 1) { const float t = __shfl_up(pre, o); if (lane >= o) pre += t; }
    pre -= tot;
#pragma unroll
    for (int j = 0; j < 32; ++j) cb[((size_t)b * 8 + h) * SEQ + lane * 32 + j] = -(v[j] + pre) * LOG2E;
}
__global__ void __launch_bounds__(256) k_fox_attn(const bf16* proj, const float* cb, const float* gain, bf16* y) {
    __shared__ float pbuf[4][SEQ];
    __shared__ float qbuf[4][64];
    const int w = threadIdx.x >> 6, lane = threadIdx.x & 63;
    const int gq = blockIdx.x * 4 + w;
    const int q = gq % SEQ, h = (gq / SEQ) % 8, b = gq / (SEQ * 8);
    const size_t tok = (size_t)b * SEQ + q;
    qbuf[w][lane] = bf2f(proj[tok * PW + C_FQ + h * 64 + lane]);
    __syncthreads();
    const float* cbp = cb + ((size_t)b * 8 + h) * SEQ;
    float s[32]; float mx = -INFINITY;
#pragma unroll
    for (int j = 0; j < 32; ++j) {
        const int key = lane + 64 * j; float v = -INFINITY;
        if (key <= q) {
            const uint4* kr = (const uint4*)(proj + ((size_t)b * SEQ + key) * PW + C_FK + h * 64);
            float d = 0.f;
#pragma unroll
            for (int c8 = 0; c8 < 8; ++c8) { const uint4 u = kr[c8]; const unsigned ww[4] = {u.x, u.y, u.z, u.w};
#pragma unroll
                for (int e = 0; e < 4; ++e) { d += qbuf[w][c8 * 8 + 2 * e] * bf2f((bf16)(ww[e] & 0xffff)); d += qbuf[w][c8 * 8 + 2 * e + 1] * bf2f((bf16)(ww[e] >> 16)); } }
            v = d + cbp[key];
        }
        s[j] = v; mx = fmaxf(mx, v);
    }
    mx = wave_max(mx);
    float l = 0.f;
#pragma unroll
    for (int j = 0; j < 32; ++j) { const float pv = (lane + 64 * j <= q) ? exp2f(s[j] - mx) : 0.f; l += pv; pbuf[w][lane + 64 * j] = pv; }
    l = wave_sum(l);
    __syncthreads();
    float o = 0.f;
    for (int key = 0; key <= q; ++key) o += pbuf[w][key] * bf2f(proj[((size_t)b * SEQ + key) * PW + C_FV + h * 64 + lane]);
    o /= l;
    const float ms = wave_sum(o * o) * (1.0f / 64.0f);
    y[tok * DM + h * 64 + lane] = (bf16)f2bf(o * rsqrtf(ms + EPS) * gain[h * 64 + lane]);
}
__global__ void __launch_bounds__(256) k_gla_la(const float* sm, const float* wup, const float* balpha, float* la) {
    const int tok = blockIdx.x, c = threadIdx.x;
    float z = balpha[c];
#pragma unroll
    for (int r = 0; r < 16; ++r) z += sm[(size_t)tok * 32 + 8 + r] * wup[r * 256 + c];
    la[(size_t)tok * 256 + c] = log_sigmoid(z) * (1.0f / 16.0f);
}
__global__ void __launch_bounds__(128) k_gla_rec(const bf16* proj, const float* la, const float* gain, bf16* y) {
    __shared__ float sh_a[64], sh_k[64], sh_q[64], red[2];
    const int b = blockIdx.x >> 2, h = blockIdx.x & 3, dv = threadIdx.x;
    float st[64];
#pragma unroll
    for (int i = 0; i < 64; ++i) st[i] = 0.f;
    const float g = gain[h * 128 + dv];
    for (int t = 0; t < SEQ; ++t) {
        const size_t tok = (size_t)b * SEQ + t;
        __syncthreads();
        if (dv < 64) { sh_a[dv] = expf(la[tok * 256 + h * 64 + dv]); sh_k[dv] = bf2f(proj[tok * PW + C_GK + h * 64 + dv]); }
        else sh_q[dv - 64] = bf2f(proj[tok * PW + C_GQ + h * 64 + dv - 64]);
        __syncthreads();
        const float v = bf2f(proj[tok * PW + C_GV + h * 128 + dv]);
        float o = 0.f;
#pragma unroll
        for (int i = 0; i < 64; ++i) { st[i] = sh_a[i] * st[i] + sh_k[i] * v; o += sh_q[i] * st[i]; }
        const float ss = wave_sum(o * o);
        if ((dv & 63) == 0) red[dv >> 6] = ss;
        __syncthreads();
        const float ms = (red[0] + red[1]) * (1.0f / 128.0f);
        const float gg = bf2f(proj[tok * PW + C_GG + h * 128 + dv]);
        y[tok * DM + 512 + h * 128 + dv] = (bf16)f2bf(o * rsqrtf(ms + EPS) * g * silu(gg));
    }
}
__global__ void __launch_bounds__(256) k_xattn(bf16* xq, const bf16* xkv, int l) {
    __shared__ float pbuf[4][256];
    __shared__ float qbuf[4][128];
    const int w = threadIdx.x >> 6, lane = threadIdx.x & 63;
    const int gq = blockIdx.x * 4 + w;
    const int q = gq % SEQ, h = (gq / SEQ) % 4, b = gq / (SEQ * 4);
    const size_t tok = (size_t)b * SEQ + q;
    qbuf[w][lane] = bf2f(xq[tok * 512 + h * 128 + lane]); qbuf[w][lane + 64] = bf2f(xq[tok * 512 + h * 128 + lane + 64]);
    __syncthreads();
    float s[4]; float mx = -INFINITY;
#pragma unroll
    for (int j = 0; j < 4; ++j) {
        const int key = lane + 64 * j;
        const uint4* kr = (const uint4*)(xkv + ((size_t)b * MEML + key) * 2048 + l * 1024 + h * 128);
        float d = 0.f;
#pragma unroll
        for (int c8 = 0; c8 < 16; ++c8) { const uint4 u = kr[c8]; const unsigned ww[4] = {u.x, u.y, u.z, u.w};
#pragma unroll
            for (int e = 0; e < 4; ++e) { d += qbuf[w][c8 * 8 + 2 * e] * bf2f((bf16)(ww[e] & 0xffff)); d += qbuf[w][c8 * 8 + 2 * e + 1] * bf2f((bf16)(ww[e] >> 16)); } }
        s[j] = d; mx = fmaxf(mx, d);
    }
    mx = wave_max(mx);
    float lsum = 0.f;
#pragma unroll
    for (int j = 0; j < 4; ++j) { const float pv = exp2f(s[j] - mx); lsum += pv; pbuf[w][lane + 64 * j] = pv; }
    lsum = wave_sum(lsum);
    __syncthreads();
    float o0 = 0.f, o1 = 0.f;
    for (int key = 0; key < 256; ++key) { const bf16* vr = xkv + ((size_t)b * MEML + key) * 2048 + l * 1024 + 512 + h * 128; const float pv = pbuf[w][key]; o0 += pv * bf2f(vr[lane]); o1 += pv * bf2f(vr[lane + 64]); }
    xq[tok * 512 + h * 128 + lane] = (bf16)f2bf(o0 / lsum); xq[tok * 512 + h * 128 + lane + 64] = (bf16)f2bf(o1 / lsum);
}
__global__ void __launch_bounds__(256) k_router(const float* h, const float* gain, const float* wrg, const float* brg, const float* wre, const float* bre, int2* toke, float2* tokg) {
    const int lane = threadIdx.x & 63, tok = blockIdx.x * 4 + (threadIdx.x >> 6);
    const float* hr = h + (size_t)tok * DM;
    float hv[16]; float q = 0.f;
#pragma unroll
    for (int j = 0; j < 16; ++j) { hv[j] = hr[lane + 64 * j]; q += hv[j] * hv[j]; }
    q = wave_sum(q);
    const float rs = rsqrtf(q * (1.0f / DM) + EPS);
#pragma unroll
    for (int j = 0; j < 16; ++j) hv[j] = hv[j] * rs * gain[lane + 64 * j];
    float lg[20];
#pragma unroll
    for (int o = 0; o < 20; ++o) {
        float d = 0.f;
#pragma unroll
        for (int j = 0; j < 16; ++j) { const int k = lane + 64 * j; d += hv[j] * (o < 4 ? wrg[k * 4 + o] : wre[k * 16 + (o - 4)]); }
        lg[o] = wave_sum(d) + (o < 4 ? brg[o] : bre[o - 4]);
    }
    if (lane == 0) {
        int g = 0; float gm = lg[0];
#pragma unroll
        for (int i = 1; i < 4; ++i) if (lg[i] > gm) { gm = lg[i]; g = i; }
        float den = 0.f;
#pragma unroll
        for (int i = 0; i < 4; ++i) den += expf(lg[i] - gm);
        const float pg = 1.0f / den;
        float el[4];
#pragma unroll
        for (int i = 0; i < 4; ++i) { float v = lg[4];
#pragma unroll
            for (int gg = 0; gg < 4; ++gg) if (gg == g) v = lg[4 + gg * 4 + i];
            el[i] = v; }
        int i0 = 0; float m0 = el[0];
#pragma unroll
        for (int i = 1; i < 4; ++i) if (el[i] > m0) { m0 = el[i]; i0 = i; }
        int i1 = -1; float m1 = -INFINITY;
#pragma unroll
        for (int i = 0; i < 4; ++i) if (i != i0 && el[i] > m1) { m1 = el[i]; i1 = i; }
        const float e1 = expf(m1 - m0), inv = 1.0f / (1.0f + e1);
        toke[tok] = make_int2(g * 4 + i0, g * 4 + i1);
        tokg[tok] = make_float2(pg * inv, pg * e1 * inv);
    }
}
__global__ void k_sort(const int2* toke, const float2* tokg, int* rowtok, float* rowgate, int* tilee, int* nt) {
    __shared__ int cnt[32], base[32];
    if (threadIdx.x != 0 || blockIdx.x != 0) return;
    for (int i = 0; i < 32; ++i) cnt[i] = 0;
    for (int t = 0; t < NTOK; ++t) { const int2 e = toke[t]; cnt[e.x]++; cnt[16 + e.y]++; }
    int tile = 0;
    for (int k = 0; k < 2; ++k) { for (int e = 0; e < 16; ++e) { base[k * 16 + e] = tile * 256; const int n = (cnt[k * 16 + e] + 255) / 256; for (int i = 0; i < n; ++i) tilee[tile + i] = e; tile += n; } nt[k] = tile; }
    for (int r = 0; r < tile * 256; ++r) { rowtok[r] = -1; rowgate[r] = 0.f; }
    for (int t = 0; t < NTOK; ++t) {
        const int2 e = toke[t]; const float2 g = tokg[t];
        { const int pos = base[e.x]++; rowtok[pos] = t; rowgate[pos] = g.x; }
        { const int pos = base[16 + e.y]++; rowtok[pos] = t; rowgate[pos] = g.y; }
    }
}

#define XB_TMO      128
#define XB_XCNT(j)  (256  + 64 * (j))
#define XB_XSUB(j)  (1280 + 64 * (j))
#define XB_XGEN(j)  (2304 + 64 * (j))
#define XB_TOP      3328
#define XB_TOPGEN   3392
#define XCD_BAR_WORDS 3456
#define XB_SPIN_CAP (1u << 18)
#define LAS __attribute__((address_space(3)))

__device__ __forceinline__ unsigned xb_ld(unsigned* p)              { return __hip_atomic_load(p, __ATOMIC_RELAXED, __HIP_MEMORY_SCOPE_AGENT); }
__device__ __forceinline__ unsigned xb_add(unsigned* p, unsigned v) { return __hip_atomic_fetch_add(p, v, __ATOMIC_RELAXED, __HIP_MEMORY_SCOPE_AGENT); }
__device__ __forceinline__ unsigned xb_xcc_id() { return (unsigned)__builtin_amdgcn_s_getreg((3 << 11) | 20) & 0xFu; }
#define XB_SPIN(cond, bar) do { unsigned _sp = 0; while (cond) { __builtin_amdgcn_s_sleep(1); \
    if ((++_sp & 255u) == 0u) { if (xb_ld(&(bar)[XB_TMO])) break; if (_sp > XB_SPIN_CAP) { atomicAdd(&(bar)[XB_TMO], 1u); break; } } } } while (0)

struct XcdBarrier {
    unsigned* bar; unsigned x;
    volatile LAS unsigned* st;
};

__device__ __forceinline__ XcdBarrier xcd_barrier_post(unsigned* bar, volatile LAS unsigned* st) {
    XcdBarrier b; b.bar = bar; b.x = xb_xcc_id(); b.st = st;
    if (threadIdx.x == 0) (void)xb_add(&bar[XB_XCNT(b.x)], 1u);
    return b;
}
__device__ __forceinline__ void xcd_barrier_complete(unsigned* bar, unsigned x, unsigned& nloc, unsigned& nx) {
    const unsigned G = gridDim.x * gridDim.y * gridDim.z;
    unsigned sum, cnt, mine, sp = 0u;
    for (;;) {
        sum = 0u; cnt = 0u; mine = 0u;
#pragma unroll
        for (unsigned j = 0; j < 16; ++j) { const unsigned c = xb_ld(&bar[XB_XCNT(j)]); sum += c; cnt += (c > 0u) ? 1u : 0u; mine = (j == x) ? c : mine; }
        if (sum == G) break;
        __builtin_amdgcn_s_sleep(1);
        if ((++sp & 255u) == 0u) { if (xb_ld(&bar[XB_TMO])) break; if (sp > XB_SPIN_CAP) { atomicAdd(&bar[XB_TMO], 1u); break; } }
    }
    nloc = mine > 0u ? mine : 1u; nx = cnt > 0u ? cnt : 1u;
}

__device__ __forceinline__ void xcd_barrier(const XcdBarrier& b) {
    asm volatile("s_waitcnt vmcnt(0)" ::: "memory");
    __syncthreads();
    if (threadIdx.x == 0) {
        unsigned* bar = b.bar;
        __builtin_amdgcn_s_waitcnt(0);
        unsigned nloc = b.st[0], nx = b.st[1];
        if (nloc == 0u) { xcd_barrier_complete(bar, b.x, nloc, nx); b.st[0] = nloc; b.st[1] = nx; }
        const unsigned old = xb_add(&bar[XB_XSUB(b.x)], 1u);
        const unsigned gen = old / nloc;
        if (old + 1u == (gen + 1u) * nloc) {
            __builtin_amdgcn_fence(__ATOMIC_RELEASE, "agent");
            asm volatile("s_waitcnt vmcnt(0)" ::: "memory");
            const unsigned og = xb_add(&bar[XB_TOP], 1u);
            const unsigned tg = og / nx;
            if (og + 1u == (tg + 1u) * nx) xb_add(&bar[XB_TOPGEN], 1u);
            else XB_SPIN(xb_ld(&bar[XB_TOPGEN]) == tg, bar);
            __builtin_amdgcn_fence(__ATOMIC_ACQUIRE, "agent");
            xb_add(&bar[XB_XGEN(b.x)], 1u);
            asm volatile("s_waitcnt vmcnt(0)" ::: "memory");
        } else {
            XB_SPIN(xb_ld(&bar[XB_XGEN(b.x)]) == gen, bar);
            __builtin_amdgcn_fence(__ATOMIC_ACQUIRE, "agent");
            asm volatile("s_waitcnt vmcnt(0)" ::: "memory");
        }
    }
    __syncthreads();
}

namespace pg8 {
#define PG8_LAS __attribute__((address_space(3)))
typedef unsigned short bf16_t;
typedef short bf16x8 __attribute__((ext_vector_type(8)));
typedef float f32x4 __attribute__((ext_vector_type(4)));
typedef unsigned u32x4 __attribute__((ext_vector_type(4)));
typedef unsigned u32x2 __attribute__((ext_vector_type(2)));
constexpr int BM = 256, BK = 64, HALF = 128, HTB = HALF * BK * 2, STAGE_BYTES = 8 * HTB, NXCD = 8, WGM = 8;

__host__ __device__ __forceinline__ int lds_byte(int r, int c) { const int st = (r >> 4) * 2 + (c >> 5), rr = r & 15, cc = c & 31, ob = rr * 64 + cc * 2; return st * 1024 + (ob ^ (((ob >> 9) & 1) << 5)); }
__host__ __device__ __forceinline__ void stage_rc(int b, int& R, int& C) { const int st = b / 1024, sb = b % 1024, swz = sb ^ (((sb >> 9) & 1) << 5); R = (st >> 1) * 16 + swz / 64; C = (st & 1) * 32 + (swz % 64) / 2; }
__host__ __device__ __forceinline__ int perm32(int rho) { const int n = rho >> 4, i = rho & 15; return 8 * (i >> 2) + 4 * n + (i & 3); }

struct Unit { int pm, pn, e; };

struct StaticOrder {
    static constexpr bool GATHER = false;
    const char* A; const char* Bt; int K; int nM, nN, nwg, G, c;
    __device__ void init(const void* A_, const void* Bt_, int M, int N, int K_, int G_, int c_) { A = (const char*)A_; Bt = (const char*)Bt_; K = K_; nM = M / BM; nN = N / BM; nwg = nM * nN; G = G_; c = c_; }
    __device__ bool next(int i, Unit& u) const {
        const long L = (long)i * G + c; if (L >= nwg) return false;
        int wgid = (int)L; { const int q = nwg / NXCD, r = nwg % NXCD, xcd = wgid % NXCD, off = wgid / NXCD; wgid = (xcd < r ? xcd * (q + 1) : r * (q + 1) + (xcd - r) * q) + off; }
        const int nig = WGM * nN, gid = wgid / nig, fm = gid * WGM, gsz = (nM - fm) < WGM ? (nM - fm) : WGM;
        u.pm = fm + ((wgid % nig) % gsz); u.pn = (wgid % nig) / gsz; u.e = 0; return true;
    }
    __device__ __forceinline__ const char* a_base(const Unit& u) const { return A + (size_t)u.pm * (size_t)(BM * 2) * K; }
    __device__ __forceinline__ const char* b_base(const Unit& u) const { return Bt + (size_t)u.pn * (size_t)(BM * 2) * K; }
    __device__ __forceinline__ void a_voff(int, int, int, int, unsigned (&)[2]) const {}
};

__device__ __forceinline__ unsigned cvt_pk_bf16(float lo, float hi) { unsigned r; asm volatile("v_cvt_pk_bf16_f32 %0, %1, %2" : "=v"(r) : "v"(lo), "v"(hi)); return r; }

template <int K, class Epi, class Sched, bool ALIGN_EPI>
__device__ __forceinline__ void gemm_phase(PG8_LAS unsigned char* lds, const Sched& S, const Epi& E) {
    int tid_ = threadIdx.x; asm volatile("" : "+v"(tid_));
    const int tid = tid_, wid = __builtin_amdgcn_readfirstlane(tid >> 6), lane = tid & 63, wr = wid >> 2, wc = wid & 3, fr = lane & 15, fq = lane >> 4;
    constexpr int nt = K / BK;
    constexpr int NH = Sched::GATHER ? 2 : 1;
    unsigned voffB[2], cvA[NH][2], nvA[NH][2];
#pragma unroll
    for (int i = 0; i < 2; ++i) { int R, C; stage_rc(tid * 16 + i * 8192, R, C); const int Rb = Epi::PERM ? ((R & ~31) + perm32(R & 31)) : R;
        voffB[i] = (unsigned)(Rb * K + C) * 2u;
        cvA[0][i] = nvA[0][i] = (unsigned)(R * K + C) * 2u; if constexpr (NH == 2) { cvA[NH - 1][i] = nvA[NH - 1][i] = cvA[0][i]; } }
    constexpr size_t kstep = (size_t)(BK * 2);
    constexpr size_t hstep = (size_t)HALF * K * 2;
    constexpr size_t hstepA = Sched::GATHER ? (size_t)0 : hstep;
    const unsigned ldsw = (unsigned)wid * 1024u;
    const int aoff = lds_byte(wr * 64 + fr, fq * 8), boff = lds_byte(wc * 32 + fr, fq * 8);
#define PG8_SA(b, h) (((b) * 2 + (h)) * HTB)
#define PG8_SB(b, h) ((4 + (b) * 2 + (h)) * HTB)
#define PG8_STAGE(bufoff, gbase, voff) do { _Pragma("unroll") for (int _i = 0; _i < 2; ++_i) \
        __builtin_amdgcn_global_load_lds((const unsigned*)((const char*)(gbase) + (voff)[_i]), (PG8_LAS unsigned*)(lds + (bufoff) + ldsw + _i * 8192), 16, 0, 0); } while (0)
#define PG8_LDA(dst, b, h) do { _Pragma("unroll") for (int m = 0; m < 4; ++m) _Pragma("unroll") for (int k = 0; k < 2; ++k) dst[m][k] = *(const PG8_LAS bf16x8*)(lds + PG8_SA(b, h) + aoff + m * 2048 + k * 1024); } while (0)
#define PG8_LDB(dst, b, h) do { _Pragma("unroll") for (int n = 0; n < 2; ++n) _Pragma("unroll") for (int k = 0; k < 2; ++k) dst[n][k] = *(const PG8_LAS bf16x8*)(lds + PG8_SB(b, h) + boff + n * 2048 + k * 1024); } while (0)
#define PG8_MMA(ai, bj, At, Bt) do { __builtin_amdgcn_s_setprio(1); _Pragma("unroll") for (int m = 0; m < 4; ++m) _Pragma("unroll") for (int n = 0; n < 2; ++n) _Pragma("unroll") for (int k = 0; k < 2; ++k) \
        acc[ai][bj][m][n] = __builtin_amdgcn_mfma_f32_16x16x32_bf16(Bt[n][k], At[m][k], acc[ai][bj][m][n], 0, 0, 0); __builtin_amdgcn_s_setprio(0); } while (0)
#define PG8_WAIT_V(n) asm volatile("s_waitcnt vmcnt(" #n ")" ::: "memory")
#define PG8_WAIT_L(n) asm volatile("s_waitcnt lgkmcnt(" #n ")" ::: "memory")
#define PG8_BAR __builtin_amdgcn_s_barrier()
#define PG8_SCHED __builtin_amdgcn_sched_barrier(0)
    Unit cur, nxt; int ui = 0;
    if (!S.next(0, cur)) return;
    f32x4 acc[2][2][4][2];
#pragma unroll
    for (int a = 0; a < 2; ++a)
#pragma unroll
        for (int b = 0; b < 2; ++b)
#pragma unroll
            for (int m = 0; m < 4; ++m)
#pragma unroll
                for (int n = 0; n < 2; ++n) acc[a][b][m][n] = (f32x4){0.f, 0.f, 0.f, 0.f};
    bf16x8 At[4][2], B0[2][2], B1[2][2];
    const char* cA = S.a_base(cur); const char* cB = S.b_base(cur);
    if constexpr (Sched::GATHER) {
        int R0, C0, R1, C1; stage_rc(tid * 16, R0, C0); stage_rc(tid * 16 + 8192, R1, C1);
#pragma unroll
        for (int h = 0; h < 2; ++h) { unsigned v[2]; S.a_voff(0, h, R0, R1, v); cvA[h][0] = v[0] + (unsigned)C0 * 2u; cvA[h][1] = v[1] + (unsigned)C1 * 2u; }
    }
    PG8_STAGE(PG8_SB(0, 0), cB, voffB); PG8_STAGE(PG8_SB(0, 1), cB + hstep, voffB); PG8_STAGE(PG8_SA(0, 0), cA, cvA[0]); PG8_STAGE(PG8_SA(0, 1), cA + hstepA, cvA[NH - 1]);
    if (wr == 1) PG8_BAR;
    PG8_WAIT_V(2); PG8_BAR;
    PG8_STAGE(PG8_SB(1, 0), cB + kstep, voffB); PG8_STAGE(PG8_SA(1, 0), cA + kstep, cvA[0]); PG8_STAGE(PG8_SB(1, 1), cB + hstep + kstep, voffB);
    PG8_WAIT_V(6); PG8_BAR;
    for (;;) {
        const bool has_next = S.next(ui + 1, nxt);
        const char* nA = has_next ? S.a_base(nxt) : cA; const char* nB = has_next ? S.b_base(nxt) : cB;
        if constexpr (Sched::GATHER) {
            if (has_next) {
                int t2 = threadIdx.x; asm volatile("" : "+v"(t2));
                int R0, C0, R1, C1; stage_rc(t2 * 16, R0, C0); stage_rc(t2 * 16 + 8192, R1, C1);
#pragma unroll
                for (int h = 0; h < 2; ++h) { unsigned v[2]; S.a_voff(ui + 1, h, R0, R1, v); nvA[h][0] = v[0] + (unsigned)C0 * 2u; nvA[h][1] = v[1] + (unsigned)C1 * 2u; }
            } else {
#pragma unroll
                for (int h = 0; h < 2; ++h) { nvA[h][0] = cvA[h][0]; nvA[h][1] = cvA[h][1]; }
            }
        }
        for (int t = 0; t < nt; t += 2) {
            const bool last = (t == nt - 2);
            const char* a1 = cA + (size_t)(t + 1) * kstep;
            const char* a2 = last ? nA : cA + (size_t)(t + 2) * kstep; const char* b2 = last ? nB : cB + (size_t)(t + 2) * kstep;
            const char* a3 = a2 + kstep; const char* b3 = b2 + kstep;
            unsigned v2[NH][2];
#pragma unroll
            for (int h = 0; h < NH; ++h) { if constexpr (Sched::GATHER) { v2[h][0] = last ? nvA[h][0] : cvA[h][0]; v2[h][1] = last ? nvA[h][1] : cvA[h][1]; } else { v2[h][0] = cvA[h][0]; v2[h][1] = cvA[h][1]; } }
            PG8_LDB(B0, 0, 0); PG8_LDB(B1, 0, 1); PG8_SCHED; PG8_LDA(At, 0, 0); PG8_STAGE(PG8_SA(1, 1), a1 + hstepA, cvA[NH - 1]);
            PG8_WAIT_V(8); PG8_WAIT_L(0); PG8_BAR; PG8_MMA(0, 0, At, B0); PG8_MMA(0, 1, At, B1); PG8_BAR; PG8_SCHED;
            PG8_LDA(At, 0, 1); PG8_STAGE(PG8_SB(0, 0), b2, voffB); PG8_STAGE(PG8_SB(0, 1), b2 + hstep, voffB); PG8_STAGE(PG8_SA(0, 0), a2, v2[0]);
            PG8_WAIT_V(8); PG8_WAIT_L(0); PG8_BAR; PG8_MMA(1, 0, At, B0); PG8_MMA(1, 1, At, B1); PG8_BAR; PG8_SCHED;
            PG8_LDB(B0, 1, 0); PG8_LDB(B1, 1, 1); PG8_SCHED; PG8_LDA(At, 1, 0); PG8_STAGE(PG8_SA(0, 1), a2 + hstepA, v2[NH - 1]);
            PG8_WAIT_V(8); PG8_WAIT_L(0); PG8_BAR; PG8_MMA(0, 0, At, B0); PG8_MMA(0, 1, At, B1); PG8_BAR; PG8_SCHED;
            PG8_LDA(At, 1, 1); PG8_STAGE(PG8_SB(1, 0), b3, voffB); PG8_STAGE(PG8_SB(1, 1), b3 + hstep, voffB); PG8_STAGE(PG8_SA(1, 0), a3, v2[0]);
            PG8_WAIT_V(8); PG8_WAIT_L(0); PG8_BAR; PG8_MMA(1, 0, At, B0); PG8_MMA(1, 1, At, B1); PG8_BAR; PG8_SCHED;
        }
        if constexpr (ALIGN_EPI) { if (wr == 0) PG8_BAR; }
        E(acc, cur, ui, wr, wc, fr, fq);
        if (!has_next) break;
#pragma unroll
        for (int a = 0; a < 2; ++a)
#pragma unroll
            for (int b = 0; b < 2; ++b)
#pragma unroll
                for (int m = 0; m < 4; ++m)
#pragma unroll
                    for (int n = 0; n < 2; ++n) acc[a][b][m][n] = (f32x4){0.f, 0.f, 0.f, 0.f};
        cur = nxt; cA = nA; cB = nB; ++ui;
        if constexpr (Sched::GATHER) {
#pragma unroll
            for (int h = 0; h < NH; ++h) { cvA[h][0] = nvA[h][0]; cvA[h][1] = nvA[h][1]; }
        }
        if constexpr (ALIGN_EPI) { if (wr == 1) PG8_BAR; }
    }
    PG8_WAIT_V(0);
    if constexpr (!ALIGN_EPI) { if (wr == 0) PG8_BAR; }
    PG8_BAR;
#undef PG8_SA
#undef PG8_SB
#undef PG8_STAGE
#undef PG8_LDA
#undef PG8_LDB
#undef PG8_MMA
#undef PG8_WAIT_V
#undef PG8_WAIT_L
#undef PG8_BAR
#undef PG8_SCHED
}
}
#define GAS __attribute__((address_space(1)))
typedef float f32x4 __attribute__((ext_vector_type(4)));
typedef float f32x16 __attribute__((ext_vector_type(16)));
typedef short bf16x8 __attribute__((ext_vector_type(8)));
typedef unsigned v4u __attribute__((ext_vector_type(4)));
typedef unsigned v2u __attribute__((ext_vector_type(2)));
#define LDS_WAIT() asm volatile("s_waitcnt lgkmcnt(0)" ::: "memory")
#define VM_WAIT() asm volatile("s_waitcnt vmcnt(0)" ::: "memory")
__device__ __forceinline__ unsigned pk2(float lo, float hi) { return f2bf(lo) | (f2bf(hi) << 16); }

constexpr int NWAVES = 8, NTHR = 512;
constexpr int LDS_STAGE = 0;
constexpr int LDS_RS = 131072;
constexpr int LDS_ROWTOK = LDS_RS + 8192;
constexpr int LDS_GATE = LDS_ROWTOK + 8192;
constexpr int LDS_MISC = LDS_GATE + 8192;
constexpr int LDS_BYTES = LDS_MISC + 256;
constexpr size_t WO_IN = 0, WO_SM = 6 * MiB, WO_RHI = 6 * MiB + 65536, WO_RLO = 6 * MiB + 131072, WO_OUT = 7 * MiB, WO_XQ = 9 * MiB, WO_XO = 10 * MiB, WO_GU = 11 * MiB, WO_D = 43 * MiB;
static_assert(WO_D + 16 * MiB <= WS_WLAYER, "weight block");
constexpr int CW_BAR = 4096;
constexpr int MAX_LAUNCH = 40;
static_assert((CW_BAR + MAX_LAUNCH * XCD_BAR_WORDS) * 4 <= (int)(1 * MiB), "ctl");

enum { PH_PRO = 0, PH_XKV = 1, PH_L0 = 2, NPH = 13, PH_FINAL = PH_L0 + NLAYER * NPH, PH_END = PH_FINAL + 1 };
enum { LP_INPROJ = 0, LP_MIXA, LP_MIXB, LP_MIXC, LP_WOUT, LP_XQ, LP_XATTN, LP_XO, LP_ROUTE, LP_SORT, LP_GU, LP_DOWN0, LP_DOWN1 };

struct Args { P p; int ph_lo, ph_hi, li, pad; };

template <bool HAS_RS> struct EpiBf16 {
    static constexpr bool PERM = true;
    bf16* O; int ldc; const LAS float* rstab;
    __device__ __forceinline__ void operator()(const pg8::f32x4 (&acc)[2][2][4][2], const pg8::Unit& u, int iu, int wr, int wc, int fr, int fq) const {
#pragma unroll
        for (int ai = 0; ai < 2; ++ai)
#pragma unroll
            for (int m = 0; m < 4; ++m) {
                const int lrow = ai * 128 + wr * 64 + m * 16 + fr;
                float sc = 1.f; if (HAS_RS) sc = rstab[iu * 256 + lrow];
                bf16* rowp = O + (size_t)(u.pm * 256 + lrow) * ldc + u.pn * 256 + wc * 32 + 8 * fq;
#pragma unroll
                for (int bj = 0; bj < 2; ++bj) { const pg8::f32x4 v0 = acc[ai][bj][m][0] * sc, v1 = acc[ai][bj][m][1] * sc;
                    pg8::u32x4 w; w.x = pg8::cvt_pk_bf16(v0[0], v0[1]); w.y = pg8::cvt_pk_bf16(v0[2], v0[3]); w.z = pg8::cvt_pk_bf16(v1[0], v1[1]); w.w = pg8::cvt_pk_bf16(v1[2], v1[3]);
                    st_b128(rowp + bj * 128, w); }
            }
    }
};
struct EpiGU {
    static constexpr bool PERM = true;
    bf16* U; const LAS float* rstab;
    __device__ __forceinline__ void operator()(const pg8::f32x4 (&acc)[2][2][4][2], const pg8::Unit& u, int iu, int wr, int wc, int fr, int fq) const {
#pragma unroll
        for (int ai = 0; ai < 2; ++ai)
#pragma unroll
            for (int m = 0; m < 4; ++m) {
                const int lrow = ai * 128 + wr * 64 + m * 16 + fr;
                const float sc = rstab[iu * 256 + lrow];
                float o[8];
#pragma unroll
                for (int n = 0; n < 2; ++n)
#pragma unroll
                    for (int j = 0; j < 4; ++j) { const float g = acc[ai][0][m][n][j] * sc, uu = acc[ai][1][m][n][j] * sc; o[n * 4 + j] = g * uu * __builtin_amdgcn_rcpf(1.f + __expf(-g)); }
                pg8::u32x4 w; w.x = pg8::cvt_pk_bf16(o[0], o[1]); w.y = pg8::cvt_pk_bf16(o[2], o[3]); w.z = pg8::cvt_pk_bf16(o[4], o[5]); w.w = pg8::cvt_pk_bf16(o[6], o[7]);
                st_b128(U + (size_t)(u.pm * 256 + lrow) * 512 + u.pn * 128 + wc * 32 + 8 * fq, w);
            }
    }
};
template <int MODE> struct EpiRes {
    static constexpr bool PERM = false;
    static constexpr bool MOE = MODE != 0;
    const float* base; float* out; bf16* hb; float* ssq; const LAS int* rowtab; const LAS float* gatetab; float gs; bf16* t0;
    __device__ __forceinline__ void operator()(const pg8::f32x4 (&acc)[2][2][4][2], const pg8::Unit& u, int iu, int wr, int wc, int fr, int fq) const {
#pragma unroll
        for (int ai = 0; ai < 2; ++ai)
#pragma unroll
            for (int m = 0; m < 4; ++m) {
                const int lrow = ai * 128 + wr * 64 + m * 16 + fr;
                int row = u.pm * 256 + lrow; float g = gs;
                if (MOE) { row = rowtab[iu * 256 + lrow]; g = gatetab[iu * 256 + lrow] * gs; }
                const bool ok = !MOE || row >= 0;
                const size_t off = (size_t)(ok ? row : 0) * DM + u.pn * 256 + wc * 32 + 4 * fq;
                float q = 0.f;
                if (ok) {
#pragma unroll
                    for (int bj = 0; bj < 2; ++bj)
#pragma unroll
                        for (int n = 0; n < 2; ++n) {
                            if (MODE == 1) { const pg8::f32x4 o = acc[ai][bj][m][n] * g; pg8::u32x2 w; w.x = pg8::cvt_pk_bf16(o[0], o[1]); w.y = pg8::cvt_pk_bf16(o[2], o[3]); st_b64(t0 + off + bj * 128 + n * 16, w); }
                            else {
                                pg8::f32x4 bs = *(const pg8::f32x4*)(base + off + bj * 128 + n * 16);
                                if (MODE == 2) { const pg8::u32x2 tw = *(const pg8::u32x2*)(t0 + off + bj * 128 + n * 16);
                                    bs[0] += __builtin_bit_cast(float, tw.x << 16); bs[1] += __builtin_bit_cast(float, tw.x & 0xffff0000u); bs[2] += __builtin_bit_cast(float, tw.y << 16); bs[3] += __builtin_bit_cast(float, tw.y & 0xffff0000u); }
                                const pg8::f32x4 o = bs + acc[ai][bj][m][n] * g;
                                st_b128(out + off + bj * 128 + n * 16, __builtin_bit_cast(st_v4u, o));
                                q += (o[0] * o[0] + o[1] * o[1]) + (o[2] * o[2] + o[3] * o[3]); pg8::u32x2 w; w.x = pg8::cvt_pk_bf16(o[0], o[1]); w.y = pg8::cvt_pk_bf16(o[2], o[3]); st_b64(hb + off + bj * 128 + n * 16, w); } }
                }
                if (MODE != 1) { q += __shfl_xor(q, 16); q += __shfl_xor(q, 32); if (fq == 0 && ok) ssq[(size_t)row * 16 + u.pn * 4 + wc] = q; }
            }
    }
};
template <bool GATH> struct MoeOrder {
    static constexpr bool GATHER = GATH;
    const char* A; const char* Bt; int K; size_t estride; int lo, hi, G, c; const int* tilee; const LAS int* rowtab;
    __device__ bool next(int i, pg8::Unit& u) const { const int L = i * G + c, t = lo + (L >> 2); if (t >= hi) return false; u.pm = t; u.pn = L & 3; u.e = tilee[t]; return true; }
    __device__ __forceinline__ const char* a_base(const pg8::Unit& u) const { return GATH ? A : A + (size_t)u.pm * (size_t)512 * K; }
    __device__ __forceinline__ const char* b_base(const pg8::Unit& u) const { return Bt + (size_t)u.e * estride + (size_t)u.pn * (size_t)512 * K; }
    __device__ __forceinline__ void a_voff(int iu, int h, int R0, int R1, unsigned (&v)[2]) const { v[0] = (unsigned)rowtab[iu * 256 + h * 128 + R0] * (unsigned)(K * 2); v[1] = (unsigned)rowtab[iu * 256 + h * 128 + R1] * (unsigned)(K * 2); }
};

__device__ __forceinline__ void router_weights(const P& p, int gtid, int gstride);
__device__ __forceinline__ void tr_item(const float* W, int N, int K, int k0, int n0, const float* gain, float scale, bf16* dst, LAS float* scr, int lane) {
    const int kr = lane >> 3, c4 = lane & 7;
    f32x4 v[8];
#pragma unroll
    for (int i = 0; i < 8; ++i) v[i] = *(const f32x4*)(W + (size_t)(k0 + 8 * i + kr) * N + n0 + 4 * c4);
#pragma unroll
    for (int i = 0; i < 8; ++i) { const int kk = 8 * i + kr; float g = scale; if (gain) g *= gain[k0 + kk];
        LAS float* d = scr + kk * 33 + 4 * c4; d[0] = v[i].x * g; d[1] = v[i].y * g; d[2] = v[i].z * g; d[3] = v[i].w * g; }
    LDS_WAIT();
    const int c = lane & 7;
#pragma unroll
    for (int j = 0; j < 4; ++j) { const int n = (lane >> 3) + 8 * j; const LAS float* s = scr + (8 * c) * 33 + n;
        v4u o; o.x = pk2(s[0 * 33], s[1 * 33]); o.y = pk2(s[2 * 33], s[3 * 33]); o.z = pk2(s[4 * 33], s[5 * 33]); o.w = pk2(s[6 * 33], s[7 * 33]);
        st_b128(dst + (size_t)n * K + k0 + 8 * c, o); }
    LDS_WAIT();
}
constexpr int IT_LAYER = 15360;
__device__ __forceinline__ void prologue_item(const P& p, int it, LAS float* scr, int lane) {
    const int l = it / IT_LAYER; int r = it % IT_LAYER;
    unsigned char* wl = ws_base(p.ws) + WS_W + (size_t)l * WS_WLAYER;
    if (r < 1536) {
        const int seg = r / 768; r %= 768; const int kb = r / 48, nb = r % 48; const int n0 = (seg ? 1544 : 0) + 32 * nb, drow = seg * 1536 + 32 * nb;
        const float sc = drow < 512 ? 0.125f * LOG2E : ((drow >= C_GQ && drow < C_GK) ? 0.125f : 1.f);
        tr_item(p.w_in + (size_t)l * DM * INW, INW, DM, 64 * kb, n0, p.mix_norm + l * DM, sc, (bf16*)(wl + WO_IN) + (size_t)drow * DM, scr, lane); return; }
    r -= 1536;
    if (r < 512) { const int kb = r / 32, nb = r % 32; tr_item(p.w_out + (size_t)l * DM * DM, DM, DM, 64 * kb, 32 * nb, nullptr, 1.f, (bf16*)(wl + WO_OUT) + (size_t)(32 * nb) * DM, scr, lane); return; }
    r -= 512;
    if (r < 256) { const int kb = r / 16, nb = r % 16; tr_item(p.w_xq + (size_t)l * DM * 512, 512, DM, 64 * kb, 32 * nb, p.cross_norm + l * DM, 0.08838834764831845f * LOG2E, (bf16*)(wl + WO_XQ) + (size_t)(32 * nb) * DM, scr, lane); return; }
    r -= 256;
    if (r < 256) { const int kb = r / 32, nb = r % 32; tr_item(p.w_xo + (size_t)l * 512 * DM, DM, 512, 64 * kb, 32 * nb, nullptr, 1.f, (bf16*)(wl + WO_XO) + (size_t)(32 * nb) * 512, scr, lane); return; }
    r -= 256;
    if (r < 512) { const int kv = r / 256; r %= 256; const int kb = r / 16, nb = r % 16;
        tr_item((kv ? p.w_xv : p.w_xk) + (size_t)l * DM * 512, 512, DM, 64 * kb, 32 * nb, nullptr, 1.f, (bf16*)(ws_base(p.ws) + WS_WXKV) + (size_t)(l * 1024 + kv * 512 + 32 * nb) * DM, scr, lane); return; }
    r -= 512;
    if (r < 8192) { const int up = r / 4096; r %= 4096; const int e = r / 256; r %= 256; const int kb = r / 16, nb = r % 16; const int c0 = 32 * nb, drow = (c0 >> 7) * 256 + up * 128 + (c0 & 127);
        tr_item((up ? p.w_eu : p.w_eg) + ((size_t)l * 16 + e) * DM * 512, 512, DM, 64 * kb, c0, p.moe_norm + l * DM, 1.f, (bf16*)(wl + WO_GU) + ((size_t)e * 1024 + drow) * DM, scr, lane); return; }
    r -= 8192;
    { const int e = r / 256; r %= 256; const int kb = r / 32, nb = r % 32;
      tr_item(p.w_ed + ((size_t)l * 16 + e) * 512 * DM, DM, 512, 64 * kb, 32 * nb, nullptr, 1.f, (bf16*)(wl + WO_D) + ((size_t)e * 1024 + 32 * nb) * 512, scr, lane); }
}
__device__ __forceinline__ void row_to_bf16(const float* src, bf16* dst, float* ssq, const float* gain, int lane, int mode) {
    const f32x4* s = (const f32x4*)src + lane;
    f32x4 v[4]; float q = 0.f;
#pragma unroll
    for (int j = 0; j < 4; ++j) { v[j] = s[64 * j]; q += (v[j].x * v[j].x + v[j].y * v[j].y) + (v[j].z * v[j].z + v[j].w * v[j].w); }
    q = wave_sum(q);
    float sc = 1.f;
    if (mode == 1) sc = rsqrtf(q * (1.0f / DM) + EPS);
    else if (lane < 16) ssq[lane] = lane == 0 ? q : 0.f;
    v2u* d = (v2u*)dst + lane;
#pragma unroll
    for (int j = 0; j < 4; ++j) {
        f32x4 g = (f32x4){1.f, 1.f, 1.f, 1.f}; if (mode == 1) g = ((const f32x4*)gain)[lane + 64 * j];
        v2u o; o.x = pk2(v[j].x * sc * g.x, v[j].y * sc * g.y); o.y = pk2(v[j].z * sc * g.z, v[j].w * sc * g.w); st_b64(d + 64 * j, o); }
}
__device__ __forceinline__ void prologue(const P& p, LAS unsigned char* lds, int vcu, int G, int wave, int lane) {
    asm volatile("" : "+v"(lane));
    LAS float* scr = (LAS float*)(lds + LDS_STAGE + wave * 16384);
    const int gw = vcu * NWAVES + wave, NGW = G * NWAVES;
    for (int it = gw; it < NLAYER * IT_LAYER; it += NGW) prologue_item(p, it, scr, lane);
    for (int idx = gw * 64 + lane; idx < NLAYER * 2 * 32768; idx += NGW * 64) {
        const int l = idx / 65536, r = idx % 65536, which = r / 32768, e = r % 32768, row = e / 1024, k = e % 1024;
        unsigned char* wl = ws_base(p.ws) + WS_W + (size_t)l * WS_WLAYER;
        if (which == 0) {
            float v = 0.f;
            if (row < 8) v = p.w_in[((size_t)l * DM + k) * INW + 1536 + row]; else if (row < 24) v = p.w_in[((size_t)l * DM + k) * INW + 3080 + (row - 8)];
            ((bf16*)(wl + WO_SM))[row * 1024 + k] = (bf16)f2bf(v * p.mix_norm[l * DM + k]);
        }
    }
    router_weights(p, gw * 64 + lane, NGW * 64);
    for (int m = gw; m < 4096; m += NGW) row_to_bf16(p.mem + (size_t)m * DM, WSP(bf16, WS_MEMN) + (size_t)m * DM, nullptr, p.mem_norm, lane, 1);
    for (int m = gw; m < NTOK; m += NGW) row_to_bf16(p.x + (size_t)m * DM, WSP(bf16, WS_HB) + (size_t)m * DM, WSP(float, WS_SSQ) + (size_t)m * 16, nullptr, lane, 0);
}
__device__ __forceinline__ void small_proj(const P& p, int l, int vcu, int G, int wave, int lane) {
    asm volatile("" : "+v"(lane));
    const int gw = vcu * NWAVES + wave, NGW = G * NWAVES;
    const bf16* wsm = (const bf16*)(ws_base(p.ws) + WS_W + (size_t)l * WS_WLAYER + WO_SM);
    const bf16* hb = WSP(bf16, WS_HB); const float* ssq = WSP(float, WS_SSQ); float* sm = WSP(float, WS_SM);
    const int r = lane & 31, hh = lane >> 5;
    for (int blk = gw; blk < NTOK / 32; blk += NGW) {
        const int tok0 = blk * 32;
        const bf16x8* ap = (const bf16x8*)(hb + (size_t)(tok0 + r) * DM + hh * 32);
        const bf16x8* bp = (const bf16x8*)(wsm + (size_t)r * DM + hh * 32);
        f32x16 acc = {};
#pragma unroll 2
        for (int s = 0; s < 16; ++s) {
#pragma unroll
            for (int j = 0; j < 4; ++j) acc = __builtin_amdgcn_mfma_f32_32x32x16_bf16(ap[s * 8 + j], bp[s * 8 + j], acc, 0, 0, 0);
        }
        const float rsv = row_rs(ssq, tok0 + r);
#pragma unroll
        for (int g = 0; g < 16; ++g) { const int trow = (g & 3) + 8 * (g >> 2) + 4 * hh; const float rs = __shfl(rsv, trow); if (r < 24) sm[(size_t)(tok0 + trow) * 32 + r] = acc[g] * rs; }
    }
}
typedef short v4i16_t __attribute__((ext_vector_type(4)));
typedef __bf16 bf16x2_t __attribute__((ext_vector_type(2)));
typedef float f32x2_t __attribute__((ext_vector_type(2)));
__device__ __forceinline__ unsigned cvtpk(float lo, float hi) { f32x2_t v = {lo, hi}; bf16x2_t b = __builtin_convertvector(v, bf16x2_t); return __builtin_bit_cast(unsigned, b); }
__device__ __forceinline__ bf16x8 pack8(const f32x16& p, int o) {
    v4u w; w.x = cvtpk(p[o], p[o + 1]); w.y = cvtpk(p[o + 2], p[o + 3]); w.z = cvtpk(p[o + 4], p[o + 5]); w.w = cvtpk(p[o + 6], p[o + 7]);
    return __builtin_bit_cast(bf16x8, w);
}
template <int D, bool FOX>
__device__ __forceinline__ void attn_unit(LAS unsigned char* lds, const bf16* Qg, int qpitch, const bf16* Kg, const bf16* Vg, int kvpitch, int NT,
                                          const float* cb, int q0, bf16* Og, int opitch, const float* gain) {
    constexpr int KS = D * 2 + 16, VS = D * 2 + 64;
    constexpr int KBYTES = 64 * KS, VBYTES = 64 * VS;
    constexpr int CPR = D / 8, NCH = 64 * CPR / NTHR, NS = D / 16, NDB = D / 32;
    constexpr int OFF_K = 0, OFF_V = 2 * KBYTES, OFF_CB = 2 * KBYTES + 2 * VBYTES;
    int tid = threadIdx.x; asm volatile("" : "+v"(tid));
    const int lane = tid & 63, wave = __builtin_amdgcn_readfirstlane(tid >> 6), r32 = lane & 31, hh = lane >> 5;
    bf16x8 qf[NS];
    { const bf16* qrow = Qg + (size_t)(wave * 32 + r32) * qpitch;
#pragma unroll
      for (int s = 0; s < NS; ++s) qf[s] = *(const bf16x8*)(qrow + 16 * s + 8 * hh); }
    v4u kreg[NCH], vreg[NCH]; f32x4 cbreg = {0.f, 0.f, 0.f, 0.f};
#define AT_GLOAD(t) do { _Pragma("unroll") for (int i_ = 0; i_ < NCH; ++i_) { const int idx_ = tid + NTHR * i_, key_ = idx_ / CPR, c_ = idx_ % CPR; \
        kreg[i_] = *(const v4u*)(Kg + (size_t)((t) * 64 + key_) * kvpitch + c_ * 8); vreg[i_] = *(const v4u*)(Vg + (size_t)((t) * 64 + key_) * kvpitch + c_ * 8); } \
        if (FOX && tid < 16) cbreg = *(const f32x4*)(cb + (t) * 64 + tid * 4); } while (0)
#define AT_LSTORE(b) do { _Pragma("unroll") for (int i_ = 0; i_ < NCH; ++i_) { const int idx_ = tid + NTHR * i_, key_ = idx_ / CPR, c_ = idx_ % CPR; \
        *(LAS v4u*)(lds + OFF_K + (b) * KBYTES + key_ * KS + c_ * 16) = kreg[i_]; *(LAS v4u*)(lds + OFF_V + (b) * VBYTES + key_ * VS + c_ * 16) = vreg[i_]; } \
        if (FOX && tid < 16) *(LAS f32x4*)(lds + OFF_CB + (b) * 256 + tid * 16) = cbreg; } while (0)
    float m = -INFINITY, l = 0.f;
    f32x16 o[NDB];
#pragma unroll
    for (int d = 0; d < NDB; ++d) o[d] = f32x16{};
    const int qlo = q0 + wave * 32, qabs = qlo + r32;
    AT_GLOAD(0); AT_LSTORE(0);
    __syncthreads();
#pragma unroll 1
    for (int t = 0; t < NT; ++t) {
        const int b = t & 1;
        if (t + 1 < NT) AT_GLOAD(t + 1);
        const int kt0 = t * 64;
        if (!FOX || kt0 <= qlo + 31) {
            f32x16 p[2];
#pragma unroll
            for (int kb = 0; kb < 2; ++kb) {
                if (FOX) {
#pragma unroll
                    for (int g = 0; g < 4; ++g) { const f32x4 c4 = *(const LAS f32x4*)(lds + OFF_CB + b * 256 + (kb * 32 + 8 * g + 4 * hh) * 4); p[kb][4 * g] = c4.x; p[kb][4 * g + 1] = c4.y; p[kb][4 * g + 2] = c4.z; p[kb][4 * g + 3] = c4.w; }
                } else p[kb] = f32x16{};
                const LAS unsigned char* kp = lds + OFF_K + b * KBYTES + (kb * 32 + r32) * KS + hh * 16;
#pragma unroll
                for (int s = 0; s < NS; ++s) { const bf16x8 kf = *(const LAS bf16x8*)(kp + s * 32); p[kb] = __builtin_amdgcn_mfma_f32_32x32x16_bf16(kf, qf[s], p[kb], 0, 0, 0); }
            }
            if (FOX && kt0 + 63 > qlo) {
#pragma unroll
                for (int kb = 0; kb < 2; ++kb)
#pragma unroll
                    for (int r = 0; r < 16; ++r) { const int key = kt0 + kb * 32 + (r & 3) + 8 * (r >> 2) + 4 * hh; if (key > qabs) p[kb][r] = -INFINITY; }
            }
            float mt = fmaxf(p[0][0], p[1][0]);
#pragma unroll
            for (int r = 1; r < 16; ++r) mt = fmaxf(mt, fmaxf(p[0][r], p[1][r]));
            mt = fmaxf(mt, __shfl_xor(mt, 32));
            const float mnew = fmaxf(m, mt);
            const float alpha = __builtin_amdgcn_exp2f(m - mnew);
            float ls = 0.f;
#pragma unroll
            for (int kb = 0; kb < 2; ++kb)
#pragma unroll
                for (int r = 0; r < 16; ++r) { const float e = __builtin_amdgcn_exp2f(p[kb][r] - mnew); p[kb][r] = e; ls += e; }
            m = mnew; l = l * alpha + ls;
#pragma unroll
            for (int d = 0; d < NDB; ++d)
#pragma unroll
                for (int r = 0; r < 16; ++r) o[d][r] *= alpha;
            bf16x8 pa[2][2];
#pragma unroll
            for (int kb = 0; kb < 2; ++kb) { pa[kb][0] = pack8(p[kb], 0); pa[kb][1] = pack8(p[kb], 8); }
            const LAS unsigned char* vp = lds + OFF_V + b * VBYTES + (4 * hh + ((lane & 15) >> 2)) * VS + (16 * ((lane >> 4) & 1) + 4 * (lane & 3)) * 2;
#pragma unroll
            for (int d = 0; d < NDB; ++d) {
#pragma unroll
                for (int kb = 0; kb < 2; ++kb)
#pragma unroll
                    for (int ks = 0; ks < 2; ++ks) {
                        const LAS unsigned char* a0 = vp + (kb * 32 + 16 * ks) * VS + d * 64;
                        const v4i16_t lo = __builtin_amdgcn_ds_read_tr16_b64_v4i16((LAS v4i16_t*)a0);
                        const v4i16_t hi = __builtin_amdgcn_ds_read_tr16_b64_v4i16((LAS v4i16_t*)(a0 + 8 * VS));
                        const bf16x8 vf = (bf16x8){lo[0], lo[1], lo[2], lo[3], hi[0], hi[1], hi[2], hi[3]};
                        o[d] = __builtin_amdgcn_mfma_f32_32x32x16_bf16(vf, pa[kb][ks], o[d], 0, 0, 0);
                    }
            }
        }
        if (t + 1 < NT) AT_LSTORE(b ^ 1);
        __syncthreads();
    }
#undef AT_GLOAD
#undef AT_LSTORE
    l += __shfl_xor(l, 32);
    const float inv = 1.0f / l;
    float rs = inv;
    if (FOX) {
        float ss = 0.f;
#pragma unroll
        for (int d = 0; d < NDB; ++d)
#pragma unroll
            for (int r = 0; r < 16; ++r) { const float v = o[d][r] * inv; ss += v * v; }
        ss += __shfl_xor(ss, 32);
        rs = inv * rsqrtf(ss * (1.0f / D) + EPS);
    }
    bf16* orow = Og + (size_t)(wave * 32 + r32) * opitch;
#pragma unroll
    for (int d = 0; d < NDB; ++d)
#pragma unroll
        for (int g = 0; g < 4; ++g) {
            f32x4 gn = {1.f, 1.f, 1.f, 1.f}; if (FOX) gn = *(const f32x4*)(gain + 32 * d + 8 * g + 4 * hh);
            v2u w; w.x = cvtpk(o[d][4 * g] * rs * gn.x, o[d][4 * g + 1] * rs * gn.y); w.y = cvtpk(o[d][4 * g + 2] * rs * gn.z, o[d][4 * g + 3] * rs * gn.w);
            st_b64(orow + 32 * d + 8 * g + 4 * hh, w);
        }
}
__device__ __forceinline__ void fox_phase(const P& p, int l, LAS unsigned char* lds, int vcu, int G) {
    const bf16* proj = WSP(bf16, WS_PROJ); const float* cb = WSP(float, WS_CB); bf16* y = WSP(bf16, WS_Y);
    for (int pu = vcu; pu < 512; pu += G) {
        const int bh = pu >> 2, pr = pu & 3, b = bh >> 3, h = bh & 7;
        for (int half = 0; half < 2; ++half) {
            const int qb = half ? pr : 7 - pr;
            const size_t row0 = (size_t)b * SEQ;
            attn_unit<64, true>(lds, proj + (row0 + qb * 256) * PW + C_FQ + h * 64, PW, proj + row0 * PW + C_FK + h * 64, proj + row0 * PW + C_FV + h * 64, PW, 4 * (qb + 1),
                                cb + ((size_t)b * 8 + h) * SEQ, qb * 256, y + (row0 + qb * 256) * DM + h * 64, DM, p.fox_gain + l * 512 + h * 64);
        }
    }
}
__device__ __forceinline__ void xattn_phase(const P& p, int l, LAS unsigned char* lds, int vcu, int G, bool dummy) {
    bf16* xq = WSP(bf16, WS_XQ); const bf16* xkv = WSP(bf16, WS_XKV);
    for (int u = vcu; u < 512; u += G) {
        const int b = u >> 5, h = (u >> 3) & 3, qb = u & 7;
        bf16* qp = xq + ((size_t)b * SEQ + qb * 256) * 512 + h * 128;
        const bf16* kp = xkv + (size_t)b * MEML * 2048 + l * 1024 + h * 128;
        attn_unit<128, false>(lds, qp, 512, kp, kp + 512, 2048, 4, nullptr, 0, dummy ? WSP(bf16, WS_Y) + (qp - xq) : qp, 512, nullptr);
    }
}
constexpr size_t WS_GLOC = WS_HB;
constexpr size_t WS_GB = WS_END;
constexpr size_t WS_GDEC = WS_GB + 32 * MiB;
constexpr size_t WS_END2 = WS_GDEC + 1 * MiB;
static_assert(WS_END2 <= 512 * MiB, "workspace map 2");
constexpr int GL_B = 0;
constexpr int GL_TOT = 16384;
constexpr int GL_Q1 = 18432, GL_Q2 = GL_Q1 + 64 * 144, GL_K2 = GL_Q2 + 64 * 144;
constexpr int GL_KD = GL_K2 + 64 * 144;
constexpr int GL_V = GL_KD + 64 * 192;
constexpr int GL_SSQ = GL_V + 64 * 320;
constexpr int GL_GA = GL_SSQ + 1024;
constexpr int GL_END = GL_GA + 4096;
static_assert(GL_END <= 131072, "gla lds");

__device__ __forceinline__ float fast_log_sigmoid(float z) { return fminf(z, 0.f) - __logf(1.f + __expf(-fabsf(z))); }
__device__ __forceinline__ void gla_decay(const P& p, int l, int h, size_t tok0, LAS unsigned char* lds, int lane, int wave) {
    const float* sm = WSP(float, WS_SM);
    float w[16];
#pragma unroll
    for (int r = 0; r < 16; ++r) w[r] = p.w_alpha_up[((size_t)l * 16 + r) * 256 + h * 64 + lane];
    const float bias = p.b_alpha[l * 256 + h * 64 + lane];
    LAS f32x4* gat = (LAS f32x4*)(lds + GL_GA + wave * 512);
    if (lane < 32) gat[lane] = *(const f32x4*)(sm + (tok0 + wave * 8 + (lane >> 2)) * 32 + 8 + 4 * (lane & 3));
    float bl[8]; float run = 0.f;
#pragma unroll
    for (int j = 0; j < 8; ++j) {
        float z = bias;
#pragma unroll
        for (int r4 = 0; r4 < 4; ++r4) { const f32x4 g4 = gat[j * 4 + r4]; z += g4.x * w[4 * r4] + g4.y * w[4 * r4 + 1] + g4.z * w[4 * r4 + 2] + g4.w * w[4 * r4 + 3]; }
        run += fast_log_sigmoid(z) * (1.0f / 16.0f); bl[j] = run;
    }
    LAS float* tot = (LAS float*)(lds + GL_TOT);
    tot[wave * 64 + lane] = run;
    __syncthreads();
    float pre = 0.f;
#pragma unroll
    for (int g = 0; g < 8; ++g) { const float t = tot[g * 64 + lane]; if (g < wave) pre += t; }
    LAS float* Bm = (LAS float*)(lds + GL_B);
#pragma unroll
    for (int j = 0; j < 8; ++j) Bm[(wave * 8 + j) * 64 + lane] = bl[j] + pre;
    __syncthreads();
}
__device__ __forceinline__ void gla_load_v(const bf16* proj, size_t tok0, int h, LAS unsigned char* lds, int tid) {
#pragma unroll
    for (int i = 0; i < 2; ++i) { const int idx = tid + NTHR * i, t = idx >> 4, c = idx & 15;
        *(LAS v4u*)(lds + GL_V + t * 320 + c * 16) = *(const v4u*)(proj + (tok0 + t) * PW + C_GV + h * 128 + c * 8); }
}
__device__ __forceinline__ bf16x8 tr_frag(const LAS unsigned char* a0, int rowstride4) {
    const v4i16_t lo = __builtin_amdgcn_ds_read_tr16_b64_v4i16((LAS v4i16_t*)a0);
    const v4i16_t hi = __builtin_amdgcn_ds_read_tr16_b64_v4i16((LAS v4i16_t*)(a0 + rowstride4));
    return (bf16x8){lo[0], lo[1], lo[2], lo[3], hi[0], hi[1], hi[2], hi[3]};
}
__device__ __forceinline__ void gla_phase_a(const P& p, int l, LAS unsigned char* lds, int vcu, int G) {
    int tid = threadIdx.x; asm volatile("" : "+v"(tid));
    const int lane = tid & 63, wave = __builtin_amdgcn_readfirstlane(tid >> 6), hh = lane >> 5;
    const bf16* proj = WSP(bf16, WS_PROJ); float* loc = WSP(float, WS_GLOC); float* dec = WSP(float, WS_GDEC); const float* sm = WSP(float, WS_SM); float* gb = WSP(float, WS_GB);
    LAS unsigned char* kd = lds + wave * 16384; LAS unsigned char* vh = kd + 8192;
    const int crow8 = lane >> 3, cch = lane & 7;
    const int trow = (lane & 15) >> 2, tcol = 16 * ((lane >> 4) & 1) + 4 * (lane & 3);
    for (int u = vcu * NWAVES + wave; u < 2048; u += G * NWAVES) {
        const int c = u & 31, h = (u >> 5) & 3, b = u >> 7;
        const size_t tok0 = (size_t)b * SEQ + c * 64;
        v4u kreg[8], v0reg[8], v1reg[8];
#pragma unroll
        for (int i = 0; i < 8; ++i) { const bf16* rp = proj + (tok0 + i * 8 + crow8) * PW;
            kreg[i] = *(const v4u*)(rp + C_GK + h * 64 + cch * 8); v0reg[i] = *(const v4u*)(rp + C_GV + h * 128 + cch * 8); v1reg[i] = *(const v4u*)(rp + C_GV + h * 128 + 64 + cch * 8); }
        float w[16];
#pragma unroll
        for (int r = 0; r < 16; ++r) w[r] = p.w_alpha_up[((size_t)l * 16 + r) * 256 + h * 64 + lane];
        const float bias = p.b_alpha[l * 256 + h * 64 + lane];
        { LAS f32x4* gw = (LAS f32x4*)vh;
#pragma unroll
          for (int i = 0; i < 4; ++i) gw[lane * 4 + i] = *(const f32x4*)(sm + (tok0 + lane) * 32 + 8 + 4 * i); }
        float bt[64]; float run = 0.f;
#pragma unroll
        for (int t = 0; t < 64; ++t) {
            float z = bias;
#pragma unroll
            for (int r4 = 0; r4 < 4; ++r4) { const f32x4 g4 = ((const LAS f32x4*)vh)[t * 4 + r4]; z += g4.x * w[4 * r4] + g4.y * w[4 * r4 + 1] + g4.z * w[4 * r4 + 2] + g4.w * w[4 * r4 + 3]; }
            run += fast_log_sigmoid(z) * (1.0f / 16.0f); bt[t] = run; gb[(tok0 + t) * 256 + h * 64 + lane] = run;
        }
#pragma unroll
        for (int i = 0; i < 8; ++i) { *(LAS v4u*)(kd + (i * 8 + crow8) * 128 + cch * 16) = kreg[i]; *(LAS v4u*)(vh + (i * 8 + crow8) * 128 + cch * 16) = v0reg[i]; }
#pragma unroll
        for (int t = 0; t < 64; ++t) { LAS bf16* kp = (LAS bf16*)(kd + t * 128 + lane * 2); *kp = (bf16)f2bf(bf2f(*kp) * __expf(run - bt[t])); }
        dec[(size_t)u * 64 + lane] = __expf(run);
#pragma unroll
        for (int half = 0; half < 2; ++half) {
            if (half == 1) {
#pragma unroll
                for (int i = 0; i < 8; ++i) *(LAS v4u*)(vh + (i * 8 + crow8) * 128 + cch * 16) = v1reg[i];
            }
            f32x16 acc[2][2];
#pragma unroll
            for (int x = 0; x < 2; ++x)
#pragma unroll
                for (int y = 0; y < 2; ++y) acc[x][y] = f32x16{};
#pragma unroll
            for (int s = 0; s < 4; ++s) {
                bf16x8 af[2], bfr[2];
#pragma unroll
                for (int x = 0; x < 2; ++x) { af[x] = tr_frag(vh + (16 * s + 8 * hh + trow) * 128 + (32 * x + tcol) * 2, 4 * 128); bfr[x] = tr_frag(kd + (16 * s + 8 * hh + trow) * 128 + (32 * x + tcol) * 2, 4 * 128); }
#pragma unroll
                for (int x = 0; x < 2; ++x)
#pragma unroll
                    for (int y = 0; y < 2; ++y) acc[x][y] = __builtin_amdgcn_mfma_f32_32x32x16_bf16(af[x], bfr[y], acc[x][y], 0, 0, 0);
            }
#pragma unroll
            for (int x = 0; x < 2; ++x)
#pragma unroll
                for (int y = 0; y < 2; ++y) { float* lo = loc + (size_t)u * 8192 + 32 * y + (lane & 31);
#pragma unroll
                    for (int r = 0; r < 16; ++r) lo[(size_t)(64 * half + 32 * x + (r & 3) + 8 * (r >> 2) + 4 * hh) * 64] = acc[x][y][r]; }
        }
    }
}
__device__ __forceinline__ void gla_phase_b(const P& p, int vcu, int G) {
    int tid = threadIdx.x; asm volatile("" : "+v"(tid));
    float* loc = WSP(float, WS_GLOC); const float* dec = WSP(float, WS_GDEC);
    for (int u = vcu; u < 256; u += G) {
        const int bh = u >> 2, q4 = u & 3;
        const int e = q4 * 2048 + tid * 4, dk = e & 63;
        f32x4 st = {0.f, 0.f, 0.f, 0.f};
#pragma unroll 2
        for (int c = 0; c < 32; ++c) {
            const size_t cu = (size_t)bh * 32 + c;
            const f32x4 lv = *(const f32x4*)(loc + cu * 8192 + e);
            const f32x4 dv = *(const f32x4*)(dec + cu * 64 + dk);
            asm volatile("s_waitcnt vmcnt(0)" ::: "memory");
            __syncthreads();
            v2u w; w.x = pk2(st.x, st.y); w.y = pk2(st.z, st.w);
            *(v2u*)((unsigned char*)loc + cu * 32768 + 8192 * q4 + 8 * tid) = w;
            st = dv * st + lv;
        }
    }
}
__device__ __forceinline__ void gla_phase_c(const P& p, int l, LAS unsigned char* lds, int vcu, int G) {
    int tid = threadIdx.x; asm volatile("" : "+v"(tid));
    const int lane = tid & 63, wave = __builtin_amdgcn_readfirstlane(tid >> 6), hh = lane >> 5, r32 = lane & 31;
    const bf16* proj = WSP(bf16, WS_PROJ); const unsigned char* gs = WSP(const unsigned char, WS_GLOC); bf16* y = WSP(bf16, WS_Y); const float* gb = WSP(const float, WS_GB);
    for (int u = vcu; u < 2048; u += G) {
        const int c = u & 31, h = (u >> 5) & 3, b = u >> 7;
        const size_t tok0 = (size_t)b * SEQ + c * 64;
        const int dvb = wave >> 1, tb = wave & 1;
        bf16 qraw[8], kraw[8]; v4u vreg[2]; bf16x8 sfr[4]; v2u ggr[4]; f32x4 gnr[4];
#pragma unroll
        for (int j = 0; j < 8; ++j) { const bf16* rp = proj + (tok0 + wave * 8 + j) * PW + h * 64 + lane; qraw[j] = rp[C_GQ]; kraw[j] = rp[C_GK]; }
#pragma unroll
        for (int i = 0; i < 2; ++i) { const int idx = tid + NTHR * i, t = idx >> 4, cc = idx & 15; vreg[i] = *(const v4u*)(proj + (tok0 + t) * PW + C_GV + h * 128 + cc * 8); }
        { const bf16* sp = (const bf16*)(gs + (size_t)u * 32768 + 8192 * dvb) + r32 * 64 + 8 * hh;
#pragma unroll
          for (int s2 = 0; s2 < 4; ++s2) sfr[s2] = *(const bf16x8*)(sp + 16 * s2); }
        float btv[8];
#pragma unroll
        for (int j = 0; j < 8; ++j) btv[j] = gb[(tok0 + wave * 8 + j) * 256 + h * 64 + lane];
        const float rref = gb[(tok0 + 31) * 256 + h * 64 + lane];
#pragma unroll
        for (int g = 0; g < 4; ++g) { const int dv = 32 * dvb + 8 * g + 4 * hh;
            gnr[g] = *(const f32x4*)(p.gla_gain + l * 512 + h * 128 + dv); ggr[g] = *(const v2u*)(proj + (tok0 + 32 * tb + r32) * PW + C_GG + h * 128 + dv); }
#pragma unroll
        for (int i = 0; i < 2; ++i) { const int idx = tid + NTHR * i, t = idx >> 4, cc = idx & 15; *(LAS v4u*)(lds + GL_V + t * 320 + cc * 16) = vreg[i]; }
#pragma unroll
        for (int j = 0; j < 8; ++j) { const int t = wave * 8 + j; const float bt = btv[j];
            const float qv = bf2f(qraw[j]), kv = bf2f(kraw[j]);
            *(LAS bf16*)(lds + GL_Q1 + t * 144 + lane * 2) = (bf16)f2bf(qv * __expf(bt));
            *(LAS bf16*)(lds + GL_Q2 + t * 144 + lane * 2) = (bf16)f2bf(qv * __expf(bt - rref));
            *(LAS bf16*)(lds + GL_K2 + t * 144 + lane * 2) = (bf16)f2bf(kv * __expf(rref - bt)); }
        __syncthreads();
        const int trow = (lane & 15) >> 2, tcol = 16 * ((lane >> 4) & 1) + 4 * (lane & 3);
        f32x16 o = {};
        {
#pragma unroll
          for (int s = 0; s < 4; ++s) { const bf16x8 af = sfr[s]; const bf16x8 bq = *(const LAS bf16x8*)(lds + GL_Q1 + (32 * tb + r32) * 144 + (16 * s + 8 * hh) * 2);
              o = __builtin_amdgcn_mfma_f32_32x32x16_bf16(af, bq, o, 0, 0, 0); } }
#pragma unroll
        for (int sb = 0; sb < 2; ++sb) {
            if (sb <= tb) {
                f32x16 pt = {};
#pragma unroll
                for (int s = 0; s < 4; ++s) { const bf16x8 ak = *(const LAS bf16x8*)(lds + GL_K2 + (32 * sb + r32) * 144 + (16 * s + 8 * hh) * 2); const bf16x8 bq = *(const LAS bf16x8*)(lds + GL_Q2 + (32 * tb + r32) * 144 + (16 * s + 8 * hh) * 2);
                    pt = __builtin_amdgcn_mfma_f32_32x32x16_bf16(ak, bq, pt, 0, 0, 0); }
                if (sb == tb) {
#pragma unroll
                    for (int r = 0; r < 16; ++r) { const int s_ = (r & 3) + 8 * (r >> 2) + 4 * hh; if (s_ > r32) pt[r] = 0.f; }
                }
#pragma unroll
                for (int ks = 0; ks < 2; ++ks) {
                    const bf16x8 pa = pack8(pt, 8 * ks);
                    const bf16x8 vf = tr_frag(lds + GL_V + (32 * sb + 16 * ks + 4 * hh + trow) * 320 + (32 * dvb + tcol) * 2, 8 * 320);
                    o = __builtin_amdgcn_mfma_f32_32x32x16_bf16(vf, pa, o, 0, 0, 0);
                }
            }
        }
        float ss = 0.f;
#pragma unroll
        for (int r = 0; r < 16; ++r) ss += o[r] * o[r];
        ss += __shfl_xor(ss, 32);
        LAS float* sq = (LAS float*)(lds + GL_SSQ);
        if (hh == 0) sq[dvb * 64 + 32 * tb + r32] = ss;
        __syncthreads();
        const int t = 32 * tb + r32;
        const float tot = (sq[t] + sq[64 + t]) + (sq[128 + t] + sq[192 + t]);
        const float rs = rsqrtf(tot * (1.0f / 128.0f) + EPS);
        const size_t tok = tok0 + t;
#pragma unroll
        for (int g = 0; g < 4; ++g) {
            const int dv = 32 * dvb + 8 * g + 4 * hh;
            const f32x4 gn = gnr[g];
            const v2u gg = ggr[g];
            const float g0 = bf2f((bf16)(gg.x & 0xffff)), g1 = bf2f((bf16)(gg.x >> 16)), g2 = bf2f((bf16)(gg.y & 0xffff)), g3 = bf2f((bf16)(gg.y >> 16));
            const float v0 = o[4 * g] * rs * gn.x * g0 * __builtin_amdgcn_rcpf(1.f + __expf(-g0)), v1 = o[4 * g + 1] * rs * gn.y * g1 * __builtin_amdgcn_rcpf(1.f + __expf(-g1));
            const float v2 = o[4 * g + 2] * rs * gn.z * g2 * __builtin_amdgcn_rcpf(1.f + __expf(-g2)), v3 = o[4 * g + 3] * rs * gn.w * g3 * __builtin_amdgcn_rcpf(1.f + __expf(-g3));
            v2u w; w.x = cvtpk(v0, v1); w.y = cvtpk(v2, v3);
            st_b64(y + tok * DM + 512 + h * 128 + dv, w);
        }
        __syncthreads();
    }
}
__device__ __forceinline__ void fox_cumsum_phase(const P& p, int l, int vcu, int G) {
    int tid = threadIdx.x; asm volatile("" : "+v"(tid));
    const int lane = tid & 63, wave = __builtin_amdgcn_readfirstlane(tid >> 6);
    const float* sm = WSP(float, WS_SM); float* cb = WSP(float, WS_CB);
    for (int u = vcu * NWAVES + wave; u < NBATCH * 8; u += G * NWAVES) {
        const int b = u >> 3, h = u & 7;
        const float bias = p.b_forget[l * 8 + h];
        float v[32]; float run = 0.f;
#pragma unroll
        for (int j = 0; j < 32; ++j) { run += fast_log_sigmoid(sm[((size_t)b * SEQ + lane * 32 + j) * 32 + h] + bias); v[j] = run; }
        float pre = run;
#pragma unroll
        for (int o = 1; o < 64; o <<= 1) { const float t = __shfl_up(pre, o); if (lane >= o) pre += t; }
        pre -= run;
#pragma unroll
        for (int j = 0; j < 32; ++j) cb[((size_t)b * 8 + h) * SEQ + lane * 32 + j] = -(v[j] + pre) * LOG2E;
    }
}
__device__ __forceinline__ void router_weights(const P& p, int gtid, int gstride) {
    for (int idx = gtid; idx < NLAYER * 32768; idx += gstride) {
        const int l = idx >> 15, r = idx & 32767, k = r >> 5, n = r & 31;
        float v = 0.f;
        if (n < 16) v = p.w_re[((size_t)l * DM + k) * 16 + n]; else if (n < 20) v = p.w_rg[((size_t)l * DM + k) * 4 + (n - 16)];
        v *= p.moe_norm[l * DM + k];
        float* wr = (float*)(ws_base(p.ws) + WS_W + (size_t)l * WS_WLAYER + WO_RHI);
        wr[(((k >> 4) * 4 + ((k >> 2) & 3)) * 32 + n) * 4 + (k & 3)] = v;
    }
}
__device__ __forceinline__ void route_phase(const P& p, int l, LAS unsigned char* lds, int vcu, int G) {
    int tid = threadIdx.x; asm volatile("" : "+v"(tid));
    const int lane = tid & 63, wave = __builtin_amdgcn_readfirstlane(tid >> 6);
    { const v4u* src = (const v4u*)(ws_base(p.ws) + WS_W + (size_t)l * WS_WLAYER + WO_RHI);
#pragma unroll 4
      for (int i = 0; i < 16; ++i) *(LAS v4u*)(lds + LDS_STAGE + (tid + NTHR * i) * 16) = src[tid + NTHR * i]; }
    LAS int* hist = (LAS int*)(lds + LDS_GATE);
    if (tid < 32) hist[tid] = 0;
    __syncthreads();
    const float* H = p.out;
    int2* toke = WSP(int2, WS_MOE + MO_TOKE); float2* tokg = WSP(float2, WS_MOE + MO_TOKG);
    LAS float* lgb = (LAS float*)(lds + LDS_RS + wave * 2048);
    const int r = lane & 15, kq = lane >> 4;
    for (int task = vcu * NWAVES + wave; task < NTOK / 16; task += G * NWAVES) {
        const int tok0 = task * 16;
        const f32x4* hp = (const f32x4*)(H + (size_t)(tok0 + r) * DM + 4 * kq);
        f32x4 acc0 = {0.f, 0.f, 0.f, 0.f}, acc1 = {0.f, 0.f, 0.f, 0.f}; float q = 0.f;
#pragma unroll 8
        for (int s = 0; s < 64; ++s) {
            const f32x4 a = hp[4 * s];
            const f32x4 b0 = *(const LAS f32x4*)(lds + LDS_STAGE + ((s * 4 + kq) * 32 + r) * 16);
            const f32x4 b1 = *(const LAS f32x4*)(lds + LDS_STAGE + ((s * 4 + kq) * 32 + 16 + r) * 16);
            q += (a.x * a.x + a.y * a.y) + (a.z * a.z + a.w * a.w);
            acc0 = __builtin_amdgcn_mfma_f32_16x16x4f32(a.x, b0.x, acc0, 0, 0, 0); acc1 = __builtin_amdgcn_mfma_f32_16x16x4f32(a.x, b1.x, acc1, 0, 0, 0);
            acc0 = __builtin_amdgcn_mfma_f32_16x16x4f32(a.y, b0.y, acc0, 0, 0, 0); acc1 = __builtin_amdgcn_mfma_f32_16x16x4f32(a.y, b1.y, acc1, 0, 0, 0);
            acc0 = __builtin_amdgcn_mfma_f32_16x16x4f32(a.z, b0.z, acc0, 0, 0, 0); acc1 = __builtin_amdgcn_mfma_f32_16x16x4f32(a.z, b1.z, acc1, 0, 0, 0);
            acc0 = __builtin_amdgcn_mfma_f32_16x16x4f32(a.w, b0.w, acc0, 0, 0, 0); acc1 = __builtin_amdgcn_mfma_f32_16x16x4f32(a.w, b1.w, acc1, 0, 0, 0);
        }
        q += __shfl_xor(q, 16); q += __shfl_xor(q, 32);
        const float rsv = rsqrtf(q * (1.0f / DM) + EPS);
        const float bias0 = p.b_re[l * 16 + r], bias1 = r < 4 ? p.b_rg[l * 4 + r] : 0.f;
#pragma unroll
        for (int g = 0; g < 4; ++g) { const int row = 4 * kq + g; const float rs = __shfl(rsv, row);
            lgb[row * 32 + r] = acc0[g] * rs + bias0; lgb[row * 32 + 16 + r] = acc1[g] * rs + bias1; }
        LDS_WAIT();
        if (lane < 16) {
            const int tok = tok0 + lane;
            const LAS f32x4* lr = (const LAS f32x4*)(lgb + lane * 32);
            const f32x4 e0 = lr[0], e1 = lr[1], e2 = lr[2], e3 = lr[3], gl = lr[4];
            int g = 0; float gm = gl.x;
            if (gl.y > gm) { gm = gl.y; g = 1; } if (gl.z > gm) { gm = gl.z; g = 2; } if (gl.w > gm) { gm = gl.w; g = 3; }
            const float den = (expf(gl.x - gm) + expf(gl.y - gm)) + (expf(gl.z - gm) + expf(gl.w - gm));
            const float pg = 1.0f / den;
            const f32x4 el = g == 0 ? e0 : (g == 1 ? e1 : (g == 2 ? e2 : e3));
            int i0 = 0; float m0 = el.x;
            if (el.y > m0) { m0 = el.y; i0 = 1; } if (el.z > m0) { m0 = el.z; i0 = 2; } if (el.w > m0) { m0 = el.w; i0 = 3; }
            int i1 = -1; float m1 = -INFINITY;
            if (i0 != 0 && el.x > m1) { m1 = el.x; i1 = 0; } if (i0 != 1 && el.y > m1) { m1 = el.y; i1 = 1; }
            if (i0 != 2 && el.z > m1) { m1 = el.z; i1 = 2; } if (i0 != 3 && el.w > m1) { m1 = el.w; i1 = 3; }
            const float ex = expf(m1 - m0), inv = 1.0f / (1.0f + ex);
            const int ea = g * 4 + i0, eb = g * 4 + i1;
            toke[tok] = make_int2(ea, eb); tokg[tok] = make_float2(pg * inv, pg * ex * inv);
            atomicAdd((int*)&hist[ea], 1); atomicAdd((int*)&hist[16 + eb], 1);
        }
        LDS_WAIT();
    }
    __syncthreads();
    if (tid < 32) WSP(int, WS_MOE + MO_HIST)[vcu * 32 + tid] = hist[tid];
}
__device__ __forceinline__ void sort_phase(const P& p, LAS unsigned char* lds, int vcu, int G) {
    int tid = threadIdx.x; asm volatile("" : "+v"(tid));
    const int lane = tid & 63, wave = __builtin_amdgcn_readfirstlane(tid >> 6);
    LAS int* cnt = (LAS int*)(lds + LDS_GATE); LAS int* pre = cnt + 32; LAS int* base = cnt + 64; LAS int* ntl = cnt + 96;
    const int* histg = WSP(const int, WS_MOE + MO_HIST);
    int* rowtok = WSP(int, WS_MOE + MO_ROWTOK); float* rowgate = WSP(float, WS_MOE + MO_ROWGATE); int* tilee = WSP(int, WS_MOE + MO_TILEE); int* nt = WSP(int, WS_MOE + MO_NT);
    const int2* toke = WSP(const int2, WS_MOE + MO_TOKE); const float2* tokg = WSP(const float2, WS_MOE + MO_TOKG);
    { LAS int* part = (LAS int*)(lds + LDS_RS);
      const int j = tid & 31, part_i = tid >> 5; int c = 0, pr = 0;
      for (int w = part_i; w < G; w += 16) { const int v = histg[w * 32 + j]; if (w < vcu) pr += v; c += v; }
      part[part_i * 64 + j] = c; part[part_i * 64 + 32 + j] = pr;
      __syncthreads();
      if (tid < 32) { int cc = 0, pp = 0;
#pragma unroll
          for (int q = 0; q < 16; ++q) { cc += part[q * 64 + tid]; pp += part[q * 64 + 32 + tid]; }
          cnt[tid] = cc; pre[tid] = pp; } }
    __syncthreads();
    if (tid == 0) { int t = 0; for (int j = 0; j < 32; ++j) { base[j] = t * 256; const int n = (cnt[j] + 255) >> 8; ntl[j] = n; t += n; if (j == 15 && vcu == 0) nt[0] = t; } if (vcu == 0) nt[1] = t; }
    __syncthreads();
    if (vcu == 0 && tid < 32) { const int t0 = base[tid] >> 8; for (int i = 0; i < ntl[tid]; ++i) tilee[t0 + i] = tid & 15; }
    if (vcu < 32) { const int j = vcu, lo = base[j] + cnt[j], hi = base[j] + 256 * ntl[j]; for (int r = lo + tid; r < hi; r += NTHR) { rowtok[r] = -1; rowgate[r] = 0.f; } }
    if (wave < 2) {
        const int k = wave;
        int run[16];
#pragma unroll
        for (int e = 0; e < 16; ++e) run[e] = 0;
        for (int task0 = vcu * NWAVES; task0 < NTOK / 16; task0 += G * NWAVES) {
#pragma unroll 1
            for (int half = 0; half < 2; ++half) {
                const int tok = task0 * 16 + half * 64 + lane;
                const int2 ee = toke[tok]; const float2 gg = tokg[tok];
                const int e = k ? ee.y : ee.x; const float gt = k ? gg.y : gg.x;
                int rank = 0;
#pragma unroll
                for (int x = 0; x < 16; ++x) { const unsigned long long m = __ballot(e == x); if (e == x) rank = run[x] + __popcll(m & ((1ull << lane) - 1ull)); run[x] += __popcll(m); }
                const int pos = base[k * 16 + e] + pre[k * 16 + e] + rank;
                rowtok[pos] = tok; rowgate[pos] = gt;
            }
        }
    }
}
__device__ __forceinline__ void final_phase(const P& p, int vcu, int G) {
    int tid = threadIdx.x; asm volatile("" : "+v"(tid));
    const int lane = tid & 63, wave = __builtin_amdgcn_readfirstlane(tid >> 6);
    const float* ssq = WSP(const float, WS_SSQ);
    for (int m = vcu * NWAVES + wave; m < NTOK; m += G * NWAVES) {
        f32x4* s = (f32x4*)(p.out + (size_t)m * DM) + lane;
        const float rs = row_rs(ssq, m);
#pragma unroll
        for (int j = 0; j < 4; ++j) { const f32x4 g = ((const f32x4*)p.final_norm)[lane + 64 * j]; const f32x4 v = s[64 * j]; s[64 * j] = v * rs * g; }
    }
}
#ifndef ENMASK
#define ENMASK 0xffffffffu
#endif
#define EN(b) (((ENMASK) >> (b)) & 1u)
#ifndef REPMASK
#define REPMASK 0u
#endif
#define REPN(b) ((((REPMASK) >> (b)) & 1u) ? 2 : 1)
__device__ __attribute__((noinline)) void grid_barrier(unsigned* barw, unsigned x, volatile LAS unsigned* st) { XcdBarrier b; b.bar = barw; b.x = x; b.st = st; xcd_barrier(b); }
__global__ void __launch_bounds__(NTHR, 2) fwd(Args args) {
    extern __shared__ __attribute__((aligned(16))) unsigned char lds_raw[];
    LAS unsigned char* lds = (LAS unsigned char*)lds_raw;
    const P& p = args.p;
    const int tid = threadIdx.x, lane = tid & 63, wave = __builtin_amdgcn_readfirstlane(tid >> 6);
    const int G = gridDim.x; const int bx = blockIdx.x; const int vcu = (G % 8 == 0) ? (bx % 8) * (G / 8) + bx / 8 : bx;
    volatile LAS unsigned* MISC = (volatile LAS unsigned*)(lds + LDS_MISC);
    if (tid < 64) MISC[tid] = 0u;
    __syncthreads();
    unsigned* ctl = (unsigned*)(p.ws + WS_CTL);
    const int lo = args.ph_lo, hi = args.ph_hi;
    XcdBarrier bar; bar.bar = ctl + CW_BAR + args.li * XCD_BAR_WORDS; bar.x = 0; bar.st = nullptr;
    if (hi - lo > 1) bar = xcd_barrier_post(ctl + CW_BAR + args.li * XCD_BAR_WORDS, MISC);
#define IN(k) (lo <= (k) && (k) < hi)
#define PHL int vcuL = vcu, GL = G, bxL = bx; asm volatile("" : "+s"(vcuL), "+s"(GL), "+s"(bxL)); (void)vcuL; (void)GL; (void)bxL;
#define LTID(v) int v = threadIdx.x; asm volatile("" : "+v"(v))
#define SEAM(k) do { if (IN(k) && IN((k) + 1)) { grid_barrier(bar.bar, bar.x, bar.st); if (REPN(20) == 2) grid_barrier(bar.bar, bar.x, bar.st); } } while (0)
    LAS float* rstab = (LAS float*)(lds + LDS_RS); LAS int* rowtab = (LAS int*)(lds + LDS_ROWTOK); LAS float* gatetab = (LAS float*)(lds + LDS_GATE);
#define HB WSP(bf16, WS_HB)
#define PROJ WSP(bf16, WS_PROJ)
#define Y WSP(bf16, WS_Y)
#define XKV WSP(bf16, WS_XKV)
#define MEMN WSP(bf16, WS_MEMN)
#define SSQ WSP(float, WS_SSQ)
#define XQ WSP(bf16, WS_XQ)
#define U WSP(bf16, WS_U)
#define ROWTOK WSP(const int, WS_MOE + MO_ROWTOK)
#define ROWGATE WSP(const float, WS_MOE + MO_ROWGATE)
#define TILEE WSP(const int, WS_MOE + MO_TILEE)
#define NT WSP(const int, WS_MOE + MO_NT)
#define H (p.out)

    if (EN(0) && IN(PH_PRO)) _Pragma("unroll 1") for (int rep_ = 0; rep_ < REPN(0); ++rep_) { PHL prologue(p, lds, vcuL, GL, wave, lane); }
    SEAM(PH_PRO);
    if (EN(1) && IN(PH_XKV)) _Pragma("unroll 1") for (int rep_ = 0; rep_ < REPN(1); ++rep_) { PHL
        pg8::StaticOrder S; S.init(MEMN, ws_base(p.ws) + WS_WXKV, 4096, 2048, DM, GL, bxL);
        EpiBf16<false> E{XKV, 2048, rstab};
        pg8::gemm_phase<DM, EpiBf16<false>, pg8::StaticOrder, true>(lds + LDS_STAGE, S, E);
    }
    if (REPN(18) == 2 && IN(PH_XKV)) { PHL
        pg8::StaticOrder S; S.init(HB, ws_base(p.ws) + WS_W + WO_IN, NTOK, 3072, DM, GL, bxL);
        { pg8::Unit u; for (int iu = 0; S.next(iu, u); ++iu) { LTID(tq); if (tq < 256) rstab[iu * 256 + tq] = row_rs(SSQ, u.pm * 256 + tq); } }
        __syncthreads();
        EpiBf16<true> E{PROJ, PW, rstab};
        pg8::gemm_phase<DM, EpiBf16<true>, pg8::StaticOrder, true>(lds + LDS_STAGE, S, E);
    }
    SEAM(PH_XKV);
    for (int l = 0; l < NLAYER; ++l) {
        const int pb = PH_L0 + l * NPH;
        unsigned char* wl = ws_base(p.ws) + WS_W + (size_t)l * WS_WLAYER;
        if (EN(2) && IN(pb + LP_INPROJ)) _Pragma("unroll 1") for (int rep_ = 0; rep_ < REPN(2); ++rep_) { PHL
            pg8::StaticOrder S; S.init(HB, wl + WO_IN, NTOK, 3072, DM, GL, bxL);
            { pg8::Unit u; for (int iu = 0; S.next(iu, u); ++iu) { LTID(tq); if (tq < 256) rstab[iu * 256 + tq] = row_rs(SSQ, u.pm * 256 + tq); } }
            __syncthreads();
            EpiBf16<true> E{PROJ, PW, rstab};
            pg8::gemm_phase<DM, EpiBf16<true>, pg8::StaticOrder, true>(lds + LDS_STAGE, S, E);
            _Pragma("unroll 1") for (int r2_ = 0; r2_ < REPN(19); ++r2_) small_proj(p, l, vcuL, GL, wave, lane);
        }
        SEAM(pb + LP_INPROJ);
        if (EN(11) && IN(pb + LP_MIXA)) _Pragma("unroll 1") for (int rep_ = 0; rep_ < REPN(11); ++rep_) { PHL gla_phase_a(p, l, lds + LDS_STAGE, vcuL, GL); fox_cumsum_phase(p, l, vcuL, GL); }
        SEAM(pb + LP_MIXA);
        if (EN(12) && IN(pb + LP_MIXB)) _Pragma("unroll 1") for (int rep_ = 0; rep_ < REPN(12); ++rep_) { PHL gla_phase_b(p, vcuL, GL); }
        SEAM(pb + LP_MIXB);
        if (EN(9) && IN(pb + LP_MIXC)) { PHL _Pragma("unroll 1") for (int rep_ = 0; rep_ < REPN(16); ++rep_) fox_phase(p, l, lds + LDS_STAGE, vcuL, GL); _Pragma("unroll 1") for (int rep_ = 0; rep_ < REPN(17); ++rep_) gla_phase_c(p, l, lds + LDS_STAGE, vcuL, GL); }
        SEAM(pb + LP_MIXC);
        if (EN(3) && IN(pb + LP_WOUT)) _Pragma("unroll 1") for (int rep_ = 0; rep_ < REPN(3); ++rep_) { PHL
            pg8::StaticOrder S; S.init(Y, wl + WO_OUT, NTOK, DM, DM, GL, bxL);
            EpiRes<0> E{l == 0 ? p.x : H, H, HB, SSQ, rowtab, gatetab, rep_ == REPN(3) - 1 ? 1.f : 0.f, Y};
            pg8::gemm_phase<DM, EpiRes<0>, pg8::StaticOrder, true>(lds + LDS_STAGE, S, E);
        }
        SEAM(pb + LP_WOUT);
        if (EN(4) && IN(pb + LP_XQ)) _Pragma("unroll 1") for (int rep_ = 0; rep_ < REPN(4); ++rep_) { PHL
            pg8::StaticOrder S; S.init(HB, wl + WO_XQ, NTOK, 512, DM, GL, bxL);
            { pg8::Unit u; for (int iu = 0; S.next(iu, u); ++iu) { LTID(tq); if (tq < 256) rstab[iu * 256 + tq] = row_rs(SSQ, u.pm * 256 + tq); } }
            __syncthreads();
            EpiBf16<true> E{XQ, 512, rstab};
            pg8::gemm_phase<DM, EpiBf16<true>, pg8::StaticOrder, true>(lds + LDS_STAGE, S, E);
        }
        SEAM(pb + LP_XQ);
        if (EN(10) && IN(pb + LP_XATTN)) _Pragma("unroll 1") for (int rep_ = 0; rep_ < REPN(10); ++rep_) { PHL xattn_phase(p, l, lds + LDS_STAGE, vcuL, GL, rep_ != REPN(10) - 1); }
        SEAM(pb + LP_XATTN);
        if (EN(5) && IN(pb + LP_XO)) _Pragma("unroll 1") for (int rep_ = 0; rep_ < REPN(5); ++rep_) { PHL
            pg8::StaticOrder S; S.init(XQ, wl + WO_XO, NTOK, DM, 512, GL, bxL);
            EpiRes<0> E{H, H, HB, SSQ, rowtab, gatetab, rep_ == REPN(5) - 1 ? 1.f : 0.f, Y};
            pg8::gemm_phase<512, EpiRes<0>, pg8::StaticOrder, true>(lds + LDS_STAGE, S, E);
        }
        SEAM(pb + LP_XO);
        if (EN(13) && IN(pb + LP_ROUTE)) _Pragma("unroll 1") for (int rep_ = 0; rep_ < REPN(13); ++rep_) { PHL route_phase(p, l, lds, vcuL, GL); }
        SEAM(pb + LP_ROUTE);
        if (EN(14) && IN(pb + LP_SORT)) _Pragma("unroll 1") for (int rep_ = 0; rep_ < REPN(14); ++rep_) { PHL sort_phase(p, lds, vcuL, GL); }
        SEAM(pb + LP_SORT);
        if (EN(6) && IN(pb + LP_GU)) _Pragma("unroll 1") for (int rep_ = 0; rep_ < REPN(6); ++rep_) { PHL
            MoeOrder<true> S{(const char*)HB, (const char*)(wl + WO_GU), DM, (size_t)1024 * DM * 2, 0, NT[1], GL, vcuL, TILEE, rowtab};
            { pg8::Unit u; for (int iu = 0; S.next(iu, u); ++iu) { LTID(tq); if (tq < 256) { int t = ROWTOK[u.pm * 256 + tq]; t = t < 0 ? 0 : t; rowtab[iu * 256 + tq] = t; rstab[iu * 256 + tq] = row_rs(SSQ, t); } } }
            __syncthreads();
            EpiGU E{U, rstab};
            pg8::gemm_phase<DM, EpiGU, MoeOrder<true>, true>(lds + LDS_STAGE, S, E);
        }
        SEAM(pb + LP_GU);
        if (EN(7) && IN(pb + LP_DOWN0)) _Pragma("unroll 1") for (int rep_ = 0; rep_ < REPN(7); ++rep_) { PHL
            MoeOrder<false> S{(const char*)U, (const char*)(wl + WO_D), 512, (size_t)1024 * 512 * 2, 0, NT[0], GL, vcuL, TILEE, rowtab};
            __syncthreads();
            { pg8::Unit u; for (int iu = 0; S.next(iu, u); ++iu) { LTID(tq); if (tq < 256) { rowtab[iu * 256 + tq] = ROWTOK[u.pm * 256 + tq]; gatetab[iu * 256 + tq] = ROWGATE[u.pm * 256 + tq]; } } }
            __syncthreads();
            EpiRes<1> E{H, H, HB, SSQ, rowtab, gatetab, 1.f, Y};
            pg8::gemm_phase<512, EpiRes<1>, MoeOrder<false>, true>(lds + LDS_STAGE, S, E);
        }
        SEAM(pb + LP_DOWN0);
        if (EN(8) && IN(pb + LP_DOWN1)) _Pragma("unroll 1") for (int rep_ = 0; rep_ < REPN(8); ++rep_) { PHL
            MoeOrder<false> S{(const char*)U, (const char*)(wl + WO_D), 512, (size_t)1024 * 512 * 2, NT[0], NT[1], GL, vcuL, TILEE, rowtab};
            __syncthreads();
            { pg8::Unit u; for (int iu = 0; S.next(iu, u); ++iu) { LTID(tq); if (tq < 256) { rowtab[iu * 256 + tq] = ROWTOK[u.pm * 256 + tq]; gatetab[iu * 256 + tq] = ROWGATE[u.pm * 256 + tq]; } } }
            __syncthreads();
            EpiRes<2> E{H, H, HB, SSQ, rowtab, gatetab, 1.f, Y};
            pg8::gemm_phase<512, EpiRes<2>, MoeOrder<false>, true>(lds + LDS_STAGE, S, E);
        }
        SEAM(pb + LP_DOWN1);
    }
    if (EN(15) && IN(PH_FINAL)) _Pragma("unroll 1") for (int rep_ = 0; rep_ < REPN(15); ++rep_) { PHL final_phase(p, vcuL, GL); }
#undef IN
#undef SEAM
#undef HB
#undef PROJ
#undef Y
#undef XKV
#undef MEMN
#undef SSQ
#undef XQ
#undef U
#undef ROWTOK
#undef ROWGATE
#undef TILEE
#undef NT
#undef H
}

static int g_grid = 0;
static void launch_fast(const P& p, int lo, int hi, int& li, hipStream_t stream) {
    Args a{}; a.p = p; a.ph_lo = lo; a.ph_hi = hi; a.li = li++; a.pad = 0;
    hipLaunchKernelGGL(fwd, dim3(g_grid), dim3(NTHR), LDS_BYTES, stream, a);
    const hipError_t le = hipPeekAtLastError();
    if (le != hipSuccess) fprintf(stderr, "kernel_launch: fwd launch [%d,%d) failed: %s\n", lo, hi, hipGetErrorName(le));
}
extern "C" void kernel_launch(void* const* d_in, const int* in_sizes, int n_in, void* d_out, int out_size, void* d_ws, size_t ws_size, hipStream_t stream) {
    if (n_in != 25 || out_size != NTOK * DM || ws_size < WS_END2) { fprintf(stderr, "kernel_launch: unexpected sizes n_in %d out %d ws %zu (need %zu)\n", n_in, out_size, ws_size, (size_t)WS_END2); return; }
    if (g_grid == 0) {
        int dev = 0, cus = 0, per_cu = 0;
        if (hipGetDevice(&dev) != hipSuccess || hipDeviceGetAttribute(&cus, hipDeviceAttributeMultiprocessorCount, dev) != hipSuccess) { g_grid = -1; return; }
        if (hipFuncSetAttribute((const void*)fwd, hipFuncAttributeMaxDynamicSharedMemorySize, LDS_BYTES) != hipSuccess) { fprintf(stderr, "kernel_launch: hipFuncSetAttribute failed\n"); g_grid = -1; return; }
        if (hipOccupancyMaxActiveBlocksPerMultiprocessor(&per_cu, (const void*)fwd, NTHR, LDS_BYTES) != hipSuccess || per_cu < 1) { fprintf(stderr, "kernel_launch: occupancy query says %d\n", per_cu); }
        (void)hipGetLastError();
        g_grid = cus;
    }
    if (g_grid < 0) return;
    P p{};
    const float** pp = (const float**)&p;
    for (int i = 0; i < 25; ++i) pp[i] = (const float*)d_in[i];
    p.out = (float*)d_out; p.ws = (unsigned char*)d_ws;
    hipMemsetAsync((char*)d_ws + WS_CTL, 0, 1 * MiB, stream);
    bf16* HB = WSP(bf16, WS_HB); bf16* PROJ = WSP(bf16, WS_PROJ); float* SM = WSP(float, WS_SM); float* CB = WSP(float, WS_CB); bf16* Y = WSP(bf16, WS_Y);
    bf16* XKV = WSP(bf16, WS_XKV); float* SSQ = WSP(float, WS_SSQ); bf16* XQ = WSP(bf16, WS_XQ);
    float* LA = WSP(float, WS_HB);
    int2* TOKE = WSP(int2, WS_MOE + MO_TOKE); float2* TOKG = WSP(float2, WS_MOE + MO_TOKG); int* ROWTOK = WSP(int, WS_MOE + MO_ROWTOK); float* ROWGATE = WSP(float, WS_MOE + MO_ROWGATE);
    int* TILEE = WSP(int, WS_MOE + MO_TILEE); int* NT = WSP(int, WS_MOE + MO_NT);
    float* H = p.out;
    (void)HB; (void)SSQ; (void)XQ;
    int li = 0;
    launch_fast(p, PH_PRO, PH_END, li, stream);
}
```

```cpp
#define REPMASK 0x0
#include <hip/hip_runtime.h>
#include <cstdio>
#include <cstdint>

constexpr int NTOK = 32768, DM = 1024, NBATCH = 16, SEQ = 2048, NLAYER = 2, MEML = 256;
constexpr int PW = 3072;
constexpr int C_FQ = 0, C_FK = 512, C_FV = 1024, C_GQ = 1536, C_GK = 1792, C_GV = 2048, C_GG = 2560;
constexpr int INW = 3096;
constexpr float EPS = 1e-6f, LOG2E = 1.4426950408889634f;
constexpr int MAXTILES = 288;
constexpr int MAXROWS = MAXTILES * 256;

typedef unsigned short bf16;
__device__ __forceinline__ unsigned f2bf(float f) { unsigned u = __builtin_bit_cast(unsigned, f); return (u + 0x7fffu + ((u >> 16) & 1u)) >> 16; }
__device__ __forceinline__ float bf2f(bf16 b) { return __builtin_bit_cast(float, ((unsigned)b) << 16); }

constexpr size_t MiB = 1u << 20;
constexpr size_t WS_CTL = 0;
constexpr size_t WS_W = 1 * MiB;
constexpr size_t WS_WLAYER = 59 * MiB;
constexpr size_t WS_WXKV = WS_W + 2 * WS_WLAYER;
constexpr size_t WS_HB = WS_WXKV + 4 * MiB;
constexpr size_t WS_PROJ = WS_HB + 64 * MiB;
constexpr size_t WS_XQ = WS_PROJ;
constexpr size_t WS_U = WS_PROJ + 32 * MiB;
constexpr size_t WS_SM = WS_PROJ + 192 * MiB;
constexpr size_t WS_CB = WS_SM + 4 * MiB;
constexpr size_t WS_Y = WS_CB + 1 * MiB;
constexpr size_t WS_XKV = WS_Y + 64 * MiB;
constexpr size_t WS_MEMN = WS_XKV + 16 * MiB;
constexpr size_t WS_SSQ = WS_MEMN + 8 * MiB;
constexpr size_t WS_MOE = WS_SSQ + 2 * MiB;
constexpr size_t WS_END = WS_MOE + 2 * MiB;
static_assert(WS_END <= 512 * MiB, "workspace map");
constexpr size_t MO_TOKE = 0;
constexpr size_t MO_TOKG = 256 * 1024;
constexpr size_t MO_ROWTOK = 512 * 1024;
constexpr size_t MO_ROWGATE = 832 * 1024;
constexpr size_t MO_TILEE = 1152 * 1024;
constexpr size_t MO_NT = 1156 * 1024;
constexpr size_t MO_HIST = 1160 * 1024;

struct P {
    const float *x, *mem, *mem_norm, *mix_norm, *w_in, *b_forget, *w_alpha_up, *b_alpha, *fox_gain, *gla_gain, *w_out, *cross_norm, *w_xq, *w_xk, *w_xv, *w_xo,
        *moe_norm, *w_rg, *b_rg, *w_re, *b_re, *w_eg, *w_eu, *w_ed, *final_norm;
    float* out; unsigned char* ws;
};
__host__ __device__ __forceinline__ unsigned char* ws_base(unsigned char* w) {
#if defined(__HIP_DEVICE_COMPILE__)
    asm volatile("" : "+s"(w));
#endif
    return w; }
#define WSP(T, off) ((T*)(ws_base(p.ws) + (off)))

__device__ __forceinline__ float wave_sum(float v) {
#pragma unroll
    for (int o = 1; o < 64; o <<= 1) v += __shfl_xor(v, o);
    return v;
}
__device__ __forceinline__ float wave_max(float v) {
#pragma unroll
    for (int o = 1; o < 64; o <<= 1) v = fmaxf(v, __shfl_xor(v, o));
    return v;
}
__device__ __forceinline__ float row_rs(const float* ssq, int row) {
    const float4* s = (const float4*)(ssq + (size_t)row * 16);
    float4 a = s[0], b = s[1], c = s[2], d = s[3];
    float t = ((a.x + a.y) + (a.z + a.w)) + ((b.x + b.y) + (b.z + b.w)) + ((c.x + c.y) + (c.z + c.w)) + ((d.x + d.y) + (d.z + d.w));
    return rsqrtf(t * (1.0f / DM) + EPS);
}
__device__ __forceinline__ float log_sigmoid(float z) { return fminf(z, 0.f) - log1pf(expf(-fabsf(z))); }
__device__ __forceinline__ float silu(float z) { return z / (1.f + expf(-z)); }

typedef unsigned st_v4u __attribute__((ext_vector_type(4)));
typedef unsigned st_v2u __attribute__((ext_vector_type(2)));
#ifndef WT_STORES
#define WT_STORES 0
#endif
__device__ __forceinline__ void st_b128(void* p, st_v4u v) {
#if WT_STORES
    asm volatile("global_store_dwordx4 %0, %1, off sc1\n\ts_nop 1" :: "v"(p), "v"(v) : "memory");
#else
    *(st_v4u*)p = v;
#endif
}
__device__ __forceinline__ void st_b64(void* p, st_v2u v) {
#if WT_STORES
    asm volatile("global_store_dwordx2 %0, %1, off sc1" :: "v"(p), "v"(v) : "memory");
#else
    *(st_v2u*)p = v;
#endif
}
__global__ void __launch_bounds__(256) k_rowprep(const float* src, bf16* dst, float* ssq, const float* gain, int rows, int mode) {
    const int lane = threadIdx.x & 63, row = blockIdx.x * 4 + (threadIdx.x >> 6);
    if (row >= rows) return;
    const float4* s = (const float4*)(src + (size_t)row * DM) + lane;
    float4 v[4]; float q = 0.f;
#pragma unroll
    for (int j = 0; j < 4; ++j) { v[j] = s[64 * j]; q += (v[j].x * v[j].x + v[j].y * v[j].y) + (v[j].z * v[j].z + v[j].w * v[j].w); }
    q = wave_sum(q);
    float sc = 1.f;
    if (mode == 1) sc = rsqrtf(q * (1.0f / DM) + EPS);
    else if (lane < 16) ssq[(size_t)row * 16 + lane] = lane == 0 ? q : 0.f;
    uint2* d = (uint2*)(dst + (size_t)row * DM) + lane;
#pragma unroll
    for (int j = 0; j < 4; ++j) {
        float4 g = mode == 1 ? ((const float4*)gain)[lane + 64 * j] : make_float4(1.f, 1.f, 1.f, 1.f);
        d[64 * j] = make_uint2(f2bf(v[j].x * sc * g.x) | (f2bf(v[j].y * sc * g.y) << 16), f2bf(v[j].z * sc * g.z) | (f2bf(v[j].w * sc * g.w) << 16));
    }
}
__global__ void __launch_bounds__(256) k_final(float* io, const float* gain) {
    const int lane = threadIdx.x & 63, row = blockIdx.x * 4 + (threadIdx.x >> 6);
    float4* s = (float4*)(io + (size_t)row * DM) + lane;
    float4 v[4]; float q = 0.f;
#pragma unroll
    for (int j = 0; j < 4; ++j) { v[j] = s[64 * j]; q += (v[j].x * v[j].x + v[j].y * v[j].y) + (v[j].z * v[j].z + v[j].w * v[j].w); }
    q = wave_sum(q);
    const float sc = rsqrtf(q * (1.0f / DM) + EPS);
#pragma unroll
    for (int j = 0; j < 4; ++j) { float4 g = ((const float4*)gain)[lane + 64 * j]; s[64 * j] = make_float4(v[j].x * sc * g.x, v[j].y * sc * g.y, v[j].z * sc * g.z, v[j].w * sc * g.w); }
}

template <class C> __global__ void __launch_bounds__(256) k_ngemm(C c) {
    __shared__ float As[16][65];
    __shared__ float Bs[C::NB][16][65];
    const int M = c.rows();
    const int row0 = blockIdx.y * 64, col0 = blockIdx.x * 64;
    if (row0 >= M || row0 < c.row_lo()) return;
    const int tx = threadIdx.x & 15, ty = threadIdx.x >> 4;
    float acc[C::NB][4][4];
#pragma unroll
    for (int n = 0; n < C::NB; ++n)
#pragma unroll
        for (int i = 0; i < 4; ++i)
#pragma unroll
            for (int j = 0; j < 4; ++j) acc[n][i][j] = 0.f;
    for (int k0 = 0; k0 < c.K; k0 += 16) {
#pragma unroll
        for (int i = 0; i < 4; ++i) { const int idx = threadIdx.x + 256 * i, r = idx >> 4, kk = idx & 15; As[kk][r] = c.a(row0 + r, k0 + kk); }
#pragma unroll
        for (int n = 0; n < C::NB; ++n)
#pragma unroll
            for (int i = 0; i < 4; ++i) { const int idx = threadIdx.x + 256 * i, kk = idx >> 6, cc = idx & 63; Bs[n][kk][cc] = c.b(n, k0 + kk, col0 + cc, row0); }
        __syncthreads();
#pragma unroll
        for (int kk = 0; kk < 16; ++kk) {
            float a[4];
#pragma unroll
            for (int i = 0; i < 4; ++i) a[i] = As[kk][ty * 4 + i];
#pragma unroll
            for (int n = 0; n < C::NB; ++n) {
                float b[4];
#pragma unroll
                for (int j = 0; j < 4; ++j) b[j] = Bs[n][kk][tx * 4 + j];
#pragma unroll
                for (int i = 0; i < 4; ++i)
#pragma unroll
                    for (int j = 0; j < 4; ++j) acc[n][i][j] += a[i] * b[j];
            }
        }
        __syncthreads();
    }
#pragma unroll
    for (int i = 0; i < 4; ++i)
#pragma unroll
        for (int j = 0; j < 4; ++j) c.epi(row0 + ty * 4 + i, col0 + tx * 4 + j, acc[0][i][j], acc[C::NB - 1][i][j]);
}

struct CfgXKV {
    __device__ int row_lo() const { return 0; }
    static constexpr int NB = 1; int K; const bf16* A; const float *wk, *wv; bf16* O; int l;
    __device__ int rows() const { return 4096; }
    __device__ float a(int r, int k) const { return bf2f(A[(size_t)r * DM + k]); }
    __device__ float b(int, int k, int c, int) const { return c < 512 ? wk[(size_t)k * 512 + c] : wv[(size_t)k * 512 + c - 512]; }
    __device__ void epi(int r, int c, float v, float) const { O[(size_t)r * 2048 + l * 1024 + c] = (bf16)f2bf(v); }
};
struct CfgInProj {
    __device__ int row_lo() const { return 0; }
    static constexpr int NB = 1; int K; const bf16* A; const float *w, *gain, *ssq; bf16* proj; float* sm;
    __device__ int rows() const { return NTOK; }
    __device__ float a(int r, int k) const { return bf2f(A[(size_t)r * DM + k]); }
    __device__ float b(int, int k, int c, int) const { return c < INW ? gain[k] * w[(size_t)k * INW + c] : 0.f; }
    __device__ void epi(int r, int c, float v, float) const {
        if (c >= INW) return;
        v *= row_rs(ssq, r);
        if (c < 1536) { if (c < 512) v *= 0.125f * LOG2E; proj[(size_t)r * PW + c] = (bf16)f2bf(v); }
        else if (c < 1544) sm[(size_t)r * 32 + (c - 1536)] = v;
        else if (c < 3080) { if (c < 1800) v *= 0.125f; proj[(size_t)r * PW + (c - 8)] = (bf16)f2bf(v); }
        else sm[(size_t)r * 32 + 8 + (c - 3080)] = v;
    }
};
struct CfgRes {
    __device__ int row_lo() const { return 0; }
    static constexpr int NB = 1; int K; const bf16* A; const float* w; const float* base; float* out;
    __device__ int rows() const { return NTOK; }
    __device__ float a(int r, int k) const { return bf2f(A[(size_t)r * K + k]); }
    __device__ float b(int, int k, int c, int) const { return w[(size_t)k * DM + c]; }
    __device__ void epi(int r, int c, float v, float) const { out[(size_t)r * DM + c] = base[(size_t)r * DM + c] + v; }
};
struct CfgXQ {
    __device__ int row_lo() const { return 0; }
    static constexpr int NB = 1; int K; const bf16* A; const float *w, *gain, *ssq; bf16* O;
    __device__ int rows() const { return NTOK; }
    __device__ float a(int r, int k) const { return bf2f(A[(size_t)r * DM + k]); }
    __device__ float b(int, int k, int c, int) const { return gain[k] * w[(size_t)k * 512 + c]; }
    __device__ void epi(int r, int c, float v, float) const { O[(size_t)r * 512 + c] = (bf16)f2bf(v * row_rs(ssq, r) * (0.08838834764831845f * LOG2E)); }
};
struct CfgGU {
    __device__ int row_lo() const { return 0; }
    static constexpr int NB = 2; int K; const bf16* A; const float *wg, *wu, *gain, *ssq; const int *rowtok, *tilee, *nt; bf16* U;
    __device__ int rows() const { return nt[1] * 256; }
    __device__ float a(int r, int k) const { int t = rowtok[r]; t = t < 0 ? 0 : t; return bf2f(A[(size_t)t * DM + k]); }
    __device__ float b(int n, int k, int c, int row0) const { const int e = tilee[row0 >> 8]; const size_t o = ((size_t)e * DM + k) * 512 + c; return n == 0 ? gain[k] * wg[o] : gain[k] * wu[o]; }
    __device__ void epi(int r, int c, float g, float u) const {
        const int t = rowtok[r]; float v = 0.f;
        if (t >= 0) { const float rs = row_rs(ssq, t); v = silu(g * rs) * (u * rs); }
        U[(size_t)r * 512 + c] = (bf16)f2bf(v);
    }
};
struct CfgDown {
    static constexpr int NB = 1; int K; const bf16* U; const float* wd; const int *rowtok, *tilee, *nt; const float* rowgate; float* out; int which;
    __device__ int rows() const { return nt[which] * 256; }
    __device__ int row_lo() const { return which == 1 ? nt[0] * 256 : 0; }
    __device__ float a(int r, int k) const { return bf2f(U[(size_t)r * 512 + k]); }
    __device__ float b(int, int k, int c, int row0) const { const int e = tilee[row0 >> 8]; return wd[((size_t)e * 512 + k) * DM + c]; }
    __device__ void epi(int r, int c, float v, float) const {
        if (which == 1 && r < nt[0] * 256) return;
        const int t = rowtok[r]; if (t >= 0) out[(size_t)t * DM + c] += rowgate[r] * v;
    }
};

__global__ void __launch_bounds__(64) k_fox_cumsum(const float* sm, const float* bfor, float* cb) {
    const int b = blockIdx.x >> 3, h = blockIdx.x & 7, lane = threadIdx.x;
    const float bias = bfor[h];
    float v[32]; float run = 0.f;
#pragma unroll
    for (int j = 0; j < 32; ++j) { const int s = lane * 32 + j; run += log_sigmoid(sm[((size_t)b * SEQ + s) * 32 + h] + bias); v[j] = run; }
    float tot = run, pre = run;
#pragma unroll
    for (int o = 1; o < 64; o <<= 1) { const float t = __shfl_up(pre, o); if (lane >= o) pre += t; }
    pre -= tot;
#pragma unroll
    for (int j = 0; j < 32; ++j) cb[((size_t)b * 8 + h) * SEQ + lane * 32 + j] = -(v[j] + pre) * LOG2E;
}
__global__ void __launch_bounds__(256) k_fox_attn(const bf16* proj, const float* cb, const float* gain, bf16* y) {
    __shared__ float pbuf[4][SEQ];
    __shared__ float qbuf[4][64];
    const int w = threadIdx.x >> 6, lane = threadIdx.x & 63;
    const int gq = blockIdx.x * 4 + w;
    const int q = gq % SEQ, h = (gq / SEQ) % 8, b = gq / (SEQ * 8);
    const size_t tok = (size_t)b * SEQ + q;
    qbuf[w][lane] = bf2f(proj[tok * PW + C_FQ + h * 64 + lane]);
    __syncthreads();
    const float* cbp = cb + ((size_t)b * 8 + h) * SEQ;
    float s[32]; float mx = -INFINITY;
#pragma unroll
    for (int j = 0; j < 32; ++j) {
        const int key = lane + 64 * j; float v = -INFINITY;
        if (key <= q) {
            const uint4* kr = (const uint4*)(proj + ((size_t)b * SEQ + key) * PW + C_FK + h * 64);
            float d = 0.f;
#pragma unroll
            for (int c8 = 0; c8 < 8; ++c8) { const uint4 u = kr[c8]; const unsigned ww[4] = {u.x, u.y, u.z, u.w};
#pragma unroll
                for (int e = 0; e < 4; ++e) { d += qbuf[w][c8 * 8 + 2 * e] * bf2f((bf16)(ww[e] & 0xffff)); d += qbuf[w][c8 * 8 + 2 * e + 1] * bf2f((bf16)(ww[e] >> 16)); } }
            v = d + cbp[key];
        }
        s[j] = v; mx = fmaxf(mx, v);
    }
    mx = wave_max(mx);
    float l = 0.f;
#pragma unroll
    for (int j = 0; j < 32; ++j) { const float pv = (lane + 64 * j <= q) ? exp2f(s[j] - mx) : 0.f; l += pv; pbuf[w][lane + 64 * j] = pv; }
    l = wave_sum(l);
    __syncthreads();
    float o = 0.f;
    for (int key = 0; key <= q; ++key) o += pbuf[w][key] * bf2f(proj[((size_t)b * SEQ + key) * PW + C_FV + h * 64 + lane]);
    o /= l;
    const float ms = wave_sum(o * o) * (1.0f / 64.0f);
    y[tok * DM + h * 64 + lane] = (bf16)f2bf(o * rsqrtf(ms + EPS) * gain[h * 64 + lane]);
}
__global__ void __launch_bounds__(256) k_gla_la(const float* sm, const float* wup, const float* balpha, float* la) {
    const int tok = blockIdx.x, c = threadIdx.x;
    float z = balpha[c];
#pragma unroll
    for (int r = 0; r < 16; ++r) z += sm[(size_t)tok * 32 + 8 + r] * wup[r * 256 + c];
    la[(size_t)tok * 256 + c] = log_sigmoid(z) * (1.0f / 16.0f);
}
__global__ void __launch_bounds__(128) k_gla_rec(const bf16* proj, const float* la, const float* gain, bf16* y) {
    __shared__ float sh_a[64], sh_k[64], sh_q[64], red[2];
    const int b = blockIdx.x >> 2, h = blockIdx.x & 3, dv = threadIdx.x;
    float st[64];
#pragma unroll
    for (int i = 0; i < 64; ++i) st[i] = 0.f;
    const float g = gain[h * 128 + dv];
    for (int t = 0; t < SEQ; ++t) {
        const size_t tok = (size_t)b * SEQ + t;
        __syncthreads();
        if (dv < 64) { sh_a[dv] = expf(la[tok * 256 + h * 64 + dv]); sh_k[dv] = bf2f(proj[tok * PW + C_GK + h * 64 + dv]); }
        else sh_q[dv - 64] = bf2f(proj[tok * PW + C_GQ + h * 64 + dv - 64]);
        __syncthreads();
        const float v = bf2f(proj[tok * PW + C_GV + h * 128 + dv]);
        float o = 0.f;
#pragma unroll
        for (int i = 0; i < 64; ++i) { st[i] = sh_a[i] * st[i] + sh_k[i] * v; o += sh_q[i] * st[i]; }
        const float ss = wave_sum(o * o);
        if ((dv & 63) == 0) red[dv >> 6] = ss;
        __syncthreads();
        const float ms = (red[0] + red[1]) * (1.0f / 128.0f);
        const float gg = bf2f(proj[tok * PW + C_GG + h * 128 + dv]);
        y[tok * DM + 512 + h * 128 + dv] = (bf16)f2bf(o * rsqrtf(ms + EPS) * g * silu(gg));
    }
}
__global__ void __launch_bounds__(256) k_xattn(bf16* xq, const bf16* xkv, int l) {
    __shared__ float pbuf[4][256];
    __shared__ float qbuf[4][128];
    const int w = threadIdx.x >> 6, lane = threadIdx.x & 63;
    const int gq = blockIdx.x * 4 + w;
    const int q = gq % SEQ, h = (gq / SEQ) % 4, b = gq / (SEQ * 4);
    const size_t tok = (size_t)b * SEQ + q;
    qbuf[w][lane] = bf2f(xq[tok * 512 + h * 128 + lane]); qbuf[w][lane + 64] = bf2f(xq[tok * 512 + h * 128 + lane + 64]);
    __syncthreads();
    float s[4]; float mx = -INFINITY;
#pragma unroll
    for (int j = 0; j < 4; ++j) {
        const int key = lane + 64 * j;
        const uint4* kr = (const uint4*)(xkv + ((size_t)b * MEML + key) * 2048 + l * 1024 + h * 128);
        float d = 0.f;
#pragma unroll
        for (int c8 = 0; c8 < 16; ++c8) { const uint4 u = kr[c8]; const unsigned ww[4] = {u.x, u.y, u.z, u.w};
#pragma unroll
            for (int e = 0; e < 4; ++e) { d += qbuf[w][c8 * 8 + 2 * e] * bf2f((bf16)(ww[e] & 0xffff)); d += qbuf[w][c8 * 8 + 2 * e + 1] * bf2f((bf16)(ww[e] >> 16)); } }
        s[j] = d; mx = fmaxf(mx, d);
    }
    mx = wave_max(mx);
    float lsum = 0.f;
#pragma unroll
    for (int j = 0; j < 4; ++j) { const float pv = exp2f(s[j] - mx); lsum += pv; pbuf[w][lane + 64 * j] = pv; }
    lsum = wave_sum(lsum);
    __syncthreads();
    float o0 = 0.f, o1 = 0.f;
    for (int key = 0; key < 256; ++key) { const bf16* vr = xkv + ((size_t)b * MEML + key) * 2048 + l * 1024 + 512 + h * 128; const float pv = pbuf[w][key]; o0 += pv * bf2f(vr[lane]); o1 += pv * bf2f(vr[lane + 64]); }
    xq[tok * 512 + h * 128 + lane] = (bf16)f2bf(o0 / lsum); xq[tok * 512 + h * 128 + lane + 64] = (bf16)f2bf(o1 / lsum);
}
__global__ void __launch_bounds__(256) k_router(const float* h, const float* gain, const float* wrg, const float* brg, const float* wre, const float* bre, int2* toke, float2* tokg) {
    const int lane = threadIdx.x & 63, tok = blockIdx.x * 4 + (threadIdx.x >> 6);
    const float* hr = h + (size_t)tok * DM;
    float hv[16]; float q = 0.f;
#pragma unroll
    for (int j = 0; j < 16; ++j) { hv[j] = hr[lane + 64 * j]; q += hv[j] * hv[j]; }
    q = wave_sum(q);
    const float rs = rsqrtf(q * (1.0f / DM) + EPS);
#pragma unroll
    for (int j = 0; j < 16; ++j) hv[j] = hv[j] * rs * gain[lane + 64 * j];
    float lg[20];
#pragma unroll
    for (int o = 0; o < 20; ++o) {
        float d = 0.f;
#pragma unroll
        for (int j = 0; j < 16; ++j) { const int k = lane + 64 * j; d += hv[j] * (o < 4 ? wrg[k * 4 + o] : wre[k * 16 + (o - 4)]); }
        lg[o] = wave_sum(d) + (o < 4 ? brg[o] : bre[o - 4]);
    }
    if (lane == 0) {
        int g = 0; float gm = lg[0];
#pragma unroll
        for (int i = 1; i < 4; ++i) if (lg[i] > gm) { gm = lg[i]; g = i; }
        float den = 0.f;
#pragma unroll
        for (int i = 0; i < 4; ++i) den += expf(lg[i] - gm);
        const float pg = 1.0f / den;
        float el[4];
#pragma unroll
        for (int i = 0; i < 4; ++i) { float v = lg[4];
#pragma unroll
            for (int gg = 0; gg < 4; ++gg) if (gg == g) v = lg[4 + gg * 4 + i];
            el[i] = v; }
        int i0 = 0; float m0 = el[0];
#pragma unroll
        for (int i = 1; i < 4; ++i) if (el[i] > m0) { m0 = el[i]; i0 = i; }
        int i1 = -1; float m1 = -INFINITY;
#pragma unroll
        for (int i = 0; i < 4; ++i) if (i != i0 && el[i] > m1) { m1 = el[i]; i1 = i; }
        const float e1 = expf(m1 - m0), inv = 1.0f / (1.0f + e1);
        toke[tok] = make_int2(g * 4 + i0, g * 4 + i1);
        tokg[tok] = make_float2(pg * inv, pg * e1 * inv);
    }
}
__global__ void k_sort(const int2* toke, const float2* tokg, int* rowtok, float* rowgate, int* tilee, int* nt) {
    __shared__ int cnt[32], base[32];
    if (threadIdx.x != 0 || blockIdx.x != 0) return;
    for (int i = 0; i < 32; ++i) cnt[i] = 0;
    for (int t = 0; t < NTOK; ++t) { const int2 e = toke[t]; cnt[e.x]++; cnt[16 + e.y]++; }
    int tile = 0;
    for (int k = 0; k < 2; ++k) { for (int e = 0; e < 16; ++e) { base[k * 16 + e] = tile * 256; const int n = (cnt[k * 16 + e] + 255) / 256; for (int i = 0; i < n; ++i) tilee[tile + i] = e; tile += n; } nt[k] = tile; }
    for (int r = 0; r < tile * 256; ++r) { rowtok[r] = -1; rowgate[r] = 0.f; }
    for (int t = 0; t < NTOK; ++t) {
        const int2 e = toke[t]; const float2 g = tokg[t];
        { const int pos = base[e.x]++; rowtok[pos] = t; rowgate[pos] = g.x; }
        { const int pos = base[16 + e.y]++; rowtok[pos] = t; rowgate[pos] = g.y; }
    }
}

#define XB_TMO      128
#define XB_XCNT(j)  (256  + 64 * (j))
#define XB_XSUB(j)  (1280 + 64 * (j))
#define XB_XGEN(j)  (2304 + 64 * (j))
#define XB_TOP      3328
#define XB_TOPGEN   3392
#define XCD_BAR_WORDS 3456
#define XB_SPIN_CAP (1u << 18)
#define LAS __attribute__((address_space(3)))

__device__ __forceinline__ unsigned xb_ld(unsigned* p)              { return __hip_atomic_load(p, __ATOMIC_RELAXED, __HIP_MEMORY_SCOPE_AGENT); }
__device__ __forceinline__ unsigned xb_add(unsigned* p, unsigned v) { return __hip_atomic_fetch_add(p, v, __ATOMIC_RELAXED, __HIP_MEMORY_SCOPE_AGENT); }
__device__ __forceinline__ unsigned xb_xcc_id() { return (unsigned)__builtin_amdgcn_s_getreg((3 << 11) | 20) & 0xFu; }
#define XB_SPIN(cond, bar) do { unsigned _sp = 0; while (cond) { __builtin_amdgcn_s_sleep(1); \
    if ((++_sp & 255u) == 0u) { if (xb_ld(&(bar)[XB_TMO])) break; if (_sp > XB_SPIN_CAP) { atomicAdd(&(bar)[XB_TMO], 1u); break; } } } } while (0)

struct XcdBarrier {
    unsigned* bar; unsigned x;
    volatile LAS unsigned* st;
};

__device__ __forceinline__ XcdBarrier xcd_barrier_post(unsigned* bar, volatile LAS unsigned* st) {
    XcdBarrier b; b.bar = bar; b.x = xb_xcc_id(); b.st = st;
    if (threadIdx.x == 0) (void)xb_add(&bar[XB_XCNT(b.x)], 1u);
    return b;
}
__device__ __forceinline__ void xcd_barrier_complete(unsigned* bar, unsigned x, unsigned& nloc, unsigned& nx) {
    const unsigned G = gridDim.x * gridDim.y * gridDim.z;
    unsigned sum, cnt, mine, sp = 0u;
    for (;;) {
        sum = 0u; cnt = 0u; mine = 0u;
#pragma unroll
        for (unsigned j = 0; j < 16; ++j) { const unsigned c = xb_ld(&bar[XB_XCNT(j)]); sum += c; cnt += (c > 0u) ? 1u : 0u; mine = (j == x) ? c : mine; }
        if (sum == G) break;
        __builtin_amdgcn_s_sleep(1);
        if ((++sp & 255u) == 0u) { if (xb_ld(&bar[XB_TMO])) break; if (sp > XB_SPIN_CAP) { atomicAdd(&bar[XB_TMO], 1u); break; } }
    }
    nloc = mine > 0u ? mine : 1u; nx = cnt > 0u ? cnt : 1u;
}

__device__ __forceinline__ void xcd_barrier(const XcdBarrier& b) {
    asm volatile("s_waitcnt vmcnt(0)" ::: "memory");
    __syncthreads();
    if (threadIdx.x == 0) {
        unsigned* bar = b.bar;
        __builtin_amdgcn_s_waitcnt(0);
        unsigned nloc = b.st[0], nx = b.st[1];
        if (nloc == 0u) { xcd_barrier_complete(bar, b.x, nloc, nx); b.st[0] = nloc; b.st[1] = nx; }
        const unsigned old = xb_add(&bar[XB_XSUB(b.x)], 1u);
        const unsigned gen = old / nloc;
        if (old + 1u == (gen + 1u) * nloc) {
            __builtin_amdgcn_fence(__ATOMIC_RELEASE, "agent");
            asm volatile("s_waitcnt vmcnt(0)" ::: "memory");
            const unsigned og = xb_add(&bar[XB_TOP], 1u);
            const unsigned tg = og / nx;
            if (og + 1u == (tg + 1u) * nx) xb_add(&bar[XB_TOPGEN], 1u);
            else XB_SPIN(xb_ld(&bar[XB_TOPGEN]) == tg, bar);
            __builtin_amdgcn_fence(__ATOMIC_ACQUIRE, "agent");
            xb_add(&bar[XB_XGEN(b.x)], 1u);
            asm volatile("s_waitcnt vmcnt(0)" ::: "memory");
        } else {
            XB_SPIN(xb_ld(&bar[XB_XGEN(b.x)]) == gen, bar);
            __builtin_amdgcn_fence(__ATOMIC_ACQUIRE, "agent");
            asm volatile("s_waitcnt vmcnt(0)" ::: "memory");
        }
    }
    __syncthreads();
}

namespace pg8 {
#define PG8_LAS __attribute__((address_space(3)))
typedef unsigned short bf16_t;
typedef short bf16x8 __attribute__((ext_vector_type(8)));
typedef float f32x4 __attribute__((ext_vector_type(4)));
typedef unsigned u32x4 __attribute__((ext_vector_type(4)));
typedef unsigned u32x2 __attribute__((ext_vector_type(2)));
constexpr int BM = 256, BK = 64, HALF = 128, HTB = HALF * BK * 2, STAGE_BYTES = 8 * HTB, NXCD = 8, WGM = 8;

__host__ __device__ __forceinline__ int lds_byte(int r, int c) { const int st = (r >> 4) * 2 + (c >> 5), rr = r & 15, cc = c & 31, ob = rr * 64 + cc * 2; return st * 1024 + (ob ^ (((ob >> 9) & 1) << 5)); }
__host__ __device__ __forceinline__ void stage_rc(int b, int& R, int& C) { const int st = b / 1024, sb = b % 1024, swz = sb ^ (((sb >> 9) & 1) << 5); R = (st >> 1) * 16 + swz / 64; C = (st & 1) * 32 + (swz % 64) / 2; }
__host__ __device__ __forceinline__ int perm32(int rho) { const int n = rho >> 4, i = rho & 15; return 8 * (i >> 2) + 4 * n + (i & 3); }

struct Unit { int pm, pn, e; };

struct StaticOrder {
    static constexpr bool GATHER = false;
    const char* A; const char* Bt; int K; int nM, nN, nwg, G, c;
    __device__ void init(const void* A_, const void* Bt_, int M, int N, int K_, int G_, int c_) { A = (const char*)A_; Bt = (const char*)Bt_; K = K_; nM = M / BM; nN = N / BM; nwg = nM * nN; G = G_; c = c_; }
    __device__ bool next(int i, Unit& u) const {
        const long L = (long)i * G + c; if (L >= nwg) return false;
        int wgid = (int)L; { const int q = nwg / NXCD, r = nwg % NXCD, xcd = wgid % NXCD, off = wgid / NXCD; wgid = (xcd < r ? xcd * (q + 1) : r * (q + 1) + (xcd - r) * q) + off; }
        const int nig = WGM * nN, gid = wgid / nig, fm = gid * WGM, gsz = (nM - fm) < WGM ? (nM - fm) : WGM;
        u.pm = fm + ((wgid % nig) % gsz); u.pn = (wgid % nig) / gsz; u.e = 0; return true;
    }
    __device__ __forceinline__ const char* a_base(const Unit& u) const { return A + (size_t)u.pm * (size_t)(BM * 2) * K; }
    __device__ __forceinline__ const char* b_base(const Unit& u) const { return Bt + (size_t)u.pn * (size_t)(BM * 2) * K; }
    __device__ __forceinline__ void a_voff(int, int, int, int, unsigned (&)[2]) const {}
};

__device__ __forceinline__ unsigned cvt_pk_bf16(float lo, float hi) { unsigned r; asm volatile("v_cvt_pk_bf16_f32 %0, %1, %2" : "=v"(r) : "v"(lo), "v"(hi)); return r; }

template <int K, class Epi, class Sched, bool ALIGN_EPI>
__device__ __forceinline__ void gemm_phase(PG8_LAS unsigned char* lds, const Sched& S, const Epi& E) {
    int tid_ = threadIdx.x; asm volatile("" : "+v"(tid_));
    const int tid = tid_, wid = __builtin_amdgcn_readfirstlane(tid >> 6), lane = tid & 63, wr = wid >> 2, wc = wid & 3, fr = lane & 15, fq = lane >> 4;
    constexpr int nt = K / BK;
    constexpr int NH = Sched::GATHER ? 2 : 1;
    unsigned voffB[2], cvA[NH][2], nvA[NH][2];
#pragma unroll
    for (int i = 0; i < 2; ++i) { int R, C; stage_rc(tid * 16 + i * 8192, R, C); const int Rb = Epi::PERM ? ((R & ~31) + perm32(R & 31)) : R;
        voffB[i] = (unsigned)(Rb * K + C) * 2u;
        cvA[0][i] = nvA[0][i] = (unsigned)(R * K + C) * 2u; if constexpr (NH == 2) { cvA[NH - 1][i] = nvA[NH - 1][i] = cvA[0][i]; } }
    constexpr size_t kstep = (size_t)(BK * 2);
    constexpr size_t hstep = (size_t)HALF * K * 2;
    constexpr size_t hstepA = Sched::GATHER ? (size_t)0 : hstep;
    const unsigned ldsw = (unsigned)wid * 1024u;
    const int aoff = lds_byte(wr * 64 + fr, fq * 8), boff = lds_byte(wc * 32 + fr, fq * 8);
#define PG8_SA(b, h) (((b) * 2 + (h)) * HTB)
#define PG8_SB(b, h) ((4 + (b) * 2 + (h)) * HTB)
#define PG8_STAGE(bufoff, gbase, voff) do { _Pragma("unroll") for (int _i = 0; _i < 2; ++_i) \
        __builtin_amdgcn_global_load_lds((const unsigned*)((const char*)(gbase) + (voff)[_i]), (PG8_LAS unsigned*)(lds + (bufoff) + ldsw + _i * 8192), 16, 0, 0); } while (0)
#define PG8_LDA(dst, b, h) do { _Pragma("unroll") for (int m = 0; m < 4; ++m) _Pragma("unroll") for (int k = 0; k < 2; ++k) dst[m][k] = *(const PG8_LAS bf16x8*)(lds + PG8_SA(b, h) + aoff + m * 2048 + k * 1024); } while (0)
#define PG8_LDB(dst, b, h) do { _Pragma("unroll") for (int n = 0; n < 2; ++n) _Pragma("unroll") for (int k = 0; k < 2; ++k) dst[n][k] = *(const PG8_LAS bf16x8*)(lds + PG8_SB(b, h) + boff + n * 2048 + k * 1024); } while (0)
#define PG8_MMA(ai, bj, At, Bt) do { __builtin_amdgcn_s_setprio(1); _Pragma("unroll") for (int m = 0; m < 4; ++m) _Pragma("unroll") for (int n = 0; n < 2; ++n) _Pragma("unroll") for (int k = 0; k < 2; ++k) \
        acc[ai][bj][m][n] = __builtin_amdgcn_mfma_f32_16x16x32_bf16(Bt[n][k], At[m][k], acc[ai][bj][m][n], 0, 0, 0); __builtin_amdgcn_s_setprio(0); } while (0)
#define PG8_WAIT_V(n) asm volatile("s_waitcnt vmcnt(" #n ")" ::: "memory")
#define PG8_WAIT_L(n) asm volatile("s_waitcnt lgkmcnt(" #n ")" ::: "memory")
#define PG8_BAR __builtin_amdgcn_s_barrier()
#define PG8_SCHED __builtin_amdgcn_sched_barrier(0)
    Unit cur, nxt; int ui = 0;
    if (!S.next(0, cur)) return;
    f32x4 acc[2][2][4][2];
#pragma unroll
    for (int a = 0; a < 2; ++a)
#pragma unroll
        for (int b = 0; b < 2; ++b)
#pragma unroll
            for (int m = 0; m < 4; ++m)
#pragma unroll
                for (int n = 0; n < 2; ++n) acc[a][b][m][n] = (f32x4){0.f, 0.f, 0.f, 0.f};
    bf16x8 At[4][2], B0[2][2], B1[2][2];
    const char* cA = S.a_base(cur); const char* cB = S.b_base(cur);
    if constexpr (Sched::GATHER) {
        int R0, C0, R1, C1; stage_rc(tid * 16, R0, C0); stage_rc(tid * 16 + 8192, R1, C1);
#pragma unroll
        for (int h = 0; h < 2; ++h) { unsigned v[2]; S.a_voff(0, h, R0, R1, v); cvA[h][0] = v[0] + (unsigned)C0 * 2u; cvA[h][1] = v[1] + (unsigned)C1 * 2u; }
    }
    PG8_STAGE(PG8_SB(0, 0), cB, voffB); PG8_STAGE(PG8_SB(0, 1), cB + hstep, voffB); PG8_STAGE(PG8_SA(0, 0), cA, cvA[0]); PG8_STAGE(PG8_SA(0, 1), cA + hstepA, cvA[NH - 1]);
    if (wr == 1) PG8_BAR;
    PG8_WAIT_V(2); PG8_BAR;
    PG8_STAGE(PG8_SB(1, 0), cB + kstep, voffB); PG8_STAGE(PG8_SA(1, 0), cA + kstep, cvA[0]); PG8_STAGE(PG8_SB(1, 1), cB + hstep + kstep, voffB);
    PG8_WAIT_V(6); PG8_BAR;
    for (;;) {
        const bool has_next = S.next(ui + 1, nxt);
        const char* nA = has_next ? S.a_base(nxt) : cA; const char* nB = has_next ? S.b_base(nxt) : cB;
        if constexpr (Sched::GATHER) {
            if (has_next) {
                int t2 = threadIdx.x; asm volatile("" : "+v"(t2));
                int R0, C0, R1, C1; stage_rc(t2 * 16, R0, C0); stage_rc(t2 * 16 + 8192, R1, C1);
#pragma unroll
                for (int h = 0; h < 2; ++h) { unsigned v[2]; S.a_voff(ui + 1, h, R0, R1, v); nvA[h][0] = v[0] + (unsigned)C0 * 2u; nvA[h][1] = v[1] + (unsigned)C1 * 2u; }
            } else {
#pragma unroll
                for (int h = 0; h < 2; ++h) { nvA[h][0] = cvA[h][0]; nvA[h][1] = cvA[h][1]; }
            }
        }
        for (int t = 0; t < nt; t += 2) {
            const bool last = (t == nt - 2);
            const char* a1 = cA + (size_t)(t + 1) * kstep;
            const char* a2 = last ? nA : cA + (size_t)(t + 2) * kstep; const char* b2 = last ? nB : cB + (size_t)(t + 2) * kstep;
            const char* a3 = a2 + kstep; const char* b3 = b2 + kstep;
            unsigned v2[NH][2];
#pragma unroll
            for (int h = 0; h < NH; ++h) { if constexpr (Sched::GATHER) { v2[h][0] = last ? nvA[h][0] : cvA[h][0]; v2[h][1] = last ? nvA[h][1] : cvA[h][1]; } else { v2[h][0] = cvA[h][0]; v2[h][1] = cvA[h][1]; } }
            PG8_LDB(B0, 0, 0); PG8_LDB(B1, 0, 1); PG8_SCHED; PG8_LDA(At, 0, 0); PG8_STAGE(PG8_SA(1, 1), a1 + hstepA, cvA[NH - 1]);
            PG8_WAIT_V(8); PG8_WAIT_L(0); PG8_BAR; PG8_MMA(0, 0, At, B0); PG8_MMA(0, 1, At, B1); PG8_BAR; PG8_SCHED;
            PG8_LDA(At, 0, 1); PG8_STAGE(PG8_SB(0, 0), b2, voffB); PG8_STAGE(PG8_SB(0, 1), b2 + hstep, voffB); PG8_STAGE(PG8_SA(0, 0), a2, v2[0]);
            PG8_WAIT_V(8); PG8_WAIT_L(0); PG8_BAR; PG8_MMA(1, 0, At, B0); PG8_MMA(1, 1, At, B1); PG8_BAR; PG8_SCHED;
            PG8_LDB(B0, 1, 0); PG8_LDB(B1, 1, 1); PG8_SCHED; PG8_LDA(At, 1, 0); PG8_STAGE(PG8_SA(0, 1), a2 + hstepA, v2[NH - 1]);
            PG8_WAIT_V(8); PG8_WAIT_L(0); PG8_BAR; PG8_MMA(0, 0, At, B0); PG8_MMA(0, 1, At, B1); PG8_BAR; PG8_SCHED;
            PG8_LDA(At, 1, 1); PG8_STAGE(PG8_SB(1, 0), b3, voffB); PG8_STAGE(PG8_SB(1, 1), b3 + hstep, voffB); PG8_STAGE(PG8_SA(1, 0), a3, v2[0]);
            PG8_WAIT_V(8); PG8_WAIT_L(0); PG8_BAR; PG8_MMA(1, 0, At, B0); PG8_MMA(1, 1, At, B1); PG8_BAR; PG8_SCHED;
        }
        if constexpr (ALIGN_EPI) { if (wr == 0) PG8_BAR; }
        E(acc, cur, ui, wr, wc, fr, fq);
        if (!has_next) break;
#pragma unroll
        for (int a = 0; a < 2; ++a)
#pragma unroll
            for (int b = 0; b < 2; ++b)
#pragma unroll
                for (int m = 0; m < 4; ++m)
#pragma unroll
                    for (int n = 0; n < 2; ++n) acc[a][b][m][n] = (f32x4){0.f, 0.f, 0.f, 0.f};
        cur = nxt; cA = nA; cB = nB; ++ui;
        if constexpr (Sched::GATHER) {
#pragma unroll
            for (int h = 0; h < NH; ++h) { cvA[h][0] = nvA[h][0]; cvA[h][1] = nvA[h][1]; }
        }
        if constexpr (ALIGN_EPI) { if (wr == 1) PG8_BAR; }
    }
    PG8_WAIT_V(0);
    if constexpr (!ALIGN_EPI) { if (wr == 0) PG8_BAR; }
    PG8_BAR;
#undef PG8_SA
#undef PG8_SB
#undef PG8_STAGE
#undef PG8_LDA
#undef PG8_LDB
#undef PG8_MMA
#undef PG8_WAIT_V
#undef PG8_WAIT_L
#undef PG8_BAR
#undef PG8_SCHED
}
}
#define GAS __attribute__((address_space(1)))
typedef float f32x4 __attribute__((ext_vector_type(4)));
typedef float f32x16 __attribute__((ext_vector_type(16)));
typedef short bf16x8 __attribute__((ext_vector_type(8)));
typedef unsigned v4u __attribute__((ext_vector_type(4)));
typedef unsigned v2u __attribute__((ext_vector_type(2)));
#define LDS_WAIT() asm volatile("s_waitcnt lgkmcnt(0)" ::: "memory")
#define VM_WAIT() asm volatile("s_waitcnt vmcnt(0)" ::: "memory")
__device__ __forceinline__ unsigned pk2(float lo, float hi) { return f2bf(lo) | (f2bf(hi) << 16); }

constexpr int NWAVES = 8, NTHR = 512;
constexpr int LDS_STAGE = 0;
constexpr int LDS_RS = 131072;
constexpr int LDS_ROWTOK = LDS_RS + 8192;
constexpr int LDS_GATE = LDS_ROWTOK + 8192;
constexpr int LDS_MISC = LDS_GATE + 8192;
constexpr int LDS_BYTES = LDS_MISC + 256;
constexpr size_t WO_IN = 0, WO_SM = 6 * MiB, WO_RHI = 6 * MiB + 65536, WO_RLO = 6 * MiB + 131072, WO_OUT = 7 * MiB, WO_XQ = 9 * MiB, WO_XO = 10 * MiB, WO_GU = 11 * MiB, WO_D = 43 * MiB;
static_assert(WO_D + 16 * MiB <= WS_WLAYER, "weight block");
constexpr int CW_BAR = 4096;
constexpr int MAX_LAUNCH = 40;
static_assert((CW_BAR + MAX_LAUNCH * XCD_BAR_WORDS) * 4 <= (int)(1 * MiB), "ctl");

enum { PH_PRO = 0, PH_XKV = 1, PH_L0 = 2, NPH = 13, PH_FINAL = PH_L0 + NLAYER * NPH, PH_END = PH_FINAL + 1 };
enum { LP_INPROJ = 0, LP_MIXA, LP_MIXB, LP_MIXC, LP_WOUT, LP_XQ, LP_XATTN, LP_XO, LP_ROUTE, LP_SORT, LP_GU, LP_DOWN0, LP_DOWN1 };

struct Args { P p; int ph_lo, ph_hi, li, pad; };

template <bool HAS_RS> struct EpiBf16 {
    static constexpr bool PERM = true;
    bf16* O; int ldc; const LAS float* rstab;
    __device__ __forceinline__ void operator()(const pg8::f32x4 (&acc)[2][2][4][2], const pg8::Unit& u, int iu, int wr, int wc, int fr, int fq) const {
#pragma unroll
        for (int ai = 0; ai < 2; ++ai)
#pragma unroll
            for (int m = 0; m < 4; ++m) {
                const int lrow = ai * 128 + wr * 64 + m * 16 + fr;
                float sc = 1.f; if (HAS_RS) sc = rstab[iu * 256 + lrow];
                bf16* rowp = O + (size_t)(u.pm * 256 + lrow) * ldc + u.pn * 256 + wc * 32 + 8 * fq;
#pragma unroll
                for (int bj = 0; bj < 2; ++bj) { const pg8::f32x4 v0 = acc[ai][bj][m][0] * sc, v1 = acc[ai][bj][m][1] * sc;
                    pg8::u32x4 w; w.x = pg8::cvt_pk_bf16(v0[0], v0[1]); w.y = pg8::cvt_pk_bf16(v0[2], v0[3]); w.z = pg8::cvt_pk_bf16(v1[0], v1[1]); w.w = pg8::cvt_pk_bf16(v1[2], v1[3]);
                    st_b128(rowp + bj * 128, w); }
            }
    }
};
struct EpiGU {
    static constexpr bool PERM = true;
    bf16* U; const LAS float* rstab;
    __device__ __forceinline__ void operator()(const pg8::f32x4 (&acc)[2][2][4][2], const pg8::Unit& u, int iu, int wr, int wc, int fr, int fq) const {
#pragma unroll
        for (int ai = 0; ai < 2; ++ai)
#pragma unroll
            for (int m = 0; m < 4; ++m) {
                const int lrow = ai * 128 + wr * 64 + m * 16 + fr;
                const float sc = rstab[iu * 256 + lrow];
                float o[8];
#pragma unroll
                for (int n = 0; n < 2; ++n)
#pragma unroll
                    for (int j = 0; j < 4; ++j) { const float g = acc[ai][0][m][n][j] * sc, uu = acc[ai][1][m][n][j] * sc; o[n * 4 + j] = g * uu * __builtin_amdgcn_rcpf(1.f + __expf(-g)); }
                pg8::u32x4 w; w.x = pg8::cvt_pk_bf16(o[0], o[1]); w.y = pg8::cvt_pk_bf16(o[2], o[3]); w.z = pg8::cvt_pk_bf16(o[4], o[5]); w.w = pg8::cvt_pk_bf16(o[6], o[7]);
                st_b128(U + (size_t)(u.pm * 256 + lrow) * 512 + u.pn * 128 + wc * 32 + 8 * fq, w);
            }
    }
};
template <int MODE> struct EpiRes {
    static constexpr bool PERM = false;
    static constexpr bool MOE = MODE != 0;
    bf16* hb; float* ssq; const LAS int* rowtab; const LAS float* gatetab; float gs; bf16* t0;
    __device__ __forceinline__ void operator()(const pg8::f32x4 (&acc)[2][2][4][2], const pg8::Unit& u, int iu, int wr, int wc, int fr, int fq) const {
#pragma unroll
        for (int ai = 0; ai < 2; ++ai)
#pragma unroll
            for (int m = 0; m < 4; ++m) {
                const int lrow = ai * 128 + wr * 64 + m * 16 + fr;
                int row = u.pm * 256 + lrow; float g = gs;
                if (MOE) { row = rowtab[iu * 256 + lrow]; g = gatetab[iu * 256 + lrow] * gs; }
                const bool ok = !MOE || row >= 0;
                const size_t off = (size_t)(ok ? row : 0) * DM + u.pn * 256 + wc * 32 + 4 * fq;
                float q = 0.f;
                if (ok) {
#pragma unroll
                    for (int bj = 0; bj < 2; ++bj)
#pragma unroll
                        for (int n = 0; n < 2; ++n) {
                            if (MODE == 1) { const pg8::f32x4 o = acc[ai][bj][m][n] * g; pg8::u32x2 w; w.x = pg8::cvt_pk_bf16(o[0], o[1]); w.y = pg8::cvt_pk_bf16(o[2], o[3]); st_b64(t0 + off + bj * 128 + n * 16, w); }
                            else {
                                const pg8::u32x2 bw = *(const pg8::u32x2*)(hb + off + bj * 128 + n * 16);
                                pg8::f32x4 bs; bs[0] = __builtin_bit_cast(float, bw.x << 16); bs[1] = __builtin_bit_cast(float, bw.x & 0xffff0000u); bs[2] = __builtin_bit_cast(float, bw.y << 16); bs[3] = __builtin_bit_cast(float, bw.y & 0xffff0000u);
                                if (MODE == 2) { const pg8::u32x2 tw = *(const pg8::u32x2*)(t0 + off + bj * 128 + n * 16);
                                    bs[0] += __builtin_bit_cast(float, tw.x << 16); bs[1] += __builtin_bit_cast(float, tw.x & 0xffff0000u); bs[2] += __builtin_bit_cast(float, tw.y << 16); bs[3] += __builtin_bit_cast(float, tw.y & 0xffff0000u); }
                                const pg8::f32x4 o = bs + acc[ai][bj][m][n] * g;
                                pg8::u32x2 w; w.x = pg8::cvt_pk_bf16(o[0], o[1]); w.y = pg8::cvt_pk_bf16(o[2], o[3]);
                                const float r0 = __builtin_bit_cast(float, w.x << 16), r1 = __builtin_bit_cast(float, w.x & 0xffff0000u), r2 = __builtin_bit_cast(float, w.y << 16), r3 = __builtin_bit_cast(float, w.y & 0xffff0000u);
                                q += (r0 * r0 + r1 * r1) + (r2 * r2 + r3 * r3);
                                st_b64(hb + off + bj * 128 + n * 16, w); } }
                }
                if (MODE != 1) { q += __shfl_xor(q, 16); q += __shfl_xor(q, 32); if (fq == 0 && ok) ssq[(size_t)row * 16 + u.pn * 4 + wc] = q; }
            }
    }
};
template <bool GATH> struct MoeOrder {
    static constexpr bool GATHER = GATH;
    const char* A; const char* Bt; int K; size_t estride; int lo, hi, G, c; const int* tilee; const LAS int* rowtab;
    __device__ bool next(int i, pg8::Unit& u) const { const int L = i * G + c, t = lo + (L >> 2); if (t >= hi) return false; u.pm = t; u.pn = L & 3; u.e = tilee[t]; return true; }
    __device__ __forceinline__ const char* a_base(const pg8::Unit& u) const { return GATH ? A : A + (size_t)u.pm * (size_t)512 * K; }
    __device__ __forceinline__ const char* b_base(const pg8::Unit& u) const { return Bt + (size_t)u.e * estride + (size_t)u.pn * (size_t)512 * K; }
    __device__ __forceinline__ void a_voff(int iu, int h, int R0, int R1, unsigned (&v)[2]) const { v[0] = (unsigned)rowtab[iu * 256 + h * 128 + R0] * (unsigned)(K * 2); v[1] = (unsigned)rowtab[iu * 256 + h * 128 + R1] * (unsigned)(K * 2); }
};

__device__ __forceinline__ void router_weights(const P& p, int gtid, int gstride);
__device__ __forceinline__ void tr_item(const float* W, int N, int K, int k0, int n0, const float* gain, float scale, bf16* dst, LAS float* scr, int lane) {
    const int kr = lane >> 3, c4 = lane & 7;
    f32x4 v[8];
#pragma unroll
    for (int i = 0; i < 8; ++i) v[i] = *(const f32x4*)(W + (size_t)(k0 + 8 * i + kr) * N + n0 + 4 * c4);
#pragma unroll
    for (int i = 0; i < 8; ++i) { const int kk = 8 * i + kr; float g = scale; if (gain) g *= gain[k0 + kk];
        LAS float* d = scr + kk * 33 + 4 * c4; d[0] = v[i].x * g; d[1] = v[i].y * g; d[2] = v[i].z * g; d[3] = v[i].w * g; }
    LDS_WAIT();
    const int c = lane & 7;
#pragma unroll
    for (int j = 0; j < 4; ++j) { const int n = (lane >> 3) + 8 * j; const LAS float* s = scr + (8 * c) * 33 + n;
        v4u o; o.x = pk2(s[0 * 33], s[1 * 33]); o.y = pk2(s[2 * 33], s[3 * 33]); o.z = pk2(s[4 * 33], s[5 * 33]); o.w = pk2(s[6 * 33], s[7 * 33]);
        st_b128(dst + (size_t)n * K + k0 + 8 * c, o); }
    LDS_WAIT();
}
constexpr int IT_LAYER = 15360;
__device__ __forceinline__ void prologue_item(const P& p, int it, LAS float* scr, int lane) {
    const int l = it / IT_LAYER; int r = it % IT_LAYER;
    unsigned char* wl = ws_base(p.ws) + WS_W + (size_t)l * WS_WLAYER;
    if (r < 1536) {
        const int seg = r / 768; r %= 768; const int kb = r / 48, nb = r % 48; const int n0 = (seg ? 1544 : 0) + 32 * nb, drow = seg * 1536 + 32 * nb;
        const float sc = drow < 512 ? 0.125f * LOG2E : ((drow >= C_GQ && drow < C_GK) ? 0.125f : 1.f);
        tr_item(p.w_in + (size_t)l * DM * INW, INW, DM, 64 * kb, n0, p.mix_norm + l * DM, sc, (bf16*)(wl + WO_IN) + (size_t)drow * DM, scr, lane); return; }
    r -= 1536;
    if (r < 512) { const int kb = r / 32, nb = r % 32; tr_item(p.w_out + (size_t)l * DM * DM, DM, DM, 64 * kb, 32 * nb, nullptr, 1.f, (bf16*)(wl + WO_OUT) + (size_t)(32 * nb) * DM, scr, lane); return; }
    r -= 512;
    if (r < 256) { const int kb = r / 16, nb = r % 16; tr_item(p.w_xq + (size_t)l * DM * 512, 512, DM, 64 * kb, 32 * nb, p.cross_norm + l * DM, 0.08838834764831845f * LOG2E, (bf16*)(wl + WO_XQ) + (size_t)(32 * nb) * DM, scr, lane); return; }
    r -= 256;
    if (r < 256) { const int kb = r / 32, nb = r % 32; tr_item(p.w_xo + (size_t)l * 512 * DM, DM, 512, 64 * kb, 32 * nb, nullptr, 1.f, (bf16*)(wl + WO_XO) + (size_t)(32 * nb) * 512, scr, lane); return; }
    r -= 256;
    if (r < 512) { const int kv = r / 256; r %= 256; const int kb = r / 16, nb = r % 16;
        tr_item((kv ? p.w_xv : p.w_xk) + (size_t)l * DM * 512, 512, DM, 64 * kb, 32 * nb, nullptr, 1.f, (bf16*)(ws_base(p.ws) + WS_WXKV) + (size_t)(l * 1024 + kv * 512 + 32 * nb) * DM, scr, lane); return; }
    r -= 512;
    if (r < 8192) { const int up = r / 4096; r %= 4096; const int e = r / 256; r %= 256; const int kb = r / 16, nb = r % 16; const int c0 = 32 * nb, drow = (c0 >> 7) * 256 + up * 128 + (c0 & 127);
        tr_item((up ? p.w_eu : p.w_eg) + ((size_t)l * 16 + e) * DM * 512, 512, DM, 64 * kb, c0, p.moe_norm + l * DM, 1.f, (bf16*)(wl + WO_GU) + ((size_t)e * 1024 + drow) * DM, scr, lane); return; }
    r -= 8192;
    { const int e = r / 256; r %= 256; const int kb = r / 32, nb = r % 32;
      tr_item(p.w_ed + ((size_t)l * 16 + e) * 512 * DM, DM, 512, 64 * kb, 32 * nb, nullptr, 1.f, (bf16*)(wl + WO_D) + ((size_t)e * 1024 + 32 * nb) * 512, scr, lane); }
}
__device__ __forceinline__ void row_to_bf16(const float* src, bf16* dst, float* ssq, const float* gain, int lane, int mode) {
    const f32x4* s = (const f32x4*)src + lane;
    f32x4 v[4]; float q = 0.f;
#pragma unroll
    for (int j = 0; j < 4; ++j) { v[j] = s[64 * j]; q += (v[j].x * v[j].x + v[j].y * v[j].y) + (v[j].z * v[j].z + v[j].w * v[j].w); }
    q = wave_sum(q);
    float sc = 1.f;
    if (mode == 1) sc = rsqrtf(q * (1.0f / DM) + EPS);
    v2u* d = (v2u*)dst + lane; float q2 = 0.f;
#pragma unroll
    for (int j = 0; j < 4; ++j) {
        f32x4 g = (f32x4){1.f, 1.f, 1.f, 1.f}; if (mode == 1) g = ((const f32x4*)gain)[lane + 64 * j];
        v2u o; o.x = pk2(v[j].x * sc * g.x, v[j].y * sc * g.y); o.y = pk2(v[j].z * sc * g.z, v[j].w * sc * g.w); st_b64(d + 64 * j, o);
        const float r0 = __builtin_bit_cast(float, o.x << 16), r1 = __builtin_bit_cast(float, o.x & 0xffff0000u), r2 = __builtin_bit_cast(float, o.y << 16), r3 = __builtin_bit_cast(float, o.y & 0xffff0000u);
        q2 += (r0 * r0 + r1 * r1) + (r2 * r2 + r3 * r3); }
    if (mode == 0) { q2 = wave_sum(q2); if (lane < 16) ssq[lane] = lane == 0 ? q2 : 0.f; }
}
__device__ __forceinline__ void prologue(const P& p, LAS unsigned char* lds, int vcu, int G, int wave, int lane) {
    asm volatile("" : "+v"(lane));
    LAS float* scr = (LAS float*)(lds + LDS_STAGE + wave * 16384);
    const int gw = vcu * NWAVES + wave, NGW = G * NWAVES;
    for (int it = gw; it < NLAYER * IT_LAYER; it += NGW) prologue_item(p, it, scr, lane);
    for (int idx = gw * 64 + lane; idx < NLAYER * 2 * 32768; idx += NGW * 64) {
        const int l = idx / 65536, r = idx % 65536, which = r / 32768, e = r % 32768, row = e / 1024, k = e % 1024;
        unsigned char* wl = ws_base(p.ws) + WS_W + (size_t)l * WS_WLAYER;
        if (which == 0) {
            float v = 0.f;
            if (row < 8) v = p.w_in[((size_t)l * DM + k) * INW + 1536 + row]; else if (row < 24) v = p.w_in[((size_t)l * DM + k) * INW + 3080 + (row - 8)];
            ((bf16*)(wl + WO_SM))[row * 1024 + k] = (bf16)f2bf(v * p.mix_norm[l * DM + k]);
        }
    }
    router_weights(p, gw * 64 + lane, NGW * 64);
    for (int m = gw; m < 4096; m += NGW) row_to_bf16(p.mem + (size_t)m * DM, WSP(bf16, WS_MEMN) + (size_t)m * DM, nullptr, p.mem_norm, lane, 1);
    for (int m = gw; m < NTOK; m += NGW) row_to_bf16(p.x + (size_t)m * DM, WSP(bf16, WS_HB) + (size_t)m * DM, WSP(float, WS_SSQ) + (size_t)m * 16, nullptr, lane, 0);
}
__device__ __forceinline__ void small_proj(const P& p, int l, int vcu, int G, int wave, int lane) {
    asm volatile("" : "+v"(lane));
    const int gw = vcu * NWAVES + wave, NGW = G * NWAVES;
    const bf16* wsm = (const bf16*)(ws_base(p.ws) + WS_W + (size_t)l * WS_WLAYER + WO_SM);
    const bf16* hb = WSP(bf16, WS_HB); const float* ssq = WSP(float, WS_SSQ); float* sm = WSP(float, WS_SM);
    const int r = lane & 31, hh = lane >> 5;
    for (int blk = gw; blk < NTOK / 32; blk += NGW) {
        const int tok0 = blk * 32;
        const bf16x8* ap = (const bf16x8*)(hb + (size_t)(tok0 + r) * DM + hh * 32);
        const bf16x8* bp = (const bf16x8*)(wsm + (size_t)r * DM + hh * 32);
        f32x16 acc = {};
#pragma unroll 2
        for (int s = 0; s < 16; ++s) {
#pragma unroll
            for (int j = 0; j < 4; ++j) acc = __builtin_amdgcn_mfma_f32_32x32x16_bf16(ap[s * 8 + j], bp[s * 8 + j], acc, 0, 0, 0);
        }
        const float rsv = row_rs(ssq, tok0 + r);
#pragma unroll
        for (int g = 0; g < 16; ++g) { const int trow = (g & 3) + 8 * (g >> 2) + 4 * hh; const float rs = __shfl(rsv, trow); if (r < 24) sm[(size_t)(tok0 + trow) * 32 + r] = acc[g] * rs; }
    }
}
typedef short v4i16_t __attribute__((ext_vector_type(4)));
typedef __bf16 bf16x2_t __attribute__((ext_vector_type(2)));
typedef float f32x2_t __attribute__((ext_vector_type(2)));
__device__ __forceinline__ unsigned cvtpk(float lo, float hi) { f32x2_t v = {lo, hi}; bf16x2_t b = __builtin_convertvector(v, bf16x2_t); return __builtin_bit_cast(unsigned, b); }
__device__ __forceinline__ bf16x8 pack8(const f32x16& p, int o) {
    v4u w; w.x = cvtpk(p[o], p[o + 1]); w.y = cvtpk(p[o + 2], p[o + 3]); w.z = cvtpk(p[o + 4], p[o + 5]); w.w = cvtpk(p[o + 6], p[o + 7]);
    return __builtin_bit_cast(bf16x8, w);
}
template <int D, bool FOX>
__device__ __forceinline__ void attn_unit(LAS unsigned char* lds, const bf16* Qg, int qpitch, const bf16* Kg, const bf16* Vg, int kvpitch, int NT,
                                          const float* cb, int q0, bf16* Og, int opitch, const float* gain) {
    constexpr int KS = D * 2 + 16, VS = D * 2 + 64;
    constexpr int KBYTES = 64 * KS, VBYTES = 64 * VS;
    constexpr int CPR = D / 8, NCH = 64 * CPR / NTHR, NS = D / 16, NDB = D / 32;
    constexpr int OFF_K = 0, OFF_V = 2 * KBYTES, OFF_CB = 2 * KBYTES + 2 * VBYTES;
    int tid = threadIdx.x; asm volatile("" : "+v"(tid));
    const int lane = tid & 63, wave = __builtin_amdgcn_readfirstlane(tid >> 6), r32 = lane & 31, hh = lane >> 5;
    bf16x8 qf[NS];
    { const bf16* qrow = Qg + (size_t)(wave * 32 + r32) * qpitch;
#pragma unroll
      for (int s = 0; s < NS; ++s) qf[s] = *(const bf16x8*)(qrow + 16 * s + 8 * hh); }
    v4u kreg[NCH], vreg[NCH]; f32x4 cbreg = {0.f, 0.f, 0.f, 0.f};
#define AT_GLOAD(t) do { _Pragma("unroll") for (int i_ = 0; i_ < NCH; ++i_) { const int idx_ = tid + NTHR * i_, key_ = idx_ / CPR, c_ = idx_ % CPR; \
        kreg[i_] = *(const v4u*)(Kg + (size_t)((t) * 64 + key_) * kvpitch + c_ * 8); vreg[i_] = *(const v4u*)(Vg + (size_t)((t) * 64 + key_) * kvpitch + c_ * 8); } \
        if (FOX && tid < 16) cbreg = *(const f32x4*)(cb + (t) * 64 + tid * 4); } while (0)
#define AT_LSTORE(b) do { _Pragma("unroll") for (int i_ = 0; i_ < NCH; ++i_) { const int idx_ = tid + NTHR * i_, key_ = idx_ / CPR, c_ = idx_ % CPR; \
        *(LAS v4u*)(lds + OFF_K + (b) * KBYTES + key_ * KS + c_ * 16) = kreg[i_]; *(LAS v4u*)(lds + OFF_V + (b) * VBYTES + key_ * VS + c_ * 16) = vreg[i_]; } \
        if (FOX && tid < 16) *(LAS f32x4*)(lds + OFF_CB + (b) * 256 + tid * 16) = cbreg; } while (0)
    float m = -INFINITY, l = 0.f;
    f32x16 o[NDB];
#pragma unroll
    for (int d = 0; d < NDB; ++d) o[d] = f32x16{};
    const int qlo = q0 + wave * 32, qabs = qlo + r32;
    AT_GLOAD(0); AT_LSTORE(0);
    __syncthreads();
#pragma unroll 1
    for (int t = 0; t < NT; ++t) {
        const int b = t & 1;
        if (t + 1 < NT) AT_GLOAD(t + 1);
        const int kt0 = t * 64;
        if (!FOX || kt0 <= qlo + 31) {
            f32x16 p[2];
#pragma unroll
            for (int kb = 0; kb < 2; ++kb) {
                if (FOX) {
#pragma unroll
                    for (int g = 0; g < 4; ++g) { const f32x4 c4 = *(const LAS f32x4*)(lds + OFF_CB + b * 256 + (kb * 32 + 8 * g + 4 * hh) * 4); p[kb][4 * g] = c4.x; p[kb][4 * g + 1] = c4.y; p[kb][4 * g + 2] = c4.z; p[kb][4 * g + 3] = c4.w; }
                } else p[kb] = f32x16{};
                const LAS unsigned char* kp = lds + OFF_K + b * KBYTES + (kb * 32 + r32) * KS + hh * 16;
#pragma unroll
                for (int s = 0; s < NS; ++s) { const bf16x8 kf = *(const LAS bf16x8*)(kp + s * 32); p[kb] = __builtin_amdgcn_mfma_f32_32x32x16_bf16(kf, qf[s], p[kb], 0, 0, 0); }
            }
            if (FOX && kt0 + 63 > qlo) {
#pragma unroll
                for (int kb = 0; kb < 2; ++kb)
#pragma unroll
                    for (int r = 0; r < 16; ++r) { const int key = kt0 + kb * 32 + (r & 3) + 8 * (r >> 2) + 4 * hh; if (key > qabs) p[kb][r] = -INFINITY; }
            }
            float mt = fmaxf(p[0][0], p[1][0]);
#pragma unroll
            for (int r = 1; r < 16; ++r) mt = fmaxf(mt, fmaxf(p[0][r], p[1][r]));
            mt = fmaxf(mt, __shfl_xor(mt, 32));
            const float mnew = fmaxf(m, mt);
            const float alpha = __builtin_amdgcn_exp2f(m - mnew);
            float ls = 0.f;
#pragma unroll
            for (int kb = 0; kb < 2; ++kb)
#pragma unroll
                for (int r = 0; r < 16; ++r) { const float e = __builtin_amdgcn_exp2f(p[kb][r] - mnew); p[kb][r] = e; ls += e; }
            m = mnew; l = l * alpha + ls;
#pragma unroll
            for (int d = 0; d < NDB; ++d)
#pragma unroll
                for (int r = 0; r < 16; ++r) o[d][r] *= alpha;
            bf16x8 pa[2][2];
#pragma unroll
            for (int kb = 0; kb < 2; ++kb) { pa[kb][0] = pack8(p[kb], 0); pa[kb][1] = pack8(p[kb], 8); }
            const LAS unsigned char* vp = lds + OFF_V + b * VBYTES + (4 * hh + ((lane & 15) >> 2)) * VS + (16 * ((lane >> 4) & 1) + 4 * (lane & 3)) * 2;
#pragma unroll
            for (int d = 0; d < NDB; ++d) {
#pragma unroll
                for (int kb = 0; kb < 2; ++kb)
#pragma unroll
                    for (int ks = 0; ks < 2; ++ks) {
                        const LAS unsigned char* a0 = vp + (kb * 32 + 16 * ks) * VS + d * 64;
                        const v4i16_t lo = __builtin_amdgcn_ds_read_tr16_b64_v4i16((LAS v4i16_t*)a0);
                        const v4i16_t hi = __builtin_amdgcn_ds_read_tr16_b64_v4i16((LAS v4i16_t*)(a0 + 8 * VS));
                        const bf16x8 vf = (bf16x8){lo[0], lo[1], lo[2], lo[3], hi[0], hi[1], hi[2], hi[3]};
                        o[d] = __builtin_amdgcn_mfma_f32_32x32x16_bf16(vf, pa[kb][ks], o[d], 0, 0, 0);
                    }
            }
        }
        if (t + 1 < NT) AT_LSTORE(b ^ 1);
        __syncthreads();
    }
#undef AT_GLOAD
#undef AT_LSTORE
    l += __shfl_xor(l, 32);
    const float inv = 1.0f / l;
    float rs = inv;
    if (FOX) {
        float ss = 0.f;
#pragma unroll
        for (int d = 0; d < NDB; ++d)
#pragma unroll
            for (int r = 0; r < 16; ++r) { const float v = o[d][r] * inv; ss += v * v; }
        ss += __shfl_xor(ss, 32);
        rs = inv * rsqrtf(ss * (1.0f / D) + EPS);
    }
    bf16* orow = Og + (size_t)(wave * 32 + r32) * opitch;
#pragma unroll
    for (int d = 0; d < NDB; ++d)
#pragma unroll
        for (int g = 0; g < 4; ++g) {
            f32x4 gn = {1.f, 1.f, 1.f, 1.f}; if (FOX) gn = *(const f32x4*)(gain + 32 * d + 8 * g + 4 * hh);
            v2u w; w.x = cvtpk(o[d][4 * g] * rs * gn.x, o[d][4 * g + 1] * rs * gn.y); w.y = cvtpk(o[d][4 * g + 2] * rs * gn.z, o[d][4 * g + 3] * rs * gn.w);
            st_b64(orow + 32 * d + 8 * g + 4 * hh, w);
        }
}
__device__ __forceinline__ void fox_phase(const P& p, int l, LAS unsigned char* lds, int vcu, int G) {
    const bf16* proj = WSP(bf16, WS_PROJ); const float* cb = WSP(float, WS_CB); bf16* y = WSP(bf16, WS_Y);
    for (int pu = vcu; pu < 512; pu += G) {
        const int bh = pu >> 2, pr = pu & 3, b = bh >> 3, h = bh & 7;
        for (int half = 0; half < 2; ++half) {
            const int qb = half ? pr : 7 - pr;
            const size_t row0 = (size_t)b * SEQ;
            attn_unit<64, true>(lds, proj + (row0 + qb * 256) * PW + C_FQ + h * 64, PW, proj + row0 * PW + C_FK + h * 64, proj + row0 * PW + C_FV + h * 64, PW, 4 * (qb + 1),
                                cb + ((size_t)b * 8 + h) * SEQ, qb * 256, y + (row0 + qb * 256) * DM + h * 64, DM, p.fox_gain + l * 512 + h * 64);
        }
    }
}
__device__ __forceinline__ void xattn_phase(const P& p, int l, LAS unsigned char* lds, int vcu, int G, bool dummy) {
    bf16* xq = WSP(bf16, WS_XQ); const bf16* xkv = WSP(bf16, WS_XKV);
    for (int u = vcu; u < 512; u += G) {
        const int b = u >> 5, h = (u >> 3) & 3, qb = u & 7;
        bf16* qp = xq + ((size_t)b * SEQ + qb * 256) * 512 + h * 128;
        const bf16* kp = xkv + (size_t)b * MEML * 2048 + l * 1024 + h * 128;
        attn_unit<128, false>(lds, qp, 512, kp, kp + 512, 2048, 4, nullptr, 0, dummy ? WSP(bf16, WS_Y) + (qp - xq) : qp, 512, nullptr);
    }
}
constexpr size_t WS_GB = WS_END;
constexpr size_t WS_GDEC = WS_GB + 32 * MiB;
constexpr size_t WS_END2 = WS_GDEC + 1 * MiB;
static_assert(WS_END2 <= 512 * MiB, "workspace map 2");
constexpr int GL_B = 0;
constexpr int GL_TOT = 16384;
constexpr int GL_Q1 = 18432, GL_Q2 = GL_Q1 + 64 * 144, GL_K2 = GL_Q2 + 64 * 144;
constexpr int GL_KD = GL_K2 + 64 * 144;
constexpr int GL_V = GL_KD + 64 * 192;
constexpr int GL_SSQ = GL_V + 64 * 320;
constexpr int GL_GA = GL_SSQ + 1024;
constexpr int GL_END = GL_GA + 4096;
static_assert(GL_END <= 131072, "gla lds");

__device__ __forceinline__ float fast_log_sigmoid(float z) { return fminf(z, 0.f) - __logf(1.f + __expf(-fabsf(z))); }
__device__ __forceinline__ void gla_decay(const P& p, int l, int h, size_t tok0, LAS unsigned char* lds, int lane, int wave) {
    const float* sm = WSP(float, WS_SM);
    float w[16];
#pragma unroll
    for (int r = 0; r < 16; ++r) w[r] = p.w_alpha_up[((size_t)l * 16 + r) * 256 + h * 64 + lane];
    const float bias = p.b_alpha[l * 256 + h * 64 + lane];
    LAS f32x4* gat = (LAS f32x4*)(lds + GL_GA + wave * 512);
    if (lane < 32) gat[lane] = *(const f32x4*)(sm + (tok0 + wave * 8 + (lane >> 2)) * 32 + 8 + 4 * (lane & 3));
    float bl[8]; float run = 0.f;
#pragma unroll
    for (int j = 0; j < 8; ++j) {
        float z = bias;
#pragma unroll
        for (int r4 = 0; r4 < 4; ++r4) { const f32x4 g4 = gat[j * 4 + r4]; z += g4.x * w[4 * r4] + g4.y * w[4 * r4 + 1] + g4.z * w[4 * r4 + 2] + g4.w * w[4 * r4 + 3]; }
        run += fast_log_sigmoid(z) * (1.0f / 16.0f); bl[j] = run;
    }
    LAS float* tot = (LAS float*)(lds + GL_TOT);
    tot[wave * 64 + lane] = run;
    __syncthreads();
    float pre = 0.f;
#pragma unroll
    for (int g = 0; g < 8; ++g) { const float t = tot[g * 64 + lane]; if (g < wave) pre += t; }
    LAS float* Bm = (LAS float*)(lds + GL_B);
#pragma unroll
    for (int j = 0; j < 8; ++j) Bm[(wave * 8 + j) * 64 + lane] = bl[j] + pre;
    __syncthreads();
}
__device__ __forceinline__ void gla_load_v(const bf16* proj, size_t tok0, int h, LAS unsigned char* lds, int tid) {
#pragma unroll
    for (int i = 0; i < 2; ++i) { const int idx = tid + NTHR * i, t = idx >> 4, c = idx & 15;
        *(LAS v4u*)(lds + GL_V + t * 320 + c * 16) = *(const v4u*)(proj + (tok0 + t) * PW + C_GV + h * 128 + c * 8); }
}
__device__ __forceinline__ bf16x8 tr_frag(const LAS unsigned char* a0, int rowstride4) {
    const v4i16_t lo = __builtin_amdgcn_ds_read_tr16_b64_v4i16((LAS v4i16_t*)a0);
    const v4i16_t hi = __builtin_amdgcn_ds_read_tr16_b64_v4i16((LAS v4i16_t*)(a0 + rowstride4));
    return (bf16x8){lo[0], lo[1], lo[2], lo[3], hi[0], hi[1], hi[2], hi[3]};
}
__device__ __forceinline__ void gla_phase_a(const P& p, int l, LAS unsigned char* lds, int vcu, int G) {
    int tid = threadIdx.x; asm volatile("" : "+v"(tid));
    const int lane = tid & 63, wave = __builtin_amdgcn_readfirstlane(tid >> 6), hh = lane >> 5;
    const bf16* proj = WSP(bf16, WS_PROJ); float* loc = ((float*)p.out); float* dec = WSP(float, WS_GDEC); const float* sm = WSP(float, WS_SM); float* gb = WSP(float, WS_GB);
    LAS unsigned char* kd = lds + wave * 16384; LAS unsigned char* vh = kd + 8192;
    const int crow8 = lane >> 3, cch = lane & 7;
    const int trow = (lane & 15) >> 2, tcol = 16 * ((lane >> 4) & 1) + 4 * (lane & 3);
    for (int u = vcu * NWAVES + wave; u < 2048; u += G * NWAVES) {
        const int c = u & 31, h = (u >> 5) & 3, b = u >> 7;
        const size_t tok0 = (size_t)b * SEQ + c * 64;
        v4u kreg[8], v0reg[8], v1reg[8];
#pragma unroll
        for (int i = 0; i < 8; ++i) { const bf16* rp = proj + (tok0 + i * 8 + crow8) * PW;
            kreg[i] = *(const v4u*)(rp + C_GK + h * 64 + cch * 8); v0reg[i] = *(const v4u*)(rp + C_GV + h * 128 + cch * 8); v1reg[i] = *(const v4u*)(rp + C_GV + h * 128 + 64 + cch * 8); }
        float w[16];
#pragma unroll
        for (int r = 0; r < 16; ++r) w[r] = p.w_alpha_up[((size_t)l * 16 + r) * 256 + h * 64 + lane];
        const float bias = p.b_alpha[l * 256 + h * 64 + lane];
        { LAS f32x4* gw = (LAS f32x4*)vh;
#pragma unroll
          for (int i = 0; i < 4; ++i) gw[lane * 4 + i] = *(const f32x4*)(sm + (tok0 + lane) * 32 + 8 + 4 * i); }
        float bt[64]; float run = 0.f;
#pragma unroll
        for (int t = 0; t < 64; ++t) {
            float z = bias;
#pragma unroll
            for (int r4 = 0; r4 < 4; ++r4) { const f32x4 g4 = ((const LAS f32x4*)vh)[t * 4 + r4]; z += g4.x * w[4 * r4] + g4.y * w[4 * r4 + 1] + g4.z * w[4 * r4 + 2] + g4.w * w[4 * r4 + 3]; }
            run += fast_log_sigmoid(z) * (1.0f / 16.0f); bt[t] = run; gb[(tok0 + t) * 256 + h * 64 + lane] = run;
        }
#pragma unroll
        for (int i = 0; i < 8; ++i) { *(LAS v4u*)(kd + (i * 8 + crow8) * 128 + cch * 16) = kreg[i]; *(LAS v4u*)(vh + (i * 8 + crow8) * 128 + cch * 16) = v0reg[i]; }
#pragma unroll
        for (int t = 0; t < 64; ++t) { LAS bf16* kp = (LAS bf16*)(kd + t * 128 + lane * 2); *kp = (bf16)f2bf(bf2f(*kp) * __expf(run - bt[t])); }
        dec[(size_t)u * 64 + lane] = __expf(run);
#pragma unroll
        for (int half = 0; half < 2; ++half) {
            if (half == 1) {
#pragma unroll
                for (int i = 0; i < 8; ++i) *(LAS v4u*)(vh + (i * 8 + crow8) * 128 + cch * 16) = v1reg[i];
            }
            f32x16 acc[2][2];
#pragma unroll
            for (int x = 0; x < 2; ++x)
#pragma unroll
                for (int y = 0; y < 2; ++y) acc[x][y] = f32x16{};
#pragma unroll
            for (int s = 0; s < 4; ++s) {
                bf16x8 af[2], bfr[2];
#pragma unroll
                for (int x = 0; x < 2; ++x) { af[x] = tr_frag(vh + (16 * s + 8 * hh + trow) * 128 + (32 * x + tcol) * 2, 4 * 128); bfr[x] = tr_frag(kd + (16 * s + 8 * hh + trow) * 128 + (32 * x + tcol) * 2, 4 * 128); }
#pragma unroll
                for (int x = 0; x < 2; ++x)
#pragma unroll
                    for (int y = 0; y < 2; ++y) acc[x][y] = __builtin_amdgcn_mfma_f32_32x32x16_bf16(af[x], bfr[y], acc[x][y], 0, 0, 0);
            }
#pragma unroll
            for (int x = 0; x < 2; ++x)
#pragma unroll
                for (int y = 0; y < 2; ++y) { float* lo = loc + (size_t)u * 8192 + 32 * y + (lane & 31);
#pragma unroll
                    for (int r = 0; r < 16; ++r) lo[(size_t)(64 * half + 32 * x + (r & 3) + 8 * (r >> 2) + 4 * hh) * 64] = acc[x][y][r]; }
        }
    }
}
__device__ __forceinline__ void gla_phase_b(const P& p, int vcu, int G) {
    int tid = threadIdx.x; asm volatile("" : "+v"(tid));
    float* loc = ((float*)p.out); const float* dec = WSP(float, WS_GDEC);
    for (int u = vcu; u < 256; u += G) {
        const int bh = u >> 2, q4 = u & 3;
        const int e = q4 * 2048 + tid * 4, dk = e & 63;
        f32x4 st = {0.f, 0.f, 0.f, 0.f};
#pragma unroll 2
        for (int c = 0; c < 32; ++c) {
            const size_t cu = (size_t)bh * 32 + c;
            const f32x4 lv = *(const f32x4*)(loc + cu * 8192 + e);
            const f32x4 dv = *(const f32x4*)(dec + cu * 64 + dk);
            asm volatile("s_waitcnt vmcnt(0)" ::: "memory");
            __syncthreads();
            v2u w; w.x = pk2(st.x, st.y); w.y = pk2(st.z, st.w);
            *(v2u*)((unsigned char*)loc + cu * 32768 + 8192 * q4 + 8 * tid) = w;
            st = dv * st + lv;
        }
    }
}
__device__ __forceinline__ void gla_phase_c(const P& p, int l, LAS unsigned char* lds, int vcu, int G) {
    int tid = threadIdx.x; asm volatile("" : "+v"(tid));
    const int lane = tid & 63, wave = __builtin_amdgcn_readfirstlane(tid >> 6), hh = lane >> 5, r32 = lane & 31;
    const bf16* proj = WSP(bf16, WS_PROJ); const unsigned char* gs = ((const unsigned char*)p.out); bf16* y = WSP(bf16, WS_Y); const float* gb = WSP(const float, WS_GB);
    for (int u = vcu; u < 2048; u += G) {
        const int c = u & 31, h = (u >> 5) & 3, b = u >> 7;
        const size_t tok0 = (size_t)b * SEQ + c * 64;
        const int dvb = wave >> 1, tb = wave & 1;
        bf16 qraw[8], kraw[8]; v4u vreg[2]; bf16x8 sfr[4]; v2u ggr[4]; f32x4 gnr[4];
#pragma unroll
        for (int j = 0; j < 8; ++j) { const bf16* rp = proj + (tok0 + wave * 8 + j) * PW + h * 64 + lane; qraw[j] = rp[C_GQ]; kraw[j] = rp[C_GK]; }
#pragma unroll
        for (int i = 0; i < 2; ++i) { const int idx = tid + NTHR * i, t = idx >> 4, cc = idx & 15; vreg[i] = *(const v4u*)(proj + (tok0 + t) * PW + C_GV + h * 128 + cc * 8); }
        { const bf16* sp = (const bf16*)(gs + (size_t)u * 32768 + 8192 * dvb) + r32 * 64 + 8 * hh;
#pragma unroll
          for (int s2 = 0; s2 < 4; ++s2) sfr[s2] = *(const bf16x8*)(sp + 16 * s2); }
        float btv[8];
#pragma unroll
        for (int j = 0; j < 8; ++j) btv[j] = gb[(tok0 + wave * 8 + j) * 256 + h * 64 + lane];
        const float rref = gb[(tok0 + 31) * 256 + h * 64 + lane];
#pragma unroll
        for (int g = 0; g < 4; ++g) { const int dv = 32 * dvb + 8 * g + 4 * hh;
            gnr[g] = *(const f32x4*)(p.gla_gain + l * 512 + h * 128 + dv); ggr[g] = *(const v2u*)(proj + (tok0 + 32 * tb + r32) * PW + C_GG + h * 128 + dv); }
#pragma unroll
        for (int i = 0; i < 2; ++i) { const int idx = tid + NTHR * i, t = idx >> 4, cc = idx & 15; *(LAS v4u*)(lds + GL_V + t * 320 + cc * 16) = vreg[i]; }
#pragma unroll
        for (int j = 0; j < 8; ++j) { const int t = wave * 8 + j; const float bt = btv[j];
            const float qv = bf2f(qraw[j]), kv = bf2f(kraw[j]);
            *(LAS bf16*)(lds + GL_Q1 + t * 144 + lane * 2) = (bf16)f2bf(qv * __expf(bt));
            *(LAS bf16*)(lds + GL_Q2 + t * 144 + lane * 2) = (bf16)f2bf(qv * __expf(bt - rref));
            *(LAS bf16*)(lds + GL_K2 + t * 144 + lane * 2) = (bf16)f2bf(kv * __expf(rref - bt)); }
        __syncthreads();
        const int trow = (lane & 15) >> 2, tcol = 16 * ((lane >> 4) & 1) + 4 * (lane & 3);
        f32x16 o = {};
        {
#pragma unroll
          for (int s = 0; s < 4; ++s) { const bf16x8 af = sfr[s]; const bf16x8 bq = *(const LAS bf16x8*)(lds + GL_Q1 + (32 * tb + r32) * 144 + (16 * s + 8 * hh) * 2);
              o = __builtin_amdgcn_mfma_f32_32x32x16_bf16(af, bq, o, 0, 0, 0); } }
#pragma unroll
        for (int sb = 0; sb < 2; ++sb) {
            if (sb <= tb) {
                f32x16 pt = {};
#pragma unroll
                for (int s = 0; s < 4; ++s) { const bf16x8 ak = *(const LAS bf16x8*)(lds + GL_K2 + (32 * sb + r32) * 144 + (16 * s + 8 * hh) * 2); const bf16x8 bq = *(const LAS bf16x8*)(lds + GL_Q2 + (32 * tb + r32) * 144 + (16 * s + 8 * hh) * 2);
                    pt = __builtin_amdgcn_mfma_f32_32x32x16_bf16(ak, bq, pt, 0, 0, 0); }
                if (sb == tb) {
#pragma unroll
                    for (int r = 0; r < 16; ++r) { const int s_ = (r & 3) + 8 * (r >> 2) + 4 * hh; if (s_ > r32) pt[r] = 0.f; }
                }
#pragma unroll
                for (int ks = 0; ks < 2; ++ks) {
                    const bf16x8 pa = pack8(pt, 8 * ks);
                    const bf16x8 vf = tr_frag(lds + GL_V + (32 * sb + 16 * ks + 4 * hh + trow) * 320 + (32 * dvb + tcol) * 2, 8 * 320);
                    o = __builtin_amdgcn_mfma_f32_32x32x16_bf16(vf, pa, o, 0, 0, 0);
                }
            }
        }
        float ss = 0.f;
#pragma unroll
        for (int r = 0; r < 16; ++r) ss += o[r] * o[r];
        ss += __shfl_xor(ss, 32);
        LAS float* sq = (LAS float*)(lds + GL_SSQ);
        if (hh == 0) sq[dvb * 64 + 32 * tb + r32] = ss;
        __syncthreads();
        const int t = 32 * tb + r32;
        const float tot = (sq[t] + sq[64 + t]) + (sq[128 + t] + sq[192 + t]);
        const float rs = rsqrtf(tot * (1.0f / 128.0f) + EPS);
        const size_t tok = tok0 + t;
#pragma unroll
        for (int g = 0; g < 4; ++g) {
            const int dv = 32 * dvb + 8 * g + 4 * hh;
            const f32x4 gn = gnr[g];
            const v2u gg = ggr[g];
            const float g0 = bf2f((bf16)(gg.x & 0xffff)), g1 = bf2f((bf16)(gg.x >> 16)), g2 = bf2f((bf16)(gg.y & 0xffff)), g3 = bf2f((bf16)(gg.y >> 16));
            const float v0 = o[4 * g] * rs * gn.x * g0 * __builtin_amdgcn_rcpf(1.f + __expf(-g0)), v1 = o[4 * g + 1] * rs * gn.y * g1 * __builtin_amdgcn_rcpf(1.f + __expf(-g1));
            const float v2 = o[4 * g + 2] * rs * gn.z * g2 * __builtin_amdgcn_rcpf(1.f + __expf(-g2)), v3 = o[4 * g + 3] * rs * gn.w * g3 * __builtin_amdgcn_rcpf(1.f + __expf(-g3));
            v2u w; w.x = cvtpk(v0, v1); w.y = cvtpk(v2, v3);
            st_b64(y + tok * DM + 512 + h * 128 + dv, w);
        }
        __syncthreads();
    }
}
__device__ __forceinline__ void fox_cumsum_phase(const P& p, int l, int vcu, int G) {
    int tid = threadIdx.x; asm volatile("" : "+v"(tid));
    const int lane = tid & 63, wave = __builtin_amdgcn_readfirstlane(tid >> 6);
    const float* sm = WSP(float, WS_SM); float* cb = WSP(float, WS_CB);
    for (int u = vcu * NWAVES + wave; u < NBATCH * 8; u += G * NWAVES) {
        const int b = u >> 3, h = u & 7;
        const float bias = p.b_forget[l * 8 + h];
        float v[32]; float run = 0.f;
#pragma unroll
        for (int j = 0; j < 32; ++j) { run += fast_log_sigmoid(sm[((size_t)b * SEQ + lane * 32 + j) * 32 + h] + bias); v[j] = run; }
        float pre = run;
#pragma unroll
        for (int o = 1; o < 64; o <<= 1) { const float t = __shfl_up(pre, o); if (lane >= o) pre += t; }
        pre -= run;
#pragma unroll
        for (int j = 0; j < 32; ++j) cb[((size_t)b * 8 + h) * SEQ + lane * 32 + j] = -(v[j] + pre) * LOG2E;
    }
}
__device__ __forceinline__ void router_weights(const P& p, int gtid, int gstride) {
    for (int idx = gtid; idx < NLAYER * 32768; idx += gstride) {
        const int l = idx >> 15, r = idx & 32767, k = r >> 5, n = r & 31;
        float v = 0.f;
        if (n < 16) v = p.w_re[((size_t)l * DM + k) * 16 + n]; else if (n < 20) v = p.w_rg[((size_t)l * DM + k) * 4 + (n - 16)];
        v *= p.moe_norm[l * DM + k];
        float* wr = (float*)(ws_base(p.ws) + WS_W + (size_t)l * WS_WLAYER + WO_RHI);
        wr[(((k >> 4) * 4 + ((k >> 2) & 3)) * 32 + n) * 4 + (k & 3)] = v;
    }
}
__device__ __forceinline__ void route_phase(const P& p, int l, LAS unsigned char* lds, int vcu, int G) {
    int tid = threadIdx.x; asm volatile("" : "+v"(tid));
    const int lane = tid & 63, wave = __builtin_amdgcn_readfirstlane(tid >> 6);
    { const v4u* src = (const v4u*)(ws_base(p.ws) + WS_W + (size_t)l * WS_WLAYER + WO_RHI);
#pragma unroll 4
      for (int i = 0; i < 16; ++i) *(LAS v4u*)(lds + LDS_STAGE + (tid + NTHR * i) * 16) = src[tid + NTHR * i]; }
    LAS int* hist = (LAS int*)(lds + LDS_GATE);
    if (tid < 32) hist[tid] = 0;
    __syncthreads();
    const bf16* HBp = WSP(const bf16, WS_HB);
    int2* toke = WSP(int2, WS_MOE + MO_TOKE); float2* tokg = WSP(float2, WS_MOE + MO_TOKG);
    LAS float* lgb = (LAS float*)(lds + LDS_RS + wave * 2048);
    const int r = lane & 15, kq = lane >> 4;
    for (int task = vcu * NWAVES + wave; task < NTOK / 16; task += G * NWAVES) {
        const int tok0 = task * 16;
        const v2u* hp = (const v2u*)(HBp + (size_t)(tok0 + r) * DM + 4 * kq);
        f32x4 acc0 = {0.f, 0.f, 0.f, 0.f}, acc1 = {0.f, 0.f, 0.f, 0.f}; float q = 0.f;
#pragma unroll 8
        for (int s = 0; s < 64; ++s) {
            const v2u aw = hp[4 * s]; f32x4 a; a.x = __builtin_bit_cast(float, aw.x << 16); a.y = __builtin_bit_cast(float, aw.x & 0xffff0000u); a.z = __builtin_bit_cast(float, aw.y << 16); a.w = __builtin_bit_cast(float, aw.y & 0xffff0000u);
            const f32x4 b0 = *(const LAS f32x4*)(lds + LDS_STAGE + ((s * 4 + kq) * 32 + r) * 16);
            const f32x4 b1 = *(const LAS f32x4*)(lds + LDS_STAGE + ((s * 4 + kq) * 32 + 16 + r) * 16);
            q += (a.x * a.x + a.y * a.y) + (a.z * a.z + a.w * a.w);
            acc0 = __builtin_amdgcn_mfma_f32_16x16x4f32(a.x, b0.x, acc0, 0, 0, 0); acc1 = __builtin_amdgcn_mfma_f32_16x16x4f32(a.x, b1.x, acc1, 0, 0, 0);
            acc0 = __builtin_amdgcn_mfma_f32_16x16x4f32(a.y, b0.y, acc0, 0, 0, 0); acc1 = __builtin_amdgcn_mfma_f32_16x16x4f32(a.y, b1.y, acc1, 0, 0, 0);
            acc0 = __builtin_amdgcn_mfma_f32_16x16x4f32(a.z, b0.z, acc0, 0, 0, 0); acc1 = __builtin_amdgcn_mfma_f32_16x16x4f32(a.z, b1.z, acc1, 0, 0, 0);
            acc0 = __builtin_amdgcn_mfma_f32_16x16x4f32(a.w, b0.w, acc0, 0, 0, 0); acc1 = __builtin_amdgcn_mfma_f32_16x16x4f32(a.w, b1.w, acc1, 0, 0, 0);
        }
        q += __shfl_xor(q, 16); q += __shfl_xor(q, 32);
        const float rsv = rsqrtf(q * (1.0f / DM) + EPS);
        const float bias0 = p.b_re[l * 16 + r], bias1 = r < 4 ? p.b_rg[l * 4 + r] : 0.f;
#pragma unroll
        for (int g = 0; g < 4; ++g) { const int row = 4 * kq + g; const float rs = __shfl(rsv, row);
            lgb[row * 32 + r] = acc0[g] * rs + bias0; lgb[row * 32 + 16 + r] = acc1[g] * rs + bias1; }
        LDS_WAIT();
        if (lane < 16) {
            const int tok = tok0 + lane;
            const LAS f32x4* lr = (const LAS f32x4*)(lgb + lane * 32);
            const f32x4 e0 = lr[0], e1 = lr[1], e2 = lr[2], e3 = lr[3], gl = lr[4];
            int g = 0; float gm = gl.x;
            if (gl.y > gm) { gm = gl.y; g = 1; } if (gl.z > gm) { gm = gl.z; g = 2; } if (gl.w > gm) { gm = gl.w; g = 3; }
            const float den = (expf(gl.x - gm) + expf(gl.y - gm)) + (expf(gl.z - gm) + expf(gl.w - gm));
            const float pg = 1.0f / den;
            const f32x4 el = g == 0 ? e0 : (g == 1 ? e1 : (g == 2 ? e2 : e3));
            int i0 = 0; float m0 = el.x;
            if (el.y > m0) { m0 = el.y; i0 = 1; } if (el.z > m0) { m0 = el.z; i0 = 2; } if (el.w > m0) { m0 = el.w; i0 = 3; }
            int i1 = -1; float m1 = -INFINITY;
            if (i0 != 0 && el.x > m1) { m1 = el.x; i1 = 0; } if (i0 != 1 && el.y > m1) { m1 = el.y; i1 = 1; }
            if (i0 != 2 && el.z > m1) { m1 = el.z; i1 = 2; } if (i0 != 3 && el.w > m1) { m1 = el.w; i1 = 3; }
            const float ex = expf(m1 - m0), inv = 1.0f / (1.0f + ex);
            const int ea = g * 4 + i0, eb = g * 4 + i1;
            toke[tok] = make_int2(ea, eb); tokg[tok] = make_float2(pg * inv, pg * ex * inv);
            atomicAdd((int*)&hist[ea], 1); atomicAdd((int*)&hist[16 + eb], 1);
        }
        LDS_WAIT();
    }
    __syncthreads();
    if (tid < 32) WSP(int, WS_MOE + MO_HIST)[vcu * 32 + tid] = hist[tid];
}
__device__ __forceinline__ void sort_phase(const P& p, LAS unsigned char* lds, int vcu, int G) {
    int tid = threadIdx.x; asm volatile("" : "+v"(tid));
    const int lane = tid & 63, wave = __builtin_amdgcn_readfirstlane(tid >> 6);
    LAS int* cnt = (LAS int*)(lds + LDS_GATE); LAS int* pre = cnt + 32; LAS int* base = cnt + 64; LAS int* ntl = cnt + 96;
    const int* histg = WSP(const int, WS_MOE + MO_HIST);
    int* rowtok = WSP(int, WS_MOE + MO_ROWTOK); float* rowgate = WSP(float, WS_MOE + MO_ROWGATE); int* tilee = WSP(int, WS_MOE + MO_TILEE); int* nt = WSP(int, WS_MOE + MO_NT);
    const int2* toke = WSP(const int2, WS_MOE + MO_TOKE); const float2* tokg = WSP(const float2, WS_MOE + MO_TOKG);
    { LAS int* part = (LAS int*)(lds + LDS_RS);
      const int j = tid & 31, part_i = tid >> 5; int c = 0, pr = 0;
      for (int w = part_i; w < G; w += 16) { const int v = histg[w * 32 + j]; if (w < vcu) pr += v; c += v; }
      part[part_i * 64 + j] = c; part[part_i * 64 + 32 + j] = pr;
      __syncthreads();
      if (tid < 32) { int cc = 0, pp = 0;
#pragma unroll
          for (int q = 0; q < 16; ++q) { cc += part[q * 64 + tid]; pp += part[q * 64 + 32 + tid]; }
          cnt[tid] = cc; pre[tid] = pp; } }
    __syncthreads();
    if (tid == 0) { int t = 0; for (int j = 0; j < 32; ++j) { base[j] = t * 256; const int n = (cnt[j] + 255) >> 8; ntl[j] = n; t += n; if (j == 15 && vcu == 0) nt[0] = t; } if (vcu == 0) nt[1] = t; }
    __syncthreads();
    if (vcu == 0 && tid < 32) { const int t0 = base[tid] >> 8; for (int i = 0; i < ntl[tid]; ++i) tilee[t0 + i] = tid & 15; }
    if (vcu < 32) { const int j = vcu, lo = base[j] + cnt[j], hi = base[j] + 256 * ntl[j]; for (int r = lo + tid; r < hi; r += NTHR) { rowtok[r] = -1; rowgate[r] = 0.f; } }
    if (wave < 2) {
        const int k = wave;
        int run[16];
#pragma unroll
        for (int e = 0; e < 16; ++e) run[e] = 0;
        for (int task0 = vcu * NWAVES; task0 < NTOK / 16; task0 += G * NWAVES) {
#pragma unroll 1
            for (int half = 0; half < 2; ++half) {
                const int tok = task0 * 16 + half * 64 + lane;
                const int2 ee = toke[tok]; const float2 gg = tokg[tok];
                const int e = k ? ee.y : ee.x; const float gt = k ? gg.y : gg.x;
                int rank = 0;
#pragma unroll
                for (int x = 0; x < 16; ++x) { const unsigned long long m = __ballot(e == x); if (e == x) rank = run[x] + __popcll(m & ((1ull << lane) - 1ull)); run[x] += __popcll(m); }
                const int pos = base[k * 16 + e] + pre[k * 16 + e] + rank;
                rowtok[pos] = tok; rowgate[pos] = gt;
            }
        }
    }
}
__device__ __forceinline__ void final_phase(const P& p, int vcu, int G) {
    int tid = threadIdx.x; asm volatile("" : "+v"(tid));
    const int lane = tid & 63, wave = __builtin_amdgcn_readfirstlane(tid >> 6);
    const float* ssq = WSP(const float, WS_SSQ); const bf16* hb = WSP(const bf16, WS_HB);
    for (int m = vcu * NWAVES + wave; m < NTOK; m += G * NWAVES) {
        f32x4* s = (f32x4*)(p.out + (size_t)m * DM) + lane; const v2u* h = (const v2u*)(hb + (size_t)m * DM) + lane;
        const float rs = row_rs(ssq, m);
#pragma unroll
        for (int j = 0; j < 4; ++j) { const f32x4 g = ((const f32x4*)p.final_norm)[lane + 64 * j]; const v2u w = h[64 * j];
            f32x4 v; v.x = __builtin_bit_cast(float, w.x << 16); v.y = __builtin_bit_cast(float, w.x & 0xffff0000u); v.z = __builtin_bit_cast(float, w.y << 16); v.w = __builtin_bit_cast(float, w.y & 0xffff0000u);
            s[64 * j] = v * rs * g; }
    }
}
#ifndef ENMASK
#define ENMASK 0xffffffffu
#endif
#define EN(b) (((ENMASK) >> (b)) & 1u)
#ifndef REPMASK
#define REPMASK 0u
#endif
#define REPN(b) ((((REPMASK) >> (b)) & 1u) ? 2 : 1)
__device__ __attribute__((noinline)) void grid_barrier(unsigned* barw, unsigned x, volatile LAS unsigned* st) { XcdBarrier b; b.bar = barw; b.x = x; b.st = st; xcd_barrier(b); }
__global__ void __launch_bounds__(NTHR, 2) fwd(Args args) {
    extern __shared__ __attribute__((aligned(16))) unsigned char lds_raw[];
    LAS unsigned char* lds = (LAS unsigned char*)lds_raw;
    const P& p = args.p;
    const int tid = threadIdx.x, lane = tid & 63, wave = __builtin_amdgcn_readfirstlane(tid >> 6);
    const int G = gridDim.x; const int bx = blockIdx.x; const int vcu = (G % 8 == 0) ? (bx % 8) * (G / 8) + bx / 8 : bx;
    volatile LAS unsigned* MISC = (volatile LAS unsigned*)(lds + LDS_MISC);
    if (tid < 64) MISC[tid] = 0u;
    __syncthreads();
    unsigned* ctl = (unsigned*)(p.ws + WS_CTL);
    const int lo = args.ph_lo, hi = args.ph_hi;
    XcdBarrier bar; bar.bar = ctl + CW_BAR + args.li * XCD_BAR_WORDS; bar.x = 0; bar.st = nullptr;
    if (hi - lo > 1) bar = xcd_barrier_post(ctl + CW_BAR + args.li * XCD_BAR_WORDS, MISC);
#define IN(k) (lo <= (k) && (k) < hi)
#define PHL int vcuL = vcu, GL = G, bxL = bx; asm volatile("" : "+s"(vcuL), "+s"(GL), "+s"(bxL)); (void)vcuL; (void)GL; (void)bxL;
#define LTID(v) int v = threadIdx.x; asm volatile("" : "+v"(v))
#define SEAM(k) do { if (IN(k) && IN((k) + 1)) { grid_barrier(bar.bar, bar.x, bar.st); if (REPN(20) == 2) grid_barrier(bar.bar, bar.x, bar.st); } } while (0)
    LAS float* rstab = (LAS float*)(lds + LDS_RS); LAS int* rowtab = (LAS int*)(lds + LDS_ROWTOK); LAS float* gatetab = (LAS float*)(lds + LDS_GATE);
#define HB WSP(bf16, WS_HB)
#define PROJ WSP(bf16, WS_PROJ)
#define Y WSP(bf16, WS_Y)
#define XKV WSP(bf16, WS_XKV)
#define MEMN WSP(bf16, WS_MEMN)
#define SSQ WSP(float, WS_SSQ)
#define XQ WSP(bf16, WS_XQ)
#define U WSP(bf16, WS_U)
#define ROWTOK WSP(const int, WS_MOE + MO_ROWTOK)
#define ROWGATE WSP(const float, WS_MOE + MO_ROWGATE)
#define TILEE WSP(const int, WS_MOE + MO_TILEE)
#define NT WSP(const int, WS_MOE + MO_NT)
#define H (p.out)

    if (EN(0) && IN(PH_PRO)) _Pragma("unroll 1") for (int rep_ = 0; rep_ < REPN(0); ++rep_) { PHL prologue(p, lds, vcuL, GL, wave, lane); }
    SEAM(PH_PRO);
    if (EN(1) && IN(PH_XKV)) _Pragma("unroll 1") for (int rep_ = 0; rep_ < REPN(1); ++rep_) { PHL
        pg8::StaticOrder S; S.init(MEMN, ws_base(p.ws) + WS_WXKV, 4096, 2048, DM, GL, bxL);
        EpiBf16<false> E{XKV, 2048, rstab};
        pg8::gemm_phase<DM, EpiBf16<false>, pg8::StaticOrder, true>(lds + LDS_STAGE, S, E);
    }
    if (REPN(18) == 2 && IN(PH_XKV)) { PHL
        pg8::StaticOrder S; S.init(HB, ws_base(p.ws) + WS_W + WO_IN, NTOK, 3072, DM, GL, bxL);
        { pg8::Unit u; for (int iu = 0; S.next(iu, u); ++iu) { LTID(tq); if (tq < 256) rstab[iu * 256 + tq] = row_rs(SSQ, u.pm * 256 + tq); } }
        __syncthreads();
        EpiBf16<true> E{PROJ, PW, rstab};
        pg8::gemm_phase<DM, EpiBf16<true>, pg8::StaticOrder, true>(lds + LDS_STAGE, S, E);
    }
    SEAM(PH_XKV);
    for (int l = 0; l < NLAYER; ++l) {
        const int pb = PH_L0 + l * NPH;
        unsigned char* wl = ws_base(p.ws) + WS_W + (size_t)l * WS_WLAYER;
        if (EN(2) && IN(pb + LP_INPROJ)) _Pragma("unroll 1") for (int rep_ = 0; rep_ < REPN(2); ++rep_) { PHL
            pg8::StaticOrder S; S.init(HB, wl + WO_IN, NTOK, 3072, DM, GL, bxL);
            { pg8::Unit u; for (int iu = 0; S.next(iu, u); ++iu) { LTID(tq); if (tq < 256) rstab[iu * 256 + tq] = row_rs(SSQ, u.pm * 256 + tq); } }
            __syncthreads();
            EpiBf16<true> E{PROJ, PW, rstab};
            pg8::gemm_phase<DM, EpiBf16<true>, pg8::StaticOrder, true>(lds + LDS_STAGE, S, E);
            _Pragma("unroll 1") for (int r2_ = 0; r2_ < REPN(19); ++r2_) small_proj(p, l, vcuL, GL, wave, lane);
        }
        SEAM(pb + LP_INPROJ);
        if (EN(11) && IN(pb + LP_MIXA)) _Pragma("unroll 1") for (int rep_ = 0; rep_ < REPN(11); ++rep_) { PHL gla_phase_a(p, l, lds + LDS_STAGE, vcuL, GL); fox_cumsum_phase(p, l, vcuL, GL); }
        SEAM(pb + LP_MIXA);
        if (EN(12) && IN(pb + LP_MIXB)) _Pragma("unroll 1") for (int rep_ = 0; rep_ < REPN(12); ++rep_) { PHL gla_phase_b(p, vcuL, GL); }
        SEAM(pb + LP_MIXB);
        if (EN(9) && IN(pb + LP_MIXC)) { PHL _Pragma("unroll 1") for (int rep_ = 0; rep_ < REPN(16); ++rep_) fox_phase(p, l, lds + LDS_STAGE, vcuL, GL); _Pragma("unroll 1") for (int rep_ = 0; rep_ < REPN(17); ++rep_) gla_phase_c(p, l, lds + LDS_STAGE, vcuL, GL); }
        SEAM(pb + LP_MIXC);
        if (EN(3) && IN(pb + LP_WOUT)) _Pragma("unroll 1") for (int rep_ = 0; rep_ < REPN(3); ++rep_) { PHL
            pg8::StaticOrder S; S.init(Y, wl + WO_OUT, NTOK, DM, DM, GL, bxL);
            EpiRes<0> E{HB, SSQ, rowtab, gatetab, rep_ == REPN(3) - 1 ? 1.f : 0.f, Y};
            pg8::gemm_phase<DM, EpiRes<0>, pg8::StaticOrder, true>(lds + LDS_STAGE, S, E);
        }
        SEAM(pb + LP_WOUT);
        if (EN(4) && IN(pb + LP_XQ)) _Pragma("unroll 1") for (int rep_ = 0; rep_ < REPN(4); ++rep_) { PHL
            pg8::StaticOrder S; S.init(HB, wl + WO_XQ, NTOK, 512, DM, GL, bxL);
            { pg8::Unit u; for (int iu = 0; S.next(iu, u); ++iu) { LTID(tq); if (tq < 256) rstab[iu * 256 + tq] = row_rs(SSQ, u.pm * 256 + tq); } }
            __syncthreads();
            EpiBf16<true> E{XQ, 512, rstab};
            pg8::gemm_phase<DM, EpiBf16<true>, pg8::StaticOrder, true>(lds + LDS_STAGE, S, E);
        }
        SEAM(pb + LP_XQ);
        if (EN(10) && IN(pb + LP_XATTN)) _Pragma("unroll 1") for (int rep_ = 0; rep_ < REPN(10); ++rep_) { PHL xattn_phase(p, l, lds + LDS_STAGE, vcuL, GL, rep_ != REPN(10) - 1); }
        SEAM(pb + LP_XATTN);
        if (EN(5) && IN(pb + LP_XO)) _Pragma("unroll 1") for (int rep_ = 0; rep_ < REPN(5); ++rep_) { PHL
            pg8::StaticOrder S; S.init(XQ, wl + WO_XO, NTOK, DM, 512, GL, bxL);
            EpiRes<0> E{HB, SSQ, rowtab, gatetab, rep_ == REPN(5) - 1 ? 1.f : 0.f, Y};
            pg8::gemm_phase<512, EpiRes<0>, pg8::StaticOrder, true>(lds + LDS_STAGE, S, E);
        }
        SEAM(pb + LP_XO);
        if (EN(13) && IN(pb + LP_ROUTE)) _Pragma("unroll 1") for (int rep_ = 0; rep_ < REPN(13); ++rep_) { PHL route_phase(p, l, lds, vcuL, GL); }
        SEAM(pb + LP_ROUTE);
        if (EN(14) && IN(pb + LP_SORT)) _Pragma("unroll 1") for (int rep_ = 0; rep_ < REPN(14); ++rep_) { PHL sort_phase(p, lds, vcuL, GL); }
        SEAM(pb + LP_SORT);
        if (EN(6) && IN(pb + LP_GU)) _Pragma("unroll 1") for (int rep_ = 0; rep_ < REPN(6); ++rep_) { PHL
            MoeOrder<true> S{(const char*)HB, (const char*)(wl + WO_GU), DM, (size_t)1024 * DM * 2, 0, NT[1], GL, vcuL, TILEE, rowtab};
            { pg8::Unit u; for (int iu = 0; S.next(iu, u); ++iu) { LTID(tq); if (tq < 256) { int t = ROWTOK[u.pm * 256 + tq]; t = t < 0 ? 0 : t; rowtab[iu * 256 + tq] = t; rstab[iu * 256 + tq] = row_rs(SSQ, t); } } }
            __syncthreads();
            EpiGU E{U, rstab};
            pg8::gemm_phase<DM, EpiGU, MoeOrder<true>, true>(lds + LDS_STAGE, S, E);
        }
        SEAM(pb + LP_GU);
        if (EN(7) && IN(pb + LP_DOWN0)) _Pragma("unroll 1") for (int rep_ = 0; rep_ < REPN(7); ++rep_) { PHL
            MoeOrder<false> S{(const char*)U, (const char*)(wl + WO_D), 512, (size_t)1024 * 512 * 2, 0, NT[0], GL, vcuL, TILEE, rowtab};
            __syncthreads();
            { pg8::Unit u; for (int iu = 0; S.next(iu, u); ++iu) { LTID(tq); if (tq < 256) { rowtab[iu * 256 + tq] = ROWTOK[u.pm * 256 + tq]; gatetab[iu * 256 + tq] = ROWGATE[u.pm * 256 + tq]; } } }
            __syncthreads();
            EpiRes<1> E{HB, SSQ, rowtab, gatetab, 1.f, Y};
            pg8::gemm_phase<512, EpiRes<1>, MoeOrder<false>, true>(lds + LDS_STAGE, S, E);
        }
        SEAM(pb + LP_DOWN0);
        if (EN(8) && IN(pb + LP_DOWN1)) _Pragma("unroll 1") for (int rep_ = 0; rep_ < REPN(8); ++rep_) { PHL
            MoeOrder<false> S{(const char*)U, (const char*)(wl + WO_D), 512, (size_t)1024 * 512 * 2, NT[0], NT[1], GL, vcuL, TILEE, rowtab};
            __syncthreads();
            { pg8::Unit u; for (int iu = 0; S.next(iu, u); ++iu) { LTID(tq); if (tq < 256) { rowtab[iu * 256 + tq] = ROWTOK[u.pm * 256 + tq]; gatetab[iu * 256 + tq] = ROWGATE[u.pm * 256 + tq]; } } }
            __syncthreads();
            EpiRes<2> E{HB, SSQ, rowtab, gatetab, 1.f, Y};
            pg8::gemm_phase<512, EpiRes<2>, MoeOrder<false>, true>(lds + LDS_STAGE, S, E);
        }
        SEAM(pb + LP_DOWN1);
    }
    if (EN(15) && IN(PH_FINAL)) _Pragma("unroll 1") for (int rep_ = 0; rep_ < REPN(15); ++rep_) { PHL final_phase(p, vcuL, GL); }
#undef IN
#undef SEAM
#undef HB
#undef PROJ
#undef Y
#undef XKV
#undef MEMN
#undef SSQ
#undef XQ
#undef U
#undef ROWTOK
#undef ROWGATE
#undef TILEE
#undef NT
#undef H
}

static int g_grid = 0;
static void launch_fast(const P& p, int lo, int hi, int& li, hipStream_t stream) {
    Args a{}; a.p = p; a.ph_lo = lo; a.ph_hi = hi; a.li = li++; a.pad = 0;
    hipLaunchKernelGGL(fwd, dim3(g_grid), dim3(NTHR), LDS_BYTES, stream, a);
    const hipError_t le = hipPeekAtLastError();
    if (le != hipSuccess) fprintf(stderr, "kernel_launch: fwd launch [%d,%d) failed: %s\n", lo, hi, hipGetErrorName(le));
}
extern "C" void kernel_launch(void* const* d_in, const int* in_sizes, int n_in, void* d_out, int out_size, void* d_ws, size_t ws_size, hipStream_t stream) {
    if (n_in != 25 || out_size != NTOK * DM || ws_size < WS_END2) { fprintf(stderr, "kernel_launch: unexpected sizes n_in %d out %d ws %zu (need %zu)\n", n_in, out_size, ws_size, (size_t)WS_END2); return; }
    if (g_grid == 0) {
        int dev = 0, cus = 0, per_cu = 0;
        if (hipGetDevice(&dev) != hipSuccess || hipDeviceGetAttribute(&cus, hipDeviceAttributeMultiprocessorCount, dev) != hipSuccess) { g_grid = -1; return; }
        if (hipFuncSetAttribute((const void*)fwd, hipFuncAttributeMaxDynamicSharedMemorySize, LDS_BYTES) != hipSuccess) { fprintf(stderr, "kernel_launch: hipFuncSetAttribute failed\n"); g_grid = -1; return; }
        if (hipOccupancyMaxActiveBlocksPerMultiprocessor(&per_cu, (const void*)fwd, NTHR, LDS_BYTES) != hipSuccess || per_cu < 1) { fprintf(stderr, "kernel_launch: occupancy query says %d\n", per_cu); }
        (void)hipGetLastError();
        g_grid = cus;
    }
    if (g_grid < 0) return;
    P p{};
    const float** pp = (const float**)&p;
    for (int i = 0; i < 25; ++i) pp[i] = (const float*)d_in[i];
    p.out = (float*)d_out; p.ws = (unsigned char*)d_ws;
    hipMemsetAsync((char*)d_ws + WS_CTL, 0, 1 * MiB, stream);
    bf16* HB = WSP(bf16, WS_HB); bf16* PROJ = WSP(bf16, WS_PROJ); float* SM = WSP(float, WS_SM); float* CB = WSP(float, WS_CB); bf16* Y = WSP(bf16, WS_Y);
    bf16* XKV = WSP(bf16, WS_XKV); float* SSQ = WSP(float, WS_SSQ); bf16* XQ = WSP(bf16, WS_XQ);
    float* LA = WSP(float, WS_HB);
    int2* TOKE = WSP(int2, WS_MOE + MO_TOKE); float2* TOKG = WSP(float2, WS_MOE + MO_TOKG); int* ROWTOK = WSP(int, WS_MOE + MO_ROWTOK); float* ROWGATE = WSP(float, WS_MOE + MO_ROWGATE);
    int* TILEE = WSP(int, WS_MOE + MO_TILEE); int* NT = WSP(int, WS_MOE + MO_NT);
    float* H = p.out;
    (void)HB; (void)SSQ; (void)XQ;
    int li = 0;
    launch_fast(p, PH_PRO, PH_END, li, stream);
}
```

```cpp
#define REPMASK 0x0
#include <hip/hip_runtime.h>
#include <cstdio>
#include <cstdint>

constexpr int NTOK = 32768, DM = 1024, NBATCH = 16, SEQ = 2048, NLAYER = 2, MEML = 256;
constexpr int PW = 3072;
constexpr int C_FQ = 0, C_FK = 512, C_FV = 1024, C_GQ = 1536, C_GK = 1792, C_GV = 2048, C_GG = 2560;
constexpr int INW = 3096;
constexpr float EPS = 1e-6f, LOG2E = 1.4426950408889634f;
constexpr int MAXTILES = 288;
constexpr int MAXROWS = MAXTILES * 256;

typedef unsigned short bf16;
__device__ __forceinline__ unsigned f2bf(float f) { unsigned u = __builtin_bit_cast(unsigned, f); return (u + 0x7fffu + ((u >> 16) & 1u)) >> 16; }
__device__ __forceinline__ float bf2f(bf16 b) { return __builtin_bit_cast(float, ((unsigned)b) << 16); }

constexpr size_t MiB = 1u << 20;
constexpr size_t WS_CTL = 0;
constexpr size_t WS_W = 1 * MiB;
constexpr size_t WS_WLAYER = 59 * MiB;
constexpr size_t WS_WXKV = WS_W + 2 * WS_WLAYER;
constexpr size_t WS_HB = WS_WXKV + 4 * MiB;
constexpr size_t WS_PROJ = WS_HB + 64 * MiB;
constexpr size_t WS_XQ = WS_PROJ;
constexpr size_t WS_U = WS_PROJ + 32 * MiB;
constexpr size_t WS_SM = WS_PROJ + 192 * MiB;
constexpr size_t WS_CB = WS_SM + 4 * MiB;
constexpr size_t WS_Y = WS_CB + 1 * MiB;
constexpr size_t WS_XKV = WS_Y + 64 * MiB;
constexpr size_t WS_MEMN = WS_XKV + 16 * MiB;
constexpr size_t WS_SSQ = WS_MEMN + 8 * MiB;
constexpr size_t WS_MOE = WS_SSQ + 2 * MiB;
constexpr size_t WS_END = WS_MOE + 2 * MiB;
static_assert(WS_END <= 512 * MiB, "workspace map");
constexpr size_t MO_TOKE = 0;
constexpr size_t MO_TOKG = 256 * 1024;
constexpr size_t MO_ROWTOK = 512 * 1024;
constexpr size_t MO_ROWGATE = 832 * 1024;
constexpr size_t MO_TILEE = 1152 * 1024;
constexpr size_t MO_NT = 1156 * 1024;
constexpr size_t MO_HIST = 1160 * 1024;
constexpr size_t MO_KN = 1280 * 1024;

struct P {
    const float *x, *mem, *mem_norm, *mix_norm, *w_in, *b_forget, *w_alpha_up, *b_alpha, *fox_gain, *gla_gain, *w_out, *cross_norm, *w_xq, *w_xk, *w_xv, *w_xo,
        *moe_norm, *w_rg, *b_rg, *w_re, *b_re, *w_eg, *w_eu, *w_ed, *final_norm;
    float* out; unsigned char* ws;
};
__host__ __device__ __forceinline__ unsigned char* ws_base(unsigned char* w) {
#if defined(__HIP_DEVICE_COMPILE__)
    size_t z = 0; asm volatile("" : "+s"(z));
    return w + z;
#else
    return w;
#endif
}
#define WSP(T, off) ((T*)(ws_base(p.ws) + (off)))

__device__ __forceinline__ float wave_sum(float v) {
#pragma unroll
    for (int o = 1; o < 64; o <<= 1) v += __shfl_xor(v, o);
    return v;
}
__device__ __forceinline__ float wave_min(float v) {
#pragma unroll
    for (int o = 1; o < 64; o <<= 1) v = fminf(v, __shfl_xor(v, o));
    return v;
}
__device__ __forceinline__ float wave_max(float v) {
#pragma unroll
    for (int o = 1; o < 64; o <<= 1) v = fmaxf(v, __shfl_xor(v, o));
    return v;
}
__device__ __forceinline__ float row_rs(const float* ssq, int row) {
    const float4* s = (const float4*)(ssq + (size_t)row * 16);
    float4 a = s[0], b = s[1], c = s[2], d = s[3];
    float t = ((a.x + a.y) + (a.z + a.w)) + ((b.x + b.y) + (b.z + b.w)) + ((c.x + c.y) + (c.z + c.w)) + ((d.x + d.y) + (d.z + d.w));
    return rsqrtf(t * (1.0f / DM) + EPS);
}
__device__ __forceinline__ float log_sigmoid(float z) { return fminf(z, 0.f) - log1pf(expf(-fabsf(z))); }
__device__ __forceinline__ float silu(float z) { return z / (1.f + expf(-z)); }

typedef unsigned st_v4u __attribute__((ext_vector_type(4)));
typedef unsigned st_v2u __attribute__((ext_vector_type(2)));
#ifndef WT_STORES
#define WT_STORES 0
#endif
__device__ __forceinline__ void st_b128(void* p, st_v4u v) {
#if WT_STORES
    asm volatile("global_store_dwordx4 %0, %1, off sc1\n\ts_nop 1" :: "v"(p), "v"(v) : "memory");
#else
    *(st_v4u*)p = v;
#endif
}
__device__ __forceinline__ void st_b64(void* p, st_v2u v) {
#if WT_STORES
    asm volatile("global_store_dwordx2 %0, %1, off sc1" :: "v"(p), "v"(v) : "memory");
#else
    *(st_v2u*)p = v;
#endif
}
__global__ void __launch_bounds__(256) k_rowprep(const float* src, bf16* dst, float* ssq, const float* gain, int rows, int mode) {
    const int lane = threadIdx.x & 63, row = blockIdx.x * 4 + (threadIdx.x >> 6);
    if (row >= rows) return;
    const float4* s = (const float4*)(src + (size_t)row * DM) + lane;
    float4 v[4]; float q = 0.f;
#pragma unroll
    for (int j = 0; j < 4; ++j) { v[j] = s[64 * j]; q += (v[j].x * v[j].x + v[j].y * v[j].y) + (v[j].z * v[j].z + v[j].w * v[j].w); }
    q = wave_sum(q);
    float sc = 1.f;
    if (mode == 1) sc = rsqrtf(q * (1.0f / DM) + EPS);
    else if (lane < 16) ssq[(size_t)row * 16 + lane] = lane == 0 ? q : 0.f;
    uint2* d = (uint2*)(dst + (size_t)row * DM) + lane;
#pragma unroll
    for (int j = 0; j < 4; ++j) {
        float4 g = mode == 1 ? ((const float4*)gain)[lane + 64 * j] : make_float4(1.f, 1.f, 1.f, 1.f);
        d[64 * j] = make_uint2(f2bf(v[j].x * sc * g.x) | (f2bf(v[j].y * sc * g.y) << 16), f2bf(v[j].z * sc * g.z) | (f2bf(v[j].w * sc * g.w) << 16));
    }
}
__global__ void __launch_bounds__(256) k_final(float* io, const float* gain) {
    const int lane = threadIdx.x & 63, row = blockIdx.x * 4 + (threadIdx.x >> 6);
    float4* s = (float4*)(io + (size_t)row * DM) + lane;
    float4 v[4]; float q = 0.f;
#pragma unroll
    for (int j = 0; j < 4; ++j) { v[j] = s[64 * j]; q += (v[j].x * v[j].x + v[j].y * v[j].y) + (v[j].z * v[j].z + v[j].w * v[j].w); }
    q = wave_sum(q);
    const float sc = rsqrtf(q * (1.0f / DM) + EPS);
#pragma unroll
    for (int j = 0; j < 4; ++j) { float4 g = ((const float4*)gain)[lane + 64 * j]; s[64 * j] = make_float4(v[j].x * sc * g.x, v[j].y * sc * g.y, v[j].z * sc * g.z, v[j].w * sc * g.w); }
}

template <class C> __global__ void __launch_bounds__(256) k_ngemm(C c) {
    __shared__ float As[16][65];
    __shared__ float Bs[C::NB][16][65];
    const int M = c.rows();
    const int row0 = blockIdx.y * 64, col0 = blockIdx.x * 64;
    if (row0 >= M || row0 < c.row_lo()) return;
    const int tx = threadIdx.x & 15, ty = threadIdx.x >> 4;
    float acc[C::NB][4][4];
#pragma unroll
    for (int n = 0; n < C::NB; ++n)
#pragma unroll
        for (int i = 0; i < 4; ++i)
#pragma unroll
            for (int j = 0; j < 4; ++j) acc[n][i][j] = 0.f;
    for (int k0 = 0; k0 < c.K; k0 += 16) {
#pragma unroll
        for (int i = 0; i < 4; ++i) { const int idx = threadIdx.x + 256 * i, r = idx >> 4, kk = idx & 15; As[kk][r] = c.a(row0 + r, k0 + kk); }
#pragma unroll
        for (int n = 0; n < C::NB; ++n)
#pragma unroll
            for (int i = 0; i < 4; ++i) { const int idx = threadIdx.x + 256 * i, kk = idx >> 6, cc = idx & 63; Bs[n][kk][cc] = c.b(n, k0 + kk, col0 + cc, row0); }
        __syncthreads();
#pragma unroll
        for (int kk = 0; kk < 16; ++kk) {
            float a[4];
#pragma unroll
            for (int i = 0; i < 4; ++i) a[i] = As[kk][ty * 4 + i];
#pragma unroll
            for (int n = 0; n < C::NB; ++n) {
                float b[4];
#pragma unroll
                for (int j = 0; j < 4; ++j) b[j] = Bs[n][kk][tx * 4 + j];
#pragma unroll
                for (int i = 0; i < 4; ++i)
#pragma unroll
                    for (int j = 0; j < 4; ++j) acc[n][i][j] += a[i] * b[j];
            }
        }
        __syncthreads();
    }
#pragma unroll
    for (int i = 0; i < 4; ++i)
#pragma unroll
        for (int j = 0; j < 4; ++j) c.epi(row0 + ty * 4 + i, col0 + tx * 4 + j, acc[0][i][j], acc[C::NB - 1][i][j]);
}

struct CfgXKV {
    __device__ int row_lo() const { return 0; }
    static constexpr int NB = 1; int K; const bf16* A; const float *wk, *wv; bf16* O; int l;
    __device__ int rows() const { return 4096; }
    __device__ float a(int r, int k) const { return bf2f(A[(size_t)r * DM + k]); }
    __device__ float b(int, int k, int c, int) const { return c < 512 ? wk[(size_t)k * 512 + c] : wv[(size_t)k * 512 + c - 512]; }
    __device__ void epi(int r, int c, float v, float) const { O[(size_t)r * 2048 + l * 1024 + c] = (bf16)f2bf(v); }
};
struct CfgInProj {
    __device__ int row_lo() const { return 0; }
    static constexpr int NB = 1; int K; const bf16* A; const float *w, *gain, *ssq; bf16* proj; float* sm;
    __device__ int rows() const { return NTOK; }
    __device__ float a(int r, int k) const { return bf2f(A[(size_t)r * DM + k]); }
    __device__ float b(int, int k, int c, int) const { return c < INW ? gain[k] * w[(size_t)k * INW + c] : 0.f; }
    __device__ void epi(int r, int c, float v, float) const {
        if (c >= INW) return;
        v *= row_rs(ssq, r);
        if (c < 1536) { if (c < 512) v *= 0.125f * LOG2E; proj[(size_t)r * PW + c] = (bf16)f2bf(v); }
        else if (c < 1544) sm[(size_t)r * 32 + (c - 1536)] = v;
        else if (c < 3080) { if (c < 1800) v *= 0.125f; proj[(size_t)r * PW + (c - 8)] = (bf16)f2bf(v); }
        else sm[(size_t)r * 32 + 8 + (c - 3080)] = v;
    }
};
struct CfgRes {
    __device__ int row_lo() const { return 0; }
    static constexpr int NB = 1; int K; const bf16* A; const float* w; const float* base; float* out;
    __device__ int rows() const { return NTOK; }
    __device__ float a(int r, int k) const { return bf2f(A[(size_t)r * K + k]); }
    __device__ float b(int, int k, int c, int) const { return w[(size_t)k * DM + c]; }
    __device__ void epi(int r, int c, float v, float) const { out[(size_t)r * DM + c] = base[(size_t)r * DM + c] + v; }
};
struct CfgXQ {
    __device__ int row_lo() const { return 0; }
    static constexpr int NB = 1; int K; const bf16* A; const float *w, *gain, *ssq; bf16* O;
    __device__ int rows() const { return NTOK; }
    __device__ float a(int r, int k) const { return bf2f(A[(size_t)r * DM + k]); }
    __device__ float b(int, int k, int c, int) const { return gain[k] * w[(size_t)k * 512 + c]; }
    __device__ void epi(int r, int c, float v, float) const { O[(size_t)r * 512 + c] = (bf16)f2bf(v * row_rs(ssq, r) * (0.08838834764831845f * LOG2E)); }
};
struct CfgGU {
    __device__ int row_lo() const { return 0; }
    static constexpr int NB = 2; int K; const bf16* A; const float *wg, *wu, *gain, *ssq; const int *rowtok, *tilee, *nt; bf16* U;
    __device__ int rows() const { return nt[1] * 256; }
    __device__ float a(int r, int k) const { int t = rowtok[r]; t = t < 0 ? 0 : t; return bf2f(A[(size_t)t * DM + k]); }
    __device__ float b(int n, int k, int c, int row0) const { const int e = tilee[row0 >> 8]; const size_t o = ((size_t)e * DM + k) * 512 + c; return n == 0 ? gain[k] * wg[o] : gain[k] * wu[o]; }
    __device__ void epi(int r, int c, float g, float u) const {
        const int t = rowtok[r]; float v = 0.f;
        if (t >= 0) { const float rs = row_rs(ssq, t); v = silu(g * rs) * (u * rs); }
        U[(size_t)r * 512 + c] = (bf16)f2bf(v);
    }
};
struct CfgDown {
    static constexpr int NB = 1; int K; const bf16* U; const float* wd; const int *rowtok, *tilee, *nt; const float* rowgate; float* out; int which;
    __device__ int rows() const { return nt[which] * 256; }
    __device__ int row_lo() const { return which == 1 ? nt[0] * 256 : 0; }
    __device__ float a(int r, int k) const { return bf2f(U[(size_t)r * 512 + k]); }
    __device__ float b(int, int k, int c, int row0) const { const int e = tilee[row0 >> 8]; return wd[((size_t)e * 512 + k) * DM + c]; }
    __device__ void epi(int r, int c, float v, float) const {
        if (which == 1 && r < nt[0] * 256) return;
        const int t = rowtok[r]; if (t >= 0) out[(size_t)t * DM + c] += rowgate[r] * v;
    }
};

__global__ void __launch_bounds__(64) k_fox_cumsum(const float* sm, const float* bfor, float* cb) {
    const int b = blockIdx.x >> 3, h = blockIdx.x & 7, lane = threadIdx.x;
    const float bias = bfor[h];
    float v[32]; float run = 0.f;
#pragma unroll
    for (int j = 0; j < 32; ++j) { const int s = lane * 32 + j; run += log_sigmoid(sm[((size_t)b * SEQ + s) * 32 + h] + bias); v[j] = run; }
    float tot = run, pre = run;
#pragma unroll
    for (int o = 1; o < 64; o <<= 1) { const float t = __shfl_up(pre, o); if (lane >= o) pre += t; }
    pre -= tot;
#pragma unroll
    for (int j = 0; j < 32; ++j) cb[((size_t)b * 8 + h) * SEQ + lane * 32 + j] = -(v[j] + pre) * LOG2E;
}
__global__ void __launch_bounds__(256) k_fox_attn(const bf16* proj, const float* cb, const float* gain, bf16* y) {
    __shared__ float pbuf[4][SEQ];
    __shared__ float qbuf[4][64];
    const int w = threadIdx.x >> 6, lane = threadIdx.x & 63;
    const int gq = blockIdx.x * 4 + w;
    const int q = gq % SEQ, h = (gq / SEQ) % 8, b = gq / (SEQ * 8);
    const size_t tok = (size_t)b * SEQ + q;
    qbuf[w][lane] = bf2f(proj[tok * PW + C_FQ + h * 64 + lane]);
    __syncthreads();
    const float* cbp = cb + ((size_t)b * 8 + h) * SEQ;
    float s[32]; float mx = -INFINITY;
#pragma unroll
    for (int j = 0; j < 32; ++j) {
        const int key = lane + 64 * j; float v = -INFINITY;
        if (key <= q) {
            const uint4* kr = (const uint4*)(proj + ((size_t)b * SEQ + key) * PW + C_FK + h * 64);
            float d = 0.f;
#pragma unroll
            for (int c8 = 0; c8 < 8; ++c8) { const uint4 u = kr[c8]; const unsigned ww[4] = {u.x, u.y, u.z, u.w};
#pragma unroll
                for (int e = 0; e < 4; ++e) { d += qbuf[w][c8 * 8 + 2 * e] * bf2f((bf16)(ww[e] & 0xffff)); d += qbuf[w][c8 * 8 + 2 * e + 1] * bf2f((bf16)(ww[e] >> 16)); } }
            v = d + cbp[key];
        }
        s[j] = v; mx = fmaxf(mx, v);
    }
    mx = wave_max(mx);
    float l = 0.f;
#pragma unroll
    for (int j = 0; j < 32; ++j) { const float pv = (lane + 64 * j <= q) ? exp2f(s[j] - mx) : 0.f; l += pv; pbuf[w][lane + 64 * j] = pv; }
    l = wave_sum(l);
    __syncthreads();
    float o = 0.f;
    for (int key = 0; key <= q; ++key) o += pbuf[w][key] * bf2f(proj[((size_t)b * SEQ + key) * PW + C_FV + h * 64 + lane]);
    o /= l;
    const float ms = wave_sum(o * o) * (1.0f / 64.0f);
    y[tok * DM + h * 64 + lane] = (bf16)f2bf(o * rsqrtf(ms + EPS) * gain[h * 64 + lane]);
}
__global__ void __launch_bounds__(256) k_gla_la(const float* sm, const float* wup, const float* balpha, float* la) {
    const int tok = blockIdx.x, c = threadIdx.x;
    float z = balpha[c];
#pragma unroll
    for (int r = 0; r < 16; ++r) z += sm[(size_t)tok * 32 + 8 + r] * wup[r * 256 + c];
    la[(size_t)tok * 256 + c] = log_sigmoid(z) * (1.0f / 16.0f);
}
__global__ void __launch_bounds__(128) k_gla_rec(const bf16* proj, const float* la, const float* gain, bf16* y) {
    __shared__ float sh_a[64], sh_k[64], sh_q[64], red[2];
    const int b = blockIdx.x >> 2, h = blockIdx.x & 3, dv = threadIdx.x;
    float st[64];
#pragma unroll
    for (int i = 0; i < 64; ++i) st[i] = 0.f;
    const float g = gain[h * 128 + dv];
    for (int t = 0; t < SEQ; ++t) {
        const size_t tok = (size_t)b * SEQ + t;
        __syncthreads();
        if (dv < 64) { sh_a[dv] = expf(la[tok * 256 + h * 64 + dv]); sh_k[dv] = bf2f(proj[tok * PW + C_GK + h * 64 + dv]); }
        else sh_q[dv - 64] = bf2f(proj[tok * PW + C_GQ + h * 64 + dv - 64]);
        __syncthreads();
        const float v = bf2f(proj[tok * PW + C_GV + h * 128 + dv]);
        float o = 0.f;
#pragma unroll
        for (int i = 0; i < 64; ++i) { st[i] = sh_a[i] * st[i] + sh_k[i] * v; o += sh_q[i] * st[i]; }
        const float ss = wave_sum(o * o);
        if ((dv & 63) == 0) red[dv >> 6] = ss;
        __syncthreads();
        const float ms = (red[0] + red[1]) * (1.0f / 128.0f);
        const float gg = bf2f(proj[tok * PW + C_GG + h * 128 + dv]);
        y[tok * DM + 512 + h * 128 + dv] = (bf16)f2bf(o * rsqrtf(ms + EPS) * g * silu(gg));
    }
}
__global__ void __launch_bounds__(256) k_xattn(bf16* xq, const bf16* xkv, int l) {
    __shared__ float pbuf[4][256];
    __shared__ float qbuf[4][128];
    const int w = threadIdx.x >> 6, lane = threadIdx.x & 63;
    const int gq = blockIdx.x * 4 + w;
    const int q = gq % SEQ, h = (gq / SEQ) % 4, b = gq / (SEQ * 4);
    const size_t tok = (size_t)b * SEQ + q;
    qbuf[w][lane] = bf2f(xq[tok * 512 + h * 128 + lane]); qbuf[w][lane + 64] = bf2f(xq[tok * 512 + h * 128 + lane + 64]);
    __syncthreads();
    float s[4]; float mx = -INFINITY;
#pragma unroll
    for (int j = 0; j < 4; ++j) {
        const int key = lane + 64 * j;
        const uint4* kr = (const uint4*)(xkv + ((size_t)b * MEML + key) * 2048 + l * 1024 + h * 128);
        float d = 0.f;
#pragma unroll
        for (int c8 = 0; c8 < 16; ++c8) { const uint4 u = kr[c8]; const unsigned ww[4] = {u.x, u.y, u.z, u.w};
#pragma unroll
            for (int e = 0; e < 4; ++e) { d += qbuf[w][c8 * 8 + 2 * e] * bf2f((bf16)(ww[e] & 0xffff)); d += qbuf[w][c8 * 8 + 2 * e + 1] * bf2f((bf16)(ww[e] >> 16)); } }
        s[j] = d; mx = fmaxf(mx, d);
    }
    mx = wave_max(mx);
    float lsum = 0.f;
#pragma unroll
    for (int j = 0; j < 4; ++j) { const float pv = exp2f(s[j] - mx); lsum += pv; pbuf[w][lane + 64 * j] = pv; }
    lsum = wave_sum(lsum);
    __syncthreads();
    float o0 = 0.f, o1 = 0.f;
    for (int key = 0; key < 256; ++key) { const bf16* vr = xkv + ((size_t)b * MEML + key) * 2048 + l * 1024 + 512 + h * 128; const float pv = pbuf[w][key]; o0 += pv * bf2f(vr[lane]); o1 += pv * bf2f(vr[lane + 64]); }
    xq[tok * 512 + h * 128 + lane] = (bf16)f2bf(o0 / lsum); xq[tok * 512 + h * 128 + lane + 64] = (bf16)f2bf(o1 / lsum);
}
__global__ void __launch_bounds__(256) k_router(const float* h, const float* gain, const float* wrg, const float* brg, const float* wre, const float* bre, int2* toke, float2* tokg) {
    const int lane = threadIdx.x & 63, tok = blockIdx.x * 4 + (threadIdx.x >> 6);
    const float* hr = h + (size_t)tok * DM;
    float hv[16]; float q = 0.f;
#pragma unroll
    for (int j = 0; j < 16; ++j) { hv[j] = hr[lane + 64 * j]; q += hv[j] * hv[j]; }
    q = wave_sum(q);
    const float rs = rsqrtf(q * (1.0f / DM) + EPS);
#pragma unroll
    for (int j = 0; j < 16; ++j) hv[j] = hv[j] * rs * gain[lane + 64 * j];
    float lg[20];
#pragma unroll
    for (int o = 0; o < 20; ++o) {
        float d = 0.f;
#pragma unroll
        for (int j = 0; j < 16; ++j) { const int k = lane + 64 * j; d += hv[j] * (o < 4 ? wrg[k * 4 + o] : wre[k * 16 + (o - 4)]); }
        lg[o] = wave_sum(d) + (o < 4 ? brg[o] : bre[o - 4]);
    }
    if (lane == 0) {
        int g = 0; float gm = lg[0];
#pragma unroll
        for (int i = 1; i < 4; ++i) if (lg[i] > gm) { gm = lg[i]; g = i; }
        float den = 0.f;
#pragma unroll
        for (int i = 0; i < 4; ++i) den += expf(lg[i] - gm);
        const float pg = 1.0f / den;
        float el[4];
#pragma unroll
        for (int i = 0; i < 4; ++i) { float v = lg[4];
#pragma unroll
            for (int gg = 0; gg < 4; ++gg) if (gg == g) v = lg[4 + gg * 4 + i];
            el[i] = v; }
        int i0 = 0; float m0 = el[0];
#pragma unroll
        for (int i = 1; i < 4; ++i) if (el[i] > m0) { m0 = el[i]; i0 = i; }
        int i1 = -1; float m1 = -INFINITY;
#pragma unroll
        for (int i = 0; i < 4; ++i) if (i != i0 && el[i] > m1) { m1 = el[i]; i1 = i; }
        const float e1 = expf(m1 - m0), inv = 1.0f / (1.0f + e1);
        toke[tok] = make_int2(g * 4 + i0, g * 4 + i1);
        tokg[tok] = make_float2(pg * inv, pg * e1 * inv);
    }
}
__global__ void k_sort(const int2* toke, const float2* tokg, int* rowtok, float* rowgate, int* tilee, int* nt) {
    __shared__ int cnt[32], base[32];
    if (threadIdx.x != 0 || blockIdx.x != 0) return;
    for (int i = 0; i < 32; ++i) cnt[i] = 0;
    for (int t = 0; t < NTOK; ++t) { const int2 e = toke[t]; cnt[e.x]++; cnt[16 + e.y]++; }
    int tile = 0;
    for (int k = 0; k < 2; ++k) { for (int e = 0; e < 16; ++e) { base[k * 16 + e] = tile * 256; const int n = (cnt[k * 16 + e] + 255) / 256; for (int i = 0; i < n; ++i) tilee[tile + i] = e; tile += n; } nt[k] = tile; }
    for (int r = 0; r < tile * 256; ++r) { rowtok[r] = -1; rowgate[r] = 0.f; }
    for (int t = 0; t < NTOK; ++t) {
        const int2 e = toke[t]; const float2 g = tokg[t];
        { const int pos = base[e.x]++; rowtok[pos] = t; rowgate[pos] = g.x; }
        { const int pos = base[16 + e.y]++; rowtok[pos] = t; rowgate[pos] = g.y; }
    }
}

#define XB_TMO      128
#define XB_XCNT(j)  (256  + 64 * (j))
#define XB_XSUB(j)  (1280 + 64 * (j))
#define XB_XGEN(j)  (2304 + 64 * (j))
#define XB_TOP      3328
#define XB_TOPGEN   3392
#define XCD_BAR_WORDS 3456
#define XB_SPIN_CAP (1u << 18)
#define LAS __attribute__((address_space(3)))

__device__ __forceinline__ unsigned xb_ld(unsigned* p)              { return __hip_atomic_load(p, __ATOMIC_RELAXED, __HIP_MEMORY_SCOPE_AGENT); }
__device__ __forceinline__ unsigned xb_add(unsigned* p, unsigned v) { return __hip_atomic_fetch_add(p, v, __ATOMIC_RELAXED, __HIP_MEMORY_SCOPE_AGENT); }
__device__ __forceinline__ unsigned xb_xcc_id() { return (unsigned)__builtin_amdgcn_s_getreg((3 << 11) | 20) & 0xFu; }
#define XB_SPIN(cond, bar) do { unsigned _sp = 0; while (cond) { __builtin_amdgcn_s_sleep(1); \
    if ((++_sp & 255u) == 0u) { if (xb_ld(&(bar)[XB_TMO])) break; if (_sp > XB_SPIN_CAP) { atomicAdd(&(bar)[XB_TMO], 1u); break; } } } } while (0)

struct XcdBarrier {
    unsigned* bar; unsigned x;
    volatile LAS unsigned* st;
};

__device__ __forceinline__ XcdBarrier xcd_barrier_post(unsigned* bar, volatile LAS unsigned* st) {
    XcdBarrier b; b.bar = bar; b.x = xb_xcc_id(); b.st = st;
    if (threadIdx.x == 0) (void)xb_add(&bar[XB_XCNT(b.x)], 1u);
    return b;
}
__device__ __forceinline__ void xcd_barrier_complete(unsigned* bar, unsigned x, unsigned& nloc, unsigned& nx) {
    const unsigned G = gridDim.x * gridDim.y * gridDim.z;
    unsigned sum, cnt, mine, sp = 0u;
    for (;;) {
        sum = 0u; cnt = 0u; mine = 0u;
#pragma unroll
        for (unsigned j = 0; j < 16; ++j) { const unsigned c = xb_ld(&bar[XB_XCNT(j)]); sum += c; cnt += (c > 0u) ? 1u : 0u; mine = (j == x) ? c : mine; }
        if (sum == G) break;
        __builtin_amdgcn_s_sleep(1);
        if ((++sp & 255u) == 0u) { if (xb_ld(&bar[XB_TMO])) break; if (sp > XB_SPIN_CAP) { atomicAdd(&bar[XB_TMO], 1u); break; } }
    }
    nloc = mine > 0u ? mine : 1u; nx = cnt > 0u ? cnt : 1u;
}

__device__ __forceinline__ void xcd_barrier(const XcdBarrier& b) {
    asm volatile("s_waitcnt vmcnt(0)" ::: "memory");
    __syncthreads();
    if (threadIdx.x == 0) {
        unsigned* bar = b.bar;
        __builtin_amdgcn_s_waitcnt(0);
        unsigned nloc = b.st[0], nx = b.st[1];
        if (nloc == 0u) { xcd_barrier_complete(bar, b.x, nloc, nx); b.st[0] = nloc; b.st[1] = nx; }
        const unsigned old = xb_add(&bar[XB_XSUB(b.x)], 1u);
        const unsigned gen = old / nloc;
        if (old + 1u == (gen + 1u) * nloc) {
            __builtin_amdgcn_fence(__ATOMIC_RELEASE, "agent");
            asm volatile("s_waitcnt vmcnt(0)" ::: "memory");
            const unsigned og = xb_add(&bar[XB_TOP], 1u);
            const unsigned tg = og / nx;
            if (og + 1u == (tg + 1u) * nx) xb_add(&bar[XB_TOPGEN], 1u);
            else XB_SPIN(xb_ld(&bar[XB_TOPGEN]) == tg, bar);
            __builtin_amdgcn_fence(__ATOMIC_ACQUIRE, "agent");
            xb_add(&bar[XB_XGEN(b.x)], 1u);
            asm volatile("s_waitcnt vmcnt(0)" ::: "memory");
        } else {
            XB_SPIN(xb_ld(&bar[XB_XGEN(b.x)]) == gen, bar);
            __builtin_amdgcn_fence(__ATOMIC_ACQUIRE, "agent");
            asm volatile("s_waitcnt vmcnt(0)" ::: "memory");
        }
    }
    __syncthreads();
}

namespace pg8 {
#define PG8_LAS __attribute__((address_space(3)))
typedef unsigned short bf16_t;
typedef short bf16x8 __attribute__((ext_vector_type(8)));
typedef float f32x4 __attribute__((ext_vector_type(4)));
typedef unsigned u32x4 __attribute__((ext_vector_type(4)));
typedef unsigned u32x2 __attribute__((ext_vector_type(2)));
constexpr int BM = 256, BK = 64, HALF = 128, HTB = HALF * BK * 2, STAGE_BYTES = 8 * HTB, NXCD = 8, WGM = 8;

__host__ __device__ __forceinline__ int lds_byte(int r, int c) { const int st = (r >> 4) * 2 + (c >> 5), rr = r & 15, cc = c & 31, ob = rr * 64 + cc * 2; return st * 1024 + (ob ^ (((ob >> 9) & 1) << 5)); }
__host__ __device__ __forceinline__ void stage_rc(int b, int& R, int& C) { const int st = b / 1024, sb = b % 1024, swz = sb ^ (((sb >> 9) & 1) << 5); R = (st >> 1) * 16 + swz / 64; C = (st & 1) * 32 + (swz % 64) / 2; }
__host__ __device__ __forceinline__ int perm32(int rho) { const int n = rho >> 4, i = rho & 15; return 8 * (i >> 2) + 4 * n + (i & 3); }

struct Unit { int pm, pn, e; };

struct StaticOrder {
    static constexpr bool GATHER = false;
    const char* A; const char* Bt; int K; int nM, nN, nwg, G, c;
    __device__ void init(const void* A_, const void* Bt_, int M, int N, int K_, int G_, int c_) { A = (const char*)A_; Bt = (const char*)Bt_; K = K_; nM = M / BM; nN = N / BM; nwg = nM * nN; G = G_; c = c_; }
    __device__ bool next(int i, Unit& u) const {
        const long L = (long)i * G + c; if (L >= nwg) return false;
        int wgid = (int)L; { const int q = nwg / NXCD, r = nwg % NXCD, xcd = wgid % NXCD, off = wgid / NXCD; wgid = (xcd < r ? xcd * (q + 1) : r * (q + 1) + (xcd - r) * q) + off; }
        const int nig = WGM * nN, gid = wgid / nig, fm = gid * WGM, gsz = (nM - fm) < WGM ? (nM - fm) : WGM;
        u.pm = fm + ((wgid % nig) % gsz); u.pn = (wgid % nig) / gsz; u.e = 0; return true;
    }
    __device__ __forceinline__ const char* a_base(const Unit& u) const { return A + (size_t)u.pm * (size_t)(BM * 2) * K; }
    __device__ __forceinline__ const char* b_base(const Unit& u) const { return Bt + (size_t)u.pn * (size_t)(BM * 2) * K; }
    __device__ __forceinline__ void a_voff(int, int, int, int, unsigned (&)[2]) const {}
};

__device__ __forceinline__ unsigned cvt_pk_bf16(float lo, float hi) { unsigned r; asm volatile("v_cvt_pk_bf16_f32 %0, %1, %2" : "=v"(r) : "v"(lo), "v"(hi)); return r; }

typedef int i32x8 __attribute__((ext_vector_type(8)));
typedef int i32x4 __attribute__((ext_vector_type(4)));
template <int K, class Epi, class Sched, bool ALIGN_EPI, bool FP8 = false, int SA = 127, int SB = 127>
__device__ __forceinline__ void gemm_phase(PG8_LAS unsigned char* lds, const Sched& S, const Epi& E) {
    int tid_ = threadIdx.x; asm volatile("" : "+v"(tid_));
    const int tid = tid_, wid = __builtin_amdgcn_readfirstlane(tid >> 6), lane = tid & 63, wr = wid >> 2, wc = wid & 3, fr = lane & 15, fq = lane >> 4;
    constexpr int nt = K / BK;
    constexpr int NH = Sched::GATHER ? 2 : 1;
    unsigned voffB[2], cvA[NH][2], nvA[NH][2];
#pragma unroll
    for (int i = 0; i < 2; ++i) { int R, C; stage_rc(tid * 16 + i * 8192, R, C); const int Rb = Epi::PERM ? ((R & ~31) + perm32(R & 31)) : R;
        voffB[i] = (unsigned)(Rb * K + C) * 2u;
        cvA[0][i] = nvA[0][i] = (unsigned)(R * K + C) * 2u; if constexpr (NH == 2) { cvA[NH - 1][i] = nvA[NH - 1][i] = cvA[0][i]; } }
    constexpr size_t kstep = (size_t)(BK * 2);
    constexpr size_t hstep = (size_t)HALF * K * 2;
    constexpr size_t hstepA = Sched::GATHER ? (size_t)0 : hstep;
    const unsigned ldsw = (unsigned)wid * 1024u;
    const int aoff = lds_byte(wr * 64 + fr, fq * 8), boff = lds_byte(wc * 32 + fr, fq * 8);
#define PG8_SA(b, h) (((b) * 2 + (h)) * HTB)
#define PG8_SB(b, h) ((4 + (b) * 2 + (h)) * HTB)
#define PG8_STAGE(bufoff, gbase, voff) do { _Pragma("unroll") for (int _i = 0; _i < 2; ++_i) \
        __builtin_amdgcn_global_load_lds((const unsigned*)((const char*)(gbase) + (voff)[_i]), (PG8_LAS unsigned*)(lds + (bufoff) + ldsw + _i * 8192), 16, 0, 0); } while (0)
#define PG8_LD32(addr) __builtin_shufflevector(*(const PG8_LAS i32x4*)(addr), *(const PG8_LAS i32x4*)((addr) + 1024), 0, 1, 2, 3, 4, 5, 6, 7)
#define PG8_LDA(dst, b, h) do { _Pragma("unroll") for (int m = 0; m < 4; ++m) dst[m] = PG8_LD32(lds + PG8_SA(b, h) + aoff + m * 2048); } while (0)
#define PG8_LDB(dst, b, h) do { _Pragma("unroll") for (int n = 0; n < 2; ++n) dst[n] = PG8_LD32(lds + PG8_SB(b, h) + boff + n * 2048); } while (0)
#define PG8_H0(x) __builtin_bit_cast(bf16x8, __builtin_shufflevector((x), (x), 0, 1, 2, 3))
#define PG8_H1(x) __builtin_bit_cast(bf16x8, __builtin_shufflevector((x), (x), 4, 5, 6, 7))
#define PG8_MMA(ai, bj, At, Bt) do { __builtin_amdgcn_s_setprio(1); _Pragma("unroll") for (int m = 0; m < 4; ++m) _Pragma("unroll") for (int n = 0; n < 2; ++n) { \
        if constexpr (FP8) asm volatile("v_mfma_scale_f32_16x16x128_f8f6f4 %0, %1, %2, %0, %3, %4 op_sel_hi:[0,0,0]" : "+v"(acc[ai][bj][m][n]) : "v"(Bt[n]), "v"(At[m]), "v"(sbv), "v"(sav)); \
        else { acc[ai][bj][m][n] = __builtin_amdgcn_mfma_f32_16x16x32_bf16(PG8_H0(Bt[n]), PG8_H0(At[m]), acc[ai][bj][m][n], 0, 0, 0); \
               acc[ai][bj][m][n] = __builtin_amdgcn_mfma_f32_16x16x32_bf16(PG8_H1(Bt[n]), PG8_H1(At[m]), acc[ai][bj][m][n], 0, 0, 0); } } \
        __builtin_amdgcn_s_setprio(0); } while (0)
#define PG8_WAIT_V(n) asm volatile("s_waitcnt vmcnt(" #n ")" ::: "memory")
#define PG8_WAIT_L(n) asm volatile("s_waitcnt lgkmcnt(" #n ")" ::: "memory")
#define PG8_BAR __builtin_amdgcn_s_barrier()
#define PG8_SCHED __builtin_amdgcn_sched_barrier(0)
    int sav = SA, sbv = SB; asm volatile("" : "+v"(sav), "+v"(sbv));
    Unit cur, nxt; int ui = 0;
    if (!S.next(0, cur)) return;
    f32x4 acc[2][2][4][2];
#pragma unroll
    for (int a = 0; a < 2; ++a)
#pragma unroll
        for (int b = 0; b < 2; ++b)
#pragma unroll
            for (int m = 0; m < 4; ++m)
#pragma unroll
                for (int n = 0; n < 2; ++n) acc[a][b][m][n] = (f32x4){0.f, 0.f, 0.f, 0.f};
    i32x8 At[4], B0[2], B1[2];
    const char* cA = S.a_base(cur); const char* cB = S.b_base(cur);
    if constexpr (Sched::GATHER) {
        int R0, C0, R1, C1; stage_rc(tid * 16, R0, C0); stage_rc(tid * 16 + 8192, R1, C1);
#pragma unroll
        for (int h = 0; h < 2; ++h) { unsigned v[2]; S.a_voff(0, h, R0, R1, v); cvA[h][0] = v[0] + (unsigned)C0 * 2u; cvA[h][1] = v[1] + (unsigned)C1 * 2u; }
    }
    PG8_STAGE(PG8_SB(0, 0), cB, voffB); PG8_STAGE(PG8_SB(0, 1), cB + hstep, voffB); PG8_STAGE(PG8_SA(0, 0), cA, cvA[0]); PG8_STAGE(PG8_SA(0, 1), cA + hstepA, cvA[NH - 1]);
    if (wr == 1) PG8_BAR;
    PG8_WAIT_V(2); PG8_BAR;
    PG8_STAGE(PG8_SB(1, 0), cB + kstep, voffB); PG8_STAGE(PG8_SA(1, 0), cA + kstep, cvA[0]); PG8_STAGE(PG8_SB(1, 1), cB + hstep + kstep, voffB);
    PG8_WAIT_V(6); PG8_BAR;
    for (;;) {
        const bool has_next = S.next(ui + 1, nxt);
        const char* nA = has_next ? S.a_base(nxt) : cA; const char* nB = has_next ? S.b_base(nxt) : cB;
        if constexpr (Sched::GATHER) {
            if (has_next) {
                int t2 = threadIdx.x; asm volatile("" : "+v"(t2));
                int R0, C0, R1, C1; stage_rc(t2 * 16, R0, C0); stage_rc(t2 * 16 + 8192, R1, C1);
#pragma unroll
                for (int h = 0; h < 2; ++h) { unsigned v[2]; S.a_voff(ui + 1, h, R0, R1, v); nvA[h][0] = v[0] + (unsigned)C0 * 2u; nvA[h][1] = v[1] + (unsigned)C1 * 2u; }
            } else {
#pragma unroll
                for (int h = 0; h < 2; ++h) { nvA[h][0] = cvA[h][0]; nvA[h][1] = cvA[h][1]; }
            }
        }
#pragma unroll 1
        for (int t = 0; t < nt; t += 2) {
            const bool last = (t == nt - 2);
            const char* a1 = cA + (size_t)(t + 1) * kstep;
            const char* a2 = last ? nA : cA + (size_t)(t + 2) * kstep; const char* b2 = last ? nB : cB + (size_t)(t + 2) * kstep;
            const char* a3 = a2 + kstep; const char* b3 = b2 + kstep;
            unsigned v2[NH][2];
#pragma unroll
            for (int h = 0; h < NH; ++h) { if constexpr (Sched::GATHER) { v2[h][0] = last ? nvA[h][0] : cvA[h][0]; v2[h][1] = last ? nvA[h][1] : cvA[h][1]; } else { v2[h][0] = cvA[h][0]; v2[h][1] = cvA[h][1]; } }
            PG8_LDB(B0, 0, 0); PG8_LDB(B1, 0, 1); PG8_SCHED; PG8_LDA(At, 0, 0); PG8_STAGE(PG8_SA(1, 1), a1 + hstepA, cvA[NH - 1]);
            PG8_WAIT_V(8); PG8_WAIT_L(0); PG8_BAR; PG8_MMA(0, 0, At, B0); PG8_MMA(0, 1, At, B1); PG8_BAR; PG8_SCHED;
            PG8_LDA(At, 0, 1); PG8_STAGE(PG8_SB(0, 0), b2, voffB); PG8_STAGE(PG8_SB(0, 1), b2 + hstep, voffB); PG8_STAGE(PG8_SA(0, 0), a2, v2[0]);
            PG8_WAIT_V(8); PG8_WAIT_L(0); PG8_BAR; PG8_MMA(1, 0, At, B0); PG8_MMA(1, 1, At, B1); PG8_BAR; PG8_SCHED;
            PG8_LDB(B0, 1, 0); PG8_LDB(B1, 1, 1); PG8_SCHED; PG8_LDA(At, 1, 0); PG8_STAGE(PG8_SA(0, 1), a2 + hstepA, v2[NH - 1]);
            PG8_WAIT_V(8); PG8_WAIT_L(0); PG8_BAR; PG8_MMA(0, 0, At, B0); PG8_MMA(0, 1, At, B1); PG8_BAR; PG8_SCHED;
            PG8_LDA(At, 1, 1); PG8_STAGE(PG8_SB(1, 0), b3, voffB); PG8_STAGE(PG8_SB(1, 1), b3 + hstep, voffB); PG8_STAGE(PG8_SA(1, 0), a3, v2[0]);
            PG8_WAIT_V(8); PG8_WAIT_L(0); PG8_BAR; PG8_MMA(1, 0, At, B0); PG8_MMA(1, 1, At, B1); PG8_BAR; PG8_SCHED;
        }
        if constexpr (ALIGN_EPI) { if (wr == 0) PG8_BAR; }
        if constexpr (FP8) asm volatile("s_nop 15\n\ts_nop 15" ::: "memory");
        E(acc, cur, ui, wr, wc, fr, fq);
        if (!has_next) break;
#pragma unroll
        for (int a = 0; a < 2; ++a)
#pragma unroll
            for (int b = 0; b < 2; ++b)
#pragma unroll
                for (int m = 0; m < 4; ++m)
#pragma unroll
                    for (int n = 0; n < 2; ++n) acc[a][b][m][n] = (f32x4){0.f, 0.f, 0.f, 0.f};
        cur = nxt; cA = nA; cB = nB; ++ui;
        if constexpr (Sched::GATHER) {
#pragma unroll
            for (int h = 0; h < NH; ++h) { cvA[h][0] = nvA[h][0]; cvA[h][1] = nvA[h][1]; }
        }
        if constexpr (ALIGN_EPI) { if (wr == 1) PG8_BAR; }
    }
    PG8_WAIT_V(0);
    if constexpr (!ALIGN_EPI) { if (wr == 0) PG8_BAR; }
    PG8_BAR;
#undef PG8_SA
#undef PG8_SB
#undef PG8_STAGE
#undef PG8_LDA
#undef PG8_LDB
#undef PG8_MMA
#undef PG8_LD32
#undef PG8_H0
#undef PG8_H1
#undef PG8_WAIT_V
#undef PG8_WAIT_L
#undef PG8_BAR
#undef PG8_SCHED
}
}
#define GAS __attribute__((address_space(1)))
typedef float f32x4 __attribute__((ext_vector_type(4)));
typedef float f32x16 __attribute__((ext_vector_type(16)));
typedef short bf16x8 __attribute__((ext_vector_type(8)));
typedef unsigned v4u __attribute__((ext_vector_type(4)));
typedef unsigned v2u __attribute__((ext_vector_type(2)));
#define LDS_WAIT() asm volatile("s_waitcnt lgkmcnt(0)" ::: "memory")
#define VM_WAIT() asm volatile("s_waitcnt vmcnt(0)" ::: "memory")
__device__ __forceinline__ unsigned pk2(float lo, float hi) { return f2bf(lo) | (f2bf(hi) << 16); }

constexpr int NWAVES = 8, NTHR = 512;
constexpr int LDS_STAGE = 0;
constexpr int LDS_RS = 131072;
constexpr int LDS_ROWTOK = LDS_RS + 8192;
constexpr int LDS_GATE = LDS_ROWTOK + 8192;
constexpr int LDS_MISC = LDS_GATE + 8192;
constexpr int LDS_BYTES = LDS_MISC + 256;
constexpr size_t WO_IN = 0, WO_SM = 6 * MiB, WO_RHI = 6 * MiB + 65536, WO_RLO = 6 * MiB + 131072, WO_OUT = 7 * MiB, WO_XQ = 9 * MiB, WO_XO = 10 * MiB, WO_GU = 11 * MiB, WO_D = 43 * MiB;
static_assert(WO_D + 16 * MiB <= WS_WLAYER, "weight block");
constexpr int CW_BAR = 4096;
constexpr int MAX_LAUNCH = 40;
static_assert((CW_BAR + MAX_LAUNCH * XCD_BAR_WORDS) * 4 <= (int)(1 * MiB), "ctl");

enum { PH_PRO = 0, PH_XKV = 1, PH_L0 = 2, NPH = 13, PH_FINAL = PH_L0 + NLAYER * NPH, PH_END = PH_FINAL + 1 };
enum { LP_INPROJ = 0, LP_MIXA, LP_MIXB, LP_MIXC, LP_WOUT, LP_XQ, LP_XATTN, LP_XO, LP_ROUTE, LP_SORT, LP_GU, LP_DOWN0, LP_DOWN1 };

struct Args { P p; int ph_lo, ph_hi, li, pad; };

template <bool HAS_RS> struct EpiBf16 {
    static constexpr bool PERM = true;
    bf16* O; int ldc; const LAS float* rstab;
    __device__ __forceinline__ void operator()(const pg8::f32x4 (&acc)[2][2][4][2], const pg8::Unit& u, int iu, int wr, int wc, int fr, int fq) const {
#pragma unroll
        for (int ai = 0; ai < 2; ++ai)
#pragma unroll
            for (int m = 0; m < 4; ++m) {
                const int lrow = ai * 128 + wr * 64 + m * 16 + fr;
                float sc = 1.f; if (HAS_RS) sc = rstab[iu * 256 + lrow];
                bf16* rowp = O + (size_t)(u.pm * 256 + lrow) * ldc + u.pn * 256 + wc * 32 + 8 * fq;
#pragma unroll
                for (int bj = 0; bj < 2; ++bj) { const pg8::f32x4 v0 = acc[ai][bj][m][0] * sc, v1 = acc[ai][bj][m][1] * sc;
                    pg8::u32x4 w; w.x = pg8::cvt_pk_bf16(v0[0], v0[1]); w.y = pg8::cvt_pk_bf16(v0[2], v0[3]); w.z = pg8::cvt_pk_bf16(v1[0], v1[1]); w.w = pg8::cvt_pk_bf16(v1[2], v1[3]);
                    st_b128(rowp + bj * 128, w); }
            }
    }
};
__device__ __forceinline__ unsigned pk4_fp8(float a, float b, float c, float d) { int w = __builtin_amdgcn_cvt_pk_fp8_f32(a, b, 0, false); w = __builtin_amdgcn_cvt_pk_fp8_f32(c, d, w, true); return (unsigned)w; }
struct EpiGU {
    static constexpr bool PERM = true;
    unsigned char* U8; const LAS float* rstab;
    __device__ __forceinline__ void operator()(const pg8::f32x4 (&acc)[2][2][4][2], const pg8::Unit& u, int iu, int wr, int wc, int fr, int fq) const {
#pragma unroll
        for (int ai = 0; ai < 2; ++ai)
#pragma unroll
            for (int m = 0; m < 4; ++m) {
                const int lrow = ai * 128 + wr * 64 + m * 16 + fr;
                const float sc = rstab[iu * 256 + lrow];
                float o[8];
#pragma unroll
                for (int n = 0; n < 2; ++n)
#pragma unroll
                    for (int j = 0; j < 4; ++j) { const float g = acc[ai][0][m][n][j] * sc, uu = acc[ai][1][m][n][j] * sc; o[n * 4 + j] = 4.f * g * uu * __builtin_amdgcn_rcpf(1.f + __expf(-g)); }
                pg8::u32x2 w; w.x = pk4_fp8(o[0], o[1], o[2], o[3]); w.y = pk4_fp8(o[4], o[5], o[6], o[7]);
                st_b64(U8 + (size_t)(u.pm * 256 + lrow) * 512 + u.pn * 128 + wc * 32 + 8 * fq, w);
            }
    }
};
template <int MODE, bool W8 = false> struct EpiRes {
    static constexpr bool PERM = false;
    static constexpr bool MOE = MODE != 0;
    bf16* hb; float* ssq; const LAS int* rowtab; const LAS float* gatetab; float gs; bf16* t0; unsigned char* h8;
    __device__ __forceinline__ void operator()(const pg8::f32x4 (&acc)[2][2][4][2], const pg8::Unit& u, int iu, int wr, int wc, int fr, int fq) const {
#pragma unroll
        for (int ai = 0; ai < 2; ++ai)
#pragma unroll
            for (int m = 0; m < 4; ++m) {
                const int lrow = ai * 128 + wr * 64 + m * 16 + fr;
                int row = u.pm * 256 + lrow; float g = gs;
                if (MOE) { row = rowtab[iu * 256 + lrow]; g = gatetab[iu * 256 + lrow] * gs; }
                const bool ok = !MOE || row >= 0;
                const size_t off = (size_t)(ok ? row : 0) * DM + u.pn * 256 + wc * 32 + 4 * fq;
                float q = 0.f;
                if (ok) {
#pragma unroll
                    for (int bj = 0; bj < 2; ++bj)
#pragma unroll
                        for (int n = 0; n < 2; ++n) {
                            if (MODE == 1) { const pg8::f32x4 o = acc[ai][bj][m][n] * g; pg8::u32x2 w; w.x = pg8::cvt_pk_bf16(o[0], o[1]); w.y = pg8::cvt_pk_bf16(o[2], o[3]); st_b64(t0 + off + bj * 128 + n * 16, w); }
                            else {
                                const pg8::u32x2 bw = *(const pg8::u32x2*)(hb + off + bj * 128 + n * 16);
                                pg8::f32x4 bs; bs[0] = __builtin_bit_cast(float, bw.x << 16); bs[1] = __builtin_bit_cast(float, bw.x & 0xffff0000u); bs[2] = __builtin_bit_cast(float, bw.y << 16); bs[3] = __builtin_bit_cast(float, bw.y & 0xffff0000u);
                                if (MODE == 2) { const pg8::u32x2 tw = *(const pg8::u32x2*)(t0 + off + bj * 128 + n * 16);
                                    bs[0] += __builtin_bit_cast(float, tw.x << 16); bs[1] += __builtin_bit_cast(float, tw.x & 0xffff0000u); bs[2] += __builtin_bit_cast(float, tw.y << 16); bs[3] += __builtin_bit_cast(float, tw.y & 0xffff0000u); }
                                const pg8::f32x4 o = bs + acc[ai][bj][m][n] * g;
                                pg8::u32x2 w; w.x = pg8::cvt_pk_bf16(o[0], o[1]); w.y = pg8::cvt_pk_bf16(o[2], o[3]);
                                const float r0 = __builtin_bit_cast(float, w.x << 16), r1 = __builtin_bit_cast(float, w.x & 0xffff0000u), r2 = __builtin_bit_cast(float, w.y << 16), r3 = __builtin_bit_cast(float, w.y & 0xffff0000u);
                                q += (r0 * r0 + r1 * r1) + (r2 * r2 + r3 * r3);
                                st_b64(hb + off + bj * 128 + n * 16, w);
                                if (W8) *(unsigned*)(h8 + off + bj * 128 + n * 16) = pk4_fp8(o[0], o[1], o[2], o[3]); } }
                }
                if (MODE != 1) { q += __shfl_xor(q, 16); q += __shfl_xor(q, 32); if (fq == 0 && ok) ssq[(size_t)row * 16 + u.pn * 4 + wc] = q; }
            }
    }
};
template <bool GATH> struct MoeOrder {
    static constexpr bool GATHER = GATH;
    const char* A; const char* Bt; int K; size_t estride; int lo, hi, G, c; const int* tilee; const LAS int* rowtab;
    __device__ bool next(int i, pg8::Unit& u) const { const int L = i * G + c, t = lo + (L >> 2); if (t >= hi) return false; u.pm = t; u.pn = L & 3; u.e = tilee[t]; return true; }
    __device__ __forceinline__ const char* a_base(const pg8::Unit& u) const { return GATH ? A : A + (size_t)u.pm * (size_t)512 * K; }
    __device__ __forceinline__ const char* b_base(const pg8::Unit& u) const { return Bt + (size_t)u.e * estride + (size_t)u.pn * (size_t)512 * K; }
    __device__ __forceinline__ void a_voff(int iu, int h, int R0, int R1, unsigned (&v)[2]) const { v[0] = (unsigned)rowtab[iu * 256 + h * 128 + R0] * (unsigned)(K * 2); v[1] = (unsigned)rowtab[iu * 256 + h * 128 + R1] * (unsigned)(K * 2); }
};

__device__ __forceinline__ void router_weights(const P& p, int gtid, int gstride);
__device__ __forceinline__ void tr_item(const float* W, int N, int K, int k0, int n0, const float* gain, float scale, bf16* dst, LAS float* scr, int lane) {
    const int kr = lane >> 3, c4 = lane & 7;
    f32x4 v[8];
#pragma unroll
    for (int i = 0; i < 8; ++i) v[i] = *(const f32x4*)(W + (size_t)(k0 + 8 * i + kr) * N + n0 + 4 * c4);
#pragma unroll
    for (int i = 0; i < 8; ++i) { const int kk = 8 * i + kr; float g = scale; if (gain) g *= gain[k0 + kk];
        LAS float* d = scr + kk * 33 + 4 * c4; d[0] = v[i].x * g; d[1] = v[i].y * g; d[2] = v[i].z * g; d[3] = v[i].w * g; }
    LDS_WAIT();
    const int c = lane & 7;
#pragma unroll
    for (int j = 0; j < 4; ++j) { const int n = (lane >> 3) + 8 * j; const LAS float* s = scr + (8 * c) * 33 + n;
        v4u o; o.x = pk2(s[0 * 33], s[1 * 33]); o.y = pk2(s[2 * 33], s[3 * 33]); o.z = pk2(s[4 * 33], s[5 * 33]); o.w = pk2(s[6 * 33], s[7 * 33]);
        st_b128(dst + (size_t)n * K + k0 + 8 * c, o); }
    LDS_WAIT();
}
__device__ __forceinline__ void tr_item8(const float* W, int N, int K, int k0, int n0, const float* gain, float scale, unsigned char* dst, LAS float* scr, int lane) {
    const int kr = lane >> 3, c4 = lane & 7;
    f32x4 v[8];
#pragma unroll
    for (int i = 0; i < 8; ++i) v[i] = *(const f32x4*)(W + (size_t)(k0 + 8 * i + kr) * N + n0 + 4 * c4);
#pragma unroll
    for (int i = 0; i < 8; ++i) { const int kk = 8 * i + kr; float g = scale; if (gain) g *= gain[k0 + kk];
        LAS float* d = scr + kk * 33 + 4 * c4; d[0] = v[i].x * g; d[1] = v[i].y * g; d[2] = v[i].z * g; d[3] = v[i].w * g; }
    LDS_WAIT();
    const int c = lane & 7;
#pragma unroll
    for (int j = 0; j < 4; ++j) { const int n = (lane >> 3) + 8 * j; const LAS float* s = scr + (8 * c) * 33 + n;
        v2u o; o.x = pk4_fp8(s[0 * 33], s[1 * 33], s[2 * 33], s[3 * 33]); o.y = pk4_fp8(s[4 * 33], s[5 * 33], s[6 * 33], s[7 * 33]);
        st_b64(dst + (size_t)n * K + k0 + 8 * c, o); }
    LDS_WAIT();
}
constexpr int IT_LAYER = 15360;
__device__ __forceinline__ void prologue_item(const P& p, int it, LAS float* scr, int lane) {
    const int l = it / IT_LAYER; int r = it % IT_LAYER;
    unsigned char* wl = ws_base(p.ws) + WS_W + (size_t)l * WS_WLAYER;
    if (r < 1536) {
        const int seg = r / 768; r %= 768; const int kb = r / 48, nb = r % 48; const int n0 = (seg ? 1544 : 0) + 32 * nb, drow = seg * 1536 + 32 * nb;
        const float sc = drow < 512 ? 0.125f * LOG2E : ((drow >= C_GQ && drow < C_GK) ? 0.125f : 1.f);
        tr_item(p.w_in + (size_t)l * DM * INW, INW, DM, 64 * kb, n0, p.mix_norm + l * DM, sc, (bf16*)(wl + WO_IN) + (size_t)drow * DM, scr, lane); return; }
    r -= 1536;
    if (r < 512) { const int kb = r / 32, nb = r % 32; tr_item(p.w_out + (size_t)l * DM * DM, DM, DM, 64 * kb, 32 * nb, nullptr, 1.f, (bf16*)(wl + WO_OUT) + (size_t)(32 * nb) * DM, scr, lane); return; }
    r -= 512;
    if (r < 256) { const int kb = r / 16, nb = r % 16; tr_item(p.w_xq + (size_t)l * DM * 512, 512, DM, 64 * kb, 32 * nb, p.cross_norm + l * DM, 0.08838834764831845f * LOG2E, (bf16*)(wl + WO_XQ) + (size_t)(32 * nb) * DM, scr, lane); return; }
    r -= 256;
    if (r < 256) { const int kb = r / 32, nb = r % 32; tr_item(p.w_xo + (size_t)l * 512 * DM, DM, 512, 64 * kb, 32 * nb, nullptr, 1.f, (bf16*)(wl + WO_XO) + (size_t)(32 * nb) * 512, scr, lane); return; }
    r -= 256;
    if (r < 512) { const int kv = r / 256; r %= 256; const int kb = r / 16, nb = r % 16;
        tr_item((kv ? p.w_xv : p.w_xk) + (size_t)l * DM * 512, 512, DM, 64 * kb, 32 * nb, nullptr, 1.f, (bf16*)(ws_base(p.ws) + WS_WXKV) + (size_t)(l * 1024 + kv * 512 + 32 * nb) * DM, scr, lane); return; }
    r -= 512;
    if (r < 8192) { const int up = r / 4096; r %= 4096; const int e = r / 256; r %= 256; const int kb = r / 16, nb = r % 16; const int c0 = 32 * nb, drow = (c0 >> 7) * 256 + up * 128 + (c0 & 127);
        tr_item8((up ? p.w_eu : p.w_eg) + ((size_t)l * 16 + e) * DM * 512, 512, DM, 64 * kb, c0, p.moe_norm + l * DM, 32.f, (unsigned char*)(wl + WO_GU) + ((size_t)e * 1024 + drow) * DM, scr, lane); return; }
    r -= 8192;
    { const int e = r / 256; r %= 256; const int kb = r / 32, nb = r % 32;
      tr_item8(p.w_ed + ((size_t)l * 16 + e) * 512 * DM, DM, 512, 64 * kb, 32 * nb, nullptr, 32.f, (unsigned char*)(wl + WO_D) + ((size_t)e * 1024 + 32 * nb) * 512, scr, lane); }
}
__device__ __forceinline__ void row_to_bf16(const float* src, bf16* dst, float* ssq, const float* gain, int lane, int mode) {
    const f32x4* s = (const f32x4*)src + lane;
    f32x4 v[4]; float q = 0.f;
#pragma unroll
    for (int j = 0; j < 4; ++j) { v[j] = s[64 * j]; q += (v[j].x * v[j].x + v[j].y * v[j].y) + (v[j].z * v[j].z + v[j].w * v[j].w); }
    q = wave_sum(q);
    float sc = 1.f;
    if (mode == 1) sc = rsqrtf(q * (1.0f / DM) + EPS);
    v2u* d = (v2u*)dst + lane; float q2 = 0.f;
#pragma unroll
    for (int j = 0; j < 4; ++j) {
        f32x4 g = (f32x4){1.f, 1.f, 1.f, 1.f}; if (mode == 1) g = ((const f32x4*)gain)[lane + 64 * j];
        v2u o; o.x = pk2(v[j].x * sc * g.x, v[j].y * sc * g.y); o.y = pk2(v[j].z * sc * g.z, v[j].w * sc * g.w); st_b64(d + 64 * j, o);
        const float r0 = __builtin_bit_cast(float, o.x << 16), r1 = __builtin_bit_cast(float, o.x & 0xffff0000u), r2 = __builtin_bit_cast(float, o.y << 16), r3 = __builtin_bit_cast(float, o.y & 0xffff0000u);
        q2 += (r0 * r0 + r1 * r1) + (r2 * r2 + r3 * r3); }
    if (mode == 0) { q2 = wave_sum(q2); if (lane < 16) ssq[lane] = lane == 0 ? q2 : 0.f; }
}
__device__ __forceinline__ void prologue(const P& p, LAS unsigned char* lds, int vcu, int G, int wave, int lane) {
    asm volatile("" : "+v"(lane));
    LAS float* scr = (LAS float*)(lds + LDS_STAGE + wave * 16384);
    const int gw = vcu * NWAVES + wave, NGW = G * NWAVES;
    for (int it = gw; it < NLAYER * IT_LAYER; it += NGW) prologue_item(p, it, scr, lane);
    for (int idx = gw * 64 + lane; idx < NLAYER * 2 * 32768; idx += NGW * 64) {
        const int l = idx / 65536, r = idx % 65536, which = r / 32768, e = r % 32768, row = e / 1024, k = e % 1024;
        unsigned char* wl = ws_base(p.ws) + WS_W + (size_t)l * WS_WLAYER;
        if (which == 0) {
            float v = 0.f;
            if (row < 8) v = p.w_in[((size_t)l * DM + k) * INW + 1536 + row]; else if (row < 24) v = p.w_in[((size_t)l * DM + k) * INW + 3080 + (row - 8)];
            ((bf16*)(wl + WO_SM))[row * 1024 + k] = (bf16)f2bf(v * p.mix_norm[l * DM + k]);
        }
    }
    router_weights(p, gw * 64 + lane, NGW * 64);
    for (int m = gw; m < 4096; m += NGW) row_to_bf16(p.mem + (size_t)m * DM, WSP(bf16, WS_MEMN) + (size_t)m * DM, nullptr, p.mem_norm, lane, 1);
    for (int m = gw; m < NTOK; m += NGW) row_to_bf16(p.x + (size_t)m * DM, WSP(bf16, WS_HB) + (size_t)m * DM, WSP(float, WS_SSQ) + (size_t)m * 16, nullptr, lane, 0);
}
__device__ __forceinline__ void small_proj(const P& p, int l, int vcu, int G, int wave, int lane) {
    asm volatile("" : "+v"(lane));
    const int gw = vcu * NWAVES + wave, NGW = G * NWAVES;
    const bf16* wsm = (const bf16*)(ws_base(p.ws) + WS_W + (size_t)l * WS_WLAYER + WO_SM);
    const bf16* hb = WSP(bf16, WS_HB); const float* ssq = WSP(float, WS_SSQ); float* sm = WSP(float, WS_SM);
    const int r = lane & 31, hh = lane >> 5;
    for (int blk = gw; blk < NTOK / 32; blk += NGW) {
        const int tok0 = blk * 32;
        const bf16x8* ap = (const bf16x8*)(hb + (size_t)(tok0 + r) * DM + hh * 32);
        const bf16x8* bp = (const bf16x8*)(wsm + (size_t)r * DM + hh * 32);
        f32x16 acc = {};
#pragma unroll 2
        for (int s = 0; s < 16; ++s) {
#pragma unroll
            for (int j = 0; j < 4; ++j) acc = __builtin_amdgcn_mfma_f32_32x32x16_bf16(ap[s * 8 + j], bp[s * 8 + j], acc, 0, 0, 0);
        }
        const float rsv = row_rs(ssq, tok0 + r);
#pragma unroll
        for (int g = 0; g < 16; ++g) { const int trow = (g & 3) + 8 * (g >> 2) + 4 * hh; const float rs = __shfl(rsv, trow); if (r < 24) sm[(size_t)(tok0 + trow) * 32 + r] = acc[g] * rs; }
    }
}
typedef short v4i16_t __attribute__((ext_vector_type(4)));
typedef __bf16 bf16x2_t __attribute__((ext_vector_type(2)));
typedef float f32x2_t __attribute__((ext_vector_type(2)));
__device__ __forceinline__ unsigned cvtpk(float lo, float hi) { f32x2_t v = {lo, hi}; bf16x2_t b = __builtin_convertvector(v, bf16x2_t); return __builtin_bit_cast(unsigned, b); }
__device__ __forceinline__ bf16x8 pack8(const f32x16& p, int o) {
    v4u w; w.x = cvtpk(p[o], p[o + 1]); w.y = cvtpk(p[o + 2], p[o + 3]); w.z = cvtpk(p[o + 4], p[o + 5]); w.w = cvtpk(p[o + 6], p[o + 7]);
    return __builtin_bit_cast(bf16x8, w);
}
template <int D, bool FOX>
__device__ __forceinline__ void attn_unit(LAS unsigned char* lds, const bf16* Qg, int qpitch, const bf16* Kg, const bf16* Vg, int kvpitch, int NT,
                                          const float* cb, int q0, bf16* Og, int opitch, const float* gain, const float* kn) {
    constexpr int KS = D * 2 + 16, VS = D * 2 + 64;
    constexpr int KBYTES = 64 * KS, VBYTES = 64 * VS;
    constexpr int CPR = D / 8, NCH = 64 * CPR / NTHR, NS = D / 16, NDB = D / 32;
    constexpr int OFF_K = 0, OFF_V = 2 * KBYTES, OFF_CB = 2 * KBYTES + 2 * VBYTES, OFF_FX = OFF_CB + 512;
    int tid = threadIdx.x; asm volatile("" : "+v"(tid));
    const int lane = tid & 63, wave = __builtin_amdgcn_readfirstlane(tid >> 6), r32 = lane & 31, hh = lane >> 5;
    bf16x8 qf[NS];
    { const bf16* qrow = Qg + (size_t)(wave * 32 + r32) * qpitch;
#pragma unroll
      for (int s = 0; s < NS; ++s) qf[s] = *(const bf16x8*)(qrow + 16 * s + 8 * hh); }
    v4u kreg[NCH], vreg[NCH]; f32x4 cbreg = {0.f, 0.f, 0.f, 0.f};
#define AT_GLOAD(t) do { _Pragma("unroll") for (int i_ = 0; i_ < NCH; ++i_) { const int idx_ = tid + NTHR * i_, key_ = idx_ / CPR, c_ = idx_ % CPR; \
        kreg[i_] = *(const v4u*)(Kg + (size_t)((t) * 64 + key_) * kvpitch + c_ * 8); vreg[i_] = *(const v4u*)(Vg + (size_t)((t) * 64 + key_) * kvpitch + c_ * 8); } \
        if (FOX && tid < 16) cbreg = *(const f32x4*)(cb + (t) * 64 + tid * 4); } while (0)
#define AT_LSTORE(b) do { _Pragma("unroll") for (int i_ = 0; i_ < NCH; ++i_) { const int idx_ = tid + NTHR * i_, key_ = idx_ / CPR, c_ = idx_ % CPR; \
        *(LAS v4u*)(lds + OFF_K + (b) * KBYTES + key_ * KS + c_ * 16) = kreg[i_]; *(LAS v4u*)(lds + OFF_V + (b) * VBYTES + key_ * VS + c_ * 16) = vreg[i_]; } \
        if (FOX && tid < 16) *(LAS f32x4*)(lds + OFF_CB + (b) * 256 + tid * 16) = cbreg; } while (0)
    float m = -INFINITY, l = 0.f;
    f32x16 o[NDB];
#pragma unroll
    for (int d = 0; d < NDB; ++d) o[d] = f32x16{};
    const int qlo = q0 + wave * 32, qabs = qlo + r32;
    float knpre = 0.f, qkmax = 0.f;
    LAS float* fx = (LAS float*)(lds + OFF_FX);
    __syncthreads();
    if (FOX) {
        float qn2 = 0.f;
#pragma unroll
        for (int s = 0; s < NS; ++s)
#pragma unroll
            for (int e = 0; e < 8; ++e) { const float v = __builtin_bit_cast(float, ((unsigned)(unsigned short)qf[s][e]) << 16); qn2 += v * v; }
        qn2 += __shfl_xor(qn2, 32);
        qn2 = wave_max(qn2);
        if (lane == 0) fx[wave] = qn2;
        knpre = lane < 32 ? kn[lane] : 0.f;
#pragma unroll
        for (int o_ = 1; o_ < 32; o_ <<= 1) { const float t_ = __shfl_up(knpre, o_); if (lane >= o_) knpre = fmaxf(knpre, t_); }
    }
    const int t_first = FOX ? NT - 1 : 0;
    AT_GLOAD(t_first); AT_LSTORE(0);
    __syncthreads();
    if (FOX) { float q2 = fx[0];
#pragma unroll
        for (int w_ = 1; w_ < 8; ++w_) q2 = fmaxf(q2, fx[w_]);
        qkmax = sqrtf(q2); }
#pragma unroll 1
    for (int it = 0; it < NT; ++it) {
        const int b = it & 1;
        const int t = FOX ? NT - 1 - it : it;
        const int tn = FOX ? t - 1 : t + 1;
        if (it + 1 < NT) AT_GLOAD(tn);
        const int kt0 = t * 64;
        if (!FOX || kt0 <= qlo + 31) {
            f32x16 p[2];
#pragma unroll
            for (int kb = 0; kb < 2; ++kb) {
                if (FOX) {
#pragma unroll
                    for (int g = 0; g < 4; ++g) { const f32x4 c4 = *(const LAS f32x4*)(lds + OFF_CB + b * 256 + (kb * 32 + 8 * g + 4 * hh) * 4); p[kb][4 * g] = c4.x; p[kb][4 * g + 1] = c4.y; p[kb][4 * g + 2] = c4.z; p[kb][4 * g + 3] = c4.w; }
                } else p[kb] = f32x16{};
                const LAS unsigned char* kp = lds + OFF_K + b * KBYTES + (kb * 32 + r32) * KS + hh * 16;
#pragma unroll
                for (int s = 0; s < NS; ++s) { const bf16x8 kf = *(const LAS bf16x8*)(kp + s * 32); p[kb] = __builtin_amdgcn_mfma_f32_32x32x16_bf16(kf, qf[s], p[kb], 0, 0, 0); }
            }
            if (FOX && kt0 + 63 > qlo) {
#pragma unroll
                for (int kb = 0; kb < 2; ++kb)
#pragma unroll
                    for (int r = 0; r < 16; ++r) { const int key = kt0 + kb * 32 + (r & 3) + 8 * (r >> 2) + 4 * hh; if (key > qabs) p[kb][r] = -INFINITY; }
            }
            float mt = fmaxf(p[0][0], p[1][0]);
#pragma unroll
            for (int r = 1; r < 16; ++r) mt = fmaxf(mt, fmaxf(p[0][r], p[1][r]));
            mt = fmaxf(mt, __shfl_xor(mt, 32));
            const float mnew = fmaxf(m, mt);
            float ls = 0.f;
#pragma unroll
            for (int kb = 0; kb < 2; ++kb)
#pragma unroll
                for (int r = 0; r < 16; ++r) { const float e = __builtin_amdgcn_exp2f(p[kb][r] - mnew); p[kb][r] = e; ls += e; }
            if (!FOX || __builtin_amdgcn_ballot_w64(mnew > m) != 0ull) {
                const float alpha = __builtin_amdgcn_exp2f(m - mnew);
                l *= alpha;
#pragma unroll
                for (int d = 0; d < NDB; ++d)
#pragma unroll
                    for (int r = 0; r < 16; ++r) o[d][r] *= alpha;
            }
            m = mnew; l += ls;
            bf16x8 pa[2][2];
#pragma unroll
            for (int kb = 0; kb < 2; ++kb) { pa[kb][0] = pack8(p[kb], 0); pa[kb][1] = pack8(p[kb], 8); }
            const LAS unsigned char* vp = lds + OFF_V + b * VBYTES + (4 * hh + ((lane & 15) >> 2)) * VS + (16 * ((lane >> 4) & 1) + 4 * (lane & 3)) * 2;
#pragma unroll
            for (int d = 0; d < NDB; ++d) {
#pragma unroll
                for (int kb = 0; kb < 2; ++kb)
#pragma unroll
                    for (int ks = 0; ks < 2; ++ks) {
                        const LAS unsigned char* a0 = vp + (kb * 32 + 16 * ks) * VS + d * 64;
                        const v4i16_t lo = __builtin_amdgcn_ds_read_tr16_b64_v4i16((LAS v4i16_t*)a0);
                        const v4i16_t hi = __builtin_amdgcn_ds_read_tr16_b64_v4i16((LAS v4i16_t*)(a0 + 8 * VS));
                        const bf16x8 vf = (bf16x8){lo[0], lo[1], lo[2], lo[3], hi[0], hi[1], hi[2], hi[3]};
                        o[d] = __builtin_amdgcn_mfma_f32_32x32x16_bf16(vf, pa[kb][ks], o[d], 0, 0, 0);
                    }
            }
        }
        if (FOX) { const float mm = wave_min(m); if (lane == 0) fx[8 + b * 8 + wave] = mm; }
        if (it + 1 < NT) AT_LSTORE(b ^ 1);
        __syncthreads();
        if (FOX && t > 0) {
            float M0 = fx[8 + b * 8];
#pragma unroll
            for (int w_ = 1; w_ < 8; ++w_) M0 = fminf(M0, fx[8 + b * 8 + w_]);
            const float cbl = *(const LAS float*)(lds + OFF_CB + (b ^ 1) * 256 + 63 * 4);
            const float knb = __builtin_bit_cast(float, __builtin_amdgcn_readlane(__builtin_bit_cast(int, knpre), t - 1));
            if (qkmax * knb + cbl < M0 - 40.f) break;
        }
    }
#undef AT_GLOAD
#undef AT_LSTORE
    l += __shfl_xor(l, 32);
    const float inv = 1.0f / l;
    float rs = inv;
    if (FOX) {
        float ss = 0.f;
#pragma unroll
        for (int d = 0; d < NDB; ++d)
#pragma unroll
            for (int r = 0; r < 16; ++r) { const float v = o[d][r] * inv; ss += v * v; }
        ss += __shfl_xor(ss, 32);
        rs = inv * rsqrtf(ss * (1.0f / D) + EPS);
    }
    bf16* orow = Og + (size_t)(wave * 32 + r32) * opitch;
#pragma unroll
    for (int d = 0; d < NDB; ++d)
#pragma unroll
        for (int g = 0; g < 4; ++g) {
            f32x4 gn = {1.f, 1.f, 1.f, 1.f}; if (FOX) gn = *(const f32x4*)(gain + 32 * d + 8 * g + 4 * hh);
            v2u w; w.x = cvtpk(o[d][4 * g] * rs * gn.x, o[d][4 * g + 1] * rs * gn.y); w.y = cvtpk(o[d][4 * g + 2] * rs * gn.z, o[d][4 * g + 3] * rs * gn.w);
            st_b64(orow + 32 * d + 8 * g + 4 * hh, w);
        }
}
__device__ __forceinline__ void fox_phase(const P& p, int l, LAS unsigned char* lds, int vcu, int G) {
    const bf16* proj = WSP(bf16, WS_PROJ); const float* cb = WSP(float, WS_CB); bf16* y = WSP(bf16, WS_Y);
    for (int pu = vcu; pu < 512; pu += G) {
        const int bh = pu >> 2, pr = pu < 256 ? (pu & 3) : 3 - (pu & 3), b = bh >> 3, h = bh & 7;
        for (int half = 0; half < 2; ++half) {
            const int qb = half ? pr : 7 - pr;
            const size_t row0 = (size_t)b * SEQ;
            attn_unit<64, true>(lds, proj + (row0 + qb * 256) * PW + C_FQ + h * 64, PW, proj + row0 * PW + C_FK + h * 64, proj + row0 * PW + C_FV + h * 64, PW, 4 * (qb + 1),
                                cb + ((size_t)b * 8 + h) * SEQ, qb * 256, y + (row0 + qb * 256) * DM + h * 64, DM, p.fox_gain + l * 512 + h * 64, WSP(const float, WS_MOE + MO_KN) + (b * 8 + h) * 32);
        }
    }
}
__device__ __forceinline__ void xattn_phase(const P& p, int l, LAS unsigned char* lds, int vcu, int G, bool dummy) {
    bf16* xq = WSP(bf16, WS_XQ); const bf16* xkv = WSP(bf16, WS_XKV);
    for (int u = vcu; u < 512; u += G) {
        const int b = u >> 5, h = (u >> 3) & 3, qb = u & 7;
        bf16* qp = xq + ((size_t)b * SEQ + qb * 256) * 512 + h * 128;
        const bf16* kp = xkv + (size_t)b * MEML * 2048 + l * 1024 + h * 128;
        attn_unit<128, false>(lds, qp, 512, kp, kp + 512, 2048, 4, nullptr, 0, dummy ? WSP(bf16, WS_Y) + (qp - xq) : qp, 512, nullptr, nullptr);
    }
}
constexpr size_t WS_GB = WS_END;
constexpr size_t WS_GDEC = WS_GB + 32 * MiB;
constexpr size_t WS_END2 = WS_GDEC + 1 * MiB;
static_assert(WS_END2 <= 512 * MiB, "workspace map 2");
constexpr int GL_B = 0;
constexpr int GL_TOT = 16384;
constexpr int GL_Q1 = 18432, GL_Q2 = GL_Q1 + 64 * 144, GL_K2 = GL_Q2 + 64 * 144;
constexpr int GL_KD = GL_K2 + 64 * 144;
constexpr int GL_V = GL_KD + 64 * 192;
constexpr int GL_SSQ = GL_V + 64 * 320;
constexpr int GL_GA = GL_SSQ + 1024;
constexpr int GL_END = GL_GA + 4096;
static_assert(GL_END <= 131072, "gla lds");

__device__ __forceinline__ float fast_log_sigmoid(float z) { return fminf(z, 0.f) - __logf(1.f + __expf(-fabsf(z))); }
__device__ __forceinline__ void gla_decay(const P& p, int l, int h, size_t tok0, LAS unsigned char* lds, int lane, int wave) {
    const float* sm = WSP(float, WS_SM);
    float w[16];
#pragma unroll
    for (int r = 0; r < 16; ++r) w[r] = p.w_alpha_up[((size_t)l * 16 + r) * 256 + h * 64 + lane];
    const float bias = p.b_alpha[l * 256 + h * 64 + lane];
    LAS f32x4* gat = (LAS f32x4*)(lds + GL_GA + wave * 512);
    if (lane < 32) gat[lane] = *(const f32x4*)(sm + (tok0 + wave * 8 + (lane >> 2)) * 32 + 8 + 4 * (lane & 3));
    float bl[8]; float run = 0.f;
#pragma unroll
    for (int j = 0; j < 8; ++j) {
        float z = bias;
#pragma unroll
        for (int r4 = 0; r4 < 4; ++r4) { const f32x4 g4 = gat[j * 4 + r4]; z += g4.x * w[4 * r4] + g4.y * w[4 * r4 + 1] + g4.z * w[4 * r4 + 2] + g4.w * w[4 * r4 + 3]; }
        run += fast_log_sigmoid(z) * (1.0f / 16.0f); bl[j] = run;
    }
    LAS float* tot = (LAS float*)(lds + GL_TOT);
    tot[wave * 64 + lane] = run;
    __syncthreads();
    float pre = 0.f;
#pragma unroll
    for (int g = 0; g < 8; ++g) { const float t = tot[g * 64 + lane]; if (g < wave) pre += t; }
    LAS float* Bm = (LAS float*)(lds + GL_B);
#pragma unroll
    for (int j = 0; j < 8; ++j) Bm[(wave * 8 + j) * 64 + lane] = bl[j] + pre;
    __syncthreads();
}
__device__ __forceinline__ void gla_load_v(const bf16* proj, size_t tok0, int h, LAS unsigned char* lds, int tid) {
#pragma unroll
    for (int i = 0; i < 2; ++i) { const int idx = tid + NTHR * i, t = idx >> 4, c = idx & 15;
        *(LAS v4u*)(lds + GL_V + t * 320 + c * 16) = *(const v4u*)(proj + (tok0 + t) * PW + C_GV + h * 128 + c * 8); }
}
__device__ __forceinline__ bf16x8 tr_frag(const LAS unsigned char* a0, int rowstride4) {
    const v4i16_t lo = __builtin_amdgcn_ds_read_tr16_b64_v4i16((LAS v4i16_t*)a0);
    const v4i16_t hi = __builtin_amdgcn_ds_read_tr16_b64_v4i16((LAS v4i16_t*)(a0 + rowstride4));
    return (bf16x8){lo[0], lo[1], lo[2], lo[3], hi[0], hi[1], hi[2], hi[3]};
}
__device__ __forceinline__ void gla_phase_a(const P& p, int l, LAS unsigned char* lds, int vcu, int G) {
    int tid = threadIdx.x; asm volatile("" : "+v"(tid));
    const int lane = tid & 63, wave = __builtin_amdgcn_readfirstlane(tid >> 6), hh = lane >> 5;
    const bf16* proj = WSP(bf16, WS_PROJ); float* loc = ((float*)p.out); float* dec = WSP(float, WS_GDEC); const float* sm = WSP(float, WS_SM); float* gb = WSP(float, WS_GB);
    LAS unsigned char* kd = lds + wave * 16384; LAS unsigned char* vh = kd + 8192;
    const int crow8 = lane >> 3, cch = lane & 7;
    const int trow = (lane & 15) >> 2, tcol = 16 * ((lane >> 4) & 1) + 4 * (lane & 3);
    for (int u = vcu * NWAVES + wave; u < 2048; u += G * NWAVES) {
        const int c = u & 31, h = (u >> 5) & 3, b = u >> 7;
        const size_t tok0 = (size_t)b * SEQ + c * 64;
        v4u kreg[8], v0reg[8], v1reg[8];
#pragma unroll
        for (int i = 0; i < 8; ++i) { const bf16* rp = proj + (tok0 + i * 8 + crow8) * PW;
            kreg[i] = *(const v4u*)(rp + C_GK + h * 64 + cch * 8); v0reg[i] = *(const v4u*)(rp + C_GV + h * 128 + cch * 8); v1reg[i] = *(const v4u*)(rp + C_GV + h * 128 + 64 + cch * 8); }
        float w[16];
#pragma unroll
        for (int r = 0; r < 16; ++r) w[r] = p.w_alpha_up[((size_t)l * 16 + r) * 256 + h * 64 + lane];
        const float bias = p.b_alpha[l * 256 + h * 64 + lane];
        { LAS f32x4* gw = (LAS f32x4*)vh;
#pragma unroll
          for (int i = 0; i < 4; ++i) gw[lane * 4 + i] = *(const f32x4*)(sm + (tok0 + lane) * 32 + 8 + 4 * i); }
        float bt[64]; float run = 0.f;
#pragma unroll
        for (int t = 0; t < 64; ++t) {
            float z = bias;
#pragma unroll
            for (int r4 = 0; r4 < 4; ++r4) { const f32x4 g4 = ((const LAS f32x4*)vh)[t * 4 + r4]; z += g4.x * w[4 * r4] + g4.y * w[4 * r4 + 1] + g4.z * w[4 * r4 + 2] + g4.w * w[4 * r4 + 3]; }
            run += fast_log_sigmoid(z) * (1.0f / 16.0f); bt[t] = run; gb[(tok0 + t) * 256 + h * 64 + lane] = run;
        }
#pragma unroll
        for (int i = 0; i < 8; ++i) { *(LAS v4u*)(kd + (i * 8 + crow8) * 128 + cch * 16) = kreg[i]; *(LAS v4u*)(vh + (i * 8 + crow8) * 128 + cch * 16) = v0reg[i]; }
#pragma unroll
        for (int t = 0; t < 64; ++t) { LAS bf16* kp = (LAS bf16*)(kd + t * 128 + lane * 2); *kp = (bf16)f2bf(bf2f(*kp) * __expf(run - bt[t])); }
        dec[(size_t)u * 64 + lane] = __expf(run);
#pragma unroll
        for (int half = 0; half < 2; ++half) {
            if (half == 1) {
#pragma unroll
                for (int i = 0; i < 8; ++i) *(LAS v4u*)(vh + (i * 8 + crow8) * 128 + cch * 16) = v1reg[i];
            }
            f32x16 acc[2][2];
#pragma unroll
            for (int x = 0; x < 2; ++x)
#pragma unroll
                for (int y = 0; y < 2; ++y) acc[x][y] = f32x16{};
#pragma unroll
            for (int s = 0; s < 4; ++s) {
                bf16x8 af[2], bfr[2];
#pragma unroll
                for (int x = 0; x < 2; ++x) { af[x] = tr_frag(vh + (16 * s + 8 * hh + trow) * 128 + (32 * x + tcol) * 2, 4 * 128); bfr[x] = tr_frag(kd + (16 * s + 8 * hh + trow) * 128 + (32 * x + tcol) * 2, 4 * 128); }
#pragma unroll
                for (int x = 0; x < 2; ++x)
#pragma unroll
                    for (int y = 0; y < 2; ++y) acc[x][y] = __builtin_amdgcn_mfma_f32_32x32x16_bf16(af[x], bfr[y], acc[x][y], 0, 0, 0);
            }
#pragma unroll
            for (int x = 0; x < 2; ++x)
#pragma unroll
                for (int y = 0; y < 2; ++y) { float* lo = loc + (size_t)u * 8192 + 32 * y + (lane & 31);
#pragma unroll
                    for (int r = 0; r < 16; ++r) lo[(size_t)(64 * half + 32 * x + (r & 3) + 8 * (r >> 2) + 4 * hh) * 64] = acc[x][y][r]; }
        }
    }
}
__device__ __forceinline__ void gla_phase_b(const P& p, int vcu, int G) {
    int tid = threadIdx.x; asm volatile("" : "+v"(tid));
    float* loc = ((float*)p.out); const float* dec = WSP(float, WS_GDEC);
    for (int u = vcu; u < 256; u += G) {
        const int bh = u >> 2, q4 = u & 3;
        const int e = q4 * 2048 + tid * 4, dk = e & 63;
        f32x4 st = {0.f, 0.f, 0.f, 0.f};
#pragma unroll 2
        for (int c = 0; c < 32; ++c) {
            const size_t cu = (size_t)bh * 32 + c;
            const f32x4 lv = *(const f32x4*)(loc + cu * 8192 + e);
            const f32x4 dv = *(const f32x4*)(dec + cu * 64 + dk);
            asm volatile("s_waitcnt vmcnt(0)" ::: "memory");
            __syncthreads();
            v2u w; w.x = pk2(st.x, st.y); w.y = pk2(st.z, st.w);
            *(v2u*)((unsigned char*)loc + cu * 32768 + 8192 * q4 + 8 * tid) = w;
            st = dv * st + lv;
        }
    }
}
__device__ __forceinline__ void gla_phase_c(const P& p, int l, LAS unsigned char* lds, int vcu, int G) {
    int tid = threadIdx.x; asm volatile("" : "+v"(tid));
    const int lane = tid & 63, wave = __builtin_amdgcn_readfirstlane(tid >> 6), hh = lane >> 5, r32 = lane & 31;
    const bf16* proj = WSP(bf16, WS_PROJ); const unsigned char* gs = ((const unsigned char*)p.out); bf16* y = WSP(bf16, WS_Y); const float* gb = WSP(const float, WS_GB);
    for (int u = vcu; u < 2048; u += G) {
        const int c = u & 31, h = (u >> 5) & 3, b = u >> 7;
        const size_t tok0 = (size_t)b * SEQ + c * 64;
        const int dvb = wave >> 1, tb = wave & 1;
        bf16 qraw[8], kraw[8]; v4u vreg[2]; bf16x8 sfr[4]; v2u ggr[4]; f32x4 gnr[4];
#pragma unroll
        for (int j = 0; j < 8; ++j) { const bf16* rp = proj + (tok0 + wave * 8 + j) * PW + h * 64 + lane; qraw[j] = rp[C_GQ]; kraw[j] = rp[C_GK]; }
#pragma unroll
        for (int i = 0; i < 2; ++i) { const int idx = tid + NTHR * i, t = idx >> 4, cc = idx & 15; vreg[i] = *(const v4u*)(proj + (tok0 + t) * PW + C_GV + h * 128 + cc * 8); }
        { const bf16* sp = (const bf16*)(gs + (size_t)u * 32768 + 8192 * dvb) + r32 * 64 + 8 * hh;
#pragma unroll
          for (int s2 = 0; s2 < 4; ++s2) sfr[s2] = *(const bf16x8*)(sp + 16 * s2); }
        float btv[8];
#pragma unroll
        for (int j = 0; j < 8; ++j) btv[j] = gb[(tok0 + wave * 8 + j) * 256 + h * 64 + lane];
        const float rref = gb[(tok0 + 31) * 256 + h * 64 + lane];
#pragma unroll
        for (int g = 0; g < 4; ++g) { const int dv = 32 * dvb + 8 * g + 4 * hh;
            gnr[g] = *(const f32x4*)(p.gla_gain + l * 512 + h * 128 + dv); ggr[g] = *(const v2u*)(proj + (tok0 + 32 * tb + r32) * PW + C_GG + h * 128 + dv); }
#pragma unroll
        for (int i = 0; i < 2; ++i) { const int idx = tid + NTHR * i, t = idx >> 4, cc = idx & 15; *(LAS v4u*)(lds + GL_V + t * 320 + cc * 16) = vreg[i]; }
#pragma unroll
        for (int j = 0; j < 8; ++j) { const int t = wave * 8 + j; const float bt = btv[j];
            const float qv = bf2f(qraw[j]), kv = bf2f(kraw[j]);
            *(LAS bf16*)(lds + GL_Q1 + t * 144 + lane * 2) = (bf16)f2bf(qv * __expf(bt));
            *(LAS bf16*)(lds + GL_Q2 + t * 144 + lane * 2) = (bf16)f2bf(qv * __expf(bt - rref));
            *(LAS bf16*)(lds + GL_K2 + t * 144 + lane * 2) = (bf16)f2bf(kv * __expf(rref - bt)); }
        __syncthreads();
        const int trow = (lane & 15) >> 2, tcol = 16 * ((lane >> 4) & 1) + 4 * (lane & 3);
        f32x16 o = {};
        {
#pragma unroll
          for (int s = 0; s < 4; ++s) { const bf16x8 af = sfr[s]; const bf16x8 bq = *(const LAS bf16x8*)(lds + GL_Q1 + (32 * tb + r32) * 144 + (16 * s + 8 * hh) * 2);
              o = __builtin_amdgcn_mfma_f32_32x32x16_bf16(af, bq, o, 0, 0, 0); } }
#pragma unroll
        for (int sb = 0; sb < 2; ++sb) {
            if (sb <= tb) {
                f32x16 pt = {};
#pragma unroll
                for (int s = 0; s < 4; ++s) { const bf16x8 ak = *(const LAS bf16x8*)(lds + GL_K2 + (32 * sb + r32) * 144 + (16 * s + 8 * hh) * 2); const bf16x8 bq = *(const LAS bf16x8*)(lds + GL_Q2 + (32 * tb + r32) * 144 + (16 * s + 8 * hh) * 2);
                    pt = __builtin_amdgcn_mfma_f32_32x32x16_bf16(ak, bq, pt, 0, 0, 0); }
                if (sb == tb) {
#pragma unroll
                    for (int r = 0; r < 16; ++r) { const int s_ = (r & 3) + 8 * (r >> 2) + 4 * hh; if (s_ > r32) pt[r] = 0.f; }
                }
#pragma unroll
                for (int ks = 0; ks < 2; ++ks) {
                    const bf16x8 pa = pack8(pt, 8 * ks);
                    const bf16x8 vf = tr_frag(lds + GL_V + (32 * sb + 16 * ks + 4 * hh + trow) * 320 + (32 * dvb + tcol) * 2, 8 * 320);
                    o = __builtin_amdgcn_mfma_f32_32x32x16_bf16(vf, pa, o, 0, 0, 0);
                }
            }
        }
        float ss = 0.f;
#pragma unroll
        for (int r = 0; r < 16; ++r) ss += o[r] * o[r];
        ss += __shfl_xor(ss, 32);
        LAS float* sq = (LAS float*)(lds + GL_SSQ);
        if (hh == 0) sq[dvb * 64 + 32 * tb + r32] = ss;
        __syncthreads();
        const int t = 32 * tb + r32;
        const float tot = (sq[t] + sq[64 + t]) + (sq[128 + t] + sq[192 + t]);
        const float rs = rsqrtf(tot * (1.0f / 128.0f) + EPS);
        const size_t tok = tok0 + t;
#pragma unroll
        for (int g = 0; g < 4; ++g) {
            const int dv = 32 * dvb + 8 * g + 4 * hh;
            const f32x4 gn = gnr[g];
            const v2u gg = ggr[g];
            const float g0 = bf2f((bf16)(gg.x & 0xffff)), g1 = bf2f((bf16)(gg.x >> 16)), g2 = bf2f((bf16)(gg.y & 0xffff)), g3 = bf2f((bf16)(gg.y >> 16));
            const float v0 = o[4 * g] * rs * gn.x * g0 * __builtin_amdgcn_rcpf(1.f + __expf(-g0)), v1 = o[4 * g + 1] * rs * gn.y * g1 * __builtin_amdgcn_rcpf(1.f + __expf(-g1));
            const float v2 = o[4 * g + 2] * rs * gn.z * g2 * __builtin_amdgcn_rcpf(1.f + __expf(-g2)), v3 = o[4 * g + 3] * rs * gn.w * g3 * __builtin_amdgcn_rcpf(1.f + __expf(-g3));
            v2u w; w.x = cvtpk(v0, v1); w.y = cvtpk(v2, v3);
            st_b64(y + tok * DM + 512 + h * 128 + dv, w);
        }
        __syncthreads();
    }
}
__device__ __forceinline__ void fox_cumsum_phase(const P& p, int l, int vcu, int G) {
    int tid = threadIdx.x; asm volatile("" : "+v"(tid));
    const int lane = tid & 63, wave = __builtin_amdgcn_readfirstlane(tid >> 6);
    const float* sm = WSP(float, WS_SM); float* cb = WSP(float, WS_CB);
    for (int u = vcu * NWAVES + wave; u < NBATCH * 8; u += G * NWAVES) {
        const int b = u >> 3, h = u & 7;
        const float bias = p.b_forget[l * 8 + h];
        float v[32]; float run = 0.f;
#pragma unroll
        for (int j = 0; j < 32; ++j) { run += fast_log_sigmoid(sm[((size_t)b * SEQ + lane * 32 + j) * 32 + h] + bias); v[j] = run; }
        float pre = run;
#pragma unroll
        for (int o = 1; o < 64; o <<= 1) { const float t = __shfl_up(pre, o); if (lane >= o) pre += t; }
        pre -= run;
#pragma unroll
        for (int j = 0; j < 32; ++j) cb[((size_t)b * 8 + h) * SEQ + lane * 32 + j] = -(v[j] + pre) * LOG2E;
    }
}

__device__ __forceinline__ void fox_knorm_phase(const P& p, int vcu, int G) {
    int tid = threadIdx.x; asm volatile("" : "+v"(tid));
    const int lane = tid & 63, wave = __builtin_amdgcn_readfirstlane(tid >> 6);
    const bf16* proj = WSP(bf16, WS_PROJ); float* kn = WSP(float, WS_MOE + MO_KN);
    for (int task = vcu * NWAVES + wave; task < NBATCH * 8 * 32; task += G * NWAVES) {
        const int j = task & 31, h = (task >> 5) & 7, b = task >> 8;
        float mx = 0.f;
#pragma unroll
        for (int i = 0; i < 8; ++i) {
            const v4u w = *(const v4u*)(proj + ((size_t)b * SEQ + j * 64 + i * 8 + (lane >> 3)) * PW + C_FK + h * 64 + (lane & 7) * 8);
            const unsigned ww[4] = {w.x, w.y, w.z, w.w}; float ss = 0.f;
#pragma unroll
            for (int e = 0; e < 4; ++e) { const float a = __builtin_bit_cast(float, ww[e] << 16), c = __builtin_bit_cast(float, ww[e] & 0xffff0000u); ss += a * a + c * c; }
            ss += __shfl_xor(ss, 1); ss += __shfl_xor(ss, 2); ss += __shfl_xor(ss, 4);
            mx = fmaxf(mx, ss);
        }
        mx = wave_max(mx);
        if (lane == 0) kn[task] = sqrtf(mx) * 1.0001f;
    }
}
__device__ __forceinline__ void router_weights(const P& p, int gtid, int gstride) {
    for (int idx = gtid; idx < NLAYER * 32768; idx += gstride) {
        const int l = idx >> 15, r = idx & 32767, k = r >> 5, n = r & 31;
        float v = 0.f;
        if (n < 16) v = p.w_re[((size_t)l * DM + k) * 16 + n]; else if (n < 20) v = p.w_rg[((size_t)l * DM + k) * 4 + (n - 16)];
        v *= p.moe_norm[l * DM + k];
        float* wr = (float*)(ws_base(p.ws) + WS_W + (size_t)l * WS_WLAYER + WO_RHI);
        wr[(((k >> 4) * 4 + ((k >> 2) & 3)) * 32 + n) * 4 + (k & 3)] = v;
    }
}
__device__ __forceinline__ void route_phase(const P& p, int l, LAS unsigned char* lds, int vcu, int G) {
    int tid = threadIdx.x; asm volatile("" : "+v"(tid));
    const int lane = tid & 63, wave = __builtin_amdgcn_readfirstlane(tid >> 6);
    { const v4u* src = (const v4u*)(ws_base(p.ws) + WS_W + (size_t)l * WS_WLAYER + WO_RHI);
#pragma unroll 4
      for (int i = 0; i < 16; ++i) *(LAS v4u*)(lds + LDS_STAGE + (tid + NTHR * i) * 16) = src[tid + NTHR * i]; }
    LAS int* hist = (LAS int*)(lds + LDS_GATE);
    if (tid < 32) hist[tid] = 0;
    __syncthreads();
    const bf16* HBp = WSP(const bf16, WS_HB);
    int2* toke = WSP(int2, WS_MOE + MO_TOKE); float2* tokg = WSP(float2, WS_MOE + MO_TOKG);
    LAS float* lgb = (LAS float*)(lds + LDS_RS + wave * 2048);
    const int r = lane & 15, kq = lane >> 4;
    for (int task = vcu * NWAVES + wave; task < NTOK / 16; task += G * NWAVES) {
        const int tok0 = task * 16;
        const v2u* hp = (const v2u*)(HBp + (size_t)(tok0 + r) * DM + 4 * kq);
        f32x4 acc0 = {0.f, 0.f, 0.f, 0.f}, acc1 = {0.f, 0.f, 0.f, 0.f}; float q = 0.f;
#pragma unroll 8
        for (int s = 0; s < 64; ++s) {
            const v2u aw = hp[4 * s]; f32x4 a; a.x = __builtin_bit_cast(float, aw.x << 16); a.y = __builtin_bit_cast(float, aw.x & 0xffff0000u); a.z = __builtin_bit_cast(float, aw.y << 16); a.w = __builtin_bit_cast(float, aw.y & 0xffff0000u);
            const f32x4 b0 = *(const LAS f32x4*)(lds + LDS_STAGE + ((s * 4 + kq) * 32 + r) * 16);
            const f32x4 b1 = *(const LAS f32x4*)(lds + LDS_STAGE + ((s * 4 + kq) * 32 + 16 + r) * 16);
            q += (a.x * a.x + a.y * a.y) + (a.z * a.z + a.w * a.w);
            acc0 = __builtin_amdgcn_mfma_f32_16x16x4f32(a.x, b0.x, acc0, 0, 0, 0); acc1 = __builtin_amdgcn_mfma_f32_16x16x4f32(a.x, b1.x, acc1, 0, 0, 0);
            acc0 = __builtin_amdgcn_mfma_f32_16x16x4f32(a.y, b0.y, acc0, 0, 0, 0); acc1 = __builtin_amdgcn_mfma_f32_16x16x4f32(a.y, b1.y, acc1, 0, 0, 0);
            acc0 = __builtin_amdgcn_mfma_f32_16x16x4f32(a.z, b0.z, acc0, 0, 0, 0); acc1 = __builtin_amdgcn_mfma_f32_16x16x4f32(a.z, b1.z, acc1, 0, 0, 0);
            acc0 = __builtin_amdgcn_mfma_f32_16x16x4f32(a.w, b0.w, acc0, 0, 0, 0); acc1 = __builtin_amdgcn_mfma_f32_16x16x4f32(a.w, b1.w, acc1, 0, 0, 0);
        }
        q += __shfl_xor(q, 16); q += __shfl_xor(q, 32);
        const float rsv = rsqrtf(q * (1.0f / DM) + EPS);
        const float bias0 = p.b_re[l * 16 + r], bias1 = r < 4 ? p.b_rg[l * 4 + r] : 0.f;
#pragma unroll
        for (int g = 0; g < 4; ++g) { const int row = 4 * kq + g; const float rs = __shfl(rsv, row);
            lgb[row * 32 + r] = acc0[g] * rs + bias0; lgb[row * 32 + 16 + r] = acc1[g] * rs + bias1; }
        LDS_WAIT();
        if (lane < 16) {
            const int tok = tok0 + lane;
            const LAS f32x4* lr = (const LAS f32x4*)(lgb + lane * 32);
            const f32x4 e0 = lr[0], e1 = lr[1], e2 = lr[2], e3 = lr[3], gl = lr[4];
            int g = 0; float gm = gl.x;
            if (gl.y > gm) { gm = gl.y; g = 1; } if (gl.z > gm) { gm = gl.z; g = 2; } if (gl.w > gm) { gm = gl.w; g = 3; }
            const float den = (expf(gl.x - gm) + expf(gl.y - gm)) + (expf(gl.z - gm) + expf(gl.w - gm));
            const float pg = 1.0f / den;
            const f32x4 el = g == 0 ? e0 : (g == 1 ? e1 : (g == 2 ? e2 : e3));
            int i0 = 0; float m0 = el.x;
            if (el.y > m0) { m0 = el.y; i0 = 1; } if (el.z > m0) { m0 = el.z; i0 = 2; } if (el.w > m0) { m0 = el.w; i0 = 3; }
            int i1 = -1; float m1 = -INFINITY;
            if (i0 != 0 && el.x > m1) { m1 = el.x; i1 = 0; } if (i0 != 1 && el.y > m1) { m1 = el.y; i1 = 1; }
            if (i0 != 2 && el.z > m1) { m1 = el.z; i1 = 2; } if (i0 != 3 && el.w > m1) { m1 = el.w; i1 = 3; }
            const float ex = expf(m1 - m0), inv = 1.0f / (1.0f + ex);
            const int ea = g * 4 + i0, eb = g * 4 + i1;
            toke[tok] = make_int2(ea, eb); tokg[tok] = make_float2(pg * inv, pg * ex * inv);
            atomicAdd((int*)&hist[ea], 1); atomicAdd((int*)&hist[16 + eb], 1);
        }
        LDS_WAIT();
    }
    __syncthreads();
    if (tid < 32) WSP(int, WS_MOE + MO_HIST)[vcu * 32 + tid] = hist[tid];
}
__device__ __forceinline__ void sort_phase(const P& p, LAS unsigned char* lds, int vcu, int G) {
    int tid = threadIdx.x; asm volatile("" : "+v"(tid));
    const int lane = tid & 63, wave = __builtin_amdgcn_readfirstlane(tid >> 6);
    LAS int* cnt = (LAS int*)(lds + LDS_GATE); LAS int* pre = cnt + 32; LAS int* base = cnt + 64; LAS int* ntl = cnt + 96;
    const int* histg = WSP(const int, WS_MOE + MO_HIST);
    int* rowtok = WSP(int, WS_MOE + MO_ROWTOK); float* rowgate = WSP(float, WS_MOE + MO_ROWGATE); int* tilee = WSP(int, WS_MOE + MO_TILEE); int* nt = WSP(int, WS_MOE + MO_NT);
    const int2* toke = WSP(const int2, WS_MOE + MO_TOKE); const float2* tokg = WSP(const float2, WS_MOE + MO_TOKG);
    { LAS int* part = (LAS int*)(lds + LDS_RS);
      const int j = tid & 31, part_i = tid >> 5; int c = 0, pr = 0;
      for (int w = part_i; w < G; w += 16) { const int v = histg[w * 32 + j]; if (w < vcu) pr += v; c += v; }
      part[part_i * 64 + j] = c; part[part_i * 64 + 32 + j] = pr;
      __syncthreads();
      if (tid < 32) { int cc = 0, pp = 0;
#pragma unroll
          for (int q = 0; q < 16; ++q) { cc += part[q * 64 + tid]; pp += part[q * 64 + 32 + tid]; }
          cnt[tid] = cc; pre[tid] = pp; } }
    __syncthreads();
    if (tid == 0) { int t = 0; for (int j = 0; j < 32; ++j) { base[j] = t * 256; const int n = (cnt[j] + 255) >> 8; ntl[j] = n; t += n; if (j == 15 && vcu == 0) nt[0] = t; } if (vcu == 0) nt[1] = t; }
    __syncthreads();
    if (vcu == 0 && tid < 32) { const int t0 = base[tid] >> 8; for (int i = 0; i < ntl[tid]; ++i) tilee[t0 + i] = tid & 15; }
    if (vcu < 32) { const int j = vcu, lo = base[j] + cnt[j], hi = base[j] + 256 * ntl[j]; for (int r = lo + tid; r < hi; r += NTHR) { rowtok[r] = -1; rowgate[r] = 0.f; } }
    if (wave < 2) {
        const int k = wave;
        int run[16];
#pragma unroll
        for (int e = 0; e < 16; ++e) run[e] = 0;
        for (int task0 = vcu * NWAVES; task0 < NTOK / 16; task0 += G * NWAVES) {
#pragma unroll 1
            for (int half = 0; half < 2; ++half) {
                const int tok = task0 * 16 + half * 64 + lane;
                const int2 ee = toke[tok]; const float2 gg = tokg[tok];
                const int e = k ? ee.y : ee.x; const float gt = k ? gg.y : gg.x;
                int rank = 0;
#pragma unroll
                for (int x = 0; x < 16; ++x) { const unsigned long long m = __ballot(e == x); if (e == x) rank = run[x] + __popcll(m & ((1ull << lane) - 1ull)); run[x] += __popcll(m); }
                const int pos = base[k * 16 + e] + pre[k * 16 + e] + rank;
                rowtok[pos] = tok; rowgate[pos] = gt;
            }
        }
    }
}
__device__ __forceinline__ void final_phase(const P& p, int vcu, int G) {
    int tid = threadIdx.x; asm volatile("" : "+v"(tid));
    const int lane = tid & 63, wave = __builtin_amdgcn_readfirstlane(tid >> 6);
    const float* ssq = WSP(const float, WS_SSQ); const bf16* hb = WSP(const bf16, WS_HB);
    for (int m = vcu * NWAVES + wave; m < NTOK; m += G * NWAVES) {
        f32x4* s = (f32x4*)(p.out + (size_t)m * DM) + lane; const v2u* h = (const v2u*)(hb + (size_t)m * DM) + lane;
        const float rs = row_rs(ssq, m);
#pragma unroll
        for (int j = 0; j < 4; ++j) { const f32x4 g = ((const f32x4*)p.final_norm)[lane + 64 * j]; const v2u w = h[64 * j];
            f32x4 v; v.x = __builtin_bit_cast(float, w.x << 16); v.y = __builtin_bit_cast(float, w.x & 0xffff0000u); v.z = __builtin_bit_cast(float, w.y << 16); v.w = __builtin_bit_cast(float, w.y & 0xffff0000u);
            s[64 * j] = v * rs * g; }
    }
}
#ifndef ENMASK
#define ENMASK 0xffffffffu
#endif
#define EN(b) (((ENMASK) >> (b)) & 1u)
#ifndef REPMASK
#define REPMASK 0u
#endif
#define REPN(b) ((((REPMASK) >> (b)) & 1u) ? 2 : 1)
__device__ __attribute__((noinline)) void grid_barrier(unsigned* barw, unsigned x, volatile LAS unsigned* st) { XcdBarrier b; b.bar = barw; b.x = x; b.st = st; xcd_barrier(b); }
__global__ void __launch_bounds__(NTHR, 2) fwd(Args args) {
    extern __shared__ __attribute__((aligned(16))) unsigned char lds_raw[];
    LAS unsigned char* lds = (LAS unsigned char*)lds_raw;
    const P& p = args.p;
    const int tid = threadIdx.x, lane = tid & 63, wave = __builtin_amdgcn_readfirstlane(tid >> 6);
    const int G = gridDim.x; const int bx = blockIdx.x; const int vcu = (G % 8 == 0) ? (bx % 8) * (G / 8) + bx / 8 : bx;
    volatile LAS unsigned* MISC = (volatile LAS unsigned*)(lds + LDS_MISC);
    if (tid < 64) MISC[tid] = 0u;
    __syncthreads();
    unsigned* ctl = (unsigned*)(p.ws + WS_CTL);
    const int lo = args.ph_lo, hi = args.ph_hi;
    XcdBarrier bar; bar.bar = ctl + CW_BAR + args.li * XCD_BAR_WORDS; bar.x = 0; bar.st = nullptr;
    if (hi - lo > 1) bar = xcd_barrier_post(ctl + CW_BAR + args.li * XCD_BAR_WORDS, MISC);
#define IN(k) (lo <= (k) && (k) < hi)
#define PHL int vcuL = vcu, GL = G, bxL = bx; asm volatile("" : "+s"(vcuL), "+s"(GL), "+s"(bxL)); (void)vcuL; (void)GL; (void)bxL;
#define LTID(v) int v = threadIdx.x; asm volatile("" : "+v"(v))
#define SEAM(k) do { if (IN(k) && IN((k) + 1)) { grid_barrier(bar.bar, bar.x, bar.st); if (REPN(20) == 2) grid_barrier(bar.bar, bar.x, bar.st); } } while (0)
    LAS float* rstab = (LAS float*)(lds + LDS_RS); LAS int* rowtab = (LAS int*)(lds + LDS_ROWTOK); LAS float* gatetab = (LAS float*)(lds + LDS_GATE);
#define HB WSP(bf16, WS_HB)
#define PROJ WSP(bf16, WS_PROJ)
#define Y WSP(bf16, WS_Y)
#define XKV WSP(bf16, WS_XKV)
#define MEMN WSP(bf16, WS_MEMN)
#define SSQ WSP(float, WS_SSQ)
#define XQ WSP(bf16, WS_XQ)
#define U WSP(bf16, WS_U)
#define ROWTOK WSP(const int, WS_MOE + MO_ROWTOK)
#define ROWGATE WSP(const float, WS_MOE + MO_ROWGATE)
#define TILEE WSP(const int, WS_MOE + MO_TILEE)
#define NT WSP(const int, WS_MOE + MO_NT)
#define H (p.out)
#define HB8 ((unsigned char*)p.out + 64 * MiB)
#define U8 WSP(unsigned char, WS_U)

    if (EN(0) && IN(PH_PRO)) _Pragma("unroll 1") for (int rep_ = 0; rep_ < REPN(0); ++rep_) { PHL prologue(p, lds, vcuL, GL, wave, lane); }
    SEAM(PH_PRO);
    if (EN(1) && IN(PH_XKV)) _Pragma("unroll 1") for (int rep_ = 0; rep_ < REPN(1); ++rep_) { PHL
        pg8::StaticOrder S; S.init(MEMN, ws_base(p.ws) + WS_WXKV, 4096, 2048, DM, GL, bxL);
        EpiBf16<false> E{XKV, 2048, rstab};
        pg8::gemm_phase<DM, EpiBf16<false>, pg8::StaticOrder, true>(lds + LDS_STAGE, S, E);
    }
    if (REPN(18) == 2 && IN(PH_XKV)) { PHL
        pg8::StaticOrder S; S.init(HB, ws_base(p.ws) + WS_W + WO_IN, NTOK, 3072, DM, GL, bxL);
        { pg8::Unit u; for (int iu = 0; S.next(iu, u); ++iu) { LTID(tq); if (tq < 256) rstab[iu * 256 + tq] = row_rs(SSQ, u.pm * 256 + tq); } }
        __syncthreads();
        EpiBf16<true> E{PROJ, PW, rstab};
        pg8::gemm_phase<DM, EpiBf16<true>, pg8::StaticOrder, true>(lds + LDS_STAGE, S, E);
    }
    SEAM(PH_XKV);
    for (int l = 0; l < NLAYER; ++l) {
        const int pb = PH_L0 + l * NPH;
        unsigned char* wl = ws_base(p.ws) + WS_W + (size_t)l * WS_WLAYER;
        if (EN(2) && IN(pb + LP_INPROJ)) _Pragma("unroll 1") for (int rep_ = 0; rep_ < REPN(2); ++rep_) { PHL
            pg8::StaticOrder S; S.init(HB, wl + WO_IN, NTOK, 3072, DM, GL, bxL);
            { pg8::Unit u; for (int iu = 0; S.next(iu, u); ++iu) { LTID(tq); if (tq < 256) rstab[iu * 256 + tq] = row_rs(SSQ, u.pm * 256 + tq); } }
            __syncthreads();
            EpiBf16<true> E{PROJ, PW, rstab};
            pg8::gemm_phase<DM, EpiBf16<true>, pg8::StaticOrder, true>(lds + LDS_STAGE, S, E);
            _Pragma("unroll 1") for (int r2_ = 0; r2_ < REPN(19); ++r2_) small_proj(p, l, vcuL, GL, wave, lane);
        }
        SEAM(pb + LP_INPROJ);
        if (EN(11) && IN(pb + LP_MIXA)) _Pragma("unroll 1") for (int rep_ = 0; rep_ < REPN(11); ++rep_) { PHL gla_phase_a(p, l, lds + LDS_STAGE, vcuL, GL); fox_cumsum_phase(p, l, vcuL, GL); fox_knorm_phase(p, vcuL, GL); }
        SEAM(pb + LP_MIXA);
        if (EN(12) && IN(pb + LP_MIXB)) _Pragma("unroll 1") for (int rep_ = 0; rep_ < REPN(12); ++rep_) { PHL gla_phase_b(p, vcuL, GL); }
        SEAM(pb + LP_MIXB);
        if (EN(9) && IN(pb + LP_MIXC)) { PHL _Pragma("unroll 1") for (int rep_ = 0; rep_ < REPN(16); ++rep_) fox_phase(p, l, lds + LDS_STAGE, vcuL, GL); _Pragma("unroll 1") for (int rep_ = 0; rep_ < REPN(17); ++rep_) gla_phase_c(p, l, lds + LDS_STAGE, vcuL, GL); }
        SEAM(pb + LP_MIXC);
        if (EN(3) && IN(pb + LP_WOUT)) _Pragma("unroll 1") for (int rep_ = 0; rep_ < REPN(3); ++rep_) { PHL
            pg8::StaticOrder S; S.init(Y, wl + WO_OUT, NTOK, DM, DM, GL, bxL);
            EpiRes<0> E{HB, SSQ, rowtab, gatetab, rep_ == REPN(3) - 1 ? 1.f : 0.f, Y, nullptr};
            pg8::gemm_phase<DM, EpiRes<0>, pg8::StaticOrder, true>(lds + LDS_STAGE, S, E);
        }
        SEAM(pb + LP_WOUT);
        if (EN(4) && IN(pb + LP_XQ)) _Pragma("unroll 1") for (int rep_ = 0; rep_ < REPN(4); ++rep_) { PHL
            pg8::StaticOrder S; S.init(HB, wl + WO_XQ, NTOK, 512, DM, GL, bxL);
            { pg8::Unit u; for (int iu = 0; S.next(iu, u); ++iu) { LTID(tq); if (tq < 256) rstab[iu * 256 + tq] = row_rs(SSQ, u.pm * 256 + tq); } }
            __syncthreads();
            EpiBf16<true> E{XQ, 512, rstab};
            pg8::gemm_phase<DM, EpiBf16<true>, pg8::StaticOrder, true>(lds + LDS_STAGE, S, E);
        }
        SEAM(pb + LP_XQ);
        if (EN(10) && IN(pb + LP_XATTN)) _Pragma("unroll 1") for (int rep_ = 0; rep_ < REPN(10); ++rep_) { PHL xattn_phase(p, l, lds + LDS_STAGE, vcuL, GL, rep_ != REPN(10) - 1); }
        SEAM(pb + LP_XATTN);
        if (EN(5) && IN(pb + LP_XO)) _Pragma("unroll 1") for (int rep_ = 0; rep_ < REPN(5); ++rep_) { PHL
            pg8::StaticOrder S; S.init(XQ, wl + WO_XO, NTOK, DM, 512, GL, bxL);
            EpiRes<0, true> E{HB, SSQ, rowtab, gatetab, rep_ == REPN(5) - 1 ? 1.f : 0.f, Y, HB8};
            pg8::gemm_phase<512, EpiRes<0, true>, pg8::StaticOrder, true>(lds + LDS_STAGE, S, E);
        }
        SEAM(pb + LP_XO);
        if (EN(13) && IN(pb + LP_ROUTE)) _Pragma("unroll 1") for (int rep_ = 0; rep_ < REPN(13); ++rep_) { PHL route_phase(p, l, lds, vcuL, GL); }
        SEAM(pb + LP_ROUTE);
        if (EN(14) && IN(pb + LP_SORT)) _Pragma("unroll 1") for (int rep_ = 0; rep_ < REPN(14); ++rep_) { PHL sort_phase(p, lds, vcuL, GL); }
        SEAM(pb + LP_SORT);
        if (EN(6) && IN(pb + LP_GU)) _Pragma("unroll 1") for (int rep_ = 0; rep_ < REPN(6); ++rep_) { PHL
            MoeOrder<true> S{(const char*)HB8, (const char*)(wl + WO_GU), 512, (size_t)1024 * 1024, 0, NT[1], GL, vcuL, TILEE, rowtab};
            { pg8::Unit u; for (int iu = 0; S.next(iu, u); ++iu) { LTID(tq); if (tq < 256) { int t = ROWTOK[u.pm * 256 + tq]; t = t < 0 ? 0 : t; rowtab[iu * 256 + tq] = t; rstab[iu * 256 + tq] = row_rs(SSQ, t); } } }
            __syncthreads();
            EpiGU E{U8, rstab};
            pg8::gemm_phase<512, EpiGU, MoeOrder<true>, true, true, 127, 122>(lds + LDS_STAGE, S, E);
        }
        SEAM(pb + LP_GU);
        if (EN(7) && IN(pb + LP_DOWN0)) _Pragma("unroll 1") for (int rep_ = 0; rep_ < REPN(7); ++rep_) { PHL
            MoeOrder<false> S{(const char*)U8, (const char*)(wl + WO_D), 256, (size_t)1024 * 512, 0, NT[0], GL, vcuL, TILEE, rowtab};
            __syncthreads();
            { pg8::Unit u; for (int iu = 0; S.next(iu, u); ++iu) { LTID(tq); if (tq < 256) { rowtab[iu * 256 + tq] = ROWTOK[u.pm * 256 + tq]; gatetab[iu * 256 + tq] = ROWGATE[u.pm * 256 + tq]; } } }
            __syncthreads();
            EpiRes<1> E{HB, SSQ, rowtab, gatetab, 1.f, Y, nullptr};
            pg8::gemm_phase<256, EpiRes<1>, MoeOrder<false>, true, true, 125, 122>(lds + LDS_STAGE, S, E);
        }
        SEAM(pb + LP_DOWN0);
        if (EN(8) && IN(pb + LP_DOWN1)) _Pragma("unroll 1") for (int rep_ = 0; rep_ < REPN(8); ++rep_) { PHL
            MoeOrder<false> S{(const char*)U8, (const char*)(wl + WO_D), 256, (size_t)1024 * 512, NT[0], NT[1], GL, vcuL, TILEE, rowtab};
            __syncthreads();
            { pg8::Unit u; for (int iu = 0; S.next(iu, u); ++iu) { LTID(tq); if (tq < 256) { rowtab[iu * 256 + tq] = ROWTOK[u.pm * 256 + tq]; gatetab[iu * 256 + tq] = ROWGATE[u.pm * 256 + tq]; } } }
            __syncthreads();
            EpiRes<2> E{HB, SSQ, rowtab, gatetab, 1.f, Y, nullptr};
            pg8::gemm_phase<256, EpiRes<2>, MoeOrder<false>, true, true, 125, 122>(lds + LDS_STAGE, S, E);
        }
        SEAM(pb + LP_DOWN1);
    }
    if (EN(15) && IN(PH_FINAL)) _Pragma("unroll 1") for (int rep_ = 0; rep_ < REPN(15); ++rep_) { PHL final_phase(p, vcuL, GL); }
#undef IN
#undef SEAM
#undef HB
#undef PROJ
#undef Y
#undef XKV
#undef MEMN
#undef SSQ
#undef XQ
#undef U
#undef ROWTOK
#undef ROWGATE
#undef TILEE
#undef NT
#undef H
#undef HB8
#undef U8
}

static int g_grid = 0;
static void launch_fast(const P& p, int lo, int hi, int& li, hipStream_t stream) {
    Args a{}; a.p = p; a.ph_lo = lo; a.ph_hi = hi; a.li = li++; a.pad = 0;
    hipLaunchKernelGGL(fwd, dim3(g_grid), dim3(NTHR), LDS_BYTES, stream, a);
    const hipError_t le = hipPeekAtLastError();
    if (le != hipSuccess) fprintf(stderr, "kernel_launch: fwd launch [%d,%d) failed: %s\n", lo, hi, hipGetErrorName(le));
}
extern "C" void kernel_launch(void* const* d_in, const int* in_sizes, int n_in, void* d_out, int out_size, void* d_ws, size_t ws_size, hipStream_t stream) {
    if (n_in != 25 || out_size != NTOK * DM || ws_size < WS_END2) { fprintf(stderr, "kernel_launch: unexpected sizes n_in %d out %d ws %zu (need %zu)\n", n_in, out_size, ws_size, (size_t)WS_END2); return; }
    if (g_grid == 0) {
        int dev = 0, cus = 0, per_cu = 0;
        if (hipGetDevice(&dev) != hipSuccess || hipDeviceGetAttribute(&cus, hipDeviceAttributeMultiprocessorCount, dev) != hipSuccess) { g_grid = -1; return; }
        if (hipFuncSetAttribute((const void*)fwd, hipFuncAttributeMaxDynamicSharedMemorySize, LDS_BYTES) != hipSuccess) { fprintf(stderr, "kernel_launch: hipFuncSetAttribute failed\n"); g_grid = -1; return; }
        if (hipOccupancyMaxActiveBlocksPerMultiprocessor(&per_cu, (const void*)fwd, NTHR, LDS_BYTES) != hipSuccess || per_cu < 1) { fprintf(stderr, "kernel_launch: occupancy query says %d\n", per_cu); }
        (void)hipGetLastError();
        g_grid = cus;
    }
    if (g_grid < 0) return;
    P p{};
    const float** pp = (const float**)&p;
    for (int i = 0; i < 25; ++i) pp[i] = (const float*)d_in[i];
    p.out = (float*)d_out; p.ws = (unsigned char*)d_ws;
    hipMemsetAsync((char*)d_ws + WS_CTL, 0, 1 * MiB, stream);
    bf16* HB = WSP(bf16, WS_HB); bf16* PROJ = WSP(bf16, WS_PROJ); float* SM = WSP(float, WS_SM); float* CB = WSP(float, WS_CB); bf16* Y = WSP(bf16, WS_Y);
    bf16* XKV = WSP(bf16, WS_XKV); float* SSQ = WSP(float, WS_SSQ); bf16* XQ = WSP(bf16, WS_XQ);
    float* LA = WSP(float, WS_HB);
    int2* TOKE = WSP(int2, WS_MOE + MO_TOKE); float2* TOKG = WSP(float2, WS_MOE + MO_TOKG); int* ROWTOK = WSP(int, WS_MOE + MO_ROWTOK); float* ROWGATE = WSP(float, WS_MOE + MO_ROWGATE);
    int* TILEE = WSP(int, WS_MOE + MO_TILEE); int* NT = WSP(int, WS_MOE + MO_NT);
    float* H = p.out;
    (void)HB; (void)SSQ; (void)XQ;
    int li = 0;
    launch_fast(p, PH_PRO, PH_END, li, stream);
}
```

```cpp
#define REPMASK 0x0
#include <hip/hip_runtime.h>
#include <cstdio>
#include <cstdint>

constexpr int NTOK = 32768, DM = 1024, NBATCH = 16, SEQ = 2048, NLAYER = 2, MEML = 256;
constexpr int PW = 3072;
constexpr int C_FQ = 0, C_FK = 512, C_FV = 1024, C_GQ = 1536, C_GK = 1792, C_GV = 2048, C_GG = 2560;
constexpr int INW = 3096;
constexpr float EPS = 1e-6f, LOG2E = 1.4426950408889634f;
constexpr int MAXTILES = 288;
constexpr int MAXROWS = MAXTILES * 256;

typedef unsigned short bf16;
__device__ __forceinline__ unsigned f2bf(float f) { unsigned u = __builtin_bit_cast(unsigned, f); return (u + 0x7fffu + ((u >> 16) & 1u)) >> 16; }
__device__ __forceinline__ float bf2f(bf16 b) { return __builtin_bit_cast(float, ((unsigned)b) << 16); }

constexpr size_t MiB = 1u << 20;
constexpr size_t WS_CTL = 0;
constexpr size_t WS_W = 1 * MiB;
constexpr size_t WS_WLAYER = 59 * MiB;
constexpr size_t WS_WXKV = WS_W + 2 * WS_WLAYER;
constexpr size_t WS_HB = WS_WXKV + 4 * MiB;
constexpr size_t WS_PROJ = WS_HB + 64 * MiB;
constexpr size_t WS_XQ = WS_PROJ;
constexpr size_t WS_U = WS_PROJ + 32 * MiB;
constexpr size_t WS_XO8 = WS_U + 40 * MiB;
constexpr size_t WS_SM = WS_PROJ + 192 * MiB;
constexpr size_t WS_CB = WS_SM + 4 * MiB;
constexpr size_t WS_Y = WS_CB + 1 * MiB;
constexpr size_t WS_XKV = WS_Y + 64 * MiB;
constexpr size_t WS_MEMN = WS_XKV + 16 * MiB;
constexpr size_t WS_SSQ = WS_MEMN + 8 * MiB;
constexpr size_t WS_MOE = WS_SSQ + 2 * MiB;
constexpr size_t WS_END = WS_MOE + 2 * MiB;
static_assert(WS_END <= 512 * MiB, "workspace map");
constexpr size_t MO_TOKE = 0;
constexpr size_t MO_TOKG = 256 * 1024;
constexpr size_t MO_ROWTOK = 512 * 1024;
constexpr size_t MO_ROWGATE = 832 * 1024;
constexpr size_t MO_TILEE = 1152 * 1024;
constexpr size_t MO_NT = 1156 * 1024;
constexpr size_t MO_HIST = 1160 * 1024;
constexpr size_t MO_KN = 1280 * 1024;

struct P {
    const float *x, *mem, *mem_norm, *mix_norm, *w_in, *b_forget, *w_alpha_up, *b_alpha, *fox_gain, *gla_gain, *w_out, *cross_norm, *w_xq, *w_xk, *w_xv, *w_xo,
        *moe_norm, *w_rg, *b_rg, *w_re, *b_re, *w_eg, *w_eu, *w_ed, *final_norm;
    float* out; unsigned char* ws;
};
__host__ __device__ __forceinline__ unsigned char* ws_base(unsigned char* w) {
#if defined(__HIP_DEVICE_COMPILE__)
    size_t z = 0; asm volatile("" : "+s"(z));
    return w + z;
#else
    return w;
#endif
}
#define WSP(T, off) ((T*)(ws_base(p.ws) + (off)))

__device__ __forceinline__ float wave_sum(float v) {
#pragma unroll
    for (int o = 1; o < 64; o <<= 1) v += __shfl_xor(v, o);
    return v;
}
__device__ __forceinline__ float wave_min(float v) {
#pragma unroll
    for (int o = 1; o < 64; o <<= 1) v = fminf(v, __shfl_xor(v, o));
    return v;
}
__device__ __forceinline__ float wave_max(float v) {
#pragma unroll
    for (int o = 1; o < 64; o <<= 1) v = fmaxf(v, __shfl_xor(v, o));
    return v;
}
__device__ __forceinline__ float row_rs(const float* ssq, int row) {
    const float4* s = (const float4*)(ssq + (size_t)row * 16);
    float4 a = s[0], b = s[1], c = s[2], d = s[3];
    float t = ((a.x + a.y) + (a.z + a.w)) + ((b.x + b.y) + (b.z + b.w)) + ((c.x + c.y) + (c.z + c.w)) + ((d.x + d.y) + (d.z + d.w));
    return rsqrtf(t * (1.0f / DM) + EPS);
}
__device__ __forceinline__ float log_sigmoid(float z) { return fminf(z, 0.f) - log1pf(expf(-fabsf(z))); }
__device__ __forceinline__ float silu(float z) { return z / (1.f + expf(-z)); }

typedef unsigned st_v4u __attribute__((ext_vector_type(4)));
typedef unsigned st_v2u __attribute__((ext_vector_type(2)));
#ifndef WT_STORES
#define WT_STORES 0
#endif
__device__ __forceinline__ void st_b128(void* p, st_v4u v) {
#if WT_STORES
    asm volatile("global_store_dwordx4 %0, %1, off sc1\n\ts_nop 1" :: "v"(p), "v"(v) : "memory");
#else
    *(st_v4u*)p = v;
#endif
}
__device__ __forceinline__ void st_b64(void* p, st_v2u v) {
#if WT_STORES
    asm volatile("global_store_dwordx2 %0, %1, off sc1" :: "v"(p), "v"(v) : "memory");
#else
    *(st_v2u*)p = v;
#endif
}
__global__ void __launch_bounds__(256) k_rowprep(const float* src, bf16* dst, float* ssq, const float* gain, int rows, int mode) {
    const int lane = threadIdx.x & 63, row = blockIdx.x * 4 + (threadIdx.x >> 6);
    if (row >= rows) return;
    const float4* s = (const float4*)(src + (size_t)row * DM) + lane;
    float4 v[4]; float q = 0.f;
#pragma unroll
    for (int j = 0; j < 4; ++j) { v[j] = s[64 * j]; q += (v[j].x * v[j].x + v[j].y * v[j].y) + (v[j].z * v[j].z + v[j].w * v[j].w); }
    q = wave_sum(q);
    float sc = 1.f;
    if (mode == 1) sc = rsqrtf(q * (1.0f / DM) + EPS);
    else if (lane < 16) ssq[(size_t)row * 16 + lane] = lane == 0 ? q : 0.f;
    uint2* d = (uint2*)(dst + (size_t)row * DM) + lane;
#pragma unroll
    for (int j = 0; j < 4; ++j) {
        float4 g = mode == 1 ? ((const float4*)gain)[lane + 64 * j] : make_float4(1.f, 1.f, 1.f, 1.f);
        d[64 * j] = make_uint2(f2bf(v[j].x * sc * g.x) | (f2bf(v[j].y * sc * g.y) << 16), f2bf(v[j].z * sc * g.z) | (f2bf(v[j].w * sc * g.w) << 16));
    }
}
__global__ void __launch_bounds__(256) k_final(float* io, const float* gain) {
    const int lane = threadIdx.x & 63, row = blockIdx.x * 4 + (threadIdx.x >> 6);
    float4* s = (float4*)(io + (size_t)row * DM) + lane;
    float4 v[4]; float q = 0.f;
#pragma unroll
    for (int j = 0; j < 4; ++j) { v[j] = s[64 * j]; q += (v[j].x * v[j].x + v[j].y * v[j].y) + (v[j].z * v[j].z + v[j].w * v[j].w); }
    q = wave_sum(q);
    const float sc = rsqrtf(q * (1.0f / DM) + EPS);
#pragma unroll
    for (int j = 0; j < 4; ++j) { float4 g = ((const float4*)gain)[lane + 64 * j]; s[64 * j] = make_float4(v[j].x * sc * g.x, v[j].y * sc * g.y, v[j].z * sc * g.z, v[j].w * sc * g.w); }
}

template <class C> __global__ void __launch_bounds__(256) k_ngemm(C c) {
    __shared__ float As[16][65];
    __shared__ float Bs[C::NB][16][65];
    const int M = c.rows();
    const int row0 = blockIdx.y * 64, col0 = blockIdx.x * 64;
    if (row0 >= M || row0 < c.row_lo()) return;
    const int tx = threadIdx.x & 15, ty = threadIdx.x >> 4;
    float acc[C::NB][4][4];
#pragma unroll
    for (int n = 0; n < C::NB; ++n)
#pragma unroll
        for (int i = 0; i < 4; ++i)
#pragma unroll
            for (int j = 0; j < 4; ++j) acc[n][i][j] = 0.f;
    for (int k0 = 0; k0 < c.K; k0 += 16) {
#pragma unroll
        for (int i = 0; i < 4; ++i) { const int idx = threadIdx.x + 256 * i, r = idx >> 4, kk = idx & 15; As[kk][r] = c.a(row0 + r, k0 + kk); }
#pragma unroll
        for (int n = 0; n < C::NB; ++n)
#pragma unroll
            for (int i = 0; i < 4; ++i) { const int idx = threadIdx.x + 256 * i, kk = idx >> 6, cc = idx & 63; Bs[n][kk][cc] = c.b(n, k0 + kk, col0 + cc, row0); }
        __syncthreads();
#pragma unroll
        for (int kk = 0; kk < 16; ++kk) {
            float a[4];
#pragma unroll
            for (int i = 0; i < 4; ++i) a[i] = As[kk][ty * 4 + i];
#pragma unroll
            for (int n = 0; n < C::NB; ++n) {
                float b[4];
#pragma unroll
                for (int j = 0; j < 4; ++j) b[j] = Bs[n][kk][tx * 4 + j];
#pragma unroll
                for (int i = 0; i < 4; ++i)
#pragma unroll
                    for (int j = 0; j < 4; ++j) acc[n][i][j] += a[i] * b[j];
            }
        }
        __syncthreads();
    }
#pragma unroll
    for (int i = 0; i < 4; ++i)
#pragma unroll
        for (int j = 0; j < 4; ++j) c.epi(row0 + ty * 4 + i, col0 + tx * 4 + j, acc[0][i][j], acc[C::NB - 1][i][j]);
}

struct CfgXKV {
    __device__ int row_lo() const { return 0; }
    static constexpr int NB = 1; int K; const bf16* A; const float *wk, *wv; bf16* O; int l;
    __device__ int rows() const { return 4096; }
    __device__ float a(int r, int k) const { return bf2f(A[(size_t)r * DM + k]); }
    __device__ float b(int, int k, int c, int) const { return c < 512 ? wk[(size_t)k * 512 + c] : wv[(size_t)k * 512 + c - 512]; }
    __device__ void epi(int r, int c, float v, float) const { O[(size_t)r * 2048 + l * 1024 + c] = (bf16)f2bf(v); }
};
struct CfgInProj {
    __device__ int row_lo() const { return 0; }
    static constexpr int NB = 1; int K; const bf16* A; const float *w, *gain, *ssq; bf16* proj; float* sm;
    __device__ int rows() const { return NTOK; }
    __device__ float a(int r, int k) const { return bf2f(A[(size_t)r * DM + k]); }
    __device__ float b(int, int k, int c, int) const { return c < INW ? gain[k] * w[(size_t)k * INW + c] : 0.f; }
    __device__ void epi(int r, int c, float v, float) const {
        if (c >= INW) return;
        v *= row_rs(ssq, r);
        if (c < 1536) { if (c < 512) v *= 0.125f * LOG2E; proj[(size_t)r * PW + c] = (bf16)f2bf(v); }
        else if (c < 1544) sm[(size_t)r * 32 + (c - 1536)] = v;
        else if (c < 3080) { if (c < 1800) v *= 0.125f; proj[(size_t)r * PW + (c - 8)] = (bf16)f2bf(v); }
        else sm[(size_t)r * 32 + 8 + (c - 3080)] = v;
    }
};
struct CfgRes {
    __device__ int row_lo() const { return 0; }
    static constexpr int NB = 1; int K; const bf16* A; const float* w; const float* base; float* out;
    __device__ int rows() const { return NTOK; }
    __device__ float a(int r, int k) const { return bf2f(A[(size_t)r * K + k]); }
    __device__ float b(int, int k, int c, int) const { return w[(size_t)k * DM + c]; }
    __device__ void epi(int r, int c, float v, float) const { out[(size_t)r * DM + c] = base[(size_t)r * DM + c] + v; }
};
struct CfgXQ {
    __device__ int row_lo() const { return 0; }
    static constexpr int NB = 1; int K; const bf16* A; const float *w, *gain, *ssq; bf16* O;
    __device__ int rows() const { return NTOK; }
    __device__ float a(int r, int k) const { return bf2f(A[(size_t)r * DM + k]); }
    __device__ float b(int, int k, int c, int) const { return gain[k] * w[(size_t)k * 512 + c]; }
    __device__ void epi(int r, int c, float v, float) const { O[(size_t)r * 512 + c] = (bf16)f2bf(v * row_rs(ssq, r) * (0.08838834764831845f * LOG2E)); }
};
struct CfgGU {
    __device__ int row_lo() const { return 0; }
    static constexpr int NB = 2; int K; const bf16* A; const float *wg, *wu, *gain, *ssq; const int *rowtok, *tilee, *nt; bf16* U;
    __device__ int rows() const { return nt[1] * 256; }
    __device__ float a(int r, int k) const { int t = rowtok[r]; t = t < 0 ? 0 : t; return bf2f(A[(size_t)t * DM + k]); }
    __device__ float b(int n, int k, int c, int row0) const { const int e = tilee[row0 >> 8]; const size_t o = ((size_t)e * DM + k) * 512 + c; return n == 0 ? gain[k] * wg[o] : gain[k] * wu[o]; }
    __device__ void epi(int r, int c, float g, float u) const {
        const int t = rowtok[r]; float v = 0.f;
        if (t >= 0) { const float rs = row_rs(ssq, t); v = silu(g * rs) * (u * rs); }
        U[(size_t)r * 512 + c] = (bf16)f2bf(v);
    }
};
struct CfgDown {
    static constexpr int NB = 1; int K; const bf16* U; const float* wd; const int *rowtok, *tilee, *nt; const float* rowgate; float* out; int which;
    __device__ int rows() const { return nt[which] * 256; }
    __device__ int row_lo() const { return which == 1 ? nt[0] * 256 : 0; }
    __device__ float a(int r, int k) const { return bf2f(U[(size_t)r * 512 + k]); }
    __device__ float b(int, int k, int c, int row0) const { const int e = tilee[row0 >> 8]; return wd[((size_t)e * 512 + k) * DM + c]; }
    __device__ void epi(int r, int c, float v, float) const {
        if (which == 1 && r < nt[0] * 256) return;
        const int t = rowtok[r]; if (t >= 0) out[(size_t)t * DM + c] += rowgate[r] * v;
    }
};

__global__ void __launch_bounds__(64) k_fox_cumsum(const float* sm, const float* bfor, float* cb) {
    const int b = blockIdx.x >> 3, h = blockIdx.x & 7, lane = threadIdx.x;
    const float bias = bfor[h];
    float v[32]; float run = 0.f;
#pragma unroll
    for (int j = 0; j < 32; ++j) { const int s = lane * 32 + j; run += log_sigmoid(sm[((size_t)b * SEQ + s) * 32 + h] + bias); v[j] = run; }
    float tot = run, pre = run;
#pragma unroll
    for (int o = 1; o < 64; o <<= 1) { const float t = __shfl_up(pre, o); if (lane >= o) pre += t; }
    pre -= tot;
#pragma unroll
    for (int j = 0; j < 32; ++j) cb[((size_t)b * 8 + h) * SEQ + lane * 32 + j] = -(v[j] + pre) * LOG2E;
}
__global__ void __launch_bounds__(256) k_fox_attn(const bf16* proj, const float* cb, const float* gain, bf16* y) {
    __shared__ float pbuf[4][SEQ];
    __shared__ float qbuf[4][64];
    const int w = threadIdx.x >> 6, lane = threadIdx.x & 63;
    const int gq = blockIdx.x * 4 + w;
    const int q = gq % SEQ, h = (gq / SEQ) % 8, b = gq / (SEQ * 8);
    const size_t tok = (size_t)b * SEQ + q;
    qbuf[w][lane] = bf2f(proj[tok * PW + C_FQ + h * 64 + lane]);
    __syncthreads();
    const float* cbp = cb + ((size_t)b * 8 + h) * SEQ;
    float s[32]; float mx = -INFINITY;
#pragma unroll
    for (int j = 0; j < 32; ++j) {
        const int key = lane + 64 * j; float v = -INFINITY;
        if (key <= q) {
            const uint4* kr = (const uint4*)(proj + ((size_t)b * SEQ + key) * PW + C_FK + h * 64);
            float d = 0.f;
#pragma unroll
            for (int c8 = 0; c8 < 8; ++c8) { const uint4 u = kr[c8]; const unsigned ww[4] = {u.x, u.y, u.z, u.w};
#pragma unroll
                for (int e = 0; e < 4; ++e) { d += qbuf[w][c8 * 8 + 2 * e] * bf2f((bf16)(ww[e] & 0xffff)); d += qbuf[w][c8 * 8 + 2 * e + 1] * bf2f((bf16)(ww[e] >> 16)); } }
            v = d + cbp[key];
        }
        s[j] = v; mx = fmaxf(mx, v);
    }
    mx = wave_max(mx);
    float l = 0.f;
#pragma unroll
    for (int j = 0; j < 32; ++j) { const float pv = (lane + 64 * j <= q) ? exp2f(s[j] - mx) : 0.f; l += pv; pbuf[w][lane + 64 * j] = pv; }
    l = wave_sum(l);
    __syncthreads();
    float o = 0.f;
    for (int key = 0; key <= q; ++key) o += pbuf[w][key] * bf2f(proj[((size_t)b * SEQ + key) * PW + C_FV + h * 64 + lane]);
    o /= l;
    const float ms = wave_sum(o * o) * (1.0f / 64.0f);
    y[tok * DM + h * 64 + lane] = (bf16)f2bf(o * rsqrtf(ms + EPS) * gain[h * 64 + lane]);
}
__global__ void __launch_bounds__(256) k_gla_la(const float* sm, const float* wup, const float* balpha, float* la) {
    const int tok = blockIdx.x, c = threadIdx.x;
    float z = balpha[c];
#pragma unroll
    for (int r = 0; r < 16; ++r) z += sm[(size_t)tok * 32 + 8 + r] * wup[r * 256 + c];
    la[(size_t)tok * 256 + c] = log_sigmoid(z) * (1.0f / 16.0f);
}
__global__ void __launch_bounds__(128) k_gla_rec(const bf16* proj, const float* la, const float* gain, bf16* y) {
    __shared__ float sh_a[64], sh_k[64], sh_q[64], red[2];
    const int b = blockIdx.x >> 2, h = blockIdx.x & 3, dv = threadIdx.x;
    float st[64];
#pragma unroll
    for (int i = 0; i < 64; ++i) st[i] = 0.f;
    const float g = gain[h * 128 + dv];
    for (int t = 0; t < SEQ; ++t) {
        const size_t tok = (size_t)b * SEQ + t;
        __syncthreads();
        if (dv < 64) { sh_a[dv] = expf(la[tok * 256 + h * 64 + dv]); sh_k[dv] = bf2f(proj[tok * PW + C_GK + h * 64 + dv]); }
        else sh_q[dv - 64] = bf2f(proj[tok * PW + C_GQ + h * 64 + dv - 64]);
        __syncthreads();
        const float v = bf2f(proj[tok * PW + C_GV + h * 128 + dv]);
        float o = 0.f;
#pragma unroll
        for (int i = 0; i < 64; ++i) { st[i] = sh_a[i] * st[i] + sh_k[i] * v; o += sh_q[i] * st[i]; }
        const float ss = wave_sum(o * o);
        if ((dv & 63) == 0) red[dv >> 6] = ss;
        __syncthreads();
        const float ms = (red[0] + red[1]) * (1.0f / 128.0f);
        const float gg = bf2f(proj[tok * PW + C_GG + h * 128 + dv]);
        y[tok * DM + 512 + h * 128 + dv] = (bf16)f2bf(o * rsqrtf(ms + EPS) * g * silu(gg));
    }
}
__global__ void __launch_bounds__(256) k_xattn(bf16* xq, const bf16* xkv, int l) {
    __shared__ float pbuf[4][256];
    __shared__ float qbuf[4][128];
    const int w = threadIdx.x >> 6, lane = threadIdx.x & 63;
    const int gq = blockIdx.x * 4 + w;
    const int q = gq % SEQ, h = (gq / SEQ) % 4, b = gq / (SEQ * 4);
    const size_t tok = (size_t)b * SEQ + q;
    qbuf[w][lane] = bf2f(xq[tok * 512 + h * 128 + lane]); qbuf[w][lane + 64] = bf2f(xq[tok * 512 + h * 128 + lane + 64]);
    __syncthreads();
    float s[4]; float mx = -INFINITY;
#pragma unroll
    for (int j = 0; j < 4; ++j) {
        const int key = lane + 64 * j;
        const uint4* kr = (const uint4*)(xkv + ((size_t)b * MEML + key) * 2048 + l * 1024 + h * 128);
        float d = 0.f;
#pragma unroll
        for (int c8 = 0; c8 < 16; ++c8) { const uint4 u = kr[c8]; const unsigned ww[4] = {u.x, u.y, u.z, u.w};
#pragma unroll
            for (int e = 0; e < 4; ++e) { d += qbuf[w][c8 * 8 + 2 * e] * bf2f((bf16)(ww[e] & 0xffff)); d += qbuf[w][c8 * 8 + 2 * e + 1] * bf2f((bf16)(ww[e] >> 16)); } }
        s[j] = d; mx = fmaxf(mx, d);
    }
    mx = wave_max(mx);
    float lsum = 0.f;
#pragma unroll
    for (int j = 0; j < 4; ++j) { const float pv = exp2f(s[j] - mx); lsum += pv; pbuf[w][lane + 64 * j] = pv; }
    lsum = wave_sum(lsum);
    __syncthreads();
    float o0 = 0.f, o1 = 0.f;
    for (int key = 0; key < 256; ++key) { const bf16* vr = xkv + ((size_t)b * MEML + key) * 2048 + l * 1024 + 512 + h * 128; const float pv = pbuf[w][key]; o0 += pv * bf2f(vr[lane]); o1 += pv * bf2f(vr[lane + 64]); }
    xq[tok * 512 + h * 128 + lane] = (bf16)f2bf(o0 / lsum); xq[tok * 512 + h * 128 + lane + 64] = (bf16)f2bf(o1 / lsum);
}
__global__ void __launch_bounds__(256) k_router(const float* h, const float* gain, const float* wrg, const float* brg, const float* wre, const float* bre, int2* toke, float2* tokg) {
    const int lane = threadIdx.x & 63, tok = blockIdx.x * 4 + (threadIdx.x >> 6);
    const float* hr = h + (size_t)tok * DM;
    float hv[16]; float q = 0.f;
#pragma unroll
    for (int j = 0; j < 16; ++j) { hv[j] = hr[lane + 64 * j]; q += hv[j] * hv[j]; }
    q = wave_sum(q);
    const float rs = rsqrtf(q * (1.0f / DM) + EPS);
#pragma unroll
    for (int j = 0; j < 16; ++j) hv[j] = hv[j] * rs * gain[lane + 64 * j];
    float lg[20];
#pragma unroll
    for (int o = 0; o < 20; ++o) {
        float d = 0.f;
#pragma unroll
        for (int j = 0; j < 16; ++j) { const int k = lane + 64 * j; d += hv[j] * (o < 4 ? wrg[k * 4 + o] : wre[k * 16 + (o - 4)]); }
        lg[o] = wave_sum(d) + (o < 4 ? brg[o] : bre[o - 4]);
    }
    if (lane == 0) {
        int g = 0; float gm = lg[0];
#pragma unroll
        for (int i = 1; i < 4; ++i) if (lg[i] > gm) { gm = lg[i]; g = i; }
        float den = 0.f;
#pragma unroll
        for (int i = 0; i < 4; ++i) den += expf(lg[i] - gm);
        const float pg = 1.0f / den;
        float el[4];
#pragma unroll
        for (int i = 0; i < 4; ++i) { float v = lg[4];
#pragma unroll
            for (int gg = 0; gg < 4; ++gg) if (gg == g) v = lg[4 + gg * 4 + i];
            el[i] = v; }
        int i0 = 0; float m0 = el[0];
#pragma unroll
        for (int i = 1; i < 4; ++i) if (el[i] > m0) { m0 = el[i]; i0 = i; }
        int i1 = -1; float m1 = -INFINITY;
#pragma unroll
        for (int i = 0; i < 4; ++i) if (i != i0 && el[i] > m1) { m1 = el[i]; i1 = i; }
        const float e1 = expf(m1 - m0), inv = 1.0f / (1.0f + e1);
        toke[tok] = make_int2(g * 4 + i0, g * 4 + i1);
        tokg[tok] = make_float2(pg * inv, pg * e1 * inv);
    }
}
__global__ void k_sort(const int2* toke, const float2* tokg, int* rowtok, float* rowgate, int* tilee, int* nt) {
    __shared__ int cnt[32], base[32];
    if (threadIdx.x != 0 || blockIdx.x != 0) return;
    for (int i = 0; i < 32; ++i) cnt[i] = 0;
    for (int t = 0; t < NTOK; ++t) { const int2 e = toke[t]; cnt[e.x]++; cnt[16 + e.y]++; }
    int tile = 0;
    for (int k = 0; k < 2; ++k) { for (int e = 0; e < 16; ++e) { base[k * 16 + e] = tile * 256; const int n = (cnt[k * 16 + e] + 255) / 256; for (int i = 0; i < n; ++i) tilee[tile + i] = e; tile += n; } nt[k] = tile; }
    for (int r = 0; r < tile * 256; ++r) { rowtok[r] = -1; rowgate[r] = 0.f; }
    for (int t = 0; t < NTOK; ++t) {
        const int2 e = toke[t]; const float2 g = tokg[t];
        { const int pos = base[e.x]++; rowtok[pos] = t; rowgate[pos] = g.x; }
        { const int pos = base[16 + e.y]++; rowtok[pos] = t; rowgate[pos] = g.y; }
    }
}

#define XB_TMO      128
#define XB_XCNT(j)  (256  + 64 * (j))
#define XB_XSUB(j)  (1280 + 64 * (j))
#define XB_XGEN(j)  (2304 + 64 * (j))
#define XB_TOP      3328
#define XB_TOPGEN   3392
#define XCD_BAR_WORDS 3456
#define XB_SPIN_CAP (1u << 18)
#define LAS __attribute__((address_space(3)))

__device__ __forceinline__ unsigned xb_ld(unsigned* p)              { return __hip_atomic_load(p, __ATOMIC_RELAXED, __HIP_MEMORY_SCOPE_AGENT); }
__device__ __forceinline__ unsigned xb_add(unsigned* p, unsigned v) { return __hip_atomic_fetch_add(p, v, __ATOMIC_RELAXED, __HIP_MEMORY_SCOPE_AGENT); }
__device__ __forceinline__ unsigned xb_xcc_id() { return (unsigned)__builtin_amdgcn_s_getreg((3 << 11) | 20) & 0xFu; }
#define XB_SPIN(cond, bar) do { unsigned _sp = 0; while (cond) { __builtin_amdgcn_s_sleep(1); \
    if ((++_sp & 255u) == 0u) { if (xb_ld(&(bar)[XB_TMO])) break; if (_sp > XB_SPIN_CAP) { atomicAdd(&(bar)[XB_TMO], 1u); break; } } } } while (0)

struct XcdBarrier {
    unsigned* bar; unsigned x;
    volatile LAS unsigned* st;
};

__device__ __forceinline__ XcdBarrier xcd_barrier_post(unsigned* bar, volatile LAS unsigned* st) {
    XcdBarrier b; b.bar = bar; b.x = xb_xcc_id(); b.st = st;
    if (threadIdx.x == 0) (void)xb_add(&bar[XB_XCNT(b.x)], 1u);
    return b;
}
__device__ __forceinline__ void xcd_barrier_complete(unsigned* bar, unsigned x, unsigned& nloc, unsigned& nx) {
    const unsigned G = gridDim.x * gridDim.y * gridDim.z;
    unsigned sum, cnt, mine, sp = 0u;
    for (;;) {
        sum = 0u; cnt = 0u; mine = 0u;
#pragma unroll
        for (unsigned j = 0; j < 16; ++j) { const unsigned c = xb_ld(&bar[XB_XCNT(j)]); sum += c; cnt += (c > 0u) ? 1u : 0u; mine = (j == x) ? c : mine; }
        if (sum == G) break;
        __builtin_amdgcn_s_sleep(1);
        if ((++sp & 255u) == 0u) { if (xb_ld(&bar[XB_TMO])) break; if (sp > XB_SPIN_CAP) { atomicAdd(&bar[XB_TMO], 1u); break; } }
    }
    nloc = mine > 0u ? mine : 1u; nx = cnt > 0u ? cnt : 1u;
}

__device__ __forceinline__ void xcd_barrier(const XcdBarrier& b) {
    asm volatile("s_waitcnt vmcnt(0)" ::: "memory");
    __syncthreads();
    if (threadIdx.x == 0) {
        unsigned* bar = b.bar;
        __builtin_amdgcn_s_waitcnt(0);
        unsigned nloc = b.st[0], nx = b.st[1];
        if (nloc == 0u) { xcd_barrier_complete(bar, b.x, nloc, nx); b.st[0] = nloc; b.st[1] = nx; }
        const unsigned old = xb_add(&bar[XB_XSUB(b.x)], 1u);
        const unsigned gen = old / nloc;
        if (old + 1u == (gen + 1u) * nloc) {
            __builtin_amdgcn_fence(__ATOMIC_RELEASE, "agent");
            asm volatile("s_waitcnt vmcnt(0)" ::: "memory");
            const unsigned og = xb_add(&bar[XB_TOP], 1u);
            const unsigned tg = og / nx;
            if (og + 1u == (tg + 1u) * nx) xb_add(&bar[XB_TOPGEN], 1u);
            else XB_SPIN(xb_ld(&bar[XB_TOPGEN]) == tg, bar);
            __builtin_amdgcn_fence(__ATOMIC_ACQUIRE, "agent");
            xb_add(&bar[XB_XGEN(b.x)], 1u);
            asm volatile("s_waitcnt vmcnt(0)" ::: "memory");
        } else {
            XB_SPIN(xb_ld(&bar[XB_XGEN(b.x)]) == gen, bar);
            __builtin_amdgcn_fence(__ATOMIC_ACQUIRE, "agent");
            asm volatile("s_waitcnt vmcnt(0)" ::: "memory");
        }
    }
    __syncthreads();
}

namespace pg8 {
#define PG8_LAS __attribute__((address_space(3)))
typedef unsigned short bf16_t;
typedef short bf16x8 __attribute__((ext_vector_type(8)));
typedef float f32x4 __attribute__((ext_vector_type(4)));
typedef unsigned u32x4 __attribute__((ext_vector_type(4)));
typedef unsigned u32x2 __attribute__((ext_vector_type(2)));
constexpr int BM = 256, BK = 64, HALF = 128, HTB = HALF * BK * 2, STAGE_BYTES = 8 * HTB, NXCD = 8, WGM = 8;

__host__ __device__ __forceinline__ int lds_byte(int r, int c) { const int st = (r >> 4) * 2 + (c >> 5), rr = r & 15, cc = c & 31, ob = rr * 64 + cc * 2; return st * 1024 + (ob ^ (((ob >> 9) & 1) << 5)); }
__host__ __device__ __forceinline__ void stage_rc(int b, int& R, int& C) { const int st = b / 1024, sb = b % 1024, swz = sb ^ (((sb >> 9) & 1) << 5); R = (st >> 1) * 16 + swz / 64; C = (st & 1) * 32 + (swz % 64) / 2; }
__host__ __device__ __forceinline__ int perm32(int rho) { const int n = rho >> 4, i = rho & 15; return 8 * (i >> 2) + 4 * n + (i & 3); }

struct Unit { int pm, pn, e; };

struct StaticOrder {
    static constexpr bool GATHER = false;
    const char* A; const char* Bt; int K; int nM, nN, nwg, G, c;
    __device__ void init(const void* A_, const void* Bt_, int M, int N, int K_, int G_, int c_) { A = (const char*)A_; Bt = (const char*)Bt_; K = K_; nM = M / BM; nN = N / BM; nwg = nM * nN; G = G_; c = c_; }
    __device__ bool next(int i, Unit& u) const {
        const long L = (long)i * G + c; if (L >= nwg) return false;
        int wgid = (int)L; { const int q = nwg / NXCD, r = nwg % NXCD, xcd = wgid % NXCD, off = wgid / NXCD; wgid = (xcd < r ? xcd * (q + 1) : r * (q + 1) + (xcd - r) * q) + off; }
        const int nig = WGM * nN, gid = wgid / nig, fm = gid * WGM, gsz = (nM - fm) < WGM ? (nM - fm) : WGM;
        u.pm = fm + ((wgid % nig) % gsz); u.pn = (wgid % nig) / gsz; u.e = 0; return true;
    }
    __device__ __forceinline__ const char* a_base(const Unit& u) const { return A + (size_t)u.pm * (size_t)(BM * 2) * K; }
    __device__ __forceinline__ const char* b_base(const Unit& u) const { return Bt + (size_t)u.pn * (size_t)(BM * 2) * K; }
    __device__ __forceinline__ void a_voff(int, int, int, int, unsigned (&)[2]) const {}
};

__device__ __forceinline__ unsigned cvt_pk_bf16(float lo, float hi) { unsigned r; asm volatile("v_cvt_pk_bf16_f32 %0, %1, %2" : "=v"(r) : "v"(lo), "v"(hi)); return r; }

typedef int i32x8 __attribute__((ext_vector_type(8)));
typedef int i32x4 __attribute__((ext_vector_type(4)));
template <int K, class Epi, class Sched, bool ALIGN_EPI, bool FP8 = false, int SA = 127, int SB = 127>
__device__ __forceinline__ void gemm_phase(PG8_LAS unsigned char* lds, const Sched& S, const Epi& E) {
    int tid_ = threadIdx.x; asm volatile("" : "+v"(tid_));
    const int tid = tid_, wid = __builtin_amdgcn_readfirstlane(tid >> 6), lane = tid & 63, wr = wid >> 2, wc = wid & 3, fr = lane & 15, fq = lane >> 4;
    constexpr int nt = K / BK;
    constexpr int NH = Sched::GATHER ? 2 : 1;
    unsigned voffB[2], cvA[NH][2], nvA[NH][2];
#pragma unroll
    for (int i = 0; i < 2; ++i) { int R, C; stage_rc(tid * 16 + i * 8192, R, C); const int Rb = Epi::PERM ? ((R & ~31) + perm32(R & 31)) : R;
        voffB[i] = (unsigned)(Rb * K + C) * 2u;
        cvA[0][i] = nvA[0][i] = (unsigned)(R * K + C) * 2u; if constexpr (NH == 2) { cvA[NH - 1][i] = nvA[NH - 1][i] = cvA[0][i]; } }
    constexpr size_t kstep = (size_t)(BK * 2);
    constexpr size_t hstep = (size_t)HALF * K * 2;
    constexpr size_t hstepA = Sched::GATHER ? (size_t)0 : hstep;
    const unsigned ldsw = (unsigned)wid * 1024u;
    const int aoff = lds_byte(wr * 64 + fr, fq * 8), boff = lds_byte(wc * 32 + fr, fq * 8);
#define PG8_SA(b, h) (((b) * 2 + (h)) * HTB)
#define PG8_SB(b, h) ((4 + (b) * 2 + (h)) * HTB)
#define PG8_STAGE(bufoff, gbase, voff) do { _Pragma("unroll") for (int _i = 0; _i < 2; ++_i) \
        __builtin_amdgcn_global_load_lds((const unsigned*)((const char*)(gbase) + (voff)[_i]), (PG8_LAS unsigned*)(lds + (bufoff) + ldsw + _i * 8192), 16, 0, 0); } while (0)
#define PG8_LD32(addr) __builtin_shufflevector(*(const PG8_LAS i32x4*)(addr), *(const PG8_LAS i32x4*)((addr) + 1024), 0, 1, 2, 3, 4, 5, 6, 7)
#define PG8_LDA(dst, b, h) do { _Pragma("unroll") for (int m = 0; m < 4; ++m) dst[m] = PG8_LD32(lds + PG8_SA(b, h) + aoff + m * 2048); } while (0)
#define PG8_LDB(dst, b, h) do { _Pragma("unroll") for (int n = 0; n < 2; ++n) dst[n] = PG8_LD32(lds + PG8_SB(b, h) + boff + n * 2048); } while (0)
#define PG8_H0(x) __builtin_bit_cast(bf16x8, __builtin_shufflevector((x), (x), 0, 1, 2, 3))
#define PG8_H1(x) __builtin_bit_cast(bf16x8, __builtin_shufflevector((x), (x), 4, 5, 6, 7))
#define PG8_MMA(ai, bj, At, Bt) do { __builtin_amdgcn_s_setprio(1); _Pragma("unroll") for (int m = 0; m < 4; ++m) _Pragma("unroll") for (int n = 0; n < 2; ++n) { \
        if constexpr (FP8) asm volatile("v_mfma_scale_f32_16x16x128_f8f6f4 %0, %1, %2, %0, %3, %4 op_sel_hi:[0,0,0]" : "+v"(acc[ai][bj][m][n]) : "v"(Bt[n]), "v"(At[m]), "v"(sbv), "v"(sav)); \
        else { acc[ai][bj][m][n] = __builtin_amdgcn_mfma_f32_16x16x32_bf16(PG8_H0(Bt[n]), PG8_H0(At[m]), acc[ai][bj][m][n], 0, 0, 0); \
               acc[ai][bj][m][n] = __builtin_amdgcn_mfma_f32_16x16x32_bf16(PG8_H1(Bt[n]), PG8_H1(At[m]), acc[ai][bj][m][n], 0, 0, 0); } } \
        __builtin_amdgcn_s_setprio(0); } while (0)
#define PG8_WAIT_V(n) asm volatile("s_waitcnt vmcnt(" #n ")" ::: "memory")
#define PG8_WAIT_L(n) asm volatile("s_waitcnt lgkmcnt(" #n ")" ::: "memory")
#define PG8_BAR __builtin_amdgcn_s_barrier()
#define PG8_SCHED __builtin_amdgcn_sched_barrier(0)
    int sav = SA, sbv = SB; asm volatile("" : "+v"(sav), "+v"(sbv));
    Unit cur, nxt; int ui = 0;
    if (!S.next(0, cur)) return;
    f32x4 acc[2][2][4][2];
#pragma unroll
    for (int a = 0; a < 2; ++a)
#pragma unroll
        for (int b = 0; b < 2; ++b)
#pragma unroll
            for (int m = 0; m < 4; ++m)
#pragma unroll
                for (int n = 0; n < 2; ++n) acc[a][b][m][n] = (f32x4){0.f, 0.f, 0.f, 0.f};
    i32x8 At[4], B0[2], B1[2];
    const char* cA = S.a_base(cur); const char* cB = S.b_base(cur);
    if constexpr (Sched::GATHER) {
        int R0, C0, R1, C1; stage_rc(tid * 16, R0, C0); stage_rc(tid * 16 + 8192, R1, C1);
#pragma unroll
        for (int h = 0; h < 2; ++h) { unsigned v[2]; S.a_voff(0, h, R0, R1, v); cvA[h][0] = v[0] + (unsigned)C0 * 2u; cvA[h][1] = v[1] + (unsigned)C1 * 2u; }
    }
    PG8_STAGE(PG8_SB(0, 0), cB, voffB); PG8_STAGE(PG8_SB(0, 1), cB + hstep, voffB); PG8_STAGE(PG8_SA(0, 0), cA, cvA[0]); PG8_STAGE(PG8_SA(0, 1), cA + hstepA, cvA[NH - 1]);
    if (wr == 1) PG8_BAR;
    PG8_WAIT_V(2); PG8_BAR;
    PG8_STAGE(PG8_SB(1, 0), cB + kstep, voffB); PG8_STAGE(PG8_SA(1, 0), cA + kstep, cvA[0]); PG8_STAGE(PG8_SB(1, 1), cB + hstep + kstep, voffB);
    PG8_WAIT_V(6); PG8_BAR;
    for (;;) {
        const bool has_next = S.next(ui + 1, nxt);
        const char* nA = has_next ? S.a_base(nxt) : cA; const char* nB = has_next ? S.b_base(nxt) : cB;
        if constexpr (Sched::GATHER) {
            if (has_next) {
                int t2 = threadIdx.x; asm volatile("" : "+v"(t2));
                int R0, C0, R1, C1; stage_rc(t2 * 16, R0, C0); stage_rc(t2 * 16 + 8192, R1, C1);
#pragma unroll
                for (int h = 0; h < 2; ++h) { unsigned v[2]; S.a_voff(ui + 1, h, R0, R1, v); nvA[h][0] = v[0] + (unsigned)C0 * 2u; nvA[h][1] = v[1] + (unsigned)C1 * 2u; }
            } else {
#pragma unroll
                for (int h = 0; h < 2; ++h) { nvA[h][0] = cvA[h][0]; nvA[h][1] = cvA[h][1]; }
            }
        }
#pragma unroll 1
        for (int t = 0; t < nt; t += 2) {
            const bool last = (t == nt - 2);
            const char* a1 = cA + (size_t)(t + 1) * kstep;
            const char* a2 = last ? nA : cA + (size_t)(t + 2) * kstep; const char* b2 = last ? nB : cB + (size_t)(t + 2) * kstep;
            const char* a3 = a2 + kstep; const char* b3 = b2 + kstep;
            unsigned v2[NH][2];
#pragma unroll
            for (int h = 0; h < NH; ++h) { if constexpr (Sched::GATHER) { v2[h][0] = last ? nvA[h][0] : cvA[h][0]; v2[h][1] = last ? nvA[h][1] : cvA[h][1]; } else { v2[h][0] = cvA[h][0]; v2[h][1] = cvA[h][1]; } }
            PG8_LDB(B0, 0, 0); PG8_LDB(B1, 0, 1); PG8_SCHED; PG8_LDA(At, 0, 0); PG8_STAGE(PG8_SA(1, 1), a1 + hstepA, cvA[NH - 1]);
            PG8_WAIT_V(8); PG8_WAIT_L(0); PG8_BAR; PG8_MMA(0, 0, At, B0); PG8_MMA(0, 1, At, B1); PG8_BAR; PG8_SCHED;
            PG8_LDA(At, 0, 1); PG8_STAGE(PG8_SB(0, 0), b2, voffB); PG8_STAGE(PG8_SB(0, 1), b2 + hstep, voffB); PG8_STAGE(PG8_SA(0, 0), a2, v2[0]);
            PG8_WAIT_V(8); PG8_WAIT_L(0); PG8_BAR; PG8_MMA(1, 0, At, B0); PG8_MMA(1, 1, At, B1); PG8_BAR; PG8_SCHED;
            PG8_LDB(B0, 1, 0); PG8_LDB(B1, 1, 1); PG8_SCHED; PG8_LDA(At, 1, 0); PG8_STAGE(PG8_SA(0, 1), a2 + hstepA, v2[NH - 1]);
            PG8_WAIT_V(8); PG8_WAIT_L(0); PG8_BAR; PG8_MMA(0, 0, At, B0); PG8_MMA(0, 1, At, B1); PG8_BAR; PG8_SCHED;
            PG8_LDA(At, 1, 1); PG8_STAGE(PG8_SB(1, 0), b3, voffB); PG8_STAGE(PG8_SB(1, 1), b3 + hstep, voffB); PG8_STAGE(PG8_SA(1, 0), a3, v2[0]);
            PG8_WAIT_V(8); PG8_WAIT_L(0); PG8_BAR; PG8_MMA(1, 0, At, B0); PG8_MMA(1, 1, At, B1); PG8_BAR; PG8_SCHED;
        }
        if constexpr (ALIGN_EPI) { if (wr == 0) PG8_BAR; }
        if constexpr (FP8) asm volatile("s_nop 15\n\ts_nop 15" ::: "memory");
        E(acc, cur, ui, wr, wc, fr, fq);
        if (!has_next) break;
#pragma unroll
        for (int a = 0; a < 2; ++a)
#pragma unroll
            for (int b = 0; b < 2; ++b)
#pragma unroll
                for (int m = 0; m < 4; ++m)
#pragma unroll
                    for (int n = 0; n < 2; ++n) acc[a][b][m][n] = (f32x4){0.f, 0.f, 0.f, 0.f};
        cur = nxt; cA = nA; cB = nB; ++ui;
        if constexpr (Sched::GATHER) {
#pragma unroll
            for (int h = 0; h < NH; ++h) { cvA[h][0] = nvA[h][0]; cvA[h][1] = nvA[h][1]; }
        }
        if constexpr (ALIGN_EPI) { if (wr == 1) PG8_BAR; }
    }
    PG8_WAIT_V(0);
    if constexpr (!ALIGN_EPI) { if (wr == 0) PG8_BAR; }
    PG8_BAR;
#undef PG8_SA
#undef PG8_SB
#undef PG8_STAGE
#undef PG8_LDA
#undef PG8_LDB
#undef PG8_MMA
#undef PG8_LD32
#undef PG8_H0
#undef PG8_H1
#undef PG8_WAIT_V
#undef PG8_WAIT_L
#undef PG8_BAR
#undef PG8_SCHED
}
}
#define GAS __attribute__((address_space(1)))
typedef float f32x4 __attribute__((ext_vector_type(4)));
typedef float f32x16 __attribute__((ext_vector_type(16)));
typedef short bf16x8 __attribute__((ext_vector_type(8)));
typedef unsigned v4u __attribute__((ext_vector_type(4)));
typedef unsigned v2u __attribute__((ext_vector_type(2)));
#define LDS_WAIT() asm volatile("s_waitcnt lgkmcnt(0)" ::: "memory")
#define VM_WAIT() asm volatile("s_waitcnt vmcnt(0)" ::: "memory")
__device__ __forceinline__ unsigned pk2(float lo, float hi) { return f2bf(lo) | (f2bf(hi) << 16); }

constexpr int NWAVES = 8, NTHR = 512;
constexpr int LDS_STAGE = 0;
constexpr int LDS_RS = 131072;
constexpr int LDS_ROWTOK = LDS_RS + 8192;
constexpr int LDS_GATE = LDS_ROWTOK + 8192;
constexpr int LDS_MISC = LDS_GATE + 8192;
constexpr int LDS_BYTES = LDS_MISC + 256;
constexpr size_t WO_IN = 0, WO_SM = 6 * MiB, WO_RHI = 6 * MiB + 65536, WO_RLO = 6 * MiB + 131072, WO_OUT = 7 * MiB, WO_XQ = 9 * MiB, WO_XO = 10 * MiB, WO_GU = 11 * MiB, WO_D = 43 * MiB;
static_assert(WO_D + 16 * MiB <= WS_WLAYER, "weight block");
constexpr int CW_BAR = 4096;
constexpr int MAX_LAUNCH = 40;
static_assert((CW_BAR + MAX_LAUNCH * XCD_BAR_WORDS) * 4 <= (int)(1 * MiB), "ctl");

enum { PH_PRO = 0, PH_XKV = 1, PH_L0 = 2, NPH = 13, PH_FINAL = PH_L0 + NLAYER * NPH, PH_END = PH_FINAL + 1 };
enum { LP_INPROJ = 0, LP_MIXA, LP_MIXB, LP_MIXC, LP_WOUT, LP_XQ, LP_XATTN, LP_XO, LP_ROUTE, LP_SORT, LP_GU, LP_DOWN0, LP_DOWN1 };

struct Args { P p; int ph_lo, ph_hi, li, pad; };

template <bool HAS_RS> struct EpiBf16 {
    static constexpr bool PERM = true;
    bf16* O; int ldc; const LAS float* rstab;
    __device__ __forceinline__ void operator()(const pg8::f32x4 (&acc)[2][2][4][2], const pg8::Unit& u, int iu, int wr, int wc, int fr, int fq) const {
#pragma unroll
        for (int ai = 0; ai < 2; ++ai)
#pragma unroll
            for (int m = 0; m < 4; ++m) {
                const int lrow = ai * 128 + wr * 64 + m * 16 + fr;
                float sc = 1.f; if (HAS_RS) sc = rstab[iu * 256 + lrow];
                bf16* rowp = O + (size_t)(u.pm * 256 + lrow) * ldc + u.pn * 256 + wc * 32 + 8 * fq;
#pragma unroll
                for (int bj = 0; bj < 2; ++bj) { const pg8::f32x4 v0 = acc[ai][bj][m][0] * sc, v1 = acc[ai][bj][m][1] * sc;
                    pg8::u32x4 w; w.x = pg8::cvt_pk_bf16(v0[0], v0[1]); w.y = pg8::cvt_pk_bf16(v0[2], v0[3]); w.z = pg8::cvt_pk_bf16(v1[0], v1[1]); w.w = pg8::cvt_pk_bf16(v1[2], v1[3]);
                    st_b128(rowp + bj * 128, w); }
            }
    }
};
__device__ __forceinline__ unsigned pk4_fp8(float a, float b, float c, float d) { int w = __builtin_amdgcn_cvt_pk_fp8_f32(a, b, 0, false); w = __builtin_amdgcn_cvt_pk_fp8_f32(c, d, w, true); return (unsigned)w; }
struct EpiGU {
    static constexpr bool PERM = true;
    unsigned char* U8; const LAS float* rstab;
    __device__ __forceinline__ void operator()(const pg8::f32x4 (&acc)[2][2][4][2], const pg8::Unit& u, int iu, int wr, int wc, int fr, int fq) const {
#pragma unroll
        for (int ai = 0; ai < 2; ++ai)
#pragma unroll
            for (int m = 0; m < 4; ++m) {
                const int lrow = ai * 128 + wr * 64 + m * 16 + fr;
                const float sc = rstab[iu * 256 + lrow];
                float o[8];
#pragma unroll
                for (int n = 0; n < 2; ++n)
#pragma unroll
                    for (int j = 0; j < 4; ++j) { const float g = acc[ai][0][m][n][j] * sc, uu = acc[ai][1][m][n][j] * sc; o[n * 4 + j] = 4.f * g * uu * __builtin_amdgcn_rcpf(1.f + __expf(-g)); }
                pg8::u32x2 w; w.x = pk4_fp8(o[0], o[1], o[2], o[3]); w.y = pk4_fp8(o[4], o[5], o[6], o[7]);
                st_b64(U8 + (size_t)(u.pm * 256 + lrow) * 512 + u.pn * 128 + wc * 32 + 8 * fq, w);
            }
    }
};
template <int MODE, bool W8 = false> struct EpiRes {
    static constexpr bool PERM = false;
    static constexpr bool MOE = MODE != 0;
    bf16* hb; float* ssq; const LAS int* rowtab; const LAS float* gatetab; float gs; bf16* t0; unsigned char* h8;
    __device__ __forceinline__ void operator()(const pg8::f32x4 (&acc)[2][2][4][2], const pg8::Unit& u, int iu, int wr, int wc, int fr, int fq) const {
#pragma unroll
        for (int ai = 0; ai < 2; ++ai)
#pragma unroll
            for (int m = 0; m < 4; ++m) {
                const int lrow = ai * 128 + wr * 64 + m * 16 + fr;
                int row = u.pm * 256 + lrow; float g = gs;
                if (MOE) { row = rowtab[iu * 256 + lrow]; g = gatetab[iu * 256 + lrow] * gs; }
                const bool ok = !MOE || row >= 0;
                const size_t off = (size_t)(ok ? row : 0) * DM + u.pn * 256 + wc * 32 + 4 * fq;
                float q = 0.f;
                if (ok) {
#pragma unroll
                    for (int bj = 0; bj < 2; ++bj)
#pragma unroll
                        for (int n = 0; n < 2; ++n) {
                            if (MODE == 1) { const pg8::f32x4 o = acc[ai][bj][m][n] * g; pg8::u32x2 w; w.x = pg8::cvt_pk_bf16(o[0], o[1]); w.y = pg8::cvt_pk_bf16(o[2], o[3]); st_b64(t0 + off + bj * 128 + n * 16, w); }
                            else {
                                const pg8::u32x2 bw = *(const pg8::u32x2*)(hb + off + bj * 128 + n * 16);
                                pg8::f32x4 bs; bs[0] = __builtin_bit_cast(float, bw.x << 16); bs[1] = __builtin_bit_cast(float, bw.x & 0xffff0000u); bs[2] = __builtin_bit_cast(float, bw.y << 16); bs[3] = __builtin_bit_cast(float, bw.y & 0xffff0000u);
                                if (MODE == 2) { const pg8::u32x2 tw = *(const pg8::u32x2*)(t0 + off + bj * 128 + n * 16);
                                    bs[0] += __builtin_bit_cast(float, tw.x << 16); bs[1] += __builtin_bit_cast(float, tw.x & 0xffff0000u); bs[2] += __builtin_bit_cast(float, tw.y << 16); bs[3] += __builtin_bit_cast(float, tw.y & 0xffff0000u); }
                                const pg8::f32x4 o = bs + acc[ai][bj][m][n] * g;
                                pg8::u32x2 w; w.x = pg8::cvt_pk_bf16(o[0], o[1]); w.y = pg8::cvt_pk_bf16(o[2], o[3]);
                                const float r0 = __builtin_bit_cast(float, w.x << 16), r1 = __builtin_bit_cast(float, w.x & 0xffff0000u), r2 = __builtin_bit_cast(float, w.y << 16), r3 = __builtin_bit_cast(float, w.y & 0xffff0000u);
                                q += (r0 * r0 + r1 * r1) + (r2 * r2 + r3 * r3);
                                st_b64(hb + off + bj * 128 + n * 16, w);
                                if (W8) *(unsigned*)(h8 + off + bj * 128 + n * 16) = pk4_fp8(o[0], o[1], o[2], o[3]); } }
                }
                if (MODE != 1) { q += __shfl_xor(q, 16); q += __shfl_xor(q, 32); if (fq == 0 && ok) ssq[(size_t)row * 16 + u.pn * 4 + wc] = q; }
            }
    }
};
template <bool GATH> struct MoeOrder {
    static constexpr bool GATHER = GATH;
    const char* A; const char* Bt; int K; size_t estride; int lo, hi, G, c; const int* tilee; const LAS int* rowtab;
    __device__ bool next(int i, pg8::Unit& u) const { const int L = i * G + c, t = lo + (L >> 2); if (t >= hi) return false; u.pm = t; u.pn = L & 3; u.e = tilee[t]; return true; }
    __device__ __forceinline__ const char* a_base(const pg8::Unit& u) const { return GATH ? A : A + (size_t)u.pm * (size_t)512 * K; }
    __device__ __forceinline__ const char* b_base(const pg8::Unit& u) const { return Bt + (size_t)u.e * estride + (size_t)u.pn * (size_t)512 * K; }
    __device__ __forceinline__ void a_voff(int iu, int h, int R0, int R1, unsigned (&v)[2]) const { v[0] = (unsigned)rowtab[iu * 256 + h * 128 + R0] * (unsigned)(K * 2); v[1] = (unsigned)rowtab[iu * 256 + h * 128 + R1] * (unsigned)(K * 2); }
};

__device__ __forceinline__ void router_weights(const P& p, int gtid, int gstride);
__device__ __forceinline__ void tr_item(const float* W, int N, int K, int k0, int n0, const float* gain, float scale, bf16* dst, LAS float* scr, int lane) {
    const int kr = lane >> 3, c4 = lane & 7;
    f32x4 v[8];
#pragma unroll
    for (int i = 0; i < 8; ++i) v[i] = *(const f32x4*)(W + (size_t)(k0 + 8 * i + kr) * N + n0 + 4 * c4);
#pragma unroll
    for (int i = 0; i < 8; ++i) { const int kk = 8 * i + kr; float g = scale; if (gain) g *= gain[k0 + kk];
        LAS float* d = scr + kk * 33 + 4 * c4; d[0] = v[i].x * g; d[1] = v[i].y * g; d[2] = v[i].z * g; d[3] = v[i].w * g; }
    LDS_WAIT();
    const int c = lane & 7;
#pragma unroll
    for (int j = 0; j < 4; ++j) { const int n = (lane >> 3) + 8 * j; const LAS float* s = scr + (8 * c) * 33 + n;
        v4u o; o.x = pk2(s[0 * 33], s[1 * 33]); o.y = pk2(s[2 * 33], s[3 * 33]); o.z = pk2(s[4 * 33], s[5 * 33]); o.w = pk2(s[6 * 33], s[7 * 33]);
        st_b128(dst + (size_t)n * K + k0 + 8 * c, o); }
    LDS_WAIT();
}
__device__ __forceinline__ void tr_item8(const float* W, int N, int K, int k0, int n0, const float* gain, float scale, unsigned char* dst, LAS float* scr, int lane) {
    const int kr = lane >> 3, c4 = lane & 7;
    f32x4 v[8];
#pragma unroll
    for (int i = 0; i < 8; ++i) v[i] = *(const f32x4*)(W + (size_t)(k0 + 8 * i + kr) * N + n0 + 4 * c4);
#pragma unroll
    for (int i = 0; i < 8; ++i) { const int kk = 8 * i + kr; float g = scale; if (gain) g *= gain[k0 + kk];
        LAS float* d = scr + kk * 33 + 4 * c4; d[0] = v[i].x * g; d[1] = v[i].y * g; d[2] = v[i].z * g; d[3] = v[i].w * g; }
    LDS_WAIT();
    const int c = lane & 7;
#pragma unroll
    for (int j = 0; j < 4; ++j) { const int n = (lane >> 3) + 8 * j; const LAS float* s = scr + (8 * c) * 33 + n;
        v2u o; o.x = pk4_fp8(s[0 * 33], s[1 * 33], s[2 * 33], s[3 * 33]); o.y = pk4_fp8(s[4 * 33], s[5 * 33], s[6 * 33], s[7 * 33]);
        st_b64(dst + (size_t)n * K + k0 + 8 * c, o); }
    LDS_WAIT();
}
constexpr int IT_LAYER = 15360;
__device__ __forceinline__ void prologue_item(const P& p, int it, LAS float* scr, int lane) {
    const int l = it / IT_LAYER; int r = it % IT_LAYER;
    unsigned char* wl = ws_base(p.ws) + WS_W + (size_t)l * WS_WLAYER;
    if (r < 1536) {
        const int seg = r / 768; r %= 768; const int kb = r / 48, nb = r % 48; const int n0 = (seg ? 1544 : 0) + 32 * nb, drow = seg * 1536 + 32 * nb;
        const float sc = drow < 512 ? 0.125f * LOG2E : ((drow >= C_GQ && drow < C_GK) ? 0.125f : 1.f);
        tr_item(p.w_in + (size_t)l * DM * INW, INW, DM, 64 * kb, n0, p.mix_norm + l * DM, sc, (bf16*)(wl + WO_IN) + (size_t)drow * DM, scr, lane); return; }
    r -= 1536;
    if (r < 512) { const int kb = r / 32, nb = r % 32; tr_item(p.w_out + (size_t)l * DM * DM, DM, DM, 64 * kb, 32 * nb, nullptr, 1.f, (bf16*)(wl + WO_OUT) + (size_t)(32 * nb) * DM, scr, lane); return; }
    r -= 512;
    if (r < 256) { const int kb = r / 16, nb = r % 16; tr_item(p.w_xq + (size_t)l * DM * 512, 512, DM, 64 * kb, 32 * nb, p.cross_norm + l * DM, 0.08838834764831845f * LOG2E, (bf16*)(wl + WO_XQ) + (size_t)(32 * nb) * DM, scr, lane); return; }
    r -= 256;
    if (r < 256) { const int kb = r / 32, nb = r % 32; tr_item8(p.w_xo + (size_t)l * 512 * DM, DM, 512, 64 * kb, 32 * nb, nullptr, 32.f, (unsigned char*)(wl + WO_XO) + (size_t)(32 * nb) * 512, scr, lane); return; }
    r -= 256;
    if (r < 512) { const int kv = r / 256; r %= 256; const int kb = r / 16, nb = r % 16;
        tr_item((kv ? p.w_xv : p.w_xk) + (size_t)l * DM * 512, 512, DM, 64 * kb, 32 * nb, nullptr, 1.f, (bf16*)(ws_base(p.ws) + WS_WXKV) + (size_t)(l * 1024 + kv * 512 + 32 * nb) * DM, scr, lane); return; }
    r -= 512;
    if (r < 8192) { const int up = r / 4096; r %= 4096; const int e = r / 256; r %= 256; const int kb = r / 16, nb = r % 16; const int c0 = 32 * nb, drow = (c0 >> 7) * 256 + up * 128 + (c0 & 127);
        tr_item8((up ? p.w_eu : p.w_eg) + ((size_t)l * 16 + e) * DM * 512, 512, DM, 64 * kb, c0, p.moe_norm + l * DM, 32.f, (unsigned char*)(wl + WO_GU) + ((size_t)e * 1024 + drow) * DM, scr, lane); return; }
    r -= 8192;
    { const int e = r / 256; r %= 256; const int kb = r / 32, nb = r % 32;
      tr_item8(p.w_ed + ((size_t)l * 16 + e) * 512 * DM, DM, 512, 64 * kb, 32 * nb, nullptr, 32.f, (unsigned char*)(wl + WO_D) + ((size_t)e * 1024 + 32 * nb) * 512, scr, lane); }
}
__device__ __forceinline__ void row_to_bf16(const float* src, bf16* dst, float* ssq, const float* gain, int lane, int mode) {
    const f32x4* s = (const f32x4*)src + lane;
    f32x4 v[4]; float q = 0.f;
#pragma unroll
    for (int j = 0; j < 4; ++j) { v[j] = s[64 * j]; q += (v[j].x * v[j].x + v[j].y * v[j].y) + (v[j].z * v[j].z + v[j].w * v[j].w); }
    q = wave_sum(q);
    float sc = 1.f;
    if (mode == 1) sc = rsqrtf(q * (1.0f / DM) + EPS);
    v2u* d = (v2u*)dst + lane; float q2 = 0.f;
#pragma unroll
    for (int j = 0; j < 4; ++j) {
        f32x4 g = (f32x4){1.f, 1.f, 1.f, 1.f}; if (mode == 1) g = ((const f32x4*)gain)[lane + 64 * j];
        v2u o; o.x = pk2(v[j].x * sc * g.x, v[j].y * sc * g.y); o.y = pk2(v[j].z * sc * g.z, v[j].w * sc * g.w); st_b64(d + 64 * j, o);
        const float r0 = __builtin_bit_cast(float, o.x << 16), r1 = __builtin_bit_cast(float, o.x & 0xffff0000u), r2 = __builtin_bit_cast(float, o.y << 16), r3 = __builtin_bit_cast(float, o.y & 0xffff0000u);
        q2 += (r0 * r0 + r1 * r1) + (r2 * r2 + r3 * r3); }
    if (mode == 0) { q2 = wave_sum(q2); if (lane < 16) ssq[lane] = lane == 0 ? q2 : 0.f; }
}
__device__ __forceinline__ void prologue(const P& p, LAS unsigned char* lds, int vcu, int G, int wave, int lane) {
    asm volatile("" : "+v"(lane));
    LAS float* scr = (LAS float*)(lds + LDS_STAGE + wave * 16384);
    const int gw = vcu * NWAVES + wave, NGW = G * NWAVES;
    for (int it = gw; it < NLAYER * IT_LAYER; it += NGW) prologue_item(p, it, scr, lane);
    for (int idx = gw * 64 + lane; idx < NLAYER * 2 * 32768; idx += NGW * 64) {
        const int l = idx / 65536, r = idx % 65536, which = r / 32768, e = r % 32768, row = e / 1024, k = e % 1024;
        unsigned char* wl = ws_base(p.ws) + WS_W + (size_t)l * WS_WLAYER;
        if (which == 0) {
            float v = 0.f;
            if (row < 8) v = p.w_in[((size_t)l * DM + k) * INW + 1536 + row]; else if (row < 24) v = p.w_in[((size_t)l * DM + k) * INW + 3080 + (row - 8)];
            ((bf16*)(wl + WO_SM))[row * 1024 + k] = (bf16)f2bf(v * p.mix_norm[l * DM + k]);
        }
    }
    router_weights(p, gw * 64 + lane, NGW * 64);
    for (int m = gw; m < 4096; m += NGW) row_to_bf16(p.mem + (size_t)m * DM, WSP(bf16, WS_MEMN) + (size_t)m * DM, nullptr, p.mem_norm, lane, 1);
    for (int m = gw; m < NTOK; m += NGW) row_to_bf16(p.x + (size_t)m * DM, WSP(bf16, WS_HB) + (size_t)m * DM, WSP(float, WS_SSQ) + (size_t)m * 16, nullptr, lane, 0);
}
__device__ __forceinline__ void small_proj(const P& p, int l, LAS unsigned char* lds, int vcu, int G, int wave, int lane) {
    asm volatile("" : "+v"(lane));
    const bf16* wsm = (const bf16*)(ws_base(p.ws) + WS_W + (size_t)l * WS_WLAYER + WO_SM);
    const bf16* hb = WSP(bf16, WS_HB); const float* ssq = WSP(float, WS_SSQ); float* sm = WSP(float, WS_SM);
    constexpr int BST = 2048 + 16;
    { const int tid = wave * 64 + lane;
#pragma unroll
      for (int i = 0; i < 8; ++i) { const int idx = tid + NTHR * i, row = idx >> 7, c = idx & 127; *(LAS v4u*)(lds + row * BST + c * 16) = *(const v4u*)(wsm + row * 1024 + c * 8); } }
    __syncthreads();
    const int r = lane & 15, kq = lane >> 4;
    for (int blk = vcu * NWAVES + wave; blk < NTOK / 16; blk += G * NWAVES) {
        const int tok0 = blk * 16;
        const bf16x8* ap = (const bf16x8*)(hb + (size_t)(tok0 + r) * DM + kq * 32);
        pg8::f32x4 acc0 = {0.f, 0.f, 0.f, 0.f}, acc1 = {0.f, 0.f, 0.f, 0.f};
#pragma unroll
        for (int half = 0; half < 2; ++half) {
            bf16x8 af[16];
#pragma unroll
            for (int i = 0; i < 16; ++i) af[i] = ap[(half * 4 + (i >> 2)) * 16 + (i & 3)];
#pragma unroll
            for (int i = 0; i < 16; ++i) { const int s_ = half * 4 + (i >> 2), j = i & 3;
                const bf16x8 b0 = *(const LAS bf16x8*)(lds + r * BST + (128 * s_ + 32 * kq + 8 * j) * 2);
                const bf16x8 b1 = *(const LAS bf16x8*)(lds + (16 + r) * BST + (128 * s_ + 32 * kq + 8 * j) * 2);
                acc0 = __builtin_amdgcn_mfma_f32_16x16x32_bf16(af[i], b0, acc0, 0, 0, 0);
                acc1 = __builtin_amdgcn_mfma_f32_16x16x32_bf16(af[i], b1, acc1, 0, 0, 0);
                if ((i & 3) == 3) __builtin_amdgcn_sched_barrier(0); }
        }
        const float rsv = row_rs(ssq, tok0 + r);
#pragma unroll
        for (int g = 0; g < 4; ++g) { const int trow = 4 * kq + g; const float rs = __shfl(rsv, trow);
            sm[(size_t)(tok0 + trow) * 32 + r] = acc0[g] * rs; if (r < 8) sm[(size_t)(tok0 + trow) * 32 + 16 + r] = acc1[g] * rs; }
    }
    __syncthreads();
}
typedef short v4i16_t __attribute__((ext_vector_type(4)));
typedef __bf16 bf16x2_t __attribute__((ext_vector_type(2)));
typedef float f32x2_t __attribute__((ext_vector_type(2)));
__device__ __forceinline__ unsigned cvtpk(float lo, float hi) { f32x2_t v = {lo, hi}; bf16x2_t b = __builtin_convertvector(v, bf16x2_t); return __builtin_bit_cast(unsigned, b); }
__device__ __forceinline__ bf16x8 pack8(const f32x16& p, int o) {
    v4u w; w.x = cvtpk(p[o], p[o + 1]); w.y = cvtpk(p[o + 2], p[o + 3]); w.z = cvtpk(p[o + 4], p[o + 5]); w.w = cvtpk(p[o + 6], p[o + 7]);
    return __builtin_bit_cast(bf16x8, w);
}
__device__ __forceinline__ float max3f(float a, float b, float c) { float r; asm("v_max3_f32 %0, %1, %2, %3" : "=v"(r) : "v"(a), "v"(b), "v"(c)); return r; }
template <int D, bool FOX, bool OUT8 = false>
__device__ __forceinline__ void attn_unit(LAS unsigned char* lds, const bf16* Qg, int qpitch, const bf16* Kg, const bf16* Vg, int kvpitch, int NT,
                                          const float* cb, int q0, bf16* Og, int opitch, const float* gain, const float* kn) {
    constexpr int KS = D * 2 + 16, VS = D * 2 + 64;
    constexpr int KBYTES = 64 * KS, VBYTES = 64 * VS;
    constexpr int CPR = D / 8, NCH = 64 * CPR / NTHR, NS = D / 16, NDB = D / 32;
    constexpr int OFF_K = 0, OFF_V = 2 * KBYTES, OFF_CB = 2 * KBYTES + 2 * VBYTES, OFF_FX = OFF_CB + 512;
    int tid = threadIdx.x; asm volatile("" : "+v"(tid));
    const int lane = tid & 63, wave = __builtin_amdgcn_readfirstlane(tid >> 6), r32 = lane & 31, hh = lane >> 5;
    bf16x8 qf[NS];
    { const bf16* qrow = Qg + (size_t)(wave * 32 + r32) * qpitch;
#pragma unroll
      for (int s = 0; s < NS; ++s) qf[s] = *(const bf16x8*)(qrow + 16 * s + 8 * hh); }
    v4u kreg[NCH], vreg[NCH]; f32x4 cbreg = {0.f, 0.f, 0.f, 0.f};
#define AT_GLOAD(t) do { _Pragma("unroll") for (int i_ = 0; i_ < NCH; ++i_) { const int idx_ = tid + NTHR * i_, key_ = idx_ / CPR, c_ = idx_ % CPR; \
        kreg[i_] = *(const v4u*)(Kg + (size_t)((t) * 64 + key_) * kvpitch + c_ * 8); vreg[i_] = *(const v4u*)(Vg + (size_t)((t) * 64 + key_) * kvpitch + c_ * 8); } \
        if (FOX && tid < 16) cbreg = *(const f32x4*)(cb + (t) * 64 + tid * 4); } while (0)
#define AT_LSTORE(b) do { _Pragma("unroll") for (int i_ = 0; i_ < NCH; ++i_) { const int idx_ = tid + NTHR * i_, key_ = idx_ / CPR, c_ = idx_ % CPR; \
        *(LAS v4u*)(lds + OFF_K + (b) * KBYTES + key_ * KS + c_ * 16) = kreg[i_]; *(LAS v4u*)(lds + OFF_V + (b) * VBYTES + key_ * VS + c_ * 16) = vreg[i_]; } \
        if (FOX && tid < 16) *(LAS f32x4*)(lds + OFF_CB + (b) * 256 + tid * 16) = cbreg; } while (0)
    float m = -INFINITY, l = 0.f;
    f32x16 o[NDB];
#pragma unroll
    for (int d = 0; d < NDB; ++d) o[d] = f32x16{};
    const int qlo = q0 + wave * 32, qabs = qlo + r32;
    float knpre = 0.f, qkmax = 0.f;
    LAS float* fx = (LAS float*)(lds + OFF_FX);
    __syncthreads();
    if (FOX) {
        float qn2 = 0.f;
#pragma unroll
        for (int s = 0; s < NS; ++s)
#pragma unroll
            for (int e = 0; e < 8; ++e) { const float v = __builtin_bit_cast(float, ((unsigned)(unsigned short)qf[s][e]) << 16); qn2 += v * v; }
        qn2 += __shfl_xor(qn2, 32);
        qn2 = wave_max(qn2);
        if (lane == 0) fx[wave] = qn2;
        knpre = lane < 32 ? kn[lane] : 0.f;
#pragma unroll
        for (int o_ = 1; o_ < 32; o_ <<= 1) { const float t_ = __shfl_up(knpre, o_); if (lane >= o_) knpre = fmaxf(knpre, t_); }
    }
    const int t_first = FOX ? NT - 1 : 0;
    AT_GLOAD(t_first); AT_LSTORE(0);
    __syncthreads();
    if (FOX) { float q2 = fx[0];
#pragma unroll
        for (int w_ = 1; w_ < 8; ++w_) q2 = fmaxf(q2, fx[w_]);
        qkmax = sqrtf(q2); }
#pragma unroll 1
    for (int it = 0; it < NT; ++it) {
        const int b = it & 1;
        const int t = FOX ? NT - 1 - it : it;
        const int tn = FOX ? t - 1 : t + 1;
        if (it + 1 < NT) AT_GLOAD(tn);
        const int kt0 = t * 64;
        if (!FOX || kt0 <= qlo + 31) {
            f32x16 p[2];
#pragma unroll
            for (int kb = 0; kb < 2; ++kb) {
                if (FOX) {
#pragma unroll
                    for (int g = 0; g < 4; ++g) { const f32x4 c4 = *(const LAS f32x4*)(lds + OFF_CB + b * 256 + (kb * 32 + 8 * g + 4 * hh) * 4); p[kb][4 * g] = c4.x; p[kb][4 * g + 1] = c4.y; p[kb][4 * g + 2] = c4.z; p[kb][4 * g + 3] = c4.w; }
                } else p[kb] = f32x16{};
                const LAS unsigned char* kp = lds + OFF_K + b * KBYTES + (kb * 32 + r32) * KS + hh * 16;
#pragma unroll
                for (int s = 0; s < NS; ++s) { const bf16x8 kf = *(const LAS bf16x8*)(kp + s * 32); p[kb] = __builtin_amdgcn_mfma_f32_32x32x16_bf16(kf, qf[s], p[kb], 0, 0, 0); }
            }
            if (FOX && kt0 + 63 > qlo) {
#pragma unroll
                for (int kb = 0; kb < 2; ++kb)
#pragma unroll
                    for (int r = 0; r < 16; ++r) { const int key = kt0 + kb * 32 + (r & 3) + 8 * (r >> 2) + 4 * hh; if (key > qabs) p[kb][r] = -INFINITY; }
            }
            float mt = fmaxf(p[1][0], p[0][0]);
#pragma unroll
            for (int r = 1; r < 16; ++r) mt = max3f(mt, p[0][r], p[1][r]);
            mt = fmaxf(mt, __shfl_xor(mt, 32));
            const float mnew = fmaxf(m, mt);
            float ls = 0.f;
#pragma unroll
            for (int kb = 0; kb < 2; ++kb)
#pragma unroll
                for (int r = 0; r < 16; ++r) { const float e = __builtin_amdgcn_exp2f(p[kb][r] - mnew); p[kb][r] = e; ls += e; }
            if (!FOX || __builtin_amdgcn_ballot_w64(mnew > m) != 0ull) {
                const float alpha = __builtin_amdgcn_exp2f(m - mnew);
                l *= alpha;
#pragma unroll
                for (int d = 0; d < NDB; ++d)
#pragma unroll
                    for (int r = 0; r < 16; ++r) o[d][r] *= alpha;
            }
            m = mnew; l += ls;
            bf16x8 pa[2][2];
#pragma unroll
            for (int kb = 0; kb < 2; ++kb) { pa[kb][0] = pack8(p[kb], 0); pa[kb][1] = pack8(p[kb], 8); }
            const LAS unsigned char* vp = lds + OFF_V + b * VBYTES + (4 * hh + ((lane & 15) >> 2)) * VS + (16 * ((lane >> 4) & 1) + 4 * (lane & 3)) * 2;
#pragma unroll
            for (int d = 0; d < NDB; ++d) {
#pragma unroll
                for (int kb = 0; kb < 2; ++kb)
#pragma unroll
                    for (int ks = 0; ks < 2; ++ks) {
                        const LAS unsigned char* a0 = vp + (kb * 32 + 16 * ks) * VS + d * 64;
                        const v4i16_t lo = __builtin_amdgcn_ds_read_tr16_b64_v4i16((LAS v4i16_t*)a0);
                        const v4i16_t hi = __builtin_amdgcn_ds_read_tr16_b64_v4i16((LAS v4i16_t*)(a0 + 8 * VS));
                        const bf16x8 vf = (bf16x8){lo[0], lo[1], lo[2], lo[3], hi[0], hi[1], hi[2], hi[3]};
                        o[d] = __builtin_amdgcn_mfma_f32_32x32x16_bf16(vf, pa[kb][ks], o[d], 0, 0, 0);
                    }
            }
        }
        if (FOX) { const float mm = wave_min(m); if (lane == 0) fx[8 + b * 8 + wave] = mm; }
        if (it + 1 < NT) AT_LSTORE(b ^ 1);
        __syncthreads();
        if (FOX && t > 0) {
            float M0 = fx[8 + b * 8];
#pragma unroll
            for (int w_ = 1; w_ < 8; ++w_) M0 = fminf(M0, fx[8 + b * 8 + w_]);
            const float cbl = *(const LAS float*)(lds + OFF_CB + (b ^ 1) * 256 + 63 * 4);
            const float knb = __builtin_bit_cast(float, __builtin_amdgcn_readlane(__builtin_bit_cast(int, knpre), t - 1));
            if (qkmax * knb + cbl < M0 - 40.f) break;
        }
    }
#undef AT_GLOAD
#undef AT_LSTORE
    l += __shfl_xor(l, 32);
    const float inv = 1.0f / l;
    float rs = inv;
    if (FOX) {
        float ss = 0.f;
#pragma unroll
        for (int d = 0; d < NDB; ++d)
#pragma unroll
            for (int r = 0; r < 16; ++r) { const float v = o[d][r] * inv; ss += v * v; }
        ss += __shfl_xor(ss, 32);
        rs = inv * rsqrtf(ss * (1.0f / D) + EPS);
    }
    bf16* orow = Og + (size_t)(wave * 32 + r32) * opitch;
#pragma unroll
    for (int d = 0; d < NDB; ++d)
#pragma unroll
        for (int g = 0; g < 4; ++g) {
            f32x4 gn = {1.f, 1.f, 1.f, 1.f}; if (FOX) gn = *(const f32x4*)(gain + 32 * d + 8 * g + 4 * hh);
            if (OUT8) { *(unsigned*)((unsigned char*)Og + (size_t)(wave * 32 + r32) * opitch + 32 * d + 8 * g + 4 * hh) = pk4_fp8(o[d][4 * g] * rs, o[d][4 * g + 1] * rs, o[d][4 * g + 2] * rs, o[d][4 * g + 3] * rs); }
            else { v2u w; w.x = cvtpk(o[d][4 * g] * rs * gn.x, o[d][4 * g + 1] * rs * gn.y); w.y = cvtpk(o[d][4 * g + 2] * rs * gn.z, o[d][4 * g + 3] * rs * gn.w);
                st_b64(orow + 32 * d + 8 * g + 4 * hh, w); }
        }
}
__device__ __forceinline__ void fox_phase(const P& p, int l, LAS unsigned char* lds, int vcu, int G) {
    const bf16* proj = WSP(bf16, WS_PROJ); const float* cb = WSP(float, WS_CB); bf16* y = WSP(bf16, WS_Y);
    for (int pu = vcu; pu < 512; pu += G) {
        const int bh = pu >> 2, pr = pu < 256 ? (pu & 3) : 3 - (pu & 3), b = bh >> 3, h = bh & 7;
        for (int half = 0; half < 2; ++half) {
            const int qb = half ? pr : 7 - pr;
            const size_t row0 = (size_t)b * SEQ;
            attn_unit<64, true>(lds, proj + (row0 + qb * 256) * PW + C_FQ + h * 64, PW, proj + row0 * PW + C_FK + h * 64, proj + row0 * PW + C_FV + h * 64, PW, 4 * (qb + 1),
                                cb + ((size_t)b * 8 + h) * SEQ, qb * 256, y + (row0 + qb * 256) * DM + h * 64, DM, p.fox_gain + l * 512 + h * 64, WSP(const float, WS_MOE + MO_KN) + (b * 8 + h) * 32);
        }
    }
}
__device__ __forceinline__ void xattn_phase(const P& p, int l, LAS unsigned char* lds, int vcu, int G, bool dummy) {
    bf16* xq = WSP(bf16, WS_XQ); const bf16* xkv = WSP(bf16, WS_XKV);
    for (int u = vcu; u < 512; u += G) {
        const int b = u >> 5, h = (u >> 3) & 3, qb = u & 7;
        bf16* qp = xq + ((size_t)b * SEQ + qb * 256) * 512 + h * 128;
        const bf16* kp = xkv + (size_t)b * MEML * 2048 + l * 1024 + h * 128;
        attn_unit<128, false, true>(lds, qp, 512, kp, kp + 512, 2048, 4, nullptr, 0, (bf16*)((dummy ? WSP(unsigned char, WS_Y) : WSP(unsigned char, WS_XO8)) + ((size_t)b * SEQ + qb * 256) * 512 + h * 128), 512, nullptr, nullptr);
    }
}
constexpr size_t WS_GB = WS_END;
constexpr size_t WS_GDEC = WS_GB + 32 * MiB;
constexpr size_t WS_END2 = WS_GDEC + 1 * MiB;
static_assert(WS_END2 <= 512 * MiB, "workspace map 2");
constexpr int GL_B = 0;
constexpr int GL_TOT = 16384;
constexpr int GL_Q1 = 18432, GL_Q2 = GL_Q1 + 64 * 144, GL_K2 = GL_Q2 + 64 * 144;
constexpr int GL_KD = GL_K2 + 64 * 144;
constexpr int GL_V = GL_KD + 64 * 192;
constexpr int GL_SSQ = GL_V + 64 * 320;
constexpr int GL_GA = GL_SSQ + 1024;
constexpr int GL_END = GL_GA + 4096;
static_assert(GL_END <= 131072, "gla lds");

__device__ __forceinline__ float fast_log_sigmoid(float z) { return fminf(z, 0.f) - __logf(1.f + __expf(-fabsf(z))); }
__device__ __forceinline__ void gla_decay(const P& p, int l, int h, size_t tok0, LAS unsigned char* lds, int lane, int wave) {
    const float* sm = WSP(float, WS_SM);
    float w[16];
#pragma unroll
    for (int r = 0; r < 16; ++r) w[r] = p.w_alpha_up[((size_t)l * 16 + r) * 256 + h * 64 + lane];
    const float bias = p.b_alpha[l * 256 + h * 64 + lane];
    LAS f32x4* gat = (LAS f32x4*)(lds + GL_GA + wave * 512);
    if (lane < 32) gat[lane] = *(const f32x4*)(sm + (tok0 + wave * 8 + (lane >> 2)) * 32 + 8 + 4 * (lane & 3));
    float bl[8]; float run = 0.f;
#pragma unroll
    for (int j = 0; j < 8; ++j) {
        float z = bias;
#pragma unroll
        for (int r4 = 0; r4 < 4; ++r4) { const f32x4 g4 = gat[j * 4 + r4]; z += g4.x * w[4 * r4] + g4.y * w[4 * r4 + 1] + g4.z * w[4 * r4 + 2] + g4.w * w[4 * r4 + 3]; }
        run += fast_log_sigmoid(z) * (1.0f / 16.0f); bl[j] = run;
    }
    LAS float* tot = (LAS float*)(lds + GL_TOT);
    tot[wave * 64 + lane] = run;
    __syncthreads();
    float pre = 0.f;
#pragma unroll
    for (int g = 0; g < 8; ++g) { const float t = tot[g * 64 + lane]; if (g < wave) pre += t; }
    LAS float* Bm = (LAS float*)(lds + GL_B);
#pragma unroll
    for (int j = 0; j < 8; ++j) Bm[(wave * 8 + j) * 64 + lane] = bl[j] + pre;
    __syncthreads();
}
__device__ __forceinline__ void gla_load_v(const bf16* proj, size_t tok0, int h, LAS unsigned char* lds, int tid) {
#pragma unroll
    for (int i = 0; i < 2; ++i) { const int idx = tid + NTHR * i, t = idx >> 4, c = idx & 15;
        *(LAS v4u*)(lds + GL_V + t * 320 + c * 16) = *(const v4u*)(proj + (tok0 + t) * PW + C_GV + h * 128 + c * 8); }
}
__device__ __forceinline__ bf16x8 tr_frag(const LAS unsigned char* a0, int rowstride4) {
    const v4i16_t lo = __builtin_amdgcn_ds_read_tr16_b64_v4i16((LAS v4i16_t*)a0);
    const v4i16_t hi = __builtin_amdgcn_ds_read_tr16_b64_v4i16((LAS v4i16_t*)(a0 + rowstride4));
    return (bf16x8){lo[0], lo[1], lo[2], lo[3], hi[0], hi[1], hi[2], hi[3]};
}
__device__ __forceinline__ void gla_phase_a(const P& p, int l, LAS unsigned char* lds, int vcu, int G) {
    int tid = threadIdx.x; asm volatile("" : "+v"(tid));
    const int lane = tid & 63, wave = __builtin_amdgcn_readfirstlane(tid >> 6), hh = lane >> 5;
    const bf16* proj = WSP(bf16, WS_PROJ); float* loc = ((float*)p.out); float* dec = WSP(float, WS_GDEC); const float* sm = WSP(float, WS_SM); float* gb = WSP(float, WS_GB);
    LAS unsigned char* kd = lds + wave * 16384; LAS unsigned char* vh = kd + 8192;
    const int crow8 = lane >> 3, cch = lane & 7;
    const int trow = (lane & 15) >> 2, tcol = 16 * ((lane >> 4) & 1) + 4 * (lane & 3);
    for (int u = vcu * NWAVES + wave; u < 2048; u += G * NWAVES) {
        const int c = u & 31, h = (u >> 5) & 3, b = u >> 7;
        const size_t tok0 = (size_t)b * SEQ + c * 64;
        v4u kreg[8], v0reg[8], v1reg[8];
#pragma unroll
        for (int i = 0; i < 8; ++i) { const bf16* rp = proj + (tok0 + i * 8 + crow8) * PW;
            kreg[i] = *(const v4u*)(rp + C_GK + h * 64 + cch * 8); v0reg[i] = *(const v4u*)(rp + C_GV + h * 128 + cch * 8); v1reg[i] = *(const v4u*)(rp + C_GV + h * 128 + 64 + cch * 8); }
        float w[16];
#pragma unroll
        for (int r = 0; r < 16; ++r) w[r] = p.w_alpha_up[((size_t)l * 16 + r) * 256 + h * 64 + lane];
        const float bias = p.b_alpha[l * 256 + h * 64 + lane];
        { LAS f32x4* gw = (LAS f32x4*)vh;
#pragma unroll
          for (int i = 0; i < 4; ++i) gw[lane * 4 + i] = *(const f32x4*)(sm + (tok0 + lane) * 32 + 8 + 4 * i); }
        float bt[64]; float run = 0.f;
#pragma unroll
        for (int t = 0; t < 64; ++t) {
            float z = bias;
#pragma unroll
            for (int r4 = 0; r4 < 4; ++r4) { const f32x4 g4 = ((const LAS f32x4*)vh)[t * 4 + r4]; z += g4.x * w[4 * r4] + g4.y * w[4 * r4 + 1] + g4.z * w[4 * r4 + 2] + g4.w * w[4 * r4 + 3]; }
            run += fast_log_sigmoid(z) * (1.0f / 16.0f); bt[t] = run; gb[(tok0 + t) * 256 + h * 64 + lane] = run;
        }
#pragma unroll
        for (int i = 0; i < 8; ++i) { *(LAS v4u*)(kd + (i * 8 + crow8) * 128 + cch * 16) = kreg[i]; *(LAS v4u*)(vh + (i * 8 + crow8) * 128 + cch * 16) = v0reg[i]; }
#pragma unroll
        for (int t = 0; t < 64; ++t) { LAS bf16* kp = (LAS bf16*)(kd + t * 128 + lane * 2); *kp = (bf16)f2bf(bf2f(*kp) * __expf(run - bt[t])); }
        dec[(size_t)u * 64 + lane] = __expf(run);
#pragma unroll
        for (int half = 0; half < 2; ++half) {
            if (half == 1) {
#pragma unroll
                for (int i = 0; i < 8; ++i) *(LAS v4u*)(vh + (i * 8 + crow8) * 128 + cch * 16) = v1reg[i];
            }
            f32x16 acc[2][2];
#pragma unroll
            for (int x = 0; x < 2; ++x)
#pragma unroll
                for (int y = 0; y < 2; ++y) acc[x][y] = f32x16{};
#pragma unroll
            for (int s = 0; s < 4; ++s) {
                bf16x8 af[2], bfr[2];
#pragma unroll
                for (int x = 0; x < 2; ++x) { af[x] = tr_frag(vh + (16 * s + 8 * hh + trow) * 128 + (32 * x + tcol) * 2, 4 * 128); bfr[x] = tr_frag(kd + (16 * s + 8 * hh + trow) * 128 + (32 * x + tcol) * 2, 4 * 128); }
#pragma unroll
                for (int x = 0; x < 2; ++x)
#pragma unroll
                    for (int y = 0; y < 2; ++y) acc[x][y] = __builtin_amdgcn_mfma_f32_32x32x16_bf16(af[x], bfr[y], acc[x][y], 0, 0, 0);
            }
#pragma unroll
            for (int x = 0; x < 2; ++x)
#pragma unroll
                for (int y = 0; y < 2; ++y) { float* lo = loc + (size_t)u * 8192 + 32 * y + (lane & 31);
#pragma unroll
                    for (int r = 0; r < 16; ++r) lo[(size_t)(64 * half + 32 * x + (r & 3) + 8 * (r >> 2) + 4 * hh) * 64] = acc[x][y][r]; }
        }
    }
}
__device__ __forceinline__ void gla_phase_b(const P& p, int vcu, int G) {
    int tid = threadIdx.x; asm volatile("" : "+v"(tid));
    float* loc = ((float*)p.out); const float* dec = WSP(float, WS_GDEC);
    for (int u = vcu; u < 256; u += G) {
        const int bh = u >> 2, q4 = u & 3;
        const int e = q4 * 2048 + tid * 4, dk = e & 63;
        f32x4 st = {0.f, 0.f, 0.f, 0.f};
#pragma unroll 2
        for (int c = 0; c < 32; ++c) {
            const size_t cu = (size_t)bh * 32 + c;
            const f32x4 lv = *(const f32x4*)(loc + cu * 8192 + e);
            const f32x4 dv = *(const f32x4*)(dec + cu * 64 + dk);
            asm volatile("s_waitcnt vmcnt(0)" ::: "memory");
            __syncthreads();
            v2u w; w.x = pk2(st.x, st.y); w.y = pk2(st.z, st.w);
            *(v2u*)((unsigned char*)loc + cu * 32768 + 8192 * q4 + 8 * tid) = w;
            st = dv * st + lv;
        }
    }
}
__device__ __forceinline__ void gla_phase_c(const P& p, int l, LAS unsigned char* lds, int vcu, int G) {
    int tid = threadIdx.x; asm volatile("" : "+v"(tid));
    const int lane = tid & 63, wave = __builtin_amdgcn_readfirstlane(tid >> 6), hh = lane >> 5, r32 = lane & 31;
    const bf16* proj = WSP(bf16, WS_PROJ); const unsigned char* gs = ((const unsigned char*)p.out); bf16* y = WSP(bf16, WS_Y); const float* gb = WSP(const float, WS_GB);
    const int dvb = wave >> 1, tb = wave & 1;
    const int trow = (lane & 15) >> 2, tcol = 16 * ((lane >> 4) & 1) + 4 * (lane & 3);
    bf16 n_q[8], n_k[8]; v4u n_v[2]; bf16x8 n_s[4]; v2u n_g[4]; f32x4 n_n[4]; float n_b[8], n_r = 0.f;
#define GC_LOAD(uu) do { const int c_ = (uu) & 31, h_ = ((uu) >> 5) & 3, b_ = (uu) >> 7; const size_t t0_ = (size_t)b_ * SEQ + c_ * 64; \
        _Pragma("unroll") for (int j = 0; j < 8; ++j) { const bf16* rp = proj + (t0_ + wave * 8 + j) * PW + h_ * 64 + lane; n_q[j] = rp[C_GQ]; n_k[j] = rp[C_GK]; } \
        _Pragma("unroll") for (int i = 0; i < 2; ++i) { const int idx = tid + NTHR * i, t = idx >> 4, cc = idx & 15; n_v[i] = *(const v4u*)(proj + (t0_ + t) * PW + C_GV + h_ * 128 + cc * 8); } \
        { const bf16* sp = (const bf16*)(gs + (size_t)(uu) * 32768 + 8192 * dvb) + r32 * 64 + 8 * hh; \
          _Pragma("unroll") for (int s2 = 0; s2 < 4; ++s2) n_s[s2] = *(const bf16x8*)(sp + 16 * s2); } \
        _Pragma("unroll") for (int j = 0; j < 8; ++j) n_b[j] = gb[(t0_ + wave * 8 + j) * 256 + h_ * 64 + lane]; \
        n_r = gb[(t0_ + 31) * 256 + h_ * 64 + lane]; \
        _Pragma("unroll") for (int g = 0; g < 4; ++g) { const int dv = 32 * dvb + 8 * g + 4 * hh; \
            n_n[g] = *(const f32x4*)(p.gla_gain + l * 512 + h_ * 128 + dv); n_g[g] = *(const v2u*)(proj + (t0_ + 32 * tb + r32) * PW + C_GG + h_ * 128 + dv); } } while (0)
    if (vcu < 2048) GC_LOAD(vcu);
    for (int u = vcu; u < 2048; u += G) {
        const int c = u & 31, h = (u >> 5) & 3, b = u >> 7;
        const size_t tok0 = (size_t)b * SEQ + c * 64;
        bf16x8 sfr[4]; v2u ggr[4]; f32x4 gnr[4];
#pragma unroll
        for (int i = 0; i < 4; ++i) { sfr[i] = n_s[i]; ggr[i] = n_g[i]; gnr[i] = n_n[i]; }
#pragma unroll
        for (int i = 0; i < 2; ++i) { const int idx = tid + NTHR * i, t = idx >> 4, cc = idx & 15; *(LAS v4u*)(lds + GL_V + t * 320 + cc * 16) = n_v[i]; }
        { const float rref = n_r;
#pragma unroll
          for (int j = 0; j < 8; ++j) { const int t = wave * 8 + j; const float bt = n_b[j];
            const float qv = bf2f(n_q[j]), kv = bf2f(n_k[j]);
            *(LAS bf16*)(lds + GL_Q1 + t * 144 + lane * 2) = (bf16)f2bf(qv * __expf(bt));
            *(LAS bf16*)(lds + GL_Q2 + t * 144 + lane * 2) = (bf16)f2bf(qv * __expf(bt - rref));
            *(LAS bf16*)(lds + GL_K2 + t * 144 + lane * 2) = (bf16)f2bf(kv * __expf(rref - bt)); } }
        __syncthreads();
        if (u + G < 2048) GC_LOAD(u + G);
        f32x16 o = {};
        {
#pragma unroll
          for (int s = 0; s < 4; ++s) { const bf16x8 af = sfr[s]; const bf16x8 bq = *(const LAS bf16x8*)(lds + GL_Q1 + (32 * tb + r32) * 144 + (16 * s + 8 * hh) * 2);
              o = __builtin_amdgcn_mfma_f32_32x32x16_bf16(af, bq, o, 0, 0, 0); } }
#pragma unroll
        for (int sb = 0; sb < 2; ++sb) {
            if (sb <= tb) {
                f32x16 pt = {};
#pragma unroll
                for (int s = 0; s < 4; ++s) { const bf16x8 ak = *(const LAS bf16x8*)(lds + GL_K2 + (32 * sb + r32) * 144 + (16 * s + 8 * hh) * 2); const bf16x8 bq = *(const LAS bf16x8*)(lds + GL_Q2 + (32 * tb + r32) * 144 + (16 * s + 8 * hh) * 2);
                    pt = __builtin_amdgcn_mfma_f32_32x32x16_bf16(ak, bq, pt, 0, 0, 0); }
                if (sb == tb) {
#pragma unroll
                    for (int r = 0; r < 16; ++r) { const int s_ = (r & 3) + 8 * (r >> 2) + 4 * hh; if (s_ > r32) pt[r] = 0.f; }
                }
#pragma unroll
                for (int ks = 0; ks < 2; ++ks) {
                    const bf16x8 pa = pack8(pt, 8 * ks);
                    const bf16x8 vf = tr_frag(lds + GL_V + (32 * sb + 16 * ks + 4 * hh + trow) * 320 + (32 * dvb + tcol) * 2, 8 * 320);
                    o = __builtin_amdgcn_mfma_f32_32x32x16_bf16(vf, pa, o, 0, 0, 0);
                }
            }
        }
        float ss = 0.f;
#pragma unroll
        for (int r = 0; r < 16; ++r) ss += o[r] * o[r];
        ss += __shfl_xor(ss, 32);
        LAS float* sq = (LAS float*)(lds + GL_SSQ);
        if (hh == 0) sq[dvb * 64 + 32 * tb + r32] = ss;
        __syncthreads();
        const int t = 32 * tb + r32;
        const float tot = (sq[t] + sq[64 + t]) + (sq[128 + t] + sq[192 + t]);
        const float rs = rsqrtf(tot * (1.0f / 128.0f) + EPS);
        const size_t tok = tok0 + t;
#pragma unroll
        for (int g = 0; g < 4; ++g) {
            const int dv = 32 * dvb + 8 * g + 4 * hh;
            const f32x4 gn = gnr[g];
            const v2u gg = ggr[g];
            const float g0 = bf2f((bf16)(gg.x & 0xffff)), g1 = bf2f((bf16)(gg.x >> 16)), g2 = bf2f((bf16)(gg.y & 0xffff)), g3 = bf2f((bf16)(gg.y >> 16));
            const float v0 = o[4 * g] * rs * gn.x * g0 * __builtin_amdgcn_rcpf(1.f + __expf(-g0)), v1 = o[4 * g + 1] * rs * gn.y * g1 * __builtin_amdgcn_rcpf(1.f + __expf(-g1));
            const float v2 = o[4 * g + 2] * rs * gn.z * g2 * __builtin_amdgcn_rcpf(1.f + __expf(-g2)), v3 = o[4 * g + 3] * rs * gn.w * g3 * __builtin_amdgcn_rcpf(1.f + __expf(-g3));
            v2u w; w.x = cvtpk(v0, v1); w.y = cvtpk(v2, v3);
            st_b64(y + tok * DM + 512 + h * 128 + dv, w);
        }
        __syncthreads();
    }
#undef GC_LOAD
}
__device__ __forceinline__ void fox_cumsum_phase(const P& p, int l, int vcu, int G) {
    int tid = threadIdx.x; asm volatile("" : "+v"(tid));
    const int lane = tid & 63, wave = __builtin_amdgcn_readfirstlane(tid >> 6);
    const float* sm = WSP(float, WS_SM); float* cb = WSP(float, WS_CB);
    for (int u = vcu * NWAVES + wave; u < NBATCH * 8; u += G * NWAVES) {
        const int b = u >> 3, h = u & 7;
        const float bias = p.b_forget[l * 8 + h];
        float v[32]; float run = 0.f;
#pragma unroll
        for (int j = 0; j < 32; ++j) { run += fast_log_sigmoid(sm[((size_t)b * SEQ + lane * 32 + j) * 32 + h] + bias); v[j] = run; }
        float pre = run;
#pragma unroll
        for (int o = 1; o < 64; o <<= 1) { const float t = __shfl_up(pre, o); if (lane >= o) pre += t; }
        pre -= run;
#pragma unroll
        for (int j = 0; j < 32; ++j) cb[((size_t)b * 8 + h) * SEQ + lane * 32 + j] = -(v[j] + pre) * LOG2E;
    }
}

__device__ __forceinline__ void fox_knorm_phase(const P& p, int vcu, int G) {
    int tid = threadIdx.x; asm volatile("" : "+v"(tid));
    const int lane = tid & 63, wave = __builtin_amdgcn_readfirstlane(tid >> 6);
    const bf16* proj = WSP(bf16, WS_PROJ); float* kn = WSP(float, WS_MOE + MO_KN);
    for (int task = vcu * NWAVES + wave; task < NBATCH * 8 * 32; task += G * NWAVES) {
        const int j = task & 31, h = (task >> 5) & 7, b = task >> 8;
        float mx = 0.f;
#pragma unroll
        for (int i = 0; i < 8; ++i) {
            const v4u w = *(const v4u*)(proj + ((size_t)b * SEQ + j * 64 + i * 8 + (lane >> 3)) * PW + C_FK + h * 64 + (lane & 7) * 8);
            const unsigned ww[4] = {w.x, w.y, w.z, w.w}; float ss = 0.f;
#pragma unroll
            for (int e = 0; e < 4; ++e) { const float a = __builtin_bit_cast(float, ww[e] << 16), c = __builtin_bit_cast(float, ww[e] & 0xffff0000u); ss += a * a + c * c; }
            ss += __shfl_xor(ss, 1); ss += __shfl_xor(ss, 2); ss += __shfl_xor(ss, 4);
            mx = fmaxf(mx, ss);
        }
        mx = wave_max(mx);
        if (lane == 0) kn[task] = sqrtf(mx) * 1.0001f;
    }
}
__device__ __forceinline__ void router_weights(const P& p, int gtid, int gstride) {
    for (int idx = gtid; idx < NLAYER * 32768; idx += gstride) {
        const int l = idx >> 15, r = idx & 32767, k = r >> 5, n = r & 31;
        float v = 0.f;
        if (n < 16) v = p.w_re[((size_t)l * DM + k) * 16 + n]; else if (n < 20) v = p.w_rg[((size_t)l * DM + k) * 4 + (n - 16)];
        v *= p.moe_norm[l * DM + k];
        float* wr = (float*)(ws_base(p.ws) + WS_W + (size_t)l * WS_WLAYER + WO_RHI);
        wr[(((k >> 4) * 4 + ((k >> 2) & 3)) * 32 + n) * 4 + (k & 3)] = v;
    }
}
__device__ __forceinline__ void route_phase(const P& p, int l, LAS unsigned char* lds, int vcu, int G) {
    int tid = threadIdx.x; asm volatile("" : "+v"(tid));
    const int lane = tid & 63, wave = __builtin_amdgcn_readfirstlane(tid >> 6);
    { const v4u* src = (const v4u*)(ws_base(p.ws) + WS_W + (size_t)l * WS_WLAYER + WO_RHI);
#pragma unroll 4
      for (int i = 0; i < 16; ++i) *(LAS v4u*)(lds + LDS_STAGE + (tid + NTHR * i) * 16) = src[tid + NTHR * i]; }
    LAS int* hist = (LAS int*)(lds + LDS_GATE);
    if (tid < 32) hist[tid] = 0;
    __syncthreads();
    const bf16* HBp = WSP(const bf16, WS_HB);
    int2* toke = WSP(int2, WS_MOE + MO_TOKE); float2* tokg = WSP(float2, WS_MOE + MO_TOKG);
    LAS float* lgb = (LAS float*)(lds + LDS_RS + wave * 2048);
    const int r = lane & 15, kq = lane >> 4;
    for (int task = vcu * NWAVES + wave; task < NTOK / 16; task += G * NWAVES) {
        const int tok0 = task * 16;
        const v2u* hp = (const v2u*)(HBp + (size_t)(tok0 + r) * DM + 4 * kq);
        f32x4 acc0 = {0.f, 0.f, 0.f, 0.f}, acc1 = {0.f, 0.f, 0.f, 0.f}; float q = 0.f;
#pragma unroll 8
        for (int s = 0; s < 64; ++s) {
            const v2u aw = hp[4 * s]; f32x4 a; a.x = __builtin_bit_cast(float, aw.x << 16); a.y = __builtin_bit_cast(float, aw.x & 0xffff0000u); a.z = __builtin_bit_cast(float, aw.y << 16); a.w = __builtin_bit_cast(float, aw.y & 0xffff0000u);
            const f32x4 b0 = *(const LAS f32x4*)(lds + LDS_STAGE + ((s * 4 + kq) * 32 + r) * 16);
            const f32x4 b1 = *(const LAS f32x4*)(lds + LDS_STAGE + ((s * 4 + kq) * 32 + 16 + r) * 16);
            q += (a.x * a.x + a.y * a.y) + (a.z * a.z + a.w * a.w);
            acc0 = __builtin_amdgcn_mfma_f32_16x16x4f32(a.x, b0.x, acc0, 0, 0, 0); acc1 = __builtin_amdgcn_mfma_f32_16x16x4f32(a.x, b1.x, acc1, 0, 0, 0);
            acc0 = __builtin_amdgcn_mfma_f32_16x16x4f32(a.y, b0.y, acc0, 0, 0, 0); acc1 = __builtin_amdgcn_mfma_f32_16x16x4f32(a.y, b1.y, acc1, 0, 0, 0);
            acc0 = __builtin_amdgcn_mfma_f32_16x16x4f32(a.z, b0.z, acc0, 0, 0, 0); acc1 = __builtin_amdgcn_mfma_f32_16x16x4f32(a.z, b1.z, acc1, 0, 0, 0);
            acc0 = __builtin_amdgcn_mfma_f32_16x16x4f32(a.w, b0.w, acc0, 0, 0, 0); acc1 = __builtin_amdgcn_mfma_f32_16x16x4f32(a.w, b1.w, acc1, 0, 0, 0);
        }
        q += __shfl_xor(q, 16); q += __shfl_xor(q, 32);
        const float rsv = rsqrtf(q * (1.0f / DM) + EPS);
        const float bias0 = p.b_re[l * 16 + r], bias1 = r < 4 ? p.b_rg[l * 4 + r] : 0.f;
#pragma unroll
        for (int g = 0; g < 4; ++g) { const int row = 4 * kq + g; const float rs = __shfl(rsv, row);
            lgb[row * 32 + r] = acc0[g] * rs + bias0; lgb[row * 32 + 16 + r] = acc1[g] * rs + bias1; }
        LDS_WAIT();
        if (lane < 16) {
            const int tok = tok0 + lane;
            const LAS f32x4* lr = (const LAS f32x4*)(lgb + lane * 32);
            const f32x4 e0 = lr[0], e1 = lr[1], e2 = lr[2], e3 = lr[3], gl = lr[4];
            int g = 0; float gm = gl.x;
            if (gl.y > gm) { gm = gl.y; g = 1; } if (gl.z > gm) { gm = gl.z; g = 2; } if (gl.w > gm) { gm = gl.w; g = 3; }
            const float den = (expf(gl.x - gm) + expf(gl.y - gm)) + (expf(gl.z - gm) + expf(gl.w - gm));
            const float pg = 1.0f / den;
            const f32x4 el = g == 0 ? e0 : (g == 1 ? e1 : (g == 2 ? e2 : e3));
            int i0 = 0; float m0 = el.x;
            if (el.y > m0) { m0 = el.y; i0 = 1; } if (el.z > m0) { m0 = el.z; i0 = 2; } if (el.w > m0) { m0 = el.w; i0 = 3; }
            int i1 = -1; float m1 = -INFINITY;
            if (i0 != 0 && el.x > m1) { m1 = el.x; i1 = 0; } if (i0 != 1 && el.y > m1) { m1 = el.y; i1 = 1; }
            if (i0 != 2 && el.z > m1) { m1 = el.z; i1 = 2; } if (i0 != 3 && el.w > m1) { m1 = el.w; i1 = 3; }
            const float ex = expf(m1 - m0), inv = 1.0f / (1.0f + ex);
            const int ea = g * 4 + i0, eb = g * 4 + i1;
            toke[tok] = make_int2(ea, eb); tokg[tok] = make_float2(pg * inv, pg * ex * inv);
            atomicAdd((int*)&hist[ea], 1); atomicAdd((int*)&hist[16 + eb], 1);
        }
        LDS_WAIT();
    }
    __syncthreads();
    if (tid < 32) WSP(int, WS_MOE + MO_HIST)[vcu * 32 + tid] = hist[tid];
}
__device__ __forceinline__ void sort_phase(const P& p, LAS unsigned char* lds, int vcu, int G) {
    int tid = threadIdx.x; asm volatile("" : "+v"(tid));
    const int lane = tid & 63, wave = __builtin_amdgcn_readfirstlane(tid >> 6);
    LAS int* cnt = (LAS int*)(lds + LDS_GATE); LAS int* pre = cnt + 32; LAS int* base = cnt + 64; LAS int* ntl = cnt + 96;
    const int* histg = WSP(const int, WS_MOE + MO_HIST);
    int* rowtok = WSP(int, WS_MOE + MO_ROWTOK); float* rowgate = WSP(float, WS_MOE + MO_ROWGATE); int* tilee = WSP(int, WS_MOE + MO_TILEE); int* nt = WSP(int, WS_MOE + MO_NT);
    const int2* toke = WSP(const int2, WS_MOE + MO_TOKE); const float2* tokg = WSP(const float2, WS_MOE + MO_TOKG);
    { LAS int* part = (LAS int*)(lds + LDS_RS);
      const int j = tid & 31, part_i = tid >> 5; int c = 0, pr = 0;
      for (int w = part_i; w < G; w += 16) { const int v = histg[w * 32 + j]; if (w < vcu) pr += v; c += v; }
      part[part_i * 64 + j] = c; part[part_i * 64 + 32 + j] = pr;
      __syncthreads();
      if (tid < 32) { int cc = 0, pp = 0;
#pragma unroll
          for (int q = 0; q < 16; ++q) { cc += part[q * 64 + tid]; pp += part[q * 64 + 32 + tid]; }
          cnt[tid] = cc; pre[tid] = pp; } }
    __syncthreads();
    if (tid == 0) { int t = 0; for (int j = 0; j < 32; ++j) { base[j] = t * 256; const int n = (cnt[j] + 255) >> 8; ntl[j] = n; t += n; if (j == 15 && vcu == 0) nt[0] = t; } if (vcu == 0) nt[1] = t; }
    __syncthreads();
    if (vcu == 0 && tid < 32) { const int t0 = base[tid] >> 8; for (int i = 0; i < ntl[tid]; ++i) tilee[t0 + i] = tid & 15; }
    if (vcu < 32) { const int j = vcu, lo = base[j] + cnt[j], hi = base[j] + 256 * ntl[j]; for (int r = lo + tid; r < hi; r += NTHR) { rowtok[r] = -1; rowgate[r] = 0.f; } }
    if (wave < 2) {
        const int k = wave;
        int run[16];
#pragma unroll
        for (int e = 0; e < 16; ++e) run[e] = 0;
        for (int task0 = vcu * NWAVES; task0 < NTOK / 16; task0 += G * NWAVES) {
#pragma unroll 1
            for (int half = 0; half < 2; ++half) {
                const int tok = task0 * 16 + half * 64 + lane;
                const int2 ee = toke[tok]; const float2 gg = tokg[tok];
                const int e = k ? ee.y : ee.x; const float gt = k ? gg.y : gg.x;
                int rank = 0;
#pragma unroll
                for (int x = 0; x < 16; ++x) { const unsigned long long m = __ballot(e == x); if (e == x) rank = run[x] + __popcll(m & ((1ull << lane) - 1ull)); run[x] += __popcll(m); }
                const int pos = base[k * 16 + e] + pre[k * 16 + e] + rank;
                rowtok[pos] = tok; rowgate[pos] = gt;
            }
        }
    }
}
__device__ __forceinline__ void final_phase(const P& p, int vcu, int G) {
    int tid = threadIdx.x; asm volatile("" : "+v"(tid));
    const int lane = tid & 63, wave = __builtin_amdgcn_readfirstlane(tid >> 6);
    const float* ssq = WSP(const float, WS_SSQ); const bf16* hb = WSP(const bf16, WS_HB);
    for (int m = vcu * NWAVES + wave; m < NTOK; m += G * NWAVES) {
        f32x4* s = (f32x4*)(p.out + (size_t)m * DM) + lane; const v2u* h = (const v2u*)(hb + (size_t)m * DM) + lane;
        const float rs = row_rs(ssq, m);
#pragma unroll
        for (int j = 0; j < 4; ++j) { const f32x4 g = ((const f32x4*)p.final_norm)[lane + 64 * j]; const v2u w = h[64 * j];
            f32x4 v; v.x = __builtin_bit_cast(float, w.x << 16); v.y = __builtin_bit_cast(float, w.x & 0xffff0000u); v.z = __builtin_bit_cast(float, w.y << 16); v.w = __builtin_bit_cast(float, w.y & 0xffff0000u);
            s[64 * j] = v * rs * g; }
    }
}
#ifndef ENMASK
#define ENMASK 0xffffffffu
#endif
#define EN(b) (((ENMASK) >> (b)) & 1u)
#ifndef REPMASK
#define REPMASK 0u
#endif
#define REPN(b) ((((REPMASK) >> (b)) & 1u) ? 2 : 1)
__device__ __attribute__((noinline)) void grid_barrier(unsigned* barw, unsigned x, volatile LAS unsigned* st) { XcdBarrier b; b.bar = barw; b.x = x; b.st = st; xcd_barrier(b); }
__global__ void __launch_bounds__(NTHR, 2) fwd(Args args) {
    extern __shared__ __attribute__((aligned(16))) unsigned char lds_raw[];
    LAS unsigned char* lds = (LAS unsigned char*)lds_raw;
    const P& p = args.p;
    const int tid = threadIdx.x, lane = tid & 63, wave = __builtin_amdgcn_readfirstlane(tid >> 6);
    const int G = gridDim.x; const int bx = blockIdx.x; const int vcu = (G % 8 == 0) ? (bx % 8) * (G / 8) + bx / 8 : bx;
    volatile LAS unsigned* MISC = (volatile LAS unsigned*)(lds + LDS_MISC);
    if (tid < 64) MISC[tid] = 0u;
    __syncthreads();
    unsigned* ctl = (unsigned*)(p.ws + WS_CTL);
    const int lo = args.ph_lo, hi = args.ph_hi;
    XcdBarrier bar; bar.bar = ctl + CW_BAR + args.li * XCD_BAR_WORDS; bar.x = 0; bar.st = nullptr;
    if (hi - lo > 1) bar = xcd_barrier_post(ctl + CW_BAR + args.li * XCD_BAR_WORDS, MISC);
#define IN(k) (lo <= (k) && (k) < hi)
#define PHL int vcuL = vcu, GL = G, bxL = bx; asm volatile("" : "+s"(vcuL), "+s"(GL), "+s"(bxL)); (void)vcuL; (void)GL; (void)bxL;
#define LTID(v) int v = threadIdx.x; asm volatile("" : "+v"(v))
#define SEAM(k) do { if (IN(k) && IN((k) + 1)) { grid_barrier(bar.bar, bar.x, bar.st); if (REPN(20) == 2) grid_barrier(bar.bar, bar.x, bar.st); } } while (0)
    LAS float* rstab = (LAS float*)(lds + LDS_RS); LAS int* rowtab = (LAS int*)(lds + LDS_ROWTOK); LAS float* gatetab = (LAS float*)(lds + LDS_GATE);
#define HB WSP(bf16, WS_HB)
#define PROJ WSP(bf16, WS_PROJ)
#define Y WSP(bf16, WS_Y)
#define XKV WSP(bf16, WS_XKV)
#define MEMN WSP(bf16, WS_MEMN)
#define SSQ WSP(float, WS_SSQ)
#define XQ WSP(bf16, WS_XQ)
#define U WSP(bf16, WS_U)
#define ROWTOK WSP(const int, WS_MOE + MO_ROWTOK)
#define ROWGATE WSP(const float, WS_MOE + MO_ROWGATE)
#define TILEE WSP(const int, WS_MOE + MO_TILEE)
#define NT WSP(const int, WS_MOE + MO_NT)
#define H (p.out)
#define HB8 ((unsigned char*)p.out + 64 * MiB)
#define U8 WSP(unsigned char, WS_U)

    if (EN(0) && IN(PH_PRO)) _Pragma("unroll 1") for (int rep_ = 0; rep_ < REPN(0); ++rep_) { PHL prologue(p, lds, vcuL, GL, wave, lane); }
    SEAM(PH_PRO);
    if (EN(1) && IN(PH_XKV)) _Pragma("unroll 1") for (int rep_ = 0; rep_ < REPN(1); ++rep_) { PHL
        pg8::StaticOrder S; S.init(MEMN, ws_base(p.ws) + WS_WXKV, 4096, 2048, DM, GL, bxL);
        EpiBf16<false> E{XKV, 2048, rstab};
        pg8::gemm_phase<DM, EpiBf16<false>, pg8::StaticOrder, true>(lds + LDS_STAGE, S, E);
    }
    if (REPN(18) == 2 && IN(PH_XKV)) { PHL
        pg8::StaticOrder S; S.init(HB, ws_base(p.ws) + WS_W + WO_IN, NTOK, 3072, DM, GL, bxL);
        { pg8::Unit u; for (int iu = 0; S.next(iu, u); ++iu) { LTID(tq); if (tq < 256) rstab[iu * 256 + tq] = row_rs(SSQ, u.pm * 256 + tq); } }
        __syncthreads();
        EpiBf16<true> E{PROJ, PW, rstab};
        pg8::gemm_phase<DM, EpiBf16<true>, pg8::StaticOrder, true>(lds + LDS_STAGE, S, E);
    }
    SEAM(PH_XKV);
    for (int l = 0; l < NLAYER; ++l) {
        const int pb = PH_L0 + l * NPH;
        unsigned char* wl = ws_base(p.ws) + WS_W + (size_t)l * WS_WLAYER;
        if (EN(2) && IN(pb + LP_INPROJ)) _Pragma("unroll 1") for (int rep_ = 0; rep_ < REPN(2); ++rep_) { PHL
            pg8::StaticOrder S; S.init(HB, wl + WO_IN, NTOK, 3072, DM, GL, bxL);
            { pg8::Unit u; for (int iu = 0; S.next(iu, u); ++iu) { LTID(tq); if (tq < 256) rstab[iu * 256 + tq] = row_rs(SSQ, u.pm * 256 + tq); } }
            __syncthreads();
            EpiBf16<true> E{PROJ, PW, rstab};
            pg8::gemm_phase<DM, EpiBf16<true>, pg8::StaticOrder, true>(lds + LDS_STAGE, S, E);
            _Pragma("unroll 1") for (int r2_ = 0; r2_ < REPN(19); ++r2_) small_proj(p, l, lds + LDS_STAGE, vcuL, GL, wave, lane);
        }
        SEAM(pb + LP_INPROJ);
        if (EN(11) && IN(pb + LP_MIXA)) _Pragma("unroll 1") for (int rep_ = 0; rep_ < REPN(11); ++rep_) { PHL gla_phase_a(p, l, lds + LDS_STAGE, vcuL, GL); fox_cumsum_phase(p, l, vcuL, GL); fox_knorm_phase(p, vcuL, GL); }
        SEAM(pb + LP_MIXA);
        if (EN(12) && IN(pb + LP_MIXB)) _Pragma("unroll 1") for (int rep_ = 0; rep_ < REPN(12); ++rep_) { PHL gla_phase_b(p, vcuL, GL); }
        SEAM(pb + LP_MIXB);
        if (EN(9) && IN(pb + LP_MIXC)) { PHL _Pragma("unroll 1") for (int rep_ = 0; rep_ < REPN(16); ++rep_) fox_phase(p, l, lds + LDS_STAGE, vcuL, GL); _Pragma("unroll 1") for (int rep_ = 0; rep_ < REPN(17); ++rep_) gla_phase_c(p, l, lds + LDS_STAGE, vcuL, GL); }
        SEAM(pb + LP_MIXC);
        if (EN(3) && IN(pb + LP_WOUT)) _Pragma("unroll 1") for (int rep_ = 0; rep_ < REPN(3); ++rep_) { PHL
            pg8::StaticOrder S; S.init(Y, wl + WO_OUT, NTOK, DM, DM, GL, bxL);
            EpiRes<0> E{HB, SSQ, rowtab, gatetab, rep_ == REPN(3) - 1 ? 1.f : 0.f, Y, nullptr};
            pg8::gemm_phase<DM, EpiRes<0>, pg8::StaticOrder, true>(lds + LDS_STAGE, S, E);
        }
        SEAM(pb + LP_WOUT);
        if (EN(4) && IN(pb + LP_XQ)) _Pragma("unroll 1") for (int rep_ = 0; rep_ < REPN(4); ++rep_) { PHL
            pg8::StaticOrder S; S.init(HB, wl + WO_XQ, NTOK, 512, DM, GL, bxL);
            { pg8::Unit u; for (int iu = 0; S.next(iu, u); ++iu) { LTID(tq); if (tq < 256) rstab[iu * 256 + tq] = row_rs(SSQ, u.pm * 256 + tq); } }
            __syncthreads();
            EpiBf16<true> E{XQ, 512, rstab};
            pg8::gemm_phase<DM, EpiBf16<true>, pg8::StaticOrder, true>(lds + LDS_STAGE, S, E);
        }
        SEAM(pb + LP_XQ);
        if (EN(10) && IN(pb + LP_XATTN)) _Pragma("unroll 1") for (int rep_ = 0; rep_ < REPN(10); ++rep_) { PHL xattn_phase(p, l, lds + LDS_STAGE, vcuL, GL, rep_ != REPN(10) - 1); }
        SEAM(pb + LP_XATTN);
        if (EN(5) && IN(pb + LP_XO)) _Pragma("unroll 1") for (int rep_ = 0; rep_ < REPN(5); ++rep_) { PHL
            pg8::StaticOrder S; S.init(WSP(unsigned char, WS_XO8), wl + WO_XO, NTOK, DM, 256, GL, bxL);
            EpiRes<0, true> E{HB, SSQ, rowtab, gatetab, rep_ == REPN(5) - 1 ? 1.f : 0.f, Y, HB8};
            pg8::gemm_phase<256, EpiRes<0, true>, pg8::StaticOrder, true, true, 127, 122>(lds + LDS_STAGE, S, E);
        }
        SEAM(pb + LP_XO);
        if (EN(13) && IN(pb + LP_ROUTE)) _Pragma("unroll 1") for (int rep_ = 0; rep_ < REPN(13); ++rep_) { PHL route_phase(p, l, lds, vcuL, GL); }
        SEAM(pb + LP_ROUTE);
        if (EN(14) && IN(pb + LP_SORT)) _Pragma("unroll 1") for (int rep_ = 0; rep_ < REPN(14); ++rep_) { PHL sort_phase(p, lds, vcuL, GL); }
        SEAM(pb + LP_SORT);
        if (EN(6) && IN(pb + LP_GU)) _Pragma("unroll 1") for (int rep_ = 0; rep_ < REPN(6); ++rep_) { PHL
            MoeOrder<true> S{(const char*)HB8, (const char*)(wl + WO_GU), 512, (size_t)1024 * 1024, 0, NT[1], GL, vcuL, TILEE, rowtab};
            { pg8::Unit u; for (int iu = 0; S.next(iu, u); ++iu) { LTID(tq); if (tq < 256) { int t = ROWTOK[u.pm * 256 + tq]; t = t < 0 ? 0 : t; rowtab[iu * 256 + tq] = t; rstab[iu * 256 + tq] = row_rs(SSQ, t); } } }
            __syncthreads();
            EpiGU E{U8, rstab};
            pg8::gemm_phase<512, EpiGU, MoeOrder<true>, true, true, 127, 122>(lds + LDS_STAGE, S, E);
        }
        SEAM(pb + LP_GU);
        if (EN(7) && IN(pb + LP_DOWN0)) _Pragma("unroll 1") for (int rep_ = 0; rep_ < REPN(7); ++rep_) { PHL
            MoeOrder<false> S{(const char*)U8, (const char*)(wl + WO_D), 256, (size_t)1024 * 512, 0, NT[0], GL, vcuL, TILEE, rowtab};
            __syncthreads();
            { pg8::Unit u; for (int iu = 0; S.next(iu, u); ++iu) { LTID(tq); if (tq < 256) { rowtab[iu * 256 + tq] = ROWTOK[u.pm * 256 + tq]; gatetab[iu * 256 + tq] = ROWGATE[u.pm * 256 + tq]; } } }
            __syncthreads();
            EpiRes<1> E{HB, SSQ, rowtab, gatetab, 1.f, Y, nullptr};
            pg8::gemm_phase<256, EpiRes<1>, MoeOrder<false>, true, true, 125, 122>(lds + LDS_STAGE, S, E);
        }
        SEAM(pb + LP_DOWN0);
        if (EN(8) && IN(pb + LP_DOWN1)) _Pragma("unroll 1") for (int rep_ = 0; rep_ < REPN(8); ++rep_) { PHL
            MoeOrder<false> S{(const char*)U8, (const char*)(wl + WO_D), 256, (size_t)1024 * 512, NT[0], NT[1], GL, vcuL, TILEE, rowtab};
            __syncthreads();
            { pg8::Unit u; for (int iu = 0; S.next(iu, u); ++iu) { LTID(tq); if (tq < 256) { rowtab[iu * 256 + tq] = ROWTOK[u.pm * 256 + tq]; gatetab[iu * 256 + tq] = ROWGATE[u.pm * 256 + tq]; } } }
            __syncthreads();
            EpiRes<2> E{HB, SSQ, rowtab, gatetab, 1.f, Y, nullptr};
            pg8::gemm_phase<256, EpiRes<2>, MoeOrder<false>, true, true, 125, 122>(lds + LDS_STAGE, S, E);
        }
        SEAM(pb + LP_DOWN1);
    }
    if (EN(15) && IN(PH_FINAL)) _Pragma("unroll 1") for (int rep_ = 0; rep_ < REPN(15); ++rep_) { PHL final_phase(p, vcuL, GL); }
#undef IN
#undef SEAM
#undef HB
#undef PROJ
#undef Y
#undef XKV
#undef MEMN
#undef SSQ
#undef XQ
#undef U
#undef ROWTOK
#undef ROWGATE
#undef TILEE
#undef NT
#undef H
#undef HB8
#undef U8
}

static int g_grid = 0;
static void launch_fast(const P& p, int lo, int hi, int& li, hipStream_t stream) {
    Args a{}; a.p = p; a.ph_lo = lo; a.ph_hi = hi; a.li = li++; a.pad = 0;
    hipLaunchKernelGGL(fwd, dim3(g_grid), dim3(NTHR), LDS_BYTES, stream, a);
    const hipError_t le = hipPeekAtLastError();
    if (le != hipSuccess) fprintf(stderr, "kernel_launch: fwd launch [%d,%d) failed: %s\n", lo, hi, hipGetErrorName(le));
}
extern "C" void kernel_launch(void* const* d_in, const int* in_sizes, int n_in, void* d_out, int out_size, void* d_ws, size_t ws_size, hipStream_t stream) {
    if (n_in != 25 || out_size != NTOK * DM || ws_size < WS_END2) { fprintf(stderr, "kernel_launch: unexpected sizes n_in %d out %d ws %zu (need %zu)\n", n_in, out_size, ws_size, (size_t)WS_END2); return; }
    if (g_grid == 0) {
        int dev = 0, cus = 0, per_cu = 0;
        if (hipGetDevice(&dev) != hipSuccess || hipDeviceGetAttribute(&cus, hipDeviceAttributeMultiprocessorCount, dev) != hipSuccess) { g_grid = -1; return; }
        if (hipFuncSetAttribute((const void*)fwd, hipFuncAttributeMaxDynamicSharedMemorySize, LDS_BYTES) != hipSuccess) { fprintf(stderr, "kernel_launch: hipFuncSetAttribute failed\n"); g_grid = -1; return; }
        if (hipOccupancyMaxActiveBlocksPerMultiprocessor(&per_cu, (const void*)fwd, NTHR, LDS_BYTES) != hipSuccess || per_cu < 1) { fprintf(stderr, "kernel_launch: occupancy query says %d\n", per_cu); }
        (void)hipGetLastError();
        g_grid = cus;
    }
    if (g_grid < 0) return;
    P p{};
    const float** pp = (const float**)&p;
    for (int i = 0; i < 25; ++i) pp[i] = (const float*)d_in[i];
    p.out = (float*)d_out; p.ws = (unsigned char*)d_ws;
    hipMemsetAsync((char*)d_ws + WS_CTL, 0, 1 * MiB, stream);
    bf16* HB = WSP(bf16, WS_HB); bf16* PROJ = WSP(bf16, WS_PROJ); float* SM = WSP(float, WS_SM); float* CB = WSP(float, WS_CB); bf16* Y = WSP(bf16, WS_Y);
    bf16* XKV = WSP(bf16, WS_XKV); float* SSQ = WSP(float, WS_SSQ); bf16* XQ = WSP(bf16, WS_XQ);
    float* LA = WSP(float, WS_HB);
    int2* TOKE = WSP(int2, WS_MOE + MO_TOKE); float2* TOKG = WSP(float2, WS_MOE + MO_TOKG); int* ROWTOK = WSP(int, WS_MOE + MO_ROWTOK); float* ROWGATE = WSP(float, WS_MOE + MO_ROWGATE);
    int* TILEE = WSP(int, WS_MOE + MO_TILEE); int* NT = WSP(int, WS_MOE + MO_NT);
    float* H = p.out;
    (void)HB; (void)SSQ; (void)XQ;
    int li = 0;
    launch_fast(p, PH_PRO, PH_END, li, stream);
}
```

```cpp
#define REPMASK 0x0
#include <hip/hip_runtime.h>
#include <cstdio>
#include <cstdint>

constexpr int NTOK = 32768, DM = 1024, NBATCH = 16, SEQ = 2048, NLAYER = 2, MEML = 256;
constexpr int PW = 3072;
constexpr int C_FQ = 0, C_FK = 512, C_FV = 1024, C_GQ = 1536, C_GK = 1792, C_GV = 2048, C_GG = 2560;
constexpr int INW = 3096;
constexpr float EPS = 1e-6f, LOG2E = 1.4426950408889634f;
constexpr int MAXTILES = 288;
constexpr int MAXROWS = MAXTILES * 256;

typedef unsigned short bf16;
__device__ __forceinline__ unsigned f2bf(float f) { unsigned u = __builtin_bit_cast(unsigned, f); return (u + 0x7fffu + ((u >> 16) & 1u)) >> 16; }
__device__ __forceinline__ float bf2f(bf16 b) { return __builtin_bit_cast(float, ((unsigned)b) << 16); }

constexpr size_t MiB = 1u << 20;
constexpr size_t WS_CTL = 0;
constexpr size_t WS_W = 1 * MiB;
constexpr size_t WS_WLAYER = 59 * MiB;
constexpr size_t WS_WXKV = WS_W + 2 * WS_WLAYER;
constexpr size_t WS_HB = WS_WXKV + 4 * MiB;
constexpr size_t WS_PROJ = WS_HB + 64 * MiB;
constexpr size_t WS_XQ = WS_PROJ;
constexpr size_t WS_U = WS_PROJ + 32 * MiB;
constexpr size_t WS_XO8 = WS_U + 40 * MiB;
constexpr size_t WS_SM = WS_PROJ + 192 * MiB;
constexpr size_t WS_CB = WS_SM + 4 * MiB;
constexpr size_t WS_Y = WS_CB + 1 * MiB;
constexpr size_t WS_XKV = WS_Y + 64 * MiB;
constexpr size_t WS_MEMN = WS_XKV + 16 * MiB;
constexpr size_t WS_SSQ = WS_MEMN + 8 * MiB;
constexpr size_t WS_MOE = WS_SSQ + 2 * MiB;
constexpr size_t WS_END = WS_MOE + 2 * MiB;
static_assert(WS_END <= 512 * MiB, "workspace map");
constexpr size_t MO_TOKE = 0;
constexpr size_t MO_TOKG = 256 * 1024;
constexpr size_t MO_ROWTOK = 512 * 1024;
constexpr size_t MO_ROWGATE = 832 * 1024;
constexpr size_t MO_TILEE = 1152 * 1024;
constexpr size_t MO_NT = 1156 * 1024;
constexpr size_t MO_HIST = 1160 * 1024;
constexpr size_t MO_KN = 1280 * 1024;

struct P {
    const float *x, *mem, *mem_norm, *mix_norm, *w_in, *b_forget, *w_alpha_up, *b_alpha, *fox_gain, *gla_gain, *w_out, *cross_norm, *w_xq, *w_xk, *w_xv, *w_xo,
        *moe_norm, *w_rg, *b_rg, *w_re, *b_re, *w_eg, *w_eu, *w_ed, *final_norm;
    float* out; unsigned char* ws;
};
__host__ __device__ __forceinline__ unsigned char* ws_base(unsigned char* w) {
#if defined(__HIP_DEVICE_COMPILE__)
    size_t z = 0; asm volatile("" : "+s"(z));
    return w + z;
#else
    return w;
#endif
}
#define WSP(T, off) ((T*)(ws_base(p.ws) + (off)))

__device__ __forceinline__ float wave_sum(float v) {
#pragma unroll
    for (int o = 1; o < 64; o <<= 1) v += __shfl_xor(v, o);
    return v;
}
__device__ __forceinline__ float wave_min(float v) {
#pragma unroll
    for (int o = 1; o < 64; o <<= 1) v = fminf(v, __shfl_xor(v, o));
    return v;
}
__device__ __forceinline__ float wave_max(float v) {
#pragma unroll
    for (int o = 1; o < 64; o <<= 1) v = fmaxf(v, __shfl_xor(v, o));
    return v;
}
__device__ __forceinline__ float row_rs(const float* ssq, int row) {
    const float4* s = (const float4*)(ssq + (size_t)row * 16);
    float4 a = s[0], b = s[1], c = s[2], d = s[3];
    float t = ((a.x + a.y) + (a.z + a.w)) + ((b.x + b.y) + (b.z + b.w)) + ((c.x + c.y) + (c.z + c.w)) + ((d.x + d.y) + (d.z + d.w));
    return rsqrtf(t * (1.0f / DM) + EPS);
}
__device__ __forceinline__ float log_sigmoid(float z) { return fminf(z, 0.f) - log1pf(expf(-fabsf(z))); }
__device__ __forceinline__ float silu(float z) { return z / (1.f + expf(-z)); }

typedef unsigned st_v4u __attribute__((ext_vector_type(4)));
typedef unsigned st_v2u __attribute__((ext_vector_type(2)));
#ifndef WT_STORES
#define WT_STORES 0
#endif
__device__ __forceinline__ void st_b128(void* p, st_v4u v) {
#if WT_STORES
    asm volatile("global_store_dwordx4 %0, %1, off sc1\n\ts_nop 1" :: "v"(p), "v"(v) : "memory");
#else
    *(st_v4u*)p = v;
#endif
}
__device__ __forceinline__ void st_b128_wt(void* p, st_v4u v) { asm volatile("global_store_dwordx4 %0, %1, off sc1\n\ts_nop 1" :: "v"(p), "v"(v) : "memory"); }
__device__ __forceinline__ void st_b64(void* p, st_v2u v) {
#if WT_STORES
    asm volatile("global_store_dwordx2 %0, %1, off sc1" :: "v"(p), "v"(v) : "memory");
#else
    *(st_v2u*)p = v;
#endif
}
#define XB_TMO      128
#define XB_XCNT(j)  (256  + 64 * (j))
#define XB_XSUB(j)  (1280 + 64 * (j))
#define XB_XGEN(j)  (2304 + 64 * (j))
#define XB_TOP      3328
#define XB_TOPGEN   3392
#define XCD_BAR_WORDS 3456
#define XB_SPIN_CAP (1u << 18)
#define LAS __attribute__((address_space(3)))

__device__ __forceinline__ unsigned xb_ld(unsigned* p)              { return __hip_atomic_load(p, __ATOMIC_RELAXED, __HIP_MEMORY_SCOPE_AGENT); }
__device__ __forceinline__ unsigned xb_add(unsigned* p, unsigned v) { return __hip_atomic_fetch_add(p, v, __ATOMIC_RELAXED, __HIP_MEMORY_SCOPE_AGENT); }
__device__ __forceinline__ unsigned xb_xcc_id() { return (unsigned)__builtin_amdgcn_s_getreg((3 << 11) | 20) & 0xFu; }
#define XB_SPIN(cond, bar) do { unsigned _sp = 0; while (cond) { __builtin_amdgcn_s_sleep(1); \
    if ((++_sp & 255u) == 0u) { if (xb_ld(&(bar)[XB_TMO])) break; if (_sp > XB_SPIN_CAP) { atomicAdd(&(bar)[XB_TMO], 1u); break; } } } } while (0)

struct XcdBarrier {
    unsigned* bar; unsigned x;
    volatile LAS unsigned* st;
};

__device__ __forceinline__ XcdBarrier xcd_barrier_post(unsigned* bar, volatile LAS unsigned* st) {
    XcdBarrier b; b.bar = bar; b.x = xb_xcc_id(); b.st = st;
    if (threadIdx.x == 0) (void)xb_add(&bar[XB_XCNT(b.x)], 1u);
    return b;
}
__device__ __forceinline__ void xcd_barrier_complete(unsigned* bar, unsigned x, unsigned& nloc, unsigned& nx) {
    const unsigned G = gridDim.x * gridDim.y * gridDim.z;
    unsigned sum, cnt, mine, sp = 0u;
    for (;;) {
        sum = 0u; cnt = 0u; mine = 0u;
#pragma unroll
        for (unsigned j = 0; j < 16; ++j) { const unsigned c = xb_ld(&bar[XB_XCNT(j)]); sum += c; cnt += (c > 0u) ? 1u : 0u; mine = (j == x) ? c : mine; }
        if (sum == G) break;
        __builtin_amdgcn_s_sleep(1);
        if ((++sp & 255u) == 0u) { if (xb_ld(&bar[XB_TMO])) break; if (sp > XB_SPIN_CAP) { atomicAdd(&bar[XB_TMO], 1u); break; } }
    }
    nloc = mine > 0u ? mine : 1u; nx = cnt > 0u ? cnt : 1u;
}

__device__ __forceinline__ void xcd_barrier(const XcdBarrier& b) {
    asm volatile("s_waitcnt vmcnt(0)" ::: "memory");
    __syncthreads();
    if (threadIdx.x == 0) {
        unsigned* bar = b.bar;
        __builtin_amdgcn_s_waitcnt(0);
        unsigned nloc = b.st[0], nx = b.st[1];
        if (nloc == 0u) { xcd_barrier_complete(bar, b.x, nloc, nx); b.st[0] = nloc; b.st[1] = nx; }
        const unsigned old = xb_add(&bar[XB_XSUB(b.x)], 1u);
        const unsigned gen = old / nloc;
        if (old + 1u == (gen + 1u) * nloc) {
            __builtin_amdgcn_fence(__ATOMIC_RELEASE, "agent");
            asm volatile("s_waitcnt vmcnt(0)" ::: "memory");
            const unsigned og = xb_add(&bar[XB_TOP], 1u);
            const unsigned tg = og / nx;
            if (og + 1u == (tg + 1u) * nx) xb_add(&bar[XB_TOPGEN], 1u);
            else XB_SPIN(xb_ld(&bar[XB_TOPGEN]) == tg, bar);
            __builtin_amdgcn_fence(__ATOMIC_ACQUIRE, "agent");
            xb_add(&bar[XB_XGEN(b.x)], 1u);
            asm volatile("s_waitcnt vmcnt(0)" ::: "memory");
        } else {
            XB_SPIN(xb_ld(&bar[XB_XGEN(b.x)]) == gen, bar);
            __builtin_amdgcn_fence(__ATOMIC_ACQUIRE, "agent");
            asm volatile("s_waitcnt vmcnt(0)" ::: "memory");
        }
    }
    __syncthreads();
}

namespace pg8 {
#define PG8_LAS __attribute__((address_space(3)))
typedef unsigned short bf16_t;
typedef short bf16x8 __attribute__((ext_vector_type(8)));
typedef float f32x4 __attribute__((ext_vector_type(4)));
typedef unsigned u32x4 __attribute__((ext_vector_type(4)));
typedef unsigned u32x2 __attribute__((ext_vector_type(2)));
constexpr int BM = 256, BK = 64, HALF = 128, HTB = HALF * BK * 2, STAGE_BYTES = 8 * HTB, NXCD = 8, WGM = 8;

__host__ __device__ __forceinline__ int lds_byte(int r, int c) { const int st = (r >> 4) * 2 + (c >> 5), rr = r & 15, cc = c & 31, ob = rr * 64 + cc * 2; return st * 1024 + (ob ^ (((ob >> 9) & 1) << 5)); }
__host__ __device__ __forceinline__ void stage_rc(int b, int& R, int& C) { const int st = b / 1024, sb = b % 1024, swz = sb ^ (((sb >> 9) & 1) << 5); R = (st >> 1) * 16 + swz / 64; C = (st & 1) * 32 + (swz % 64) / 2; }
__host__ __device__ __forceinline__ int perm32(int rho) { const int n = rho >> 4, i = rho & 15; return 8 * (i >> 2) + 4 * n + (i & 3); }

struct Unit { int pm, pn, e; };

struct StaticOrder {
    static constexpr bool GATHER = false;
    const char* A; const char* Bt; int K; int nM, nN, nwg, G, c;
    __device__ void init(const void* A_, const void* Bt_, int M, int N, int K_, int G_, int c_) { A = (const char*)A_; Bt = (const char*)Bt_; K = K_; nM = M / BM; nN = N / BM; nwg = nM * nN; G = G_; c = c_; }
    __device__ bool next(int i, Unit& u) const {
        const long L = (long)i * G + c; if (L >= nwg) return false;
        int wgid = (int)L; { const int q = nwg / NXCD, r = nwg % NXCD, xcd = wgid % NXCD, off = wgid / NXCD; wgid = (xcd < r ? xcd * (q + 1) : r * (q + 1) + (xcd - r) * q) + off; }
        const int nig = WGM * nN, gid = wgid / nig, fm = gid * WGM, gsz = (nM - fm) < WGM ? (nM - fm) : WGM;
        u.pm = fm + ((wgid % nig) % gsz); u.pn = (wgid % nig) / gsz; u.e = 0; return true;
    }
    __device__ __forceinline__ const char* a_base(const Unit& u) const { return A + (size_t)u.pm * (size_t)(BM * 2) * K; }
    __device__ __forceinline__ const char* b_base(const Unit& u) const { return Bt + (size_t)u.pn * (size_t)(BM * 2) * K; }
    __device__ __forceinline__ void a_voff(int, int, int, int, unsigned (&)[2]) const {}
};

__device__ __forceinline__ unsigned cvt_pk_bf16(float lo, float hi) { unsigned r; asm volatile("v_cvt_pk_bf16_f32 %0, %1, %2" : "=v"(r) : "v"(lo), "v"(hi)); return r; }

typedef int i32x8 __attribute__((ext_vector_type(8)));
typedef int i32x4 __attribute__((ext_vector_type(4)));
template <int K, class Epi, class Sched, bool ALIGN_EPI, bool FP8 = false, int SA = 127, int SB = 127>
__device__ __forceinline__ void gemm_phase(PG8_LAS unsigned char* lds, const Sched& S, const Epi& E) {
    int tid_ = threadIdx.x; asm volatile("" : "+v"(tid_));
    const int tid = tid_, wid = __builtin_amdgcn_readfirstlane(tid >> 6), lane = tid & 63, wr = wid >> 2, wc = wid & 3, fr = lane & 15, fq = lane >> 4;
    constexpr int nt = K / BK;
    constexpr int NH = Sched::GATHER ? 2 : 1;
    unsigned voffB[2], cvA[NH][2], nvA[NH][2];
#pragma unroll
    for (int i = 0; i < 2; ++i) { int R, C; stage_rc(tid * 16 + i * 8192, R, C); const int Rb = Epi::PERM ? ((R & ~31) + perm32(R & 31)) : R;
        voffB[i] = (unsigned)(Rb * K + C) * 2u;
        cvA[0][i] = nvA[0][i] = (unsigned)(R * K + C) * 2u; if constexpr (NH == 2) { cvA[NH - 1][i] = nvA[NH - 1][i] = cvA[0][i]; } }
    constexpr size_t kstep = (size_t)(BK * 2);
    constexpr size_t hstep = (size_t)HALF * K * 2;
    constexpr size_t hstepA = Sched::GATHER ? (size_t)0 : hstep;
    const unsigned ldsw = (unsigned)wid * 1024u;
    const int aoff = lds_byte(wr * 64 + fr, fq * 8), boff = lds_byte(wc * 32 + fr, fq * 8);
#define PG8_SA(b, h) (((b) * 2 + (h)) * HTB)
#define PG8_SB(b, h) ((4 + (b) * 2 + (h)) * HTB)
#define PG8_STAGE(bufoff, gbase, voff) do { _Pragma("unroll") for (int _i = 0; _i < 2; ++_i) \
        __builtin_amdgcn_global_load_lds((const unsigned*)((const char*)(gbase) + (voff)[_i]), (PG8_LAS unsigned*)(lds + (bufoff) + ldsw + _i * 8192), 16, 0, 0); } while (0)
#define PG8_LD32(addr) __builtin_shufflevector(*(const PG8_LAS i32x4*)(addr), *(const PG8_LAS i32x4*)((addr) + 1024), 0, 1, 2, 3, 4, 5, 6, 7)
#define PG8_LDA(dst, b, h) do { _Pragma("unroll") for (int m = 0; m < 4; ++m) dst[m] = PG8_LD32(lds + PG8_SA(b, h) + aoff + m * 2048); } while (0)
#define PG8_LDB(dst, b, h) do { _Pragma("unroll") for (int n = 0; n < 2; ++n) dst[n] = PG8_LD32(lds + PG8_SB(b, h) + boff + n * 2048); } while (0)
#define PG8_H0(x) __builtin_bit_cast(bf16x8, __builtin_shufflevector((x), (x), 0, 1, 2, 3))
#define PG8_H1(x) __builtin_bit_cast(bf16x8, __builtin_shufflevector((x), (x), 4, 5, 6, 7))
#define PG8_MMA(ai, bj, At, Bt) do { __builtin_amdgcn_s_setprio(1); _Pragma("unroll") for (int m = 0; m < 4; ++m) _Pragma("unroll") for (int n = 0; n < 2; ++n) { \
        if constexpr (FP8) asm volatile("v_mfma_scale_f32_16x16x128_f8f6f4 %0, %1, %2, %0, %3, %4 op_sel_hi:[0,0,0]" : "+v"(acc[ai][bj][m][n]) : "v"(Bt[n]), "v"(At[m]), "v"(sbv), "v"(sav)); \
        else { acc[ai][bj][m][n] = __builtin_amdgcn_mfma_f32_16x16x32_bf16(PG8_H0(Bt[n]), PG8_H0(At[m]), acc[ai][bj][m][n], 0, 0, 0); \
               acc[ai][bj][m][n] = __builtin_amdgcn_mfma_f32_16x16x32_bf16(PG8_H1(Bt[n]), PG8_H1(At[m]), acc[ai][bj][m][n], 0, 0, 0); } } \
        __builtin_amdgcn_s_setprio(0); } while (0)
#define PG8_WAIT_V(n) asm volatile("s_waitcnt vmcnt(" #n ")" ::: "memory")
#define PG8_WAIT_L(n) asm volatile("s_waitcnt lgkmcnt(" #n ")" ::: "memory")
#define PG8_BAR __builtin_amdgcn_s_barrier()
#define PG8_SCHED __builtin_amdgcn_sched_barrier(0)
    int sav = SA, sbv = SB; asm volatile("" : "+v"(sav), "+v"(sbv));
    Unit cur, nxt; int ui = 0;
    if (!S.next(0, cur)) return;
    f32x4 acc[2][2][4][2];
#pragma unroll
    for (int a = 0; a < 2; ++a)
#pragma unroll
        for (int b = 0; b < 2; ++b)
#pragma unroll
            for (int m = 0; m < 4; ++m)
#pragma unroll
                for (int n = 0; n < 2; ++n) acc[a][b][m][n] = (f32x4){0.f, 0.f, 0.f, 0.f};
    i32x8 At[4], B0[2], B1[2];
    const char* cA = S.a_base(cur); const char* cB = S.b_base(cur);
    if constexpr (Sched::GATHER) {
        int R0, C0, R1, C1; stage_rc(tid * 16, R0, C0); stage_rc(tid * 16 + 8192, R1, C1);
#pragma unroll
        for (int h = 0; h < 2; ++h) { unsigned v[2]; S.a_voff(0, h, R0, R1, v); cvA[h][0] = v[0] + (unsigned)C0 * 2u; cvA[h][1] = v[1] + (unsigned)C1 * 2u; }
    }
    PG8_STAGE(PG8_SB(0, 0), cB, voffB); PG8_STAGE(PG8_SB(0, 1), cB + hstep, voffB); PG8_STAGE(PG8_SA(0, 0), cA, cvA[0]); PG8_STAGE(PG8_SA(0, 1), cA + hstepA, cvA[NH - 1]);
    if (wr == 1) PG8_BAR;
    PG8_WAIT_V(2); PG8_BAR;
    PG8_STAGE(PG8_SB(1, 0), cB + kstep, voffB); PG8_STAGE(PG8_SA(1, 0), cA + kstep, cvA[0]); PG8_STAGE(PG8_SB(1, 1), cB + hstep + kstep, voffB);
    PG8_WAIT_V(6); PG8_BAR;
    for (;;) {
        const bool has_next = S.next(ui + 1, nxt);
        const char* nA = has_next ? S.a_base(nxt) : cA; const char* nB = has_next ? S.b_base(nxt) : cB;
        if constexpr (Sched::GATHER) {
            if (has_next) {
                int t2 = threadIdx.x; asm volatile("" : "+v"(t2));
                int R0, C0, R1, C1; stage_rc(t2 * 16, R0, C0); stage_rc(t2 * 16 + 8192, R1, C1);
#pragma unroll
                for (int h = 0; h < 2; ++h) { unsigned v[2]; S.a_voff(ui + 1, h, R0, R1, v); nvA[h][0] = v[0] + (unsigned)C0 * 2u; nvA[h][1] = v[1] + (unsigned)C1 * 2u; }
            } else {
#pragma unroll
                for (int h = 0; h < 2; ++h) { nvA[h][0] = cvA[h][0]; nvA[h][1] = cvA[h][1]; }
            }
        }
#pragma unroll 1
        for (int t = 0; t < nt; t += 2) {
            const bool last = (t == nt - 2);
            const char* a1 = cA + (size_t)(t + 1) * kstep;
            const char* a2 = last ? nA : cA + (size_t)(t + 2) * kstep; const char* b2 = last ? nB : cB + (size_t)(t + 2) * kstep;
            const char* a3 = a2 + kstep; const char* b3 = b2 + kstep;
            unsigned v2[NH][2];
#pragma unroll
            for (int h = 0; h < NH; ++h) { if constexpr (Sched::GATHER) { v2[h][0] = last ? nvA[h][0] : cvA[h][0]; v2[h][1] = last ? nvA[h][1] : cvA[h][1]; } else { v2[h][0] = cvA[h][0]; v2[h][1] = cvA[h][1]; } }
            PG8_LDB(B0, 0, 0); PG8_LDB(B1, 0, 1); PG8_SCHED; PG8_LDA(At, 0, 0); PG8_STAGE(PG8_SA(1, 1), a1 + hstepA, cvA[NH - 1]);
            PG8_WAIT_V(8); PG8_WAIT_L(0); PG8_BAR; PG8_MMA(0, 0, At, B0); PG8_MMA(0, 1, At, B1); PG8_BAR; PG8_SCHED;
            PG8_LDA(At, 0, 1); PG8_STAGE(PG8_SB(0, 0), b2, voffB); PG8_STAGE(PG8_SB(0, 1), b2 + hstep, voffB); PG8_STAGE(PG8_SA(0, 0), a2, v2[0]);
            PG8_WAIT_V(8); PG8_WAIT_L(0); PG8_BAR; PG8_MMA(1, 0, At, B0); PG8_MMA(1, 1, At, B1); PG8_BAR; PG8_SCHED;
            PG8_LDB(B0, 1, 0); PG8_LDB(B1, 1, 1); PG8_SCHED; PG8_LDA(At, 1, 0); PG8_STAGE(PG8_SA(0, 1), a2 + hstepA, v2[NH - 1]);
            PG8_WAIT_V(8); PG8_WAIT_L(0); PG8_BAR; PG8_MMA(0, 0, At, B0); PG8_MMA(0, 1, At, B1); PG8_BAR; PG8_SCHED;
            PG8_LDA(At, 1, 1); PG8_STAGE(PG8_SB(1, 0), b3, voffB); PG8_STAGE(PG8_SB(1, 1), b3 + hstep, voffB); PG8_STAGE(PG8_SA(1, 0), a3, v2[0]);
            PG8_WAIT_V(8); PG8_WAIT_L(0); PG8_BAR; PG8_MMA(1, 0, At, B0); PG8_MMA(1, 1, At, B1); PG8_BAR; PG8_SCHED;
        }
        if constexpr (ALIGN_EPI) { if (wr == 0) PG8_BAR; }
        if constexpr (FP8) asm volatile("s_nop 15\n\ts_nop 15" ::: "memory");
        E(acc, cur, ui, wr, wc, fr, fq);
        if (!has_next) break;
#pragma unroll
        for (int a = 0; a < 2; ++a)
#pragma unroll
            for (int b = 0; b < 2; ++b)
#pragma unroll
                for (int m = 0; m < 4; ++m)
#pragma unroll
                    for (int n = 0; n < 2; ++n) acc[a][b][m][n] = (f32x4){0.f, 0.f, 0.f, 0.f};
        cur = nxt; cA = nA; cB = nB; ++ui;
        if constexpr (Sched::GATHER) {
#pragma unroll
            for (int h = 0; h < NH; ++h) { cvA[h][0] = nvA[h][0]; cvA[h][1] = nvA[h][1]; }
        }
        if constexpr (ALIGN_EPI) { if (wr == 1) PG8_BAR; }
    }
    PG8_WAIT_V(0);
    if constexpr (!ALIGN_EPI) { if (wr == 0) PG8_BAR; }
    PG8_BAR;
#undef PG8_SA
#undef PG8_SB
#undef PG8_STAGE
#undef PG8_LDA
#undef PG8_LDB
#undef PG8_MMA
#undef PG8_LD32
#undef PG8_H0
#undef PG8_H1
#undef PG8_WAIT_V
#undef PG8_WAIT_L
#undef PG8_BAR
#undef PG8_SCHED
}
}
#define GAS __attribute__((address_space(1)))
typedef float f32x4 __attribute__((ext_vector_type(4)));
typedef float f32x16 __attribute__((ext_vector_type(16)));
typedef short bf16x8 __attribute__((ext_vector_type(8)));
typedef unsigned v4u __attribute__((ext_vector_type(4)));
typedef unsigned v2u __attribute__((ext_vector_type(2)));
#define LDS_WAIT() asm volatile("s_waitcnt lgkmcnt(0)" ::: "memory")
#define VM_WAIT() asm volatile("s_waitcnt vmcnt(0)" ::: "memory")
__device__ __forceinline__ unsigned pk2(float lo, float hi) { return f2bf(lo) | (f2bf(hi) << 16); }

constexpr int NWAVES = 8, NTHR = 512;
constexpr int LDS_STAGE = 0;
constexpr int LDS_RS = 131072;
constexpr int LDS_ROWTOK = LDS_RS + 8192;
constexpr int LDS_GATE = LDS_ROWTOK + 8192;
constexpr int LDS_MISC = LDS_GATE + 8192;
constexpr int LDS_BYTES = LDS_MISC + 256;
constexpr size_t WO_IN = 0, WO_SM = 6 * MiB, WO_RHI = 6 * MiB + 65536, WO_RLO = 6 * MiB + 131072, WO_OUT = 7 * MiB, WO_XQ = 9 * MiB, WO_XO = 10 * MiB, WO_GU = 11 * MiB, WO_D = 43 * MiB;
static_assert(WO_D + 16 * MiB <= WS_WLAYER, "weight block");
constexpr int CW_BAR = 4096;
constexpr int MAX_LAUNCH = 40;
static_assert((CW_BAR + MAX_LAUNCH * XCD_BAR_WORDS) * 4 <= (int)(1 * MiB), "ctl");

enum { PH_PRO = 0, PH_XKV = 1, PH_L0 = 2, NPH = 13, PH_FINAL = PH_L0 + NLAYER * NPH, PH_END = PH_FINAL + 1 };
enum { LP_INPROJ = 0, LP_MIXA, LP_MIXB, LP_MIXC, LP_WOUT, LP_XQ, LP_XATTN, LP_XO, LP_ROUTE, LP_SORT, LP_GU, LP_DOWN0, LP_DOWN1 };

struct Args { P p; int ph_lo, ph_hi, li, pad; };

#ifndef WT_PROJ
#define WT_PROJ 0
#endif
template <bool HAS_RS> struct EpiBf16 {
    static constexpr bool PERM = true;
    bf16* O; int ldc; const LAS float* rstab;
    __device__ __forceinline__ void operator()(const pg8::f32x4 (&acc)[2][2][4][2], const pg8::Unit& u, int iu, int wr, int wc, int fr, int fq) const {
#pragma unroll
        for (int ai = 0; ai < 2; ++ai)
#pragma unroll
            for (int m = 0; m < 4; ++m) {
                const int lrow = ai * 128 + wr * 64 + m * 16 + fr;
                float sc = 1.f; if (HAS_RS) sc = rstab[iu * 256 + lrow];
                bf16* rowp = O + (size_t)(u.pm * 256 + lrow) * ldc + u.pn * 256 + wc * 32 + 8 * fq;
#pragma unroll
                for (int bj = 0; bj < 2; ++bj) { const pg8::f32x4 v0 = acc[ai][bj][m][0] * sc, v1 = acc[ai][bj][m][1] * sc;
                    pg8::u32x4 w; w.x = pg8::cvt_pk_bf16(v0[0], v0[1]); w.y = pg8::cvt_pk_bf16(v0[2], v0[3]); w.z = pg8::cvt_pk_bf16(v1[0], v1[1]); w.w = pg8::cvt_pk_bf16(v1[2], v1[3]);
                    if (WT_PROJ) st_b128_wt(rowp + bj * 128, w); else st_b128(rowp + bj * 128, w); }
            }
    }
};
__device__ __forceinline__ unsigned pk4_fp8(float a, float b, float c, float d) { int w = __builtin_amdgcn_cvt_pk_fp8_f32(a, b, 0, false); w = __builtin_amdgcn_cvt_pk_fp8_f32(c, d, w, true); return (unsigned)w; }
struct EpiGU {
    static constexpr bool PERM = true;
    unsigned char* U8; const LAS float* rstab;
    __device__ __forceinline__ void operator()(const pg8::f32x4 (&acc)[2][2][4][2], const pg8::Unit& u, int iu, int wr, int wc, int fr, int fq) const {
#pragma unroll
        for (int ai = 0; ai < 2; ++ai)
#pragma unroll
            for (int m = 0; m < 4; ++m) {
                const int lrow = ai * 128 + wr * 64 + m * 16 + fr;
                const float sc = rstab[iu * 256 + lrow];
                float o[8];
#pragma unroll
                for (int n = 0; n < 2; ++n)
#pragma unroll
                    for (int j = 0; j < 4; ++j) { const float g = acc[ai][0][m][n][j] * sc, uu = acc[ai][1][m][n][j] * sc; o[n * 4 + j] = 4.f * g * uu * __builtin_amdgcn_rcpf(1.f + __expf(-g)); }
                pg8::u32x2 w; w.x = pk4_fp8(o[0], o[1], o[2], o[3]); w.y = pk4_fp8(o[4], o[5], o[6], o[7]);
                st_b64(U8 + (size_t)(u.pm * 256 + lrow) * 512 + u.pn * 128 + wc * 32 + 8 * fq, w);
            }
    }
};
template <int MODE, bool W8 = false> struct EpiRes {
    static constexpr bool PERM = false;
    static constexpr bool MOE = MODE != 0;
    bf16* hb; float* ssq; const LAS int* rowtab; const LAS float* gatetab; float gs; bf16* t0; unsigned char* h8;
    __device__ __forceinline__ void operator()(const pg8::f32x4 (&acc)[2][2][4][2], const pg8::Unit& u, int iu, int wr, int wc, int fr, int fq) const {
#pragma unroll
        for (int ai = 0; ai < 2; ++ai)
#pragma unroll
            for (int m = 0; m < 4; ++m) {
                const int lrow = ai * 128 + wr * 64 + m * 16 + fr;
                int row = u.pm * 256 + lrow; float g = gs;
                if (MOE) { row = rowtab[iu * 256 + lrow]; g = gatetab[iu * 256 + lrow] * gs; }
                const bool ok = !MOE || row >= 0;
                const size_t off = (size_t)(ok ? row : 0) * DM + u.pn * 256 + wc * 32 + 4 * fq;
                float q = 0.f;
                if (ok) {
#pragma unroll
                    for (int bj = 0; bj < 2; ++bj)
#pragma unroll
                        for (int n = 0; n < 2; ++n) {
                            if (MODE == 1) { const pg8::f32x4 o = acc[ai][bj][m][n] * g; pg8::u32x2 w; w.x = pg8::cvt_pk_bf16(o[0], o[1]); w.y = pg8::cvt_pk_bf16(o[2], o[3]); st_b64(t0 + off + bj * 128 + n * 16, w); }
                            else {
                                const pg8::u32x2 bw = *(const pg8::u32x2*)(hb + off + bj * 128 + n * 16);
                                pg8::f32x4 bs; bs[0] = __builtin_bit_cast(float, bw.x << 16); bs[1] = __builtin_bit_cast(float, bw.x & 0xffff0000u); bs[2] = __builtin_bit_cast(float, bw.y << 16); bs[3] = __builtin_bit_cast(float, bw.y & 0xffff0000u);
                                if (MODE == 2) { const pg8::u32x2 tw = *(const pg8::u32x2*)(t0 + off + bj * 128 + n * 16);
                                    bs[0] += __builtin_bit_cast(float, tw.x << 16); bs[1] += __builtin_bit_cast(float, tw.x & 0xffff0000u); bs[2] += __builtin_bit_cast(float, tw.y << 16); bs[3] += __builtin_bit_cast(float, tw.y & 0xffff0000u); }
                                const pg8::f32x4 o = bs + acc[ai][bj][m][n] * g;
                                pg8::u32x2 w; w.x = pg8::cvt_pk_bf16(o[0], o[1]); w.y = pg8::cvt_pk_bf16(o[2], o[3]);
                                const float r0 = __builtin_bit_cast(float, w.x << 16), r1 = __builtin_bit_cast(float, w.x & 0xffff0000u), r2 = __builtin_bit_cast(float, w.y << 16), r3 = __builtin_bit_cast(float, w.y & 0xffff0000u);
                                q += (r0 * r0 + r1 * r1) + (r2 * r2 + r3 * r3);
                                st_b64(hb + off + bj * 128 + n * 16, w);
                                if (W8) *(unsigned*)(h8 + off + bj * 128 + n * 16) = pk4_fp8(o[0], o[1], o[2], o[3]); } }
                }
                if (MODE != 1) { q += __shfl_xor(q, 16); q += __shfl_xor(q, 32); if (fq == 0 && ok) ssq[(size_t)row * 16 + u.pn * 4 + wc] = q; }
            }
    }
};
template <bool GATH> struct MoeOrder {
    static constexpr bool GATHER = GATH;
    const char* A; const char* Bt; int K; size_t estride; int lo, hi, G, c; const int* tilee; const LAS int* rowtab;
    __device__ bool next(int i, pg8::Unit& u) const { const int L = i * G + c, t = lo + (L >> 2); if (t >= hi) return false; u.pm = t; u.pn = L & 3; u.e = tilee[t]; return true; }
    __device__ __forceinline__ const char* a_base(const pg8::Unit& u) const { return GATH ? A : A + (size_t)u.pm * (size_t)512 * K; }
    __device__ __forceinline__ const char* b_base(const pg8::Unit& u) const { return Bt + (size_t)u.e * estride + (size_t)u.pn * (size_t)512 * K; }
    __device__ __forceinline__ void a_voff(int iu, int h, int R0, int R1, unsigned (&v)[2]) const { v[0] = (unsigned)rowtab[iu * 256 + h * 128 + R0] * (unsigned)(K * 2); v[1] = (unsigned)rowtab[iu * 256 + h * 128 + R1] * (unsigned)(K * 2); }
};

__device__ __forceinline__ void router_weights(const P& p, int gtid, int gstride);
__device__ __forceinline__ void tr_item(const float* W, int N, int K, int k0, int n0, const float* gain, float scale, bf16* dst, LAS float* scr, int lane) {
    const int kr = lane >> 3, c4 = lane & 7;
    f32x4 v[8];
#pragma unroll
    for (int i = 0; i < 8; ++i) v[i] = *(const f32x4*)(W + (size_t)(k0 + 8 * i + kr) * N + n0 + 4 * c4);
#pragma unroll
    for (int i = 0; i < 8; ++i) { const int kk = 8 * i + kr; float g = scale; if (gain) g *= gain[k0 + kk];
        LAS float* d = scr + kk * 33 + 4 * c4; d[0] = v[i].x * g; d[1] = v[i].y * g; d[2] = v[i].z * g; d[3] = v[i].w * g; }
    LDS_WAIT();
    const int c = lane & 7;
#pragma unroll
    for (int j = 0; j < 4; ++j) { const int n = (lane >> 3) + 8 * j; const LAS float* s = scr + (8 * c) * 33 + n;
        v4u o; o.x = pk2(s[0 * 33], s[1 * 33]); o.y = pk2(s[2 * 33], s[3 * 33]); o.z = pk2(s[4 * 33], s[5 * 33]); o.w = pk2(s[6 * 33], s[7 * 33]);
        st_b128(dst + (size_t)n * K + k0 + 8 * c, o); }
    LDS_WAIT();
}
__device__ __forceinline__ void tr_item8(const float* W, int N, int K, int k0, int n0, const float* gain, float scale, unsigned char* dst, LAS float* scr, int lane) {
    const int kr = lane >> 3, c4 = lane & 7;
    f32x4 v[8];
#pragma unroll
    for (int i = 0; i < 8; ++i) v[i] = *(const f32x4*)(W + (size_t)(k0 + 8 * i + kr) * N + n0 + 4 * c4);
#pragma unroll
    for (int i = 0; i < 8; ++i) { const int kk = 8 * i + kr; float g = scale; if (gain) g *= gain[k0 + kk];
        LAS float* d = scr + kk * 33 + 4 * c4; d[0] = v[i].x * g; d[1] = v[i].y * g; d[2] = v[i].z * g; d[3] = v[i].w * g; }
    LDS_WAIT();
    const int c = lane & 7;
#pragma unroll
    for (int j = 0; j < 4; ++j) { const int n = (lane >> 3) + 8 * j; const LAS float* s = scr + (8 * c) * 33 + n;
        v2u o; o.x = pk4_fp8(s[0 * 33], s[1 * 33], s[2 * 33], s[3 * 33]); o.y = pk4_fp8(s[4 * 33], s[5 * 33], s[6 * 33], s[7 * 33]);
        st_b64(dst + (size_t)n * K + k0 + 8 * c, o); }
    LDS_WAIT();
}
constexpr int IT_LAYER = 15360;
__device__ __forceinline__ void prologue_item(const P& p, int it, LAS float* scr, int lane) {
    const int l = it / IT_LAYER; int r = it % IT_LAYER;
    unsigned char* wl = ws_base(p.ws) + WS_W + (size_t)l * WS_WLAYER;
    if (r < 1536) {
        const int seg = r / 768; r %= 768; const int kb = r / 48, nb = r % 48; const int n0 = (seg ? 1544 : 0) + 32 * nb, drow = seg * 1536 + 32 * nb;
        const float sc = drow < 512 ? 0.125f * LOG2E : ((drow >= C_GQ && drow < C_GK) ? 0.125f : 1.f);
        tr_item(p.w_in + (size_t)l * DM * INW, INW, DM, 64 * kb, n0, p.mix_norm + l * DM, sc, (bf16*)(wl + WO_IN) + (size_t)drow * DM, scr, lane); return; }
    r -= 1536;
    if (r < 512) { const int kb = r / 32, nb = r % 32; tr_item(p.w_out + (size_t)l * DM * DM, DM, DM, 64 * kb, 32 * nb, nullptr, 1.f, (bf16*)(wl + WO_OUT) + (size_t)(32 * nb) * DM, scr, lane); return; }
    r -= 512;
    if (r < 256) { const int kb = r / 16, nb = r % 16; tr_item(p.w_xq + (size_t)l * DM * 512, 512, DM, 64 * kb, 32 * nb, p.cross_norm + l * DM, 0.08838834764831845f * LOG2E, (bf16*)(wl + WO_XQ) + (size_t)(32 * nb) * DM, scr, lane); return; }
    r -= 256;
    if (r < 256) { const int kb = r / 32, nb = r % 32; tr_item8(p.w_xo + (size_t)l * 512 * DM, DM, 512, 64 * kb, 32 * nb, nullptr, 32.f, (unsigned char*)(wl + WO_XO) + (size_t)(32 * nb) * 512, scr, lane); return; }
    r -= 256;
    if (r < 512) { const int kv = r / 256; r %= 256; const int kb = r / 16, nb = r % 16;
        tr_item((kv ? p.w_xv : p.w_xk) + (size_t)l * DM * 512, 512, DM, 64 * kb, 32 * nb, nullptr, 1.f, (bf16*)(ws_base(p.ws) + WS_WXKV) + (size_t)(l * 1024 + kv * 512 + 32 * nb) * DM, scr, lane); return; }
    r -= 512;
    if (r < 8192) { const int up = r / 4096; r %= 4096; const int e = r / 256; r %= 256; const int kb = r / 16, nb = r % 16; const int c0 = 32 * nb, drow = (c0 >> 7) * 256 + up * 128 + (c0 & 127);
        tr_item8((up ? p.w_eu : p.w_eg) + ((size_t)l * 16 + e) * DM * 512, 512, DM, 64 * kb, c0, p.moe_norm + l * DM, 32.f, (unsigned char*)(wl + WO_GU) + ((size_t)e * 1024 + drow) * DM, scr, lane); return; }
    r -= 8192;
    { const int e = r / 256; r %= 256; const int kb = r / 32, nb = r % 32;
      tr_item8(p.w_ed + ((size_t)l * 16 + e) * 512 * DM, DM, 512, 64 * kb, 32 * nb, nullptr, 32.f, (unsigned char*)(wl + WO_D) + ((size_t)e * 1024 + 32 * nb) * 512, scr, lane); }
}
__device__ __forceinline__ void row_to_bf16(const float* src, bf16* dst, float* ssq, const float* gain, int lane, int mode) {
    const f32x4* s = (const f32x4*)src + lane;
    f32x4 v[4]; float q = 0.f;
#pragma unroll
    for (int j = 0; j < 4; ++j) { v[j] = s[64 * j]; q += (v[j].x * v[j].x + v[j].y * v[j].y) + (v[j].z * v[j].z + v[j].w * v[j].w); }
    q = wave_sum(q);
    float sc = 1.f;
    if (mode == 1) sc = rsqrtf(q * (1.0f / DM) + EPS);
    v2u* d = (v2u*)dst + lane; float q2 = 0.f;
#pragma unroll
    for (int j = 0; j < 4; ++j) {
        f32x4 g = (f32x4){1.f, 1.f, 1.f, 1.f}; if (mode == 1) g = ((const f32x4*)gain)[lane + 64 * j];
        v2u o; o.x = pk2(v[j].x * sc * g.x, v[j].y * sc * g.y); o.y = pk2(v[j].z * sc * g.z, v[j].w * sc * g.w); st_b64(d + 64 * j, o);
        const float r0 = __builtin_bit_cast(float, o.x << 16), r1 = __builtin_bit_cast(float, o.x & 0xffff0000u), r2 = __builtin_bit_cast(float, o.y << 16), r3 = __builtin_bit_cast(float, o.y & 0xffff0000u);
        q2 += (r0 * r0 + r1 * r1) + (r2 * r2 + r3 * r3); }
    if (mode == 0) { q2 = wave_sum(q2); if (lane < 16) ssq[lane] = lane == 0 ? q2 : 0.f; }
}
__device__ __forceinline__ void prologue(const P& p, LAS unsigned char* lds, int vcu, int G, int wave, int lane) {
    asm volatile("" : "+v"(lane));
    LAS float* scr = (LAS float*)(lds + LDS_STAGE + wave * 16384);
    const int gw = vcu * NWAVES + wave, NGW = G * NWAVES;
    for (int it = gw; it < NLAYER * IT_LAYER; it += NGW) prologue_item(p, it, scr, lane);
    for (int idx = gw * 64 + lane; idx < NLAYER * 2 * 32768; idx += NGW * 64) {
        const int l = idx / 65536, r = idx % 65536, which = r / 32768, e = r % 32768, row = e / 1024, k = e % 1024;
        unsigned char* wl = ws_base(p.ws) + WS_W + (size_t)l * WS_WLAYER;
        if (which == 0) {
            float v = 0.f;
            if (row < 8) v = p.w_in[((size_t)l * DM + k) * INW + 1536 + row]; else if (row < 24) v = p.w_in[((size_t)l * DM + k) * INW + 3080 + (row - 8)];
            ((bf16*)(wl + WO_SM))[row * 1024 + k] = (bf16)f2bf(v * p.mix_norm[l * DM + k]);
        }
    }
    router_weights(p, gw * 64 + lane, NGW * 64);
    for (int m = gw; m < 4096; m += NGW) row_to_bf16(p.mem + (size_t)m * DM, WSP(bf16, WS_MEMN) + (size_t)m * DM, nullptr, p.mem_norm, lane, 1);
    { bf16* hbp = WSP(bf16, WS_HB); float* sqp = WSP(float, WS_SSQ);
      for (int m0 = gw * 4; m0 < NTOK; m0 += NGW * 4) {
        f32x4 v[4][4];
#pragma unroll
        for (int r = 0; r < 4; ++r)
#pragma unroll
            for (int j = 0; j < 4; ++j) v[r][j] = ((const f32x4*)(p.x + (size_t)(m0 + r) * DM))[lane + 64 * j];
#pragma unroll
        for (int r = 0; r < 4; ++r) { float q2 = 0.f; v2u* d = (v2u*)(hbp + (size_t)(m0 + r) * DM) + lane;
#pragma unroll
            for (int j = 0; j < 4; ++j) { v2u o; o.x = pk2(v[r][j].x, v[r][j].y); o.y = pk2(v[r][j].z, v[r][j].w); st_b64(d + 64 * j, o);
                const float r0 = __builtin_bit_cast(float, o.x << 16), r1 = __builtin_bit_cast(float, o.x & 0xffff0000u), r2 = __builtin_bit_cast(float, o.y << 16), r3 = __builtin_bit_cast(float, o.y & 0xffff0000u);
                q2 += (r0 * r0 + r1 * r1) + (r2 * r2 + r3 * r3); }
            q2 = wave_sum(q2); if (lane < 16) sqp[(size_t)(m0 + r) * 16 + lane] = lane == 0 ? q2 : 0.f; }
      } }
}
__device__ __forceinline__ void small_proj(const P& p, int l, LAS unsigned char* lds, int vcu, int G, int wave, int lane) {
    asm volatile("" : "+v"(lane));
    const bf16* wsm = (const bf16*)(ws_base(p.ws) + WS_W + (size_t)l * WS_WLAYER + WO_SM);
    const bf16* hb = WSP(bf16, WS_HB); const float* ssq = WSP(float, WS_SSQ); float* sm = WSP(float, WS_SM);
    constexpr int BST = 2048 + 16;
    { const int tid = wave * 64 + lane;
#pragma unroll
      for (int i = 0; i < 8; ++i) { const int idx = tid + NTHR * i, row = idx >> 7, c = idx & 127; *(LAS v4u*)(lds + row * BST + c * 16) = *(const v4u*)(wsm + row * 1024 + c * 8); } }
    __syncthreads();
    const int r = lane & 15, kq = lane >> 4;
    for (int blk = vcu * NWAVES + wave; blk < NTOK / 16; blk += G * NWAVES) {
        const int tok0 = blk * 16;
        const bf16x8* ap = (const bf16x8*)(hb + (size_t)(tok0 + r) * DM + kq * 32);
        pg8::f32x4 acc0 = {0.f, 0.f, 0.f, 0.f}, acc1 = {0.f, 0.f, 0.f, 0.f};
#pragma unroll
        for (int half = 0; half < 2; ++half) {
            bf16x8 af[16];
#pragma unroll
            for (int i = 0; i < 16; ++i) af[i] = ap[(half * 4 + (i >> 2)) * 16 + (i & 3)];
#pragma unroll
            for (int i = 0; i < 16; ++i) { const int s_ = half * 4 + (i >> 2), j = i & 3;
                const bf16x8 b0 = *(const LAS bf16x8*)(lds + r * BST + (128 * s_ + 32 * kq + 8 * j) * 2);
                const bf16x8 b1 = *(const LAS bf16x8*)(lds + (16 + r) * BST + (128 * s_ + 32 * kq + 8 * j) * 2);
                acc0 = __builtin_amdgcn_mfma_f32_16x16x32_bf16(af[i], b0, acc0, 0, 0, 0);
                acc1 = __builtin_amdgcn_mfma_f32_16x16x32_bf16(af[i], b1, acc1, 0, 0, 0);
                if ((i & 3) == 3) __builtin_amdgcn_sched_barrier(0); }
        }
        const float rsv = row_rs(ssq, tok0 + r);
#pragma unroll
        for (int g = 0; g < 4; ++g) { const int trow = 4 * kq + g; const float rs = __shfl(rsv, trow);
            sm[(size_t)(tok0 + trow) * 32 + r] = acc0[g] * rs; if (r < 8) sm[(size_t)(tok0 + trow) * 32 + 16 + r] = acc1[g] * rs; }
    }
    __syncthreads();
}
typedef short v4i16_t __attribute__((ext_vector_type(4)));
typedef __bf16 bf16x2_t __attribute__((ext_vector_type(2)));
typedef float f32x2_t __attribute__((ext_vector_type(2)));
__device__ __forceinline__ unsigned cvtpk(float lo, float hi) { f32x2_t v = {lo, hi}; bf16x2_t b = __builtin_convertvector(v, bf16x2_t); return __builtin_bit_cast(unsigned, b); }
__device__ __forceinline__ bf16x8 pack8(const f32x16& p, int o) {
    v4u w; w.x = cvtpk(p[o], p[o + 1]); w.y = cvtpk(p[o + 2], p[o + 3]); w.z = cvtpk(p[o + 4], p[o + 5]); w.w = cvtpk(p[o + 6], p[o + 7]);
    return __builtin_bit_cast(bf16x8, w);
}
__device__ __forceinline__ float max3f(float a, float b, float c) { float r; asm("v_max3_f32 %0, %1, %2, %3" : "=v"(r) : "v"(a), "v"(b), "v"(c)); return r; }
template <int D, bool FOX, bool OUT8 = false>
__device__ __forceinline__ void attn_unit(LAS unsigned char* lds, const bf16* Qg, int qpitch, const bf16* Kg, const bf16* Vg, int kvpitch, int NT,
                                          const float* cb, int q0, bf16* Og, int opitch, const float* gain, const float* kn) {
    constexpr int KS = D * 2 + 16, VS = D * 2 + 64;
    constexpr int KBYTES = 64 * KS, VBYTES = 64 * VS;
    constexpr int CPR = D / 8, NCH = 64 * CPR / NTHR, NS = D / 16, NDB = D / 32;
    constexpr int OFF_K = 0, OFF_V = 2 * KBYTES, OFF_CB = 2 * KBYTES + 2 * VBYTES, OFF_FX = OFF_CB + 512;
    int tid = threadIdx.x; asm volatile("" : "+v"(tid));
    const int lane = tid & 63, wave = __builtin_amdgcn_readfirstlane(tid >> 6), r32 = lane & 31, hh = lane >> 5;
    bf16x8 qf[NS];
    { const bf16* qrow = Qg + (size_t)(wave * 32 + r32) * qpitch;
#pragma unroll
      for (int s = 0; s < NS; ++s) qf[s] = *(const bf16x8*)(qrow + 16 * s + 8 * hh); }
    v4u kreg[NCH], vreg[NCH]; f32x4 cbreg = {0.f, 0.f, 0.f, 0.f};
#define AT_GLOAD(t) do { _Pragma("unroll") for (int i_ = 0; i_ < NCH; ++i_) { const int idx_ = tid + NTHR * i_, key_ = idx_ / CPR, c_ = idx_ % CPR; \
        kreg[i_] = *(const v4u*)(Kg + (size_t)((t) * 64 + key_) * kvpitch + c_ * 8); vreg[i_] = *(const v4u*)(Vg + (size_t)((t) * 64 + key_) * kvpitch + c_ * 8); } \
        if (FOX && tid < 16) cbreg = *(const f32x4*)(cb + (t) * 64 + tid * 4); } while (0)
#define AT_LSTORE(b) do { _Pragma("unroll") for (int i_ = 0; i_ < NCH; ++i_) { const int idx_ = tid + NTHR * i_, key_ = idx_ / CPR, c_ = idx_ % CPR; \
        *(LAS v4u*)(lds + OFF_K + (b) * KBYTES + key_ * KS + c_ * 16) = kreg[i_]; *(LAS v4u*)(lds + OFF_V + (b) * VBYTES + key_ * VS + c_ * 16) = vreg[i_]; } \
        if (FOX && tid < 16) *(LAS f32x4*)(lds + OFF_CB + (b) * 256 + tid * 16) = cbreg; } while (0)
    float m = -INFINITY, l = 0.f;
    f32x16 osum = f32x16{};
    f32x16 o[NDB];
#pragma unroll
    for (int d = 0; d < NDB; ++d) o[d] = f32x16{};
    const int qlo = q0 + wave * 32, qabs = qlo + r32;
    float knpre = 0.f, qkmax = 0.f;
    LAS float* fx = (LAS float*)(lds + OFF_FX);
    __syncthreads();
    if (FOX) {
        float qn2 = 0.f;
#pragma unroll
        for (int s = 0; s < NS; ++s)
#pragma unroll
            for (int e = 0; e < 8; ++e) { const float v = __builtin_bit_cast(float, ((unsigned)(unsigned short)qf[s][e]) << 16); qn2 += v * v; }
        qn2 += __shfl_xor(qn2, 32);
        qn2 = wave_max(qn2);
        if (lane == 0) fx[wave] = qn2;
        knpre = lane < 32 ? kn[lane] : 0.f;
#pragma unroll
        for (int o_ = 1; o_ < 32; o_ <<= 1) { const float t_ = __shfl_up(knpre, o_); if (lane >= o_) knpre = fmaxf(knpre, t_); }
    }
    const int t_first = FOX ? NT - 1 : 0;
    AT_GLOAD(t_first); AT_LSTORE(0);
    __syncthreads();
    if (FOX) { float q2 = fx[0];
#pragma unroll
        for (int w_ = 1; w_ < 8; ++w_) q2 = fmaxf(q2, fx[w_]);
        qkmax = sqrtf(q2); }
#pragma unroll 1
    for (int it = 0; it < NT; ++it) {
        const int b = it & 1;
        const int t = FOX ? NT - 1 - it : it;
        const int tn = FOX ? t - 1 : t + 1;
        if (it + 1 < NT) AT_GLOAD(tn);
        const int kt0 = t * 64;
        if (!FOX || kt0 <= qlo + 31) {
            f32x16 p[2];
#pragma unroll
            for (int kb = 0; kb < 2; ++kb) {
                if (FOX) {
#pragma unroll
                    for (int g = 0; g < 4; ++g) { const f32x4 c4 = *(const LAS f32x4*)(lds + OFF_CB + b * 256 + (kb * 32 + 8 * g + 4 * hh) * 4); p[kb][4 * g] = c4.x; p[kb][4 * g + 1] = c4.y; p[kb][4 * g + 2] = c4.z; p[kb][4 * g + 3] = c4.w; }
                } else p[kb] = f32x16{};
                const LAS unsigned char* kp = lds + OFF_K + b * KBYTES + (kb * 32 + r32) * KS + hh * 16;
#pragma unroll
                for (int s = 0; s < NS; ++s) { const bf16x8 kf = *(const LAS bf16x8*)(kp + s * 32); p[kb] = __builtin_amdgcn_mfma_f32_32x32x16_bf16(kf, qf[s], p[kb], 0, 0, 0); }
            }
            if (FOX && kt0 + 63 > qlo) {
#pragma unroll
                for (int kb = 0; kb < 2; ++kb)
#pragma unroll
                    for (int r = 0; r < 16; ++r) { const int key = kt0 + kb * 32 + (r & 3) + 8 * (r >> 2) + 4 * hh; if (key > qabs) p[kb][r] = -INFINITY; }
            }
            float mt = fmaxf(p[1][0], p[0][0]);
#pragma unroll
            for (int r = 1; r < 16; ++r) mt = max3f(mt, p[0][r], p[1][r]);
            mt = fmaxf(mt, __shfl_xor(mt, 32));
            const float mnew = fmaxf(m, mt);
            float ls = 0.f;
#pragma unroll
            for (int kb = 0; kb < 2; ++kb)
#pragma unroll
                for (int r = 0; r < 16; ++r) { const float e = __builtin_amdgcn_exp2f(p[kb][r] - mnew); p[kb][r] = e; if (!FOX) ls += e; }
            if (!FOX || __builtin_amdgcn_ballot_w64(mnew > m) != 0ull) {
                const float alpha = __builtin_amdgcn_exp2f(m - mnew);
                l *= alpha; if (FOX) osum[0] *= alpha;
#pragma unroll
                for (int d = 0; d < NDB; ++d)
#pragma unroll
                    for (int r = 0; r < 16; ++r) o[d][r] *= alpha;
            }
            m = mnew; l += ls;
            bf16x8 pa[2][2];
#pragma unroll
            for (int kb = 0; kb < 2; ++kb) { pa[kb][0] = pack8(p[kb], 0); pa[kb][1] = pack8(p[kb], 8); }
            const LAS unsigned char* vp = lds + OFF_V + b * VBYTES + (4 * hh + ((lane & 15) >> 2)) * VS + (16 * ((lane >> 4) & 1) + 4 * (lane & 3)) * 2;
#pragma unroll
            for (int d = 0; d < NDB; ++d) {
#pragma unroll
                for (int kb = 0; kb < 2; ++kb)
#pragma unroll
                    for (int ks = 0; ks < 2; ++ks) {
                        const LAS unsigned char* a0 = vp + (kb * 32 + 16 * ks) * VS + d * 64;
                        const v4i16_t lo = __builtin_amdgcn_ds_read_tr16_b64_v4i16((LAS v4i16_t*)a0);
                        const v4i16_t hi = __builtin_amdgcn_ds_read_tr16_b64_v4i16((LAS v4i16_t*)(a0 + 8 * VS));
                        const bf16x8 vf = (bf16x8){lo[0], lo[1], lo[2], lo[3], hi[0], hi[1], hi[2], hi[3]};
                        o[d] = __builtin_amdgcn_mfma_f32_32x32x16_bf16(vf, pa[kb][ks], o[d], 0, 0, 0);
                    }
            }
            if (FOX) {
                const bf16x8 ones = __builtin_bit_cast(bf16x8, (v4u){0x3F803F80u, 0x3F803F80u, 0x3F803F80u, 0x3F803F80u});
#pragma unroll
                for (int kb = 0; kb < 2; ++kb)
#pragma unroll
                    for (int ks = 0; ks < 2; ++ks) osum = __builtin_amdgcn_mfma_f32_32x32x16_bf16(ones, pa[kb][ks], osum, 0, 0, 0);
            }
        }
        if (FOX) { const float mm = wave_min(m); if (lane == 0) fx[8 + b * 8 + wave] = mm; }
        if (it + 1 < NT) AT_LSTORE(b ^ 1);
        __syncthreads();
        if (FOX && t > 0) {
            float M0 = fx[8 + b * 8];
#pragma unroll
            for (int w_ = 1; w_ < 8; ++w_) M0 = fminf(M0, fx[8 + b * 8 + w_]);
            const float cbl = *(const LAS float*)(lds + OFF_CB + (b ^ 1) * 256 + 63 * 4);
            const float knb = __builtin_bit_cast(float, __builtin_amdgcn_readlane(__builtin_bit_cast(int, knpre), t - 1));
            if (qkmax * knb + cbl < M0 - 40.f) break;
        }
    }
#undef AT_GLOAD
#undef AT_LSTORE
    if (FOX) l = osum[0]; else l += __shfl_xor(l, 32);
    const float inv = 1.0f / l;
    float rs = inv;
    if (FOX) {
        float ss = 0.f;
#pragma unroll
        for (int d = 0; d < NDB; ++d)
#pragma unroll
            for (int r = 0; r < 16; ++r) { const float v = o[d][r] * inv; ss += v * v; }
        ss += __shfl_xor(ss, 32);
        rs = inv * rsqrtf(ss * (1.0f / D) + EPS);
    }
    bf16* orow = Og + (size_t)(wave * 32 + r32) * opitch;
#pragma unroll
    for (int d = 0; d < NDB; ++d)
#pragma unroll
        for (int g = 0; g < 4; ++g) {
            f32x4 gn = {1.f, 1.f, 1.f, 1.f}; if (FOX) gn = *(const f32x4*)(gain + 32 * d + 8 * g + 4 * hh);
            if (OUT8) { *(unsigned*)((unsigned char*)Og + (size_t)(wave * 32 + r32) * opitch + 32 * d + 8 * g + 4 * hh) = pk4_fp8(o[d][4 * g] * rs, o[d][4 * g + 1] * rs, o[d][4 * g + 2] * rs, o[d][4 * g + 3] * rs); }
            else { v2u w; w.x = cvtpk(o[d][4 * g] * rs * gn.x, o[d][4 * g + 1] * rs * gn.y); w.y = cvtpk(o[d][4 * g + 2] * rs * gn.z, o[d][4 * g + 3] * rs * gn.w);
                st_b64(orow + 32 * d + 8 * g + 4 * hh, w); }
        }
}
__device__ __forceinline__ void fox_phase(const P& p, int l, LAS unsigned char* lds, int vcu, int G) {
    const bf16* proj = WSP(bf16, WS_PROJ); const float* cb = WSP(float, WS_CB); bf16* y = WSP(bf16, WS_Y);
    for (int pu = vcu; pu < 512; pu += G) {
        const int bh = pu >> 2, pr = pu < 256 ? (pu & 3) : 3 - (pu & 3), b = bh >> 3, h = bh & 7;
        for (int half = 0; half < 2; ++half) {
            const int qb = half ? pr : 7 - pr;
            const size_t row0 = (size_t)b * SEQ;
            attn_unit<64, true>(lds, proj + (row0 + qb * 256) * PW + C_FQ + h * 64, PW, proj + row0 * PW + C_FK + h * 64, proj + row0 * PW + C_FV + h * 64, PW, 4 * (qb + 1),
                                cb + ((size_t)b * 8 + h) * SEQ, qb * 256, y + (row0 + qb * 256) * DM + h * 64, DM, p.fox_gain + l * 512 + h * 64, WSP(const float, WS_MOE + MO_KN) + (b * 8 + h) * 32);
        }
    }
}
__device__ __forceinline__ void xattn_phase(const P& p, int l, LAS unsigned char* lds, int vcu, int G, bool dummy) {
    bf16* xq = WSP(bf16, WS_XQ); const bf16* xkv = WSP(bf16, WS_XKV);
    for (int u = vcu; u < 512; u += G) {
        const int b = u >> 5, h = (u >> 3) & 3, qb = u & 7;
        bf16* qp = xq + ((size_t)b * SEQ + qb * 256) * 512 + h * 128;
        const bf16* kp = xkv + (size_t)b * MEML * 2048 + l * 1024 + h * 128;
        attn_unit<128, false, true>(lds, qp, 512, kp, kp + 512, 2048, 4, nullptr, 0, (bf16*)((dummy ? WSP(unsigned char, WS_Y) : WSP(unsigned char, WS_XO8)) + ((size_t)b * SEQ + qb * 256) * 512 + h * 128), 512, nullptr, nullptr);
    }
}

__device__ __forceinline__ void xattn_pair(const P& p, int l, LAS unsigned char* lds, int pm, int pn, bool dummy) {
    const bf16* xq = WSP(bf16, WS_XQ); const bf16* xkv = WSP(bf16, WS_XKV);
    const int b = pm >> 3;
    for (int hh2 = 0; hh2 < 2; ++hh2) {
        const int h = 2 * pn + hh2;
        const bf16* qp = xq + (size_t)pm * 256 * 512 + h * 128;
        const bf16* kp = xkv + (size_t)b * MEML * 2048 + l * 1024 + h * 128;
        attn_unit<128, false, true>(lds, qp, 512, kp, kp + 512, 2048, 4, nullptr, 0, (bf16*)((dummy ? WSP(unsigned char, WS_Y) : WSP(unsigned char, WS_XO8)) + (size_t)pm * 256 * 512 + h * 128), 512, nullptr, nullptr);
    }
}
constexpr size_t WS_GB = WS_END;
constexpr size_t WS_GDEC = WS_GB + 32 * MiB;
constexpr size_t WS_END2 = WS_GDEC + 1 * MiB;
static_assert(WS_END2 <= 512 * MiB, "workspace map 2");
constexpr int GL_B = 0;
constexpr int GL_TOT = 16384;
constexpr int GL_Q1 = 18432, GL_Q2 = GL_Q1 + 64 * 144, GL_K2 = GL_Q2 + 64 * 144;
constexpr int GL_KD = GL_K2 + 64 * 144;
constexpr int GL_V = GL_KD + 64 * 192;
constexpr int GL_SSQ = GL_V + 64 * 320;
constexpr int GL_GA = GL_SSQ + 1024;
constexpr int GL_END = GL_GA + 4096;
static_assert(GL_END <= 131072, "gla lds");

__device__ __forceinline__ float fast_log_sigmoid(float z) { return fminf(z, 0.f) - __logf(1.f + __expf(-fabsf(z))); }
__device__ __forceinline__ void gla_decay(const P& p, int l, int h, size_t tok0, LAS unsigned char* lds, int lane, int wave) {
    const float* sm = WSP(float, WS_SM);
    float w[16];
#pragma unroll
    for (int r = 0; r < 16; ++r) w[r] = p.w_alpha_up[((size_t)l * 16 + r) * 256 + h * 64 + lane];
    const float bias = p.b_alpha[l * 256 + h * 64 + lane];
    LAS f32x4* gat = (LAS f32x4*)(lds + GL_GA + wave * 512);
    if (lane < 32) gat[lane] = *(const f32x4*)(sm + (tok0 + wave * 8 + (lane >> 2)) * 32 + 8 + 4 * (lane & 3));
    float bl[8]; float run = 0.f;
#pragma unroll
    for (int j = 0; j < 8; ++j) {
        float z = bias;
#pragma unroll
        for (int r4 = 0; r4 < 4; ++r4) { const f32x4 g4 = gat[j * 4 + r4]; z += g4.x * w[4 * r4] + g4.y * w[4 * r4 + 1] + g4.z * w[4 * r4 + 2] + g4.w * w[4 * r4 + 3]; }
        run += fast_log_sigmoid(z) * (1.0f / 16.0f); bl[j] = run;
    }
    LAS float* tot = (LAS float*)(lds + GL_TOT);
    tot[wave * 64 + lane] = run;
    __syncthreads();
    float pre = 0.f;
#pragma unroll
    for (int g = 0; g < 8; ++g) { const float t = tot[g * 64 + lane]; if (g < wave) pre += t; }
    LAS float* Bm = (LAS float*)(lds + GL_B);
#pragma unroll
    for (int j = 0; j < 8; ++j) Bm[(wave * 8 + j) * 64 + lane] = bl[j] + pre;
    __syncthreads();
}
__device__ __forceinline__ void gla_load_v(const bf16* proj, size_t tok0, int h, LAS unsigned char* lds, int tid) {
#pragma unroll
    for (int i = 0; i < 2; ++i) { const int idx = tid + NTHR * i, t = idx >> 4, c = idx & 15;
        *(LAS v4u*)(lds + GL_V + t * 320 + c * 16) = *(const v4u*)(proj + (tok0 + t) * PW + C_GV + h * 128 + c * 8); }
}
__device__ __forceinline__ bf16x8 tr_frag(const LAS unsigned char* a0, int rowstride4) {
    const v4i16_t lo = __builtin_amdgcn_ds_read_tr16_b64_v4i16((LAS v4i16_t*)a0);
    const v4i16_t hi = __builtin_amdgcn_ds_read_tr16_b64_v4i16((LAS v4i16_t*)(a0 + rowstride4));
    return (bf16x8){lo[0], lo[1], lo[2], lo[3], hi[0], hi[1], hi[2], hi[3]};
}
__device__ __forceinline__ void gla_phase_a(const P& p, int l, LAS unsigned char* lds, int vcu, int G) {
    int tid = threadIdx.x; asm volatile("" : "+v"(tid));
    const int lane = tid & 63, wave = __builtin_amdgcn_readfirstlane(tid >> 6), hh = lane >> 5;
    const bf16* proj = WSP(bf16, WS_PROJ); float* loc = ((float*)p.out); float* dec = WSP(float, WS_GDEC); const float* sm = WSP(float, WS_SM); float* gb = WSP(float, WS_GB);
    LAS unsigned char* kd = lds + wave * 16384; LAS unsigned char* vh = kd + 8192;
    const int crow8 = lane >> 3, cch = lane & 7;
    const int trow = (lane & 15) >> 2, tcol = 16 * ((lane >> 4) & 1) + 4 * (lane & 3);
    for (int u = vcu * NWAVES + wave; u < 2048; u += G * NWAVES) {
        const int c = u & 31, h = (u >> 5) & 3, b = u >> 7;
        const size_t tok0 = (size_t)b * SEQ + c * 64;
        v4u kreg[8], v0reg[8], v1reg[8];
#pragma unroll
        for (int i = 0; i < 8; ++i) { const bf16* rp = proj + (tok0 + i * 8 + crow8) * PW;
            kreg[i] = *(const v4u*)(rp + C_GK + h * 64 + cch * 8); v0reg[i] = *(const v4u*)(rp + C_GV + h * 128 + cch * 8); v1reg[i] = *(const v4u*)(rp + C_GV + h * 128 + 64 + cch * 8); }
        float w[16];
#pragma unroll
        for (int r = 0; r < 16; ++r) w[r] = p.w_alpha_up[((size_t)l * 16 + r) * 256 + h * 64 + lane];
        const float bias = p.b_alpha[l * 256 + h * 64 + lane];
        { LAS f32x4* gw = (LAS f32x4*)vh;
#pragma unroll
          for (int i = 0; i < 4; ++i) gw[lane * 4 + i] = *(const f32x4*)(sm + (tok0 + lane) * 32 + 8 + 4 * i); }
        float bt[64]; float run = 0.f;
#pragma unroll
        for (int t = 0; t < 64; ++t) {
            float z = bias;
#pragma unroll
            for (int r4 = 0; r4 < 4; ++r4) { const f32x4 g4 = ((const LAS f32x4*)vh)[t * 4 + r4]; z += g4.x * w[4 * r4] + g4.y * w[4 * r4 + 1] + g4.z * w[4 * r4 + 2] + g4.w * w[4 * r4 + 3]; }
            run += fast_log_sigmoid(z) * (1.0f / 16.0f); bt[t] = run; gb[(tok0 + t) * 256 + h * 64 + lane] = run;
        }
#pragma unroll
        for (int i = 0; i < 8; ++i) { *(LAS v4u*)(kd + (i * 8 + crow8) * 128 + cch * 16) = kreg[i]; *(LAS v4u*)(vh + (i * 8 + crow8) * 128 + cch * 16) = v0reg[i]; }
#pragma unroll
        for (int t = 0; t < 64; ++t) { LAS bf16* kp = (LAS bf16*)(kd + t * 128 + lane * 2); *kp = (bf16)f2bf(bf2f(*kp) * __expf(run - bt[t])); }
        dec[(size_t)u * 64 + lane] = __expf(run);
#pragma unroll
        for (int half = 0; half < 2; ++half) {
            if (half == 1) {
#pragma unroll
                for (int i = 0; i < 8; ++i) *(LAS v4u*)(vh + (i * 8 + crow8) * 128 + cch * 16) = v1reg[i];
            }
            f32x16 acc[2][2];
#pragma unroll
            for (int x = 0; x < 2; ++x)
#pragma unroll
                for (int y = 0; y < 2; ++y) acc[x][y] = f32x16{};
#pragma unroll
            for (int s = 0; s < 4; ++s) {
                bf16x8 af[2], bfr[2];
#pragma unroll
                for (int x = 0; x < 2; ++x) { af[x] = tr_frag(vh + (16 * s + 8 * hh + trow) * 128 + (32 * x + tcol) * 2, 4 * 128); bfr[x] = tr_frag(kd + (16 * s + 8 * hh + trow) * 128 + (32 * x + tcol) * 2, 4 * 128); }
#pragma unroll
                for (int x = 0; x < 2; ++x)
#pragma unroll
                    for (int y = 0; y < 2; ++y) acc[x][y] = __builtin_amdgcn_mfma_f32_32x32x16_bf16(af[x], bfr[y], acc[x][y], 0, 0, 0);
            }
#pragma unroll
            for (int x = 0; x < 2; ++x)
#pragma unroll
                for (int y = 0; y < 2; ++y) { float* lo = loc + (size_t)u * 8192 + 32 * y + (lane & 31);
#pragma unroll
                    for (int r = 0; r < 16; ++r) lo[(size_t)(64 * half + 32 * x + (r & 3) + 8 * (r >> 2) + 4 * hh) * 64] = acc[x][y][r]; }
        }
    }
}
__device__ __forceinline__ void gla_phase_b(const P& p, int vcu, int G) {
    int tid = threadIdx.x; asm volatile("" : "+v"(tid));
    float* loc = ((float*)p.out); const float* dec = WSP(float, WS_GDEC);
    for (int u = vcu; u < 256; u += G) {
        const int bh = u >> 2, q4 = u & 3;
        const int e = q4 * 2048 + tid * 4, dk = e & 63;
        f32x4 st = {0.f, 0.f, 0.f, 0.f};
#pragma unroll 2
        for (int c = 0; c < 32; ++c) {
            const size_t cu = (size_t)bh * 32 + c;
            const f32x4 lv = *(const f32x4*)(loc + cu * 8192 + e);
            const f32x4 dv = *(const f32x4*)(dec + cu * 64 + dk);
            asm volatile("s_waitcnt vmcnt(0)" ::: "memory");
            __syncthreads();
            v2u w; w.x = pk2(st.x, st.y); w.y = pk2(st.z, st.w);
            *(v2u*)((unsigned char*)loc + cu * 32768 + 8192 * q4 + 8 * tid) = w;
            st = dv * st + lv;
        }
    }
}
__device__ __forceinline__ void gla_phase_c(const P& p, int l, LAS unsigned char* lds, int vcu, int G) {
    int tid = threadIdx.x; asm volatile("" : "+v"(tid));
    const int lane = tid & 63, wave = __builtin_amdgcn_readfirstlane(tid >> 6), hh = lane >> 5, r32 = lane & 31;
    const bf16* proj = WSP(bf16, WS_PROJ); const unsigned char* gs = ((const unsigned char*)p.out); bf16* y = WSP(bf16, WS_Y); const float* gb = WSP(const float, WS_GB);
    const int dvb = wave >> 1, tb = wave & 1;
    const int trow = (lane & 15) >> 2, tcol = 16 * ((lane >> 4) & 1) + 4 * (lane & 3);
    bf16 n_q[8], n_k[8]; v4u n_v[2]; bf16x8 n_s[4]; v2u n_g[4]; f32x4 n_n[4]; float n_b[8], n_r = 0.f;
#define GC_LOAD(uu) do { const int c_ = (uu) & 31, h_ = ((uu) >> 5) & 3, b_ = (uu) >> 7; const size_t t0_ = (size_t)b_ * SEQ + c_ * 64; \
        _Pragma("unroll") for (int j = 0; j < 8; ++j) { const bf16* rp = proj + (t0_ + wave * 8 + j) * PW + h_ * 64 + lane; n_q[j] = rp[C_GQ]; n_k[j] = rp[C_GK]; } \
        _Pragma("unroll") for (int i = 0; i < 2; ++i) { const int idx = tid + NTHR * i, t = idx >> 4, cc = idx & 15; n_v[i] = *(const v4u*)(proj + (t0_ + t) * PW + C_GV + h_ * 128 + cc * 8); } \
        { const bf16* sp = (const bf16*)(gs + (size_t)(uu) * 32768 + 8192 * dvb) + r32 * 64 + 8 * hh; \
          _Pragma("unroll") for (int s2 = 0; s2 < 4; ++s2) n_s[s2] = *(const bf16x8*)(sp + 16 * s2); } \
        _Pragma("unroll") for (int j = 0; j < 8; ++j) n_b[j] = gb[(t0_ + wave * 8 + j) * 256 + h_ * 64 + lane]; \
        n_r = gb[(t0_ + 31) * 256 + h_ * 64 + lane]; \
        _Pragma("unroll") for (int g = 0; g < 4; ++g) { const int dv = 32 * dvb + 8 * g + 4 * hh; \
            n_n[g] = *(const f32x4*)(p.gla_gain + l * 512 + h_ * 128 + dv); n_g[g] = *(const v2u*)(proj + (t0_ + 32 * tb + r32) * PW + C_GG + h_ * 128 + dv); } } while (0)
    if (vcu < 2048) GC_LOAD(vcu);
    for (int u = vcu; u < 2048; u += G) {
        const int c = u & 31, h = (u >> 5) & 3, b = u >> 7;
        const size_t tok0 = (size_t)b * SEQ + c * 64;
        bf16x8 sfr[4]; v2u ggr[4]; f32x4 gnr[4];
#pragma unroll
        for (int i = 0; i < 4; ++i) { sfr[i] = n_s[i]; ggr[i] = n_g[i]; gnr[i] = n_n[i]; }
#pragma unroll
        for (int i = 0; i < 2; ++i) { const int idx = tid + NTHR * i, t = idx >> 4, cc = idx & 15; *(LAS v4u*)(lds + GL_V + t * 320 + cc * 16) = n_v[i]; }
        { const float rref = n_r;
#pragma unroll
          for (int j = 0; j < 8; ++j) { const int t = wave * 8 + j; const float bt = n_b[j];
            const float qv = bf2f(n_q[j]), kv = bf2f(n_k[j]);
            *(LAS bf16*)(lds + GL_Q1 + t * 144 + lane * 2) = (bf16)f2bf(qv * __expf(bt));
            *(LAS bf16*)(lds + GL_Q2 + t * 144 + lane * 2) = (bf16)f2bf(qv * __expf(bt - rref));
            *(LAS bf16*)(lds + GL_K2 + t * 144 + lane * 2) = (bf16)f2bf(kv * __expf(rref - bt)); } }
        __syncthreads();
        if (u + G < 2048) GC_LOAD(u + G);
        f32x16 o = {};
        {
#pragma unroll
          for (int s = 0; s < 4; ++s) { const bf16x8 af = sfr[s]; const bf16x8 bq = *(const LAS bf16x8*)(lds + GL_Q1 + (32 * tb + r32) * 144 + (16 * s + 8 * hh) * 2);
              o = __builtin_amdgcn_mfma_f32_32x32x16_bf16(af, bq, o, 0, 0, 0); } }
#pragma unroll
        for (int sb = 0; sb < 2; ++sb) {
            if (sb <= tb) {
                f32x16 pt = {};
#pragma unroll
                for (int s = 0; s < 4; ++s) { const bf16x8 ak = *(const LAS bf16x8*)(lds + GL_K2 + (32 * sb + r32) * 144 + (16 * s + 8 * hh) * 2); const bf16x8 bq = *(const LAS bf16x8*)(lds + GL_Q2 + (32 * tb + r32) * 144 + (16 * s + 8 * hh) * 2);
                    pt = __builtin_amdgcn_mfma_f32_32x32x16_bf16(ak, bq, pt, 0, 0, 0); }
                if (sb == tb) {
#pragma unroll
                    for (int r = 0; r < 16; ++r) { const int s_ = (r & 3) + 8 * (r >> 2) + 4 * hh; if (s_ > r32) pt[r] = 0.f; }
                }
#pragma unroll
                for (int ks = 0; ks < 2; ++ks) {
                    const bf16x8 pa = pack8(pt, 8 * ks);
                    const bf16x8 vf = tr_frag(lds + GL_V + (32 * sb + 16 * ks + 4 * hh + trow) * 320 + (32 * dvb + tcol) * 2, 8 * 320);
                    o = __builtin_amdgcn_mfma_f32_32x32x16_bf16(vf, pa, o, 0, 0, 0);
                }
            }
        }
        float ss = 0.f;
#pragma unroll
        for (int r = 0; r < 16; ++r) ss += o[r] * o[r];
        ss += __shfl_xor(ss, 32);
        LAS float* sq = (LAS float*)(lds + GL_SSQ);
        if (hh == 0) sq[dvb * 64 + 32 * tb + r32] = ss;
        __syncthreads();
        const int t = 32 * tb + r32;
        const float tot = (sq[t] + sq[64 + t]) + (sq[128 + t] + sq[192 + t]);
        const float rs = rsqrtf(tot * (1.0f / 128.0f) + EPS);
        const size_t tok = tok0 + t;
#pragma unroll
        for (int g = 0; g < 4; ++g) {
            const int dv = 32 * dvb + 8 * g + 4 * hh;
            const f32x4 gn = gnr[g];
            const v2u gg = ggr[g];
            const float g0 = bf2f((bf16)(gg.x & 0xffff)), g1 = bf2f((bf16)(gg.x >> 16)), g2 = bf2f((bf16)(gg.y & 0xffff)), g3 = bf2f((bf16)(gg.y >> 16));
            const float v0 = o[4 * g] * rs * gn.x * g0 * __builtin_amdgcn_rcpf(1.f + __expf(-g0)), v1 = o[4 * g + 1] * rs * gn.y * g1 * __builtin_amdgcn_rcpf(1.f + __expf(-g1));
            const float v2 = o[4 * g + 2] * rs * gn.z * g2 * __builtin_amdgcn_rcpf(1.f + __expf(-g2)), v3 = o[4 * g + 3] * rs * gn.w * g3 * __builtin_amdgcn_rcpf(1.f + __expf(-g3));
            v2u w; w.x = cvtpk(v0, v1); w.y = cvtpk(v2, v3);
            st_b64(y + tok * DM + 512 + h * 128 + dv, w);
        }
        __syncthreads();
    }
#undef GC_LOAD
}
__device__ __forceinline__ void fox_cumsum_phase(const P& p, int l, int vcu, int G) {
    int tid = threadIdx.x; asm volatile("" : "+v"(tid));
    const int lane = tid & 63, wave = __builtin_amdgcn_readfirstlane(tid >> 6);
    const float* sm = WSP(float, WS_SM); float* cb = WSP(float, WS_CB);
    for (int u = vcu * NWAVES + wave; u < NBATCH * 8; u += G * NWAVES) {
        const int b = u >> 3, h = u & 7;
        const float bias = p.b_forget[l * 8 + h];
        float v[32]; float run = 0.f;
#pragma unroll
        for (int j = 0; j < 32; ++j) { run += fast_log_sigmoid(sm[((size_t)b * SEQ + lane * 32 + j) * 32 + h] + bias); v[j] = run; }
        float pre = run;
#pragma unroll
        for (int o = 1; o < 64; o <<= 1) { const float t = __shfl_up(pre, o); if (lane >= o) pre += t; }
        pre -= run;
#pragma unroll
        for (int j = 0; j < 32; ++j) cb[((size_t)b * 8 + h) * SEQ + lane * 32 + j] = -(v[j] + pre) * LOG2E;
    }
}

__device__ __forceinline__ void fox_knorm_phase(const P& p, int vcu, int G) {
    int tid = threadIdx.x; asm volatile("" : "+v"(tid));
    const int lane = tid & 63, wave = __builtin_amdgcn_readfirstlane(tid >> 6);
    const bf16* proj = WSP(bf16, WS_PROJ); float* kn = WSP(float, WS_MOE + MO_KN);
    for (int task = vcu * NWAVES + wave; task < NBATCH * 8 * 32; task += G * NWAVES) {
        const int j = task & 31, h = (task >> 5) & 7, b = task >> 8;
        float mx = 0.f;
#pragma unroll
        for (int i = 0; i < 8; ++i) {
            const v4u w = *(const v4u*)(proj + ((size_t)b * SEQ + j * 64 + i * 8 + (lane >> 3)) * PW + C_FK + h * 64 + (lane & 7) * 8);
            const unsigned ww[4] = {w.x, w.y, w.z, w.w}; float ss = 0.f;
#pragma unroll
            for (int e = 0; e < 4; ++e) { const float a = __builtin_bit_cast(float, ww[e] << 16), c = __builtin_bit_cast(float, ww[e] & 0xffff0000u); ss += a * a + c * c; }
            ss += __shfl_xor(ss, 1); ss += __shfl_xor(ss, 2); ss += __shfl_xor(ss, 4);
            mx = fmaxf(mx, ss);
        }
        mx = wave_max(mx);
        if (lane == 0) kn[task] = sqrtf(mx) * 1.0001f;
    }
}
__device__ __forceinline__ void router_weights(const P& p, int gtid, int gstride) {
    for (int idx = gtid; idx < NLAYER * 32768; idx += gstride) {
        const int l = idx >> 15, r = idx & 32767, k = r >> 5, n = r & 31;
        float v = 0.f;
        if (n < 16) v = p.w_re[((size_t)l * DM + k) * 16 + n]; else if (n < 20) v = p.w_rg[((size_t)l * DM + k) * 4 + (n - 16)];
        v *= p.moe_norm[l * DM + k];
        float* wr = (float*)(ws_base(p.ws) + WS_W + (size_t)l * WS_WLAYER + WO_RHI);
        wr[(((k >> 4) * 4 + ((k >> 2) & 3)) * 32 + n) * 4 + (k & 3)] = v;
    }
}
__device__ __forceinline__ void route_phase(const P& p, int l, LAS unsigned char* lds, int vcu, int G) {
    int tid = threadIdx.x; asm volatile("" : "+v"(tid));
    const int lane = tid & 63, wave = __builtin_amdgcn_readfirstlane(tid >> 6);
    { const v4u* src = (const v4u*)(ws_base(p.ws) + WS_W + (size_t)l * WS_WLAYER + WO_RHI);
#pragma unroll 4
      for (int i = 0; i < 16; ++i) *(LAS v4u*)(lds + LDS_STAGE + (tid + NTHR * i) * 16) = src[tid + NTHR * i]; }
    LAS int* hist = (LAS int*)(lds + LDS_GATE);
    if (tid < 32) hist[tid] = 0;
    __syncthreads();
    const bf16* HBp = WSP(const bf16, WS_HB);
    int2* toke = WSP(int2, WS_MOE + MO_TOKE); float2* tokg = WSP(float2, WS_MOE + MO_TOKG);
    LAS float* lgb = (LAS float*)(lds + LDS_RS + wave * 2048);
    const int r = lane & 15, kq = lane >> 4;
    for (int task = vcu * NWAVES + wave; task < NTOK / 16; task += G * NWAVES) {
        const int tok0 = task * 16;
        const v2u* hp = (const v2u*)(HBp + (size_t)(tok0 + r) * DM + 4 * kq);
        f32x4 acc0 = {0.f, 0.f, 0.f, 0.f}, acc1 = {0.f, 0.f, 0.f, 0.f}; float q = 0.f;
#pragma unroll 8
        for (int s = 0; s < 64; ++s) {
            const v2u aw = hp[4 * s]; f32x4 a; a.x = __builtin_bit_cast(float, aw.x << 16); a.y = __builtin_bit_cast(float, aw.x & 0xffff0000u); a.z = __builtin_bit_cast(float, aw.y << 16); a.w = __builtin_bit_cast(float, aw.y & 0xffff0000u);
            const f32x4 b0 = *(const LAS f32x4*)(lds + LDS_STAGE + ((s * 4 + kq) * 32 + r) * 16);
            const f32x4 b1 = *(const LAS f32x4*)(lds + LDS_STAGE + ((s * 4 + kq) * 32 + 16 + r) * 16);
            q += (a.x * a.x + a.y * a.y) + (a.z * a.z + a.w * a.w);
            acc0 = __builtin_amdgcn_mfma_f32_16x16x4f32(a.x, b0.x, acc0, 0, 0, 0); acc1 = __builtin_amdgcn_mfma_f32_16x16x4f32(a.x, b1.x, acc1, 0, 0, 0);
            acc0 = __builtin_amdgcn_mfma_f32_16x16x4f32(a.y, b0.y, acc0, 0, 0, 0); acc1 = __builtin_amdgcn_mfma_f32_16x16x4f32(a.y, b1.y, acc1, 0, 0, 0);
            acc0 = __builtin_amdgcn_mfma_f32_16x16x4f32(a.z, b0.z, acc0, 0, 0, 0); acc1 = __builtin_amdgcn_mfma_f32_16x16x4f32(a.z, b1.z, acc1, 0, 0, 0);
            acc0 = __builtin_amdgcn_mfma_f32_16x16x4f32(a.w, b0.w, acc0, 0, 0, 0); acc1 = __builtin_amdgcn_mfma_f32_16x16x4f32(a.w, b1.w, acc1, 0, 0, 0);
        }
        q += __shfl_xor(q, 16); q += __shfl_xor(q, 32);
        const float rsv = rsqrtf(q * (1.0f / DM) + EPS);
        const float bias0 = p.b_re[l * 16 + r], bias1 = r < 4 ? p.b_rg[l * 4 + r] : 0.f;
#pragma unroll
        for (int g = 0; g < 4; ++g) { const int row = 4 * kq + g; const float rs = __shfl(rsv, row);
            lgb[row * 32 + r] = acc0[g] * rs + bias0; lgb[row * 32 + 16 + r] = acc1[g] * rs + bias1; }
        LDS_WAIT();
        if (lane < 16) {
            const int tok = tok0 + lane;
            const LAS f32x4* lr = (const LAS f32x4*)(lgb + lane * 32);
            const f32x4 e0 = lr[0], e1 = lr[1], e2 = lr[2], e3 = lr[3], gl = lr[4];
            int g = 0; float gm = gl.x;
            if (gl.y > gm) { gm = gl.y; g = 1; } if (gl.z > gm) { gm = gl.z; g = 2; } if (gl.w > gm) { gm = gl.w; g = 3; }
            const float den = (expf(gl.x - gm) + expf(gl.y - gm)) + (expf(gl.z - gm) + expf(gl.w - gm));
            const float pg = 1.0f / den;
            const f32x4 el = g == 0 ? e0 : (g == 1 ? e1 : (g == 2 ? e2 : e3));
            int i0 = 0; float m0 = el.x;
            if (el.y > m0) { m0 = el.y; i0 = 1; } if (el.z > m0) { m0 = el.z; i0 = 2; } if (el.w > m0) { m0 = el.w; i0 = 3; }
            int i1 = -1; float m1 = -INFINITY;
            if (i0 != 0 && el.x > m1) { m1 = el.x; i1 = 0; } if (i0 != 1 && el.y > m1) { m1 = el.y; i1 = 1; }
            if (i0 != 2 && el.z > m1) { m1 = el.z; i1 = 2; } if (i0 != 3 && el.w > m1) { m1 = el.w; i1 = 3; }
            const float ex = expf(m1 - m0), inv = 1.0f / (1.0f + ex);
            const int ea = g * 4 + i0, eb = g * 4 + i1;
            toke[tok] = make_int2(ea, eb); tokg[tok] = make_float2(pg * inv, pg * ex * inv);
            atomicAdd((int*)&hist[ea], 1); atomicAdd((int*)&hist[16 + eb], 1);
        }
        LDS_WAIT();
    }
    __syncthreads();
    if (tid < 32) WSP(int, WS_MOE + MO_HIST)[vcu * 32 + tid] = hist[tid];
}
__device__ __forceinline__ void sort_phase(const P& p, LAS unsigned char* lds, int vcu, int G) {
    int tid = threadIdx.x; asm volatile("" : "+v"(tid));
    const int lane = tid & 63, wave = __builtin_amdgcn_readfirstlane(tid >> 6);
    LAS int* cnt = (LAS int*)(lds + LDS_GATE); LAS int* pre = cnt + 32; LAS int* base = cnt + 64; LAS int* ntl = cnt + 96;
    const int* histg = WSP(const int, WS_MOE + MO_HIST);
    int* rowtok = WSP(int, WS_MOE + MO_ROWTOK); float* rowgate = WSP(float, WS_MOE + MO_ROWGATE); int* tilee = WSP(int, WS_MOE + MO_TILEE); int* nt = WSP(int, WS_MOE + MO_NT);
    const int2* toke = WSP(const int2, WS_MOE + MO_TOKE); const float2* tokg = WSP(const float2, WS_MOE + MO_TOKG);
    { LAS int* part = (LAS int*)(lds + LDS_RS);
      const int j = tid & 31, part_i = tid >> 5; int c = 0, pr = 0;
      for (int w = part_i; w < G; w += 16) { const int v = histg[w * 32 + j]; if (w < vcu) pr += v; c += v; }
      part[part_i * 64 + j] = c; part[part_i * 64 + 32 + j] = pr;
      __syncthreads();
      if (tid < 32) { int cc = 0, pp = 0;
#pragma unroll
          for (int q = 0; q < 16; ++q) { cc += part[q * 64 + tid]; pp += part[q * 64 + 32 + tid]; }
          cnt[tid] = cc; pre[tid] = pp; } }
    __syncthreads();
    if (tid == 0) { int t = 0; for (int j = 0; j < 32; ++j) { base[j] = t * 256; const int n = (cnt[j] + 255) >> 8; ntl[j] = n; t += n; if (j == 15 && vcu == 0) nt[0] = t; } if (vcu == 0) nt[1] = t; }
    __syncthreads();
    if (vcu == 0 && tid < 32) { const int t0 = base[tid] >> 8; for (int i = 0; i < ntl[tid]; ++i) tilee[t0 + i] = tid & 15; }
    if (vcu < 32) { const int j = vcu, lo = base[j] + cnt[j], hi = base[j] + 256 * ntl[j]; for (int r = lo + tid; r < hi; r += NTHR) { rowtok[r] = -1; rowgate[r] = 0.f; } }
    if (wave < 2) {
        const int k = wave;
        int run[16];
#pragma unroll
        for (int e = 0; e < 16; ++e) run[e] = 0;
        for (int task0 = vcu * NWAVES; task0 < NTOK / 16; task0 += G * NWAVES) {
#pragma unroll 1
            for (int half = 0; half < 2; ++half) {
                const int tok = task0 * 16 + half * 64 + lane;
                const int2 ee = toke[tok]; const float2 gg = tokg[tok];
                const int e = k ? ee.y : ee.x; const float gt = k ? gg.y : gg.x;
                int rank = 0;
#pragma unroll
                for (int x = 0; x < 16; ++x) { const unsigned long long m = __ballot(e == x); if (e == x) rank = run[x] + __popcll(m & ((1ull << lane) - 1ull)); run[x] += __popcll(m); }
                const int pos = base[k * 16 + e] + pre[k * 16 + e] + rank;
                rowtok[pos] = tok; rowgate[pos] = gt;
            }
        }
    }
}
__device__ __forceinline__ void final_phase(const P& p, int vcu, int G) {
    int tid = threadIdx.x; asm volatile("" : "+v"(tid));
    const int lane = tid & 63, wave = __builtin_amdgcn_readfirstlane(tid >> 6);
    const float* ssq = WSP(const float, WS_SSQ); const bf16* hb = WSP(const bf16, WS_HB);
    f32x4 g[4];
#pragma unroll
    for (int j = 0; j < 4; ++j) g[j] = ((const f32x4*)p.final_norm)[lane + 64 * j];
    for (int m0 = (vcu * NWAVES + wave) * 4; m0 < NTOK; m0 += G * NWAVES * 4) {
        v2u w[4][4]; float rs[4];
#pragma unroll
        for (int r = 0; r < 4; ++r) { rs[r] = row_rs(ssq, m0 + r);
#pragma unroll
            for (int j = 0; j < 4; ++j) w[r][j] = ((const v2u*)(hb + (size_t)(m0 + r) * DM))[lane + 64 * j]; }
#pragma unroll
        for (int r = 0; r < 4; ++r) { f32x4* s = (f32x4*)(p.out + (size_t)(m0 + r) * DM) + lane;
#pragma unroll
            for (int j = 0; j < 4; ++j) { f32x4 v; v.x = __builtin_bit_cast(float, w[r][j].x << 16); v.y = __builtin_bit_cast(float, w[r][j].x & 0xffff0000u); v.z = __builtin_bit_cast(float, w[r][j].y << 16); v.w = __builtin_bit_cast(float, w[r][j].y & 0xffff0000u);
                s[64 * j] = v * rs[r] * g[j]; } }
    }
}
#ifndef ENMASK
#define ENMASK 0xffffffffu
#endif
#define EN(b) (((ENMASK) >> (b)) & 1u)
#ifndef REPMASK
#define REPMASK 0u
#endif
#define REPN(b) ((((REPMASK) >> (b)) & 1u) ? 2 : 1)
__device__ __attribute__((noinline)) void grid_barrier(unsigned* barw, unsigned x, volatile LAS unsigned* st) { XcdBarrier b; b.bar = barw; b.x = x; b.st = st; xcd_barrier(b); }
__global__ void __launch_bounds__(NTHR, 2) fwd(Args args) {
    extern __shared__ __attribute__((aligned(16))) unsigned char lds_raw[];
    LAS unsigned char* lds = (LAS unsigned char*)lds_raw;
    const P& p = args.p;
    const int tid = threadIdx.x, lane = tid & 63, wave = __builtin_amdgcn_readfirstlane(tid >> 6);
    const int G = gridDim.x; const int bx = blockIdx.x; const int vcu = (G % 8 == 0) ? (bx % 8) * (G / 8) + bx / 8 : bx;
    volatile LAS unsigned* MISC = (volatile LAS unsigned*)(lds + LDS_MISC);
    if (tid < 64) MISC[tid] = 0u;
    __syncthreads();
    unsigned* ctl = (unsigned*)(p.ws + WS_CTL);
    const int lo = args.ph_lo, hi = args.ph_hi;
    XcdBarrier bar; bar.bar = ctl + CW_BAR + args.li * XCD_BAR_WORDS; bar.x = 0; bar.st = nullptr;
    if (hi - lo > 1) bar = xcd_barrier_post(ctl + CW_BAR + args.li * XCD_BAR_WORDS, MISC);
#define IN(k) (lo <= (k) && (k) < hi)
#define PHL int vcuL = vcu, GL = G, bxL = bx; asm volatile("" : "+s"(vcuL), "+s"(GL), "+s"(bxL)); (void)vcuL; (void)GL; (void)bxL;
#define LTID(v) int v = threadIdx.x; asm volatile("" : "+v"(v))
#define FILL_RS_DENSE() do { LTID(tq); const int rr_ = tq & 255, hf_ = tq >> 8; f32x4 sv_[4][4]; bool ok_[4]; \
        _Pragma("unroll") for (int k_ = 0; k_ < 4; ++k_) { pg8::Unit u_; ok_[k_] = S.next(hf_ + 2 * k_, u_); const f32x4* sp_ = (const f32x4*)(SSQ + (size_t)(ok_[k_] ? u_.pm * 256 + rr_ : 0) * 16); \
            _Pragma("unroll") for (int j_ = 0; j_ < 4; ++j_) sv_[k_][j_] = sp_[j_]; } \
        _Pragma("unroll") for (int k_ = 0; k_ < 4; ++k_) if (ok_[k_]) { const f32x4 a_ = (sv_[k_][0] + sv_[k_][1]) + (sv_[k_][2] + sv_[k_][3]); rstab[(hf_ + 2 * k_) * 256 + rr_] = rsqrtf(((a_.x + a_.y) + (a_.z + a_.w)) * (1.0f / DM) + EPS); } } while (0)
#define FILL_GU() do { LTID(tq); const int rr_ = tq & 255, hf_ = tq >> 8; f32x4 sv_[4][4]; bool ok_[4]; int tk_[4]; \
        _Pragma("unroll") for (int k_ = 0; k_ < 4; ++k_) { pg8::Unit u_; ok_[k_] = S.next(hf_ + 2 * k_, u_); tk_[k_] = ok_[k_] ? ROWTOK[u_.pm * 256 + rr_] : 0; } \
        _Pragma("unroll") for (int k_ = 0; k_ < 4; ++k_) { tk_[k_] = tk_[k_] < 0 ? 0 : tk_[k_]; const f32x4* sp_ = (const f32x4*)(SSQ + (size_t)tk_[k_] * 16); \
            _Pragma("unroll") for (int j_ = 0; j_ < 4; ++j_) sv_[k_][j_] = sp_[j_]; } \
        _Pragma("unroll") for (int k_ = 0; k_ < 4; ++k_) if (ok_[k_]) { const f32x4 a_ = (sv_[k_][0] + sv_[k_][1]) + (sv_[k_][2] + sv_[k_][3]); rowtab[(hf_ + 2 * k_) * 256 + rr_] = tk_[k_]; \
            rstab[(hf_ + 2 * k_) * 256 + rr_] = rsqrtf(((a_.x + a_.y) + (a_.z + a_.w)) * (1.0f / DM) + EPS); } } while (0)
#define FILL_DOWN() do { LTID(tq); const int rr_ = tq & 255, hf_ = tq >> 8; bool ok_[4]; int tk_[4]; float gt_[4]; \
        _Pragma("unroll") for (int k_ = 0; k_ < 4; ++k_) { pg8::Unit u_; ok_[k_] = S.next(hf_ + 2 * k_, u_); const int r_ = ok_[k_] ? u_.pm * 256 + rr_ : 0; tk_[k_] = ROWTOK[r_]; gt_[k_] = ROWGATE[r_]; } \
        _Pragma("unroll") for (int k_ = 0; k_ < 4; ++k_) if (ok_[k_]) { rowtab[(hf_ + 2 * k_) * 256 + rr_] = tk_[k_]; gatetab[(hf_ + 2 * k_) * 256 + rr_] = gt_[k_]; } } while (0)

#define SEAM(k) do { if (IN(k) && IN((k) + 1)) { grid_barrier(bar.bar, bar.x, bar.st); if (REPN(20) == 2) grid_barrier(bar.bar, bar.x, bar.st); } } while (0)
    LAS float* rstab = (LAS float*)(lds + LDS_RS); LAS int* rowtab = (LAS int*)(lds + LDS_ROWTOK); LAS float* gatetab = (LAS float*)(lds + LDS_GATE);
#define HB WSP(bf16, WS_HB)
#define PROJ WSP(bf16, WS_PROJ)
#define Y WSP(bf16, WS_Y)
#define XKV WSP(bf16, WS_XKV)
#define MEMN WSP(bf16, WS_MEMN)
#define SSQ WSP(float, WS_SSQ)
#define XQ WSP(bf16, WS_XQ)
#define U WSP(bf16, WS_U)
#define ROWTOK WSP(const int, WS_MOE + MO_ROWTOK)
#define ROWGATE WSP(const float, WS_MOE + MO_ROWGATE)
#define TILEE WSP(const int, WS_MOE + MO_TILEE)
#define NT WSP(const int, WS_MOE + MO_NT)
#define H (p.out)
#define HB8 ((unsigned char*)p.out + 64 * MiB)
#define U8 WSP(unsigned char, WS_U)

    if (EN(0) && IN(PH_PRO)) _Pragma("unroll 1") for (int rep_ = 0; rep_ < REPN(0); ++rep_) { PHL prologue(p, lds, vcuL, GL, wave, lane); }
    SEAM(PH_PRO);
    if (REPN(18) == 2 && IN(PH_XKV)) { PHL
        pg8::StaticOrder S; S.init(HB, ws_base(p.ws) + WS_W + WO_IN, NTOK, 3072, DM, GL, bxL);
        FILL_RS_DENSE();
        __syncthreads();
        EpiBf16<true> E{PROJ, PW, rstab};
        pg8::gemm_phase<DM, EpiBf16<true>, pg8::StaticOrder, true>(lds + LDS_STAGE, S, E);
    }
    for (int l = 0; l < NLAYER; ++l) {
        const int pb = PH_L0 + l * NPH;
        unsigned char* wl = ws_base(p.ws) + WS_W + (size_t)l * WS_WLAYER;
        if (EN(2) && IN(pb + LP_INPROJ)) _Pragma("unroll 1") for (int rep_ = 0; rep_ < REPN(2); ++rep_) { PHL
            pg8::StaticOrder S; S.init(HB, wl + WO_IN, NTOK, 3072, DM, GL, bxL);
            FILL_RS_DENSE();
            __syncthreads();
            EpiBf16<true> E{PROJ, PW, rstab};
            pg8::gemm_phase<DM, EpiBf16<true>, pg8::StaticOrder, true>(lds + LDS_STAGE, S, E);
            _Pragma("unroll 1") for (int r2_ = 0; r2_ < REPN(19); ++r2_) small_proj(p, l, lds + LDS_STAGE, vcuL, GL, wave, lane);
        }
        SEAM(pb + LP_INPROJ);
        if (EN(11) && IN(pb + LP_MIXA)) _Pragma("unroll 1") for (int rep_ = 0; rep_ < REPN(11); ++rep_) { PHL gla_phase_a(p, l, lds + LDS_STAGE, vcuL, GL); fox_cumsum_phase(p, l, vcuL, GL); fox_knorm_phase(p, vcuL, GL); }
        SEAM(pb + LP_MIXA);
        if (EN(12) && IN(pb + LP_MIXB)) _Pragma("unroll 1") for (int rep_ = 0; rep_ < REPN(12); ++rep_) { PHL gla_phase_b(p, vcuL, GL); }
        if (EN(1) && l == 0 && IN(pb + LP_MIXB)) { PHL
            pg8::StaticOrder S; S.init(MEMN, ws_base(p.ws) + WS_WXKV, 4096, 2048, DM, GL, bxL);
            EpiBf16<false> E{XKV, 2048, rstab};
            pg8::gemm_phase<DM, EpiBf16<false>, pg8::StaticOrder, true>(lds + LDS_STAGE, S, E);
        }
        SEAM(pb + LP_MIXB);
        if (EN(9) && IN(pb + LP_MIXC)) { PHL _Pragma("unroll 1") for (int rep_ = 0; rep_ < REPN(16); ++rep_) fox_phase(p, l, lds + LDS_STAGE, vcuL, GL); _Pragma("unroll 1") for (int rep_ = 0; rep_ < REPN(17); ++rep_) gla_phase_c(p, l, lds + LDS_STAGE, vcuL, GL); }
        SEAM(pb + LP_MIXC);
        if (EN(3) && IN(pb + LP_WOUT)) _Pragma("unroll 1") for (int rep_ = 0; rep_ < REPN(3); ++rep_) { PHL
            pg8::StaticOrder S; S.init(Y, wl + WO_OUT, NTOK, DM, DM, GL, bxL);
            EpiRes<0> E{HB, SSQ, rowtab, gatetab, rep_ == REPN(3) - 1 ? 1.f : 0.f, Y, nullptr};
            pg8::gemm_phase<DM, EpiRes<0>, pg8::StaticOrder, true>(lds + LDS_STAGE, S, E);
        }
        SEAM(pb + LP_WOUT);
        if (EN(4) && IN(pb + LP_XQ)) _Pragma("unroll 1") for (int rep_ = 0; rep_ < REPN(4); ++rep_) { PHL
            pg8::StaticOrder S; S.init(HB, wl + WO_XQ, NTOK, 512, DM, GL, bxL);
            FILL_RS_DENSE();
            __syncthreads();
            EpiBf16<true> E{XQ, 512, rstab};
            pg8::gemm_phase<DM, EpiBf16<true>, pg8::StaticOrder, true>(lds + LDS_STAGE, S, E);
            asm volatile("s_waitcnt vmcnt(0)" ::: "memory"); __syncthreads();
            { pg8::Unit u; for (int iu = 0; S.next(iu, u); ++iu) { xattn_pair(p, l, lds + LDS_STAGE, u.pm, u.pn, rep_ != REPN(4) - 1); } }
        }
        SEAM(pb + LP_XQ);
        if (EN(5) && IN(pb + LP_XO)) _Pragma("unroll 1") for (int rep_ = 0; rep_ < REPN(5); ++rep_) { PHL
            pg8::StaticOrder S; S.init(WSP(unsigned char, WS_XO8), wl + WO_XO, NTOK, DM, 256, GL, bxL);
            EpiRes<0, true> E{HB, SSQ, rowtab, gatetab, rep_ == REPN(5) - 1 ? 1.f : 0.f, Y, HB8};
            pg8::gemm_phase<256, EpiRes<0, true>, pg8::StaticOrder, true, true, 127, 122>(lds + LDS_STAGE, S, E);
        }
        SEAM(pb + LP_XO);
        if (EN(13) && IN(pb + LP_ROUTE)) _Pragma("unroll 1") for (int rep_ = 0; rep_ < REPN(13); ++rep_) { PHL route_phase(p, l, lds, vcuL, GL); }
        SEAM(pb + LP_ROUTE);
        if (EN(14) && IN(pb + LP_SORT)) _Pragma("unroll 1") for (int rep_ = 0; rep_ < REPN(14); ++rep_) { PHL sort_phase(p, lds, vcuL, GL); }
        SEAM(pb + LP_SORT);
        if (EN(6) && IN(pb + LP_GU)) _Pragma("unroll 1") for (int rep_ = 0; rep_ < REPN(6); ++rep_) { PHL
            MoeOrder<true> S{(const char*)HB8, (const char*)(wl + WO_GU), 512, (size_t)1024 * 1024, 0, NT[1], GL, vcuL, TILEE, rowtab};
            FILL_GU();
            __syncthreads();
            EpiGU E{U8, rstab};
            pg8::gemm_phase<512, EpiGU, MoeOrder<true>, true, true, 127, 122>(lds + LDS_STAGE, S, E);
        }
        SEAM(pb + LP_GU);
        if (EN(7) && IN(pb + LP_DOWN0)) _Pragma("unroll 1") for (int rep_ = 0; rep_ < REPN(7); ++rep_) { PHL
            MoeOrder<false> S{(const char*)U8, (const char*)(wl + WO_D), 256, (size_t)1024 * 512, 0, NT[0], GL, vcuL, TILEE, rowtab};
            __syncthreads();
            FILL_DOWN();
            __syncthreads();
            EpiRes<1> E{HB, SSQ, rowtab, gatetab, 1.f, Y, nullptr};
            pg8::gemm_phase<256, EpiRes<1>, MoeOrder<false>, true, true, 125, 122>(lds + LDS_STAGE, S, E);
        }
        SEAM(pb + LP_DOWN0);
        if (EN(8) && IN(pb + LP_DOWN1)) _Pragma("unroll 1") for (int rep_ = 0; rep_ < REPN(8); ++rep_) { PHL
            MoeOrder<false> S{(const char*)U8, (const char*)(wl + WO_D), 256, (size_t)1024 * 512, NT[0], NT[1], GL, vcuL, TILEE, rowtab};
            __syncthreads();
            FILL_DOWN();
            __syncthreads();
            EpiRes<2> E{HB, SSQ, rowtab, gatetab, 1.f, Y, nullptr};
            pg8::gemm_phase<256, EpiRes<2>, MoeOrder<false>, true, true, 125, 122>(lds + LDS_STAGE, S, E);
        }
        SEAM(pb + LP_DOWN1);
    }
    if (EN(15) && IN(PH_FINAL)) _Pragma("unroll 1") for (int rep_ = 0; rep_ < REPN(15); ++rep_) { PHL final_phase(p, vcuL, GL); }
#undef IN
#undef SEAM
#undef HB
#undef PROJ
#undef Y
#undef XKV
#undef MEMN
#undef SSQ
#undef XQ
#undef U
#undef ROWTOK
#undef ROWGATE
#undef TILEE
#undef NT
#undef H
#undef HB8
#undef U8
}

static int g_grid = 0;
static void launch_fast(const P& p, int lo, int hi, int& li, hipStream_t stream) {
    Args a{}; a.p = p; a.ph_lo = lo; a.ph_hi = hi; a.li = li++; a.pad = 0;
    hipLaunchKernelGGL(fwd, dim3(g_grid), dim3(NTHR), LDS_BYTES, stream, a);
    const hipError_t le = hipPeekAtLastError();
    if (le != hipSuccess) fprintf(stderr, "kernel_launch: fwd launch [%d,%d) failed: %s\n", lo, hi, hipGetErrorName(le));
}
extern "C" void kernel_launch(void* const* d_in, const int* in_sizes, int n_in, void* d_out, int out_size, void* d_ws, size_t ws_size, hipStream_t stream) {
    if (n_in != 25 || out_size != NTOK * DM || ws_size < WS_END2) { fprintf(stderr, "kernel_launch: unexpected sizes n_in %d out %d ws %zu (need %zu)\n", n_in, out_size, ws_size, (size_t)WS_END2); return; }
    if (g_grid == 0) {
        int dev = 0, cus = 0, per_cu = 0;
        if (hipGetDevice(&dev) != hipSuccess || hipDeviceGetAttribute(&cus, hipDeviceAttributeMultiprocessorCount, dev) != hipSuccess) { g_grid = -1; return; }
        if (hipFuncSetAttribute((const void*)fwd, hipFuncAttributeMaxDynamicSharedMemorySize, LDS_BYTES) != hipSuccess) { fprintf(stderr, "kernel_launch: hipFuncSetAttribute failed\n"); g_grid = -1; return; }
        if (hipOccupancyMaxActiveBlocksPerMultiprocessor(&per_cu, (const void*)fwd, NTHR, LDS_BYTES) != hipSuccess || per_cu < 1) { fprintf(stderr, "kernel_launch: occupancy query says %d\n", per_cu); }
        (void)hipGetLastError();
        g_grid = cus;
    }
    if (g_grid < 0) return;
    P p{};
    const float** pp = (const float**)&p;
    for (int i = 0; i < 25; ++i) pp[i] = (const float*)d_in[i];
    p.out = (float*)d_out; p.ws = (unsigned char*)d_ws;
    if (hipMemsetAsync((char*)d_ws + WS_CTL, 0, 1 * MiB, stream) != hipSuccess) { fprintf(stderr, "kernel_launch: hipMemsetAsync failed\n"); return; }
    int li = 0;
    launch_fast(p, PH_PRO, PH_END, li, stream);
}
```

```cpp
#define REPMASK 0x0
#include <hip/hip_runtime.h>
#include <cstdio>
#include <cstdint>

constexpr int NTOK = 32768, DM = 1024, NBATCH = 16, SEQ = 2048, NLAYER = 2, MEML = 256;
constexpr int PW = 3072;
constexpr int C_FQ = 0, C_FK = 512, C_FV = 1024, C_GQ = 1536, C_GK = 1792, C_GV = 2048, C_GG = 2560;
constexpr int INW = 3096;
constexpr float EPS = 1e-6f, LOG2E = 1.4426950408889634f;
constexpr int MAXTILES = 288;
constexpr int MAXROWS = MAXTILES * 256;

typedef unsigned short bf16;
__device__ __forceinline__ unsigned f2bf(float f) { unsigned u = __builtin_bit_cast(unsigned, f); return (u + 0x7fffu + ((u >> 16) & 1u)) >> 16; }
__device__ __forceinline__ float bf2f(bf16 b) { return __builtin_bit_cast(float, ((unsigned)b) << 16); }

constexpr size_t MiB = 1u << 20;
constexpr size_t WS_CTL = 0;
constexpr size_t WS_W = 1 * MiB;
constexpr size_t WS_WLAYER = 59 * MiB;
constexpr size_t WS_WXKV = WS_W + 2 * WS_WLAYER;
constexpr size_t WS_HB = WS_WXKV + 4 * MiB;
constexpr size_t WS_PROJ = WS_HB + 64 * MiB;
constexpr size_t WS_XQ = WS_PROJ;
constexpr size_t WS_U = WS_PROJ + 32 * MiB;
constexpr size_t WS_XO8 = WS_U + 40 * MiB;
constexpr size_t WS_SM = WS_PROJ + 192 * MiB;
constexpr size_t WS_CB = WS_SM + 4 * MiB;
constexpr size_t WS_Y = WS_CB + 1 * MiB;
constexpr size_t WS_XKV = WS_Y + 64 * MiB;
constexpr size_t WS_MEMN = WS_XKV + 16 * MiB;
constexpr size_t WS_SSQ = WS_MEMN + 8 * MiB;
constexpr size_t WS_MOE = WS_SSQ + 2 * MiB;
constexpr size_t WS_END = WS_MOE + 2 * MiB;
static_assert(WS_END <= 512 * MiB, "workspace map");
constexpr size_t MO_TOKE = 0;
constexpr size_t MO_TOKG = 256 * 1024;
constexpr size_t MO_ROWTOK = 512 * 1024;
constexpr size_t MO_ROWGATE = 832 * 1024;
constexpr size_t MO_TILEE = 1152 * 1024;
constexpr size_t MO_NT = 1156 * 1024;
constexpr size_t MO_HIST = 1160 * 1024;
constexpr size_t MO_KN = 1280 * 1024;

struct P {
    const float *x, *mem, *mem_norm, *mix_norm, *w_in, *b_forget, *w_alpha_up, *b_alpha, *fox_gain, *gla_gain, *w_out, *cross_norm, *w_xq, *w_xk, *w_xv, *w_xo,
        *moe_norm, *w_rg, *b_rg, *w_re, *b_re, *w_eg, *w_eu, *w_ed, *final_norm;
    float* out; unsigned char* ws;
};
__host__ __device__ __forceinline__ unsigned char* ws_base(unsigned char* w) {
#if defined(__HIP_DEVICE_COMPILE__)
    size_t z = 0; asm volatile("" : "+s"(z));
    return w + z;
#else
    return w;
#endif
}
#define WSP(T, off) ((T*)(ws_base(p.ws) + (off)))

__device__ __forceinline__ float wave_sum(float v) {
#pragma unroll
    for (int o = 1; o < 64; o <<= 1) v += __shfl_xor(v, o);
    return v;
}
__device__ __forceinline__ float wave_min(float v) {
#pragma unroll
    for (int o = 1; o < 64; o <<= 1) v = fminf(v, __shfl_xor(v, o));
    return v;
}
__device__ __forceinline__ float wave_max(float v) {
#pragma unroll
    for (int o = 1; o < 64; o <<= 1) v = fmaxf(v, __shfl_xor(v, o));
    return v;
}
__device__ __forceinline__ float row_rs(const float* ssq, int row) {
    const float4* s = (const float4*)(ssq + (size_t)row * 16);
    float4 a = s[0], b = s[1], c = s[2], d = s[3];
    float t = ((a.x + a.y) + (a.z + a.w)) + ((b.x + b.y) + (b.z + b.w)) + ((c.x + c.y) + (c.z + c.w)) + ((d.x + d.y) + (d.z + d.w));
    return rsqrtf(t * (1.0f / DM) + EPS);
}
__device__ __forceinline__ float log_sigmoid(float z) { return fminf(z, 0.f) - log1pf(expf(-fabsf(z))); }
__device__ __forceinline__ float silu(float z) { return z / (1.f + expf(-z)); }

typedef unsigned st_v4u __attribute__((ext_vector_type(4)));
typedef unsigned st_v2u __attribute__((ext_vector_type(2)));
#ifndef WT_STORES
#define WT_STORES 0
#endif
__device__ __forceinline__ void st_b128(void* p, st_v4u v) {
#if WT_STORES
    asm volatile("global_store_dwordx4 %0, %1, off sc1\n\ts_nop 1" :: "v"(p), "v"(v) : "memory");
#else
    *(st_v4u*)p = v;
#endif
}
__device__ __forceinline__ void st_b128_wt(void* p, st_v4u v) { asm volatile("global_store_dwordx4 %0, %1, off sc1\n\ts_nop 1" :: "v"(p), "v"(v) : "memory"); }
__device__ __forceinline__ void st_b64(void* p, st_v2u v) {
#if WT_STORES
    asm volatile("global_store_dwordx2 %0, %1, off sc1" :: "v"(p), "v"(v) : "memory");
#else
    *(st_v2u*)p = v;
#endif
}
#define XB_TMO      128
#define XB_XCNT(j)  (256  + 64 * (j))
#define XB_XSUB(j)  (1280 + 64 * (j))
#define XB_XGEN(j)  (2304 + 64 * (j))
#define XB_TOP      3328
#define XB_TOPGEN   3392
#define XCD_BAR_WORDS 3456
#define XB_SPIN_CAP (1u << 18)
#define LAS __attribute__((address_space(3)))

__device__ __forceinline__ unsigned xb_ld(unsigned* p)              { return __hip_atomic_load(p, __ATOMIC_RELAXED, __HIP_MEMORY_SCOPE_AGENT); }
__device__ __forceinline__ unsigned xb_add(unsigned* p, unsigned v) { return __hip_atomic_fetch_add(p, v, __ATOMIC_RELAXED, __HIP_MEMORY_SCOPE_AGENT); }
__device__ __forceinline__ unsigned xb_xcc_id() { return (unsigned)__builtin_amdgcn_s_getreg((3 << 11) | 20) & 0xFu; }
#define XB_SPIN(cond, bar) do { unsigned _sp = 0; while (cond) { __builtin_amdgcn_s_sleep(1); \
    if ((++_sp & 255u) == 0u) { if (xb_ld(&(bar)[XB_TMO])) break; if (_sp > XB_SPIN_CAP) { atomicAdd(&(bar)[XB_TMO], 1u); break; } } } } while (0)

struct XcdBarrier {
    unsigned* bar; unsigned x;
    volatile LAS unsigned* st;
};

__device__ __forceinline__ XcdBarrier xcd_barrier_post(unsigned* bar, volatile LAS unsigned* st) {
    XcdBarrier b; b.bar = bar; b.x = xb_xcc_id(); b.st = st;
    if (threadIdx.x == 0) (void)xb_add(&bar[XB_XCNT(b.x)], 1u);
    return b;
}
__device__ __forceinline__ void xcd_barrier_complete(unsigned* bar, unsigned x, unsigned& nloc, unsigned& nx) {
    const unsigned G = gridDim.x * gridDim.y * gridDim.z;
    unsigned sum, cnt, mine, sp = 0u;
    for (;;) {
        sum = 0u; cnt = 0u; mine = 0u;
#pragma unroll
        for (unsigned j = 0; j < 16; ++j) { const unsigned c = xb_ld(&bar[XB_XCNT(j)]); sum += c; cnt += (c > 0u) ? 1u : 0u; mine = (j == x) ? c : mine; }
        if (sum == G) break;
        __builtin_amdgcn_s_sleep(1);
        if ((++sp & 255u) == 0u) { if (xb_ld(&bar[XB_TMO])) break; if (sp > XB_SPIN_CAP) { atomicAdd(&bar[XB_TMO], 1u); break; } }
    }
    nloc = mine > 0u ? mine : 1u; nx = cnt > 0u ? cnt : 1u;
}

__device__ __forceinline__ void xcd_barrier(const XcdBarrier& b) {
    asm volatile("s_waitcnt vmcnt(0)" ::: "memory");
    __syncthreads();
    if (threadIdx.x == 0) {
        unsigned* bar = b.bar;
        __builtin_amdgcn_s_waitcnt(0);
        unsigned nloc = b.st[0], nx = b.st[1];
        if (nloc == 0u) { xcd_barrier_complete(bar, b.x, nloc, nx); b.st[0] = nloc; b.st[1] = nx; }
        const unsigned old = xb_add(&bar[XB_XSUB(b.x)], 1u);
        const unsigned gen = old / nloc;
        if (old + 1u == (gen + 1u) * nloc) {
            __builtin_amdgcn_fence(__ATOMIC_RELEASE, "agent");
            asm volatile("s_waitcnt vmcnt(0)" ::: "memory");
            const unsigned og = xb_add(&bar[XB_TOP], 1u);
            const unsigned tg = og / nx;
            if (og + 1u == (tg + 1u) * nx) xb_add(&bar[XB_TOPGEN], 1u);
            else XB_SPIN(xb_ld(&bar[XB_TOPGEN]) == tg, bar);
            __builtin_amdgcn_fence(__ATOMIC_ACQUIRE, "agent");
            xb_add(&bar[XB_XGEN(b.x)], 1u);
            asm volatile("s_waitcnt vmcnt(0)" ::: "memory");
        } else {
            XB_SPIN(xb_ld(&bar[XB_XGEN(b.x)]) == gen, bar);
            __builtin_amdgcn_fence(__ATOMIC_ACQUIRE, "agent");
            asm volatile("s_waitcnt vmcnt(0)" ::: "memory");
        }
    }
    __syncthreads();
}

namespace pg8 {
#define PG8_LAS __attribute__((address_space(3)))
typedef unsigned short bf16_t;
typedef short bf16x8 __attribute__((ext_vector_type(8)));
typedef float f32x4 __attribute__((ext_vector_type(4)));
typedef unsigned u32x4 __attribute__((ext_vector_type(4)));
typedef unsigned u32x2 __attribute__((ext_vector_type(2)));
constexpr int BM = 256, BK = 64, HALF = 128, HTB = HALF * BK * 2, STAGE_BYTES = 8 * HTB, NXCD = 8, WGM = 8;

__host__ __device__ __forceinline__ int lds_byte(int r, int c) { const int st = (r >> 4) * 2 + (c >> 5), rr = r & 15, cc = c & 31, ob = rr * 64 + cc * 2; return st * 1024 + (ob ^ (((ob >> 9) & 1) << 5)); }
__host__ __device__ __forceinline__ void stage_rc(int b, int& R, int& C) { const int st = b / 1024, sb = b % 1024, swz = sb ^ (((sb >> 9) & 1) << 5); R = (st >> 1) * 16 + swz / 64; C = (st & 1) * 32 + (swz % 64) / 2; }
__host__ __device__ __forceinline__ int perm32(int rho) { const int n = rho >> 4, i = rho & 15; return 8 * (i >> 2) + 4 * n + (i & 3); }

struct Unit { int pm, pn, e; };

struct StaticOrder {
    static constexpr bool GATHER = false;
    static constexpr size_t KSTEP_A = 128;
    const char* A; const char* Bt; int K; int nM, nN, nwg, G, c;
    __device__ void init(const void* A_, const void* Bt_, int M, int N, int K_, int G_, int c_) { A = (const char*)A_; Bt = (const char*)Bt_; K = K_; nM = M / BM; nN = N / BM; nwg = nM * nN; G = G_; c = c_; }
    __device__ bool next(int i, Unit& u) const {
        const long L = (long)i * G + c; if (L >= nwg) return false;
        int wgid = (int)L; { const int q = nwg / NXCD, r = nwg % NXCD, xcd = wgid % NXCD, off = wgid / NXCD; wgid = (xcd < r ? xcd * (q + 1) : r * (q + 1) + (xcd - r) * q) + off; }
        const int nig = WGM * nN, gid = wgid / nig, fm = gid * WGM, gsz = (nM - fm) < WGM ? (nM - fm) : WGM;
        u.pm = fm + ((wgid % nig) % gsz); u.pn = (wgid % nig) / gsz; u.e = 0; return true;
    }
    __device__ __forceinline__ const char* a_base(const Unit& u) const { return A + (size_t)u.pm * (size_t)(BM * 2) * K; }
    __device__ __forceinline__ const char* b_base(const Unit& u) const { return Bt + (size_t)u.pn * (size_t)(BM * 2) * K; }
    __device__ __forceinline__ unsigned a_off(int, int, int, int) const { return 0u; }
};

__device__ __forceinline__ unsigned cvt_pk_bf16(float lo, float hi) { unsigned r; asm volatile("v_cvt_pk_bf16_f32 %0, %1, %2" : "=v"(r) : "v"(lo), "v"(hi)); return r; }

typedef int i32x8 __attribute__((ext_vector_type(8)));
typedef int i32x4 __attribute__((ext_vector_type(4)));
template <int K, class Epi, class Sched, bool ALIGN_EPI, bool FP8 = false, int SA = 127, int SB = 127>
__device__ __forceinline__ void gemm_phase(PG8_LAS unsigned char* lds, const Sched& S, const Epi& E) {
    int tid_ = threadIdx.x; asm volatile("" : "+v"(tid_));
    const int tid = tid_, wid = __builtin_amdgcn_readfirstlane(tid >> 6), lane = tid & 63, wr = wid >> 2, wc = wid & 3, fr = lane & 15, fq = lane >> 4;
    constexpr int nt = K / BK;
    constexpr int NH = Sched::GATHER ? 2 : 1;
    unsigned voffB[2], cvA[NH][2], nvA[NH][2];
#pragma unroll
    for (int i = 0; i < 2; ++i) { int R, C; stage_rc(tid * 16 + i * 8192, R, C); const int Rb = Epi::PERM ? ((R & ~31) + perm32(R & 31)) : R;
        voffB[i] = (unsigned)(Rb * K + C) * 2u;
        cvA[0][i] = nvA[0][i] = (unsigned)(R * K + C) * 2u; if constexpr (NH == 2) { cvA[NH - 1][i] = nvA[NH - 1][i] = cvA[0][i]; } }
    constexpr size_t kstep = (size_t)(BK * 2);
    constexpr size_t hstep = (size_t)HALF * K * 2;
    constexpr size_t hstepA = Sched::GATHER ? (size_t)0 : hstep;
    constexpr size_t kstepA = Sched::KSTEP_A;
    const unsigned ldsw = (unsigned)wid * 1024u;
    const int aoff = lds_byte(wr * 64 + fr, fq * 8), boff = lds_byte(wc * 32 + fr, fq * 8);
#define PG8_SA(b, h) (((b) * 2 + (h)) * HTB)
#define PG8_SB(b, h) ((4 + (b) * 2 + (h)) * HTB)
#define PG8_STAGE(bufoff, gbase, voff) do { _Pragma("unroll") for (int _i = 0; _i < 2; ++_i) \
        __builtin_amdgcn_global_load_lds((const unsigned*)((const char*)(gbase) + (voff)[_i]), (PG8_LAS unsigned*)(lds + (bufoff) + ldsw + _i * 8192), 16, 0, 0); } while (0)
#define PG8_LD32(addr) __builtin_shufflevector(*(const PG8_LAS i32x4*)(addr), *(const PG8_LAS i32x4*)((addr) + 1024), 0, 1, 2, 3, 4, 5, 6, 7)
#define PG8_LDA(dst, b, h) do { _Pragma("unroll") for (int m = 0; m < 4; ++m) dst[m] = PG8_LD32(lds + PG8_SA(b, h) + aoff + m * 2048); } while (0)
#define PG8_LDB(dst, b, h) do { _Pragma("unroll") for (int n = 0; n < 2; ++n) dst[n] = PG8_LD32(lds + PG8_SB(b, h) + boff + n * 2048); } while (0)
#define PG8_H0(x) __builtin_bit_cast(bf16x8, __builtin_shufflevector((x), (x), 0, 1, 2, 3))
#define PG8_H1(x) __builtin_bit_cast(bf16x8, __builtin_shufflevector((x), (x), 4, 5, 6, 7))
#define PG8_MMA(ai, bj, At, Bt) do { __builtin_amdgcn_s_setprio(1); _Pragma("unroll") for (int m = 0; m < 4; ++m) _Pragma("unroll") for (int n = 0; n < 2; ++n) { \
        if constexpr (FP8) asm volatile("v_mfma_scale_f32_16x16x128_f8f6f4 %0, %1, %2, %0, %3, %4 op_sel_hi:[0,0,0]" : "+v"(acc[ai][bj][m][n]) : "v"(Bt[n]), "v"(At[m]), "v"(sbv), "v"(sav)); \
        else { acc[ai][bj][m][n] = __builtin_amdgcn_mfma_f32_16x16x32_bf16(PG8_H0(Bt[n]), PG8_H0(At[m]), acc[ai][bj][m][n], 0, 0, 0); \
               acc[ai][bj][m][n] = __builtin_amdgcn_mfma_f32_16x16x32_bf16(PG8_H1(Bt[n]), PG8_H1(At[m]), acc[ai][bj][m][n], 0, 0, 0); } } \
        __builtin_amdgcn_s_setprio(0); } while (0)
#define PG8_WAIT_V(n) asm volatile("s_waitcnt vmcnt(" #n ")" ::: "memory")
#define PG8_WAIT_L(n) asm volatile("s_waitcnt lgkmcnt(" #n ")" ::: "memory")
#define PG8_BAR __builtin_amdgcn_s_barrier()
#define PG8_SCHED __builtin_amdgcn_sched_barrier(0)
    int sav = SA, sbv = SB; asm volatile("" : "+v"(sav), "+v"(sbv));
    Unit cur, nxt; int ui = 0;
    if (!S.next(0, cur)) return;
    f32x4 acc[2][2][4][2];
#pragma unroll
    for (int a = 0; a < 2; ++a)
#pragma unroll
        for (int b = 0; b < 2; ++b)
#pragma unroll
            for (int m = 0; m < 4; ++m)
#pragma unroll
                for (int n = 0; n < 2; ++n) acc[a][b][m][n] = (f32x4){0.f, 0.f, 0.f, 0.f};
    i32x8 At[4], B0[2], B1[2];
    const char* cA = S.a_base(cur); const char* cB = S.b_base(cur);
    if constexpr (Sched::GATHER) {
        int R0, C0, R1, C1; stage_rc(tid * 16, R0, C0); stage_rc(tid * 16 + 8192, R1, C1);
#pragma unroll
        for (int h = 0; h < 2; ++h) { cvA[h][0] = S.a_off(0, h, R0, C0 * 2); cvA[h][1] = S.a_off(0, h, R1, C1 * 2); }
    }
    PG8_STAGE(PG8_SB(0, 0), cB, voffB); PG8_STAGE(PG8_SB(0, 1), cB + hstep, voffB); PG8_STAGE(PG8_SA(0, 0), cA, cvA[0]); PG8_STAGE(PG8_SA(0, 1), cA + hstepA, cvA[NH - 1]);
    if (wr == 1) PG8_BAR;
    PG8_WAIT_V(2); PG8_BAR;
    PG8_STAGE(PG8_SB(1, 0), cB + kstep, voffB); PG8_STAGE(PG8_SA(1, 0), cA + kstepA, cvA[0]); PG8_STAGE(PG8_SB(1, 1), cB + hstep + kstep, voffB);
    PG8_WAIT_V(6); PG8_BAR;
    for (;;) {
        const bool has_next = S.next(ui + 1, nxt);
        const char* nA = has_next ? S.a_base(nxt) : cA; const char* nB = has_next ? S.b_base(nxt) : cB;
        if constexpr (Sched::GATHER) {
            if (has_next) {
                int t2 = threadIdx.x; asm volatile("" : "+v"(t2));
                int R0, C0, R1, C1; stage_rc(t2 * 16, R0, C0); stage_rc(t2 * 16 + 8192, R1, C1);
#pragma unroll
                for (int h = 0; h < 2; ++h) { nvA[h][0] = S.a_off(ui + 1, h, R0, C0 * 2); nvA[h][1] = S.a_off(ui + 1, h, R1, C1 * 2); }
            } else {
#pragma unroll
                for (int h = 0; h < 2; ++h) { nvA[h][0] = cvA[h][0]; nvA[h][1] = cvA[h][1]; }
            }
        }
#pragma unroll 1
        for (int t = 0; t < nt; t += 2) {
            const bool last = (t == nt - 2);
            const char* a1 = cA + (size_t)(t + 1) * kstepA;
            const char* a2 = last ? nA : cA + (size_t)(t + 2) * kstepA; const char* b2 = last ? nB : cB + (size_t)(t + 2) * kstep;
            const char* a3 = a2 + kstepA; const char* b3 = b2 + kstep;
            unsigned v2[NH][2];
#pragma unroll
            for (int h = 0; h < NH; ++h) { if constexpr (Sched::GATHER) { v2[h][0] = last ? nvA[h][0] : cvA[h][0]; v2[h][1] = last ? nvA[h][1] : cvA[h][1]; } else { v2[h][0] = cvA[h][0]; v2[h][1] = cvA[h][1]; } }
            PG8_LDB(B0, 0, 0); PG8_LDB(B1, 0, 1); PG8_SCHED; PG8_LDA(At, 0, 0); PG8_STAGE(PG8_SA(1, 1), a1 + hstepA, cvA[NH - 1]);
            PG8_WAIT_V(8); PG8_WAIT_L(0); PG8_BAR; PG8_MMA(0, 0, At, B0); PG8_MMA(0, 1, At, B1); PG8_BAR; PG8_SCHED;
            PG8_LDA(At, 0, 1); PG8_STAGE(PG8_SB(0, 0), b2, voffB); PG8_STAGE(PG8_SB(0, 1), b2 + hstep, voffB); PG8_STAGE(PG8_SA(0, 0), a2, v2[0]);
            PG8_WAIT_V(8); PG8_WAIT_L(0); PG8_BAR; PG8_MMA(1, 0, At, B0); PG8_MMA(1, 1, At, B1); PG8_BAR; PG8_SCHED;
            PG8_LDB(B0, 1, 0); PG8_LDB(B1, 1, 1); PG8_SCHED; PG8_LDA(At, 1, 0); PG8_STAGE(PG8_SA(0, 1), a2 + hstepA, v2[NH - 1]);
            PG8_WAIT_V(8); PG8_WAIT_L(0); PG8_BAR; PG8_MMA(0, 0, At, B0); PG8_MMA(0, 1, At, B1); PG8_BAR; PG8_SCHED;
            PG8_LDA(At, 1, 1); PG8_STAGE(PG8_SB(1, 0), b3, voffB); PG8_STAGE(PG8_SB(1, 1), b3 + hstep, voffB); PG8_STAGE(PG8_SA(1, 0), a3, v2[0]);
            PG8_WAIT_V(8); PG8_WAIT_L(0); PG8_BAR; PG8_MMA(1, 0, At, B0); PG8_MMA(1, 1, At, B1); PG8_BAR; PG8_SCHED;
        }
        if constexpr (ALIGN_EPI) { if (wr == 0) PG8_BAR; }
        if constexpr (FP8) asm volatile("s_nop 15\n\ts_nop 15" ::: "memory");
        E(acc, cur, ui, wr, wc, fr, fq);
        if (!has_next) break;
#pragma unroll
        for (int a = 0; a < 2; ++a)
#pragma unroll
            for (int b = 0; b < 2; ++b)
#pragma unroll
                for (int m = 0; m < 4; ++m)
#pragma unroll
                    for (int n = 0; n < 2; ++n) acc[a][b][m][n] = (f32x4){0.f, 0.f, 0.f, 0.f};
        cur = nxt; cA = nA; cB = nB; ++ui;
        if constexpr (Sched::GATHER) {
#pragma unroll
            for (int h = 0; h < NH; ++h) { cvA[h][0] = nvA[h][0]; cvA[h][1] = nvA[h][1]; }
        }
        if constexpr (ALIGN_EPI) { if (wr == 1) PG8_BAR; }
    }
    PG8_WAIT_V(0);
    if constexpr (!ALIGN_EPI) { if (wr == 0) PG8_BAR; }
    PG8_BAR;
#undef PG8_SA
#undef PG8_SB
#undef PG8_STAGE
#undef PG8_LDA
#undef PG8_LDB
#undef PG8_MMA
#undef PG8_LD32
#undef PG8_H0
#undef PG8_H1
#undef PG8_WAIT_V
#undef PG8_WAIT_L
#undef PG8_BAR
#undef PG8_SCHED
}
}
#define GAS __attribute__((address_space(1)))
typedef float f32x4 __attribute__((ext_vector_type(4)));
typedef float f32x16 __attribute__((ext_vector_type(16)));
typedef short bf16x8 __attribute__((ext_vector_type(8)));
typedef unsigned v4u __attribute__((ext_vector_type(4)));
typedef unsigned v2u __attribute__((ext_vector_type(2)));
#define LDS_WAIT() asm volatile("s_waitcnt lgkmcnt(0)" ::: "memory")
#define VM_WAIT() asm volatile("s_waitcnt vmcnt(0)" ::: "memory")
__device__ __forceinline__ unsigned pk2(float lo, float hi) { return f2bf(lo) | (f2bf(hi) << 16); }

constexpr int NWAVES = 8, NTHR = 512;
constexpr int LDS_STAGE = 0;
constexpr int LDS_RS = 131072;
constexpr int LDS_ROWTOK = LDS_RS + 8192;
constexpr int LDS_GATE = LDS_ROWTOK + 8192;
constexpr int LDS_MISC = LDS_GATE + 8192;
constexpr int LDS_BYTES = LDS_MISC + 256;
constexpr size_t WO_IN = 0, WO_SM = 6 * MiB, WO_RHI = 6 * MiB + 65536, WO_RLO = 6 * MiB + 131072, WO_OUT = 7 * MiB, WO_XQ = 9 * MiB, WO_XO = 10 * MiB, WO_GU = 11 * MiB, WO_D = 43 * MiB;
static_assert(WO_D + 16 * MiB <= WS_WLAYER, "weight block");
constexpr int CW_BAR = 4096;
constexpr int MAX_LAUNCH = 40;
static_assert((CW_BAR + MAX_LAUNCH * XCD_BAR_WORDS) * 4 <= (int)(1 * MiB), "ctl");

enum { PH_PRO = 0, PH_XKV = 1, PH_L0 = 2, NPH = 13, PH_FINAL = PH_L0 + NLAYER * NPH, PH_END = PH_FINAL + 1 };
enum { LP_INPROJ = 0, LP_MIXA, LP_MIXB, LP_MIXC, LP_WOUT, LP_XQ, LP_XATTN, LP_XO, LP_ROUTE, LP_SORT, LP_GU, LP_DOWN0, LP_DOWN1 };

struct Args { P p; int ph_lo, ph_hi, li, pad; };

#ifndef WT_PROJ
#define WT_PROJ 0
#endif
template <bool HAS_RS> struct EpiBf16 {
    static constexpr bool PERM = true;
    bf16* O; int ldc; const LAS float* rstab;
    __device__ __forceinline__ void operator()(const pg8::f32x4 (&acc)[2][2][4][2], const pg8::Unit& u, int iu, int wr, int wc, int fr, int fq) const {
#pragma unroll
        for (int ai = 0; ai < 2; ++ai)
#pragma unroll
            for (int m = 0; m < 4; ++m) {
                const int lrow = ai * 128 + wr * 64 + m * 16 + fr;
                float sc = 1.f; if (HAS_RS) sc = rstab[iu * 256 + lrow];
                bf16* rowp = O + (size_t)(u.pm * 256 + lrow) * ldc + u.pn * 256 + wc * 32 + 8 * fq;
#pragma unroll
                for (int bj = 0; bj < 2; ++bj) { const pg8::f32x4 v0 = acc[ai][bj][m][0] * sc, v1 = acc[ai][bj][m][1] * sc;
                    pg8::u32x4 w; w.x = pg8::cvt_pk_bf16(v0[0], v0[1]); w.y = pg8::cvt_pk_bf16(v0[2], v0[3]); w.z = pg8::cvt_pk_bf16(v1[0], v1[1]); w.w = pg8::cvt_pk_bf16(v1[2], v1[3]);
                    if (WT_PROJ) st_b128_wt(rowp + bj * 128, w); else st_b128(rowp + bj * 128, w); }
            }
    }
};
__device__ __forceinline__ unsigned pk4_fp8(float a, float b, float c, float d) { int w = __builtin_amdgcn_cvt_pk_fp8_f32(a, b, 0, false); w = __builtin_amdgcn_cvt_pk_fp8_f32(c, d, w, true); return (unsigned)w; }
struct EpiGU {
    static constexpr bool PERM = true;
    unsigned char* U8; const LAS float* rstab;
    __device__ __forceinline__ void operator()(const pg8::f32x4 (&acc)[2][2][4][2], const pg8::Unit& u, int iu, int wr, int wc, int fr, int fq) const {
#pragma unroll
        for (int ai = 0; ai < 2; ++ai)
#pragma unroll
            for (int m = 0; m < 4; ++m) {
                const int lrow = ai * 128 + wr * 64 + m * 16 + fr;
                const float sc = rstab[iu * 256 + lrow];
                float o[8];
#pragma unroll
                for (int n = 0; n < 2; ++n)
#pragma unroll
                    for (int j = 0; j < 4; ++j) { const float g = acc[ai][0][m][n][j] * sc, uu = acc[ai][1][m][n][j] * sc; o[n * 4 + j] = 4.f * g * uu * __builtin_amdgcn_rcpf(1.f + __expf(-g)); }
                pg8::u32x2 w; w.x = pk4_fp8(o[0], o[1], o[2], o[3]); w.y = pk4_fp8(o[4], o[5], o[6], o[7]);
                st_b64(U8 + (size_t)(u.pm * 256 + lrow) * 512 + u.pn * 128 + wc * 32 + 8 * fq, w);
            }
    }
};
template <int MODE, bool W8 = false> struct EpiRes {
    static constexpr bool PERM = true;
    static constexpr bool MOE = MODE != 0;
    bf16* hb; float* ssq; const LAS int* rowtab; const LAS float* gatetab; float gs; bf16* t0; unsigned char* h8;
    static __device__ __forceinline__ void unpack8(const pg8::u32x4& w, float (&f)[8]) {
        f[0] = __builtin_bit_cast(float, w.x << 16); f[1] = __builtin_bit_cast(float, w.x & 0xffff0000u); f[2] = __builtin_bit_cast(float, w.y << 16); f[3] = __builtin_bit_cast(float, w.y & 0xffff0000u);
        f[4] = __builtin_bit_cast(float, w.z << 16); f[5] = __builtin_bit_cast(float, w.z & 0xffff0000u); f[6] = __builtin_bit_cast(float, w.w << 16); f[7] = __builtin_bit_cast(float, w.w & 0xffff0000u); }
    __device__ __forceinline__ void operator()(const pg8::f32x4 (&acc)[2][2][4][2], const pg8::Unit& u, int iu, int wr, int wc, int fr, int fq) const {
#pragma unroll
        for (int ai = 0; ai < 2; ++ai)
#pragma unroll
            for (int m = 0; m < 4; ++m) {
                const int lrow = ai * 128 + wr * 64 + m * 16 + fr;
                int row = u.pm * 256 + lrow; float g = gs;
                if (MOE) { row = rowtab[iu * 256 + lrow]; g = gatetab[iu * 256 + lrow] * gs; }
                const bool ok = !MOE || row >= 0;
                const size_t off = (size_t)(ok ? row : 0) * DM + u.pn * 256 + wc * 32 + 8 * fq;
                float q = 0.f;
                if (ok) {
#pragma unroll
                    for (int bj = 0; bj < 2; ++bj) {
                        float o[8];
#pragma unroll
                        for (int j = 0; j < 4; ++j) { o[j] = acc[ai][bj][m][0][j] * g; o[4 + j] = acc[ai][bj][m][1][j] * g; }
                        if (MODE == 1) { pg8::u32x4 w; w.x = pg8::cvt_pk_bf16(o[0], o[1]); w.y = pg8::cvt_pk_bf16(o[2], o[3]); w.z = pg8::cvt_pk_bf16(o[4], o[5]); w.w = pg8::cvt_pk_bf16(o[6], o[7]); st_b128(t0 + off + bj * 128, w); }
                        else {
                            float bs[8]; unpack8(*(const pg8::u32x4*)(hb + off + bj * 128), bs);
                            if (MODE == 2) { float tv[8]; unpack8(*(const pg8::u32x4*)(t0 + off + bj * 128), tv);
#pragma unroll
                                for (int j = 0; j < 8; ++j) bs[j] += tv[j]; }
#pragma unroll
                            for (int j = 0; j < 8; ++j) o[j] += bs[j];
                            pg8::u32x4 w; w.x = pg8::cvt_pk_bf16(o[0], o[1]); w.y = pg8::cvt_pk_bf16(o[2], o[3]); w.z = pg8::cvt_pk_bf16(o[4], o[5]); w.w = pg8::cvt_pk_bf16(o[6], o[7]);
                            float r[8]; unpack8(w, r);
#pragma unroll
                            for (int j = 0; j < 8; ++j) q += r[j] * r[j];
                            st_b128(hb + off + bj * 128, w);
                            if (W8) { pg8::u32x2 w8; w8.x = pk4_fp8(o[0], o[1], o[2], o[3]); w8.y = pk4_fp8(o[4], o[5], o[6], o[7]); st_b64(h8 + off + bj * 128, w8); } }
                    }
                }
                if (MODE != 1) { q += __shfl_xor(q, 16); q += __shfl_xor(q, 32); if (fq == 0 && ok) ssq[(size_t)row * 16 + u.pn * 4 + wc] = q; }
            }
    }
};
template <int MODE> struct MoeOrder {
    static constexpr bool GATHER = MODE == 0;
    static constexpr size_t KSTEP_A = 128;
    const char* A; const char* Bt; int K; size_t estride; int lo, hi, G, c; const int* tilee; const LAS int* rowtab;
    __device__ bool next(int i, pg8::Unit& u) const { const int L = i * G + c, t = lo + (L >> 2); if (t >= hi) return false; u.pm = t; u.pn = L & 3; u.e = tilee[t]; return true; }
    __device__ __forceinline__ const char* a_base(const pg8::Unit& u) const { return GATHER ? A : A + (size_t)u.pm * (size_t)512 * K; }
    __device__ __forceinline__ const char* b_base(const pg8::Unit& u) const { return Bt + (size_t)u.e * estride + (size_t)u.pn * (size_t)512 * K; }
    __device__ __forceinline__ unsigned a_off(int iu, int h, int R, int Cb) const { return (unsigned)rowtab[iu * 256 + h * 128 + R] * (unsigned)(K * 2) + (unsigned)Cb; }
};

__device__ __forceinline__ void router_weights(const P& p, int gtid, int gstride);
__device__ __forceinline__ void tr_item(const float* W, int N, int K, int k0, int n0, const float* gain, float scale, bf16* dst, LAS float* scr, int lane) {
    const int kr = lane >> 3, c4 = lane & 7;
    f32x4 v[8];
#pragma unroll
    for (int i = 0; i < 8; ++i) v[i] = *(const f32x4*)(W + (size_t)(k0 + 8 * i + kr) * N + n0 + 4 * c4);
#pragma unroll
    for (int i = 0; i < 8; ++i) { const int kk = 8 * i + kr; float g = scale; if (gain) g *= gain[k0 + kk];
        LAS float* d = scr + kk * 33 + 4 * c4; d[0] = v[i].x * g; d[1] = v[i].y * g; d[2] = v[i].z * g; d[3] = v[i].w * g; }
    LDS_WAIT();
    const int c = lane & 7;
#pragma unroll
    for (int j = 0; j < 4; ++j) { const int n = (lane >> 3) + 8 * j; const LAS float* s = scr + (8 * c) * 33 + n;
        v4u o; o.x = pk2(s[0 * 33], s[1 * 33]); o.y = pk2(s[2 * 33], s[3 * 33]); o.z = pk2(s[4 * 33], s[5 * 33]); o.w = pk2(s[6 * 33], s[7 * 33]);
        st_b128(dst + (size_t)n * K + k0 + 8 * c, o); }
    LDS_WAIT();
}
__device__ __forceinline__ void tr_item8(const float* W, int N, int K, int k0, int n0, const float* gain, float scale, unsigned char* dst, LAS float* scr, int lane) {
    const int kr = lane >> 3, c4 = lane & 7;
    f32x4 v[8];
#pragma unroll
    for (int i = 0; i < 8; ++i) v[i] = *(const f32x4*)(W + (size_t)(k0 + 8 * i + kr) * N + n0 + 4 * c4);
#pragma unroll
    for (int i = 0; i < 8; ++i) { const int kk = 8 * i + kr; float g = scale; if (gain) g *= gain[k0 + kk];
        LAS float* d = scr + kk * 33 + 4 * c4; d[0] = v[i].x * g; d[1] = v[i].y * g; d[2] = v[i].z * g; d[3] = v[i].w * g; }
    LDS_WAIT();
    const int c = lane & 7;
#pragma unroll
    for (int j = 0; j < 4; ++j) { const int n = (lane >> 3) + 8 * j; const LAS float* s = scr + (8 * c) * 33 + n;
        v2u o; o.x = pk4_fp8(s[0 * 33], s[1 * 33], s[2 * 33], s[3 * 33]); o.y = pk4_fp8(s[4 * 33], s[5 * 33], s[6 * 33], s[7 * 33]);
        st_b64(dst + (size_t)n * K + k0 + 8 * c, o); }
    LDS_WAIT();
}
constexpr int IT_LAYER = 15360;
__device__ __forceinline__ void prologue_item(const P& p, int it, LAS float* scr, int lane) {
    const int l = it / IT_LAYER; int r = it % IT_LAYER;
    unsigned char* wl = ws_base(p.ws) + WS_W + (size_t)l * WS_WLAYER;
    if (r < 1536) {
        const int seg = r / 768; r %= 768; const int kb = r / 48, nb = r % 48; const int n0 = (seg ? 1544 : 0) + 32 * nb, drow = seg * 1536 + 32 * nb;
        const float sc = drow < 512 ? 0.125f * LOG2E : ((drow >= C_GQ && drow < C_GK) ? 0.125f : 1.f);
        tr_item(p.w_in + (size_t)l * DM * INW, INW, DM, 64 * kb, n0, p.mix_norm + l * DM, sc, (bf16*)(wl + WO_IN) + (size_t)drow * DM, scr, lane); return; }
    r -= 1536;
    if (r < 512) { const int kb = r / 32, nb = r % 32; tr_item(p.w_out + (size_t)l * DM * DM, DM, DM, 64 * kb, 32 * nb, nullptr, 1.f, (bf16*)(wl + WO_OUT) + (size_t)(32 * nb) * DM, scr, lane); return; }
    r -= 512;
    if (r < 256) { const int kb = r / 16, nb = r % 16; tr_item(p.w_xq + (size_t)l * DM * 512, 512, DM, 64 * kb, 32 * nb, p.cross_norm + l * DM, 0.08838834764831845f * LOG2E, (bf16*)(wl + WO_XQ) + (size_t)(32 * nb) * DM, scr, lane); return; }
    r -= 256;
    if (r < 256) { const int kb = r / 32, nb = r % 32; tr_item8(p.w_xo + (size_t)l * 512 * DM, DM, 512, 64 * kb, 32 * nb, nullptr, 32.f, (unsigned char*)(wl + WO_XO) + (size_t)(32 * nb) * 512, scr, lane); return; }
    r -= 256;
    if (r < 512) { const int kv = r / 256; r %= 256; const int kb = r / 16, nb = r % 16;
        tr_item((kv ? p.w_xv : p.w_xk) + (size_t)l * DM * 512, 512, DM, 64 * kb, 32 * nb, nullptr, 1.f, (bf16*)(ws_base(p.ws) + WS_WXKV) + (size_t)(l * 1024 + kv * 512 + 32 * nb) * DM, scr, lane); return; }
    r -= 512;
    if (r < 8192) { const int up = r / 4096; r %= 4096; const int e = r / 256; r %= 256; const int kb = r / 16, nb = r % 16; const int c0 = 32 * nb, drow = (c0 >> 7) * 256 + up * 128 + (c0 & 127);
        tr_item8((up ? p.w_eu : p.w_eg) + ((size_t)l * 16 + e) * DM * 512, 512, DM, 64 * kb, c0, p.moe_norm + l * DM, 32.f, (unsigned char*)(wl + WO_GU) + ((size_t)e * 1024 + drow) * DM, scr, lane); return; }
    r -= 8192;
    { const int e = r / 256; r %= 256; const int kb = r / 32, nb = r % 32;
      tr_item8(p.w_ed + ((size_t)l * 16 + e) * 512 * DM, DM, 512, 64 * kb, 32 * nb, nullptr, 32.f, (unsigned char*)(wl + WO_D) + ((size_t)e * 1024 + 32 * nb) * 512, scr, lane); }
}
__device__ __forceinline__ void row_to_bf16(const float* src, bf16* dst, float* ssq, const float* gain, int lane, int mode) {
    const f32x4* s = (const f32x4*)src + lane;
    f32x4 v[4]; float q = 0.f;
#pragma unroll
    for (int j = 0; j < 4; ++j) { v[j] = s[64 * j]; q += (v[j].x * v[j].x + v[j].y * v[j].y) + (v[j].z * v[j].z + v[j].w * v[j].w); }
    q = wave_sum(q);
    float sc = 1.f;
    if (mode == 1) sc = rsqrtf(q * (1.0f / DM) + EPS);
    v2u* d = (v2u*)dst + lane; float q2 = 0.f;
#pragma unroll
    for (int j = 0; j < 4; ++j) {
        f32x4 g = (f32x4){1.f, 1.f, 1.f, 1.f}; if (mode == 1) g = ((const f32x4*)gain)[lane + 64 * j];
        v2u o; o.x = pk2(v[j].x * sc * g.x, v[j].y * sc * g.y); o.y = pk2(v[j].z * sc * g.z, v[j].w * sc * g.w); st_b64(d + 64 * j, o);
        const float r0 = __builtin_bit_cast(float, o.x << 16), r1 = __builtin_bit_cast(float, o.x & 0xffff0000u), r2 = __builtin_bit_cast(float, o.y << 16), r3 = __builtin_bit_cast(float, o.y & 0xffff0000u);
        q2 += (r0 * r0 + r1 * r1) + (r2 * r2 + r3 * r3); }
    if (mode == 0) { q2 = wave_sum(q2); if (lane < 16) ssq[lane] = lane == 0 ? q2 : 0.f; }
}
__device__ __forceinline__ void prologue(const P& p, LAS unsigned char* lds, int vcu, int G, int wave, int lane) {
    asm volatile("" : "+v"(lane));
    LAS float* scr = (LAS float*)(lds + LDS_STAGE + wave * 16384);
    const int gw = vcu * NWAVES + wave, NGW = G * NWAVES;
    for (int it = gw; it < NLAYER * IT_LAYER; it += NGW) prologue_item(p, it, scr, lane);
    for (int idx = gw * 64 + lane; idx < NLAYER * 2 * 32768; idx += NGW * 64) {
        const int l = idx / 65536, r = idx % 65536, which = r / 32768, e = r % 32768, row = e / 1024, k = e % 1024;
        unsigned char* wl = ws_base(p.ws) + WS_W + (size_t)l * WS_WLAYER;
        if (which == 0) {
            float v = 0.f;
            if (row < 8) v = p.w_in[((size_t)l * DM + k) * INW + 1536 + row]; else if (row < 24) v = p.w_in[((size_t)l * DM + k) * INW + 3080 + (row - 8)];
            ((bf16*)(wl + WO_SM))[row * 1024 + k] = (bf16)f2bf(v * p.mix_norm[l * DM + k]);
        }
    }
    router_weights(p, gw * 64 + lane, NGW * 64);
    for (int m = gw; m < 4096; m += NGW) row_to_bf16(p.mem + (size_t)m * DM, WSP(bf16, WS_MEMN) + (size_t)m * DM, nullptr, p.mem_norm, lane, 1);
    { bf16* hbp = WSP(bf16, WS_HB); float* sqp = WSP(float, WS_SSQ);
      for (int m0 = gw * 4; m0 < NTOK; m0 += NGW * 4) {
        f32x4 v[4][4];
#pragma unroll
        for (int r = 0; r < 4; ++r)
#pragma unroll
            for (int j = 0; j < 4; ++j) v[r][j] = ((const f32x4*)(p.x + (size_t)(m0 + r) * DM))[lane + 64 * j];
#pragma unroll
        for (int r = 0; r < 4; ++r) { float q2 = 0.f; v2u* d = (v2u*)(hbp + (size_t)(m0 + r) * DM) + lane;
#pragma unroll
            for (int j = 0; j < 4; ++j) { v2u o; o.x = pk2(v[r][j].x, v[r][j].y); o.y = pk2(v[r][j].z, v[r][j].w); st_b64(d + 64 * j, o);
                const float r0 = __builtin_bit_cast(float, o.x << 16), r1 = __builtin_bit_cast(float, o.x & 0xffff0000u), r2 = __builtin_bit_cast(float, o.y << 16), r3 = __builtin_bit_cast(float, o.y & 0xffff0000u);
                q2 += (r0 * r0 + r1 * r1) + (r2 * r2 + r3 * r3); }
            q2 = wave_sum(q2); if (lane < 16) sqp[(size_t)(m0 + r) * 16 + lane] = lane == 0 ? q2 : 0.f; }
      } }
}
__device__ __forceinline__ void small_proj(const P& p, int l, LAS unsigned char* lds, int vcu, int G, int wave, int lane) {
    asm volatile("" : "+v"(lane));
    const bf16* wsm = (const bf16*)(ws_base(p.ws) + WS_W + (size_t)l * WS_WLAYER + WO_SM);
    const bf16* hb = WSP(bf16, WS_HB); const float* ssq = WSP(float, WS_SSQ); float* sm = WSP(float, WS_SM);
    constexpr int BST = 2048 + 16;
    { const int tid = wave * 64 + lane;
#pragma unroll
      for (int i = 0; i < 8; ++i) { const int idx = tid + NTHR * i, row = idx >> 7, c = idx & 127; *(LAS v4u*)(lds + row * BST + c * 16) = *(const v4u*)(wsm + row * 1024 + c * 8); } }
    __syncthreads();
    const int r = lane & 15, kq = lane >> 4;
    for (int blk = vcu * NWAVES + wave; blk < NTOK / 16; blk += G * NWAVES) {
        const int tok0 = blk * 16;
        const bf16x8* ap = (const bf16x8*)(hb + (size_t)(tok0 + r) * DM + kq * 32);
        pg8::f32x4 acc0 = {0.f, 0.f, 0.f, 0.f}, acc1 = {0.f, 0.f, 0.f, 0.f};
#pragma unroll
        for (int half = 0; half < 2; ++half) {
            bf16x8 af[16];
#pragma unroll
            for (int i = 0; i < 16; ++i) af[i] = ap[(half * 4 + (i >> 2)) * 16 + (i & 3)];
#pragma unroll
            for (int i = 0; i < 16; ++i) { const int s_ = half * 4 + (i >> 2), j = i & 3;
                const bf16x8 b0 = *(const LAS bf16x8*)(lds + r * BST + (128 * s_ + 32 * kq + 8 * j) * 2);
                const bf16x8 b1 = *(const LAS bf16x8*)(lds + (16 + r) * BST + (128 * s_ + 32 * kq + 8 * j) * 2);
                acc0 = __builtin_amdgcn_mfma_f32_16x16x32_bf16(af[i], b0, acc0, 0, 0, 0);
                acc1 = __builtin_amdgcn_mfma_f32_16x16x32_bf16(af[i], b1, acc1, 0, 0, 0);
                if ((i & 3) == 3) __builtin_amdgcn_sched_barrier(0); }
        }
        const float rsv = row_rs(ssq, tok0 + r);
#pragma unroll
        for (int g = 0; g < 4; ++g) { const int trow = 4 * kq + g; const float rs = __shfl(rsv, trow);
            sm[(size_t)(tok0 + trow) * 32 + r] = acc0[g] * rs; if (r < 8) sm[(size_t)(tok0 + trow) * 32 + 16 + r] = acc1[g] * rs; }
    }
    __syncthreads();
}
typedef short v4i16_t __attribute__((ext_vector_type(4)));
typedef __bf16 bf16x2_t __attribute__((ext_vector_type(2)));
typedef float f32x2_t __attribute__((ext_vector_type(2)));
__device__ __forceinline__ unsigned cvtpk(float lo, float hi) { f32x2_t v = {lo, hi}; bf16x2_t b = __builtin_convertvector(v, bf16x2_t); return __builtin_bit_cast(unsigned, b); }
__device__ __forceinline__ bf16x8 pack8(const f32x16& p, int o) {
    v4u w; w.x = cvtpk(p[o], p[o + 1]); w.y = cvtpk(p[o + 2], p[o + 3]); w.z = cvtpk(p[o + 4], p[o + 5]); w.w = cvtpk(p[o + 6], p[o + 7]);
    return __builtin_bit_cast(bf16x8, w);
}
__device__ __forceinline__ float max3f(float a, float b, float c) { float r; asm("v_max3_f32 %0, %1, %2, %3" : "=v"(r) : "v"(a), "v"(b), "v"(c)); return r; }
template <int D, bool FOX, bool OUT8 = false>
__device__ __forceinline__ void attn_unit(LAS unsigned char* lds, const bf16* Qg, int qpitch, const bf16* Kg, const bf16* Vg, int kvpitch, int NT,
                                          const float* cb, int q0, bf16* Og, int opitch, const float* gain, const float* kn) {
    constexpr int KS = D * 2 + 16, VS = D * 2 + 64;
    constexpr int KBYTES = 64 * KS, VBYTES = 64 * VS;
    constexpr int CPR = D / 8, NCH = 64 * CPR / NTHR, NS = D / 16, NDB = D / 32;
    constexpr int OFF_K = 0, OFF_V = 2 * KBYTES, OFF_CB = 2 * KBYTES + 2 * VBYTES, OFF_FX = OFF_CB + 512;
    int tid = threadIdx.x; asm volatile("" : "+v"(tid));
    const int lane = tid & 63, wave = __builtin_amdgcn_readfirstlane(tid >> 6), r32 = lane & 31, hh = lane >> 5;
    bf16x8 qf[NS];
    { const bf16* qrow = Qg + (size_t)(wave * 32 + r32) * qpitch;
#pragma unroll
      for (int s = 0; s < NS; ++s) qf[s] = *(const bf16x8*)(qrow + 16 * s + 8 * hh); }
    v4u kreg[NCH], vreg[NCH]; f32x4 cbreg = {0.f, 0.f, 0.f, 0.f};
#define AT_GLOAD(t) do { _Pragma("unroll") for (int i_ = 0; i_ < NCH; ++i_) { const int idx_ = tid + NTHR * i_, key_ = idx_ / CPR, c_ = idx_ % CPR; \
        kreg[i_] = *(const v4u*)(Kg + (size_t)((t) * 64 + key_) * kvpitch + c_ * 8); vreg[i_] = *(const v4u*)(Vg + (size_t)((t) * 64 + key_) * kvpitch + c_ * 8); } \
        if (FOX && tid < 16) cbreg = *(const f32x4*)(cb + (t) * 64 + tid * 4); } while (0)
#define AT_LSTORE(b) do { _Pragma("unroll") for (int i_ = 0; i_ < NCH; ++i_) { const int idx_ = tid + NTHR * i_, key_ = idx_ / CPR, c_ = idx_ % CPR; \
        *(LAS v4u*)(lds + OFF_K + (b) * KBYTES + key_ * KS + c_ * 16) = kreg[i_]; *(LAS v4u*)(lds + OFF_V + (b) * VBYTES + key_ * VS + c_ * 16) = vreg[i_]; } \
        if (FOX && tid < 16) *(LAS f32x4*)(lds + OFF_CB + (b) * 256 + tid * 16) = cbreg; } while (0)
    float m = -INFINITY, l = 0.f;
    f32x16 osum = f32x16{};
    f32x16 o[NDB];
#pragma unroll
    for (int d = 0; d < NDB; ++d) o[d] = f32x16{};
    const int qlo = q0 + wave * 32, qabs = qlo + r32;
    float knpre = 0.f, qkmax = 0.f;
    LAS float* fx = (LAS float*)(lds + OFF_FX);
    __syncthreads();
    if (FOX) {
        float qn2 = 0.f;
#pragma unroll
        for (int s = 0; s < NS; ++s)
#pragma unroll
            for (int e = 0; e < 8; ++e) { const float v = __builtin_bit_cast(float, ((unsigned)(unsigned short)qf[s][e]) << 16); qn2 += v * v; }
        qn2 += __shfl_xor(qn2, 32);
        qn2 = wave_max(qn2);
        if (lane == 0) fx[wave] = qn2;
        knpre = lane < 32 ? kn[lane] : 0.f;
#pragma unroll
        for (int o_ = 1; o_ < 32; o_ <<= 1) { const float t_ = __shfl_up(knpre, o_); if (lane >= o_) knpre = fmaxf(knpre, t_); }
    }
    const int t_first = FOX ? NT - 1 : 0;
    AT_GLOAD(t_first); AT_LSTORE(0);
    __syncthreads();
    if (FOX) { float q2 = fx[0];
#pragma unroll
        for (int w_ = 1; w_ < 8; ++w_) q2 = fmaxf(q2, fx[w_]);
        qkmax = sqrtf(q2); }
#pragma unroll 1
    for (int it = 0; it < NT; ++it) {
        const int b = it & 1;
        const int t = FOX ? NT - 1 - it : it;
        const int tn = FOX ? t - 1 : t + 1;
        if (it + 1 < NT) AT_GLOAD(tn);
        const int kt0 = t * 64;
        if (!FOX || kt0 <= qlo + 31) {
            f32x16 p[2];
#pragma unroll
            for (int kb = 0; kb < 2; ++kb) {
                if (FOX) {
#pragma unroll
                    for (int g = 0; g < 4; ++g) { const f32x4 c4 = *(const LAS f32x4*)(lds + OFF_CB + b * 256 + (kb * 32 + 8 * g + 4 * hh) * 4); p[kb][4 * g] = c4.x; p[kb][4 * g + 1] = c4.y; p[kb][4 * g + 2] = c4.z; p[kb][4 * g + 3] = c4.w; }
                } else p[kb] = f32x16{};
                const LAS unsigned char* kp = lds + OFF_K + b * KBYTES + (kb * 32 + r32) * KS + hh * 16;
#pragma unroll
                for (int s = 0; s < NS; ++s) { const bf16x8 kf = *(const LAS bf16x8*)(kp + s * 32); p[kb] = __builtin_amdgcn_mfma_f32_32x32x16_bf16(kf, qf[s], p[kb], 0, 0, 0); }
            }
            if (FOX && kt0 + 63 > qlo) {
#pragma unroll
                for (int kb = 0; kb < 2; ++kb)
#pragma unroll
                    for (int r = 0; r < 16; ++r) { const int key = kt0 + kb * 32 + (r & 3) + 8 * (r >> 2) + 4 * hh; if (key > qabs) p[kb][r] = -INFINITY; }
            }
            float mt = fmaxf(p[1][0], p[0][0]);
#pragma unroll
            for (int r = 1; r < 16; ++r) mt = max3f(mt, p[0][r], p[1][r]);
            mt = fmaxf(mt, __shfl_xor(mt, 32));
            const float mnew = fmaxf(m, mt);
            float ls = 0.f;
#pragma unroll
            for (int kb = 0; kb < 2; ++kb)
#pragma unroll
                for (int r = 0; r < 16; ++r) { const float e = __builtin_amdgcn_exp2f(p[kb][r] - mnew); p[kb][r] = e; if (!FOX) ls += e; }
            if (!FOX || __builtin_amdgcn_ballot_w64(mnew > m) != 0ull) {
                const float alpha = __builtin_amdgcn_exp2f(m - mnew);
                l *= alpha; if (FOX) osum[0] *= alpha;
#pragma unroll
                for (int d = 0; d < NDB; ++d)
#pragma unroll
                    for (int r = 0; r < 16; ++r) o[d][r] *= alpha;
            }
            m = mnew; l += ls;
            bf16x8 pa[2][2];
#pragma unroll
            for (int kb = 0; kb < 2; ++kb) { pa[kb][0] = pack8(p[kb], 0); pa[kb][1] = pack8(p[kb], 8); }
            const LAS unsigned char* vp = lds + OFF_V + b * VBYTES + (4 * hh + ((lane & 15) >> 2)) * VS + (16 * ((lane >> 4) & 1) + 4 * (lane & 3)) * 2;
#pragma unroll
            for (int d = 0; d < NDB; ++d) {
#pragma unroll
                for (int kb = 0; kb < 2; ++kb)
#pragma unroll
                    for (int ks = 0; ks < 2; ++ks) {
                        const LAS unsigned char* a0 = vp + (kb * 32 + 16 * ks) * VS + d * 64;
                        const v4i16_t lo = __builtin_amdgcn_ds_read_tr16_b64_v4i16((LAS v4i16_t*)a0);
                        const v4i16_t hi = __builtin_amdgcn_ds_read_tr16_b64_v4i16((LAS v4i16_t*)(a0 + 8 * VS));
                        const bf16x8 vf = (bf16x8){lo[0], lo[1], lo[2], lo[3], hi[0], hi[1], hi[2], hi[3]};
                        o[d] = __builtin_amdgcn_mfma_f32_32x32x16_bf16(vf, pa[kb][ks], o[d], 0, 0, 0);
                    }
            }
            if (FOX) {
                const bf16x8 ones = __builtin_bit_cast(bf16x8, (v4u){0x3F803F80u, 0x3F803F80u, 0x3F803F80u, 0x3F803F80u});
#pragma unroll
                for (int kb = 0; kb < 2; ++kb)
#pragma unroll
                    for (int ks = 0; ks < 2; ++ks) osum = __builtin_amdgcn_mfma_f32_32x32x16_bf16(ones, pa[kb][ks], osum, 0, 0, 0);
            }
        }
        if (FOX) { const float mm = wave_min(m); if (lane == 0) fx[8 + b * 8 + wave] = mm; }
        if (it + 1 < NT) AT_LSTORE(b ^ 1);
        __syncthreads();
        if (FOX && t > 0) {
            float M0 = fx[8 + b * 8];
#pragma unroll
            for (int w_ = 1; w_ < 8; ++w_) M0 = fminf(M0, fx[8 + b * 8 + w_]);
            const float cbl = *(const LAS float*)(lds + OFF_CB + (b ^ 1) * 256 + 63 * 4);
            const float knb = __builtin_bit_cast(float, __builtin_amdgcn_readlane(__builtin_bit_cast(int, knpre), t - 1));
            if (qkmax * knb + cbl < M0 - 40.f) break;
        }
    }
#undef AT_GLOAD
#undef AT_LSTORE
    if (FOX) l = osum[0]; else l += __shfl_xor(l, 32);
    const float inv = 1.0f / l;
    float rs = inv;
    if (FOX) {
        float ss = 0.f;
#pragma unroll
        for (int d = 0; d < NDB; ++d)
#pragma unroll
            for (int r = 0; r < 16; ++r) { const float v = o[d][r] * inv; ss += v * v; }
        ss += __shfl_xor(ss, 32);
        rs = inv * rsqrtf(ss * (1.0f / D) + EPS);
    }
    constexpr int SROW = 144;
    LAS unsigned char* stg = lds + OFF_K + wave * (32 * SROW);
#pragma unroll
    for (int d = 0; d < NDB; ++d)
#pragma unroll
        for (int g = 0; g < 4; ++g) {
            if (OUT8) { *(LAS unsigned*)(stg + r32 * SROW + 32 * d + 8 * g + 4 * hh) = pk4_fp8(o[d][4 * g] * rs, o[d][4 * g + 1] * rs, o[d][4 * g + 2] * rs, o[d][4 * g + 3] * rs); }
            else { f32x4 gn = {1.f, 1.f, 1.f, 1.f}; if (FOX) gn = *(const f32x4*)(gain + 32 * d + 8 * g + 4 * hh);
                v2u w; w.x = cvtpk(o[d][4 * g] * rs * gn.x, o[d][4 * g + 1] * rs * gn.y); w.y = cvtpk(o[d][4 * g + 2] * rs * gn.z, o[d][4 * g + 3] * rs * gn.w);
                *(LAS v2u*)(stg + r32 * SROW + (32 * d + 8 * g + 4 * hh) * 2) = w; }
        }
    static_assert((OUT8 ? D : D * 2) == 128, "stage rows are 128 bytes");
    { unsigned char* ob = (unsigned char*)Og; const size_t pitchb = (size_t)opitch * (OUT8 ? 1 : 2);
#pragma unroll
      for (int i = 0; i < 4; ++i) { const int row = i * 8 + (lane >> 3), ch = lane & 7;
          const v4u w = *(const LAS v4u*)(stg + row * SROW + ch * 16);
          st_b128(ob + (size_t)(wave * 32 + row) * pitchb + ch * 16, w); } }
}
__device__ __forceinline__ void fox_phase(const P& p, int l, LAS unsigned char* lds, int vcu, int G) {
    const bf16* proj = WSP(bf16, WS_PROJ); const float* cb = WSP(float, WS_CB); bf16* y = WSP(bf16, WS_Y);
    for (int pu = vcu; pu < 512; pu += G) {
        const int bh = pu >> 2, pr = pu < 256 ? (pu & 3) : 3 - (pu & 3), b = bh >> 3, h = bh & 7;
        for (int half = 0; half < 2; ++half) {
            const int qb = half ? pr : 7 - pr;
            const size_t row0 = (size_t)b * SEQ;
            attn_unit<64, true>(lds, proj + (row0 + qb * 256) * PW + C_FQ + h * 64, PW, proj + row0 * PW + C_FK + h * 64, proj + row0 * PW + C_FV + h * 64, PW, 4 * (qb + 1),
                                cb + ((size_t)b * 8 + h) * SEQ, qb * 256, y + (row0 + qb * 256) * DM + h * 64, DM, p.fox_gain + l * 512 + h * 64, WSP(const float, WS_MOE + MO_KN) + (b * 8 + h) * 32);
        }
    }
}
__device__ __forceinline__ void xattn_phase(const P& p, int l, LAS unsigned char* lds, int vcu, int G, bool dummy) {
    bf16* xq = WSP(bf16, WS_XQ); const bf16* xkv = WSP(bf16, WS_XKV);
    for (int u = vcu; u < 512; u += G) {
        const int b = u >> 5, h = (u >> 3) & 3, qb = u & 7;
        bf16* qp = xq + ((size_t)b * SEQ + qb * 256) * 512 + h * 128;
        const bf16* kp = xkv + (size_t)b * MEML * 2048 + l * 1024 + h * 128;
        attn_unit<128, false, true>(lds, qp, 512, kp, kp + 512, 2048, 4, nullptr, 0, (bf16*)((dummy ? WSP(unsigned char, WS_Y) : WSP(unsigned char, WS_XO8)) + ((size_t)b * SEQ + qb * 256) * 512 + h * 128), 512, nullptr, nullptr);
    }
}

__device__ __forceinline__ void xattn_pair(const P& p, int l, LAS unsigned char* lds, int pm, int pn, bool dummy) {
    const bf16* xq = WSP(bf16, WS_XQ); const bf16* xkv = WSP(bf16, WS_XKV);
    const int b = pm >> 3;
    for (int hh2 = 0; hh2 < 2; ++hh2) {
        const int h = 2 * pn + hh2;
        const bf16* qp = xq + (size_t)pm * 256 * 512 + h * 128;
        const bf16* kp = xkv + (size_t)b * MEML * 2048 + l * 1024 + h * 128;
        attn_unit<128, false, true>(lds, qp, 512, kp, kp + 512, 2048, 4, nullptr, 0, (bf16*)((dummy ? WSP(unsigned char, WS_Y) : WSP(unsigned char, WS_XO8)) + (size_t)pm * 256 * 512 + h * 128), 512, nullptr, nullptr);
    }
}
constexpr size_t WS_GB = WS_END;
constexpr size_t WS_GDEC = WS_GB + 32 * MiB;
constexpr size_t WS_END2 = WS_GDEC + 1 * MiB;
static_assert(WS_END2 <= 512 * MiB, "workspace map 2");
constexpr int GL_B = 0;
constexpr int GL_TOT = 16384;
constexpr int GL_Q1 = 18432, GL_Q2 = GL_Q1 + 64 * 144, GL_K2 = GL_Q2 + 64 * 144;
constexpr int GL_KD = GL_K2 + 64 * 144;
constexpr int GL_V = GL_KD + 64 * 192;
constexpr int GL_SSQ = GL_V + 64 * 320;
constexpr int GL_GA = GL_SSQ + 1024;
constexpr int GL_YST = GL_GA + 4096;
constexpr int GL_GG = GL_YST + 64 * 272;
constexpr int GL_END = GL_GG + 64 * 272;
static_assert(GL_END <= 131072, "gla lds");

__device__ __forceinline__ float fast_log_sigmoid(float z) { return fminf(z, 0.f) - __logf(1.f + __expf(-fabsf(z))); }
__device__ __forceinline__ void gla_decay(const P& p, int l, int h, size_t tok0, LAS unsigned char* lds, int lane, int wave) {
    const float* sm = WSP(float, WS_SM);
    float w[16];
#pragma unroll
    for (int r = 0; r < 16; ++r) w[r] = p.w_alpha_up[((size_t)l * 16 + r) * 256 + h * 64 + lane];
    const float bias = p.b_alpha[l * 256 + h * 64 + lane];
    LAS f32x4* gat = (LAS f32x4*)(lds + GL_GA + wave * 512);
    if (lane < 32) gat[lane] = *(const f32x4*)(sm + (tok0 + wave * 8 + (lane >> 2)) * 32 + 8 + 4 * (lane & 3));
    float bl[8]; float run = 0.f;
#pragma unroll
    for (int j = 0; j < 8; ++j) {
        float z = bias;
#pragma unroll
        for (int r4 = 0; r4 < 4; ++r4) { const f32x4 g4 = gat[j * 4 + r4]; z += g4.x * w[4 * r4] + g4.y * w[4 * r4 + 1] + g4.z * w[4 * r4 + 2] + g4.w * w[4 * r4 + 3]; }
        run += fast_log_sigmoid(z) * (1.0f / 16.0f); bl[j] = run;
    }
    LAS float* tot = (LAS float*)(lds + GL_TOT);
    tot[wave * 64 + lane] = run;
    __syncthreads();
    float pre = 0.f;
#pragma unroll
    for (int g = 0; g < 8; ++g) { const float t = tot[g * 64 + lane]; if (g < wave) pre += t; }
    LAS float* Bm = (LAS float*)(lds + GL_B);
#pragma unroll
    for (int j = 0; j < 8; ++j) Bm[(wave * 8 + j) * 64 + lane] = bl[j] + pre;
    __syncthreads();
}
__device__ __forceinline__ void gla_load_v(const bf16* proj, size_t tok0, int h, LAS unsigned char* lds, int tid) {
#pragma unroll
    for (int i = 0; i < 2; ++i) { const int idx = tid + NTHR * i, t = idx >> 4, c = idx & 15;
        *(LAS v4u*)(lds + GL_V + t * 320 + c * 16) = *(const v4u*)(proj + (tok0 + t) * PW + C_GV + h * 128 + c * 8); }
}
__device__ __forceinline__ bf16x8 tr_frag(const LAS unsigned char* a0, int rowstride4) {
    const v4i16_t lo = __builtin_amdgcn_ds_read_tr16_b64_v4i16((LAS v4i16_t*)a0);
    const v4i16_t hi = __builtin_amdgcn_ds_read_tr16_b64_v4i16((LAS v4i16_t*)(a0 + rowstride4));
    return (bf16x8){lo[0], lo[1], lo[2], lo[3], hi[0], hi[1], hi[2], hi[3]};
}
__device__ __forceinline__ void gla_phase_a(const P& p, int l, LAS unsigned char* lds, int vcu, int G) {
    int tid = threadIdx.x; asm volatile("" : "+v"(tid));
    const int lane = tid & 63, wave = __builtin_amdgcn_readfirstlane(tid >> 6), hh = lane >> 5;
    const bf16* proj = WSP(bf16, WS_PROJ); float* loc = ((float*)p.out); float* dec = WSP(float, WS_GDEC); const float* sm = WSP(float, WS_SM); float* gb = WSP(float, WS_GB);
    LAS unsigned char* kd = lds + wave * 16384; LAS unsigned char* vh = kd + 8192;
    const int crow8 = lane >> 3, cch = lane & 7;
    const int trow = (lane & 15) >> 2, tcol = 16 * ((lane >> 4) & 1) + 4 * (lane & 3);
    for (int u = vcu * NWAVES + wave; u < 2048; u += G * NWAVES) {
        const int c = u & 31, h = (u >> 5) & 3, b = u >> 7;
        const size_t tok0 = (size_t)b * SEQ + c * 64;
        v4u kreg[8], v0reg[8], v1reg[8];
#pragma unroll
        for (int i = 0; i < 8; ++i) { const bf16* rp = proj + (tok0 + i * 8 + crow8) * PW;
            kreg[i] = *(const v4u*)(rp + C_GK + h * 64 + cch * 8); v0reg[i] = *(const v4u*)(rp + C_GV + h * 128 + cch * 8); v1reg[i] = *(const v4u*)(rp + C_GV + h * 128 + 64 + cch * 8); }
        float w[16];
#pragma unroll
        for (int r = 0; r < 16; ++r) w[r] = p.w_alpha_up[((size_t)l * 16 + r) * 256 + h * 64 + lane];
        const float bias = p.b_alpha[l * 256 + h * 64 + lane];
        { LAS f32x4* gw = (LAS f32x4*)vh;
#pragma unroll
          for (int i = 0; i < 4; ++i) gw[lane * 4 + i] = *(const f32x4*)(sm + (tok0 + lane) * 32 + 8 + 4 * i); }
        float bt[64]; float run = 0.f;
#pragma unroll
        for (int t = 0; t < 64; ++t) {
            float z = bias;
#pragma unroll
            for (int r4 = 0; r4 < 4; ++r4) { const f32x4 g4 = ((const LAS f32x4*)vh)[t * 4 + r4]; z += g4.x * w[4 * r4] + g4.y * w[4 * r4 + 1] + g4.z * w[4 * r4 + 2] + g4.w * w[4 * r4 + 3]; }
            run += fast_log_sigmoid(z) * (1.0f / 16.0f); bt[t] = run; gb[(tok0 + t) * 256 + h * 64 + lane] = run;
        }
#pragma unroll
        for (int i = 0; i < 8; ++i) { *(LAS v4u*)(kd + (i * 8 + crow8) * 128 + cch * 16) = kreg[i]; *(LAS v4u*)(vh + (i * 8 + crow8) * 128 + cch * 16) = v0reg[i]; }
#pragma unroll
        for (int t = 0; t < 64; ++t) { LAS bf16* kp = (LAS bf16*)(kd + t * 128 + lane * 2); *kp = (bf16)f2bf(bf2f(*kp) * __expf(run - bt[t])); }
        dec[(size_t)u * 64 + lane] = __expf(run);
#pragma unroll
        for (int half = 0; half < 2; ++half) {
            if (half == 1) {
#pragma unroll
                for (int i = 0; i < 8; ++i) *(LAS v4u*)(vh + (i * 8 + crow8) * 128 + cch * 16) = v1reg[i];
            }
            f32x16 acc[2][2];
#pragma unroll
            for (int x = 0; x < 2; ++x)
#pragma unroll
                for (int y = 0; y < 2; ++y) acc[x][y] = f32x16{};
#pragma unroll
            for (int s = 0; s < 4; ++s) {
                bf16x8 af[2], bfr[2];
#pragma unroll
                for (int x = 0; x < 2; ++x) { af[x] = tr_frag(vh + (16 * s + 8 * hh + trow) * 128 + (32 * x + tcol) * 2, 4 * 128); bfr[x] = tr_frag(kd + (16 * s + 8 * hh + trow) * 128 + (32 * x + tcol) * 2, 4 * 128); }
#pragma unroll
                for (int x = 0; x < 2; ++x)
#pragma unroll
                    for (int y = 0; y < 2; ++y) acc[x][y] = __builtin_amdgcn_mfma_f32_32x32x16_bf16(af[x], bfr[y], acc[x][y], 0, 0, 0);
            }
#pragma unroll
            for (int x = 0; x < 2; ++x)
#pragma unroll
                for (int y = 0; y < 2; ++y) { float* lo = loc + (size_t)u * 8192 + 32 * y + (lane & 31);
#pragma unroll
                    for (int r = 0; r < 16; ++r) lo[(size_t)(64 * half + 32 * x + (r & 3) + 8 * (r >> 2) + 4 * hh) * 64] = acc[x][y][r]; }
        }
    }
}
__device__ __forceinline__ void gla_phase_b(const P& p, int vcu, int G) {
    int tid = threadIdx.x; asm volatile("" : "+v"(tid));
    float* loc = ((float*)p.out); const float* dec = WSP(float, WS_GDEC);
    for (int u = vcu; u < 256; u += G) {
        const int bh = u >> 2, q4 = u & 3;
        const int e = q4 * 2048 + tid * 4, dk = e & 63;
        f32x4 st = {0.f, 0.f, 0.f, 0.f};
#pragma unroll 2
        for (int c = 0; c < 32; ++c) {
            const size_t cu = (size_t)bh * 32 + c;
            const f32x4 lv = *(const f32x4*)(loc + cu * 8192 + e);
            const f32x4 dv = *(const f32x4*)(dec + cu * 64 + dk);
            asm volatile("s_waitcnt vmcnt(0)" ::: "memory");
            __syncthreads();
            v2u w; w.x = pk2(st.x, st.y); w.y = pk2(st.z, st.w);
            *(v2u*)((unsigned char*)loc + cu * 32768 + 8192 * q4 + 8 * tid) = w;
            st = dv * st + lv;
        }
    }
}
__device__ __forceinline__ void gla_phase_c(const P& p, int l, LAS unsigned char* lds, int vcu, int G) {
    int tid = threadIdx.x; asm volatile("" : "+v"(tid));
    const int lane = tid & 63, wave = __builtin_amdgcn_readfirstlane(tid >> 6), hh = lane >> 5, r32 = lane & 31;
    const bf16* proj = WSP(bf16, WS_PROJ); const unsigned char* gs = ((const unsigned char*)p.out); bf16* y = WSP(bf16, WS_Y); const float* gb = WSP(const float, WS_GB);
    const int dvb = wave >> 1, tb = wave & 1;
    const int trow = (lane & 15) >> 2, tcol = 16 * ((lane >> 4) & 1) + 4 * (lane & 3);
    bf16 n_q[8], n_k[8]; v4u n_v[2], n_g[2]; bf16x8 n_s[4]; f32x4 n_n[4]; float n_b[8], n_r = 0.f;
#define GC_LOAD(uu) do { const int c_ = (uu) & 31, h_ = ((uu) >> 5) & 3, b_ = (uu) >> 7; const size_t t0_ = (size_t)b_ * SEQ + c_ * 64; \
        _Pragma("unroll") for (int j = 0; j < 8; ++j) { const bf16* rp = proj + (t0_ + wave * 8 + j) * PW + h_ * 64 + lane; n_q[j] = rp[C_GQ]; n_k[j] = rp[C_GK]; } \
        _Pragma("unroll") for (int i = 0; i < 2; ++i) { const int idx = tid + NTHR * i, t = idx >> 4, cc = idx & 15; n_v[i] = *(const v4u*)(proj + (t0_ + t) * PW + C_GV + h_ * 128 + cc * 8); n_g[i] = *(const v4u*)(proj + (t0_ + t) * PW + C_GG + h_ * 128 + cc * 8); } \
        { const bf16* sp = (const bf16*)(gs + (size_t)(uu) * 32768 + 8192 * dvb) + r32 * 64 + 8 * hh; \
          _Pragma("unroll") for (int s2 = 0; s2 < 4; ++s2) n_s[s2] = *(const bf16x8*)(sp + 16 * s2); } \
        _Pragma("unroll") for (int j = 0; j < 8; ++j) n_b[j] = gb[(t0_ + wave * 8 + j) * 256 + h_ * 64 + lane]; \
        n_r = gb[(t0_ + 31) * 256 + h_ * 64 + lane]; \
        _Pragma("unroll") for (int g = 0; g < 4; ++g) { const int dv = 32 * dvb + 8 * g + 4 * hh; \
            n_n[g] = *(const f32x4*)(p.gla_gain + l * 512 + h_ * 128 + dv); } } while (0)
    if (vcu < 2048) GC_LOAD(vcu);
    for (int u = vcu; u < 2048; u += G) {
        const int c = u & 31, h = (u >> 5) & 3, b = u >> 7;
        const size_t tok0 = (size_t)b * SEQ + c * 64;
        bf16x8 sfr[4]; f32x4 gnr[4];
#pragma unroll
        for (int i = 0; i < 4; ++i) { sfr[i] = n_s[i]; gnr[i] = n_n[i]; }
#pragma unroll
        for (int i = 0; i < 2; ++i) { const int idx = tid + NTHR * i, t = idx >> 4, cc = idx & 15; *(LAS v4u*)(lds + GL_V + t * 320 + cc * 16) = n_v[i]; *(LAS v4u*)(lds + GL_GG + t * 272 + cc * 16) = n_g[i]; }
        { const float rref = n_r;
#pragma unroll
          for (int j = 0; j < 8; ++j) { const int t = wave * 8 + j; const float bt = n_b[j];
            const float qv = bf2f(n_q[j]), kv = bf2f(n_k[j]);
            *(LAS bf16*)(lds + GL_Q1 + t * 144 + lane * 2) = (bf16)f2bf(qv * __expf(bt));
            *(LAS bf16*)(lds + GL_Q2 + t * 144 + lane * 2) = (bf16)f2bf(qv * __expf(bt - rref));
            *(LAS bf16*)(lds + GL_K2 + t * 144 + lane * 2) = (bf16)f2bf(kv * __expf(rref - bt)); } }
        __syncthreads();
        if (u + G < 2048) GC_LOAD(u + G);
        f32x16 o = {};
        {
#pragma unroll
          for (int s = 0; s < 4; ++s) { const bf16x8 af = sfr[s]; const bf16x8 bq = *(const LAS bf16x8*)(lds + GL_Q1 + (32 * tb + r32) * 144 + (16 * s + 8 * hh) * 2);
              o = __builtin_amdgcn_mfma_f32_32x32x16_bf16(af, bq, o, 0, 0, 0); } }
#pragma unroll
        for (int sb = 0; sb < 2; ++sb) {
            if (sb <= tb) {
                f32x16 pt = {};
#pragma unroll
                for (int s = 0; s < 4; ++s) { const bf16x8 ak = *(const LAS bf16x8*)(lds + GL_K2 + (32 * sb + r32) * 144 + (16 * s + 8 * hh) * 2); const bf16x8 bq = *(const LAS bf16x8*)(lds + GL_Q2 + (32 * tb + r32) * 144 + (16 * s + 8 * hh) * 2);
                    pt = __builtin_amdgcn_mfma_f32_32x32x16_bf16(ak, bq, pt, 0, 0, 0); }
                if (sb == tb) {
#pragma unroll
                    for (int r = 0; r < 16; ++r) { const int s_ = (r & 3) + 8 * (r >> 2) + 4 * hh; if (s_ > r32) pt[r] = 0.f; }
                }
#pragma unroll
                for (int ks = 0; ks < 2; ++ks) {
                    const bf16x8 pa = pack8(pt, 8 * ks);
                    const bf16x8 vf = tr_frag(lds + GL_V + (32 * sb + 16 * ks + 4 * hh + trow) * 320 + (32 * dvb + tcol) * 2, 8 * 320);
                    o = __builtin_amdgcn_mfma_f32_32x32x16_bf16(vf, pa, o, 0, 0, 0);
                }
            }
        }
        float ss = 0.f;
#pragma unroll
        for (int r = 0; r < 16; ++r) ss += o[r] * o[r];
        ss += __shfl_xor(ss, 32);
        LAS float* sq = (LAS float*)(lds + GL_SSQ);
        if (hh == 0) sq[dvb * 64 + 32 * tb + r32] = ss;
        __syncthreads();
        const int t = 32 * tb + r32;
        const float tot = (sq[t] + sq[64 + t]) + (sq[128 + t] + sq[192 + t]);
        const float rs = rsqrtf(tot * (1.0f / 128.0f) + EPS);
#pragma unroll
        for (int g = 0; g < 4; ++g) {
            const int dv = 32 * dvb + 8 * g + 4 * hh;
            const f32x4 gn = gnr[g];
            const v2u gg = *(const LAS v2u*)(lds + GL_GG + t * 272 + dv * 2);
            const float g0 = bf2f((bf16)(gg.x & 0xffff)), g1 = bf2f((bf16)(gg.x >> 16)), g2 = bf2f((bf16)(gg.y & 0xffff)), g3 = bf2f((bf16)(gg.y >> 16));
            const float v0 = o[4 * g] * rs * gn.x * g0 * __builtin_amdgcn_rcpf(1.f + __expf(-g0)), v1 = o[4 * g + 1] * rs * gn.y * g1 * __builtin_amdgcn_rcpf(1.f + __expf(-g1));
            const float v2 = o[4 * g + 2] * rs * gn.z * g2 * __builtin_amdgcn_rcpf(1.f + __expf(-g2)), v3 = o[4 * g + 3] * rs * gn.w * g3 * __builtin_amdgcn_rcpf(1.f + __expf(-g3));
            v2u w; w.x = cvtpk(v0, v1); w.y = cvtpk(v2, v3);
            *(LAS v2u*)(lds + GL_YST + t * 272 + dv * 2) = w;
        }
        __syncthreads();
#pragma unroll
        for (int i = 0; i < 2; ++i) { const int idx = tid + NTHR * i, tr_ = idx >> 4, ch = idx & 15;
            st_b128(y + (tok0 + tr_) * DM + 512 + h * 128 + ch * 8, *(const LAS v4u*)(lds + GL_YST + tr_ * 272 + ch * 16)); }
    }
#undef GC_LOAD
}
__device__ __forceinline__ void fox_cumsum_phase(const P& p, int l, int vcu, int G) {
    int tid = threadIdx.x; asm volatile("" : "+v"(tid));
    const int lane = tid & 63, wave = __builtin_amdgcn_readfirstlane(tid >> 6);
    const float* sm = WSP(float, WS_SM); float* cb = WSP(float, WS_CB);
    for (int u = vcu * NWAVES + wave; u < NBATCH * 8; u += G * NWAVES) {
        const int b = u >> 3, h = u & 7;
        const float bias = p.b_forget[l * 8 + h];
        float v[32]; float run = 0.f;
#pragma unroll
        for (int j = 0; j < 32; ++j) { run += fast_log_sigmoid(sm[((size_t)b * SEQ + lane * 32 + j) * 32 + h] + bias); v[j] = run; }
        float pre = run;
#pragma unroll
        for (int o = 1; o < 64; o <<= 1) { const float t = __shfl_up(pre, o); if (lane >= o) pre += t; }
        pre -= run;
#pragma unroll
        for (int j = 0; j < 32; ++j) cb[((size_t)b * 8 + h) * SEQ + lane * 32 + j] = -(v[j] + pre) * LOG2E;
    }
}

__device__ __forceinline__ void fox_knorm_phase(const P& p, int vcu, int G) {
    int tid = threadIdx.x; asm volatile("" : "+v"(tid));
    const int lane = tid & 63, wave = __builtin_amdgcn_readfirstlane(tid >> 6);
    const bf16* proj = WSP(bf16, WS_PROJ); float* kn = WSP(float, WS_MOE + MO_KN);
    for (int task = vcu * NWAVES + wave; task < NBATCH * 8 * 32; task += G * NWAVES) {
        const int j = task & 31, h = (task >> 5) & 7, b = task >> 8;
        float mx = 0.f;
#pragma unroll
        for (int i = 0; i < 8; ++i) {
            const v4u w = *(const v4u*)(proj + ((size_t)b * SEQ + j * 64 + i * 8 + (lane >> 3)) * PW + C_FK + h * 64 + (lane & 7) * 8);
            const unsigned ww[4] = {w.x, w.y, w.z, w.w}; float ss = 0.f;
#pragma unroll
            for (int e = 0; e < 4; ++e) { const float a = __builtin_bit_cast(float, ww[e] << 16), c = __builtin_bit_cast(float, ww[e] & 0xffff0000u); ss += a * a + c * c; }
            ss += __shfl_xor(ss, 1); ss += __shfl_xor(ss, 2); ss += __shfl_xor(ss, 4);
            mx = fmaxf(mx, ss);
        }
        mx = wave_max(mx);
        if (lane == 0) kn[task] = sqrtf(mx) * 1.0001f;
    }
}
__device__ __forceinline__ void router_weights(const P& p, int gtid, int gstride) {
    for (int idx = gtid; idx < NLAYER * 32768; idx += gstride) {
        const int l = idx >> 15, r = idx & 32767, k = r >> 5, n = r & 31;
        float v = 0.f;
        if (n < 16) v = p.w_re[((size_t)l * DM + k) * 16 + n]; else if (n < 20) v = p.w_rg[((size_t)l * DM + k) * 4 + (n - 16)];
        v *= p.moe_norm[l * DM + k];
        float* wr = (float*)(ws_base(p.ws) + WS_W + (size_t)l * WS_WLAYER + WO_RHI);
        wr[((((k >> 5) * 4 + ((k >> 3) & 3)) * 2 + ((k >> 2) & 1)) * 32 + n) * 4 + (k & 3)] = v;
    }
}
__device__ __forceinline__ void route_phase(const P& p, int l, LAS unsigned char* lds, int vcu, int G) {
    int tid = threadIdx.x; asm volatile("" : "+v"(tid));
    const int lane = tid & 63, wave = __builtin_amdgcn_readfirstlane(tid >> 6);
    { const v4u* src = (const v4u*)(ws_base(p.ws) + WS_W + (size_t)l * WS_WLAYER + WO_RHI);
#pragma unroll 4
      for (int i = 0; i < 16; ++i) *(LAS v4u*)(lds + LDS_STAGE + (tid + NTHR * i) * 16) = src[tid + NTHR * i]; }
    LAS int* hist = (LAS int*)(lds + LDS_GATE);
    if (tid < 32) hist[tid] = 0;
    __syncthreads();
    const bf16* HBp = WSP(const bf16, WS_HB);
    int2* toke = WSP(int2, WS_MOE + MO_TOKE); float2* tokg = WSP(float2, WS_MOE + MO_TOKG);
    LAS float* lgb = (LAS float*)(lds + LDS_RS + wave * 2048);
    const int r = lane & 15, kq = lane >> 4;
    for (int task = vcu * NWAVES + wave; task < NTOK / 16; task += G * NWAVES) {
        const int tok0 = task * 16;
        const v4u* hp = (const v4u*)(HBp + (size_t)(tok0 + r) * DM + 8 * kq);
        f32x4 acc0 = {0.f, 0.f, 0.f, 0.f}, acc1 = {0.f, 0.f, 0.f, 0.f}; float q = 0.f;
#pragma unroll 8
        for (int s = 0; s < 32; ++s) {
            const v4u aw = hp[4 * s];
            const unsigned ww[4] = {aw.x, aw.y, aw.z, aw.w};
            const LAS unsigned char* bp = lds + LDS_STAGE + ((s * 4 + kq) * 2 * 32 + r) * 16;
            const f32x4 b00 = *(const LAS f32x4*)(bp), b01 = *(const LAS f32x4*)(bp + 32 * 16), b10 = *(const LAS f32x4*)(bp + 16 * 16), b11 = *(const LAS f32x4*)(bp + 48 * 16);
#pragma unroll
            for (int e = 0; e < 4; ++e) {
                const float a0 = __builtin_bit_cast(float, ww[e] << 16), a1 = __builtin_bit_cast(float, ww[e] & 0xffff0000u);
                q += a0 * a0 + a1 * a1;
                const f32x4& bl = e < 2 ? b00 : b01; const f32x4& bh = e < 2 ? b10 : b11;
                acc0 = __builtin_amdgcn_mfma_f32_16x16x4f32(a0, bl[(2 * e) & 3], acc0, 0, 0, 0); acc1 = __builtin_amdgcn_mfma_f32_16x16x4f32(a0, bh[(2 * e) & 3], acc1, 0, 0, 0);
                acc0 = __builtin_amdgcn_mfma_f32_16x16x4f32(a1, bl[(2 * e + 1) & 3], acc0, 0, 0, 0); acc1 = __builtin_amdgcn_mfma_f32_16x16x4f32(a1, bh[(2 * e + 1) & 3], acc1, 0, 0, 0);
            }
        }
        q += __shfl_xor(q, 16); q += __shfl_xor(q, 32);
        const float rsv = rsqrtf(q * (1.0f / DM) + EPS);
        const float bias0 = p.b_re[l * 16 + r], bias1 = r < 4 ? p.b_rg[l * 4 + r] : 0.f;
#pragma unroll
        for (int g = 0; g < 4; ++g) { const int row = 4 * kq + g; const float rs = __shfl(rsv, row);
            lgb[row * 32 + r] = acc0[g] * rs + bias0; lgb[row * 32 + 16 + r] = acc1[g] * rs + bias1; }
        LDS_WAIT();
        if (lane < 16) {
            const int tok = tok0 + lane;
            const LAS f32x4* lr = (const LAS f32x4*)(lgb + lane * 32);
            const f32x4 e0 = lr[0], e1 = lr[1], e2 = lr[2], e3 = lr[3], gl = lr[4];
            int g = 0; float gm = gl.x;
            if (gl.y > gm) { gm = gl.y; g = 1; } if (gl.z > gm) { gm = gl.z; g = 2; } if (gl.w > gm) { gm = gl.w; g = 3; }
            const float den = (expf(gl.x - gm) + expf(gl.y - gm)) + (expf(gl.z - gm) + expf(gl.w - gm));
            const float pg = 1.0f / den;
            const f32x4 el = g == 0 ? e0 : (g == 1 ? e1 : (g == 2 ? e2 : e3));
            int i0 = 0; float m0 = el.x;
            if (el.y > m0) { m0 = el.y; i0 = 1; } if (el.z > m0) { m0 = el.z; i0 = 2; } if (el.w > m0) { m0 = el.w; i0 = 3; }
            int i1 = -1; float m1 = -INFINITY;
            if (i0 != 0 && el.x > m1) { m1 = el.x; i1 = 0; } if (i0 != 1 && el.y > m1) { m1 = el.y; i1 = 1; }
            if (i0 != 2 && el.z > m1) { m1 = el.z; i1 = 2; } if (i0 != 3 && el.w > m1) { m1 = el.w; i1 = 3; }
            const float ex = expf(m1 - m0), inv = 1.0f / (1.0f + ex);
            const int ea = g * 4 + i0, eb = g * 4 + i1;
            toke[tok] = make_int2(ea, eb); tokg[tok] = make_float2(pg * inv, pg * ex * inv);
            atomicAdd((int*)&hist[ea], 1); atomicAdd((int*)&hist[16 + eb], 1);
        }
        LDS_WAIT();
    }
    __syncthreads();
    if (tid < 32) WSP(int, WS_MOE + MO_HIST)[vcu * 32 + tid] = hist[tid];
}
__device__ __forceinline__ void sort_phase(const P& p, LAS unsigned char* lds, int vcu, int G) {
    int tid = threadIdx.x; asm volatile("" : "+v"(tid));
    const int lane = tid & 63, wave = __builtin_amdgcn_readfirstlane(tid >> 6);
    LAS int* cnt = (LAS int*)(lds + LDS_GATE); LAS int* pre = cnt + 32; LAS int* base = cnt + 64; LAS int* ntl = cnt + 96;
    const int* histg = WSP(const int, WS_MOE + MO_HIST);
    int* rowtok = WSP(int, WS_MOE + MO_ROWTOK); float* rowgate = WSP(float, WS_MOE + MO_ROWGATE); int* tilee = WSP(int, WS_MOE + MO_TILEE); int* nt = WSP(int, WS_MOE + MO_NT);
    const int2* toke = WSP(const int2, WS_MOE + MO_TOKE); const float2* tokg = WSP(const float2, WS_MOE + MO_TOKG);
    { LAS int* part = (LAS int*)(lds + LDS_RS);
      const int j = tid & 31, part_i = tid >> 5; int c = 0, pr = 0;
      for (int w = part_i; w < G; w += 16) { const int v = histg[w * 32 + j]; if (w < vcu) pr += v; c += v; }
      part[part_i * 64 + j] = c; part[part_i * 64 + 32 + j] = pr;
      __syncthreads();
      if (tid < 32) { int cc = 0, pp = 0;
#pragma unroll
          for (int q = 0; q < 16; ++q) { cc += part[q * 64 + tid]; pp += part[q * 64 + 32 + tid]; }
          cnt[tid] = cc; pre[tid] = pp; } }
    __syncthreads();
    if (tid == 0) { int t = 0; for (int j = 0; j < 32; ++j) { base[j] = t * 256; const int n = (cnt[j] + 255) >> 8; ntl[j] = n; t += n; if (j == 15 && vcu == 0) nt[0] = t; } if (vcu == 0) nt[1] = t; }
    __syncthreads();
    if (vcu == 0 && tid < 32) { const int t0 = base[tid] >> 8; for (int i = 0; i < ntl[tid]; ++i) tilee[t0 + i] = tid & 15; }
    if (vcu < 32) { const int j = vcu, lo = base[j] + cnt[j], hi = base[j] + 256 * ntl[j]; for (int r = lo + tid; r < hi; r += NTHR) { rowtok[r] = -1; rowgate[r] = 0.f; } }
    if (wave < 2) {
        const int k = wave;
        int run[16];
#pragma unroll
        for (int e = 0; e < 16; ++e) run[e] = 0;
        for (int task0 = vcu * NWAVES; task0 < NTOK / 16; task0 += G * NWAVES) {
#pragma unroll 1
            for (int half = 0; half < 2; ++half) {
                const int tok = task0 * 16 + half * 64 + lane;
                const int2 ee = toke[tok]; const float2 gg = tokg[tok];
                const int e = k ? ee.y : ee.x; const float gt = k ? gg.y : gg.x;
                int rank = 0;
#pragma unroll
                for (int x = 0; x < 16; ++x) { const unsigned long long m = __ballot(e == x); if (e == x) rank = run[x] + __popcll(m & ((1ull << lane) - 1ull)); run[x] += __popcll(m); }
                const int pos = base[k * 16 + e] + pre[k * 16 + e] + rank;
                rowtok[pos] = tok; rowgate[pos] = gt;
            }
        }
    }
}
__device__ __forceinline__ void final_phase(const P& p, int vcu, int G) {
    int tid = threadIdx.x; asm volatile("" : "+v"(tid));
    const int lane = tid & 63, wave = __builtin_amdgcn_readfirstlane(tid >> 6);
    const float* ssq = WSP(const float, WS_SSQ); const bf16* hb = WSP(const bf16, WS_HB);
    f32x4 g[4];
#pragma unroll
    for (int j = 0; j < 4; ++j) g[j] = ((const f32x4*)p.final_norm)[lane + 64 * j];
    for (int m0 = (vcu * NWAVES + wave) * 4; m0 < NTOK; m0 += G * NWAVES * 4) {
        v2u w[4][4]; float rs[4];
#pragma unroll
        for (int r = 0; r < 4; ++r) { rs[r] = row_rs(ssq, m0 + r);
#pragma unroll
            for (int j = 0; j < 4; ++j) w[r][j] = ((const v2u*)(hb + (size_t)(m0 + r) * DM))[lane + 64 * j]; }
#pragma unroll
        for (int r = 0; r < 4; ++r) { f32x4* s = (f32x4*)(p.out + (size_t)(m0 + r) * DM) + lane;
#pragma unroll
            for (int j = 0; j < 4; ++j) { f32x4 v; v.x = __builtin_bit_cast(float, w[r][j].x << 16); v.y = __builtin_bit_cast(float, w[r][j].x & 0xffff0000u); v.z = __builtin_bit_cast(float, w[r][j].y << 16); v.w = __builtin_bit_cast(float, w[r][j].y & 0xffff0000u);
                s[64 * j] = v * rs[r] * g[j]; } }
    }
}
#ifndef ENMASK
#define ENMASK 0xffffffffu
#endif
#define EN(b) (((ENMASK) >> (b)) & 1u)
#ifndef REPMASK
#define REPMASK 0u
#endif
#define REPN(b) ((((REPMASK) >> (b)) & 1u) ? 2 : 1)
__device__ __attribute__((noinline)) void grid_barrier(unsigned* barw, unsigned x, volatile LAS unsigned* st) { XcdBarrier b; b.bar = barw; b.x = x; b.st = st; xcd_barrier(b); }
__global__ void __launch_bounds__(NTHR, 2) fwd(Args args) {
    extern __shared__ __attribute__((aligned(16))) unsigned char lds_raw[];
    LAS unsigned char* lds = (LAS unsigned char*)lds_raw;
    const P& p = args.p;
    const int tid = threadIdx.x, lane = tid & 63, wave = __builtin_amdgcn_readfirstlane(tid >> 6);
    const int G = gridDim.x; const int bx = blockIdx.x; const int vcu = (G % 8 == 0) ? (bx % 8) * (G / 8) + bx / 8 : bx;
    volatile LAS unsigned* MISC = (volatile LAS unsigned*)(lds + LDS_MISC);
    if (tid < 64) MISC[tid] = 0u;
    __syncthreads();
    unsigned* ctl = (unsigned*)(p.ws + WS_CTL);
    const int lo = args.ph_lo, hi = args.ph_hi;
    XcdBarrier bar; bar.bar = ctl + CW_BAR + args.li * XCD_BAR_WORDS; bar.x = 0; bar.st = nullptr;
    if (hi - lo > 1) bar = xcd_barrier_post(ctl + CW_BAR + args.li * XCD_BAR_WORDS, MISC);
#define IN(k) (lo <= (k) && (k) < hi)
#define PHL int vcuL = vcu, GL = G, bxL = bx; asm volatile("" : "+s"(vcuL), "+s"(GL), "+s"(bxL)); (void)vcuL; (void)GL; (void)bxL;
#define LTID(v) int v = threadIdx.x; asm volatile("" : "+v"(v))
#define FILL_RS_DENSE() do { LTID(tq); const int rr_ = tq & 255, hf_ = tq >> 8; f32x4 sv_[4][4]; bool ok_[4]; \
        _Pragma("unroll") for (int k_ = 0; k_ < 4; ++k_) { pg8::Unit u_; ok_[k_] = S.next(hf_ + 2 * k_, u_); const f32x4* sp_ = (const f32x4*)(SSQ + (size_t)(ok_[k_] ? u_.pm * 256 + rr_ : 0) * 16); \
            _Pragma("unroll") for (int j_ = 0; j_ < 4; ++j_) sv_[k_][j_] = sp_[j_]; } \
        _Pragma("unroll") for (int k_ = 0; k_ < 4; ++k_) if (ok_[k_]) { const f32x4 a_ = (sv_[k_][0] + sv_[k_][1]) + (sv_[k_][2] + sv_[k_][3]); rstab[(hf_ + 2 * k_) * 256 + rr_] = rsqrtf(((a_.x + a_.y) + (a_.z + a_.w)) * (1.0f / DM) + EPS); } } while (0)
#define FILL_GU() do { LTID(tq); const int rr_ = tq & 255, hf_ = tq >> 8; f32x4 sv_[4][4]; bool ok_[4]; int tk_[4]; \
        _Pragma("unroll") for (int k_ = 0; k_ < 4; ++k_) { pg8::Unit u_; ok_[k_] = S.next(hf_ + 2 * k_, u_); tk_[k_] = ok_[k_] ? ROWTOK[u_.pm * 256 + rr_] : 0; } \
        _Pragma("unroll") for (int k_ = 0; k_ < 4; ++k_) { tk_[k_] = tk_[k_] < 0 ? 0 : tk_[k_]; const f32x4* sp_ = (const f32x4*)(SSQ + (size_t)tk_[k_] * 16); \
            _Pragma("unroll") for (int j_ = 0; j_ < 4; ++j_) sv_[k_][j_] = sp_[j_]; } \
        _Pragma("unroll") for (int k_ = 0; k_ < 4; ++k_) if (ok_[k_]) { const f32x4 a_ = (sv_[k_][0] + sv_[k_][1]) + (sv_[k_][2] + sv_[k_][3]); rowtab[(hf_ + 2 * k_) * 256 + rr_] = tk_[k_]; \
            rstab[(hf_ + 2 * k_) * 256 + rr_] = rsqrtf(((a_.x + a_.y) + (a_.z + a_.w)) * (1.0f / DM) + EPS); } } while (0)
#define FILL_DOWN() do { LTID(tq); const int rr_ = tq & 255, hf_ = tq >> 8; bool ok_[4]; int tk_[4]; float gt_[4]; \
        _Pragma("unroll") for (int k_ = 0; k_ < 4; ++k_) { pg8::Unit u_; ok_[k_] = S.next(hf_ + 2 * k_, u_); const int r_ = ok_[k_] ? u_.pm * 256 + rr_ : 0; tk_[k_] = ROWTOK[r_]; gt_[k_] = ROWGATE[r_]; } \
        _Pragma("unroll") for (int k_ = 0; k_ < 4; ++k_) if (ok_[k_]) { rowtab[(hf_ + 2 * k_) * 256 + rr_] = tk_[k_]; gatetab[(hf_ + 2 * k_) * 256 + rr_] = gt_[k_]; } } while (0)

#define SEAM(k) do { if (IN(k) && IN((k) + 1)) { grid_barrier(bar.bar, bar.x, bar.st); if (REPN(20) == 2) grid_barrier(bar.bar, bar.x, bar.st); } } while (0)
    LAS float* rstab = (LAS float*)(lds + LDS_RS); LAS int* rowtab = (LAS int*)(lds + LDS_ROWTOK); LAS float* gatetab = (LAS float*)(lds + LDS_GATE);
#define HB WSP(bf16, WS_HB)
#define PROJ WSP(bf16, WS_PROJ)
#define Y WSP(bf16, WS_Y)
#define XKV WSP(bf16, WS_XKV)
#define MEMN WSP(bf16, WS_MEMN)
#define SSQ WSP(float, WS_SSQ)
#define XQ WSP(bf16, WS_XQ)
#define U WSP(bf16, WS_U)
#define ROWTOK WSP(const int, WS_MOE + MO_ROWTOK)
#define ROWGATE WSP(const float, WS_MOE + MO_ROWGATE)
#define TILEE WSP(const int, WS_MOE + MO_TILEE)
#define NT WSP(const int, WS_MOE + MO_NT)
#define H (p.out)
#define HB8 ((unsigned char*)p.out + 64 * MiB)
#define U8 WSP(unsigned char, WS_U)

    if (EN(0) && IN(PH_PRO)) _Pragma("unroll 1") for (int rep_ = 0; rep_ < REPN(0); ++rep_) { PHL prologue(p, lds, vcuL, GL, wave, lane); }
    SEAM(PH_PRO);
    if (REPN(18) == 2 && IN(PH_XKV)) { PHL
        pg8::StaticOrder S; S.init(HB, ws_base(p.ws) + WS_W + WO_IN, NTOK, 3072, DM, GL, bxL);
        FILL_RS_DENSE();
        __syncthreads();
        EpiBf16<true> E{PROJ, PW, rstab};
        pg8::gemm_phase<DM, EpiBf16<true>, pg8::StaticOrder, true>(lds + LDS_STAGE, S, E);
    }
    for (int l = 0; l < NLAYER; ++l) {
        const int pb = PH_L0 + l * NPH;
        unsigned char* wl = ws_base(p.ws) + WS_W + (size_t)l * WS_WLAYER;
        if (EN(2) && IN(pb + LP_INPROJ)) _Pragma("unroll 1") for (int rep_ = 0; rep_ < REPN(2); ++rep_) { PHL
            pg8::StaticOrder S; S.init(HB, wl + WO_IN, NTOK, 3072, DM, GL, bxL);
            FILL_RS_DENSE();
            __syncthreads();
            EpiBf16<true> E{PROJ, PW, rstab};
            pg8::gemm_phase<DM, EpiBf16<true>, pg8::StaticOrder, true>(lds + LDS_STAGE, S, E);
            _Pragma("unroll 1") for (int r2_ = 0; r2_ < REPN(19); ++r2_) small_proj(p, l, lds + LDS_STAGE, vcuL, GL, wave, lane);
        }
        SEAM(pb + LP_INPROJ);
        if (EN(11) && IN(pb + LP_MIXA)) _Pragma("unroll 1") for (int rep_ = 0; rep_ < REPN(11); ++rep_) { PHL gla_phase_a(p, l, lds + LDS_STAGE, vcuL, GL); fox_cumsum_phase(p, l, vcuL, GL); fox_knorm_phase(p, vcuL, GL); }
        SEAM(pb + LP_MIXA);
        if (EN(12) && IN(pb + LP_MIXB)) _Pragma("unroll 1") for (int rep_ = 0; rep_ < REPN(12); ++rep_) { PHL gla_phase_b(p, vcuL, GL); }
        if (EN(1) && l == 0 && IN(pb + LP_MIXB)) { PHL
            pg8::StaticOrder S; S.init(MEMN, ws_base(p.ws) + WS_WXKV, 4096, 2048, DM, GL, bxL);
            EpiBf16<false> E{XKV, 2048, rstab};
            pg8::gemm_phase<DM, EpiBf16<false>, pg8::StaticOrder, true>(lds + LDS_STAGE, S, E);
        }
        SEAM(pb + LP_MIXB);
        if (EN(9) && IN(pb + LP_MIXC)) { PHL _Pragma("unroll 1") for (int rep_ = 0; rep_ < REPN(16); ++rep_) fox_phase(p, l, lds + LDS_STAGE, vcuL, GL); _Pragma("unroll 1") for (int rep_ = 0; rep_ < REPN(17); ++rep_) gla_phase_c(p, l, lds + LDS_STAGE, vcuL, GL); }
        SEAM(pb + LP_MIXC);
        if (EN(3) && IN(pb + LP_WOUT)) _Pragma("unroll 1") for (int rep_ = 0; rep_ < REPN(3); ++rep_) { PHL
            pg8::StaticOrder S; S.init(Y, wl + WO_OUT, NTOK, DM, DM, GL, bxL);
            EpiRes<0> E{HB, SSQ, rowtab, gatetab, rep_ == REPN(3) - 1 ? 1.f : 0.f, Y, nullptr};
            pg8::gemm_phase<DM, EpiRes<0>, pg8::StaticOrder, true>(lds + LDS_STAGE, S, E);
        }
        SEAM(pb + LP_WOUT);
        if (EN(4) && IN(pb + LP_XQ)) _Pragma("unroll 1") for (int rep_ = 0; rep_ < REPN(4); ++rep_) { PHL
            pg8::StaticOrder S; S.init(HB, wl + WO_XQ, NTOK, 512, DM, GL, bxL);
            FILL_RS_DENSE();
            __syncthreads();
            EpiBf16<true> E{XQ, 512, rstab};
            pg8::gemm_phase<DM, EpiBf16<true>, pg8::StaticOrder, true>(lds + LDS_STAGE, S, E);
            asm volatile("s_waitcnt vmcnt(0)" ::: "memory"); __syncthreads();
            { pg8::Unit u; for (int iu = 0; S.next(iu, u); ++iu) { xattn_pair(p, l, lds + LDS_STAGE, u.pm, u.pn, rep_ != REPN(4) - 1); } }
        }
        SEAM(pb + LP_XQ);
        if (EN(5) && IN(pb + LP_XO)) _Pragma("unroll 1") for (int rep_ = 0; rep_ < REPN(5); ++rep_) { PHL
            pg8::StaticOrder S; S.init(WSP(unsigned char, WS_XO8), wl + WO_XO, NTOK, DM, 256, GL, bxL);
            EpiRes<0, true> E{HB, SSQ, rowtab, gatetab, rep_ == REPN(5) - 1 ? 1.f : 0.f, Y, HB8};
            pg8::gemm_phase<256, EpiRes<0, true>, pg8::StaticOrder, true, true, 127, 122>(lds + LDS_STAGE, S, E);
        }
        SEAM(pb + LP_XO);
        if (EN(13) && IN(pb + LP_ROUTE)) _Pragma("unroll 1") for (int rep_ = 0; rep_ < REPN(13); ++rep_) { PHL route_phase(p, l, lds, vcuL, GL); }
        SEAM(pb + LP_ROUTE);
        if (EN(14) && IN(pb + LP_SORT)) _Pragma("unroll 1") for (int rep_ = 0; rep_ < REPN(14); ++rep_) { PHL sort_phase(p, lds, vcuL, GL); }
        SEAM(pb + LP_SORT);
        if (EN(6) && IN(pb + LP_GU)) _Pragma("unroll 1") for (int rep_ = 0; rep_ < REPN(6); ++rep_) { PHL
            MoeOrder<0> S{(const char*)HB8, (const char*)(wl + WO_GU), 512, (size_t)1024 * 1024, 0, NT[1], GL, vcuL, TILEE, rowtab};
            FILL_GU();
            __syncthreads();
            EpiGU E{U8, rstab};
            pg8::gemm_phase<512, EpiGU, MoeOrder<0>, true, true, 127, 122>(lds + LDS_STAGE, S, E);
        }
        SEAM(pb + LP_GU);
        if (EN(7) && IN(pb + LP_DOWN0)) _Pragma("unroll 1") for (int rep_ = 0; rep_ < REPN(7); ++rep_) { PHL
            MoeOrder<1> S{(const char*)U8, (const char*)(wl + WO_D), 256, (size_t)1024 * 512, 0, NT[0], GL, vcuL, TILEE, rowtab};
            __syncthreads();
            FILL_DOWN();
            __syncthreads();
            EpiRes<1> E{HB, SSQ, rowtab, gatetab, 1.f, Y, nullptr};
            pg8::gemm_phase<256, EpiRes<1>, MoeOrder<1>, true, true, 125, 122>(lds + LDS_STAGE, S, E);
        }
        SEAM(pb + LP_DOWN0);
        if (EN(8) && IN(pb + LP_DOWN1)) _Pragma("unroll 1") for (int rep_ = 0; rep_ < REPN(8); ++rep_) { PHL
            MoeOrder<1> S{(const char*)U8, (const char*)(wl + WO_D), 256, (size_t)1024 * 512, NT[0], NT[1], GL, vcuL, TILEE, rowtab};
            __syncthreads();
            FILL_DOWN();
            __syncthreads();
            EpiRes<2> E{HB, SSQ, rowtab, gatetab, 1.f, Y, nullptr};
            pg8::gemm_phase<256, EpiRes<2>, MoeOrder<1>, true, true, 125, 122>(lds + LDS_STAGE, S, E);
        }
        SEAM(pb + LP_DOWN1);
    }
    if (EN(15) && IN(PH_FINAL)) _Pragma("unroll 1") for (int rep_ = 0; rep_ < REPN(15); ++rep_) { PHL final_phase(p, vcuL, GL); }
#undef IN
#undef SEAM
#undef HB
#undef PROJ
#undef Y
#undef XKV
#undef MEMN
#undef SSQ
#undef XQ
#undef U
#undef ROWTOK
#undef ROWGATE
#undef TILEE
#undef NT
#undef H
#undef HB8
#undef U8
}

static int g_grid = 0;
static void launch_fast(const P& p, int lo, int hi, int& li, hipStream_t stream) {
    Args a{}; a.p = p; a.ph_lo = lo; a.ph_hi = hi; a.li = li++; a.pad = 0;
    hipLaunchKernelGGL(fwd, dim3(g_grid), dim3(NTHR), LDS_BYTES, stream, a);
    const hipError_t le = hipPeekAtLastError();
    if (le != hipSuccess) fprintf(stderr, "kernel_launch: fwd launch [%d,%d) failed: %s\n", lo, hi, hipGetErrorName(le));
}
extern "C" void kernel_launch(void* const* d_in, const int* in_sizes, int n_in, void* d_out, int out_size, void* d_ws, size_t ws_size, hipStream_t stream) {
    if (n_in != 25 || out_size != NTOK * DM || ws_size < WS_END2) { fprintf(stderr, "kernel_launch: unexpected sizes n_in %d out %d ws %zu (need %zu)\n", n_in, out_size, ws_size, (size_t)WS_END2); return; }
    if (g_grid == 0) {
        int dev = 0, cus = 0, per_cu = 0;
        if (hipGetDevice(&dev) != hipSuccess || hipDeviceGetAttribute(&cus, hipDeviceAttributeMultiprocessorCount, dev) != hipSuccess) { g_grid = -1; return; }
        if (hipFuncSetAttribute((const void*)fwd, hipFuncAttributeMaxDynamicSharedMemorySize, LDS_BYTES) != hipSuccess) { fprintf(stderr, "kernel_launch: hipFuncSetAttribute failed\n"); g_grid = -1; return; }
        if (hipOccupancyMaxActiveBlocksPerMultiprocessor(&per_cu, (const void*)fwd, NTHR, LDS_BYTES) != hipSuccess || per_cu < 1) { fprintf(stderr, "kernel_launch: occupancy query says %d\n", per_cu); }
        (void)hipGetLastError();
        g_grid = cus;
    }
    if (g_grid < 0) return;
    P p{};
    const float** pp = (const float**)&p;
    for (int i = 0; i < 25; ++i) pp[i] = (const float*)d_in[i];
    p.out = (float*)d_out; p.ws = (unsigned char*)d_ws;
    if (hipMemsetAsync((char*)d_ws + WS_CTL, 0, 1 * MiB, stream) != hipSuccess) { fprintf(stderr, "kernel_launch: hipMemsetAsync failed\n"); return; }
    int li = 0;
    launch_fast(p, PH_PRO, PH_END, li, stream);
}
```

```cpp
#include <hip/hip_runtime.h>
#include <cstdio>
#include <cstdint>

constexpr int NTOK = 32768, DM = 1024, NBATCH = 16, SEQ = 2048, NLAYER = 2, MEML = 256;
constexpr int PW = 3072;
constexpr int C_FQ = 0, C_FK = 512, C_FV = 1024, C_GQ = 1536, C_GK = 1792, C_GV = 2048, C_GG = 2560;
constexpr int INW = 3096;
constexpr float EPS = 1e-6f, LOG2E = 1.4426950408889634f;
constexpr int MAXTILES = 288;
constexpr int MAXROWS = MAXTILES * 256;

typedef unsigned short bf16;
__device__ __forceinline__ unsigned f2bf(float f) { unsigned u = __builtin_bit_cast(unsigned, f); return (u + 0x7fffu + ((u >> 16) & 1u)) >> 16; }
__device__ __forceinline__ float bf2f(bf16 b) { return __builtin_bit_cast(float, ((unsigned)b) << 16); }

constexpr size_t MiB = 1u << 20;
constexpr size_t WS_CTL = 0;
constexpr size_t WS_W = 1 * MiB;
constexpr size_t WS_WLAYER = 59 * MiB;
constexpr size_t WS_WXKV = WS_W + 2 * WS_WLAYER;
constexpr size_t WS_HB = WS_WXKV + 4 * MiB;
constexpr size_t WS_PROJ = WS_HB + 64 * MiB;
constexpr size_t WS_XQ = WS_PROJ;
constexpr size_t WS_U = WS_PROJ + 32 * MiB;
constexpr size_t WS_XO8 = WS_U + 40 * MiB;
constexpr size_t WS_SM = WS_PROJ + 192 * MiB;
constexpr size_t WS_CB = WS_SM + 4 * MiB;
constexpr size_t WS_Y = WS_CB + 1 * MiB;
constexpr size_t WS_XKV = WS_Y + 64 * MiB;
constexpr size_t WS_MEMN = WS_XKV + 16 * MiB;
constexpr size_t WS_SSQ = WS_MEMN + 8 * MiB;
constexpr size_t WS_MOE = WS_SSQ + 2 * MiB;
constexpr size_t WS_END = WS_MOE + 2 * MiB;
static_assert(WS_END <= 512 * MiB, "workspace map");
constexpr size_t MO_TOKE = 0;
constexpr size_t MO_TOKG = 256 * 1024;
constexpr size_t MO_ROWTOK = 512 * 1024;
constexpr size_t MO_ROWGATE = 832 * 1024;
constexpr size_t MO_TILEE = 1152 * 1024;
constexpr size_t MO_NT = 1156 * 1024;
constexpr size_t MO_HIST = 1160 * 1024;
constexpr size_t MO_KN = 1280 * 1024;

struct P {
    const float *x, *mem, *mem_norm, *mix_norm, *w_in, *b_forget, *w_alpha_up, *b_alpha, *fox_gain, *gla_gain, *w_out, *cross_norm, *w_xq, *w_xk, *w_xv, *w_xo,
        *moe_norm, *w_rg, *b_rg, *w_re, *b_re, *w_eg, *w_eu, *w_ed, *final_norm;
    float* out; unsigned char* ws;
};
__host__ __device__ __forceinline__ unsigned char* ws_base(unsigned char* w) {
#if defined(__HIP_DEVICE_COMPILE__)
    size_t z = 0; asm volatile("" : "+s"(z));
    return w + z;
#else
    return w;
#endif
}
#define WSP(T, off) ((T*)(ws_base(p.ws) + (off)))

__device__ __forceinline__ float wave_sum(float v) {
#pragma unroll
    for (int o = 1; o < 64; o <<= 1) v += __shfl_xor(v, o);
    return v;
}
__device__ __forceinline__ float wave_min(float v) {
#pragma unroll
    for (int o = 1; o < 64; o <<= 1) v = fminf(v, __shfl_xor(v, o));
    return v;
}
__device__ __forceinline__ float wave_max(float v) {
#pragma unroll
    for (int o = 1; o < 64; o <<= 1) v = fmaxf(v, __shfl_xor(v, o));
    return v;
}
__device__ __forceinline__ float row_rs(const float* ssq, int row) {
    const float4* s = (const float4*)(ssq + (size_t)row * 16);
    float4 a = s[0], b = s[1], c = s[2], d = s[3];
    float t = ((a.x + a.y) + (a.z + a.w)) + ((b.x + b.y) + (b.z + b.w)) + ((c.x + c.y) + (c.z + c.w)) + ((d.x + d.y) + (d.z + d.w));
    return rsqrtf(t * (1.0f / DM) + EPS);
}
__device__ __forceinline__ float log_sigmoid(float z) { return fminf(z, 0.f) - log1pf(expf(-fabsf(z))); }
__device__ __forceinline__ float silu(float z) { return z / (1.f + expf(-z)); }

typedef unsigned st_v4u __attribute__((ext_vector_type(4)));
typedef unsigned st_v2u __attribute__((ext_vector_type(2)));
#ifndef WT_STORES
#define WT_STORES 0
#endif
__device__ __forceinline__ void st_b128(void* p, st_v4u v) {
#if WT_STORES
    asm volatile("global_store_dwordx4 %0, %1, off sc1\n\ts_nop 1" :: "v"(p), "v"(v) : "memory");
#else
    *(st_v4u*)p = v;
#endif
}
__device__ __forceinline__ void st_b128_wt(void* p, st_v4u v) { asm volatile("global_store_dwordx4 %0, %1, off sc1\n\ts_nop 1" :: "v"(p), "v"(v) : "memory"); }
__device__ __forceinline__ void st_b64(void* p, st_v2u v) {
#if WT_STORES
    asm volatile("global_store_dwordx2 %0, %1, off sc1" :: "v"(p), "v"(v) : "memory");
#else
    *(st_v2u*)p = v;
#endif
}
#define XB_TMO      128
#define XB_XCNT(j)  (256  + 64 * (j))
#define XB_XSUB(j)  (1280 + 64 * (j))
#define XB_XGEN(j)  (2304 + 64 * (j))
#define XB_TOP      3328
#define XB_TOPGEN   3392
#define XCD_BAR_WORDS 3456
#define XB_SPIN_CAP (1u << 18)
#define LAS __attribute__((address_space(3)))

__device__ __forceinline__ unsigned xb_ld(unsigned* p)              { return __hip_atomic_load(p, __ATOMIC_RELAXED, __HIP_MEMORY_SCOPE_AGENT); }
__device__ __forceinline__ unsigned xb_add(unsigned* p, unsigned v) { return __hip_atomic_fetch_add(p, v, __ATOMIC_RELAXED, __HIP_MEMORY_SCOPE_AGENT); }
__device__ __forceinline__ unsigned xb_xcc_id() { return (unsigned)__builtin_amdgcn_s_getreg((3 << 11) | 20) & 0xFu; }
#define XB_SPIN(cond, bar) do { unsigned _sp = 0; while (cond) { __builtin_amdgcn_s_sleep(1); \
    if ((++_sp & 255u) == 0u) { if (xb_ld(&(bar)[XB_TMO])) break; if (_sp > XB_SPIN_CAP) { atomicAdd(&(bar)[XB_TMO], 1u); break; } } } } while (0)

struct XcdBarrier {
    unsigned* bar; unsigned x;
    volatile LAS unsigned* st;
};

__device__ __forceinline__ XcdBarrier xcd_barrier_post(unsigned* bar, volatile LAS unsigned* st) {
    XcdBarrier b; b.bar = bar; b.x = xb_xcc_id(); b.st = st;
    if (threadIdx.x == 0) (void)xb_add(&bar[XB_XCNT(b.x)], 1u);
    return b;
}
__device__ __forceinline__ void xcd_barrier_complete(unsigned* bar, unsigned x, unsigned& nloc, unsigned& nx) {
    const unsigned G = gridDim.x * gridDim.y * gridDim.z;
    unsigned sum, cnt, mine, sp = 0u;
    for (;;) {
        sum = 0u; cnt = 0u; mine = 0u;
#pragma unroll
        for (unsigned j = 0; j < 16; ++j) { const unsigned c = xb_ld(&bar[XB_XCNT(j)]); sum += c; cnt += (c > 0u) ? 1u : 0u; mine = (j == x) ? c : mine; }
        if (sum == G) break;
        __builtin_amdgcn_s_sleep(1);
        if ((++sp & 255u) == 0u) { if (xb_ld(&bar[XB_TMO])) break; if (sp > XB_SPIN_CAP) { atomicAdd(&bar[XB_TMO], 1u); break; } }
    }
    nloc = mine > 0u ? mine : 1u; nx = cnt > 0u ? cnt : 1u;
}

__device__ __forceinline__ void xcd_barrier(const XcdBarrier& b) {
    asm volatile("s_waitcnt vmcnt(0)" ::: "memory");
    __syncthreads();
    if (threadIdx.x == 0) {
        unsigned* bar = b.bar;
        __builtin_amdgcn_s_waitcnt(0);
        unsigned nloc = b.st[0], nx = b.st[1];
        if (nloc == 0u) { xcd_barrier_complete(bar, b.x, nloc, nx); b.st[0] = nloc; b.st[1] = nx; }
        const unsigned old = xb_add(&bar[XB_XSUB(b.x)], 1u);
        const unsigned gen = old / nloc;
        if (old + 1u == (gen + 1u) * nloc) {
            __builtin_amdgcn_fence(__ATOMIC_RELEASE, "agent");
            asm volatile("s_waitcnt vmcnt(0)" ::: "memory");
            const unsigned og = xb_add(&bar[XB_TOP], 1u);
            const unsigned tg = og / nx;
            if (og + 1u == (tg + 1u) * nx) xb_add(&bar[XB_TOPGEN], 1u);
            else XB_SPIN(xb_ld(&bar[XB_TOPGEN]) == tg, bar);
            __builtin_amdgcn_fence(__ATOMIC_ACQUIRE, "agent");
            xb_add(&bar[XB_XGEN(b.x)], 1u);
            asm volatile("s_waitcnt vmcnt(0)" ::: "memory");
        } else {
            XB_SPIN(xb_ld(&bar[XB_XGEN(b.x)]) == gen, bar);
            __builtin_amdgcn_fence(__ATOMIC_ACQUIRE, "agent");
            asm volatile("s_waitcnt vmcnt(0)" ::: "memory");
        }
    }
    __syncthreads();
}

namespace pg8 {
#define PG8_LAS __attribute__((address_space(3)))
typedef unsigned short bf16_t;
typedef short bf16x8 __attribute__((ext_vector_type(8)));
typedef float f32x4 __attribute__((ext_vector_type(4)));
typedef unsigned u32x4 __attribute__((ext_vector_type(4)));
typedef unsigned u32x2 __attribute__((ext_vector_type(2)));
constexpr int BM = 256, BK = 64, HALF = 128, HTB = HALF * BK * 2, STAGE_BYTES = 8 * HTB, NXCD = 8, WGM = 8;

__host__ __device__ __forceinline__ int lds_byte(int r, int c) { const int st = (r >> 4) * 2 + (c >> 5), rr = r & 15, cc = c & 31, ob = rr * 64 + cc * 2; return st * 1024 + (ob ^ (((ob >> 9) & 1) << 5)); }
__host__ __device__ __forceinline__ void stage_rc(int b, int& R, int& C) { const int st = b / 1024, sb = b % 1024, swz = sb ^ (((sb >> 9) & 1) << 5); R = (st >> 1) * 16 + swz / 64; C = (st & 1) * 32 + (swz % 64) / 2; }
__host__ __device__ __forceinline__ int perm32(int rho) { const int n = rho >> 4, i = rho & 15; return 8 * (i >> 2) + 4 * n + (i & 3); }

struct Unit { int pm, pn, e; };

struct StaticOrder {
    static constexpr bool GATHER = false;
    static constexpr size_t KSTEP_A = 128;
    const char* A; const char* Bt; int K; int nM, nN, nwg, G, c;
    __device__ void init(const void* A_, const void* Bt_, int M, int N, int K_, int G_, int c_) { A = (const char*)A_; Bt = (const char*)Bt_; K = K_; nM = M / BM; nN = N / BM; nwg = nM * nN; G = G_; c = c_; }
    __device__ bool next(int i, Unit& u) const {
        const long L = (long)i * G + c; if (L >= nwg) return false;
        int wgid = (int)L; { const int q = nwg / NXCD, r = nwg % NXCD, xcd = wgid % NXCD, off = wgid / NXCD; wgid = (xcd < r ? xcd * (q + 1) : r * (q + 1) + (xcd - r) * q) + off; }
        const int nig = WGM * nN, gid = wgid / nig, fm = gid * WGM, gsz = (nM - fm) < WGM ? (nM - fm) : WGM;
        u.pm = fm + ((wgid % nig) % gsz); u.pn = (wgid % nig) / gsz; u.e = 0; return true;
    }
    __device__ __forceinline__ const char* a_base(const Unit& u) const { return A + (size_t)u.pm * (size_t)(BM * 2) * K; }
    __device__ __forceinline__ const char* b_base(const Unit& u) const { return Bt + (size_t)u.pn * (size_t)(BM * 2) * K; }
    __device__ __forceinline__ unsigned a_off(int, int, int, int) const { return 0u; }
};

__device__ __forceinline__ unsigned cvt_pk_bf16(float lo, float hi) { unsigned r; asm volatile("v_cvt_pk_bf16_f32 %0, %1, %2" : "=v"(r) : "v"(lo), "v"(hi)); return r; }

typedef int i32x8 __attribute__((ext_vector_type(8)));
typedef int i32x4 __attribute__((ext_vector_type(4)));
template <int K, class Epi, class Sched, bool ALIGN_EPI, bool FP8 = false, int SA = 127, int SB = 127>
__device__ __forceinline__ void gemm_phase(PG8_LAS unsigned char* lds, const Sched& S, const Epi& E) {
    int tid_ = threadIdx.x; asm volatile("" : "+v"(tid_));
    const int tid = tid_, wid = __builtin_amdgcn_readfirstlane(tid >> 6), lane = tid & 63, wr = wid >> 2, wc = wid & 3, fr = lane & 15, fq = lane >> 4;
    constexpr int nt = K / BK;
    constexpr int NH = Sched::GATHER ? 2 : 1;
    unsigned voffB[2], cvA[NH][2], nvA[NH][2];
#pragma unroll
    for (int i = 0; i < 2; ++i) { int R, C; stage_rc(tid * 16 + i * 8192, R, C); const int Rb = Epi::PERM ? ((R & ~31) + perm32(R & 31)) : R;
        voffB[i] = (unsigned)(Rb * K + C) * 2u;
        cvA[0][i] = nvA[0][i] = (unsigned)(R * K + C) * 2u; if constexpr (NH == 2) { cvA[NH - 1][i] = nvA[NH - 1][i] = cvA[0][i]; } }
    constexpr size_t kstep = (size_t)(BK * 2);
    constexpr size_t hstep = (size_t)HALF * K * 2;
    constexpr size_t hstepA = Sched::GATHER ? (size_t)0 : hstep;
    constexpr size_t kstepA = Sched::KSTEP_A;
    const unsigned ldsw = (unsigned)wid * 1024u;
    const int aoff = lds_byte(wr * 64 + fr, fq * 8), boff = lds_byte(wc * 32 + fr, fq * 8);
#define PG8_SA(b, h) (((b) * 2 + (h)) * HTB)
#define PG8_SB(b, h) ((4 + (b) * 2 + (h)) * HTB)
#define PG8_STAGE(bufoff, gbase, voff) do { _Pragma("unroll") for (int _i = 0; _i < 2; ++_i) \
        __builtin_amdgcn_global_load_lds((const unsigned*)((const char*)(gbase) + (voff)[_i]), (PG8_LAS unsigned*)(lds + (bufoff) + ldsw + _i * 8192), 16, 0, 0); } while (0)
#define PG8_LD32(addr) __builtin_shufflevector(*(const PG8_LAS i32x4*)(addr), *(const PG8_LAS i32x4*)((addr) + 1024), 0, 1, 2, 3, 4, 5, 6, 7)
#define PG8_LDA(dst, b, h) do { _Pragma("unroll") for (int m = 0; m < 4; ++m) dst[m] = PG8_LD32(lds + PG8_SA(b, h) + aoff + m * 2048); } while (0)
#define PG8_LDB(dst, b, h) do { _Pragma("unroll") for (int n = 0; n < 2; ++n) dst[n] = PG8_LD32(lds + PG8_SB(b, h) + boff + n * 2048); } while (0)
#define PG8_H0(x) __builtin_bit_cast(bf16x8, __builtin_shufflevector((x), (x), 0, 1, 2, 3))
#define PG8_H1(x) __builtin_bit_cast(bf16x8, __builtin_shufflevector((x), (x), 4, 5, 6, 7))
#define PG8_MMA(ai, bj, At, Bt) do { __builtin_amdgcn_s_setprio(1); _Pragma("unroll") for (int m = 0; m < 4; ++m) _Pragma("unroll") for (int n = 0; n < 2; ++n) { \
        if constexpr (FP8) asm volatile("v_mfma_scale_f32_16x16x128_f8f6f4 %0, %1, %2, %0, %3, %4 op_sel_hi:[0,0,0]" : "+v"(acc[ai][bj][m][n]) : "v"(Bt[n]), "v"(At[m]), "v"(sbv), "v"(sav)); \
        else { acc[ai][bj][m][n] = __builtin_amdgcn_mfma_f32_16x16x32_bf16(PG8_H0(Bt[n]), PG8_H0(At[m]), acc[ai][bj][m][n], 0, 0, 0); \
               acc[ai][bj][m][n] = __builtin_amdgcn_mfma_f32_16x16x32_bf16(PG8_H1(Bt[n]), PG8_H1(At[m]), acc[ai][bj][m][n], 0, 0, 0); } } \
        __builtin_amdgcn_s_setprio(0); } while (0)
#define PG8_WAIT_V(n) asm volatile("s_waitcnt vmcnt(" #n ")" ::: "memory")
#define PG8_WAIT_L(n) asm volatile("s_waitcnt lgkmcnt(" #n ")" ::: "memory")
#define PG8_BAR __builtin_amdgcn_s_barrier()
#define PG8_SCHED __builtin_amdgcn_sched_barrier(0)
    int sav = SA, sbv = SB; asm volatile("" : "+v"(sav), "+v"(sbv));
    Unit cur, nxt; int ui = 0;
    if (!S.next(0, cur)) return;
    f32x4 acc[2][2][4][2];
#pragma unroll
    for (int a = 0; a < 2; ++a)
#pragma unroll
        for (int b = 0; b < 2; ++b)
#pragma unroll
            for (int m = 0; m < 4; ++m)
#pragma unroll
                for (int n = 0; n < 2; ++n) acc[a][b][m][n] = (f32x4){0.f, 0.f, 0.f, 0.f};
    i32x8 At[4], B0[2], B1[2];
    const char* cA = S.a_base(cur); const char* cB = S.b_base(cur);
    if constexpr (Sched::GATHER) {
        int R0, C0, R1, C1; stage_rc(tid * 16, R0, C0); stage_rc(tid * 16 + 8192, R1, C1);
#pragma unroll
        for (int h = 0; h < 2; ++h) { cvA[h][0] = S.a_off(0, h, R0, C0 * 2); cvA[h][1] = S.a_off(0, h, R1, C1 * 2); }
    }
    PG8_STAGE(PG8_SB(0, 0), cB, voffB); PG8_STAGE(PG8_SB(0, 1), cB + hstep, voffB); PG8_STAGE(PG8_SA(0, 0), cA, cvA[0]); PG8_STAGE(PG8_SA(0, 1), cA + hstepA, cvA[NH - 1]);
    if (wr == 1) PG8_BAR;
    PG8_WAIT_V(2); PG8_BAR;
    PG8_STAGE(PG8_SB(1, 0), cB + kstep, voffB); PG8_STAGE(PG8_SA(1, 0), cA + kstepA, cvA[0]); PG8_STAGE(PG8_SB(1, 1), cB + hstep + kstep, voffB);
    PG8_WAIT_V(6); PG8_BAR;
    for (;;) {
        const bool has_next = S.next(ui + 1, nxt);
        const char* nA = has_next ? S.a_base(nxt) : cA; const char* nB = has_next ? S.b_base(nxt) : cB;
        if constexpr (Sched::GATHER) {
            if (has_next) {
                int t2 = threadIdx.x; asm volatile("" : "+v"(t2));
                int R0, C0, R1, C1; stage_rc(t2 * 16, R0, C0); stage_rc(t2 * 16 + 8192, R1, C1);
#pragma unroll
                for (int h = 0; h < 2; ++h) { nvA[h][0] = S.a_off(ui + 1, h, R0, C0 * 2); nvA[h][1] = S.a_off(ui + 1, h, R1, C1 * 2); }
            } else {
#pragma unroll
                for (int h = 0; h < 2; ++h) { nvA[h][0] = cvA[h][0]; nvA[h][1] = cvA[h][1]; }
            }
        }
#pragma unroll 1
        for (int t = 0; t < nt; t += 2) {
            const bool last = (t == nt - 2);
            const char* a1 = cA + (size_t)(t + 1) * kstepA;
            const char* a2 = last ? nA : cA + (size_t)(t + 2) * kstepA; const char* b2 = last ? nB : cB + (size_t)(t + 2) * kstep;
            const char* a3 = a2 + kstepA; const char* b3 = b2 + kstep;
            unsigned v2[NH][2];
#pragma unroll
            for (int h = 0; h < NH; ++h) { if constexpr (Sched::GATHER) { v2[h][0] = last ? nvA[h][0] : cvA[h][0]; v2[h][1] = last ? nvA[h][1] : cvA[h][1]; } else { v2[h][0] = cvA[h][0]; v2[h][1] = cvA[h][1]; } }
            PG8_LDB(B0, 0, 0); PG8_LDB(B1, 0, 1); PG8_SCHED; PG8_LDA(At, 0, 0); PG8_STAGE(PG8_SA(1, 1), a1 + hstepA, cvA[NH - 1]);
            PG8_WAIT_V(8); PG8_WAIT_L(0); PG8_BAR; PG8_MMA(0, 0, At, B0); PG8_MMA(0, 1, At, B1); PG8_BAR; PG8_SCHED;
            PG8_LDA(At, 0, 1); PG8_STAGE(PG8_SB(0, 0), b2, voffB); PG8_STAGE(PG8_SB(0, 1), b2 + hstep, voffB); PG8_STAGE(PG8_SA(0, 0), a2, v2[0]);
            PG8_WAIT_V(8); PG8_WAIT_L(0); PG8_BAR; PG8_MMA(1, 0, At, B0); PG8_MMA(1, 1, At, B1); PG8_BAR; PG8_SCHED;
            PG8_LDB(B0, 1, 0); PG8_LDB(B1, 1, 1); PG8_SCHED; PG8_LDA(At, 1, 0); PG8_STAGE(PG8_SA(0, 1), a2 + hstepA, v2[NH - 1]);
            PG8_WAIT_V(8); PG8_WAIT_L(0); PG8_BAR; PG8_MMA(0, 0, At, B0); PG8_MMA(0, 1, At, B1); PG8_BAR; PG8_SCHED;
            PG8_LDA(At, 1, 1); PG8_STAGE(PG8_SB(1, 0), b3, voffB); PG8_STAGE(PG8_SB(1, 1), b3 + hstep, voffB); PG8_STAGE(PG8_SA(1, 0), a3, v2[0]);
            PG8_WAIT_V(8); PG8_WAIT_L(0); PG8_BAR; PG8_MMA(1, 0, At, B0); PG8_MMA(1, 1, At, B1); PG8_BAR; PG8_SCHED;
        }
        if constexpr (ALIGN_EPI) { if (wr == 0) PG8_BAR; }
        if constexpr (FP8) asm volatile("s_nop 15\n\ts_nop 15" ::: "memory");
        E(acc, cur, ui, wr, wc, fr, fq);
        if (!has_next) break;
#pragma unroll
        for (int a = 0; a < 2; ++a)
#pragma unroll
            for (int b = 0; b < 2; ++b)
#pragma unroll
                for (int m = 0; m < 4; ++m)
#pragma unroll
                    for (int n = 0; n < 2; ++n) acc[a][b][m][n] = (f32x4){0.f, 0.f, 0.f, 0.f};
        cur = nxt; cA = nA; cB = nB; ++ui;
        if constexpr (Sched::GATHER) {
#pragma unroll
            for (int h = 0; h < NH; ++h) { cvA[h][0] = nvA[h][0]; cvA[h][1] = nvA[h][1]; }
        }
        if constexpr (ALIGN_EPI) { if (wr == 1) PG8_BAR; }
    }
    PG8_WAIT_V(0);
    if constexpr (!ALIGN_EPI) { if (wr == 0) PG8_BAR; }
    PG8_BAR;
#undef PG8_SA
#undef PG8_SB
#undef PG8_STAGE
#undef PG8_LDA
#undef PG8_LDB
#undef PG8_MMA
#undef PG8_LD32
#undef PG8_H0
#undef PG8_H1
#undef PG8_WAIT_V
#undef PG8_WAIT_L
#undef PG8_BAR
#undef PG8_SCHED
}
}
#define GAS __attribute__((address_space(1)))
typedef float f32x4 __attribute__((ext_vector_type(4)));
typedef float f32x16 __attribute__((ext_vector_type(16)));
typedef short bf16x8 __attribute__((ext_vector_type(8)));
typedef unsigned v4u __attribute__((ext_vector_type(4)));
typedef unsigned v2u __attribute__((ext_vector_type(2)));
#define LDS_WAIT() asm volatile("s_waitcnt lgkmcnt(0)" ::: "memory")
#define VM_WAIT() asm volatile("s_waitcnt vmcnt(0)" ::: "memory")
__device__ __forceinline__ unsigned pk2(float lo, float hi) { return f2bf(lo) | (f2bf(hi) << 16); }

constexpr int NWAVES = 8, NTHR = 512;
constexpr int LDS_STAGE = 0;
constexpr int LDS_RS = 131072;
constexpr int LDS_ROWTOK = LDS_RS + 8192;
constexpr int LDS_GATE = LDS_ROWTOK + 8192;
constexpr int LDS_MISC = LDS_GATE + 8192;
constexpr int LDS_BYTES = LDS_MISC + 256;
constexpr size_t WO_IN = 0, WO_SM = 6 * MiB, WO_RHI = 6 * MiB + 65536, WO_RLO = 6 * MiB + 131072, WO_OUT = 7 * MiB, WO_XQ = 9 * MiB, WO_XO = 10 * MiB, WO_GU = 11 * MiB, WO_D = 43 * MiB;
static_assert(WO_D + 16 * MiB <= WS_WLAYER, "weight block");
constexpr int CW_BAR = 4096;
constexpr int MAX_LAUNCH = 40;
static_assert((CW_BAR + MAX_LAUNCH * XCD_BAR_WORDS) * 4 <= (int)(1 * MiB), "ctl");

enum { PH_PRO = 0, PH_XKV = 1, PH_L0 = 2, NPH = 13, PH_FINAL = PH_L0 + NLAYER * NPH, PH_END = PH_FINAL + 1 };
enum { LP_INPROJ = 0, LP_MIXA, LP_MIXB, LP_MIXC, LP_WOUT, LP_XQ, LP_XATTN, LP_XO, LP_ROUTE, LP_SORT, LP_GU, LP_DOWN0, LP_DOWN1 };

struct Args { P p; int ph_lo, ph_hi, li, pad; };

#ifndef WT_PROJ
#define WT_PROJ 0
#endif
template <bool HAS_RS> struct EpiBf16 {
    static constexpr bool PERM = true;
    bf16* O; int ldc; const LAS float* rstab;
    __device__ __forceinline__ void operator()(const pg8::f32x4 (&acc)[2][2][4][2], const pg8::Unit& u, int iu, int wr, int wc, int fr, int fq) const {
#pragma unroll
        for (int ai = 0; ai < 2; ++ai)
#pragma unroll
            for (int m = 0; m < 4; ++m) {
                const int lrow = ai * 128 + wr * 64 + m * 16 + fr;
                float sc = 1.f; if (HAS_RS) sc = rstab[iu * 256 + lrow];
                bf16* rowp = O + (size_t)(u.pm * 256 + lrow) * ldc + u.pn * 256 + wc * 32 + 8 * fq;
#pragma unroll
                for (int bj = 0; bj < 2; ++bj) { const pg8::f32x4 v0 = acc[ai][bj][m][0] * sc, v1 = acc[ai][bj][m][1] * sc;
                    pg8::u32x4 w; w.x = pg8::cvt_pk_bf16(v0[0], v0[1]); w.y = pg8::cvt_pk_bf16(v0[2], v0[3]); w.z = pg8::cvt_pk_bf16(v1[0], v1[1]); w.w = pg8::cvt_pk_bf16(v1[2], v1[3]);
                    if (WT_PROJ) st_b128_wt(rowp + bj * 128, w); else st_b128(rowp + bj * 128, w); }
            }
    }
};
__device__ __forceinline__ unsigned pk4_fp8(float a, float b, float c, float d) { int w = __builtin_amdgcn_cvt_pk_fp8_f32(a, b, 0, false); w = __builtin_amdgcn_cvt_pk_fp8_f32(c, d, w, true); return (unsigned)w; }
struct EpiGU {
    static constexpr bool PERM = true;
    unsigned char* U8; const LAS float* rstab;
    __device__ __forceinline__ void operator()(const pg8::f32x4 (&acc)[2][2][4][2], const pg8::Unit& u, int iu, int wr, int wc, int fr, int fq) const {
#pragma unroll
        for (int ai = 0; ai < 2; ++ai)
#pragma unroll
            for (int m = 0; m < 4; ++m) {
                const int lrow = ai * 128 + wr * 64 + m * 16 + fr;
                const float sc = rstab[iu * 256 + lrow];
                float o[8];
#pragma unroll
                for (int n = 0; n < 2; ++n)
#pragma unroll
                    for (int j = 0; j < 4; ++j) { const float g = acc[ai][0][m][n][j] * sc, uu = acc[ai][1][m][n][j] * sc; o[n * 4 + j] = 4.f * g * uu * __builtin_amdgcn_rcpf(1.f + __expf(-g)); }
                pg8::u32x2 w; w.x = pk4_fp8(o[0], o[1], o[2], o[3]); w.y = pk4_fp8(o[4], o[5], o[6], o[7]);
                st_b64(U8 + (size_t)(u.pm * 256 + lrow) * 512 + u.pn * 128 + wc * 32 + 8 * fq, w);
            }
    }
};
template <int MODE, bool W8 = false> struct EpiRes {
    static constexpr bool PERM = true;
    static constexpr bool MOE = MODE != 0;
    bf16* hb; float* ssq; const LAS int* rowtab; const LAS float* gatetab; float gs; bf16* t0; unsigned char* h8;
    static __device__ __forceinline__ void unpack8(const pg8::u32x4& w, float (&f)[8]) {
        f[0] = __builtin_bit_cast(float, w.x << 16); f[1] = __builtin_bit_cast(float, w.x & 0xffff0000u); f[2] = __builtin_bit_cast(float, w.y << 16); f[3] = __builtin_bit_cast(float, w.y & 0xffff0000u);
        f[4] = __builtin_bit_cast(float, w.z << 16); f[5] = __builtin_bit_cast(float, w.z & 0xffff0000u); f[6] = __builtin_bit_cast(float, w.w << 16); f[7] = __builtin_bit_cast(float, w.w & 0xffff0000u); }
    __device__ __forceinline__ void operator()(const pg8::f32x4 (&acc)[2][2][4][2], const pg8::Unit& u, int iu, int wr, int wc, int fr, int fq) const {
#pragma unroll
        for (int ai = 0; ai < 2; ++ai)
#pragma unroll
            for (int m = 0; m < 4; ++m) {
                const int lrow = ai * 128 + wr * 64 + m * 16 + fr;
                int row = u.pm * 256 + lrow; float g = gs;
                if (MOE) { row = rowtab[iu * 256 + lrow]; g = gatetab[iu * 256 + lrow] * gs; }
                const bool ok = !MOE || row >= 0;
                const size_t off = (size_t)(ok ? row : 0) * DM + u.pn * 256 + wc * 32 + 8 * fq;
                float q = 0.f;
                if (ok) {
#pragma unroll
                    for (int bj = 0; bj < 2; ++bj) {
                        float o[8];
#pragma unroll
                        for (int j = 0; j < 4; ++j) { o[j] = acc[ai][bj][m][0][j] * g; o[4 + j] = acc[ai][bj][m][1][j] * g; }
                        if (MODE == 1) { pg8::u32x4 w; w.x = pg8::cvt_pk_bf16(o[0], o[1]); w.y = pg8::cvt_pk_bf16(o[2], o[3]); w.z = pg8::cvt_pk_bf16(o[4], o[5]); w.w = pg8::cvt_pk_bf16(o[6], o[7]); st_b128(t0 + off + bj * 128, w); }
                        else {
                            float bs[8]; unpack8(*(const pg8::u32x4*)(hb + off + bj * 128), bs);
                            if (MODE == 2) { float tv[8]; unpack8(*(const pg8::u32x4*)(t0 + off + bj * 128), tv);
#pragma unroll
                                for (int j = 0; j < 8; ++j) bs[j] += tv[j]; }
#pragma unroll
                            for (int j = 0; j < 8; ++j) o[j] += bs[j];
                            pg8::u32x4 w; w.x = pg8::cvt_pk_bf16(o[0], o[1]); w.y = pg8::cvt_pk_bf16(o[2], o[3]); w.z = pg8::cvt_pk_bf16(o[4], o[5]); w.w = pg8::cvt_pk_bf16(o[6], o[7]);
                            float r[8]; unpack8(w, r);
#pragma unroll
                            for (int j = 0; j < 8; ++j) q += r[j] * r[j];
                            st_b128(hb + off + bj * 128, w);
                            if (W8) { pg8::u32x2 w8; w8.x = pk4_fp8(o[0], o[1], o[2], o[3]); w8.y = pk4_fp8(o[4], o[5], o[6], o[7]); st_b64(h8 + off + bj * 128, w8); } }
                    }
                }
                if (MODE != 1) { q += __shfl_xor(q, 16); q += __shfl_xor(q, 32); if (fq == 0 && ok) ssq[(size_t)row * 16 + u.pn * 4 + wc] = q; }
            }
    }
};
template <int MODE> struct MoeOrder {
    static constexpr bool GATHER = MODE == 0;
    static constexpr size_t KSTEP_A = 128;
    const char* A; const char* Bt; int K; size_t estride; int lo, hi, G, c; const int* tilee; const LAS int* rowtab;
    __device__ bool next(int i, pg8::Unit& u) const { const int L = i * G + c, t = lo + (L >> 2); if (t >= hi) return false; u.pm = t; u.pn = L & 3; u.e = tilee[t]; return true; }
    __device__ __forceinline__ const char* a_base(const pg8::Unit& u) const { return GATHER ? A : A + (size_t)u.pm * (size_t)512 * K; }
    __device__ __forceinline__ const char* b_base(const pg8::Unit& u) const { return Bt + (size_t)u.e * estride + (size_t)u.pn * (size_t)512 * K; }
    __device__ __forceinline__ unsigned a_off(int iu, int h, int R, int Cb) const { return (unsigned)rowtab[iu * 256 + h * 128 + R] * (unsigned)(K * 2) + (unsigned)Cb; }
};

__device__ __forceinline__ void router_weights(const P& p, int gtid, int gstride);
__device__ __forceinline__ void tr_item(const float* W, int N, int K, int k0, int n0, const float* gain, float scale, bf16* dst, LAS float* scr, int lane) {
    const int kr = lane >> 3, c4 = lane & 7;
    f32x4 v[8];
#pragma unroll
    for (int i = 0; i < 8; ++i) v[i] = *(const f32x4*)(W + (size_t)(k0 + 8 * i + kr) * N + n0 + 4 * c4);
#pragma unroll
    for (int i = 0; i < 8; ++i) { const int kk = 8 * i + kr; float g = scale; if (gain) g *= gain[k0 + kk];
        LAS float* d = scr + kk * 33 + 4 * c4; d[0] = v[i].x * g; d[1] = v[i].y * g; d[2] = v[i].z * g; d[3] = v[i].w * g; }
    LDS_WAIT();
    const int c = lane & 7;
#pragma unroll
    for (int j = 0; j < 4; ++j) { const int n = (lane >> 3) + 8 * j; const LAS float* s = scr + (8 * c) * 33 + n;
        v4u o; o.x = pk2(s[0 * 33], s[1 * 33]); o.y = pk2(s[2 * 33], s[3 * 33]); o.z = pk2(s[4 * 33], s[5 * 33]); o.w = pk2(s[6 * 33], s[7 * 33]);
        st_b128(dst + (size_t)n * K + k0 + 8 * c, o); }
    LDS_WAIT();
}
__device__ __forceinline__ void tr_item8(const float* W, int N, int K, int k0, int n0, const float* gain, float scale, unsigned char* dst, LAS float* scr, int lane) {
    const int kr = lane >> 3, c4 = lane & 7;
    f32x4 v[8];
#pragma unroll
    for (int i = 0; i < 8; ++i) v[i] = *(const f32x4*)(W + (size_t)(k0 + 8 * i + kr) * N + n0 + 4 * c4);
#pragma unroll
    for (int i = 0; i < 8; ++i) { const int kk = 8 * i + kr; float g = scale; if (gain) g *= gain[k0 + kk];
        LAS float* d = scr + kk * 33 + 4 * c4; d[0] = v[i].x * g; d[1] = v[i].y * g; d[2] = v[i].z * g; d[3] = v[i].w * g; }
    LDS_WAIT();
    const int c = lane & 7;
#pragma unroll
    for (int j = 0; j < 4; ++j) { const int n = (lane >> 3) + 8 * j; const LAS float* s = scr + (8 * c) * 33 + n;
        v2u o; o.x = pk4_fp8(s[0 * 33], s[1 * 33], s[2 * 33], s[3 * 33]); o.y = pk4_fp8(s[4 * 33], s[5 * 33], s[6 * 33], s[7 * 33]);
        st_b64(dst + (size_t)n * K + k0 + 8 * c, o); }
    LDS_WAIT();
}
constexpr int IT_LAYER = 15360;
__device__ __forceinline__ void prologue_item(const P& p, int it, LAS float* scr, int lane) {
    const int l = it / IT_LAYER; int r = it % IT_LAYER;
    unsigned char* wl = ws_base(p.ws) + WS_W + (size_t)l * WS_WLAYER;
    if (r < 1536) {
        const int seg = r / 768; r %= 768; const int kb = r / 48, nb = r % 48; const int n0 = (seg ? 1544 : 0) + 32 * nb, drow = seg * 1536 + 32 * nb;
        const float sc = drow < 512 ? 0.125f * LOG2E : ((drow >= C_GQ && drow < C_GK) ? 0.125f : 1.f);
        tr_item(p.w_in + (size_t)l * DM * INW, INW, DM, 64 * kb, n0, p.mix_norm + l * DM, sc, (bf16*)(wl + WO_IN) + (size_t)drow * DM, scr, lane); return; }
    r -= 1536;
    if (r < 512) { const int kb = r / 32, nb = r % 32; tr_item(p.w_out + (size_t)l * DM * DM, DM, DM, 64 * kb, 32 * nb, nullptr, 1.f, (bf16*)(wl + WO_OUT) + (size_t)(32 * nb) * DM, scr, lane); return; }
    r -= 512;
    if (r < 256) { const int kb = r / 16, nb = r % 16; tr_item(p.w_xq + (size_t)l * DM * 512, 512, DM, 64 * kb, 32 * nb, p.cross_norm + l * DM, 0.08838834764831845f * LOG2E, (bf16*)(wl + WO_XQ) + (size_t)(32 * nb) * DM, scr, lane); return; }
    r -= 256;
    if (r < 256) { const int kb = r / 32, nb = r % 32; tr_item8(p.w_xo + (size_t)l * 512 * DM, DM, 512, 64 * kb, 32 * nb, nullptr, 32.f, (unsigned char*)(wl + WO_XO) + (size_t)(32 * nb) * 512, scr, lane); return; }
    r -= 256;
    if (r < 512) { const int kv = r / 256; r %= 256; const int kb = r / 16, nb = r % 16;
        tr_item((kv ? p.w_xv : p.w_xk) + (size_t)l * DM * 512, 512, DM, 64 * kb, 32 * nb, nullptr, 1.f, (bf16*)(ws_base(p.ws) + WS_WXKV) + (size_t)(l * 1024 + kv * 512 + 32 * nb) * DM, scr, lane); return; }
    r -= 512;
    if (r < 8192) { const int up = r / 4096; r %= 4096; const int e = r / 256; r %= 256; const int kb = r / 16, nb = r % 16; const int c0 = 32 * nb, drow = (c0 >> 7) * 256 + up * 128 + (c0 & 127);
        tr_item8((up ? p.w_eu : p.w_eg) + ((size_t)l * 16 + e) * DM * 512, 512, DM, 64 * kb, c0, p.moe_norm + l * DM, 32.f, (unsigned char*)(wl + WO_GU) + ((size_t)e * 1024 + drow) * DM, scr, lane); return; }
    r -= 8192;
    { const int e = r / 256; r %= 256; const int kb = r / 32, nb = r % 32;
      tr_item8(p.w_ed + ((size_t)l * 16 + e) * 512 * DM, DM, 512, 64 * kb, 32 * nb, nullptr, 32.f, (unsigned char*)(wl + WO_D) + ((size_t)e * 1024 + 32 * nb) * 512, scr, lane); }
}
__device__ __forceinline__ void row_to_bf16(const float* src, bf16* dst, float* ssq, const float* gain, int lane, int mode) {
    const f32x4* s = (const f32x4*)src + lane;
    f32x4 v[4]; float q = 0.f;
#pragma unroll
    for (int j = 0; j < 4; ++j) { v[j] = s[64 * j]; q += (v[j].x * v[j].x + v[j].y * v[j].y) + (v[j].z * v[j].z + v[j].w * v[j].w); }
    q = wave_sum(q);
    float sc = 1.f;
    if (mode == 1) sc = rsqrtf(q * (1.0f / DM) + EPS);
    v2u* d = (v2u*)dst + lane; float q2 = 0.f;
#pragma unroll
    for (int j = 0; j < 4; ++j) {
        f32x4 g = (f32x4){1.f, 1.f, 1.f, 1.f}; if (mode == 1) g = ((const f32x4*)gain)[lane + 64 * j];
        v2u o; o.x = pk2(v[j].x * sc * g.x, v[j].y * sc * g.y); o.y = pk2(v[j].z * sc * g.z, v[j].w * sc * g.w); st_b64(d + 64 * j, o);
        const float r0 = __builtin_bit_cast(float, o.x << 16), r1 = __builtin_bit_cast(float, o.x & 0xffff0000u), r2 = __builtin_bit_cast(float, o.y << 16), r3 = __builtin_bit_cast(float, o.y & 0xffff0000u);
        q2 += (r0 * r0 + r1 * r1) + (r2 * r2 + r3 * r3); }
    if (mode == 0) { q2 = wave_sum(q2); if (lane < 16) ssq[lane] = lane == 0 ? q2 : 0.f; }
}
__device__ __forceinline__ void prologue(const P& p, LAS unsigned char* lds, int vcu, int G, int wave, int lane) {
    asm volatile("" : "+v"(lane));
    LAS float* scr = (LAS float*)(lds + LDS_STAGE + wave * 16384);
    const int gw = vcu * NWAVES + wave, NGW = G * NWAVES;
    for (int it = gw; it < NLAYER * IT_LAYER; it += NGW) prologue_item(p, it, scr, lane);
    for (int idx = gw * 64 + lane; idx < NLAYER * 2 * 32768; idx += NGW * 64) {
        const int l = idx / 65536, r = idx % 65536, which = r / 32768, e = r % 32768, row = e & 31, k = e >> 5;
        unsigned char* wl = ws_base(p.ws) + WS_W + (size_t)l * WS_WLAYER;
        if (which == 0) {
            float v = 0.f;
            if (row < 8) v = p.w_in[((size_t)l * DM + k) * INW + 1536 + row]; else if (row < 24) v = p.w_in[((size_t)l * DM + k) * INW + 3080 + (row - 8)];
            ((bf16*)(wl + WO_SM))[row * 1024 + k] = (bf16)f2bf(v * p.mix_norm[l * DM + k]);
        }
    }
    router_weights(p, gw * 64 + lane, NGW * 64);
    for (int m = gw; m < 4096; m += NGW) row_to_bf16(p.mem + (size_t)m * DM, WSP(bf16, WS_MEMN) + (size_t)m * DM, nullptr, p.mem_norm, lane, 1);
    { bf16* hbp = WSP(bf16, WS_HB); float* sqp = WSP(float, WS_SSQ);
      for (int m0 = gw * 4; m0 < NTOK; m0 += NGW * 4) {
        f32x4 v[4][4];
#pragma unroll
        for (int r = 0; r < 4; ++r)
#pragma unroll
            for (int j = 0; j < 4; ++j) v[r][j] = ((const f32x4*)(p.x + (size_t)(m0 + r) * DM))[lane + 64 * j];
#pragma unroll
        for (int r = 0; r < 4; ++r) { float q2 = 0.f; v2u* d = (v2u*)(hbp + (size_t)(m0 + r) * DM) + lane;
#pragma unroll
            for (int j = 0; j < 4; ++j) { v2u o; o.x = pk2(v[r][j].x, v[r][j].y); o.y = pk2(v[r][j].z, v[r][j].w); st_b64(d + 64 * j, o);
                const float r0 = __builtin_bit_cast(float, o.x << 16), r1 = __builtin_bit_cast(float, o.x & 0xffff0000u), r2 = __builtin_bit_cast(float, o.y << 16), r3 = __builtin_bit_cast(float, o.y & 0xffff0000u);
                q2 += (r0 * r0 + r1 * r1) + (r2 * r2 + r3 * r3); }
            q2 = wave_sum(q2); if (lane < 16) sqp[(size_t)(m0 + r) * 16 + lane] = lane == 0 ? q2 : 0.f; }
      } }
}
__device__ __forceinline__ void small_proj(const P& p, int l, LAS unsigned char* lds, int vcu, int G, int wave, int lane) {
    asm volatile("" : "+v"(lane));
    const bf16* wsm = (const bf16*)(ws_base(p.ws) + WS_W + (size_t)l * WS_WLAYER + WO_SM);
    const bf16* hb = WSP(bf16, WS_HB); const float* ssq = WSP(float, WS_SSQ); float* sm = WSP(float, WS_SM);
    constexpr int BST = 2048 + 16;
    { const int tid = wave * 64 + lane;
#pragma unroll
      for (int i = 0; i < 8; ++i) { const int idx = tid + NTHR * i, row = idx >> 7, c = idx & 127; *(LAS v4u*)(lds + row * BST + c * 16) = *(const v4u*)(wsm + row * 1024 + c * 8); } }
    __syncthreads();
    const int r = lane & 15, kq = lane >> 4;
    for (int blk = vcu * NWAVES + wave; blk < NTOK / 16; blk += G * NWAVES) {
        const int tok0 = blk * 16;
        const bf16x8* ap = (const bf16x8*)(hb + (size_t)(tok0 + r) * DM + kq * 32);
        pg8::f32x4 acc0 = {0.f, 0.f, 0.f, 0.f}, acc1 = {0.f, 0.f, 0.f, 0.f};
#pragma unroll
        for (int half = 0; half < 2; ++half) {
            bf16x8 af[16];
#pragma unroll
            for (int i = 0; i < 16; ++i) af[i] = ap[(half * 4 + (i >> 2)) * 16 + (i & 3)];
#pragma unroll
            for (int i = 0; i < 16; ++i) { const int s_ = half * 4 + (i >> 2), j = i & 3;
                const bf16x8 b0 = *(const LAS bf16x8*)(lds + r * BST + (128 * s_ + 32 * kq + 8 * j) * 2);
                const bf16x8 b1 = *(const LAS bf16x8*)(lds + (16 + r) * BST + (128 * s_ + 32 * kq + 8 * j) * 2);
                acc0 = __builtin_amdgcn_mfma_f32_16x16x32_bf16(af[i], b0, acc0, 0, 0, 0);
                acc1 = __builtin_amdgcn_mfma_f32_16x16x32_bf16(af[i], b1, acc1, 0, 0, 0);
                if ((i & 3) == 3) __builtin_amdgcn_sched_barrier(0); }
        }
        const float rsv = row_rs(ssq, tok0 + r);
#pragma unroll
        for (int g = 0; g < 4; ++g) { const int trow = 4 * kq + g; const float rs = __shfl(rsv, trow);
            sm[(size_t)(tok0 + trow) * 32 + r] = acc0[g] * rs; if (r < 8) sm[(size_t)(tok0 + trow) * 32 + 16 + r] = acc1[g] * rs; }
    }
    __syncthreads();
}
typedef short v4i16_t __attribute__((ext_vector_type(4)));
typedef __bf16 bf16x2_t __attribute__((ext_vector_type(2)));
typedef float f32x2_t __attribute__((ext_vector_type(2)));
__device__ __forceinline__ unsigned cvtpk(float lo, float hi) { f32x2_t v = {lo, hi}; bf16x2_t b = __builtin_convertvector(v, bf16x2_t); return __builtin_bit_cast(unsigned, b); }
__device__ __forceinline__ bf16x8 pack8(const f32x16& p, int o) {
    v4u w; w.x = cvtpk(p[o], p[o + 1]); w.y = cvtpk(p[o + 2], p[o + 3]); w.z = cvtpk(p[o + 4], p[o + 5]); w.w = cvtpk(p[o + 6], p[o + 7]);
    return __builtin_bit_cast(bf16x8, w);
}
__device__ __forceinline__ float max3f(float a, float b, float c) { float r; asm("v_max3_f32 %0, %1, %2, %3" : "=v"(r) : "v"(a), "v"(b), "v"(c)); return r; }
template <int D, bool FOX, bool OUT8 = false>
__device__ __forceinline__ void attn_unit(LAS unsigned char* lds, const bf16* Qg, int qpitch, const bf16* Kg, const bf16* Vg, int kvpitch, int NT,
                                          const float* cb, int q0, bf16* Og, int opitch, const float* gain, const float* kn) {
    constexpr int KS = D * 2 + 16, VS = D * 2 + 64;
    constexpr int KBYTES = 64 * KS, VBYTES = 64 * VS;
    constexpr int CPR = D / 8, NCH = 64 * CPR / NTHR, NS = D / 16, NDB = D / 32;
    constexpr int OFF_K = 0, OFF_V = 2 * KBYTES, OFF_CB = 2 * KBYTES + 2 * VBYTES, OFF_FX = OFF_CB + 512;
    int tid = threadIdx.x; asm volatile("" : "+v"(tid));
    const int lane = tid & 63, wave = __builtin_amdgcn_readfirstlane(tid >> 6), r32 = lane & 31, hh = lane >> 5;
    bf16x8 qf[NS];
    { const bf16* qrow = Qg + (size_t)(wave * 32 + r32) * qpitch;
#pragma unroll
      for (int s = 0; s < NS; ++s) qf[s] = *(const bf16x8*)(qrow + 16 * s + 8 * hh); }
    v4u kreg[NCH], vreg[NCH]; f32x4 cbreg = {0.f, 0.f, 0.f, 0.f};
#define AT_GLOAD(t) do { _Pragma("unroll") for (int i_ = 0; i_ < NCH; ++i_) { const int idx_ = tid + NTHR * i_, key_ = idx_ / CPR, c_ = idx_ % CPR; \
        kreg[i_] = *(const v4u*)(Kg + (size_t)((t) * 64 + key_) * kvpitch + c_ * 8); vreg[i_] = *(const v4u*)(Vg + (size_t)((t) * 64 + key_) * kvpitch + c_ * 8); } \
        if (FOX && tid < 16) cbreg = *(const f32x4*)(cb + (t) * 64 + tid * 4); } while (0)
#define AT_LSTORE(b) do { _Pragma("unroll") for (int i_ = 0; i_ < NCH; ++i_) { const int idx_ = tid + NTHR * i_, key_ = idx_ / CPR, c_ = idx_ % CPR; \
        *(LAS v4u*)(lds + OFF_K + (b) * KBYTES + key_ * KS + c_ * 16) = kreg[i_]; *(LAS v4u*)(lds + OFF_V + (b) * VBYTES + key_ * VS + c_ * 16) = vreg[i_]; } \
        if (FOX && tid < 16) *(LAS f32x4*)(lds + OFF_CB + (b) * 256 + tid * 16) = cbreg; } while (0)
    float m = -INFINITY, l = 0.f;
    f32x16 osum = f32x16{};
    f32x16 o[NDB];
#pragma unroll
    for (int d = 0; d < NDB; ++d) o[d] = f32x16{};
    const int qlo = q0 + wave * 32, qabs = qlo + r32;
    float knpre = 0.f, qkmax = 0.f;
    LAS float* fx = (LAS float*)(lds + OFF_FX);
    __syncthreads();
    if (FOX) {
        float qn2 = 0.f;
#pragma unroll
        for (int s = 0; s < NS; ++s)
#pragma unroll
            for (int e = 0; e < 8; ++e) { const float v = __builtin_bit_cast(float, ((unsigned)(unsigned short)qf[s][e]) << 16); qn2 += v * v; }
        qn2 += __shfl_xor(qn2, 32);
        qn2 = wave_max(qn2);
        if (lane == 0) fx[wave] = qn2;
        knpre = lane < 32 ? kn[lane] : 0.f;
#pragma unroll
        for (int o_ = 1; o_ < 32; o_ <<= 1) { const float t_ = __shfl_up(knpre, o_); if (lane >= o_) knpre = fmaxf(knpre, t_); }
    }
    const int t_first = FOX ? NT - 1 : 0;
    AT_GLOAD(t_first); AT_LSTORE(0);
    __syncthreads();
    if (FOX) { float q2 = fx[0];
#pragma unroll
        for (int w_ = 1; w_ < 8; ++w_) q2 = fmaxf(q2, fx[w_]);
        qkmax = sqrtf(q2); }
#pragma unroll 1
    for (int it = 0; it < NT; ++it) {
        const int b = it & 1;
        const int t = FOX ? NT - 1 - it : it;
        const int tn = FOX ? t - 1 : t + 1;
        if (it + 1 < NT) AT_GLOAD(tn);
        const int kt0 = t * 64;
        if (!FOX || kt0 <= qlo + 31) {
            f32x16 p[2];
#pragma unroll
            for (int kb = 0; kb < 2; ++kb) {
                if (FOX) {
#pragma unroll
                    for (int g = 0; g < 4; ++g) { const f32x4 c4 = *(const LAS f32x4*)(lds + OFF_CB + b * 256 + (kb * 32 + 8 * g + 4 * hh) * 4); p[kb][4 * g] = c4.x; p[kb][4 * g + 1] = c4.y; p[kb][4 * g + 2] = c4.z; p[kb][4 * g + 3] = c4.w; }
                } else p[kb] = f32x16{};
                const LAS unsigned char* kp = lds + OFF_K + b * KBYTES + (kb * 32 + r32) * KS + hh * 16;
#pragma unroll
                for (int s = 0; s < NS; ++s) { const bf16x8 kf = *(const LAS bf16x8*)(kp + s * 32); p[kb] = __builtin_amdgcn_mfma_f32_32x32x16_bf16(kf, qf[s], p[kb], 0, 0, 0); }
            }
            if (FOX && kt0 + 63 > qlo) {
#pragma unroll
                for (int kb = 0; kb < 2; ++kb)
#pragma unroll
                    for (int r = 0; r < 16; ++r) { const int key = kt0 + kb * 32 + (r & 3) + 8 * (r >> 2) + 4 * hh; if (key > qabs) p[kb][r] = -INFINITY; }
            }
            float mt = fmaxf(p[1][0], p[0][0]);
#pragma unroll
            for (int r = 1; r < 16; ++r) mt = max3f(mt, p[0][r], p[1][r]);
            mt = fmaxf(mt, __shfl_xor(mt, 32));
            const float mnew = fmaxf(m, mt);
            float ls = 0.f;
#pragma unroll
            for (int kb = 0; kb < 2; ++kb)
#pragma unroll
                for (int r = 0; r < 16; ++r) { const float e = __builtin_amdgcn_exp2f(p[kb][r] - mnew); p[kb][r] = e; if (!FOX) ls += e; }
            if (!FOX || __builtin_amdgcn_ballot_w64(mnew > m) != 0ull) {
                const float alpha = __builtin_amdgcn_exp2f(m - mnew);
                l *= alpha; if (FOX) osum[0] *= alpha;
#pragma unroll
                for (int d = 0; d < NDB; ++d)
#pragma unroll
                    for (int r = 0; r < 16; ++r) o[d][r] *= alpha;
            }
            m = mnew; l += ls;
            bf16x8 pa[2][2];
#pragma unroll
            for (int kb = 0; kb < 2; ++kb) { pa[kb][0] = pack8(p[kb], 0); pa[kb][1] = pack8(p[kb], 8); }
            const LAS unsigned char* vp = lds + OFF_V + b * VBYTES + (4 * hh + ((lane & 15) >> 2)) * VS + (16 * ((lane >> 4) & 1) + 4 * (lane & 3)) * 2;
#pragma unroll
            for (int d = 0; d < NDB; ++d) {
#pragma unroll
                for (int kb = 0; kb < 2; ++kb)
#pragma unroll
                    for (int ks = 0; ks < 2; ++ks) {
                        const LAS unsigned char* a0 = vp + (kb * 32 + 16 * ks) * VS + d * 64;
                        const v4i16_t lo = __builtin_amdgcn_ds_read_tr16_b64_v4i16((LAS v4i16_t*)a0);
                        const v4i16_t hi = __builtin_amdgcn_ds_read_tr16_b64_v4i16((LAS v4i16_t*)(a0 + 8 * VS));
                        const bf16x8 vf = (bf16x8){lo[0], lo[1], lo[2], lo[3], hi[0], hi[1], hi[2], hi[3]};
                        o[d] = __builtin_amdgcn_mfma_f32_32x32x16_bf16(vf, pa[kb][ks], o[d], 0, 0, 0);
                    }
            }
            if (FOX) {
                const bf16x8 ones = __builtin_bit_cast(bf16x8, (v4u){0x3F803F80u, 0x3F803F80u, 0x3F803F80u, 0x3F803F80u});
#pragma unroll
                for (int kb = 0; kb < 2; ++kb)
#pragma unroll
                    for (int ks = 0; ks < 2; ++ks) osum = __builtin_amdgcn_mfma_f32_32x32x16_bf16(ones, pa[kb][ks], osum, 0, 0, 0);
            }
        }
        if (FOX) { const float mm = wave_min(m); if (lane == 0) fx[8 + b * 8 + wave] = mm; }
        if (it + 1 < NT) AT_LSTORE(b ^ 1);
        __syncthreads();
        if (FOX && t > 0) {
            float M0 = fx[8 + b * 8];
#pragma unroll
            for (int w_ = 1; w_ < 8; ++w_) M0 = fminf(M0, fx[8 + b * 8 + w_]);
            const float cbl = *(const LAS float*)(lds + OFF_CB + (b ^ 1) * 256 + 63 * 4);
            const float knb = __builtin_bit_cast(float, __builtin_amdgcn_readlane(__builtin_bit_cast(int, knpre), t - 1));
            if (qkmax * knb + cbl < M0 - 40.f) break;
        }
    }
#undef AT_GLOAD
#undef AT_LSTORE
    if (FOX) l = osum[0]; else l += __shfl_xor(l, 32);
    const float inv = 1.0f / l;
    float rs = inv;
    if (FOX) {
        float ss = 0.f;
#pragma unroll
        for (int d = 0; d < NDB; ++d)
#pragma unroll
            for (int r = 0; r < 16; ++r) { const float v = o[d][r] * inv; ss += v * v; }
        ss += __shfl_xor(ss, 32);
        rs = inv * rsqrtf(ss * (1.0f / D) + EPS);
    }
    constexpr int SROW = 144;
    LAS unsigned char* stg = lds + OFF_K + wave * (32 * SROW);
#pragma unroll
    for (int d = 0; d < NDB; ++d)
#pragma unroll
        for (int g = 0; g < 4; ++g) {
            if (OUT8) { *(LAS unsigned*)(stg + r32 * SROW + 32 * d + 8 * g + 4 * hh) = pk4_fp8(o[d][4 * g] * rs, o[d][4 * g + 1] * rs, o[d][4 * g + 2] * rs, o[d][4 * g + 3] * rs); }
            else { f32x4 gn = {1.f, 1.f, 1.f, 1.f}; if (FOX) gn = *(const f32x4*)(gain + 32 * d + 8 * g + 4 * hh);
                v2u w; w.x = cvtpk(o[d][4 * g] * rs * gn.x, o[d][4 * g + 1] * rs * gn.y); w.y = cvtpk(o[d][4 * g + 2] * rs * gn.z, o[d][4 * g + 3] * rs * gn.w);
                *(LAS v2u*)(stg + r32 * SROW + (32 * d + 8 * g + 4 * hh) * 2) = w; }
        }
    static_assert((OUT8 ? D : D * 2) == 128, "stage rows are 128 bytes");
    { unsigned char* ob = (unsigned char*)Og; const size_t pitchb = (size_t)opitch * (OUT8 ? 1 : 2);
#pragma unroll
      for (int i = 0; i < 4; ++i) { const int row = i * 8 + (lane >> 3), ch = lane & 7;
          const v4u w = *(const LAS v4u*)(stg + row * SROW + ch * 16);
          st_b128(ob + (size_t)(wave * 32 + row) * pitchb + ch * 16, w); } }
}
__device__ __forceinline__ void fox_phase(const P& p, int l, LAS unsigned char* lds, int vcu, int G) {
    const bf16* proj = WSP(bf16, WS_PROJ); const float* cb = WSP(float, WS_CB); bf16* y = WSP(bf16, WS_Y);
    for (int pu = vcu; pu < 512; pu += G) {
        const int bh = pu >> 2, pr = pu < 256 ? (pu & 3) : 3 - (pu & 3), b = bh >> 3, h = bh & 7;
        for (int half = 0; half < 2; ++half) {
            const int qb = half ? pr : 7 - pr;
            const size_t row0 = (size_t)b * SEQ;
            attn_unit<64, true>(lds, proj + (row0 + qb * 256) * PW + C_FQ + h * 64, PW, proj + row0 * PW + C_FK + h * 64, proj + row0 * PW + C_FV + h * 64, PW, 4 * (qb + 1),
                                cb + ((size_t)b * 8 + h) * SEQ, qb * 256, y + (row0 + qb * 256) * DM + h * 64, DM, p.fox_gain + l * 512 + h * 64, WSP(const float, WS_MOE + MO_KN) + (b * 8 + h) * 32);
        }
    }
}
__device__ __forceinline__ void xattn_phase(const P& p, int l, LAS unsigned char* lds, int vcu, int G, bool dummy) {
    bf16* xq = WSP(bf16, WS_XQ); const bf16* xkv = WSP(bf16, WS_XKV);
    for (int u = vcu; u < 512; u += G) {
        const int b = u >> 5, h = (u >> 3) & 3, qb = u & 7;
        bf16* qp = xq + ((size_t)b * SEQ + qb * 256) * 512 + h * 128;
        const bf16* kp = xkv + (size_t)b * MEML * 2048 + l * 1024 + h * 128;
        attn_unit<128, false, true>(lds, qp, 512, kp, kp + 512, 2048, 4, nullptr, 0, (bf16*)((dummy ? WSP(unsigned char, WS_Y) : WSP(unsigned char, WS_XO8)) + ((size_t)b * SEQ + qb * 256) * 512 + h * 128), 512, nullptr, nullptr);
    }
}

__device__ __forceinline__ void xattn_pair(const P& p, int l, LAS unsigned char* lds, int pm, int pn, bool dummy) {
    const bf16* xq = WSP(bf16, WS_XQ); const bf16* xkv = WSP(bf16, WS_XKV);
    const int b = pm >> 3;
    for (int hh2 = 0; hh2 < 2; ++hh2) {
        const int h = 2 * pn + hh2;
        const bf16* qp = xq + (size_t)pm * 256 * 512 + h * 128;
        const bf16* kp = xkv + (size_t)b * MEML * 2048 + l * 1024 + h * 128;
        attn_unit<128, false, true>(lds, qp, 512, kp, kp + 512, 2048, 4, nullptr, 0, (bf16*)((dummy ? WSP(unsigned char, WS_Y) : WSP(unsigned char, WS_XO8)) + (size_t)pm * 256 * 512 + h * 128), 512, nullptr, nullptr);
    }
}
constexpr size_t WS_GB = WS_END;
constexpr size_t WS_GDEC = WS_GB + 32 * MiB;
constexpr size_t WS_END2 = WS_GDEC + 1 * MiB;
static_assert(WS_END2 <= 512 * MiB, "workspace map 2");
constexpr int GL_B = 0;
constexpr int GL_TOT = 16384;
constexpr int GL_Q1 = 18432, GL_Q2 = GL_Q1 + 64 * 144, GL_K2 = GL_Q2 + 64 * 144;
constexpr int GL_KD = GL_K2 + 64 * 144;
constexpr int GL_V = GL_KD + 64 * 192;
constexpr int GL_SSQ = GL_V + 64 * 320;
constexpr int GL_GA = GL_SSQ + 1024;
constexpr int GL_YST = GL_GA + 4096;
constexpr int GL_GG = GL_YST + 64 * 272;
constexpr int GL_END = GL_GG + 64 * 272;
static_assert(GL_END <= 131072, "gla lds");

__device__ __forceinline__ float fast_log_sigmoid(float z) { return fminf(z, 0.f) - __logf(1.f + __expf(-fabsf(z))); }
__device__ __forceinline__ void gla_decay(const P& p, int l, int h, size_t tok0, LAS unsigned char* lds, int lane, int wave) {
    const float* sm = WSP(float, WS_SM);
    float w[16];
#pragma unroll
    for (int r = 0; r < 16; ++r) w[r] = p.w_alpha_up[((size_t)l * 16 + r) * 256 + h * 64 + lane];
    const float bias = p.b_alpha[l * 256 + h * 64 + lane];
    LAS f32x4* gat = (LAS f32x4*)(lds + GL_GA + wave * 512);
    if (lane < 32) gat[lane] = *(const f32x4*)(sm + (tok0 + wave * 8 + (lane >> 2)) * 32 + 8 + 4 * (lane & 3));
    float bl[8]; float run = 0.f;
#pragma unroll
    for (int j = 0; j < 8; ++j) {
        float z = bias;
#pragma unroll
        for (int r4 = 0; r4 < 4; ++r4) { const f32x4 g4 = gat[j * 4 + r4]; z += g4.x * w[4 * r4] + g4.y * w[4 * r4 + 1] + g4.z * w[4 * r4 + 2] + g4.w * w[4 * r4 + 3]; }
        run += fast_log_sigmoid(z) * (1.0f / 16.0f); bl[j] = run;
    }
    LAS float* tot = (LAS float*)(lds + GL_TOT);
    tot[wave * 64 + lane] = run;
    __syncthreads();
    float pre = 0.f;
#pragma unroll
    for (int g = 0; g < 8; ++g) { const float t = tot[g * 64 + lane]; if (g < wave) pre += t; }
    LAS float* Bm = (LAS float*)(lds + GL_B);
#pragma unroll
    for (int j = 0; j < 8; ++j) Bm[(wave * 8 + j) * 64 + lane] = bl[j] + pre;
    __syncthreads();
}
__device__ __forceinline__ void gla_load_v(const bf16* proj, size_t tok0, int h, LAS unsigned char* lds, int tid) {
#pragma unroll
    for (int i = 0; i < 2; ++i) { const int idx = tid + NTHR * i, t = idx >> 4, c = idx & 15;
        *(LAS v4u*)(lds + GL_V + t * 320 + c * 16) = *(const v4u*)(proj + (tok0 + t) * PW + C_GV + h * 128 + c * 8); }
}
__device__ __forceinline__ bf16x8 tr_frag(const LAS unsigned char* a0, int rowstride4) {
    const v4i16_t lo = __builtin_amdgcn_ds_read_tr16_b64_v4i16((LAS v4i16_t*)a0);
    const v4i16_t hi = __builtin_amdgcn_ds_read_tr16_b64_v4i16((LAS v4i16_t*)(a0 + rowstride4));
    return (bf16x8){lo[0], lo[1], lo[2], lo[3], hi[0], hi[1], hi[2], hi[3]};
}
__device__ __forceinline__ void gla_phase_a(const P& p, int l, LAS unsigned char* lds, int vcu, int G) {
    int tid = threadIdx.x; asm volatile("" : "+v"(tid));
    const int lane = tid & 63, wave = __builtin_amdgcn_readfirstlane(tid >> 6), hh = lane >> 5;
    const bf16* proj = WSP(bf16, WS_PROJ); float* loc = ((float*)p.out); float* dec = WSP(float, WS_GDEC); const float* sm = WSP(float, WS_SM); float* gb = WSP(float, WS_GB);
    LAS unsigned char* kd = lds + wave * 16384; LAS unsigned char* vh = kd + 8192;
    const int crow8 = lane >> 3, cch = lane & 7;
    const int trow = (lane & 15) >> 2, tcol = 16 * ((lane >> 4) & 1) + 4 * (lane & 3);
    for (int u = vcu * NWAVES + wave; u < 2048; u += G * NWAVES) {
        const int c = u & 31, h = (u >> 5) & 3, b = u >> 7;
        const size_t tok0 = (size_t)b * SEQ + c * 64;
        v4u kreg[8], v0reg[8], v1reg[8];
#pragma unroll
        for (int i = 0; i < 8; ++i) { const bf16* rp = proj + (tok0 + i * 8 + crow8) * PW;
            kreg[i] = *(const v4u*)(rp + C_GK + h * 64 + cch * 8); v0reg[i] = *(const v4u*)(rp + C_GV + h * 128 + cch * 8); v1reg[i] = *(const v4u*)(rp + C_GV + h * 128 + 64 + cch * 8); }
        float w[16];
#pragma unroll
        for (int r = 0; r < 16; ++r) w[r] = p.w_alpha_up[((size_t)l * 16 + r) * 256 + h * 64 + lane];
        const float bias = p.b_alpha[l * 256 + h * 64 + lane];
        { LAS f32x4* gw = (LAS f32x4*)vh;
#pragma unroll
          for (int i = 0; i < 4; ++i) gw[lane * 4 + i] = *(const f32x4*)(sm + (tok0 + lane) * 32 + 8 + 4 * i); }
        float bt[64]; float run = 0.f;
#pragma unroll
        for (int t = 0; t < 64; ++t) {
            float z = bias;
#pragma unroll
            for (int r4 = 0; r4 < 4; ++r4) { const f32x4 g4 = ((const LAS f32x4*)vh)[t * 4 + r4]; z += g4.x * w[4 * r4] + g4.y * w[4 * r4 + 1] + g4.z * w[4 * r4 + 2] + g4.w * w[4 * r4 + 3]; }
            run += fast_log_sigmoid(z) * (1.0f / 16.0f); bt[t] = run; gb[(tok0 + t) * 256 + h * 64 + lane] = run;
        }
#pragma unroll
        for (int i = 0; i < 8; ++i) { *(LAS v4u*)(kd + (i * 8 + crow8) * 128 + cch * 16) = kreg[i]; *(LAS v4u*)(vh + (i * 8 + crow8) * 128 + cch * 16) = v0reg[i]; }
#pragma unroll
        for (int t = 0; t < 64; ++t) { LAS bf16* kp = (LAS bf16*)(kd + t * 128 + lane * 2); *kp = (bf16)f2bf(bf2f(*kp) * __expf(run - bt[t])); }
        dec[(size_t)u * 64 + lane] = __expf(run);
#pragma unroll
        for (int half = 0; half < 2; ++half) {
            if (half == 1) {
#pragma unroll
                for (int i = 0; i < 8; ++i) *(LAS v4u*)(vh + (i * 8 + crow8) * 128 + cch * 16) = v1reg[i];
            }
            f32x16 acc[2][2];
#pragma unroll
            for (int x = 0; x < 2; ++x)
#pragma unroll
                for (int y = 0; y < 2; ++y) acc[x][y] = f32x16{};
#pragma unroll
            for (int s = 0; s < 4; ++s) {
                bf16x8 af[2], bfr[2];
#pragma unroll
                for (int x = 0; x < 2; ++x) { af[x] = tr_frag(vh + (16 * s + 8 * hh + trow) * 128 + (32 * x + tcol) * 2, 4 * 128); bfr[x] = tr_frag(kd + (16 * s + 8 * hh + trow) * 128 + (32 * x + tcol) * 2, 4 * 128); }
#pragma unroll
                for (int x = 0; x < 2; ++x)
#pragma unroll
                    for (int y = 0; y < 2; ++y) acc[x][y] = __builtin_amdgcn_mfma_f32_32x32x16_bf16(af[x], bfr[y], acc[x][y], 0, 0, 0);
            }
#pragma unroll
            for (int x = 0; x < 2; ++x)
#pragma unroll
                for (int y = 0; y < 2; ++y) { float* lo = loc + (size_t)u * 8192 + 32 * y + (lane & 31);
#pragma unroll
                    for (int r = 0; r < 16; ++r) lo[(size_t)(64 * half + 32 * x + (r & 3) + 8 * (r >> 2) + 4 * hh) * 64] = acc[x][y][r]; }
        }
    }
}
__device__ __forceinline__ void gla_phase_b(const P& p, int vcu, int G) {
    int tid = threadIdx.x; asm volatile("" : "+v"(tid));
    const float* loc = ((const float*)p.out); const float* dec = WSP(float, WS_GDEC); bf16* gs = (bf16*)((unsigned char*)p.out + 96 * MiB);
    for (int u = vcu; u < 256; u += G) {
        const int bh = u >> 2, q4 = u & 3;
        const int e = q4 * 2048 + tid * 4, dk = e & 63;
        f32x4 st = {0.f, 0.f, 0.f, 0.f};
#pragma unroll 8
        for (int c = 0; c < 32; ++c) {
            const size_t cu = (size_t)bh * 32 + c;
            const f32x4 lv = *(const f32x4*)(loc + cu * 8192 + e);
            const f32x4 dv = *(const f32x4*)(dec + cu * 64 + dk);
            v2u w; w.x = pk2(st.x, st.y); w.y = pk2(st.z, st.w);
            *(v2u*)(gs + cu * 8192 + e) = w;
            st = dv * st + lv;
        }
    }
}
__device__ __forceinline__ void gla_phase_c(const P& p, int l, LAS unsigned char* lds, int vcu, int G) {
    int tid = threadIdx.x; asm volatile("" : "+v"(tid));
    const int lane = tid & 63, wave = __builtin_amdgcn_readfirstlane(tid >> 6), hh = lane >> 5, r32 = lane & 31;
    const bf16* proj = WSP(bf16, WS_PROJ); const bf16* gs = (const bf16*)((const unsigned char*)p.out + 96 * MiB); bf16* y = WSP(bf16, WS_Y); const float* gb = WSP(const float, WS_GB);
    const int dvb = wave >> 1, tb = wave & 1;
    const int trow = (lane & 15) >> 2, tcol = 16 * ((lane >> 4) & 1) + 4 * (lane & 3);
    bf16 n_q[8], n_k[8]; v4u n_v[2], n_g[2]; bf16x8 n_s[4]; f32x4 n_n[4]; float n_b[8], n_r = 0.f;
#define GC_LOAD(uu) do { const int c_ = (uu) & 31, h_ = ((uu) >> 5) & 3, b_ = (uu) >> 7; const size_t t0_ = (size_t)b_ * SEQ + c_ * 64; \
        _Pragma("unroll") for (int j = 0; j < 8; ++j) { const bf16* rp = proj + (t0_ + wave * 8 + j) * PW + h_ * 64 + lane; n_q[j] = rp[C_GQ]; n_k[j] = rp[C_GK]; } \
        _Pragma("unroll") for (int i = 0; i < 2; ++i) { const int idx = tid + NTHR * i, t = idx >> 4, cc = idx & 15; n_v[i] = *(const v4u*)(proj + (t0_ + t) * PW + C_GV + h_ * 128 + cc * 8); n_g[i] = *(const v4u*)(proj + (t0_ + t) * PW + C_GG + h_ * 128 + cc * 8); } \
        { const bf16* sp = gs + (size_t)(uu) * 8192 + (size_t)(32 * dvb + r32) * 64 + 8 * hh; \
          _Pragma("unroll") for (int s2 = 0; s2 < 4; ++s2) n_s[s2] = *(const bf16x8*)(sp + 16 * s2); } \
        _Pragma("unroll") for (int j = 0; j < 8; ++j) n_b[j] = gb[(t0_ + wave * 8 + j) * 256 + h_ * 64 + lane]; \
        n_r = gb[(t0_ + 31) * 256 + h_ * 64 + lane]; \
        _Pragma("unroll") for (int g = 0; g < 4; ++g) { const int dv = 32 * dvb + 8 * g + 4 * hh; \
            n_n[g] = *(const f32x4*)(p.gla_gain + l * 512 + h_ * 128 + dv); } } while (0)
    if (vcu < 2048) GC_LOAD(vcu);
    for (int u = vcu; u < 2048; u += G) {
        const int c = u & 31, h = (u >> 5) & 3, b = u >> 7;
        const size_t tok0 = (size_t)b * SEQ + c * 64;
        bf16x8 sfr[4]; f32x4 gnr[4];
#pragma unroll
        for (int i = 0; i < 4; ++i) { sfr[i] = n_s[i]; gnr[i] = n_n[i]; }
#pragma unroll
        for (int i = 0; i < 2; ++i) { const int idx = tid + NTHR * i, t = idx >> 4, cc = idx & 15; *(LAS v4u*)(lds + GL_V + t * 320 + cc * 16) = n_v[i]; *(LAS v4u*)(lds + GL_GG + t * 272 + cc * 16) = n_g[i]; }
        { const float rref = n_r;
#pragma unroll
          for (int j = 0; j < 8; ++j) { const int t = wave * 8 + j; const float bt = n_b[j];
            const float qv = bf2f(n_q[j]), kv = bf2f(n_k[j]);
            *(LAS bf16*)(lds + GL_Q1 + t * 144 + lane * 2) = (bf16)f2bf(qv * __expf(bt));
            *(LAS bf16*)(lds + GL_Q2 + t * 144 + lane * 2) = (bf16)f2bf(qv * __expf(bt - rref));
            *(LAS bf16*)(lds + GL_K2 + t * 144 + lane * 2) = (bf16)f2bf(kv * __expf(rref - bt)); } }
        __syncthreads();
        if (u + G < 2048) GC_LOAD(u + G);
        f32x16 o = {};
        {
#pragma unroll
          for (int s = 0; s < 4; ++s) { const bf16x8 af = sfr[s]; const bf16x8 bq = *(const LAS bf16x8*)(lds + GL_Q1 + (32 * tb + r32) * 144 + (16 * s + 8 * hh) * 2);
              o = __builtin_amdgcn_mfma_f32_32x32x16_bf16(af, bq, o, 0, 0, 0); } }
#pragma unroll
        for (int sb = 0; sb < 2; ++sb) {
            if (sb <= tb) {
                f32x16 pt = {};
#pragma unroll
                for (int s = 0; s < 4; ++s) { const bf16x8 ak = *(const LAS bf16x8*)(lds + GL_K2 + (32 * sb + r32) * 144 + (16 * s + 8 * hh) * 2); const bf16x8 bq = *(const LAS bf16x8*)(lds + GL_Q2 + (32 * tb + r32) * 144 + (16 * s + 8 * hh) * 2);
                    pt = __builtin_amdgcn_mfma_f32_32x32x16_bf16(ak, bq, pt, 0, 0, 0); }
                if (sb == tb) {
#pragma unroll
                    for (int r = 0; r < 16; ++r) { const int s_ = (r & 3) + 8 * (r >> 2) + 4 * hh; if (s_ > r32) pt[r] = 0.f; }
                }
#pragma unroll
                for (int ks = 0; ks < 2; ++ks) {
                    const bf16x8 pa = pack8(pt, 8 * ks);
                    const bf16x8 vf = tr_frag(lds + GL_V + (32 * sb + 16 * ks + 4 * hh + trow) * 320 + (32 * dvb + tcol) * 2, 8 * 320);
                    o = __builtin_amdgcn_mfma_f32_32x32x16_bf16(vf, pa, o, 0, 0, 0);
                }
            }
        }
        float ss = 0.f;
#pragma unroll
        for (int r = 0; r < 16; ++r) ss += o[r] * o[r];
        ss += __shfl_xor(ss, 32);
        LAS float* sq = (LAS float*)(lds + GL_SSQ);
        if (hh == 0) sq[dvb * 64 + 32 * tb + r32] = ss;
        __syncthreads();
        const int t = 32 * tb + r32;
        const float tot = (sq[t] + sq[64 + t]) + (sq[128 + t] + sq[192 + t]);
        const float rs = rsqrtf(tot * (1.0f / 128.0f) + EPS);
#pragma unroll
        for (int g = 0; g < 4; ++g) {
            const int dv = 32 * dvb + 8 * g + 4 * hh;
            const f32x4 gn = gnr[g];
            const v2u gg = *(const LAS v2u*)(lds + GL_GG + t * 272 + dv * 2);
            const float g0 = bf2f((bf16)(gg.x & 0xffff)), g1 = bf2f((bf16)(gg.x >> 16)), g2 = bf2f((bf16)(gg.y & 0xffff)), g3 = bf2f((bf16)(gg.y >> 16));
            const float v0 = o[4 * g] * rs * gn.x * g0 * __builtin_amdgcn_rcpf(1.f + __expf(-g0)), v1 = o[4 * g + 1] * rs * gn.y * g1 * __builtin_amdgcn_rcpf(1.f + __expf(-g1));
            const float v2 = o[4 * g + 2] * rs * gn.z * g2 * __builtin_amdgcn_rcpf(1.f + __expf(-g2)), v3 = o[4 * g + 3] * rs * gn.w * g3 * __builtin_amdgcn_rcpf(1.f + __expf(-g3));
            v2u w; w.x = cvtpk(v0, v1); w.y = cvtpk(v2, v3);
            *(LAS v2u*)(lds + GL_YST + t * 272 + dv * 2) = w;
        }
        __syncthreads();
#pragma unroll
        for (int i = 0; i < 2; ++i) { const int idx = tid + NTHR * i, tr_ = idx >> 4, ch = idx & 15;
            st_b128(y + (tok0 + tr_) * DM + 512 + h * 128 + ch * 8, *(const LAS v4u*)(lds + GL_YST + tr_ * 272 + ch * 16)); }
    }
#undef GC_LOAD
}
__device__ __forceinline__ void fox_cumsum_phase(const P& p, int l, LAS unsigned char* lds, int vcu, int G) {
    int tid = threadIdx.x; asm volatile("" : "+v"(tid));
    const int lane = tid & 63, wave = __builtin_amdgcn_readfirstlane(tid >> 6);
    const float* sm = WSP(float, WS_SM); float* cb = WSP(float, WS_CB);
    LAS float* tot = (LAS float*)(lds + 256);
    for (int u = vcu; u < NBATCH * 8; u += G) {
        const int b = u >> 3, h = u & 7;
        const float bias = p.b_forget[l * 8 + h];
        const int s0 = wave * 256 + lane * 4;
        float v[4]; float run = 0.f;
#pragma unroll
        for (int j = 0; j < 4; ++j) v[j] = sm[((size_t)b * SEQ + s0 + j) * 32 + h];
#pragma unroll
        for (int j = 0; j < 4; ++j) { run += fast_log_sigmoid(v[j] + bias); v[j] = run; }
        float pre = run;
#pragma unroll
        for (int o = 1; o < 64; o <<= 1) { const float t = __shfl_up(pre, o); if (lane >= o) pre += t; }
        __syncthreads();
        if (lane == 63) tot[wave] = pre;
        __syncthreads();
        float base = pre - run;
#pragma unroll
        for (int w_ = 0; w_ < 8; ++w_) { const float t = tot[w_]; if (w_ < wave) base += t; }
        f32x4 o4; o4.x = -(v[0] + base) * LOG2E; o4.y = -(v[1] + base) * LOG2E; o4.z = -(v[2] + base) * LOG2E; o4.w = -(v[3] + base) * LOG2E;
        *(f32x4*)(cb + ((size_t)b * 8 + h) * SEQ + s0) = o4;
    }
}
__device__ __forceinline__ void fox_knorm_phase(const P& p, int vcu, int G) {
    int tid = threadIdx.x; asm volatile("" : "+v"(tid));
    const int lane = tid & 63, wave = __builtin_amdgcn_readfirstlane(tid >> 6);
    const bf16* proj = WSP(bf16, WS_PROJ); float* kn = WSP(float, WS_MOE + MO_KN);
    for (int task = vcu * NWAVES + wave; task < NBATCH * 8 * 32; task += G * NWAVES) {
        const int j = task & 31, h = (task >> 5) & 7, b = task >> 8;
        float mx = 0.f;
#pragma unroll
        for (int i = 0; i < 8; ++i) {
            const v4u w = *(const v4u*)(proj + ((size_t)b * SEQ + j * 64 + i * 8 + (lane >> 3)) * PW + C_FK + h * 64 + (lane & 7) * 8);
            const unsigned ww[4] = {w.x, w.y, w.z, w.w}; float ss = 0.f;
#pragma unroll
            for (int e = 0; e < 4; ++e) { const float a = __builtin_bit_cast(float, ww[e] << 16), c = __builtin_bit_cast(float, ww[e] & 0xffff0000u); ss += a * a + c * c; }
            ss += __shfl_xor(ss, 1); ss += __shfl_xor(ss, 2); ss += __shfl_xor(ss, 4);
            mx = fmaxf(mx, ss);
        }
        mx = wave_max(mx);
        if (lane == 0) kn[task] = sqrtf(mx) * 1.0001f;
    }
}
__device__ __forceinline__ void router_weights(const P& p, int gtid, int gstride) {
    for (int idx = gtid; idx < NLAYER * 32768; idx += gstride) {
        const int l = idx >> 15, r = idx & 32767, k = r >> 5, n = r & 31;
        float v = 0.f;
        if (n < 16) v = p.w_re[((size_t)l * DM + k) * 16 + n]; else if (n < 20) v = p.w_rg[((size_t)l * DM + k) * 4 + (n - 16)];
        v *= p.moe_norm[l * DM + k];
        float* wr = (float*)(ws_base(p.ws) + WS_W + (size_t)l * WS_WLAYER + WO_RHI);
        wr[((((k >> 5) * 4 + ((k >> 3) & 3)) * 2 + ((k >> 2) & 1)) * 32 + n) * 4 + (k & 3)] = v;
    }
}
__device__ __forceinline__ void route_phase(const P& p, int l, LAS unsigned char* lds, int vcu, int G) {
    int tid = threadIdx.x; asm volatile("" : "+v"(tid));
    const int lane = tid & 63, wave = __builtin_amdgcn_readfirstlane(tid >> 6);
    { const v4u* src = (const v4u*)(ws_base(p.ws) + WS_W + (size_t)l * WS_WLAYER + WO_RHI);
#pragma unroll 4
      for (int i = 0; i < 16; ++i) *(LAS v4u*)(lds + LDS_STAGE + (tid + NTHR * i) * 16) = src[tid + NTHR * i]; }
    LAS int* hist = (LAS int*)(lds + LDS_GATE);
    if (tid < 32) hist[tid] = 0;
    __syncthreads();
    const bf16* HBp = WSP(const bf16, WS_HB);
    int2* toke = WSP(int2, WS_MOE + MO_TOKE); float2* tokg = WSP(float2, WS_MOE + MO_TOKG);
    LAS float* lgb = (LAS float*)(lds + LDS_RS + wave * 2048);
    const int r = lane & 15, kq = lane >> 4;
    for (int task = vcu * NWAVES + wave; task < NTOK / 16; task += G * NWAVES) {
        const int tok0 = task * 16;
        const v4u* hp = (const v4u*)(HBp + (size_t)(tok0 + r) * DM + 8 * kq);
        f32x4 acc0 = {0.f, 0.f, 0.f, 0.f}, acc1 = {0.f, 0.f, 0.f, 0.f}; float q = 0.f;
#pragma unroll 8
        for (int s = 0; s < 32; ++s) {
            const v4u aw = hp[4 * s];
            const unsigned ww[4] = {aw.x, aw.y, aw.z, aw.w};
            const LAS unsigned char* bp = lds + LDS_STAGE + ((s * 4 + kq) * 2 * 32 + r) * 16;
            const f32x4 b00 = *(const LAS f32x4*)(bp), b01 = *(const LAS f32x4*)(bp + 32 * 16), b10 = *(const LAS f32x4*)(bp + 16 * 16), b11 = *(const LAS f32x4*)(bp + 48 * 16);
#pragma unroll
            for (int e = 0; e < 4; ++e) {
                const float a0 = __builtin_bit_cast(float, ww[e] << 16), a1 = __builtin_bit_cast(float, ww[e] & 0xffff0000u);
                q += a0 * a0 + a1 * a1;
                const f32x4& bl = e < 2 ? b00 : b01; const f32x4& bh = e < 2 ? b10 : b11;
                acc0 = __builtin_amdgcn_mfma_f32_16x16x4f32(a0, bl[(2 * e) & 3], acc0, 0, 0, 0); acc1 = __builtin_amdgcn_mfma_f32_16x16x4f32(a0, bh[(2 * e) & 3], acc1, 0, 0, 0);
                acc0 = __builtin_amdgcn_mfma_f32_16x16x4f32(a1, bl[(2 * e + 1) & 3], acc0, 0, 0, 0); acc1 = __builtin_amdgcn_mfma_f32_16x16x4f32(a1, bh[(2 * e + 1) & 3], acc1, 0, 0, 0);
            }
        }
        q += __shfl_xor(q, 16); q += __shfl_xor(q, 32);
        const float rsv = rsqrtf(q * (1.0f / DM) + EPS);
        const float bias0 = p.b_re[l * 16 + r], bias1 = r < 4 ? p.b_rg[l * 4 + r] : 0.f;
#pragma unroll
        for (int g = 0; g < 4; ++g) { const int row = 4 * kq + g; const float rs = __shfl(rsv, row);
            lgb[row * 32 + r] = acc0[g] * rs + bias0; lgb[row * 32 + 16 + r] = acc1[g] * rs + bias1; }
        LDS_WAIT();
        if (lane < 16) {
            const int tok = tok0 + lane;
            const LAS f32x4* lr = (const LAS f32x4*)(lgb + lane * 32);
            const f32x4 e0 = lr[0], e1 = lr[1], e2 = lr[2], e3 = lr[3], gl = lr[4];
            int g = 0; float gm = gl.x;
            if (gl.y > gm) { gm = gl.y; g = 1; } if (gl.z > gm) { gm = gl.z; g = 2; } if (gl.w > gm) { gm = gl.w; g = 3; }
            const float den = (expf(gl.x - gm) + expf(gl.y - gm)) + (expf(gl.z - gm) + expf(gl.w - gm));
            const float pg = 1.0f / den;
            const f32x4 el = g == 0 ? e0 : (g == 1 ? e1 : (g == 2 ? e2 : e3));
            int i0 = 0; float m0 = el.x;
            if (el.y > m0) { m0 = el.y; i0 = 1; } if (el.z > m0) { m0 = el.z; i0 = 2; } if (el.w > m0) { m0 = el.w; i0 = 3; }
            int i1 = -1; float m1 = -INFINITY;
            if (i0 != 0 && el.x > m1) { m1 = el.x; i1 = 0; } if (i0 != 1 && el.y > m1) { m1 = el.y; i1 = 1; }
            if (i0 != 2 && el.z > m1) { m1 = el.z; i1 = 2; } if (i0 != 3 && el.w > m1) { m1 = el.w; i1 = 3; }
            const float ex = expf(m1 - m0), inv = 1.0f / (1.0f + ex);
            const int ea = g * 4 + i0, eb = g * 4 + i1;
            toke[tok] = make_int2(ea, eb); tokg[tok] = make_float2(pg * inv, pg * ex * inv);
            atomicAdd((int*)&hist[ea], 1); atomicAdd((int*)&hist[16 + eb], 1);
        }
        LDS_WAIT();
    }
    __syncthreads();
    if (tid < 32) WSP(int, WS_MOE + MO_HIST)[vcu * 32 + tid] = hist[tid];
}
__device__ __forceinline__ void sort_phase(const P& p, LAS unsigned char* lds, int vcu, int G) {
    int tid = threadIdx.x; asm volatile("" : "+v"(tid));
    const int lane = tid & 63, wave = __builtin_amdgcn_readfirstlane(tid >> 6);
    LAS int* cnt = (LAS int*)(lds + LDS_GATE); LAS int* pre = cnt + 32; LAS int* base = cnt + 64; LAS int* ntl = cnt + 96;
    const int* histg = WSP(const int, WS_MOE + MO_HIST);
    int* rowtok = WSP(int, WS_MOE + MO_ROWTOK); float* rowgate = WSP(float, WS_MOE + MO_ROWGATE); int* tilee = WSP(int, WS_MOE + MO_TILEE); int* nt = WSP(int, WS_MOE + MO_NT);
    const int2* toke = WSP(const int2, WS_MOE + MO_TOKE); const float2* tokg = WSP(const float2, WS_MOE + MO_TOKG);
    { LAS int* part = (LAS int*)(lds + LDS_RS);
      const int j = tid & 31, part_i = tid >> 5; int c = 0, pr = 0;
      for (int w = part_i; w < G; w += 16) { const int v = histg[w * 32 + j]; if (w < vcu) pr += v; c += v; }
      part[part_i * 64 + j] = c; part[part_i * 64 + 32 + j] = pr;
      __syncthreads();
      if (tid < 32) { int cc = 0, pp = 0;
#pragma unroll
          for (int q = 0; q < 16; ++q) { cc += part[q * 64 + tid]; pp += part[q * 64 + 32 + tid]; }
          cnt[tid] = cc; pre[tid] = pp; } }
    __syncthreads();
    if (tid == 0) { int t = 0; for (int j = 0; j < 32; ++j) { base[j] = t * 256; const int n = (cnt[j] + 255) >> 8; ntl[j] = n; t += n; if (j == 15 && vcu == 0) nt[0] = t; } if (vcu == 0) nt[1] = t; }
    __syncthreads();
    if (vcu == 0 && tid < 32) { const int t0 = base[tid] >> 8; for (int i = 0; i < ntl[tid]; ++i) tilee[t0 + i] = tid & 15; }
    if (vcu < 32) { const int j = vcu, lo = base[j] + cnt[j], hi = base[j] + 256 * ntl[j]; for (int r = lo + tid; r < hi; r += NTHR) { rowtok[r] = -1; rowgate[r] = 0.f; } }
    if (wave < 2) {
        const int k = wave;
        int run[16];
#pragma unroll
        for (int e = 0; e < 16; ++e) run[e] = 0;
        for (int task0 = vcu * NWAVES; task0 < NTOK / 16; task0 += G * NWAVES) {
#pragma unroll 1
            for (int half = 0; half < 2; ++half) {
                const int tok = task0 * 16 + half * 64 + lane;
                const int2 ee = toke[tok]; const float2 gg = tokg[tok];
                const int e = k ? ee.y : ee.x; const float gt = k ? gg.y : gg.x;
                int rank = 0;
#pragma unroll
                for (int x = 0; x < 16; ++x) { const unsigned long long m = __ballot(e == x); if (e == x) rank = run[x] + __popcll(m & ((1ull << lane) - 1ull)); run[x] += __popcll(m); }
                const int pos = base[k * 16 + e] + pre[k * 16 + e] + rank;
                rowtok[pos] = tok; rowgate[pos] = gt;
            }
        }
    }
}
__device__ __forceinline__ void final_phase(const P& p, int vcu, int G) {
    int tid = threadIdx.x; asm volatile("" : "+v"(tid));
    const int lane = tid & 63, wave = __builtin_amdgcn_readfirstlane(tid >> 6);
    const float* ssq = WSP(const float, WS_SSQ); const bf16* hb = WSP(const bf16, WS_HB);
    f32x4 g[4];
#pragma unroll
    for (int j = 0; j < 4; ++j) g[j] = ((const f32x4*)p.final_norm)[lane + 64 * j];
    for (int m0 = (vcu * NWAVES + wave) * 4; m0 < NTOK; m0 += G * NWAVES * 4) {
        v2u w[4][4]; float rs[4];
#pragma unroll
        for (int r = 0; r < 4; ++r) { rs[r] = row_rs(ssq, m0 + r);
#pragma unroll
            for (int j = 0; j < 4; ++j) w[r][j] = ((const v2u*)(hb + (size_t)(m0 + r) * DM))[lane + 64 * j]; }
#pragma unroll
        for (int r = 0; r < 4; ++r) { f32x4* s = (f32x4*)(p.out + (size_t)(m0 + r) * DM) + lane;
#pragma unroll
            for (int j = 0; j < 4; ++j) { f32x4 v; v.x = __builtin_bit_cast(float, w[r][j].x << 16); v.y = __builtin_bit_cast(float, w[r][j].x & 0xffff0000u); v.z = __builtin_bit_cast(float, w[r][j].y << 16); v.w = __builtin_bit_cast(float, w[r][j].y & 0xffff0000u);
                s[64 * j] = v * rs[r] * g[j]; } }
    }
}
#ifndef ENMASK
#define ENMASK 0xffffffffu
#endif
#define EN(b) (((ENMASK) >> (b)) & 1u)
#ifndef REPMASK
#define REPMASK 0u
#endif
#define REPN(b) ((((REPMASK) >> (b)) & 1u) ? 2 : 1)
__device__ __attribute__((noinline)) void grid_barrier(unsigned* barw, unsigned x, volatile LAS unsigned* st) { XcdBarrier b; b.bar = barw; b.x = x; b.st = st; xcd_barrier(b); }
__global__ void __launch_bounds__(NTHR, 2) fwd(Args args) {
    extern __shared__ __attribute__((aligned(16))) unsigned char lds_raw[];
    LAS unsigned char* lds = (LAS unsigned char*)lds_raw;
    const P& p = args.p;
    const int tid = threadIdx.x, lane = tid & 63, wave = __builtin_amdgcn_readfirstlane(tid >> 6);
    const int G = gridDim.x; const int bx = blockIdx.x; const int vcu = (G % 8 == 0) ? (bx % 8) * (G / 8) + bx / 8 : bx;
    volatile LAS unsigned* MISC = (volatile LAS unsigned*)(lds + LDS_MISC);
    if (tid < 64) MISC[tid] = 0u;
    __syncthreads();
    unsigned* ctl = (unsigned*)(p.ws + WS_CTL);
    const int lo = args.ph_lo, hi = args.ph_hi;
    XcdBarrier bar; bar.bar = ctl + CW_BAR + args.li * XCD_BAR_WORDS; bar.x = 0; bar.st = nullptr;
    if (hi - lo > 1) bar = xcd_barrier_post(ctl + CW_BAR + args.li * XCD_BAR_WORDS, MISC);
#define IN(k) (lo <= (k) && (k) < hi)
#define PHL int vcuL = vcu, GL = G, bxL = bx; asm volatile("" : "+s"(vcuL), "+s"(GL), "+s"(bxL)); (void)vcuL; (void)GL; (void)bxL;
#define LTID(v) int v = threadIdx.x; asm volatile("" : "+v"(v))
#define FILL_RS_DENSE() do { LTID(tq); const int rr_ = tq & 255, hf_ = tq >> 8; f32x4 sv_[4][4]; bool ok_[4]; \
        _Pragma("unroll") for (int k_ = 0; k_ < 4; ++k_) { pg8::Unit u_; ok_[k_] = S.next(hf_ + 2 * k_, u_); const f32x4* sp_ = (const f32x4*)(SSQ + (size_t)(ok_[k_] ? u_.pm * 256 + rr_ : 0) * 16); \
            _Pragma("unroll") for (int j_ = 0; j_ < 4; ++j_) sv_[k_][j_] = sp_[j_]; } \
        _Pragma("unroll") for (int k_ = 0; k_ < 4; ++k_) if (ok_[k_]) { const f32x4 a_ = (sv_[k_][0] + sv_[k_][1]) + (sv_[k_][2] + sv_[k_][3]); rstab[(hf_ + 2 * k_) * 256 + rr_] = rsqrtf(((a_.x + a_.y) + (a_.z + a_.w)) * (1.0f / DM) + EPS); } } while (0)
#define FILL_GU() do { LTID(tq); const int rr_ = tq & 255, hf_ = tq >> 8; f32x4 sv_[4][4]; bool ok_[4]; int tk_[4]; \
        _Pragma("unroll") for (int k_ = 0; k_ < 4; ++k_) { pg8::Unit u_; ok_[k_] = S.next(hf_ + 2 * k_, u_); tk_[k_] = ok_[k_] ? ROWTOK[u_.pm * 256 + rr_] : 0; } \
        _Pragma("unroll") for (int k_ = 0; k_ < 4; ++k_) { tk_[k_] = tk_[k_] < 0 ? 0 : tk_[k_]; const f32x4* sp_ = (const f32x4*)(SSQ + (size_t)tk_[k_] * 16); \
            _Pragma("unroll") for (int j_ = 0; j_ < 4; ++j_) sv_[k_][j_] = sp_[j_]; } \
        _Pragma("unroll") for (int k_ = 0; k_ < 4; ++k_) if (ok_[k_]) { const f32x4 a_ = (sv_[k_][0] + sv_[k_][1]) + (sv_[k_][2] + sv_[k_][3]); rowtab[(hf_ + 2 * k_) * 256 + rr_] = tk_[k_]; \
            rstab[(hf_ + 2 * k_) * 256 + rr_] = rsqrtf(((a_.x + a_.y) + (a_.z + a_.w)) * (1.0f / DM) + EPS); } } while (0)
#define FILL_DOWN() do { LTID(tq); const int rr_ = tq & 255, hf_ = tq >> 8; bool ok_[4]; int tk_[4]; float gt_[4]; \
        _Pragma("unroll") for (int k_ = 0; k_ < 4; ++k_) { pg8::Unit u_; ok_[k_] = S.next(hf_ + 2 * k_, u_); const int r_ = ok_[k_] ? u_.pm * 256 + rr_ : 0; tk_[k_] = ROWTOK[r_]; gt_[k_] = ROWGATE[r_]; } \
        _Pragma("unroll") for (int k_ = 0; k_ < 4; ++k_) if (ok_[k_]) { rowtab[(hf_ + 2 * k_) * 256 + rr_] = tk_[k_]; gatetab[(hf_ + 2 * k_) * 256 + rr_] = gt_[k_]; } } while (0)

#define SEAM(k) do { if (IN(k) && IN((k) + 1)) { grid_barrier(bar.bar, bar.x, bar.st); if (REPN(20) == 2) grid_barrier(bar.bar, bar.x, bar.st); } } while (0)
    LAS float* rstab = (LAS float*)(lds + LDS_RS); LAS int* rowtab = (LAS int*)(lds + LDS_ROWTOK); LAS float* gatetab = (LAS float*)(lds + LDS_GATE);
#define HB WSP(bf16, WS_HB)
#define PROJ WSP(bf16, WS_PROJ)
#define Y WSP(bf16, WS_Y)
#define XKV WSP(bf16, WS_XKV)
#define MEMN WSP(bf16, WS_MEMN)
#define SSQ WSP(float, WS_SSQ)
#define XQ WSP(bf16, WS_XQ)
#define U WSP(bf16, WS_U)
#define ROWTOK WSP(const int, WS_MOE + MO_ROWTOK)
#define ROWGATE WSP(const float, WS_MOE + MO_ROWGATE)
#define TILEE WSP(const int, WS_MOE + MO_TILEE)
#define NT WSP(const int, WS_MOE + MO_NT)
#define H (p.out)
#define HB8 ((unsigned char*)p.out + 64 * MiB)
#define U8 WSP(unsigned char, WS_U)

    if (EN(0) && IN(PH_PRO)) _Pragma("unroll 1") for (int rep_ = 0; rep_ < REPN(0); ++rep_) { PHL prologue(p, lds, vcuL, GL, wave, lane); }
    SEAM(PH_PRO);
    if (REPN(18) == 2 && IN(PH_XKV)) { PHL
        pg8::StaticOrder S; S.init(HB, ws_base(p.ws) + WS_W + WO_IN, NTOK, 3072, DM, GL, bxL);
        FILL_RS_DENSE();
        __syncthreads();
        EpiBf16<true> E{PROJ, PW, rstab};
        pg8::gemm_phase<DM, EpiBf16<true>, pg8::StaticOrder, true>(lds + LDS_STAGE, S, E);
    }
    for (int l = 0; l < NLAYER; ++l) {
        const int pb = PH_L0 + l * NPH;
        unsigned char* wl = ws_base(p.ws) + WS_W + (size_t)l * WS_WLAYER;
        if (EN(2) && IN(pb + LP_INPROJ)) _Pragma("unroll 1") for (int rep_ = 0; rep_ < REPN(2); ++rep_) { PHL
            pg8::StaticOrder S; S.init(HB, wl + WO_IN, NTOK, 3072, DM, GL, bxL);
            FILL_RS_DENSE();
            __syncthreads();
            EpiBf16<true> E{PROJ, PW, rstab};
            pg8::gemm_phase<DM, EpiBf16<true>, pg8::StaticOrder, true>(lds + LDS_STAGE, S, E);
            _Pragma("unroll 1") for (int r2_ = 0; r2_ < REPN(19); ++r2_) small_proj(p, l, lds + LDS_STAGE, vcuL, GL, wave, lane);
        }
        SEAM(pb + LP_INPROJ);
        if (EN(11) && IN(pb + LP_MIXA)) _Pragma("unroll 1") for (int rep_ = 0; rep_ < REPN(11); ++rep_) { PHL gla_phase_a(p, l, lds + LDS_STAGE, vcuL, GL); fox_cumsum_phase(p, l, lds + LDS_STAGE, vcuL, GL); fox_knorm_phase(p, vcuL, GL); }
        SEAM(pb + LP_MIXA);
        if (EN(12) && IN(pb + LP_MIXB)) _Pragma("unroll 1") for (int rep_ = 0; rep_ < REPN(12); ++rep_) { PHL gla_phase_b(p, vcuL, GL); }
        if (EN(1) && l == 0 && IN(pb + LP_MIXB)) { PHL
            pg8::StaticOrder S; S.init(MEMN, ws_base(p.ws) + WS_WXKV, 4096, 2048, DM, GL, bxL);
            EpiBf16<false> E{XKV, 2048, rstab};
            pg8::gemm_phase<DM, EpiBf16<false>, pg8::StaticOrder, true>(lds + LDS_STAGE, S, E);
        }
        SEAM(pb + LP_MIXB);
        if (EN(9) && IN(pb + LP_MIXC)) { PHL _Pragma("unroll 1") for (int rep_ = 0; rep_ < REPN(16); ++rep_) fox_phase(p, l, lds + LDS_STAGE, vcuL, GL); _Pragma("unroll 1") for (int rep_ = 0; rep_ < REPN(17); ++rep_) gla_phase_c(p, l, lds + LDS_STAGE, vcuL, GL); }
        SEAM(pb + LP_MIXC);
        if (EN(3) && IN(pb + LP_WOUT)) _Pragma("unroll 1") for (int rep_ = 0; rep_ < REPN(3); ++rep_) { PHL
            pg8::StaticOrder S; S.init(Y, wl + WO_OUT, NTOK, DM, DM, GL, bxL);
            EpiRes<0> E{HB, SSQ, rowtab, gatetab, rep_ == REPN(3) - 1 ? 1.f : 0.f, Y, nullptr};
            pg8::gemm_phase<DM, EpiRes<0>, pg8::StaticOrder, true>(lds + LDS_STAGE, S, E);
        }
        SEAM(pb + LP_WOUT);
        if (EN(4) && IN(pb + LP_XQ)) _Pragma("unroll 1") for (int rep_ = 0; rep_ < REPN(4); ++rep_) { PHL
            pg8::StaticOrder S; S.init(HB, wl + WO_XQ, NTOK, 512, DM, GL, bxL);
            FILL_RS_DENSE();
            __syncthreads();
            EpiBf16<true> E{XQ, 512, rstab};
            pg8::gemm_phase<DM, EpiBf16<true>, pg8::StaticOrder, true>(lds + LDS_STAGE, S, E);
            asm volatile("s_waitcnt vmcnt(0)" ::: "memory"); __syncthreads();
            { pg8::Unit u; for (int iu = 0; S.next(iu, u); ++iu) { xattn_pair(p, l, lds + LDS_STAGE, u.pm, u.pn, rep_ != REPN(4) - 1); } }
        }
        SEAM(pb + LP_XQ);
        if (EN(5) && IN(pb + LP_XO)) _Pragma("unroll 1") for (int rep_ = 0; rep_ < REPN(5); ++rep_) { PHL
            pg8::StaticOrder S; S.init(WSP(unsigned char, WS_XO8), wl + WO_XO, NTOK, DM, 256, GL, bxL);
            EpiRes<0, true> E{HB, SSQ, rowtab, gatetab, rep_ == REPN(5) - 1 ? 1.f : 0.f, Y, HB8};
            pg8::gemm_phase<256, EpiRes<0, true>, pg8::StaticOrder, true, true, 127, 122>(lds + LDS_STAGE, S, E);
        }
        SEAM(pb + LP_XO);
        if (EN(13) && IN(pb + LP_ROUTE)) _Pragma("unroll 1") for (int rep_ = 0; rep_ < REPN(13); ++rep_) { PHL route_phase(p, l, lds, vcuL, GL); }
        SEAM(pb + LP_ROUTE);
        if (EN(14) && IN(pb + LP_SORT)) _Pragma("unroll 1") for (int rep_ = 0; rep_ < REPN(14); ++rep_) { PHL sort_phase(p, lds, vcuL, GL); }
        SEAM(pb + LP_SORT);
        if (EN(6) && IN(pb + LP_GU)) _Pragma("unroll 1") for (int rep_ = 0; rep_ < REPN(6); ++rep_) { PHL
            MoeOrder<0> S{(const char*)HB8, (const char*)(wl + WO_GU), 512, (size_t)1024 * 1024, 0, NT[1], GL, vcuL, TILEE, rowtab};
            FILL_GU();
            __syncthreads();
            EpiGU E{U8, rstab};
            pg8::gemm_phase<512, EpiGU, MoeOrder<0>, true, true, 127, 122>(lds + LDS_STAGE, S, E);
        }
        SEAM(pb + LP_GU);
        if (EN(7) && IN(pb + LP_DOWN0)) _Pragma("unroll 1") for (int rep_ = 0; rep_ < REPN(7); ++rep_) { PHL
            MoeOrder<1> S{(const char*)U8, (const char*)(wl + WO_D), 256, (size_t)1024 * 512, 0, NT[0], GL, vcuL, TILEE, rowtab};
            __syncthreads();
            FILL_DOWN();
            __syncthreads();
            EpiRes<1> E{HB, SSQ, rowtab, gatetab, 1.f, Y, nullptr};
            pg8::gemm_phase<256, EpiRes<1>, MoeOrder<1>, true, true, 125, 122>(lds + LDS_STAGE, S, E);
        }
        SEAM(pb + LP_DOWN0);
        if (EN(8) && IN(pb + LP_DOWN1)) _Pragma("unroll 1") for (int rep_ = 0; rep_ < REPN(8); ++rep_) { PHL
            MoeOrder<1> S{(const char*)U8, (const char*)(wl + WO_D), 256, (size_t)1024 * 512, NT[0], NT[1], GL, vcuL, TILEE, rowtab};
            __syncthreads();
            FILL_DOWN();
            __syncthreads();
            EpiRes<2> E{HB, SSQ, rowtab, gatetab, 1.f, Y, nullptr};
            pg8::gemm_phase<256, EpiRes<2>, MoeOrder<1>, true, true, 125, 122>(lds + LDS_STAGE, S, E);
        }
        SEAM(pb + LP_DOWN1);
    }
    if (EN(15) && IN(PH_FINAL)) _Pragma("unroll 1") for (int rep_ = 0; rep_ < REPN(15); ++rep_) { PHL final_phase(p, vcuL, GL); }
#undef IN
#undef SEAM
#undef HB
#undef PROJ
#undef Y
#undef XKV
#undef MEMN
#undef SSQ
#undef XQ
#undef U
#undef ROWTOK
#undef ROWGATE
#undef TILEE
#undef NT
#undef H
#undef HB8
#undef U8
}

static int g_grid = 0;
static void launch_fast(const P& p, int lo, int hi, int& li, hipStream_t stream) {
    Args a{}; a.p = p; a.ph_lo = lo; a.ph_hi = hi; a.li = li++; a.pad = 0;
    hipLaunchKernelGGL(fwd, dim3(g_grid), dim3(NTHR), LDS_BYTES, stream, a);
    const hipError_t le = hipPeekAtLastError();
    if (le != hipSuccess) fprintf(stderr, "kernel_launch: fwd launch [%d,%d) failed: %s\n", lo, hi, hipGetErrorName(le));
}
extern "C" void kernel_launch(void* const* d_in, const int* in_sizes, int n_in, void* d_out, int out_size, void* d_ws, size_t ws_size, hipStream_t stream) {
    if (n_in != 25 || out_size != NTOK * DM || ws_size < WS_END2) { fprintf(stderr, "kernel_launch: unexpected sizes n_in %d out %d ws %zu (need %zu)\n", n_in, out_size, ws_size, (size_t)WS_END2); return; }
    if (g_grid == 0) {
        int dev = 0, cus = 0, per_cu = 0;
        if (hipGetDevice(&dev) != hipSuccess || hipDeviceGetAttribute(&cus, hipDeviceAttributeMultiprocessorCount, dev) != hipSuccess) { g_grid = -1; return; }
        if (hipFuncSetAttribute((const void*)fwd, hipFuncAttributeMaxDynamicSharedMemorySize, LDS_BYTES) != hipSuccess) { fprintf(stderr, "kernel_launch: hipFuncSetAttribute failed\n"); g_grid = -1; return; }
        if (hipOccupancyMaxActiveBlocksPerMultiprocessor(&per_cu, (const void*)fwd, NTHR, LDS_BYTES) != hipSuccess || per_cu < 1) { fprintf(stderr, "kernel_launch: occupancy query says %d\n", per_cu); }
        (void)hipGetLastError();
        g_grid = cus;
    }
    if (g_grid < 0) return;
    P p{};
    const float** pp = (const float**)&p;
    for (int i = 0; i < 25; ++i) pp[i] = (const float*)d_in[i];
    p.out = (float*)d_out; p.ws = (unsigned char*)d_ws;
    if (hipMemsetAsync((char*)d_ws + WS_CTL + (size_t)CW_BAR * 4, 0, (size_t)XCD_BAR_WORDS * 4, stream) != hipSuccess) { fprintf(stderr, "kernel_launch: hipMemsetAsync failed\n"); return; }
    int li = 0;
    launch_fast(p, PH_PRO, PH_END, li, stream);
}
```

```cpp
#include <hip/hip_runtime.h>
#include <cstdio>
#include <cstdint>

constexpr int NTOK = 32768, DM = 1024, NBATCH = 16, SEQ = 2048, NLAYER = 2, MEML = 256;
constexpr int PW = 3072;
constexpr int C_FQ = 0, C_FK = 512, C_FV = 1024, C_GQ = 1536, C_GK = 1792, C_GV = 2048, C_GG = 2560;
constexpr int INW = 3096;
constexpr float EPS = 1e-6f, LOG2E = 1.4426950408889634f;
constexpr int MAXTILES = 288;
constexpr int MAXROWS = MAXTILES * 256;

typedef unsigned short bf16;
__device__ __forceinline__ unsigned f2bf(float f) { unsigned u = __builtin_bit_cast(unsigned, f); return (u + 0x7fffu + ((u >> 16) & 1u)) >> 16; }
__device__ __forceinline__ float bf2f(bf16 b) { return __builtin_bit_cast(float, ((unsigned)b) << 16); }

constexpr size_t MiB = 1u << 20;
constexpr size_t WS_CTL = 0;
constexpr size_t WS_W = 1 * MiB;
constexpr size_t WS_WLAYER = 59 * MiB;
constexpr size_t WS_WXKV = WS_W + 2 * WS_WLAYER;
constexpr size_t WS_HB = WS_WXKV + 4 * MiB;
constexpr size_t WS_PROJ = WS_HB + 64 * MiB;
constexpr size_t WS_XQ = WS_PROJ;
constexpr size_t WS_U = WS_PROJ + 32 * MiB;
constexpr size_t WS_XO8 = WS_U + 40 * MiB;
constexpr size_t WS_SM = WS_PROJ + 192 * MiB;
constexpr size_t WS_CB = WS_SM + 4 * MiB;
constexpr size_t WS_Y = WS_CB + 1 * MiB;
constexpr size_t WS_XKV = WS_Y + 64 * MiB;
constexpr size_t WS_MEMN = WS_XKV + 16 * MiB;
constexpr size_t WS_SSQ = WS_MEMN + 8 * MiB;
constexpr size_t WS_MOE = WS_SSQ + 2 * MiB;
constexpr size_t WS_END = WS_MOE + 2 * MiB;
static_assert(WS_END <= 512 * MiB, "workspace map");
constexpr size_t MO_TOKE = 0;
constexpr size_t MO_TOKG = 256 * 1024;
constexpr size_t MO_ROWTOK = 512 * 1024;
constexpr size_t MO_ROWGATE = 832 * 1024;
constexpr size_t MO_TILEE = 1152 * 1024;
constexpr size_t MO_NT = 1156 * 1024;
constexpr size_t MO_HIST = 1160 * 1024;
constexpr size_t MO_KN = 1280 * 1024;

struct P {
    const float *x, *mem, *mem_norm, *mix_norm, *w_in, *b_forget, *w_alpha_up, *b_alpha, *fox_gain, *gla_gain, *w_out, *cross_norm, *w_xq, *w_xk, *w_xv, *w_xo,
        *moe_norm, *w_rg, *b_rg, *w_re, *b_re, *w_eg, *w_eu, *w_ed, *final_norm;
    float* out; unsigned char* ws;
};
__host__ __device__ __forceinline__ unsigned char* ws_base(unsigned char* w) {
#if defined(__HIP_DEVICE_COMPILE__)
    size_t z = 0; asm volatile("" : "+s"(z));
    return w + z;
#else
    return w;
#endif
}
#define WSP(T, off) ((T*)(ws_base(p.ws) + (off)))

__device__ __forceinline__ float wave_sum(float v) {
#pragma unroll
    for (int o = 1; o < 64; o <<= 1) v += __shfl_xor(v, o);
    return v;
}
__device__ __forceinline__ float wave_min(float v) {
#pragma unroll
    for (int o = 1; o < 64; o <<= 1) v = fminf(v, __shfl_xor(v, o));
    return v;
}
__device__ __forceinline__ float wave_max(float v) {
#pragma unroll
    for (int o = 1; o < 64; o <<= 1) v = fmaxf(v, __shfl_xor(v, o));
    return v;
}
__device__ __forceinline__ float row_rs(const float* ssq, int row) {
    const float4* s = (const float4*)(ssq + (size_t)row * 16);
    float4 a = s[0], b = s[1], c = s[2], d = s[3];
    float t = ((a.x + a.y) + (a.z + a.w)) + ((b.x + b.y) + (b.z + b.w)) + ((c.x + c.y) + (c.z + c.w)) + ((d.x + d.y) + (d.z + d.w));
    return rsqrtf(t * (1.0f / DM) + EPS);
}
__device__ __forceinline__ float log_sigmoid(float z) { return fminf(z, 0.f) - log1pf(expf(-fabsf(z))); }
__device__ __forceinline__ float silu(float z) { return z / (1.f + expf(-z)); }

typedef unsigned st_v4u __attribute__((ext_vector_type(4)));
typedef unsigned st_v2u __attribute__((ext_vector_type(2)));
#ifndef WT_STORES
#define WT_STORES 0
#endif
__device__ __forceinline__ void st_b128(void* p, st_v4u v) {
#if WT_STORES
    asm volatile("global_store_dwordx4 %0, %1, off sc1\n\ts_nop 1" :: "v"(p), "v"(v) : "memory");
#else
    *(st_v4u*)p = v;
#endif
}
__device__ __forceinline__ void st_b128_wt(void* p, st_v4u v) { asm volatile("global_store_dwordx4 %0, %1, off sc1\n\ts_nop 1" :: "v"(p), "v"(v) : "memory"); }
__device__ __forceinline__ void st_b64(void* p, st_v2u v) {
#if WT_STORES
    asm volatile("global_store_dwordx2 %0, %1, off sc1" :: "v"(p), "v"(v) : "memory");
#else
    *(st_v2u*)p = v;
#endif
}
#define XB_TMO      128
#define XB_XCNT(j)  (256  + 64 * (j))
#define XB_XSUB(j)  (1280 + 64 * (j))
#define XB_XGEN(j)  (2304 + 64 * (j))
#define XB_TOP      3328
#define XB_TOPGEN   3392
#define XCD_BAR_WORDS 3456
#define XB_SPIN_CAP (1u << 18)
#define LAS __attribute__((address_space(3)))

__device__ __forceinline__ unsigned xb_ld(unsigned* p)              { return __hip_atomic_load(p, __ATOMIC_RELAXED, __HIP_MEMORY_SCOPE_AGENT); }
__device__ __forceinline__ unsigned xb_add(unsigned* p, unsigned v) { return __hip_atomic_fetch_add(p, v, __ATOMIC_RELAXED, __HIP_MEMORY_SCOPE_AGENT); }
__device__ __forceinline__ unsigned xb_xcc_id() { return (unsigned)__builtin_amdgcn_s_getreg((3 << 11) | 20) & 0xFu; }
#define XB_SPIN(cond, bar) do { unsigned _sp = 0; while (cond) { __builtin_amdgcn_s_sleep(1); \
    if ((++_sp & 255u) == 0u) { if (xb_ld(&(bar)[XB_TMO])) break; if (_sp > XB_SPIN_CAP) { atomicAdd(&(bar)[XB_TMO], 1u); break; } } } } while (0)

struct XcdBarrier {
    unsigned* bar; unsigned x;
    volatile LAS unsigned* st;
};

__device__ __forceinline__ XcdBarrier xcd_barrier_post(unsigned* bar, volatile LAS unsigned* st) {
    XcdBarrier b; b.bar = bar; b.x = xb_xcc_id(); b.st = st;
    if (threadIdx.x == 0) (void)xb_add(&bar[XB_XCNT(b.x)], 1u);
    return b;
}
__device__ __forceinline__ void xcd_barrier_complete(unsigned* bar, unsigned x, unsigned& nloc, unsigned& nx) {
    const unsigned G = gridDim.x * gridDim.y * gridDim.z;
    unsigned sum, cnt, mine, sp = 0u;
    for (;;) {
        sum = 0u; cnt = 0u; mine = 0u;
#pragma unroll
        for (unsigned j = 0; j < 16; ++j) { const unsigned c = xb_ld(&bar[XB_XCNT(j)]); sum += c; cnt += (c > 0u) ? 1u : 0u; mine = (j == x) ? c : mine; }
        if (sum == G) break;
        __builtin_amdgcn_s_sleep(1);
        if ((++sp & 255u) == 0u) { if (xb_ld(&bar[XB_TMO])) break; if (sp > XB_SPIN_CAP) { atomicAdd(&bar[XB_TMO], 1u); break; } }
    }
    nloc = mine > 0u ? mine : 1u; nx = cnt > 0u ? cnt : 1u;
}

__device__ __forceinline__ void xcd_barrier(const XcdBarrier& b) {
    asm volatile("s_waitcnt vmcnt(0)" ::: "memory");
    __syncthreads();
    if (threadIdx.x == 0) {
        unsigned* bar = b.bar;
        __builtin_amdgcn_s_waitcnt(0);
        unsigned nloc = b.st[0], nx = b.st[1];
        if (nloc == 0u) { xcd_barrier_complete(bar, b.x, nloc, nx); b.st[0] = nloc; b.st[1] = nx; }
        const unsigned old = xb_add(&bar[XB_XSUB(b.x)], 1u);
        const unsigned gen = old / nloc;
        if (old + 1u == (gen + 1u) * nloc) {
            __builtin_amdgcn_fence(__ATOMIC_RELEASE, "agent");
            asm volatile("s_waitcnt vmcnt(0)" ::: "memory");
            const unsigned og = xb_add(&bar[XB_TOP], 1u);
            const unsigned tg = og / nx;
            if (og + 1u == (tg + 1u) * nx) xb_add(&bar[XB_TOPGEN], 1u);
            else XB_SPIN(xb_ld(&bar[XB_TOPGEN]) == tg, bar);
            __builtin_amdgcn_fence(__ATOMIC_ACQUIRE, "agent");
            xb_add(&bar[XB_XGEN(b.x)], 1u);
            asm volatile("s_waitcnt vmcnt(0)" ::: "memory");
        } else {
            XB_SPIN(xb_ld(&bar[XB_XGEN(b.x)]) == gen, bar);
            __builtin_amdgcn_fence(__ATOMIC_ACQUIRE, "agent");
            asm volatile("s_waitcnt vmcnt(0)" ::: "memory");
        }
    }
    __syncthreads();
}

namespace pg8 {
#define PG8_LAS __attribute__((address_space(3)))
typedef unsigned short bf16_t;
typedef short bf16x8 __attribute__((ext_vector_type(8)));
typedef float f32x4 __attribute__((ext_vector_type(4)));
typedef unsigned u32x4 __attribute__((ext_vector_type(4)));
typedef unsigned u32x2 __attribute__((ext_vector_type(2)));
constexpr int BM = 256, BK = 64, HALF = 128, HTB = HALF * BK * 2, STAGE_BYTES = 8 * HTB, NXCD = 8, WGM = 8;

__host__ __device__ __forceinline__ int lds_byte(int r, int c) { const int st = (r >> 4) * 2 + (c >> 5), rr = r & 15, cc = c & 31, ob = rr * 64 + cc * 2; return st * 1024 + (ob ^ (((ob >> 9) & 1) << 5)); }
__host__ __device__ __forceinline__ void stage_rc(int b, int& R, int& C) { const int st = b / 1024, sb = b % 1024, swz = sb ^ (((sb >> 9) & 1) << 5); R = (st >> 1) * 16 + swz / 64; C = (st & 1) * 32 + (swz % 64) / 2; }
__host__ __device__ __forceinline__ int perm32(int rho) { const int n = rho >> 4, i = rho & 15; return 8 * (i >> 2) + 4 * n + (i & 3); }

struct Unit { int pm, pn, e; };

struct StaticOrder {
    static constexpr bool GATHER = false;
    static constexpr size_t KSTEP_A = 128;
    const char* A; const char* Bt; int K; int nM, nN, nwg, G, c;
    __device__ void init(const void* A_, const void* Bt_, int M, int N, int K_, int G_, int c_) { A = (const char*)A_; Bt = (const char*)Bt_; K = K_; nM = M / BM; nN = N / BM; nwg = nM * nN; G = G_; c = c_; }
    __device__ bool next(int i, Unit& u) const {
        const long L = (long)i * G + c; if (L >= nwg) return false;
        int wgid = (int)L; { const int q = nwg / NXCD, r = nwg % NXCD, xcd = wgid % NXCD, off = wgid / NXCD; wgid = (xcd < r ? xcd * (q + 1) : r * (q + 1) + (xcd - r) * q) + off; }
        const int nig = WGM * nN, gid = wgid / nig, fm = gid * WGM, gsz = (nM - fm) < WGM ? (nM - fm) : WGM;
        u.pm = fm + ((wgid % nig) % gsz); u.pn = (wgid % nig) / gsz; u.e = 0; return true;
    }
    __device__ __forceinline__ const char* a_base(const Unit& u) const { return A + (size_t)u.pm * (size_t)(BM * 2) * K; }
    __device__ __forceinline__ const char* b_base(const Unit& u) const { return Bt + (size_t)u.pn * (size_t)(BM * 2) * K; }
    __device__ __forceinline__ unsigned a_off(int, int, int, int) const { return 0u; }
};

__device__ __forceinline__ unsigned cvt_pk_bf16(float lo, float hi) { unsigned r; asm volatile("v_cvt_pk_bf16_f32 %0, %1, %2" : "=v"(r) : "v"(lo), "v"(hi)); return r; }

typedef int i32x8 __attribute__((ext_vector_type(8)));
typedef int i32x4 __attribute__((ext_vector_type(4)));
template <int K, class Epi, class Sched, bool ALIGN_EPI, bool FP8 = false, int SA = 127, int SB = 127>
__device__ __forceinline__ void gemm_phase(PG8_LAS unsigned char* lds, const Sched& S, const Epi& E) {
    int tid_ = threadIdx.x; asm volatile("" : "+v"(tid_));
    const int tid = tid_, wid = __builtin_amdgcn_readfirstlane(tid >> 6), lane = tid & 63, wr = wid >> 2, wc = wid & 3, fr = lane & 15, fq = lane >> 4;
    constexpr int nt = K / BK;
    constexpr int NH = Sched::GATHER ? 2 : 1;
    unsigned voffB[2], cvA[NH][2], nvA[NH][2];
#pragma unroll
    for (int i = 0; i < 2; ++i) { int R, C; stage_rc(tid * 16 + i * 8192, R, C); const int Rb = Epi::PERM ? ((R & ~31) + perm32(R & 31)) : R;
        voffB[i] = (unsigned)(Rb * K + C) * 2u;
        cvA[0][i] = nvA[0][i] = (unsigned)(R * K + C) * 2u; if constexpr (NH == 2) { cvA[NH - 1][i] = nvA[NH - 1][i] = cvA[0][i]; } }
    constexpr size_t kstep = (size_t)(BK * 2);
    constexpr size_t hstep = (size_t)HALF * K * 2;
    constexpr size_t hstepA = Sched::GATHER ? (size_t)0 : hstep;
    constexpr size_t kstepA = Sched::KSTEP_A;
    const unsigned ldsw = (unsigned)wid * 1024u;
    const int aoff = lds_byte(wr * 64 + fr, fq * 8), boff = lds_byte(wc * 32 + fr, fq * 8);
#define PG8_SA(b, h) (((b) * 2 + (h)) * HTB)
#define PG8_SB(b, h) ((4 + (b) * 2 + (h)) * HTB)
#define PG8_STAGE(bufoff, gbase, voff) do { _Pragma("unroll") for (int _i = 0; _i < 2; ++_i) \
        __builtin_amdgcn_global_load_lds((const unsigned*)((const char*)(gbase) + (voff)[_i]), (PG8_LAS unsigned*)(lds + (bufoff) + ldsw + _i * 8192), 16, 0, 0); } while (0)
#define PG8_LD32(addr) __builtin_shufflevector(*(const PG8_LAS i32x4*)(addr), *(const PG8_LAS i32x4*)((addr) + 1024), 0, 1, 2, 3, 4, 5, 6, 7)
#define PG8_LDA(dst, b, h) do { _Pragma("unroll") for (int m = 0; m < 4; ++m) dst[m] = PG8_LD32(lds + PG8_SA(b, h) + aoff + m * 2048); } while (0)
#define PG8_LDB(dst, b, h) do { _Pragma("unroll") for (int n = 0; n < 2; ++n) dst[n] = PG8_LD32(lds + PG8_SB(b, h) + boff + n * 2048); } while (0)
#define PG8_H0(x) __builtin_bit_cast(bf16x8, __builtin_shufflevector((x), (x), 0, 1, 2, 3))
#define PG8_H1(x) __builtin_bit_cast(bf16x8, __builtin_shufflevector((x), (x), 4, 5, 6, 7))
#define PG8_MMA(ai, bj, At, Bt) do { __builtin_amdgcn_s_setprio(1); _Pragma("unroll") for (int m = 0; m < 4; ++m) _Pragma("unroll") for (int n = 0; n < 2; ++n) { \
        if constexpr (FP8) asm volatile("v_mfma_scale_f32_16x16x128_f8f6f4 %0, %1, %2, %0, %3, %4 op_sel_hi:[0,0,0]" : "+v"(acc[ai][bj][m][n]) : "v"(Bt[n]), "v"(At[m]), "v"(sbv), "v"(sav)); \
        else { acc[ai][bj][m][n] = __builtin_amdgcn_mfma_f32_16x16x32_bf16(PG8_H0(Bt[n]), PG8_H0(At[m]), acc[ai][bj][m][n], 0, 0, 0); \
               acc[ai][bj][m][n] = __builtin_amdgcn_mfma_f32_16x16x32_bf16(PG8_H1(Bt[n]), PG8_H1(At[m]), acc[ai][bj][m][n], 0, 0, 0); } } \
        __builtin_amdgcn_s_setprio(0); } while (0)
#define PG8_WAIT_V(n) asm volatile("s_waitcnt vmcnt(" #n ")" ::: "memory")
#define PG8_WAIT_L(n) asm volatile("s_waitcnt lgkmcnt(" #n ")" ::: "memory")
#define PG8_BAR __builtin_amdgcn_s_barrier()
#define PG8_SCHED __builtin_amdgcn_sched_barrier(0)
    int sav = SA, sbv = SB; asm volatile("" : "+v"(sav), "+v"(sbv));
    Unit cur, nxt; int ui = 0;
    if (!S.next(0, cur)) return;
    f32x4 acc[2][2][4][2];
#pragma unroll
    for (int a = 0; a < 2; ++a)
#pragma unroll
        for (int b = 0; b < 2; ++b)
#pragma unroll
            for (int m = 0; m < 4; ++m)
#pragma unroll
                for (int n = 0; n < 2; ++n) acc[a][b][m][n] = (f32x4){0.f, 0.f, 0.f, 0.f};
    i32x8 At[4], B0[2], B1[2];
    const char* cA = S.a_base(cur); const char* cB = S.b_base(cur);
    if constexpr (Sched::GATHER) {
        int R0, C0, R1, C1; stage_rc(tid * 16, R0, C0); stage_rc(tid * 16 + 8192, R1, C1);
#pragma unroll
        for (int h = 0; h < 2; ++h) { cvA[h][0] = S.a_off(0, h, R0, C0 * 2); cvA[h][1] = S.a_off(0, h, R1, C1 * 2); }
    }
    PG8_STAGE(PG8_SB(0, 0), cB, voffB); PG8_STAGE(PG8_SB(0, 1), cB + hstep, voffB); PG8_STAGE(PG8_SA(0, 0), cA, cvA[0]); PG8_STAGE(PG8_SA(0, 1), cA + hstepA, cvA[NH - 1]);
    if (wr == 1) PG8_BAR;
    PG8_WAIT_V(2); PG8_BAR;
    PG8_STAGE(PG8_SB(1, 0), cB + kstep, voffB); PG8_STAGE(PG8_SA(1, 0), cA + kstepA, cvA[0]); PG8_STAGE(PG8_SB(1, 1), cB + hstep + kstep, voffB);
    PG8_WAIT_V(6); PG8_BAR;
    for (;;) {
        const bool has_next = S.next(ui + 1, nxt);
        const char* nA = has_next ? S.a_base(nxt) : cA; const char* nB = has_next ? S.b_base(nxt) : cB;
        if constexpr (Sched::GATHER) {
            if (has_next) {
                int t2 = threadIdx.x; asm volatile("" : "+v"(t2));
                int R0, C0, R1, C1; stage_rc(t2 * 16, R0, C0); stage_rc(t2 * 16 + 8192, R1, C1);
#pragma unroll
                for (int h = 0; h < 2; ++h) { nvA[h][0] = S.a_off(ui + 1, h, R0, C0 * 2); nvA[h][1] = S.a_off(ui + 1, h, R1, C1 * 2); }
            } else {
#pragma unroll
                for (int h = 0; h < 2; ++h) { nvA[h][0] = cvA[h][0]; nvA[h][1] = cvA[h][1]; }
            }
        }
#pragma unroll 1
        for (int t = 0; t < nt; t += 2) {
            const bool last = (t == nt - 2);
            const char* a1 = cA + (size_t)(t + 1) * kstepA;
            const char* a2 = last ? nA : cA + (size_t)(t + 2) * kstepA; const char* b2 = last ? nB : cB + (size_t)(t + 2) * kstep;
            const char* a3 = a2 + kstepA; const char* b3 = b2 + kstep;
            unsigned v2[NH][2];
#pragma unroll
            for (int h = 0; h < NH; ++h) { if constexpr (Sched::GATHER) { v2[h][0] = last ? nvA[h][0] : cvA[h][0]; v2[h][1] = last ? nvA[h][1] : cvA[h][1]; } else { v2[h][0] = cvA[h][0]; v2[h][1] = cvA[h][1]; } }
            PG8_LDB(B0, 0, 0); PG8_LDB(B1, 0, 1); PG8_SCHED; PG8_LDA(At, 0, 0); PG8_STAGE(PG8_SA(1, 1), a1 + hstepA, cvA[NH - 1]);
            PG8_WAIT_V(8); PG8_WAIT_L(0); PG8_BAR; PG8_MMA(0, 0, At, B0); PG8_MMA(0, 1, At, B1); PG8_BAR; PG8_SCHED;
            PG8_LDA(At, 0, 1); PG8_STAGE(PG8_SB(0, 0), b2, voffB); PG8_STAGE(PG8_SB(0, 1), b2 + hstep, voffB); PG8_STAGE(PG8_SA(0, 0), a2, v2[0]);
            PG8_WAIT_V(8); PG8_WAIT_L(0); PG8_BAR; PG8_MMA(1, 0, At, B0); PG8_MMA(1, 1, At, B1); PG8_BAR; PG8_SCHED;
            PG8_LDB(B0, 1, 0); PG8_LDB(B1, 1, 1); PG8_SCHED; PG8_LDA(At, 1, 0); PG8_STAGE(PG8_SA(0, 1), a2 + hstepA, v2[NH - 1]);
            PG8_WAIT_V(8); PG8_WAIT_L(0); PG8_BAR; PG8_MMA(0, 0, At, B0); PG8_MMA(0, 1, At, B1); PG8_BAR; PG8_SCHED;
            PG8_LDA(At, 1, 1); PG8_STAGE(PG8_SB(1, 0), b3, voffB); PG8_STAGE(PG8_SB(1, 1), b3 + hstep, voffB); PG8_STAGE(PG8_SA(1, 0), a3, v2[0]);
            PG8_WAIT_V(8); PG8_WAIT_L(0); PG8_BAR; PG8_MMA(1, 0, At, B0); PG8_MMA(1, 1, At, B1); PG8_BAR; PG8_SCHED;
        }
        if constexpr (ALIGN_EPI) { if (wr == 0) PG8_BAR; }
        if constexpr (FP8) asm volatile("s_nop 15\n\ts_nop 15" ::: "memory");
        E(acc, cur, ui, wr, wc, fr, fq);
        if (!has_next) break;
#pragma unroll
        for (int a = 0; a < 2; ++a)
#pragma unroll
            for (int b = 0; b < 2; ++b)
#pragma unroll
                for (int m = 0; m < 4; ++m)
#pragma unroll
                    for (int n = 0; n < 2; ++n) acc[a][b][m][n] = (f32x4){0.f, 0.f, 0.f, 0.f};
        cur = nxt; cA = nA; cB = nB; ++ui;
        if constexpr (Sched::GATHER) {
#pragma unroll
            for (int h = 0; h < NH; ++h) { cvA[h][0] = nvA[h][0]; cvA[h][1] = nvA[h][1]; }
        }
        if constexpr (ALIGN_EPI) { if (wr == 1) PG8_BAR; }
    }
    PG8_WAIT_V(0);
    if constexpr (!ALIGN_EPI) { if (wr == 0) PG8_BAR; }
    PG8_BAR;
#undef PG8_SA
#undef PG8_SB
#undef PG8_STAGE
#undef PG8_LDA
#undef PG8_LDB
#undef PG8_MMA
#undef PG8_LD32
#undef PG8_H0
#undef PG8_H1
#undef PG8_WAIT_V
#undef PG8_WAIT_L
#undef PG8_BAR
#undef PG8_SCHED
}
}
#define GAS __attribute__((address_space(1)))
typedef float f32x4 __attribute__((ext_vector_type(4)));
typedef float f32x16 __attribute__((ext_vector_type(16)));
typedef short bf16x8 __attribute__((ext_vector_type(8)));
typedef unsigned v4u __attribute__((ext_vector_type(4)));
typedef unsigned v2u __attribute__((ext_vector_type(2)));
#define LDS_WAIT() asm volatile("s_waitcnt lgkmcnt(0)" ::: "memory")
#define VM_WAIT() asm volatile("s_waitcnt vmcnt(0)" ::: "memory")
__device__ __forceinline__ unsigned pk2(float lo, float hi) { return f2bf(lo) | (f2bf(hi) << 16); }

constexpr int NWAVES = 8, NTHR = 512;
constexpr int LDS_STAGE = 0;
constexpr int LDS_RS = 131072;
constexpr int LDS_ROWTOK = LDS_RS + 8192;
constexpr int LDS_GATE = LDS_ROWTOK + 8192;
constexpr int LDS_MISC = LDS_GATE + 8192;
constexpr int LDS_BYTES = LDS_MISC + 256;
constexpr size_t WO_IN = 0, WO_SM = 6 * MiB, WO_RHI = 6 * MiB + 65536, WO_RLO = 6 * MiB + 131072, WO_OUT = 7 * MiB, WO_XQ = 9 * MiB, WO_XO = 10 * MiB, WO_GU = 11 * MiB, WO_D = 43 * MiB;
static_assert(WO_D + 16 * MiB <= WS_WLAYER, "weight block");
constexpr int CW_BAR = 4096;
constexpr int MAX_LAUNCH = 40;
static_assert((CW_BAR + MAX_LAUNCH * XCD_BAR_WORDS) * 4 <= (int)(1 * MiB), "ctl");

enum { PH_PRO = 0, PH_XKV = 1, PH_L0 = 2, NPH = 13, PH_FINAL = PH_L0 + NLAYER * NPH, PH_END = PH_FINAL + 1 };
enum { LP_INPROJ = 0, LP_MIXA, LP_MIXB, LP_MIXC, LP_WOUT, LP_XQ, LP_XATTN, LP_XO, LP_ROUTE, LP_SORT, LP_GU, LP_DOWN0, LP_DOWN1 };

struct Args { P p; int ph_lo, ph_hi, li, pad; };

#ifndef WT_PROJ
#define WT_PROJ 0
#endif
template <bool HAS_RS> struct EpiBf16 {
    static constexpr bool PERM = true;
    bf16* O; int ldc; const LAS float* rstab;
    __device__ __forceinline__ void operator()(const pg8::f32x4 (&acc)[2][2][4][2], const pg8::Unit& u, int iu, int wr, int wc, int fr, int fq) const {
#pragma unroll
        for (int ai = 0; ai < 2; ++ai)
#pragma unroll
            for (int m = 0; m < 4; ++m) {
                const int lrow = ai * 128 + wr * 64 + m * 16 + fr;
                float sc = 1.f; if (HAS_RS) sc = rstab[iu * 256 + lrow];
                bf16* rowp = O + (size_t)(u.pm * 256 + lrow) * ldc + u.pn * 256 + wc * 32 + 8 * fq;
#pragma unroll
                for (int bj = 0; bj < 2; ++bj) { const pg8::f32x4 v0 = acc[ai][bj][m][0] * sc, v1 = acc[ai][bj][m][1] * sc;
                    pg8::u32x4 w; w.x = pg8::cvt_pk_bf16(v0[0], v0[1]); w.y = pg8::cvt_pk_bf16(v0[2], v0[3]); w.z = pg8::cvt_pk_bf16(v1[0], v1[1]); w.w = pg8::cvt_pk_bf16(v1[2], v1[3]);
                    if (WT_PROJ) st_b128_wt(rowp + bj * 128, w); else st_b128(rowp + bj * 128, w); }
            }
    }
};
__device__ __forceinline__ unsigned pk4_fp8(float a, float b, float c, float d) { int w = __builtin_amdgcn_cvt_pk_fp8_f32(a, b, 0, false); w = __builtin_amdgcn_cvt_pk_fp8_f32(c, d, w, true); return (unsigned)w; }
struct EpiGU {
    static constexpr bool PERM = true;
    unsigned char* U8; const LAS float* rstab;
    __device__ __forceinline__ void operator()(const pg8::f32x4 (&acc)[2][2][4][2], const pg8::Unit& u, int iu, int wr, int wc, int fr, int fq) const {
#pragma unroll
        for (int ai = 0; ai < 2; ++ai)
#pragma unroll
            for (int m = 0; m < 4; ++m) {
                const int lrow = ai * 128 + wr * 64 + m * 16 + fr;
                const float sc = rstab[iu * 256 + lrow];
                float o[8];
#pragma unroll
                for (int n = 0; n < 2; ++n)
#pragma unroll
                    for (int j = 0; j < 4; ++j) { const float g = acc[ai][0][m][n][j] * sc, uu = acc[ai][1][m][n][j] * sc; o[n * 4 + j] = 4.f * g * uu * __builtin_amdgcn_rcpf(1.f + __expf(-g)); }
                pg8::u32x2 w; w.x = pk4_fp8(o[0], o[1], o[2], o[3]); w.y = pk4_fp8(o[4], o[5], o[6], o[7]);
                st_b64(U8 + (size_t)(u.pm * 256 + lrow) * 512 + u.pn * 128 + wc * 32 + 8 * fq, w);
            }
    }
};
template <int MODE, bool W8 = false> struct EpiRes {
    static constexpr bool PERM = true;
    static constexpr bool MOE = MODE != 0;
    bf16* hb; float* ssq; const LAS int* rowtab; const LAS float* gatetab; float gs; bf16* t0; unsigned char* h8;
    static __device__ __forceinline__ void unpack8(const pg8::u32x4& w, float (&f)[8]) {
        f[0] = __builtin_bit_cast(float, w.x << 16); f[1] = __builtin_bit_cast(float, w.x & 0xffff0000u); f[2] = __builtin_bit_cast(float, w.y << 16); f[3] = __builtin_bit_cast(float, w.y & 0xffff0000u);
        f[4] = __builtin_bit_cast(float, w.z << 16); f[5] = __builtin_bit_cast(float, w.z & 0xffff0000u); f[6] = __builtin_bit_cast(float, w.w << 16); f[7] = __builtin_bit_cast(float, w.w & 0xffff0000u); }
    __device__ __forceinline__ void operator()(const pg8::f32x4 (&acc)[2][2][4][2], const pg8::Unit& u, int iu, int wr, int wc, int fr, int fq) const {
#pragma unroll
        for (int ai = 0; ai < 2; ++ai)
#pragma unroll
            for (int m = 0; m < 4; ++m) {
                const int lrow = ai * 128 + wr * 64 + m * 16 + fr;
                int row = u.pm * 256 + lrow; float g = gs;
                if (MOE) { row = rowtab[iu * 256 + lrow]; g = gatetab[iu * 256 + lrow] * gs; }
                const bool ok = !MOE || row >= 0;
                const size_t off = (size_t)(ok ? row : 0) * DM + u.pn * 256 + wc * 32 + 8 * fq;
                float q = 0.f;
                if (ok) {
#pragma unroll
                    for (int bj = 0; bj < 2; ++bj) {
                        float o[8];
#pragma unroll
                        for (int j = 0; j < 4; ++j) { o[j] = acc[ai][bj][m][0][j] * g; o[4 + j] = acc[ai][bj][m][1][j] * g; }
                        if (MODE == 1) { pg8::u32x4 w; w.x = pg8::cvt_pk_bf16(o[0], o[1]); w.y = pg8::cvt_pk_bf16(o[2], o[3]); w.z = pg8::cvt_pk_bf16(o[4], o[5]); w.w = pg8::cvt_pk_bf16(o[6], o[7]); st_b128(t0 + off + bj * 128, w); }
                        else {
                            float bs[8]; unpack8(*(const pg8::u32x4*)(hb + off + bj * 128), bs);
                            if (MODE == 2) { float tv[8]; unpack8(*(const pg8::u32x4*)(t0 + off + bj * 128), tv);
#pragma unroll
                                for (int j = 0; j < 8; ++j) bs[j] += tv[j]; }
#pragma unroll
                            for (int j = 0; j < 8; ++j) o[j] += bs[j];
                            pg8::u32x4 w; w.x = pg8::cvt_pk_bf16(o[0], o[1]); w.y = pg8::cvt_pk_bf16(o[2], o[3]); w.z = pg8::cvt_pk_bf16(o[4], o[5]); w.w = pg8::cvt_pk_bf16(o[6], o[7]);
                            float r[8]; unpack8(w, r);
#pragma unroll
                            for (int j = 0; j < 8; ++j) q += r[j] * r[j];
                            st_b128(hb + off + bj * 128, w);
                            if (W8) { pg8::u32x2 w8; w8.x = pk4_fp8(o[0], o[1], o[2], o[3]); w8.y = pk4_fp8(o[4], o[5], o[6], o[7]); st_b64(h8 + off + bj * 128, w8); } }
                    }
                }
                if (MODE != 1) { q += __shfl_xor(q, 16); q += __shfl_xor(q, 32); if (fq == 0 && ok) ssq[(size_t)row * 16 + u.pn * 4 + wc] = q; }
            }
    }
};
template <int MODE> struct MoeOrder {
    static constexpr bool GATHER = MODE == 0;
    static constexpr size_t KSTEP_A = 128;
    const char* A; const char* Bt; int K; size_t estride; int lo, hi, G, c; const int* tilee; const LAS int* rowtab;
    __device__ bool next(int i, pg8::Unit& u) const { const int L = i * G + c, t = lo + (L >> 2); if (t >= hi) return false; u.pm = t; u.pn = L & 3; u.e = tilee[t]; return true; }
    __device__ __forceinline__ const char* a_base(const pg8::Unit& u) const { return GATHER ? A : A + (size_t)u.pm * (size_t)512 * K; }
    __device__ __forceinline__ const char* b_base(const pg8::Unit& u) const { return Bt + (size_t)u.e * estride + (size_t)u.pn * (size_t)512 * K; }
    __device__ __forceinline__ unsigned a_off(int iu, int h, int R, int Cb) const { return (unsigned)rowtab[iu * 256 + h * 128 + R] * (unsigned)(K * 2) + (unsigned)Cb; }
};

__device__ __forceinline__ void router_weights(const P& p, int gtid, int gstride);
__device__ __forceinline__ void tr_item(const float* W, int N, int K, int k0, int n0, const float* gain, float scale, bf16* dst, LAS float* scr, int lane) {
    const int kr = lane >> 3, c4 = lane & 7;
    f32x4 v[8];
#pragma unroll
    for (int i = 0; i < 8; ++i) v[i] = *(const f32x4*)(W + (size_t)(k0 + 8 * i + kr) * N + n0 + 4 * c4);
#pragma unroll
    for (int i = 0; i < 8; ++i) { const int kk = 8 * i + kr; float g = scale; if (gain) g *= gain[k0 + kk];
        LAS float* d = scr + kk * 33 + 4 * c4; d[0] = v[i].x * g; d[1] = v[i].y * g; d[2] = v[i].z * g; d[3] = v[i].w * g; }
    LDS_WAIT();
    const int c = lane & 7;
#pragma unroll
    for (int j = 0; j < 4; ++j) { const int n = (lane >> 3) + 8 * j; const LAS float* s = scr + (8 * c) * 33 + n;
        v4u o; o.x = pk2(s[0 * 33], s[1 * 33]); o.y = pk2(s[2 * 33], s[3 * 33]); o.z = pk2(s[4 * 33], s[5 * 33]); o.w = pk2(s[6 * 33], s[7 * 33]);
        st_b128(dst + (size_t)n * K + k0 + 8 * c, o); }
    LDS_WAIT();
}
__device__ __forceinline__ void tr_item8(const float* W, int N, int K, int k0, int n0, const float* gain, float scale, unsigned char* dst, LAS float* scr, int lane) {
    const int kr = lane >> 3, c4 = lane & 7;
    f32x4 v[8];
#pragma unroll
    for (int i = 0; i < 8; ++i) v[i] = *(const f32x4*)(W + (size_t)(k0 + 8 * i + kr) * N + n0 + 4 * c4);
#pragma unroll
    for (int i = 0; i < 8; ++i) { const int kk = 8 * i + kr; float g = scale; if (gain) g *= gain[k0 + kk];
        LAS float* d = scr + kk * 33 + 4 * c4; d[0] = v[i].x * g; d[1] = v[i].y * g; d[2] = v[i].z * g; d[3] = v[i].w * g; }
    LDS_WAIT();
    const int c = lane & 7;
#pragma unroll
    for (int j = 0; j < 4; ++j) { const int n = (lane >> 3) + 8 * j; const LAS float* s = scr + (8 * c) * 33 + n;
        v2u o; o.x = pk4_fp8(s[0 * 33], s[1 * 33], s[2 * 33], s[3 * 33]); o.y = pk4_fp8(s[4 * 33], s[5 * 33], s[6 * 33], s[7 * 33]);
        st_b64(dst + (size_t)n * K + k0 + 8 * c, o); }
    LDS_WAIT();
}
constexpr int IT_LAYER = 15360;
__device__ __forceinline__ void prologue_item(const P& p, int it, LAS float* scr, int lane) {
    const int l = it / IT_LAYER; int r = it % IT_LAYER;
    unsigned char* wl = ws_base(p.ws) + WS_W + (size_t)l * WS_WLAYER;
    if (r < 1536) {
        const int seg = r / 768; r %= 768; const int kb = r / 48, nb = r % 48; const int n0 = (seg ? 1544 : 0) + 32 * nb, drow = seg * 1536 + 32 * nb;
        const float sc = drow < 512 ? 0.125f * LOG2E : ((drow >= C_GQ && drow < C_GK) ? 0.125f : 1.f);
        tr_item(p.w_in + (size_t)l * DM * INW, INW, DM, 64 * kb, n0, p.mix_norm + l * DM, sc, (bf16*)(wl + WO_IN) + (size_t)drow * DM, scr, lane); return; }
    r -= 1536;
    if (r < 512) { const int kb = r / 32, nb = r % 32; tr_item(p.w_out + (size_t)l * DM * DM, DM, DM, 64 * kb, 32 * nb, nullptr, 1.f, (bf16*)(wl + WO_OUT) + (size_t)(32 * nb) * DM, scr, lane); return; }
    r -= 512;
    if (r < 256) { const int kb = r / 16, nb = r % 16; tr_item(p.w_xq + (size_t)l * DM * 512, 512, DM, 64 * kb, 32 * nb, p.cross_norm + l * DM, 0.08838834764831845f * LOG2E, (bf16*)(wl + WO_XQ) + (size_t)(32 * nb) * DM, scr, lane); return; }
    r -= 256;
    if (r < 256) { const int kb = r / 32, nb = r % 32; tr_item8(p.w_xo + (size_t)l * 512 * DM, DM, 512, 64 * kb, 32 * nb, nullptr, 32.f, (unsigned char*)(wl + WO_XO) + (size_t)(32 * nb) * 512, scr, lane); return; }
    r -= 256;
    if (r < 512) { const int kv = r / 256; r %= 256; const int kb = r / 16, nb = r % 16;
        tr_item((kv ? p.w_xv : p.w_xk) + (size_t)l * DM * 512, 512, DM, 64 * kb, 32 * nb, nullptr, 1.f, (bf16*)(ws_base(p.ws) + WS_WXKV) + (size_t)(l * 1024 + kv * 512 + 32 * nb) * DM, scr, lane); return; }
    r -= 512;
    if (r < 8192) { const int up = r / 4096; r %= 4096; const int e = r / 256; r %= 256; const int kb = r / 16, nb = r % 16; const int c0 = 32 * nb, drow = (c0 >> 7) * 256 + up * 128 + (c0 & 127);
        tr_item8((up ? p.w_eu : p.w_eg) + ((size_t)l * 16 + e) * DM * 512, 512, DM, 64 * kb, c0, p.moe_norm + l * DM, 32.f, (unsigned char*)(wl + WO_GU) + ((size_t)e * 1024 + drow) * DM, scr, lane); return; }
    r -= 8192;
    { const int e = r / 256; r %= 256; const int kb = r / 32, nb = r % 32;
      tr_item8(p.w_ed + ((size_t)l * 16 + e) * 512 * DM, DM, 512, 64 * kb, 32 * nb, nullptr, 32.f, (unsigned char*)(wl + WO_D) + ((size_t)e * 1024 + 32 * nb) * 512, scr, lane); }
}
__device__ __forceinline__ void row_to_bf16(const float* src, bf16* dst, float* ssq, const float* gain, int lane, int mode) {
    const f32x4* s = (const f32x4*)src + lane;
    f32x4 v[4]; float q = 0.f;
#pragma unroll
    for (int j = 0; j < 4; ++j) { v[j] = s[64 * j]; q += (v[j].x * v[j].x + v[j].y * v[j].y) + (v[j].z * v[j].z + v[j].w * v[j].w); }
    q = wave_sum(q);
    float sc = 1.f;
    if (mode == 1) sc = rsqrtf(q * (1.0f / DM) + EPS);
    v2u* d = (v2u*)dst + lane; float q2 = 0.f;
#pragma unroll
    for (int j = 0; j < 4; ++j) {
        f32x4 g = (f32x4){1.f, 1.f, 1.f, 1.f}; if (mode == 1) g = ((const f32x4*)gain)[lane + 64 * j];
        v2u o; o.x = pk2(v[j].x * sc * g.x, v[j].y * sc * g.y); o.y = pk2(v[j].z * sc * g.z, v[j].w * sc * g.w); st_b64(d + 64 * j, o);
        const float r0 = __builtin_bit_cast(float, o.x << 16), r1 = __builtin_bit_cast(float, o.x & 0xffff0000u), r2 = __builtin_bit_cast(float, o.y << 16), r3 = __builtin_bit_cast(float, o.y & 0xffff0000u);
        q2 += (r0 * r0 + r1 * r1) + (r2 * r2 + r3 * r3); }
    if (mode == 0) { q2 = wave_sum(q2); if (lane < 16) ssq[lane] = lane == 0 ? q2 : 0.f; }
}
__device__ __forceinline__ void prologue(const P& p, LAS unsigned char* lds, int vcu, int G, int wave, int lane) {
    asm volatile("" : "+v"(lane));
    LAS float* scr = (LAS float*)(lds + LDS_STAGE + wave * 16384);
    const int gw = vcu * NWAVES + wave, NGW = G * NWAVES;
    for (int it = gw; it < NLAYER * IT_LAYER; it += NGW) prologue_item(p, it, scr, lane);
    for (int idx = gw * 64 + lane; idx < NLAYER * 2 * 32768; idx += NGW * 64) {
        const int l = idx / 65536, r = idx % 65536, which = r / 32768, e = r % 32768, row = e & 31, k = e >> 5;
        unsigned char* wl = ws_base(p.ws) + WS_W + (size_t)l * WS_WLAYER;
        if (which == 0) {
            float v = 0.f;
            if (row < 8) v = p.w_in[((size_t)l * DM + k) * INW + 1536 + row]; else if (row < 24) v = p.w_in[((size_t)l * DM + k) * INW + 3080 + (row - 8)];
            ((bf16*)(wl + WO_SM))[row * 1024 + k] = (bf16)f2bf(v * p.mix_norm[l * DM + k]);
        }
    }
    router_weights(p, gw * 64 + lane, NGW * 64);
    for (int m = gw; m < 4096; m += NGW) row_to_bf16(p.mem + (size_t)m * DM, WSP(bf16, WS_MEMN) + (size_t)m * DM, nullptr, p.mem_norm, lane, 1);
    { bf16* hbp = WSP(bf16, WS_HB); float* sqp = WSP(float, WS_SSQ);
      for (int m0 = gw * 4; m0 < NTOK; m0 += NGW * 4) {
        f32x4 v[4][4];
#pragma unroll
        for (int r = 0; r < 4; ++r)
#pragma unroll
            for (int j = 0; j < 4; ++j) v[r][j] = ((const f32x4*)(p.x + (size_t)(m0 + r) * DM))[lane + 64 * j];
#pragma unroll
        for (int r = 0; r < 4; ++r) { float q2 = 0.f; v2u* d = (v2u*)(hbp + (size_t)(m0 + r) * DM) + lane;
#pragma unroll
            for (int j = 0; j < 4; ++j) { v2u o; o.x = pk2(v[r][j].x, v[r][j].y); o.y = pk2(v[r][j].z, v[r][j].w); st_b64(d + 64 * j, o);
                const float r0 = __builtin_bit_cast(float, o.x << 16), r1 = __builtin_bit_cast(float, o.x & 0xffff0000u), r2 = __builtin_bit_cast(float, o.y << 16), r3 = __builtin_bit_cast(float, o.y & 0xffff0000u);
                q2 += (r0 * r0 + r1 * r1) + (r2 * r2 + r3 * r3); }
            q2 = wave_sum(q2); if (lane < 16) sqp[(size_t)(m0 + r) * 16 + lane] = lane == 0 ? q2 : 0.f; }
      } }
}
__device__ __forceinline__ void small_proj(const P& p, int l, LAS unsigned char* lds, int vcu, int G, int wave, int lane) {
    asm volatile("" : "+v"(lane));
    const bf16* wsm = (const bf16*)(ws_base(p.ws) + WS_W + (size_t)l * WS_WLAYER + WO_SM);
    const bf16* hb = WSP(bf16, WS_HB); const float* ssq = WSP(float, WS_SSQ); float* sm = WSP(float, WS_SM);
    constexpr int BST = 2048 + 16;
    { const int tid = wave * 64 + lane;
#pragma unroll
      for (int i = 0; i < 8; ++i) { const int idx = tid + NTHR * i, row = idx >> 7, c = idx & 127; *(LAS v4u*)(lds + row * BST + c * 16) = *(const v4u*)(wsm + row * 1024 + c * 8); } }
    __syncthreads();
    const int r = lane & 15, kq = lane >> 4;
    for (int blk = vcu * NWAVES + wave; blk < NTOK / 16; blk += G * NWAVES) {
        const int tok0 = blk * 16;
        const bf16x8* ap = (const bf16x8*)(hb + (size_t)(tok0 + r) * DM + kq * 32);
        pg8::f32x4 acc0 = {0.f, 0.f, 0.f, 0.f}, acc1 = {0.f, 0.f, 0.f, 0.f};
#pragma unroll
        for (int half = 0; half < 2; ++half) {
            bf16x8 af[16];
#pragma unroll
            for (int i = 0; i < 16; ++i) af[i] = ap[(half * 4 + (i >> 2)) * 16 + (i & 3)];
#pragma unroll
            for (int i = 0; i < 16; ++i) { const int s_ = half * 4 + (i >> 2), j = i & 3;
                const bf16x8 b0 = *(const LAS bf16x8*)(lds + r * BST + (128 * s_ + 32 * kq + 8 * j) * 2);
                const bf16x8 b1 = *(const LAS bf16x8*)(lds + (16 + r) * BST + (128 * s_ + 32 * kq + 8 * j) * 2);
                acc0 = __builtin_amdgcn_mfma_f32_16x16x32_bf16(af[i], b0, acc0, 0, 0, 0);
                acc1 = __builtin_amdgcn_mfma_f32_16x16x32_bf16(af[i], b1, acc1, 0, 0, 0);
                if ((i & 3) == 3) __builtin_amdgcn_sched_barrier(0); }
        }
        const float rsv = row_rs(ssq, tok0 + r);
#pragma unroll
        for (int g = 0; g < 4; ++g) { const int trow = 4 * kq + g; const float rs = __shfl(rsv, trow);
            sm[(size_t)(tok0 + trow) * 32 + r] = acc0[g] * rs; if (r < 8) sm[(size_t)(tok0 + trow) * 32 + 16 + r] = acc1[g] * rs; }
    }
    __syncthreads();
}
typedef short v4i16_t __attribute__((ext_vector_type(4)));
typedef __bf16 bf16x2_t __attribute__((ext_vector_type(2)));
typedef float f32x2_t __attribute__((ext_vector_type(2)));
__device__ __forceinline__ unsigned cvtpk(float lo, float hi) { f32x2_t v = {lo, hi}; bf16x2_t b = __builtin_convertvector(v, bf16x2_t); return __builtin_bit_cast(unsigned, b); }
__device__ __forceinline__ bf16x8 pack8(const f32x16& p, int o) {
    v4u w; w.x = cvtpk(p[o], p[o + 1]); w.y = cvtpk(p[o + 2], p[o + 3]); w.z = cvtpk(p[o + 4], p[o + 5]); w.w = cvtpk(p[o + 6], p[o + 7]);
    return __builtin_bit_cast(bf16x8, w);
}
__device__ __forceinline__ float max3f(float a, float b, float c) { float r; asm("v_max3_f32 %0, %1, %2, %3" : "=v"(r) : "v"(a), "v"(b), "v"(c)); return r; }
template <int D, bool FOX, bool OUT8 = false>
__device__ __forceinline__ void attn_unit(LAS unsigned char* lds, const bf16* Qg, int qpitch, const bf16* Kg, const bf16* Vg, int kvpitch, int NT,
                                          const float* cb, int q0, bf16* Og, int opitch, const float* gain, const float* kn) {
    constexpr int KS = D * 2 + 16, VS = D * 2 + 64;
    constexpr int KT = FOX ? 2 : 1, KEYS = 64 * KT;
    constexpr int KBYTES = KEYS * KS, VBYTES = KEYS * VS;
    constexpr int CPR = D / 8, NCH = KEYS * CPR / NTHR, NS = D / 16, NDB = D / 32;
    constexpr int OFF_K = 0, OFF_V = 2 * KBYTES, OFF_CB = 2 * KBYTES + 2 * VBYTES, OFF_FX = OFF_CB + 2 * KEYS * 4;
    int tid = threadIdx.x; asm volatile("" : "+v"(tid));
    const int lane = tid & 63, wave = __builtin_amdgcn_readfirstlane(tid >> 6), r32 = lane & 31, hh = lane >> 5;
    bf16x8 qf[NS];
    { const bf16* qrow = Qg + (size_t)(wave * 32 + r32) * qpitch;
#pragma unroll
      for (int s = 0; s < NS; ++s) qf[s] = *(const bf16x8*)(qrow + 16 * s + 8 * hh); }
    v4u kreg[NCH], vreg[NCH]; f32x4 cbreg = {0.f, 0.f, 0.f, 0.f};
#define AT_GLOAD(t) do { _Pragma("unroll") for (int i_ = 0; i_ < NCH; ++i_) { const int idx_ = tid + NTHR * i_, key_ = idx_ / CPR, c_ = idx_ % CPR; \
        kreg[i_] = *(const v4u*)(Kg + (size_t)((t) * KEYS + key_) * kvpitch + c_ * 8); vreg[i_] = *(const v4u*)(Vg + (size_t)((t) * KEYS + key_) * kvpitch + c_ * 8); } \
        if (FOX && tid < KEYS / 4) cbreg = *(const f32x4*)(cb + (t) * KEYS + tid * 4); } while (0)
#define AT_LSTORE(b) do { _Pragma("unroll") for (int i_ = 0; i_ < NCH; ++i_) { const int idx_ = tid + NTHR * i_, key_ = idx_ / CPR, c_ = idx_ % CPR; \
        *(LAS v4u*)(lds + OFF_K + (b) * KBYTES + key_ * KS + c_ * 16) = kreg[i_]; *(LAS v4u*)(lds + OFF_V + (b) * VBYTES + key_ * VS + c_ * 16) = vreg[i_]; } \
        if (FOX && tid < KEYS / 4) *(LAS f32x4*)(lds + OFF_CB + (b) * (KEYS * 4) + tid * 16) = cbreg; } while (0)
    float m = -INFINITY, l = 0.f;
    f32x16 osum = f32x16{};
    f32x16 o[NDB];
#pragma unroll
    for (int d = 0; d < NDB; ++d) o[d] = f32x16{};
    const int qlo = q0 + wave * 32, qabs = qlo + r32;
    float knpre = 0.f, qkmax = 0.f;
    LAS float* fx = (LAS float*)(lds + OFF_FX);
    __syncthreads();
    if (FOX) {
        float qn2 = 0.f;
#pragma unroll
        for (int s = 0; s < NS; ++s)
#pragma unroll
            for (int e = 0; e < 8; ++e) { const float v = __builtin_bit_cast(float, ((unsigned)(unsigned short)qf[s][e]) << 16); qn2 += v * v; }
        qn2 += __shfl_xor(qn2, 32);
        qn2 = wave_max(qn2);
        if (lane == 0) fx[wave] = qn2;
        knpre = lane < 32 ? kn[lane] : 0.f;
#pragma unroll
        for (int o_ = 1; o_ < 32; o_ <<= 1) { const float t_ = __shfl_up(knpre, o_); if (lane >= o_) knpre = fmaxf(knpre, t_); }
    }
    const int NTG = NT / KT;
    const int t_first = FOX ? NTG - 1 : 0;
    AT_GLOAD(t_first); AT_LSTORE(0);
    __syncthreads();
    if (FOX) { float q2 = fx[0];
#pragma unroll
        for (int w_ = 1; w_ < 8; ++w_) q2 = fmaxf(q2, fx[w_]);
        qkmax = sqrtf(q2); }
#pragma unroll 1
    for (int it = 0; it < NTG; ++it) {
        const int b = it & 1;
        const int tg = FOX ? NTG - 1 - it : it;
        const int tn = FOX ? tg - 1 : tg + 1;
        if (it + 1 < NTG) AT_GLOAD(tn);
#pragma unroll
        for (int sub_ = 0; sub_ < KT; ++sub_) {
        const int sub = FOX ? KT - 1 - sub_ : sub_, koff = sub * 64;
        const int kt0 = (tg * KT + sub) * 64;
        if (!FOX || kt0 <= qlo + 31) {
            f32x16 p[2];
#pragma unroll
            for (int kb = 0; kb < 2; ++kb) {
                if (FOX) {
#pragma unroll
                    for (int g = 0; g < 4; ++g) { const f32x4 c4 = *(const LAS f32x4*)(lds + OFF_CB + b * (KEYS * 4) + (koff + kb * 32 + 8 * g + 4 * hh) * 4); p[kb][4 * g] = c4.x; p[kb][4 * g + 1] = c4.y; p[kb][4 * g + 2] = c4.z; p[kb][4 * g + 3] = c4.w; }
                } else p[kb] = f32x16{};
                const LAS unsigned char* kp = lds + OFF_K + b * KBYTES + (koff + kb * 32 + r32) * KS + hh * 16;
#pragma unroll
                for (int s = 0; s < NS; ++s) { const bf16x8 kf = *(const LAS bf16x8*)(kp + s * 32); p[kb] = __builtin_amdgcn_mfma_f32_32x32x16_bf16(kf, qf[s], p[kb], 0, 0, 0); }
            }
            if (FOX && kt0 + 63 > qlo) {
#pragma unroll
                for (int kb = 0; kb < 2; ++kb)
#pragma unroll
                    for (int r = 0; r < 16; ++r) { const int key = kt0 + kb * 32 + (r & 3) + 8 * (r >> 2) + 4 * hh; if (key > qabs) p[kb][r] = -INFINITY; }
            }
            float mt = fmaxf(p[1][0], p[0][0]);
#pragma unroll
            for (int r = 1; r < 16; ++r) mt = max3f(mt, p[0][r], p[1][r]);
            mt = fmaxf(mt, __shfl_xor(mt, 32));
            const float mnew = fmaxf(m, mt);
            float ls = 0.f;
#pragma unroll
            for (int kb = 0; kb < 2; ++kb)
#pragma unroll
                for (int r = 0; r < 16; ++r) { const float e = __builtin_amdgcn_exp2f(p[kb][r] - mnew); p[kb][r] = e; if (!FOX) ls += e; }
            if (!FOX || __builtin_amdgcn_ballot_w64(mnew > m) != 0ull) {
                const float alpha = __builtin_amdgcn_exp2f(m - mnew);
                l *= alpha; if (FOX) osum[0] *= alpha;
#pragma unroll
                for (int d = 0; d < NDB; ++d)
#pragma unroll
                    for (int r = 0; r < 16; ++r) o[d][r] *= alpha;
            }
            m = mnew; l += ls;
            bf16x8 pa[2][2];
#pragma unroll
            for (int kb = 0; kb < 2; ++kb) { pa[kb][0] = pack8(p[kb], 0); pa[kb][1] = pack8(p[kb], 8); }
            const LAS unsigned char* vp = lds + OFF_V + b * VBYTES + (koff + 4 * hh + ((lane & 15) >> 2)) * VS + (16 * ((lane >> 4) & 1) + 4 * (lane & 3)) * 2;
#pragma unroll
            for (int d = 0; d < NDB; ++d) {
#pragma unroll
                for (int kb = 0; kb < 2; ++kb)
#pragma unroll
                    for (int ks = 0; ks < 2; ++ks) {
                        const LAS unsigned char* a0 = vp + (kb * 32 + 16 * ks) * VS + d * 64;
                        const v4i16_t lo = __builtin_amdgcn_ds_read_tr16_b64_v4i16((LAS v4i16_t*)a0);
                        const v4i16_t hi = __builtin_amdgcn_ds_read_tr16_b64_v4i16((LAS v4i16_t*)(a0 + 8 * VS));
                        const bf16x8 vf = (bf16x8){lo[0], lo[1], lo[2], lo[3], hi[0], hi[1], hi[2], hi[3]};
                        o[d] = __builtin_amdgcn_mfma_f32_32x32x16_bf16(vf, pa[kb][ks], o[d], 0, 0, 0);
                    }
            }
            if (FOX) {
                const bf16x8 ones = __builtin_bit_cast(bf16x8, (v4u){0x3F803F80u, 0x3F803F80u, 0x3F803F80u, 0x3F803F80u});
#pragma unroll
                for (int kb = 0; kb < 2; ++kb)
#pragma unroll
                    for (int ks = 0; ks < 2; ++ks) osum = __builtin_amdgcn_mfma_f32_32x32x16_bf16(ones, pa[kb][ks], osum, 0, 0, 0);
            }
        }
        }
        if (FOX) { const float mm = wave_min(m); if (lane == 0) fx[8 + b * 8 + wave] = mm; }
        if (it + 1 < NTG) AT_LSTORE(b ^ 1);
        __syncthreads();
        if (FOX && tg > 0) {
            float M0 = fx[8 + b * 8];
#pragma unroll
            for (int w_ = 1; w_ < 8; ++w_) M0 = fminf(M0, fx[8 + b * 8 + w_]);
            const float cbl = *(const LAS float*)(lds + OFF_CB + (b ^ 1) * (KEYS * 4) + (KEYS - 1) * 4);
            const float knb = __builtin_bit_cast(float, __builtin_amdgcn_readlane(__builtin_bit_cast(int, knpre), tg * KT - 1));
            if (qkmax * knb + cbl < M0 - 40.f) break;
        }
    }
#undef AT_GLOAD
#undef AT_LSTORE
    if (FOX) l = osum[0]; else l += __shfl_xor(l, 32);
    const float inv = 1.0f / l;
    float rs = inv;
    if (FOX) {
        float ss = 0.f;
#pragma unroll
        for (int d = 0; d < NDB; ++d)
#pragma unroll
            for (int r = 0; r < 16; ++r) { const float v = o[d][r] * inv; ss += v * v; }
        ss += __shfl_xor(ss, 32);
        rs = inv * rsqrtf(ss * (1.0f / D) + EPS);
    }
    constexpr int SROW = 144;
    LAS unsigned char* stg = lds + OFF_K + wave * (32 * SROW);
#pragma unroll
    for (int d = 0; d < NDB; ++d)
#pragma unroll
        for (int g = 0; g < 4; ++g) {
            if (OUT8) { *(LAS unsigned*)(stg + r32 * SROW + 32 * d + 8 * g + 4 * hh) = pk4_fp8(o[d][4 * g] * rs, o[d][4 * g + 1] * rs, o[d][4 * g + 2] * rs, o[d][4 * g + 3] * rs); }
            else { f32x4 gn = {1.f, 1.f, 1.f, 1.f}; if (FOX) gn = *(const f32x4*)(gain + 32 * d + 8 * g + 4 * hh);
                v2u w; w.x = cvtpk(o[d][4 * g] * rs * gn.x, o[d][4 * g + 1] * rs * gn.y); w.y = cvtpk(o[d][4 * g + 2] * rs * gn.z, o[d][4 * g + 3] * rs * gn.w);
                *(LAS v2u*)(stg + r32 * SROW + (32 * d + 8 * g + 4 * hh) * 2) = w; }
        }
    static_assert((OUT8 ? D : D * 2) == 128, "stage rows are 128 bytes");
    { unsigned char* ob = (unsigned char*)Og; const size_t pitchb = (size_t)opitch * (OUT8 ? 1 : 2);
#pragma unroll
      for (int i = 0; i < 4; ++i) { const int row = i * 8 + (lane >> 3), ch = lane & 7;
          const v4u w = *(const LAS v4u*)(stg + row * SROW + ch * 16);
          st_b128(ob + (size_t)(wave * 32 + row) * pitchb + ch * 16, w); } }
}
__device__ __forceinline__ void fox_phase(const P& p, int l, LAS unsigned char* lds, int vcu, int G) {
    const bf16* proj = WSP(bf16, WS_PROJ); const float* cb = WSP(float, WS_CB); bf16* y = WSP(bf16, WS_Y);
    for (int pu = vcu; pu < 512; pu += G) {
        const int bh = pu >> 2, pr = pu < 256 ? (pu & 3) : 3 - (pu & 3), b = bh >> 3, h = bh & 7;
        for (int half = 0; half < 2; ++half) {
            const int qb = half ? pr : 7 - pr;
            const size_t row0 = (size_t)b * SEQ;
            attn_unit<64, true>(lds, proj + (row0 + qb * 256) * PW + C_FQ + h * 64, PW, proj + row0 * PW + C_FK + h * 64, proj + row0 * PW + C_FV + h * 64, PW, 4 * (qb + 1),
                                cb + ((size_t)b * 8 + h) * SEQ, qb * 256, y + (row0 + qb * 256) * DM + h * 64, DM, p.fox_gain + l * 512 + h * 64, WSP(const float, WS_MOE + MO_KN) + (b * 8 + h) * 32);
        }
    }
}
__device__ __forceinline__ void xattn_phase(const P& p, int l, LAS unsigned char* lds, int vcu, int G, bool dummy) {
    bf16* xq = WSP(bf16, WS_XQ); const bf16* xkv = WSP(bf16, WS_XKV);
    for (int u = vcu; u < 512; u += G) {
        const int b = u >> 5, h = (u >> 3) & 3, qb = u & 7;
        bf16* qp = xq + ((size_t)b * SEQ + qb * 256) * 512 + h * 128;
        const bf16* kp = xkv + (size_t)b * MEML * 2048 + l * 1024 + h * 128;
        attn_unit<128, false, true>(lds, qp, 512, kp, kp + 512, 2048, 4, nullptr, 0, (bf16*)((dummy ? WSP(unsigned char, WS_Y) : WSP(unsigned char, WS_XO8)) + ((size_t)b * SEQ + qb * 256) * 512 + h * 128), 512, nullptr, nullptr);
    }
}

__device__ __forceinline__ void xattn_pair(const P& p, int l, LAS unsigned char* lds, int pm, int pn, bool dummy) {
    const bf16* xq = WSP(bf16, WS_XQ); const bf16* xkv = WSP(bf16, WS_XKV);
    const int b = pm >> 3;
    for (int hh2 = 0; hh2 < 2; ++hh2) {
        const int h = 2 * pn + hh2;
        const bf16* qp = xq + (size_t)pm * 256 * 512 + h * 128;
        const bf16* kp = xkv + (size_t)b * MEML * 2048 + l * 1024 + h * 128;
        attn_unit<128, false, true>(lds, qp, 512, kp, kp + 512, 2048, 4, nullptr, 0, (bf16*)((dummy ? WSP(unsigned char, WS_Y) : WSP(unsigned char, WS_XO8)) + (size_t)pm * 256 * 512 + h * 128), 512, nullptr, nullptr);
    }
}
constexpr size_t WS_GB = WS_END;
constexpr size_t WS_GDEC = WS_GB + 32 * MiB;
constexpr size_t WS_END2 = WS_GDEC + 1 * MiB;
static_assert(WS_END2 <= 512 * MiB, "workspace map 2");
constexpr int GL_B = 0;
constexpr int GL_TOT = 16384;
constexpr int GL_Q1 = 18432, GL_Q2 = GL_Q1 + 64 * 144, GL_K2 = GL_Q2 + 64 * 144;
constexpr int GL_KD = GL_K2 + 64 * 144;
constexpr int GL_V = GL_KD + 64 * 192;
constexpr int GL_SSQ = GL_V + 64 * 320;
constexpr int GL_GA = GL_SSQ + 1024;
constexpr int GL_YST = GL_GA + 4096;
constexpr int GL_GG = GL_YST + 64 * 272;
constexpr int GL_END = GL_GG + 64 * 272;
static_assert(GL_END <= 131072, "gla lds");

__device__ __forceinline__ float fast_log_sigmoid(float z) { return fminf(z, 0.f) - __logf(1.f + __expf(-fabsf(z))); }
__device__ __forceinline__ void gla_decay(const P& p, int l, int h, size_t tok0, LAS unsigned char* lds, int lane, int wave) {
    const float* sm = WSP(float, WS_SM);
    float w[16];
#pragma unroll
    for (int r = 0; r < 16; ++r) w[r] = p.w_alpha_up[((size_t)l * 16 + r) * 256 + h * 64 + lane];
    const float bias = p.b_alpha[l * 256 + h * 64 + lane];
    LAS f32x4* gat = (LAS f32x4*)(lds + GL_GA + wave * 512);
    if (lane < 32) gat[lane] = *(const f32x4*)(sm + (tok0 + wave * 8 + (lane >> 2)) * 32 + 8 + 4 * (lane & 3));
    float bl[8]; float run = 0.f;
#pragma unroll
    for (int j = 0; j < 8; ++j) {
        float z = bias;
#pragma unroll
        for (int r4 = 0; r4 < 4; ++r4) { const f32x4 g4 = gat[j * 4 + r4]; z += g4.x * w[4 * r4] + g4.y * w[4 * r4 + 1] + g4.z * w[4 * r4 + 2] + g4.w * w[4 * r4 + 3]; }
        run += fast_log_sigmoid(z) * (1.0f / 16.0f); bl[j] = run;
    }
    LAS float* tot = (LAS float*)(lds + GL_TOT);
    tot[wave * 64 + lane] = run;
    __syncthreads();
    float pre = 0.f;
#pragma unroll
    for (int g = 0; g < 8; ++g) { const float t = tot[g * 64 + lane]; if (g < wave) pre += t; }
    LAS float* Bm = (LAS float*)(lds + GL_B);
#pragma unroll
    for (int j = 0; j < 8; ++j) Bm[(wave * 8 + j) * 64 + lane] = bl[j] + pre;
    __syncthreads();
}
__device__ __forceinline__ void gla_load_v(const bf16* proj, size_t tok0, int h, LAS unsigned char* lds, int tid) {
#pragma unroll
    for (int i = 0; i < 2; ++i) { const int idx = tid + NTHR * i, t = idx >> 4, c = idx & 15;
        *(LAS v4u*)(lds + GL_V + t * 320 + c * 16) = *(const v4u*)(proj + (tok0 + t) * PW + C_GV + h * 128 + c * 8); }
}
__device__ __forceinline__ bf16x8 tr_frag(const LAS unsigned char* a0, int rowstride4) {
    const v4i16_t lo = __builtin_amdgcn_ds_read_tr16_b64_v4i16((LAS v4i16_t*)a0);
    const v4i16_t hi = __builtin_amdgcn_ds_read_tr16_b64_v4i16((LAS v4i16_t*)(a0 + rowstride4));
    return (bf16x8){lo[0], lo[1], lo[2], lo[3], hi[0], hi[1], hi[2], hi[3]};
}
__device__ __forceinline__ void gla_phase_a(const P& p, int l, LAS unsigned char* lds, int vcu, int G) {
    int tid = threadIdx.x; asm volatile("" : "+v"(tid));
    const int lane = tid & 63, wave = __builtin_amdgcn_readfirstlane(tid >> 6), hh = lane >> 5;
    const bf16* proj = WSP(bf16, WS_PROJ); float* loc = ((float*)p.out); float* dec = WSP(float, WS_GDEC); const float* sm = WSP(float, WS_SM); float* gb = WSP(float, WS_GB);
    LAS unsigned char* kd = lds + wave * 16384; LAS unsigned char* vh = kd + 8192;
    const int crow8 = lane >> 3, cch = lane & 7;
    const int trow = (lane & 15) >> 2, tcol = 16 * ((lane >> 4) & 1) + 4 * (lane & 3);
    for (int u = vcu * NWAVES + wave; u < 2048; u += G * NWAVES) {
        const int c = u & 31, h = (u >> 5) & 3, b = u >> 7;
        const size_t tok0 = (size_t)b * SEQ + c * 64;
        v4u kreg[8], v0reg[8], v1reg[8];
#pragma unroll
        for (int i = 0; i < 8; ++i) { const bf16* rp = proj + (tok0 + i * 8 + crow8) * PW;
            kreg[i] = *(const v4u*)(rp + C_GK + h * 64 + cch * 8); v0reg[i] = *(const v4u*)(rp + C_GV + h * 128 + cch * 8); v1reg[i] = *(const v4u*)(rp + C_GV + h * 128 + 64 + cch * 8); }
        float w[16];
#pragma unroll
        for (int r = 0; r < 16; ++r) w[r] = p.w_alpha_up[((size_t)l * 16 + r) * 256 + h * 64 + lane];
        const float bias = p.b_alpha[l * 256 + h * 64 + lane];
        { LAS f32x4* gw = (LAS f32x4*)vh;
#pragma unroll
          for (int i = 0; i < 4; ++i) gw[lane * 4 + i] = *(const f32x4*)(sm + (tok0 + lane) * 32 + 8 + 4 * i); }
        float bt[64]; float run = 0.f;
#pragma unroll
        for (int t = 0; t < 64; ++t) {
            float z = bias;
#pragma unroll
            for (int r4 = 0; r4 < 4; ++r4) { const f32x4 g4 = ((const LAS f32x4*)vh)[t * 4 + r4]; z += g4.x * w[4 * r4] + g4.y * w[4 * r4 + 1] + g4.z * w[4 * r4 + 2] + g4.w * w[4 * r4 + 3]; }
            run += fast_log_sigmoid(z) * (1.0f / 16.0f); bt[t] = run; gb[(tok0 + t) * 256 + h * 64 + lane] = run;
        }
#pragma unroll
        for (int i = 0; i < 8; ++i) { *(LAS v4u*)(kd + (i * 8 + crow8) * 128 + cch * 16) = kreg[i]; *(LAS v4u*)(vh + (i * 8 + crow8) * 128 + cch * 16) = v0reg[i]; }
#pragma unroll
        for (int t = 0; t < 64; ++t) { LAS bf16* kp = (LAS bf16*)(kd + t * 128 + lane * 2); *kp = (bf16)f2bf(bf2f(*kp) * __expf(run - bt[t])); }
        dec[(size_t)u * 64 + lane] = __expf(run);
#pragma unroll
        for (int half = 0; half < 2; ++half) {
            if (half == 1) {
#pragma unroll
                for (int i = 0; i < 8; ++i) *(LAS v4u*)(vh + (i * 8 + crow8) * 128 + cch * 16) = v1reg[i];
            }
            f32x16 acc[2][2];
#pragma unroll
            for (int x = 0; x < 2; ++x)
#pragma unroll
                for (int y = 0; y < 2; ++y) acc[x][y] = f32x16{};
#pragma unroll
            for (int s = 0; s < 4; ++s) {
                bf16x8 af[2], bfr[2];
#pragma unroll
                for (int x = 0; x < 2; ++x) { af[x] = tr_frag(vh + (16 * s + 8 * hh + trow) * 128 + (32 * x + tcol) * 2, 4 * 128); bfr[x] = tr_frag(kd + (16 * s + 8 * hh + trow) * 128 + (32 * x + tcol) * 2, 4 * 128); }
#pragma unroll
                for (int x = 0; x < 2; ++x)
#pragma unroll
                    for (int y = 0; y < 2; ++y) acc[x][y] = __builtin_amdgcn_mfma_f32_32x32x16_bf16(af[x], bfr[y], acc[x][y], 0, 0, 0);
            }
#pragma unroll
            for (int x = 0; x < 2; ++x)
#pragma unroll
                for (int y = 0; y < 2; ++y) { float* lo = loc + (size_t)u * 8192 + 32 * y + (lane & 31);
#pragma unroll
                    for (int r = 0; r < 16; ++r) lo[(size_t)(64 * half + 32 * x + (r & 3) + 8 * (r >> 2) + 4 * hh) * 64] = acc[x][y][r]; }
        }
    }
}
__device__ __forceinline__ void gla_phase_b(const P& p, int vcu, int G) {
    int tid = threadIdx.x; asm volatile("" : "+v"(tid));
    const float* loc = ((const float*)p.out); const float* dec = WSP(float, WS_GDEC); bf16* gs = (bf16*)((unsigned char*)p.out + 96 * MiB);
    for (int u = vcu; u < 256; u += G) {
        const int bh = u >> 2, q4 = u & 3;
        const int e = q4 * 2048 + tid * 4, dk = e & 63;
        f32x4 st = {0.f, 0.f, 0.f, 0.f};
#pragma unroll 8
        for (int c = 0; c < 32; ++c) {
            const size_t cu = (size_t)bh * 32 + c;
            const f32x4 lv = *(const f32x4*)(loc + cu * 8192 + e);
            const f32x4 dv = *(const f32x4*)(dec + cu * 64 + dk);
            v2u w; w.x = pk2(st.x, st.y); w.y = pk2(st.z, st.w);
            *(v2u*)(gs + cu * 8192 + e) = w;
            st = dv * st + lv;
        }
    }
}
__device__ __forceinline__ void gla_phase_c(const P& p, int l, LAS unsigned char* lds, int vcu, int G) {
    int tid = threadIdx.x; asm volatile("" : "+v"(tid));
    const int lane = tid & 63, wave = __builtin_amdgcn_readfirstlane(tid >> 6), hh = lane >> 5, r32 = lane & 31;
    const bf16* proj = WSP(bf16, WS_PROJ); const bf16* gs = (const bf16*)((const unsigned char*)p.out + 96 * MiB); bf16* y = WSP(bf16, WS_Y); const float* gb = WSP(const float, WS_GB);
    const int dvb = wave >> 1, tb = wave & 1;
    const int trow = (lane & 15) >> 2, tcol = 16 * ((lane >> 4) & 1) + 4 * (lane & 3);
    bf16 n_q[8], n_k[8]; v4u n_v[2], n_g[2]; bf16x8 n_s[4]; f32x4 n_n[4]; float n_b[8], n_r = 0.f;
#define GC_LOAD(uu) do { const int c_ = (uu) & 31, h_ = ((uu) >> 5) & 3, b_ = (uu) >> 7; const size_t t0_ = (size_t)b_ * SEQ + c_ * 64; \
        _Pragma("unroll") for (int j = 0; j < 8; ++j) { const bf16* rp = proj + (t0_ + wave * 8 + j) * PW + h_ * 64 + lane; n_q[j] = rp[C_GQ]; n_k[j] = rp[C_GK]; } \
        _Pragma("unroll") for (int i = 0; i < 2; ++i) { const int idx = tid + NTHR * i, t = idx >> 4, cc = idx & 15; n_v[i] = *(const v4u*)(proj + (t0_ + t) * PW + C_GV + h_ * 128 + cc * 8); n_g[i] = *(const v4u*)(proj + (t0_ + t) * PW + C_GG + h_ * 128 + cc * 8); } \
        { const bf16* sp = gs + (size_t)(uu) * 8192 + (size_t)(32 * dvb + r32) * 64 + 8 * hh; \
          _Pragma("unroll") for (int s2 = 0; s2 < 4; ++s2) n_s[s2] = *(const bf16x8*)(sp + 16 * s2); } \
        _Pragma("unroll") for (int j = 0; j < 8; ++j) n_b[j] = gb[(t0_ + wave * 8 + j) * 256 + h_ * 64 + lane]; \
        n_r = gb[(t0_ + 31) * 256 + h_ * 64 + lane]; \
        _Pragma("unroll") for (int g = 0; g < 4; ++g) { const int dv = 32 * dvb + 8 * g + 4 * hh; \
            n_n[g] = *(const f32x4*)(p.gla_gain + l * 512 + h_ * 128 + dv); } } while (0)
    if (vcu < 2048) GC_LOAD(vcu);
    for (int u = vcu; u < 2048; u += G) {
        const int c = u & 31, h = (u >> 5) & 3, b = u >> 7;
        const size_t tok0 = (size_t)b * SEQ + c * 64;
        bf16x8 sfr[4]; f32x4 gnr[4];
#pragma unroll
        for (int i = 0; i < 4; ++i) { sfr[i] = n_s[i]; gnr[i] = n_n[i]; }
#pragma unroll
        for (int i = 0; i < 2; ++i) { const int idx = tid + NTHR * i, t = idx >> 4, cc = idx & 15; *(LAS v4u*)(lds + GL_V + t * 320 + cc * 16) = n_v[i]; *(LAS v4u*)(lds + GL_GG + t * 272 + cc * 16) = n_g[i]; }
        { const float rref = n_r;
#pragma unroll
          for (int j = 0; j < 8; ++j) { const int t = wave * 8 + j; const float bt = n_b[j];
            const float qv = bf2f(n_q[j]), kv = bf2f(n_k[j]);
            *(LAS bf16*)(lds + GL_Q1 + t * 144 + lane * 2) = (bf16)f2bf(qv * __expf(bt));
            *(LAS bf16*)(lds + GL_Q2 + t * 144 + lane * 2) = (bf16)f2bf(qv * __expf(bt - rref));
            *(LAS bf16*)(lds + GL_K2 + t * 144 + lane * 2) = (bf16)f2bf(kv * __expf(rref - bt)); } }
        __syncthreads();
        if (u + G < 2048) GC_LOAD(u + G);
        f32x16 o = {};
        {
#pragma unroll
          for (int s = 0; s < 4; ++s) { const bf16x8 af = sfr[s]; const bf16x8 bq = *(const LAS bf16x8*)(lds + GL_Q1 + (32 * tb + r32) * 144 + (16 * s + 8 * hh) * 2);
              o = __builtin_amdgcn_mfma_f32_32x32x16_bf16(af, bq, o, 0, 0, 0); } }
#pragma unroll
        for (int sb = 0; sb < 2; ++sb) {
            if (sb <= tb) {
                f32x16 pt = {};
#pragma unroll
                for (int s = 0; s < 4; ++s) { const bf16x8 ak = *(const LAS bf16x8*)(lds + GL_K2 + (32 * sb + r32) * 144 + (16 * s + 8 * hh) * 2); const bf16x8 bq = *(const LAS bf16x8*)(lds + GL_Q2 + (32 * tb + r32) * 144 + (16 * s + 8 * hh) * 2);
                    pt = __builtin_amdgcn_mfma_f32_32x32x16_bf16(ak, bq, pt, 0, 0, 0); }
                if (sb == tb) {
#pragma unroll
                    for (int r = 0; r < 16; ++r) { const int s_ = (r & 3) + 8 * (r >> 2) + 4 * hh; if (s_ > r32) pt[r] = 0.f; }
                }
#pragma unroll
                for (int ks = 0; ks < 2; ++ks) {
                    const bf16x8 pa = pack8(pt, 8 * ks);
                    const bf16x8 vf = tr_frag(lds + GL_V + (32 * sb + 16 * ks + 4 * hh + trow) * 320 + (32 * dvb + tcol) * 2, 8 * 320);
                    o = __builtin_amdgcn_mfma_f32_32x32x16_bf16(vf, pa, o, 0, 0, 0);
                }
            }
        }
        float ss = 0.f;
#pragma unroll
        for (int r = 0; r < 16; ++r) ss += o[r] * o[r];
        ss += __shfl_xor(ss, 32);
        LAS float* sq = (LAS float*)(lds + GL_SSQ);
        if (hh == 0) sq[dvb * 64 + 32 * tb + r32] = ss;
        __syncthreads();
        const int t = 32 * tb + r32;
        const float tot = (sq[t] + sq[64 + t]) + (sq[128 + t] + sq[192 + t]);
        const float rs = rsqrtf(tot * (1.0f / 128.0f) + EPS);
#pragma unroll
        for (int g = 0; g < 4; ++g) {
            const int dv = 32 * dvb + 8 * g + 4 * hh;
            const f32x4 gn = gnr[g];
            const v2u gg = *(const LAS v2u*)(lds + GL_GG + t * 272 + dv * 2);
            const float g0 = bf2f((bf16)(gg.x & 0xffff)), g1 = bf2f((bf16)(gg.x >> 16)), g2 = bf2f((bf16)(gg.y & 0xffff)), g3 = bf2f((bf16)(gg.y >> 16));
            const float v0 = o[4 * g] * rs * gn.x * g0 * __builtin_amdgcn_rcpf(1.f + __expf(-g0)), v1 = o[4 * g + 1] * rs * gn.y * g1 * __builtin_amdgcn_rcpf(1.f + __expf(-g1));
            const float v2 = o[4 * g + 2] * rs * gn.z * g2 * __builtin_amdgcn_rcpf(1.f + __expf(-g2)), v3 = o[4 * g + 3] * rs * gn.w * g3 * __builtin_amdgcn_rcpf(1.f + __expf(-g3));
            v2u w; w.x = cvtpk(v0, v1); w.y = cvtpk(v2, v3);
            *(LAS v2u*)(lds + GL_YST + t * 272 + dv * 2) = w;
        }
        __syncthreads();
#pragma unroll
        for (int i = 0; i < 2; ++i) { const int idx = tid + NTHR * i, tr_ = idx >> 4, ch = idx & 15;
            st_b128(y + (tok0 + tr_) * DM + 512 + h * 128 + ch * 8, *(const LAS v4u*)(lds + GL_YST + tr_ * 272 + ch * 16)); }
    }
#undef GC_LOAD
}
__device__ __forceinline__ void fox_cumsum_phase(const P& p, int l, LAS unsigned char* lds, int vcu, int G) {
    int tid = threadIdx.x; asm volatile("" : "+v"(tid));
    const int lane = tid & 63, wave = __builtin_amdgcn_readfirstlane(tid >> 6);
    const float* sm = WSP(float, WS_SM); float* cb = WSP(float, WS_CB);
    LAS float* tot = (LAS float*)(lds + 256);
    for (int u = vcu; u < NBATCH * 8; u += G) {
        const int b = u >> 3, h = u & 7;
        const float bias = p.b_forget[l * 8 + h];
        const int s0 = wave * 256 + lane * 4;
        float v[4]; float run = 0.f;
#pragma unroll
        for (int j = 0; j < 4; ++j) v[j] = sm[((size_t)b * SEQ + s0 + j) * 32 + h];
#pragma unroll
        for (int j = 0; j < 4; ++j) { run += fast_log_sigmoid(v[j] + bias); v[j] = run; }
        float pre = run;
#pragma unroll
        for (int o = 1; o < 64; o <<= 1) { const float t = __shfl_up(pre, o); if (lane >= o) pre += t; }
        __syncthreads();
        if (lane == 63) tot[wave] = pre;
        __syncthreads();
        float base = pre - run;
#pragma unroll
        for (int w_ = 0; w_ < 8; ++w_) { const float t = tot[w_]; if (w_ < wave) base += t; }
        f32x4 o4; o4.x = -(v[0] + base) * LOG2E; o4.y = -(v[1] + base) * LOG2E; o4.z = -(v[2] + base) * LOG2E; o4.w = -(v[3] + base) * LOG2E;
        *(f32x4*)(cb + ((size_t)b * 8 + h) * SEQ + s0) = o4;
    }
}
__device__ __forceinline__ void fox_knorm_phase(const P& p, int vcu, int G) {
    int tid = threadIdx.x; asm volatile("" : "+v"(tid));
    const int lane = tid & 63, wave = __builtin_amdgcn_readfirstlane(tid >> 6);
    const bf16* proj = WSP(bf16, WS_PROJ); float* kn = WSP(float, WS_MOE + MO_KN);
    for (int task = vcu * NWAVES + wave; task < NBATCH * 8 * 32; task += G * NWAVES) {
        const int j = task & 31, h = (task >> 5) & 7, b = task >> 8;
        float mx = 0.f;
#pragma unroll
        for (int i = 0; i < 8; ++i) {
            const v4u w = *(const v4u*)(proj + ((size_t)b * SEQ + j * 64 + i * 8 + (lane >> 3)) * PW + C_FK + h * 64 + (lane & 7) * 8);
            const unsigned ww[4] = {w.x, w.y, w.z, w.w}; float ss = 0.f;
#pragma unroll
            for (int e = 0; e < 4; ++e) { const float a = __builtin_bit_cast(float, ww[e] << 16), c = __builtin_bit_cast(float, ww[e] & 0xffff0000u); ss += a * a + c * c; }
            ss += __shfl_xor(ss, 1); ss += __shfl_xor(ss, 2); ss += __shfl_xor(ss, 4);
            mx = fmaxf(mx, ss);
        }
        mx = wave_max(mx);
        if (lane == 0) kn[task] = sqrtf(mx) * 1.0001f;
    }
}
__device__ __forceinline__ void router_weights(const P& p, int gtid, int gstride) {
    for (int idx = gtid; idx < NLAYER * 32768; idx += gstride) {
        const int l = idx >> 15, r = idx & 32767, k = r >> 5, n = r & 31;
        float v = 0.f;
        if (n < 16) v = p.w_re[((size_t)l * DM + k) * 16 + n]; else if (n < 20) v = p.w_rg[((size_t)l * DM + k) * 4 + (n - 16)];
        v *= p.moe_norm[l * DM + k];
        float* wr = (float*)(ws_base(p.ws) + WS_W + (size_t)l * WS_WLAYER + WO_RHI);
        wr[((((k >> 5) * 4 + ((k >> 3) & 3)) * 2 + ((k >> 2) & 1)) * 32 + n) * 4 + (k & 3)] = v;
    }
}
__device__ __forceinline__ void route_phase(const P& p, int l, LAS unsigned char* lds, int vcu, int G) {
    int tid = threadIdx.x; asm volatile("" : "+v"(tid));
    const int lane = tid & 63, wave = __builtin_amdgcn_readfirstlane(tid >> 6);
    { const v4u* src = (const v4u*)(ws_base(p.ws) + WS_W + (size_t)l * WS_WLAYER + WO_RHI);
#pragma unroll 4
      for (int i = 0; i < 16; ++i) *(LAS v4u*)(lds + LDS_STAGE + (tid + NTHR * i) * 16) = src[tid + NTHR * i]; }
    LAS int* hist = (LAS int*)(lds + LDS_GATE);
    if (tid < 32) hist[tid] = 0;
    __syncthreads();
    const bf16* HBp = WSP(const bf16, WS_HB);
    int2* toke = WSP(int2, WS_MOE + MO_TOKE); float2* tokg = WSP(float2, WS_MOE + MO_TOKG);
    LAS float* lgb = (LAS float*)(lds + LDS_RS + wave * 2048);
    const int r = lane & 15, kq = lane >> 4;
    for (int task = vcu * NWAVES + wave; task < NTOK / 16; task += G * NWAVES) {
        const int tok0 = task * 16;
        const v4u* hp = (const v4u*)(HBp + (size_t)(tok0 + r) * DM + 8 * kq);
        f32x4 acc0 = {0.f, 0.f, 0.f, 0.f}, acc1 = {0.f, 0.f, 0.f, 0.f}; float q = 0.f;
#pragma unroll 8
        for (int s = 0; s < 32; ++s) {
            const v4u aw = hp[4 * s];
            const unsigned ww[4] = {aw.x, aw.y, aw.z, aw.w};
            const LAS unsigned char* bp = lds + LDS_STAGE + ((s * 4 + kq) * 2 * 32 + r) * 16;
            const f32x4 b00 = *(const LAS f32x4*)(bp), b01 = *(const LAS f32x4*)(bp + 32 * 16), b10 = *(const LAS f32x4*)(bp + 16 * 16), b11 = *(const LAS f32x4*)(bp + 48 * 16);
#pragma unroll
            for (int e = 0; e < 4; ++e) {
                const float a0 = __builtin_bit_cast(float, ww[e] << 16), a1 = __builtin_bit_cast(float, ww[e] & 0xffff0000u);
                q += a0 * a0 + a1 * a1;
                const f32x4& bl = e < 2 ? b00 : b01; const f32x4& bh = e < 2 ? b10 : b11;
                acc0 = __builtin_amdgcn_mfma_f32_16x16x4f32(a0, bl[(2 * e) & 3], acc0, 0, 0, 0); acc1 = __builtin_amdgcn_mfma_f32_16x16x4f32(a0, bh[(2 * e) & 3], acc1, 0, 0, 0);
                acc0 = __builtin_amdgcn_mfma_f32_16x16x4f32(a1, bl[(2 * e + 1) & 3], acc0, 0, 0, 0); acc1 = __builtin_amdgcn_mfma_f32_16x16x4f32(a1, bh[(2 * e + 1) & 3], acc1, 0, 0, 0);
            }
        }
        q += __shfl_xor(q, 16); q += __shfl_xor(q, 32);
        const float rsv = rsqrtf(q * (1.0f / DM) + EPS);
        const float bias0 = p.b_re[l * 16 + r], bias1 = r < 4 ? p.b_rg[l * 4 + r] : 0.f;
#pragma unroll
        for (int g = 0; g < 4; ++g) { const int row = 4 * kq + g; const float rs = __shfl(rsv, row);
            lgb[row * 32 + r] = acc0[g] * rs + bias0; lgb[row * 32 + 16 + r] = acc1[g] * rs + bias1; }
        LDS_WAIT();
        if (lane < 16) {
            const int tok = tok0 + lane;
            const LAS f32x4* lr = (const LAS f32x4*)(lgb + lane * 32);
            const f32x4 e0 = lr[0], e1 = lr[1], e2 = lr[2], e3 = lr[3], gl = lr[4];
            int g = 0; float gm = gl.x;
            if (gl.y > gm) { gm = gl.y; g = 1; } if (gl.z > gm) { gm = gl.z; g = 2; } if (gl.w > gm) { gm = gl.w; g = 3; }
            const float den = (expf(gl.x - gm) + expf(gl.y - gm)) + (expf(gl.z - gm) + expf(gl.w - gm));
            const float pg = 1.0f / den;
            const f32x4 el = g == 0 ? e0 : (g == 1 ? e1 : (g == 2 ? e2 : e3));
            int i0 = 0; float m0 = el.x;
            if (el.y > m0) { m0 = el.y; i0 = 1; } if (el.z > m0) { m0 = el.z; i0 = 2; } if (el.w > m0) { m0 = el.w; i0 = 3; }
            int i1 = -1; float m1 = -INFINITY;
            if (i0 != 0 && el.x > m1) { m1 = el.x; i1 = 0; } if (i0 != 1 && el.y > m1) { m1 = el.y; i1 = 1; }
            if (i0 != 2 && el.z > m1) { m1 = el.z; i1 = 2; } if (i0 != 3 && el.w > m1) { m1 = el.w; i1 = 3; }
            const float ex = expf(m1 - m0), inv = 1.0f / (1.0f + ex);
            const int ea = g * 4 + i0, eb = g * 4 + i1;
            toke[tok] = make_int2(ea, eb); tokg[tok] = make_float2(pg * inv, pg * ex * inv);
            atomicAdd((int*)&hist[ea], 1); atomicAdd((int*)&hist[16 + eb], 1);
        }
        LDS_WAIT();
    }
    __syncthreads();
    if (tid < 32) WSP(int, WS_MOE + MO_HIST)[vcu * 32 + tid] = hist[tid];
}
__device__ __forceinline__ void sort_phase(const P& p, LAS unsigned char* lds, int vcu, int G) {
    int tid = threadIdx.x; asm volatile("" : "+v"(tid));
    const int lane = tid & 63, wave = __builtin_amdgcn_readfirstlane(tid >> 6);
    LAS int* cnt = (LAS int*)(lds + LDS_GATE); LAS int* pre = cnt + 32; LAS int* base = cnt + 64; LAS int* ntl = cnt + 96;
    const int* histg = WSP(const int, WS_MOE + MO_HIST);
    int* rowtok = WSP(int, WS_MOE + MO_ROWTOK); float* rowgate = WSP(float, WS_MOE + MO_ROWGATE); int* tilee = WSP(int, WS_MOE + MO_TILEE); int* nt = WSP(int, WS_MOE + MO_NT);
    const int2* toke = WSP(const int2, WS_MOE + MO_TOKE); const float2* tokg = WSP(const float2, WS_MOE + MO_TOKG);
    { LAS int* part = (LAS int*)(lds + LDS_RS);
      const int j = tid & 31, part_i = tid >> 5; int c = 0, pr = 0;
      for (int w = part_i; w < G; w += 16) { const int v = histg[w * 32 + j]; if (w < vcu) pr += v; c += v; }
      part[part_i * 64 + j] = c; part[part_i * 64 + 32 + j] = pr;
      __syncthreads();
      if (tid < 32) { int cc = 0, pp = 0;
#pragma unroll
          for (int q = 0; q < 16; ++q) { cc += part[q * 64 + tid]; pp += part[q * 64 + 32 + tid]; }
          cnt[tid] = cc; pre[tid] = pp; } }
    __syncthreads();
    if (tid == 0) { int t = 0; for (int j = 0; j < 32; ++j) { base[j] = t * 256; const int n = (cnt[j] + 255) >> 8; ntl[j] = n; t += n; if (j == 15 && vcu == 0) nt[0] = t; } if (vcu == 0) nt[1] = t; }
    __syncthreads();
    if (vcu == 0 && tid < 32) { const int t0 = base[tid] >> 8; for (int i = 0; i < ntl[tid]; ++i) tilee[t0 + i] = tid & 15; }
    if (vcu < 32) { const int j = vcu, lo = base[j] + cnt[j], hi = base[j] + 256 * ntl[j]; for (int r = lo + tid; r < hi; r += NTHR) { rowtok[r] = -1; rowgate[r] = 0.f; } }
    if (wave < 2) {
        const int k = wave;
        int run[16];
#pragma unroll
        for (int e = 0; e < 16; ++e) run[e] = 0;
        for (int task0 = vcu * NWAVES; task0 < NTOK / 16; task0 += G * NWAVES) {
#pragma unroll 1
            for (int half = 0; half < 2; ++half) {
                const int tok = task0 * 16 + half * 64 + lane;
                const int2 ee = toke[tok]; const float2 gg = tokg[tok];
                const int e = k ? ee.y : ee.x; const float gt = k ? gg.y : gg.x;
                int rank = 0;
#pragma unroll
                for (int x = 0; x < 16; ++x) { const unsigned long long m = __ballot(e == x); if (e == x) rank = run[x] + __popcll(m & ((1ull << lane) - 1ull)); run[x] += __popcll(m); }
                const int pos = base[k * 16 + e] + pre[k * 16 + e] + rank;
                rowtok[pos] = tok; rowgate[pos] = gt;
            }
        }
    }
}
__device__ __forceinline__ void final_phase(const P& p, int vcu, int G) {
    int tid = threadIdx.x; asm volatile("" : "+v"(tid));
    const int lane = tid & 63, wave = __builtin_amdgcn_readfirstlane(tid >> 6);
    const float* ssq = WSP(const float, WS_SSQ); const bf16* hb = WSP(const bf16, WS_HB);
    f32x4 g[4];
#pragma unroll
    for (int j = 0; j < 4; ++j) g[j] = ((const f32x4*)p.final_norm)[lane + 64 * j];
    for (int m0 = (vcu * NWAVES + wave) * 4; m0 < NTOK; m0 += G * NWAVES * 4) {
        v2u w[4][4]; float rs[4];
#pragma unroll
        for (int r = 0; r < 4; ++r) { rs[r] = row_rs(ssq, m0 + r);
#pragma unroll
            for (int j = 0; j < 4; ++j) w[r][j] = ((const v2u*)(hb + (size_t)(m0 + r) * DM))[lane + 64 * j]; }
#pragma unroll
        for (int r = 0; r < 4; ++r) { f32x4* s = (f32x4*)(p.out + (size_t)(m0 + r) * DM) + lane;
#pragma unroll
            for (int j = 0; j < 4; ++j) { f32x4 v; v.x = __builtin_bit_cast(float, w[r][j].x << 16); v.y = __builtin_bit_cast(float, w[r][j].x & 0xffff0000u); v.z = __builtin_bit_cast(float, w[r][j].y << 16); v.w = __builtin_bit_cast(float, w[r][j].y & 0xffff0000u);
                s[64 * j] = v * rs[r] * g[j]; } }
    }
}
#ifndef ENMASK
#define ENMASK 0xffffffffu
#endif
#define EN(b) (((ENMASK) >> (b)) & 1u)
#ifndef REPMASK
#define REPMASK 0u
#endif
#define REPN(b) ((((REPMASK) >> (b)) & 1u) ? 2 : 1)
__device__ __attribute__((noinline)) void grid_barrier(unsigned* barw, unsigned x, volatile LAS unsigned* st) { XcdBarrier b; b.bar = barw; b.x = x; b.st = st; xcd_barrier(b); }
__global__ void __launch_bounds__(NTHR, 2) fwd(Args args) {
    extern __shared__ __attribute__((aligned(16))) unsigned char lds_raw[];
    LAS unsigned char* lds = (LAS unsigned char*)lds_raw;
    const P& p = args.p;
    const int tid = threadIdx.x, lane = tid & 63, wave = __builtin_amdgcn_readfirstlane(tid >> 6);
    const int G = gridDim.x; const int bx = blockIdx.x; const int vcu = (G % 8 == 0) ? (bx % 8) * (G / 8) + bx / 8 : bx;
    volatile LAS unsigned* MISC = (volatile LAS unsigned*)(lds + LDS_MISC);
    if (tid < 64) MISC[tid] = 0u;
    __syncthreads();
    unsigned* ctl = (unsigned*)(p.ws + WS_CTL);
    const int lo = args.ph_lo, hi = args.ph_hi;
    XcdBarrier bar; bar.bar = ctl + CW_BAR + args.li * XCD_BAR_WORDS; bar.x = 0; bar.st = nullptr;
    if (hi - lo > 1) bar = xcd_barrier_post(ctl + CW_BAR + args.li * XCD_BAR_WORDS, MISC);
#define IN(k) (lo <= (k) && (k) < hi)
#define PHL int vcuL = vcu, GL = G, bxL = bx; asm volatile("" : "+s"(vcuL), "+s"(GL), "+s"(bxL)); (void)vcuL; (void)GL; (void)bxL;
#define LTID(v) int v = threadIdx.x; asm volatile("" : "+v"(v))
#define FILL_RS_DENSE() do { LTID(tq); const int rr_ = tq & 255, hf_ = tq >> 8; f32x4 sv_[4][4]; bool ok_[4]; \
        _Pragma("unroll") for (int k_ = 0; k_ < 4; ++k_) { pg8::Unit u_; ok_[k_] = S.next(hf_ + 2 * k_, u_); const f32x4* sp_ = (const f32x4*)(SSQ + (size_t)(ok_[k_] ? u_.pm * 256 + rr_ : 0) * 16); \
            _Pragma("unroll") for (int j_ = 0; j_ < 4; ++j_) sv_[k_][j_] = sp_[j_]; } \
        _Pragma("unroll") for (int k_ = 0; k_ < 4; ++k_) if (ok_[k_]) { const f32x4 a_ = (sv_[k_][0] + sv_[k_][1]) + (sv_[k_][2] + sv_[k_][3]); rstab[(hf_ + 2 * k_) * 256 + rr_] = rsqrtf(((a_.x + a_.y) + (a_.z + a_.w)) * (1.0f / DM) + EPS); } } while (0)
#define FILL_GU() do { LTID(tq); const int rr_ = tq & 255, hf_ = tq >> 8; f32x4 sv_[4][4]; bool ok_[4]; int tk_[4]; \
        _Pragma("unroll") for (int k_ = 0; k_ < 4; ++k_) { pg8::Unit u_; ok_[k_] = S.next(hf_ + 2 * k_, u_); tk_[k_] = ok_[k_] ? ROWTOK[u_.pm * 256 + rr_] : 0; } \
        _Pragma("unroll") for (int k_ = 0; k_ < 4; ++k_) { tk_[k_] = tk_[k_] < 0 ? 0 : tk_[k_]; const f32x4* sp_ = (const f32x4*)(SSQ + (size_t)tk_[k_] * 16); \
            _Pragma("unroll") for (int j_ = 0; j_ < 4; ++j_) sv_[k_][j_] = sp_[j_]; } \
        _Pragma("unroll") for (int k_ = 0; k_ < 4; ++k_) if (ok_[k_]) { const f32x4 a_ = (sv_[k_][0] + sv_[k_][1]) + (sv_[k_][2] + sv_[k_][3]); rowtab[(hf_ + 2 * k_) * 256 + rr_] = tk_[k_]; \
            rstab[(hf_ + 2 * k_) * 256 + rr_] = rsqrtf(((a_.x + a_.y) + (a_.z + a_.w)) * (1.0f / DM) + EPS); } } while (0)
#define FILL_DOWN() do { LTID(tq); const int rr_ = tq & 255, hf_ = tq >> 8; bool ok_[4]; int tk_[4]; float gt_[4]; \
        _Pragma("unroll") for (int k_ = 0; k_ < 4; ++k_) { pg8::Unit u_; ok_[k_] = S.next(hf_ + 2 * k_, u_); const int r_ = ok_[k_] ? u_.pm * 256 + rr_ : 0; tk_[k_] = ROWTOK[r_]; gt_[k_] = ROWGATE[r_]; } \
        _Pragma("unroll") for (int k_ = 0; k_ < 4; ++k_) if (ok_[k_]) { rowtab[(hf_ + 2 * k_) * 256 + rr_] = tk_[k_]; gatetab[(hf_ + 2 * k_) * 256 + rr_] = gt_[k_]; } } while (0)

#define SEAM(k) do { if (IN(k) && IN((k) + 1)) { grid_barrier(bar.bar, bar.x, bar.st); if (REPN(20) == 2) grid_barrier(bar.bar, bar.x, bar.st); } } while (0)
    LAS float* rstab = (LAS float*)(lds + LDS_RS); LAS int* rowtab = (LAS int*)(lds + LDS_ROWTOK); LAS float* gatetab = (LAS float*)(lds + LDS_GATE);
#define HB WSP(bf16, WS_HB)
#define PROJ WSP(bf16, WS_PROJ)
#define Y WSP(bf16, WS_Y)
#define XKV WSP(bf16, WS_XKV)
#define MEMN WSP(bf16, WS_MEMN)
#define SSQ WSP(float, WS_SSQ)
#define XQ WSP(bf16, WS_XQ)
#define U WSP(bf16, WS_U)
#define ROWTOK WSP(const int, WS_MOE + MO_ROWTOK)
#define ROWGATE WSP(const float, WS_MOE + MO_ROWGATE)
#define TILEE WSP(const int, WS_MOE + MO_TILEE)
#define NT WSP(const int, WS_MOE + MO_NT)
#define H (p.out)
#define HB8 ((unsigned char*)p.out + 64 * MiB)
#define U8 WSP(unsigned char, WS_U)

    if (EN(0) && IN(PH_PRO)) _Pragma("unroll 1") for (int rep_ = 0; rep_ < REPN(0); ++rep_) { PHL prologue(p, lds, vcuL, GL, wave, lane); }
    SEAM(PH_PRO);
    if (REPN(18) == 2 && IN(PH_XKV)) { PHL
        pg8::StaticOrder S; S.init(HB, ws_base(p.ws) + WS_W + WO_IN, NTOK, 3072, DM, GL, bxL);
        FILL_RS_DENSE();
        __syncthreads();
        EpiBf16<true> E{PROJ, PW, rstab};
        pg8::gemm_phase<DM, EpiBf16<true>, pg8::StaticOrder, true>(lds + LDS_STAGE, S, E);
    }
    for (int l = 0; l < NLAYER; ++l) {
        const int pb = PH_L0 + l * NPH;
        unsigned char* wl = ws_base(p.ws) + WS_W + (size_t)l * WS_WLAYER;
        if (EN(2) && IN(pb + LP_INPROJ)) _Pragma("unroll 1") for (int rep_ = 0; rep_ < REPN(2); ++rep_) { PHL
            pg8::StaticOrder S; S.init(HB, wl + WO_IN, NTOK, 3072, DM, GL, bxL);
            FILL_RS_DENSE();
            __syncthreads();
            EpiBf16<true> E{PROJ, PW, rstab};
            pg8::gemm_phase<DM, EpiBf16<true>, pg8::StaticOrder, true>(lds + LDS_STAGE, S, E);
            _Pragma("unroll 1") for (int r2_ = 0; r2_ < REPN(19); ++r2_) small_proj(p, l, lds + LDS_STAGE, vcuL, GL, wave, lane);
        }
        SEAM(pb + LP_INPROJ);
        if (EN(11) && IN(pb + LP_MIXA)) _Pragma("unroll 1") for (int rep_ = 0; rep_ < REPN(11); ++rep_) { PHL gla_phase_a(p, l, lds + LDS_STAGE, vcuL, GL); fox_cumsum_phase(p, l, lds + LDS_STAGE, vcuL, GL); fox_knorm_phase(p, vcuL, GL); }
        SEAM(pb + LP_MIXA);
        if (EN(12) && IN(pb + LP_MIXB)) _Pragma("unroll 1") for (int rep_ = 0; rep_ < REPN(12); ++rep_) { PHL gla_phase_b(p, vcuL, GL); }
        if (EN(1) && l == 0 && IN(pb + LP_MIXB)) { PHL
            pg8::StaticOrder S; S.init(MEMN, ws_base(p.ws) + WS_WXKV, 4096, 2048, DM, GL, bxL);
            EpiBf16<false> E{XKV, 2048, rstab};
            pg8::gemm_phase<DM, EpiBf16<false>, pg8::StaticOrder, true>(lds + LDS_STAGE, S, E);
        }
        SEAM(pb + LP_MIXB);
        if (EN(9) && IN(pb + LP_MIXC)) { PHL _Pragma("unroll 1") for (int rep_ = 0; rep_ < REPN(16); ++rep_) fox_phase(p, l, lds + LDS_STAGE, vcuL, GL); _Pragma("unroll 1") for (int rep_ = 0; rep_ < REPN(17); ++rep_) gla_phase_c(p, l, lds + LDS_STAGE, vcuL, GL); }
        SEAM(pb + LP_MIXC);
        if (EN(3) && IN(pb + LP_WOUT)) _Pragma("unroll 1") for (int rep_ = 0; rep_ < REPN(3); ++rep_) { PHL
            pg8::StaticOrder S; S.init(Y, wl + WO_OUT, NTOK, DM, DM, GL, bxL);
            EpiRes<0> E{HB, SSQ, rowtab, gatetab, rep_ == REPN(3) - 1 ? 1.f : 0.f, Y, nullptr};
            pg8::gemm_phase<DM, EpiRes<0>, pg8::StaticOrder, true>(lds + LDS_STAGE, S, E);
        }
        SEAM(pb + LP_WOUT);
        if (EN(4) && IN(pb + LP_XQ)) _Pragma("unroll 1") for (int rep_ = 0; rep_ < REPN(4); ++rep_) { PHL
            pg8::StaticOrder S; S.init(HB, wl + WO_XQ, NTOK, 512, DM, GL, bxL);
            FILL_RS_DENSE();
            __syncthreads();
            EpiBf16<true> E{XQ, 512, rstab};
            pg8::gemm_phase<DM, EpiBf16<true>, pg8::StaticOrder, true>(lds + LDS_STAGE, S, E);
            asm volatile("s_waitcnt vmcnt(0)" ::: "memory"); __syncthreads();
            { pg8::Unit u; for (int iu = 0; S.next(iu, u); ++iu) { xattn_pair(p, l, lds + LDS_STAGE, u.pm, u.pn, rep_ != REPN(4) - 1); } }
        }
        SEAM(pb + LP_XQ);
        if (EN(5) && IN(pb + LP_XO)) _Pragma("unroll 1") for (int rep_ = 0; rep_ < REPN(5); ++rep_) { PHL
            pg8::StaticOrder S; S.init(WSP(unsigned char, WS_XO8), wl + WO_XO, NTOK, DM, 256, GL, bxL);
            EpiRes<0, true> E{HB, SSQ, rowtab, gatetab, rep_ == REPN(5) - 1 ? 1.f : 0.f, Y, HB8};
            pg8::gemm_phase<256, EpiRes<0, true>, pg8::StaticOrder, true, true, 127, 122>(lds + LDS_STAGE, S, E);
        }
        SEAM(pb + LP_XO);
        if (EN(13) && IN(pb + LP_ROUTE)) _Pragma("unroll 1") for (int rep_ = 0; rep_ < REPN(13); ++rep_) { PHL route_phase(p, l, lds, vcuL, GL); }
        SEAM(pb + LP_ROUTE);
        if (EN(14) && IN(pb + LP_SORT)) _Pragma("unroll 1") for (int rep_ = 0; rep_ < REPN(14); ++rep_) { PHL sort_phase(p, lds, vcuL, GL); }
        SEAM(pb + LP_SORT);
        if (EN(6) && IN(pb + LP_GU)) _Pragma("unroll 1") for (int rep_ = 0; rep_ < REPN(6); ++rep_) { PHL
            MoeOrder<0> S{(const char*)HB8, (const char*)(wl + WO_GU), 512, (size_t)1024 * 1024, 0, NT[1], GL, vcuL, TILEE, rowtab};
            FILL_GU();
            __syncthreads();
            EpiGU E{U8, rstab};
            pg8::gemm_phase<512, EpiGU, MoeOrder<0>, true, true, 127, 122>(lds + LDS_STAGE, S, E);
        }
        SEAM(pb + LP_GU);
        if (EN(7) && IN(pb + LP_DOWN0)) _Pragma("unroll 1") for (int rep_ = 0; rep_ < REPN(7); ++rep_) { PHL
            MoeOrder<1> S{(const char*)U8, (const char*)(wl + WO_D), 256, (size_t)1024 * 512, 0, NT[0], GL, vcuL, TILEE, rowtab};
            __syncthreads();
            FILL_DOWN();
            __syncthreads();
            EpiRes<1> E{HB, SSQ, rowtab, gatetab, 1.f, Y, nullptr};
            pg8::gemm_phase<256, EpiRes<1>, MoeOrder<1>, true, true, 125, 122>(lds + LDS_STAGE, S, E);
        }
        SEAM(pb + LP_DOWN0);
        if (EN(8) && IN(pb + LP_DOWN1)) _Pragma("unroll 1") for (int rep_ = 0; rep_ < REPN(8); ++rep_) { PHL
            MoeOrder<1> S{(const char*)U8, (const char*)(wl + WO_D), 256, (size_t)1024 * 512, NT[0], NT[1], GL, vcuL, TILEE, rowtab};
            __syncthreads();
            FILL_DOWN();
            __syncthreads();
            EpiRes<2> E{HB, SSQ, rowtab, gatetab, 1.f, Y, nullptr};
            pg8::gemm_phase<256, EpiRes<2>, MoeOrder<1>, true, true, 125, 122>(lds + LDS_STAGE, S, E);
        }
        SEAM(pb + LP_DOWN1);
    }
    if (EN(15) && IN(PH_FINAL)) _Pragma("unroll 1") for (int rep_ = 0; rep_ < REPN(15); ++rep_) { PHL final_phase(p, vcuL, GL); }
#undef IN
#undef SEAM
#undef HB
#undef PROJ
#undef Y
#undef XKV
#undef MEMN
#undef SSQ
#undef XQ
#undef U
#undef ROWTOK
#undef ROWGATE
#undef TILEE
#undef NT
#undef H
#undef HB8
#undef U8
}

static int g_grid = 0;
static void launch_fast(const P& p, int lo, int hi, int& li, hipStream_t stream) {
    Args a{}; a.p = p; a.ph_lo = lo; a.ph_hi = hi; a.li = li++; a.pad = 0;
    hipLaunchKernelGGL(fwd, dim3(g_grid), dim3(NTHR), LDS_BYTES, stream, a);
    const hipError_t le = hipPeekAtLastError();
    if (le != hipSuccess) fprintf(stderr, "kernel_launch: fwd launch [%d,%d) failed: %s\n", lo, hi, hipGetErrorName(le));
}
extern "C" void kernel_launch(void* const* d_in, const int* in_sizes, int n_in, void* d_out, int out_size, void* d_ws, size_t ws_size, hipStream_t stream) {
    if (n_in != 25 || out_size != NTOK * DM || ws_size < WS_END2) { fprintf(stderr, "kernel_launch: unexpected sizes n_in %d out %d ws %zu (need %zu)\n", n_in, out_size, ws_size, (size_t)WS_END2); return; }
    if (g_grid == 0) {
        int dev = 0, cus = 0, per_cu = 0;
        if (hipGetDevice(&dev) != hipSuccess || hipDeviceGetAttribute(&cus, hipDeviceAttributeMultiprocessorCount, dev) != hipSuccess) { g_grid = -1; return; }
        if (hipFuncSetAttribute((const void*)fwd, hipFuncAttributeMaxDynamicSharedMemorySize, LDS_BYTES) != hipSuccess) { fprintf(stderr, "kernel_launch: hipFuncSetAttribute failed\n"); g_grid = -1; return; }
        if (hipOccupancyMaxActiveBlocksPerMultiprocessor(&per_cu, (const void*)fwd, NTHR, LDS_BYTES) != hipSuccess || per_cu < 1) { fprintf(stderr, "kernel_launch: occupancy query says %d\n", per_cu); }
        (void)hipGetLastError();
        g_grid = cus;
    }
    if (g_grid < 0) return;
    P p{};
    const float** pp = (const float**)&p;
    for (int i = 0; i < 25; ++i) pp[i] = (const float*)d_in[i];
    p.out = (float*)d_out; p.ws = (unsigned char*)d_ws;
    if (hipMemsetAsync((char*)d_ws + WS_CTL + (size_t)CW_BAR * 4, 0, (size_t)XCD_BAR_WORDS * 4, stream) != hipSuccess) { fprintf(stderr, "kernel_launch: hipMemsetAsync failed\n"); return; }
    int li = 0;
    launch_fast(p, PH_PRO, PH_END, li, stream);
}
```

```cpp
#include <hip/hip_runtime.h>
#include <cstdio>
#include <cstdint>

constexpr int NTOK = 32768, DM = 1024, NBATCH = 16, SEQ = 2048, NLAYER = 2, MEML = 256;
constexpr int PW = 3072;
constexpr int C_FQ = 0, C_FK = 512, C_FV = 1024, C_GQ = 1536, C_GK = 1792, C_GV = 2048, C_GG = 2560;
constexpr int INW = 3096;
constexpr float EPS = 1e-6f, LOG2E = 1.4426950408889634f;
constexpr int MAXTILES = 288;
constexpr int MAXROWS = MAXTILES * 256;

typedef unsigned short bf16;
__device__ __forceinline__ unsigned f2bf(float f) { unsigned u = __builtin_bit_cast(unsigned, f); return (u + 0x7fffu + ((u >> 16) & 1u)) >> 16; }
__device__ __forceinline__ float bf2f(bf16 b) { return __builtin_bit_cast(float, ((unsigned)b) << 16); }

constexpr size_t MiB = 1u << 20;
constexpr size_t WS_CTL = 0;
constexpr size_t WS_W = 1 * MiB;
constexpr size_t WS_WLAYER = 59 * MiB;
constexpr size_t WS_WXKV = WS_W + 2 * WS_WLAYER;
constexpr size_t WS_HB = WS_WXKV + 4 * MiB;
constexpr size_t WS_PROJ = WS_HB + 64 * MiB;
constexpr size_t WS_XQ = WS_PROJ;
constexpr size_t WS_U = WS_PROJ + 32 * MiB;
constexpr size_t WS_XO8 = WS_U + 40 * MiB;
constexpr size_t WS_SM = WS_PROJ + 192 * MiB;
constexpr size_t WS_CB = WS_SM + 4 * MiB;
constexpr size_t WS_Y = WS_CB + 1 * MiB;
constexpr size_t WS_XKV = WS_Y + 64 * MiB;
constexpr size_t WS_MEMN = WS_XKV + 16 * MiB;
constexpr size_t WS_SSQ = WS_MEMN + 8 * MiB;
constexpr size_t WS_MOE = WS_SSQ + 2 * MiB;
constexpr size_t WS_END = WS_MOE + 2 * MiB;
static_assert(WS_END <= 512 * MiB, "workspace map");
constexpr size_t MO_TOKE = 0;
constexpr size_t MO_TOKG = 256 * 1024;
constexpr size_t MO_ROWTOK = 512 * 1024;
constexpr size_t MO_ROWGATE = 832 * 1024;
constexpr size_t MO_TILEE = 1152 * 1024;
constexpr size_t MO_NT = 1156 * 1024;
constexpr size_t MO_HIST = 1160 * 1024;
constexpr size_t MO_KN = 1280 * 1024;

struct P {
    const float *x, *mem, *mem_norm, *mix_norm, *w_in, *b_forget, *w_alpha_up, *b_alpha, *fox_gain, *gla_gain, *w_out, *cross_norm, *w_xq, *w_xk, *w_xv, *w_xo,
        *moe_norm, *w_rg, *b_rg, *w_re, *b_re, *w_eg, *w_eu, *w_ed, *final_norm;
    float* out; unsigned char* ws;
};
__host__ __device__ __forceinline__ unsigned char* ws_base(unsigned char* w) {
#if defined(__HIP_DEVICE_COMPILE__)
    size_t z = 0; asm volatile("" : "+s"(z));
    return w + z;
#else
    return w;
#endif
}
#define WSP(T, off) ((T*)(ws_base(p.ws) + (off)))

__device__ __forceinline__ float wave_sum(float v) {
#pragma unroll
    for (int o = 1; o < 64; o <<= 1) v += __shfl_xor(v, o);
    return v;
}
__device__ __forceinline__ float wave_min(float v) {
#pragma unroll
    for (int o = 1; o < 64; o <<= 1) v = fminf(v, __shfl_xor(v, o));
    return v;
}
__device__ __forceinline__ float wave_max(float v) {
#pragma unroll
    for (int o = 1; o < 64; o <<= 1) v = fmaxf(v, __shfl_xor(v, o));
    return v;
}
__device__ __forceinline__ float row_rs(const float* ssq, int row) {
    const float4* s = (const float4*)(ssq + (size_t)row * 16);
    float4 a = s[0], b = s[1], c = s[2], d = s[3];
    float t = ((a.x + a.y) + (a.z + a.w)) + ((b.x + b.y) + (b.z + b.w)) + ((c.x + c.y) + (c.z + c.w)) + ((d.x + d.y) + (d.z + d.w));
    return rsqrtf(t * (1.0f / DM) + EPS);
}
__device__ __forceinline__ float log_sigmoid(float z) { return fminf(z, 0.f) - log1pf(expf(-fabsf(z))); }
__device__ __forceinline__ float silu(float z) { return z / (1.f + expf(-z)); }

typedef unsigned st_v4u __attribute__((ext_vector_type(4)));
typedef unsigned st_v2u __attribute__((ext_vector_type(2)));
#ifndef WT_STORES
#define WT_STORES 0
#endif
__device__ __forceinline__ void st_b128(void* p, st_v4u v) {
#if WT_STORES
    asm volatile("global_store_dwordx4 %0, %1, off sc1\n\ts_nop 1" :: "v"(p), "v"(v) : "memory");
#else
    *(st_v4u*)p = v;
#endif
}
__device__ __forceinline__ void st_b128_wt(void* p, st_v4u v) { asm volatile("global_store_dwordx4 %0, %1, off sc1\n\ts_nop 1" :: "v"(p), "v"(v) : "memory"); }
__device__ __forceinline__ void st_b64(void* p, st_v2u v) {
#if WT_STORES
    asm volatile("global_store_dwordx2 %0, %1, off sc1" :: "v"(p), "v"(v) : "memory");
#else
    *(st_v2u*)p = v;
#endif
}
#define XB_TMO      128
#define XB_XCNT(j)  (256  + 64 * (j))
#define XB_XSUB(j)  (1280 + 64 * (j))
#define XB_XGEN(j)  (2304 + 64 * (j))
#define XB_TOP      3328
#define XB_TOPGEN   3392
#define XCD_BAR_WORDS 3456
#define XB_SPIN_CAP (1u << 18)
#define LAS __attribute__((address_space(3)))

__device__ __forceinline__ unsigned xb_ld(unsigned* p)              { return __hip_atomic_load(p, __ATOMIC_RELAXED, __HIP_MEMORY_SCOPE_AGENT); }
__device__ __forceinline__ unsigned xb_add(unsigned* p, unsigned v) { return __hip_atomic_fetch_add(p, v, __ATOMIC_RELAXED, __HIP_MEMORY_SCOPE_AGENT); }
__device__ __forceinline__ unsigned xb_xcc_id() { return (unsigned)__builtin_amdgcn_s_getreg((3 << 11) | 20) & 0xFu; }
#define XB_SPIN(cond, bar) do { unsigned _sp = 0; while (cond) { __builtin_amdgcn_s_sleep(1); \
    if ((++_sp & 255u) == 0u) { if (xb_ld(&(bar)[XB_TMO])) break; if (_sp > XB_SPIN_CAP) { atomicAdd(&(bar)[XB_TMO], 1u); break; } } } } while (0)

struct XcdBarrier {
    unsigned* bar; unsigned x;
    volatile LAS unsigned* st;
};

__device__ __forceinline__ XcdBarrier xcd_barrier_post(unsigned* bar, volatile LAS unsigned* st) {
    XcdBarrier b; b.bar = bar; b.x = xb_xcc_id(); b.st = st;
    if (threadIdx.x == 0) (void)xb_add(&bar[XB_XCNT(b.x)], 1u);
    return b;
}
__device__ __forceinline__ void xcd_barrier_complete(unsigned* bar, unsigned x, unsigned& nloc, unsigned& nx) {
    const unsigned G = gridDim.x * gridDim.y * gridDim.z;
    unsigned sum, cnt, mine, sp = 0u;
    for (;;) {
        sum = 0u; cnt = 0u; mine = 0u;
#pragma unroll
        for (unsigned j = 0; j < 16; ++j) { const unsigned c = xb_ld(&bar[XB_XCNT(j)]); sum += c; cnt += (c > 0u) ? 1u : 0u; mine = (j == x) ? c : mine; }
        if (sum == G) break;
        __builtin_amdgcn_s_sleep(1);
        if ((++sp & 255u) == 0u) { if (xb_ld(&bar[XB_TMO])) break; if (sp > XB_SPIN_CAP) { atomicAdd(&bar[XB_TMO], 1u); break; } }
    }
    nloc = mine > 0u ? mine : 1u; nx = cnt > 0u ? cnt : 1u;
}

__device__ __forceinline__ void xcd_barrier(const XcdBarrier& b) {
    asm volatile("s_waitcnt vmcnt(0)" ::: "memory");
    __syncthreads();
    if (threadIdx.x == 0) {
        unsigned* bar = b.bar;
        __builtin_amdgcn_s_waitcnt(0);
        unsigned nloc = b.st[0], nx = b.st[1];
        if (nloc == 0u) { xcd_barrier_complete(bar, b.x, nloc, nx); b.st[0] = nloc; b.st[1] = nx; }
        const unsigned old = xb_add(&bar[XB_XSUB(b.x)], 1u);
        const unsigned gen = old / nloc;
        if (old + 1u == (gen + 1u) * nloc) {
            __builtin_amdgcn_fence(__ATOMIC_RELEASE, "agent");
            asm volatile("s_waitcnt vmcnt(0)" ::: "memory");
            const unsigned og = xb_add(&bar[XB_TOP], 1u);
            const unsigned tg = og / nx;
            if (og + 1u == (tg + 1u) * nx) xb_add(&bar[XB_TOPGEN], 1u);
            else XB_SPIN(xb_ld(&bar[XB_TOPGEN]) == tg, bar);
            __builtin_amdgcn_fence(__ATOMIC_ACQUIRE, "agent");
            xb_add(&bar[XB_XGEN(b.x)], 1u);
            asm volatile("s_waitcnt vmcnt(0)" ::: "memory");
        } else {
            XB_SPIN(xb_ld(&bar[XB_XGEN(b.x)]) == gen, bar);
            __builtin_amdgcn_fence(__ATOMIC_ACQUIRE, "agent");
            asm volatile("s_waitcnt vmcnt(0)" ::: "memory");
        }
    }
    __syncthreads();
}

namespace pg8 {
#define PG8_LAS __attribute__((address_space(3)))
typedef unsigned short bf16_t;
typedef short bf16x8 __attribute__((ext_vector_type(8)));
typedef float f32x4 __attribute__((ext_vector_type(4)));
typedef unsigned u32x4 __attribute__((ext_vector_type(4)));
typedef unsigned u32x2 __attribute__((ext_vector_type(2)));
constexpr int BM = 256, BK = 64, HALF = 128, HTB = HALF * BK * 2, STAGE_BYTES = 8 * HTB, NXCD = 8, WGM = 8;

__host__ __device__ __forceinline__ int lds_byte(int r, int c) { const int st = (r >> 4) * 2 + (c >> 5), rr = r & 15, cc = c & 31, ob = rr * 64 + cc * 2; return st * 1024 + (ob ^ (((ob >> 9) & 1) << 5)); }
__host__ __device__ __forceinline__ void stage_rc(int b, int& R, int& C) { const int st = b / 1024, sb = b % 1024, swz = sb ^ (((sb >> 9) & 1) << 5); R = (st >> 1) * 16 + swz / 64; C = (st & 1) * 32 + (swz % 64) / 2; }
__host__ __device__ __forceinline__ int perm32(int rho) { const int n = rho >> 4, i = rho & 15; return 8 * (i >> 2) + 4 * n + (i & 3); }

struct Unit { int pm, pn, e; };

struct StaticOrder {
    static constexpr bool GATHER = false;
    static constexpr size_t KSTEP_A = 128;
    const char* A; const char* Bt; int K; int nM, nN, nwg, G, c;
    __device__ void init(const void* A_, const void* Bt_, int M, int N, int K_, int G_, int c_) { A = (const char*)A_; Bt = (const char*)Bt_; K = K_; nM = M / BM; nN = N / BM; nwg = nM * nN; G = G_; c = c_; }
    __device__ bool next(int i, Unit& u) const {
        const long L = (long)i * G + c; if (L >= nwg) return false;
        int wgid = (int)L; { const int q = nwg / NXCD, r = nwg % NXCD, xcd = wgid % NXCD, off = wgid / NXCD; wgid = (xcd < r ? xcd * (q + 1) : r * (q + 1) + (xcd - r) * q) + off; }
        const int nig = WGM * nN, gid = wgid / nig, fm = gid * WGM, gsz = (nM - fm) < WGM ? (nM - fm) : WGM;
        u.pm = fm + ((wgid % nig) % gsz); u.pn = (wgid % nig) / gsz; u.e = 0; return true;
    }
    __device__ __forceinline__ const char* a_base(const Unit& u) const { return A + (size_t)u.pm * (size_t)(BM * 2) * K; }
    __device__ __forceinline__ const char* b_base(const Unit& u) const { return Bt + (size_t)u.pn * (size_t)(BM * 2) * K; }
    __device__ __forceinline__ unsigned a_off(int, int, int, int) const { return 0u; }
};

__device__ __forceinline__ unsigned cvt_pk_bf16(float lo, float hi) { unsigned r; asm volatile("v_cvt_pk_bf16_f32 %0, %1, %2" : "=v"(r) : "v"(lo), "v"(hi)); return r; }

typedef int i32x8 __attribute__((ext_vector_type(8)));
typedef int i32x4 __attribute__((ext_vector_type(4)));
template <int K, class Epi, class Sched, bool ALIGN_EPI, bool FP8 = false, int SA = 127, int SB = 127>
__device__ __forceinline__ void gemm_phase(PG8_LAS unsigned char* lds, const Sched& S, const Epi& E) {
    int tid_ = threadIdx.x; asm volatile("" : "+v"(tid_));
    const int tid = tid_, wid = __builtin_amdgcn_readfirstlane(tid >> 6), lane = tid & 63, wr = wid >> 2, wc = wid & 3, fr = lane & 15, fq = lane >> 4;
    constexpr int nt = K / BK;
    constexpr int NH = Sched::GATHER ? 2 : 1;
    unsigned voffB[2], cvA[NH][2], nvA[NH][2];
#pragma unroll
    for (int i = 0; i < 2; ++i) { int R, C; stage_rc(tid * 16 + i * 8192, R, C); const int Rb = Epi::PERM ? ((R & ~31) + perm32(R & 31)) : R;
        voffB[i] = (unsigned)(Rb * K + C) * 2u;
        cvA[0][i] = nvA[0][i] = (unsigned)(R * K + C) * 2u; if constexpr (NH == 2) { cvA[NH - 1][i] = nvA[NH - 1][i] = cvA[0][i]; } }
    constexpr size_t kstep = (size_t)(BK * 2);
    constexpr size_t hstep = (size_t)HALF * K * 2;
    constexpr size_t hstepA = Sched::GATHER ? (size_t)0 : hstep;
    constexpr size_t kstepA = Sched::KSTEP_A;
    const unsigned ldsw = (unsigned)wid * 1024u;
    const int aoff = lds_byte(wr * 64 + fr, fq * 8), boff = lds_byte(wc * 32 + fr, fq * 8);
#define PG8_SA(b, h) (((b) * 2 + (h)) * HTB)
#define PG8_SB(b, h) ((4 + (b) * 2 + (h)) * HTB)
#define PG8_STAGE(bufoff, gbase, voff) do { _Pragma("unroll") for (int _i = 0; _i < 2; ++_i) \
        __builtin_amdgcn_global_load_lds((const unsigned*)((const char*)(gbase) + (voff)[_i]), (PG8_LAS unsigned*)(lds + (bufoff) + ldsw + _i * 8192), 16, 0, 0); } while (0)
#define PG8_LD32(addr) __builtin_shufflevector(*(const PG8_LAS i32x4*)(addr), *(const PG8_LAS i32x4*)((addr) + 1024), 0, 1, 2, 3, 4, 5, 6, 7)
#define PG8_LDA(dst, b, h) do { _Pragma("unroll") for (int m = 0; m < 4; ++m) dst[m] = PG8_LD32(lds + PG8_SA(b, h) + aoff + m * 2048); } while (0)
#define PG8_LDB(dst, b, h) do { _Pragma("unroll") for (int n = 0; n < 2; ++n) dst[n] = PG8_LD32(lds + PG8_SB(b, h) + boff + n * 2048); } while (0)
#define PG8_H0(x) __builtin_bit_cast(bf16x8, __builtin_shufflevector((x), (x), 0, 1, 2, 3))
#define PG8_H1(x) __builtin_bit_cast(bf16x8, __builtin_shufflevector((x), (x), 4, 5, 6, 7))
#define PG8_MMA(ai, bj, At, Bt) do { __builtin_amdgcn_s_setprio(1); _Pragma("unroll") for (int m = 0; m < 4; ++m) _Pragma("unroll") for (int n = 0; n < 2; ++n) { \
        if constexpr (FP8) asm volatile("v_mfma_scale_f32_16x16x128_f8f6f4 %0, %1, %2, %0, %3, %4 op_sel_hi:[0,0,0]" : "+v"(acc[ai][bj][m][n]) : "v"(Bt[n]), "v"(At[m]), "v"(sbv), "v"(sav)); \
        else { acc[ai][bj][m][n] = __builtin_amdgcn_mfma_f32_16x16x32_bf16(PG8_H0(Bt[n]), PG8_H0(At[m]), acc[ai][bj][m][n], 0, 0, 0); \
               acc[ai][bj][m][n] = __builtin_amdgcn_mfma_f32_16x16x32_bf16(PG8_H1(Bt[n]), PG8_H1(At[m]), acc[ai][bj][m][n], 0, 0, 0); } } \
        __builtin_amdgcn_s_setprio(0); } while (0)
#define PG8_WAIT_V(n) asm volatile("s_waitcnt vmcnt(" #n ")" ::: "memory")
#define PG8_WAIT_L(n) asm volatile("s_waitcnt lgkmcnt(" #n ")" ::: "memory")
#define PG8_BAR __builtin_amdgcn_s_barrier()
#define PG8_SCHED __builtin_amdgcn_sched_barrier(0)
    int sav = SA, sbv = SB; asm volatile("" : "+v"(sav), "+v"(sbv));
    Unit cur, nxt; int ui = 0;
    if (!S.next(0, cur)) return;
    f32x4 acc[2][2][4][2];
#pragma unroll
    for (int a = 0; a < 2; ++a)
#pragma unroll
        for (int b = 0; b < 2; ++b)
#pragma unroll
            for (int m = 0; m < 4; ++m)
#pragma unroll
                for (int n = 0; n < 2; ++n) acc[a][b][m][n] = (f32x4){0.f, 0.f, 0.f, 0.f};
    i32x8 At[4], B0[2], B1[2];
    const char* cA = S.a_base(cur); const char* cB = S.b_base(cur);
    if constexpr (Sched::GATHER) {
        int R0, C0, R1, C1; stage_rc(tid * 16, R0, C0); stage_rc(tid * 16 + 8192, R1, C1);
#pragma unroll
        for (int h = 0; h < 2; ++h) { cvA[h][0] = S.a_off(0, h, R0, C0 * 2); cvA[h][1] = S.a_off(0, h, R1, C1 * 2); }
    }
    PG8_STAGE(PG8_SB(0, 0), cB, voffB); PG8_STAGE(PG8_SB(0, 1), cB + hstep, voffB); PG8_STAGE(PG8_SA(0, 0), cA, cvA[0]); PG8_STAGE(PG8_SA(0, 1), cA + hstepA, cvA[NH - 1]);
    if (wr == 1) PG8_BAR;
    PG8_WAIT_V(2); PG8_BAR;
    PG8_STAGE(PG8_SB(1, 0), cB + kstep, voffB); PG8_STAGE(PG8_SA(1, 0), cA + kstepA, cvA[0]); PG8_STAGE(PG8_SB(1, 1), cB + hstep + kstep, voffB);
    PG8_WAIT_V(6); PG8_BAR;
    for (;;) {
        const bool has_next = S.next(ui + 1, nxt);
        const char* nA = has_next ? S.a_base(nxt) : cA; const char* nB = has_next ? S.b_base(nxt) : cB;
        if constexpr (Sched::GATHER) {
            if (has_next) {
                int t2 = threadIdx.x; asm volatile("" : "+v"(t2));
                int R0, C0, R1, C1; stage_rc(t2 * 16, R0, C0); stage_rc(t2 * 16 + 8192, R1, C1);
#pragma unroll
                for (int h = 0; h < 2; ++h) { nvA[h][0] = S.a_off(ui + 1, h, R0, C0 * 2); nvA[h][1] = S.a_off(ui + 1, h, R1, C1 * 2); }
            } else {
#pragma unroll
                for (int h = 0; h < 2; ++h) { nvA[h][0] = cvA[h][0]; nvA[h][1] = cvA[h][1]; }
            }
        }
#pragma unroll 1
        for (int t = 0; t < nt; t += 2) {
            const bool last = (t == nt - 2);
            const char* a1 = cA + (size_t)(t + 1) * kstepA;
            const char* a2 = last ? nA : cA + (size_t)(t + 2) * kstepA; const char* b2 = last ? nB : cB + (size_t)(t + 2) * kstep;
            const char* a3 = a2 + kstepA; const char* b3 = b2 + kstep;
            unsigned v2[NH][2];
#pragma unroll
            for (int h = 0; h < NH; ++h) { if constexpr (Sched::GATHER) { v2[h][0] = last ? nvA[h][0] : cvA[h][0]; v2[h][1] = last ? nvA[h][1] : cvA[h][1]; } else { v2[h][0] = cvA[h][0]; v2[h][1] = cvA[h][1]; } }
            PG8_LDB(B0, 0, 0); PG8_LDB(B1, 0, 1); PG8_SCHED; PG8_LDA(At, 0, 0); PG8_STAGE(PG8_SA(1, 1), a1 + hstepA, cvA[NH - 1]);
            PG8_WAIT_V(8); PG8_WAIT_L(0); PG8_BAR; PG8_MMA(0, 0, At, B0); PG8_MMA(0, 1, At, B1); PG8_BAR; PG8_SCHED;
            PG8_LDA(At, 0, 1); PG8_STAGE(PG8_SB(0, 0), b2, voffB); PG8_STAGE(PG8_SB(0, 1), b2 + hstep, voffB); PG8_STAGE(PG8_SA(0, 0), a2, v2[0]);
            PG8_WAIT_V(8); PG8_WAIT_L(0); PG8_BAR; PG8_MMA(1, 0, At, B0); PG8_MMA(1, 1, At, B1); PG8_BAR; PG8_SCHED;
            PG8_LDB(B0, 1, 0); PG8_LDB(B1, 1, 1); PG8_SCHED; PG8_LDA(At, 1, 0); PG8_STAGE(PG8_SA(0, 1), a2 + hstepA, v2[NH - 1]);
            PG8_WAIT_V(8); PG8_WAIT_L(0); PG8_BAR; PG8_MMA(0, 0, At, B0); PG8_MMA(0, 1, At, B1); PG8_BAR; PG8_SCHED;
            PG8_LDA(At, 1, 1); PG8_STAGE(PG8_SB(1, 0), b3, voffB); PG8_STAGE(PG8_SB(1, 1), b3 + hstep, voffB); PG8_STAGE(PG8_SA(1, 0), a3, v2[0]);
            PG8_WAIT_V(8); PG8_WAIT_L(0); PG8_BAR; PG8_MMA(1, 0, At, B0); PG8_MMA(1, 1, At, B1); PG8_BAR; PG8_SCHED;
        }
        if constexpr (ALIGN_EPI) { if (wr == 0) PG8_BAR; }
        if constexpr (FP8) asm volatile("s_nop 15\n\ts_nop 15" ::: "memory");
        E(acc, cur, ui, wr, wc, fr, fq);
        if (!has_next) break;
#pragma unroll
        for (int a = 0; a < 2; ++a)
#pragma unroll
            for (int b = 0; b < 2; ++b)
#pragma unroll
                for (int m = 0; m < 4; ++m)
#pragma unroll
                    for (int n = 0; n < 2; ++n) acc[a][b][m][n] = (f32x4){0.f, 0.f, 0.f, 0.f};
        cur = nxt; cA = nA; cB = nB; ++ui;
        if constexpr (Sched::GATHER) {
#pragma unroll
            for (int h = 0; h < NH; ++h) { cvA[h][0] = nvA[h][0]; cvA[h][1] = nvA[h][1]; }
        }
        if constexpr (ALIGN_EPI) { if (wr == 1) PG8_BAR; }
    }
    PG8_WAIT_V(0);
    if constexpr (!ALIGN_EPI) { if (wr == 0) PG8_BAR; }
    PG8_BAR;
#undef PG8_SA
#undef PG8_SB
#undef PG8_STAGE
#undef PG8_LDA
#undef PG8_LDB
#undef PG8_MMA
#undef PG8_LD32
#undef PG8_H0
#undef PG8_H1
#undef PG8_WAIT_V
#undef PG8_WAIT_L
#undef PG8_BAR
#undef PG8_SCHED
}
}
#define GAS __attribute__((address_space(1)))
typedef float f32x4 __attribute__((ext_vector_type(4)));
typedef float f32x16 __attribute__((ext_vector_type(16)));
typedef short bf16x8 __attribute__((ext_vector_type(8)));
typedef unsigned v4u __attribute__((ext_vector_type(4)));
typedef unsigned v2u __attribute__((ext_vector_type(2)));
#define LDS_WAIT() asm volatile("s_waitcnt lgkmcnt(0)" ::: "memory")
#define VM_WAIT() asm volatile("s_waitcnt vmcnt(0)" ::: "memory")
__device__ __forceinline__ unsigned pk2(float lo, float hi) { return f2bf(lo) | (f2bf(hi) << 16); }

constexpr int NWAVES = 8, NTHR = 512;
constexpr int LDS_STAGE = 0;
constexpr int LDS_RS = 131072;
constexpr int LDS_ROWTOK = LDS_RS + 8192;
constexpr int LDS_GATE = LDS_ROWTOK + 8192;
constexpr int LDS_MISC = LDS_GATE + 8192;
constexpr int LDS_BYTES = LDS_MISC + 256;
constexpr size_t WO_IN = 0, WO_SM = 6 * MiB, WO_RHI = 6 * MiB + 65536, WO_RLO = 6 * MiB + 131072, WO_OUT = 7 * MiB, WO_XQ = 9 * MiB, WO_XO = 10 * MiB, WO_GU = 11 * MiB, WO_D = 43 * MiB;
static_assert(WO_D + 16 * MiB <= WS_WLAYER, "weight block");
constexpr int CW_BAR = 4096;
constexpr int MAX_LAUNCH = 40;
static_assert((CW_BAR + MAX_LAUNCH * XCD_BAR_WORDS) * 4 <= (int)(1 * MiB), "ctl");

enum { PH_PRO = 0, PH_XKV = 1, PH_L0 = 2, NPH = 13, PH_FINAL = PH_L0 + NLAYER * NPH, PH_END = PH_FINAL + 1 };
enum { LP_INPROJ = 0, LP_MIXA, LP_MIXB, LP_MIXC, LP_WOUT, LP_XQ, LP_XATTN, LP_XO, LP_ROUTE, LP_SORT, LP_GU, LP_DOWN0, LP_DOWN1 };

struct Args { P p; int ph_lo, ph_hi, li, pad; };

#ifndef WT_PROJ
#define WT_PROJ 0
#endif
template <bool HAS_RS> struct EpiBf16 {
    static constexpr bool PERM = true;
    bf16* O; int ldc; const LAS float* rstab;
    __device__ __forceinline__ void operator()(const pg8::f32x4 (&acc)[2][2][4][2], const pg8::Unit& u, int iu, int wr, int wc, int fr, int fq) const {
#pragma unroll
        for (int ai = 0; ai < 2; ++ai)
#pragma unroll
            for (int m = 0; m < 4; ++m) {
                const int lrow = ai * 128 + wr * 64 + m * 16 + fr;
                float sc = 1.f; if (HAS_RS) sc = rstab[iu * 256 + lrow];
                bf16* rowp = O + (size_t)(u.pm * 256 + lrow) * ldc + u.pn * 256 + wc * 32 + 8 * fq;
#pragma unroll
                for (int bj = 0; bj < 2; ++bj) { const pg8::f32x4 v0 = acc[ai][bj][m][0] * sc, v1 = acc[ai][bj][m][1] * sc;
                    pg8::u32x4 w; w.x = pg8::cvt_pk_bf16(v0[0], v0[1]); w.y = pg8::cvt_pk_bf16(v0[2], v0[3]); w.z = pg8::cvt_pk_bf16(v1[0], v1[1]); w.w = pg8::cvt_pk_bf16(v1[2], v1[3]);
                    if (WT_PROJ) st_b128_wt(rowp + bj * 128, w); else st_b128(rowp + bj * 128, w); }
            }
    }
};
__device__ __forceinline__ unsigned pk4_fp8(float a, float b, float c, float d) { int w = __builtin_amdgcn_cvt_pk_fp8_f32(a, b, 0, false); w = __builtin_amdgcn_cvt_pk_fp8_f32(c, d, w, true); return (unsigned)w; }
struct EpiGU {
    static constexpr bool PERM = true;
    unsigned char* U8; const LAS float* rstab;
    __device__ __forceinline__ void operator()(const pg8::f32x4 (&acc)[2][2][4][2], const pg8::Unit& u, int iu, int wr, int wc, int fr, int fq) const {
#pragma unroll
        for (int ai = 0; ai < 2; ++ai)
#pragma unroll
            for (int m = 0; m < 4; ++m) {
                const int lrow = ai * 128 + wr * 64 + m * 16 + fr;
                const float sc = rstab[iu * 256 + lrow];
                float o[8];
#pragma unroll
                for (int n = 0; n < 2; ++n)
#pragma unroll
                    for (int j = 0; j < 4; ++j) { const float g = acc[ai][0][m][n][j] * sc, uu = acc[ai][1][m][n][j] * sc; o[n * 4 + j] = 4.f * g * uu * __builtin_amdgcn_rcpf(1.f + __expf(-g)); }
                pg8::u32x2 w; w.x = pk4_fp8(o[0], o[1], o[2], o[3]); w.y = pk4_fp8(o[4], o[5], o[6], o[7]);
                st_b64(U8 + (size_t)(u.pm * 256 + lrow) * 512 + u.pn * 128 + wc * 32 + 8 * fq, w);
            }
    }
};
template <int MODE, bool W8 = false> struct EpiRes {
    static constexpr bool PERM = true;
    static constexpr bool MOE = MODE != 0;
    bf16* hb; float* ssq; const LAS int* rowtab; const LAS float* gatetab; float gs; bf16* t0; unsigned char* h8;
    static __device__ __forceinline__ void unpack8(const pg8::u32x4& w, float (&f)[8]) {
        f[0] = __builtin_bit_cast(float, w.x << 16); f[1] = __builtin_bit_cast(float, w.x & 0xffff0000u); f[2] = __builtin_bit_cast(float, w.y << 16); f[3] = __builtin_bit_cast(float, w.y & 0xffff0000u);
        f[4] = __builtin_bit_cast(float, w.z << 16); f[5] = __builtin_bit_cast(float, w.z & 0xffff0000u); f[6] = __builtin_bit_cast(float, w.w << 16); f[7] = __builtin_bit_cast(float, w.w & 0xffff0000u); }
    __device__ __forceinline__ void operator()(const pg8::f32x4 (&acc)[2][2][4][2], const pg8::Unit& u, int iu, int wr, int wc, int fr, int fq) const {
#pragma unroll
        for (int ai = 0; ai < 2; ++ai)
#pragma unroll
            for (int m = 0; m < 4; ++m) {
                const int lrow = ai * 128 + wr * 64 + m * 16 + fr;
                int row = u.pm * 256 + lrow; float g = gs;
                if (MOE) { row = rowtab[iu * 256 + lrow]; g = gatetab[iu * 256 + lrow] * gs; }
                const bool ok = !MOE || row >= 0;
                const size_t off = (size_t)(ok ? row : 0) * DM + u.pn * 256 + wc * 32 + 8 * fq;
                float q = 0.f;
                if (ok) {
#pragma unroll
                    for (int bj = 0; bj < 2; ++bj) {
                        float o[8];
#pragma unroll
                        for (int j = 0; j < 4; ++j) { o[j] = acc[ai][bj][m][0][j] * g; o[4 + j] = acc[ai][bj][m][1][j] * g; }
                        if (MODE == 1) { pg8::u32x4 w; w.x = pg8::cvt_pk_bf16(o[0], o[1]); w.y = pg8::cvt_pk_bf16(o[2], o[3]); w.z = pg8::cvt_pk_bf16(o[4], o[5]); w.w = pg8::cvt_pk_bf16(o[6], o[7]); st_b128(t0 + off + bj * 128, w); }
                        else {
                            float bs[8]; unpack8(*(const pg8::u32x4*)(hb + off + bj * 128), bs);
                            if (MODE == 2) { float tv[8]; unpack8(*(const pg8::u32x4*)(t0 + off + bj * 128), tv);
#pragma unroll
                                for (int j = 0; j < 8; ++j) bs[j] += tv[j]; }
#pragma unroll
                            for (int j = 0; j < 8; ++j) o[j] += bs[j];
                            pg8::u32x4 w; w.x = pg8::cvt_pk_bf16(o[0], o[1]); w.y = pg8::cvt_pk_bf16(o[2], o[3]); w.z = pg8::cvt_pk_bf16(o[4], o[5]); w.w = pg8::cvt_pk_bf16(o[6], o[7]);
                            float r[8]; unpack8(w, r);
#pragma unroll
                            for (int j = 0; j < 8; ++j) q += r[j] * r[j];
                            st_b128(hb + off + bj * 128, w);
                            if (W8) { pg8::u32x2 w8; w8.x = pk4_fp8(o[0], o[1], o[2], o[3]); w8.y = pk4_fp8(o[4], o[5], o[6], o[7]); st_b64(h8 + off + bj * 128, w8); } }
                    }
                }
                if (MODE != 1) { q += __shfl_xor(q, 16); q += __shfl_xor(q, 32); if (fq == 0 && ok) ssq[(size_t)row * 16 + u.pn * 4 + wc] = q; }
            }
    }
};
template <int MODE> struct MoeOrder {
    static constexpr bool GATHER = MODE == 0;
    static constexpr size_t KSTEP_A = 128;
    const char* A; const char* Bt; int K; size_t estride; int lo, hi, G, c; const int* tilee; const LAS int* rowtab;
    __device__ bool next(int i, pg8::Unit& u) const { const int L = i * G + c, t = lo + (L >> 2); if (t >= hi) return false; u.pm = t; u.pn = L & 3; u.e = tilee[t]; return true; }
    __device__ __forceinline__ const char* a_base(const pg8::Unit& u) const { return GATHER ? A : A + (size_t)u.pm * (size_t)512 * K; }
    __device__ __forceinline__ const char* b_base(const pg8::Unit& u) const { return Bt + (size_t)u.e * estride + (size_t)u.pn * (size_t)512 * K; }
    __device__ __forceinline__ unsigned a_off(int iu, int h, int R, int Cb) const { return (unsigned)rowtab[iu * 256 + h * 128 + R] * (unsigned)(K * 2) + (unsigned)Cb; }
};

__device__ __forceinline__ void router_weights(const P& p, int gtid, int gstride);
__device__ __forceinline__ void tr_item(const float* W, int N, int K, int k0, int n0, const float* gain, float scale, bf16* dst, LAS float* scr, int lane) {
    const int kr = lane >> 3, c4 = lane & 7;
    f32x4 v[8];
#pragma unroll
    for (int i = 0; i < 8; ++i) v[i] = *(const f32x4*)(W + (size_t)(k0 + 8 * i + kr) * N + n0 + 4 * c4);
#pragma unroll
    for (int i = 0; i < 8; ++i) { const int kk = 8 * i + kr; float g = scale; if (gain) g *= gain[k0 + kk];
        LAS float* d = scr + kk * 33 + 4 * c4; d[0] = v[i].x * g; d[1] = v[i].y * g; d[2] = v[i].z * g; d[3] = v[i].w * g; }
    LDS_WAIT();
    const int c = lane & 7;
#pragma unroll
    for (int j = 0; j < 4; ++j) { const int n = (lane >> 3) + 8 * j; const LAS float* s = scr + (8 * c) * 33 + n;
        v4u o; o.x = pk2(s[0 * 33], s[1 * 33]); o.y = pk2(s[2 * 33], s[3 * 33]); o.z = pk2(s[4 * 33], s[5 * 33]); o.w = pk2(s[6 * 33], s[7 * 33]);
        st_b128(dst + (size_t)n * K + k0 + 8 * c, o); }
    LDS_WAIT();
}
__device__ __forceinline__ void tr_item8(const float* W, int N, int K, int k0, int n0, const float* gain, float scale, unsigned char* dst, LAS float* scr, int lane) {
    const int kr = lane >> 3, c4 = lane & 7;
    f32x4 v[8];
#pragma unroll
    for (int i = 0; i < 8; ++i) v[i] = *(const f32x4*)(W + (size_t)(k0 + 8 * i + kr) * N + n0 + 4 * c4);
#pragma unroll
    for (int i = 0; i < 8; ++i) { const int kk = 8 * i + kr; float g = scale; if (gain) g *= gain[k0 + kk];
        LAS float* d = scr + kk * 33 + 4 * c4; d[0] = v[i].x * g; d[1] = v[i].y * g; d[2] = v[i].z * g; d[3] = v[i].w * g; }
    LDS_WAIT();
    const int c = lane & 7;
#pragma unroll
    for (int j = 0; j < 4; ++j) { const int n = (lane >> 3) + 8 * j; const LAS float* s = scr + (8 * c) * 33 + n;
        v2u o; o.x = pk4_fp8(s[0 * 33], s[1 * 33], s[2 * 33], s[3 * 33]); o.y = pk4_fp8(s[4 * 33], s[5 * 33], s[6 * 33], s[7 * 33]);
        st_b64(dst + (size_t)n * K + k0 + 8 * c, o); }
    LDS_WAIT();
}
constexpr int IT_LAYER = 15360;
__device__ __forceinline__ void prologue_item(const P& p, int it, LAS float* scr, int lane) {
    const int l = it / IT_LAYER; int r = it % IT_LAYER;
    unsigned char* wl = ws_base(p.ws) + WS_W + (size_t)l * WS_WLAYER;
    if (r < 1536) {
        const int seg = r / 768; r %= 768; const int kb = r / 48, nb = r % 48; const int n0 = (seg ? 1544 : 0) + 32 * nb, drow = seg * 1536 + 32 * nb;
        const float sc = drow < 512 ? 0.125f * LOG2E : ((drow >= C_GQ && drow < C_GK) ? 0.125f : 1.f);
        tr_item(p.w_in + (size_t)l * DM * INW, INW, DM, 64 * kb, n0, p.mix_norm + l * DM, sc, (bf16*)(wl + WO_IN) + (size_t)drow * DM, scr, lane); return; }
    r -= 1536;
    if (r < 512) { const int kb = r / 32, nb = r % 32; tr_item(p.w_out + (size_t)l * DM * DM, DM, DM, 64 * kb, 32 * nb, nullptr, 1.f, (bf16*)(wl + WO_OUT) + (size_t)(32 * nb) * DM, scr, lane); return; }
    r -= 512;
    if (r < 256) { const int kb = r / 16, nb = r % 16; tr_item(p.w_xq + (size_t)l * DM * 512, 512, DM, 64 * kb, 32 * nb, p.cross_norm + l * DM, 0.08838834764831845f * LOG2E, (bf16*)(wl + WO_XQ) + (size_t)(32 * nb) * DM, scr, lane); return; }
    r -= 256;
    if (r < 256) { const int kb = r / 32, nb = r % 32; tr_item8(p.w_xo + (size_t)l * 512 * DM, DM, 512, 64 * kb, 32 * nb, nullptr, 32.f, (unsigned char*)(wl + WO_XO) + (size_t)(32 * nb) * 512, scr, lane); return; }
    r -= 256;
    if (r < 512) { const int kv = r / 256; r %= 256; const int kb = r / 16, nb = r % 16;
        tr_item((kv ? p.w_xv : p.w_xk) + (size_t)l * DM * 512, 512, DM, 64 * kb, 32 * nb, nullptr, 1.f, (bf16*)(ws_base(p.ws) + WS_WXKV) + (size_t)(l * 1024 + kv * 512 + 32 * nb) * DM, scr, lane); return; }
    r -= 512;
    if (r < 8192) { const int up = r / 4096; r %= 4096; const int e = r / 256; r %= 256; const int kb = r / 16, nb = r % 16; const int c0 = 32 * nb, drow = (c0 >> 7) * 256 + up * 128 + (c0 & 127);
        tr_item8((up ? p.w_eu : p.w_eg) + ((size_t)l * 16 + e) * DM * 512, 512, DM, 64 * kb, c0, p.moe_norm + l * DM, 32.f, (unsigned char*)(wl + WO_GU) + ((size_t)e * 1024 + drow) * DM, scr, lane); return; }
    r -= 8192;
    { const int e = r / 256; r %= 256; const int kb = r / 32, nb = r % 32;
      tr_item8(p.w_ed + ((size_t)l * 16 + e) * 512 * DM, DM, 512, 64 * kb, 32 * nb, nullptr, 32.f, (unsigned char*)(wl + WO_D) + ((size_t)e * 1024 + 32 * nb) * 512, scr, lane); }
}
__device__ __forceinline__ void row_to_bf16(const float* src, bf16* dst, float* ssq, const float* gain, int lane, int mode) {
    const f32x4* s = (const f32x4*)src + lane;
    f32x4 v[4]; float q = 0.f;
#pragma unroll
    for (int j = 0; j < 4; ++j) { v[j] = s[64 * j]; q += (v[j].x * v[j].x + v[j].y * v[j].y) + (v[j].z * v[j].z + v[j].w * v[j].w); }
    q = wave_sum(q);
    float sc = 1.f;
    if (mode == 1) sc = rsqrtf(q * (1.0f / DM) + EPS);
    v2u* d = (v2u*)dst + lane; float q2 = 0.f;
#pragma unroll
    for (int j = 0; j < 4; ++j) {
        f32x4 g = (f32x4){1.f, 1.f, 1.f, 1.f}; if (mode == 1) g = ((const f32x4*)gain)[lane + 64 * j];
        v2u o; o.x = pk2(v[j].x * sc * g.x, v[j].y * sc * g.y); o.y = pk2(v[j].z * sc * g.z, v[j].w * sc * g.w); st_b64(d + 64 * j, o);
        const float r0 = __builtin_bit_cast(float, o.x << 16), r1 = __builtin_bit_cast(float, o.x & 0xffff0000u), r2 = __builtin_bit_cast(float, o.y << 16), r3 = __builtin_bit_cast(float, o.y & 0xffff0000u);
        q2 += (r0 * r0 + r1 * r1) + (r2 * r2 + r3 * r3); }
    if (mode == 0) { q2 = wave_sum(q2); if (lane < 16) ssq[lane] = lane == 0 ? q2 : 0.f; }
}
__device__ __forceinline__ void prologue(const P& p, LAS unsigned char* lds, int vcu, int G, int wave, int lane) {
    asm volatile("" : "+v"(lane));
    LAS float* scr = (LAS float*)(lds + LDS_STAGE + wave * 16384);
    const int gw = vcu * NWAVES + wave, NGW = G * NWAVES;
    for (int it = gw; it < NLAYER * IT_LAYER; it += NGW) prologue_item(p, it, scr, lane);
    for (int idx = gw * 64 + lane; idx < NLAYER * 2 * 32768; idx += NGW * 64) {
        const int l = idx / 65536, r = idx % 65536, which = r / 32768, e = r % 32768, row = e & 31, k = e >> 5;
        unsigned char* wl = ws_base(p.ws) + WS_W + (size_t)l * WS_WLAYER;
        if (which == 0) {
            float v = 0.f;
            if (row < 8) v = p.w_in[((size_t)l * DM + k) * INW + 1536 + row]; else if (row < 24) v = p.w_in[((size_t)l * DM + k) * INW + 3080 + (row - 8)];
            ((bf16*)(wl + WO_SM))[row * 1024 + k] = (bf16)f2bf(v * p.mix_norm[l * DM + k]);
        }
    }
    router_weights(p, gw * 64 + lane, NGW * 64);
    for (int m = gw; m < 4096; m += NGW) row_to_bf16(p.mem + (size_t)m * DM, WSP(bf16, WS_MEMN) + (size_t)m * DM, nullptr, p.mem_norm, lane, 1);
    { bf16* hbp = WSP(bf16, WS_HB); float* sqp = WSP(float, WS_SSQ);
      for (int m0 = gw * 4; m0 < NTOK; m0 += NGW * 4) {
        f32x4 v[4][4];
#pragma unroll
        for (int r = 0; r < 4; ++r)
#pragma unroll
            for (int j = 0; j < 4; ++j) v[r][j] = ((const f32x4*)(p.x + (size_t)(m0 + r) * DM))[lane + 64 * j];
#pragma unroll
        for (int r = 0; r < 4; ++r) { float q2 = 0.f; v2u* d = (v2u*)(hbp + (size_t)(m0 + r) * DM) + lane;
#pragma unroll
            for (int j = 0; j < 4; ++j) { v2u o; o.x = pk2(v[r][j].x, v[r][j].y); o.y = pk2(v[r][j].z, v[r][j].w); st_b64(d + 64 * j, o);
                const float r0 = __builtin_bit_cast(float, o.x << 16), r1 = __builtin_bit_cast(float, o.x & 0xffff0000u), r2 = __builtin_bit_cast(float, o.y << 16), r3 = __builtin_bit_cast(float, o.y & 0xffff0000u);
                q2 += (r0 * r0 + r1 * r1) + (r2 * r2 + r3 * r3); }
            q2 = wave_sum(q2); if (lane < 16) sqp[(size_t)(m0 + r) * 16 + lane] = lane == 0 ? q2 : 0.f; }
      } }
}
__device__ __forceinline__ void small_proj(const P& p, int l, LAS unsigned char* lds, int vcu, int G, int wave, int lane) {
    asm volatile("" : "+v"(lane));
    const bf16* wsm = (const bf16*)(ws_base(p.ws) + WS_W + (size_t)l * WS_WLAYER + WO_SM);
    const bf16* hb = WSP(bf16, WS_HB); const float* ssq = WSP(float, WS_SSQ); float* sm = WSP(float, WS_SM);
    constexpr int BST = 2048 + 16;
    { const int tid = wave * 64 + lane;
#pragma unroll
      for (int i = 0; i < 8; ++i) { const int idx = tid + NTHR * i, row = idx >> 7, c = idx & 127; *(LAS v4u*)(lds + row * BST + c * 16) = *(const v4u*)(wsm + row * 1024 + c * 8); } }
    __syncthreads();
    const int r = lane & 15, kq = lane >> 4;
    for (int blk = vcu * NWAVES + wave; blk < NTOK / 16; blk += G * NWAVES) {
        const int tok0 = blk * 16;
        const bf16x8* ap = (const bf16x8*)(hb + (size_t)(tok0 + r) * DM + kq * 32);
        pg8::f32x4 acc0 = {0.f, 0.f, 0.f, 0.f}, acc1 = {0.f, 0.f, 0.f, 0.f};
#pragma unroll
        for (int half = 0; half < 2; ++half) {
            bf16x8 af[16];
#pragma unroll
            for (int i = 0; i < 16; ++i) af[i] = ap[(half * 4 + (i >> 2)) * 16 + (i & 3)];
#pragma unroll
            for (int i = 0; i < 16; ++i) { const int s_ = half * 4 + (i >> 2), j = i & 3;
                const bf16x8 b0 = *(const LAS bf16x8*)(lds + r * BST + (128 * s_ + 32 * kq + 8 * j) * 2);
                const bf16x8 b1 = *(const LAS bf16x8*)(lds + (16 + r) * BST + (128 * s_ + 32 * kq + 8 * j) * 2);
                acc0 = __builtin_amdgcn_mfma_f32_16x16x32_bf16(af[i], b0, acc0, 0, 0, 0);
                acc1 = __builtin_amdgcn_mfma_f32_16x16x32_bf16(af[i], b1, acc1, 0, 0, 0);
                if ((i & 3) == 3) __builtin_amdgcn_sched_barrier(0); }
        }
        const float rsv = row_rs(ssq, tok0 + r);
#pragma unroll
        for (int g = 0; g < 4; ++g) { const int trow = 4 * kq + g; const float rs = __shfl(rsv, trow);
            sm[(size_t)(tok0 + trow) * 32 + r] = acc0[g] * rs; if (r < 8) sm[(size_t)(tok0 + trow) * 32 + 16 + r] = acc1[g] * rs; }
    }
    __syncthreads();
}
typedef short v4i16_t __attribute__((ext_vector_type(4)));
typedef __bf16 bf16x2_t __attribute__((ext_vector_type(2)));
typedef float f32x2_t __attribute__((ext_vector_type(2)));
__device__ __forceinline__ unsigned cvtpk(float lo, float hi) { f32x2_t v = {lo, hi}; bf16x2_t b = __builtin_convertvector(v, bf16x2_t); return __builtin_bit_cast(unsigned, b); }
__device__ __forceinline__ bf16x8 pack8(const f32x16& p, int o) {
    v4u w; w.x = cvtpk(p[o], p[o + 1]); w.y = cvtpk(p[o + 2], p[o + 3]); w.z = cvtpk(p[o + 4], p[o + 5]); w.w = cvtpk(p[o + 6], p[o + 7]);
    return __builtin_bit_cast(bf16x8, w);
}
__device__ __forceinline__ float max3f(float a, float b, float c) { float r; asm("v_max3_f32 %0, %1, %2, %3" : "=v"(r) : "v"(a), "v"(b), "v"(c)); return r; }
template <int D, bool FOX, bool OUT8 = false>
__device__ __forceinline__ void attn_unit(LAS unsigned char* lds, const bf16* Qg, int qpitch, const bf16* Kg, const bf16* Vg, int kvpitch, int NT,
                                          const float* cb, int q0, bf16* Og, int opitch, const float* gain, const float* kn) {
    constexpr int KS = D * 2 + 16, VS = D * 2 + 64;
    constexpr int KT = FOX ? 2 : 1, KEYS = 64 * KT;
    constexpr int KBYTES = KEYS * KS, VBYTES = KEYS * VS;
    constexpr int CPR = D / 8, NCH = KEYS * CPR / NTHR, NS = D / 16, NDB = D / 32;
    constexpr int OFF_K = 0, OFF_V = 2 * KBYTES, OFF_CB = 2 * KBYTES + 2 * VBYTES, OFF_FX = OFF_CB + 2 * KEYS * 4;
    int tid = threadIdx.x; asm volatile("" : "+v"(tid));
    const int lane = tid & 63, wave = __builtin_amdgcn_readfirstlane(tid >> 6), r32 = lane & 31, hh = lane >> 5;
    bf16x8 qf[NS];
    { const bf16* qrow = Qg + (size_t)(wave * 32 + r32) * qpitch;
#pragma unroll
      for (int s = 0; s < NS; ++s) qf[s] = *(const bf16x8*)(qrow + 16 * s + 8 * hh); }
    v4u kreg[NCH], vreg[NCH]; f32x4 cbreg = {0.f, 0.f, 0.f, 0.f};
#define AT_GLOAD(t) do { _Pragma("unroll") for (int i_ = 0; i_ < NCH; ++i_) { const int idx_ = tid + NTHR * i_, key_ = idx_ / CPR, c_ = idx_ % CPR; \
        kreg[i_] = *(const v4u*)(Kg + (size_t)((t) * KEYS + key_) * kvpitch + c_ * 8); vreg[i_] = *(const v4u*)(Vg + (size_t)((t) * KEYS + key_) * kvpitch + c_ * 8); } \
        if (FOX && tid < KEYS / 4) cbreg = *(const f32x4*)(cb + (t) * KEYS + tid * 4); } while (0)
#define AT_LSTORE(b) do { _Pragma("unroll") for (int i_ = 0; i_ < NCH; ++i_) { const int idx_ = tid + NTHR * i_, key_ = idx_ / CPR, c_ = idx_ % CPR; \
        *(LAS v4u*)(lds + OFF_K + (b) * KBYTES + key_ * KS + c_ * 16) = kreg[i_]; *(LAS v4u*)(lds + OFF_V + (b) * VBYTES + key_ * VS + c_ * 16) = vreg[i_]; } \
        if (FOX && tid < KEYS / 4) *(LAS f32x4*)(lds + OFF_CB + (b) * (KEYS * 4) + tid * 16) = cbreg; } while (0)
    float m = -INFINITY, l = 0.f;
    f32x16 osum = f32x16{};
    f32x16 o[NDB];
#pragma unroll
    for (int d = 0; d < NDB; ++d) o[d] = f32x16{};
    const int qlo = q0 + wave * 32, qabs = qlo + r32;
    float knpre = 0.f, qkmax = 0.f;
    LAS float* fx = (LAS float*)(lds + OFF_FX);
    const int NTG = NT / KT;
    const int t_first = FOX ? NTG - 1 : 0;
    AT_GLOAD(t_first);
    __syncthreads();
    if (FOX) {
        float qn2 = 0.f;
#pragma unroll
        for (int s = 0; s < NS; ++s)
#pragma unroll
            for (int e = 0; e < 8; ++e) { const float v = __builtin_bit_cast(float, ((unsigned)(unsigned short)qf[s][e]) << 16); qn2 += v * v; }
        qn2 += __shfl_xor(qn2, 32);
        qn2 = wave_max(qn2);
        if (lane == 0) fx[wave] = qn2;
        knpre = lane < 32 ? kn[lane] : 0.f;
#pragma unroll
        for (int o_ = 1; o_ < 32; o_ <<= 1) { const float t_ = __shfl_up(knpre, o_); if (lane >= o_) knpre = fmaxf(knpre, t_); }
    }
    AT_LSTORE(0);
    __syncthreads();
    if (FOX) { float q2 = fx[0];
#pragma unroll
        for (int w_ = 1; w_ < 8; ++w_) q2 = fmaxf(q2, fx[w_]);
        qkmax = sqrtf(q2); }
#pragma unroll 1
    for (int it = 0; it < NTG; ++it) {
        const int b = it & 1;
        const int tg = FOX ? NTG - 1 - it : it;
        const int tn = FOX ? tg - 1 : tg + 1;
        if (it + 1 < NTG) AT_GLOAD(tn);
#pragma unroll
        for (int sub_ = 0; sub_ < KT; ++sub_) {
        const int sub = FOX ? KT - 1 - sub_ : sub_, koff = sub * 64;
        const int kt0 = (tg * KT + sub) * 64;
        if (!FOX || kt0 <= qlo + 31) {
            f32x16 p[2];
#pragma unroll
            for (int kb = 0; kb < 2; ++kb) {
                if (FOX) {
#pragma unroll
                    for (int g = 0; g < 4; ++g) { const f32x4 c4 = *(const LAS f32x4*)(lds + OFF_CB + b * (KEYS * 4) + (koff + kb * 32 + 8 * g + 4 * hh) * 4); p[kb][4 * g] = c4.x; p[kb][4 * g + 1] = c4.y; p[kb][4 * g + 2] = c4.z; p[kb][4 * g + 3] = c4.w; }
                } else p[kb] = f32x16{};
                const LAS unsigned char* kp = lds + OFF_K + b * KBYTES + (koff + kb * 32 + r32) * KS + hh * 16;
#pragma unroll
                for (int s = 0; s < NS; ++s) { const bf16x8 kf = *(const LAS bf16x8*)(kp + s * 32); p[kb] = __builtin_amdgcn_mfma_f32_32x32x16_bf16(kf, qf[s], p[kb], 0, 0, 0); }
            }
            if (FOX && kt0 + 63 > qlo) {
#pragma unroll
                for (int kb = 0; kb < 2; ++kb)
#pragma unroll
                    for (int r = 0; r < 16; ++r) { const int key = kt0 + kb * 32 + (r & 3) + 8 * (r >> 2) + 4 * hh; if (key > qabs) p[kb][r] = -INFINITY; }
            }
            float mt = fmaxf(p[1][0], p[0][0]);
#pragma unroll
            for (int r = 1; r < 16; ++r) mt = max3f(mt, p[0][r], p[1][r]);
            mt = fmaxf(mt, __shfl_xor(mt, 32));
            const float mnew = fmaxf(m, mt);
            float ls = 0.f;
#pragma unroll
            for (int kb = 0; kb < 2; ++kb)
#pragma unroll
                for (int r = 0; r < 16; ++r) { const float e = __builtin_amdgcn_exp2f(p[kb][r] - mnew); p[kb][r] = e; if (!FOX) ls += e; }
            if (!FOX || __builtin_amdgcn_ballot_w64(mnew > m) != 0ull) {
                const float alpha = __builtin_amdgcn_exp2f(m - mnew);
                l *= alpha; if (FOX) osum[0] *= alpha;
#pragma unroll
                for (int d = 0; d < NDB; ++d)
#pragma unroll
                    for (int r = 0; r < 16; ++r) o[d][r] *= alpha;
            }
            m = mnew; l += ls;
            bf16x8 pa[2][2];
#pragma unroll
            for (int kb = 0; kb < 2; ++kb) { pa[kb][0] = pack8(p[kb], 0); pa[kb][1] = pack8(p[kb], 8); }
            const LAS unsigned char* vp = lds + OFF_V + b * VBYTES + (koff + 4 * hh + ((lane & 15) >> 2)) * VS + (16 * ((lane >> 4) & 1) + 4 * (lane & 3)) * 2;
#pragma unroll
            for (int d = 0; d < NDB; ++d) {
#pragma unroll
                for (int kb = 0; kb < 2; ++kb)
#pragma unroll
                    for (int ks = 0; ks < 2; ++ks) {
                        const LAS unsigned char* a0 = vp + (kb * 32 + 16 * ks) * VS + d * 64;
                        const v4i16_t lo = __builtin_amdgcn_ds_read_tr16_b64_v4i16((LAS v4i16_t*)a0);
                        const v4i16_t hi = __builtin_amdgcn_ds_read_tr16_b64_v4i16((LAS v4i16_t*)(a0 + 8 * VS));
                        const bf16x8 vf = (bf16x8){lo[0], lo[1], lo[2], lo[3], hi[0], hi[1], hi[2], hi[3]};
                        o[d] = __builtin_amdgcn_mfma_f32_32x32x16_bf16(vf, pa[kb][ks], o[d], 0, 0, 0);
                    }
            }
            if (FOX) {
                const bf16x8 ones = __builtin_bit_cast(bf16x8, (v4u){0x3F803F80u, 0x3F803F80u, 0x3F803F80u, 0x3F803F80u});
#pragma unroll
                for (int kb = 0; kb < 2; ++kb)
#pragma unroll
                    for (int ks = 0; ks < 2; ++ks) osum = __builtin_amdgcn_mfma_f32_32x32x16_bf16(ones, pa[kb][ks], osum, 0, 0, 0);
            }
        }
        }
        if (FOX) { const float mm = wave_min(m); if (lane == 0) fx[8 + b * 8 + wave] = mm; }
        if (it + 1 < NTG) AT_LSTORE(b ^ 1);
        __syncthreads();
        if (FOX && tg > 0) {
            float M0 = fx[8 + b * 8];
#pragma unroll
            for (int w_ = 1; w_ < 8; ++w_) M0 = fminf(M0, fx[8 + b * 8 + w_]);
            const float cbl = *(const LAS float*)(lds + OFF_CB + (b ^ 1) * (KEYS * 4) + (KEYS - 1) * 4);
            const float knb = __builtin_bit_cast(float, __builtin_amdgcn_readlane(__builtin_bit_cast(int, knpre), tg * KT - 1));
            if (qkmax * knb + cbl < M0 - 40.f) break;
        }
    }
#undef AT_GLOAD
#undef AT_LSTORE
    if (FOX) l = osum[0]; else l += __shfl_xor(l, 32);
    const float inv = 1.0f / l;
    float rs = inv;
    if (FOX) {
        float ss = 0.f;
#pragma unroll
        for (int d = 0; d < NDB; ++d)
#pragma unroll
            for (int r = 0; r < 16; ++r) { const float v = o[d][r] * inv; ss += v * v; }
        ss += __shfl_xor(ss, 32);
        rs = inv * rsqrtf(ss * (1.0f / D) + EPS);
    }
    constexpr int SROW = 144;
    LAS unsigned char* stg = lds + OFF_K + wave * (32 * SROW);
#pragma unroll
    for (int d = 0; d < NDB; ++d)
#pragma unroll
        for (int g = 0; g < 4; ++g) {
            if (OUT8) { *(LAS unsigned*)(stg + r32 * SROW + 32 * d + 8 * g + 4 * hh) = pk4_fp8(o[d][4 * g] * rs, o[d][4 * g + 1] * rs, o[d][4 * g + 2] * rs, o[d][4 * g + 3] * rs); }
            else { f32x4 gn = {1.f, 1.f, 1.f, 1.f}; if (FOX) gn = *(const f32x4*)(gain + 32 * d + 8 * g + 4 * hh);
                v2u w; w.x = cvtpk(o[d][4 * g] * rs * gn.x, o[d][4 * g + 1] * rs * gn.y); w.y = cvtpk(o[d][4 * g + 2] * rs * gn.z, o[d][4 * g + 3] * rs * gn.w);
                *(LAS v2u*)(stg + r32 * SROW + (32 * d + 8 * g + 4 * hh) * 2) = w; }
        }
    static_assert((OUT8 ? D : D * 2) == 128, "stage rows are 128 bytes");
    { unsigned char* ob = (unsigned char*)Og; const size_t pitchb = (size_t)opitch * (OUT8 ? 1 : 2);
#pragma unroll
      for (int i = 0; i < 4; ++i) { const int row = i * 8 + (lane >> 3), ch = lane & 7;
          const v4u w = *(const LAS v4u*)(stg + row * SROW + ch * 16);
          st_b128(ob + (size_t)(wave * 32 + row) * pitchb + ch * 16, w); } }
}
__device__ __forceinline__ void fox_phase(const P& p, int l, LAS unsigned char* lds, int vcu, int G) {
    const bf16* proj = WSP(bf16, WS_PROJ); const float* cb = WSP(float, WS_CB); bf16* y = WSP(bf16, WS_Y);
    for (int pu = vcu; pu < 512; pu += G) {
        const int bh = pu >> 2, pr = pu < 256 ? (pu & 3) : 3 - (pu & 3), b = bh >> 3, h = bh & 7;
        for (int half = 0; half < 2; ++half) {
            const int qb = half ? pr : 7 - pr;
            const size_t row0 = (size_t)b * SEQ;
            attn_unit<64, true>(lds, proj + (row0 + qb * 256) * PW + C_FQ + h * 64, PW, proj + row0 * PW + C_FK + h * 64, proj + row0 * PW + C_FV + h * 64, PW, 4 * (qb + 1),
                                cb + ((size_t)b * 8 + h) * SEQ, qb * 256, y + (row0 + qb * 256) * DM + h * 64, DM, p.fox_gain + l * 512 + h * 64, WSP(const float, WS_MOE + MO_KN) + (b * 8 + h) * 32);
        }
    }
}
__device__ __forceinline__ void xattn_phase(const P& p, int l, LAS unsigned char* lds, int vcu, int G, bool dummy) {
    bf16* xq = WSP(bf16, WS_XQ); const bf16* xkv = WSP(bf16, WS_XKV);
    for (int u = vcu; u < 512; u += G) {
        const int b = u >> 5, h = (u >> 3) & 3, qb = u & 7;
        bf16* qp = xq + ((size_t)b * SEQ + qb * 256) * 512 + h * 128;
        const bf16* kp = xkv + (size_t)b * MEML * 2048 + l * 1024 + h * 128;
        attn_unit<128, false, true>(lds, qp, 512, kp, kp + 512, 2048, 4, nullptr, 0, (bf16*)((dummy ? WSP(unsigned char, WS_Y) : WSP(unsigned char, WS_XO8)) + ((size_t)b * SEQ + qb * 256) * 512 + h * 128), 512, nullptr, nullptr);
    }
}

__device__ __forceinline__ void xattn_pair(const P& p, int l, LAS unsigned char* lds, int pm, int pn, bool dummy) {
    const bf16* xq = WSP(bf16, WS_XQ); const bf16* xkv = WSP(bf16, WS_XKV);
    const int b = pm >> 3;
    for (int hh2 = 0; hh2 < 2; ++hh2) {
        const int h = 2 * pn + hh2;
        const bf16* qp = xq + (size_t)pm * 256 * 512 + h * 128;
        const bf16* kp = xkv + (size_t)b * MEML * 2048 + l * 1024 + h * 128;
        attn_unit<128, false, true>(lds, qp, 512, kp, kp + 512, 2048, 4, nullptr, 0, (bf16*)((dummy ? WSP(unsigned char, WS_Y) : WSP(unsigned char, WS_XO8)) + (size_t)pm * 256 * 512 + h * 128), 512, nullptr, nullptr);
    }
}
constexpr size_t WS_GB = WS_END;
constexpr size_t WS_GDEC = WS_GB + 32 * MiB;
constexpr size_t WS_END2 = WS_GDEC + 1 * MiB;
static_assert(WS_END2 <= 512 * MiB, "workspace map 2");
constexpr int GL_B = 0;
constexpr int GL_TOT = 16384;
constexpr int GL_Q1 = 18432, GL_Q2 = GL_Q1 + 64 * 144, GL_K2 = GL_Q2 + 64 * 144;
constexpr int GL_KD = GL_K2 + 64 * 144;
constexpr int GL_V = GL_KD + 64 * 192;
constexpr int GL_SSQ = GL_V + 64 * 320;
constexpr int GL_GA = GL_SSQ + 1024;
constexpr int GL_YST = GL_GA + 4096;
constexpr int GL_GG = GL_YST + 64 * 272;
constexpr int GL_END = GL_GG + 64 * 272;
static_assert(GL_END <= 131072, "gla lds");

__device__ __forceinline__ float fast_log_sigmoid(float z) { return fminf(z, 0.f) - __logf(1.f + __expf(-fabsf(z))); }
__device__ __forceinline__ void gla_decay(const P& p, int l, int h, size_t tok0, LAS unsigned char* lds, int lane, int wave) {
    const float* sm = WSP(float, WS_SM);
    float w[16];
#pragma unroll
    for (int r = 0; r < 16; ++r) w[r] = p.w_alpha_up[((size_t)l * 16 + r) * 256 + h * 64 + lane];
    const float bias = p.b_alpha[l * 256 + h * 64 + lane];
    LAS f32x4* gat = (LAS f32x4*)(lds + GL_GA + wave * 512);
    if (lane < 32) gat[lane] = *(const f32x4*)(sm + (tok0 + wave * 8 + (lane >> 2)) * 32 + 8 + 4 * (lane & 3));
    float bl[8]; float run = 0.f;
#pragma unroll
    for (int j = 0; j < 8; ++j) {
        float z = bias;
#pragma unroll
        for (int r4 = 0; r4 < 4; ++r4) { const f32x4 g4 = gat[j * 4 + r4]; z += g4.x * w[4 * r4] + g4.y * w[4 * r4 + 1] + g4.z * w[4 * r4 + 2] + g4.w * w[4 * r4 + 3]; }
        run += fast_log_sigmoid(z) * (1.0f / 16.0f); bl[j] = run;
    }
    LAS float* tot = (LAS float*)(lds + GL_TOT);
    tot[wave * 64 + lane] = run;
    __syncthreads();
    float pre = 0.f;
#pragma unroll
    for (int g = 0; g < 8; ++g) { const float t = tot[g * 64 + lane]; if (g < wave) pre += t; }
    LAS float* Bm = (LAS float*)(lds + GL_B);
#pragma unroll
    for (int j = 0; j < 8; ++j) Bm[(wave * 8 + j) * 64 + lane] = bl[j] + pre;
    __syncthreads();
}
__device__ __forceinline__ void gla_load_v(const bf16* proj, size_t tok0, int h, LAS unsigned char* lds, int tid) {
#pragma unroll
    for (int i = 0; i < 2; ++i) { const int idx = tid + NTHR * i, t = idx >> 4, c = idx & 15;
        *(LAS v4u*)(lds + GL_V + t * 320 + c * 16) = *(const v4u*)(proj + (tok0 + t) * PW + C_GV + h * 128 + c * 8); }
}
__device__ __forceinline__ bf16x8 tr_frag(const LAS unsigned char* a0, int rowstride4) {
    const v4i16_t lo = __builtin_amdgcn_ds_read_tr16_b64_v4i16((LAS v4i16_t*)a0);
    const v4i16_t hi = __builtin_amdgcn_ds_read_tr16_b64_v4i16((LAS v4i16_t*)(a0 + rowstride4));
    return (bf16x8){lo[0], lo[1], lo[2], lo[3], hi[0], hi[1], hi[2], hi[3]};
}
__device__ __forceinline__ void gla_phase_a(const P& p, int l, LAS unsigned char* lds, int vcu, int G) {
    int tid = threadIdx.x; asm volatile("" : "+v"(tid));
    const int lane = tid & 63, wave = __builtin_amdgcn_readfirstlane(tid >> 6), hh = lane >> 5;
    const bf16* proj = WSP(bf16, WS_PROJ); float* loc = ((float*)p.out); float* dec = WSP(float, WS_GDEC); const float* sm = WSP(float, WS_SM); float* gb = WSP(float, WS_GB);
    LAS unsigned char* kd = lds + wave * 16384; LAS unsigned char* vh = kd + 8192;
    const int crow8 = lane >> 3, cch = lane & 7;
    const int trow = (lane & 15) >> 2, tcol = 16 * ((lane >> 4) & 1) + 4 * (lane & 3);
    for (int u = vcu * NWAVES + wave; u < 2048; u += G * NWAVES) {
        const int c = u & 31, h = (u >> 5) & 3, b = u >> 7;
        const size_t tok0 = (size_t)b * SEQ + c * 64;
        v4u kreg[8], v0reg[8], v1reg[8];
#pragma unroll
        for (int i = 0; i < 8; ++i) { const bf16* rp = proj + (tok0 + i * 8 + crow8) * PW;
            kreg[i] = *(const v4u*)(rp + C_GK + h * 64 + cch * 8); v0reg[i] = *(const v4u*)(rp + C_GV + h * 128 + cch * 8); v1reg[i] = *(const v4u*)(rp + C_GV + h * 128 + 64 + cch * 8); }
        float w[16];
#pragma unroll
        for (int r = 0; r < 16; ++r) w[r] = p.w_alpha_up[((size_t)l * 16 + r) * 256 + h * 64 + lane];
        const float bias = p.b_alpha[l * 256 + h * 64 + lane];
        { LAS f32x4* gw = (LAS f32x4*)vh;
#pragma unroll
          for (int i = 0; i < 4; ++i) gw[lane * 4 + i] = *(const f32x4*)(sm + (tok0 + lane) * 32 + 8 + 4 * i); }
        float bt[64]; float run = 0.f;
#pragma unroll
        for (int t = 0; t < 64; ++t) {
            float z = bias;
#pragma unroll
            for (int r4 = 0; r4 < 4; ++r4) { const f32x4 g4 = ((const LAS f32x4*)vh)[t * 4 + r4]; z += g4.x * w[4 * r4] + g4.y * w[4 * r4 + 1] + g4.z * w[4 * r4 + 2] + g4.w * w[4 * r4 + 3]; }
            run += fast_log_sigmoid(z) * (1.0f / 16.0f); bt[t] = run; gb[(tok0 + t) * 256 + h * 64 + lane] = run;
        }
#pragma unroll
        for (int i = 0; i < 8; ++i) { *(LAS v4u*)(kd + (i * 8 + crow8) * 128 + cch * 16) = kreg[i]; *(LAS v4u*)(vh + (i * 8 + crow8) * 128 + cch * 16) = v0reg[i]; }
#pragma unroll
        for (int t = 0; t < 64; ++t) { LAS bf16* kp = (LAS bf16*)(kd + t * 128 + lane * 2); *kp = (bf16)f2bf(bf2f(*kp) * __expf(run - bt[t])); }
        dec[(size_t)u * 64 + lane] = __expf(run);
#pragma unroll
        for (int half = 0; half < 2; ++half) {
            if (half == 1) {
#pragma unroll
                for (int i = 0; i < 8; ++i) *(LAS v4u*)(vh + (i * 8 + crow8) * 128 + cch * 16) = v1reg[i];
            }
            f32x16 acc[2][2];
#pragma unroll
            for (int x = 0; x < 2; ++x)
#pragma unroll
                for (int y = 0; y < 2; ++y) acc[x][y] = f32x16{};
#pragma unroll
            for (int s = 0; s < 4; ++s) {
                bf16x8 af[2], bfr[2];
#pragma unroll
                for (int x = 0; x < 2; ++x) { af[x] = tr_frag(vh + (16 * s + 8 * hh + trow) * 128 + (32 * x + tcol) * 2, 4 * 128); bfr[x] = tr_frag(kd + (16 * s + 8 * hh + trow) * 128 + (32 * x + tcol) * 2, 4 * 128); }
#pragma unroll
                for (int x = 0; x < 2; ++x)
#pragma unroll
                    for (int y = 0; y < 2; ++y) acc[x][y] = __builtin_amdgcn_mfma_f32_32x32x16_bf16(af[x], bfr[y], acc[x][y], 0, 0, 0);
            }
#pragma unroll
            for (int x = 0; x < 2; ++x)
#pragma unroll
                for (int y = 0; y < 2; ++y) { float* lo = loc + (size_t)u * 8192 + 32 * y + (lane & 31);
#pragma unroll
                    for (int r = 0; r < 16; ++r) lo[(size_t)(64 * half + 32 * x + (r & 3) + 8 * (r >> 2) + 4 * hh) * 64] = acc[x][y][r]; }
        }
    }
}
__device__ __forceinline__ void gla_phase_b(const P& p, int vcu, int G) {
    int tid = threadIdx.x; asm volatile("" : "+v"(tid));
    const float* loc = ((const float*)p.out); const float* dec = WSP(float, WS_GDEC); bf16* gs = (bf16*)((unsigned char*)p.out + 96 * MiB);
    for (int u = vcu; u < 256; u += G) {
        const int bh = u >> 2, q4 = u & 3;
        const int e = q4 * 2048 + tid * 4, dk = e & 63;
        f32x4 st = {0.f, 0.f, 0.f, 0.f};
#pragma unroll 8
        for (int c = 0; c < 32; ++c) {
            const size_t cu = (size_t)bh * 32 + c;
            const f32x4 lv = *(const f32x4*)(loc + cu * 8192 + e);
            const f32x4 dv = *(const f32x4*)(dec + cu * 64 + dk);
            v2u w; w.x = pk2(st.x, st.y); w.y = pk2(st.z, st.w);
            *(v2u*)(gs + cu * 8192 + e) = w;
            st = dv * st + lv;
        }
    }
}
__device__ __forceinline__ void gla_phase_c(const P& p, int l, LAS unsigned char* lds, int vcu, int G) {
    int tid = threadIdx.x; asm volatile("" : "+v"(tid));
    const int lane = tid & 63, wave = __builtin_amdgcn_readfirstlane(tid >> 6), hh = lane >> 5, r32 = lane & 31;
    const bf16* proj = WSP(bf16, WS_PROJ); const bf16* gs = (const bf16*)((const unsigned char*)p.out + 96 * MiB); bf16* y = WSP(bf16, WS_Y); const float* gb = WSP(const float, WS_GB);
    const int dvb = wave >> 1, tb = wave & 1;
    const int trow = (lane & 15) >> 2, tcol = 16 * ((lane >> 4) & 1) + 4 * (lane & 3);
    bf16 n_q[8], n_k[8]; v4u n_v[2], n_g[2]; bf16x8 n_s[4]; f32x4 n_n[4]; float n_b[8], n_r = 0.f;
#define GC_LOAD(uu) do { const int c_ = (uu) & 31, h_ = ((uu) >> 5) & 3, b_ = (uu) >> 7; const size_t t0_ = (size_t)b_ * SEQ + c_ * 64; \
        _Pragma("unroll") for (int j = 0; j < 8; ++j) { const bf16* rp = proj + (t0_ + wave * 8 + j) * PW + h_ * 64 + lane; n_q[j] = rp[C_GQ]; n_k[j] = rp[C_GK]; } \
        _Pragma("unroll") for (int i = 0; i < 2; ++i) { const int idx = tid + NTHR * i, t = idx >> 4, cc = idx & 15; n_v[i] = *(const v4u*)(proj + (t0_ + t) * PW + C_GV + h_ * 128 + cc * 8); n_g[i] = *(const v4u*)(proj + (t0_ + t) * PW + C_GG + h_ * 128 + cc * 8); } \
        { const bf16* sp = gs + (size_t)(uu) * 8192 + (size_t)(32 * dvb + r32) * 64 + 8 * hh; \
          _Pragma("unroll") for (int s2 = 0; s2 < 4; ++s2) n_s[s2] = *(const bf16x8*)(sp + 16 * s2); } \
        _Pragma("unroll") for (int j = 0; j < 8; ++j) n_b[j] = gb[(t0_ + wave * 8 + j) * 256 + h_ * 64 + lane]; \
        n_r = gb[(t0_ + 31) * 256 + h_ * 64 + lane]; \
        _Pragma("unroll") for (int g = 0; g < 4; ++g) { const int dv = 32 * dvb + 8 * g + 4 * hh; \
            n_n[g] = *(const f32x4*)(p.gla_gain + l * 512 + h_ * 128 + dv); } } while (0)
    if (vcu < 2048) GC_LOAD(vcu);
    __syncthreads();
    for (int u = vcu; u < 2048; u += G) {
        const int c = u & 31, h = (u >> 5) & 3, b = u >> 7;
        const size_t tok0 = (size_t)b * SEQ + c * 64;
        bf16x8 sfr[4]; f32x4 gnr[4];
#pragma unroll
        for (int i = 0; i < 4; ++i) { sfr[i] = n_s[i]; gnr[i] = n_n[i]; }
#pragma unroll
        for (int i = 0; i < 2; ++i) { const int idx = tid + NTHR * i, t = idx >> 4, cc = idx & 15; *(LAS v4u*)(lds + GL_V + t * 320 + cc * 16) = n_v[i]; *(LAS v4u*)(lds + GL_GG + t * 272 + cc * 16) = n_g[i]; }
        { const float rref = n_r;
#pragma unroll
          for (int j = 0; j < 8; ++j) { const int t = wave * 8 + j; const float bt = n_b[j];
            const float qv = bf2f(n_q[j]), kv = bf2f(n_k[j]);
            *(LAS bf16*)(lds + GL_Q1 + t * 144 + lane * 2) = (bf16)f2bf(qv * __expf(bt));
            *(LAS bf16*)(lds + GL_Q2 + t * 144 + lane * 2) = (bf16)f2bf(qv * __expf(bt - rref));
            *(LAS bf16*)(lds + GL_K2 + t * 144 + lane * 2) = (bf16)f2bf(kv * __expf(rref - bt)); } }
        __syncthreads();
        if (u + G < 2048) GC_LOAD(u + G);
        f32x16 o = {};
        {
#pragma unroll
          for (int s = 0; s < 4; ++s) { const bf16x8 af = sfr[s]; const bf16x8 bq = *(const LAS bf16x8*)(lds + GL_Q1 + (32 * tb + r32) * 144 + (16 * s + 8 * hh) * 2);
              o = __builtin_amdgcn_mfma_f32_32x32x16_bf16(af, bq, o, 0, 0, 0); } }
#pragma unroll
        for (int sb = 0; sb < 2; ++sb) {
            if (sb <= tb) {
                f32x16 pt = {};
#pragma unroll
                for (int s = 0; s < 4; ++s) { const bf16x8 ak = *(const LAS bf16x8*)(lds + GL_K2 + (32 * sb + r32) * 144 + (16 * s + 8 * hh) * 2); const bf16x8 bq = *(const LAS bf16x8*)(lds + GL_Q2 + (32 * tb + r32) * 144 + (16 * s + 8 * hh) * 2);
                    pt = __builtin_amdgcn_mfma_f32_32x32x16_bf16(ak, bq, pt, 0, 0, 0); }
                if (sb == tb) {
#pragma unroll
                    for (int r = 0; r < 16; ++r) { const int s_ = (r & 3) + 8 * (r >> 2) + 4 * hh; if (s_ > r32) pt[r] = 0.f; }
                }
#pragma unroll
                for (int ks = 0; ks < 2; ++ks) {
                    const bf16x8 pa = pack8(pt, 8 * ks);
                    const bf16x8 vf = tr_frag(lds + GL_V + (32 * sb + 16 * ks + 4 * hh + trow) * 320 + (32 * dvb + tcol) * 2, 8 * 320);
                    o = __builtin_amdgcn_mfma_f32_32x32x16_bf16(vf, pa, o, 0, 0, 0);
                }
            }
        }
        float ss = 0.f;
#pragma unroll
        for (int r = 0; r < 16; ++r) ss += o[r] * o[r];
        ss += __shfl_xor(ss, 32);
        LAS float* sq = (LAS float*)(lds + GL_SSQ);
        if (hh == 0) sq[dvb * 64 + 32 * tb + r32] = ss;
        __syncthreads();
        const int t = 32 * tb + r32;
        const float tot = (sq[t] + sq[64 + t]) + (sq[128 + t] + sq[192 + t]);
        const float rs = rsqrtf(tot * (1.0f / 128.0f) + EPS);
#pragma unroll
        for (int g = 0; g < 4; ++g) {
            const int dv = 32 * dvb + 8 * g + 4 * hh;
            const f32x4 gn = gnr[g];
            const v2u gg = *(const LAS v2u*)(lds + GL_GG + t * 272 + dv * 2);
            const float g0 = bf2f((bf16)(gg.x & 0xffff)), g1 = bf2f((bf16)(gg.x >> 16)), g2 = bf2f((bf16)(gg.y & 0xffff)), g3 = bf2f((bf16)(gg.y >> 16));
            const float v0 = o[4 * g] * rs * gn.x * g0 * __builtin_amdgcn_rcpf(1.f + __expf(-g0)), v1 = o[4 * g + 1] * rs * gn.y * g1 * __builtin_amdgcn_rcpf(1.f + __expf(-g1));
            const float v2 = o[4 * g + 2] * rs * gn.z * g2 * __builtin_amdgcn_rcpf(1.f + __expf(-g2)), v3 = o[4 * g + 3] * rs * gn.w * g3 * __builtin_amdgcn_rcpf(1.f + __expf(-g3));
            v2u w; w.x = cvtpk(v0, v1); w.y = cvtpk(v2, v3);
            *(LAS v2u*)(lds + GL_YST + t * 272 + dv * 2) = w;
        }
        __syncthreads();
#pragma unroll
        for (int i = 0; i < 2; ++i) { const int idx = tid + NTHR * i, tr_ = idx >> 4, ch = idx & 15;
            st_b128(y + (tok0 + tr_) * DM + 512 + h * 128 + ch * 8, *(const LAS v4u*)(lds + GL_YST + tr_ * 272 + ch * 16)); }
    }
#undef GC_LOAD
}
__device__ __forceinline__ void fox_cumsum_phase(const P& p, int l, LAS unsigned char* lds, int vcu, int G) {
    int tid = threadIdx.x; asm volatile("" : "+v"(tid));
    const int lane = tid & 63, wave = __builtin_amdgcn_readfirstlane(tid >> 6);
    const float* sm = WSP(float, WS_SM); float* cb = WSP(float, WS_CB);
    LAS float* tot = (LAS float*)(lds + 256);
    for (int u = vcu; u < NBATCH * 8; u += G) {
        const int b = u >> 3, h = u & 7;
        const float bias = p.b_forget[l * 8 + h];
        const int s0 = wave * 256 + lane * 4;
        float v[4]; float run = 0.f;
#pragma unroll
        for (int j = 0; j < 4; ++j) v[j] = sm[((size_t)b * SEQ + s0 + j) * 32 + h];
#pragma unroll
        for (int j = 0; j < 4; ++j) { run += fast_log_sigmoid(v[j] + bias); v[j] = run; }
        float pre = run;
#pragma unroll
        for (int o = 1; o < 64; o <<= 1) { const float t = __shfl_up(pre, o); if (lane >= o) pre += t; }
        __syncthreads();
        if (lane == 63) tot[wave] = pre;
        __syncthreads();
        float base = pre - run;
#pragma unroll
        for (int w_ = 0; w_ < 8; ++w_) { const float t = tot[w_]; if (w_ < wave) base += t; }
        f32x4 o4; o4.x = -(v[0] + base) * LOG2E; o4.y = -(v[1] + base) * LOG2E; o4.z = -(v[2] + base) * LOG2E; o4.w = -(v[3] + base) * LOG2E;
        *(f32x4*)(cb + ((size_t)b * 8 + h) * SEQ + s0) = o4;
    }
}
__device__ __forceinline__ void fox_knorm_phase(const P& p, int vcu, int G) {
    int tid = threadIdx.x; asm volatile("" : "+v"(tid));
    const int lane = tid & 63, wave = __builtin_amdgcn_readfirstlane(tid >> 6);
    const bf16* proj = WSP(bf16, WS_PROJ); float* kn = WSP(float, WS_MOE + MO_KN);
    for (int task = vcu * NWAVES + wave; task < NBATCH * 8 * 32; task += G * NWAVES) {
        const int j = task & 31, h = (task >> 5) & 7, b = task >> 8;
        float mx = 0.f;
#pragma unroll
        for (int i = 0; i < 8; ++i) {
            const v4u w = *(const v4u*)(proj + ((size_t)b * SEQ + j * 64 + i * 8 + (lane >> 3)) * PW + C_FK + h * 64 + (lane & 7) * 8);
            const unsigned ww[4] = {w.x, w.y, w.z, w.w}; float ss = 0.f;
#pragma unroll
            for (int e = 0; e < 4; ++e) { const float a = __builtin_bit_cast(float, ww[e] << 16), c = __builtin_bit_cast(float, ww[e] & 0xffff0000u); ss += a * a + c * c; }
            ss += __shfl_xor(ss, 1); ss += __shfl_xor(ss, 2); ss += __shfl_xor(ss, 4);
            mx = fmaxf(mx, ss);
        }
        mx = wave_max(mx);
        if (lane == 0) kn[task] = sqrtf(mx) * 1.0001f;
    }
}
__device__ __forceinline__ void router_weights(const P& p, int gtid, int gstride) {
    for (int idx = gtid; idx < NLAYER * 32768; idx += gstride) {
        const int l = idx >> 15, r = idx & 32767, k = r >> 5, n = r & 31;
        float v = 0.f;
        if (n < 16) v = p.w_re[((size_t)l * DM + k) * 16 + n]; else if (n < 20) v = p.w_rg[((size_t)l * DM + k) * 4 + (n - 16)];
        v *= p.moe_norm[l * DM + k];
        float* wr = (float*)(ws_base(p.ws) + WS_W + (size_t)l * WS_WLAYER + WO_RHI);
        wr[((((k >> 5) * 4 + ((k >> 3) & 3)) * 2 + ((k >> 2) & 1)) * 32 + n) * 4 + (k & 3)] = v;
    }
}
__device__ __forceinline__ void route_phase(const P& p, int l, LAS unsigned char* lds, int vcu, int G) {
    int tid = threadIdx.x; asm volatile("" : "+v"(tid));
    const int lane = tid & 63, wave = __builtin_amdgcn_readfirstlane(tid >> 6);
    { const v4u* src = (const v4u*)(ws_base(p.ws) + WS_W + (size_t)l * WS_WLAYER + WO_RHI);
#pragma unroll 4
      for (int i = 0; i < 16; ++i) *(LAS v4u*)(lds + LDS_STAGE + (tid + NTHR * i) * 16) = src[tid + NTHR * i]; }
    LAS int* hist = (LAS int*)(lds + LDS_GATE);
    if (tid < 32) hist[tid] = 0;
    __syncthreads();
    const bf16* HBp = WSP(const bf16, WS_HB);
    int2* toke = WSP(int2, WS_MOE + MO_TOKE); float2* tokg = WSP(float2, WS_MOE + MO_TOKG);
    LAS float* lgb = (LAS float*)(lds + LDS_RS + wave * 2048);
    const int r = lane & 15, kq = lane >> 4;
    for (int task = vcu * NWAVES + wave; task < NTOK / 16; task += G * NWAVES) {
        const int tok0 = task * 16;
        const v4u* hp = (const v4u*)(HBp + (size_t)(tok0 + r) * DM + 8 * kq);
        f32x4 acc0 = {0.f, 0.f, 0.f, 0.f}, acc1 = {0.f, 0.f, 0.f, 0.f}; float q = 0.f;
#pragma unroll 8
        for (int s = 0; s < 32; ++s) {
            const v4u aw = hp[4 * s];
            const unsigned ww[4] = {aw.x, aw.y, aw.z, aw.w};
            const LAS unsigned char* bp = lds + LDS_STAGE + ((s * 4 + kq) * 2 * 32 + r) * 16;
            const f32x4 b00 = *(const LAS f32x4*)(bp), b01 = *(const LAS f32x4*)(bp + 32 * 16), b10 = *(const LAS f32x4*)(bp + 16 * 16), b11 = *(const LAS f32x4*)(bp + 48 * 16);
#pragma unroll
            for (int e = 0; e < 4; ++e) {
                const float a0 = __builtin_bit_cast(float, ww[e] << 16), a1 = __builtin_bit_cast(float, ww[e] & 0xffff0000u);
                q += a0 * a0 + a1 * a1;
                const f32x4& bl = e < 2 ? b00 : b01; const f32x4& bh = e < 2 ? b10 : b11;
                acc0 = __builtin_amdgcn_mfma_f32_16x16x4f32(a0, bl[(2 * e) & 3], acc0, 0, 0, 0); acc1 = __builtin_amdgcn_mfma_f32_16x16x4f32(a0, bh[(2 * e) & 3], acc1, 0, 0, 0);
                acc0 = __builtin_amdgcn_mfma_f32_16x16x4f32(a1, bl[(2 * e + 1) & 3], acc0, 0, 0, 0); acc1 = __builtin_amdgcn_mfma_f32_16x16x4f32(a1, bh[(2 * e + 1) & 3], acc1, 0, 0, 0);
            }
        }
        q += __shfl_xor(q, 16); q += __shfl_xor(q, 32);
        const float rsv = rsqrtf(q * (1.0f / DM) + EPS);
        const float bias0 = p.b_re[l * 16 + r], bias1 = r < 4 ? p.b_rg[l * 4 + r] : 0.f;
#pragma unroll
        for (int g = 0; g < 4; ++g) { const int row = 4 * kq + g; const float rs = __shfl(rsv, row);
            lgb[row * 32 + r] = acc0[g] * rs + bias0; lgb[row * 32 + 16 + r] = acc1[g] * rs + bias1; }
        LDS_WAIT();
        if (lane < 16) {
            const int tok = tok0 + lane;
            const LAS f32x4* lr = (const LAS f32x4*)(lgb + lane * 32);
            const f32x4 e0 = lr[0], e1 = lr[1], e2 = lr[2], e3 = lr[3], gl = lr[4];
            int g = 0; float gm = gl.x;
            if (gl.y > gm) { gm = gl.y; g = 1; } if (gl.z > gm) { gm = gl.z; g = 2; } if (gl.w > gm) { gm = gl.w; g = 3; }
            const float den = (expf(gl.x - gm) + expf(gl.y - gm)) + (expf(gl.z - gm) + expf(gl.w - gm));
            const float pg = 1.0f / den;
            const f32x4 el = g == 0 ? e0 : (g == 1 ? e1 : (g == 2 ? e2 : e3));
            int i0 = 0; float m0 = el.x;
            if (el.y > m0) { m0 = el.y; i0 = 1; } if (el.z > m0) { m0 = el.z; i0 = 2; } if (el.w > m0) { m0 = el.w; i0 = 3; }
            int i1 = -1; float m1 = -INFINITY;
            if (i0 != 0 && el.x > m1) { m1 = el.x; i1 = 0; } if (i0 != 1 && el.y > m1) { m1 = el.y; i1 = 1; }
            if (i0 != 2 && el.z > m1) { m1 = el.z; i1 = 2; } if (i0 != 3 && el.w > m1) { m1 = el.w; i1 = 3; }
            const float ex = expf(m1 - m0), inv = 1.0f / (1.0f + ex);
            const int ea = g * 4 + i0, eb = g * 4 + i1;
            toke[tok] = make_int2(ea, eb); tokg[tok] = make_float2(pg * inv, pg * ex * inv);
            atomicAdd((int*)&hist[ea], 1); atomicAdd((int*)&hist[16 + eb], 1);
        }
        LDS_WAIT();
    }
    __syncthreads();
    if (tid < 32) WSP(int, WS_MOE + MO_HIST)[vcu * 32 + tid] = hist[tid];
}
__device__ __forceinline__ void sort_phase(const P& p, LAS unsigned char* lds, int vcu, int G) {
    int tid = threadIdx.x; asm volatile("" : "+v"(tid));
    const int lane = tid & 63, wave = __builtin_amdgcn_readfirstlane(tid >> 6);
    LAS int* cnt = (LAS int*)(lds + LDS_GATE); LAS int* pre = cnt + 32; LAS int* base = cnt + 64; LAS int* ntl = cnt + 96;
    const int* histg = WSP(const int, WS_MOE + MO_HIST);
    int* rowtok = WSP(int, WS_MOE + MO_ROWTOK); float* rowgate = WSP(float, WS_MOE + MO_ROWGATE); int* tilee = WSP(int, WS_MOE + MO_TILEE); int* nt = WSP(int, WS_MOE + MO_NT);
    const int2* toke = WSP(const int2, WS_MOE + MO_TOKE); const float2* tokg = WSP(const float2, WS_MOE + MO_TOKG);
    { LAS int* part = (LAS int*)(lds + LDS_RS);
      const int j = tid & 31, part_i = tid >> 5; int c = 0, pr = 0;
      for (int w = part_i; w < G; w += 16) { const int v = histg[w * 32 + j]; if (w < vcu) pr += v; c += v; }
      part[part_i * 64 + j] = c; part[part_i * 64 + 32 + j] = pr;
      __syncthreads();
      if (tid < 32) { int cc = 0, pp = 0;
#pragma unroll
          for (int q = 0; q < 16; ++q) { cc += part[q * 64 + tid]; pp += part[q * 64 + 32 + tid]; }
          cnt[tid] = cc; pre[tid] = pp; } }
    __syncthreads();
    if (tid == 0) { int t = 0; for (int j = 0; j < 32; ++j) { base[j] = t * 256; const int n = (cnt[j] + 255) >> 8; ntl[j] = n; t += n; if (j == 15 && vcu == 0) nt[0] = t; } if (vcu == 0) nt[1] = t; }
    __syncthreads();
    if (vcu == 0 && tid < 32) { const int t0 = base[tid] >> 8; for (int i = 0; i < ntl[tid]; ++i) tilee[t0 + i] = tid & 15; }
    if (vcu < 32) { const int j = vcu, lo = base[j] + cnt[j], hi = base[j] + 256 * ntl[j]; for (int r = lo + tid; r < hi; r += NTHR) { rowtok[r] = -1; rowgate[r] = 0.f; } }
    if (wave < 2) {
        const int k = wave;
        int run[16];
#pragma unroll
        for (int e = 0; e < 16; ++e) run[e] = 0;
        for (int task0 = vcu * NWAVES; task0 < NTOK / 16; task0 += G * NWAVES) {
#pragma unroll 1
            for (int half = 0; half < 2; ++half) {
                const int tok = task0 * 16 + half * 64 + lane;
                const int2 ee = toke[tok]; const float2 gg = tokg[tok];
                const int e = k ? ee.y : ee.x; const float gt = k ? gg.y : gg.x;
                int rank = 0;
#pragma unroll
                for (int x = 0; x < 16; ++x) { const unsigned long long m = __ballot(e == x); if (e == x) rank = run[x] + __popcll(m & ((1ull << lane) - 1ull)); run[x] += __popcll(m); }
                const int pos = base[k * 16 + e] + pre[k * 16 + e] + rank;
                rowtok[pos] = tok; rowgate[pos] = gt;
            }
        }
    }
}
__device__ __forceinline__ void final_phase(const P& p, int vcu, int G) {
    int tid = threadIdx.x; asm volatile("" : "+v"(tid));
    const int lane = tid & 63, wave = __builtin_amdgcn_readfirstlane(tid >> 6);
    const float* ssq = WSP(const float, WS_SSQ); const bf16* hb = WSP(const bf16, WS_HB);
    f32x4 g[4];
#pragma unroll
    for (int j = 0; j < 4; ++j) g[j] = ((const f32x4*)p.final_norm)[lane + 64 * j];
    for (int m0 = (vcu * NWAVES + wave) * 4; m0 < NTOK; m0 += G * NWAVES * 4) {
        v2u w[4][4]; float rs[4];
#pragma unroll
        for (int r = 0; r < 4; ++r) { rs[r] = row_rs(ssq, m0 + r);
#pragma unroll
            for (int j = 0; j < 4; ++j) w[r][j] = ((const v2u*)(hb + (size_t)(m0 + r) * DM))[lane + 64 * j]; }
#pragma unroll
        for (int r = 0; r < 4; ++r) { f32x4* s = (f32x4*)(p.out + (size_t)(m0 + r) * DM) + lane;
#pragma unroll
            for (int j = 0; j < 4; ++j) { f32x4 v; v.x = __builtin_bit_cast(float, w[r][j].x << 16); v.y = __builtin_bit_cast(float, w[r][j].x & 0xffff0000u); v.z = __builtin_bit_cast(float, w[r][j].y << 16); v.w = __builtin_bit_cast(float, w[r][j].y & 0xffff0000u);
                s[64 * j] = v * rs[r] * g[j]; } }
    }
}
#ifndef ENMASK
#define ENMASK 0xffffffffu
#endif
#define EN(b) (((ENMASK) >> (b)) & 1u)
#ifndef REPMASK
#define REPMASK 0u
#endif
#define REPN(b) ((((REPMASK) >> (b)) & 1u) ? 2 : 1)
__device__ __attribute__((noinline)) void grid_barrier(unsigned* barw, unsigned x, volatile LAS unsigned* st) { XcdBarrier b; b.bar = barw; b.x = x; b.st = st; xcd_barrier(b); }
__global__ void __launch_bounds__(NTHR, 2) fwd(Args args) {
    extern __shared__ __attribute__((aligned(16))) unsigned char lds_raw[];
    LAS unsigned char* lds = (LAS unsigned char*)lds_raw;
    const P& p = args.p;
    const int tid = threadIdx.x, lane = tid & 63, wave = __builtin_amdgcn_readfirstlane(tid >> 6);
    const int G = gridDim.x; const int bx = blockIdx.x; const int vcu = (G % 8 == 0) ? (bx % 8) * (G / 8) + bx / 8 : bx;
    volatile LAS unsigned* MISC = (volatile LAS unsigned*)(lds + LDS_MISC);
    if (tid < 64) MISC[tid] = 0u;
    __syncthreads();
    unsigned* ctl = (unsigned*)(p.ws + WS_CTL);
    const int lo = args.ph_lo, hi = args.ph_hi;
    XcdBarrier bar; bar.bar = ctl + CW_BAR + args.li * XCD_BAR_WORDS; bar.x = 0; bar.st = nullptr;
    if (hi - lo > 1) bar = xcd_barrier_post(ctl + CW_BAR + args.li * XCD_BAR_WORDS, MISC);
#define IN(k) (lo <= (k) && (k) < hi)
#define PHL int vcuL = vcu, GL = G, bxL = bx; asm volatile("" : "+s"(vcuL), "+s"(GL), "+s"(bxL)); (void)vcuL; (void)GL; (void)bxL;
#define LTID(v) int v = threadIdx.x; asm volatile("" : "+v"(v))
#define FILL_RS_DENSE() do { LTID(tq); const int rr_ = tq & 255, hf_ = tq >> 8; f32x4 sv_[4][4]; bool ok_[4]; \
        _Pragma("unroll") for (int k_ = 0; k_ < 4; ++k_) { pg8::Unit u_; ok_[k_] = S.next(hf_ + 2 * k_, u_); const f32x4* sp_ = (const f32x4*)(SSQ + (size_t)(ok_[k_] ? u_.pm * 256 + rr_ : 0) * 16); \
            _Pragma("unroll") for (int j_ = 0; j_ < 4; ++j_) sv_[k_][j_] = sp_[j_]; } \
        _Pragma("unroll") for (int k_ = 0; k_ < 4; ++k_) if (ok_[k_]) { const f32x4 a_ = (sv_[k_][0] + sv_[k_][1]) + (sv_[k_][2] + sv_[k_][3]); rstab[(hf_ + 2 * k_) * 256 + rr_] = rsqrtf(((a_.x + a_.y) + (a_.z + a_.w)) * (1.0f / DM) + EPS); } } while (0)
#define FILL_GU() do { LTID(tq); const int rr_ = tq & 255, hf_ = tq >> 8; f32x4 sv_[4][4]; bool ok_[4]; int tk_[4]; \
        _Pragma("unroll") for (int k_ = 0; k_ < 4; ++k_) { pg8::Unit u_; ok_[k_] = S.next(hf_ + 2 * k_, u_); tk_[k_] = ok_[k_] ? ROWTOK[u_.pm * 256 + rr_] : 0; } \
        _Pragma("unroll") for (int k_ = 0; k_ < 4; ++k_) { tk_[k_] = tk_[k_] < 0 ? 0 : tk_[k_]; const f32x4* sp_ = (const f32x4*)(SSQ + (size_t)tk_[k_] * 16); \
            _Pragma("unroll") for (int j_ = 0; j_ < 4; ++j_) sv_[k_][j_] = sp_[j_]; } \
        _Pragma("unroll") for (int k_ = 0; k_ < 4; ++k_) if (ok_[k_]) { const f32x4 a_ = (sv_[k_][0] + sv_[k_][1]) + (sv_[k_][2] + sv_[k_][3]); rowtab[(hf_ + 2 * k_) * 256 + rr_] = tk_[k_]; \
            rstab[(hf_ + 2 * k_) * 256 + rr_] = rsqrtf(((a_.x + a_.y) + (a_.z + a_.w)) * (1.0f / DM) + EPS); } } while (0)
#define FILL_DOWN() do { LTID(tq); const int rr_ = tq & 255, hf_ = tq >> 8; bool ok_[4]; int tk_[4]; float gt_[4]; \
        _Pragma("unroll") for (int k_ = 0; k_ < 4; ++k_) { pg8::Unit u_; ok_[k_] = S.next(hf_ + 2 * k_, u_); const int r_ = ok_[k_] ? u_.pm * 256 + rr_ : 0; tk_[k_] = ROWTOK[r_]; gt_[k_] = ROWGATE[r_]; } \
        _Pragma("unroll") for (int k_ = 0; k_ < 4; ++k_) if (ok_[k_]) { rowtab[(hf_ + 2 * k_) * 256 + rr_] = tk_[k_]; gatetab[(hf_ + 2 * k_) * 256 + rr_] = gt_[k_]; } } while (0)

#define SEAM(k) do { if (IN(k) && IN((k) + 1)) { grid_barrier(bar.bar, bar.x, bar.st); if (REPN(20) == 2) grid_barrier(bar.bar, bar.x, bar.st); } } while (0)
    LAS float* rstab = (LAS float*)(lds + LDS_RS); LAS int* rowtab = (LAS int*)(lds + LDS_ROWTOK); LAS float* gatetab = (LAS float*)(lds + LDS_GATE);
#define HB WSP(bf16, WS_HB)
#define PROJ WSP(bf16, WS_PROJ)
#define Y WSP(bf16, WS_Y)
#define XKV WSP(bf16, WS_XKV)
#define MEMN WSP(bf16, WS_MEMN)
#define SSQ WSP(float, WS_SSQ)
#define XQ WSP(bf16, WS_XQ)
#define U WSP(bf16, WS_U)
#define ROWTOK WSP(const int, WS_MOE + MO_ROWTOK)
#define ROWGATE WSP(const float, WS_MOE + MO_ROWGATE)
#define TILEE WSP(const int, WS_MOE + MO_TILEE)
#define NT WSP(const int, WS_MOE + MO_NT)
#define H (p.out)
#define HB8 ((unsigned char*)p.out + 64 * MiB)
#define U8 WSP(unsigned char, WS_U)

    if (EN(0) && IN(PH_PRO)) _Pragma("unroll 1") for (int rep_ = 0; rep_ < REPN(0); ++rep_) { PHL prologue(p, lds, vcuL, GL, wave, lane); }
    SEAM(PH_PRO);
    if (REPN(18) == 2 && IN(PH_XKV)) { PHL
        pg8::StaticOrder S; S.init(HB, ws_base(p.ws) + WS_W + WO_IN, NTOK, 3072, DM, GL, bxL);
        FILL_RS_DENSE();
        __syncthreads();
        EpiBf16<true> E{PROJ, PW, rstab};
        pg8::gemm_phase<DM, EpiBf16<true>, pg8::StaticOrder, true>(lds + LDS_STAGE, S, E);
    }
    for (int l = 0; l < NLAYER; ++l) {
        const int pb = PH_L0 + l * NPH;
        unsigned char* wl = ws_base(p.ws) + WS_W + (size_t)l * WS_WLAYER;
        if (EN(2) && IN(pb + LP_INPROJ)) _Pragma("unroll 1") for (int rep_ = 0; rep_ < REPN(2); ++rep_) { PHL
            pg8::StaticOrder S; S.init(HB, wl + WO_IN, NTOK, 3072, DM, GL, bxL);
            FILL_RS_DENSE();
            __syncthreads();
            EpiBf16<true> E{PROJ, PW, rstab};
            pg8::gemm_phase<DM, EpiBf16<true>, pg8::StaticOrder, true>(lds + LDS_STAGE, S, E);
            _Pragma("unroll 1") for (int r2_ = 0; r2_ < REPN(19); ++r2_) small_proj(p, l, lds + LDS_STAGE, vcuL, GL, wave, lane);
        }
        SEAM(pb + LP_INPROJ);
        if (EN(11) && IN(pb + LP_MIXA)) _Pragma("unroll 1") for (int rep_ = 0; rep_ < REPN(11); ++rep_) { PHL gla_phase_a(p, l, lds + LDS_STAGE, vcuL, GL); fox_cumsum_phase(p, l, lds + LDS_STAGE, vcuL, GL); fox_knorm_phase(p, vcuL, GL); }
        SEAM(pb + LP_MIXA);
        if (EN(12) && IN(pb + LP_MIXB)) _Pragma("unroll 1") for (int rep_ = 0; rep_ < REPN(12); ++rep_) { PHL gla_phase_b(p, vcuL, GL); }
        if (EN(1) && l == 0 && IN(pb + LP_MIXB)) { PHL
            pg8::StaticOrder S; S.init(MEMN, ws_base(p.ws) + WS_WXKV, 4096, 2048, DM, GL, bxL);
            EpiBf16<false> E{XKV, 2048, rstab};
            pg8::gemm_phase<DM, EpiBf16<false>, pg8::StaticOrder, true>(lds + LDS_STAGE, S, E);
        }
        SEAM(pb + LP_MIXB);
        if (EN(9) && IN(pb + LP_MIXC)) { PHL _Pragma("unroll 1") for (int rep_ = 0; rep_ < REPN(16); ++rep_) fox_phase(p, l, lds + LDS_STAGE, vcuL, GL); _Pragma("unroll 1") for (int rep_ = 0; rep_ < REPN(17); ++rep_) gla_phase_c(p, l, lds + LDS_STAGE, vcuL, GL); }
        SEAM(pb + LP_MIXC);
        if (EN(3) && IN(pb + LP_WOUT)) _Pragma("unroll 1") for (int rep_ = 0; rep_ < REPN(3); ++rep_) { PHL
            pg8::StaticOrder S; S.init(Y, wl + WO_OUT, NTOK, DM, DM, GL, bxL);
            EpiRes<0> E{HB, SSQ, rowtab, gatetab, rep_ == REPN(3) - 1 ? 1.f : 0.f, Y, nullptr};
            pg8::gemm_phase<DM, EpiRes<0>, pg8::StaticOrder, true>(lds + LDS_STAGE, S, E);
        }
        SEAM(pb + LP_WOUT);
        if (EN(4) && IN(pb + LP_XQ)) _Pragma("unroll 1") for (int rep_ = 0; rep_ < REPN(4); ++rep_) { PHL
            pg8::StaticOrder S; S.init(HB, wl + WO_XQ, NTOK, 512, DM, GL, bxL);
            FILL_RS_DENSE();
            __syncthreads();
            EpiBf16<true> E{XQ, 512, rstab};
            pg8::gemm_phase<DM, EpiBf16<true>, pg8::StaticOrder, true>(lds + LDS_STAGE, S, E);
            asm volatile("s_waitcnt vmcnt(0)" ::: "memory"); __syncthreads();
            { pg8::Unit u; for (int iu = 0; S.next(iu, u); ++iu) { xattn_pair(p, l, lds + LDS_STAGE, u.pm, u.pn, rep_ != REPN(4) - 1); } }
        }
        SEAM(pb + LP_XQ);
        if (EN(5) && IN(pb + LP_XO)) _Pragma("unroll 1") for (int rep_ = 0; rep_ < REPN(5); ++rep_) { PHL
            pg8::StaticOrder S; S.init(WSP(unsigned char, WS_XO8), wl + WO_XO, NTOK, DM, 256, GL, bxL);
            EpiRes<0, true> E{HB, SSQ, rowtab, gatetab, rep_ == REPN(5) - 1 ? 1.f : 0.f, Y, HB8};
            pg8::gemm_phase<256, EpiRes<0, true>, pg8::StaticOrder, true, true, 127, 122>(lds + LDS_STAGE, S, E);
        }
        SEAM(pb + LP_XO);
        if (EN(13) && IN(pb + LP_ROUTE)) _Pragma("unroll 1") for (int rep_ = 0; rep_ < REPN(13); ++rep_) { PHL route_phase(p, l, lds, vcuL, GL); }
        SEAM(pb + LP_ROUTE);
        if (EN(14) && IN(pb + LP_SORT)) _Pragma("unroll 1") for (int rep_ = 0; rep_ < REPN(14); ++rep_) { PHL sort_phase(p, lds, vcuL, GL); }
        SEAM(pb + LP_SORT);
        if (EN(6) && IN(pb + LP_GU)) _Pragma("unroll 1") for (int rep_ = 0; rep_ < REPN(6); ++rep_) { PHL
            MoeOrder<0> S{(const char*)HB8, (const char*)(wl + WO_GU), 512, (size_t)1024 * 1024, 0, NT[1], GL, vcuL, TILEE, rowtab};
            FILL_GU();
            __syncthreads();
            EpiGU E{U8, rstab};
            pg8::gemm_phase<512, EpiGU, MoeOrder<0>, true, true, 127, 122>(lds + LDS_STAGE, S, E);
        }
        SEAM(pb + LP_GU);
        if (EN(7) && IN(pb + LP_DOWN0)) _Pragma("unroll 1") for (int rep_ = 0; rep_ < REPN(7); ++rep_) { PHL
            MoeOrder<1> S{(const char*)U8, (const char*)(wl + WO_D), 256, (size_t)1024 * 512, 0, NT[0], GL, vcuL, TILEE, rowtab};
            __syncthreads();
            FILL_DOWN();
            __syncthreads();
            EpiRes<1> E{HB, SSQ, rowtab, gatetab, 1.f, Y, nullptr};
            pg8::gemm_phase<256, EpiRes<1>, MoeOrder<1>, true, true, 125, 122>(lds + LDS_STAGE, S, E);
        }
        SEAM(pb + LP_DOWN0);
        if (EN(8) && IN(pb + LP_DOWN1)) _Pragma("unroll 1") for (int rep_ = 0; rep_ < REPN(8); ++rep_) { PHL
            MoeOrder<1> S{(const char*)U8, (const char*)(wl + WO_D), 256, (size_t)1024 * 512, NT[0], NT[1], GL, vcuL, TILEE, rowtab};
            __syncthreads();
            FILL_DOWN();
            __syncthreads();
            EpiRes<2> E{HB, SSQ, rowtab, gatetab, 1.f, Y, nullptr};
            pg8::gemm_phase<256, EpiRes<2>, MoeOrder<1>, true, true, 125, 122>(lds + LDS_STAGE, S, E);
        }
        SEAM(pb + LP_DOWN1);
    }
    if (EN(15) && IN(PH_FINAL)) _Pragma("unroll 1") for (int rep_ = 0; rep_ < REPN(15); ++rep_) { PHL final_phase(p, vcuL, GL); }
#undef IN
#undef SEAM
#undef HB
#undef PROJ
#undef Y
#undef XKV
#undef MEMN
#undef SSQ
#undef XQ
#undef U
#undef ROWTOK
#undef ROWGATE
#undef TILEE
#undef NT
#undef H
#undef HB8
#undef U8
}

static int g_grid = 0;
static void launch_fast(const P& p, int lo, int hi, int& li, hipStream_t stream) {
    Args a{}; a.p = p; a.ph_lo = lo; a.ph_hi = hi; a.li = li++; a.pad = 0;
    hipLaunchKernelGGL(fwd, dim3(g_grid), dim3(NTHR), LDS_BYTES, stream, a);
    const hipError_t le = hipPeekAtLastError();
    if (le != hipSuccess) fprintf(stderr, "kernel_launch: fwd launch [%d,%d) failed: %s\n", lo, hi, hipGetErrorName(le));
}
extern "C" void kernel_launch(void* const* d_in, const int* in_sizes, int n_in, void* d_out, int out_size, void* d_ws, size_t ws_size, hipStream_t stream) {
    if (n_in != 25 || out_size != NTOK * DM || ws_size < WS_END2) { fprintf(stderr, "kernel_launch: unexpected sizes n_in %d out %d ws %zu (need %zu)\n", n_in, out_size, ws_size, (size_t)WS_END2); return; }
    if (g_grid == 0) {
        int dev = 0, cus = 0, per_cu = 0;
        if (hipGetDevice(&dev) != hipSuccess || hipDeviceGetAttribute(&cus, hipDeviceAttributeMultiprocessorCount, dev) != hipSuccess) { g_grid = -1; return; }
        if (hipFuncSetAttribute((const void*)fwd, hipFuncAttributeMaxDynamicSharedMemorySize, LDS_BYTES) != hipSuccess) { fprintf(stderr, "kernel_launch: hipFuncSetAttribute failed\n"); g_grid = -1; return; }
        if (hipOccupancyMaxActiveBlocksPerMultiprocessor(&per_cu, (const void*)fwd, NTHR, LDS_BYTES) != hipSuccess || per_cu < 1) { fprintf(stderr, "kernel_launch: occupancy query says %d\n", per_cu); }
        (void)hipGetLastError();
        g_grid = cus;
    }
    if (g_grid < 0) return;
    P p{};
    const float** pp = (const float**)&p;
    for (int i = 0; i < 25; ++i) pp[i] = (const float*)d_in[i];
    p.out = (float*)d_out; p.ws = (unsigned char*)d_ws;
    if (hipMemsetAsync((char*)d_ws + WS_CTL + (size_t)CW_BAR * 4, 0, (size_t)XCD_BAR_WORDS * 4, stream) != hipSuccess) { fprintf(stderr, "kernel_launch: hipMemsetAsync failed\n"); return; }
    int li = 0;
    launch_fast(p, PH_PRO, PH_END, li, stream);
}
```

```cpp
#include <hip/hip_runtime.h>
#include <cstdio>
#include <cstdint>

constexpr int NTOK = 32768, DM = 1024, NBATCH = 16, SEQ = 2048, NLAYER = 2, MEML = 256;
constexpr int PW = 3072;
constexpr int C_FQ = 0, C_FK = 512, C_FV = 1024, C_GQ = 1536, C_GK = 1792, C_GV = 2048, C_GG = 2560;
constexpr int INW = 3096;
constexpr float EPS = 1e-6f, LOG2E = 1.4426950408889634f;
constexpr int MAXTILES = 288;
constexpr int MAXROWS = MAXTILES * 256;

typedef unsigned short bf16;
__device__ __forceinline__ unsigned f2bf(float f) { unsigned u = __builtin_bit_cast(unsigned, f); return (u + 0x7fffu + ((u >> 16) & 1u)) >> 16; }
__device__ __forceinline__ float bf2f(bf16 b) { return __builtin_bit_cast(float, ((unsigned)b) << 16); }

constexpr size_t MiB = 1u << 20;
constexpr size_t WS_CTL = 0;
constexpr size_t WS_W = 1 * MiB;
constexpr size_t WS_WLAYER = 59 * MiB;
constexpr size_t WS_WXKV = WS_W + 2 * WS_WLAYER;
constexpr size_t WS_HB = WS_WXKV + 4 * MiB;
constexpr size_t WS_PROJ = WS_HB + 64 * MiB;
constexpr size_t WS_XQ = WS_PROJ;
constexpr size_t WS_U = WS_PROJ + 32 * MiB;
constexpr size_t WS_XO8 = WS_U + 40 * MiB;
constexpr size_t WS_SM = WS_PROJ + 192 * MiB;
constexpr size_t WS_CB = WS_SM + 4 * MiB;
constexpr size_t WS_Y = WS_CB + 1 * MiB;
constexpr size_t WS_XKV = WS_Y + 64 * MiB;
constexpr size_t WS_MEMN = WS_XKV + 16 * MiB;
constexpr size_t WS_SSQ = WS_MEMN + 8 * MiB;
constexpr size_t WS_MOE = WS_SSQ + 2 * MiB;
constexpr size_t WS_END = WS_MOE + 2 * MiB;
static_assert(WS_END <= 512 * MiB, "workspace map");
constexpr size_t MO_TOKE = 0;
constexpr size_t MO_TOKG = 256 * 1024;
constexpr size_t MO_ROWTOK = 512 * 1024;
constexpr size_t MO_ROWGATE = 832 * 1024;
constexpr size_t MO_TILEE = 1152 * 1024;
constexpr size_t MO_NT = 1156 * 1024;
constexpr size_t MO_HIST = 1160 * 1024;
constexpr size_t MO_KN = 1280 * 1024;

struct P {
    const float *x, *mem, *mem_norm, *mix_norm, *w_in, *b_forget, *w_alpha_up, *b_alpha, *fox_gain, *gla_gain, *w_out, *cross_norm, *w_xq, *w_xk, *w_xv, *w_xo,
        *moe_norm, *w_rg, *b_rg, *w_re, *b_re, *w_eg, *w_eu, *w_ed, *final_norm;
    float* out; unsigned char* ws;
};
__host__ __device__ __forceinline__ unsigned char* ws_base(unsigned char* w) {
#if defined(__HIP_DEVICE_COMPILE__)
    size_t z = 0; asm volatile("" : "+s"(z));
    return w + z;
#else
    return w;
#endif
}
#define WSP(T, off) ((T*)(ws_base(p.ws) + (off)))

__device__ __forceinline__ float wave_sum(float v) {
#pragma unroll
    for (int o = 1; o < 64; o <<= 1) v += __shfl_xor(v, o);
    return v;
}
__device__ __forceinline__ float wave_min(float v) {
#pragma unroll
    for (int o = 1; o < 64; o <<= 1) v = fminf(v, __shfl_xor(v, o));
    return v;
}
__device__ __forceinline__ float wave_max(float v) {
#pragma unroll
    for (int o = 1; o < 64; o <<= 1) v = fmaxf(v, __shfl_xor(v, o));
    return v;
}
__device__ __forceinline__ float row_rs(const float* ssq, int row) {
    const float4* s = (const float4*)(ssq + (size_t)row * 16);
    float4 a = s[0], b = s[1], c = s[2], d = s[3];
    float t = ((a.x + a.y) + (a.z + a.w)) + ((b.x + b.y) + (b.z + b.w)) + ((c.x + c.y) + (c.z + c.w)) + ((d.x + d.y) + (d.z + d.w));
    return rsqrtf(t * (1.0f / DM) + EPS);
}
__device__ __forceinline__ float log_sigmoid(float z) { return fminf(z, 0.f) - log1pf(expf(-fabsf(z))); }
__device__ __forceinline__ float silu(float z) { return z / (1.f + expf(-z)); }

typedef unsigned st_v4u __attribute__((ext_vector_type(4)));
typedef unsigned st_v2u __attribute__((ext_vector_type(2)));
#ifndef WT_STORES
#define WT_STORES 0
#endif
__device__ __forceinline__ void st_b128(void* p, st_v4u v) {
#if WT_STORES
    asm volatile("global_store_dwordx4 %0, %1, off sc1\n\ts_nop 1" :: "v"(p), "v"(v) : "memory");
#else
    *(st_v4u*)p = v;
#endif
}
__device__ __forceinline__ void st_b128_wt(void* p, st_v4u v) { asm volatile("global_store_dwordx4 %0, %1, off sc1\n\ts_nop 1" :: "v"(p), "v"(v) : "memory"); }
__device__ __forceinline__ void st_b64(void* p, st_v2u v) {
#if WT_STORES
    asm volatile("global_store_dwordx2 %0, %1, off sc1" :: "v"(p), "v"(v) : "memory");
#else
    *(st_v2u*)p = v;
#endif
}
#define XB_TMO      128
#define XB_XCNT(j)  (256  + 64 * (j))
#define XB_XSUB(j)  (1280 + 64 * (j))
#define XB_XGEN(j)  (2304 + 64 * (j))
#define XB_TOP      3328
#define XB_TOPGEN   3392
#define XCD_BAR_WORDS 3456
#define XB_SPIN_CAP (1u << 18)
#define LAS __attribute__((address_space(3)))

__device__ __forceinline__ unsigned xb_ld(unsigned* p)              { return __hip_atomic_load(p, __ATOMIC_RELAXED, __HIP_MEMORY_SCOPE_AGENT); }
__device__ __forceinline__ unsigned xb_add(unsigned* p, unsigned v) { return __hip_atomic_fetch_add(p, v, __ATOMIC_RELAXED, __HIP_MEMORY_SCOPE_AGENT); }
__device__ __forceinline__ unsigned xb_xcc_id() { return (unsigned)__builtin_amdgcn_s_getreg((3 << 11) | 20) & 0xFu; }
#define XB_SPIN(cond, bar) do { unsigned _sp = 0; while (cond) { __builtin_amdgcn_s_sleep(1); \
    if ((++_sp & 255u) == 0u) { if (xb_ld(&(bar)[XB_TMO])) break; if (_sp > XB_SPIN_CAP) { atomicAdd(&(bar)[XB_TMO], 1u); break; } } } } while (0)

struct XcdBarrier {
    unsigned* bar; unsigned x;
    volatile LAS unsigned* st;
};

__device__ __forceinline__ XcdBarrier xcd_barrier_post(unsigned* bar, volatile LAS unsigned* st) {
    XcdBarrier b; b.bar = bar; b.x = xb_xcc_id(); b.st = st;
    if (threadIdx.x == 0) (void)xb_add(&bar[XB_XCNT(b.x)], 1u);
    return b;
}
__device__ __forceinline__ void xcd_barrier_complete(unsigned* bar, unsigned x, unsigned& nloc, unsigned& nx) {
    const unsigned G = gridDim.x * gridDim.y * gridDim.z;
    unsigned sum, cnt, mine, sp = 0u;
    for (;;) {
        sum = 0u; cnt = 0u; mine = 0u;
#pragma unroll
        for (unsigned j = 0; j < 16; ++j) { const unsigned c = xb_ld(&bar[XB_XCNT(j)]); sum += c; cnt += (c > 0u) ? 1u : 0u; mine = (j == x) ? c : mine; }
        if (sum == G) break;
        __builtin_amdgcn_s_sleep(1);
        if ((++sp & 255u) == 0u) { if (xb_ld(&bar[XB_TMO])) break; if (sp > XB_SPIN_CAP) { atomicAdd(&bar[XB_TMO], 1u); break; } }
    }
    nloc = mine > 0u ? mine : 1u; nx = cnt > 0u ? cnt : 1u;
}

__device__ __forceinline__ void xcd_barrier(const XcdBarrier& b) {
    asm volatile("s_waitcnt vmcnt(0)" ::: "memory");
    __syncthreads();
    if (threadIdx.x == 0) {
        unsigned* bar = b.bar;
        __builtin_amdgcn_s_waitcnt(0);
        unsigned nloc = b.st[0], nx = b.st[1];
        if (nloc == 0u) { xcd_barrier_complete(bar, b.x, nloc, nx); b.st[0] = nloc; b.st[1] = nx; }
        const unsigned old = xb_add(&bar[XB_XSUB(b.x)], 1u);
        const unsigned gen = old / nloc;
        if (old + 1u == (gen + 1u) * nloc) {
            __builtin_amdgcn_fence(__ATOMIC_RELEASE, "agent");
            asm volatile("s_waitcnt vmcnt(0)" ::: "memory");
            const unsigned og = xb_add(&bar[XB_TOP], 1u);
            const unsigned tg = og / nx;
            if (og + 1u == (tg + 1u) * nx) xb_add(&bar[XB_TOPGEN], 1u);
            else XB_SPIN(xb_ld(&bar[XB_TOPGEN]) == tg, bar);
            __builtin_amdgcn_fence(__ATOMIC_ACQUIRE, "agent");
            xb_add(&bar[XB_XGEN(b.x)], 1u);
            asm volatile("s_waitcnt vmcnt(0)" ::: "memory");
        } else {
            XB_SPIN(xb_ld(&bar[XB_XGEN(b.x)]) == gen, bar);
            __builtin_amdgcn_fence(__ATOMIC_ACQUIRE, "agent");
            asm volatile("s_waitcnt vmcnt(0)" ::: "memory");
        }
    }
    __syncthreads();
}

namespace pg8 {
#define PG8_LAS __attribute__((address_space(3)))
typedef unsigned short bf16_t;
typedef short bf16x8 __attribute__((ext_vector_type(8)));
typedef float f32x4 __attribute__((ext_vector_type(4)));
typedef unsigned u32x4 __attribute__((ext_vector_type(4)));
typedef unsigned u32x2 __attribute__((ext_vector_type(2)));
constexpr int BM = 256, BK = 64, HALF = 128, HTB = HALF * BK * 2, STAGE_BYTES = 8 * HTB, NXCD = 8, WGM = 8;

__host__ __device__ __forceinline__ int lds_byte(int r, int c) { const int st = (r >> 4) * 2 + (c >> 5), rr = r & 15, cc = c & 31, ob = rr * 64 + cc * 2; return st * 1024 + (ob ^ (((ob >> 9) & 1) << 5)); }
__host__ __device__ __forceinline__ void stage_rc(int b, int& R, int& C) { const int st = b / 1024, sb = b % 1024, swz = sb ^ (((sb >> 9) & 1) << 5); R = (st >> 1) * 16 + swz / 64; C = (st & 1) * 32 + (swz % 64) / 2; }
__host__ __device__ __forceinline__ int perm32(int rho) { const int n = rho >> 4, i = rho & 15; return 8 * (i >> 2) + 4 * n + (i & 3); }

struct Unit { int pm, pn, e; };

struct StaticOrder {
    static constexpr bool GATHER = false;
    static constexpr size_t KSTEP_A = 128;
    const char* A; const char* Bt; int K; int nM, nN, nwg, G, c;
    __device__ void init(const void* A_, const void* Bt_, int M, int N, int K_, int G_, int c_) { A = (const char*)A_; Bt = (const char*)Bt_; K = K_; nM = M / BM; nN = N / BM; nwg = nM * nN; G = G_; c = c_; }
    __device__ bool next(int i, Unit& u) const {
        const long L = (long)i * G + c; if (L >= nwg) return false;
        int wgid = (int)L; { const int q = nwg / NXCD, r = nwg % NXCD, xcd = wgid % NXCD, off = wgid / NXCD; wgid = (xcd < r ? xcd * (q + 1) : r * (q + 1) + (xcd - r) * q) + off; }
        const int nig = WGM * nN, gid = wgid / nig, fm = gid * WGM, gsz = (nM - fm) < WGM ? (nM - fm) : WGM;
        u.pm = fm + ((wgid % nig) % gsz); u.pn = (wgid % nig) / gsz; u.e = 0; return true;
    }
    __device__ __forceinline__ const char* a_base(const Unit& u) const { return A + (size_t)u.pm * (size_t)(BM * 2) * K; }
    __device__ __forceinline__ const char* b_base(const Unit& u) const { return Bt + (size_t)u.pn * (size_t)(BM * 2) * K; }
    __device__ __forceinline__ unsigned a_off(int, int, int, int) const { return 0u; }
};

__device__ __forceinline__ unsigned cvt_pk_bf16(float lo, float hi) { unsigned r; asm volatile("v_cvt_pk_bf16_f32 %0, %1, %2" : "=v"(r) : "v"(lo), "v"(hi)); return r; }

typedef int i32x8 __attribute__((ext_vector_type(8)));
typedef int i32x4 __attribute__((ext_vector_type(4)));
template <int K, class Epi, class Sched, bool ALIGN_EPI, bool FP8 = false, int SA = 127, int SB = 127>
__device__ __forceinline__ void gemm_phase(PG8_LAS unsigned char* lds, const Sched& S, const Epi& E) {
    int tid_ = threadIdx.x; asm volatile("" : "+v"(tid_));
    const int tid = tid_, wid = __builtin_amdgcn_readfirstlane(tid >> 6), lane = tid & 63, wr = wid >> 2, wc = wid & 3, fr = lane & 15, fq = lane >> 4;
    constexpr int nt = K / BK;
    constexpr int NH = Sched::GATHER ? 2 : 1;
    unsigned voffB[2], cvA[NH][2], nvA[NH][2];
#pragma unroll
    for (int i = 0; i < 2; ++i) { int R, C; stage_rc(tid * 16 + i * 8192, R, C); const int Rb = Epi::PERM ? ((R & ~31) + perm32(R & 31)) : R;
        voffB[i] = (unsigned)(Rb * K + C) * 2u;
        cvA[0][i] = nvA[0][i] = (unsigned)(R * K + C) * 2u; if constexpr (NH == 2) { cvA[NH - 1][i] = nvA[NH - 1][i] = cvA[0][i]; } }
    constexpr size_t kstep = (size_t)(BK * 2);
    constexpr size_t hstep = (size_t)HALF * K * 2;
    constexpr size_t hstepA = Sched::GATHER ? (size_t)0 : hstep;
    constexpr size_t kstepA = Sched::KSTEP_A;
    const unsigned ldsw = (unsigned)wid * 1024u;
    const int aoff = lds_byte(wr * 64 + fr, fq * 8), boff = lds_byte(wc * 32 + fr, fq * 8);
#define PG8_SA(b, h) (((b) * 2 + (h)) * HTB)
#define PG8_SB(b, h) ((4 + (b) * 2 + (h)) * HTB)
#define PG8_STAGE(bufoff, gbase, voff) do { _Pragma("unroll") for (int _i = 0; _i < 2; ++_i) \
        __builtin_amdgcn_global_load_lds((const unsigned*)((const char*)(gbase) + (voff)[_i]), (PG8_LAS unsigned*)(lds + (bufoff) + ldsw + _i * 8192), 16, 0, 0); } while (0)
#define PG8_LD32(addr) __builtin_shufflevector(*(const PG8_LAS i32x4*)(addr), *(const PG8_LAS i32x4*)((addr) + 1024), 0, 1, 2, 3, 4, 5, 6, 7)
#define PG8_LDA(dst, b, h) do { _Pragma("unroll") for (int m = 0; m < 4; ++m) dst[m] = PG8_LD32(lds + PG8_SA(b, h) + aoff + m * 2048); } while (0)
#define PG8_LDB(dst, b, h) do { _Pragma("unroll") for (int n = 0; n < 2; ++n) dst[n] = PG8_LD32(lds + PG8_SB(b, h) + boff + n * 2048); } while (0)
#define PG8_H0(x) __builtin_bit_cast(bf16x8, __builtin_shufflevector((x), (x), 0, 1, 2, 3))
#define PG8_H1(x) __builtin_bit_cast(bf16x8, __builtin_shufflevector((x), (x), 4, 5, 6, 7))
#define PG8_MMA(ai, bj, At, Bt) do { __builtin_amdgcn_s_setprio(1); _Pragma("unroll") for (int m = 0; m < 4; ++m) _Pragma("unroll") for (int n = 0; n < 2; ++n) { \
        if constexpr (FP8) asm volatile("v_mfma_scale_f32_16x16x128_f8f6f4 %0, %1, %2, %0, %3, %4 op_sel_hi:[0,0,0]" : "+v"(acc[ai][bj][m][n]) : "v"(Bt[n]), "v"(At[m]), "v"(sbv), "v"(sav)); \
        else { acc[ai][bj][m][n] = __builtin_amdgcn_mfma_f32_16x16x32_bf16(PG8_H0(Bt[n]), PG8_H0(At[m]), acc[ai][bj][m][n], 0, 0, 0); \
               acc[ai][bj][m][n] = __builtin_amdgcn_mfma_f32_16x16x32_bf16(PG8_H1(Bt[n]), PG8_H1(At[m]), acc[ai][bj][m][n], 0, 0, 0); } } \
        __builtin_amdgcn_s_setprio(0); } while (0)
#define PG8_WAIT_V(n) asm volatile("s_waitcnt vmcnt(" #n ")" ::: "memory")
#define PG8_WAIT_L(n) asm volatile("s_waitcnt lgkmcnt(" #n ")" ::: "memory")
#define PG8_BAR __builtin_amdgcn_s_barrier()
#define PG8_SCHED __builtin_amdgcn_sched_barrier(0)
    int sav = SA, sbv = SB; asm volatile("" : "+v"(sav), "+v"(sbv));
    Unit cur, nxt; int ui = 0;
    if (!S.next(0, cur)) return;
    f32x4 acc[2][2][4][2];
#pragma unroll
    for (int a = 0; a < 2; ++a)
#pragma unroll
        for (int b = 0; b < 2; ++b)
#pragma unroll
            for (int m = 0; m < 4; ++m)
#pragma unroll
                for (int n = 0; n < 2; ++n) acc[a][b][m][n] = (f32x4){0.f, 0.f, 0.f, 0.f};
    i32x8 At[4], B0[2], B1[2];
    const char* cA = S.a_base(cur); const char* cB = S.b_base(cur);
    if constexpr (Sched::GATHER) {
        int R0, C0, R1, C1; stage_rc(tid * 16, R0, C0); stage_rc(tid * 16 + 8192, R1, C1);
#pragma unroll
        for (int h = 0; h < 2; ++h) { cvA[h][0] = S.a_off(0, h, R0, C0 * 2); cvA[h][1] = S.a_off(0, h, R1, C1 * 2); }
    }
    PG8_STAGE(PG8_SB(0, 0), cB, voffB); PG8_STAGE(PG8_SB(0, 1), cB + hstep, voffB); PG8_STAGE(PG8_SA(0, 0), cA, cvA[0]); PG8_STAGE(PG8_SA(0, 1), cA + hstepA, cvA[NH - 1]);
    if (wr == 1) PG8_BAR;
    PG8_WAIT_V(2); PG8_BAR;
    PG8_STAGE(PG8_SB(1, 0), cB + kstep, voffB); PG8_STAGE(PG8_SA(1, 0), cA + kstepA, cvA[0]); PG8_STAGE(PG8_SB(1, 1), cB + hstep + kstep, voffB);
    PG8_WAIT_V(6); PG8_BAR;
    for (;;) {
        const bool has_next = S.next(ui + 1, nxt);
        const char* nA = has_next ? S.a_base(nxt) : cA; const char* nB = has_next ? S.b_base(nxt) : cB;
        if constexpr (Sched::GATHER) {
            if (has_next) {
                int t2 = threadIdx.x; asm volatile("" : "+v"(t2));
                int R0, C0, R1, C1; stage_rc(t2 * 16, R0, C0); stage_rc(t2 * 16 + 8192, R1, C1);
#pragma unroll
                for (int h = 0; h < 2; ++h) { nvA[h][0] = S.a_off(ui + 1, h, R0, C0 * 2); nvA[h][1] = S.a_off(ui + 1, h, R1, C1 * 2); }
            } else {
#pragma unroll
                for (int h = 0; h < 2; ++h) { nvA[h][0] = cvA[h][0]; nvA[h][1] = cvA[h][1]; }
            }
        }
#pragma unroll 1
        for (int t = 0; t < nt; t += 2) {
            const bool last = (t == nt - 2);
            const char* a1 = cA + (size_t)(t + 1) * kstepA;
            const char* a2 = last ? nA : cA + (size_t)(t + 2) * kstepA; const char* b2 = last ? nB : cB + (size_t)(t + 2) * kstep;
            const char* a3 = a2 + kstepA; const char* b3 = b2 + kstep;
            unsigned v2[NH][2];
#pragma unroll
            for (int h = 0; h < NH; ++h) { if constexpr (Sched::GATHER) { v2[h][0] = last ? nvA[h][0] : cvA[h][0]; v2[h][1] = last ? nvA[h][1] : cvA[h][1]; } else { v2[h][0] = cvA[h][0]; v2[h][1] = cvA[h][1]; } }
            PG8_LDB(B0, 0, 0); PG8_LDB(B1, 0, 1); PG8_SCHED; PG8_LDA(At, 0, 0); PG8_STAGE(PG8_SA(1, 1), a1 + hstepA, cvA[NH - 1]);
            PG8_WAIT_V(8); PG8_WAIT_L(0); PG8_BAR; PG8_MMA(0, 0, At, B0); PG8_MMA(0, 1, At, B1); PG8_BAR; PG8_SCHED;
            PG8_LDA(At, 0, 1); PG8_STAGE(PG8_SB(0, 0), b2, voffB); PG8_STAGE(PG8_SB(0, 1), b2 + hstep, voffB); PG8_STAGE(PG8_SA(0, 0), a2, v2[0]);
            PG8_WAIT_V(8); PG8_WAIT_L(0); PG8_BAR; PG8_MMA(1, 0, At, B0); PG8_MMA(1, 1, At, B1); PG8_BAR; PG8_SCHED;
            PG8_LDB(B0, 1, 0); PG8_LDB(B1, 1, 1); PG8_SCHED; PG8_LDA(At, 1, 0); PG8_STAGE(PG8_SA(0, 1), a2 + hstepA, v2[NH - 1]);
            PG8_WAIT_V(8); PG8_WAIT_L(0); PG8_BAR; PG8_MMA(0, 0, At, B0); PG8_MMA(0, 1, At, B1); PG8_BAR; PG8_SCHED;
            PG8_LDA(At, 1, 1); PG8_STAGE(PG8_SB(1, 0), b3, voffB); PG8_STAGE(PG8_SB(1, 1), b3 + hstep, voffB); PG8_STAGE(PG8_SA(1, 0), a3, v2[0]);
            PG8_WAIT_V(8); PG8_WAIT_L(0); PG8_BAR; PG8_MMA(1, 0, At, B0); PG8_MMA(1, 1, At, B1); PG8_BAR; PG8_SCHED;
        }
        if constexpr (ALIGN_EPI) { if (wr == 0) PG8_BAR; }
        if constexpr (FP8) asm volatile("s_nop 15\n\ts_nop 15" ::: "memory");
        E(acc, cur, ui, wr, wc, fr, fq);
        if (!has_next) break;
#pragma unroll
        for (int a = 0; a < 2; ++a)
#pragma unroll
            for (int b = 0; b < 2; ++b)
#pragma unroll
                for (int m = 0; m < 4; ++m)
#pragma unroll
                    for (int n = 0; n < 2; ++n) acc[a][b][m][n] = (f32x4){0.f, 0.f, 0.f, 0.f};
        cur = nxt; cA = nA; cB = nB; ++ui;
        if constexpr (Sched::GATHER) {
#pragma unroll
            for (int h = 0; h < NH; ++h) { cvA[h][0] = nvA[h][0]; cvA[h][1] = nvA[h][1]; }
        }
        if constexpr (ALIGN_EPI) { if (wr == 1) PG8_BAR; }
    }
    PG8_WAIT_V(0);
    if constexpr (!ALIGN_EPI) { if (wr == 0) PG8_BAR; }
    PG8_BAR;
#undef PG8_SA
#undef PG8_SB
#undef PG8_STAGE
#undef PG8_LDA
#undef PG8_LDB
#undef PG8_MMA
#undef PG8_LD32
#undef PG8_H0
#undef PG8_H1
#undef PG8_WAIT_V
#undef PG8_WAIT_L
#undef PG8_BAR
#undef PG8_SCHED
}
}
#define GAS __attribute__((address_space(1)))
typedef float f32x4 __attribute__((ext_vector_type(4)));
typedef float f32x16 __attribute__((ext_vector_type(16)));
typedef short bf16x8 __attribute__((ext_vector_type(8)));
typedef unsigned v4u __attribute__((ext_vector_type(4)));
typedef unsigned v2u __attribute__((ext_vector_type(2)));
#define LDS_WAIT() asm volatile("s_waitcnt lgkmcnt(0)" ::: "memory")
#define VM_WAIT() asm volatile("s_waitcnt vmcnt(0)" ::: "memory")
__device__ __forceinline__ unsigned pk2(float lo, float hi) { return f2bf(lo) | (f2bf(hi) << 16); }

constexpr int NWAVES = 8, NTHR = 512;
constexpr int LDS_STAGE = 0;
constexpr int LDS_RS = 131072;
constexpr int LDS_ROWTOK = LDS_RS + 8192;
constexpr int LDS_GATE = LDS_ROWTOK + 8192;
constexpr int LDS_MISC = LDS_GATE + 8192;
constexpr int LDS_BYTES = LDS_MISC + 256;
constexpr size_t WO_IN = 0, WO_SM = 6 * MiB, WO_RHI = 6 * MiB + 65536, WO_RLO = 6 * MiB + 131072, WO_OUT = 7 * MiB, WO_XQ = 9 * MiB, WO_XO = 10 * MiB, WO_GU = 11 * MiB, WO_D = 43 * MiB;
static_assert(WO_D + 16 * MiB <= WS_WLAYER, "weight block");
constexpr int CW_BAR = 4096;
constexpr int MAX_LAUNCH = 40;
static_assert((CW_BAR + MAX_LAUNCH * XCD_BAR_WORDS) * 4 <= (int)(1 * MiB), "ctl");

enum { PH_PRO = 0, PH_XKV = 1, PH_L0 = 2, NPH = 13, PH_FINAL = PH_L0 + NLAYER * NPH, PH_END = PH_FINAL + 1 };
enum { LP_INPROJ = 0, LP_MIXA, LP_MIXB, LP_MIXC, LP_WOUT, LP_XQ, LP_XATTN, LP_XO, LP_ROUTE, LP_SORT, LP_GU, LP_DOWN0, LP_DOWN1 };

struct Args { P p; int ph_lo, ph_hi, li, pad; };

#ifndef WT_PROJ
#define WT_PROJ 0
#endif
template <bool HAS_RS> struct EpiBf16 {
    static constexpr bool PERM = true;
    bf16* O; int ldc; const LAS float* rstab;
    __device__ __forceinline__ void operator()(const pg8::f32x4 (&acc)[2][2][4][2], const pg8::Unit& u, int iu, int wr, int wc, int fr, int fq) const {
#pragma unroll
        for (int ai = 0; ai < 2; ++ai)
#pragma unroll
            for (int m = 0; m < 4; ++m) {
                const int lrow = ai * 128 + wr * 64 + m * 16 + fr;
                float sc = 1.f; if (HAS_RS) sc = rstab[iu * 256 + lrow];
                bf16* rowp = O + (size_t)(u.pm * 256 + lrow) * ldc + u.pn * 256 + wc * 32 + 8 * fq;
#pragma unroll
                for (int bj = 0; bj < 2; ++bj) { const pg8::f32x4 v0 = acc[ai][bj][m][0] * sc, v1 = acc[ai][bj][m][1] * sc;
                    pg8::u32x4 w; w.x = pg8::cvt_pk_bf16(v0[0], v0[1]); w.y = pg8::cvt_pk_bf16(v0[2], v0[3]); w.z = pg8::cvt_pk_bf16(v1[0], v1[1]); w.w = pg8::cvt_pk_bf16(v1[2], v1[3]);
                    if (WT_PROJ) st_b128_wt(rowp + bj * 128, w); else st_b128(rowp + bj * 128, w); }
            }
    }
};
__device__ __forceinline__ unsigned pk4_fp8(float a, float b, float c, float d) { int w = __builtin_amdgcn_cvt_pk_fp8_f32(a, b, 0, false); w = __builtin_amdgcn_cvt_pk_fp8_f32(c, d, w, true); return (unsigned)w; }
struct EpiGU {
    static constexpr bool PERM = true;
    unsigned char* U8; const LAS float* rstab;
    __device__ __forceinline__ void operator()(const pg8::f32x4 (&acc)[2][2][4][2], const pg8::Unit& u, int iu, int wr, int wc, int fr, int fq) const {
#pragma unroll
        for (int ai = 0; ai < 2; ++ai)
#pragma unroll
            for (int m = 0; m < 4; ++m) {
                const int lrow = ai * 128 + wr * 64 + m * 16 + fr;
                const float sc = rstab[iu * 256 + lrow];
                float o[8];
#pragma unroll
                for (int n = 0; n < 2; ++n)
#pragma unroll
                    for (int j = 0; j < 4; ++j) { const float g = acc[ai][0][m][n][j] * sc, uu = acc[ai][1][m][n][j] * sc; o[n * 4 + j] = 4.f * g * uu * __builtin_amdgcn_rcpf(1.f + __expf(-g)); }
                pg8::u32x2 w; w.x = pk4_fp8(o[0], o[1], o[2], o[3]); w.y = pk4_fp8(o[4], o[5], o[6], o[7]);
                st_b64(U8 + (size_t)(u.pm * 256 + lrow) * 512 + u.pn * 128 + wc * 32 + 8 * fq, w);
            }
    }
};
template <int MODE, bool W8 = false> struct EpiRes {
    static constexpr bool PERM = true;
    static constexpr bool MOE = MODE != 0;
    bf16* hb; float* ssq; const LAS int* rowtab; const LAS float* gatetab; float gs; bf16* t0; unsigned char* h8;
    static __device__ __forceinline__ void unpack8(const pg8::u32x4& w, float (&f)[8]) {
        f[0] = __builtin_bit_cast(float, w.x << 16); f[1] = __builtin_bit_cast(float, w.x & 0xffff0000u); f[2] = __builtin_bit_cast(float, w.y << 16); f[3] = __builtin_bit_cast(float, w.y & 0xffff0000u);
        f[4] = __builtin_bit_cast(float, w.z << 16); f[5] = __builtin_bit_cast(float, w.z & 0xffff0000u); f[6] = __builtin_bit_cast(float, w.w << 16); f[7] = __builtin_bit_cast(float, w.w & 0xffff0000u); }
    __device__ __forceinline__ void operator()(const pg8::f32x4 (&acc)[2][2][4][2], const pg8::Unit& u, int iu, int wr, int wc, int fr, int fq) const {
#pragma unroll
        for (int ai = 0; ai < 2; ++ai)
#pragma unroll
            for (int m = 0; m < 4; ++m) {
                const int lrow = ai * 128 + wr * 64 + m * 16 + fr;
                int row = u.pm * 256 + lrow; float g = gs;
                if (MOE) { row = rowtab[iu * 256 + lrow]; g = gatetab[iu * 256 + lrow] * gs; }
                const bool ok = !MOE || row >= 0;
                const size_t off = (size_t)(ok ? row : 0) * DM + u.pn * 256 + wc * 32 + 8 * fq;
                float q = 0.f;
                if (ok) {
#pragma unroll
                    for (int bj = 0; bj < 2; ++bj) {
                        float o[8];
#pragma unroll
                        for (int j = 0; j < 4; ++j) { o[j] = acc[ai][bj][m][0][j] * g; o[4 + j] = acc[ai][bj][m][1][j] * g; }
                        if (MODE == 1) { pg8::u32x4 w; w.x = pg8::cvt_pk_bf16(o[0], o[1]); w.y = pg8::cvt_pk_bf16(o[2], o[3]); w.z = pg8::cvt_pk_bf16(o[4], o[5]); w.w = pg8::cvt_pk_bf16(o[6], o[7]); st_b128(t0 + off + bj * 128, w); }
                        else {
                            float bs[8]; unpack8(*(const pg8::u32x4*)(hb + off + bj * 128), bs);
                            if (MODE == 2) { float tv[8]; unpack8(*(const pg8::u32x4*)(t0 + off + bj * 128), tv);
#pragma unroll
                                for (int j = 0; j < 8; ++j) bs[j] += tv[j]; }
#pragma unroll
                            for (int j = 0; j < 8; ++j) o[j] += bs[j];
                            pg8::u32x4 w; w.x = pg8::cvt_pk_bf16(o[0], o[1]); w.y = pg8::cvt_pk_bf16(o[2], o[3]); w.z = pg8::cvt_pk_bf16(o[4], o[5]); w.w = pg8::cvt_pk_bf16(o[6], o[7]);
                            float r[8]; unpack8(w, r);
#pragma unroll
                            for (int j = 0; j < 8; ++j) q += r[j] * r[j];
                            st_b128(hb + off + bj * 128, w);
                            if (W8) { pg8::u32x2 w8; w8.x = pk4_fp8(o[0], o[1], o[2], o[3]); w8.y = pk4_fp8(o[4], o[5], o[6], o[7]); st_b64(h8 + off + bj * 128, w8); } }
                    }
                }
                if (MODE != 1) { q += __shfl_xor(q, 16); q += __shfl_xor(q, 32); if (fq == 0 && ok) ssq[(size_t)row * 16 + u.pn * 4 + wc] = q; }
            }
    }
};
template <int MODE> struct MoeOrder {
    static constexpr bool GATHER = MODE == 0;
    static constexpr size_t KSTEP_A = 128;
    const char* A; const char* Bt; int K; size_t estride; int lo, hi, G, c; const int* tilee; const LAS int* rowtab;
    __device__ bool next(int i, pg8::Unit& u) const { const int L = i * G + c, t = lo + (L >> 2); if (t >= hi) return false; u.pm = t; u.pn = L & 3; u.e = tilee[t]; return true; }
    __device__ __forceinline__ const char* a_base(const pg8::Unit& u) const { return GATHER ? A : A + (size_t)u.pm * (size_t)512 * K; }
    __device__ __forceinline__ const char* b_base(const pg8::Unit& u) const { return Bt + (size_t)u.e * estride + (size_t)u.pn * (size_t)512 * K; }
    __device__ __forceinline__ unsigned a_off(int iu, int h, int R, int Cb) const { return (unsigned)rowtab[iu * 256 + h * 128 + R] * (unsigned)(K * 2) + (unsigned)Cb; }
};

__device__ __forceinline__ void router_weights(const P& p, int gtid, int gstride);
__device__ __forceinline__ void tr_item(const float* W, int N, int K, int k0, int n0, const float* gain, float scale, bf16* dst, LAS float* scr, int lane) {
    const int kr = lane >> 3, c4 = lane & 7;
    f32x4 v[8];
#pragma unroll
    for (int i = 0; i < 8; ++i) v[i] = *(const f32x4*)(W + (size_t)(k0 + 8 * i + kr) * N + n0 + 4 * c4);
#pragma unroll
    for (int i = 0; i < 8; ++i) { const int kk = 8 * i + kr; float g = scale; if (gain) g *= gain[k0 + kk];
        LAS float* d = scr + kk * 33 + 4 * c4; d[0] = v[i].x * g; d[1] = v[i].y * g; d[2] = v[i].z * g; d[3] = v[i].w * g; }
    LDS_WAIT();
    const int c = lane & 7;
#pragma unroll
    for (int j = 0; j < 4; ++j) { const int n = (lane >> 3) + 8 * j; const LAS float* s = scr + (8 * c) * 33 + n;
        v4u o; o.x = pk2(s[0 * 33], s[1 * 33]); o.y = pk2(s[2 * 33], s[3 * 33]); o.z = pk2(s[4 * 33], s[5 * 33]); o.w = pk2(s[6 * 33], s[7 * 33]);
        st_b128(dst + (size_t)n * K + k0 + 8 * c, o); }
    LDS_WAIT();
}
__device__ __forceinline__ void tr_item8(const float* W, int N, int K, int k0, int n0, const float* gain, float scale, unsigned char* dst, LAS float* scr, int lane) {
    const int kr = lane >> 3, c4 = lane & 7;
    f32x4 v[8];
#pragma unroll
    for (int i = 0; i < 8; ++i) v[i] = *(const f32x4*)(W + (size_t)(k0 + 8 * i + kr) * N + n0 + 4 * c4);
#pragma unroll
    for (int i = 0; i < 8; ++i) { const int kk = 8 * i + kr; float g = scale; if (gain) g *= gain[k0 + kk];
        LAS float* d = scr + kk * 33 + 4 * c4; d[0] = v[i].x * g; d[1] = v[i].y * g; d[2] = v[i].z * g; d[3] = v[i].w * g; }
    LDS_WAIT();
    const int c = lane & 7;
#pragma unroll
    for (int j = 0; j < 4; ++j) { const int n = (lane >> 3) + 8 * j; const LAS float* s = scr + (8 * c) * 33 + n;
        v2u o; o.x = pk4_fp8(s[0 * 33], s[1 * 33], s[2 * 33], s[3 * 33]); o.y = pk4_fp8(s[4 * 33], s[5 * 33], s[6 * 33], s[7 * 33]);
        st_b64(dst + (size_t)n * K + k0 + 8 * c, o); }
    LDS_WAIT();
}
constexpr int IT_LAYER = 15360;
__device__ __forceinline__ void prologue_item(const P& p, int it, LAS float* scr, int lane) {
    const int l = it / IT_LAYER; int r = it % IT_LAYER;
    unsigned char* wl = ws_base(p.ws) + WS_W + (size_t)l * WS_WLAYER;
    if (r < 1536) {
        const int seg = r / 768; r %= 768; const int kb = r / 48, nb = r % 48; const int n0 = (seg ? 1544 : 0) + 32 * nb, drow = seg * 1536 + 32 * nb;
        const float sc = drow < 512 ? 0.125f * LOG2E : ((drow >= C_GQ && drow < C_GK) ? 0.125f : 1.f);
        tr_item(p.w_in + (size_t)l * DM * INW, INW, DM, 64 * kb, n0, p.mix_norm + l * DM, sc, (bf16*)(wl + WO_IN) + (size_t)drow * DM, scr, lane); return; }
    r -= 1536;
    if (r < 512) { const int kb = r / 32, nb = r % 32; tr_item(p.w_out + (size_t)l * DM * DM, DM, DM, 64 * kb, 32 * nb, nullptr, 1.f, (bf16*)(wl + WO_OUT) + (size_t)(32 * nb) * DM, scr, lane); return; }
    r -= 512;
    if (r < 256) { const int kb = r / 16, nb = r % 16; tr_item(p.w_xq + (size_t)l * DM * 512, 512, DM, 64 * kb, 32 * nb, p.cross_norm + l * DM, 0.08838834764831845f * LOG2E, (bf16*)(wl + WO_XQ) + (size_t)(32 * nb) * DM, scr, lane); return; }
    r -= 256;
    if (r < 256) { const int kb = r / 32, nb = r % 32; tr_item8(p.w_xo + (size_t)l * 512 * DM, DM, 512, 64 * kb, 32 * nb, nullptr, 32.f, (unsigned char*)(wl + WO_XO) + (size_t)(32 * nb) * 512, scr, lane); return; }
    r -= 256;
    if (r < 512) { const int kv = r / 256; r %= 256; const int kb = r / 16, nb = r % 16;
        tr_item((kv ? p.w_xv : p.w_xk) + (size_t)l * DM * 512, 512, DM, 64 * kb, 32 * nb, nullptr, 1.f, (bf16*)(ws_base(p.ws) + WS_WXKV) + (size_t)(l * 1024 + kv * 512 + 32 * nb) * DM, scr, lane); return; }
    r -= 512;
    if (r < 8192) { const int up = r / 4096; r %= 4096; const int e = r / 256; r %= 256; const int kb = r / 16, nb = r % 16; const int c0 = 32 * nb, drow = (c0 >> 7) * 256 + up * 128 + (c0 & 127);
        tr_item8((up ? p.w_eu : p.w_eg) + ((size_t)l * 16 + e) * DM * 512, 512, DM, 64 * kb, c0, p.moe_norm + l * DM, 32.f, (unsigned char*)(wl + WO_GU) + ((size_t)e * 1024 + drow) * DM, scr, lane); return; }
    r -= 8192;
    { const int e = r / 256; r %= 256; const int kb = r / 32, nb = r % 32;
      tr_item8(p.w_ed + ((size_t)l * 16 + e) * 512 * DM, DM, 512, 64 * kb, 32 * nb, nullptr, 32.f, (unsigned char*)(wl + WO_D) + ((size_t)e * 1024 + 32 * nb) * 512, scr, lane); }
}
__device__ __forceinline__ void row_to_bf16(const float* src, bf16* dst, float* ssq, const float* gain, int lane, int mode) {
    const f32x4* s = (const f32x4*)src + lane;
    f32x4 v[4]; float q = 0.f;
#pragma unroll
    for (int j = 0; j < 4; ++j) { v[j] = s[64 * j]; q += (v[j].x * v[j].x + v[j].y * v[j].y) + (v[j].z * v[j].z + v[j].w * v[j].w); }
    q = wave_sum(q);
    float sc = 1.f;
    if (mode == 1) sc = rsqrtf(q * (1.0f / DM) + EPS);
    v2u* d = (v2u*)dst + lane; float q2 = 0.f;
#pragma unroll
    for (int j = 0; j < 4; ++j) {
        f32x4 g = (f32x4){1.f, 1.f, 1.f, 1.f}; if (mode == 1) g = ((const f32x4*)gain)[lane + 64 * j];
        v2u o; o.x = pk2(v[j].x * sc * g.x, v[j].y * sc * g.y); o.y = pk2(v[j].z * sc * g.z, v[j].w * sc * g.w); st_b64(d + 64 * j, o);
        const float r0 = __builtin_bit_cast(float, o.x << 16), r1 = __builtin_bit_cast(float, o.x & 0xffff0000u), r2 = __builtin_bit_cast(float, o.y << 16), r3 = __builtin_bit_cast(float, o.y & 0xffff0000u);
        q2 += (r0 * r0 + r1 * r1) + (r2 * r2 + r3 * r3); }
    if (mode == 0) { q2 = wave_sum(q2); if (lane < 16) ssq[lane] = lane == 0 ? q2 : 0.f; }
}
__device__ __forceinline__ void prologue(const P& p, LAS unsigned char* lds, int vcu, int G, int wave, int lane) {
    asm volatile("" : "+v"(lane));
    LAS float* scr = (LAS float*)(lds + LDS_STAGE + wave * 16384);
    const int gw = vcu * NWAVES + wave, NGW = G * NWAVES;
    for (int it = gw; it < NLAYER * IT_LAYER; it += NGW) prologue_item(p, it, scr, lane);
    for (int idx = gw * 64 + lane; idx < NLAYER * 2 * 32768; idx += NGW * 64) {
        const int l = idx / 65536, r = idx % 65536, which = r / 32768, e = r % 32768, row = e & 31, k = e >> 5;
        unsigned char* wl = ws_base(p.ws) + WS_W + (size_t)l * WS_WLAYER;
        if (which == 0) {
            float v = 0.f;
            if (row < 8) v = p.w_in[((size_t)l * DM + k) * INW + 1536 + row]; else if (row < 24) v = p.w_in[((size_t)l * DM + k) * INW + 3080 + (row - 8)];
            ((bf16*)(wl + WO_SM))[row * 1024 + k] = (bf16)f2bf(v * p.mix_norm[l * DM + k]);
        }
    }
    router_weights(p, gw * 64 + lane, NGW * 64);
    for (int m = gw; m < 4096; m += NGW) row_to_bf16(p.mem + (size_t)m * DM, WSP(bf16, WS_MEMN) + (size_t)m * DM, nullptr, p.mem_norm, lane, 1);
    { bf16* hbp = WSP(bf16, WS_HB); float* sqp = WSP(float, WS_SSQ);
      for (int m0 = gw * 4; m0 < NTOK; m0 += NGW * 4) {
        f32x4 v[4][4];
#pragma unroll
        for (int r = 0; r < 4; ++r)
#pragma unroll
            for (int j = 0; j < 4; ++j) v[r][j] = ((const f32x4*)(p.x + (size_t)(m0 + r) * DM))[lane + 64 * j];
#pragma unroll
        for (int r = 0; r < 4; ++r) { float q2 = 0.f; v2u* d = (v2u*)(hbp + (size_t)(m0 + r) * DM) + lane;
#pragma unroll
            for (int j = 0; j < 4; ++j) { v2u o; o.x = pk2(v[r][j].x, v[r][j].y); o.y = pk2(v[r][j].z, v[r][j].w); st_b64(d + 64 * j, o);
                const float r0 = __builtin_bit_cast(float, o.x << 16), r1 = __builtin_bit_cast(float, o.x & 0xffff0000u), r2 = __builtin_bit_cast(float, o.y << 16), r3 = __builtin_bit_cast(float, o.y & 0xffff0000u);
                q2 += (r0 * r0 + r1 * r1) + (r2 * r2 + r3 * r3); }
            q2 = wave_sum(q2); if (lane < 16) sqp[(size_t)(m0 + r) * 16 + lane] = lane == 0 ? q2 : 0.f; }
      } }
}
__device__ __forceinline__ void small_proj(const P& p, int l, LAS unsigned char* lds, int vcu, int G, int wave, int lane) {
    asm volatile("" : "+v"(lane));
    const bf16* wsm = (const bf16*)(ws_base(p.ws) + WS_W + (size_t)l * WS_WLAYER + WO_SM);
    const bf16* hb = WSP(bf16, WS_HB); const float* ssq = WSP(float, WS_SSQ); float* sm = WSP(float, WS_SM);
    constexpr int BST = 2048 + 16;
    { const int tid = wave * 64 + lane;
#pragma unroll
      for (int i = 0; i < 8; ++i) { const int idx = tid + NTHR * i, row = idx >> 7, c = idx & 127; *(LAS v4u*)(lds + row * BST + c * 16) = *(const v4u*)(wsm + row * 1024 + c * 8); } }
    __syncthreads();
    const int r = lane & 15, kq = lane >> 4;
    for (int blk = vcu * NWAVES + wave; blk < NTOK / 16; blk += G * NWAVES) {
        const int tok0 = blk * 16;
        const bf16x8* ap = (const bf16x8*)(hb + (size_t)(tok0 + r) * DM + kq * 32);
        pg8::f32x4 acc0 = {0.f, 0.f, 0.f, 0.f}, acc1 = {0.f, 0.f, 0.f, 0.f};
#pragma unroll
        for (int half = 0; half < 2; ++half) {
            bf16x8 af[16];
#pragma unroll
            for (int i = 0; i < 16; ++i) af[i] = ap[(half * 4 + (i >> 2)) * 16 + (i & 3)];
#pragma unroll
            for (int i = 0; i < 16; ++i) { const int s_ = half * 4 + (i >> 2), j = i & 3;
                const bf16x8 b0 = *(const LAS bf16x8*)(lds + r * BST + (128 * s_ + 32 * kq + 8 * j) * 2);
                const bf16x8 b1 = *(const LAS bf16x8*)(lds + (16 + r) * BST + (128 * s_ + 32 * kq + 8 * j) * 2);
                acc0 = __builtin_amdgcn_mfma_f32_16x16x32_bf16(af[i], b0, acc0, 0, 0, 0);
                acc1 = __builtin_amdgcn_mfma_f32_16x16x32_bf16(af[i], b1, acc1, 0, 0, 0);
                if ((i & 3) == 3) __builtin_amdgcn_sched_barrier(0); }
        }
        const float rsv = row_rs(ssq, tok0 + r);
#pragma unroll
        for (int g = 0; g < 4; ++g) { const int trow = 4 * kq + g; const float rs = __shfl(rsv, trow);
            sm[(size_t)(tok0 + trow) * 32 + r] = acc0[g] * rs; if (r < 8) sm[(size_t)(tok0 + trow) * 32 + 16 + r] = acc1[g] * rs; }
    }
    __syncthreads();
}
typedef short v4i16_t __attribute__((ext_vector_type(4)));
typedef __bf16 bf16x2_t __attribute__((ext_vector_type(2)));
typedef float f32x2_t __attribute__((ext_vector_type(2)));
__device__ __forceinline__ unsigned cvtpk(float lo, float hi) { f32x2_t v = {lo, hi}; bf16x2_t b = __builtin_convertvector(v, bf16x2_t); return __builtin_bit_cast(unsigned, b); }
__device__ __forceinline__ bf16x8 pack8(const f32x16& p, int o) {
    v4u w; w.x = cvtpk(p[o], p[o + 1]); w.y = cvtpk(p[o + 2], p[o + 3]); w.z = cvtpk(p[o + 4], p[o + 5]); w.w = cvtpk(p[o + 6], p[o + 7]);
    return __builtin_bit_cast(bf16x8, w);
}
__device__ __forceinline__ float max3f(float a, float b, float c) { float r; asm("v_max3_f32 %0, %1, %2, %3" : "=v"(r) : "v"(a), "v"(b), "v"(c)); return r; }
template <int D, bool FOX, bool OUT8 = false>
__device__ __forceinline__ void attn_unit(LAS unsigned char* lds, const bf16* Qg, int qpitch, const bf16* Kg, const bf16* Vg, int kvpitch, int NT,
                                          const float* cb, int q0, bf16* Og, int opitch, const float* gain, const float* kn) {
    constexpr int KS = D * 2 + 16, VS = D * 2 + 64;
    constexpr int KT = FOX ? 2 : 1, KEYS = 64 * KT;
    constexpr int KBYTES = KEYS * KS, VBYTES = KEYS * VS;
    constexpr int CPR = D / 8, NCH = KEYS * CPR / NTHR, NS = D / 16, NDB = D / 32;
    constexpr int OFF_K = 0, OFF_V = 2 * KBYTES, OFF_CB = 2 * KBYTES + 2 * VBYTES, OFF_FX = OFF_CB + 2 * KEYS * 4;
    int tid = threadIdx.x; asm volatile("" : "+v"(tid));
    const int lane = tid & 63, wave = __builtin_amdgcn_readfirstlane(tid >> 6), r32 = lane & 31, hh = lane >> 5;
    bf16x8 qf[NS];
    { const bf16* qrow = Qg + (size_t)(wave * 32 + r32) * qpitch;
#pragma unroll
      for (int s = 0; s < NS; ++s) qf[s] = *(const bf16x8*)(qrow + 16 * s + 8 * hh); }
    v4u kreg[NCH], vreg[NCH]; f32x4 cbreg = {0.f, 0.f, 0.f, 0.f};
#define AT_GLOAD(t) do { _Pragma("unroll") for (int i_ = 0; i_ < NCH; ++i_) { const int idx_ = tid + NTHR * i_, key_ = idx_ / CPR, c_ = idx_ % CPR; \
        kreg[i_] = *(const v4u*)(Kg + (size_t)((t) * KEYS + key_) * kvpitch + c_ * 8); vreg[i_] = *(const v4u*)(Vg + (size_t)((t) * KEYS + key_) * kvpitch + c_ * 8); } \
        if (FOX && tid < KEYS / 4) cbreg = *(const f32x4*)(cb + (t) * KEYS + tid * 4); } while (0)
#define AT_LSTORE(b) do { _Pragma("unroll") for (int i_ = 0; i_ < NCH; ++i_) { const int idx_ = tid + NTHR * i_, key_ = idx_ / CPR, c_ = idx_ % CPR; \
        *(LAS v4u*)(lds + OFF_K + (b) * KBYTES + key_ * KS + c_ * 16) = kreg[i_]; *(LAS v4u*)(lds + OFF_V + (b) * VBYTES + key_ * VS + c_ * 16) = vreg[i_]; } \
        if (FOX && tid < KEYS / 4) *(LAS f32x4*)(lds + OFF_CB + (b) * (KEYS * 4) + tid * 16) = cbreg; } while (0)
    float m = -INFINITY, l = 0.f;
    f32x16 osum = f32x16{};
    f32x16 o[NDB];
#pragma unroll
    for (int d = 0; d < NDB; ++d) o[d] = f32x16{};
    const int qlo = q0 + wave * 32, qabs = qlo + r32;
    float knpre = 0.f, qkmax = 0.f;
    LAS float* fx = (LAS float*)(lds + OFF_FX);
    const int NTG = NT / KT;
    const int t_first = FOX ? NTG - 1 : 0;
    AT_GLOAD(t_first);
    __syncthreads();
    if (FOX) {
        float qn2 = 0.f;
#pragma unroll
        for (int s = 0; s < NS; ++s)
#pragma unroll
            for (int e = 0; e < 8; ++e) { const float v = __builtin_bit_cast(float, ((unsigned)(unsigned short)qf[s][e]) << 16); qn2 += v * v; }
        qn2 += __shfl_xor(qn2, 32);
        qn2 = wave_max(qn2);
        if (lane == 0) fx[wave] = qn2;
        knpre = lane < 32 ? kn[lane] : 0.f;
#pragma unroll
        for (int o_ = 1; o_ < 32; o_ <<= 1) { const float t_ = __shfl_up(knpre, o_); if (lane >= o_) knpre = fmaxf(knpre, t_); }
    }
    AT_LSTORE(0);
    __syncthreads();
    if (FOX) { float q2 = fx[0];
#pragma unroll
        for (int w_ = 1; w_ < 8; ++w_) q2 = fmaxf(q2, fx[w_]);
        qkmax = sqrtf(q2); }
#pragma unroll 1
    for (int it = 0; it < NTG; ++it) {
        const int b = it & 1;
        const int tg = FOX ? NTG - 1 - it : it;
        const int tn = FOX ? tg - 1 : tg + 1;
        if (it + 1 < NTG) AT_GLOAD(tn);
#pragma unroll
        for (int sub_ = 0; sub_ < KT; ++sub_) {
        const int sub = FOX ? KT - 1 - sub_ : sub_, koff = sub * 64;
        const int kt0 = (tg * KT + sub) * 64;
        if (!FOX || kt0 <= qlo + 31) {
            f32x16 p[2];
#pragma unroll
            for (int kb = 0; kb < 2; ++kb) {
                if (FOX) {
#pragma unroll
                    for (int g = 0; g < 4; ++g) { const f32x4 c4 = *(const LAS f32x4*)(lds + OFF_CB + b * (KEYS * 4) + (koff + kb * 32 + 8 * g + 4 * hh) * 4); p[kb][4 * g] = c4.x; p[kb][4 * g + 1] = c4.y; p[kb][4 * g + 2] = c4.z; p[kb][4 * g + 3] = c4.w; }
                } else p[kb] = f32x16{};
                const LAS unsigned char* kp = lds + OFF_K + b * KBYTES + (koff + kb * 32 + r32) * KS + hh * 16;
#pragma unroll
                for (int s = 0; s < NS; ++s) { const bf16x8 kf = *(const LAS bf16x8*)(kp + s * 32); p[kb] = __builtin_amdgcn_mfma_f32_32x32x16_bf16(kf, qf[s], p[kb], 0, 0, 0); }
            }
            if (FOX && kt0 + 63 > qlo) {
#pragma unroll
                for (int kb = 0; kb < 2; ++kb)
#pragma unroll
                    for (int r = 0; r < 16; ++r) { const int key = kt0 + kb * 32 + (r & 3) + 8 * (r >> 2) + 4 * hh; if (key > qabs) p[kb][r] = -INFINITY; }
            }
            float mt = fmaxf(p[1][0], p[0][0]);
#pragma unroll
            for (int r = 1; r < 16; ++r) mt = max3f(mt, p[0][r], p[1][r]);
            mt = fmaxf(mt, __shfl_xor(mt, 32));
            const float mnew = fmaxf(m, mt);
            float ls = 0.f;
#pragma unroll
            for (int kb = 0; kb < 2; ++kb)
#pragma unroll
                for (int r = 0; r < 16; ++r) { const float e = __builtin_amdgcn_exp2f(p[kb][r] - mnew); p[kb][r] = e; if (!FOX) ls += e; }
            if (!FOX || __builtin_amdgcn_ballot_w64(mnew > m) != 0ull) {
                const float alpha = __builtin_amdgcn_exp2f(m - mnew);
                l *= alpha; if (FOX) osum[0] *= alpha;
#pragma unroll
                for (int d = 0; d < NDB; ++d)
#pragma unroll
                    for (int r = 0; r < 16; ++r) o[d][r] *= alpha;
            }
            m = mnew; l += ls;
            bf16x8 pa[2][2];
#pragma unroll
            for (int kb = 0; kb < 2; ++kb) { pa[kb][0] = pack8(p[kb], 0); pa[kb][1] = pack8(p[kb], 8); }
            const LAS unsigned char* vp = lds + OFF_V + b * VBYTES + (koff + 4 * hh + ((lane & 15) >> 2)) * VS + (16 * ((lane >> 4) & 1) + 4 * (lane & 3)) * 2;
#pragma unroll
            for (int d = 0; d < NDB; ++d) {
#pragma unroll
                for (int kb = 0; kb < 2; ++kb)
#pragma unroll
                    for (int ks = 0; ks < 2; ++ks) {
                        const LAS unsigned char* a0 = vp + (kb * 32 + 16 * ks) * VS + d * 64;
                        const v4i16_t lo = __builtin_amdgcn_ds_read_tr16_b64_v4i16((LAS v4i16_t*)a0);
                        const v4i16_t hi = __builtin_amdgcn_ds_read_tr16_b64_v4i16((LAS v4i16_t*)(a0 + 8 * VS));
                        const bf16x8 vf = (bf16x8){lo[0], lo[1], lo[2], lo[3], hi[0], hi[1], hi[2], hi[3]};
                        o[d] = __builtin_amdgcn_mfma_f32_32x32x16_bf16(vf, pa[kb][ks], o[d], 0, 0, 0);
                    }
            }
            if (FOX) {
                const bf16x8 ones = __builtin_bit_cast(bf16x8, (v4u){0x3F803F80u, 0x3F803F80u, 0x3F803F80u, 0x3F803F80u});
#pragma unroll
                for (int kb = 0; kb < 2; ++kb)
#pragma unroll
                    for (int ks = 0; ks < 2; ++ks) osum = __builtin_amdgcn_mfma_f32_32x32x16_bf16(ones, pa[kb][ks], osum, 0, 0, 0);
            }
        }
        }
        if (FOX) { const float mm = wave_min(m); if (lane == 0) fx[8 + b * 8 + wave] = mm; }
        if (it + 1 < NTG) AT_LSTORE(b ^ 1);
        __syncthreads();
        if (FOX && tg > 0) {
            float M0 = fx[8 + b * 8];
#pragma unroll
            for (int w_ = 1; w_ < 8; ++w_) M0 = fminf(M0, fx[8 + b * 8 + w_]);
            const float cbl = *(const LAS float*)(lds + OFF_CB + (b ^ 1) * (KEYS * 4) + (KEYS - 1) * 4);
            const float knb = __builtin_bit_cast(float, __builtin_amdgcn_readlane(__builtin_bit_cast(int, knpre), tg * KT - 1));
            if (qkmax * knb + cbl < M0 - 40.f) break;
        }
    }
#undef AT_GLOAD
#undef AT_LSTORE
    if (FOX) l = osum[0]; else l += __shfl_xor(l, 32);
    const float inv = 1.0f / l;
    float rs = inv;
    if (FOX) {
        float ss = 0.f;
#pragma unroll
        for (int d = 0; d < NDB; ++d)
#pragma unroll
            for (int r = 0; r < 16; ++r) { const float v = o[d][r] * inv; ss += v * v; }
        ss += __shfl_xor(ss, 32);
        rs = inv * rsqrtf(ss * (1.0f / D) + EPS);
    }
    constexpr int SROW = 144;
    LAS unsigned char* stg = lds + OFF_K + wave * (32 * SROW);
#pragma unroll
    for (int d = 0; d < NDB; ++d)
#pragma unroll
        for (int g = 0; g < 4; ++g) {
            if (OUT8) { *(LAS unsigned*)(stg + r32 * SROW + 32 * d + 8 * g + 4 * hh) = pk4_fp8(o[d][4 * g] * rs, o[d][4 * g + 1] * rs, o[d][4 * g + 2] * rs, o[d][4 * g + 3] * rs); }
            else { f32x4 gn = {1.f, 1.f, 1.f, 1.f}; if (FOX) gn = *(const f32x4*)(gain + 32 * d + 8 * g + 4 * hh);
                v2u w; w.x = cvtpk(o[d][4 * g] * rs * gn.x, o[d][4 * g + 1] * rs * gn.y); w.y = cvtpk(o[d][4 * g + 2] * rs * gn.z, o[d][4 * g + 3] * rs * gn.w);
                *(LAS v2u*)(stg + r32 * SROW + (32 * d + 8 * g + 4 * hh) * 2) = w; }
        }
    static_assert((OUT8 ? D : D * 2) == 128, "stage rows are 128 bytes");
    { unsigned char* ob = (unsigned char*)Og; const size_t pitchb = (size_t)opitch * (OUT8 ? 1 : 2);
#pragma unroll
      for (int i = 0; i < 4; ++i) { const int row = i * 8 + (lane >> 3), ch = lane & 7;
          const v4u w = *(const LAS v4u*)(stg + row * SROW + ch * 16);
          st_b128(ob + (size_t)(wave * 32 + row) * pitchb + ch * 16, w); } }
}
__device__ __forceinline__ void fox_phase(const P& p, int l, LAS unsigned char* lds, int vcu, int G) {
    const bf16* proj = WSP(bf16, WS_PROJ); const float* cb = WSP(float, WS_CB); bf16* y = WSP(bf16, WS_Y);
    for (int pu = vcu; pu < 512; pu += G) {
        const int bh = pu >> 2, pr = pu < 256 ? (pu & 3) : 3 - (pu & 3), b = bh >> 3, h = bh & 7;
        for (int half = 0; half < 2; ++half) {
            const int qb = half ? pr : 7 - pr;
            const size_t row0 = (size_t)b * SEQ;
            attn_unit<64, true>(lds, proj + (row0 + qb * 256) * PW + C_FQ + h * 64, PW, proj + row0 * PW + C_FK + h * 64, proj + row0 * PW + C_FV + h * 64, PW, 4 * (qb + 1),
                                cb + ((size_t)b * 8 + h) * SEQ, qb * 256, y + (row0 + qb * 256) * DM + h * 64, DM, p.fox_gain + l * 512 + h * 64, WSP(const float, WS_MOE + MO_KN) + (b * 8 + h) * 32);
        }
    }
}
__device__ __forceinline__ void xattn_phase(const P& p, int l, LAS unsigned char* lds, int vcu, int G, bool dummy) {
    bf16* xq = WSP(bf16, WS_XQ); const bf16* xkv = WSP(bf16, WS_XKV);
    for (int u = vcu; u < 512; u += G) {
        const int b = u >> 5, h = (u >> 3) & 3, qb = u & 7;
        bf16* qp = xq + ((size_t)b * SEQ + qb * 256) * 512 + h * 128;
        const bf16* kp = xkv + (size_t)b * MEML * 2048 + l * 1024 + h * 128;
        attn_unit<128, false, true>(lds, qp, 512, kp, kp + 512, 2048, 4, nullptr, 0, (bf16*)((dummy ? WSP(unsigned char, WS_Y) : WSP(unsigned char, WS_XO8)) + ((size_t)b * SEQ + qb * 256) * 512 + h * 128), 512, nullptr, nullptr);
    }
}

__device__ __forceinline__ void xattn_pair(const P& p, int l, LAS unsigned char* lds, int pm, int pn, bool dummy) {
    const bf16* xq = WSP(bf16, WS_XQ); const bf16* xkv = WSP(bf16, WS_XKV);
    const int b = pm >> 3;
    for (int hh2 = 0; hh2 < 2; ++hh2) {
        const int h = 2 * pn + hh2;
        const bf16* qp = xq + (size_t)pm * 256 * 512 + h * 128;
        const bf16* kp = xkv + (size_t)b * MEML * 2048 + l * 1024 + h * 128;
        attn_unit<128, false, true>(lds, qp, 512, kp, kp + 512, 2048, 4, nullptr, 0, (bf16*)((dummy ? WSP(unsigned char, WS_Y) : WSP(unsigned char, WS_XO8)) + (size_t)pm * 256 * 512 + h * 128), 512, nullptr, nullptr);
    }
}
constexpr size_t WS_GB = WS_END;
constexpr size_t WS_GDEC = WS_GB + 32 * MiB;
constexpr size_t WS_END2 = WS_GDEC + 1 * MiB;
static_assert(WS_END2 <= 512 * MiB, "workspace map 2");
constexpr int GL_B = 0;
constexpr int GL_TOT = 16384;
constexpr int GL_Q1 = 18432, GL_Q2 = GL_Q1 + 64 * 144, GL_K2 = GL_Q2 + 64 * 144;
constexpr int GL_KD = GL_K2 + 64 * 144;
constexpr int GL_V = GL_KD + 64 * 192;
constexpr int GL_SSQ = GL_V + 64 * 320;
constexpr int GL_GA = GL_SSQ + 1024;
constexpr int GL_YST = GL_GA + 4096;
constexpr int GL_GG = GL_YST + 64 * 272;
constexpr int GL_END = GL_GG + 64 * 272;
static_assert(GL_END <= 131072, "gla lds");

__device__ __forceinline__ float fast_log_sigmoid(float z) { return fminf(z, 0.f) - __logf(1.f + __expf(-fabsf(z))); }
__device__ __forceinline__ void gla_load_v(const bf16* proj, size_t tok0, int h, LAS unsigned char* lds, int tid) {
#pragma unroll
    for (int i = 0; i < 2; ++i) { const int idx = tid + NTHR * i, t = idx >> 4, c = idx & 15;
        *(LAS v4u*)(lds + GL_V + t * 320 + c * 16) = *(const v4u*)(proj + (tok0 + t) * PW + C_GV + h * 128 + c * 8); }
}
__device__ __forceinline__ bf16x8 tr_frag(const LAS unsigned char* a0, int rowstride4) {
    const v4i16_t lo = __builtin_amdgcn_ds_read_tr16_b64_v4i16((LAS v4i16_t*)a0);
    const v4i16_t hi = __builtin_amdgcn_ds_read_tr16_b64_v4i16((LAS v4i16_t*)(a0 + rowstride4));
    return (bf16x8){lo[0], lo[1], lo[2], lo[3], hi[0], hi[1], hi[2], hi[3]};
}
constexpr int GA_WAVE = 19456, GA_SROW = 144;
static_assert(8 * GA_WAVE <= LDS_MISC && 128 * GA_SROW <= GA_WAVE, "gla phase A lds");
__device__ __forceinline__ void gla_phase_a(const P& p, int l, LAS unsigned char* lds, int vcu, int G) {
    int tid = threadIdx.x; asm volatile("" : "+v"(tid));
    const int lane = tid & 63, wave = __builtin_amdgcn_readfirstlane(tid >> 6), hh = lane >> 5;
    const bf16* proj = WSP(bf16, WS_PROJ); bf16* loc = ((bf16*)p.out); float* dec = WSP(float, WS_GDEC); const float* sm = WSP(float, WS_SM); _Float16* gb = WSP(_Float16, WS_GB);
    LAS unsigned char* kd = lds + wave * GA_WAVE; LAS unsigned char* vh = kd + 8192;
    const int crow8 = lane >> 3, cch = lane & 7;
    const int trow = (lane & 15) >> 2, tcol = 16 * ((lane >> 4) & 1) + 4 * (lane & 3);
    for (int u = vcu * NWAVES + wave; u < 2048; u += G * NWAVES) {
        const int c = u & 31, h = (u >> 5) & 3, b = u >> 7;
        const size_t tok0 = (size_t)b * SEQ + c * 64;
        v4u kreg[8], v0reg[8], v1reg[8];
#pragma unroll
        for (int i = 0; i < 8; ++i) { const bf16* rp = proj + (tok0 + i * 8 + crow8) * PW;
            kreg[i] = *(const v4u*)(rp + C_GK + h * 64 + cch * 8); v0reg[i] = *(const v4u*)(rp + C_GV + h * 128 + cch * 8); v1reg[i] = *(const v4u*)(rp + C_GV + h * 128 + 64 + cch * 8); }
        float w[16];
#pragma unroll
        for (int r = 0; r < 16; ++r) w[r] = p.w_alpha_up[((size_t)l * 16 + r) * 256 + h * 64 + lane];
        const float bias = p.b_alpha[l * 256 + h * 64 + lane];
        { LAS f32x4* gw = (LAS f32x4*)vh;
#pragma unroll
          for (int i = 0; i < 4; ++i) gw[lane * 4 + i] = *(const f32x4*)(sm + (tok0 + lane) * 32 + 8 + 4 * i); }
        float bt[64]; float run = 0.f;
#pragma unroll
        for (int t = 0; t < 64; ++t) {
            float z = bias;
#pragma unroll
            for (int r4 = 0; r4 < 4; ++r4) { const f32x4 g4 = ((const LAS f32x4*)vh)[t * 4 + r4]; z += g4.x * w[4 * r4] + g4.y * w[4 * r4 + 1] + g4.z * w[4 * r4 + 2] + g4.w * w[4 * r4 + 3]; }
            run += fast_log_sigmoid(z) * (1.0f / 16.0f); bt[t] = run; gb[(tok0 + t) * 256 + h * 64 + lane] = (_Float16)run;
        }
#pragma unroll
        for (int i = 0; i < 8; ++i) { *(LAS v4u*)(kd + (i * 8 + crow8) * 128 + cch * 16) = kreg[i]; *(LAS v4u*)(vh + (i * 8 + crow8) * 128 + cch * 16) = v0reg[i]; }
#pragma unroll
        for (int t = 0; t < 64; ++t) { LAS bf16* kp = (LAS bf16*)(kd + t * 128 + lane * 2); *kp = (bf16)f2bf(bf2f(*kp) * __expf(run - bt[t])); }
        dec[(size_t)u * 64 + lane] = __expf(run);
        f32x16 acc[2][2][2];
#pragma unroll
        for (int half = 0; half < 2; ++half) {
            if (half == 1) {
#pragma unroll
                for (int i = 0; i < 8; ++i) *(LAS v4u*)(vh + (i * 8 + crow8) * 128 + cch * 16) = v1reg[i];
            }
#pragma unroll
            for (int x = 0; x < 2; ++x)
#pragma unroll
                for (int y = 0; y < 2; ++y) acc[half][y][x] = f32x16{};
#pragma unroll
            for (int s = 0; s < 4; ++s) {
                bf16x8 af[2], bfr[2];
#pragma unroll
                for (int x = 0; x < 2; ++x) { af[x] = tr_frag(vh + (16 * s + 8 * hh + trow) * 128 + (32 * x + tcol) * 2, 4 * 128); bfr[x] = tr_frag(kd + (16 * s + 8 * hh + trow) * 128 + (32 * x + tcol) * 2, 4 * 128); }
#pragma unroll
                for (int x = 0; x < 2; ++x)
#pragma unroll
                    for (int y = 0; y < 2; ++y) acc[half][y][x] = __builtin_amdgcn_mfma_f32_32x32x16_bf16(bfr[y], af[x], acc[half][y][x], 0, 0, 0);
            }
        }
#pragma unroll
        for (int half = 0; half < 2; ++half)
#pragma unroll
            for (int x = 0; x < 2; ++x)
#pragma unroll
                for (int y = 0; y < 2; ++y)
#pragma unroll
                    for (int g = 0; g < 4; ++g) { const f32x16& a = acc[half][y][x];
                        v2u w2; w2.x = cvtpk(a[4 * g], a[4 * g + 1]); w2.y = cvtpk(a[4 * g + 2], a[4 * g + 3]);
                        *(LAS v2u*)(kd + (64 * half + 32 * x + (lane & 31)) * GA_SROW + (32 * y + 8 * g + 4 * hh) * 2) = w2; }
#pragma unroll
        for (int i = 0; i < 16; ++i) { const int idx = lane + 64 * i, row = idx >> 3, ch = idx & 7;
            st_b128(loc + (size_t)u * 8192 + row * 64 + ch * 8, *(const LAS v4u*)(kd + row * GA_SROW + ch * 16)); }
    }
}
__device__ __forceinline__ void gla_phase_b(const P& p, int vcu, int G) {
    int tid = threadIdx.x; asm volatile("" : "+v"(tid));
    const bf16* loc = ((const bf16*)p.out); const float* dec = WSP(float, WS_GDEC); bf16* gs = (bf16*)((unsigned char*)p.out + 96 * MiB);
    for (int u = vcu; u < 256; u += G) {
        const int bh = u >> 2, q4 = u & 3;
        const int e = q4 * 2048 + tid * 4, dk = e & 63;
        f32x4 st = {0.f, 0.f, 0.f, 0.f};
#pragma unroll 8
        for (int c = 0; c < 32; ++c) {
            const size_t cu = (size_t)bh * 32 + c;
            const v2u lw = *(const v2u*)(loc + cu * 8192 + e);
            const f32x4 lv = {__builtin_bit_cast(float, lw.x << 16), __builtin_bit_cast(float, lw.x & 0xffff0000u), __builtin_bit_cast(float, lw.y << 16), __builtin_bit_cast(float, lw.y & 0xffff0000u)};
            const f32x4 dv = *(const f32x4*)(dec + cu * 64 + dk);
            v2u w; w.x = pk2(st.x, st.y); w.y = pk2(st.z, st.w);
            *(v2u*)(gs + cu * 8192 + e) = w;
            st = dv * st + lv;
        }
    }
}
__device__ __forceinline__ void gla_phase_c(const P& p, int l, LAS unsigned char* lds, int vcu, int G) {
    int tid = threadIdx.x; asm volatile("" : "+v"(tid));
    const int lane = tid & 63, wave = __builtin_amdgcn_readfirstlane(tid >> 6), hh = lane >> 5, r32 = lane & 31;
    const bf16* proj = WSP(bf16, WS_PROJ); const bf16* gs = (const bf16*)((const unsigned char*)p.out + 96 * MiB); bf16* y = WSP(bf16, WS_Y); const _Float16* gb = WSP(const _Float16, WS_GB);
    const int dvb = wave >> 1, tb = wave & 1;
    const int trow = (lane & 15) >> 2, tcol = 16 * ((lane >> 4) & 1) + 4 * (lane & 3);
    bf16 n_q[8], n_k[8]; v4u n_v[2], n_g[2]; bf16x8 n_s[4]; f32x4 n_n[4]; float n_b[8], n_r = 0.f;
#define GC_LOAD(uu) do { const int c_ = (uu) & 31, h_ = ((uu) >> 5) & 3, b_ = (uu) >> 7; const size_t t0_ = (size_t)b_ * SEQ + c_ * 64; \
        _Pragma("unroll") for (int j = 0; j < 8; ++j) { const bf16* rp = proj + (t0_ + wave * 8 + j) * PW + h_ * 64 + lane; n_q[j] = rp[C_GQ]; n_k[j] = rp[C_GK]; } \
        _Pragma("unroll") for (int i = 0; i < 2; ++i) { const int idx = tid + NTHR * i, t = idx >> 4, cc = idx & 15; n_v[i] = *(const v4u*)(proj + (t0_ + t) * PW + C_GV + h_ * 128 + cc * 8); n_g[i] = *(const v4u*)(proj + (t0_ + t) * PW + C_GG + h_ * 128 + cc * 8); } \
        { const bf16* sp = gs + (size_t)(uu) * 8192 + (size_t)(32 * dvb + r32) * 64 + 8 * hh; \
          _Pragma("unroll") for (int s2 = 0; s2 < 4; ++s2) n_s[s2] = *(const bf16x8*)(sp + 16 * s2); } \
        _Pragma("unroll") for (int j = 0; j < 8; ++j) n_b[j] = (float)gb[(t0_ + wave * 8 + j) * 256 + h_ * 64 + lane]; \
        n_r = (float)gb[(t0_ + 31) * 256 + h_ * 64 + lane]; \
        _Pragma("unroll") for (int g = 0; g < 4; ++g) { const int dv = 32 * dvb + 8 * g + 4 * hh; \
            n_n[g] = *(const f32x4*)(p.gla_gain + l * 512 + h_ * 128 + dv); } } while (0)
    if (vcu < 2048) GC_LOAD(vcu);
    __syncthreads();
    for (int u = vcu; u < 2048; u += G) {
        const int c = u & 31, h = (u >> 5) & 3, b = u >> 7;
        const size_t tok0 = (size_t)b * SEQ + c * 64;
        bf16x8 sfr[4]; f32x4 gnr[4];
#pragma unroll
        for (int i = 0; i < 4; ++i) { sfr[i] = n_s[i]; gnr[i] = n_n[i]; }
#pragma unroll
        for (int i = 0; i < 2; ++i) { const int idx = tid + NTHR * i, t = idx >> 4, cc = idx & 15; *(LAS v4u*)(lds + GL_V + t * 320 + cc * 16) = n_v[i]; *(LAS v4u*)(lds + GL_GG + t * 272 + cc * 16) = n_g[i]; }
        { const float rref = n_r;
#pragma unroll
          for (int j = 0; j < 8; ++j) { const int t = wave * 8 + j; const float bt = n_b[j];
            const float qv = bf2f(n_q[j]), kv = bf2f(n_k[j]);
            *(LAS bf16*)(lds + GL_Q1 + t * 144 + lane * 2) = (bf16)f2bf(qv * __expf(bt));
            *(LAS bf16*)(lds + GL_Q2 + t * 144 + lane * 2) = (bf16)f2bf(qv * __expf(bt - rref));
            *(LAS bf16*)(lds + GL_K2 + t * 144 + lane * 2) = (bf16)f2bf(kv * __expf(rref - bt)); } }
        __syncthreads();
        if (u + G < 2048) GC_LOAD(u + G);
        f32x16 o = {};
        {
#pragma unroll
          for (int s = 0; s < 4; ++s) { const bf16x8 af = sfr[s]; const bf16x8 bq = *(const LAS bf16x8*)(lds + GL_Q1 + (32 * tb + r32) * 144 + (16 * s + 8 * hh) * 2);
              o = __builtin_amdgcn_mfma_f32_32x32x16_bf16(af, bq, o, 0, 0, 0); } }
#pragma unroll
        for (int sb = 0; sb < 2; ++sb) {
            if (sb <= tb) {
                f32x16 pt = {};
#pragma unroll
                for (int s = 0; s < 4; ++s) { const bf16x8 ak = *(const LAS bf16x8*)(lds + GL_K2 + (32 * sb + r32) * 144 + (16 * s + 8 * hh) * 2); const bf16x8 bq = *(const LAS bf16x8*)(lds + GL_Q2 + (32 * tb + r32) * 144 + (16 * s + 8 * hh) * 2);
                    pt = __builtin_amdgcn_mfma_f32_32x32x16_bf16(ak, bq, pt, 0, 0, 0); }
                if (sb == tb) {
#pragma unroll
                    for (int r = 0; r < 16; ++r) { const int s_ = (r & 3) + 8 * (r >> 2) + 4 * hh; if (s_ > r32) pt[r] = 0.f; }
                }
#pragma unroll
                for (int ks = 0; ks < 2; ++ks) {
                    const bf16x8 pa = pack8(pt, 8 * ks);
                    const bf16x8 vf = tr_frag(lds + GL_V + (32 * sb + 16 * ks + 4 * hh + trow) * 320 + (32 * dvb + tcol) * 2, 8 * 320);
                    o = __builtin_amdgcn_mfma_f32_32x32x16_bf16(vf, pa, o, 0, 0, 0);
                }
            }
        }
        float ss = 0.f;
#pragma unroll
        for (int r = 0; r < 16; ++r) ss += o[r] * o[r];
        ss += __shfl_xor(ss, 32);
        LAS float* sq = (LAS float*)(lds + GL_SSQ);
        if (hh == 0) sq[dvb * 64 + 32 * tb + r32] = ss;
        __syncthreads();
        const int t = 32 * tb + r32;
        const float tot = (sq[t] + sq[64 + t]) + (sq[128 + t] + sq[192 + t]);
        const float rs = rsqrtf(tot * (1.0f / 128.0f) + EPS);
#pragma unroll
        for (int g = 0; g < 4; ++g) {
            const int dv = 32 * dvb + 8 * g + 4 * hh;
            const f32x4 gn = gnr[g];
            const v2u gg = *(const LAS v2u*)(lds + GL_GG + t * 272 + dv * 2);
            const float g0 = bf2f((bf16)(gg.x & 0xffff)), g1 = bf2f((bf16)(gg.x >> 16)), g2 = bf2f((bf16)(gg.y & 0xffff)), g3 = bf2f((bf16)(gg.y >> 16));
            const float v0 = o[4 * g] * rs * gn.x * g0 * __builtin_amdgcn_rcpf(1.f + __expf(-g0)), v1 = o[4 * g + 1] * rs * gn.y * g1 * __builtin_amdgcn_rcpf(1.f + __expf(-g1));
            const float v2 = o[4 * g + 2] * rs * gn.z * g2 * __builtin_amdgcn_rcpf(1.f + __expf(-g2)), v3 = o[4 * g + 3] * rs * gn.w * g3 * __builtin_amdgcn_rcpf(1.f + __expf(-g3));
            v2u w; w.x = cvtpk(v0, v1); w.y = cvtpk(v2, v3);
            *(LAS v2u*)(lds + GL_YST + t * 272 + dv * 2) = w;
        }
        __syncthreads();
#pragma unroll
        for (int i = 0; i < 2; ++i) { const int idx = tid + NTHR * i, tr_ = idx >> 4, ch = idx & 15;
            st_b128(y + (tok0 + tr_) * DM + 512 + h * 128 + ch * 8, *(const LAS v4u*)(lds + GL_YST + tr_ * 272 + ch * 16)); }
    }
#undef GC_LOAD
}
__device__ __forceinline__ void fox_cumsum_phase(const P& p, int l, LAS unsigned char* lds, int vcu, int G) {
    int tid = threadIdx.x; asm volatile("" : "+v"(tid));
    const int lane = tid & 63, wave = __builtin_amdgcn_readfirstlane(tid >> 6);
    const float* sm = WSP(float, WS_SM); float* cb = WSP(float, WS_CB);
    LAS float* tot = (LAS float*)(lds + 256);
    for (int u = vcu; u < NBATCH * 8; u += G) {
        const int b = u >> 3, h = u & 7;
        const float bias = p.b_forget[l * 8 + h];
        const int s0 = wave * 256 + lane * 4;
        float v[4]; float run = 0.f;
#pragma unroll
        for (int j = 0; j < 4; ++j) v[j] = sm[((size_t)b * SEQ + s0 + j) * 32 + h];
#pragma unroll
        for (int j = 0; j < 4; ++j) { run += fast_log_sigmoid(v[j] + bias); v[j] = run; }
        float pre = run;
#pragma unroll
        for (int o = 1; o < 64; o <<= 1) { const float t = __shfl_up(pre, o); if (lane >= o) pre += t; }
        __syncthreads();
        if (lane == 63) tot[wave] = pre;
        __syncthreads();
        float base = pre - run;
#pragma unroll
        for (int w_ = 0; w_ < 8; ++w_) { const float t = tot[w_]; if (w_ < wave) base += t; }
        f32x4 o4; o4.x = -(v[0] + base) * LOG2E; o4.y = -(v[1] + base) * LOG2E; o4.z = -(v[2] + base) * LOG2E; o4.w = -(v[3] + base) * LOG2E;
        *(f32x4*)(cb + ((size_t)b * 8 + h) * SEQ + s0) = o4;
    }
}
__device__ __forceinline__ void fox_knorm_phase(const P& p, int vcu, int G) {
    int tid = threadIdx.x; asm volatile("" : "+v"(tid));
    const int lane = tid & 63, wave = __builtin_amdgcn_readfirstlane(tid >> 6);
    const bf16* proj = WSP(bf16, WS_PROJ); float* kn = WSP(float, WS_MOE + MO_KN);
    for (int task = vcu * NWAVES + wave; task < NBATCH * 8 * 32; task += G * NWAVES) {
        const int j = task & 31, h = (task >> 5) & 7, b = task >> 8;
        float mx = 0.f;
#pragma unroll
        for (int i = 0; i < 8; ++i) {
            const v4u w = *(const v4u*)(proj + ((size_t)b * SEQ + j * 64 + i * 8 + (lane >> 3)) * PW + C_FK + h * 64 + (lane & 7) * 8);
            const unsigned ww[4] = {w.x, w.y, w.z, w.w}; float ss = 0.f;
#pragma unroll
            for (int e = 0; e < 4; ++e) { const float a = __builtin_bit_cast(float, ww[e] << 16), c = __builtin_bit_cast(float, ww[e] & 0xffff0000u); ss += a * a + c * c; }
            ss += __shfl_xor(ss, 1); ss += __shfl_xor(ss, 2); ss += __shfl_xor(ss, 4);
            mx = fmaxf(mx, ss);
        }
        mx = wave_max(mx);
        if (lane == 0) kn[task] = sqrtf(mx) * 1.0001f;
    }
}
__device__ __forceinline__ void router_weights(const P& p, int gtid, int gstride) {
    for (int idx = gtid; idx < NLAYER * 32768; idx += gstride) {
        const int l = idx >> 15, r = idx & 32767, k = r >> 5, n = r & 31;
        float v = 0.f;
        if (n < 16) v = p.w_re[((size_t)l * DM + k) * 16 + n]; else if (n < 20) v = p.w_rg[((size_t)l * DM + k) * 4 + (n - 16)];
        v *= p.moe_norm[l * DM + k];
        float* wr = (float*)(ws_base(p.ws) + WS_W + (size_t)l * WS_WLAYER + WO_RHI);
        wr[((((k >> 5) * 4 + ((k >> 3) & 3)) * 2 + ((k >> 2) & 1)) * 32 + n) * 4 + (k & 3)] = v;
    }
}
__device__ __forceinline__ void route_phase(const P& p, int l, LAS unsigned char* lds, int vcu, int G) {
    int tid = threadIdx.x; asm volatile("" : "+v"(tid));
    const int lane = tid & 63, wave = __builtin_amdgcn_readfirstlane(tid >> 6);
    { const v4u* src = (const v4u*)(ws_base(p.ws) + WS_W + (size_t)l * WS_WLAYER + WO_RHI);
#pragma unroll 4
      for (int i = 0; i < 16; ++i) *(LAS v4u*)(lds + LDS_STAGE + (tid + NTHR * i) * 16) = src[tid + NTHR * i]; }
    LAS int* hist = (LAS int*)(lds + LDS_GATE);
    if (tid < 32) hist[tid] = 0;
    __syncthreads();
    const bf16* HBp = WSP(const bf16, WS_HB);
    int2* toke = WSP(int2, WS_MOE + MO_TOKE); float2* tokg = WSP(float2, WS_MOE + MO_TOKG);
    LAS float* lgb = (LAS float*)(lds + LDS_RS + wave * 2048);
    const int r = lane & 15, kq = lane >> 4;
    for (int task = vcu * NWAVES + wave; task < NTOK / 16; task += G * NWAVES) {
        const int tok0 = task * 16;
        const v4u* hp = (const v4u*)(HBp + (size_t)(tok0 + r) * DM + 8 * kq);
        f32x4 acc0 = {0.f, 0.f, 0.f, 0.f}, acc1 = {0.f, 0.f, 0.f, 0.f}; float q = 0.f;
#pragma unroll 8
        for (int s = 0; s < 32; ++s) {
            const v4u aw = hp[4 * s];
            const unsigned ww[4] = {aw.x, aw.y, aw.z, aw.w};
            const LAS unsigned char* bp = lds + LDS_STAGE + ((s * 4 + kq) * 2 * 32 + r) * 16;
            const f32x4 b00 = *(const LAS f32x4*)(bp), b01 = *(const LAS f32x4*)(bp + 32 * 16), b10 = *(const LAS f32x4*)(bp + 16 * 16), b11 = *(const LAS f32x4*)(bp + 48 * 16);
#pragma unroll
            for (int e = 0; e < 4; ++e) {
                const float a0 = __builtin_bit_cast(float, ww[e] << 16), a1 = __builtin_bit_cast(float, ww[e] & 0xffff0000u);
                q += a0 * a0 + a1 * a1;
                const f32x4& bl = e < 2 ? b00 : b01; const f32x4& bh = e < 2 ? b10 : b11;
                acc0 = __builtin_amdgcn_mfma_f32_16x16x4f32(a0, bl[(2 * e) & 3], acc0, 0, 0, 0); acc1 = __builtin_amdgcn_mfma_f32_16x16x4f32(a0, bh[(2 * e) & 3], acc1, 0, 0, 0);
                acc0 = __builtin_amdgcn_mfma_f32_16x16x4f32(a1, bl[(2 * e + 1) & 3], acc0, 0, 0, 0); acc1 = __builtin_amdgcn_mfma_f32_16x16x4f32(a1, bh[(2 * e + 1) & 3], acc1, 0, 0, 0);
            }
        }
        q += __shfl_xor(q, 16); q += __shfl_xor(q, 32);
        const float rsv = rsqrtf(q * (1.0f / DM) + EPS);
        const float bias0 = p.b_re[l * 16 + r], bias1 = r < 4 ? p.b_rg[l * 4 + r] : 0.f;
#pragma unroll
        for (int g = 0; g < 4; ++g) { const int row = 4 * kq + g; const float rs = __shfl(rsv, row);
            lgb[row * 32 + r] = acc0[g] * rs + bias0; lgb[row * 32 + 16 + r] = acc1[g] * rs + bias1; }
        LDS_WAIT();
        if (lane < 16) {
            const int tok = tok0 + lane;
            const LAS f32x4* lr = (const LAS f32x4*)(lgb + lane * 32);
            const f32x4 e0 = lr[0], e1 = lr[1], e2 = lr[2], e3 = lr[3], gl = lr[4];
            int g = 0; float gm = gl.x;
            if (gl.y > gm) { gm = gl.y; g = 1; } if (gl.z > gm) { gm = gl.z; g = 2; } if (gl.w > gm) { gm = gl.w; g = 3; }
            const float den = (expf(gl.x - gm) + expf(gl.y - gm)) + (expf(gl.z - gm) + expf(gl.w - gm));
            const float pg = 1.0f / den;
            const f32x4 el = g == 0 ? e0 : (g == 1 ? e1 : (g == 2 ? e2 : e3));
            int i0 = 0; float m0 = el.x;
            if (el.y > m0) { m0 = el.y; i0 = 1; } if (el.z > m0) { m0 = el.z; i0 = 2; } if (el.w > m0) { m0 = el.w; i0 = 3; }
            int i1 = -1; float m1 = -INFINITY;
            if (i0 != 0 && el.x > m1) { m1 = el.x; i1 = 0; } if (i0 != 1 && el.y > m1) { m1 = el.y; i1 = 1; }
            if (i0 != 2 && el.z > m1) { m1 = el.z; i1 = 2; } if (i0 != 3 && el.w > m1) { m1 = el.w; i1 = 3; }
            const float ex = expf(m1 - m0), inv = 1.0f / (1.0f + ex);
            const int ea = g * 4 + i0, eb = g * 4 + i1;
            toke[tok] = make_int2(ea, eb); tokg[tok] = make_float2(pg * inv, pg * ex * inv);
            atomicAdd((int*)&hist[ea], 1); atomicAdd((int*)&hist[16 + eb], 1);
        }
        LDS_WAIT();
    }
    __syncthreads();
    if (tid < 32) WSP(int, WS_MOE + MO_HIST)[vcu * 32 + tid] = hist[tid];
}
__device__ __forceinline__ void sort_phase(const P& p, LAS unsigned char* lds, int vcu, int G) {
    int tid = threadIdx.x; asm volatile("" : "+v"(tid));
    const int lane = tid & 63, wave = __builtin_amdgcn_readfirstlane(tid >> 6);
    LAS int* cnt = (LAS int*)(lds + LDS_GATE); LAS int* pre = cnt + 32; LAS int* base = cnt + 64; LAS int* ntl = cnt + 96;
    const int* histg = WSP(const int, WS_MOE + MO_HIST);
    int* rowtok = WSP(int, WS_MOE + MO_ROWTOK); float* rowgate = WSP(float, WS_MOE + MO_ROWGATE); int* tilee = WSP(int, WS_MOE + MO_TILEE); int* nt = WSP(int, WS_MOE + MO_NT);
    const int2* toke = WSP(const int2, WS_MOE + MO_TOKE); const float2* tokg = WSP(const float2, WS_MOE + MO_TOKG);
    { LAS int* part = (LAS int*)(lds + LDS_RS);
      const int j = tid & 31, part_i = tid >> 5; int c = 0, pr = 0;
      for (int w = part_i; w < G; w += 16) { const int v = histg[w * 32 + j]; if (w < vcu) pr += v; c += v; }
      part[part_i * 64 + j] = c; part[part_i * 64 + 32 + j] = pr;
      __syncthreads();
      if (tid < 32) { int cc = 0, pp = 0;
#pragma unroll
          for (int q = 0; q < 16; ++q) { cc += part[q * 64 + tid]; pp += part[q * 64 + 32 + tid]; }
          cnt[tid] = cc; pre[tid] = pp; } }
    __syncthreads();
    if (tid == 0) { int t = 0; for (int j = 0; j < 32; ++j) { base[j] = t * 256; const int n = (cnt[j] + 255) >> 8; ntl[j] = n; t += n; if (j == 15 && vcu == 0) nt[0] = t; } if (vcu == 0) nt[1] = t; }
    __syncthreads();
    if (vcu == 0 && tid < 32) { const int t0 = base[tid] >> 8; for (int i = 0; i < ntl[tid]; ++i) tilee[t0 + i] = tid & 15; }
    if (vcu < 32) { const int j = vcu, lo = base[j] + cnt[j], hi = base[j] + 256 * ntl[j]; for (int r = lo + tid; r < hi; r += NTHR) { rowtok[r] = -1; rowgate[r] = 0.f; } }
    if (wave < 2) {
        const int k = wave;
        int run[16];
#pragma unroll
        for (int e = 0; e < 16; ++e) run[e] = 0;
        for (int task0 = vcu * NWAVES; task0 < NTOK / 16; task0 += G * NWAVES) {
#pragma unroll 1
            for (int half = 0; half < 2; ++half) {
                const int tok = task0 * 16 + half * 64 + lane;
                const int2 ee = toke[tok]; const float2 gg = tokg[tok];
                const int e = k ? ee.y : ee.x; const float gt = k ? gg.y : gg.x;
                int rank = 0;
#pragma unroll
                for (int x = 0; x < 16; ++x) { const unsigned long long m = __ballot(e == x); if (e == x) rank = run[x] + __popcll(m & ((1ull << lane) - 1ull)); run[x] += __popcll(m); }
                const int pos = base[k * 16 + e] + pre[k * 16 + e] + rank;
                rowtok[pos] = tok; rowgate[pos] = gt;
            }
        }
    }
}
__device__ __forceinline__ void final_phase(const P& p, int vcu, int G) {
    int tid = threadIdx.x; asm volatile("" : "+v"(tid));
    const int lane = tid & 63, wave = __builtin_amdgcn_readfirstlane(tid >> 6);
    const float* ssq = WSP(const float, WS_SSQ); const bf16* hb = WSP(const bf16, WS_HB);
    f32x4 g[4];
#pragma unroll
    for (int j = 0; j < 4; ++j) g[j] = ((const f32x4*)p.final_norm)[lane + 64 * j];
    for (int m0 = (vcu * NWAVES + wave) * 4; m0 < NTOK; m0 += G * NWAVES * 4) {
        v2u w[4][4]; float rs[4];
#pragma unroll
        for (int r = 0; r < 4; ++r) { rs[r] = row_rs(ssq, m0 + r);
#pragma unroll
            for (int j = 0; j < 4; ++j) w[r][j] = ((const v2u*)(hb + (size_t)(m0 + r) * DM))[lane + 64 * j]; }
#pragma unroll
        for (int r = 0; r < 4; ++r) { f32x4* s = (f32x4*)(p.out + (size_t)(m0 + r) * DM) + lane;
#pragma unroll
            for (int j = 0; j < 4; ++j) { f32x4 v; v.x = __builtin_bit_cast(float, w[r][j].x << 16); v.y = __builtin_bit_cast(float, w[r][j].x & 0xffff0000u); v.z = __builtin_bit_cast(float, w[r][j].y << 16); v.w = __builtin_bit_cast(float, w[r][j].y & 0xffff0000u);
                s[64 * j] = v * rs[r] * g[j]; } }
    }
}
#ifndef ENMASK
#define ENMASK 0xffffffffu
#endif
#define EN(b) (((ENMASK) >> (b)) & 1u)
#ifndef REPMASK
#define REPMASK 0u
#endif
#define REPN(b) ((((REPMASK) >> (b)) & 1u) ? 2 : 1)
__device__ __attribute__((noinline)) void grid_barrier(unsigned* barw, unsigned x, volatile LAS unsigned* st) { XcdBarrier b; b.bar = barw; b.x = x; b.st = st; xcd_barrier(b); }
__global__ void __launch_bounds__(NTHR, 2) fwd(Args args) {
    extern __shared__ __attribute__((aligned(16))) unsigned char lds_raw[];
    LAS unsigned char* lds = (LAS unsigned char*)lds_raw;
    const P& p = args.p;
    const int tid = threadIdx.x, lane = tid & 63, wave = __builtin_amdgcn_readfirstlane(tid >> 6);
    const int G = gridDim.x; const int bx = blockIdx.x; const int vcu = (G % 8 == 0) ? (bx % 8) * (G / 8) + bx / 8 : bx;
    volatile LAS unsigned* MISC = (volatile LAS unsigned*)(lds + LDS_MISC);
    if (tid < 64) MISC[tid] = 0u;
    __syncthreads();
    unsigned* ctl = (unsigned*)(p.ws + WS_CTL);
    const int lo = args.ph_lo, hi = args.ph_hi;
    XcdBarrier bar; bar.bar = ctl + CW_BAR + args.li * XCD_BAR_WORDS; bar.x = 0; bar.st = nullptr;
    if (hi - lo > 1) bar = xcd_barrier_post(ctl + CW_BAR + args.li * XCD_BAR_WORDS, MISC);
#define IN(k) (lo <= (k) && (k) < hi)
#define PHL int vcuL = vcu, GL = G, bxL = bx; asm volatile("" : "+s"(vcuL), "+s"(GL), "+s"(bxL)); (void)vcuL; (void)GL; (void)bxL;
#define LTID(v) int v = threadIdx.x; asm volatile("" : "+v"(v))
#define FILL_RS_DENSE() do { LTID(tq); const int rr_ = tq & 255, hf_ = tq >> 8; f32x4 sv_[4][4]; bool ok_[4]; \
        _Pragma("unroll") for (int k_ = 0; k_ < 4; ++k_) { pg8::Unit u_ = {0, 0, 0}; ok_[k_] = S.next(hf_ + 2 * k_, u_); const f32x4* sp_ = (const f32x4*)(SSQ + (size_t)(ok_[k_] ? u_.pm * 256 + rr_ : 0) * 16); \
            _Pragma("unroll") for (int j_ = 0; j_ < 4; ++j_) sv_[k_][j_] = sp_[j_]; } \
        _Pragma("unroll") for (int k_ = 0; k_ < 4; ++k_) if (ok_[k_]) { const f32x4 a_ = (sv_[k_][0] + sv_[k_][1]) + (sv_[k_][2] + sv_[k_][3]); rstab[(hf_ + 2 * k_) * 256 + rr_] = rsqrtf(((a_.x + a_.y) + (a_.z + a_.w)) * (1.0f / DM) + EPS); } } while (0)
#define FILL_GU() do { LTID(tq); const int rr_ = tq & 255, hf_ = tq >> 8; f32x4 sv_[4][4]; bool ok_[4]; int tk_[4]; \
        _Pragma("unroll") for (int k_ = 0; k_ < 4; ++k_) { pg8::Unit u_ = {0, 0, 0}; ok_[k_] = S.next(hf_ + 2 * k_, u_); tk_[k_] = ok_[k_] ? ROWTOK[u_.pm * 256 + rr_] : 0; } \
        _Pragma("unroll") for (int k_ = 0; k_ < 4; ++k_) { tk_[k_] = tk_[k_] < 0 ? 0 : tk_[k_]; const f32x4* sp_ = (const f32x4*)(SSQ + (size_t)tk_[k_] * 16); \
            _Pragma("unroll") for (int j_ = 0; j_ < 4; ++j_) sv_[k_][j_] = sp_[j_]; } \
        _Pragma("unroll") for (int k_ = 0; k_ < 4; ++k_) if (ok_[k_]) { const f32x4 a_ = (sv_[k_][0] + sv_[k_][1]) + (sv_[k_][2] + sv_[k_][3]); rowtab[(hf_ + 2 * k_) * 256 + rr_] = tk_[k_]; \
            rstab[(hf_ + 2 * k_) * 256 + rr_] = rsqrtf(((a_.x + a_.y) + (a_.z + a_.w)) * (1.0f / DM) + EPS); } } while (0)
#define FILL_DOWN() do { LTID(tq); const int rr_ = tq & 255, hf_ = tq >> 8; bool ok_[4]; int tk_[4]; float gt_[4]; \
        _Pragma("unroll") for (int k_ = 0; k_ < 4; ++k_) { pg8::Unit u_ = {0, 0, 0}; ok_[k_] = S.next(hf_ + 2 * k_, u_); const int r_ = ok_[k_] ? u_.pm * 256 + rr_ : 0; tk_[k_] = ROWTOK[r_]; gt_[k_] = ROWGATE[r_]; } \
        _Pragma("unroll") for (int k_ = 0; k_ < 4; ++k_) if (ok_[k_]) { rowtab[(hf_ + 2 * k_) * 256 + rr_] = tk_[k_]; gatetab[(hf_ + 2 * k_) * 256 + rr_] = gt_[k_]; } } while (0)

#define SEAM(k) do { if (IN(k) && IN((k) + 1)) { grid_barrier(bar.bar, bar.x, bar.st); if (REPN(20) == 2) grid_barrier(bar.bar, bar.x, bar.st); } } while (0)
    LAS float* rstab = (LAS float*)(lds + LDS_RS); LAS int* rowtab = (LAS int*)(lds + LDS_ROWTOK); LAS float* gatetab = (LAS float*)(lds + LDS_GATE);
#define HB WSP(bf16, WS_HB)
#define PROJ WSP(bf16, WS_PROJ)
#define Y WSP(bf16, WS_Y)
#define XKV WSP(bf16, WS_XKV)
#define MEMN WSP(bf16, WS_MEMN)
#define SSQ WSP(float, WS_SSQ)
#define XQ WSP(bf16, WS_XQ)
#define U WSP(bf16, WS_U)
#define ROWTOK WSP(const int, WS_MOE + MO_ROWTOK)
#define ROWGATE WSP(const float, WS_MOE + MO_ROWGATE)
#define TILEE WSP(const int, WS_MOE + MO_TILEE)
#define NT WSP(const int, WS_MOE + MO_NT)
#define H (p.out)
#define HB8 ((unsigned char*)p.out + 64 * MiB)
#define U8 WSP(unsigned char, WS_U)

    if (EN(0) && IN(PH_PRO)) _Pragma("unroll 1") for (int rep_ = 0; rep_ < REPN(0); ++rep_) { PHL prologue(p, lds, vcuL, GL, wave, lane); }
    SEAM(PH_PRO);
    if (REPN(18) == 2 && IN(PH_XKV)) { PHL
        pg8::StaticOrder S; S.init(HB, ws_base(p.ws) + WS_W + WO_IN, NTOK, 3072, DM, GL, bxL);
        FILL_RS_DENSE();
        __syncthreads();
        EpiBf16<true> E{PROJ, PW, rstab};
        pg8::gemm_phase<DM, EpiBf16<true>, pg8::StaticOrder, true>(lds + LDS_STAGE, S, E);
    }
    for (int l = 0; l < NLAYER; ++l) {
        const int pb = PH_L0 + l * NPH;
        unsigned char* wl = ws_base(p.ws) + WS_W + (size_t)l * WS_WLAYER;
        if (EN(2) && IN(pb + LP_INPROJ)) _Pragma("unroll 1") for (int rep_ = 0; rep_ < REPN(2); ++rep_) { PHL
            pg8::StaticOrder S; S.init(HB, wl + WO_IN, NTOK, 3072, DM, GL, bxL);
            FILL_RS_DENSE();
            __syncthreads();
            EpiBf16<true> E{PROJ, PW, rstab};
            pg8::gemm_phase<DM, EpiBf16<true>, pg8::StaticOrder, true>(lds + LDS_STAGE, S, E);
            _Pragma("unroll 1") for (int r2_ = 0; r2_ < REPN(19); ++r2_) small_proj(p, l, lds + LDS_STAGE, vcuL, GL, wave, lane);
        }
        SEAM(pb + LP_INPROJ);
        if (EN(11) && IN(pb + LP_MIXA)) _Pragma("unroll 1") for (int rep_ = 0; rep_ < REPN(11); ++rep_) { PHL gla_phase_a(p, l, lds + LDS_STAGE, vcuL, GL); fox_cumsum_phase(p, l, lds + LDS_STAGE, vcuL, GL); fox_knorm_phase(p, vcuL, GL); }
        SEAM(pb + LP_MIXA);
        if (EN(12) && IN(pb + LP_MIXB)) _Pragma("unroll 1") for (int rep_ = 0; rep_ < REPN(12); ++rep_) { PHL gla_phase_b(p, vcuL, GL); }
        if (EN(1) && l == 0 && IN(pb + LP_MIXB)) { PHL
            pg8::StaticOrder S; S.init(MEMN, ws_base(p.ws) + WS_WXKV, 4096, 2048, DM, GL, bxL);
            EpiBf16<false> E{XKV, 2048, rstab};
            pg8::gemm_phase<DM, EpiBf16<false>, pg8::StaticOrder, true>(lds + LDS_STAGE, S, E);
        }
        SEAM(pb + LP_MIXB);
        if (EN(9) && IN(pb + LP_MIXC)) { PHL _Pragma("unroll 1") for (int rep_ = 0; rep_ < REPN(16); ++rep_) fox_phase(p, l, lds + LDS_STAGE, vcuL, GL); _Pragma("unroll 1") for (int rep_ = 0; rep_ < REPN(17); ++rep_) gla_phase_c(p, l, lds + LDS_STAGE, vcuL, GL); }
        SEAM(pb + LP_MIXC);
        if (EN(3) && IN(pb + LP_WOUT)) _Pragma("unroll 1") for (int rep_ = 0; rep_ < REPN(3); ++rep_) { PHL
            pg8::StaticOrder S; S.init(Y, wl + WO_OUT, NTOK, DM, DM, GL, bxL);
            EpiRes<0> E{HB, SSQ, rowtab, gatetab, rep_ == REPN(3) - 1 ? 1.f : 0.f, Y, nullptr};
            pg8::gemm_phase<DM, EpiRes<0>, pg8::StaticOrder, true>(lds + LDS_STAGE, S, E);
        }
        SEAM(pb + LP_WOUT);
        if (EN(4) && IN(pb + LP_XQ)) _Pragma("unroll 1") for (int rep_ = 0; rep_ < REPN(4); ++rep_) { PHL
            pg8::StaticOrder S; S.init(HB, wl + WO_XQ, NTOK, 512, DM, GL, bxL);
            FILL_RS_DENSE();
            __syncthreads();
            EpiBf16<true> E{XQ, 512, rstab};
            pg8::gemm_phase<DM, EpiBf16<true>, pg8::StaticOrder, true>(lds + LDS_STAGE, S, E);
            asm volatile("s_waitcnt vmcnt(0)" ::: "memory"); __syncthreads();
            { pg8::Unit u; for (int iu = 0; S.next(iu, u); ++iu) { xattn_pair(p, l, lds + LDS_STAGE, u.pm, u.pn, rep_ != REPN(4) - 1); } }
        }
        SEAM(pb + LP_XQ);
        if (EN(5) && IN(pb + LP_XO)) _Pragma("unroll 1") for (int rep_ = 0; rep_ < REPN(5); ++rep_) { PHL
            pg8::StaticOrder S; S.init(WSP(unsigned char, WS_XO8), wl + WO_XO, NTOK, DM, 256, GL, bxL);
            EpiRes<0, true> E{HB, SSQ, rowtab, gatetab, rep_ == REPN(5) - 1 ? 1.f : 0.f, Y, HB8};
            pg8::gemm_phase<256, EpiRes<0, true>, pg8::StaticOrder, true, true, 127, 122>(lds + LDS_STAGE, S, E);
        }
        SEAM(pb + LP_XO);
        if (EN(13) && IN(pb + LP_ROUTE)) _Pragma("unroll 1") for (int rep_ = 0; rep_ < REPN(13); ++rep_) { PHL route_phase(p, l, lds, vcuL, GL); }
        SEAM(pb + LP_ROUTE);
        if (EN(14) && IN(pb + LP_SORT)) _Pragma("unroll 1") for (int rep_ = 0; rep_ < REPN(14); ++rep_) { PHL sort_phase(p, lds, vcuL, GL); }
        SEAM(pb + LP_SORT);
        if (EN(6) && IN(pb + LP_GU)) _Pragma("unroll 1") for (int rep_ = 0; rep_ < REPN(6); ++rep_) { PHL
            MoeOrder<0> S{(const char*)HB8, (const char*)(wl + WO_GU), 512, (size_t)1024 * 1024, 0, NT[1], GL, vcuL, TILEE, rowtab};
            FILL_GU();
            __syncthreads();
            EpiGU E{U8, rstab};
            pg8::gemm_phase<512, EpiGU, MoeOrder<0>, true, true, 127, 122>(lds + LDS_STAGE, S, E);
        }
        SEAM(pb + LP_GU);
        if (EN(7) && IN(pb + LP_DOWN0)) _Pragma("unroll 1") for (int rep_ = 0; rep_ < REPN(7); ++rep_) { PHL
            MoeOrder<1> S{(const char*)U8, (const char*)(wl + WO_D), 256, (size_t)1024 * 512, 0, NT[0], GL, vcuL, TILEE, rowtab};
            __syncthreads();
            FILL_DOWN();
            __syncthreads();
            EpiRes<1> E{HB, SSQ, rowtab, gatetab, 1.f, Y, nullptr};
            pg8::gemm_phase<256, EpiRes<1>, MoeOrder<1>, true, true, 125, 122>(lds + LDS_STAGE, S, E);
        }
        SEAM(pb + LP_DOWN0);
        if (EN(8) && IN(pb + LP_DOWN1)) _Pragma("unroll 1") for (int rep_ = 0; rep_ < REPN(8); ++rep_) { PHL
            MoeOrder<1> S{(const char*)U8, (const char*)(wl + WO_D), 256, (size_t)1024 * 512, NT[0], NT[1], GL, vcuL, TILEE, rowtab};
            __syncthreads();
            FILL_DOWN();
            __syncthreads();
            EpiRes<2> E{HB, SSQ, rowtab, gatetab, 1.f, Y, nullptr};
            pg8::gemm_phase<256, EpiRes<2>, MoeOrder<1>, true, true, 125, 122>(lds + LDS_STAGE, S, E);
        }
        SEAM(pb + LP_DOWN1);
    }
    if (EN(15) && IN(PH_FINAL)) _Pragma("unroll 1") for (int rep_ = 0; rep_ < REPN(15); ++rep_) { PHL final_phase(p, vcuL, GL); }
#undef IN
#undef SEAM
#undef HB
#undef PROJ
#undef Y
#undef XKV
#undef MEMN
#undef SSQ
#undef XQ
#undef U
#undef ROWTOK
#undef ROWGATE
#undef TILEE
#undef NT
#undef H
#undef HB8
#undef U8
}

static int g_grid = 0;
static void launch_fast(const P& p, int lo, int hi, int& li, hipStream_t stream) {
    Args a{}; a.p = p; a.ph_lo = lo; a.ph_hi = hi; a.li = li++; a.pad = 0;
    hipLaunchKernelGGL(fwd, dim3(g_grid), dim3(NTHR), LDS_BYTES, stream, a);
    const hipError_t le = hipPeekAtLastError();
    if (le != hipSuccess) fprintf(stderr, "kernel_launch: fwd launch [%d,%d) failed: %s\n", lo, hi, hipGetErrorName(le));
}
extern "C" void kernel_launch(void* const* d_in, const int* in_sizes, int n_in, void* d_out, int out_size, void* d_ws, size_t ws_size, hipStream_t stream) {
    if (n_in != 25 || out_size != NTOK * DM || ws_size < WS_END2) { fprintf(stderr, "kernel_launch: unexpected sizes n_in %d out %d ws %zu (need %zu)\n", n_in, out_size, ws_size, (size_t)WS_END2); return; }
    if (g_grid == 0) {
        int dev = 0, cus = 0, per_cu = 0;
        if (hipGetDevice(&dev) != hipSuccess || hipDeviceGetAttribute(&cus, hipDeviceAttributeMultiprocessorCount, dev) != hipSuccess) { g_grid = -1; return; }
        if (hipFuncSetAttribute((const void*)fwd, hipFuncAttributeMaxDynamicSharedMemorySize, LDS_BYTES) != hipSuccess) { fprintf(stderr, "kernel_launch: hipFuncSetAttribute failed\n"); g_grid = -1; return; }
        if (hipOccupancyMaxActiveBlocksPerMultiprocessor(&per_cu, (const void*)fwd, NTHR, LDS_BYTES) != hipSuccess || per_cu < 1) { fprintf(stderr, "kernel_launch: occupancy query says %d\n", per_cu); }
        (void)hipGetLastError();
        g_grid = cus;
    }
    if (g_grid < 0) return;
    P p{};
    const float** pp = (const float**)&p;
    for (int i = 0; i < 25; ++i) pp[i] = (const float*)d_in[i];
    p.out = (float*)d_out; p.ws = (unsigned char*)d_ws;
    if (hipMemsetAsync((char*)d_ws + WS_CTL + (size_t)CW_BAR * 4, 0, (size_t)XCD_BAR_WORDS * 4, stream) != hipSuccess) { fprintf(stderr, "kernel_launch: hipMemsetAsync failed\n"); return; }
    int li = 0;
    launch_fast(p, PH_PRO, PH_END, li, stream);
}
```

```cpp
#include <hip/hip_runtime.h>
#include <cstdio>
#include <cstdint>

constexpr int NTOK = 32768, DM = 1024, NBATCH = 16, SEQ = 2048, NLAYER = 2, MEML = 256;
constexpr int PW = 3072;
constexpr int C_FQ = 0, C_FK = 512, C_FV = 1024, C_GQ = 1536, C_GK = 1792, C_GV = 2048, C_GG = 2560;
constexpr int INW = 3096;
constexpr float EPS = 1e-6f, LOG2E = 1.4426950408889634f;
constexpr int MAXTILES = 288;
constexpr int MAXROWS = MAXTILES * 256;

typedef unsigned short bf16;
__device__ __forceinline__ unsigned f2bf(float f) { unsigned u = __builtin_bit_cast(unsigned, f); return (u + 0x7fffu + ((u >> 16) & 1u)) >> 16; }
__device__ __forceinline__ float bf2f(bf16 b) { return __builtin_bit_cast(float, ((unsigned)b) << 16); }

constexpr size_t MiB = 1u << 20;
constexpr size_t WS_CTL = 0;
constexpr size_t WS_W = 1 * MiB;
constexpr size_t WS_WLAYER = 59 * MiB;
constexpr size_t WS_WXKV = WS_W + 2 * WS_WLAYER;
constexpr size_t WS_HB = WS_WXKV + 4 * MiB;
constexpr size_t WS_PROJ = WS_HB + 64 * MiB;
constexpr size_t WS_XQ = WS_PROJ;
constexpr size_t WS_U = WS_PROJ + 32 * MiB;
constexpr size_t WS_XO8 = WS_U + 40 * MiB;
constexpr size_t WS_SM = WS_PROJ + 192 * MiB;
constexpr size_t WS_CB = WS_SM + 4 * MiB;
constexpr size_t WS_Y = WS_CB + 1 * MiB;
constexpr size_t WS_XKV = WS_Y + 64 * MiB;
constexpr size_t WS_MEMN = WS_XKV + 16 * MiB;
constexpr size_t WS_SSQ = WS_MEMN + 8 * MiB;
constexpr size_t WS_MOE = WS_SSQ + 2 * MiB;
constexpr size_t WS_END = WS_MOE + 2 * MiB;
static_assert(WS_END <= 512 * MiB, "workspace map");
constexpr size_t MO_TOKE = 0;
constexpr size_t MO_TOKG = 256 * 1024;
constexpr size_t MO_ROWTOK = 512 * 1024;
constexpr size_t MO_ROWGATE = 832 * 1024;
constexpr size_t MO_TILEE = 1152 * 1024;
constexpr size_t MO_NT = 1156 * 1024;
constexpr size_t MO_HIST = 1160 * 1024;
constexpr size_t MO_GCNT = 1160 * 1024;
constexpr int BCAP = 32768;
constexpr size_t MO_KN = 1280 * 1024;

struct P {
    const float *x, *mem, *mem_norm, *mix_norm, *w_in, *b_forget, *w_alpha_up, *b_alpha, *fox_gain, *gla_gain, *w_out, *cross_norm, *w_xq, *w_xk, *w_xv, *w_xo,
        *moe_norm, *w_rg, *b_rg, *w_re, *b_re, *w_eg, *w_eu, *w_ed, *final_norm;
    float* out; unsigned char* ws;
};
__host__ __device__ __forceinline__ unsigned char* ws_base(unsigned char* w) {
#if defined(__HIP_DEVICE_COMPILE__)
    size_t z = 0; asm volatile("" : "+s"(z));
    return w + z;
#else
    return w;
#endif
}
#define WSP(T, off) ((T*)(ws_base(p.ws) + (off)))

__device__ __forceinline__ float wave_sum(float v) {
#pragma unroll
    for (int o = 1; o < 64; o <<= 1) v += __shfl_xor(v, o);
    return v;
}
__device__ __forceinline__ float wave_min(float v) {
#pragma unroll
    for (int o = 1; o < 64; o <<= 1) v = fminf(v, __shfl_xor(v, o));
    return v;
}
__device__ __forceinline__ float wave_max(float v) {
#pragma unroll
    for (int o = 1; o < 64; o <<= 1) v = fmaxf(v, __shfl_xor(v, o));
    return v;
}
__device__ __forceinline__ float row_rs(const float* ssq, int row) {
    const float4* s = (const float4*)(ssq + (size_t)row * 16);
    float4 a = s[0], b = s[1], c = s[2], d = s[3];
    float t = ((a.x + a.y) + (a.z + a.w)) + ((b.x + b.y) + (b.z + b.w)) + ((c.x + c.y) + (c.z + c.w)) + ((d.x + d.y) + (d.z + d.w));
    return rsqrtf(t * (1.0f / DM) + EPS);
}
__device__ __forceinline__ float log_sigmoid(float z) { return fminf(z, 0.f) - log1pf(expf(-fabsf(z))); }
__device__ __forceinline__ float silu(float z) { return z / (1.f + expf(-z)); }

typedef unsigned st_v4u __attribute__((ext_vector_type(4)));
typedef unsigned st_v2u __attribute__((ext_vector_type(2)));
#ifndef WT_STORES
#define WT_STORES 0
#endif
__device__ __forceinline__ void st_b128(void* p, st_v4u v) {
#if WT_STORES
    asm volatile("global_store_dwordx4 %0, %1, off sc1\n\ts_nop 1" :: "v"(p), "v"(v) : "memory");
#else
    *(st_v4u*)p = v;
#endif
}
__device__ __forceinline__ void st_b128_wt(void* p, st_v4u v) { asm volatile("global_store_dwordx4 %0, %1, off sc1\n\ts_nop 1" :: "v"(p), "v"(v) : "memory"); }
__device__ __forceinline__ void st_b64(void* p, st_v2u v) {
#if WT_STORES
    asm volatile("global_store_dwordx2 %0, %1, off sc1" :: "v"(p), "v"(v) : "memory");
#else
    *(st_v2u*)p = v;
#endif
}
#define XB_TMO      128
#define XB_XCNT(j)  (256  + 64 * (j))
#define XB_XSUB(j)  (1280 + 64 * (j))
#define XB_XGEN(j)  (2304 + 64 * (j))
#define XB_TOP      3328
#define XB_TOPGEN   3392
#define XCD_BAR_WORDS 3456
#define XB_SPIN_CAP (1u << 18)
#define LAS __attribute__((address_space(3)))

__device__ __forceinline__ unsigned xb_ld(unsigned* p)              { return __hip_atomic_load(p, __ATOMIC_RELAXED, __HIP_MEMORY_SCOPE_AGENT); }
__device__ __forceinline__ unsigned xb_add(unsigned* p, unsigned v) { return __hip_atomic_fetch_add(p, v, __ATOMIC_RELAXED, __HIP_MEMORY_SCOPE_AGENT); }
__device__ __forceinline__ unsigned xb_xcc_id() { return (unsigned)__builtin_amdgcn_s_getreg((3 << 11) | 20) & 0xFu; }
#define XB_SPIN(cond, bar) do { unsigned _sp = 0; while (cond) { __builtin_amdgcn_s_sleep(1); \
    if ((++_sp & 255u) == 0u) { if (xb_ld(&(bar)[XB_TMO])) break; if (_sp > XB_SPIN_CAP) { atomicAdd(&(bar)[XB_TMO], 1u); break; } } } } while (0)

struct XcdBarrier {
    unsigned* bar; unsigned x;
    volatile LAS unsigned* st;
};

__device__ __forceinline__ XcdBarrier xcd_barrier_post(unsigned* bar, volatile LAS unsigned* st) {
    XcdBarrier b; b.bar = bar; b.x = xb_xcc_id(); b.st = st;
    if (threadIdx.x == 0) (void)xb_add(&bar[XB_XCNT(b.x)], 1u);
    return b;
}
__device__ __forceinline__ void xcd_barrier_complete(unsigned* bar, unsigned x, unsigned& nloc, unsigned& nx) {
    const unsigned G = gridDim.x * gridDim.y * gridDim.z;
    unsigned sum, cnt, mine, sp = 0u;
    for (;;) {
        sum = 0u; cnt = 0u; mine = 0u;
#pragma unroll
        for (unsigned j = 0; j < 16; ++j) { const unsigned c = xb_ld(&bar[XB_XCNT(j)]); sum += c; cnt += (c > 0u) ? 1u : 0u; mine = (j == x) ? c : mine; }
        if (sum == G) break;
        __builtin_amdgcn_s_sleep(1);
        if ((++sp & 255u) == 0u) { if (xb_ld(&bar[XB_TMO])) break; if (sp > XB_SPIN_CAP) { atomicAdd(&bar[XB_TMO], 1u); break; } }
    }
    nloc = mine > 0u ? mine : 1u; nx = cnt > 0u ? cnt : 1u;
}

__device__ __forceinline__ void xcd_barrier(const XcdBarrier& b) {
    asm volatile("s_waitcnt vmcnt(0)" ::: "memory");
    __syncthreads();
    if (threadIdx.x == 0) {
        unsigned* bar = b.bar;
        __builtin_amdgcn_s_waitcnt(0);
        unsigned nloc = b.st[0], nx = b.st[1];
        if (nloc == 0u) { xcd_barrier_complete(bar, b.x, nloc, nx); b.st[0] = nloc; b.st[1] = nx; }
        const unsigned old = xb_add(&bar[XB_XSUB(b.x)], 1u);
        const unsigned gen = old / nloc;
        if (old + 1u == (gen + 1u) * nloc) {
            __builtin_amdgcn_fence(__ATOMIC_RELEASE, "agent");
            asm volatile("s_waitcnt vmcnt(0)" ::: "memory");
            const unsigned og = xb_add(&bar[XB_TOP], 1u);
            const unsigned tg = og / nx;
            if (og + 1u == (tg + 1u) * nx) xb_add(&bar[XB_TOPGEN], 1u);
            else XB_SPIN(xb_ld(&bar[XB_TOPGEN]) == tg, bar);
            __builtin_amdgcn_fence(__ATOMIC_ACQUIRE, "agent");
            xb_add(&bar[XB_XGEN(b.x)], 1u);
            asm volatile("s_waitcnt vmcnt(0)" ::: "memory");
        } else {
            XB_SPIN(xb_ld(&bar[XB_XGEN(b.x)]) == gen, bar);
            __builtin_amdgcn_fence(__ATOMIC_ACQUIRE, "agent");
            asm volatile("s_waitcnt vmcnt(0)" ::: "memory");
        }
    }
    __syncthreads();
}

namespace pg8 {
#define PG8_LAS __attribute__((address_space(3)))
typedef unsigned short bf16_t;
typedef short bf16x8 __attribute__((ext_vector_type(8)));
typedef float f32x4 __attribute__((ext_vector_type(4)));
typedef unsigned u32x4 __attribute__((ext_vector_type(4)));
typedef unsigned u32x2 __attribute__((ext_vector_type(2)));
constexpr int BM = 256, BK = 64, HALF = 128, HTB = HALF * BK * 2, STAGE_BYTES = 8 * HTB, NXCD = 8, WGM = 8;

__host__ __device__ __forceinline__ int lds_byte(int r, int c) { const int st = (r >> 4) * 2 + (c >> 5), rr = r & 15, cc = c & 31, ob = rr * 64 + cc * 2; return st * 1024 + (ob ^ (((ob >> 9) & 1) << 5)); }
__host__ __device__ __forceinline__ void stage_rc(int b, int& R, int& C) { const int st = b / 1024, sb = b % 1024, swz = sb ^ (((sb >> 9) & 1) << 5); R = (st >> 1) * 16 + swz / 64; C = (st & 1) * 32 + (swz % 64) / 2; }
__host__ __device__ __forceinline__ int perm32(int rho) { const int n = rho >> 4, i = rho & 15; return 8 * (i >> 2) + 4 * n + (i & 3); }

struct Unit { int pm, pn, e; };

struct StaticOrder {
    static constexpr bool GATHER = false;
    static constexpr size_t KSTEP_A = 128;
    const char* A; const char* Bt; int K; int nM, nN, nwg, G, c;
    __device__ void init(const void* A_, const void* Bt_, int M, int N, int K_, int G_, int c_) { A = (const char*)A_; Bt = (const char*)Bt_; K = K_; nM = M / BM; nN = N / BM; nwg = nM * nN; G = G_; c = c_; }
    __device__ bool next(int i, Unit& u) const {
        const long L = (long)i * G + c; if (L >= nwg) return false;
        int wgid = (int)L; { const int q = nwg / NXCD, r = nwg % NXCD, xcd = wgid % NXCD, off = wgid / NXCD; wgid = (xcd < r ? xcd * (q + 1) : r * (q + 1) + (xcd - r) * q) + off; }
        const int nig = WGM * nN, gid = wgid / nig, fm = gid * WGM, gsz = (nM - fm) < WGM ? (nM - fm) : WGM;
        u.pm = fm + ((wgid % nig) % gsz); u.pn = (wgid % nig) / gsz; u.e = 0; return true;
    }
    __device__ __forceinline__ const char* a_base(const Unit& u) const { return A + (size_t)u.pm * (size_t)(BM * 2) * K; }
    __device__ __forceinline__ const char* b_base(const Unit& u) const { return Bt + (size_t)u.pn * (size_t)(BM * 2) * K; }
    __device__ __forceinline__ unsigned a_off(int, int, int, int) const { return 0u; }
};

__device__ __forceinline__ unsigned cvt_pk_bf16(float lo, float hi) { unsigned r; asm volatile("v_cvt_pk_bf16_f32 %0, %1, %2" : "=v"(r) : "v"(lo), "v"(hi)); return r; }

typedef int i32x8 __attribute__((ext_vector_type(8)));
typedef int i32x4 __attribute__((ext_vector_type(4)));
template <int K, class Epi, class Sched, bool ALIGN_EPI, bool FP8 = false, int SA = 127, int SB = 127, int KB = K, bool BSPLIT = false>
__device__ __forceinline__ void gemm_phase(PG8_LAS unsigned char* lds, const Sched& S, const Epi& E) {
    int tid_ = threadIdx.x; asm volatile("" : "+v"(tid_));
    const int tid = tid_, wid = __builtin_amdgcn_readfirstlane(tid >> 6), lane = tid & 63, wr = wid >> 2, wc = wid & 3, fr = lane & 15, fq = lane >> 4;
    constexpr int nt = K / BK;
    constexpr int NH = Sched::GATHER ? 2 : 1;
    unsigned voffB[2], cvA[NH][2], nvA[NH][2];
#pragma unroll
    for (int i = 0; i < 2; ++i) { int R, C; stage_rc(tid * 16 + i * 8192, R, C); const int Rb = Epi::PERM ? ((R & ~31) + perm32(R & 31)) : R;
        voffB[i] = (unsigned)(Rb * KB + C) * 2u;
        cvA[0][i] = nvA[0][i] = (unsigned)(R * K + C) * 2u; if constexpr (NH == 2) { cvA[NH - 1][i] = nvA[NH - 1][i] = cvA[0][i]; } }
    constexpr size_t kstep = (size_t)(BK * 2);
    constexpr size_t hstep = (size_t)HALF * K * 2;
    constexpr size_t hstepA = Sched::GATHER ? (size_t)0 : hstep;
    constexpr size_t hstepB = (size_t)HALF * KB * 2;
    constexpr size_t kstepA = Sched::KSTEP_A;
    const unsigned ldsw = (unsigned)wid * 1024u;
    const int aoff = lds_byte(wr * 64 + fr, fq * 8), boff = lds_byte(wc * 32 + fr, fq * 8);
#define PG8_SA(b, h) (((b) * 2 + (h)) * HTB)
#define PG8_SB(b, h) ((4 + (b) * 2 + (h)) * HTB)
#define PG8_STAGE(bufoff, gbase, voff) do { _Pragma("unroll") for (int _i = 0; _i < 2; ++_i) \
        __builtin_amdgcn_global_load_lds((const unsigned*)((const char*)(gbase) + (voff)[_i]), (PG8_LAS unsigned*)(lds + (bufoff) + ldsw + _i * 8192), 16, 0, 0); } while (0)
#define PG8_LD32(addr) __builtin_shufflevector(*(const PG8_LAS i32x4*)(addr), *(const PG8_LAS i32x4*)((addr) + 1024), 0, 1, 2, 3, 4, 5, 6, 7)
#define PG8_LDA(dst, b, h) do { _Pragma("unroll") for (int m = 0; m < 4; ++m) dst[m] = PG8_LD32(lds + PG8_SA(b, h) + aoff + m * 2048); } while (0)
#define PG8_LDB(dst, b, h) do { _Pragma("unroll") for (int n = 0; n < 2; ++n) dst[n] = PG8_LD32(lds + PG8_SB(b, h) + boff + n * 2048); } while (0)
#define PG8_H0(x) __builtin_bit_cast(bf16x8, __builtin_shufflevector((x), (x), 0, 1, 2, 3))
#define PG8_H1(x) __builtin_bit_cast(bf16x8, __builtin_shufflevector((x), (x), 4, 5, 6, 7))
#define PG8_MMA(ai, bj, At, Bt) do { __builtin_amdgcn_s_setprio(1); _Pragma("unroll") for (int m = 0; m < 4; ++m) _Pragma("unroll") for (int n = 0; n < 2; ++n) { \
        if constexpr (FP8) asm volatile("v_mfma_scale_f32_16x16x128_f8f6f4 %0, %1, %2, %0, %3, %4 op_sel_hi:[0,0,0]" : "+v"(acc[ai][bj][m][n]) : "v"(Bt[n]), "v"(At[m]), "v"(sbv), "v"(sav)); \
        else { acc[ai][bj][m][n] = __builtin_amdgcn_mfma_f32_16x16x32_bf16(PG8_H0(Bt[n]), PG8_H0(At[m]), acc[ai][bj][m][n], 0, 0, 0); \
               acc[ai][bj][m][n] = __builtin_amdgcn_mfma_f32_16x16x32_bf16(PG8_H1(Bt[n]), PG8_H1(At[m]), acc[ai][bj][m][n], 0, 0, 0); } } \
        __builtin_amdgcn_s_setprio(0); } while (0)
#define PG8_WAIT_V(n) asm volatile("s_waitcnt vmcnt(" #n ")" ::: "memory")
#define PG8_WAIT_L(n) asm volatile("s_waitcnt lgkmcnt(" #n ")" ::: "memory")
#define PG8_BAR __builtin_amdgcn_s_barrier()
#define PG8_SCHED __builtin_amdgcn_sched_barrier(0)
    int sav = SA, sbv = SB; asm volatile("" : "+v"(sav), "+v"(sbv));
    Unit cur, nxt; int ui = 0;
    if (!S.next(0, cur)) return;
    f32x4 acc[2][2][4][2];
#pragma unroll
    for (int a = 0; a < 2; ++a)
#pragma unroll
        for (int b = 0; b < 2; ++b)
#pragma unroll
            for (int m = 0; m < 4; ++m)
#pragma unroll
                for (int n = 0; n < 2; ++n) acc[a][b][m][n] = (f32x4){0.f, 0.f, 0.f, 0.f};
    i32x8 At[4], B0[2], B1[2];
    const char* cA = S.a_base(cur); const char* cB = S.b_base(cur);
    if constexpr (Sched::GATHER) {
        int R0, C0, R1, C1; stage_rc(tid * 16, R0, C0); stage_rc(tid * 16 + 8192, R1, C1);
#pragma unroll
        for (int h = 0; h < 2; ++h) { cvA[h][0] = S.a_off(0, h, R0, C0 * 2); cvA[h][1] = S.a_off(0, h, R1, C1 * 2); }
    }
    PG8_STAGE(PG8_SB(0, 0), cB, voffB); PG8_STAGE(PG8_SB(0, 1), cB + hstepB, voffB); PG8_STAGE(PG8_SA(0, 0), cA, cvA[0]); PG8_STAGE(PG8_SA(0, 1), cA + hstepA, cvA[NH - 1]);
    if (wr == 1) PG8_BAR;
    PG8_WAIT_V(2); PG8_BAR;
    PG8_STAGE(PG8_SB(1, 0), cB + kstep, voffB); PG8_STAGE(PG8_SA(1, 0), cA + kstepA, cvA[0]); PG8_STAGE(PG8_SB(1, 1), cB + hstepB + kstep, voffB);
    PG8_WAIT_V(6); PG8_BAR;
    for (;;) {
        const bool has_next = S.next(ui + 1, nxt);
        const char* nA = has_next ? S.a_base(nxt) : cA; const char* nB = has_next ? S.b_base(nxt) : cB;
        if constexpr (Sched::GATHER) {
            if (has_next) {
                int t2 = threadIdx.x; asm volatile("" : "+v"(t2));
                int R0, C0, R1, C1; stage_rc(t2 * 16, R0, C0); stage_rc(t2 * 16 + 8192, R1, C1);
#pragma unroll
                for (int h = 0; h < 2; ++h) { nvA[h][0] = S.a_off(ui + 1, h, R0, C0 * 2); nvA[h][1] = S.a_off(ui + 1, h, R1, C1 * 2); }
            } else {
#pragma unroll
                for (int h = 0; h < 2; ++h) { nvA[h][0] = cvA[h][0]; nvA[h][1] = cvA[h][1]; }
            }
        }
#pragma unroll 1
        for (int t = 0; t < nt; t += 2) {
            const bool last = (t == nt - 2);
            const char* a1 = cA + (size_t)(t + 1) * kstepA;
            const char* a2 = last ? nA : cA + (size_t)(t + 2) * kstepA; const char* b2 = last ? nB : cB + (size_t)(t + 2) * kstep;
            if constexpr (BSPLIT) { if (!last && t + 2 >= nt / 2) b2 += S.b_delta(cur); }
            const char* a3 = a2 + kstepA; const char* b3 = b2 + kstep;
            unsigned v2[NH][2];
#pragma unroll
            for (int h = 0; h < NH; ++h) { if constexpr (Sched::GATHER) { v2[h][0] = last ? nvA[h][0] : cvA[h][0]; v2[h][1] = last ? nvA[h][1] : cvA[h][1]; } else { v2[h][0] = cvA[h][0]; v2[h][1] = cvA[h][1]; } }
            PG8_LDB(B0, 0, 0); PG8_LDB(B1, 0, 1); PG8_SCHED; PG8_LDA(At, 0, 0); PG8_STAGE(PG8_SA(1, 1), a1 + hstepA, cvA[NH - 1]);
            PG8_WAIT_V(8); PG8_WAIT_L(0); PG8_BAR; PG8_MMA(0, 0, At, B0); PG8_MMA(0, 1, At, B1); PG8_BAR; PG8_SCHED;
            PG8_LDA(At, 0, 1); PG8_STAGE(PG8_SB(0, 0), b2, voffB); PG8_STAGE(PG8_SB(0, 1), b2 + hstepB, voffB); PG8_STAGE(PG8_SA(0, 0), a2, v2[0]);
            PG8_WAIT_V(8); PG8_WAIT_L(0); PG8_BAR; PG8_MMA(1, 0, At, B0); PG8_MMA(1, 1, At, B1); PG8_BAR; PG8_SCHED;
            PG8_LDB(B0, 1, 0); PG8_LDB(B1, 1, 1); PG8_SCHED; PG8_LDA(At, 1, 0); PG8_STAGE(PG8_SA(0, 1), a2 + hstepA, v2[NH - 1]);
            PG8_WAIT_V(8); PG8_WAIT_L(0); PG8_BAR; PG8_MMA(0, 0, At, B0); PG8_MMA(0, 1, At, B1); PG8_BAR; PG8_SCHED;
            PG8_LDA(At, 1, 1); PG8_STAGE(PG8_SB(1, 0), b3, voffB); PG8_STAGE(PG8_SB(1, 1), b3 + hstepB, voffB); PG8_STAGE(PG8_SA(1, 0), a3, v2[0]);
            PG8_WAIT_V(8); PG8_WAIT_L(0); PG8_BAR; PG8_MMA(1, 0, At, B0); PG8_MMA(1, 1, At, B1); PG8_BAR; PG8_SCHED;
        }
        if constexpr (ALIGN_EPI) { if (wr == 0) PG8_BAR; }
        if constexpr (FP8) asm volatile("s_nop 15\n\ts_nop 15" ::: "memory");
        E(acc, cur, ui, wr, wc, fr, fq);
        if (!has_next) break;
#pragma unroll
        for (int a = 0; a < 2; ++a)
#pragma unroll
            for (int b = 0; b < 2; ++b)
#pragma unroll
                for (int m = 0; m < 4; ++m)
#pragma unroll
                    for (int n = 0; n < 2; ++n) acc[a][b][m][n] = (f32x4){0.f, 0.f, 0.f, 0.f};
        cur = nxt; cA = nA; cB = nB; ++ui;
        if constexpr (Sched::GATHER) {
#pragma unroll
            for (int h = 0; h < NH; ++h) { cvA[h][0] = nvA[h][0]; cvA[h][1] = nvA[h][1]; }
        }
        if constexpr (ALIGN_EPI) { if (wr == 1) PG8_BAR; }
    }
    PG8_WAIT_V(0);
    if constexpr (!ALIGN_EPI) { if (wr == 0) PG8_BAR; }
    PG8_BAR;
#undef PG8_SA
#undef PG8_SB
#undef PG8_STAGE
#undef PG8_LDA
#undef PG8_LDB
#undef PG8_MMA
#undef PG8_LD32
#undef PG8_H0
#undef PG8_H1
#undef PG8_WAIT_V
#undef PG8_WAIT_L
#undef PG8_BAR
#undef PG8_SCHED
}
}
#define GAS __attribute__((address_space(1)))
typedef float f32x4 __attribute__((ext_vector_type(4)));
typedef float f32x16 __attribute__((ext_vector_type(16)));
typedef short bf16x8 __attribute__((ext_vector_type(8)));
typedef unsigned v4u __attribute__((ext_vector_type(4)));
typedef unsigned v2u __attribute__((ext_vector_type(2)));
#define LDS_WAIT() asm volatile("s_waitcnt lgkmcnt(0)" ::: "memory")
#define VM_WAIT() asm volatile("s_waitcnt vmcnt(0)" ::: "memory")
__device__ __forceinline__ unsigned pk2(float lo, float hi) { return f2bf(lo) | (f2bf(hi) << 16); }

constexpr int NWAVES = 8, NTHR = 512;
constexpr int LDS_STAGE = 0;
constexpr int LDS_RS = 131072;
constexpr int LDS_ROWTOK = LDS_RS + 8192;
constexpr int LDS_GATE = LDS_ROWTOK + 8192;
constexpr int LDS_MISC = LDS_GATE + 8192;
constexpr int LDS_MOET = LDS_MISC + 256;
constexpr int LDS_BYTES = LDS_MOET + 2048;
static_assert(LDS_BYTES <= 160 * 1024, "lds");
constexpr size_t WO_IN = 0, WO_SM = 6 * MiB, WO_RHI = 6 * MiB + 65536, WO_RLO = 6 * MiB + 131072, WO_OUT = 7 * MiB, WO_XQ = 9 * MiB, WO_XO = 10 * MiB, WO_GU = 11 * MiB, WO_D = 43 * MiB;
static_assert(WO_D + 16 * MiB <= WS_WLAYER, "weight block");
constexpr int CW_BAR = 4096;
constexpr int MAX_LAUNCH = 40;
static_assert((CW_BAR + MAX_LAUNCH * XCD_BAR_WORDS) * 4 <= (int)(1 * MiB), "ctl");

enum { PH_PRO = 0, PH_XKV = 1, PH_L0 = 2, NPH = 13, PH_FINAL = PH_L0 + NLAYER * NPH, PH_END = PH_FINAL + 1 };
enum { LP_INPROJ = 0, LP_MIXA, LP_MIXB, LP_MIXC, LP_WOUT, LP_XQ, LP_XATTN, LP_XO, LP_ROUTE, LP_SORT, LP_GU, LP_DOWN0, LP_DOWN1 };

struct Args { P p; int ph_lo, ph_hi, li, pad; };

#ifndef WT_PROJ
#define WT_PROJ 0
#endif
template <bool HAS_RS> struct EpiBf16 {
    static constexpr bool PERM = true;
    bf16* O; int ldc; const LAS float* rstab;
    __device__ __forceinline__ void operator()(const pg8::f32x4 (&acc)[2][2][4][2], const pg8::Unit& u, int iu, int wr, int wc, int fr, int fq) const {
#pragma unroll
        for (int ai = 0; ai < 2; ++ai)
#pragma unroll
            for (int m = 0; m < 4; ++m) {
                const int lrow = ai * 128 + wr * 64 + m * 16 + fr;
                float sc = 1.f; if (HAS_RS) sc = rstab[iu * 256 + lrow];
                bf16* rowp = O + (size_t)(u.pm * 256 + lrow) * ldc + u.pn * 256 + wc * 32 + 8 * fq;
#pragma unroll
                for (int bj = 0; bj < 2; ++bj) { const pg8::f32x4 v0 = acc[ai][bj][m][0] * sc, v1 = acc[ai][bj][m][1] * sc;
                    pg8::u32x4 w; w.x = pg8::cvt_pk_bf16(v0[0], v0[1]); w.y = pg8::cvt_pk_bf16(v0[2], v0[3]); w.z = pg8::cvt_pk_bf16(v1[0], v1[1]); w.w = pg8::cvt_pk_bf16(v1[2], v1[3]);
                    if (WT_PROJ) st_b128_wt(rowp + bj * 128, w); else st_b128(rowp + bj * 128, w); }
            }
    }
};
__device__ __forceinline__ unsigned pk4_fp8(float a, float b, float c, float d) { int w = __builtin_amdgcn_cvt_pk_fp8_f32(a, b, 0, false); w = __builtin_amdgcn_cvt_pk_fp8_f32(c, d, w, true); return (unsigned)w; }
struct EpiGU {
    static constexpr bool PERM = true;
    unsigned char* U8; const LAS float* rstab; const LAS float* gatetab;
    __device__ __forceinline__ void operator()(const pg8::f32x4 (&acc)[2][2][4][2], const pg8::Unit& u, int iu, int wr, int wc, int fr, int fq) const {
#pragma unroll
        for (int ai = 0; ai < 2; ++ai)
#pragma unroll
            for (int m = 0; m < 4; ++m) {
                const int lrow = ai * 128 + wr * 64 + m * 16 + fr;
                const float sc = rstab[iu * 256 + lrow], gt = 4.f * gatetab[iu * 256 + lrow];
                float o[8];
#pragma unroll
                for (int n = 0; n < 2; ++n)
#pragma unroll
                    for (int j = 0; j < 4; ++j) { const float g = acc[ai][0][m][n][j] * sc, uu = acc[ai][1][m][n][j] * sc; o[n * 4 + j] = gt * g * uu * __builtin_amdgcn_rcpf(1.f + __expf(-g)); }
                pg8::u32x2 w; w.x = pk4_fp8(o[0], o[1], o[2], o[3]); w.y = pk4_fp8(o[4], o[5], o[6], o[7]);
                st_b64(U8 + (size_t)(u.pm * 256 + lrow) * 1024 + (u.pn >> 2) * 512 + (u.pn & 3) * 128 + wc * 32 + 8 * fq, w);
            }
    }
};
template <int MODE, bool W8 = false> struct EpiRes {
    static constexpr bool PERM = true;
    static constexpr bool MOE = MODE != 0;
    bf16* hb; float* ssq; const LAS int* rowtab; float gs; unsigned char* h8;
    static __device__ __forceinline__ void unpack8(const pg8::u32x4& w, float (&f)[8]) {
        f[0] = __builtin_bit_cast(float, w.x << 16); f[1] = __builtin_bit_cast(float, w.x & 0xffff0000u); f[2] = __builtin_bit_cast(float, w.y << 16); f[3] = __builtin_bit_cast(float, w.y & 0xffff0000u);
        f[4] = __builtin_bit_cast(float, w.z << 16); f[5] = __builtin_bit_cast(float, w.z & 0xffff0000u); f[6] = __builtin_bit_cast(float, w.w << 16); f[7] = __builtin_bit_cast(float, w.w & 0xffff0000u); }
    __device__ __forceinline__ void operator()(const pg8::f32x4 (&acc)[2][2][4][2], const pg8::Unit& u, int iu, int wr, int wc, int fr, int fq) const {
#pragma unroll
        for (int ai = 0; ai < 2; ++ai)
#pragma unroll
            for (int m = 0; m < 4; ++m) {
                const int lrow = ai * 128 + wr * 64 + m * 16 + fr;
                int row = u.pm * 256 + lrow; const float g = gs;
                if (MOE) row = rowtab[iu * 256 + lrow];
                const bool ok = !MOE || row >= 0;
                const size_t off = (size_t)(ok ? row : 0) * DM + u.pn * 256 + wc * 32 + 8 * fq;
                float q = 0.f;
                if (ok) {
#pragma unroll
                    for (int bj = 0; bj < 2; ++bj) {
                        float o[8];
#pragma unroll
                        for (int j = 0; j < 4; ++j) { o[j] = acc[ai][bj][m][0][j] * g; o[4 + j] = acc[ai][bj][m][1][j] * g; }
                        float bs[8]; unpack8(*(const pg8::u32x4*)(hb + off + bj * 128), bs);
#pragma unroll
                        for (int j = 0; j < 8; ++j) o[j] += bs[j];
                        pg8::u32x4 w; w.x = pg8::cvt_pk_bf16(o[0], o[1]); w.y = pg8::cvt_pk_bf16(o[2], o[3]); w.z = pg8::cvt_pk_bf16(o[4], o[5]); w.w = pg8::cvt_pk_bf16(o[6], o[7]);
                        float r[8]; unpack8(w, r);
#pragma unroll
                        for (int j = 0; j < 8; ++j) q += r[j] * r[j];
                        st_b128(hb + off + bj * 128, w);
                        if (W8) { pg8::u32x2 w8; w8.x = pk4_fp8(o[0], o[1], o[2], o[3]); w8.y = pk4_fp8(o[4], o[5], o[6], o[7]); st_b64(h8 + off + bj * 128, w8); }
                    }
                }
                q += __shfl_xor(q, 16); q += __shfl_xor(q, 32); if (fq == 0 && ok) ssq[(size_t)row * 16 + u.pn * 4 + wc] = q;
            }
    }
};
template <int MODE> struct MoeOrder {
    static constexpr bool GATHER = MODE == 0;
    static constexpr size_t KSTEP_A = 128;
    static constexpr int SH = MODE == 0 ? 3 : 2;
    const char* A; const char* Bt; int K; size_t estride; int T, G, c; const LAS int* tile2e; const LAS int* rowtab;
    __device__ bool next(int i, pg8::Unit& u) const { const int L = i * G + c, t = L >> SH; if (t >= T) return false; u.pm = t; u.pn = L & ((1 << SH) - 1); u.e = __builtin_amdgcn_readfirstlane(tile2e[t]); return true; }
    __device__ __forceinline__ const char* a_base(const pg8::Unit& u) const { return GATHER ? A : A + (size_t)u.pm * (size_t)512 * K; }
    __device__ __forceinline__ const char* b_base(const pg8::Unit& u) const {
        if (MODE == 0) { const int e = (u.pn < 4 ? u.e >> 8 : u.e >> 16) & 255; return Bt + (size_t)e * estride + (size_t)(u.pn & 3) * (size_t)512 * K; }
        return Bt + (size_t)((u.e >> 8) & 255) * estride + (size_t)u.pn * (size_t)(256 * 512);
    }
    __device__ __forceinline__ long b_delta(const pg8::Unit& u) const { return (long)(((u.e >> 16) & 255) - ((u.e >> 8) & 255)) * (long)estride - 512; }
    __device__ __forceinline__ unsigned a_off(int iu, int h, int R, int Cb) const { return (unsigned)rowtab[iu * 256 + h * 128 + R] * (unsigned)(K * 2) + (unsigned)Cb; }
};

__device__ __forceinline__ void router_weights(const P& p, int gtid, int gstride);
__device__ __forceinline__ void tr_item(const float* W, int N, int K, int k0, int n0, const float* gain, float scale, bf16* dst, LAS float* scr, int lane) {
    const int kr = lane >> 3, c4 = lane & 7;
    f32x4 v[8];
#pragma unroll
    for (int i = 0; i < 8; ++i) v[i] = *(const f32x4*)(W + (size_t)(k0 + 8 * i + kr) * N + n0 + 4 * c4);
#pragma unroll
    for (int i = 0; i < 8; ++i) { const int kk = 8 * i + kr; float g = scale; if (gain) g *= gain[k0 + kk];
        LAS float* d = scr + kk * 33 + 4 * c4; d[0] = v[i].x * g; d[1] = v[i].y * g; d[2] = v[i].z * g; d[3] = v[i].w * g; }
    LDS_WAIT();
    const int c = lane & 7;
#pragma unroll
    for (int j = 0; j < 4; ++j) { const int n = (lane >> 3) + 8 * j; const LAS float* s = scr + (8 * c) * 33 + n;
        v4u o; o.x = pk2(s[0 * 33], s[1 * 33]); o.y = pk2(s[2 * 33], s[3 * 33]); o.z = pk2(s[4 * 33], s[5 * 33]); o.w = pk2(s[6 * 33], s[7 * 33]);
        st_b128(dst + (size_t)n * K + k0 + 8 * c, o); }
    LDS_WAIT();
}
__device__ __forceinline__ void tr_item8(const float* W, int N, int K, int k0, int n0, const float* gain, float scale, unsigned char* dst, LAS float* scr, int lane) {
    const int kr = lane >> 3, c4 = lane & 7;
    f32x4 v[8];
#pragma unroll
    for (int i = 0; i < 8; ++i) v[i] = *(const f32x4*)(W + (size_t)(k0 + 8 * i + kr) * N + n0 + 4 * c4);
#pragma unroll
    for (int i = 0; i < 8; ++i) { const int kk = 8 * i + kr; float g = scale; if (gain) g *= gain[k0 + kk];
        LAS float* d = scr + kk * 33 + 4 * c4; d[0] = v[i].x * g; d[1] = v[i].y * g; d[2] = v[i].z * g; d[3] = v[i].w * g; }
    LDS_WAIT();
    const int c = lane & 7;
#pragma unroll
    for (int j = 0; j < 4; ++j) { const int n = (lane >> 3) + 8 * j; const LAS float* s = scr + (8 * c) * 33 + n;
        v2u o; o.x = pk4_fp8(s[0 * 33], s[1 * 33], s[2 * 33], s[3 * 33]); o.y = pk4_fp8(s[4 * 33], s[5 * 33], s[6 * 33], s[7 * 33]);
        st_b64(dst + (size_t)n * K + k0 + 8 * c, o); }
    LDS_WAIT();
}
constexpr int IT_LAYER = 15360;
__device__ __forceinline__ void prologue_item(const P& p, int it, LAS float* scr, int lane) {
    const int l = it / IT_LAYER; int r = it % IT_LAYER;
    unsigned char* wl = ws_base(p.ws) + WS_W + (size_t)l * WS_WLAYER;
    if (r < 1536) {
        const int seg = r / 768; r %= 768; const int kb = r / 48, nb = r % 48; const int n0 = (seg ? 1544 : 0) + 32 * nb, drow = seg * 1536 + 32 * nb;
        const float sc = drow < 512 ? 0.125f * LOG2E : ((drow >= C_GQ && drow < C_GK) ? 0.125f : 1.f);
        tr_item(p.w_in + (size_t)l * DM * INW, INW, DM, 64 * kb, n0, p.mix_norm + l * DM, sc, (bf16*)(wl + WO_IN) + (size_t)drow * DM, scr, lane); return; }
    r -= 1536;
    if (r < 512) { const int kb = r / 32, nb = r % 32; tr_item(p.w_out + (size_t)l * DM * DM, DM, DM, 64 * kb, 32 * nb, nullptr, 1.f, (bf16*)(wl + WO_OUT) + (size_t)(32 * nb) * DM, scr, lane); return; }
    r -= 512;
    if (r < 256) { const int kb = r / 16, nb = r % 16; tr_item(p.w_xq + (size_t)l * DM * 512, 512, DM, 64 * kb, 32 * nb, p.cross_norm + l * DM, 0.08838834764831845f * LOG2E, (bf16*)(wl + WO_XQ) + (size_t)(32 * nb) * DM, scr, lane); return; }
    r -= 256;
    if (r < 256) { const int kb = r / 32, nb = r % 32; tr_item8(p.w_xo + (size_t)l * 512 * DM, DM, 512, 64 * kb, 32 * nb, nullptr, 32.f, (unsigned char*)(wl + WO_XO) + (size_t)(32 * nb) * 512, scr, lane); return; }
    r -= 256;
    if (r < 512) { const int kv = r / 256; r %= 256; const int kb = r / 16, nb = r % 16;
        tr_item((kv ? p.w_xv : p.w_xk) + (size_t)l * DM * 512, 512, DM, 64 * kb, 32 * nb, nullptr, 1.f, (bf16*)(ws_base(p.ws) + WS_WXKV) + (size_t)(l * 1024 + kv * 512 + 32 * nb) * DM, scr, lane); return; }
    r -= 512;
    if (r < 8192) { const int up = r / 4096; r %= 4096; const int e = r / 256; r %= 256; const int kb = r / 16, nb = r % 16; const int c0 = 32 * nb, drow = (c0 >> 7) * 256 + up * 128 + (c0 & 127);
        tr_item8((up ? p.w_eu : p.w_eg) + ((size_t)l * 16 + e) * DM * 512, 512, DM, 64 * kb, c0, p.moe_norm + l * DM, 32.f, (unsigned char*)(wl + WO_GU) + ((size_t)e * 1024 + drow) * DM, scr, lane); return; }
    r -= 8192;
    { const int e = r / 256; r %= 256; const int kb = r / 32, nb = r % 32;
      tr_item8(p.w_ed + ((size_t)l * 16 + e) * 512 * DM, DM, 512, 64 * kb, 32 * nb, nullptr, 32.f, (unsigned char*)(wl + WO_D) + ((size_t)e * 1024 + 32 * nb) * 512, scr, lane); }
}
__device__ __forceinline__ void row_to_bf16(const float* src, bf16* dst, float* ssq, const float* gain, int lane, int mode) {
    const f32x4* s = (const f32x4*)src + lane;
    f32x4 v[4]; float q = 0.f;
#pragma unroll
    for (int j = 0; j < 4; ++j) { v[j] = s[64 * j]; q += (v[j].x * v[j].x + v[j].y * v[j].y) + (v[j].z * v[j].z + v[j].w * v[j].w); }
    q = wave_sum(q);
    float sc = 1.f;
    if (mode == 1) sc = rsqrtf(q * (1.0f / DM) + EPS);
    v2u* d = (v2u*)dst + lane; float q2 = 0.f;
#pragma unroll
    for (int j = 0; j < 4; ++j) {
        f32x4 g = (f32x4){1.f, 1.f, 1.f, 1.f}; if (mode == 1) g = ((const f32x4*)gain)[lane + 64 * j];
        v2u o; o.x = pk2(v[j].x * sc * g.x, v[j].y * sc * g.y); o.y = pk2(v[j].z * sc * g.z, v[j].w * sc * g.w); st_b64(d + 64 * j, o);
        const float r0 = __builtin_bit_cast(float, o.x << 16), r1 = __builtin_bit_cast(float, o.x & 0xffff0000u), r2 = __builtin_bit_cast(float, o.y << 16), r3 = __builtin_bit_cast(float, o.y & 0xffff0000u);
        q2 += (r0 * r0 + r1 * r1) + (r2 * r2 + r3 * r3); }
    if (mode == 0) { q2 = wave_sum(q2); if (lane < 16) ssq[lane] = lane == 0 ? q2 : 0.f; }
}
__device__ __forceinline__ void prologue(const P& p, LAS unsigned char* lds, int vcu, int G, int wave, int lane) {
    asm volatile("" : "+v"(lane));
    if (vcu == 0 && wave == 0) WSP(int, WS_MOE + MO_GCNT)[lane] = 0;
    LAS float* scr = (LAS float*)(lds + LDS_STAGE + wave * 16384);
    const int gw = vcu * NWAVES + wave, NGW = G * NWAVES;
    for (int it = gw; it < NLAYER * IT_LAYER; it += NGW) prologue_item(p, it, scr, lane);
    for (int idx = gw * 64 + lane; idx < NLAYER * 2 * 32768; idx += NGW * 64) {
        const int l = idx / 65536, r = idx % 65536, which = r / 32768, e = r % 32768, row = e & 31, k = e >> 5;
        unsigned char* wl = ws_base(p.ws) + WS_W + (size_t)l * WS_WLAYER;
        if (which == 0) {
            float v = 0.f;
            if (row < 8) v = p.w_in[((size_t)l * DM + k) * INW + 1536 + row]; else if (row < 24) v = p.w_in[((size_t)l * DM + k) * INW + 3080 + (row - 8)];
            ((bf16*)(wl + WO_SM))[row * 1024 + k] = (bf16)f2bf(v * p.mix_norm[l * DM + k]);
        }
    }
    router_weights(p, gw * 64 + lane, NGW * 64);
    for (int m = gw; m < 4096; m += NGW) row_to_bf16(p.mem + (size_t)m * DM, WSP(bf16, WS_MEMN) + (size_t)m * DM, nullptr, p.mem_norm, lane, 1);
    { bf16* hbp = WSP(bf16, WS_HB); float* sqp = WSP(float, WS_SSQ);
      for (int m0 = gw * 4; m0 < NTOK; m0 += NGW * 4) {
        f32x4 v[4][4];
#pragma unroll
        for (int r = 0; r < 4; ++r)
#pragma unroll
            for (int j = 0; j < 4; ++j) v[r][j] = ((const f32x4*)(p.x + (size_t)(m0 + r) * DM))[lane + 64 * j];
#pragma unroll
        for (int r = 0; r < 4; ++r) { float q2 = 0.f; v2u* d = (v2u*)(hbp + (size_t)(m0 + r) * DM) + lane;
#pragma unroll
            for (int j = 0; j < 4; ++j) { v2u o; o.x = pk2(v[r][j].x, v[r][j].y); o.y = pk2(v[r][j].z, v[r][j].w); st_b64(d + 64 * j, o);
                const float r0 = __builtin_bit_cast(float, o.x << 16), r1 = __builtin_bit_cast(float, o.x & 0xffff0000u), r2 = __builtin_bit_cast(float, o.y << 16), r3 = __builtin_bit_cast(float, o.y & 0xffff0000u);
                q2 += (r0 * r0 + r1 * r1) + (r2 * r2 + r3 * r3); }
            q2 = wave_sum(q2); if (lane < 16) sqp[(size_t)(m0 + r) * 16 + lane] = lane == 0 ? q2 : 0.f; }
      } }
}
__device__ __forceinline__ void small_proj(const P& p, int l, LAS unsigned char* lds, int vcu, int G, int wave, int lane) {
    asm volatile("" : "+v"(lane));
    const bf16* wsm = (const bf16*)(ws_base(p.ws) + WS_W + (size_t)l * WS_WLAYER + WO_SM);
    const bf16* hb = WSP(bf16, WS_HB); const float* ssq = WSP(float, WS_SSQ); float* sm = WSP(float, WS_SM);
    constexpr int BST = 2048 + 16;
    { const int tid = wave * 64 + lane;
#pragma unroll
      for (int i = 0; i < 8; ++i) { const int idx = tid + NTHR * i, row = idx >> 7, c = idx & 127; *(LAS v4u*)(lds + row * BST + c * 16) = *(const v4u*)(wsm + row * 1024 + c * 8); } }
    __syncthreads();
    const int r = lane & 15, kq = lane >> 4;
    for (int blk = vcu * NWAVES + wave; blk < NTOK / 16; blk += G * NWAVES) {
        const int tok0 = blk * 16;
        const bf16x8* ap = (const bf16x8*)(hb + (size_t)(tok0 + r) * DM + kq * 32);
        pg8::f32x4 acc0 = {0.f, 0.f, 0.f, 0.f}, acc1 = {0.f, 0.f, 0.f, 0.f};
#pragma unroll
        for (int half = 0; half < 2; ++half) {
            bf16x8 af[16];
#pragma unroll
            for (int i = 0; i < 16; ++i) af[i] = ap[(half * 4 + (i >> 2)) * 16 + (i & 3)];
#pragma unroll
            for (int i = 0; i < 16; ++i) { const int s_ = half * 4 + (i >> 2), j = i & 3;
                const bf16x8 b0 = *(const LAS bf16x8*)(lds + r * BST + (128 * s_ + 32 * kq + 8 * j) * 2);
                const bf16x8 b1 = *(const LAS bf16x8*)(lds + (16 + r) * BST + (128 * s_ + 32 * kq + 8 * j) * 2);
                acc0 = __builtin_amdgcn_mfma_f32_16x16x32_bf16(af[i], b0, acc0, 0, 0, 0);
                acc1 = __builtin_amdgcn_mfma_f32_16x16x32_bf16(af[i], b1, acc1, 0, 0, 0);
                if ((i & 3) == 3) __builtin_amdgcn_sched_barrier(0); }
        }
        const float rsv = row_rs(ssq, tok0 + r);
#pragma unroll
        for (int g = 0; g < 4; ++g) { const int trow = 4 * kq + g; const float rs = __shfl(rsv, trow);
            sm[(size_t)(tok0 + trow) * 32 + r] = acc0[g] * rs; if (r < 8) sm[(size_t)(tok0 + trow) * 32 + 16 + r] = acc1[g] * rs; }
    }
    __syncthreads();
}
typedef short v4i16_t __attribute__((ext_vector_type(4)));
typedef __bf16 bf16x2_t __attribute__((ext_vector_type(2)));
typedef float f32x2_t __attribute__((ext_vector_type(2)));
__device__ __forceinline__ unsigned cvtpk(float lo, float hi) { f32x2_t v = {lo, hi}; bf16x2_t b = __builtin_convertvector(v, bf16x2_t); return __builtin_bit_cast(unsigned, b); }
__device__ __forceinline__ bf16x8 pack8(const f32x16& p, int o) {
    v4u w; w.x = cvtpk(p[o], p[o + 1]); w.y = cvtpk(p[o + 2], p[o + 3]); w.z = cvtpk(p[o + 4], p[o + 5]); w.w = cvtpk(p[o + 6], p[o + 7]);
    return __builtin_bit_cast(bf16x8, w);
}
__device__ __forceinline__ float max3f(float a, float b, float c) { float r; asm("v_max3_f32 %0, %1, %2, %3" : "=v"(r) : "v"(a), "v"(b), "v"(c)); return r; }
template <int D, bool FOX, bool OUT8 = false>
__device__ __forceinline__ void attn_unit(LAS unsigned char* lds, const bf16* Qg, int qpitch, const bf16* Kg, const bf16* Vg, int kvpitch, int NT,
                                          const float* cb, int q0, bf16* Og, int opitch, const float* gain, const float* kn) {
    constexpr int KS = D * 2 + 16, VS = D * 2 + 64;
    constexpr int KT = FOX ? 2 : 1, KEYS = 64 * KT;
    constexpr int KBYTES = KEYS * KS, VBYTES = KEYS * VS;
    constexpr int CPR = D / 8, NCH = KEYS * CPR / NTHR, NS = D / 16, NDB = D / 32;
    constexpr int OFF_K = 0, OFF_V = 2 * KBYTES, OFF_CB = 2 * KBYTES + 2 * VBYTES, OFF_FX = OFF_CB + 2 * KEYS * 4;
    int tid = threadIdx.x; asm volatile("" : "+v"(tid));
    const int lane = tid & 63, wave = __builtin_amdgcn_readfirstlane(tid >> 6), r32 = lane & 31, hh = lane >> 5;
    bf16x8 qf[NS];
    { const bf16* qrow = Qg + (size_t)(wave * 32 + r32) * qpitch;
#pragma unroll
      for (int s = 0; s < NS; ++s) qf[s] = *(const bf16x8*)(qrow + 16 * s + 8 * hh); }
    v4u kreg[NCH], vreg[NCH]; f32x4 cbreg = {0.f, 0.f, 0.f, 0.f};
#define AT_GLOAD(t) do { _Pragma("unroll") for (int i_ = 0; i_ < NCH; ++i_) { const int idx_ = tid + NTHR * i_, key_ = idx_ / CPR, c_ = idx_ % CPR; \
        kreg[i_] = *(const v4u*)(Kg + (size_t)((t) * KEYS + key_) * kvpitch + c_ * 8); vreg[i_] = *(const v4u*)(Vg + (size_t)((t) * KEYS + key_) * kvpitch + c_ * 8); } \
        if (FOX && tid < KEYS / 4) cbreg = *(const f32x4*)(cb + (t) * KEYS + tid * 4); } while (0)
#define AT_LSTORE(b) do { _Pragma("unroll") for (int i_ = 0; i_ < NCH; ++i_) { const int idx_ = tid + NTHR * i_, key_ = idx_ / CPR, c_ = idx_ % CPR; \
        *(LAS v4u*)(lds + OFF_K + (b) * KBYTES + key_ * KS + c_ * 16) = kreg[i_]; *(LAS v4u*)(lds + OFF_V + (b) * VBYTES + key_ * VS + c_ * 16) = vreg[i_]; } \
        if (FOX && tid < KEYS / 4) *(LAS f32x4*)(lds + OFF_CB + (b) * (KEYS * 4) + tid * 16) = cbreg; } while (0)
    float m = -INFINITY, l = 0.f;
    f32x16 osum = f32x16{};
    f32x16 o[NDB];
#pragma unroll
    for (int d = 0; d < NDB; ++d) o[d] = f32x16{};
    const int qlo = q0 + wave * 32, qabs = qlo + r32;
    float knpre = 0.f, qkmax = 0.f;
    LAS float* fx = (LAS float*)(lds + OFF_FX);
    const int NTG = NT / KT;
    const int t_first = FOX ? NTG - 1 : 0;
    AT_GLOAD(t_first);
    __syncthreads();
    if (FOX) {
        float qn2 = 0.f;
#pragma unroll
        for (int s = 0; s < NS; ++s)
#pragma unroll
            for (int e = 0; e < 8; ++e) { const float v = __builtin_bit_cast(float, ((unsigned)(unsigned short)qf[s][e]) << 16); qn2 += v * v; }
        qn2 += __shfl_xor(qn2, 32);
        qn2 = wave_max(qn2);
        if (lane == 0) fx[wave] = qn2;
        knpre = lane < 32 ? kn[lane] : 0.f;
#pragma unroll
        for (int o_ = 1; o_ < 32; o_ <<= 1) { const float t_ = __shfl_up(knpre, o_); if (lane >= o_) knpre = fmaxf(knpre, t_); }
    }
    AT_LSTORE(0);
    __syncthreads();
    if (FOX) { float q2 = fx[0];
#pragma unroll
        for (int w_ = 1; w_ < 8; ++w_) q2 = fmaxf(q2, fx[w_]);
        qkmax = sqrtf(q2); }
#pragma unroll 1
    for (int it = 0; it < NTG; ++it) {
        const int b = it & 1;
        const int tg = FOX ? NTG - 1 - it : it;
        const int tn = FOX ? tg - 1 : tg + 1;
        if (it + 1 < NTG) AT_GLOAD(tn);
#pragma unroll
        for (int sub_ = 0; sub_ < KT; ++sub_) {
        const int sub = FOX ? KT - 1 - sub_ : sub_, koff = sub * 64;
        const int kt0 = (tg * KT + sub) * 64;
        if (!FOX || kt0 <= qlo + 31) {
            f32x16 p[2];
#pragma unroll
            for (int kb = 0; kb < 2; ++kb) {
                if (FOX) {
#pragma unroll
                    for (int g = 0; g < 4; ++g) { const f32x4 c4 = *(const LAS f32x4*)(lds + OFF_CB + b * (KEYS * 4) + (koff + kb * 32 + 8 * g + 4 * hh) * 4); p[kb][4 * g] = c4.x; p[kb][4 * g + 1] = c4.y; p[kb][4 * g + 2] = c4.z; p[kb][4 * g + 3] = c4.w; }
                } else p[kb] = f32x16{};
                const LAS unsigned char* kp = lds + OFF_K + b * KBYTES + (koff + kb * 32 + r32) * KS + hh * 16;
#pragma unroll
                for (int s = 0; s < NS; ++s) { const bf16x8 kf = *(const LAS bf16x8*)(kp + s * 32); p[kb] = __builtin_amdgcn_mfma_f32_32x32x16_bf16(kf, qf[s], p[kb], 0, 0, 0); }
            }
            if (FOX && kt0 + 63 > qlo) {
#pragma unroll
                for (int kb = 0; kb < 2; ++kb)
#pragma unroll
                    for (int r = 0; r < 16; ++r) { const int key = kt0 + kb * 32 + (r & 3) + 8 * (r >> 2) + 4 * hh; if (key > qabs) p[kb][r] = -INFINITY; }
            }
            float mt = fmaxf(p[1][0], p[0][0]);
#pragma unroll
            for (int r = 1; r < 16; ++r) mt = max3f(mt, p[0][r], p[1][r]);
            mt = fmaxf(mt, __shfl_xor(mt, 32));
            const float mnew = fmaxf(m, mt);
            float ls = 0.f;
#pragma unroll
            for (int kb = 0; kb < 2; ++kb)
#pragma unroll
                for (int r = 0; r < 16; ++r) { const float e = __builtin_amdgcn_exp2f(p[kb][r] - mnew); p[kb][r] = e; if (!FOX) ls += e; }
            if (!FOX || __builtin_amdgcn_ballot_w64(mnew > m) != 0ull) {
                const float alpha = __builtin_amdgcn_exp2f(m - mnew);
                l *= alpha; if (FOX) osum[0] *= alpha;
#pragma unroll
                for (int d = 0; d < NDB; ++d)
#pragma unroll
                    for (int r = 0; r < 16; ++r) o[d][r] *= alpha;
            }
            m = mnew; l += ls;
            bf16x8 pa[2][2];
#pragma unroll
            for (int kb = 0; kb < 2; ++kb) { pa[kb][0] = pack8(p[kb], 0); pa[kb][1] = pack8(p[kb], 8); }
            const LAS unsigned char* vp = lds + OFF_V + b * VBYTES + (koff + 4 * hh + ((lane & 15) >> 2)) * VS + (16 * ((lane >> 4) & 1) + 4 * (lane & 3)) * 2;
#pragma unroll
            for (int d = 0; d < NDB; ++d) {
#pragma unroll
                for (int kb = 0; kb < 2; ++kb)
#pragma unroll
                    for (int ks = 0; ks < 2; ++ks) {
                        const LAS unsigned char* a0 = vp + (kb * 32 + 16 * ks) * VS + d * 64;
                        const v4i16_t lo = __builtin_amdgcn_ds_read_tr16_b64_v4i16((LAS v4i16_t*)a0);
                        const v4i16_t hi = __builtin_amdgcn_ds_read_tr16_b64_v4i16((LAS v4i16_t*)(a0 + 8 * VS));
                        const bf16x8 vf = (bf16x8){lo[0], lo[1], lo[2], lo[3], hi[0], hi[1], hi[2], hi[3]};
                        o[d] = __builtin_amdgcn_mfma_f32_32x32x16_bf16(vf, pa[kb][ks], o[d], 0, 0, 0);
                    }
            }
            if (FOX) {
                const bf16x8 ones = __builtin_bit_cast(bf16x8, (v4u){0x3F803F80u, 0x3F803F80u, 0x3F803F80u, 0x3F803F80u});
#pragma unroll
                for (int kb = 0; kb < 2; ++kb)
#pragma unroll
                    for (int ks = 0; ks < 2; ++ks) osum = __builtin_amdgcn_mfma_f32_32x32x16_bf16(ones, pa[kb][ks], osum, 0, 0, 0);
            }
        }
        }
        if (FOX) { const float mm = wave_min(m); if (lane == 0) fx[8 + b * 8 + wave] = mm; }
        if (it + 1 < NTG) AT_LSTORE(b ^ 1);
        __syncthreads();
        if (FOX && tg > 0) {
            float M0 = fx[8 + b * 8];
#pragma unroll
            for (int w_ = 1; w_ < 8; ++w_) M0 = fminf(M0, fx[8 + b * 8 + w_]);
            const float cbl = *(const LAS float*)(lds + OFF_CB + (b ^ 1) * (KEYS * 4) + (KEYS - 1) * 4);
            const float knb = __builtin_bit_cast(float, __builtin_amdgcn_readlane(__builtin_bit_cast(int, knpre), tg * KT - 1));
            if (qkmax * knb + cbl < M0 - 40.f) break;
        }
    }
#undef AT_GLOAD
#undef AT_LSTORE
    if (FOX) l = osum[0]; else l += __shfl_xor(l, 32);
    const float inv = 1.0f / l;
    float rs = inv;
    if (FOX) {
        float ss = 0.f;
#pragma unroll
        for (int d = 0; d < NDB; ++d)
#pragma unroll
            for (int r = 0; r < 16; ++r) { const float v = o[d][r] * inv; ss += v * v; }
        ss += __shfl_xor(ss, 32);
        rs = inv * rsqrtf(ss * (1.0f / D) + EPS);
    }
    constexpr int SROW = 144;
    LAS unsigned char* stg = lds + OFF_K + wave * (32 * SROW);
#pragma unroll
    for (int d = 0; d < NDB; ++d)
#pragma unroll
        for (int g = 0; g < 4; ++g) {
            if (OUT8) { *(LAS unsigned*)(stg + r32 * SROW + 32 * d + 8 * g + 4 * hh) = pk4_fp8(o[d][4 * g] * rs, o[d][4 * g + 1] * rs, o[d][4 * g + 2] * rs, o[d][4 * g + 3] * rs); }
            else { f32x4 gn = {1.f, 1.f, 1.f, 1.f}; if (FOX) gn = *(const f32x4*)(gain + 32 * d + 8 * g + 4 * hh);
                v2u w; w.x = cvtpk(o[d][4 * g] * rs * gn.x, o[d][4 * g + 1] * rs * gn.y); w.y = cvtpk(o[d][4 * g + 2] * rs * gn.z, o[d][4 * g + 3] * rs * gn.w);
                *(LAS v2u*)(stg + r32 * SROW + (32 * d + 8 * g + 4 * hh) * 2) = w; }
        }
    static_assert((OUT8 ? D : D * 2) == 128, "stage rows are 128 bytes");
    { unsigned char* ob = (unsigned char*)Og; const size_t pitchb = (size_t)opitch * (OUT8 ? 1 : 2);
#pragma unroll
      for (int i = 0; i < 4; ++i) { const int row = i * 8 + (lane >> 3), ch = lane & 7;
          const v4u w = *(const LAS v4u*)(stg + row * SROW + ch * 16);
          st_b128(ob + (size_t)(wave * 32 + row) * pitchb + ch * 16, w); } }
}
__device__ __forceinline__ void fox_phase(const P& p, int l, LAS unsigned char* lds, int vcu, int G) {
    const bf16* proj = WSP(bf16, WS_PROJ); const float* cb = WSP(float, WS_CB); bf16* y = WSP(bf16, WS_Y);
    for (int pu = vcu; pu < 512; pu += G) {
        const int bh = pu >> 2, pr = pu < 256 ? (pu & 3) : 3 - (pu & 3), b = bh >> 3, h = bh & 7;
        for (int half = 0; half < 2; ++half) {
            const int qb = half ? pr : 7 - pr;
            const size_t row0 = (size_t)b * SEQ;
            attn_unit<64, true>(lds, proj + (row0 + qb * 256) * PW + C_FQ + h * 64, PW, proj + row0 * PW + C_FK + h * 64, proj + row0 * PW + C_FV + h * 64, PW, 4 * (qb + 1),
                                cb + ((size_t)b * 8 + h) * SEQ, qb * 256, y + (row0 + qb * 256) * DM + h * 64, DM, p.fox_gain + l * 512 + h * 64, WSP(const float, WS_MOE + MO_KN) + (b * 8 + h) * 32);
        }
    }
}
__device__ __forceinline__ void xattn_phase(const P& p, int l, LAS unsigned char* lds, int vcu, int G, bool dummy) {
    bf16* xq = WSP(bf16, WS_XQ); const bf16* xkv = WSP(bf16, WS_XKV);
    for (int u = vcu; u < 512; u += G) {
        const int b = u >> 5, h = (u >> 3) & 3, qb = u & 7;
        bf16* qp = xq + ((size_t)b * SEQ + qb * 256) * 512 + h * 128;
        const bf16* kp = xkv + (size_t)b * MEML * 2048 + l * 1024 + h * 128;
        attn_unit<128, false, true>(lds, qp, 512, kp, kp + 512, 2048, 4, nullptr, 0, (bf16*)((dummy ? WSP(unsigned char, WS_Y) : WSP(unsigned char, WS_XO8)) + ((size_t)b * SEQ + qb * 256) * 512 + h * 128), 512, nullptr, nullptr);
    }
}

__device__ __forceinline__ void xattn_pair(const P& p, int l, LAS unsigned char* lds, int pm, int pn, bool dummy) {
    const bf16* xq = WSP(bf16, WS_XQ); const bf16* xkv = WSP(bf16, WS_XKV);
    const int b = pm >> 3;
    for (int hh2 = 0; hh2 < 2; ++hh2) {
        const int h = 2 * pn + hh2;
        const bf16* qp = xq + (size_t)pm * 256 * 512 + h * 128;
        const bf16* kp = xkv + (size_t)b * MEML * 2048 + l * 1024 + h * 128;
        attn_unit<128, false, true>(lds, qp, 512, kp, kp + 512, 2048, 4, nullptr, 0, (bf16*)((dummy ? WSP(unsigned char, WS_Y) : WSP(unsigned char, WS_XO8)) + (size_t)pm * 256 * 512 + h * 128), 512, nullptr, nullptr);
    }
}
constexpr size_t WS_GB = WS_END;
constexpr size_t WS_RT2 = WS_GB + 16 * MiB;
constexpr size_t WS_RG2 = WS_GB + 20 * MiB;
constexpr size_t WS_GDEC = WS_GB + 32 * MiB;
constexpr size_t WS_END2 = WS_GDEC + 1 * MiB;
static_assert(WS_END2 <= 512 * MiB, "workspace map 2");
constexpr int GL_B = 0;
constexpr int GL_TOT = 16384;
constexpr int GL_Q1 = 18432, GL_Q2 = GL_Q1 + 64 * 144, GL_K2 = GL_Q2 + 64 * 144;
constexpr int GL_KD = GL_K2 + 64 * 144;
constexpr int GL_V = GL_KD + 64 * 192;
constexpr int GL_SSQ = GL_V + 64 * 320;
constexpr int GL_GA = GL_SSQ + 1024;
constexpr int GL_YST = GL_GA + 4096;
constexpr int GL_GG = GL_YST + 64 * 272;
constexpr int GL_END = GL_GG + 64 * 272;
static_assert(GL_END <= 131072, "gla lds");

__device__ __forceinline__ float fast_log_sigmoid(float z) { return fminf(z, 0.f) - __logf(1.f + __expf(-fabsf(z))); }
__device__ __forceinline__ void gla_load_v(const bf16* proj, size_t tok0, int h, LAS unsigned char* lds, int tid) {
#pragma unroll
    for (int i = 0; i < 2; ++i) { const int idx = tid + NTHR * i, t = idx >> 4, c = idx & 15;
        *(LAS v4u*)(lds + GL_V + t * 320 + c * 16) = *(const v4u*)(proj + (tok0 + t) * PW + C_GV + h * 128 + c * 8); }
}
__device__ __forceinline__ bf16x8 tr_frag(const LAS unsigned char* a0, int rowstride4) {
    const v4i16_t lo = __builtin_amdgcn_ds_read_tr16_b64_v4i16((LAS v4i16_t*)a0);
    const v4i16_t hi = __builtin_amdgcn_ds_read_tr16_b64_v4i16((LAS v4i16_t*)(a0 + rowstride4));
    return (bf16x8){lo[0], lo[1], lo[2], lo[3], hi[0], hi[1], hi[2], hi[3]};
}
constexpr int GA_WAVE = 19456, GA_SROW = 144;
static_assert(8 * GA_WAVE <= LDS_MISC && 128 * GA_SROW <= GA_WAVE, "gla phase A lds");
__device__ __forceinline__ void gla_phase_a(const P& p, int l, LAS unsigned char* lds, int vcu, int G) {
    int tid = threadIdx.x; asm volatile("" : "+v"(tid));
    const int lane = tid & 63, wave = __builtin_amdgcn_readfirstlane(tid >> 6), hh = lane >> 5;
    const bf16* proj = WSP(bf16, WS_PROJ); bf16* loc = ((bf16*)p.out); float* dec = WSP(float, WS_GDEC); const float* sm = WSP(float, WS_SM); _Float16* gb = WSP(_Float16, WS_GB);
    LAS unsigned char* kd = lds + wave * GA_WAVE; LAS unsigned char* vh = kd + 8192;
    const int crow8 = lane >> 3, cch = lane & 7;
    const int trow = (lane & 15) >> 2, tcol = 16 * ((lane >> 4) & 1) + 4 * (lane & 3);
    for (int u = vcu * NWAVES + wave; u < 2048; u += G * NWAVES) {
        const int c = u & 31, h = (u >> 5) & 3, b = u >> 7;
        const size_t tok0 = (size_t)b * SEQ + c * 64;
        v4u kreg[8], v0reg[8], v1reg[8];
#pragma unroll
        for (int i = 0; i < 8; ++i) { const bf16* rp = proj + (tok0 + i * 8 + crow8) * PW;
            kreg[i] = *(const v4u*)(rp + C_GK + h * 64 + cch * 8); v0reg[i] = *(const v4u*)(rp + C_GV + h * 128 + cch * 8); v1reg[i] = *(const v4u*)(rp + C_GV + h * 128 + 64 + cch * 8); }
        float w[16];
#pragma unroll
        for (int r = 0; r < 16; ++r) w[r] = p.w_alpha_up[((size_t)l * 16 + r) * 256 + h * 64 + lane];
        const float bias = p.b_alpha[l * 256 + h * 64 + lane];
        { LAS f32x4* gw = (LAS f32x4*)vh;
#pragma unroll
          for (int i = 0; i < 4; ++i) gw[lane * 4 + i] = *(const f32x4*)(sm + (tok0 + lane) * 32 + 8 + 4 * i); }
        float bt[64]; float run = 0.f;
#pragma unroll
        for (int t = 0; t < 64; ++t) {
            float z = bias;
#pragma unroll
            for (int r4 = 0; r4 < 4; ++r4) { const f32x4 g4 = ((const LAS f32x4*)vh)[t * 4 + r4]; z += g4.x * w[4 * r4] + g4.y * w[4 * r4 + 1] + g4.z * w[4 * r4 + 2] + g4.w * w[4 * r4 + 3]; }
            run += fast_log_sigmoid(z) * (1.0f / 16.0f); bt[t] = run; gb[(tok0 + t) * 256 + h * 64 + lane] = (_Float16)run;
        }
#pragma unroll
        for (int i = 0; i < 8; ++i) { *(LAS v4u*)(kd + (i * 8 + crow8) * 128 + cch * 16) = kreg[i]; *(LAS v4u*)(vh + (i * 8 + crow8) * 128 + cch * 16) = v0reg[i]; }
#pragma unroll
        for (int t = 0; t < 64; ++t) { LAS bf16* kp = (LAS bf16*)(kd + t * 128 + lane * 2); *kp = (bf16)f2bf(bf2f(*kp) * __expf(run - bt[t])); }
        dec[(size_t)u * 64 + lane] = __expf(run);
        f32x16 acc[2][2][2];
#pragma unroll
        for (int half = 0; half < 2; ++half) {
            if (half == 1) {
#pragma unroll
                for (int i = 0; i < 8; ++i) *(LAS v4u*)(vh + (i * 8 + crow8) * 128 + cch * 16) = v1reg[i];
            }
#pragma unroll
            for (int x = 0; x < 2; ++x)
#pragma unroll
                for (int y = 0; y < 2; ++y) acc[half][y][x] = f32x16{};
#pragma unroll
            for (int s = 0; s < 4; ++s) {
                bf16x8 af[2], bfr[2];
#pragma unroll
                for (int x = 0; x < 2; ++x) { af[x] = tr_frag(vh + (16 * s + 8 * hh + trow) * 128 + (32 * x + tcol) * 2, 4 * 128); bfr[x] = tr_frag(kd + (16 * s + 8 * hh + trow) * 128 + (32 * x + tcol) * 2, 4 * 128); }
#pragma unroll
                for (int x = 0; x < 2; ++x)
#pragma unroll
                    for (int y = 0; y < 2; ++y) acc[half][y][x] = __builtin_amdgcn_mfma_f32_32x32x16_bf16(bfr[y], af[x], acc[half][y][x], 0, 0, 0);
            }
        }
#pragma unroll
        for (int half = 0; half < 2; ++half)
#pragma unroll
            for (int x = 0; x < 2; ++x)
#pragma unroll
                for (int y = 0; y < 2; ++y)
#pragma unroll
                    for (int g = 0; g < 4; ++g) { const f32x16& a = acc[half][y][x];
                        v2u w2; w2.x = cvtpk(a[4 * g], a[4 * g + 1]); w2.y = cvtpk(a[4 * g + 2], a[4 * g + 3]);
                        *(LAS v2u*)(kd + (64 * half + 32 * x + (lane & 31)) * GA_SROW + (32 * y + 8 * g + 4 * hh) * 2) = w2; }
#pragma unroll
        for (int i = 0; i < 16; ++i) { const int idx = lane + 64 * i, row = idx >> 3, ch = idx & 7;
            st_b128(loc + (size_t)u * 8192 + row * 64 + ch * 8, *(const LAS v4u*)(kd + row * GA_SROW + ch * 16)); }
    }
}
__device__ __forceinline__ void gla_phase_b(const P& p, int vcu, int G) {
    int tid = threadIdx.x; asm volatile("" : "+v"(tid));
    const bf16* loc = ((const bf16*)p.out); const float* dec = WSP(float, WS_GDEC); bf16* gs = (bf16*)((unsigned char*)p.out + 96 * MiB);
    for (int u = vcu; u < 256; u += G) {
        const int bh = u >> 2, q4 = u & 3;
        const int e = q4 * 2048 + tid * 4, dk = e & 63;
        f32x4 st = {0.f, 0.f, 0.f, 0.f};
#pragma unroll 8
        for (int c = 0; c < 32; ++c) {
            const size_t cu = (size_t)bh * 32 + c;
            const v2u lw = *(const v2u*)(loc + cu * 8192 + e);
            const f32x4 lv = {__builtin_bit_cast(float, lw.x << 16), __builtin_bit_cast(float, lw.x & 0xffff0000u), __builtin_bit_cast(float, lw.y << 16), __builtin_bit_cast(float, lw.y & 0xffff0000u)};
            const f32x4 dv = *(const f32x4*)(dec + cu * 64 + dk);
            v2u w; w.x = pk2(st.x, st.y); w.y = pk2(st.z, st.w);
            *(v2u*)(gs + cu * 8192 + e) = w;
            st = dv * st + lv;
        }
    }
}
__device__ __forceinline__ void gla_phase_c(const P& p, int l, LAS unsigned char* lds, int vcu, int G) {
    int tid = threadIdx.x; asm volatile("" : "+v"(tid));
    const int lane = tid & 63, wave = __builtin_amdgcn_readfirstlane(tid >> 6), hh = lane >> 5, r32 = lane & 31;
    const bf16* proj = WSP(bf16, WS_PROJ); const bf16* gs = (const bf16*)((const unsigned char*)p.out + 96 * MiB); bf16* y = WSP(bf16, WS_Y); const _Float16* gb = WSP(const _Float16, WS_GB);
    const int dvb = wave >> 1, tb = wave & 1;
    const int trow = (lane & 15) >> 2, tcol = 16 * ((lane >> 4) & 1) + 4 * (lane & 3);
    bf16 n_q[8], n_k[8]; v4u n_v[2], n_g[2]; bf16x8 n_s[4]; f32x4 n_n[4]; float n_b[8], n_r = 0.f;
#define GC_LOAD(uu) do { const int c_ = (uu) & 31, h_ = ((uu) >> 5) & 3, b_ = (uu) >> 7; const size_t t0_ = (size_t)b_ * SEQ + c_ * 64; \
        _Pragma("unroll") for (int j = 0; j < 8; ++j) { const bf16* rp = proj + (t0_ + wave * 8 + j) * PW + h_ * 64 + lane; n_q[j] = rp[C_GQ]; n_k[j] = rp[C_GK]; } \
        _Pragma("unroll") for (int i = 0; i < 2; ++i) { const int idx = tid + NTHR * i, t = idx >> 4, cc = idx & 15; n_v[i] = *(const v4u*)(proj + (t0_ + t) * PW + C_GV + h_ * 128 + cc * 8); n_g[i] = *(const v4u*)(proj + (t0_ + t) * PW + C_GG + h_ * 128 + cc * 8); } \
        { const bf16* sp = gs + (size_t)(uu) * 8192 + (size_t)(32 * dvb + r32) * 64 + 8 * hh; \
          _Pragma("unroll") for (int s2 = 0; s2 < 4; ++s2) n_s[s2] = *(const bf16x8*)(sp + 16 * s2); } \
        _Pragma("unroll") for (int j = 0; j < 8; ++j) n_b[j] = (float)gb[(t0_ + wave * 8 + j) * 256 + h_ * 64 + lane]; \
        n_r = (float)gb[(t0_ + 31) * 256 + h_ * 64 + lane]; \
        _Pragma("unroll") for (int g = 0; g < 4; ++g) { const int dv = 32 * dvb + 8 * g + 4 * hh; \
            n_n[g] = *(const f32x4*)(p.gla_gain + l * 512 + h_ * 128 + dv); } } while (0)
    if (vcu < 2048) GC_LOAD(vcu);
    __syncthreads();
    for (int u = vcu; u < 2048; u += G) {
        const int c = u & 31, h = (u >> 5) & 3, b = u >> 7;
        const size_t tok0 = (size_t)b * SEQ + c * 64;
        bf16x8 sfr[4]; f32x4 gnr[4];
#pragma unroll
        for (int i = 0; i < 4; ++i) { sfr[i] = n_s[i]; gnr[i] = n_n[i]; }
#pragma unroll
        for (int i = 0; i < 2; ++i) { const int idx = tid + NTHR * i, t = idx >> 4, cc = idx & 15; *(LAS v4u*)(lds + GL_V + t * 320 + cc * 16) = n_v[i]; *(LAS v4u*)(lds + GL_GG + t * 272 + cc * 16) = n_g[i]; }
        { const float rref = n_r;
#pragma unroll
          for (int j = 0; j < 8; ++j) { const int t = wave * 8 + j; const float bt = n_b[j];
            const float qv = bf2f(n_q[j]), kv = bf2f(n_k[j]);
            *(LAS bf16*)(lds + GL_Q1 + t * 144 + lane * 2) = (bf16)f2bf(qv * __expf(bt));
            *(LAS bf16*)(lds + GL_Q2 + t * 144 + lane * 2) = (bf16)f2bf(qv * __expf(bt - rref));
            *(LAS bf16*)(lds + GL_K2 + t * 144 + lane * 2) = (bf16)f2bf(kv * __expf(rref - bt)); } }
        __syncthreads();
        if (u + G < 2048) GC_LOAD(u + G);
        f32x16 o = {};
        {
#pragma unroll
          for (int s = 0; s < 4; ++s) { const bf16x8 af = sfr[s]; const bf16x8 bq = *(const LAS bf16x8*)(lds + GL_Q1 + (32 * tb + r32) * 144 + (16 * s + 8 * hh) * 2);
              o = __builtin_amdgcn_mfma_f32_32x32x16_bf16(af, bq, o, 0, 0, 0); } }
#pragma unroll
        for (int sb = 0; sb < 2; ++sb) {
            if (sb <= tb) {
                f32x16 pt = {};
#pragma unroll
                for (int s = 0; s < 4; ++s) { const bf16x8 ak = *(const LAS bf16x8*)(lds + GL_K2 + (32 * sb + r32) * 144 + (16 * s + 8 * hh) * 2); const bf16x8 bq = *(const LAS bf16x8*)(lds + GL_Q2 + (32 * tb + r32) * 144 + (16 * s + 8 * hh) * 2);
                    pt = __builtin_amdgcn_mfma_f32_32x32x16_bf16(ak, bq, pt, 0, 0, 0); }
                if (sb == tb) {
#pragma unroll
                    for (int r = 0; r < 16; ++r) { const int s_ = (r & 3) + 8 * (r >> 2) + 4 * hh; if (s_ > r32) pt[r] = 0.f; }
                }
#pragma unroll
                for (int ks = 0; ks < 2; ++ks) {
                    const bf16x8 pa = pack8(pt, 8 * ks);
                    const bf16x8 vf = tr_frag(lds + GL_V + (32 * sb + 16 * ks + 4 * hh + trow) * 320 + (32 * dvb + tcol) * 2, 8 * 320);
                    o = __builtin_amdgcn_mfma_f32_32x32x16_bf16(vf, pa, o, 0, 0, 0);
                }
            }
        }
        float ss = 0.f;
#pragma unroll
        for (int r = 0; r < 16; ++r) ss += o[r] * o[r];
        ss += __shfl_xor(ss, 32);
        LAS float* sq = (LAS float*)(lds + GL_SSQ);
        if (hh == 0) sq[dvb * 64 + 32 * tb + r32] = ss;
        __syncthreads();
        const int t = 32 * tb + r32;
        const float tot = (sq[t] + sq[64 + t]) + (sq[128 + t] + sq[192 + t]);
        const float rs = rsqrtf(tot * (1.0f / 128.0f) + EPS);
#pragma unroll
        for (int g = 0; g < 4; ++g) {
            const int dv = 32 * dvb + 8 * g + 4 * hh;
            const f32x4 gn = gnr[g];
            const v2u gg = *(const LAS v2u*)(lds + GL_GG + t * 272 + dv * 2);
            const float g0 = bf2f((bf16)(gg.x & 0xffff)), g1 = bf2f((bf16)(gg.x >> 16)), g2 = bf2f((bf16)(gg.y & 0xffff)), g3 = bf2f((bf16)(gg.y >> 16));
            const float v0 = o[4 * g] * rs * gn.x * g0 * __builtin_amdgcn_rcpf(1.f + __expf(-g0)), v1 = o[4 * g + 1] * rs * gn.y * g1 * __builtin_amdgcn_rcpf(1.f + __expf(-g1));
            const float v2 = o[4 * g + 2] * rs * gn.z * g2 * __builtin_amdgcn_rcpf(1.f + __expf(-g2)), v3 = o[4 * g + 3] * rs * gn.w * g3 * __builtin_amdgcn_rcpf(1.f + __expf(-g3));
            v2u w; w.x = cvtpk(v0, v1); w.y = cvtpk(v2, v3);
            *(LAS v2u*)(lds + GL_YST + t * 272 + dv * 2) = w;
        }
        __syncthreads();
#pragma unroll
        for (int i = 0; i < 2; ++i) { const int idx = tid + NTHR * i, tr_ = idx >> 4, ch = idx & 15;
            st_b128(y + (tok0 + tr_) * DM + 512 + h * 128 + ch * 8, *(const LAS v4u*)(lds + GL_YST + tr_ * 272 + ch * 16)); }
    }
#undef GC_LOAD
}
__device__ __forceinline__ void fox_cumsum_phase(const P& p, int l, LAS unsigned char* lds, int vcu, int G) {
    int tid = threadIdx.x; asm volatile("" : "+v"(tid));
    const int lane = tid & 63, wave = __builtin_amdgcn_readfirstlane(tid >> 6);
    const float* sm = WSP(float, WS_SM); float* cb = WSP(float, WS_CB);
    LAS float* tot = (LAS float*)(lds + 256);
    for (int u = vcu; u < NBATCH * 8; u += G) {
        const int b = u >> 3, h = u & 7;
        const float bias = p.b_forget[l * 8 + h];
        const int s0 = wave * 256 + lane * 4;
        float v[4]; float run = 0.f;
#pragma unroll
        for (int j = 0; j < 4; ++j) v[j] = sm[((size_t)b * SEQ + s0 + j) * 32 + h];
#pragma unroll
        for (int j = 0; j < 4; ++j) { run += fast_log_sigmoid(v[j] + bias); v[j] = run; }
        float pre = run;
#pragma unroll
        for (int o = 1; o < 64; o <<= 1) { const float t = __shfl_up(pre, o); if (lane >= o) pre += t; }
        __syncthreads();
        if (lane == 63) tot[wave] = pre;
        __syncthreads();
        float base = pre - run;
#pragma unroll
        for (int w_ = 0; w_ < 8; ++w_) { const float t = tot[w_]; if (w_ < wave) base += t; }
        f32x4 o4; o4.x = -(v[0] + base) * LOG2E; o4.y = -(v[1] + base) * LOG2E; o4.z = -(v[2] + base) * LOG2E; o4.w = -(v[3] + base) * LOG2E;
        *(f32x4*)(cb + ((size_t)b * 8 + h) * SEQ + s0) = o4;
    }
}
__device__ __forceinline__ void fox_knorm_phase(const P& p, int vcu, int G) {
    int tid = threadIdx.x; asm volatile("" : "+v"(tid));
    const int lane = tid & 63, wave = __builtin_amdgcn_readfirstlane(tid >> 6);
    const bf16* proj = WSP(bf16, WS_PROJ); float* kn = WSP(float, WS_MOE + MO_KN);
    for (int task = vcu * NWAVES + wave; task < NBATCH * 8 * 32; task += G * NWAVES) {
        const int j = task & 31, h = (task >> 5) & 7, b = task >> 8;
        float mx = 0.f;
#pragma unroll
        for (int i = 0; i < 8; ++i) {
            const v4u w = *(const v4u*)(proj + ((size_t)b * SEQ + j * 64 + i * 8 + (lane >> 3)) * PW + C_FK + h * 64 + (lane & 7) * 8);
            const unsigned ww[4] = {w.x, w.y, w.z, w.w}; float ss = 0.f;
#pragma unroll
            for (int e = 0; e < 4; ++e) { const float a = __builtin_bit_cast(float, ww[e] << 16), c = __builtin_bit_cast(float, ww[e] & 0xffff0000u); ss += a * a + c * c; }
            ss += __shfl_xor(ss, 1); ss += __shfl_xor(ss, 2); ss += __shfl_xor(ss, 4);
            mx = fmaxf(mx, ss);
        }
        mx = wave_max(mx);
        if (lane == 0) kn[task] = sqrtf(mx) * 1.0001f;
    }
}
__device__ __forceinline__ void router_weights(const P& p, int gtid, int gstride) {
    for (int idx = gtid; idx < NLAYER * 32768; idx += gstride) {
        const int l = idx >> 15, r = idx & 32767, k = r >> 5, n = r & 31;
        float v = 0.f;
        if (n < 16) v = p.w_re[((size_t)l * DM + k) * 16 + n]; else if (n < 20) v = p.w_rg[((size_t)l * DM + k) * 4 + (n - 16)];
        v *= p.moe_norm[l * DM + k];
        float* wr = (float*)(ws_base(p.ws) + WS_W + (size_t)l * WS_WLAYER + WO_RHI);
        wr[((((k >> 5) * 4 + ((k >> 3) & 3)) * 2 + ((k >> 2) & 1)) * 32 + n) * 4 + (k & 3)] = v;
    }
}
__device__ __forceinline__ void route_phase(const P& p, int l, LAS unsigned char* lds, int vcu, int G) {
    int tid = threadIdx.x; asm volatile("" : "+v"(tid));
    const int lane = tid & 63, wave = __builtin_amdgcn_readfirstlane(tid >> 6);
    { const v4u* src = (const v4u*)(ws_base(p.ws) + WS_W + (size_t)l * WS_WLAYER + WO_RHI);
#pragma unroll 4
      for (int i = 0; i < 16; ++i) *(LAS v4u*)(lds + LDS_STAGE + (tid + NTHR * i) * 16) = src[tid + NTHR * i]; }
    LAS int* hist = (LAS int*)(lds + LDS_GATE);
    LAS int* tokj = hist + 32; LAS f32x2_t* tokgl = (LAS f32x2_t*)(hist + 160); LAS int* basej = hist + 416;
    const bf16* HBp = WSP(const bf16, WS_HB);
    int* gcnt = WSP(int, WS_MOE + MO_GCNT) + l * 32; int* rowtok2 = WSP(int, WS_RT2); f32x2_t* rowg2 = WSP(f32x2_t, WS_RG2);
    LAS float* lgb = (LAS float*)(lds + LDS_RS + wave * 2048);
    const int r = lane & 15, kq = lane >> 4;
    for (int task0 = vcu * NWAVES; task0 < NTOK / 16; task0 += G * NWAVES) {
        if (tid < 32) hist[tid] = 0;
        __syncthreads();
        const int tok0 = (task0 + wave) * 16;
        const v4u* hp = (const v4u*)(HBp + (size_t)(tok0 + r) * DM + 8 * kq);
        f32x4 acc0 = {0.f, 0.f, 0.f, 0.f}, acc1 = {0.f, 0.f, 0.f, 0.f}; float q = 0.f;
#pragma unroll 8
        for (int s = 0; s < 32; ++s) {
            const v4u aw = hp[4 * s];
            const unsigned ww[4] = {aw.x, aw.y, aw.z, aw.w};
            const LAS unsigned char* bp = lds + LDS_STAGE + ((s * 4 + kq) * 2 * 32 + r) * 16;
            const f32x4 b00 = *(const LAS f32x4*)(bp), b01 = *(const LAS f32x4*)(bp + 32 * 16), b10 = *(const LAS f32x4*)(bp + 16 * 16), b11 = *(const LAS f32x4*)(bp + 48 * 16);
#pragma unroll
            for (int e = 0; e < 4; ++e) {
                const float a0 = __builtin_bit_cast(float, ww[e] << 16), a1 = __builtin_bit_cast(float, ww[e] & 0xffff0000u);
                q += a0 * a0 + a1 * a1;
                const f32x4& bl = e < 2 ? b00 : b01; const f32x4& bh = e < 2 ? b10 : b11;
                acc0 = __builtin_amdgcn_mfma_f32_16x16x4f32(a0, bl[(2 * e) & 3], acc0, 0, 0, 0); acc1 = __builtin_amdgcn_mfma_f32_16x16x4f32(a0, bh[(2 * e) & 3], acc1, 0, 0, 0);
                acc0 = __builtin_amdgcn_mfma_f32_16x16x4f32(a1, bl[(2 * e + 1) & 3], acc0, 0, 0, 0); acc1 = __builtin_amdgcn_mfma_f32_16x16x4f32(a1, bh[(2 * e + 1) & 3], acc1, 0, 0, 0);
            }
        }
        q += __shfl_xor(q, 16); q += __shfl_xor(q, 32);
        const float rsv = rsqrtf(q * (1.0f / DM) + EPS);
        const float bias0 = p.b_re[l * 16 + r], bias1 = r < 4 ? p.b_rg[l * 4 + r] : 0.f;
#pragma unroll
        for (int g = 0; g < 4; ++g) { const int row = 4 * kq + g; const float rs = __shfl(rsv, row);
            lgb[row * 32 + r] = acc0[g] * rs + bias0; lgb[row * 32 + 16 + r] = acc1[g] * rs + bias1; }
        LDS_WAIT();
        if (lane < 16) {
            const int tok = tok0 + lane;
            const LAS f32x4* lr = (const LAS f32x4*)(lgb + lane * 32);
            const f32x4 e0 = lr[0], e1 = lr[1], e2 = lr[2], e3 = lr[3], gl = lr[4];
            int g = 0; float gm = gl.x;
            if (gl.y > gm) { gm = gl.y; g = 1; } if (gl.z > gm) { gm = gl.z; g = 2; } if (gl.w > gm) { gm = gl.w; g = 3; }
            const float den = (expf(gl.x - gm) + expf(gl.y - gm)) + (expf(gl.z - gm) + expf(gl.w - gm));
            const float pg = 1.0f / den;
            const f32x4 el = g == 0 ? e0 : (g == 1 ? e1 : (g == 2 ? e2 : e3));
            int i0 = 0; float m0 = el.x;
            if (el.y > m0) { m0 = el.y; i0 = 1; } if (el.z > m0) { m0 = el.z; i0 = 2; } if (el.w > m0) { m0 = el.w; i0 = 3; }
            int i1 = -1; float m1 = -INFINITY;
            if (i0 != 0 && el.x > m1) { m1 = el.x; i1 = 0; } if (i0 != 1 && el.y > m1) { m1 = el.y; i1 = 1; }
            if (i0 != 2 && el.z > m1) { m1 = el.z; i1 = 2; } if (i0 != 3 && el.w > m1) { m1 = el.w; i1 = 3; }
            const float ex = expf(m1 - m0), inv = 1.0f / (1.0f + ex);
            const int elo = i0 < i1 ? i0 : i1, ehi = i0 < i1 ? i1 : i0;
            const int j = g * 8 + (elo == 0 ? ehi - 1 : (elo == 1 ? ehi + 1 : 5));
            const float g0 = pg * inv, g1 = pg * ex * inv;
            tokj[wave * 16 + lane] = j; tokgl[wave * 16 + lane] = i0 < i1 ? (f32x2_t){g0, g1} : (f32x2_t){g1, g0};
            atomicAdd((int*)&hist[j], 1);
        }
        __syncthreads();
        if (tid < 32) { const int n = hist[tid]; basej[tid] = n > 0 ? atomicAdd(&gcnt[tid], n) : 0; }
        __syncthreads();
        if (wave == 0) {
            int run[32];
#pragma unroll
            for (int x = 0; x < 32; ++x) run[x] = 0;
#pragma unroll 1
            for (int half = 0; half < 2; ++half) {
                const int t = half * 64 + lane, j = tokj[t];
                int rank = 0;
#pragma unroll
                for (int x = 0; x < 32; ++x) { if ((x & 7) >= 6) continue; const unsigned long long mk = __ballot(j == x); if (j == x) rank = run[x] + __popcll(mk & ((1ull << lane) - 1ull)); run[x] += __popcll(mk); }
                const int pos = basej[j] + rank;
                rowtok2[(size_t)j * BCAP + pos] = task0 * 16 + t; rowg2[(size_t)j * BCAP + pos] = tokgl[t];
            }
        }
    }
}
__device__ __forceinline__ int moe_tables(const P& p, int l, LAS unsigned char* lds) {
    int tid = threadIdx.x; asm volatile("" : "+v"(tid));
    LAS int* mt = (LAS int*)(lds + LDS_MOET);
    const int* gcnt = WSP(const int, WS_MOE + MO_GCNT) + l * 32;
    if (tid < 32) mt[tid] = gcnt[tid];
    __syncthreads();
    if (tid == 0) { int t = 0; for (int j = 0; j < 32; ++j) { mt[32 + j] = t; t += (mt[j] + 255) >> 8; } mt[64] = t; }
    __syncthreads();
    if (tid < MAXTILES) { int j = 0;
        for (int x = 1; x < 32; ++x) if (mt[32 + x] <= tid) j = x;
        const int g = j >> 3, pi = j & 7, elo = pi < 3 ? 0 : (pi < 5 ? 1 : 2), ehi = pi < 3 ? pi + 1 : (pi < 5 ? pi - 1 : 3);
        mt[96 + tid] = j | ((g * 4 + elo) << 8) | ((g * 4 + ehi) << 16); }
    __syncthreads();
    return __builtin_amdgcn_readfirstlane(mt[64]);
}
__device__ __forceinline__ void final_phase(const P& p, int vcu, int G) {
    int tid = threadIdx.x; asm volatile("" : "+v"(tid));
    const int lane = tid & 63, wave = __builtin_amdgcn_readfirstlane(tid >> 6);
    const float* ssq = WSP(const float, WS_SSQ); const bf16* hb = WSP(const bf16, WS_HB);
    f32x4 g[4];
#pragma unroll
    for (int j = 0; j < 4; ++j) g[j] = ((const f32x4*)p.final_norm)[lane + 64 * j];
    for (int m0 = (vcu * NWAVES + wave) * 4; m0 < NTOK; m0 += G * NWAVES * 4) {
        v2u w[4][4]; float rs[4];
#pragma unroll
        for (int r = 0; r < 4; ++r) { rs[r] = row_rs(ssq, m0 + r);
#pragma unroll
            for (int j = 0; j < 4; ++j) w[r][j] = ((const v2u*)(hb + (size_t)(m0 + r) * DM))[lane + 64 * j]; }
#pragma unroll
        for (int r = 0; r < 4; ++r) { f32x4* s = (f32x4*)(p.out + (size_t)(m0 + r) * DM) + lane;
#pragma unroll
            for (int j = 0; j < 4; ++j) { f32x4 v; v.x = __builtin_bit_cast(float, w[r][j].x << 16); v.y = __builtin_bit_cast(float, w[r][j].x & 0xffff0000u); v.z = __builtin_bit_cast(float, w[r][j].y << 16); v.w = __builtin_bit_cast(float, w[r][j].y & 0xffff0000u);
                s[64 * j] = v * rs[r] * g[j]; } }
    }
}
#ifndef ENMASK
#define ENMASK 0xffffffffu
#endif
#define EN(b) (((ENMASK) >> (b)) & 1u)
#ifndef REPMASK
#define REPMASK 0u
#endif
#define REPN(b) ((((REPMASK) >> (b)) & 1u) ? 2 : 1)
__device__ __attribute__((noinline)) void grid_barrier(unsigned* barw, unsigned x, volatile LAS unsigned* st) { XcdBarrier b; b.bar = barw; b.x = x; b.st = st; xcd_barrier(b); }
__global__ void __launch_bounds__(NTHR, 2) fwd(Args args) {
    extern __shared__ __attribute__((aligned(16))) unsigned char lds_raw[];
    LAS unsigned char* lds = (LAS unsigned char*)lds_raw;
    const P& p = args.p;
    const int tid = threadIdx.x, lane = tid & 63, wave = __builtin_amdgcn_readfirstlane(tid >> 6);
    const int G = gridDim.x; const int bx = blockIdx.x; const int vcu = (G % 8 == 0) ? (bx % 8) * (G / 8) + bx / 8 : bx;
    volatile LAS unsigned* MISC = (volatile LAS unsigned*)(lds + LDS_MISC);
    if (tid < 64) MISC[tid] = 0u;
    __syncthreads();
    unsigned* ctl = (unsigned*)(p.ws + WS_CTL);
    const int lo = args.ph_lo, hi = args.ph_hi;
    XcdBarrier bar; bar.bar = ctl + CW_BAR + args.li * XCD_BAR_WORDS; bar.x = 0; bar.st = nullptr;
    if (hi - lo > 1) bar = xcd_barrier_post(ctl + CW_BAR + args.li * XCD_BAR_WORDS, MISC);
#define IN(k) (lo <= (k) && (k) < hi)
#define PHL int vcuL = vcu, GL = G, bxL = bx; asm volatile("" : "+s"(vcuL), "+s"(GL), "+s"(bxL)); (void)vcuL; (void)GL; (void)bxL;
#define LTID(v) int v = threadIdx.x; asm volatile("" : "+v"(v))
#define FILL_RS_DENSE() do { LTID(tq); const int rr_ = tq & 255, hf_ = tq >> 8; f32x4 sv_[4][4]; bool ok_[4]; \
        _Pragma("unroll") for (int k_ = 0; k_ < 4; ++k_) { pg8::Unit u_ = {0, 0, 0}; ok_[k_] = S.next(hf_ + 2 * k_, u_); const f32x4* sp_ = (const f32x4*)(SSQ + (size_t)(ok_[k_] ? u_.pm * 256 + rr_ : 0) * 16); \
            _Pragma("unroll") for (int j_ = 0; j_ < 4; ++j_) sv_[k_][j_] = sp_[j_]; } \
        _Pragma("unroll") for (int k_ = 0; k_ < 4; ++k_) if (ok_[k_]) { const f32x4 a_ = (sv_[k_][0] + sv_[k_][1]) + (sv_[k_][2] + sv_[k_][3]); rstab[(hf_ + 2 * k_) * 256 + rr_] = rsqrtf(((a_.x + a_.y) + (a_.z + a_.w)) * (1.0f / DM) + EPS); } } while (0)
#define MOE_ROW(k_) pg8::Unit u_ = {0, 0, 0}; ok_[k_] = S.next(hf_ + 2 * k_, u_); const int j_ = u_.e & 255, sl_ = (u_.pm - moet[32 + j_]) * 256 + rr_; const bool v_ = ok_[k_] && sl_ < moet[j_]; \
        const size_t ix_ = (size_t)j_ * BCAP + (v_ ? sl_ : 0);
#define FILL_GU() do { LTID(tq); const int rr_ = tq & 255, hf_ = tq >> 8; f32x4 sv_[4][4]; bool ok_[4]; int tk_[4]; float gt_[4]; \
        _Pragma("unroll") for (int k_ = 0; k_ < 4; ++k_) { MOE_ROW(k_) const int t_ = RT2[ix_]; const f32x2_t g2_ = RG2[ix_]; tk_[k_] = v_ ? t_ : -1; gt_[k_] = v_ ? (u_.pn < 4 ? g2_.x : g2_.y) : 0.f; } \
        _Pragma("unroll") for (int k_ = 0; k_ < 4; ++k_) { tk_[k_] = tk_[k_] < 0 ? 0 : tk_[k_]; const f32x4* sp_ = (const f32x4*)(SSQ + (size_t)tk_[k_] * 16); \
            _Pragma("unroll") for (int j_ = 0; j_ < 4; ++j_) sv_[k_][j_] = sp_[j_]; } \
        _Pragma("unroll") for (int k_ = 0; k_ < 4; ++k_) if (ok_[k_]) { const f32x4 a_ = (sv_[k_][0] + sv_[k_][1]) + (sv_[k_][2] + sv_[k_][3]); rowtab[(hf_ + 2 * k_) * 256 + rr_] = tk_[k_]; gatetab[(hf_ + 2 * k_) * 256 + rr_] = gt_[k_]; \
            rstab[(hf_ + 2 * k_) * 256 + rr_] = rsqrtf(((a_.x + a_.y) + (a_.z + a_.w)) * (1.0f / DM) + EPS); } } while (0)
#define FILL_DOWN() do { LTID(tq); const int rr_ = tq & 255, hf_ = tq >> 8; bool ok_[4]; int tk_[4]; \
        _Pragma("unroll") for (int k_ = 0; k_ < 4; ++k_) { MOE_ROW(k_) const int t_ = RT2[ix_]; tk_[k_] = v_ ? t_ : -1; } \
        _Pragma("unroll") for (int k_ = 0; k_ < 4; ++k_) if (ok_[k_]) { rowtab[(hf_ + 2 * k_) * 256 + rr_] = tk_[k_]; } } while (0)

#define SEAM(k) do { if (IN(k) && IN((k) + 1)) { grid_barrier(bar.bar, bar.x, bar.st); if (REPN(20) == 2) grid_barrier(bar.bar, bar.x, bar.st); } } while (0)
    LAS float* rstab = (LAS float*)(lds + LDS_RS); LAS int* rowtab = (LAS int*)(lds + LDS_ROWTOK); LAS float* gatetab = (LAS float*)(lds + LDS_GATE); const LAS int* moet = (const LAS int*)(lds + LDS_MOET);
#define HB WSP(bf16, WS_HB)
#define PROJ WSP(bf16, WS_PROJ)
#define Y WSP(bf16, WS_Y)
#define XKV WSP(bf16, WS_XKV)
#define MEMN WSP(bf16, WS_MEMN)
#define SSQ WSP(float, WS_SSQ)
#define XQ WSP(bf16, WS_XQ)
#define U WSP(bf16, WS_U)
#define RT2 WSP(const int, WS_RT2)
#define RG2 WSP(const f32x2_t, WS_RG2)
#define H (p.out)
#define HB8 ((unsigned char*)p.out + 64 * MiB)
#define U8 WSP(unsigned char, WS_U)

    if (EN(0) && IN(PH_PRO)) _Pragma("unroll 1") for (int rep_ = 0; rep_ < REPN(0); ++rep_) { PHL prologue(p, lds, vcuL, GL, wave, lane); }
    SEAM(PH_PRO);
    if (REPN(18) == 2 && IN(PH_XKV)) { PHL
        pg8::StaticOrder S; S.init(HB, ws_base(p.ws) + WS_W + WO_IN, NTOK, 3072, DM, GL, bxL);
        FILL_RS_DENSE();
        __syncthreads();
        EpiBf16<true> E{PROJ, PW, rstab};
        pg8::gemm_phase<DM, EpiBf16<true>, pg8::StaticOrder, true>(lds + LDS_STAGE, S, E);
    }
    for (int l = 0; l < NLAYER; ++l) {
        const int pb = PH_L0 + l * NPH;
        unsigned char* wl = ws_base(p.ws) + WS_W + (size_t)l * WS_WLAYER;
        if (EN(2) && IN(pb + LP_INPROJ)) _Pragma("unroll 1") for (int rep_ = 0; rep_ < REPN(2); ++rep_) { PHL
            pg8::StaticOrder S; S.init(HB, wl + WO_IN, NTOK, 3072, DM, GL, bxL);
            FILL_RS_DENSE();
            __syncthreads();
            EpiBf16<true> E{PROJ, PW, rstab};
            pg8::gemm_phase<DM, EpiBf16<true>, pg8::StaticOrder, true>(lds + LDS_STAGE, S, E);
            _Pragma("unroll 1") for (int r2_ = 0; r2_ < REPN(19); ++r2_) small_proj(p, l, lds + LDS_STAGE, vcuL, GL, wave, lane);
        }
        SEAM(pb + LP_INPROJ);
        if (EN(11) && IN(pb + LP_MIXA)) _Pragma("unroll 1") for (int rep_ = 0; rep_ < REPN(11); ++rep_) { PHL gla_phase_a(p, l, lds + LDS_STAGE, vcuL, GL); fox_cumsum_phase(p, l, lds + LDS_STAGE, vcuL, GL); fox_knorm_phase(p, vcuL, GL); }
        SEAM(pb + LP_MIXA);
        if (EN(12) && IN(pb + LP_MIXB)) _Pragma("unroll 1") for (int rep_ = 0; rep_ < REPN(12); ++rep_) { PHL gla_phase_b(p, vcuL, GL); }
        if (EN(1) && l == 0 && IN(pb + LP_MIXB)) { PHL
            pg8::StaticOrder S; S.init(MEMN, ws_base(p.ws) + WS_WXKV, 4096, 2048, DM, GL, bxL);
            EpiBf16<false> E{XKV, 2048, rstab};
            pg8::gemm_phase<DM, EpiBf16<false>, pg8::StaticOrder, true>(lds + LDS_STAGE, S, E);
        }
        SEAM(pb + LP_MIXB);
        if (EN(9) && IN(pb + LP_MIXC)) { PHL _Pragma("unroll 1") for (int rep_ = 0; rep_ < REPN(16); ++rep_) fox_phase(p, l, lds + LDS_STAGE, vcuL, GL); _Pragma("unroll 1") for (int rep_ = 0; rep_ < REPN(17); ++rep_) gla_phase_c(p, l, lds + LDS_STAGE, vcuL, GL); }
        SEAM(pb + LP_MIXC);
        if (EN(3) && IN(pb + LP_WOUT)) _Pragma("unroll 1") for (int rep_ = 0; rep_ < REPN(3); ++rep_) { PHL
            pg8::StaticOrder S; S.init(Y, wl + WO_OUT, NTOK, DM, DM, GL, bxL);
            EpiRes<0> E{HB, SSQ, rowtab, rep_ == REPN(3) - 1 ? 1.f : 0.f, nullptr};
            pg8::gemm_phase<DM, EpiRes<0>, pg8::StaticOrder, true>(lds + LDS_STAGE, S, E);
        }
        SEAM(pb + LP_WOUT);
        if (EN(4) && IN(pb + LP_XQ)) _Pragma("unroll 1") for (int rep_ = 0; rep_ < REPN(4); ++rep_) { PHL
            pg8::StaticOrder S; S.init(HB, wl + WO_XQ, NTOK, 512, DM, GL, bxL);
            FILL_RS_DENSE();
            __syncthreads();
            EpiBf16<true> E{XQ, 512, rstab};
            pg8::gemm_phase<DM, EpiBf16<true>, pg8::StaticOrder, true>(lds + LDS_STAGE, S, E);
            asm volatile("s_waitcnt vmcnt(0)" ::: "memory"); __syncthreads();
            { pg8::Unit u; for (int iu = 0; S.next(iu, u); ++iu) { xattn_pair(p, l, lds + LDS_STAGE, u.pm, u.pn, rep_ != REPN(4) - 1); } }
        }
        SEAM(pb + LP_XQ);
        if (EN(5) && IN(pb + LP_XO)) _Pragma("unroll 1") for (int rep_ = 0; rep_ < REPN(5); ++rep_) { PHL
            pg8::StaticOrder S; S.init(WSP(unsigned char, WS_XO8), wl + WO_XO, NTOK, DM, 256, GL, bxL);
            EpiRes<0, true> E{HB, SSQ, rowtab, rep_ == REPN(5) - 1 ? 1.f : 0.f, HB8};
            pg8::gemm_phase<256, EpiRes<0, true>, pg8::StaticOrder, true, true, 127, 122>(lds + LDS_STAGE, S, E);
        }
        SEAM(pb + LP_XO);
        if (EN(13) && IN(pb + LP_ROUTE)) _Pragma("unroll 1") for (int rep_ = 0; rep_ < REPN(13); ++rep_) { PHL route_phase(p, l, lds, vcuL, GL); }
        SEAM(pb + LP_ROUTE);
        if (EN(6) && IN(pb + LP_GU)) { PHL
            const int T_ = moe_tables(p, l, lds);
            _Pragma("unroll 1") for (int rep_ = 0; rep_ < REPN(6); ++rep_) {
            MoeOrder<0> S{(const char*)HB8, (const char*)(wl + WO_GU), 512, (size_t)1024 * 1024, T_, GL, vcuL, moet + 96, rowtab};
            __syncthreads();
            FILL_GU();
            __syncthreads();
            EpiGU E{U8, rstab, gatetab};
            pg8::gemm_phase<512, EpiGU, MoeOrder<0>, true, true, 127, 122>(lds + LDS_STAGE, S, E);
            }
        }
        SEAM(pb + LP_GU);
        if (EN(8) && IN(pb + LP_DOWN1)) { PHL
            const int T_ = IN(pb + LP_GU) ? __builtin_amdgcn_readfirstlane(moet[64]) : moe_tables(p, l, lds);
            MoeOrder<1> S{(const char*)U8, (const char*)(wl + WO_D), 512, (size_t)1024 * 512, T_, GL, vcuL, moet + 96, rowtab};
            __syncthreads();
            FILL_DOWN();
            __syncthreads();
            EpiRes<2> E{HB, SSQ, rowtab, 1.f, nullptr};
            pg8::gemm_phase<512, EpiRes<2>, MoeOrder<1>, true, true, 125, 122, 256, true>(lds + LDS_STAGE, S, E);
        }
        SEAM(pb + LP_DOWN1);
    }
    if (EN(15) && IN(PH_FINAL)) _Pragma("unroll 1") for (int rep_ = 0; rep_ < REPN(15); ++rep_) { PHL final_phase(p, vcuL, GL); }
#undef IN
#undef SEAM
#undef HB
#undef PROJ
#undef Y
#undef XKV
#undef MEMN
#undef SSQ
#undef XQ
#undef U
#undef RT2
#undef RG2
#undef H
#undef HB8
#undef U8
}

static int g_grid = 0;
static void launch_fast(const P& p, int lo, int hi, int& li, hipStream_t stream) {
    Args a{}; a.p = p; a.ph_lo = lo; a.ph_hi = hi; a.li = li++; a.pad = 0;
    hipLaunchKernelGGL(fwd, dim3(g_grid), dim3(NTHR), LDS_BYTES, stream, a);
    const hipError_t le = hipPeekAtLastError();
    if (le != hipSuccess) fprintf(stderr, "kernel_launch: fwd launch [%d,%d) failed: %s\n", lo, hi, hipGetErrorName(le));
}
extern "C" void kernel_launch(void* const* d_in, const int* in_sizes, int n_in, void* d_out, int out_size, void* d_ws, size_t ws_size, hipStream_t stream) {
    if (n_in != 25 || out_size != NTOK * DM || ws_size < WS_END2) { fprintf(stderr, "kernel_launch: unexpected sizes n_in %d out %d ws %zu (need %zu)\n", n_in, out_size, ws_size, (size_t)WS_END2); return; }
    if (g_grid == 0) {
        int dev = 0, cus = 0, per_cu = 0;
        if (hipGetDevice(&dev) != hipSuccess || hipDeviceGetAttribute(&cus, hipDeviceAttributeMultiprocessorCount, dev) != hipSuccess) { g_grid = -1; return; }
        if (hipFuncSetAttribute((const void*)fwd, hipFuncAttributeMaxDynamicSharedMemorySize, LDS_BYTES) != hipSuccess) { fprintf(stderr, "kernel_launch: hipFuncSetAttribute failed\n"); g_grid = -1; return; }
        if (hipOccupancyMaxActiveBlocksPerMultiprocessor(&per_cu, (const void*)fwd, NTHR, LDS_BYTES) != hipSuccess || per_cu < 1) { fprintf(stderr, "kernel_launch: occupancy query says %d\n", per_cu); }
        (void)hipGetLastError();
        g_grid = cus;
    }
    if (g_grid < 0) return;
    P p{};
    const float** pp = (const float**)&p;
    for (int i = 0; i < 25; ++i) pp[i] = (const float*)d_in[i];
    p.out = (float*)d_out; p.ws = (unsigned char*)d_ws;
    if (hipMemsetAsync((char*)d_ws + WS_CTL + (size_t)CW_BAR * 4, 0, (size_t)XCD_BAR_WORDS * 4, stream) != hipSuccess) { fprintf(stderr, "kernel_launch: hipMemsetAsync failed\n"); return; }
    int li = 0;
    launch_fast(p, PH_PRO, PH_END, li, stream);
}
```

```cpp
#include <hip/hip_runtime.h>
#include <cstdio>
#include <cstdint>

constexpr int NTOK = 32768, DM = 1024, NBATCH = 16, SEQ = 2048, NLAYER = 2, MEML = 256;
constexpr int PW = 3072;
constexpr int C_FQ = 0, C_FK = 512, C_FV = 1024, C_GQ = 1536, C_GK = 1792, C_GV = 2048, C_GG = 2560;
constexpr int INW = 3096;
constexpr float EPS = 1e-6f, LOG2E = 1.4426950408889634f;
constexpr int MAXTILES = 288;
constexpr int MAXROWS = MAXTILES * 256;

typedef unsigned short bf16;
__device__ __forceinline__ unsigned f2bf(float f) { unsigned u = __builtin_bit_cast(unsigned, f); return (u + 0x7fffu + ((u >> 16) & 1u)) >> 16; }
__device__ __forceinline__ float bf2f(bf16 b) { return __builtin_bit_cast(float, ((unsigned)b) << 16); }

constexpr size_t MiB = 1u << 20;
constexpr size_t WS_CTL = 0;
constexpr size_t WS_W = 1 * MiB;
constexpr size_t WS_WLAYER = 59 * MiB;
constexpr size_t WS_WXKV = WS_W + 2 * WS_WLAYER;
constexpr size_t WS_HB = WS_WXKV + 4 * MiB;
constexpr size_t WS_PROJ = WS_HB + 64 * MiB;
constexpr size_t WS_XQ = WS_PROJ;
constexpr size_t WS_U = WS_PROJ + 32 * MiB;
constexpr size_t WS_XO8 = WS_U + 40 * MiB;
constexpr size_t WS_SM = WS_PROJ + 192 * MiB;
constexpr size_t WS_CB = WS_SM + 4 * MiB;
constexpr size_t WS_Y = WS_CB + 1 * MiB;
constexpr size_t WS_XKV = WS_Y + 64 * MiB;
constexpr size_t WS_MEMN = WS_XKV + 16 * MiB;
constexpr size_t WS_SSQ = WS_MEMN + 8 * MiB;
constexpr size_t WS_MOE = WS_SSQ + 2 * MiB;
constexpr size_t WS_END = WS_MOE + 2 * MiB;
static_assert(WS_END <= 512 * MiB, "workspace map");
constexpr size_t MO_TOKE = 0;
constexpr size_t MO_TOKG = 256 * 1024;
constexpr size_t MO_ROWTOK = 512 * 1024;
constexpr size_t MO_ROWGATE = 832 * 1024;
constexpr size_t MO_TILEE = 1152 * 1024;
constexpr size_t MO_NT = 1156 * 1024;
constexpr size_t MO_HIST = 1160 * 1024;
constexpr size_t MO_GCNT = 1160 * 1024;
constexpr int BCAP = 32768;
constexpr size_t MO_KN = 1280 * 1024;

struct P {
    const float *x, *mem, *mem_norm, *mix_norm, *w_in, *b_forget, *w_alpha_up, *b_alpha, *fox_gain, *gla_gain, *w_out, *cross_norm, *w_xq, *w_xk, *w_xv, *w_xo,
        *moe_norm, *w_rg, *b_rg, *w_re, *b_re, *w_eg, *w_eu, *w_ed, *final_norm;
    float* out; unsigned char* ws;
};
__host__ __device__ __forceinline__ unsigned char* ws_base(unsigned char* w) {
#if defined(__HIP_DEVICE_COMPILE__)
    size_t z = 0; asm volatile("" : "+s"(z));
    return w + z;
#else
    return w;
#endif
}
#define WSP(T, off) ((T*)(ws_base(p.ws) + (off)))

__device__ __forceinline__ float wave_sum(float v) {
#pragma unroll
    for (int o = 1; o < 64; o <<= 1) v += __shfl_xor(v, o);
    return v;
}
__device__ __forceinline__ float wave_min(float v) {
#pragma unroll
    for (int o = 1; o < 64; o <<= 1) v = fminf(v, __shfl_xor(v, o));
    return v;
}
__device__ __forceinline__ float wave_max(float v) {
#pragma unroll
    for (int o = 1; o < 64; o <<= 1) v = fmaxf(v, __shfl_xor(v, o));
    return v;
}
__device__ __forceinline__ float row_rs(const float* ssq, int row) {
    const float4* s = (const float4*)(ssq + (size_t)row * 16);
    float4 a = s[0], b = s[1], c = s[2], d = s[3];
    float t = ((a.x + a.y) + (a.z + a.w)) + ((b.x + b.y) + (b.z + b.w)) + ((c.x + c.y) + (c.z + c.w)) + ((d.x + d.y) + (d.z + d.w));
    return rsqrtf(t * (1.0f / DM) + EPS);
}
__device__ __forceinline__ float log_sigmoid(float z) { return fminf(z, 0.f) - log1pf(expf(-fabsf(z))); }
__device__ __forceinline__ float silu(float z) { return z / (1.f + expf(-z)); }

typedef unsigned st_v4u __attribute__((ext_vector_type(4)));
typedef unsigned st_v2u __attribute__((ext_vector_type(2)));
#ifndef WT_STORES
#define WT_STORES 0
#endif
__device__ __forceinline__ void st_b128(void* p, st_v4u v) {
#if WT_STORES
    asm volatile("global_store_dwordx4 %0, %1, off sc1\n\ts_nop 1" :: "v"(p), "v"(v) : "memory");
#else
    *(st_v4u*)p = v;
#endif
}
__device__ __forceinline__ void st_b128_wt(void* p, st_v4u v) { asm volatile("global_store_dwordx4 %0, %1, off sc1\n\ts_nop 1" :: "v"(p), "v"(v) : "memory"); }
__device__ __forceinline__ void st_b64(void* p, st_v2u v) {
#if WT_STORES
    asm volatile("global_store_dwordx2 %0, %1, off sc1" :: "v"(p), "v"(v) : "memory");
#else
    *(st_v2u*)p = v;
#endif
}
#define XB_TMO      128
#define XB_XCNT(j)  (256  + 64 * (j))
#define XB_XSUB(j)  (1280 + 64 * (j))
#define XB_XGEN(j)  (2304 + 64 * (j))
#define XB_TOP      3328
#define XB_TOPGEN   3392
#define XCD_BAR_WORDS 3456
#define XB_SPIN_CAP (1u << 18)
#define LAS __attribute__((address_space(3)))

__device__ __forceinline__ unsigned xb_ld(unsigned* p)              { return __hip_atomic_load(p, __ATOMIC_RELAXED, __HIP_MEMORY_SCOPE_AGENT); }
__device__ __forceinline__ unsigned xb_add(unsigned* p, unsigned v) { return __hip_atomic_fetch_add(p, v, __ATOMIC_RELAXED, __HIP_MEMORY_SCOPE_AGENT); }
__device__ __forceinline__ unsigned xb_xcc_id() { return (unsigned)__builtin_amdgcn_s_getreg((3 << 11) | 20) & 0xFu; }
#define XB_SPIN(cond, bar) do { unsigned _sp = 0; while (cond) { __builtin_amdgcn_s_sleep(1); \
    if ((++_sp & 255u) == 0u) { if (xb_ld(&(bar)[XB_TMO])) break; if (_sp > XB_SPIN_CAP) { atomicAdd(&(bar)[XB_TMO], 1u); break; } } } } while (0)

struct XcdBarrier {
    unsigned* bar; unsigned x;
    volatile LAS unsigned* st;
};

__device__ __forceinline__ XcdBarrier xcd_barrier_post(unsigned* bar, volatile LAS unsigned* st) {
    XcdBarrier b; b.bar = bar; b.x = xb_xcc_id(); b.st = st;
    if (threadIdx.x == 0) (void)xb_add(&bar[XB_XCNT(b.x)], 1u);
    return b;
}
__device__ __forceinline__ void xcd_barrier_complete(unsigned* bar, unsigned x, unsigned& nloc, unsigned& nx) {
    const unsigned G = gridDim.x * gridDim.y * gridDim.z;
    unsigned sum, cnt, mine, sp = 0u;
    for (;;) {
        sum = 0u; cnt = 0u; mine = 0u;
#pragma unroll
        for (unsigned j = 0; j < 16; ++j) { const unsigned c = xb_ld(&bar[XB_XCNT(j)]); sum += c; cnt += (c > 0u) ? 1u : 0u; mine = (j == x) ? c : mine; }
        if (sum == G) break;
        __builtin_amdgcn_s_sleep(1);
        if ((++sp & 255u) == 0u) { if (xb_ld(&bar[XB_TMO])) break; if (sp > XB_SPIN_CAP) { atomicAdd(&bar[XB_TMO], 1u); break; } }
    }
    nloc = mine > 0u ? mine : 1u; nx = cnt > 0u ? cnt : 1u;
}

__device__ __forceinline__ void xcd_barrier(const XcdBarrier& b) {
    asm volatile("s_waitcnt vmcnt(0)" ::: "memory");
    __syncthreads();
    if (threadIdx.x == 0) {
        unsigned* bar = b.bar;
        __builtin_amdgcn_s_waitcnt(0);
        unsigned nloc = b.st[0], nx = b.st[1];
        if (nloc == 0u) { xcd_barrier_complete(bar, b.x, nloc, nx); b.st[0] = nloc; b.st[1] = nx; }
        const unsigned old = xb_add(&bar[XB_XSUB(b.x)], 1u);
        const unsigned gen = old / nloc;
        if (old + 1u == (gen + 1u) * nloc) {
            __builtin_amdgcn_fence(__ATOMIC_RELEASE, "agent");
            asm volatile("s_waitcnt vmcnt(0)" ::: "memory");
            const unsigned og = xb_add(&bar[XB_TOP], 1u);
            const unsigned tg = og / nx;
            if (og + 1u == (tg + 1u) * nx) xb_add(&bar[XB_TOPGEN], 1u);
            else XB_SPIN(xb_ld(&bar[XB_TOPGEN]) == tg, bar);
            __builtin_amdgcn_fence(__ATOMIC_ACQUIRE, "agent");
            xb_add(&bar[XB_XGEN(b.x)], 1u);
            asm volatile("s_waitcnt vmcnt(0)" ::: "memory");
        } else {
            XB_SPIN(xb_ld(&bar[XB_XGEN(b.x)]) == gen, bar);
            __builtin_amdgcn_fence(__ATOMIC_ACQUIRE, "agent");
            asm volatile("s_waitcnt vmcnt(0)" ::: "memory");
        }
    }
    __syncthreads();
}

namespace pg8 {
#define PG8_LAS __attribute__((address_space(3)))
typedef unsigned short bf16_t;
typedef short bf16x8 __attribute__((ext_vector_type(8)));
typedef float f32x4 __attribute__((ext_vector_type(4)));
typedef unsigned u32x4 __attribute__((ext_vector_type(4)));
typedef unsigned u32x2 __attribute__((ext_vector_type(2)));
constexpr int BM = 256, BK = 64, HALF = 128, HTB = HALF * BK * 2, STAGE_BYTES = 8 * HTB, NXCD = 8, WGM = 8;

__host__ __device__ __forceinline__ int lds_byte(int r, int c) { const int st = (r >> 4) * 2 + (c >> 5), rr = r & 15, cc = c & 31, ob = rr * 64 + cc * 2; return st * 1024 + (ob ^ (((ob >> 9) & 1) << 5)); }
__host__ __device__ __forceinline__ void stage_rc(int b, int& R, int& C) { const int st = b / 1024, sb = b % 1024, swz = sb ^ (((sb >> 9) & 1) << 5); R = (st >> 1) * 16 + swz / 64; C = (st & 1) * 32 + (swz % 64) / 2; }
__host__ __device__ __forceinline__ int perm32(int rho) { const int n = rho >> 4, i = rho & 15; return 8 * (i >> 2) + 4 * n + (i & 3); }

struct Unit { int pm, pn, e; };

struct StaticOrder {
    static constexpr bool GATHER = false;
    static constexpr size_t KSTEP_A = 128;
    const char* A; const char* Bt; int K; int nM, nN, nwg, G, c;
    __device__ void init(const void* A_, const void* Bt_, int M, int N, int K_, int G_, int c_) { A = (const char*)A_; Bt = (const char*)Bt_; K = K_; nM = M / BM; nN = N / BM; nwg = nM * nN; G = G_; c = c_; }
    __device__ bool next(int i, Unit& u) const {
        const long L = (long)i * G + c; if (L >= nwg) return false;
        int wgid = (int)L; { const int q = nwg / NXCD, r = nwg % NXCD, xcd = wgid % NXCD, off = wgid / NXCD; wgid = (xcd < r ? xcd * (q + 1) : r * (q + 1) + (xcd - r) * q) + off; }
        const int nig = WGM * nN, gid = wgid / nig, fm = gid * WGM, gsz = (nM - fm) < WGM ? (nM - fm) : WGM;
        u.pm = fm + ((wgid % nig) % gsz); u.pn = (wgid % nig) / gsz; u.e = 0; return true;
    }
    __device__ __forceinline__ const char* a_base(const Unit& u) const { return A + (size_t)u.pm * (size_t)(BM * 2) * K; }
    __device__ __forceinline__ const char* b_base(const Unit& u) const { return Bt + (size_t)u.pn * (size_t)(BM * 2) * K; }
    __device__ __forceinline__ unsigned a_off(int, int, int, int) const { return 0u; }
};

struct PairOrder {
    static constexpr bool GATHER = false;
    static constexpr size_t KSTEP_A = 128;
    const char* A; const char* Bt; int K; int pm, pn0, n;
    __device__ bool next(int i, Unit& u) const { if (i >= n) return false; u.pm = pm; u.pn = pn0 + i; u.e = 0; return true; }
    __device__ __forceinline__ const char* a_base(const Unit& u) const { return A + (size_t)u.pm * (size_t)(BM * 2) * K; }
    __device__ __forceinline__ const char* b_base(const Unit& u) const { return Bt + (size_t)u.pn * (size_t)(BM * 2) * K; }
    __device__ __forceinline__ unsigned a_off(int, int, int, int) const { return 0u; }
};

__device__ __forceinline__ unsigned cvt_pk_bf16(float lo, float hi) { unsigned r; asm volatile("v_cvt_pk_bf16_f32 %0, %1, %2" : "=v"(r) : "v"(lo), "v"(hi)); return r; }

typedef int i32x8 __attribute__((ext_vector_type(8)));
typedef int i32x4 __attribute__((ext_vector_type(4)));
template <int K, class Epi, class Sched, bool ALIGN_EPI, bool FP8 = false, int SA = 127, int SB = 127, int KB = K, bool BSPLIT = false>
__device__ __forceinline__ void gemm_phase(PG8_LAS unsigned char* lds, const Sched& S, const Epi& E) {
    int tid_ = threadIdx.x; asm volatile("" : "+v"(tid_));
    const int tid = tid_, wid = __builtin_amdgcn_readfirstlane(tid >> 6), lane = tid & 63, wr = wid >> 2, wc = wid & 3, fr = lane & 15, fq = lane >> 4;
    constexpr int nt = K / BK;
    constexpr int NH = Sched::GATHER ? 2 : 1;
    unsigned voffB[2], cvA[NH][2], nvA[NH][2];
#pragma unroll
    for (int i = 0; i < 2; ++i) { int R, C; stage_rc(tid * 16 + i * 8192, R, C); const int Rb = Epi::PERM ? ((R & ~31) + perm32(R & 31)) : R;
        voffB[i] = (unsigned)(Rb * KB + C) * 2u;
        cvA[0][i] = nvA[0][i] = (unsigned)(R * K + C) * 2u; if constexpr (NH == 2) { cvA[NH - 1][i] = nvA[NH - 1][i] = cvA[0][i]; } }
    constexpr size_t kstep = (size_t)(BK * 2);
    constexpr size_t hstep = (size_t)HALF * K * 2;
    constexpr size_t hstepA = Sched::GATHER ? (size_t)0 : hstep;
    constexpr size_t hstepB = (size_t)HALF * KB * 2;
    constexpr size_t kstepA = Sched::KSTEP_A;
    const unsigned ldsw = (unsigned)wid * 1024u;
    const int aoff = lds_byte(wr * 64 + fr, fq * 8), boff = lds_byte(wc * 32 + fr, fq * 8);
#define PG8_SA(b, h) (((b) * 2 + (h)) * HTB)
#define PG8_SB(b, h) ((4 + (b) * 2 + (h)) * HTB)
#define PG8_STAGE(bufoff, gbase, voff) do { _Pragma("unroll") for (int _i = 0; _i < 2; ++_i) \
        __builtin_amdgcn_global_load_lds((const unsigned*)((const char*)(gbase) + (voff)[_i]), (PG8_LAS unsigned*)(lds + (bufoff) + ldsw + _i * 8192), 16, 0, 0); } while (0)
#define PG8_LD32(addr) __builtin_shufflevector(*(const PG8_LAS i32x4*)(addr), *(const PG8_LAS i32x4*)((addr) + 1024), 0, 1, 2, 3, 4, 5, 6, 7)
#define PG8_LDA(dst, b, h) do { _Pragma("unroll") for (int m = 0; m < 4; ++m) dst[m] = PG8_LD32(lds + PG8_SA(b, h) + aoff + m * 2048); } while (0)
#define PG8_LDB(dst, b, h) do { _Pragma("unroll") for (int n = 0; n < 2; ++n) dst[n] = PG8_LD32(lds + PG8_SB(b, h) + boff + n * 2048); } while (0)
#define PG8_H0(x) __builtin_bit_cast(bf16x8, __builtin_shufflevector((x), (x), 0, 1, 2, 3))
#define PG8_H1(x) __builtin_bit_cast(bf16x8, __builtin_shufflevector((x), (x), 4, 5, 6, 7))
#define PG8_MMA(ai, bj, At, Bt) do { __builtin_amdgcn_s_setprio(1); _Pragma("unroll") for (int m = 0; m < 4; ++m) _Pragma("unroll") for (int n = 0; n < 2; ++n) { \
        if constexpr (FP8) asm volatile("v_mfma_scale_f32_16x16x128_f8f6f4 %0, %1, %2, %0, %3, %4 op_sel_hi:[0,0,0]" : "+v"(acc[ai][bj][m][n]) : "v"(Bt[n]), "v"(At[m]), "v"(sbv), "v"(sav)); \
        else { acc[ai][bj][m][n] = __builtin_amdgcn_mfma_f32_16x16x32_bf16(PG8_H0(Bt[n]), PG8_H0(At[m]), acc[ai][bj][m][n], 0, 0, 0); \
               acc[ai][bj][m][n] = __builtin_amdgcn_mfma_f32_16x16x32_bf16(PG8_H1(Bt[n]), PG8_H1(At[m]), acc[ai][bj][m][n], 0, 0, 0); } } \
        __builtin_amdgcn_s_setprio(0); } while (0)
#define PG8_WAIT_V(n) asm volatile("s_waitcnt vmcnt(" #n ")" ::: "memory")
#define PG8_WAIT_L(n) asm volatile("s_waitcnt lgkmcnt(" #n ")" ::: "memory")
#define PG8_BAR __builtin_amdgcn_s_barrier()
#define PG8_SCHED __builtin_amdgcn_sched_barrier(0)
    int sav = SA, sbv = SB; asm volatile("" : "+v"(sav), "+v"(sbv));
    Unit cur, nxt; int ui = 0;
    if (!S.next(0, cur)) return;
    f32x4 acc[2][2][4][2];
#pragma unroll
    for (int a = 0; a < 2; ++a)
#pragma unroll
        for (int b = 0; b < 2; ++b)
#pragma unroll
            for (int m = 0; m < 4; ++m)
#pragma unroll
                for (int n = 0; n < 2; ++n) acc[a][b][m][n] = (f32x4){0.f, 0.f, 0.f, 0.f};
    i32x8 At[4], B0[2], B1[2];
    const char* cA = S.a_base(cur); const char* cB = S.b_base(cur);
    if constexpr (Sched::GATHER) {
        int R0, C0, R1, C1; stage_rc(tid * 16, R0, C0); stage_rc(tid * 16 + 8192, R1, C1);
#pragma unroll
        for (int h = 0; h < 2; ++h) { cvA[h][0] = S.a_off(0, h, R0, C0 * 2); cvA[h][1] = S.a_off(0, h, R1, C1 * 2); }
    }
    PG8_STAGE(PG8_SB(0, 0), cB, voffB); PG8_STAGE(PG8_SB(0, 1), cB + hstepB, voffB); PG8_STAGE(PG8_SA(0, 0), cA, cvA[0]); PG8_STAGE(PG8_SA(0, 1), cA + hstepA, cvA[NH - 1]);
    if (wr == 1) PG8_BAR;
    PG8_WAIT_V(2); PG8_BAR;
    PG8_STAGE(PG8_SB(1, 0), cB + kstep, voffB); PG8_STAGE(PG8_SA(1, 0), cA + kstepA, cvA[0]); PG8_STAGE(PG8_SB(1, 1), cB + hstepB + kstep, voffB);
    PG8_WAIT_V(6); PG8_BAR;
    for (;;) {
        const bool has_next = S.next(ui + 1, nxt);
        const char* nA = has_next ? S.a_base(nxt) : cA; const char* nB = has_next ? S.b_base(nxt) : cB;
        if constexpr (Sched::GATHER) {
            if (has_next) {
                int t2 = threadIdx.x; asm volatile("" : "+v"(t2));
                int R0, C0, R1, C1; stage_rc(t2 * 16, R0, C0); stage_rc(t2 * 16 + 8192, R1, C1);
#pragma unroll
                for (int h = 0; h < 2; ++h) { nvA[h][0] = S.a_off(ui + 1, h, R0, C0 * 2); nvA[h][1] = S.a_off(ui + 1, h, R1, C1 * 2); }
            } else {
#pragma unroll
                for (int h = 0; h < 2; ++h) { nvA[h][0] = cvA[h][0]; nvA[h][1] = cvA[h][1]; }
            }
        }
#pragma unroll 1
        for (int t = 0; t < nt; t += 2) {
            const bool last = (t == nt - 2);
            const char* a1 = cA + (size_t)(t + 1) * kstepA;
            const char* a2 = last ? nA : cA + (size_t)(t + 2) * kstepA; const char* b2 = last ? nB : cB + (size_t)(t + 2) * kstep;
            if constexpr (BSPLIT) { if (!last && t + 2 >= nt / 2) b2 += S.b_delta(cur); }
            const char* a3 = a2 + kstepA; const char* b3 = b2 + kstep;
            unsigned v2[NH][2];
#pragma unroll
            for (int h = 0; h < NH; ++h) { if constexpr (Sched::GATHER) { v2[h][0] = last ? nvA[h][0] : cvA[h][0]; v2[h][1] = last ? nvA[h][1] : cvA[h][1]; } else { v2[h][0] = cvA[h][0]; v2[h][1] = cvA[h][1]; } }
            PG8_LDB(B0, 0, 0); PG8_LDB(B1, 0, 1); PG8_SCHED; PG8_LDA(At, 0, 0); PG8_STAGE(PG8_SA(1, 1), a1 + hstepA, cvA[NH - 1]);
            PG8_WAIT_V(8); PG8_WAIT_L(0); PG8_BAR; PG8_MMA(0, 0, At, B0); PG8_MMA(0, 1, At, B1); PG8_BAR; PG8_SCHED;
            PG8_LDA(At, 0, 1); PG8_STAGE(PG8_SB(0, 0), b2, voffB); PG8_STAGE(PG8_SB(0, 1), b2 + hstepB, voffB); PG8_STAGE(PG8_SA(0, 0), a2, v2[0]);
            PG8_WAIT_V(8); PG8_WAIT_L(0); PG8_BAR; PG8_MMA(1, 0, At, B0); PG8_MMA(1, 1, At, B1); PG8_BAR; PG8_SCHED;
            PG8_LDB(B0, 1, 0); PG8_LDB(B1, 1, 1); PG8_SCHED; PG8_LDA(At, 1, 0); PG8_STAGE(PG8_SA(0, 1), a2 + hstepA, v2[NH - 1]);
            PG8_WAIT_V(8); PG8_WAIT_L(0); PG8_BAR; PG8_MMA(0, 0, At, B0); PG8_MMA(0, 1, At, B1); PG8_BAR; PG8_SCHED;
            PG8_LDA(At, 1, 1); PG8_STAGE(PG8_SB(1, 0), b3, voffB); PG8_STAGE(PG8_SB(1, 1), b3 + hstepB, voffB); PG8_STAGE(PG8_SA(1, 0), a3, v2[0]);
            PG8_WAIT_V(8); PG8_WAIT_L(0); PG8_BAR; PG8_MMA(1, 0, At, B0); PG8_MMA(1, 1, At, B1); PG8_BAR; PG8_SCHED;
        }
        if constexpr (ALIGN_EPI) { if (wr == 0) PG8_BAR; }
        if constexpr (FP8) asm volatile("s_nop 15\n\ts_nop 15" ::: "memory");
        { Unit eu = cur; asm volatile("" : "+s"(eu.pm), "+s"(eu.pn));
          E(acc, eu, ui, wr, wc, fr, fq); }
        if (!has_next) break;
#pragma unroll
        for (int a = 0; a < 2; ++a)
#pragma unroll
            for (int b = 0; b < 2; ++b)
#pragma unroll
                for (int m = 0; m < 4; ++m)
#pragma unroll
                    for (int n = 0; n < 2; ++n) acc[a][b][m][n] = (f32x4){0.f, 0.f, 0.f, 0.f};
        cur = nxt; cA = nA; cB = nB; ++ui;
        if constexpr (Sched::GATHER) {
#pragma unroll
            for (int h = 0; h < NH; ++h) { cvA[h][0] = nvA[h][0]; cvA[h][1] = nvA[h][1]; }
        }
        if constexpr (ALIGN_EPI) { if (wr == 1) PG8_BAR; }
    }
    PG8_WAIT_V(0);
    if constexpr (!ALIGN_EPI) { if (wr == 0) PG8_BAR; }
    PG8_BAR;
#undef PG8_SA
#undef PG8_SB
#undef PG8_STAGE
#undef PG8_LDA
#undef PG8_LDB
#undef PG8_MMA
#undef PG8_LD32
#undef PG8_H0
#undef PG8_H1
#undef PG8_WAIT_V
#undef PG8_WAIT_L
#undef PG8_BAR
#undef PG8_SCHED
}
}
#define GAS __attribute__((address_space(1)))
typedef float f32x4 __attribute__((ext_vector_type(4)));
typedef float f32x16 __attribute__((ext_vector_type(16)));
typedef short bf16x8 __attribute__((ext_vector_type(8)));
typedef unsigned v4u __attribute__((ext_vector_type(4)));
typedef unsigned v2u __attribute__((ext_vector_type(2)));
#define LDS_WAIT() asm volatile("s_waitcnt lgkmcnt(0)" ::: "memory")
#define VM_WAIT() asm volatile("s_waitcnt vmcnt(0)" ::: "memory")
__device__ __forceinline__ unsigned pk2(float lo, float hi) { return f2bf(lo) | (f2bf(hi) << 16); }

constexpr int NWAVES = 8, NTHR = 512;
constexpr int LDS_STAGE = 0;
constexpr int LDS_RS = 131072;
constexpr int LDS_ROWTOK = LDS_RS + 8192;
constexpr int LDS_GATE = LDS_ROWTOK + 8192;
constexpr int LDS_MISC = LDS_GATE + 8192;
constexpr int LDS_MOET = LDS_MISC + 256;
constexpr int LDS_BYTES = LDS_MOET + 2048;
static_assert(LDS_BYTES <= 160 * 1024, "lds");
constexpr size_t WO_IN = 0, WO_SM = 6 * MiB, WO_RHI = 6 * MiB + 65536, WO_RLO = 6 * MiB + 131072, WO_OUT = 7 * MiB, WO_XQ = 9 * MiB, WO_XO = 10 * MiB, WO_GU = 11 * MiB, WO_D = 43 * MiB;
static_assert(WO_D + 16 * MiB <= WS_WLAYER, "weight block");
constexpr int CW_BAR = 4096;
constexpr int MAX_LAUNCH = 1;
constexpr int CW_XID = 8192;
constexpr int CW_PF = 16384;
constexpr int PF_WORDS = NLAYER * 3 * 128 * 16;
static_assert(CW_BAR + MAX_LAUNCH * XCD_BAR_WORDS <= CW_XID && CW_XID + 1024 <= CW_PF && (CW_PF + PF_WORDS) * 4 <= (int)(1 * MiB), "ctl");

enum { PH_PRO = 0, PH_XKV = 1, PH_L0 = 2, NPH = 13, PH_FINAL = PH_L0 + NLAYER * NPH, PH_END = PH_FINAL + 1 };
enum { LP_INPROJ = 0, LP_MIXA, LP_MIXB, LP_MIXC, LP_WOUT, LP_XQ, LP_XATTN, LP_XO, LP_ROUTE, LP_SORT, LP_GU, LP_DOWN0, LP_DOWN1 };

struct Args { P p; int ph_lo, ph_hi, li, pad; };

#ifndef WT_PROJ
#define WT_PROJ 0
#endif
template <bool HAS_RS> struct EpiBf16 {
    static constexpr bool PERM = true;
    bf16* O; int ldc; const LAS float* rstab;
    __device__ __forceinline__ void operator()(const pg8::f32x4 (&acc)[2][2][4][2], const pg8::Unit& u, int iu, int wr, int wc, int fr, int fq) const {
#pragma unroll
        for (int ai = 0; ai < 2; ++ai)
#pragma unroll
            for (int m = 0; m < 4; ++m) {
                const int lrow = ai * 128 + wr * 64 + m * 16 + fr;
                float sc = 1.f; if (HAS_RS) sc = rstab[iu * 256 + lrow];
                bf16* rowp = O + (size_t)(u.pm * 256 + lrow) * ldc + u.pn * 256 + wc * 32 + 8 * fq;
#pragma unroll
                for (int bj = 0; bj < 2; ++bj) { const pg8::f32x4 v0 = acc[ai][bj][m][0] * sc, v1 = acc[ai][bj][m][1] * sc;
                    pg8::u32x4 w; w.x = pg8::cvt_pk_bf16(v0[0], v0[1]); w.y = pg8::cvt_pk_bf16(v0[2], v0[3]); w.z = pg8::cvt_pk_bf16(v1[0], v1[1]); w.w = pg8::cvt_pk_bf16(v1[2], v1[3]);
                    if (WT_PROJ) st_b128_wt(rowp + bj * 128, w); else st_b128(rowp + bj * 128, w); }
            }
    }
};
__device__ __forceinline__ unsigned pk4_fp8(float a, float b, float c, float d) { int w = __builtin_amdgcn_cvt_pk_fp8_f32(a, b, 0, false); w = __builtin_amdgcn_cvt_pk_fp8_f32(c, d, w, true); return (unsigned)w; }
struct EpiGU {
    static constexpr bool PERM = true;
    unsigned char* U8; const LAS float* rstab; const LAS float* gatetab;
    __device__ __forceinline__ void operator()(const pg8::f32x4 (&acc)[2][2][4][2], const pg8::Unit& u, int iu, int wr, int wc, int fr, int fq) const {
#pragma unroll
        for (int ai = 0; ai < 2; ++ai)
#pragma unroll
            for (int m = 0; m < 4; ++m) {
                const int lrow = ai * 128 + wr * 64 + m * 16 + fr;
                const float sc = rstab[iu * 256 + lrow], gt = 4.f * gatetab[iu * 256 + lrow];
                float o[8];
#pragma unroll
                for (int n = 0; n < 2; ++n)
#pragma unroll
                    for (int j = 0; j < 4; ++j) { const float g = acc[ai][0][m][n][j] * sc, uu = acc[ai][1][m][n][j] * sc; o[n * 4 + j] = gt * g * uu * __builtin_amdgcn_rcpf(1.f + __expf(-g)); }
                pg8::u32x2 w; w.x = pk4_fp8(o[0], o[1], o[2], o[3]); w.y = pk4_fp8(o[4], o[5], o[6], o[7]);
                st_b64(U8 + (size_t)(u.pm * 256 + lrow) * 1024 + (u.pn >> 2) * 512 + (u.pn & 3) * 128 + wc * 32 + 8 * fq, w);
            }
    }
};
template <int MODE, bool W8 = false> struct EpiRes {
    static constexpr bool PERM = true;
    static constexpr bool MOE = MODE != 0;
    bf16* hb; float* ssq; const LAS int* rowtab; float gs; unsigned char* h8;
    static __device__ __forceinline__ void unpack8(const pg8::u32x4& w, float (&f)[8]) {
        f[0] = __builtin_bit_cast(float, w.x << 16); f[1] = __builtin_bit_cast(float, w.x & 0xffff0000u); f[2] = __builtin_bit_cast(float, w.y << 16); f[3] = __builtin_bit_cast(float, w.y & 0xffff0000u);
        f[4] = __builtin_bit_cast(float, w.z << 16); f[5] = __builtin_bit_cast(float, w.z & 0xffff0000u); f[6] = __builtin_bit_cast(float, w.w << 16); f[7] = __builtin_bit_cast(float, w.w & 0xffff0000u); }
    __device__ __forceinline__ void operator()(const pg8::f32x4 (&acc)[2][2][4][2], const pg8::Unit& u, int iu, int wr, int wc, int fr, int fq) const {
#pragma unroll
        for (int ai = 0; ai < 2; ++ai)
#pragma unroll
            for (int m = 0; m < 4; ++m) {
                const int lrow = ai * 128 + wr * 64 + m * 16 + fr;
                int row = u.pm * 256 + lrow; const float g = gs;
                if (MOE) row = rowtab[iu * 256 + lrow];
                const bool ok = !MOE || row >= 0;
                const size_t off = (size_t)(ok ? row : 0) * DM + u.pn * 256 + wc * 32 + 8 * fq;
                float q = 0.f;
                if (ok) {
#pragma unroll
                    for (int bj = 0; bj < 2; ++bj) {
                        float o[8];
#pragma unroll
                        for (int j = 0; j < 4; ++j) { o[j] = acc[ai][bj][m][0][j] * g; o[4 + j] = acc[ai][bj][m][1][j] * g; }
                        float bs[8]; unpack8(*(const pg8::u32x4*)(hb + off + bj * 128), bs);
#pragma unroll
                        for (int j = 0; j < 8; ++j) o[j] += bs[j];
                        pg8::u32x4 w; w.x = pg8::cvt_pk_bf16(o[0], o[1]); w.y = pg8::cvt_pk_bf16(o[2], o[3]); w.z = pg8::cvt_pk_bf16(o[4], o[5]); w.w = pg8::cvt_pk_bf16(o[6], o[7]);
                        float r[8]; unpack8(w, r);
#pragma unroll
                        for (int j = 0; j < 8; ++j) q += r[j] * r[j];
                        st_b128(hb + off + bj * 128, w);
                        if (W8) { pg8::u32x2 w8; w8.x = pk4_fp8(o[0], o[1], o[2], o[3]); w8.y = pk4_fp8(o[4], o[5], o[6], o[7]); st_b64(h8 + off + bj * 128, w8); }
                    }
                }
                q += __shfl_xor(q, 16); q += __shfl_xor(q, 32); if (fq == 0 && ok) ssq[(size_t)row * 16 + u.pn * 4 + wc] = q;
            }
    }
};
template <int MODE> struct MoeOrder {
    static constexpr bool GATHER = MODE == 0;
    static constexpr size_t KSTEP_A = 128;
    static constexpr int SH = MODE == 0 ? 3 : 2;
    const char* A; const char* Bt; int K; size_t estride; int T, G, c; const LAS int* tile2e; const LAS int* rowtab;
    __device__ bool next(int i, pg8::Unit& u) const { const int L = i * G + c, t = L >> SH; if (t >= T) return false; u.pm = t; u.pn = L & ((1 << SH) - 1); u.e = __builtin_amdgcn_readfirstlane(tile2e[t]); return true; }
    __device__ __forceinline__ const char* a_base(const pg8::Unit& u) const { return GATHER ? A : A + (size_t)u.pm * (size_t)512 * K; }
    __device__ __forceinline__ const char* b_base(const pg8::Unit& u) const {
        if (MODE == 0) { const int e = (u.pn < 4 ? u.e >> 8 : u.e >> 16) & 255; return Bt + (size_t)e * estride + (size_t)(u.pn & 3) * (size_t)512 * K; }
        return Bt + (size_t)((u.e >> 8) & 255) * estride + (size_t)u.pn * (size_t)(256 * 512);
    }
    __device__ __forceinline__ long b_delta(const pg8::Unit& u) const { return (long)(((u.e >> 16) & 255) - ((u.e >> 8) & 255)) * (long)estride - 512; }
    __device__ __forceinline__ unsigned a_off(int iu, int h, int R, int Cb) const { return (unsigned)rowtab[iu * 256 + h * 128 + R] * (unsigned)(K * 2) + (unsigned)Cb; }
};

__device__ __forceinline__ void router_weights(const P& p, int gtid, int gstride);
__device__ __forceinline__ void tr_item(const float* W, int N, int K, int k0, int n0, const float* gain, float scale, bf16* dst, LAS float* scr, int lane) {
    const int kr = lane >> 3, c4 = lane & 7;
    f32x4 v[8];
#pragma unroll
    for (int i = 0; i < 8; ++i) v[i] = *(const f32x4*)(W + (size_t)(k0 + 8 * i + kr) * N + n0 + 4 * c4);
#pragma unroll
    for (int i = 0; i < 8; ++i) { const int kk = 8 * i + kr; float g = scale; if (gain) g *= gain[k0 + kk];
        LAS float* d = scr + kk * 33 + 4 * c4; d[0] = v[i].x * g; d[1] = v[i].y * g; d[2] = v[i].z * g; d[3] = v[i].w * g; }
    LDS_WAIT();
    const int c = lane & 7;
#pragma unroll
    for (int j = 0; j < 4; ++j) { const int n = (lane >> 3) + 8 * j; const LAS float* s = scr + (8 * c) * 33 + n;
        v4u o; o.x = pk2(s[0 * 33], s[1 * 33]); o.y = pk2(s[2 * 33], s[3 * 33]); o.z = pk2(s[4 * 33], s[5 * 33]); o.w = pk2(s[6 * 33], s[7 * 33]);
        st_b128(dst + (size_t)n * K + k0 + 8 * c, o); }
    LDS_WAIT();
}
__device__ __forceinline__ void tr_item8(const float* W, int N, int K, int k0, int n0, const float* gain, float scale, unsigned char* dst, LAS float* scr, int lane) {
    const int kr = lane >> 3, c4 = lane & 7;
    f32x4 v[8];
#pragma unroll
    for (int i = 0; i < 8; ++i) v[i] = *(const f32x4*)(W + (size_t)(k0 + 8 * i + kr) * N + n0 + 4 * c4);
#pragma unroll
    for (int i = 0; i < 8; ++i) { const int kk = 8 * i + kr; float g = scale; if (gain) g *= gain[k0 + kk];
        LAS float* d = scr + kk * 33 + 4 * c4; d[0] = v[i].x * g; d[1] = v[i].y * g; d[2] = v[i].z * g; d[3] = v[i].w * g; }
    LDS_WAIT();
    const int c = lane & 7;
#pragma unroll
    for (int j = 0; j < 4; ++j) { const int n = (lane >> 3) + 8 * j; const LAS float* s = scr + (8 * c) * 33 + n;
        v2u o; o.x = pk4_fp8(s[0 * 33], s[1 * 33], s[2 * 33], s[3 * 33]); o.y = pk4_fp8(s[4 * 33], s[5 * 33], s[6 * 33], s[7 * 33]);
        st_b64(dst + (size_t)n * K + k0 + 8 * c, o); }
    LDS_WAIT();
}
constexpr int IT_LAYER = 15360;
__device__ __forceinline__ void prologue_item(const P& p, int it, LAS float* scr, int lane) {
    const int l = it / IT_LAYER; int r = it % IT_LAYER;
    unsigned char* wl = ws_base(p.ws) + WS_W + (size_t)l * WS_WLAYER;
    if (r < 1536) {
        const int seg = r / 768; r %= 768; const int kb = r / 48, nb = r % 48; const int n0 = (seg ? 1544 : 0) + 32 * nb, drow = seg * 1536 + 32 * nb;
        const float sc = drow < 512 ? 0.125f * LOG2E : ((drow >= C_GQ && drow < C_GK) ? 0.125f : 1.f);
        tr_item(p.w_in + (size_t)l * DM * INW, INW, DM, 64 * kb, n0, p.mix_norm + l * DM, sc, (bf16*)(wl + WO_IN) + (size_t)drow * DM, scr, lane); return; }
    r -= 1536;
    if (r < 512) { const int kb = r / 32, nb = r % 32; tr_item(p.w_out + (size_t)l * DM * DM, DM, DM, 64 * kb, 32 * nb, nullptr, 1.f, (bf16*)(wl + WO_OUT) + (size_t)(32 * nb) * DM, scr, lane); return; }
    r -= 512;
    if (r < 256) { const int kb = r / 16, nb = r % 16; tr_item(p.w_xq + (size_t)l * DM * 512, 512, DM, 64 * kb, 32 * nb, p.cross_norm + l * DM, 0.08838834764831845f * LOG2E, (bf16*)(wl + WO_XQ) + (size_t)(32 * nb) * DM, scr, lane); return; }
    r -= 256;
    if (r < 256) { const int kb = r / 32, nb = r % 32; tr_item8(p.w_xo + (size_t)l * 512 * DM, DM, 512, 64 * kb, 32 * nb, nullptr, 32.f, (unsigned char*)(wl + WO_XO) + (size_t)(32 * nb) * 512, scr, lane); return; }
    r -= 256;
    if (r < 512) { const int kv = r / 256; r %= 256; const int kb = r / 16, nb = r % 16;
        tr_item((kv ? p.w_xv : p.w_xk) + (size_t)l * DM * 512, 512, DM, 64 * kb, 32 * nb, nullptr, 1.f, (bf16*)(ws_base(p.ws) + WS_WXKV) + (size_t)(l * 1024 + kv * 512 + 32 * nb) * DM, scr, lane); return; }
    r -= 512;
    if (r < 8192) { const int up = r / 4096; r %= 4096; const int e = r / 256; r %= 256; const int kb = r / 16, nb = r % 16; const int c0 = 32 * nb, drow = (c0 >> 7) * 256 + up * 128 + (c0 & 127);
        tr_item8((up ? p.w_eu : p.w_eg) + ((size_t)l * 16 + e) * DM * 512, 512, DM, 64 * kb, c0, p.moe_norm + l * DM, 32.f, (unsigned char*)(wl + WO_GU) + ((size_t)e * 1024 + drow) * DM, scr, lane); return; }
    r -= 8192;
    { const int e = r / 256; r %= 256; const int kb = r / 32, nb = r % 32;
      tr_item8(p.w_ed + ((size_t)l * 16 + e) * 512 * DM, DM, 512, 64 * kb, 32 * nb, nullptr, 32.f, (unsigned char*)(wl + WO_D) + ((size_t)e * 1024 + 32 * nb) * 512, scr, lane); }
}
__device__ __forceinline__ void row_to_bf16(const float* src, bf16* dst, float* ssq, const float* gain, int lane, int mode) {
    const f32x4* s = (const f32x4*)src + lane;
    f32x4 v[4]; float q = 0.f;
#pragma unroll
    for (int j = 0; j < 4; ++j) { v[j] = s[64 * j]; q += (v[j].x * v[j].x + v[j].y * v[j].y) + (v[j].z * v[j].z + v[j].w * v[j].w); }
    q = wave_sum(q);
    float sc = 1.f;
    if (mode == 1) sc = rsqrtf(q * (1.0f / DM) + EPS);
    v2u* d = (v2u*)dst + lane; float q2 = 0.f;
#pragma unroll
    for (int j = 0; j < 4; ++j) {
        f32x4 g = (f32x4){1.f, 1.f, 1.f, 1.f}; if (mode == 1) g = ((const f32x4*)gain)[lane + 64 * j];
        v2u o; o.x = pk2(v[j].x * sc * g.x, v[j].y * sc * g.y); o.y = pk2(v[j].z * sc * g.z, v[j].w * sc * g.w); st_b64(d + 64 * j, o);
        const float r0 = __builtin_bit_cast(float, o.x << 16), r1 = __builtin_bit_cast(float, o.x & 0xffff0000u), r2 = __builtin_bit_cast(float, o.y << 16), r3 = __builtin_bit_cast(float, o.y & 0xffff0000u);
        q2 += (r0 * r0 + r1 * r1) + (r2 * r2 + r3 * r3); }
    if (mode == 0) { q2 = wave_sum(q2); if (lane < 16) ssq[lane] = lane == 0 ? q2 : 0.f; }
}
__device__ __forceinline__ void prologue(const P& p, LAS unsigned char* lds, int vcu, int G, int wave, int lane) {
    asm volatile("" : "+v"(lane));
    if (vcu == 0 && wave == 0) WSP(int, WS_MOE + MO_GCNT)[lane] = 0;
    if (vcu == 1 % G) { unsigned* pf = (unsigned*)(ws_base(p.ws) + WS_CTL) + CW_PF; for (int i = wave * 64 + lane; i < PF_WORDS; i += NTHR) pf[i] = 0u; }
    LAS float* scr = (LAS float*)(lds + LDS_STAGE + wave * 16384);
    const int gw = vcu * NWAVES + wave, NGW = G * NWAVES;
    for (int it = gw; it < NLAYER * IT_LAYER; it += NGW) prologue_item(p, it, scr, lane);
    for (int idx = gw * 64 + lane; idx < NLAYER * 2 * 32768; idx += NGW * 64) {
        const int l = idx / 65536, r = idx % 65536, which = r / 32768, e = r % 32768, row = e & 31, k = e >> 5;
        unsigned char* wl = ws_base(p.ws) + WS_W + (size_t)l * WS_WLAYER;
        if (which == 0) {
            float v = 0.f;
            if (row < 8) v = p.w_in[((size_t)l * DM + k) * INW + 1536 + row]; else if (row < 24) v = p.w_in[((size_t)l * DM + k) * INW + 3080 + (row - 8)];
            ((bf16*)(wl + WO_SM))[row * 1024 + k] = (bf16)f2bf(v * p.mix_norm[l * DM + k]);
        }
    }
    router_weights(p, gw * 64 + lane, NGW * 64);
    for (int m = gw; m < 4096; m += NGW) row_to_bf16(p.mem + (size_t)m * DM, WSP(bf16, WS_MEMN) + (size_t)m * DM, nullptr, p.mem_norm, lane, 1);
    { bf16* hbp = WSP(bf16, WS_HB); float* sqp = WSP(float, WS_SSQ);
      for (int m0 = gw * 4; m0 < NTOK; m0 += NGW * 4) {
        f32x4 v[4][4];
#pragma unroll
        for (int r = 0; r < 4; ++r)
#pragma unroll
            for (int j = 0; j < 4; ++j) v[r][j] = ((const f32x4*)(p.x + (size_t)(m0 + r) * DM))[lane + 64 * j];
#pragma unroll
        for (int r = 0; r < 4; ++r) { float q2 = 0.f; v2u* d = (v2u*)(hbp + (size_t)(m0 + r) * DM) + lane;
#pragma unroll
            for (int j = 0; j < 4; ++j) { v2u o; o.x = pk2(v[r][j].x, v[r][j].y); o.y = pk2(v[r][j].z, v[r][j].w); st_b64(d + 64 * j, o);
                const float r0 = __builtin_bit_cast(float, o.x << 16), r1 = __builtin_bit_cast(float, o.x & 0xffff0000u), r2 = __builtin_bit_cast(float, o.y << 16), r3 = __builtin_bit_cast(float, o.y & 0xffff0000u);
                q2 += (r0 * r0 + r1 * r1) + (r2 * r2 + r3 * r3); }
            q2 = wave_sum(q2); if (lane < 16) sqp[(size_t)(m0 + r) * 16 + lane] = lane == 0 ? q2 : 0.f; }
      } }
}
__device__ __forceinline__ void small_proj(const P& p, int l, LAS unsigned char* lds, int vcu, int G, int wave, int lane) {
    asm volatile("" : "+v"(lane));
    const bf16* wsm = (const bf16*)(ws_base(p.ws) + WS_W + (size_t)l * WS_WLAYER + WO_SM);
    const bf16* hb = WSP(bf16, WS_HB); const float* ssq = WSP(float, WS_SSQ); float* sm = WSP(float, WS_SM);
    constexpr int BST = 2048 + 16;
    { const int tid = wave * 64 + lane;
#pragma unroll
      for (int i = 0; i < 8; ++i) { const int idx = tid + NTHR * i, row = idx >> 7, c = idx & 127; *(LAS v4u*)(lds + row * BST + c * 16) = *(const v4u*)(wsm + row * 1024 + c * 8); } }
    __syncthreads();
    const int r = lane & 15, kq = lane >> 4;
    for (int blk = vcu * NWAVES + wave; blk < NTOK / 16; blk += G * NWAVES) {
        const int tok0 = blk * 16;
        const bf16x8* ap = (const bf16x8*)(hb + (size_t)(tok0 + r) * DM + kq * 32);
        pg8::f32x4 acc0 = {0.f, 0.f, 0.f, 0.f}, acc1 = {0.f, 0.f, 0.f, 0.f};
#pragma unroll
        for (int half = 0; half < 2; ++half) {
            bf16x8 af[16];
#pragma unroll
            for (int i = 0; i < 16; ++i) af[i] = ap[(half * 4 + (i >> 2)) * 16 + (i & 3)];
#pragma unroll
            for (int i = 0; i < 16; ++i) { const int s_ = half * 4 + (i >> 2), j = i & 3;
                const bf16x8 b0 = *(const LAS bf16x8*)(lds + r * BST + (128 * s_ + 32 * kq + 8 * j) * 2);
                const bf16x8 b1 = *(const LAS bf16x8*)(lds + (16 + r) * BST + (128 * s_ + 32 * kq + 8 * j) * 2);
                acc0 = __builtin_amdgcn_mfma_f32_16x16x32_bf16(af[i], b0, acc0, 0, 0, 0);
                acc1 = __builtin_amdgcn_mfma_f32_16x16x32_bf16(af[i], b1, acc1, 0, 0, 0);
                if ((i & 3) == 3) __builtin_amdgcn_sched_barrier(0); }
        }
        const float rsv = row_rs(ssq, tok0 + r);
#pragma unroll
        for (int g = 0; g < 4; ++g) { const int trow = 4 * kq + g; const float rs = __shfl(rsv, trow);
            sm[(size_t)(tok0 + trow) * 32 + r] = acc0[g] * rs; if (r < 8) sm[(size_t)(tok0 + trow) * 32 + 16 + r] = acc1[g] * rs; }
    }
    __syncthreads();
}
typedef short v4i16_t __attribute__((ext_vector_type(4)));
typedef __bf16 bf16x2_t __attribute__((ext_vector_type(2)));
typedef float f32x2_t __attribute__((ext_vector_type(2)));
__device__ __forceinline__ unsigned cvtpk(float lo, float hi) { f32x2_t v = {lo, hi}; bf16x2_t b = __builtin_convertvector(v, bf16x2_t); return __builtin_bit_cast(unsigned, b); }
__device__ __forceinline__ bf16x8 pack8(const f32x16& p, int o) {
    v4u w; w.x = cvtpk(p[o], p[o + 1]); w.y = cvtpk(p[o + 2], p[o + 3]); w.z = cvtpk(p[o + 4], p[o + 5]); w.w = cvtpk(p[o + 6], p[o + 7]);
    return __builtin_bit_cast(bf16x8, w);
}
__device__ __forceinline__ float max3f(float a, float b, float c) { float r; asm("v_max3_f32 %0, %1, %2, %3" : "=v"(r) : "v"(a), "v"(b), "v"(c)); return r; }
template <int D, bool FOX, bool OUT8 = false>
__device__ __forceinline__ void attn_unit(LAS unsigned char* lds, const bf16* Qg, int qpitch, const bf16* Kg, const bf16* Vg, int kvpitch, int NT,
                                          const float* cb, int q0, bf16* Og, int opitch, const float* gain, const float* kn) {
    constexpr int KS = D * 2 + 16, VS = D * 2 + 64;
    constexpr int KT = FOX ? 2 : 1, KEYS = 64 * KT;
    constexpr int KBYTES = KEYS * KS, VBYTES = KEYS * VS;
    constexpr int CPR = D / 8, NCH = KEYS * CPR / NTHR, NS = D / 16, NDB = D / 32;
    constexpr int OFF_K = 0, OFF_V = 2 * KBYTES, OFF_CB = 2 * KBYTES + 2 * VBYTES, OFF_FX = OFF_CB + 2 * KEYS * 4;
    int tid = threadIdx.x; asm volatile("" : "+v"(tid));
    const int lane = tid & 63, wave = __builtin_amdgcn_readfirstlane(tid >> 6), r32 = lane & 31, hh = lane >> 5;
    bf16x8 qf[NS];
    { const bf16* qrow = Qg + (size_t)(wave * 32 + r32) * qpitch;
#pragma unroll
      for (int s = 0; s < NS; ++s) qf[s] = *(const bf16x8*)(qrow + 16 * s + 8 * hh); }
    v4u kreg[NCH], vreg[NCH]; f32x4 cbreg = {0.f, 0.f, 0.f, 0.f};
#define AT_GLOAD(t) do { _Pragma("unroll") for (int i_ = 0; i_ < NCH; ++i_) { const int idx_ = tid + NTHR * i_, key_ = idx_ / CPR, c_ = idx_ % CPR; \
        kreg[i_] = *(const v4u*)(Kg + (size_t)((t) * KEYS + key_) * kvpitch + c_ * 8); vreg[i_] = *(const v4u*)(Vg + (size_t)((t) * KEYS + key_) * kvpitch + c_ * 8); } \
        if (FOX && tid < KEYS / 4) cbreg = *(const f32x4*)(cb + (t) * KEYS + tid * 4); } while (0)
#define AT_LSTORE(b) do { _Pragma("unroll") for (int i_ = 0; i_ < NCH; ++i_) { const int idx_ = tid + NTHR * i_, key_ = idx_ / CPR, c_ = idx_ % CPR; \
        *(LAS v4u*)(lds + OFF_K + (b) * KBYTES + key_ * KS + c_ * 16) = kreg[i_]; *(LAS v4u*)(lds + OFF_V + (b) * VBYTES + key_ * VS + c_ * 16) = vreg[i_]; } \
        if (FOX && tid < KEYS / 4) *(LAS f32x4*)(lds + OFF_CB + (b) * (KEYS * 4) + tid * 16) = cbreg; } while (0)
    float m = -INFINITY, l = 0.f;
    f32x16 osum = f32x16{};
    f32x16 o[NDB];
#pragma unroll
    for (int d = 0; d < NDB; ++d) o[d] = f32x16{};
    const int qlo = q0 + wave * 32, qabs = qlo + r32;
    float knpre = 0.f, qkmax = 0.f;
    LAS float* fx = (LAS float*)(lds + OFF_FX);
    const int NTG = NT / KT;
    const int t_first = FOX ? NTG - 1 : 0;
    AT_GLOAD(t_first);
    __syncthreads();
    if (FOX) {
        float qn2 = 0.f;
#pragma unroll
        for (int s = 0; s < NS; ++s)
#pragma unroll
            for (int e = 0; e < 8; ++e) { const float v = __builtin_bit_cast(float, ((unsigned)(unsigned short)qf[s][e]) << 16); qn2 += v * v; }
        qn2 += __shfl_xor(qn2, 32);
        qn2 = wave_max(qn2);
        if (lane == 0) fx[wave] = qn2;
        knpre = lane < 32 ? kn[lane] : 0.f;
#pragma unroll
        for (int o_ = 1; o_ < 32; o_ <<= 1) { const float t_ = __shfl_up(knpre, o_); if (lane >= o_) knpre = fmaxf(knpre, t_); }
    }
    AT_LSTORE(0);
    __syncthreads();
    if (FOX) { float q2 = fx[0];
#pragma unroll
        for (int w_ = 1; w_ < 8; ++w_) q2 = fmaxf(q2, fx[w_]);
        qkmax = sqrtf(q2); }
#pragma unroll 1
    for (int it = 0; it < NTG; ++it) {
        const int b = it & 1;
        const int tg = FOX ? NTG - 1 - it : it;
        const int tn = FOX ? tg - 1 : tg + 1;
        if (it + 1 < NTG) AT_GLOAD(tn);
#pragma unroll
        for (int sub_ = 0; sub_ < KT; ++sub_) {
        const int sub = FOX ? KT - 1 - sub_ : sub_, koff = sub * 64;
        const int kt0 = (tg * KT + sub) * 64;
        if (!FOX || kt0 <= qlo + 31) {
            f32x16 p[2];
#pragma unroll
            for (int kb = 0; kb < 2; ++kb) {
                if (FOX) {
#pragma unroll
                    for (int g = 0; g < 4; ++g) { const f32x4 c4 = *(const LAS f32x4*)(lds + OFF_CB + b * (KEYS * 4) + (koff + kb * 32 + 8 * g + 4 * hh) * 4); p[kb][4 * g] = c4.x; p[kb][4 * g + 1] = c4.y; p[kb][4 * g + 2] = c4.z; p[kb][4 * g + 3] = c4.w; }
                } else p[kb] = f32x16{};
                const LAS unsigned char* kp = lds + OFF_K + b * KBYTES + (koff + kb * 32 + r32) * KS + hh * 16;
#pragma unroll
                for (int s = 0; s < NS; ++s) { const bf16x8 kf = *(const LAS bf16x8*)(kp + s * 32); p[kb] = __builtin_amdgcn_mfma_f32_32x32x16_bf16(kf, qf[s], p[kb], 0, 0, 0); }
            }
            if (FOX && kt0 + 63 > qlo) {
#pragma unroll
                for (int kb = 0; kb < 2; ++kb)
#pragma unroll
                    for (int r = 0; r < 16; ++r) { const int key = kt0 + kb * 32 + (r & 3) + 8 * (r >> 2) + 4 * hh; if (key > qabs) p[kb][r] = -INFINITY; }
            }
            float mt = fmaxf(p[1][0], p[0][0]);
#pragma unroll
            for (int r = 1; r < 16; ++r) mt = max3f(mt, p[0][r], p[1][r]);
            mt = fmaxf(mt, __shfl_xor(mt, 32));
            const float mnew = fmaxf(m, mt);
            float ls = 0.f;
#pragma unroll
            for (int kb = 0; kb < 2; ++kb)
#pragma unroll
                for (int r = 0; r < 16; ++r) { const float e = __builtin_amdgcn_exp2f(p[kb][r] - mnew); p[kb][r] = e; if (!FOX) ls += e; }
            if (!FOX || __builtin_amdgcn_ballot_w64(mnew > m) != 0ull) {
                const float alpha = __builtin_amdgcn_exp2f(m - mnew);
                l *= alpha; if (FOX) osum[0] *= alpha;
#pragma unroll
                for (int d = 0; d < NDB; ++d)
#pragma unroll
                    for (int r = 0; r < 16; ++r) o[d][r] *= alpha;
            }
            m = mnew; l += ls;
            bf16x8 pa[2][2];
#pragma unroll
            for (int kb = 0; kb < 2; ++kb) { pa[kb][0] = pack8(p[kb], 0); pa[kb][1] = pack8(p[kb], 8); }
            const LAS unsigned char* vp = lds + OFF_V + b * VBYTES + (koff + 4 * hh + ((lane & 15) >> 2)) * VS + (16 * ((lane >> 4) & 1) + 4 * (lane & 3)) * 2;
#pragma unroll
            for (int d = 0; d < NDB; ++d) {
#pragma unroll
                for (int kb = 0; kb < 2; ++kb)
#pragma unroll
                    for (int ks = 0; ks < 2; ++ks) {
                        const LAS unsigned char* a0 = vp + (kb * 32 + 16 * ks) * VS + d * 64;
                        const v4i16_t lo = __builtin_amdgcn_ds_read_tr16_b64_v4i16((LAS v4i16_t*)a0);
                        const v4i16_t hi = __builtin_amdgcn_ds_read_tr16_b64_v4i16((LAS v4i16_t*)(a0 + 8 * VS));
                        const bf16x8 vf = (bf16x8){lo[0], lo[1], lo[2], lo[3], hi[0], hi[1], hi[2], hi[3]};
                        o[d] = __builtin_amdgcn_mfma_f32_32x32x16_bf16(vf, pa[kb][ks], o[d], 0, 0, 0);
                    }
            }
            if (FOX) {
                const bf16x8 ones = __builtin_bit_cast(bf16x8, (v4u){0x3F803F80u, 0x3F803F80u, 0x3F803F80u, 0x3F803F80u});
#pragma unroll
                for (int kb = 0; kb < 2; ++kb)
#pragma unroll
                    for (int ks = 0; ks < 2; ++ks) osum = __builtin_amdgcn_mfma_f32_32x32x16_bf16(ones, pa[kb][ks], osum, 0, 0, 0);
            }
        }
        }
        if (FOX) { const float mm = wave_min(m); if (lane == 0) fx[8 + b * 8 + wave] = mm; }
        if (it + 1 < NTG) AT_LSTORE(b ^ 1);
        __syncthreads();
        if (FOX && tg > 0) {
            float M0 = fx[8 + b * 8];
#pragma unroll
            for (int w_ = 1; w_ < 8; ++w_) M0 = fminf(M0, fx[8 + b * 8 + w_]);
            const float cbl = *(const LAS float*)(lds + OFF_CB + (b ^ 1) * (KEYS * 4) + (KEYS - 1) * 4);
            const float knb = __builtin_bit_cast(float, __builtin_amdgcn_readlane(__builtin_bit_cast(int, knpre), tg * KT - 1));
            if (qkmax * knb + cbl < M0 - 40.f) break;
        }
    }
#undef AT_GLOAD
#undef AT_LSTORE
    if (FOX) l = osum[0]; else l += __shfl_xor(l, 32);
    const float inv = 1.0f / l;
    float rs = inv;
    if (FOX) {
        float ss = 0.f;
#pragma unroll
        for (int d = 0; d < NDB; ++d)
#pragma unroll
            for (int r = 0; r < 16; ++r) { const float v = o[d][r] * inv; ss += v * v; }
        ss += __shfl_xor(ss, 32);
        rs = inv * rsqrtf(ss * (1.0f / D) + EPS);
    }
    constexpr int SROW = 144;
    LAS unsigned char* stg = lds + OFF_K + wave * (32 * SROW);
#pragma unroll
    for (int d = 0; d < NDB; ++d)
#pragma unroll
        for (int g = 0; g < 4; ++g) {
            if (OUT8) { *(LAS unsigned*)(stg + r32 * SROW + 32 * d + 8 * g + 4 * hh) = pk4_fp8(o[d][4 * g] * rs, o[d][4 * g + 1] * rs, o[d][4 * g + 2] * rs, o[d][4 * g + 3] * rs); }
            else { f32x4 gn = {1.f, 1.f, 1.f, 1.f}; if (FOX) gn = *(const f32x4*)(gain + 32 * d + 8 * g + 4 * hh);
                v2u w; w.x = cvtpk(o[d][4 * g] * rs * gn.x, o[d][4 * g + 1] * rs * gn.y); w.y = cvtpk(o[d][4 * g + 2] * rs * gn.z, o[d][4 * g + 3] * rs * gn.w);
                *(LAS v2u*)(stg + r32 * SROW + (32 * d + 8 * g + 4 * hh) * 2) = w; }
        }
    static_assert((OUT8 ? D : D * 2) == 128, "stage rows are 128 bytes");
    { unsigned char* ob = (unsigned char*)Og; const size_t pitchb = (size_t)opitch * (OUT8 ? 1 : 2);
#pragma unroll
      for (int i = 0; i < 4; ++i) { const int row = i * 8 + (lane >> 3), ch = lane & 7;
          const v4u w = *(const LAS v4u*)(stg + row * SROW + ch * 16);
          st_b128(ob + (size_t)(wave * 32 + row) * pitchb + ch * 16, w); } }
}
__device__ __forceinline__ void fox_phase(const P& p, int l, LAS unsigned char* lds, int vcu, int G) {
    const bf16* proj = WSP(bf16, WS_PROJ); const float* cb = WSP(float, WS_CB); bf16* y = WSP(bf16, WS_Y);
    for (int pu = vcu; pu < 512; pu += G) {
        const int bh = pu >> 2, pr = pu < 256 ? (pu & 3) : 3 - (pu & 3), b = bh >> 3, h = bh & 7;
        for (int half = 0; half < 2; ++half) {
            const int qb = half ? pr : 7 - pr;
            const size_t row0 = (size_t)b * SEQ;
            attn_unit<64, true>(lds, proj + (row0 + qb * 256) * PW + C_FQ + h * 64, PW, proj + row0 * PW + C_FK + h * 64, proj + row0 * PW + C_FV + h * 64, PW, 4 * (qb + 1),
                                cb + ((size_t)b * 8 + h) * SEQ, qb * 256, y + (row0 + qb * 256) * DM + h * 64, DM, p.fox_gain + l * 512 + h * 64, WSP(const float, WS_MOE + MO_KN) + (b * 8 + h) * 32);
        }
    }
}
__device__ __forceinline__ void xattn_phase(const P& p, int l, LAS unsigned char* lds, int vcu, int G, bool dummy) {
    bf16* xq = WSP(bf16, WS_XQ); const bf16* xkv = WSP(bf16, WS_XKV);
    for (int u = vcu; u < 512; u += G) {
        const int b = u >> 5, h = (u >> 3) & 3, qb = u & 7;
        bf16* qp = xq + ((size_t)b * SEQ + qb * 256) * 512 + h * 128;
        const bf16* kp = xkv + (size_t)b * MEML * 2048 + l * 1024 + h * 128;
        attn_unit<128, false, true>(lds, qp, 512, kp, kp + 512, 2048, 4, nullptr, 0, (bf16*)((dummy ? WSP(unsigned char, WS_Y) : WSP(unsigned char, WS_XO8)) + ((size_t)b * SEQ + qb * 256) * 512 + h * 128), 512, nullptr, nullptr);
    }
}

__device__ __forceinline__ void xattn_pair(const P& p, int l, LAS unsigned char* lds, int pm, int pn, bool dummy) {
    const bf16* xq = WSP(bf16, WS_XQ); const bf16* xkv = WSP(bf16, WS_XKV);
    const int b = pm >> 3;
    for (int hh2 = 0; hh2 < 2; ++hh2) {
        const int h = 2 * pn + hh2;
        const bf16* qp = xq + (size_t)pm * 256 * 512 + h * 128;
        const bf16* kp = xkv + (size_t)b * MEML * 2048 + l * 1024 + h * 128;
        attn_unit<128, false, true>(lds, qp, 512, kp, kp + 512, 2048, 4, nullptr, 0, (bf16*)((dummy ? WSP(unsigned char, WS_Y) : WSP(unsigned char, WS_XO8)) + (size_t)pm * 256 * 512 + h * 128), 512, nullptr, nullptr);
    }
}
constexpr size_t WS_GB = WS_END;
constexpr size_t WS_RT2 = WS_GB + 16 * MiB;
constexpr size_t WS_RG2 = WS_GB + 20 * MiB;
constexpr size_t WS_GDEC = WS_GB + 32 * MiB;
constexpr size_t WS_END2 = WS_GDEC + 1 * MiB;
static_assert(WS_END2 <= 512 * MiB, "workspace map 2");
constexpr int GL_B = 0;
constexpr int GL_TOT = 16384;
constexpr int GL_Q1 = 18432, GL_Q2 = GL_Q1 + 64 * 144, GL_K2 = GL_Q2 + 64 * 144;
constexpr int GL_KD = GL_K2 + 64 * 144;
constexpr int GL_V = GL_KD + 64 * 192;
constexpr int GL_SSQ = GL_V + 64 * 320;
constexpr int GL_GA = GL_SSQ + 1024;
constexpr int GL_YST = GL_GA + 4096;
constexpr int GL_GG = GL_YST + 64 * 272;
constexpr int GL_END = GL_GG + 64 * 272;
static_assert(GL_END <= 131072, "gla lds");

__device__ __forceinline__ float fast_log_sigmoid(float z) { return fminf(z, 0.f) - __logf(1.f + __expf(-fabsf(z))); }
__device__ __forceinline__ void gla_load_v(const bf16* proj, size_t tok0, int h, LAS unsigned char* lds, int tid) {
#pragma unroll
    for (int i = 0; i < 2; ++i) { const int idx = tid + NTHR * i, t = idx >> 4, c = idx & 15;
        *(LAS v4u*)(lds + GL_V + t * 320 + c * 16) = *(const v4u*)(proj + (tok0 + t) * PW + C_GV + h * 128 + c * 8); }
}
__device__ __forceinline__ bf16x8 tr_frag(const LAS unsigned char* a0, int rowstride4) {
    const v4i16_t lo = __builtin_amdgcn_ds_read_tr16_b64_v4i16((LAS v4i16_t*)a0);
    const v4i16_t hi = __builtin_amdgcn_ds_read_tr16_b64_v4i16((LAS v4i16_t*)(a0 + rowstride4));
    return (bf16x8){lo[0], lo[1], lo[2], lo[3], hi[0], hi[1], hi[2], hi[3]};
}
constexpr int GA_WAVE = 19456, GA_SROW = 144;
static_assert(8 * GA_WAVE <= LDS_MISC && 128 * GA_SROW <= GA_WAVE, "gla phase A lds");
__device__ __forceinline__ void gla_phase_a(const P& p, int l, LAS unsigned char* lds, int vcu, int G) {
    int tid = threadIdx.x; asm volatile("" : "+v"(tid));
    const int lane = tid & 63, wave = __builtin_amdgcn_readfirstlane(tid >> 6), hh = lane >> 5;
    const bf16* proj = WSP(bf16, WS_PROJ); bf16* loc = ((bf16*)p.out); float* dec = WSP(float, WS_GDEC); const float* sm = WSP(float, WS_SM); _Float16* gb = WSP(_Float16, WS_GB);
    LAS unsigned char* kd = lds + wave * GA_WAVE; LAS unsigned char* vh = kd + 8192;
    const int crow8 = lane >> 3, cch = lane & 7;
    const int trow = (lane & 15) >> 2, tcol = 16 * ((lane >> 4) & 1) + 4 * (lane & 3);
    for (int u = vcu * NWAVES + wave; u < 2048; u += G * NWAVES) {
        const int c = u & 31, h = (u >> 5) & 3, b = u >> 7;
        const size_t tok0 = (size_t)b * SEQ + c * 64;
        v4u kreg[8], v0reg[8], v1reg[8];
#pragma unroll
        for (int i = 0; i < 8; ++i) { const bf16* rp = proj + (tok0 + i * 8 + crow8) * PW;
            kreg[i] = *(const v4u*)(rp + C_GK + h * 64 + cch * 8); v0reg[i] = *(const v4u*)(rp + C_GV + h * 128 + cch * 8); v1reg[i] = *(const v4u*)(rp + C_GV + h * 128 + 64 + cch * 8); }
        float w[16];
#pragma unroll
        for (int r = 0; r < 16; ++r) w[r] = p.w_alpha_up[((size_t)l * 16 + r) * 256 + h * 64 + lane];
        const float bias = p.b_alpha[l * 256 + h * 64 + lane];
        { LAS f32x4* gw = (LAS f32x4*)vh;
#pragma unroll
          for (int i = 0; i < 4; ++i) gw[lane * 4 + i] = *(const f32x4*)(sm + (tok0 + lane) * 32 + 8 + 4 * i); }
        float bt[64]; float run = 0.f;
#pragma unroll
        for (int t = 0; t < 64; ++t) {
            float z = bias;
#pragma unroll
            for (int r4 = 0; r4 < 4; ++r4) { const f32x4 g4 = ((const LAS f32x4*)vh)[t * 4 + r4]; z += g4.x * w[4 * r4] + g4.y * w[4 * r4 + 1] + g4.z * w[4 * r4 + 2] + g4.w * w[4 * r4 + 3]; }
            run += fast_log_sigmoid(z) * (1.0f / 16.0f); bt[t] = run; gb[(tok0 + t) * 256 + h * 64 + lane] = (_Float16)run;
        }
#pragma unroll
        for (int i = 0; i < 8; ++i) { *(LAS v4u*)(kd + (i * 8 + crow8) * 128 + cch * 16) = kreg[i]; *(LAS v4u*)(vh + (i * 8 + crow8) * 128 + cch * 16) = v0reg[i]; }
#pragma unroll
        for (int t = 0; t < 64; ++t) { LAS bf16* kp = (LAS bf16*)(kd + t * 128 + lane * 2); *kp = (bf16)f2bf(bf2f(*kp) * __expf(run - bt[t])); }
        dec[(size_t)u * 64 + lane] = __expf(run);
        f32x16 acc[2][2][2];
#pragma unroll
        for (int half = 0; half < 2; ++half) {
            if (half == 1) {
#pragma unroll
                for (int i = 0; i < 8; ++i) *(LAS v4u*)(vh + (i * 8 + crow8) * 128 + cch * 16) = v1reg[i];
            }
#pragma unroll
            for (int x = 0; x < 2; ++x)
#pragma unroll
                for (int y = 0; y < 2; ++y) acc[half][y][x] = f32x16{};
#pragma unroll
            for (int s = 0; s < 4; ++s) {
                bf16x8 af[2], bfr[2];
#pragma unroll
                for (int x = 0; x < 2; ++x) { af[x] = tr_frag(vh + (16 * s + 8 * hh + trow) * 128 + (32 * x + tcol) * 2, 4 * 128); bfr[x] = tr_frag(kd + (16 * s + 8 * hh + trow) * 128 + (32 * x + tcol) * 2, 4 * 128); }
#pragma unroll
                for (int x = 0; x < 2; ++x)
#pragma unroll
                    for (int y = 0; y < 2; ++y) acc[half][y][x] = __builtin_amdgcn_mfma_f32_32x32x16_bf16(bfr[y], af[x], acc[half][y][x], 0, 0, 0);
            }
        }
#pragma unroll
        for (int half = 0; half < 2; ++half)
#pragma unroll
            for (int x = 0; x < 2; ++x)
#pragma unroll
                for (int y = 0; y < 2; ++y)
#pragma unroll
                    for (int g = 0; g < 4; ++g) { const f32x16& a = acc[half][y][x];
                        v2u w2; w2.x = cvtpk(a[4 * g], a[4 * g + 1]); w2.y = cvtpk(a[4 * g + 2], a[4 * g + 3]);
                        *(LAS v2u*)(kd + (64 * half + 32 * x + (lane & 31)) * GA_SROW + (32 * y + 8 * g + 4 * hh) * 2) = w2; }
#pragma unroll
        for (int i = 0; i < 16; ++i) { const int idx = lane + 64 * i, row = idx >> 3, ch = idx & 7;
            st_b128(loc + (size_t)u * 8192 + row * 64 + ch * 8, *(const LAS v4u*)(kd + row * GA_SROW + ch * 16)); }
    }
}
__device__ __forceinline__ void gla_phase_b(const P& p, int vcu, int G) {
    int tid = threadIdx.x; asm volatile("" : "+v"(tid));
    const bf16* loc = ((const bf16*)p.out); const float* dec = WSP(float, WS_GDEC); bf16* gs = (bf16*)((unsigned char*)p.out + 96 * MiB);
    for (int u = vcu; u < 256; u += G) {
        const int bh = u >> 2, q4 = u & 3;
        const int e = q4 * 2048 + tid * 4, dk = e & 63;
        f32x4 st = {0.f, 0.f, 0.f, 0.f};
#pragma unroll 8
        for (int c = 0; c < 32; ++c) {
            const size_t cu = (size_t)bh * 32 + c;
            const v2u lw = *(const v2u*)(loc + cu * 8192 + e);
            const f32x4 lv = {__builtin_bit_cast(float, lw.x << 16), __builtin_bit_cast(float, lw.x & 0xffff0000u), __builtin_bit_cast(float, lw.y << 16), __builtin_bit_cast(float, lw.y & 0xffff0000u)};
            const f32x4 dv = *(const f32x4*)(dec + cu * 64 + dk);
            v2u w; w.x = pk2(st.x, st.y); w.y = pk2(st.z, st.w);
            *(v2u*)(gs + cu * 8192 + e) = w;
            st = dv * st + lv;
        }
    }
}
__device__ __forceinline__ void gla_phase_c(const P& p, int l, LAS unsigned char* lds, int vcu, int G) {
    int tid = threadIdx.x; asm volatile("" : "+v"(tid));
    const int lane = tid & 63, wave = __builtin_amdgcn_readfirstlane(tid >> 6), hh = lane >> 5, r32 = lane & 31;
    const bf16* proj = WSP(bf16, WS_PROJ); const bf16* gs = (const bf16*)((const unsigned char*)p.out + 96 * MiB); bf16* y = WSP(bf16, WS_Y); const _Float16* gb = WSP(const _Float16, WS_GB);
    const int dvb = wave >> 1, tb = wave & 1;
    const int trow = (lane & 15) >> 2, tcol = 16 * ((lane >> 4) & 1) + 4 * (lane & 3);
    bf16 n_q[8], n_k[8]; v4u n_v[2], n_g[2]; bf16x8 n_s[4]; f32x4 n_n[4]; float n_b[8], n_r = 0.f;
#define GC_LOAD(uu) do { const int c_ = (uu) & 31, h_ = ((uu) >> 5) & 3, b_ = (uu) >> 7; const size_t t0_ = (size_t)b_ * SEQ + c_ * 64; \
        _Pragma("unroll") for (int j = 0; j < 8; ++j) { const bf16* rp = proj + (t0_ + wave * 8 + j) * PW + h_ * 64 + lane; n_q[j] = rp[C_GQ]; n_k[j] = rp[C_GK]; } \
        _Pragma("unroll") for (int i = 0; i < 2; ++i) { const int idx = tid + NTHR * i, t = idx >> 4, cc = idx & 15; n_v[i] = *(const v4u*)(proj + (t0_ + t) * PW + C_GV + h_ * 128 + cc * 8); n_g[i] = *(const v4u*)(proj + (t0_ + t) * PW + C_GG + h_ * 128 + cc * 8); } \
        { const bf16* sp = gs + (size_t)(uu) * 8192 + (size_t)(32 * dvb + r32) * 64 + 8 * hh; \
          _Pragma("unroll") for (int s2 = 0; s2 < 4; ++s2) n_s[s2] = *(const bf16x8*)(sp + 16 * s2); } \
        _Pragma("unroll") for (int j = 0; j < 8; ++j) n_b[j] = (float)gb[(t0_ + wave * 8 + j) * 256 + h_ * 64 + lane]; \
        n_r = (float)gb[(t0_ + 31) * 256 + h_ * 64 + lane]; \
        _Pragma("unroll") for (int g = 0; g < 4; ++g) { const int dv = 32 * dvb + 8 * g + 4 * hh; \
            n_n[g] = *(const f32x4*)(p.gla_gain + l * 512 + h_ * 128 + dv); } } while (0)
    if (vcu < 2048) GC_LOAD(vcu);
    __syncthreads();
    for (int u = vcu; u < 2048; u += G) {
        const int c = u & 31, h = (u >> 5) & 3, b = u >> 7;
        const size_t tok0 = (size_t)b * SEQ + c * 64;
        bf16x8 sfr[4]; f32x4 gnr[4];
#pragma unroll
        for (int i = 0; i < 4; ++i) { sfr[i] = n_s[i]; gnr[i] = n_n[i]; }
#pragma unroll
        for (int i = 0; i < 2; ++i) { const int idx = tid + NTHR * i, t = idx >> 4, cc = idx & 15; *(LAS v4u*)(lds + GL_V + t * 320 + cc * 16) = n_v[i]; *(LAS v4u*)(lds + GL_GG + t * 272 + cc * 16) = n_g[i]; }
        { const float rref = n_r;
#pragma unroll
          for (int j = 0; j < 8; ++j) { const int t = wave * 8 + j; const float bt = n_b[j];
            const float qv = bf2f(n_q[j]), kv = bf2f(n_k[j]);
            *(LAS bf16*)(lds + GL_Q1 + t * 144 + lane * 2) = (bf16)f2bf(qv * __expf(bt));
            *(LAS bf16*)(lds + GL_Q2 + t * 144 + lane * 2) = (bf16)f2bf(qv * __expf(bt - rref));
            *(LAS bf16*)(lds + GL_K2 + t * 144 + lane * 2) = (bf16)f2bf(kv * __expf(rref - bt)); } }
        __syncthreads();
        if (u + G < 2048) GC_LOAD(u + G);
        f32x16 o = {};
        {
#pragma unroll
          for (int s = 0; s < 4; ++s) { const bf16x8 af = sfr[s]; const bf16x8 bq = *(const LAS bf16x8*)(lds + GL_Q1 + (32 * tb + r32) * 144 + (16 * s + 8 * hh) * 2);
              o = __builtin_amdgcn_mfma_f32_32x32x16_bf16(af, bq, o, 0, 0, 0); } }
#pragma unroll
        for (int sb = 0; sb < 2; ++sb) {
            if (sb <= tb) {
                f32x16 pt = {};
#pragma unroll
                for (int s = 0; s < 4; ++s) { const bf16x8 ak = *(const LAS bf16x8*)(lds + GL_K2 + (32 * sb + r32) * 144 + (16 * s + 8 * hh) * 2); const bf16x8 bq = *(const LAS bf16x8*)(lds + GL_Q2 + (32 * tb + r32) * 144 + (16 * s + 8 * hh) * 2);
                    pt = __builtin_amdgcn_mfma_f32_32x32x16_bf16(ak, bq, pt, 0, 0, 0); }
                if (sb == tb) {
#pragma unroll
                    for (int r = 0; r < 16; ++r) { const int s_ = (r & 3) + 8 * (r >> 2) + 4 * hh; if (s_ > r32) pt[r] = 0.f; }
                }
#pragma unroll
                for (int ks = 0; ks < 2; ++ks) {
                    const bf16x8 pa = pack8(pt, 8 * ks);
                    const bf16x8 vf = tr_frag(lds + GL_V + (32 * sb + 16 * ks + 4 * hh + trow) * 320 + (32 * dvb + tcol) * 2, 8 * 320);
                    o = __builtin_amdgcn_mfma_f32_32x32x16_bf16(vf, pa, o, 0, 0, 0);
                }
            }
        }
        float ss = 0.f;
#pragma unroll
        for (int r = 0; r < 16; ++r) ss += o[r] * o[r];
        ss += __shfl_xor(ss, 32);
        LAS float* sq = (LAS float*)(lds + GL_SSQ);
        if (hh == 0) sq[dvb * 64 + 32 * tb + r32] = ss;
        __syncthreads();
        const int t = 32 * tb + r32;
        const float tot = (sq[t] + sq[64 + t]) + (sq[128 + t] + sq[192 + t]);
        const float rs = rsqrtf(tot * (1.0f / 128.0f) + EPS);
#pragma unroll
        for (int g = 0; g < 4; ++g) {
            const int dv = 32 * dvb + 8 * g + 4 * hh;
            const f32x4 gn = gnr[g];
            const v2u gg = *(const LAS v2u*)(lds + GL_GG + t * 272 + dv * 2);
            const float g0 = bf2f((bf16)(gg.x & 0xffff)), g1 = bf2f((bf16)(gg.x >> 16)), g2 = bf2f((bf16)(gg.y & 0xffff)), g3 = bf2f((bf16)(gg.y >> 16));
            const float v0 = o[4 * g] * rs * gn.x * g0 * __builtin_amdgcn_rcpf(1.f + __expf(-g0)), v1 = o[4 * g + 1] * rs * gn.y * g1 * __builtin_amdgcn_rcpf(1.f + __expf(-g1));
            const float v2 = o[4 * g + 2] * rs * gn.z * g2 * __builtin_amdgcn_rcpf(1.f + __expf(-g2)), v3 = o[4 * g + 3] * rs * gn.w * g3 * __builtin_amdgcn_rcpf(1.f + __expf(-g3));
            v2u w; w.x = cvtpk(v0, v1); w.y = cvtpk(v2, v3);
            *(LAS v2u*)(lds + GL_YST + t * 272 + dv * 2) = w;
        }
        __syncthreads();
#pragma unroll
        for (int i = 0; i < 2; ++i) { const int idx = tid + NTHR * i, tr_ = idx >> 4, ch = idx & 15;
            st_b128(y + (tok0 + tr_) * DM + 512 + h * 128 + ch * 8, *(const LAS v4u*)(lds + GL_YST + tr_ * 272 + ch * 16)); }
    }
#undef GC_LOAD
}
__device__ __forceinline__ void fox_cumsum_phase(const P& p, int l, LAS unsigned char* lds, int vcu, int G) {
    int tid = threadIdx.x; asm volatile("" : "+v"(tid));
    const int lane = tid & 63, wave = __builtin_amdgcn_readfirstlane(tid >> 6);
    const float* sm = WSP(float, WS_SM); float* cb = WSP(float, WS_CB);
    LAS float* tot = (LAS float*)(lds + 256);
    for (int u = vcu; u < NBATCH * 8; u += G) {
        const int b = u >> 3, h = u & 7;
        const float bias = p.b_forget[l * 8 + h];
        const int s0 = wave * 256 + lane * 4;
        float v[4]; float run = 0.f;
#pragma unroll
        for (int j = 0; j < 4; ++j) v[j] = sm[((size_t)b * SEQ + s0 + j) * 32 + h];
#pragma unroll
        for (int j = 0; j < 4; ++j) { run += fast_log_sigmoid(v[j] + bias); v[j] = run; }
        float pre = run;
#pragma unroll
        for (int o = 1; o < 64; o <<= 1) { const float t = __shfl_up(pre, o); if (lane >= o) pre += t; }
        __syncthreads();
        if (lane == 63) tot[wave] = pre;
        __syncthreads();
        float base = pre - run;
#pragma unroll
        for (int w_ = 0; w_ < 8; ++w_) { const float t = tot[w_]; if (w_ < wave) base += t; }
        f32x4 o4; o4.x = -(v[0] + base) * LOG2E; o4.y = -(v[1] + base) * LOG2E; o4.z = -(v[2] + base) * LOG2E; o4.w = -(v[3] + base) * LOG2E;
        *(f32x4*)(cb + ((size_t)b * 8 + h) * SEQ + s0) = o4;
    }
}
__device__ __forceinline__ void fox_knorm_phase(const P& p, int vcu, int G) {
    int tid = threadIdx.x; asm volatile("" : "+v"(tid));
    const int lane = tid & 63, wave = __builtin_amdgcn_readfirstlane(tid >> 6);
    const bf16* proj = WSP(bf16, WS_PROJ); float* kn = WSP(float, WS_MOE + MO_KN);
    for (int task = vcu * NWAVES + wave; task < NBATCH * 8 * 32; task += G * NWAVES) {
        const int j = task & 31, h = (task >> 5) & 7, b = task >> 8;
        float mx = 0.f;
#pragma unroll
        for (int i = 0; i < 8; ++i) {
            const v4u w = *(const v4u*)(proj + ((size_t)b * SEQ + j * 64 + i * 8 + (lane >> 3)) * PW + C_FK + h * 64 + (lane & 7) * 8);
            const unsigned ww[4] = {w.x, w.y, w.z, w.w}; float ss = 0.f;
#pragma unroll
            for (int e = 0; e < 4; ++e) { const float a = __builtin_bit_cast(float, ww[e] << 16), c = __builtin_bit_cast(float, ww[e] & 0xffff0000u); ss += a * a + c * c; }
            ss += __shfl_xor(ss, 1); ss += __shfl_xor(ss, 2); ss += __shfl_xor(ss, 4);
            mx = fmaxf(mx, ss);
        }
        mx = wave_max(mx);
        if (lane == 0) kn[task] = sqrtf(mx) * 1.0001f;
    }
}
__device__ __forceinline__ void router_weights(const P& p, int gtid, int gstride) {
    for (int idx = gtid; idx < NLAYER * 32768; idx += gstride) {
        const int l = idx >> 15, r = idx & 32767, k = r >> 5, n = r & 31;
        float v = 0.f;
        if (n < 16) v = p.w_re[((size_t)l * DM + k) * 16 + n]; else if (n < 20) v = p.w_rg[((size_t)l * DM + k) * 4 + (n - 16)];
        v *= p.moe_norm[l * DM + k];
        float* wr = (float*)(ws_base(p.ws) + WS_W + (size_t)l * WS_WLAYER + WO_RHI);
        wr[((((k >> 5) * 4 + ((k >> 3) & 3)) * 2 + ((k >> 2) & 1)) * 32 + n) * 4 + (k & 3)] = v;
    }
}
__device__ __forceinline__ void route_phase(const P& p, int l, LAS unsigned char* lds, int t0, int tstep) {
    int tid = threadIdx.x; asm volatile("" : "+v"(tid));
    const int lane = tid & 63, wave = __builtin_amdgcn_readfirstlane(tid >> 6);
    { const v4u* src = (const v4u*)(ws_base(p.ws) + WS_W + (size_t)l * WS_WLAYER + WO_RHI);
#pragma unroll 4
      for (int i = 0; i < 16; ++i) *(LAS v4u*)(lds + LDS_STAGE + (tid + NTHR * i) * 16) = src[tid + NTHR * i]; }
    LAS int* hist = (LAS int*)(lds + LDS_GATE);
    LAS int* tokj = hist + 32; LAS f32x2_t* tokgl = (LAS f32x2_t*)(hist + 160); LAS int* basej = hist + 416;
    const bf16* HBp = WSP(const bf16, WS_HB);
    int* gcnt = WSP(int, WS_MOE + MO_GCNT) + l * 32; int* rowtok2 = WSP(int, WS_RT2); f32x2_t* rowg2 = WSP(f32x2_t, WS_RG2);
    LAS float* lgb = (LAS float*)(lds + LDS_RS + wave * 2048);
    const int r = lane & 15, kq = lane >> 4;
    for (int task0 = t0; task0 < NTOK / 16; task0 += tstep) {
        if (tid < 32) hist[tid] = 0;
        __syncthreads();
        const int tok0 = (task0 + wave) * 16;
        const v4u* hp = (const v4u*)(HBp + (size_t)(tok0 + r) * DM + 8 * kq);
        f32x4 acc0 = {0.f, 0.f, 0.f, 0.f}, acc1 = {0.f, 0.f, 0.f, 0.f}; float q = 0.f;
#pragma unroll 8
        for (int s = 0; s < 32; ++s) {
            const v4u aw = hp[4 * s];
            const unsigned ww[4] = {aw.x, aw.y, aw.z, aw.w};
            const LAS unsigned char* bp = lds + LDS_STAGE + ((s * 4 + kq) * 2 * 32 + r) * 16;
            const f32x4 b00 = *(const LAS f32x4*)(bp), b01 = *(const LAS f32x4*)(bp + 32 * 16), b10 = *(const LAS f32x4*)(bp + 16 * 16), b11 = *(const LAS f32x4*)(bp + 48 * 16);
#pragma unroll
            for (int e = 0; e < 4; ++e) {
                const float a0 = __builtin_bit_cast(float, ww[e] << 16), a1 = __builtin_bit_cast(float, ww[e] & 0xffff0000u);
                q += a0 * a0 + a1 * a1;
                const f32x4& bl = e < 2 ? b00 : b01; const f32x4& bh = e < 2 ? b10 : b11;
                acc0 = __builtin_amdgcn_mfma_f32_16x16x4f32(a0, bl[(2 * e) & 3], acc0, 0, 0, 0); acc1 = __builtin_amdgcn_mfma_f32_16x16x4f32(a0, bh[(2 * e) & 3], acc1, 0, 0, 0);
                acc0 = __builtin_amdgcn_mfma_f32_16x16x4f32(a1, bl[(2 * e + 1) & 3], acc0, 0, 0, 0); acc1 = __builtin_amdgcn_mfma_f32_16x16x4f32(a1, bh[(2 * e + 1) & 3], acc1, 0, 0, 0);
            }
        }
        q += __shfl_xor(q, 16); q += __shfl_xor(q, 32);
        const float rsv = rsqrtf(q * (1.0f / DM) + EPS);
        const float bias0 = p.b_re[l * 16 + r], bias1 = r < 4 ? p.b_rg[l * 4 + r] : 0.f;
#pragma unroll
        for (int g = 0; g < 4; ++g) { const int row = 4 * kq + g; const float rs = __shfl(rsv, row);
            lgb[row * 32 + r] = acc0[g] * rs + bias0; lgb[row * 32 + 16 + r] = acc1[g] * rs + bias1; }
        LDS_WAIT();
        if (lane < 16) {
            const int tok = tok0 + lane;
            const LAS f32x4* lr = (const LAS f32x4*)(lgb + lane * 32);
            const f32x4 e0 = lr[0], e1 = lr[1], e2 = lr[2], e3 = lr[3], gl = lr[4];
            int g = 0; float gm = gl.x;
            if (gl.y > gm) { gm = gl.y; g = 1; } if (gl.z > gm) { gm = gl.z; g = 2; } if (gl.w > gm) { gm = gl.w; g = 3; }
            const float den = (expf(gl.x - gm) + expf(gl.y - gm)) + (expf(gl.z - gm) + expf(gl.w - gm));
            const float pg = 1.0f / den;
            const f32x4 el = g == 0 ? e0 : (g == 1 ? e1 : (g == 2 ? e2 : e3));
            int i0 = 0; float m0 = el.x;
            if (el.y > m0) { m0 = el.y; i0 = 1; } if (el.z > m0) { m0 = el.z; i0 = 2; } if (el.w > m0) { m0 = el.w; i0 = 3; }
            int i1 = -1; float m1 = -INFINITY;
            if (i0 != 0 && el.x > m1) { m1 = el.x; i1 = 0; } if (i0 != 1 && el.y > m1) { m1 = el.y; i1 = 1; }
            if (i0 != 2 && el.z > m1) { m1 = el.z; i1 = 2; } if (i0 != 3 && el.w > m1) { m1 = el.w; i1 = 3; }
            const float ex = expf(m1 - m0), inv = 1.0f / (1.0f + ex);
            const int elo = i0 < i1 ? i0 : i1, ehi = i0 < i1 ? i1 : i0;
            const int j = g * 8 + (elo == 0 ? ehi - 1 : (elo == 1 ? ehi + 1 : 5));
            const float g0 = pg * inv, g1 = pg * ex * inv;
            tokj[wave * 16 + lane] = j; tokgl[wave * 16 + lane] = i0 < i1 ? (f32x2_t){g0, g1} : (f32x2_t){g1, g0};
            atomicAdd((int*)&hist[j], 1);
        }
        __syncthreads();
        if (tid < 32) { const int n = hist[tid]; basej[tid] = n > 0 ? atomicAdd(&gcnt[tid], n) : 0; }
        __syncthreads();
        if (wave == 0) {
            int run[32];
#pragma unroll
            for (int x = 0; x < 32; ++x) run[x] = 0;
#pragma unroll 1
            for (int half = 0; half < 2; ++half) {
                const int t = half * 64 + lane, j = tokj[t];
                int rank = 0;
#pragma unroll
                for (int x = 0; x < 32; ++x) { if ((x & 7) >= 6) continue; const unsigned long long mk = __ballot(j == x); if (j == x) rank = run[x] + __popcll(mk & ((1ull << lane) - 1ull)); run[x] += __popcll(mk); }
                const int pos = basej[j] + rank;
                rowtok2[(size_t)j * BCAP + pos] = task0 * 16 + t; rowg2[(size_t)j * BCAP + pos] = tokgl[t];
            }
        }
    }
}
__device__ __forceinline__ int moe_tables(const P& p, int l, LAS unsigned char* lds) {
    int tid = threadIdx.x; asm volatile("" : "+v"(tid));
    LAS int* mt = (LAS int*)(lds + LDS_MOET);
    const int* gcnt = WSP(const int, WS_MOE + MO_GCNT) + l * 32;
    if (tid < 32) mt[tid] = gcnt[tid];
    __syncthreads();
    if (tid == 0) { int t = 0; for (int j = 0; j < 32; ++j) { mt[32 + j] = t; t += (mt[j] + 255) >> 8; } mt[64] = t; }
    __syncthreads();
    if (tid < MAXTILES) { int j = 0;
        for (int x = 1; x < 32; ++x) if (mt[32 + x] <= tid) j = x;
        const int g = j >> 3, pi = j & 7, elo = pi < 3 ? 0 : (pi < 5 ? 1 : 2), ehi = pi < 3 ? pi + 1 : (pi < 5 ? pi - 1 : 3);
        mt[96 + tid] = j | ((g * 4 + elo) << 8) | ((g * 4 + ehi) << 16); }
    __syncthreads();
    return __builtin_amdgcn_readfirstlane(mt[64]);
}
__device__ __forceinline__ void final_phase(const P& p, int vcu, int G) {
    int tid = threadIdx.x; asm volatile("" : "+v"(tid));
    const int lane = tid & 63, wave = __builtin_amdgcn_readfirstlane(tid >> 6);
    const float* ssq = WSP(const float, WS_SSQ); const bf16* hb = WSP(const bf16, WS_HB);
    f32x4 g[4];
#pragma unroll
    for (int j = 0; j < 4; ++j) g[j] = ((const f32x4*)p.final_norm)[lane + 64 * j];
    for (int m0 = (vcu * NWAVES + wave) * 4; m0 < NTOK; m0 += G * NWAVES * 4) {
        v2u w[4][4]; float rs[4];
#pragma unroll
        for (int r = 0; r < 4; ++r) { rs[r] = row_rs(ssq, m0 + r);
#pragma unroll
            for (int j = 0; j < 4; ++j) w[r][j] = ((const v2u*)(hb + (size_t)(m0 + r) * DM))[lane + 64 * j]; }
#pragma unroll
        for (int r = 0; r < 4; ++r) { f32x4* s = (f32x4*)(p.out + (size_t)(m0 + r) * DM) + lane;
#pragma unroll
            for (int j = 0; j < 4; ++j) { f32x4 v; v.x = __builtin_bit_cast(float, w[r][j].x << 16); v.y = __builtin_bit_cast(float, w[r][j].x & 0xffff0000u); v.z = __builtin_bit_cast(float, w[r][j].y << 16); v.w = __builtin_bit_cast(float, w[r][j].y & 0xffff0000u);
                s[64 * j] = v * rs[r] * g[j]; } }
    }
}
#ifndef ENMASK
#define ENMASK 0xffffffffu
#endif
#define EN(b) (((ENMASK) >> (b)) & 1u)
#ifndef REPMASK
#define REPMASK 0u
#endif
#define REPN(b) ((((REPMASK) >> (b)) & 1u) ? 2 : 1)
__device__ __attribute__((noinline)) void grid_barrier(unsigned* barw, unsigned x, volatile LAS unsigned* st) { XcdBarrier b; b.bar = barw; b.x = x; b.st = st; xcd_barrier(b); }
__device__ __attribute__((noinline)) void pair_sync(unsigned* flag, unsigned* barw, int same) {
    asm volatile("s_waitcnt vmcnt(0)" ::: "memory");
    __syncthreads();
    if (threadIdx.x == 0) {
        __builtin_amdgcn_s_waitcnt(0);
        if (!same) { __builtin_amdgcn_fence(__ATOMIC_RELEASE, "agent"); asm volatile("s_waitcnt vmcnt(0)" ::: "memory"); }
        (void)xb_add(flag, 1u);
        XB_SPIN(xb_ld(flag) < 2u, barw);
        __builtin_amdgcn_fence(__ATOMIC_ACQUIRE, "agent");
        asm volatile("s_waitcnt vmcnt(0)" ::: "memory");
    }
    __syncthreads();
}
__global__ void __launch_bounds__(NTHR, 2) fwd(Args args) {
    extern __shared__ __attribute__((aligned(16))) unsigned char lds_raw[];
    LAS unsigned char* lds = (LAS unsigned char*)lds_raw;
    const P& p = args.p;
    const int tid = threadIdx.x, lane = tid & 63, wave = __builtin_amdgcn_readfirstlane(tid >> 6);
    const int G = gridDim.x; const int bx = blockIdx.x; const int vcu = (G % 8 == 0) ? (bx % 8) * (G / 8) + bx / 8 : bx;
    volatile LAS unsigned* MISC = (volatile LAS unsigned*)(lds + LDS_MISC);
    if (tid < 64) MISC[tid] = 0u;
    __syncthreads();
    unsigned* ctl = (unsigned*)(p.ws + WS_CTL);
    const int lo = args.ph_lo, hi = args.ph_hi;
    XcdBarrier bar; bar.bar = ctl + CW_BAR + args.li * XCD_BAR_WORDS; bar.x = 0; bar.st = nullptr;
    if (hi - lo > 1) bar = xcd_barrier_post(ctl + CW_BAR + args.li * XCD_BAR_WORDS, MISC);
    if (tid == 0) __hip_atomic_store(ctl + CW_XID + vcu, xb_xcc_id(), __ATOMIC_RELAXED, __HIP_MEMORY_SCOPE_AGENT);
#define IN(k) (lo <= (k) && (k) < hi)
#define PHL int vcuL = vcu, GL = G, bxL = bx; asm volatile("" : "+s"(vcuL), "+s"(GL), "+s"(bxL)); (void)vcuL; (void)GL; (void)bxL;
#define LTID(v) int v = threadIdx.x; asm volatile("" : "+v"(v))
#define FILL_RS_DENSE() do { LTID(tq); const int rr_ = tq & 255, hf_ = tq >> 8; f32x4 sv_[4][4]; bool ok_[4]; \
        _Pragma("unroll") for (int k_ = 0; k_ < 4; ++k_) { pg8::Unit u_ = {0, 0, 0}; ok_[k_] = S.next(hf_ + 2 * k_, u_); const f32x4* sp_ = (const f32x4*)(SSQ + (size_t)(ok_[k_] ? u_.pm * 256 + rr_ : 0) * 16); \
            _Pragma("unroll") for (int j_ = 0; j_ < 4; ++j_) sv_[k_][j_] = sp_[j_]; } \
        _Pragma("unroll") for (int k_ = 0; k_ < 4; ++k_) if (ok_[k_]) { const f32x4 a_ = (sv_[k_][0] + sv_[k_][1]) + (sv_[k_][2] + sv_[k_][3]); rstab[(hf_ + 2 * k_) * 256 + rr_] = rsqrtf(((a_.x + a_.y) + (a_.z + a_.w)) * (1.0f / DM) + EPS); } } while (0)
#define MOE_ROW(k_) pg8::Unit u_ = {0, 0, 0}; ok_[k_] = S.next(hf_ + 2 * k_, u_); const int j_ = u_.e & 255, sl_ = (u_.pm - moet[32 + j_]) * 256 + rr_; const bool v_ = ok_[k_] && sl_ < moet[j_]; \
        const size_t ix_ = (size_t)j_ * BCAP + (v_ ? sl_ : 0);
#define FILL_GU() do { LTID(tq); const int rr_ = tq & 255, hf_ = tq >> 8; f32x4 sv_[4][4]; bool ok_[4]; int tk_[4]; float gt_[4]; \
        _Pragma("unroll") for (int k_ = 0; k_ < 4; ++k_) { MOE_ROW(k_) const int t_ = RT2[ix_]; const f32x2_t g2_ = RG2[ix_]; tk_[k_] = v_ ? t_ : -1; gt_[k_] = v_ ? (u_.pn < 4 ? g2_.x : g2_.y) : 0.f; } \
        _Pragma("unroll") for (int k_ = 0; k_ < 4; ++k_) { tk_[k_] = tk_[k_] < 0 ? 0 : tk_[k_]; const f32x4* sp_ = (const f32x4*)(SSQ + (size_t)tk_[k_] * 16); \
            _Pragma("unroll") for (int j_ = 0; j_ < 4; ++j_) sv_[k_][j_] = sp_[j_]; } \
        _Pragma("unroll") for (int k_ = 0; k_ < 4; ++k_) if (ok_[k_]) { const f32x4 a_ = (sv_[k_][0] + sv_[k_][1]) + (sv_[k_][2] + sv_[k_][3]); rowtab[(hf_ + 2 * k_) * 256 + rr_] = tk_[k_]; gatetab[(hf_ + 2 * k_) * 256 + rr_] = gt_[k_]; \
            rstab[(hf_ + 2 * k_) * 256 + rr_] = rsqrtf(((a_.x + a_.y) + (a_.z + a_.w)) * (1.0f / DM) + EPS); } } while (0)
#define FILL_DOWN() do { LTID(tq); const int rr_ = tq & 255, hf_ = tq >> 8; bool ok_[4]; int tk_[4]; \
        _Pragma("unroll") for (int k_ = 0; k_ < 4; ++k_) { MOE_ROW(k_) const int t_ = RT2[ix_]; tk_[k_] = v_ ? t_ : -1; } \
        _Pragma("unroll") for (int k_ = 0; k_ < 4; ++k_) if (ok_[k_]) { rowtab[(hf_ + 2 * k_) * 256 + rr_] = tk_[k_]; } } while (0)

#define SEAM(k) do { if (IN(k) && IN((k) + 1)) { grid_barrier(bar.bar, bar.x, bar.st); if (REPN(20) == 2) grid_barrier(bar.bar, bar.x, bar.st); } } while (0)
    LAS float* rstab = (LAS float*)(lds + LDS_RS); LAS int* rowtab = (LAS int*)(lds + LDS_ROWTOK); LAS float* gatetab = (LAS float*)(lds + LDS_GATE); const LAS int* moet = (const LAS int*)(lds + LDS_MOET);
#define HB WSP(bf16, WS_HB)
#define PROJ WSP(bf16, WS_PROJ)
#define Y WSP(bf16, WS_Y)
#define XKV WSP(bf16, WS_XKV)
#define MEMN WSP(bf16, WS_MEMN)
#define SSQ WSP(float, WS_SSQ)
#define XQ WSP(bf16, WS_XQ)
#define U WSP(bf16, WS_U)
#define RT2 WSP(const int, WS_RT2)
#define RG2 WSP(const f32x2_t, WS_RG2)
#define H (p.out)
#define HB8 ((unsigned char*)p.out + 64 * MiB)
#define U8 WSP(unsigned char, WS_U)

    if (EN(0) && IN(PH_PRO)) _Pragma("unroll 1") for (int rep_ = 0; rep_ < REPN(0); ++rep_) { PHL prologue(p, lds, vcuL, GL, wave, lane); }
    SEAM(PH_PRO);
    if (REPN(18) == 2 && IN(PH_XKV)) { PHL
        pg8::StaticOrder S; S.init(HB, ws_base(p.ws) + WS_W + WO_IN, NTOK, 3072, DM, GL, bxL);
        FILL_RS_DENSE();
        __syncthreads();
        EpiBf16<true> E{PROJ, PW, rstab};
        pg8::gemm_phase<DM, EpiBf16<true>, pg8::StaticOrder, true>(lds + LDS_STAGE, S, E);
    }
    for (int l = 0; l < NLAYER; ++l) {
        const int pb = PH_L0 + l * NPH;
        unsigned char* wl = ws_base(p.ws) + WS_W + (size_t)l * WS_WLAYER;
        if (EN(2) && IN(pb + LP_INPROJ)) _Pragma("unroll 1") for (int rep_ = 0; rep_ < REPN(2); ++rep_) { PHL
            pg8::StaticOrder S; S.init(HB, wl + WO_IN, NTOK, 3072, DM, GL, bxL);
            FILL_RS_DENSE();
            __syncthreads();
            EpiBf16<true> E{PROJ, PW, rstab};
            pg8::gemm_phase<DM, EpiBf16<true>, pg8::StaticOrder, true>(lds + LDS_STAGE, S, E);
            _Pragma("unroll 1") for (int r2_ = 0; r2_ < REPN(19); ++r2_) small_proj(p, l, lds + LDS_STAGE, vcuL, GL, wave, lane);
        }
        SEAM(pb + LP_INPROJ);
        if (EN(11) && IN(pb + LP_MIXA)) _Pragma("unroll 1") for (int rep_ = 0; rep_ < REPN(11); ++rep_) { PHL gla_phase_a(p, l, lds + LDS_STAGE, vcuL, GL); fox_cumsum_phase(p, l, lds + LDS_STAGE, vcuL, GL); fox_knorm_phase(p, vcuL, GL); }
        SEAM(pb + LP_MIXA);
        if (EN(12) && IN(pb + LP_MIXB)) _Pragma("unroll 1") for (int rep_ = 0; rep_ < REPN(12); ++rep_) { PHL gla_phase_b(p, vcuL, GL); }
        if (EN(1) && l == 0 && IN(pb + LP_MIXB)) { PHL
            pg8::StaticOrder S; S.init(MEMN, ws_base(p.ws) + WS_WXKV, 4096, 2048, DM, GL, bxL);
            EpiBf16<false> E{XKV, 2048, rstab};
            pg8::gemm_phase<DM, EpiBf16<false>, pg8::StaticOrder, true>(lds + LDS_STAGE, S, E);
        }
        SEAM(pb + LP_MIXB);
        if (EN(9) && IN(pb + LP_MIXC)) { PHL _Pragma("unroll 1") for (int rep_ = 0; rep_ < REPN(16); ++rep_) fox_phase(p, l, lds + LDS_STAGE, vcuL, GL); _Pragma("unroll 1") for (int rep_ = 0; rep_ < REPN(17); ++rep_) gla_phase_c(p, l, lds + LDS_STAGE, vcuL, GL); }
        SEAM(pb + LP_MIXC);
        if (IN(pb + LP_WOUT)) { PHL
            const int side = vcuL & 1;
            const int same = (int)((unsigned)__builtin_amdgcn_readfirstlane((int)xb_ld(ctl + CW_XID + (vcuL ^ 1))) == xb_xcc_id());
            for (int pm = vcuL >> 1; pm < NTOK / 256; pm += GL >> 1) {
                unsigned* pf = ctl + CW_PF + ((l * 3) * 128 + pm) * 16;
                { pg8::PairOrder S{(const char*)Y, (const char*)(wl + WO_OUT), DM, pm, 2 * side, 2};
                  EpiRes<0> E{HB, SSQ, rowtab, 1.f, nullptr};
                  pg8::gemm_phase<DM, EpiRes<0>, pg8::PairOrder, true>(lds + LDS_STAGE, S, E); }
                pair_sync(pf, bar.bar, same);
                { pg8::PairOrder S{(const char*)HB, (const char*)(wl + WO_XQ), DM, pm, side, 1};
                  FILL_RS_DENSE();
                  __syncthreads();
                  EpiBf16<true> E{XQ, 512, rstab};
                  pg8::gemm_phase<DM, EpiBf16<true>, pg8::PairOrder, true>(lds + LDS_STAGE, S, E);
                  asm volatile("s_waitcnt vmcnt(0)" ::: "memory"); __syncthreads();
                  xattn_pair(p, l, lds + LDS_STAGE, pm, side, false); }
                pair_sync(pf + 128 * 16, bar.bar, same);
                { pg8::PairOrder S{(const char*)WSP(unsigned char, WS_XO8), (const char*)(wl + WO_XO), 256, pm, 2 * side, 2};
                  EpiRes<0, true> E{HB, SSQ, rowtab, 1.f, HB8};
                  pg8::gemm_phase<256, EpiRes<0, true>, pg8::PairOrder, true, true, 127, 122>(lds + LDS_STAGE, S, E); }
                pair_sync(pf + 2 * 128 * 16, bar.bar, same);
                route_phase(p, l, lds, (pm * 2 + side) * NWAVES, NTOK);
            }
        }
        SEAM(pb + LP_ROUTE);
        if (EN(6) && IN(pb + LP_GU)) { PHL
            const int T_ = moe_tables(p, l, lds);
            _Pragma("unroll 1") for (int rep_ = 0; rep_ < REPN(6); ++rep_) {
            MoeOrder<0> S{(const char*)HB8, (const char*)(wl + WO_GU), 512, (size_t)1024 * 1024, T_, GL, vcuL, moet + 96, rowtab};
            __syncthreads();
            FILL_GU();
            __syncthreads();
            EpiGU E{U8, rstab, gatetab};
            pg8::gemm_phase<512, EpiGU, MoeOrder<0>, true, true, 127, 122>(lds + LDS_STAGE, S, E);
            }
        }
        SEAM(pb + LP_GU);
        if (EN(8) && IN(pb + LP_DOWN1)) { PHL
            const int T_ = IN(pb + LP_GU) ? __builtin_amdgcn_readfirstlane(moet[64]) : moe_tables(p, l, lds);
            MoeOrder<1> S{(const char*)U8, (const char*)(wl + WO_D), 512, (size_t)1024 * 512, T_, GL, vcuL, moet + 96, rowtab};
            __syncthreads();
            FILL_DOWN();
            __syncthreads();
            EpiRes<2> E{HB, SSQ, rowtab, 1.f, nullptr};
            pg8::gemm_phase<512, EpiRes<2>, MoeOrder<1>, true, true, 125, 122, 256, true>(lds + LDS_STAGE, S, E);
        }
        SEAM(pb + LP_DOWN1);
    }
    if (EN(15) && IN(PH_FINAL)) _Pragma("unroll 1") for (int rep_ = 0; rep_ < REPN(15); ++rep_) { PHL final_phase(p, vcuL, GL); }
#undef IN
#undef SEAM
#undef HB
#undef PROJ
#undef Y
#undef XKV
#undef MEMN
#undef SSQ
#undef XQ
#undef U
#undef RT2
#undef RG2
#undef H
#undef HB8
#undef U8
}

static int g_grid = 0;
static void launch_fast(const P& p, int lo, int hi, int& li, hipStream_t stream) {
    Args a{}; a.p = p; a.ph_lo = lo; a.ph_hi = hi; a.li = li++; a.pad = 0;
    hipLaunchKernelGGL(fwd, dim3(g_grid), dim3(NTHR), LDS_BYTES, stream, a);
    const hipError_t le = hipPeekAtLastError();
    if (le != hipSuccess) fprintf(stderr, "kernel_launch: fwd launch [%d,%d) failed: %s\n", lo, hi, hipGetErrorName(le));
}
extern "C" void kernel_launch(void* const* d_in, const int* in_sizes, int n_in, void* d_out, int out_size, void* d_ws, size_t ws_size, hipStream_t stream) {
    if (n_in != 25 || out_size != NTOK * DM || ws_size < WS_END2) { fprintf(stderr, "kernel_launch: unexpected sizes n_in %d out %d ws %zu (need %zu)\n", n_in, out_size, ws_size, (size_t)WS_END2); return; }
    if (g_grid == 0) {
        int dev = 0, cus = 0, per_cu = 0;
        if (hipGetDevice(&dev) != hipSuccess || hipDeviceGetAttribute(&cus, hipDeviceAttributeMultiprocessorCount, dev) != hipSuccess) { g_grid = -1; return; }
        if (hipFuncSetAttribute((const void*)fwd, hipFuncAttributeMaxDynamicSharedMemorySize, LDS_BYTES) != hipSuccess) { fprintf(stderr, "kernel_launch: hipFuncSetAttribute failed\n"); g_grid = -1; return; }
        if (hipOccupancyMaxActiveBlocksPerMultiprocessor(&per_cu, (const void*)fwd, NTHR, LDS_BYTES) != hipSuccess || per_cu < 1) { fprintf(stderr, "kernel_launch: occupancy query says %d\n", per_cu); }
        (void)hipGetLastError();
        g_grid = cus & ~1;
    }
    if (g_grid < 0) return;
    P p{};
    const float** pp = (const float**)&p;
    for (int i = 0; i < 25; ++i) pp[i] = (const float*)d_in[i];
    p.out = (float*)d_out; p.ws = (unsigned char*)d_ws;
    if (hipMemsetAsync((char*)d_ws + WS_CTL + (size_t)CW_BAR * 4, 0, (size_t)XCD_BAR_WORDS * 4, stream) != hipSuccess) { fprintf(stderr, "kernel_launch: hipMemsetAsync failed\n"); return; }
    int li = 0;
    launch_fast(p, PH_PRO, PH_END, li, stream);
}
```

```cpp
#include <hip/hip_runtime.h>
#include <cstdio>
#include <cstdint>

constexpr int NTOK = 32768, DM = 1024, NBATCH = 16, SEQ = 2048, NLAYER = 2, MEML = 256;
constexpr int PW = 3072;
constexpr int C_FQ = 0, C_FK = 512, C_FV = 1024, C_GQ = 1536, C_GK = 1792, C_GV = 2048, C_GG = 2560;
constexpr int INW = 3096;
constexpr float EPS = 1e-6f, LOG2E = 1.4426950408889634f;
constexpr int MAXTILES = 288;
constexpr int MAXROWS = MAXTILES * 256;

typedef unsigned short bf16;
__device__ __forceinline__ unsigned f2bf(float f) { unsigned u = __builtin_bit_cast(unsigned, f); return (u + 0x7fffu + ((u >> 16) & 1u)) >> 16; }
__device__ __forceinline__ float bf2f(bf16 b) { return __builtin_bit_cast(float, ((unsigned)b) << 16); }

constexpr size_t MiB = 1u << 20;
constexpr size_t WS_CTL = 0;
constexpr size_t WS_W = 1 * MiB;
constexpr size_t WS_WLAYER = 59 * MiB;
constexpr size_t WS_WXKV = WS_W + 2 * WS_WLAYER;
constexpr size_t WS_HB = WS_WXKV + 4 * MiB;
constexpr size_t WS_PROJ = WS_HB + 64 * MiB;
constexpr size_t WS_XQ = WS_PROJ;
constexpr size_t WS_U = WS_PROJ + 32 * MiB;
constexpr size_t WS_XO8 = WS_U + 40 * MiB;
constexpr size_t WS_SM = WS_PROJ + 192 * MiB;
constexpr size_t WS_CB = WS_SM + 4 * MiB;
constexpr size_t WS_Y = WS_CB + 1 * MiB;
constexpr size_t WS_XKV = WS_Y + 64 * MiB;
constexpr size_t WS_MEMN = WS_XKV + 16 * MiB;
constexpr size_t WS_SSQ = WS_MEMN + 8 * MiB;
constexpr size_t WS_MOE = WS_SSQ + 2 * MiB;
constexpr size_t WS_END = WS_MOE + 2 * MiB;
static_assert(WS_END <= 512 * MiB, "workspace map");
constexpr size_t MO_TOKE = 0;
constexpr size_t MO_TOKG = 256 * 1024;
constexpr size_t MO_ROWTOK = 512 * 1024;
constexpr size_t MO_ROWGATE = 832 * 1024;
constexpr size_t MO_TILEE = 1152 * 1024;
constexpr size_t MO_NT = 1156 * 1024;
constexpr size_t MO_HIST = 1160 * 1024;
constexpr size_t MO_GCNT = 1160 * 1024;
constexpr int BCAP = 32768;
constexpr size_t MO_KN = 1280 * 1024;

struct P {
    const float *x, *mem, *mem_norm, *mix_norm, *w_in, *b_forget, *w_alpha_up, *b_alpha, *fox_gain, *gla_gain, *w_out, *cross_norm, *w_xq, *w_xk, *w_xv, *w_xo,
        *moe_norm, *w_rg, *b_rg, *w_re, *b_re, *w_eg, *w_eu, *w_ed, *final_norm;
    float* out; unsigned char* ws;
};
__host__ __device__ __forceinline__ unsigned char* ws_base(unsigned char* w) {
#if defined(__HIP_DEVICE_COMPILE__)
    size_t z = 0; asm volatile("" : "+s"(z));
    return w + z;
#else
    return w;
#endif
}
#define WSP(T, off) ((T*)(ws_base(p.ws) + (off)))

__device__ __forceinline__ float wave_sum(float v) {
#pragma unroll
    for (int o = 1; o < 64; o <<= 1) v += __shfl_xor(v, o);
    return v;
}
__device__ __forceinline__ float wave_min(float v) {
#pragma unroll
    for (int o = 1; o < 64; o <<= 1) v = fminf(v, __shfl_xor(v, o));
    return v;
}
__device__ __forceinline__ float wave_max(float v) {
#pragma unroll
    for (int o = 1; o < 64; o <<= 1) v = fmaxf(v, __shfl_xor(v, o));
    return v;
}
__device__ __forceinline__ float row_rs(const float* ssq, int row) {
    const float4* s = (const float4*)(ssq + (size_t)row * 16);
    float4 a = s[0], b = s[1], c = s[2], d = s[3];
    float t = ((a.x + a.y) + (a.z + a.w)) + ((b.x + b.y) + (b.z + b.w)) + ((c.x + c.y) + (c.z + c.w)) + ((d.x + d.y) + (d.z + d.w));
    return rsqrtf(t * (1.0f / DM) + EPS);
}
__device__ __forceinline__ float log_sigmoid(float z) { return fminf(z, 0.f) - log1pf(expf(-fabsf(z))); }
__device__ __forceinline__ float silu(float z) { return z / (1.f + expf(-z)); }

typedef unsigned st_v4u __attribute__((ext_vector_type(4)));
typedef unsigned st_v2u __attribute__((ext_vector_type(2)));
#ifndef WT_STORES
#define WT_STORES 0
#endif
__device__ __forceinline__ void st_b128(void* p, st_v4u v) {
#if WT_STORES
    asm volatile("global_store_dwordx4 %0, %1, off sc1\n\ts_nop 1" :: "v"(p), "v"(v) : "memory");
#else
    *(st_v4u*)p = v;
#endif
}
__device__ __forceinline__ void st_b128_wt(void* p, st_v4u v) { asm volatile("global_store_dwordx4 %0, %1, off sc1\n\ts_nop 1" :: "v"(p), "v"(v) : "memory"); }
__device__ __forceinline__ void st_b64(void* p, st_v2u v) {
#if WT_STORES
    asm volatile("global_store_dwordx2 %0, %1, off sc1" :: "v"(p), "v"(v) : "memory");
#else
    *(st_v2u*)p = v;
#endif
}
#define XB_TMO      128
#define XB_XCNT(j)  (256  + 64 * (j))
#define XB_XSUB(j)  (1280 + 64 * (j))
#define XB_XGEN(j)  (2304 + 64 * (j))
#define XB_TOP      3328
#define XB_TOPGEN   3392
#define XCD_BAR_WORDS 3456
#define XB_SPIN_CAP (1u << 18)
#define LAS __attribute__((address_space(3)))

__device__ __forceinline__ unsigned xb_ld(unsigned* p)              { return __hip_atomic_load(p, __ATOMIC_RELAXED, __HIP_MEMORY_SCOPE_AGENT); }
__device__ __forceinline__ unsigned xb_add(unsigned* p, unsigned v) { return __hip_atomic_fetch_add(p, v, __ATOMIC_RELAXED, __HIP_MEMORY_SCOPE_AGENT); }
__device__ __forceinline__ unsigned xb_xcc_id() { return (unsigned)__builtin_amdgcn_s_getreg((3 << 11) | 20) & 0xFu; }
#define XB_SPIN(cond, bar) do { unsigned _sp = 0; while (cond) { __builtin_amdgcn_s_sleep(1); \
    if ((++_sp & 255u) == 0u) { if (xb_ld(&(bar)[XB_TMO])) break; if (_sp > XB_SPIN_CAP) { atomicAdd(&(bar)[XB_TMO], 1u); break; } } } } while (0)

struct XcdBarrier {
    unsigned* bar; unsigned x;
    volatile LAS unsigned* st;
};

__device__ __forceinline__ XcdBarrier xcd_barrier_post(unsigned* bar, volatile LAS unsigned* st) {
    XcdBarrier b; b.bar = bar; b.x = xb_xcc_id(); b.st = st;
    if (threadIdx.x == 0) (void)xb_add(&bar[XB_XCNT(b.x)], 1u);
    return b;
}
__device__ __forceinline__ void xcd_barrier_complete(unsigned* bar, unsigned x, unsigned& nloc, unsigned& nx) {
    const unsigned G = gridDim.x * gridDim.y * gridDim.z;
    unsigned sum, cnt, mine, sp = 0u;
    for (;;) {
        sum = 0u; cnt = 0u; mine = 0u;
#pragma unroll
        for (unsigned j = 0; j < 16; ++j) { const unsigned c = xb_ld(&bar[XB_XCNT(j)]); sum += c; cnt += (c > 0u) ? 1u : 0u; mine = (j == x) ? c : mine; }
        if (sum == G) break;
        __builtin_amdgcn_s_sleep(1);
        if ((++sp & 255u) == 0u) { if (xb_ld(&bar[XB_TMO])) break; if (sp > XB_SPIN_CAP) { atomicAdd(&bar[XB_TMO], 1u); break; } }
    }
    nloc = mine > 0u ? mine : 1u; nx = cnt > 0u ? cnt : 1u;
}

__device__ __forceinline__ void xcd_barrier(const XcdBarrier& b) {
    asm volatile("s_waitcnt vmcnt(0)" ::: "memory");
    __syncthreads();
    if (threadIdx.x == 0) {
        unsigned* bar = b.bar;
        __builtin_amdgcn_s_waitcnt(0);
        unsigned nloc = b.st[0], nx = b.st[1];
        if (nloc == 0u) { xcd_barrier_complete(bar, b.x, nloc, nx); b.st[0] = nloc; b.st[1] = nx; }
        const unsigned old = xb_add(&bar[XB_XSUB(b.x)], 1u);
        const unsigned gen = old / nloc;
        if (old + 1u == (gen + 1u) * nloc) {
            __builtin_amdgcn_fence(__ATOMIC_RELEASE, "agent");
            asm volatile("s_waitcnt vmcnt(0)" ::: "memory");
            const unsigned og = xb_add(&bar[XB_TOP], 1u);
            const unsigned tg = og / nx;
            if (og + 1u == (tg + 1u) * nx) xb_add(&bar[XB_TOPGEN], 1u);
            else XB_SPIN(xb_ld(&bar[XB_TOPGEN]) == tg, bar);
            __builtin_amdgcn_fence(__ATOMIC_ACQUIRE, "agent");
            xb_add(&bar[XB_XGEN(b.x)], 1u);
            asm volatile("s_waitcnt vmcnt(0)" ::: "memory");
        } else {
            XB_SPIN(xb_ld(&bar[XB_XGEN(b.x)]) == gen, bar);
            __builtin_amdgcn_fence(__ATOMIC_ACQUIRE, "agent");
            asm volatile("s_waitcnt vmcnt(0)" ::: "memory");
        }
    }
    __syncthreads();
}

namespace pg8 {
#define PG8_LAS __attribute__((address_space(3)))
typedef unsigned short bf16_t;
typedef short bf16x8 __attribute__((ext_vector_type(8)));
typedef float f32x4 __attribute__((ext_vector_type(4)));
typedef unsigned u32x4 __attribute__((ext_vector_type(4)));
typedef unsigned u32x2 __attribute__((ext_vector_type(2)));
constexpr int BM = 256, BK = 64, HALF = 128, HTB = HALF * BK * 2, STAGE_BYTES = 8 * HTB, NXCD = 8, WGM = 8;

__host__ __device__ __forceinline__ int lds_byte(int r, int c) { const int st = (r >> 4) * 2 + (c >> 5), rr = r & 15, cc = c & 31, ob = rr * 64 + cc * 2; return st * 1024 + (ob ^ (((ob >> 9) & 1) << 5)); }
__host__ __device__ __forceinline__ void stage_rc(int b, int& R, int& C) { const int st = b / 1024, sb = b % 1024, swz = sb ^ (((sb >> 9) & 1) << 5); R = (st >> 1) * 16 + swz / 64; C = (st & 1) * 32 + (swz % 64) / 2; }
__host__ __device__ __forceinline__ int perm32(int rho) { const int n = rho >> 4, i = rho & 15; return 8 * (i >> 2) + 4 * n + (i & 3); }

struct Unit { int pm, pn, e; };

struct StaticOrder {
    static constexpr bool GATHER = false, SIGNAL = false, WAITS = false;
    static constexpr size_t KSTEP_A = 128;
    const char* A; const char* Bt; int K; int nM, nN, nwg, G, c;
    __device__ void init(const void* A_, const void* Bt_, int M, int N, int K_, int G_, int c_) { A = (const char*)A_; Bt = (const char*)Bt_; K = K_; nM = M / BM; nN = N / BM; nwg = nM * nN; G = G_; c = c_; }
    __device__ bool next(int i, Unit& u) const {
        const long L = (long)i * G + c; if (L >= nwg) return false;
        int wgid = (int)L; { const int q = nwg / NXCD, r = nwg % NXCD, xcd = wgid % NXCD, off = wgid / NXCD; wgid = (xcd < r ? xcd * (q + 1) : r * (q + 1) + (xcd - r) * q) + off; }
        const int nig = WGM * nN, gid = wgid / nig, fm = gid * WGM, gsz = (nM - fm) < WGM ? (nM - fm) : WGM;
        u.pm = fm + ((wgid % nig) % gsz); u.pn = (wgid % nig) / gsz; u.e = 0; return true;
    }
    __device__ __forceinline__ const char* a_base(const Unit& u) const { return A + (size_t)u.pm * (size_t)(BM * 2) * K; }
    __device__ __forceinline__ const char* b_base(const Unit& u) const { return Bt + (size_t)u.pn * (size_t)(BM * 2) * K; }
    __device__ __forceinline__ unsigned a_off(int, int, int, int) const { return 0u; }
};

struct PairOrder {
    static constexpr bool GATHER = false, SIGNAL = false, WAITS = false;
    static constexpr size_t KSTEP_A = 128;
    const char* A; const char* Bt; int K; int pm, pn0, n;
    __device__ bool next(int i, Unit& u) const { if (i >= n) return false; u.pm = pm; u.pn = pn0 + i; u.e = 0; return true; }
    __device__ __forceinline__ const char* a_base(const Unit& u) const { return A + (size_t)u.pm * (size_t)(BM * 2) * K; }
    __device__ __forceinline__ const char* b_base(const Unit& u) const { return Bt + (size_t)u.pn * (size_t)(BM * 2) * K; }
    __device__ __forceinline__ unsigned a_off(int, int, int, int) const { return 0u; }
};

__device__ __forceinline__ unsigned cvt_pk_bf16(float lo, float hi) { unsigned r; asm volatile("v_cvt_pk_bf16_f32 %0, %1, %2" : "=v"(r) : "v"(lo), "v"(hi)); return r; }

typedef int i32x8 __attribute__((ext_vector_type(8)));
typedef int i32x4 __attribute__((ext_vector_type(4)));
template <int K, class Epi, class Sched, bool ALIGN_EPI, bool FP8 = false, int SA = 127, int SB = 127, int KB = K, bool BSPLIT = false>
__device__ __forceinline__ void gemm_phase(PG8_LAS unsigned char* lds, const Sched& S, const Epi& E) {
    int tid_ = threadIdx.x; asm volatile("" : "+v"(tid_));
    const int tid = tid_, wid = __builtin_amdgcn_readfirstlane(tid >> 6), lane = tid & 63, wr = wid >> 2, wc = wid & 3, fr = lane & 15, fq = lane >> 4;
    constexpr int nt = K / BK;
    constexpr int NH = Sched::GATHER ? 2 : 1;
    unsigned voffB[2], cvA[NH][2], nvA[NH][2];
#pragma unroll
    for (int i = 0; i < 2; ++i) { int R, C; stage_rc(tid * 16 + i * 8192, R, C); const int Rb = Epi::PERM ? ((R & ~31) + perm32(R & 31)) : R;
        voffB[i] = (unsigned)(Rb * KB + C) * 2u;
        cvA[0][i] = nvA[0][i] = (unsigned)(R * K + C) * 2u; if constexpr (NH == 2) { cvA[NH - 1][i] = nvA[NH - 1][i] = cvA[0][i]; } }
    constexpr size_t kstep = (size_t)(BK * 2);
    constexpr size_t hstep = (size_t)HALF * K * 2;
    constexpr size_t hstepA = Sched::GATHER ? (size_t)0 : hstep;
    constexpr size_t hstepB = (size_t)HALF * KB * 2;
    constexpr size_t kstepA = Sched::KSTEP_A;
    const unsigned ldsw = (unsigned)wid * 1024u;
    const int aoff = lds_byte(wr * 64 + fr, fq * 8), boff = lds_byte(wc * 32 + fr, fq * 8);
#define PG8_SA(b, h) (((b) * 2 + (h)) * HTB)
#define PG8_SB(b, h) ((4 + (b) * 2 + (h)) * HTB)
#define PG8_STAGE(bufoff, gbase, voff) do { _Pragma("unroll") for (int _i = 0; _i < 2; ++_i) \
        __builtin_amdgcn_global_load_lds((const unsigned*)((const char*)(gbase) + (voff)[_i]), (PG8_LAS unsigned*)(lds + (bufoff) + ldsw + _i * 8192), 16, 0, 0); } while (0)
#define PG8_LD32(addr) __builtin_shufflevector(*(const PG8_LAS i32x4*)(addr), *(const PG8_LAS i32x4*)((addr) + 1024), 0, 1, 2, 3, 4, 5, 6, 7)
#define PG8_LDA(dst, b, h) do { _Pragma("unroll") for (int m = 0; m < 4; ++m) dst[m] = PG8_LD32(lds + PG8_SA(b, h) + aoff + m * 2048); } while (0)
#define PG8_LDB(dst, b, h) do { _Pragma("unroll") for (int n = 0; n < 2; ++n) dst[n] = PG8_LD32(lds + PG8_SB(b, h) + boff + n * 2048); } while (0)
#define PG8_H0(x) __builtin_bit_cast(bf16x8, __builtin_shufflevector((x), (x), 0, 1, 2, 3))
#define PG8_H1(x) __builtin_bit_cast(bf16x8, __builtin_shufflevector((x), (x), 4, 5, 6, 7))
#define PG8_MMA(ai, bj, At, Bt) do { __builtin_amdgcn_s_setprio(1); _Pragma("unroll") for (int m = 0; m < 4; ++m) _Pragma("unroll") for (int n = 0; n < 2; ++n) { \
        if constexpr (FP8) asm volatile("v_mfma_scale_f32_16x16x128_f8f6f4 %0, %1, %2, %0, %3, %4 op_sel_hi:[0,0,0]" : "+v"(acc[ai][bj][m][n]) : "v"(Bt[n]), "v"(At[m]), "v"(sbv), "v"(sav)); \
        else { acc[ai][bj][m][n] = __builtin_amdgcn_mfma_f32_16x16x32_bf16(PG8_H0(Bt[n]), PG8_H0(At[m]), acc[ai][bj][m][n], 0, 0, 0); \
               acc[ai][bj][m][n] = __builtin_amdgcn_mfma_f32_16x16x32_bf16(PG8_H1(Bt[n]), PG8_H1(At[m]), acc[ai][bj][m][n], 0, 0, 0); } } \
        __builtin_amdgcn_s_setprio(0); } while (0)
#define PG8_WAIT_V(n) asm volatile("s_waitcnt vmcnt(" #n ")" ::: "memory")
#define PG8_WAIT_L(n) asm volatile("s_waitcnt lgkmcnt(" #n ")" ::: "memory")
#define PG8_BAR __builtin_amdgcn_s_barrier()
#define PG8_SCHED __builtin_amdgcn_sched_barrier(0)
    int sav = SA, sbv = SB; asm volatile("" : "+v"(sav), "+v"(sbv));
    Unit cur, nxt; int ui = 0; int sig_pm = 0;
    if (!S.next(0, cur)) return;
    if constexpr (Sched::WAITS) { if (wid == 0) S.wait(cur); PG8_BAR; }
    f32x4 acc[2][2][4][2];
#pragma unroll
    for (int a = 0; a < 2; ++a)
#pragma unroll
        for (int b = 0; b < 2; ++b)
#pragma unroll
            for (int m = 0; m < 4; ++m)
#pragma unroll
                for (int n = 0; n < 2; ++n) acc[a][b][m][n] = (f32x4){0.f, 0.f, 0.f, 0.f};
    i32x8 At[4], B0[2], B1[2];
    const char* cA = S.a_base(cur); const char* cB = S.b_base(cur);
    if constexpr (Sched::GATHER) {
        int R0, C0, R1, C1; stage_rc(tid * 16, R0, C0); stage_rc(tid * 16 + 8192, R1, C1);
#pragma unroll
        for (int h = 0; h < 2; ++h) { cvA[h][0] = S.a_off(0, h, R0, C0 * 2); cvA[h][1] = S.a_off(0, h, R1, C1 * 2); }
    }
    PG8_STAGE(PG8_SB(0, 0), cB, voffB); PG8_STAGE(PG8_SB(0, 1), cB + hstepB, voffB); PG8_STAGE(PG8_SA(0, 0), cA, cvA[0]); PG8_STAGE(PG8_SA(0, 1), cA + hstepA, cvA[NH - 1]);
    if (wr == 1) PG8_BAR;
    PG8_WAIT_V(2); PG8_BAR;
    PG8_STAGE(PG8_SB(1, 0), cB + kstep, voffB); PG8_STAGE(PG8_SA(1, 0), cA + kstepA, cvA[0]); PG8_STAGE(PG8_SB(1, 1), cB + hstepB + kstep, voffB);
    PG8_WAIT_V(6); PG8_BAR;
    for (;;) {
        const bool has_next = S.next(ui + 1, nxt);
        if constexpr (Sched::WAITS) { if (has_next && wid == 0) S.wait(nxt); }
        const char* nA = has_next ? S.a_base(nxt) : cA; const char* nB = has_next ? S.b_base(nxt) : cB;
        if constexpr (Sched::GATHER) {
            if (has_next) {
                int t2 = threadIdx.x; asm volatile("" : "+v"(t2));
                int R0, C0, R1, C1; stage_rc(t2 * 16, R0, C0); stage_rc(t2 * 16 + 8192, R1, C1);
#pragma unroll
                for (int h = 0; h < 2; ++h) { nvA[h][0] = S.a_off(ui + 1, h, R0, C0 * 2); nvA[h][1] = S.a_off(ui + 1, h, R1, C1 * 2); }
            } else {
#pragma unroll
                for (int h = 0; h < 2; ++h) { nvA[h][0] = cvA[h][0]; nvA[h][1] = cvA[h][1]; }
            }
        }
#pragma unroll 1
        for (int t = 0; t < nt; t += 2) {
            const bool last = (t == nt - 2);
            const char* a1 = cA + (size_t)(t + 1) * kstepA;
            const char* a2 = last ? nA : cA + (size_t)(t + 2) * kstepA; const char* b2 = last ? nB : cB + (size_t)(t + 2) * kstep;
            if constexpr (BSPLIT) { if (!last && t + 2 >= nt / 2) b2 += S.b_delta(cur); }
            const char* a3 = a2 + kstepA; const char* b3 = b2 + kstep;
            unsigned v2[NH][2];
#pragma unroll
            for (int h = 0; h < NH; ++h) { if constexpr (Sched::GATHER) { v2[h][0] = last ? nvA[h][0] : cvA[h][0]; v2[h][1] = last ? nvA[h][1] : cvA[h][1]; } else { v2[h][0] = cvA[h][0]; v2[h][1] = cvA[h][1]; } }
            PG8_LDB(B0, 0, 0); PG8_LDB(B1, 0, 1); PG8_SCHED; PG8_LDA(At, 0, 0); PG8_STAGE(PG8_SA(1, 1), a1 + hstepA, cvA[NH - 1]);
            PG8_WAIT_V(8); PG8_WAIT_L(0); PG8_BAR; PG8_MMA(0, 0, At, B0); PG8_MMA(0, 1, At, B1); PG8_BAR; PG8_SCHED;
            PG8_LDA(At, 0, 1); PG8_STAGE(PG8_SB(0, 0), b2, voffB); PG8_STAGE(PG8_SB(0, 1), b2 + hstepB, voffB); PG8_STAGE(PG8_SA(0, 0), a2, v2[0]);
            PG8_WAIT_V(8); PG8_WAIT_L(0); PG8_BAR; PG8_MMA(1, 0, At, B0); PG8_MMA(1, 1, At, B1); PG8_BAR; PG8_SCHED;
            PG8_LDB(B0, 1, 0); PG8_LDB(B1, 1, 1); PG8_SCHED; PG8_LDA(At, 1, 0); PG8_STAGE(PG8_SA(0, 1), a2 + hstepA, v2[NH - 1]);
            PG8_WAIT_V(8); PG8_WAIT_L(0); PG8_BAR; PG8_MMA(0, 0, At, B0); PG8_MMA(0, 1, At, B1); PG8_BAR; PG8_SCHED;
            PG8_LDA(At, 1, 1); PG8_STAGE(PG8_SB(1, 0), b3, voffB); PG8_STAGE(PG8_SB(1, 1), b3 + hstepB, voffB); PG8_STAGE(PG8_SA(1, 0), a3, v2[0]);
            PG8_WAIT_V(8); PG8_WAIT_L(0); PG8_BAR; PG8_MMA(1, 0, At, B0); PG8_MMA(1, 1, At, B1); PG8_BAR; PG8_SCHED;
        }
        if constexpr (ALIGN_EPI) { if (wr == 0) PG8_BAR; }
        if constexpr (FP8) asm volatile("s_nop 15\n\ts_nop 15" ::: "memory");
        { Unit eu = cur; asm volatile("" : "+s"(eu.pm), "+s"(eu.pn));
          if constexpr (Sched::SIGNAL) { if (ui > 0) S.signal(sig_pm, lane); sig_pm = eu.pm; }
          E(acc, eu, ui, wr, wc, fr, fq); }
        if (!has_next) break;
#pragma unroll
        for (int a = 0; a < 2; ++a)
#pragma unroll
            for (int b = 0; b < 2; ++b)
#pragma unroll
                for (int m = 0; m < 4; ++m)
#pragma unroll
                    for (int n = 0; n < 2; ++n) acc[a][b][m][n] = (f32x4){0.f, 0.f, 0.f, 0.f};
        cur = nxt; cA = nA; cB = nB; ++ui;
        if constexpr (Sched::GATHER) {
#pragma unroll
            for (int h = 0; h < NH; ++h) { cvA[h][0] = nvA[h][0]; cvA[h][1] = nvA[h][1]; }
        }
        if constexpr (ALIGN_EPI) { if (wr == 1) PG8_BAR; }
    }
    PG8_WAIT_V(0);
    if constexpr (Sched::SIGNAL) S.signal(sig_pm, lane);
    if constexpr (!ALIGN_EPI) { if (wr == 0) PG8_BAR; }
    PG8_BAR;
#undef PG8_SA
#undef PG8_SB
#undef PG8_STAGE
#undef PG8_LDA
#undef PG8_LDB
#undef PG8_MMA
#undef PG8_LD32
#undef PG8_H0
#undef PG8_H1
#undef PG8_WAIT_V
#undef PG8_WAIT_L
#undef PG8_BAR
#undef PG8_SCHED
}
}
#define GAS __attribute__((address_space(1)))
typedef float f32x4 __attribute__((ext_vector_type(4)));
typedef float f32x16 __attribute__((ext_vector_type(16)));
typedef short bf16x8 __attribute__((ext_vector_type(8)));
typedef unsigned v4u __attribute__((ext_vector_type(4)));
typedef unsigned v2u __attribute__((ext_vector_type(2)));
#define LDS_WAIT() asm volatile("s_waitcnt lgkmcnt(0)" ::: "memory")
#define VM_WAIT() asm volatile("s_waitcnt vmcnt(0)" ::: "memory")
__device__ __forceinline__ unsigned pk2(float lo, float hi) { return f2bf(lo) | (f2bf(hi) << 16); }

constexpr int NWAVES = 8, NTHR = 512;
constexpr int LDS_STAGE = 0;
constexpr int LDS_RS = 131072;
constexpr int LDS_ROWTOK = LDS_RS + 8192;
constexpr int LDS_GATE = LDS_ROWTOK + 8192;
constexpr int LDS_MISC = LDS_GATE + 8192;
constexpr int LDS_MOET = LDS_MISC + 256;
constexpr int LDS_BYTES = LDS_MOET + 2048;
static_assert(LDS_BYTES <= 160 * 1024, "lds");
constexpr size_t WO_IN = 0, WO_SM = 6 * MiB, WO_RHI = 6 * MiB + 65536, WO_RLO = 6 * MiB + 131072, WO_OUT = 7 * MiB, WO_XQ = 9 * MiB, WO_XO = 10 * MiB, WO_GU = 11 * MiB, WO_D = 43 * MiB;
static_assert(WO_D + 16 * MiB <= WS_WLAYER, "weight block");
constexpr int CW_BAR = 4096;
constexpr int MAX_LAUNCH = 1;
constexpr int CW_XID = 8192;
constexpr int CW_PF = 16384;
constexpr int PF_WORDS = NLAYER * 3 * 128 * 16;
constexpr int CW_GF = CW_PF + PF_WORDS;
constexpr int GF_WORDS = NLAYER * MAXTILES * 16;
static_assert(CW_BAR + MAX_LAUNCH * XCD_BAR_WORDS <= CW_XID && CW_XID + 1024 <= CW_PF && (CW_GF + GF_WORDS) * 4 <= (int)(1 * MiB), "ctl");

enum { PH_PRO = 0, PH_XKV = 1, PH_L0 = 2, NPH = 13, PH_FINAL = PH_L0 + NLAYER * NPH, PH_END = PH_FINAL + 1 };
enum { LP_INPROJ = 0, LP_MIXA, LP_MIXB, LP_MIXC, LP_WOUT, LP_XQ, LP_XATTN, LP_XO, LP_ROUTE, LP_SORT, LP_GU, LP_DOWN0, LP_DOWN1 };

struct Args { P p; int ph_lo, ph_hi, li, pad; };

#ifndef WT_PROJ
#define WT_PROJ 0
#endif
template <bool HAS_RS> struct EpiBf16 {
    static constexpr bool PERM = true;
    bf16* O; int ldc; const LAS float* rstab;
    __device__ __forceinline__ void operator()(const pg8::f32x4 (&acc)[2][2][4][2], const pg8::Unit& u, int iu, int wr, int wc, int fr, int fq) const {
#pragma unroll
        for (int ai = 0; ai < 2; ++ai)
#pragma unroll
            for (int m = 0; m < 4; ++m) {
                const int lrow = ai * 128 + wr * 64 + m * 16 + fr;
                float sc = 1.f; if (HAS_RS) sc = rstab[iu * 256 + lrow];
                bf16* rowp = O + (size_t)(u.pm * 256 + lrow) * ldc + u.pn * 256 + wc * 32 + 8 * fq;
#pragma unroll
                for (int bj = 0; bj < 2; ++bj) { const pg8::f32x4 v0 = acc[ai][bj][m][0] * sc, v1 = acc[ai][bj][m][1] * sc;
                    pg8::u32x4 w; w.x = pg8::cvt_pk_bf16(v0[0], v0[1]); w.y = pg8::cvt_pk_bf16(v0[2], v0[3]); w.z = pg8::cvt_pk_bf16(v1[0], v1[1]); w.w = pg8::cvt_pk_bf16(v1[2], v1[3]);
                    if (WT_PROJ) st_b128_wt(rowp + bj * 128, w); else st_b128(rowp + bj * 128, w); }
            }
    }
};
__device__ __forceinline__ unsigned pk4_fp8(float a, float b, float c, float d) { int w = __builtin_amdgcn_cvt_pk_fp8_f32(a, b, 0, false); w = __builtin_amdgcn_cvt_pk_fp8_f32(c, d, w, true); return (unsigned)w; }
struct EpiGU {
    static constexpr bool PERM = true;
    unsigned char* U8; const LAS float* rstab; const LAS float* gatetab;
    __device__ __forceinline__ void operator()(const pg8::f32x4 (&acc)[2][2][4][2], const pg8::Unit& u, int iu, int wr, int wc, int fr, int fq) const {
#pragma unroll
        for (int ai = 0; ai < 2; ++ai)
#pragma unroll
            for (int m = 0; m < 4; ++m) {
                const int lrow = ai * 128 + wr * 64 + m * 16 + fr;
                const float sc = rstab[iu * 256 + lrow], gt = 4.f * gatetab[iu * 256 + lrow];
                float o[8];
#pragma unroll
                for (int n = 0; n < 2; ++n)
#pragma unroll
                    for (int j = 0; j < 4; ++j) { const float g = acc[ai][0][m][n][j] * sc, uu = acc[ai][1][m][n][j] * sc; o[n * 4 + j] = gt * g * uu * __builtin_amdgcn_rcpf(1.f + __expf(-g)); }
                pg8::u32x2 w; w.x = pk4_fp8(o[0], o[1], o[2], o[3]); w.y = pk4_fp8(o[4], o[5], o[6], o[7]);
                st_b64(U8 + (size_t)(u.pm * 256 + lrow) * 1024 + (u.pn >> 2) * 512 + (u.pn & 3) * 128 + wc * 32 + 8 * fq, w);
            }
    }
};
template <int MODE, bool W8 = false> struct EpiRes {
    static constexpr bool PERM = true;
    static constexpr bool MOE = MODE != 0;
    bf16* hb; float* ssq; const LAS int* rowtab; float gs; unsigned char* h8;
    static __device__ __forceinline__ void unpack8(const pg8::u32x4& w, float (&f)[8]) {
        f[0] = __builtin_bit_cast(float, w.x << 16); f[1] = __builtin_bit_cast(float, w.x & 0xffff0000u); f[2] = __builtin_bit_cast(float, w.y << 16); f[3] = __builtin_bit_cast(float, w.y & 0xffff0000u);
        f[4] = __builtin_bit_cast(float, w.z << 16); f[5] = __builtin_bit_cast(float, w.z & 0xffff0000u); f[6] = __builtin_bit_cast(float, w.w << 16); f[7] = __builtin_bit_cast(float, w.w & 0xffff0000u); }
    __device__ __forceinline__ void operator()(const pg8::f32x4 (&acc)[2][2][4][2], const pg8::Unit& u, int iu, int wr, int wc, int fr, int fq) const {
#pragma unroll
        for (int ai = 0; ai < 2; ++ai)
#pragma unroll
            for (int m = 0; m < 4; ++m) {
                const int lrow = ai * 128 + wr * 64 + m * 16 + fr;
                int row = u.pm * 256 + lrow; const float g = gs;
                if (MOE) row = rowtab[iu * 256 + lrow];
                const bool ok = !MOE || row >= 0;
                const size_t off = (size_t)(ok ? row : 0) * DM + u.pn * 256 + wc * 32 + 8 * fq;
                float q = 0.f;
                if (ok) {
#pragma unroll
                    for (int bj = 0; bj < 2; ++bj) {
                        float o[8];
#pragma unroll
                        for (int j = 0; j < 4; ++j) { o[j] = acc[ai][bj][m][0][j] * g; o[4 + j] = acc[ai][bj][m][1][j] * g; }
                        float bs[8]; unpack8(*(const pg8::u32x4*)(hb + off + bj * 128), bs);
#pragma unroll
                        for (int j = 0; j < 8; ++j) o[j] += bs[j];
                        pg8::u32x4 w; w.x = pg8::cvt_pk_bf16(o[0], o[1]); w.y = pg8::cvt_pk_bf16(o[2], o[3]); w.z = pg8::cvt_pk_bf16(o[4], o[5]); w.w = pg8::cvt_pk_bf16(o[6], o[7]);
                        float r[8]; unpack8(w, r);
#pragma unroll
                        for (int j = 0; j < 8; ++j) q += r[j] * r[j];
                        st_b128(hb + off + bj * 128, w);
                        if (W8) { pg8::u32x2 w8; w8.x = pk4_fp8(o[0], o[1], o[2], o[3]); w8.y = pk4_fp8(o[4], o[5], o[6], o[7]); st_b64(h8 + off + bj * 128, w8); }
                    }
                }
                q += __shfl_xor(q, 16); q += __shfl_xor(q, 32); if (fq == 0 && ok) ssq[(size_t)row * 16 + u.pn * 4 + wc] = q;
            }
    }
};
template <int MODE> struct MoeOrder {
    static constexpr bool GATHER = MODE == 0, SIGNAL = MODE == 0, WAITS = MODE == 1;
    static constexpr size_t KSTEP_A = 128;
    const char* A; const char* Bt; int K; size_t estride; const LAS int* tile2e; const LAS int* rowtab; unsigned* flags; unsigned* barw; int same;
    int NG, x, w, Tx, r;
    __device__ void init_group(int T, int G, int c) { NG = G >> 5; x = c >> 5; w = c & 31; const int per = 4 * NG, rem = T % per - 4 * x; Tx = 4 * (T / per) + (rem < 0 ? 0 : (rem > 4 ? 4 : rem)); r = (8 * Tx) & 31; }
    __device__ __forceinline__ int gtile(int tau) const { return 4 * NG * (tau >> 2) + 4 * x + (tau & 3); }
    __device__ bool next(int i, pg8::Unit& u) const {
        if (MODE == 0) { const int L = i * 32 + w; if (L >= 8 * Tx) return false; u.pm = gtile(L >> 3); u.pn = L & 7; }
        else { const int L = w >= r ? (i == 0 ? w - r : (32 - r) + (i - 1) * 32 + w) : (32 - r) + i * 32 + w; if (L >= 4 * Tx) return false; u.pm = gtile(L >> 2); u.pn = L & 3; }
        u.e = __builtin_amdgcn_readfirstlane(tile2e[u.pm]); return true;
    }
    __device__ __forceinline__ const char* a_base(const pg8::Unit& u) const { return GATHER ? A : A + (size_t)u.pm * (size_t)512 * K; }
    __device__ __forceinline__ const char* b_base(const pg8::Unit& u) const {
        if (MODE == 0) { const int e = (u.pn < 4 ? u.e >> 8 : u.e >> 16) & 255; return Bt + (size_t)e * estride + (size_t)(u.pn & 3) * (size_t)512 * K; }
        return Bt + (size_t)((u.e >> 8) & 255) * estride + (size_t)u.pn * (size_t)(256 * 512);
    }
    __device__ __forceinline__ long b_delta(const pg8::Unit& u) const { return (long)(((u.e >> 16) & 255) - ((u.e >> 8) & 255)) * (long)estride - 512; }
    __device__ __forceinline__ unsigned a_off(int iu, int h, int R, int Cb) const { return (unsigned)rowtab[iu * 256 + h * 128 + R] * (unsigned)(K * 2) + (unsigned)Cb; }
    __device__ __forceinline__ void signal(int pm, int lane) const {
        if (!same) { asm volatile("s_waitcnt vmcnt(0)" ::: "memory"); __builtin_amdgcn_fence(__ATOMIC_RELEASE, "agent"); asm volatile("s_waitcnt vmcnt(0)" ::: "memory"); }
        if (lane == 0) (void)xb_add(flags + pm * 16, 1u);
    }
    __device__ __forceinline__ void wait(const pg8::Unit& u) const {
        unsigned* f = flags + u.pm * 16;
        XB_SPIN(xb_ld(f) < 64u, barw);
        __builtin_amdgcn_fence(__ATOMIC_ACQUIRE, "agent");
    }
};

__device__ __forceinline__ void router_weights(const P& p, int gtid, int gstride);
__device__ __forceinline__ void tr_item(const float* W, int N, int K, int k0, int n0, const float* gain, float scale, bf16* dst, LAS float* scr, int lane) {
    const int kr = lane >> 3, c4 = lane & 7;
    f32x4 v[8];
#pragma unroll
    for (int i = 0; i < 8; ++i) v[i] = *(const f32x4*)(W + (size_t)(k0 + 8 * i + kr) * N + n0 + 4 * c4);
#pragma unroll
    for (int i = 0; i < 8; ++i) { const int kk = 8 * i + kr; float g = scale; if (gain) g *= gain[k0 + kk];
        LAS float* d = scr + kk * 33 + 4 * c4; d[0] = v[i].x * g; d[1] = v[i].y * g; d[2] = v[i].z * g; d[3] = v[i].w * g; }
    LDS_WAIT();
    const int c = lane & 7;
#pragma unroll
    for (int j = 0; j < 4; ++j) { const int n = (lane >> 3) + 8 * j; const LAS float* s = scr + (8 * c) * 33 + n;
        v4u o; o.x = pk2(s[0 * 33], s[1 * 33]); o.y = pk2(s[2 * 33], s[3 * 33]); o.z = pk2(s[4 * 33], s[5 * 33]); o.w = pk2(s[6 * 33], s[7 * 33]);
        st_b128(dst + (size_t)n * K + k0 + 8 * c, o); }
    LDS_WAIT();
}
__device__ __forceinline__ void tr_item8(const float* W, int N, int K, int k0, int n0, const float* gain, float scale, unsigned char* dst, LAS float* scr, int lane) {
    const int kr = lane >> 3, c4 = lane & 7;
    f32x4 v[8];
#pragma unroll
    for (int i = 0; i < 8; ++i) v[i] = *(const f32x4*)(W + (size_t)(k0 + 8 * i + kr) * N + n0 + 4 * c4);
#pragma unroll
    for (int i = 0; i < 8; ++i) { const int kk = 8 * i + kr; float g = scale; if (gain) g *= gain[k0 + kk];
        LAS float* d = scr + kk * 33 + 4 * c4; d[0] = v[i].x * g; d[1] = v[i].y * g; d[2] = v[i].z * g; d[3] = v[i].w * g; }
    LDS_WAIT();
    const int c = lane & 7;
#pragma unroll
    for (int j = 0; j < 4; ++j) { const int n = (lane >> 3) + 8 * j; const LAS float* s = scr + (8 * c) * 33 + n;
        v2u o; o.x = pk4_fp8(s[0 * 33], s[1 * 33], s[2 * 33], s[3 * 33]); o.y = pk4_fp8(s[4 * 33], s[5 * 33], s[6 * 33], s[7 * 33]);
        st_b64(dst + (size_t)n * K + k0 + 8 * c, o); }
    LDS_WAIT();
}
constexpr int IT_LAYER = 15360;
__device__ __forceinline__ void prologue_item(const P& p, int it, LAS float* scr, int lane) {
    const int l = it / IT_LAYER; int r = it % IT_LAYER;
    unsigned char* wl = ws_base(p.ws) + WS_W + (size_t)l * WS_WLAYER;
    if (r < 1536) {
        const int seg = r / 768; r %= 768; const int kb = r / 48, nb = r % 48; const int n0 = (seg ? 1544 : 0) + 32 * nb, drow = seg * 1536 + 32 * nb;
        const float sc = drow < 512 ? 0.125f * LOG2E : ((drow >= C_GQ && drow < C_GK) ? 0.125f : 1.f);
        tr_item(p.w_in + (size_t)l * DM * INW, INW, DM, 64 * kb, n0, p.mix_norm + l * DM, sc, (bf16*)(wl + WO_IN) + (size_t)drow * DM, scr, lane); return; }
    r -= 1536;
    if (r < 512) { const int kb = r / 32, nb = r % 32; tr_item(p.w_out + (size_t)l * DM * DM, DM, DM, 64 * kb, 32 * nb, nullptr, 1.f, (bf16*)(wl + WO_OUT) + (size_t)(32 * nb) * DM, scr, lane); return; }
    r -= 512;
    if (r < 256) { const int kb = r / 16, nb = r % 16; tr_item(p.w_xq + (size_t)l * DM * 512, 512, DM, 64 * kb, 32 * nb, p.cross_norm + l * DM, 0.08838834764831845f * LOG2E, (bf16*)(wl + WO_XQ) + (size_t)(32 * nb) * DM, scr, lane); return; }
    r -= 256;
    if (r < 256) { const int kb = r / 32, nb = r % 32; tr_item8(p.w_xo + (size_t)l * 512 * DM, DM, 512, 64 * kb, 32 * nb, nullptr, 32.f, (unsigned char*)(wl + WO_XO) + (size_t)(32 * nb) * 512, scr, lane); return; }
    r -= 256;
    if (r < 512) { const int kv = r / 256; r %= 256; const int kb = r / 16, nb = r % 16;
        tr_item((kv ? p.w_xv : p.w_xk) + (size_t)l * DM * 512, 512, DM, 64 * kb, 32 * nb, nullptr, 1.f, (bf16*)(ws_base(p.ws) + WS_WXKV) + (size_t)(l * 1024 + kv * 512 + 32 * nb) * DM, scr, lane); return; }
    r -= 512;
    if (r < 8192) { const int up = r / 4096; r %= 4096; const int e = r / 256; r %= 256; const int kb = r / 16, nb = r % 16; const int c0 = 32 * nb, drow = (c0 >> 7) * 256 + up * 128 + (c0 & 127);
        tr_item8((up ? p.w_eu : p.w_eg) + ((size_t)l * 16 + e) * DM * 512, 512, DM, 64 * kb, c0, p.moe_norm + l * DM, 32.f, (unsigned char*)(wl + WO_GU) + ((size_t)e * 1024 + drow) * DM, scr, lane); return; }
    r -= 8192;
    { const int e = r / 256; r %= 256; const int kb = r / 32, nb = r % 32;
      tr_item8(p.w_ed + ((size_t)l * 16 + e) * 512 * DM, DM, 512, 64 * kb, 32 * nb, nullptr, 32.f, (unsigned char*)(wl + WO_D) + ((size_t)e * 1024 + 32 * nb) * 512, scr, lane); }
}
__device__ __forceinline__ void row_to_bf16(const float* src, bf16* dst, float* ssq, const float* gain, int lane, int mode) {
    const f32x4* s = (const f32x4*)src + lane;
    f32x4 v[4]; float q = 0.f;
#pragma unroll
    for (int j = 0; j < 4; ++j) { v[j] = s[64 * j]; q += (v[j].x * v[j].x + v[j].y * v[j].y) + (v[j].z * v[j].z + v[j].w * v[j].w); }
    q = wave_sum(q);
    float sc = 1.f;
    if (mode == 1) sc = rsqrtf(q * (1.0f / DM) + EPS);
    v2u* d = (v2u*)dst + lane; float q2 = 0.f;
#pragma unroll
    for (int j = 0; j < 4; ++j) {
        f32x4 g = (f32x4){1.f, 1.f, 1.f, 1.f}; if (mode == 1) g = ((const f32x4*)gain)[lane + 64 * j];
        v2u o; o.x = pk2(v[j].x * sc * g.x, v[j].y * sc * g.y); o.y = pk2(v[j].z * sc * g.z, v[j].w * sc * g.w); st_b64(d + 64 * j, o);
        const float r0 = __builtin_bit_cast(float, o.x << 16), r1 = __builtin_bit_cast(float, o.x & 0xffff0000u), r2 = __builtin_bit_cast(float, o.y << 16), r3 = __builtin_bit_cast(float, o.y & 0xffff0000u);
        q2 += (r0 * r0 + r1 * r1) + (r2 * r2 + r3 * r3); }
    if (mode == 0) { q2 = wave_sum(q2); if (lane < 16) ssq[lane] = lane == 0 ? q2 : 0.f; }
}
__device__ __forceinline__ void prologue(const P& p, LAS unsigned char* lds, int vcu, int G, int wave, int lane) {
    asm volatile("" : "+v"(lane));
    if (vcu == 0 && wave == 0) WSP(int, WS_MOE + MO_GCNT)[lane] = 0;
    if (vcu == 1 % G) { unsigned* pf = (unsigned*)(ws_base(p.ws) + WS_CTL) + CW_PF; for (int i = wave * 64 + lane; i < PF_WORDS + GF_WORDS; i += NTHR) pf[i] = 0u; }
    LAS float* scr = (LAS float*)(lds + LDS_STAGE + wave * 16384);
    const int gw = vcu * NWAVES + wave, NGW = G * NWAVES;
    for (int it = gw; it < NLAYER * IT_LAYER; it += NGW) prologue_item(p, it, scr, lane);
    for (int idx = gw * 64 + lane; idx < NLAYER * 2 * 32768; idx += NGW * 64) {
        const int l = idx / 65536, r = idx % 65536, which = r / 32768, e = r % 32768, row = e & 31, k = e >> 5;
        unsigned char* wl = ws_base(p.ws) + WS_W + (size_t)l * WS_WLAYER;
        if (which == 0) {
            float v = 0.f;
            if (row < 8) v = p.w_in[((size_t)l * DM + k) * INW + 1536 + row]; else if (row < 24) v = p.w_in[((size_t)l * DM + k) * INW + 3080 + (row - 8)];
            ((bf16*)(wl + WO_SM))[row * 1024 + k] = (bf16)f2bf(v * p.mix_norm[l * DM + k]);
        }
    }
    router_weights(p, gw * 64 + lane, NGW * 64);
    for (int m = gw; m < 4096; m += NGW) row_to_bf16(p.mem + (size_t)m * DM, WSP(bf16, WS_MEMN) + (size_t)m * DM, nullptr, p.mem_norm, lane, 1);
    { bf16* hbp = WSP(bf16, WS_HB); float* sqp = WSP(float, WS_SSQ);
      for (int m0 = gw * 4; m0 < NTOK; m0 += NGW * 4) {
        f32x4 v[4][4];
#pragma unroll
        for (int r = 0; r < 4; ++r)
#pragma unroll
            for (int j = 0; j < 4; ++j) v[r][j] = ((const f32x4*)(p.x + (size_t)(m0 + r) * DM))[lane + 64 * j];
#pragma unroll
        for (int r = 0; r < 4; ++r) { float q2 = 0.f; v2u* d = (v2u*)(hbp + (size_t)(m0 + r) * DM) + lane;
#pragma unroll
            for (int j = 0; j < 4; ++j) { v2u o; o.x = pk2(v[r][j].x, v[r][j].y); o.y = pk2(v[r][j].z, v[r][j].w); st_b64(d + 64 * j, o);
                const float r0 = __builtin_bit_cast(float, o.x << 16), r1 = __builtin_bit_cast(float, o.x & 0xffff0000u), r2 = __builtin_bit_cast(float, o.y << 16), r3 = __builtin_bit_cast(float, o.y & 0xffff0000u);
                q2 += (r0 * r0 + r1 * r1) + (r2 * r2 + r3 * r3); }
            q2 = wave_sum(q2); if (lane < 16) sqp[(size_t)(m0 + r) * 16 + lane] = lane == 0 ? q2 : 0.f; }
      } }
}
__device__ __forceinline__ void small_proj(const P& p, int l, LAS unsigned char* lds, int vcu, int G, int wave, int lane) {
    asm volatile("" : "+v"(lane));
    const bf16* wsm = (const bf16*)(ws_base(p.ws) + WS_W + (size_t)l * WS_WLAYER + WO_SM);
    const bf16* hb = WSP(bf16, WS_HB); const float* ssq = WSP(float, WS_SSQ); float* sm = WSP(float, WS_SM);
    constexpr int BST = 2048 + 16;
    { const int tid = wave * 64 + lane;
#pragma unroll
      for (int i = 0; i < 8; ++i) { const int idx = tid + NTHR * i, row = idx >> 7, c = idx & 127; *(LAS v4u*)(lds + row * BST + c * 16) = *(const v4u*)(wsm + row * 1024 + c * 8); } }
    __syncthreads();
    const int r = lane & 15, kq = lane >> 4;
    for (int blk = vcu * NWAVES + wave; blk < NTOK / 16; blk += G * NWAVES) {
        const int tok0 = blk * 16;
        const bf16x8* ap = (const bf16x8*)(hb + (size_t)(tok0 + r) * DM + kq * 32);
        pg8::f32x4 acc0 = {0.f, 0.f, 0.f, 0.f}, acc1 = {0.f, 0.f, 0.f, 0.f};
#pragma unroll
        for (int half = 0; half < 2; ++half) {
            bf16x8 af[16];
#pragma unroll
            for (int i = 0; i < 16; ++i) af[i] = ap[(half * 4 + (i >> 2)) * 16 + (i & 3)];
#pragma unroll
            for (int i = 0; i < 16; ++i) { const int s_ = half * 4 + (i >> 2), j = i & 3;
                const bf16x8 b0 = *(const LAS bf16x8*)(lds + r * BST + (128 * s_ + 32 * kq + 8 * j) * 2);
                const bf16x8 b1 = *(const LAS bf16x8*)(lds + (16 + r) * BST + (128 * s_ + 32 * kq + 8 * j) * 2);
                acc0 = __builtin_amdgcn_mfma_f32_16x16x32_bf16(af[i], b0, acc0, 0, 0, 0);
                acc1 = __builtin_amdgcn_mfma_f32_16x16x32_bf16(af[i], b1, acc1, 0, 0, 0);
                if ((i & 3) == 3) __builtin_amdgcn_sched_barrier(0); }
        }
        const float rsv = row_rs(ssq, tok0 + r);
#pragma unroll
        for (int g = 0; g < 4; ++g) { const int trow = 4 * kq + g; const float rs = __shfl(rsv, trow);
            sm[(size_t)(tok0 + trow) * 32 + r] = acc0[g] * rs; if (r < 8) sm[(size_t)(tok0 + trow) * 32 + 16 + r] = acc1[g] * rs; }
    }
    __syncthreads();
}
typedef short v4i16_t __attribute__((ext_vector_type(4)));
typedef __bf16 bf16x2_t __attribute__((ext_vector_type(2)));
typedef float f32x2_t __attribute__((ext_vector_type(2)));
__device__ __forceinline__ unsigned cvtpk(float lo, float hi) { f32x2_t v = {lo, hi}; bf16x2_t b = __builtin_convertvector(v, bf16x2_t); return __builtin_bit_cast(unsigned, b); }
__device__ __forceinline__ bf16x8 pack8(const f32x16& p, int o) {
    v4u w; w.x = cvtpk(p[o], p[o + 1]); w.y = cvtpk(p[o + 2], p[o + 3]); w.z = cvtpk(p[o + 4], p[o + 5]); w.w = cvtpk(p[o + 6], p[o + 7]);
    return __builtin_bit_cast(bf16x8, w);
}
__device__ __forceinline__ float max3f(float a, float b, float c) { float r; asm("v_max3_f32 %0, %1, %2, %3" : "=v"(r) : "v"(a), "v"(b), "v"(c)); return r; }
template <int D, bool FOX, bool OUT8 = false>
__device__ __forceinline__ void attn_unit(LAS unsigned char* lds, const bf16* Qg, int qpitch, const bf16* Kg, const bf16* Vg, int kvpitch, int NT,
                                          const float* cb, int q0, bf16* Og, int opitch, const float* gain, const float* kn) {
    constexpr int KS = D * 2 + 16, VS = D * 2 + 64;
    constexpr int KT = FOX ? 2 : 1, KEYS = 64 * KT;
    constexpr int KBYTES = KEYS * KS, VBYTES = KEYS * VS;
    constexpr int CPR = D / 8, NCH = KEYS * CPR / NTHR, NS = D / 16, NDB = D / 32;
    constexpr int OFF_K = 0, OFF_V = 2 * KBYTES, OFF_CB = 2 * KBYTES + 2 * VBYTES, OFF_FX = OFF_CB + 2 * KEYS * 4;
    int tid = threadIdx.x; asm volatile("" : "+v"(tid));
    const int lane = tid & 63, wave = __builtin_amdgcn_readfirstlane(tid >> 6), r32 = lane & 31, hh = lane >> 5;
    bf16x8 qf[NS];
    { const bf16* qrow = Qg + (size_t)(wave * 32 + r32) * qpitch;
#pragma unroll
      for (int s = 0; s < NS; ++s) qf[s] = *(const bf16x8*)(qrow + 16 * s + 8 * hh); }
    v4u kreg[NCH], vreg[NCH]; f32x4 cbreg = {0.f, 0.f, 0.f, 0.f};
#define AT_GLOAD(t) do { _Pragma("unroll") for (int i_ = 0; i_ < NCH; ++i_) { const int idx_ = tid + NTHR * i_, key_ = idx_ / CPR, c_ = idx_ % CPR; \
        kreg[i_] = *(const v4u*)(Kg + (size_t)((t) * KEYS + key_) * kvpitch + c_ * 8); vreg[i_] = *(const v4u*)(Vg + (size_t)((t) * KEYS + key_) * kvpitch + c_ * 8); } \
        if (FOX && tid < KEYS / 4) cbreg = *(const f32x4*)(cb + (t) * KEYS + tid * 4); } while (0)
#define AT_LSTORE(b) do { _Pragma("unroll") for (int i_ = 0; i_ < NCH; ++i_) { const int idx_ = tid + NTHR * i_, key_ = idx_ / CPR, c_ = idx_ % CPR; \
        *(LAS v4u*)(lds + OFF_K + (b) * KBYTES + key_ * KS + c_ * 16) = kreg[i_]; *(LAS v4u*)(lds + OFF_V + (b) * VBYTES + key_ * VS + c_ * 16) = vreg[i_]; } \
        if (FOX && tid < KEYS / 4) *(LAS f32x4*)(lds + OFF_CB + (b) * (KEYS * 4) + tid * 16) = cbreg; } while (0)
    float m = -INFINITY, l = 0.f;
    f32x16 osum = f32x16{};
    f32x16 o[NDB];
#pragma unroll
    for (int d = 0; d < NDB; ++d) o[d] = f32x16{};
    const int qlo = q0 + wave * 32, qabs = qlo + r32;
    float knpre = 0.f, qkmax = 0.f;
    LAS float* fx = (LAS float*)(lds + OFF_FX);
    const int NTG = NT / KT;
    const int t_first = FOX ? NTG - 1 : 0;
    AT_GLOAD(t_first);
    __syncthreads();
    if (FOX) {
        float qn2 = 0.f;
#pragma unroll
        for (int s = 0; s < NS; ++s)
#pragma unroll
            for (int e = 0; e < 8; ++e) { const float v = __builtin_bit_cast(float, ((unsigned)(unsigned short)qf[s][e]) << 16); qn2 += v * v; }
        qn2 += __shfl_xor(qn2, 32);
        qn2 = wave_max(qn2);
        if (lane == 0) fx[wave] = qn2;
        knpre = lane < 32 ? kn[lane] : 0.f;
#pragma unroll
        for (int o_ = 1; o_ < 32; o_ <<= 1) { const float t_ = __shfl_up(knpre, o_); if (lane >= o_) knpre = fmaxf(knpre, t_); }
    }
    AT_LSTORE(0);
    __syncthreads();
    if (FOX) { float q2 = fx[0];
#pragma unroll
        for (int w_ = 1; w_ < 8; ++w_) q2 = fmaxf(q2, fx[w_]);
        qkmax = sqrtf(q2); }
#pragma unroll 1
    for (int it = 0; it < NTG; ++it) {
        const int b = it & 1;
        const int tg = FOX ? NTG - 1 - it : it;
        const int tn = FOX ? tg - 1 : tg + 1;
        if (it + 1 < NTG) AT_GLOAD(tn);
#pragma unroll
        for (int sub_ = 0; sub_ < KT; ++sub_) {
        const int sub = FOX ? KT - 1 - sub_ : sub_, koff = sub * 64;
        const int kt0 = (tg * KT + sub) * 64;
        if (!FOX || kt0 <= qlo + 31) {
            f32x16 p[2];
#pragma unroll
            for (int kb = 0; kb < 2; ++kb) {
                if (FOX) {
#pragma unroll
                    for (int g = 0; g < 4; ++g) { const f32x4 c4 = *(const LAS f32x4*)(lds + OFF_CB + b * (KEYS * 4) + (koff + kb * 32 + 8 * g + 4 * hh) * 4); p[kb][4 * g] = c4.x; p[kb][4 * g + 1] = c4.y; p[kb][4 * g + 2] = c4.z; p[kb][4 * g + 3] = c4.w; }
                } else p[kb] = f32x16{};
                const LAS unsigned char* kp = lds + OFF_K + b * KBYTES + (koff + kb * 32 + r32) * KS + hh * 16;
#pragma unroll
                for (int s = 0; s < NS; ++s) { const bf16x8 kf = *(const LAS bf16x8*)(kp + s * 32); p[kb] = __builtin_amdgcn_mfma_f32_32x32x16_bf16(kf, qf[s], p[kb], 0, 0, 0); }
            }
            if (FOX && kt0 + 63 > qlo) {
#pragma unroll
                for (int kb = 0; kb < 2; ++kb)
#pragma unroll
                    for (int r = 0; r < 16; ++r) { const int key = kt0 + kb * 32 + (r & 3) + 8 * (r >> 2) + 4 * hh; if (key > qabs) p[kb][r] = -INFINITY; }
            }
            float mt = fmaxf(p[1][0], p[0][0]);
#pragma unroll
            for (int r = 1; r < 16; ++r) mt = max3f(mt, p[0][r], p[1][r]);
            mt = fmaxf(mt, __shfl_xor(mt, 32));
            const float mnew = fmaxf(m, mt);
            float ls = 0.f;
#pragma unroll
            for (int kb = 0; kb < 2; ++kb)
#pragma unroll
                for (int r = 0; r < 16; ++r) { const float e = __builtin_amdgcn_exp2f(p[kb][r] - mnew); p[kb][r] = e; if (!FOX) ls += e; }
            if (!FOX || __builtin_amdgcn_ballot_w64(mnew > m) != 0ull) {
                const float alpha = __builtin_amdgcn_exp2f(m - mnew);
                l *= alpha; if (FOX) osum[0] *= alpha;
#pragma unroll
                for (int d = 0; d < NDB; ++d)
#pragma unroll
                    for (int r = 0; r < 16; ++r) o[d][r] *= alpha;
            }
            m = mnew; l += ls;
            bf16x8 pa[2][2];
#pragma unroll
            for (int kb = 0; kb < 2; ++kb) { pa[kb][0] = pack8(p[kb], 0); pa[kb][1] = pack8(p[kb], 8); }
            const LAS unsigned char* vp = lds + OFF_V + b * VBYTES + (koff + 4 * hh + ((lane & 15) >> 2)) * VS + (16 * ((lane >> 4) & 1) + 4 * (lane & 3)) * 2;
#pragma unroll
            for (int d = 0; d < NDB; ++d) {
#pragma unroll
                for (int kb = 0; kb < 2; ++kb)
#pragma unroll
                    for (int ks = 0; ks < 2; ++ks) {
                        const LAS unsigned char* a0 = vp + (kb * 32 + 16 * ks) * VS + d * 64;
                        const v4i16_t lo = __builtin_amdgcn_ds_read_tr16_b64_v4i16((LAS v4i16_t*)a0);
                        const v4i16_t hi = __builtin_amdgcn_ds_read_tr16_b64_v4i16((LAS v4i16_t*)(a0 + 8 * VS));
                        const bf16x8 vf = (bf16x8){lo[0], lo[1], lo[2], lo[3], hi[0], hi[1], hi[2], hi[3]};
                        o[d] = __builtin_amdgcn_mfma_f32_32x32x16_bf16(vf, pa[kb][ks], o[d], 0, 0, 0);
                    }
            }
            if (FOX) {
                const bf16x8 ones = __builtin_bit_cast(bf16x8, (v4u){0x3F803F80u, 0x3F803F80u, 0x3F803F80u, 0x3F803F80u});
#pragma unroll
                for (int kb = 0; kb < 2; ++kb)
#pragma unroll
                    for (int ks = 0; ks < 2; ++ks) osum = __builtin_amdgcn_mfma_f32_32x32x16_bf16(ones, pa[kb][ks], osum, 0, 0, 0);
            }
        }
        }
        if (FOX) { const float mm = wave_min(m); if (lane == 0) fx[8 + b * 8 + wave] = mm; }
        if (it + 1 < NTG) AT_LSTORE(b ^ 1);
        __syncthreads();
        if (FOX && tg > 0) {
            float M0 = fx[8 + b * 8];
#pragma unroll
            for (int w_ = 1; w_ < 8; ++w_) M0 = fminf(M0, fx[8 + b * 8 + w_]);
            const float cbl = *(const LAS float*)(lds + OFF_CB + (b ^ 1) * (KEYS * 4) + (KEYS - 1) * 4);
            const float knb = __builtin_bit_cast(float, __builtin_amdgcn_readlane(__builtin_bit_cast(int, knpre), tg * KT - 1));
            if (qkmax * knb + cbl < M0 - 40.f) break;
        }
    }
#undef AT_GLOAD
#undef AT_LSTORE
    if (FOX) l = osum[0]; else l += __shfl_xor(l, 32);
    const float inv = 1.0f / l;
    float rs = inv;
    if (FOX) {
        float ss = 0.f;
#pragma unroll
        for (int d = 0; d < NDB; ++d)
#pragma unroll
            for (int r = 0; r < 16; ++r) { const float v = o[d][r] * inv; ss += v * v; }
        ss += __shfl_xor(ss, 32);
        rs = inv * rsqrtf(ss * (1.0f / D) + EPS);
    }
    constexpr int SROW = 144;
    LAS unsigned char* stg = lds + OFF_K + wave * (32 * SROW);
#pragma unroll
    for (int d = 0; d < NDB; ++d)
#pragma unroll
        for (int g = 0; g < 4; ++g) {
            if (OUT8) { *(LAS unsigned*)(stg + r32 * SROW + 32 * d + 8 * g + 4 * hh) = pk4_fp8(o[d][4 * g] * rs, o[d][4 * g + 1] * rs, o[d][4 * g + 2] * rs, o[d][4 * g + 3] * rs); }
            else { f32x4 gn = {1.f, 1.f, 1.f, 1.f}; if (FOX) gn = *(const f32x4*)(gain + 32 * d + 8 * g + 4 * hh);
                v2u w; w.x = cvtpk(o[d][4 * g] * rs * gn.x, o[d][4 * g + 1] * rs * gn.y); w.y = cvtpk(o[d][4 * g + 2] * rs * gn.z, o[d][4 * g + 3] * rs * gn.w);
                *(LAS v2u*)(stg + r32 * SROW + (32 * d + 8 * g + 4 * hh) * 2) = w; }
        }
    static_assert((OUT8 ? D : D * 2) == 128, "stage rows are 128 bytes");
    { unsigned char* ob = (unsigned char*)Og; const size_t pitchb = (size_t)opitch * (OUT8 ? 1 : 2);
#pragma unroll
      for (int i = 0; i < 4; ++i) { const int row = i * 8 + (lane >> 3), ch = lane & 7;
          const v4u w = *(const LAS v4u*)(stg + row * SROW + ch * 16);
          st_b128(ob + (size_t)(wave * 32 + row) * pitchb + ch * 16, w); } }
}
__device__ __forceinline__ void fox_phase(const P& p, int l, LAS unsigned char* lds, int vcu, int G) {
    const bf16* proj = WSP(bf16, WS_PROJ); const float* cb = WSP(float, WS_CB); bf16* y = WSP(bf16, WS_Y);
    for (int pu = vcu; pu < 512; pu += G) {
        const int bh = pu >> 2, pr = pu < 256 ? (pu & 3) : 3 - (pu & 3), b = bh >> 3, h = bh & 7;
        for (int half = 0; half < 2; ++half) {
            const int qb = half ? pr : 7 - pr;
            const size_t row0 = (size_t)b * SEQ;
            attn_unit<64, true>(lds, proj + (row0 + qb * 256) * PW + C_FQ + h * 64, PW, proj + row0 * PW + C_FK + h * 64, proj + row0 * PW + C_FV + h * 64, PW, 4 * (qb + 1),
                                cb + ((size_t)b * 8 + h) * SEQ, qb * 256, y + (row0 + qb * 256) * DM + h * 64, DM, p.fox_gain + l * 512 + h * 64, WSP(const float, WS_MOE + MO_KN) + (b * 8 + h) * 32);
        }
    }
}
__device__ __forceinline__ void xattn_phase(const P& p, int l, LAS unsigned char* lds, int vcu, int G, bool dummy) {
    bf16* xq = WSP(bf16, WS_XQ); const bf16* xkv = WSP(bf16, WS_XKV);
    for (int u = vcu; u < 512; u += G) {
        const int b = u >> 5, h = (u >> 3) & 3, qb = u & 7;
        bf16* qp = xq + ((size_t)b * SEQ + qb * 256) * 512 + h * 128;
        const bf16* kp = xkv + (size_t)b * MEML * 2048 + l * 1024 + h * 128;
        attn_unit<128, false, true>(lds, qp, 512, kp, kp + 512, 2048, 4, nullptr, 0, (bf16*)((dummy ? WSP(unsigned char, WS_Y) : WSP(unsigned char, WS_XO8)) + ((size_t)b * SEQ + qb * 256) * 512 + h * 128), 512, nullptr, nullptr);
    }
}

__device__ __forceinline__ void xattn_pair(const P& p, int l, LAS unsigned char* lds, int pm, int pn, bool dummy) {
    const bf16* xq = WSP(bf16, WS_XQ); const bf16* xkv = WSP(bf16, WS_XKV);
    const int b = pm >> 3;
    for (int hh2 = 0; hh2 < 2; ++hh2) {
        const int h = 2 * pn + hh2;
        const bf16* qp = xq + (size_t)pm * 256 * 512 + h * 128;
        const bf16* kp = xkv + (size_t)b * MEML * 2048 + l * 1024 + h * 128;
        attn_unit<128, false, true>(lds, qp, 512, kp, kp + 512, 2048, 4, nullptr, 0, (bf16*)((dummy ? WSP(unsigned char, WS_Y) : WSP(unsigned char, WS_XO8)) + (size_t)pm * 256 * 512 + h * 128), 512, nullptr, nullptr);
    }
}
constexpr size_t WS_GB = WS_END;
constexpr size_t WS_RT2 = WS_GB + 16 * MiB;
constexpr size_t WS_RG2 = WS_GB + 20 * MiB;
constexpr size_t WS_GDEC = WS_GB + 32 * MiB;
constexpr size_t WS_END2 = WS_GDEC + 1 * MiB;
static_assert(WS_END2 <= 512 * MiB, "workspace map 2");
constexpr int GL_B = 0;
constexpr int GL_TOT = 16384;
constexpr int GL_Q1 = 18432, GL_Q2 = GL_Q1 + 64 * 144, GL_K2 = GL_Q2 + 64 * 144;
constexpr int GL_KD = GL_K2 + 64 * 144;
constexpr int GL_V = GL_KD + 64 * 192;
constexpr int GL_SSQ = GL_V + 64 * 320;
constexpr int GL_GA = GL_SSQ + 1024;
constexpr int GL_YST = GL_GA + 4096;
constexpr int GL_GG = GL_YST + 64 * 272;
constexpr int GL_END = GL_GG + 64 * 272;
static_assert(GL_END <= 131072, "gla lds");

__device__ __forceinline__ float fast_log_sigmoid(float z) { return fminf(z, 0.f) - __logf(1.f + __expf(-fabsf(z))); }
__device__ __forceinline__ void gla_load_v(const bf16* proj, size_t tok0, int h, LAS unsigned char* lds, int tid) {
#pragma unroll
    for (int i = 0; i < 2; ++i) { const int idx = tid + NTHR * i, t = idx >> 4, c = idx & 15;
        *(LAS v4u*)(lds + GL_V + t * 320 + c * 16) = *(const v4u*)(proj + (tok0 + t) * PW + C_GV + h * 128 + c * 8); }
}
__device__ __forceinline__ bf16x8 tr_frag(const LAS unsigned char* a0, int rowstride4) {
    const v4i16_t lo = __builtin_amdgcn_ds_read_tr16_b64_v4i16((LAS v4i16_t*)a0);
    const v4i16_t hi = __builtin_amdgcn_ds_read_tr16_b64_v4i16((LAS v4i16_t*)(a0 + rowstride4));
    return (bf16x8){lo[0], lo[1], lo[2], lo[3], hi[0], hi[1], hi[2], hi[3]};
}
constexpr int GA_WAVE = 19456, GA_SROW = 144;
static_assert(8 * GA_WAVE <= LDS_MISC && 128 * GA_SROW <= GA_WAVE, "gla phase A lds");
__device__ __forceinline__ void gla_phase_a(const P& p, int l, LAS unsigned char* lds, int vcu, int G) {
    int tid = threadIdx.x; asm volatile("" : "+v"(tid));
    const int lane = tid & 63, wave = __builtin_amdgcn_readfirstlane(tid >> 6), hh = lane >> 5;
    const bf16* proj = WSP(bf16, WS_PROJ); bf16* loc = ((bf16*)p.out); float* dec = WSP(float, WS_GDEC); const float* sm = WSP(float, WS_SM); _Float16* gb = WSP(_Float16, WS_GB);
    LAS unsigned char* kd = lds + wave * GA_WAVE; LAS unsigned char* vh = kd + 8192;
    const int crow8 = lane >> 3, cch = lane & 7;
    const int trow = (lane & 15) >> 2, tcol = 16 * ((lane >> 4) & 1) + 4 * (lane & 3);
    for (int u = vcu * NWAVES + wave; u < 2048; u += G * NWAVES) {
        const int c = u & 31, h = (u >> 5) & 3, b = u >> 7;
        const size_t tok0 = (size_t)b * SEQ + c * 64;
        v4u kreg[8], v0reg[8], v1reg[8];
#pragma unroll
        for (int i = 0; i < 8; ++i) { const bf16* rp = proj + (tok0 + i * 8 + crow8) * PW;
            kreg[i] = *(const v4u*)(rp + C_GK + h * 64 + cch * 8); v0reg[i] = *(const v4u*)(rp + C_GV + h * 128 + cch * 8); v1reg[i] = *(const v4u*)(rp + C_GV + h * 128 + 64 + cch * 8); }
        float w[16];
#pragma unroll
        for (int r = 0; r < 16; ++r) w[r] = p.w_alpha_up[((size_t)l * 16 + r) * 256 + h * 64 + lane];
        const float bias = p.b_alpha[l * 256 + h * 64 + lane];
        { LAS f32x4* gw = (LAS f32x4*)vh;
#pragma unroll
          for (int i = 0; i < 4; ++i) gw[lane * 4 + i] = *(const f32x4*)(sm + (tok0 + lane) * 32 + 8 + 4 * i); }
        float bt[64]; float run = 0.f;
#pragma unroll
        for (int t = 0; t < 64; ++t) {
            float z = bias;
#pragma unroll
            for (int r4 = 0; r4 < 4; ++r4) { const f32x4 g4 = ((const LAS f32x4*)vh)[t * 4 + r4]; z += g4.x * w[4 * r4] + g4.y * w[4 * r4 + 1] + g4.z * w[4 * r4 + 2] + g4.w * w[4 * r4 + 3]; }
            run += fast_log_sigmoid(z) * (1.0f / 16.0f); bt[t] = run; gb[(tok0 + t) * 256 + h * 64 + lane] = (_Float16)run;
        }
#pragma unroll
        for (int i = 0; i < 8; ++i) { *(LAS v4u*)(kd + (i * 8 + crow8) * 128 + cch * 16) = kreg[i]; *(LAS v4u*)(vh + (i * 8 + crow8) * 128 + cch * 16) = v0reg[i]; }
#pragma unroll
        for (int t = 0; t < 64; ++t) { LAS bf16* kp = (LAS bf16*)(kd + t * 128 + lane * 2); *kp = (bf16)f2bf(bf2f(*kp) * __expf(run - bt[t])); }
        dec[(size_t)u * 64 + lane] = __expf(run);
        f32x16 acc[2][2][2];
#pragma unroll
        for (int half = 0; half < 2; ++half) {
            if (half == 1) {
#pragma unroll
                for (int i = 0; i < 8; ++i) *(LAS v4u*)(vh + (i * 8 + crow8) * 128 + cch * 16) = v1reg[i];
            }
#pragma unroll
            for (int x = 0; x < 2; ++x)
#pragma unroll
                for (int y = 0; y < 2; ++y) acc[half][y][x] = f32x16{};
#pragma unroll
            for (int s = 0; s < 4; ++s) {
                bf16x8 af[2], bfr[2];
#pragma unroll
                for (int x = 0; x < 2; ++x) { af[x] = tr_frag(vh + (16 * s + 8 * hh + trow) * 128 + (32 * x + tcol) * 2, 4 * 128); bfr[x] = tr_frag(kd + (16 * s + 8 * hh + trow) * 128 + (32 * x + tcol) * 2, 4 * 128); }
#pragma unroll
                for (int x = 0; x < 2; ++x)
#pragma unroll
                    for (int y = 0; y < 2; ++y) acc[half][y][x] = __builtin_amdgcn_mfma_f32_32x32x16_bf16(bfr[y], af[x], acc[half][y][x], 0, 0, 0);
            }
        }
#pragma unroll
        for (int half = 0; half < 2; ++half)
#pragma unroll
            for (int x = 0; x < 2; ++x)
#pragma unroll
                for (int y = 0; y < 2; ++y)
#pragma unroll
                    for (int g = 0; g < 4; ++g) { const f32x16& a = acc[half][y][x];
                        v2u w2; w2.x = cvtpk(a[4 * g], a[4 * g + 1]); w2.y = cvtpk(a[4 * g + 2], a[4 * g + 3]);
                        *(LAS v2u*)(kd + (64 * half + 32 * x + (lane & 31)) * GA_SROW + (32 * y + 8 * g + 4 * hh) * 2) = w2; }
#pragma unroll
        for (int i = 0; i < 16; ++i) { const int idx = lane + 64 * i, row = idx >> 3, ch = idx & 7;
            st_b128(loc + (size_t)u * 8192 + row * 64 + ch * 8, *(const LAS v4u*)(kd + row * GA_SROW + ch * 16)); }
    }
}
__device__ __forceinline__ void gla_phase_b(const P& p, int vcu, int G) {
    int tid = threadIdx.x; asm volatile("" : "+v"(tid));
    const bf16* loc = ((const bf16*)p.out); const float* dec = WSP(float, WS_GDEC); bf16* gs = (bf16*)((unsigned char*)p.out + 96 * MiB);
    for (int u = vcu; u < 256; u += G) {
        const int bh = u >> 2, q4 = u & 3;
        const int e = q4 * 2048 + tid * 4, dk = e & 63;
        f32x4 st = {0.f, 0.f, 0.f, 0.f};
#pragma unroll 8
        for (int c = 0; c < 32; ++c) {
            const size_t cu = (size_t)bh * 32 + c;
            const v2u lw = *(const v2u*)(loc + cu * 8192 + e);
            const f32x4 lv = {__builtin_bit_cast(float, lw.x << 16), __builtin_bit_cast(float, lw.x & 0xffff0000u), __builtin_bit_cast(float, lw.y << 16), __builtin_bit_cast(float, lw.y & 0xffff0000u)};
            const f32x4 dv = *(const f32x4*)(dec + cu * 64 + dk);
            v2u w; w.x = pk2(st.x, st.y); w.y = pk2(st.z, st.w);
            *(v2u*)(gs + cu * 8192 + e) = w;
            st = dv * st + lv;
        }
    }
}
__device__ __forceinline__ void gla_phase_c(const P& p, int l, LAS unsigned char* lds, int vcu, int G) {
    int tid = threadIdx.x; asm volatile("" : "+v"(tid));
    const int lane = tid & 63, wave = __builtin_amdgcn_readfirstlane(tid >> 6), hh = lane >> 5, r32 = lane & 31;
    const bf16* proj = WSP(bf16, WS_PROJ); const bf16* gs = (const bf16*)((const unsigned char*)p.out + 96 * MiB); bf16* y = WSP(bf16, WS_Y); const _Float16* gb = WSP(const _Float16, WS_GB);
    const int dvb = wave >> 1, tb = wave & 1;
    const int trow = (lane & 15) >> 2, tcol = 16 * ((lane >> 4) & 1) + 4 * (lane & 3);
    bf16 n_q[8], n_k[8]; v4u n_v[2], n_g[2]; bf16x8 n_s[4]; f32x4 n_n[4]; float n_b[8], n_r = 0.f;
#define GC_LOAD(uu) do { const int c_ = (uu) & 31, h_ = ((uu) >> 5) & 3, b_ = (uu) >> 7; const size_t t0_ = (size_t)b_ * SEQ + c_ * 64; \
        _Pragma("unroll") for (int j = 0; j < 8; ++j) { const bf16* rp = proj + (t0_ + wave * 8 + j) * PW + h_ * 64 + lane; n_q[j] = rp[C_GQ]; n_k[j] = rp[C_GK]; } \
        _Pragma("unroll") for (int i = 0; i < 2; ++i) { const int idx = tid + NTHR * i, t = idx >> 4, cc = idx & 15; n_v[i] = *(const v4u*)(proj + (t0_ + t) * PW + C_GV + h_ * 128 + cc * 8); n_g[i] = *(const v4u*)(proj + (t0_ + t) * PW + C_GG + h_ * 128 + cc * 8); } \
        { const bf16* sp = gs + (size_t)(uu) * 8192 + (size_t)(32 * dvb + r32) * 64 + 8 * hh; \
          _Pragma("unroll") for (int s2 = 0; s2 < 4; ++s2) n_s[s2] = *(const bf16x8*)(sp + 16 * s2); } \
        _Pragma("unroll") for (int j = 0; j < 8; ++j) n_b[j] = (float)gb[(t0_ + wave * 8 + j) * 256 + h_ * 64 + lane]; \
        n_r = (float)gb[(t0_ + 31) * 256 + h_ * 64 + lane]; \
        _Pragma("unroll") for (int g = 0; g < 4; ++g) { const int dv = 32 * dvb + 8 * g + 4 * hh; \
            n_n[g] = *(const f32x4*)(p.gla_gain + l * 512 + h_ * 128 + dv); } } while (0)
    if (vcu < 2048) GC_LOAD(vcu);
    __syncthreads();
    for (int u = vcu; u < 2048; u += G) {
        const int c = u & 31, h = (u >> 5) & 3, b = u >> 7;
        const size_t tok0 = (size_t)b * SEQ + c * 64;
        bf16x8 sfr[4]; f32x4 gnr[4];
#pragma unroll
        for (int i = 0; i < 4; ++i) { sfr[i] = n_s[i]; gnr[i] = n_n[i]; }
#pragma unroll
        for (int i = 0; i < 2; ++i) { const int idx = tid + NTHR * i, t = idx >> 4, cc = idx & 15; *(LAS v4u*)(lds + GL_V + t * 320 + cc * 16) = n_v[i]; *(LAS v4u*)(lds + GL_GG + t * 272 + cc * 16) = n_g[i]; }
        { const float rref = n_r;
#pragma unroll
          for (int j = 0; j < 8; ++j) { const int t = wave * 8 + j; const float bt = n_b[j];
            const float qv = bf2f(n_q[j]), kv = bf2f(n_k[j]);
            *(LAS bf16*)(lds + GL_Q1 + t * 144 + lane * 2) = (bf16)f2bf(qv * __expf(bt));
            *(LAS bf16*)(lds + GL_Q2 + t * 144 + lane * 2) = (bf16)f2bf(qv * __expf(bt - rref));
            *(LAS bf16*)(lds + GL_K2 + t * 144 + lane * 2) = (bf16)f2bf(kv * __expf(rref - bt)); } }
        __syncthreads();
        if (u + G < 2048) GC_LOAD(u + G);
        f32x16 o = {};
        {
#pragma unroll
          for (int s = 0; s < 4; ++s) { const bf16x8 af = sfr[s]; const bf16x8 bq = *(const LAS bf16x8*)(lds + GL_Q1 + (32 * tb + r32) * 144 + (16 * s + 8 * hh) * 2);
              o = __builtin_amdgcn_mfma_f32_32x32x16_bf16(af, bq, o, 0, 0, 0); } }
#pragma unroll
        for (int sb = 0; sb < 2; ++sb) {
            if (sb <= tb) {
                f32x16 pt = {};
#pragma unroll
                for (int s = 0; s < 4; ++s) { const bf16x8 ak = *(const LAS bf16x8*)(lds + GL_K2 + (32 * sb + r32) * 144 + (16 * s + 8 * hh) * 2); const bf16x8 bq = *(const LAS bf16x8*)(lds + GL_Q2 + (32 * tb + r32) * 144 + (16 * s + 8 * hh) * 2);
                    pt = __builtin_amdgcn_mfma_f32_32x32x16_bf16(ak, bq, pt, 0, 0, 0); }
                if (sb == tb) {
#pragma unroll
                    for (int r = 0; r < 16; ++r) { const int s_ = (r & 3) + 8 * (r >> 2) + 4 * hh; if (s_ > r32) pt[r] = 0.f; }
                }
#pragma unroll
                for (int ks = 0; ks < 2; ++ks) {
                    const bf16x8 pa = pack8(pt, 8 * ks);
                    const bf16x8 vf = tr_frag(lds + GL_V + (32 * sb + 16 * ks + 4 * hh + trow) * 320 + (32 * dvb + tcol) * 2, 8 * 320);
                    o = __builtin_amdgcn_mfma_f32_32x32x16_bf16(vf, pa, o, 0, 0, 0);
                }
            }
        }
        float ss = 0.f;
#pragma unroll
        for (int r = 0; r < 16; ++r) ss += o[r] * o[r];
        ss += __shfl_xor(ss, 32);
        LAS float* sq = (LAS float*)(lds + GL_SSQ);
        if (hh == 0) sq[dvb * 64 + 32 * tb + r32] = ss;
        __syncthreads();
        const int t = 32 * tb + r32;
        const float tot = (sq[t] + sq[64 + t]) + (sq[128 + t] + sq[192 + t]);
        const float rs = rsqrtf(tot * (1.0f / 128.0f) + EPS);
#pragma unroll
        for (int g = 0; g < 4; ++g) {
            const int dv = 32 * dvb + 8 * g + 4 * hh;
            const f32x4 gn = gnr[g];
            const v2u gg = *(const LAS v2u*)(lds + GL_GG + t * 272 + dv * 2);
            const float g0 = bf2f((bf16)(gg.x & 0xffff)), g1 = bf2f((bf16)(gg.x >> 16)), g2 = bf2f((bf16)(gg.y & 0xffff)), g3 = bf2f((bf16)(gg.y >> 16));
            const float v0 = o[4 * g] * rs * gn.x * g0 * __builtin_amdgcn_rcpf(1.f + __expf(-g0)), v1 = o[4 * g + 1] * rs * gn.y * g1 * __builtin_amdgcn_rcpf(1.f + __expf(-g1));
            const float v2 = o[4 * g + 2] * rs * gn.z * g2 * __builtin_amdgcn_rcpf(1.f + __expf(-g2)), v3 = o[4 * g + 3] * rs * gn.w * g3 * __builtin_amdgcn_rcpf(1.f + __expf(-g3));
            v2u w; w.x = cvtpk(v0, v1); w.y = cvtpk(v2, v3);
            *(LAS v2u*)(lds + GL_YST + t * 272 + dv * 2) = w;
        }
        __syncthreads();
#pragma unroll
        for (int i = 0; i < 2; ++i) { const int idx = tid + NTHR * i, tr_ = idx >> 4, ch = idx & 15;
            st_b128(y + (tok0 + tr_) * DM + 512 + h * 128 + ch * 8, *(const LAS v4u*)(lds + GL_YST + tr_ * 272 + ch * 16)); }
    }
#undef GC_LOAD
}
__device__ __forceinline__ void fox_cumsum_phase(const P& p, int l, LAS unsigned char* lds, int vcu, int G) {
    int tid = threadIdx.x; asm volatile("" : "+v"(tid));
    const int lane = tid & 63, wave = __builtin_amdgcn_readfirstlane(tid >> 6);
    const float* sm = WSP(float, WS_SM); float* cb = WSP(float, WS_CB);
    LAS float* tot = (LAS float*)(lds + 256);
    for (int u = vcu; u < NBATCH * 8; u += G) {
        const int b = u >> 3, h = u & 7;
        const float bias = p.b_forget[l * 8 + h];
        const int s0 = wave * 256 + lane * 4;
        float v[4]; float run = 0.f;
#pragma unroll
        for (int j = 0; j < 4; ++j) v[j] = sm[((size_t)b * SEQ + s0 + j) * 32 + h];
#pragma unroll
        for (int j = 0; j < 4; ++j) { run += fast_log_sigmoid(v[j] + bias); v[j] = run; }
        float pre = run;
#pragma unroll
        for (int o = 1; o < 64; o <<= 1) { const float t = __shfl_up(pre, o); if (lane >= o) pre += t; }
        __syncthreads();
        if (lane == 63) tot[wave] = pre;
        __syncthreads();
        float base = pre - run;
#pragma unroll
        for (int w_ = 0; w_ < 8; ++w_) { const float t = tot[w_]; if (w_ < wave) base += t; }
        f32x4 o4; o4.x = -(v[0] + base) * LOG2E; o4.y = -(v[1] + base) * LOG2E; o4.z = -(v[2] + base) * LOG2E; o4.w = -(v[3] + base) * LOG2E;
        *(f32x4*)(cb + ((size_t)b * 8 + h) * SEQ + s0) = o4;
    }
}
__device__ __forceinline__ void fox_knorm_phase(const P& p, int vcu, int G) {
    int tid = threadIdx.x; asm volatile("" : "+v"(tid));
    const int lane = tid & 63, wave = __builtin_amdgcn_readfirstlane(tid >> 6);
    const bf16* proj = WSP(bf16, WS_PROJ); float* kn = WSP(float, WS_MOE + MO_KN);
    for (int task = vcu * NWAVES + wave; task < NBATCH * 8 * 32; task += G * NWAVES) {
        const int j = task & 31, h = (task >> 5) & 7, b = task >> 8;
        float mx = 0.f;
#pragma unroll
        for (int i = 0; i < 8; ++i) {
            const v4u w = *(const v4u*)(proj + ((size_t)b * SEQ + j * 64 + i * 8 + (lane >> 3)) * PW + C_FK + h * 64 + (lane & 7) * 8);
            const unsigned ww[4] = {w.x, w.y, w.z, w.w}; float ss = 0.f;
#pragma unroll
            for (int e = 0; e < 4; ++e) { const float a = __builtin_bit_cast(float, ww[e] << 16), c = __builtin_bit_cast(float, ww[e] & 0xffff0000u); ss += a * a + c * c; }
            ss += __shfl_xor(ss, 1); ss += __shfl_xor(ss, 2); ss += __shfl_xor(ss, 4);
            mx = fmaxf(mx, ss);
        }
        mx = wave_max(mx);
        if (lane == 0) kn[task] = sqrtf(mx) * 1.0001f;
    }
}
__device__ __forceinline__ void router_weights(const P& p, int gtid, int gstride) {
    for (int idx = gtid; idx < NLAYER * 32768; idx += gstride) {
        const int l = idx >> 15, r = idx & 32767, k = r >> 5, n = r & 31;
        float v = 0.f;
        if (n < 16) v = p.w_re[((size_t)l * DM + k) * 16 + n]; else if (n < 20) v = p.w_rg[((size_t)l * DM + k) * 4 + (n - 16)];
        v *= p.moe_norm[l * DM + k];
        float* wr = (float*)(ws_base(p.ws) + WS_W + (size_t)l * WS_WLAYER + WO_RHI);
        wr[((((k >> 5) * 4 + ((k >> 3) & 3)) * 2 + ((k >> 2) & 1)) * 32 + n) * 4 + (k & 3)] = v;
    }
}
__device__ __forceinline__ void route_phase(const P& p, int l, LAS unsigned char* lds, int t0, int tstep) {
    int tid = threadIdx.x; asm volatile("" : "+v"(tid));
    const int lane = tid & 63, wave = __builtin_amdgcn_readfirstlane(tid >> 6);
    { const v4u* src = (const v4u*)(ws_base(p.ws) + WS_W + (size_t)l * WS_WLAYER + WO_RHI);
#pragma unroll 4
      for (int i = 0; i < 16; ++i) *(LAS v4u*)(lds + LDS_STAGE + (tid + NTHR * i) * 16) = src[tid + NTHR * i]; }
    LAS int* hist = (LAS int*)(lds + LDS_GATE);
    LAS int* tokj = hist + 32; LAS f32x2_t* tokgl = (LAS f32x2_t*)(hist + 160); LAS int* basej = hist + 416;
    const bf16* HBp = WSP(const bf16, WS_HB);
    int* gcnt = WSP(int, WS_MOE + MO_GCNT) + l * 32; int* rowtok2 = WSP(int, WS_RT2); f32x2_t* rowg2 = WSP(f32x2_t, WS_RG2);
    LAS float* lgb = (LAS float*)(lds + LDS_RS + wave * 2048);
    const int r = lane & 15, kq = lane >> 4;
    for (int task0 = t0; task0 < NTOK / 16; task0 += tstep) {
        if (tid < 32) hist[tid] = 0;
        __syncthreads();
        const int tok0 = (task0 + wave) * 16;
        const v4u* hp = (const v4u*)(HBp + (size_t)(tok0 + r) * DM + 8 * kq);
        f32x4 acc0 = {0.f, 0.f, 0.f, 0.f}, acc1 = {0.f, 0.f, 0.f, 0.f}; float q = 0.f;
#pragma unroll 8
        for (int s = 0; s < 32; ++s) {
            const v4u aw = hp[4 * s];
            const unsigned ww[4] = {aw.x, aw.y, aw.z, aw.w};
            const LAS unsigned char* bp = lds + LDS_STAGE + ((s * 4 + kq) * 2 * 32 + r) * 16;
            const f32x4 b00 = *(const LAS f32x4*)(bp), b01 = *(const LAS f32x4*)(bp + 32 * 16), b10 = *(const LAS f32x4*)(bp + 16 * 16), b11 = *(const LAS f32x4*)(bp + 48 * 16);
#pragma unroll
            for (int e = 0; e < 4; ++e) {
                const float a0 = __builtin_bit_cast(float, ww[e] << 16), a1 = __builtin_bit_cast(float, ww[e] & 0xffff0000u);
                q += a0 * a0 + a1 * a1;
                const f32x4& bl = e < 2 ? b00 : b01; const f32x4& bh = e < 2 ? b10 : b11;
                acc0 = __builtin_amdgcn_mfma_f32_16x16x4f32(a0, bl[(2 * e) & 3], acc0, 0, 0, 0); acc1 = __builtin_amdgcn_mfma_f32_16x16x4f32(a0, bh[(2 * e) & 3], acc1, 0, 0, 0);
                acc0 = __builtin_amdgcn_mfma_f32_16x16x4f32(a1, bl[(2 * e + 1) & 3], acc0, 0, 0, 0); acc1 = __builtin_amdgcn_mfma_f32_16x16x4f32(a1, bh[(2 * e + 1) & 3], acc1, 0, 0, 0);
            }
        }
        q += __shfl_xor(q, 16); q += __shfl_xor(q, 32);
        const float rsv = rsqrtf(q * (1.0f / DM) + EPS);
        const float bias0 = p.b_re[l * 16 + r], bias1 = r < 4 ? p.b_rg[l * 4 + r] : 0.f;
#pragma unroll
        for (int g = 0; g < 4; ++g) { const int row = 4 * kq + g; const float rs = __shfl(rsv, row);
            lgb[row * 32 + r] = acc0[g] * rs + bias0; lgb[row * 32 + 16 + r] = acc1[g] * rs + bias1; }
        LDS_WAIT();
        if (lane < 16) {
            const int tok = tok0 + lane;
            const LAS f32x4* lr = (const LAS f32x4*)(lgb + lane * 32);
            const f32x4 e0 = lr[0], e1 = lr[1], e2 = lr[2], e3 = lr[3], gl = lr[4];
            int g = 0; float gm = gl.x;
            if (gl.y > gm) { gm = gl.y; g = 1; } if (gl.z > gm) { gm = gl.z; g = 2; } if (gl.w > gm) { gm = gl.w; g = 3; }
            const float den = (expf(gl.x - gm) + expf(gl.y - gm)) + (expf(gl.z - gm) + expf(gl.w - gm));
            const float pg = 1.0f / den;
            const f32x4 el = g == 0 ? e0 : (g == 1 ? e1 : (g == 2 ? e2 : e3));
            int i0 = 0; float m0 = el.x;
            if (el.y > m0) { m0 = el.y; i0 = 1; } if (el.z > m0) { m0 = el.z; i0 = 2; } if (el.w > m0) { m0 = el.w; i0 = 3; }
            int i1 = -1; float m1 = -INFINITY;
            if (i0 != 0 && el.x > m1) { m1 = el.x; i1 = 0; } if (i0 != 1 && el.y > m1) { m1 = el.y; i1 = 1; }
            if (i0 != 2 && el.z > m1) { m1 = el.z; i1 = 2; } if (i0 != 3 && el.w > m1) { m1 = el.w; i1 = 3; }
            const float ex = expf(m1 - m0), inv = 1.0f / (1.0f + ex);
            const int elo = i0 < i1 ? i0 : i1, ehi = i0 < i1 ? i1 : i0;
            const int j = g * 8 + (elo == 0 ? ehi - 1 : (elo == 1 ? ehi + 1 : 5));
            const float g0 = pg * inv, g1 = pg * ex * inv;
            tokj[wave * 16 + lane] = j; tokgl[wave * 16 + lane] = i0 < i1 ? (f32x2_t){g0, g1} : (f32x2_t){g1, g0};
            atomicAdd((int*)&hist[j], 1);
        }
        __syncthreads();
        if (tid < 32) { const int n = hist[tid]; basej[tid] = n > 0 ? atomicAdd(&gcnt[tid], n) : 0; }
        __syncthreads();
        if (wave == 0) {
            int run[32];
#pragma unroll
            for (int x = 0; x < 32; ++x) run[x] = 0;
#pragma unroll 1
            for (int half = 0; half < 2; ++half) {
                const int t = half * 64 + lane, j = tokj[t];
                int rank = 0;
#pragma unroll
                for (int x = 0; x < 32; ++x) { if ((x & 7) >= 6) continue; const unsigned long long mk = __ballot(j == x); if (j == x) rank = run[x] + __popcll(mk & ((1ull << lane) - 1ull)); run[x] += __popcll(mk); }
                const int pos = basej[j] + rank;
                rowtok2[(size_t)j * BCAP + pos] = task0 * 16 + t; rowg2[(size_t)j * BCAP + pos] = tokgl[t];
            }
        }
    }
}
__device__ __forceinline__ int moe_tables(const P& p, int l, LAS unsigned char* lds) {
    int tid = threadIdx.x; asm volatile("" : "+v"(tid));
    LAS int* mt = (LAS int*)(lds + LDS_MOET);
    const int* gcnt = WSP(const int, WS_MOE + MO_GCNT) + l * 32;
    if (tid < 32) mt[tid] = gcnt[tid];
    __syncthreads();
    if (tid == 0) { int t = 0; for (int j = 0; j < 32; ++j) { mt[32 + j] = t; t += (mt[j] + 255) >> 8; } mt[64] = t; }
    __syncthreads();
    if (tid < MAXTILES) { int j = 0;
        for (int x = 1; x < 32; ++x) if (mt[32 + x] <= tid) j = x;
        const int g = j >> 3, pi = j & 7, elo = pi < 3 ? 0 : (pi < 5 ? 1 : 2), ehi = pi < 3 ? pi + 1 : (pi < 5 ? pi - 1 : 3);
        mt[96 + tid] = j | ((g * 4 + elo) << 8) | ((g * 4 + ehi) << 16); }
    __syncthreads();
    return __builtin_amdgcn_readfirstlane(mt[64]);
}
__device__ __forceinline__ void final_phase(const P& p, int vcu, int G) {
    int tid = threadIdx.x; asm volatile("" : "+v"(tid));
    const int lane = tid & 63, wave = __builtin_amdgcn_readfirstlane(tid >> 6);
    const float* ssq = WSP(const float, WS_SSQ); const bf16* hb = WSP(const bf16, WS_HB);
    f32x4 g[4];
#pragma unroll
    for (int j = 0; j < 4; ++j) g[j] = ((const f32x4*)p.final_norm)[lane + 64 * j];
    for (int m0 = (vcu * NWAVES + wave) * 4; m0 < NTOK; m0 += G * NWAVES * 4) {
        v2u w[4][4]; float rs[4];
#pragma unroll
        for (int r = 0; r < 4; ++r) { rs[r] = row_rs(ssq, m0 + r);
#pragma unroll
            for (int j = 0; j < 4; ++j) w[r][j] = ((const v2u*)(hb + (size_t)(m0 + r) * DM))[lane + 64 * j]; }
#pragma unroll
        for (int r = 0; r < 4; ++r) { f32x4* s = (f32x4*)(p.out + (size_t)(m0 + r) * DM) + lane;
#pragma unroll
            for (int j = 0; j < 4; ++j) { f32x4 v; v.x = __builtin_bit_cast(float, w[r][j].x << 16); v.y = __builtin_bit_cast(float, w[r][j].x & 0xffff0000u); v.z = __builtin_bit_cast(float, w[r][j].y << 16); v.w = __builtin_bit_cast(float, w[r][j].y & 0xffff0000u);
                s[64 * j] = v * rs[r] * g[j]; } }
    }
}
#ifndef ENMASK
#define ENMASK 0xffffffffu
#endif
#define EN(b) (((ENMASK) >> (b)) & 1u)
#ifndef REPMASK
#define REPMASK 0u
#endif
#define REPN(b) ((((REPMASK) >> (b)) & 1u) ? 2 : 1)
__device__ __attribute__((noinline)) void grid_barrier(unsigned* barw, unsigned x, volatile LAS unsigned* st) { XcdBarrier b; b.bar = barw; b.x = x; b.st = st; xcd_barrier(b); }
__device__ __attribute__((noinline)) void pair_sync(unsigned* flag, unsigned* barw, int same) {
    asm volatile("s_waitcnt vmcnt(0)" ::: "memory");
    __syncthreads();
    if (threadIdx.x == 0) {
        __builtin_amdgcn_s_waitcnt(0);
        if (!same) { __builtin_amdgcn_fence(__ATOMIC_RELEASE, "agent"); asm volatile("s_waitcnt vmcnt(0)" ::: "memory"); }
        (void)xb_add(flag, 1u);
        XB_SPIN(xb_ld(flag) < 2u, barw);
        __builtin_amdgcn_fence(__ATOMIC_ACQUIRE, "agent");
        asm volatile("s_waitcnt vmcnt(0)" ::: "memory");
    }
    __syncthreads();
}
__global__ void __launch_bounds__(NTHR, 2) fwd(Args args) {
    extern __shared__ __attribute__((aligned(16))) unsigned char lds_raw[];
    LAS unsigned char* lds = (LAS unsigned char*)lds_raw;
    const P& p = args.p;
    const int tid = threadIdx.x, lane = tid & 63, wave = __builtin_amdgcn_readfirstlane(tid >> 6);
    const int G = gridDim.x; const int bx = blockIdx.x; const int vcu = (G % 8 == 0) ? (bx % 8) * (G / 8) + bx / 8 : bx;
    volatile LAS unsigned* MISC = (volatile LAS unsigned*)(lds + LDS_MISC);
    if (tid < 64) MISC[tid] = 0u;
    __syncthreads();
    unsigned* ctl = (unsigned*)(p.ws + WS_CTL);
    const int lo = args.ph_lo, hi = args.ph_hi;
    XcdBarrier bar; bar.bar = ctl + CW_BAR + args.li * XCD_BAR_WORDS; bar.x = 0; bar.st = nullptr;
    if (hi - lo > 1) bar = xcd_barrier_post(ctl + CW_BAR + args.li * XCD_BAR_WORDS, MISC);
    if (tid == 0) __hip_atomic_store(ctl + CW_XID + vcu, xb_xcc_id(), __ATOMIC_RELAXED, __HIP_MEMORY_SCOPE_AGENT);
#define IN(k) (lo <= (k) && (k) < hi)
#define PHL int vcuL = vcu, GL = G, bxL = bx; asm volatile("" : "+s"(vcuL), "+s"(GL), "+s"(bxL)); (void)vcuL; (void)GL; (void)bxL;
#define LTID(v) int v = threadIdx.x; asm volatile("" : "+v"(v))
#define FILL_RS_DENSE() do { LTID(tq); const int rr_ = tq & 255, hf_ = tq >> 8; f32x4 sv_[4][4]; bool ok_[4]; \
        _Pragma("unroll") for (int k_ = 0; k_ < 4; ++k_) { pg8::Unit u_ = {0, 0, 0}; ok_[k_] = S.next(hf_ + 2 * k_, u_); const f32x4* sp_ = (const f32x4*)(SSQ + (size_t)(ok_[k_] ? u_.pm * 256 + rr_ : 0) * 16); \
            _Pragma("unroll") for (int j_ = 0; j_ < 4; ++j_) sv_[k_][j_] = sp_[j_]; } \
        _Pragma("unroll") for (int k_ = 0; k_ < 4; ++k_) if (ok_[k_]) { const f32x4 a_ = (sv_[k_][0] + sv_[k_][1]) + (sv_[k_][2] + sv_[k_][3]); rstab[(hf_ + 2 * k_) * 256 + rr_] = rsqrtf(((a_.x + a_.y) + (a_.z + a_.w)) * (1.0f / DM) + EPS); } } while (0)
#define MOE_ROW(k_) pg8::Unit u_ = {0, 0, 0}; ok_[k_] = S.next(hf_ + 2 * k_, u_); const int j_ = u_.e & 255, sl_ = (u_.pm - moet[32 + j_]) * 256 + rr_; const bool v_ = ok_[k_] && sl_ < moet[j_]; \
        const size_t ix_ = (size_t)j_ * BCAP + (v_ ? sl_ : 0);
#define FILL_GU() do { LTID(tq); const int rr_ = tq & 255, hf_ = tq >> 8; f32x4 sv_[4][4]; bool ok_[4]; int tk_[4]; float gt_[4]; \
        _Pragma("unroll") for (int k_ = 0; k_ < 4; ++k_) { MOE_ROW(k_) const int t_ = RT2[ix_]; const f32x2_t g2_ = RG2[ix_]; tk_[k_] = v_ ? t_ : -1; gt_[k_] = v_ ? (u_.pn < 4 ? g2_.x : g2_.y) : 0.f; } \
        _Pragma("unroll") for (int k_ = 0; k_ < 4; ++k_) { tk_[k_] = tk_[k_] < 0 ? 0 : tk_[k_]; const f32x4* sp_ = (const f32x4*)(SSQ + (size_t)tk_[k_] * 16); \
            _Pragma("unroll") for (int j_ = 0; j_ < 4; ++j_) sv_[k_][j_] = sp_[j_]; } \
        _Pragma("unroll") for (int k_ = 0; k_ < 4; ++k_) if (ok_[k_]) { const f32x4 a_ = (sv_[k_][0] + sv_[k_][1]) + (sv_[k_][2] + sv_[k_][3]); rowtab[(hf_ + 2 * k_) * 256 + rr_] = tk_[k_]; gatetab[(hf_ + 2 * k_) * 256 + rr_] = gt_[k_]; \
            rstab[(hf_ + 2 * k_) * 256 + rr_] = rsqrtf(((a_.x + a_.y) + (a_.z + a_.w)) * (1.0f / DM) + EPS); } } while (0)
#define FILL_DOWN() do { LTID(tq); const int rr_ = tq & 255, hf_ = tq >> 8; bool ok_[4]; int tk_[4]; \
        _Pragma("unroll") for (int k_ = 0; k_ < 4; ++k_) { MOE_ROW(k_) const int t_ = RT2[ix_]; tk_[k_] = v_ ? t_ : -1; } \
        _Pragma("unroll") for (int k_ = 0; k_ < 4; ++k_) if (ok_[k_]) { rowtab[(hf_ + 2 * k_) * 256 + rr_] = tk_[k_]; } } while (0)

#define SEAM(k) do { if (IN(k) && IN((k) + 1)) { grid_barrier(bar.bar, bar.x, bar.st); if (REPN(20) == 2) grid_barrier(bar.bar, bar.x, bar.st); } } while (0)
    LAS float* rstab = (LAS float*)(lds + LDS_RS); LAS int* rowtab = (LAS int*)(lds + LDS_ROWTOK); LAS float* gatetab = (LAS float*)(lds + LDS_GATE); const LAS int* moet = (const LAS int*)(lds + LDS_MOET);
#define HB WSP(bf16, WS_HB)
#define PROJ WSP(bf16, WS_PROJ)
#define Y WSP(bf16, WS_Y)
#define XKV WSP(bf16, WS_XKV)
#define MEMN WSP(bf16, WS_MEMN)
#define SSQ WSP(float, WS_SSQ)
#define XQ WSP(bf16, WS_XQ)
#define U WSP(bf16, WS_U)
#define RT2 WSP(const int, WS_RT2)
#define RG2 WSP(const f32x2_t, WS_RG2)
#define H (p.out)
#define HB8 ((unsigned char*)p.out + 64 * MiB)
#define U8 WSP(unsigned char, WS_U)

    if (EN(0) && IN(PH_PRO)) _Pragma("unroll 1") for (int rep_ = 0; rep_ < REPN(0); ++rep_) { PHL prologue(p, lds, vcuL, GL, wave, lane); }
    SEAM(PH_PRO);
    if (REPN(18) == 2 && IN(PH_XKV)) { PHL
        pg8::StaticOrder S; S.init(HB, ws_base(p.ws) + WS_W + WO_IN, NTOK, 3072, DM, GL, bxL);
        FILL_RS_DENSE();
        __syncthreads();
        EpiBf16<true> E{PROJ, PW, rstab};
        pg8::gemm_phase<DM, EpiBf16<true>, pg8::StaticOrder, true>(lds + LDS_STAGE, S, E);
    }
    for (int l = 0; l < NLAYER; ++l) {
        const int pb = PH_L0 + l * NPH;
        unsigned char* wl = ws_base(p.ws) + WS_W + (size_t)l * WS_WLAYER;
        if (EN(2) && IN(pb + LP_INPROJ)) _Pragma("unroll 1") for (int rep_ = 0; rep_ < REPN(2); ++rep_) { PHL
            pg8::StaticOrder S; S.init(HB, wl + WO_IN, NTOK, 3072, DM, GL, bxL);
            FILL_RS_DENSE();
            __syncthreads();
            EpiBf16<true> E{PROJ, PW, rstab};
            pg8::gemm_phase<DM, EpiBf16<true>, pg8::StaticOrder, true>(lds + LDS_STAGE, S, E);
            _Pragma("unroll 1") for (int r2_ = 0; r2_ < REPN(19); ++r2_) small_proj(p, l, lds + LDS_STAGE, vcuL, GL, wave, lane);
        }
        SEAM(pb + LP_INPROJ);
        if (EN(11) && IN(pb + LP_MIXA)) _Pragma("unroll 1") for (int rep_ = 0; rep_ < REPN(11); ++rep_) { PHL gla_phase_a(p, l, lds + LDS_STAGE, vcuL, GL); fox_cumsum_phase(p, l, lds + LDS_STAGE, vcuL, GL); fox_knorm_phase(p, vcuL, GL); }
        SEAM(pb + LP_MIXA);
        if (EN(12) && IN(pb + LP_MIXB)) _Pragma("unroll 1") for (int rep_ = 0; rep_ < REPN(12); ++rep_) { PHL gla_phase_b(p, vcuL, GL); }
        if (EN(1) && l == 0 && IN(pb + LP_MIXB)) { PHL
            pg8::StaticOrder S; S.init(MEMN, ws_base(p.ws) + WS_WXKV, 4096, 2048, DM, GL, bxL);
            EpiBf16<false> E{XKV, 2048, rstab};
            pg8::gemm_phase<DM, EpiBf16<false>, pg8::StaticOrder, true>(lds + LDS_STAGE, S, E);
        }
        SEAM(pb + LP_MIXB);
        if (EN(9) && IN(pb + LP_MIXC)) { PHL _Pragma("unroll 1") for (int rep_ = 0; rep_ < REPN(16); ++rep_) fox_phase(p, l, lds + LDS_STAGE, vcuL, GL); _Pragma("unroll 1") for (int rep_ = 0; rep_ < REPN(17); ++rep_) gla_phase_c(p, l, lds + LDS_STAGE, vcuL, GL); }
        SEAM(pb + LP_MIXC);
        if (IN(pb + LP_WOUT)) { PHL
            const int side = vcuL & 1;
            const int same = (int)((unsigned)__builtin_amdgcn_readfirstlane((int)xb_ld(ctl + CW_XID + (vcuL ^ 1))) == xb_xcc_id());
            for (int pm = vcuL >> 1; pm < NTOK / 256; pm += GL >> 1) {
                unsigned* pf = ctl + CW_PF + ((l * 3) * 128 + pm) * 16;
                { pg8::PairOrder S{(const char*)Y, (const char*)(wl + WO_OUT), DM, pm, 2 * side, 2};
                  EpiRes<0> E{HB, SSQ, rowtab, 1.f, nullptr};
                  pg8::gemm_phase<DM, EpiRes<0>, pg8::PairOrder, true>(lds + LDS_STAGE, S, E); }
                pair_sync(pf, bar.bar, same);
                { pg8::PairOrder S{(const char*)HB, (const char*)(wl + WO_XQ), DM, pm, side, 1};
                  FILL_RS_DENSE();
                  __syncthreads();
                  EpiBf16<true> E{XQ, 512, rstab};
                  pg8::gemm_phase<DM, EpiBf16<true>, pg8::PairOrder, true>(lds + LDS_STAGE, S, E);
                  asm volatile("s_waitcnt vmcnt(0)" ::: "memory"); __syncthreads();
                  xattn_pair(p, l, lds + LDS_STAGE, pm, side, false); }
                pair_sync(pf + 128 * 16, bar.bar, same);
                { pg8::PairOrder S{(const char*)WSP(unsigned char, WS_XO8), (const char*)(wl + WO_XO), 256, pm, 2 * side, 2};
                  EpiRes<0, true> E{HB, SSQ, rowtab, 1.f, HB8};
                  pg8::gemm_phase<256, EpiRes<0, true>, pg8::PairOrder, true, true, 127, 122>(lds + LDS_STAGE, S, E); }
                pair_sync(pf + 2 * 128 * 16, bar.bar, same);
                route_phase(p, l, lds, (pm * 2 + side) * NWAVES, NTOK);
            }
        }
        SEAM(pb + LP_ROUTE);
        if (IN(pb + LP_GU)) { PHL
            const int T_ = moe_tables(p, l, lds);
            int gsame;
            { const unsigned idv = xb_ld(ctl + CW_XID + (vcuL & ~31) + (threadIdx.x & 31)); gsame = (int)(__builtin_amdgcn_ballot_w64(idv != xb_xcc_id()) == 0ull); }
            unsigned* gfl = ctl + CW_GF + l * MAXTILES * 16;
            { MoeOrder<0> S{(const char*)HB8, (const char*)(wl + WO_GU), 512, (size_t)1024 * 1024, moet + 96, rowtab, gfl, bar.bar, gsame}; S.init_group(T_, GL, vcuL);
              __syncthreads();
              FILL_GU();
              __syncthreads();
              EpiGU E{U8, rstab, gatetab};
              pg8::gemm_phase<512, EpiGU, MoeOrder<0>, true, true, 127, 122>(lds + LDS_STAGE, S, E); }
            { MoeOrder<1> S{(const char*)U8, (const char*)(wl + WO_D), 512, (size_t)1024 * 512, moet + 96, rowtab, gfl, bar.bar, gsame}; S.init_group(T_, GL, vcuL);
              __syncthreads();
              FILL_DOWN();
              __syncthreads();
              EpiRes<2> E{HB, SSQ, rowtab, 1.f, nullptr};
              pg8::gemm_phase<512, EpiRes<2>, MoeOrder<1>, true, true, 125, 122, 256, true>(lds + LDS_STAGE, S, E); }
        }
        SEAM(pb + LP_DOWN1);
    }
    if (EN(15) && IN(PH_FINAL)) _Pragma("unroll 1") for (int rep_ = 0; rep_ < REPN(15); ++rep_) { PHL final_phase(p, vcuL, GL); }
#undef IN
#undef SEAM
#undef HB
#undef PROJ
#undef Y
#undef XKV
#undef MEMN
#undef SSQ
#undef XQ
#undef U
#undef RT2
#undef RG2
#undef H
#undef HB8
#undef U8
}

static int g_grid = 0;
static void launch_fast(const P& p, int lo, int hi, int& li, hipStream_t stream) {
    Args a{}; a.p = p; a.ph_lo = lo; a.ph_hi = hi; a.li = li++; a.pad = 0;
    hipLaunchKernelGGL(fwd, dim3(g_grid), dim3(NTHR), LDS_BYTES, stream, a);
    const hipError_t le = hipPeekAtLastError();
    if (le != hipSuccess) fprintf(stderr, "kernel_launch: fwd launch [%d,%d) failed: %s\n", lo, hi, hipGetErrorName(le));
}
extern "C" void kernel_launch(void* const* d_in, const int* in_sizes, int n_in, void* d_out, int out_size, void* d_ws, size_t ws_size, hipStream_t stream) {
    if (n_in != 25 || out_size != NTOK * DM || ws_size < WS_END2) { fprintf(stderr, "kernel_launch: unexpected sizes n_in %d out %d ws %zu (need %zu)\n", n_in, out_size, ws_size, (size_t)WS_END2); return; }
    if (g_grid == 0) {
        int dev = 0, cus = 0, per_cu = 0;
        if (hipGetDevice(&dev) != hipSuccess || hipDeviceGetAttribute(&cus, hipDeviceAttributeMultiprocessorCount, dev) != hipSuccess) { g_grid = -1; return; }
        if (hipFuncSetAttribute((const void*)fwd, hipFuncAttributeMaxDynamicSharedMemorySize, LDS_BYTES) != hipSuccess) { fprintf(stderr, "kernel_launch: hipFuncSetAttribute failed\n"); g_grid = -1; return; }
        if (hipOccupancyMaxActiveBlocksPerMultiprocessor(&per_cu, (const void*)fwd, NTHR, LDS_BYTES) != hipSuccess || per_cu < 1) { fprintf(stderr, "kernel_launch: occupancy query says %d\n", per_cu); }
        (void)hipGetLastError();
        g_grid = cus & ~31;
    }
    if (g_grid < 0) return;
    P p{};
    const float** pp = (const float**)&p;
    for (int i = 0; i < 25; ++i) pp[i] = (const float*)d_in[i];
    p.out = (float*)d_out; p.ws = (unsigned char*)d_ws;
    if (hipMemsetAsync((char*)d_ws + WS_CTL + (size_t)CW_BAR * 4, 0, (size_t)XCD_BAR_WORDS * 4, stream) != hipSuccess) { fprintf(stderr, "kernel_launch: hipMemsetAsync failed\n"); return; }
    int li = 0;
    launch_fast(p, PH_PRO, PH_END, li, stream);
}
```

```cpp
#include <hip/hip_runtime.h>
#include <cstdio>
#include <cstdint>

constexpr int NTOK = 32768, DM = 1024, NBATCH = 16, SEQ = 2048, NLAYER = 2, MEML = 256;
constexpr int PW = 3072;
constexpr int C_FQ = 0, C_FK = 512, C_FV = 1024, C_GQ = 1536, C_GK = 1792, C_GV = 2048, C_GG = 2560;
constexpr int INW = 3096;
constexpr float EPS = 1e-6f, LOG2E = 1.4426950408889634f;
constexpr int MAXTILES = 288;
constexpr int MAXROWS = MAXTILES * 256;

typedef unsigned short bf16;
__device__ __forceinline__ unsigned f2bf(float f) { unsigned u = __builtin_bit_cast(unsigned, f); return (u + 0x7fffu + ((u >> 16) & 1u)) >> 16; }
__device__ __forceinline__ float bf2f(bf16 b) { return __builtin_bit_cast(float, ((unsigned)b) << 16); }

constexpr size_t MiB = 1u << 20;
constexpr size_t WS_CTL = 0;
constexpr size_t WS_W = 1 * MiB;
constexpr size_t WS_WLAYER = 59 * MiB;
constexpr size_t WS_WXKV = WS_W + 2 * WS_WLAYER;
constexpr size_t WS_HB = WS_WXKV + 4 * MiB;
constexpr size_t WS_PROJ = WS_HB + 64 * MiB;
constexpr size_t WS_XQ = WS_PROJ;
constexpr size_t WS_U = WS_PROJ + 32 * MiB;
constexpr size_t WS_XO8 = WS_U + 40 * MiB;
constexpr size_t WS_SM = WS_PROJ + 192 * MiB;
constexpr size_t WS_CB = WS_SM + 4 * MiB;
constexpr size_t WS_Y = WS_CB + 1 * MiB;
constexpr size_t WS_XKV = WS_Y + 64 * MiB;
constexpr size_t WS_MEMN = WS_XKV + 16 * MiB;
constexpr size_t WS_SSQ = WS_MEMN + 8 * MiB;
constexpr size_t WS_MOE = WS_SSQ + 2 * MiB;
constexpr size_t WS_END = WS_MOE + 2 * MiB;
static_assert(WS_END <= 512 * MiB, "workspace map");
constexpr size_t MO_TOKE = 0;
constexpr size_t MO_TOKG = 256 * 1024;
constexpr size_t MO_ROWTOK = 512 * 1024;
constexpr size_t MO_ROWGATE = 832 * 1024;
constexpr size_t MO_TILEE = 1152 * 1024;
constexpr size_t MO_NT = 1156 * 1024;
constexpr size_t MO_HIST = 1160 * 1024;
constexpr size_t MO_GCNT = 1160 * 1024;
constexpr int BCAP = 32768;
constexpr size_t MO_KN = 1280 * 1024;

struct P {
    const float *x, *mem, *mem_norm, *mix_norm, *w_in, *b_forget, *w_alpha_up, *b_alpha, *fox_gain, *gla_gain, *w_out, *cross_norm, *w_xq, *w_xk, *w_xv, *w_xo,
        *moe_norm, *w_rg, *b_rg, *w_re, *b_re, *w_eg, *w_eu, *w_ed, *final_norm;
    float* out; unsigned char* ws;
};
__host__ __device__ __forceinline__ unsigned char* ws_base(unsigned char* w) {
#if defined(__HIP_DEVICE_COMPILE__)
    size_t z = 0; asm volatile("" : "+s"(z));
    return w + z;
#else
    return w;
#endif
}
#define WSP(T, off) ((T*)(ws_base(p.ws) + (off)))

__device__ __forceinline__ float wave_sum(float v) {
#pragma unroll
    for (int o = 1; o < 64; o <<= 1) v += __shfl_xor(v, o);
    return v;
}
__device__ __forceinline__ float wave_min(float v) {
#pragma unroll
    for (int o = 1; o < 64; o <<= 1) v = fminf(v, __shfl_xor(v, o));
    return v;
}
__device__ __forceinline__ float wave_max(float v) {
#pragma unroll
    for (int o = 1; o < 64; o <<= 1) v = fmaxf(v, __shfl_xor(v, o));
    return v;
}
__device__ __forceinline__ float row_rs(const float* ssq, int row) {
    const float4* s = (const float4*)(ssq + (size_t)row * 16);
    float4 a = s[0], b = s[1], c = s[2], d = s[3];
    float t = ((a.x + a.y) + (a.z + a.w)) + ((b.x + b.y) + (b.z + b.w)) + ((c.x + c.y) + (c.z + c.w)) + ((d.x + d.y) + (d.z + d.w));
    return rsqrtf(t * (1.0f / DM) + EPS);
}
__device__ __forceinline__ float log_sigmoid(float z) { return fminf(z, 0.f) - log1pf(expf(-fabsf(z))); }
__device__ __forceinline__ float silu(float z) { return z / (1.f + expf(-z)); }

typedef unsigned st_v4u __attribute__((ext_vector_type(4)));
typedef unsigned st_v2u __attribute__((ext_vector_type(2)));
#ifndef WT_STORES
#define WT_STORES 0
#endif
__device__ __forceinline__ void st_b128(void* p, st_v4u v) {
#if WT_STORES
    asm volatile("global_store_dwordx4 %0, %1, off sc1\n\ts_nop 1" :: "v"(p), "v"(v) : "memory");
#else
    *(st_v4u*)p = v;
#endif
}
__device__ __forceinline__ void st_b128_wt(void* p, st_v4u v) { asm volatile("global_store_dwordx4 %0, %1, off sc1\n\ts_nop 1" :: "v"(p), "v"(v) : "memory"); }
__device__ __forceinline__ void st_b64(void* p, st_v2u v) {
#if WT_STORES
    asm volatile("global_store_dwordx2 %0, %1, off sc1" :: "v"(p), "v"(v) : "memory");
#else
    *(st_v2u*)p = v;
#endif
}
#define XB_TMO      128
#define XB_XCNT(j)  (256  + 64 * (j))
#define XB_XSUB(j)  (1280 + 64 * (j))
#define XB_XGEN(j)  (2304 + 64 * (j))
#define XB_TOP      3328
#define XB_TOPGEN   3392
#define XCD_BAR_WORDS 3456
#define XB_SPIN_CAP (1u << 18)
#define LAS __attribute__((address_space(3)))

__device__ __forceinline__ unsigned xb_ld(unsigned* p)              { return __hip_atomic_load(p, __ATOMIC_RELAXED, __HIP_MEMORY_SCOPE_AGENT); }
__device__ __forceinline__ unsigned xb_add(unsigned* p, unsigned v) { return __hip_atomic_fetch_add(p, v, __ATOMIC_RELAXED, __HIP_MEMORY_SCOPE_AGENT); }
__device__ __forceinline__ unsigned xb_xcc_id() { return (unsigned)__builtin_amdgcn_s_getreg((3 << 11) | 20) & 0xFu; }
#define XB_SPIN(cond, bar) do { unsigned _sp = 0; while (cond) { __builtin_amdgcn_s_sleep(1); \
    if ((++_sp & 255u) == 0u) { if (xb_ld(&(bar)[XB_TMO])) break; if (_sp > XB_SPIN_CAP) { atomicAdd(&(bar)[XB_TMO], 1u); break; } } } } while (0)

struct XcdBarrier {
    unsigned* bar; unsigned x;
    volatile LAS unsigned* st;
};

__device__ __forceinline__ XcdBarrier xcd_barrier_post(unsigned* bar, volatile LAS unsigned* st) {
    XcdBarrier b; b.bar = bar; b.x = xb_xcc_id(); b.st = st;
    if (threadIdx.x == 0) (void)xb_add(&bar[XB_XCNT(b.x)], 1u);
    return b;
}
__device__ __forceinline__ void xcd_barrier_complete(unsigned* bar, unsigned x, unsigned& nloc, unsigned& nx) {
    const unsigned G = gridDim.x * gridDim.y * gridDim.z;
    unsigned sum, cnt, mine, sp = 0u;
    for (;;) {
        sum = 0u; cnt = 0u; mine = 0u;
#pragma unroll
        for (unsigned j = 0; j < 16; ++j) { const unsigned c = xb_ld(&bar[XB_XCNT(j)]); sum += c; cnt += (c > 0u) ? 1u : 0u; mine = (j == x) ? c : mine; }
        if (sum == G) break;
        __builtin_amdgcn_s_sleep(1);
        if ((++sp & 255u) == 0u) { if (xb_ld(&bar[XB_TMO])) break; if (sp > XB_SPIN_CAP) { atomicAdd(&bar[XB_TMO], 1u); break; } }
    }
    nloc = mine > 0u ? mine : 1u; nx = cnt > 0u ? cnt : 1u;
}

__device__ __forceinline__ void xcd_barrier(const XcdBarrier& b) {
    asm volatile("s_waitcnt vmcnt(0)" ::: "memory");
    __syncthreads();
    if (threadIdx.x == 0) {
        unsigned* bar = b.bar;
        __builtin_amdgcn_s_waitcnt(0);
        unsigned nloc = b.st[0], nx = b.st[1];
        if (nloc == 0u) { xcd_barrier_complete(bar, b.x, nloc, nx); b.st[0] = nloc; b.st[1] = nx; }
        const unsigned old = xb_add(&bar[XB_XSUB(b.x)], 1u);
        const unsigned gen = old / nloc;
        if (old + 1u == (gen + 1u) * nloc) {
            __builtin_amdgcn_fence(__ATOMIC_RELEASE, "agent");
            asm volatile("s_waitcnt vmcnt(0)" ::: "memory");
            const unsigned og = xb_add(&bar[XB_TOP], 1u);
            const unsigned tg = og / nx;
            if (og + 1u == (tg + 1u) * nx) xb_add(&bar[XB_TOPGEN], 1u);
            else XB_SPIN(xb_ld(&bar[XB_TOPGEN]) == tg, bar);
            __builtin_amdgcn_fence(__ATOMIC_ACQUIRE, "agent");
            xb_add(&bar[XB_XGEN(b.x)], 1u);
            asm volatile("s_waitcnt vmcnt(0)" ::: "memory");
        } else {
            XB_SPIN(xb_ld(&bar[XB_XGEN(b.x)]) == gen, bar);
            __builtin_amdgcn_fence(__ATOMIC_ACQUIRE, "agent");
            asm volatile("s_waitcnt vmcnt(0)" ::: "memory");
        }
    }
    __syncthreads();
}

namespace pg8 {
#define PG8_LAS __attribute__((address_space(3)))
typedef unsigned short bf16_t;
typedef short bf16x8 __attribute__((ext_vector_type(8)));
typedef float f32x4 __attribute__((ext_vector_type(4)));
typedef unsigned u32x4 __attribute__((ext_vector_type(4)));
typedef unsigned u32x2 __attribute__((ext_vector_type(2)));
constexpr int BM = 256, BK = 64, HALF = 128, HTB = HALF * BK * 2, STAGE_BYTES = 8 * HTB, NXCD = 8, WGM = 8;

__host__ __device__ __forceinline__ int lds_byte(int r, int c) { const int st = (r >> 4) * 2 + (c >> 5), rr = r & 15, cc = c & 31, ob = rr * 64 + cc * 2; return st * 1024 + (ob ^ (((ob >> 9) & 1) << 5)); }
__host__ __device__ __forceinline__ void stage_rc(int b, int& R, int& C) { const int st = b / 1024, sb = b % 1024, swz = sb ^ (((sb >> 9) & 1) << 5); R = (st >> 1) * 16 + swz / 64; C = (st & 1) * 32 + (swz % 64) / 2; }
__host__ __device__ __forceinline__ int perm32(int rho) { const int n = rho >> 4, i = rho & 15; return 8 * (i >> 2) + 4 * n + (i & 3); }

struct Unit { int pm, pn, e; };

struct StaticOrder {
    static constexpr bool GATHER = false, SIGNAL = false, WAITS = false;
    static constexpr size_t KSTEP_A = 128;
    const char* A; const char* Bt; int K; int nM, nN, nwg, G, c;
    __device__ void init(const void* A_, const void* Bt_, int M, int N, int K_, int G_, int c_) { A = (const char*)A_; Bt = (const char*)Bt_; K = K_; nM = M / BM; nN = N / BM; nwg = nM * nN; G = G_; c = c_; }
    __device__ bool next(int i, Unit& u) const {
        const long L = (long)i * G + c; if (L >= nwg) return false;
        int wgid = (int)L; { const int q = nwg / NXCD, r = nwg % NXCD, xcd = wgid % NXCD, off = wgid / NXCD; wgid = (xcd < r ? xcd * (q + 1) : r * (q + 1) + (xcd - r) * q) + off; }
        const int nig = WGM * nN, gid = wgid / nig, fm = gid * WGM, gsz = (nM - fm) < WGM ? (nM - fm) : WGM;
        u.pm = fm + ((wgid % nig) % gsz); u.pn = (wgid % nig) / gsz; u.e = 0; return true;
    }
    __device__ __forceinline__ const char* a_base(const Unit& u) const { return A + (size_t)u.pm * (size_t)(BM * 2) * K; }
    __device__ __forceinline__ const char* b_base(const Unit& u) const { return Bt + (size_t)u.pn * (size_t)(BM * 2) * K; }
    __device__ __forceinline__ unsigned a_off(int, int, int, int) const { return 0u; }
};

struct PairOrder {
    static constexpr bool GATHER = false, SIGNAL = false, WAITS = false;
    static constexpr size_t KSTEP_A = 128;
    const char* A; const char* Bt; int K; int pm, pn0, n;
    __device__ bool next(int i, Unit& u) const { if (i >= n) return false; u.pm = pm; u.pn = pn0 + i; u.e = 0; return true; }
    __device__ __forceinline__ const char* a_base(const Unit& u) const { return A + (size_t)u.pm * (size_t)(BM * 2) * K; }
    __device__ __forceinline__ const char* b_base(const Unit& u) const { return Bt + (size_t)u.pn * (size_t)(BM * 2) * K; }
    __device__ __forceinline__ unsigned a_off(int, int, int, int) const { return 0u; }
};

__device__ __forceinline__ unsigned cvt_pk_bf16(float lo, float hi) { unsigned r; asm volatile("v_cvt_pk_bf16_f32 %0, %1, %2" : "=v"(r) : "v"(lo), "v"(hi)); return r; }

typedef int i32x8 __attribute__((ext_vector_type(8)));
typedef int i32x4 __attribute__((ext_vector_type(4)));
template <int K, class Epi, class Sched, bool ALIGN_EPI, bool FP8 = false, int SA = 127, int SB = 127, int KB = K, bool BSPLIT = false>
__device__ __forceinline__ void gemm_phase(PG8_LAS unsigned char* lds, const Sched& S, const Epi& E) {
    int tid_ = threadIdx.x; asm volatile("" : "+v"(tid_));
    const int tid = tid_, wid = __builtin_amdgcn_readfirstlane(tid >> 6), lane = tid & 63, wr = wid >> 2, wc = wid & 3, fr = lane & 15, fq = lane >> 4;
    constexpr int nt = K / BK;
    constexpr int NH = Sched::GATHER ? 2 : 1;
    unsigned voffB[2], cvA[NH][2], nvA[NH][2];
#pragma unroll
    for (int i = 0; i < 2; ++i) { int R, C; stage_rc(tid * 16 + i * 8192, R, C); const int Rb = Epi::PERM ? ((R & ~31) + perm32(R & 31)) : R;
        voffB[i] = (unsigned)(Rb * KB + C) * 2u;
        cvA[0][i] = nvA[0][i] = (unsigned)(R * K + C) * 2u; if constexpr (NH == 2) { cvA[NH - 1][i] = nvA[NH - 1][i] = cvA[0][i]; } }
    constexpr size_t kstep = (size_t)(BK * 2);
    constexpr size_t hstep = (size_t)HALF * K * 2;
    constexpr size_t hstepA = Sched::GATHER ? (size_t)0 : hstep;
    constexpr size_t hstepB = (size_t)HALF * KB * 2;
    constexpr size_t kstepA = Sched::KSTEP_A;
    const unsigned ldsw = (unsigned)wid * 1024u;
    const int aoff = lds_byte(wr * 64 + fr, fq * 8), boff = lds_byte(wc * 32 + fr, fq * 8);
#define PG8_SA(b, h) (((b) * 2 + (h)) * HTB)
#define PG8_SB(b, h) ((4 + (b) * 2 + (h)) * HTB)
#define PG8_STAGE(bufoff, gbase, voff) do { _Pragma("unroll") for (int _i = 0; _i < 2; ++_i) \
        __builtin_amdgcn_global_load_lds((const unsigned*)((const char*)(gbase) + (voff)[_i]), (PG8_LAS unsigned*)(lds + (bufoff) + ldsw + _i * 8192), 16, 0, 0); } while (0)
#define PG8_LD32(addr) __builtin_shufflevector(*(const PG8_LAS i32x4*)(addr), *(const PG8_LAS i32x4*)((addr) + 1024), 0, 1, 2, 3, 4, 5, 6, 7)
#define PG8_LDA(dst, b, h) do { _Pragma("unroll") for (int m = 0; m < 4; ++m) dst[m] = PG8_LD32(lds + PG8_SA(b, h) + aoff + m * 2048); } while (0)
#define PG8_LDB(dst, b, h) do { _Pragma("unroll") for (int n = 0; n < 2; ++n) dst[n] = PG8_LD32(lds + PG8_SB(b, h) + boff + n * 2048); } while (0)
#define PG8_H0(x) __builtin_bit_cast(bf16x8, __builtin_shufflevector((x), (x), 0, 1, 2, 3))
#define PG8_H1(x) __builtin_bit_cast(bf16x8, __builtin_shufflevector((x), (x), 4, 5, 6, 7))
#define PG8_MMA(ai, bj, At, Bt) do { __builtin_amdgcn_s_setprio(1); _Pragma("unroll") for (int m = 0; m < 4; ++m) _Pragma("unroll") for (int n = 0; n < 2; ++n) { \
        if constexpr (FP8) asm volatile("v_mfma_scale_f32_16x16x128_f8f6f4 %0, %1, %2, %0, %3, %4 op_sel_hi:[0,0,0]" : "+v"(acc[ai][bj][m][n]) : "v"(Bt[n]), "v"(At[m]), "v"(sbv), "v"(sav)); \
        else { acc[ai][bj][m][n] = __builtin_amdgcn_mfma_f32_16x16x32_bf16(PG8_H0(Bt[n]), PG8_H0(At[m]), acc[ai][bj][m][n], 0, 0, 0); \
               acc[ai][bj][m][n] = __builtin_amdgcn_mfma_f32_16x16x32_bf16(PG8_H1(Bt[n]), PG8_H1(At[m]), acc[ai][bj][m][n], 0, 0, 0); } } \
        __builtin_amdgcn_s_setprio(0); } while (0)
#define PG8_WAIT_V(n) asm volatile("s_waitcnt vmcnt(" #n ")" ::: "memory")
#define PG8_WAIT_L(n) asm volatile("s_waitcnt lgkmcnt(" #n ")" ::: "memory")
#define PG8_BAR __builtin_amdgcn_s_barrier()
#define PG8_SCHED __builtin_amdgcn_sched_barrier(0)
    int sav = SA, sbv = SB; asm volatile("" : "+v"(sav), "+v"(sbv));
    Unit cur, nxt; int ui = 0; int sig_pm = 0;
    if (!S.next(0, cur)) return;
    if constexpr (Sched::WAITS) { if (wid == 0) S.wait(cur); PG8_BAR; }
    f32x4 acc[2][2][4][2];
#pragma unroll
    for (int a = 0; a < 2; ++a)
#pragma unroll
        for (int b = 0; b < 2; ++b)
#pragma unroll
            for (int m = 0; m < 4; ++m)
#pragma unroll
                for (int n = 0; n < 2; ++n) acc[a][b][m][n] = (f32x4){0.f, 0.f, 0.f, 0.f};
    i32x8 At[4], B0[2], B1[2];
    const char* cA = S.a_base(cur); const char* cB = S.b_base(cur);
    if constexpr (Sched::GATHER) {
        int R0, C0, R1, C1; stage_rc(tid * 16, R0, C0); stage_rc(tid * 16 + 8192, R1, C1);
#pragma unroll
        for (int h = 0; h < 2; ++h) { cvA[h][0] = S.a_off(0, h, R0, C0 * 2); cvA[h][1] = S.a_off(0, h, R1, C1 * 2); }
    }
    PG8_STAGE(PG8_SB(0, 0), cB, voffB); PG8_STAGE(PG8_SB(0, 1), cB + hstepB, voffB); PG8_STAGE(PG8_SA(0, 0), cA, cvA[0]); PG8_STAGE(PG8_SA(0, 1), cA + hstepA, cvA[NH - 1]);
    if (wr == 1) PG8_BAR;
    PG8_WAIT_V(2); PG8_BAR;
    PG8_STAGE(PG8_SB(1, 0), cB + kstep, voffB); PG8_STAGE(PG8_SA(1, 0), cA + kstepA, cvA[0]); PG8_STAGE(PG8_SB(1, 1), cB + hstepB + kstep, voffB);
    PG8_WAIT_V(6); PG8_BAR;
    for (;;) {
        const bool has_next = S.next(ui + 1, nxt);
        if constexpr (Sched::WAITS) { if (has_next && wid == 0) S.wait(nxt); }
        const char* nA = has_next ? S.a_base(nxt) : cA; const char* nB = has_next ? S.b_base(nxt) : cB;
        if constexpr (Sched::GATHER) {
            if (has_next) {
                int t2 = threadIdx.x; asm volatile("" : "+v"(t2));
                int R0, C0, R1, C1; stage_rc(t2 * 16, R0, C0); stage_rc(t2 * 16 + 8192, R1, C1);
#pragma unroll
                for (int h = 0; h < 2; ++h) { nvA[h][0] = S.a_off(ui + 1, h, R0, C0 * 2); nvA[h][1] = S.a_off(ui + 1, h, R1, C1 * 2); }
            } else {
#pragma unroll
                for (int h = 0; h < 2; ++h) { nvA[h][0] = cvA[h][0]; nvA[h][1] = cvA[h][1]; }
            }
        }
#pragma unroll 1
        for (int t = 0; t < nt; t += 2) {
            const bool last = (t == nt - 2);
            const char* a1 = cA + (size_t)(t + 1) * kstepA;
            const char* a2 = last ? nA : cA + (size_t)(t + 2) * kstepA; const char* b2 = last ? nB : cB + (size_t)(t + 2) * kstep;
            if constexpr (BSPLIT) { if (!last && t + 2 >= nt / 2) b2 += S.b_delta(cur); }
            const char* a3 = a2 + kstepA; const char* b3 = b2 + kstep;
            unsigned v2[NH][2];
#pragma unroll
            for (int h = 0; h < NH; ++h) { if constexpr (Sched::GATHER) { v2[h][0] = last ? nvA[h][0] : cvA[h][0]; v2[h][1] = last ? nvA[h][1] : cvA[h][1]; } else { v2[h][0] = cvA[h][0]; v2[h][1] = cvA[h][1]; } }
            PG8_LDB(B0, 0, 0); PG8_LDB(B1, 0, 1); PG8_SCHED; PG8_LDA(At, 0, 0); PG8_STAGE(PG8_SA(1, 1), a1 + hstepA, cvA[NH - 1]);
            PG8_WAIT_V(8); PG8_WAIT_L(0); PG8_BAR; PG8_MMA(0, 0, At, B0); PG8_MMA(0, 1, At, B1); PG8_BAR; PG8_SCHED;
            PG8_LDA(At, 0, 1); PG8_STAGE(PG8_SB(0, 0), b2, voffB); PG8_STAGE(PG8_SB(0, 1), b2 + hstepB, voffB); PG8_STAGE(PG8_SA(0, 0), a2, v2[0]);
            PG8_WAIT_V(8); PG8_WAIT_L(0); PG8_BAR; PG8_MMA(1, 0, At, B0); PG8_MMA(1, 1, At, B1); PG8_BAR; PG8_SCHED;
            PG8_LDB(B0, 1, 0); PG8_LDB(B1, 1, 1); PG8_SCHED; PG8_LDA(At, 1, 0); PG8_STAGE(PG8_SA(0, 1), a2 + hstepA, v2[NH - 1]);
            PG8_WAIT_V(8); PG8_WAIT_L(0); PG8_BAR; PG8_MMA(0, 0, At, B0); PG8_MMA(0, 1, At, B1); PG8_BAR; PG8_SCHED;
            PG8_LDA(At, 1, 1); PG8_STAGE(PG8_SB(1, 0), b3, voffB); PG8_STAGE(PG8_SB(1, 1), b3 + hstepB, voffB); PG8_STAGE(PG8_SA(1, 0), a3, v2[0]);
            PG8_WAIT_V(8); PG8_WAIT_L(0); PG8_BAR; PG8_MMA(1, 0, At, B0); PG8_MMA(1, 1, At, B1); PG8_BAR; PG8_SCHED;
        }
        if constexpr (ALIGN_EPI) { if (wr == 0) PG8_BAR; }
        if constexpr (FP8) asm volatile("s_nop 15\n\ts_nop 15" ::: "memory");
        { Unit eu = cur; asm volatile("" : "+s"(eu.pm), "+s"(eu.pn));
          if constexpr (Sched::SIGNAL) { if (ui > 0) S.signal(sig_pm, lane); sig_pm = eu.pm; }
          E(acc, eu, ui, wr, wc, fr, fq); }
        if (!has_next) break;
#pragma unroll
        for (int a = 0; a < 2; ++a)
#pragma unroll
            for (int b = 0; b < 2; ++b)
#pragma unroll
                for (int m = 0; m < 4; ++m)
#pragma unroll
                    for (int n = 0; n < 2; ++n) acc[a][b][m][n] = (f32x4){0.f, 0.f, 0.f, 0.f};
        cur = nxt; cA = nA; cB = nB; ++ui;
        if constexpr (Sched::GATHER) {
#pragma unroll
            for (int h = 0; h < NH; ++h) { cvA[h][0] = nvA[h][0]; cvA[h][1] = nvA[h][1]; }
        }
        if constexpr (ALIGN_EPI) { if (wr == 1) PG8_BAR; }
    }
    PG8_WAIT_V(0);
    if constexpr (Sched::SIGNAL) S.signal(sig_pm, lane);
    if constexpr (!ALIGN_EPI) { if (wr == 0) PG8_BAR; }
    PG8_BAR;
#undef PG8_SA
#undef PG8_SB
#undef PG8_STAGE
#undef PG8_LDA
#undef PG8_LDB
#undef PG8_MMA
#undef PG8_LD32
#undef PG8_H0
#undef PG8_H1
#undef PG8_WAIT_V
#undef PG8_WAIT_L
#undef PG8_BAR
#undef PG8_SCHED
}
}
#define GAS __attribute__((address_space(1)))
typedef float f32x4 __attribute__((ext_vector_type(4)));
typedef float f32x16 __attribute__((ext_vector_type(16)));
typedef short bf16x8 __attribute__((ext_vector_type(8)));
typedef unsigned v4u __attribute__((ext_vector_type(4)));
typedef unsigned v2u __attribute__((ext_vector_type(2)));
#define LDS_WAIT() asm volatile("s_waitcnt lgkmcnt(0)" ::: "memory")
#define VM_WAIT() asm volatile("s_waitcnt vmcnt(0)" ::: "memory")
__device__ __forceinline__ unsigned pk2(float lo, float hi) { return f2bf(lo) | (f2bf(hi) << 16); }

constexpr int NWAVES = 8, NTHR = 512;
constexpr int LDS_STAGE = 0;
constexpr int LDS_RS = 131072;
constexpr int LDS_ROWTOK = LDS_RS + 8192;
constexpr int LDS_GATE = LDS_ROWTOK + 8192;
constexpr int LDS_MISC = LDS_GATE + 8192;
constexpr int LDS_MOET = LDS_MISC + 256;
constexpr int LDS_BYTES = LDS_MOET + 2048;
static_assert(LDS_BYTES <= 160 * 1024, "lds");
constexpr size_t WO_IN = 0, WO_SM = 6 * MiB, WO_RHI = 6 * MiB + 65536, WO_RLO = 6 * MiB + 131072, WO_OUT = 7 * MiB, WO_XQ = 9 * MiB, WO_XO = 10 * MiB, WO_GU = 11 * MiB, WO_D = 43 * MiB;
static_assert(WO_D + 16 * MiB <= WS_WLAYER, "weight block");
constexpr int CW_BAR = 4096;
constexpr int MAX_LAUNCH = 1;
constexpr int CW_XID = 8192;
constexpr int CW_PF = 16384;
constexpr int PF_WORDS = NLAYER * 3 * 128 * 16;
constexpr int CW_GF = CW_PF + PF_WORDS;
constexpr int GF_WORDS = NLAYER * MAXTILES * 16;
constexpr int CW_MF = CW_GF + GF_WORDS;
constexpr int MF_WORDS = NLAYER * 2 * 64 * 16;
static_assert(CW_BAR + MAX_LAUNCH * XCD_BAR_WORDS <= CW_XID && CW_XID + 1024 <= CW_PF && (CW_MF + MF_WORDS) * 4 <= (int)(1 * MiB), "ctl");

enum { PH_PRO = 0, PH_XKV = 1, PH_L0 = 2, NPH = 13, PH_FINAL = PH_L0 + NLAYER * NPH, PH_END = PH_FINAL + 1 };
enum { LP_INPROJ = 0, LP_MIXA, LP_MIXB, LP_MIXC, LP_WOUT, LP_XQ, LP_XATTN, LP_XO, LP_ROUTE, LP_SORT, LP_GU, LP_DOWN0, LP_DOWN1 };

struct Args { P p; int ph_lo, ph_hi, li, pad; };

#ifndef WT_PROJ
#define WT_PROJ 0
#endif
template <bool HAS_RS> struct EpiBf16 {
    static constexpr bool PERM = true;
    bf16* O; int ldc; const LAS float* rstab;
    __device__ __forceinline__ void operator()(const pg8::f32x4 (&acc)[2][2][4][2], const pg8::Unit& u, int iu, int wr, int wc, int fr, int fq) const {
#pragma unroll
        for (int ai = 0; ai < 2; ++ai)
#pragma unroll
            for (int m = 0; m < 4; ++m) {
                const int lrow = ai * 128 + wr * 64 + m * 16 + fr;
                float sc = 1.f; if (HAS_RS) sc = rstab[iu * 256 + lrow];
                bf16* rowp = O + (size_t)(u.pm * 256 + lrow) * ldc + u.pn * 256 + wc * 32 + 8 * fq;
#pragma unroll
                for (int bj = 0; bj < 2; ++bj) { const pg8::f32x4 v0 = acc[ai][bj][m][0] * sc, v1 = acc[ai][bj][m][1] * sc;
                    pg8::u32x4 w; w.x = pg8::cvt_pk_bf16(v0[0], v0[1]); w.y = pg8::cvt_pk_bf16(v0[2], v0[3]); w.z = pg8::cvt_pk_bf16(v1[0], v1[1]); w.w = pg8::cvt_pk_bf16(v1[2], v1[3]);
                    if (WT_PROJ) st_b128_wt(rowp + bj * 128, w); else st_b128(rowp + bj * 128, w); }
            }
    }
};
__device__ __forceinline__ unsigned pk4_fp8(float a, float b, float c, float d) { int w = __builtin_amdgcn_cvt_pk_fp8_f32(a, b, 0, false); w = __builtin_amdgcn_cvt_pk_fp8_f32(c, d, w, true); return (unsigned)w; }
struct EpiGU {
    static constexpr bool PERM = true;
    unsigned char* U8; const LAS float* rstab; const LAS float* gatetab;
    __device__ __forceinline__ void operator()(const pg8::f32x4 (&acc)[2][2][4][2], const pg8::Unit& u, int iu, int wr, int wc, int fr, int fq) const {
#pragma unroll
        for (int ai = 0; ai < 2; ++ai)
#pragma unroll
            for (int m = 0; m < 4; ++m) {
                const int lrow = ai * 128 + wr * 64 + m * 16 + fr;
                const float sc = rstab[iu * 256 + lrow], gt = 4.f * gatetab[iu * 256 + lrow];
                float o[8];
#pragma unroll
                for (int n = 0; n < 2; ++n)
#pragma unroll
                    for (int j = 0; j < 4; ++j) { const float g = acc[ai][0][m][n][j] * sc, uu = acc[ai][1][m][n][j] * sc; o[n * 4 + j] = gt * g * uu * __builtin_amdgcn_rcpf(1.f + __expf(-g)); }
                pg8::u32x2 w; w.x = pk4_fp8(o[0], o[1], o[2], o[3]); w.y = pk4_fp8(o[4], o[5], o[6], o[7]);
                st_b64(U8 + (size_t)(u.pm * 256 + lrow) * 1024 + (u.pn >> 2) * 512 + (u.pn & 3) * 128 + wc * 32 + 8 * fq, w);
            }
    }
};
template <int MODE, bool W8 = false> struct EpiRes {
    static constexpr bool PERM = true;
    static constexpr bool MOE = MODE != 0;
    bf16* hb; float* ssq; const LAS int* rowtab; float gs; unsigned char* h8;
    static __device__ __forceinline__ void unpack8(const pg8::u32x4& w, float (&f)[8]) {
        f[0] = __builtin_bit_cast(float, w.x << 16); f[1] = __builtin_bit_cast(float, w.x & 0xffff0000u); f[2] = __builtin_bit_cast(float, w.y << 16); f[3] = __builtin_bit_cast(float, w.y & 0xffff0000u);
        f[4] = __builtin_bit_cast(float, w.z << 16); f[5] = __builtin_bit_cast(float, w.z & 0xffff0000u); f[6] = __builtin_bit_cast(float, w.w << 16); f[7] = __builtin_bit_cast(float, w.w & 0xffff0000u); }
    __device__ __forceinline__ void operator()(const pg8::f32x4 (&acc)[2][2][4][2], const pg8::Unit& u, int iu, int wr, int wc, int fr, int fq) const {
#pragma unroll
        for (int ai = 0; ai < 2; ++ai)
#pragma unroll
            for (int m = 0; m < 4; ++m) {
                const int lrow = ai * 128 + wr * 64 + m * 16 + fr;
                int row = u.pm * 256 + lrow; const float g = gs;
                if (MOE) row = rowtab[iu * 256 + lrow];
                const bool ok = !MOE || row >= 0;
                const size_t off = (size_t)(ok ? row : 0) * DM + u.pn * 256 + wc * 32 + 8 * fq;
                float q = 0.f;
                if (ok) {
#pragma unroll
                    for (int bj = 0; bj < 2; ++bj) {
                        float o[8];
#pragma unroll
                        for (int j = 0; j < 4; ++j) { o[j] = acc[ai][bj][m][0][j] * g; o[4 + j] = acc[ai][bj][m][1][j] * g; }
                        float bs[8]; unpack8(*(const pg8::u32x4*)(hb + off + bj * 128), bs);
#pragma unroll
                        for (int j = 0; j < 8; ++j) o[j] += bs[j];
                        pg8::u32x4 w; w.x = pg8::cvt_pk_bf16(o[0], o[1]); w.y = pg8::cvt_pk_bf16(o[2], o[3]); w.z = pg8::cvt_pk_bf16(o[4], o[5]); w.w = pg8::cvt_pk_bf16(o[6], o[7]);
                        float r[8]; unpack8(w, r);
#pragma unroll
                        for (int j = 0; j < 8; ++j) q += r[j] * r[j];
                        st_b128(hb + off + bj * 128, w);
                        if (W8) { pg8::u32x2 w8; w8.x = pk4_fp8(o[0], o[1], o[2], o[3]); w8.y = pk4_fp8(o[4], o[5], o[6], o[7]); st_b64(h8 + off + bj * 128, w8); }
                    }
                }
                q += __shfl_xor(q, 16); q += __shfl_xor(q, 32); if (fq == 0 && ok) ssq[(size_t)row * 16 + u.pn * 4 + wc] = q;
            }
    }
};
template <int MODE> struct MoeOrder {
    static constexpr bool GATHER = MODE == 0, SIGNAL = MODE == 0, WAITS = MODE == 1;
    static constexpr size_t KSTEP_A = 128;
    const char* A; const char* Bt; int K; size_t estride; const LAS int* tile2e; const LAS int* rowtab; unsigned* flags; unsigned* barw; int same;
    int NG, x, w, Tx, r;
    __device__ void init_group(int T, int G, int c) { NG = G >> 5; x = c >> 5; w = c & 31; const int per = 4 * NG, rem = T % per - 4 * x; Tx = 4 * (T / per) + (rem < 0 ? 0 : (rem > 4 ? 4 : rem)); r = (8 * Tx) & 31; }
    __device__ __forceinline__ int gtile(int tau) const { return 4 * NG * (tau >> 2) + 4 * x + (tau & 3); }
    __device__ bool next(int i, pg8::Unit& u) const {
        if (MODE == 0) { const int L = i * 32 + w; if (L >= 8 * Tx) return false; u.pm = gtile(L >> 3); u.pn = L & 7; }
        else { const int L = w >= r ? (i == 0 ? w - r : (32 - r) + (i - 1) * 32 + w) : (32 - r) + i * 32 + w; if (L >= 4 * Tx) return false; u.pm = gtile(L >> 2); u.pn = L & 3; }
        u.e = __builtin_amdgcn_readfirstlane(tile2e[u.pm]); return true;
    }
    __device__ __forceinline__ const char* a_base(const pg8::Unit& u) const { return GATHER ? A : A + (size_t)u.pm * (size_t)512 * K; }
    __device__ __forceinline__ const char* b_base(const pg8::Unit& u) const {
        if (MODE == 0) { const int e = (u.pn < 4 ? u.e >> 8 : u.e >> 16) & 255; return Bt + (size_t)e * estride + (size_t)(u.pn & 3) * (size_t)512 * K; }
        return Bt + (size_t)((u.e >> 8) & 255) * estride + (size_t)u.pn * (size_t)(256 * 512);
    }
    __device__ __forceinline__ long b_delta(const pg8::Unit& u) const { return (long)(((u.e >> 16) & 255) - ((u.e >> 8) & 255)) * (long)estride - 512; }
    __device__ __forceinline__ unsigned a_off(int iu, int h, int R, int Cb) const { return (unsigned)rowtab[iu * 256 + h * 128 + R] * (unsigned)(K * 2) + (unsigned)Cb; }
    __device__ __forceinline__ void signal(int pm, int lane) const {
        if (!same) { asm volatile("s_waitcnt vmcnt(0)" ::: "memory"); __builtin_amdgcn_fence(__ATOMIC_RELEASE, "agent"); asm volatile("s_waitcnt vmcnt(0)" ::: "memory"); }
        if (lane == 0) (void)xb_add(flags + pm * 16, 1u);
    }
    __device__ __forceinline__ void wait(const pg8::Unit& u) const {
        unsigned* f = flags + u.pm * 16;
        XB_SPIN(xb_ld(f) < 64u, barw);
        __builtin_amdgcn_fence(__ATOMIC_ACQUIRE, "agent");
    }
};

__device__ __forceinline__ void router_weights(const P& p, int gtid, int gstride);
__device__ __forceinline__ void tr_item(const float* W, int N, int K, int k0, int n0, const float* gain, float scale, bf16* dst, LAS float* scr, int lane) {
    const int kr = lane >> 3, c4 = lane & 7;
    f32x4 v[8];
#pragma unroll
    for (int i = 0; i < 8; ++i) v[i] = *(const f32x4*)(W + (size_t)(k0 + 8 * i + kr) * N + n0 + 4 * c4);
#pragma unroll
    for (int i = 0; i < 8; ++i) { const int kk = 8 * i + kr; float g = scale; if (gain) g *= gain[k0 + kk];
        LAS float* d = scr + kk * 33 + 4 * c4; d[0] = v[i].x * g; d[1] = v[i].y * g; d[2] = v[i].z * g; d[3] = v[i].w * g; }
    LDS_WAIT();
    const int c = lane & 7;
#pragma unroll
    for (int j = 0; j < 4; ++j) { const int n = (lane >> 3) + 8 * j; const LAS float* s = scr + (8 * c) * 33 + n;
        v4u o; o.x = pk2(s[0 * 33], s[1 * 33]); o.y = pk2(s[2 * 33], s[3 * 33]); o.z = pk2(s[4 * 33], s[5 * 33]); o.w = pk2(s[6 * 33], s[7 * 33]);
        st_b128(dst + (size_t)n * K + k0 + 8 * c, o); }
    LDS_WAIT();
}
__device__ __forceinline__ void tr_item8(const float* W, int N, int K, int k0, int n0, const float* gain, float scale, unsigned char* dst, LAS float* scr, int lane) {
    const int kr = lane >> 3, c4 = lane & 7;
    f32x4 v[8];
#pragma unroll
    for (int i = 0; i < 8; ++i) v[i] = *(const f32x4*)(W + (size_t)(k0 + 8 * i + kr) * N + n0 + 4 * c4);
#pragma unroll
    for (int i = 0; i < 8; ++i) { const int kk = 8 * i + kr; float g = scale; if (gain) g *= gain[k0 + kk];
        LAS float* d = scr + kk * 33 + 4 * c4; d[0] = v[i].x * g; d[1] = v[i].y * g; d[2] = v[i].z * g; d[3] = v[i].w * g; }
    LDS_WAIT();
    const int c = lane & 7;
#pragma unroll
    for (int j = 0; j < 4; ++j) { const int n = (lane >> 3) + 8 * j; const LAS float* s = scr + (8 * c) * 33 + n;
        v2u o; o.x = pk4_fp8(s[0 * 33], s[1 * 33], s[2 * 33], s[3 * 33]); o.y = pk4_fp8(s[4 * 33], s[5 * 33], s[6 * 33], s[7 * 33]);
        st_b64(dst + (size_t)n * K + k0 + 8 * c, o); }
    LDS_WAIT();
}
constexpr int IT_LAYER = 15360;
__device__ __forceinline__ void prologue_item(const P& p, int it, LAS float* scr, int lane) {
    const int l = it / IT_LAYER; int r = it % IT_LAYER;
    unsigned char* wl = ws_base(p.ws) + WS_W + (size_t)l * WS_WLAYER;
    if (r < 1536) {
        const int seg = r / 768; r %= 768; const int kb = r / 48, nb = r % 48; const int n0 = (seg ? 1544 : 0) + 32 * nb, drow = seg * 1536 + 32 * nb;
        const float sc = drow < 512 ? 0.125f * LOG2E : ((drow >= C_GQ && drow < C_GK) ? 0.125f : 1.f);
        tr_item(p.w_in + (size_t)l * DM * INW, INW, DM, 64 * kb, n0, p.mix_norm + l * DM, sc, (bf16*)(wl + WO_IN) + (size_t)drow * DM, scr, lane); return; }
    r -= 1536;
    if (r < 512) { const int kb = r / 32, nb = r % 32; tr_item(p.w_out + (size_t)l * DM * DM, DM, DM, 64 * kb, 32 * nb, nullptr, 1.f, (bf16*)(wl + WO_OUT) + (size_t)(32 * nb) * DM, scr, lane); return; }
    r -= 512;
    if (r < 256) { const int kb = r / 16, nb = r % 16; tr_item(p.w_xq + (size_t)l * DM * 512, 512, DM, 64 * kb, 32 * nb, p.cross_norm + l * DM, 0.08838834764831845f * LOG2E, (bf16*)(wl + WO_XQ) + (size_t)(32 * nb) * DM, scr, lane); return; }
    r -= 256;
    if (r < 256) { const int kb = r / 32, nb = r % 32; tr_item8(p.w_xo + (size_t)l * 512 * DM, DM, 512, 64 * kb, 32 * nb, nullptr, 32.f, (unsigned char*)(wl + WO_XO) + (size_t)(32 * nb) * 512, scr, lane); return; }
    r -= 256;
    if (r < 512) { const int kv = r / 256; r %= 256; const int kb = r / 16, nb = r % 16;
        tr_item((kv ? p.w_xv : p.w_xk) + (size_t)l * DM * 512, 512, DM, 64 * kb, 32 * nb, nullptr, 1.f, (bf16*)(ws_base(p.ws) + WS_WXKV) + (size_t)(l * 1024 + kv * 512 + 32 * nb) * DM, scr, lane); return; }
    r -= 512;
    if (r < 8192) { const int up = r / 4096; r %= 4096; const int e = r / 256; r %= 256; const int kb = r / 16, nb = r % 16; const int c0 = 32 * nb, drow = (c0 >> 7) * 256 + up * 128 + (c0 & 127);
        tr_item8((up ? p.w_eu : p.w_eg) + ((size_t)l * 16 + e) * DM * 512, 512, DM, 64 * kb, c0, p.moe_norm + l * DM, 32.f, (unsigned char*)(wl + WO_GU) + ((size_t)e * 1024 + drow) * DM, scr, lane); return; }
    r -= 8192;
    { const int e = r / 256; r %= 256; const int kb = r / 32, nb = r % 32;
      tr_item8(p.w_ed + ((size_t)l * 16 + e) * 512 * DM, DM, 512, 64 * kb, 32 * nb, nullptr, 32.f, (unsigned char*)(wl + WO_D) + ((size_t)e * 1024 + 32 * nb) * 512, scr, lane); }
}
__device__ __forceinline__ void row_to_bf16(const float* src, bf16* dst, float* ssq, const float* gain, int lane, int mode) {
    const f32x4* s = (const f32x4*)src + lane;
    f32x4 v[4]; float q = 0.f;
#pragma unroll
    for (int j = 0; j < 4; ++j) { v[j] = s[64 * j]; q += (v[j].x * v[j].x + v[j].y * v[j].y) + (v[j].z * v[j].z + v[j].w * v[j].w); }
    q = wave_sum(q);
    float sc = 1.f;
    if (mode == 1) sc = rsqrtf(q * (1.0f / DM) + EPS);
    v2u* d = (v2u*)dst + lane; float q2 = 0.f;
#pragma unroll
    for (int j = 0; j < 4; ++j) {
        f32x4 g = (f32x4){1.f, 1.f, 1.f, 1.f}; if (mode == 1) g = ((const f32x4*)gain)[lane + 64 * j];
        v2u o; o.x = pk2(v[j].x * sc * g.x, v[j].y * sc * g.y); o.y = pk2(v[j].z * sc * g.z, v[j].w * sc * g.w); st_b64(d + 64 * j, o);
        const float r0 = __builtin_bit_cast(float, o.x << 16), r1 = __builtin_bit_cast(float, o.x & 0xffff0000u), r2 = __builtin_bit_cast(float, o.y << 16), r3 = __builtin_bit_cast(float, o.y & 0xffff0000u);
        q2 += (r0 * r0 + r1 * r1) + (r2 * r2 + r3 * r3); }
    if (mode == 0) { q2 = wave_sum(q2); if (lane < 16) ssq[lane] = lane == 0 ? q2 : 0.f; }
}
__device__ __forceinline__ void prologue(const P& p, LAS unsigned char* lds, int vcu, int G, int wave, int lane) {
    asm volatile("" : "+v"(lane));
    if (vcu == 0 && wave == 0) WSP(int, WS_MOE + MO_GCNT)[lane] = 0;
    if (vcu == 1 % G) { unsigned* pf = (unsigned*)(ws_base(p.ws) + WS_CTL) + CW_PF; for (int i = wave * 64 + lane; i < PF_WORDS + GF_WORDS + MF_WORDS; i += NTHR) pf[i] = 0u; }
    LAS float* scr = (LAS float*)(lds + LDS_STAGE + wave * 16384);
    const int gw = vcu * NWAVES + wave, NGW = G * NWAVES;
    for (int it = gw; it < NLAYER * IT_LAYER; it += NGW) prologue_item(p, it, scr, lane);
    for (int idx = gw * 64 + lane; idx < NLAYER * 2 * 32768; idx += NGW * 64) {
        const int l = idx / 65536, r = idx % 65536, which = r / 32768, e = r % 32768, row = e & 31, k = e >> 5;
        unsigned char* wl = ws_base(p.ws) + WS_W + (size_t)l * WS_WLAYER;
        if (which == 0) {
            float v = 0.f;
            if (row < 8) v = p.w_in[((size_t)l * DM + k) * INW + 1536 + row]; else if (row < 24) v = p.w_in[((size_t)l * DM + k) * INW + 3080 + (row - 8)];
            ((bf16*)(wl + WO_SM))[row * 1024 + k] = (bf16)f2bf(v * p.mix_norm[l * DM + k]);
        }
    }
    router_weights(p, gw * 64 + lane, NGW * 64);
    for (int m = gw; m < 4096; m += NGW) row_to_bf16(p.mem + (size_t)m * DM, WSP(bf16, WS_MEMN) + (size_t)m * DM, nullptr, p.mem_norm, lane, 1);
    { bf16* hbp = WSP(bf16, WS_HB); float* sqp = WSP(float, WS_SSQ);
      for (int m0 = gw * 4; m0 < NTOK; m0 += NGW * 4) {
        f32x4 v[4][4];
#pragma unroll
        for (int r = 0; r < 4; ++r)
#pragma unroll
            for (int j = 0; j < 4; ++j) v[r][j] = ((const f32x4*)(p.x + (size_t)(m0 + r) * DM))[lane + 64 * j];
#pragma unroll
        for (int r = 0; r < 4; ++r) { float q2 = 0.f; v2u* d = (v2u*)(hbp + (size_t)(m0 + r) * DM) + lane;
#pragma unroll
            for (int j = 0; j < 4; ++j) { v2u o; o.x = pk2(v[r][j].x, v[r][j].y); o.y = pk2(v[r][j].z, v[r][j].w); st_b64(d + 64 * j, o);
                const float r0 = __builtin_bit_cast(float, o.x << 16), r1 = __builtin_bit_cast(float, o.x & 0xffff0000u), r2 = __builtin_bit_cast(float, o.y << 16), r3 = __builtin_bit_cast(float, o.y & 0xffff0000u);
                q2 += (r0 * r0 + r1 * r1) + (r2 * r2 + r3 * r3); }
            q2 = wave_sum(q2); if (lane < 16) sqp[(size_t)(m0 + r) * 16 + lane] = lane == 0 ? q2 : 0.f; }
      } }
}
__device__ __forceinline__ void small_proj(const P& p, int l, LAS unsigned char* lds, int vcu, int G, int wave, int lane) {
    asm volatile("" : "+v"(lane));
    const bf16* wsm = (const bf16*)(ws_base(p.ws) + WS_W + (size_t)l * WS_WLAYER + WO_SM);
    const bf16* hb = WSP(bf16, WS_HB); const float* ssq = WSP(float, WS_SSQ); float* sm = WSP(float, WS_SM);
    constexpr int BST = 2048 + 16;
    { const int tid = wave * 64 + lane;
#pragma unroll
      for (int i = 0; i < 8; ++i) { const int idx = tid + NTHR * i, row = idx >> 7, c = idx & 127; *(LAS v4u*)(lds + row * BST + c * 16) = *(const v4u*)(wsm + row * 1024 + c * 8); } }
    __syncthreads();
    const int r = lane & 15, kq = lane >> 4;
    for (int blk = vcu * NWAVES + wave; blk < NTOK / 16; blk += G * NWAVES) {
        const int tok0 = blk * 16;
        const bf16x8* ap = (const bf16x8*)(hb + (size_t)(tok0 + r) * DM + kq * 32);
        pg8::f32x4 acc0 = {0.f, 0.f, 0.f, 0.f}, acc1 = {0.f, 0.f, 0.f, 0.f};
#pragma unroll
        for (int half = 0; half < 2; ++half) {
            bf16x8 af[16];
#pragma unroll
            for (int i = 0; i < 16; ++i) af[i] = ap[(half * 4 + (i >> 2)) * 16 + (i & 3)];
#pragma unroll
            for (int i = 0; i < 16; ++i) { const int s_ = half * 4 + (i >> 2), j = i & 3;
                const bf16x8 b0 = *(const LAS bf16x8*)(lds + r * BST + (128 * s_ + 32 * kq + 8 * j) * 2);
                const bf16x8 b1 = *(const LAS bf16x8*)(lds + (16 + r) * BST + (128 * s_ + 32 * kq + 8 * j) * 2);
                acc0 = __builtin_amdgcn_mfma_f32_16x16x32_bf16(af[i], b0, acc0, 0, 0, 0);
                acc1 = __builtin_amdgcn_mfma_f32_16x16x32_bf16(af[i], b1, acc1, 0, 0, 0);
                if ((i & 3) == 3) __builtin_amdgcn_sched_barrier(0); }
        }
        const float rsv = row_rs(ssq, tok0 + r);
#pragma unroll
        for (int g = 0; g < 4; ++g) { const int trow = 4 * kq + g; const float rs = __shfl(rsv, trow);
            sm[(size_t)(tok0 + trow) * 32 + r] = acc0[g] * rs; if (r < 8) sm[(size_t)(tok0 + trow) * 32 + 16 + r] = acc1[g] * rs; }
    }
    __syncthreads();
}
typedef short v4i16_t __attribute__((ext_vector_type(4)));
typedef __bf16 bf16x2_t __attribute__((ext_vector_type(2)));
typedef float f32x2_t __attribute__((ext_vector_type(2)));
__device__ __forceinline__ unsigned cvtpk(float lo, float hi) { f32x2_t v = {lo, hi}; bf16x2_t b = __builtin_convertvector(v, bf16x2_t); return __builtin_bit_cast(unsigned, b); }
__device__ __forceinline__ bf16x8 pack8(const f32x16& p, int o) {
    v4u w; w.x = cvtpk(p[o], p[o + 1]); w.y = cvtpk(p[o + 2], p[o + 3]); w.z = cvtpk(p[o + 4], p[o + 5]); w.w = cvtpk(p[o + 6], p[o + 7]);
    return __builtin_bit_cast(bf16x8, w);
}
__device__ __forceinline__ float max3f(float a, float b, float c) { float r; asm("v_max3_f32 %0, %1, %2, %3" : "=v"(r) : "v"(a), "v"(b), "v"(c)); return r; }
template <int D, bool FOX, bool OUT8 = false>
__device__ __forceinline__ void attn_unit(LAS unsigned char* lds, const bf16* Qg, int qpitch, const bf16* Kg, const bf16* Vg, int kvpitch, int NT,
                                          const float* cb, int q0, bf16* Og, int opitch, const float* gain, const float* kn) {
    constexpr int KS = D * 2 + 16, VS = D * 2 + 64;
    constexpr int KT = FOX ? 2 : 1, KEYS = 64 * KT;
    constexpr int KBYTES = KEYS * KS, VBYTES = KEYS * VS;
    constexpr int CPR = D / 8, NCH = KEYS * CPR / NTHR, NS = D / 16, NDB = D / 32;
    constexpr int OFF_K = 0, OFF_V = 2 * KBYTES, OFF_CB = 2 * KBYTES + 2 * VBYTES, OFF_FX = OFF_CB + 2 * KEYS * 4;
    int tid = threadIdx.x; asm volatile("" : "+v"(tid));
    const int lane = tid & 63, wave = __builtin_amdgcn_readfirstlane(tid >> 6), r32 = lane & 31, hh = lane >> 5;
    bf16x8 qf[NS];
    { const bf16* qrow = Qg + (size_t)(wave * 32 + r32) * qpitch;
#pragma unroll
      for (int s = 0; s < NS; ++s) qf[s] = *(const bf16x8*)(qrow + 16 * s + 8 * hh); }
    v4u kreg[NCH], vreg[NCH]; f32x4 cbreg = {0.f, 0.f, 0.f, 0.f};
#define AT_GLOAD(t) do { _Pragma("unroll") for (int i_ = 0; i_ < NCH; ++i_) { const int idx_ = tid + NTHR * i_, key_ = idx_ / CPR, c_ = idx_ % CPR; \
        kreg[i_] = *(const v4u*)(Kg + (size_t)((t) * KEYS + key_) * kvpitch + c_ * 8); vreg[i_] = *(const v4u*)(Vg + (size_t)((t) * KEYS + key_) * kvpitch + c_ * 8); } \
        if (FOX && tid < KEYS / 4) cbreg = *(const f32x4*)(cb + (t) * KEYS + tid * 4); } while (0)
#define AT_LSTORE(b) do { _Pragma("unroll") for (int i_ = 0; i_ < NCH; ++i_) { const int idx_ = tid + NTHR * i_, key_ = idx_ / CPR, c_ = idx_ % CPR; \
        *(LAS v4u*)(lds + OFF_K + (b) * KBYTES + key_ * KS + c_ * 16) = kreg[i_]; *(LAS v4u*)(lds + OFF_V + (b) * VBYTES + key_ * VS + c_ * 16) = vreg[i_]; } \
        if (FOX && tid < KEYS / 4) *(LAS f32x4*)(lds + OFF_CB + (b) * (KEYS * 4) + tid * 16) = cbreg; } while (0)
    float m = -INFINITY, l = 0.f;
    f32x16 osum = f32x16{};
    f32x16 o[NDB];
#pragma unroll
    for (int d = 0; d < NDB; ++d) o[d] = f32x16{};
    const int qlo = q0 + wave * 32, qabs = qlo + r32;
    float knpre = 0.f, qkmax = 0.f;
    LAS float* fx = (LAS float*)(lds + OFF_FX);
    const int NTG = NT / KT;
    const int t_first = FOX ? NTG - 1 : 0;
    AT_GLOAD(t_first);
    __syncthreads();
    if (FOX) {
        float qn2 = 0.f;
#pragma unroll
        for (int s = 0; s < NS; ++s)
#pragma unroll
            for (int e = 0; e < 8; ++e) { const float v = __builtin_bit_cast(float, ((unsigned)(unsigned short)qf[s][e]) << 16); qn2 += v * v; }
        qn2 += __shfl_xor(qn2, 32);
        qn2 = wave_max(qn2);
        if (lane == 0) fx[wave] = qn2;
        knpre = lane < 32 ? kn[lane] : 0.f;
#pragma unroll
        for (int o_ = 1; o_ < 32; o_ <<= 1) { const float t_ = __shfl_up(knpre, o_); if (lane >= o_) knpre = fmaxf(knpre, t_); }
    }
    AT_LSTORE(0);
    __syncthreads();
    if (FOX) { float q2 = fx[0];
#pragma unroll
        for (int w_ = 1; w_ < 8; ++w_) q2 = fmaxf(q2, fx[w_]);
        qkmax = sqrtf(q2); }
#pragma unroll 1
    for (int it = 0; it < NTG; ++it) {
        const int b = it & 1;
        const int tg = FOX ? NTG - 1 - it : it;
        const int tn = FOX ? tg - 1 : tg + 1;
        if (it + 1 < NTG) AT_GLOAD(tn);
#pragma unroll
        for (int sub_ = 0; sub_ < KT; ++sub_) {
        const int sub = FOX ? KT - 1 - sub_ : sub_, koff = sub * 64;
        const int kt0 = (tg * KT + sub) * 64;
        if (!FOX || kt0 <= qlo + 31) {
            f32x16 p[2];
#pragma unroll
            for (int kb = 0; kb < 2; ++kb) {
                if (FOX) {
#pragma unroll
                    for (int g = 0; g < 4; ++g) { const f32x4 c4 = *(const LAS f32x4*)(lds + OFF_CB + b * (KEYS * 4) + (koff + kb * 32 + 8 * g + 4 * hh) * 4); p[kb][4 * g] = c4.x; p[kb][4 * g + 1] = c4.y; p[kb][4 * g + 2] = c4.z; p[kb][4 * g + 3] = c4.w; }
                } else p[kb] = f32x16{};
                const LAS unsigned char* kp = lds + OFF_K + b * KBYTES + (koff + kb * 32 + r32) * KS + hh * 16;
#pragma unroll
                for (int s = 0; s < NS; ++s) { const bf16x8 kf = *(const LAS bf16x8*)(kp + s * 32); p[kb] = __builtin_amdgcn_mfma_f32_32x32x16_bf16(kf, qf[s], p[kb], 0, 0, 0); }
            }
            if (FOX && kt0 + 63 > qlo) {
#pragma unroll
                for (int kb = 0; kb < 2; ++kb)
#pragma unroll
                    for (int r = 0; r < 16; ++r) { const int key = kt0 + kb * 32 + (r & 3) + 8 * (r >> 2) + 4 * hh; if (key > qabs) p[kb][r] = -INFINITY; }
            }
            float mt = fmaxf(p[1][0], p[0][0]);
#pragma unroll
            for (int r = 1; r < 16; ++r) mt = max3f(mt, p[0][r], p[1][r]);
            mt = fmaxf(mt, __shfl_xor(mt, 32));
            const float mnew = fmaxf(m, mt);
            float ls = 0.f;
#pragma unroll
            for (int kb = 0; kb < 2; ++kb)
#pragma unroll
                for (int r = 0; r < 16; ++r) { const float e = __builtin_amdgcn_exp2f(p[kb][r] - mnew); p[kb][r] = e; if (!FOX) ls += e; }
            if (!FOX || __builtin_amdgcn_ballot_w64(mnew > m) != 0ull) {
                const float alpha = __builtin_amdgcn_exp2f(m - mnew);
                l *= alpha; if (FOX) osum[0] *= alpha;
#pragma unroll
                for (int d = 0; d < NDB; ++d)
#pragma unroll
                    for (int r = 0; r < 16; ++r) o[d][r] *= alpha;
            }
            m = mnew; l += ls;
            bf16x8 pa[2][2];
#pragma unroll
            for (int kb = 0; kb < 2; ++kb) { pa[kb][0] = pack8(p[kb], 0); pa[kb][1] = pack8(p[kb], 8); }
            const LAS unsigned char* vp = lds + OFF_V + b * VBYTES + (koff + 4 * hh + ((lane & 15) >> 2)) * VS + (16 * ((lane >> 4) & 1) + 4 * (lane & 3)) * 2;
#pragma unroll
            for (int d = 0; d < NDB; ++d) {
#pragma unroll
                for (int kb = 0; kb < 2; ++kb)
#pragma unroll
                    for (int ks = 0; ks < 2; ++ks) {
                        const LAS unsigned char* a0 = vp + (kb * 32 + 16 * ks) * VS + d * 64;
                        const v4i16_t lo = __builtin_amdgcn_ds_read_tr16_b64_v4i16((LAS v4i16_t*)a0);
                        const v4i16_t hi = __builtin_amdgcn_ds_read_tr16_b64_v4i16((LAS v4i16_t*)(a0 + 8 * VS));
                        const bf16x8 vf = (bf16x8){lo[0], lo[1], lo[2], lo[3], hi[0], hi[1], hi[2], hi[3]};
                        o[d] = __builtin_amdgcn_mfma_f32_32x32x16_bf16(vf, pa[kb][ks], o[d], 0, 0, 0);
                    }
            }
            if (FOX) {
                const bf16x8 ones = __builtin_bit_cast(bf16x8, (v4u){0x3F803F80u, 0x3F803F80u, 0x3F803F80u, 0x3F803F80u});
#pragma unroll
                for (int kb = 0; kb < 2; ++kb)
#pragma unroll
                    for (int ks = 0; ks < 2; ++ks) osum = __builtin_amdgcn_mfma_f32_32x32x16_bf16(ones, pa[kb][ks], osum, 0, 0, 0);
            }
        }
        }
        if (FOX) { const float mm = wave_min(m); if (lane == 0) fx[8 + b * 8 + wave] = mm; }
        if (it + 1 < NTG) AT_LSTORE(b ^ 1);
        __syncthreads();
        if (FOX && tg > 0) {
            float M0 = fx[8 + b * 8];
#pragma unroll
            for (int w_ = 1; w_ < 8; ++w_) M0 = fminf(M0, fx[8 + b * 8 + w_]);
            const float cbl = *(const LAS float*)(lds + OFF_CB + (b ^ 1) * (KEYS * 4) + (KEYS - 1) * 4);
            const float knb = __builtin_bit_cast(float, __builtin_amdgcn_readlane(__builtin_bit_cast(int, knpre), tg * KT - 1));
            if (qkmax * knb + cbl < M0 - 40.f) break;
        }
    }
#undef AT_GLOAD
#undef AT_LSTORE
    if (FOX) l = osum[0]; else l += __shfl_xor(l, 32);
    const float inv = 1.0f / l;
    float rs = inv;
    if (FOX) {
        float ss = 0.f;
#pragma unroll
        for (int d = 0; d < NDB; ++d)
#pragma unroll
            for (int r = 0; r < 16; ++r) { const float v = o[d][r] * inv; ss += v * v; }
        ss += __shfl_xor(ss, 32);
        rs = inv * rsqrtf(ss * (1.0f / D) + EPS);
    }
    constexpr int SROW = 144;
    LAS unsigned char* stg = lds + OFF_K + wave * (32 * SROW);
#pragma unroll
    for (int d = 0; d < NDB; ++d)
#pragma unroll
        for (int g = 0; g < 4; ++g) {
            if (OUT8) { *(LAS unsigned*)(stg + r32 * SROW + 32 * d + 8 * g + 4 * hh) = pk4_fp8(o[d][4 * g] * rs, o[d][4 * g + 1] * rs, o[d][4 * g + 2] * rs, o[d][4 * g + 3] * rs); }
            else { f32x4 gn = {1.f, 1.f, 1.f, 1.f}; if (FOX) gn = *(const f32x4*)(gain + 32 * d + 8 * g + 4 * hh);
                v2u w; w.x = cvtpk(o[d][4 * g] * rs * gn.x, o[d][4 * g + 1] * rs * gn.y); w.y = cvtpk(o[d][4 * g + 2] * rs * gn.z, o[d][4 * g + 3] * rs * gn.w);
                *(LAS v2u*)(stg + r32 * SROW + (32 * d + 8 * g + 4 * hh) * 2) = w; }
        }
    static_assert((OUT8 ? D : D * 2) == 128, "stage rows are 128 bytes");
    { unsigned char* ob = (unsigned char*)Og; const size_t pitchb = (size_t)opitch * (OUT8 ? 1 : 2);
#pragma unroll
      for (int i = 0; i < 4; ++i) { const int row = i * 8 + (lane >> 3), ch = lane & 7;
          const v4u w = *(const LAS v4u*)(stg + row * SROW + ch * 16);
          st_b128(ob + (size_t)(wave * 32 + row) * pitchb + ch * 16, w); } }
}
__device__ __forceinline__ void fox_phase(const P& p, int l, LAS unsigned char* lds, int vcu, int G) {
    const bf16* proj = WSP(bf16, WS_PROJ); const float* cb = WSP(float, WS_CB); bf16* y = WSP(bf16, WS_Y);
    for (int pu = vcu; pu < 512; pu += G) {
        const int bh = pu >> 2, pr = pu < 256 ? (pu & 3) : 3 - (pu & 3), b = bh >> 3, h = bh & 7;
        for (int half = 0; half < 2; ++half) {
            const int qb = half ? pr : 7 - pr;
            const size_t row0 = (size_t)b * SEQ;
            attn_unit<64, true>(lds, proj + (row0 + qb * 256) * PW + C_FQ + h * 64, PW, proj + row0 * PW + C_FK + h * 64, proj + row0 * PW + C_FV + h * 64, PW, 4 * (qb + 1),
                                cb + ((size_t)b * 8 + h) * SEQ, qb * 256, y + (row0 + qb * 256) * DM + h * 64, DM, p.fox_gain + l * 512 + h * 64, WSP(const float, WS_MOE + MO_KN) + (b * 8 + h) * 32);
        }
    }
}
__device__ __forceinline__ void xattn_phase(const P& p, int l, LAS unsigned char* lds, int vcu, int G, bool dummy) {
    bf16* xq = WSP(bf16, WS_XQ); const bf16* xkv = WSP(bf16, WS_XKV);
    for (int u = vcu; u < 512; u += G) {
        const int b = u >> 5, h = (u >> 3) & 3, qb = u & 7;
        bf16* qp = xq + ((size_t)b * SEQ + qb * 256) * 512 + h * 128;
        const bf16* kp = xkv + (size_t)b * MEML * 2048 + l * 1024 + h * 128;
        attn_unit<128, false, true>(lds, qp, 512, kp, kp + 512, 2048, 4, nullptr, 0, (bf16*)((dummy ? WSP(unsigned char, WS_Y) : WSP(unsigned char, WS_XO8)) + ((size_t)b * SEQ + qb * 256) * 512 + h * 128), 512, nullptr, nullptr);
    }
}

__device__ __forceinline__ void xattn_pair(const P& p, int l, LAS unsigned char* lds, int pm, int pn, bool dummy) {
    const bf16* xq = WSP(bf16, WS_XQ); const bf16* xkv = WSP(bf16, WS_XKV);
    const int b = pm >> 3;
    for (int hh2 = 0; hh2 < 2; ++hh2) {
        const int h = 2 * pn + hh2;
        const bf16* qp = xq + (size_t)pm * 256 * 512 + h * 128;
        const bf16* kp = xkv + (size_t)b * MEML * 2048 + l * 1024 + h * 128;
        attn_unit<128, false, true>(lds, qp, 512, kp, kp + 512, 2048, 4, nullptr, 0, (bf16*)((dummy ? WSP(unsigned char, WS_Y) : WSP(unsigned char, WS_XO8)) + (size_t)pm * 256 * 512 + h * 128), 512, nullptr, nullptr);
    }
}
constexpr size_t WS_GB = WS_END;
constexpr size_t WS_RT2 = WS_GB + 16 * MiB;
constexpr size_t WS_RG2 = WS_GB + 20 * MiB;
constexpr size_t WS_GDEC = WS_GB + 32 * MiB;
constexpr size_t WS_END2 = WS_GDEC + 1 * MiB;
static_assert(WS_END2 <= 512 * MiB, "workspace map 2");
constexpr int GL_B = 0;
constexpr int GL_TOT = 16384;
constexpr int GL_Q1 = 18432, GL_Q2 = GL_Q1 + 64 * 144, GL_K2 = GL_Q2 + 64 * 144;
constexpr int GL_KD = GL_K2 + 64 * 144;
constexpr int GL_V = GL_KD + 64 * 192;
constexpr int GL_SSQ = GL_V + 64 * 320;
constexpr int GL_GA = GL_SSQ + 1024;
constexpr int GL_YST = GL_GA + 4096;
constexpr int GL_GG = GL_YST + 64 * 272;
constexpr int GL_END = GL_GG + 64 * 272;
static_assert(GL_END <= 131072, "gla lds");

__device__ __forceinline__ float fast_log_sigmoid(float z) { return fminf(z, 0.f) - __logf(1.f + __expf(-fabsf(z))); }
__device__ __forceinline__ void gla_load_v(const bf16* proj, size_t tok0, int h, LAS unsigned char* lds, int tid) {
#pragma unroll
    for (int i = 0; i < 2; ++i) { const int idx = tid + NTHR * i, t = idx >> 4, c = idx & 15;
        *(LAS v4u*)(lds + GL_V + t * 320 + c * 16) = *(const v4u*)(proj + (tok0 + t) * PW + C_GV + h * 128 + c * 8); }
}
__device__ __forceinline__ bf16x8 tr_frag(const LAS unsigned char* a0, int rowstride4) {
    const v4i16_t lo = __builtin_amdgcn_ds_read_tr16_b64_v4i16((LAS v4i16_t*)a0);
    const v4i16_t hi = __builtin_amdgcn_ds_read_tr16_b64_v4i16((LAS v4i16_t*)(a0 + rowstride4));
    return (bf16x8){lo[0], lo[1], lo[2], lo[3], hi[0], hi[1], hi[2], hi[3]};
}
constexpr int GA_WAVE = 19456, GA_SROW = 144;
static_assert(8 * GA_WAVE <= LDS_MISC && 128 * GA_SROW <= GA_WAVE, "gla phase A lds");
__device__ __forceinline__ void gla_phase_a(const P& p, int l, LAS unsigned char* lds, int vcu, int G) {
    int tid = threadIdx.x; asm volatile("" : "+v"(tid));
    const int lane = tid & 63, wave = __builtin_amdgcn_readfirstlane(tid >> 6), hh = lane >> 5;
    const bf16* proj = WSP(bf16, WS_PROJ); bf16* loc = ((bf16*)p.out); float* dec = WSP(float, WS_GDEC); const float* sm = WSP(float, WS_SM); _Float16* gb = WSP(_Float16, WS_GB);
    LAS unsigned char* kd = lds + wave * GA_WAVE; LAS unsigned char* vh = kd + 8192;
    const int crow8 = lane >> 3, cch = lane & 7;
    const int trow = (lane & 15) >> 2, tcol = 16 * ((lane >> 4) & 1) + 4 * (lane & 3);
    for (int u = vcu * NWAVES + wave; u < 2048; u += G * NWAVES) {
        const int c = u & 31, h = (u >> 5) & 3, b = u >> 7;
        const size_t tok0 = (size_t)b * SEQ + c * 64;
        v4u kreg[8], v0reg[8], v1reg[8];
#pragma unroll
        for (int i = 0; i < 8; ++i) { const bf16* rp = proj + (tok0 + i * 8 + crow8) * PW;
            kreg[i] = *(const v4u*)(rp + C_GK + h * 64 + cch * 8); v0reg[i] = *(const v4u*)(rp + C_GV + h * 128 + cch * 8); v1reg[i] = *(const v4u*)(rp + C_GV + h * 128 + 64 + cch * 8); }
        float w[16];
#pragma unroll
        for (int r = 0; r < 16; ++r) w[r] = p.w_alpha_up[((size_t)l * 16 + r) * 256 + h * 64 + lane];
        const float bias = p.b_alpha[l * 256 + h * 64 + lane];
        { LAS f32x4* gw = (LAS f32x4*)vh;
#pragma unroll
          for (int i = 0; i < 4; ++i) gw[lane * 4 + i] = *(const f32x4*)(sm + (tok0 + lane) * 32 + 8 + 4 * i); }
        float bt[64]; float run = 0.f;
#pragma unroll
        for (int t = 0; t < 64; ++t) {
            float z = bias;
#pragma unroll
            for (int r4 = 0; r4 < 4; ++r4) { const f32x4 g4 = ((const LAS f32x4*)vh)[t * 4 + r4]; z += g4.x * w[4 * r4] + g4.y * w[4 * r4 + 1] + g4.z * w[4 * r4 + 2] + g4.w * w[4 * r4 + 3]; }
            run += fast_log_sigmoid(z) * (1.0f / 16.0f); bt[t] = run; gb[(tok0 + t) * 256 + h * 64 + lane] = (_Float16)run;
        }
#pragma unroll
        for (int i = 0; i < 8; ++i) { *(LAS v4u*)(kd + (i * 8 + crow8) * 128 + cch * 16) = kreg[i]; *(LAS v4u*)(vh + (i * 8 + crow8) * 128 + cch * 16) = v0reg[i]; }
#pragma unroll
        for (int t = 0; t < 64; ++t) { LAS bf16* kp = (LAS bf16*)(kd + t * 128 + lane * 2); *kp = (bf16)f2bf(bf2f(*kp) * __expf(run - bt[t])); }
        dec[(size_t)u * 64 + lane] = __expf(run);
        f32x16 acc[2][2][2];
#pragma unroll
        for (int half = 0; half < 2; ++half) {
            if (half == 1) {
#pragma unroll
                for (int i = 0; i < 8; ++i) *(LAS v4u*)(vh + (i * 8 + crow8) * 128 + cch * 16) = v1reg[i];
            }
#pragma unroll
            for (int x = 0; x < 2; ++x)
#pragma unroll
                for (int y = 0; y < 2; ++y) acc[half][y][x] = f32x16{};
#pragma unroll
            for (int s = 0; s < 4; ++s) {
                bf16x8 af[2], bfr[2];
#pragma unroll
                for (int x = 0; x < 2; ++x) { af[x] = tr_frag(vh + (16 * s + 8 * hh + trow) * 128 + (32 * x + tcol) * 2, 4 * 128); bfr[x] = tr_frag(kd + (16 * s + 8 * hh + trow) * 128 + (32 * x + tcol) * 2, 4 * 128); }
#pragma unroll
                for (int x = 0; x < 2; ++x)
#pragma unroll
                    for (int y = 0; y < 2; ++y) acc[half][y][x] = __builtin_amdgcn_mfma_f32_32x32x16_bf16(bfr[y], af[x], acc[half][y][x], 0, 0, 0);
            }
        }
#pragma unroll
        for (int half = 0; half < 2; ++half)
#pragma unroll
            for (int x = 0; x < 2; ++x)
#pragma unroll
                for (int y = 0; y < 2; ++y)
#pragma unroll
                    for (int g = 0; g < 4; ++g) { const f32x16& a = acc[half][y][x];
                        v2u w2; w2.x = cvtpk(a[4 * g], a[4 * g + 1]); w2.y = cvtpk(a[4 * g + 2], a[4 * g + 3]);
                        *(LAS v2u*)(kd + (64 * half + 32 * x + (lane & 31)) * GA_SROW + (32 * y + 8 * g + 4 * hh) * 2) = w2; }
#pragma unroll
        for (int i = 0; i < 16; ++i) { const int idx = lane + 64 * i, row = idx >> 3, ch = idx & 7;
            st_b128(loc + (size_t)u * 8192 + row * 64 + ch * 8, *(const LAS v4u*)(kd + row * GA_SROW + ch * 16)); }
    }
}
__device__ __forceinline__ void gla_phase_b(const P& p, int vcu, int G) {
    int tid = threadIdx.x; asm volatile("" : "+v"(tid));
    const bf16* loc = ((const bf16*)p.out); const float* dec = WSP(float, WS_GDEC); bf16* gs = (bf16*)((unsigned char*)p.out + 96 * MiB);
    for (int u = vcu; u < 256; u += G) {
        const int bh = u >> 2, q4 = u & 3;
        const int e = q4 * 2048 + tid * 4, dk = e & 63;
        f32x4 st = {0.f, 0.f, 0.f, 0.f};
#pragma unroll 8
        for (int c = 0; c < 32; ++c) {
            const size_t cu = (size_t)bh * 32 + c;
            const v2u lw = *(const v2u*)(loc + cu * 8192 + e);
            const f32x4 lv = {__builtin_bit_cast(float, lw.x << 16), __builtin_bit_cast(float, lw.x & 0xffff0000u), __builtin_bit_cast(float, lw.y << 16), __builtin_bit_cast(float, lw.y & 0xffff0000u)};
            const f32x4 dv = *(const f32x4*)(dec + cu * 64 + dk);
            v2u w; w.x = pk2(st.x, st.y); w.y = pk2(st.z, st.w);
            *(v2u*)(gs + cu * 8192 + e) = w;
            st = dv * st + lv;
        }
    }
}
__device__ __forceinline__ void gla_phase_c(const P& p, int l, LAS unsigned char* lds, int u0, int ustep, int uend) {
    int tid = threadIdx.x; asm volatile("" : "+v"(tid));
    const int lane = tid & 63, wave = __builtin_amdgcn_readfirstlane(tid >> 6), hh = lane >> 5, r32 = lane & 31;
    const bf16* proj = WSP(bf16, WS_PROJ); const bf16* gs = (const bf16*)((const unsigned char*)p.out + 96 * MiB); bf16* y = WSP(bf16, WS_Y); const _Float16* gb = WSP(const _Float16, WS_GB);
    const int dvb = wave >> 1, tb = wave & 1;
    const int trow = (lane & 15) >> 2, tcol = 16 * ((lane >> 4) & 1) + 4 * (lane & 3);
    bf16 n_q[8], n_k[8]; v4u n_v[2], n_g[2]; bf16x8 n_s[4]; f32x4 n_n[4]; float n_b[8], n_r = 0.f;
#define GC_LOAD(uu) do { const int c_ = (uu) & 31, h_ = ((uu) >> 5) & 3, b_ = (uu) >> 7; const size_t t0_ = (size_t)b_ * SEQ + c_ * 64; \
        _Pragma("unroll") for (int j = 0; j < 8; ++j) { const bf16* rp = proj + (t0_ + wave * 8 + j) * PW + h_ * 64 + lane; n_q[j] = rp[C_GQ]; n_k[j] = rp[C_GK]; } \
        _Pragma("unroll") for (int i = 0; i < 2; ++i) { const int idx = tid + NTHR * i, t = idx >> 4, cc = idx & 15; n_v[i] = *(const v4u*)(proj + (t0_ + t) * PW + C_GV + h_ * 128 + cc * 8); n_g[i] = *(const v4u*)(proj + (t0_ + t) * PW + C_GG + h_ * 128 + cc * 8); } \
        { const bf16* sp = gs + (size_t)(uu) * 8192 + (size_t)(32 * dvb + r32) * 64 + 8 * hh; \
          _Pragma("unroll") for (int s2 = 0; s2 < 4; ++s2) n_s[s2] = *(const bf16x8*)(sp + 16 * s2); } \
        _Pragma("unroll") for (int j = 0; j < 8; ++j) n_b[j] = (float)gb[(t0_ + wave * 8 + j) * 256 + h_ * 64 + lane]; \
        n_r = (float)gb[(t0_ + 31) * 256 + h_ * 64 + lane]; \
        _Pragma("unroll") for (int g = 0; g < 4; ++g) { const int dv = 32 * dvb + 8 * g + 4 * hh; \
            n_n[g] = *(const f32x4*)(p.gla_gain + l * 512 + h_ * 128 + dv); } } while (0)
    if (u0 < uend) GC_LOAD(u0);
    __syncthreads();
    for (int u = u0; u < uend; u += ustep) {
        const int c = u & 31, h = (u >> 5) & 3, b = u >> 7;
        const size_t tok0 = (size_t)b * SEQ + c * 64;
        bf16x8 sfr[4]; f32x4 gnr[4];
#pragma unroll
        for (int i = 0; i < 4; ++i) { sfr[i] = n_s[i]; gnr[i] = n_n[i]; }
#pragma unroll
        for (int i = 0; i < 2; ++i) { const int idx = tid + NTHR * i, t = idx >> 4, cc = idx & 15; *(LAS v4u*)(lds + GL_V + t * 320 + cc * 16) = n_v[i]; *(LAS v4u*)(lds + GL_GG + t * 272 + cc * 16) = n_g[i]; }
        { const float rref = n_r;
#pragma unroll
          for (int j = 0; j < 8; ++j) { const int t = wave * 8 + j; const float bt = n_b[j];
            const float qv = bf2f(n_q[j]), kv = bf2f(n_k[j]);
            *(LAS bf16*)(lds + GL_Q1 + t * 144 + lane * 2) = (bf16)f2bf(qv * __expf(bt));
            *(LAS bf16*)(lds + GL_Q2 + t * 144 + lane * 2) = (bf16)f2bf(qv * __expf(bt - rref));
            *(LAS bf16*)(lds + GL_K2 + t * 144 + lane * 2) = (bf16)f2bf(kv * __expf(rref - bt)); } }
        __syncthreads();
        if (u + ustep < uend) GC_LOAD(u + ustep);
        f32x16 o = {};
        {
#pragma unroll
          for (int s = 0; s < 4; ++s) { const bf16x8 af = sfr[s]; const bf16x8 bq = *(const LAS bf16x8*)(lds + GL_Q1 + (32 * tb + r32) * 144 + (16 * s + 8 * hh) * 2);
              o = __builtin_amdgcn_mfma_f32_32x32x16_bf16(af, bq, o, 0, 0, 0); } }
#pragma unroll
        for (int sb = 0; sb < 2; ++sb) {
            if (sb <= tb) {
                f32x16 pt = {};
#pragma unroll
                for (int s = 0; s < 4; ++s) { const bf16x8 ak = *(const LAS bf16x8*)(lds + GL_K2 + (32 * sb + r32) * 144 + (16 * s + 8 * hh) * 2); const bf16x8 bq = *(const LAS bf16x8*)(lds + GL_Q2 + (32 * tb + r32) * 144 + (16 * s + 8 * hh) * 2);
                    pt = __builtin_amdgcn_mfma_f32_32x32x16_bf16(ak, bq, pt, 0, 0, 0); }
                if (sb == tb) {
#pragma unroll
                    for (int r = 0; r < 16; ++r) { const int s_ = (r & 3) + 8 * (r >> 2) + 4 * hh; if (s_ > r32) pt[r] = 0.f; }
                }
#pragma unroll
                for (int ks = 0; ks < 2; ++ks) {
                    const bf16x8 pa = pack8(pt, 8 * ks);
                    const bf16x8 vf = tr_frag(lds + GL_V + (32 * sb + 16 * ks + 4 * hh + trow) * 320 + (32 * dvb + tcol) * 2, 8 * 320);
                    o = __builtin_amdgcn_mfma_f32_32x32x16_bf16(vf, pa, o, 0, 0, 0);
                }
            }
        }
        float ss = 0.f;
#pragma unroll
        for (int r = 0; r < 16; ++r) ss += o[r] * o[r];
        ss += __shfl_xor(ss, 32);
        LAS float* sq = (LAS float*)(lds + GL_SSQ);
        if (hh == 0) sq[dvb * 64 + 32 * tb + r32] = ss;
        __syncthreads();
        const int t = 32 * tb + r32;
        const float tot = (sq[t] + sq[64 + t]) + (sq[128 + t] + sq[192 + t]);
        const float rs = rsqrtf(tot * (1.0f / 128.0f) + EPS);
#pragma unroll
        for (int g = 0; g < 4; ++g) {
            const int dv = 32 * dvb + 8 * g + 4 * hh;
            const f32x4 gn = gnr[g];
            const v2u gg = *(const LAS v2u*)(lds + GL_GG + t * 272 + dv * 2);
            const float g0 = bf2f((bf16)(gg.x & 0xffff)), g1 = bf2f((bf16)(gg.x >> 16)), g2 = bf2f((bf16)(gg.y & 0xffff)), g3 = bf2f((bf16)(gg.y >> 16));
            const float v0 = o[4 * g] * rs * gn.x * g0 * __builtin_amdgcn_rcpf(1.f + __expf(-g0)), v1 = o[4 * g + 1] * rs * gn.y * g1 * __builtin_amdgcn_rcpf(1.f + __expf(-g1));
            const float v2 = o[4 * g + 2] * rs * gn.z * g2 * __builtin_amdgcn_rcpf(1.f + __expf(-g2)), v3 = o[4 * g + 3] * rs * gn.w * g3 * __builtin_amdgcn_rcpf(1.f + __expf(-g3));
            v2u w; w.x = cvtpk(v0, v1); w.y = cvtpk(v2, v3);
            *(LAS v2u*)(lds + GL_YST + t * 272 + dv * 2) = w;
        }
        __syncthreads();
#pragma unroll
        for (int i = 0; i < 2; ++i) { const int idx = tid + NTHR * i, tr_ = idx >> 4, ch = idx & 15;
            st_b128(y + (tok0 + tr_) * DM + 512 + h * 128 + ch * 8, *(const LAS v4u*)(lds + GL_YST + tr_ * 272 + ch * 16)); }
    }
#undef GC_LOAD
}
__device__ __forceinline__ void fox_cumsum_phase(const P& p, int l, LAS unsigned char* lds, int u0, int ustep, int uend) {
    int tid = threadIdx.x; asm volatile("" : "+v"(tid));
    const int lane = tid & 63, wave = __builtin_amdgcn_readfirstlane(tid >> 6);
    const float* sm = WSP(float, WS_SM); float* cb = WSP(float, WS_CB);
    LAS float* tot = (LAS float*)(lds + 256);
    for (int u = u0; u < uend; u += ustep) {
        const int b = u >> 3, h = u & 7;
        const float bias = p.b_forget[l * 8 + h];
        const int s0 = wave * 256 + lane * 4;
        float v[4]; float run = 0.f;
#pragma unroll
        for (int j = 0; j < 4; ++j) v[j] = sm[((size_t)b * SEQ + s0 + j) * 32 + h];
#pragma unroll
        for (int j = 0; j < 4; ++j) { run += fast_log_sigmoid(v[j] + bias); v[j] = run; }
        float pre = run;
#pragma unroll
        for (int o = 1; o < 64; o <<= 1) { const float t = __shfl_up(pre, o); if (lane >= o) pre += t; }
        __syncthreads();
        if (lane == 63) tot[wave] = pre;
        __syncthreads();
        float base = pre - run;
#pragma unroll
        for (int w_ = 0; w_ < 8; ++w_) { const float t = tot[w_]; if (w_ < wave) base += t; }
        f32x4 o4; o4.x = -(v[0] + base) * LOG2E; o4.y = -(v[1] + base) * LOG2E; o4.z = -(v[2] + base) * LOG2E; o4.w = -(v[3] + base) * LOG2E;
        *(f32x4*)(cb + ((size_t)b * 8 + h) * SEQ + s0) = o4;
    }
}
__device__ __forceinline__ void fox_knorm_phase(const P& p, int t0, int tstep, int tend) {
    int tid = threadIdx.x; asm volatile("" : "+v"(tid));
    const int lane = tid & 63, wave = __builtin_amdgcn_readfirstlane(tid >> 6);
    const bf16* proj = WSP(bf16, WS_PROJ); float* kn = WSP(float, WS_MOE + MO_KN);
    for (int task = t0 + wave; task < tend; task += tstep) {
        const int j = task & 31, h = (task >> 5) & 7, b = task >> 8;
        float mx = 0.f;
#pragma unroll
        for (int i = 0; i < 8; ++i) {
            const v4u w = *(const v4u*)(proj + ((size_t)b * SEQ + j * 64 + i * 8 + (lane >> 3)) * PW + C_FK + h * 64 + (lane & 7) * 8);
            const unsigned ww[4] = {w.x, w.y, w.z, w.w}; float ss = 0.f;
#pragma unroll
            for (int e = 0; e < 4; ++e) { const float a = __builtin_bit_cast(float, ww[e] << 16), c = __builtin_bit_cast(float, ww[e] & 0xffff0000u); ss += a * a + c * c; }
            ss += __shfl_xor(ss, 1); ss += __shfl_xor(ss, 2); ss += __shfl_xor(ss, 4);
            mx = fmaxf(mx, ss);
        }
        mx = wave_max(mx);
        if (lane == 0) kn[task] = sqrtf(mx) * 1.0001f;
    }
}
__device__ __forceinline__ void router_weights(const P& p, int gtid, int gstride) {
    for (int idx = gtid; idx < NLAYER * 32768; idx += gstride) {
        const int l = idx >> 15, r = idx & 32767, k = r >> 5, n = r & 31;
        float v = 0.f;
        if (n < 16) v = p.w_re[((size_t)l * DM + k) * 16 + n]; else if (n < 20) v = p.w_rg[((size_t)l * DM + k) * 4 + (n - 16)];
        v *= p.moe_norm[l * DM + k];
        float* wr = (float*)(ws_base(p.ws) + WS_W + (size_t)l * WS_WLAYER + WO_RHI);
        wr[((((k >> 5) * 4 + ((k >> 3) & 3)) * 2 + ((k >> 2) & 1)) * 32 + n) * 4 + (k & 3)] = v;
    }
}
__device__ __forceinline__ void route_phase(const P& p, int l, LAS unsigned char* lds, int t0, int tstep) {
    int tid = threadIdx.x; asm volatile("" : "+v"(tid));
    const int lane = tid & 63, wave = __builtin_amdgcn_readfirstlane(tid >> 6);
    { const v4u* src = (const v4u*)(ws_base(p.ws) + WS_W + (size_t)l * WS_WLAYER + WO_RHI);
#pragma unroll 4
      for (int i = 0; i < 16; ++i) *(LAS v4u*)(lds + LDS_STAGE + (tid + NTHR * i) * 16) = src[tid + NTHR * i]; }
    LAS int* hist = (LAS int*)(lds + LDS_GATE);
    LAS int* tokj = hist + 32; LAS f32x2_t* tokgl = (LAS f32x2_t*)(hist + 160); LAS int* basej = hist + 416;
    const bf16* HBp = WSP(const bf16, WS_HB);
    int* gcnt = WSP(int, WS_MOE + MO_GCNT) + l * 32; int* rowtok2 = WSP(int, WS_RT2); f32x2_t* rowg2 = WSP(f32x2_t, WS_RG2);
    LAS float* lgb = (LAS float*)(lds + LDS_RS + wave * 2048);
    const int r = lane & 15, kq = lane >> 4;
    for (int task0 = t0; task0 < NTOK / 16; task0 += tstep) {
        if (tid < 32) hist[tid] = 0;
        __syncthreads();
        const int tok0 = (task0 + wave) * 16;
        const v4u* hp = (const v4u*)(HBp + (size_t)(tok0 + r) * DM + 8 * kq);
        f32x4 acc0 = {0.f, 0.f, 0.f, 0.f}, acc1 = {0.f, 0.f, 0.f, 0.f}; float q = 0.f;
#pragma unroll 8
        for (int s = 0; s < 32; ++s) {
            const v4u aw = hp[4 * s];
            const unsigned ww[4] = {aw.x, aw.y, aw.z, aw.w};
            const LAS unsigned char* bp = lds + LDS_STAGE + ((s * 4 + kq) * 2 * 32 + r) * 16;
            const f32x4 b00 = *(const LAS f32x4*)(bp), b01 = *(const LAS f32x4*)(bp + 32 * 16), b10 = *(const LAS f32x4*)(bp + 16 * 16), b11 = *(const LAS f32x4*)(bp + 48 * 16);
#pragma unroll
            for (int e = 0; e < 4; ++e) {
                const float a0 = __builtin_bit_cast(float, ww[e] << 16), a1 = __builtin_bit_cast(float, ww[e] & 0xffff0000u);
                q += a0 * a0 + a1 * a1;
                const f32x4& bl = e < 2 ? b00 : b01; const f32x4& bh = e < 2 ? b10 : b11;
                acc0 = __builtin_amdgcn_mfma_f32_16x16x4f32(a0, bl[(2 * e) & 3], acc0, 0, 0, 0); acc1 = __builtin_amdgcn_mfma_f32_16x16x4f32(a0, bh[(2 * e) & 3], acc1, 0, 0, 0);
                acc0 = __builtin_amdgcn_mfma_f32_16x16x4f32(a1, bl[(2 * e + 1) & 3], acc0, 0, 0, 0); acc1 = __builtin_amdgcn_mfma_f32_16x16x4f32(a1, bh[(2 * e + 1) & 3], acc1, 0, 0, 0);
            }
        }
        q += __shfl_xor(q, 16); q += __shfl_xor(q, 32);
        const float rsv = rsqrtf(q * (1.0f / DM) + EPS);
        const float bias0 = p.b_re[l * 16 + r], bias1 = r < 4 ? p.b_rg[l * 4 + r] : 0.f;
#pragma unroll
        for (int g = 0; g < 4; ++g) { const int row = 4 * kq + g; const float rs = __shfl(rsv, row);
            lgb[row * 32 + r] = acc0[g] * rs + bias0; lgb[row * 32 + 16 + r] = acc1[g] * rs + bias1; }
        LDS_WAIT();
        if (lane < 16) {
            const int tok = tok0 + lane;
            const LAS f32x4* lr = (const LAS f32x4*)(lgb + lane * 32);
            const f32x4 e0 = lr[0], e1 = lr[1], e2 = lr[2], e3 = lr[3], gl = lr[4];
            int g = 0; float gm = gl.x;
            if (gl.y > gm) { gm = gl.y; g = 1; } if (gl.z > gm) { gm = gl.z; g = 2; } if (gl.w > gm) { gm = gl.w; g = 3; }
            const float den = (expf(gl.x - gm) + expf(gl.y - gm)) + (expf(gl.z - gm) + expf(gl.w - gm));
            const float pg = 1.0f / den;
            const f32x4 el = g == 0 ? e0 : (g == 1 ? e1 : (g == 2 ? e2 : e3));
            int i0 = 0; float m0 = el.x;
            if (el.y > m0) { m0 = el.y; i0 = 1; } if (el.z > m0) { m0 = el.z; i0 = 2; } if (el.w > m0) { m0 = el.w; i0 = 3; }
            int i1 = -1; float m1 = -INFINITY;
            if (i0 != 0 && el.x > m1) { m1 = el.x; i1 = 0; } if (i0 != 1 && el.y > m1) { m1 = el.y; i1 = 1; }
            if (i0 != 2 && el.z > m1) { m1 = el.z; i1 = 2; } if (i0 != 3 && el.w > m1) { m1 = el.w; i1 = 3; }
            const float ex = expf(m1 - m0), inv = 1.0f / (1.0f + ex);
            const int elo = i0 < i1 ? i0 : i1, ehi = i0 < i1 ? i1 : i0;
            const int j = g * 8 + (elo == 0 ? ehi - 1 : (elo == 1 ? ehi + 1 : 5));
            const float g0 = pg * inv, g1 = pg * ex * inv;
            tokj[wave * 16 + lane] = j; tokgl[wave * 16 + lane] = i0 < i1 ? (f32x2_t){g0, g1} : (f32x2_t){g1, g0};
            atomicAdd((int*)&hist[j], 1);
        }
        __syncthreads();
        if (tid < 32) { const int n = hist[tid]; basej[tid] = n > 0 ? atomicAdd(&gcnt[tid], n) : 0; }
        __syncthreads();
        if (wave == 0) {
            int run[32];
#pragma unroll
            for (int x = 0; x < 32; ++x) run[x] = 0;
#pragma unroll 1
            for (int half = 0; half < 2; ++half) {
                const int t = half * 64 + lane, j = tokj[t];
                int rank = 0;
#pragma unroll
                for (int x = 0; x < 32; ++x) { if ((x & 7) >= 6) continue; const unsigned long long mk = __ballot(j == x); if (j == x) rank = run[x] + __popcll(mk & ((1ull << lane) - 1ull)); run[x] += __popcll(mk); }
                const int pos = basej[j] + rank;
                rowtok2[(size_t)j * BCAP + pos] = task0 * 16 + t; rowg2[(size_t)j * BCAP + pos] = tokgl[t];
            }
        }
    }
}
__device__ __forceinline__ int moe_tables(const P& p, int l, LAS unsigned char* lds) {
    int tid = threadIdx.x; asm volatile("" : "+v"(tid));
    LAS int* mt = (LAS int*)(lds + LDS_MOET);
    const int* gcnt = WSP(const int, WS_MOE + MO_GCNT) + l * 32;
    if (tid < 32) mt[tid] = gcnt[tid];
    __syncthreads();
    if (tid == 0) { int t = 0; for (int j = 0; j < 32; ++j) { mt[32 + j] = t; t += (mt[j] + 255) >> 8; } mt[64] = t; }
    __syncthreads();
    if (tid < MAXTILES) { int j = 0;
        for (int x = 1; x < 32; ++x) if (mt[32 + x] <= tid) j = x;
        const int g = j >> 3, pi = j & 7, elo = pi < 3 ? 0 : (pi < 5 ? 1 : 2), ehi = pi < 3 ? pi + 1 : (pi < 5 ? pi - 1 : 3);
        mt[96 + tid] = j | ((g * 4 + elo) << 8) | ((g * 4 + ehi) << 16); }
    __syncthreads();
    return __builtin_amdgcn_readfirstlane(mt[64]);
}
__device__ __forceinline__ void final_phase(const P& p, int vcu, int G) {
    int tid = threadIdx.x; asm volatile("" : "+v"(tid));
    const int lane = tid & 63, wave = __builtin_amdgcn_readfirstlane(tid >> 6);
    const float* ssq = WSP(const float, WS_SSQ); const bf16* hb = WSP(const bf16, WS_HB);
    f32x4 g[4];
#pragma unroll
    for (int j = 0; j < 4; ++j) g[j] = ((const f32x4*)p.final_norm)[lane + 64 * j];
    for (int m0 = (vcu * NWAVES + wave) * 4; m0 < NTOK; m0 += G * NWAVES * 4) {
        v2u w[4][4]; float rs[4];
#pragma unroll
        for (int r = 0; r < 4; ++r) { rs[r] = row_rs(ssq, m0 + r);
#pragma unroll
            for (int j = 0; j < 4; ++j) w[r][j] = ((const v2u*)(hb + (size_t)(m0 + r) * DM))[lane + 64 * j]; }
#pragma unroll
        for (int r = 0; r < 4; ++r) { f32x4* s = (f32x4*)(p.out + (size_t)(m0 + r) * DM) + lane;
#pragma unroll
            for (int j = 0; j < 4; ++j) { f32x4 v; v.x = __builtin_bit_cast(float, w[r][j].x << 16); v.y = __builtin_bit_cast(float, w[r][j].x & 0xffff0000u); v.z = __builtin_bit_cast(float, w[r][j].y << 16); v.w = __builtin_bit_cast(float, w[r][j].y & 0xffff0000u);
                s[64 * j] = v * rs[r] * g[j]; } }
    }
}
#ifndef ENMASK
#define ENMASK 0xffffffffu
#endif
#define EN(b) (((ENMASK) >> (b)) & 1u)
#ifndef REPMASK
#define REPMASK 0u
#endif
#define REPN(b) ((((REPMASK) >> (b)) & 1u) ? 2 : 1)
__device__ __attribute__((noinline)) void grid_barrier(unsigned* barw, unsigned x, volatile LAS unsigned* st) { XcdBarrier b; b.bar = barw; b.x = x; b.st = st; xcd_barrier(b); }
__device__ __attribute__((noinline)) void pair_sync(unsigned* flag, unsigned* barw, int same, unsigned n = 2u) {
    asm volatile("s_waitcnt vmcnt(0)" ::: "memory");
    __syncthreads();
    if (threadIdx.x == 0) {
        __builtin_amdgcn_s_waitcnt(0);
        if (!same) { __builtin_amdgcn_fence(__ATOMIC_RELEASE, "agent"); asm volatile("s_waitcnt vmcnt(0)" ::: "memory"); }
        (void)xb_add(flag, 1u);
        XB_SPIN(xb_ld(flag) < n, barw);
        __builtin_amdgcn_fence(__ATOMIC_ACQUIRE, "agent");
        asm volatile("s_waitcnt vmcnt(0)" ::: "memory");
    }
    __syncthreads();
}
__global__ void __launch_bounds__(NTHR, 2) fwd(Args args) {
    extern __shared__ __attribute__((aligned(16))) unsigned char lds_raw[];
    LAS unsigned char* lds = (LAS unsigned char*)lds_raw;
    const P& p = args.p;
    const int tid = threadIdx.x, lane = tid & 63, wave = __builtin_amdgcn_readfirstlane(tid >> 6);
    const int G = gridDim.x; const int bx = blockIdx.x; const int vcu = (G % 8 == 0) ? (bx % 8) * (G / 8) + bx / 8 : bx;
    volatile LAS unsigned* MISC = (volatile LAS unsigned*)(lds + LDS_MISC);
    if (tid < 64) MISC[tid] = 0u;
    __syncthreads();
    unsigned* ctl = (unsigned*)(p.ws + WS_CTL);
    const int lo = args.ph_lo, hi = args.ph_hi;
    XcdBarrier bar; bar.bar = ctl + CW_BAR + args.li * XCD_BAR_WORDS; bar.x = 0; bar.st = nullptr;
    if (hi - lo > 1) bar = xcd_barrier_post(ctl + CW_BAR + args.li * XCD_BAR_WORDS, MISC);
    if (tid == 0) __hip_atomic_store(ctl + CW_XID + vcu, xb_xcc_id(), __ATOMIC_RELAXED, __HIP_MEMORY_SCOPE_AGENT);
#define IN(k) (lo <= (k) && (k) < hi)
#define PHL int vcuL = vcu, GL = G, bxL = bx; asm volatile("" : "+s"(vcuL), "+s"(GL), "+s"(bxL)); (void)vcuL; (void)GL; (void)bxL;
#define LTID(v) int v = threadIdx.x; asm volatile("" : "+v"(v))
#define FILL_RS_DENSE() do { LTID(tq); const int rr_ = tq & 255, hf_ = tq >> 8; f32x4 sv_[4][4]; bool ok_[4]; \
        _Pragma("unroll") for (int k_ = 0; k_ < 4; ++k_) { pg8::Unit u_ = {0, 0, 0}; ok_[k_] = S.next(hf_ + 2 * k_, u_); const f32x4* sp_ = (const f32x4*)(SSQ + (size_t)(ok_[k_] ? u_.pm * 256 + rr_ : 0) * 16); \
            _Pragma("unroll") for (int j_ = 0; j_ < 4; ++j_) sv_[k_][j_] = sp_[j_]; } \
        _Pragma("unroll") for (int k_ = 0; k_ < 4; ++k_) if (ok_[k_]) { const f32x4 a_ = (sv_[k_][0] + sv_[k_][1]) + (sv_[k_][2] + sv_[k_][3]); rstab[(hf_ + 2 * k_) * 256 + rr_] = rsqrtf(((a_.x + a_.y) + (a_.z + a_.w)) * (1.0f / DM) + EPS); } } while (0)
#define MOE_ROW(k_) pg8::Unit u_ = {0, 0, 0}; ok_[k_] = S.next(hf_ + 2 * k_, u_); const int j_ = u_.e & 255, sl_ = (u_.pm - moet[32 + j_]) * 256 + rr_; const bool v_ = ok_[k_] && sl_ < moet[j_]; \
        const size_t ix_ = (size_t)j_ * BCAP + (v_ ? sl_ : 0);
#define FILL_GU() do { LTID(tq); const int rr_ = tq & 255, hf_ = tq >> 8; f32x4 sv_[4][4]; bool ok_[4]; int tk_[4]; float gt_[4]; \
        _Pragma("unroll") for (int k_ = 0; k_ < 4; ++k_) { MOE_ROW(k_) const int t_ = RT2[ix_]; const f32x2_t g2_ = RG2[ix_]; tk_[k_] = v_ ? t_ : -1; gt_[k_] = v_ ? (u_.pn < 4 ? g2_.x : g2_.y) : 0.f; } \
        _Pragma("unroll") for (int k_ = 0; k_ < 4; ++k_) { tk_[k_] = tk_[k_] < 0 ? 0 : tk_[k_]; const f32x4* sp_ = (const f32x4*)(SSQ + (size_t)tk_[k_] * 16); \
            _Pragma("unroll") for (int j_ = 0; j_ < 4; ++j_) sv_[k_][j_] = sp_[j_]; } \
        _Pragma("unroll") for (int k_ = 0; k_ < 4; ++k_) if (ok_[k_]) { const f32x4 a_ = (sv_[k_][0] + sv_[k_][1]) + (sv_[k_][2] + sv_[k_][3]); rowtab[(hf_ + 2 * k_) * 256 + rr_] = tk_[k_]; gatetab[(hf_ + 2 * k_) * 256 + rr_] = gt_[k_]; \
            rstab[(hf_ + 2 * k_) * 256 + rr_] = rsqrtf(((a_.x + a_.y) + (a_.z + a_.w)) * (1.0f / DM) + EPS); } } while (0)
#define FILL_DOWN() do { LTID(tq); const int rr_ = tq & 255, hf_ = tq >> 8; bool ok_[4]; int tk_[4]; \
        _Pragma("unroll") for (int k_ = 0; k_ < 4; ++k_) { MOE_ROW(k_) const int t_ = RT2[ix_]; tk_[k_] = v_ ? t_ : -1; } \
        _Pragma("unroll") for (int k_ = 0; k_ < 4; ++k_) if (ok_[k_]) { rowtab[(hf_ + 2 * k_) * 256 + rr_] = tk_[k_]; } } while (0)

#define SEAM(k) do { if (IN(k) && IN((k) + 1)) { grid_barrier(bar.bar, bar.x, bar.st); if (REPN(20) == 2) grid_barrier(bar.bar, bar.x, bar.st); } } while (0)
    LAS float* rstab = (LAS float*)(lds + LDS_RS); LAS int* rowtab = (LAS int*)(lds + LDS_ROWTOK); LAS float* gatetab = (LAS float*)(lds + LDS_GATE); const LAS int* moet = (const LAS int*)(lds + LDS_MOET);
#define HB WSP(bf16, WS_HB)
#define PROJ WSP(bf16, WS_PROJ)
#define Y WSP(bf16, WS_Y)
#define XKV WSP(bf16, WS_XKV)
#define MEMN WSP(bf16, WS_MEMN)
#define SSQ WSP(float, WS_SSQ)
#define XQ WSP(bf16, WS_XQ)
#define U WSP(bf16, WS_U)
#define RT2 WSP(const int, WS_RT2)
#define RG2 WSP(const f32x2_t, WS_RG2)
#define H (p.out)
#define HB8 ((unsigned char*)p.out + 64 * MiB)
#define U8 WSP(unsigned char, WS_U)

    if (EN(0) && IN(PH_PRO)) _Pragma("unroll 1") for (int rep_ = 0; rep_ < REPN(0); ++rep_) { PHL prologue(p, lds, vcuL, GL, wave, lane); }
    SEAM(PH_PRO);
    if (REPN(18) == 2 && IN(PH_XKV)) { PHL
        pg8::StaticOrder S; S.init(HB, ws_base(p.ws) + WS_W + WO_IN, NTOK, 3072, DM, GL, bxL);
        FILL_RS_DENSE();
        __syncthreads();
        EpiBf16<true> E{PROJ, PW, rstab};
        pg8::gemm_phase<DM, EpiBf16<true>, pg8::StaticOrder, true>(lds + LDS_STAGE, S, E);
    }
    for (int l = 0; l < NLAYER; ++l) {
        const int pb = PH_L0 + l * NPH;
        unsigned char* wl = ws_base(p.ws) + WS_W + (size_t)l * WS_WLAYER;
        if (EN(2) && IN(pb + LP_INPROJ)) _Pragma("unroll 1") for (int rep_ = 0; rep_ < REPN(2); ++rep_) { PHL
            pg8::StaticOrder S; S.init(HB, wl + WO_IN, NTOK, 3072, DM, GL, bxL);
            FILL_RS_DENSE();
            __syncthreads();
            EpiBf16<true> E{PROJ, PW, rstab};
            pg8::gemm_phase<DM, EpiBf16<true>, pg8::StaticOrder, true>(lds + LDS_STAGE, S, E);
            _Pragma("unroll 1") for (int r2_ = 0; r2_ < REPN(19); ++r2_) small_proj(p, l, lds + LDS_STAGE, vcuL, GL, wave, lane);
        }
        SEAM(pb + LP_INPROJ);
        if (IN(pb + LP_MIXA)) { PHL
            const int g4 = vcuL >> 2, q4 = vcuL & 3;
            int same4; { const unsigned idv = xb_ld(ctl + CW_XID + (vcuL & ~3) + (threadIdx.x & 3)); same4 = (int)(__builtin_amdgcn_ballot_w64(idv != xb_xcc_id()) == 0ull); }
            unsigned* mf = ctl + CW_MF + (l * 2 * 64 + g4) * 16;
            gla_phase_a(p, l, lds + LDS_STAGE, vcuL, GL);
            fox_cumsum_phase(p, l, lds + LDS_STAGE, q4 * 64 + g4, 128, q4 < 2 ? 128 : 0);
            fox_knorm_phase(p, g4 * 32 + q4 * 8, 64 * 32, 128 * 32);
            pair_sync(mf, bar.bar, same4, 4u);
            gla_phase_b(p, vcuL, GL);
            if (l == 0) {
                pg8::StaticOrder S; S.init(MEMN, ws_base(p.ws) + WS_WXKV, 4096, 2048, DM, GL, bxL);
                EpiBf16<false> E{XKV, 2048, rstab};
                pg8::gemm_phase<DM, EpiBf16<false>, pg8::StaticOrder, true>(lds + LDS_STAGE, S, E);
            }
            pair_sync(mf + 64 * 16, bar.bar, same4, 4u);
            fox_phase(p, l, lds + LDS_STAGE, vcuL, GL);
            gla_phase_c(p, l, lds + LDS_STAGE, vcuL * 8, 1, vcuL * 8 + 8);
        }
        SEAM(pb + LP_MIXC);
        if (IN(pb + LP_WOUT)) { PHL
            const int side = vcuL & 1;
            const int same = (int)((unsigned)__builtin_amdgcn_readfirstlane((int)xb_ld(ctl + CW_XID + (vcuL ^ 1))) == xb_xcc_id());
            for (int pm = vcuL >> 1; pm < NTOK / 256; pm += GL >> 1) {
                unsigned* pf = ctl + CW_PF + ((l * 3) * 128 + pm) * 16;
                { pg8::PairOrder S{(const char*)Y, (const char*)(wl + WO_OUT), DM, pm, 2 * side, 2};
                  EpiRes<0> E{HB, SSQ, rowtab, 1.f, nullptr};
                  pg8::gemm_phase<DM, EpiRes<0>, pg8::PairOrder, true>(lds + LDS_STAGE, S, E); }
                pair_sync(pf, bar.bar, same);
                { pg8::PairOrder S{(const char*)HB, (const char*)(wl + WO_XQ), DM, pm, side, 1};
                  FILL_RS_DENSE();
                  __syncthreads();
                  EpiBf16<true> E{XQ, 512, rstab};
                  pg8::gemm_phase<DM, EpiBf16<true>, pg8::PairOrder, true>(lds + LDS_STAGE, S, E);
                  asm volatile("s_waitcnt vmcnt(0)" ::: "memory"); __syncthreads();
                  xattn_pair(p, l, lds + LDS_STAGE, pm, side, false); }
                pair_sync(pf + 128 * 16, bar.bar, same);
                { pg8::PairOrder S{(const char*)WSP(unsigned char, WS_XO8), (const char*)(wl + WO_XO), 256, pm, 2 * side, 2};
                  EpiRes<0, true> E{HB, SSQ, rowtab, 1.f, HB8};
                  pg8::gemm_phase<256, EpiRes<0, true>, pg8::PairOrder, true, true, 127, 122>(lds + LDS_STAGE, S, E); }
                pair_sync(pf + 2 * 128 * 16, bar.bar, same);
                route_phase(p, l, lds, (pm * 2 + side) * NWAVES, NTOK);
            }
        }
        SEAM(pb + LP_ROUTE);
        if (IN(pb + LP_GU)) { PHL
            const int T_ = moe_tables(p, l, lds);
            int gsame;
            { const unsigned idv = xb_ld(ctl + CW_XID + (vcuL & ~31) + (threadIdx.x & 31)); gsame = (int)(__builtin_amdgcn_ballot_w64(idv != xb_xcc_id()) == 0ull); }
            unsigned* gfl = ctl + CW_GF + l * MAXTILES * 16;
            { MoeOrder<0> S{(const char*)HB8, (const char*)(wl + WO_GU), 512, (size_t)1024 * 1024, moet + 96, rowtab, gfl, bar.bar, gsame}; S.init_group(T_, GL, vcuL);
              __syncthreads();
              FILL_GU();
              __syncthreads();
              EpiGU E{U8, rstab, gatetab};
              pg8::gemm_phase<512, EpiGU, MoeOrder<0>, true, true, 127, 122>(lds + LDS_STAGE, S, E); }
            { MoeOrder<1> S{(const char*)U8, (const char*)(wl + WO_D), 512, (size_t)1024 * 512, moet + 96, rowtab, gfl, bar.bar, gsame}; S.init_group(T_, GL, vcuL);
              __syncthreads();
              FILL_DOWN();
              __syncthreads();
              EpiRes<2> E{HB, SSQ, rowtab, 1.f, nullptr};
              pg8::gemm_phase<512, EpiRes<2>, MoeOrder<1>, true, true, 125, 122, 256, true>(lds + LDS_STAGE, S, E); }
        }
        SEAM(pb + LP_DOWN1);
    }
    if (EN(15) && IN(PH_FINAL)) _Pragma("unroll 1") for (int rep_ = 0; rep_ < REPN(15); ++rep_) { PHL final_phase(p, vcuL, GL); }
#undef IN
#undef SEAM
#undef HB
#undef PROJ
#undef Y
#undef XKV
#undef MEMN
#undef SSQ
#undef XQ
#undef U
#undef RT2
#undef RG2
#undef H
#undef HB8
#undef U8
}

static int g_grid = 0;
static void launch_fast(const P& p, int lo, int hi, int& li, hipStream_t stream) {
    Args a{}; a.p = p; a.ph_lo = lo; a.ph_hi = hi; a.li = li++; a.pad = 0;
    hipLaunchKernelGGL(fwd, dim3(g_grid), dim3(NTHR), LDS_BYTES, stream, a);
    const hipError_t le = hipPeekAtLastError();
    if (le != hipSuccess) fprintf(stderr, "kernel_launch: fwd launch [%d,%d) failed: %s\n", lo, hi, hipGetErrorName(le));
}
extern "C" void kernel_launch(void* const* d_in, const int* in_sizes, int n_in, void* d_out, int out_size, void* d_ws, size_t ws_size, hipStream_t stream) {
    if (n_in != 25 || out_size != NTOK * DM || ws_size < WS_END2) { fprintf(stderr, "kernel_launch: unexpected sizes n_in %d out %d ws %zu (need %zu)\n", n_in, out_size, ws_size, (size_t)WS_END2); return; }
    if (g_grid == 0) {
        int dev = 0, cus = 0, per_cu = 0;
        if (hipGetDevice(&dev) != hipSuccess || hipDeviceGetAttribute(&cus, hipDeviceAttributeMultiprocessorCount, dev) != hipSuccess) { g_grid = -1; return; }
        if (hipFuncSetAttribute((const void*)fwd, hipFuncAttributeMaxDynamicSharedMemorySize, LDS_BYTES) != hipSuccess) { fprintf(stderr, "kernel_launch: hipFuncSetAttribute failed\n"); g_grid = -1; return; }
        if (hipOccupancyMaxActiveBlocksPerMultiprocessor(&per_cu, (const void*)fwd, NTHR, LDS_BYTES) != hipSuccess || per_cu < 1) { fprintf(stderr, "kernel_launch: occupancy query says %d\n", per_cu); }
        (void)hipGetLastError();
        g_grid = cus >= 256 ? 256 : -1; if (g_grid < 0) fprintf(stderr, "kernel_launch: needs 256 CUs, device has %d\n", cus);
    }
    if (g_grid < 0) return;
    P p{};
    const float** pp = (const float**)&p;
    for (int i = 0; i < 25; ++i) pp[i] = (const float*)d_in[i];
    p.out = (float*)d_out; p.ws = (unsigned char*)d_ws;
    if (hipMemsetAsync((char*)d_ws + WS_CTL + (size_t)CW_BAR * 4, 0, (size_t)XCD_BAR_WORDS * 4, stream) != hipSuccess) { fprintf(stderr, "kernel_launch: hipMemsetAsync failed\n"); return; }
    int li = 0;
    launch_fast(p, PH_PRO, PH_END, li, stream);
}
```

```cpp
#include <hip/hip_runtime.h>
#include <cstdio>
#include <cstdint>

constexpr int NTOK = 32768, DM = 1024, NBATCH = 16, SEQ = 2048, NLAYER = 2, MEML = 256;
constexpr int PW = 3072;
constexpr int C_FQ = 0, C_FK = 512, C_FV = 1024, C_GQ = 1536, C_GK = 1792, C_GV = 2048, C_GG = 2560;
constexpr int INW = 3096;
constexpr float EPS = 1e-6f, LOG2E = 1.4426950408889634f;
constexpr int MAXTILES = 288;
constexpr int MAXROWS = MAXTILES * 256;

typedef unsigned short bf16;
__device__ __forceinline__ unsigned f2bf(float f) { unsigned u = __builtin_bit_cast(unsigned, f); return (u + 0x7fffu + ((u >> 16) & 1u)) >> 16; }
__device__ __forceinline__ float bf2f(bf16 b) { return __builtin_bit_cast(float, ((unsigned)b) << 16); }

constexpr size_t MiB = 1u << 20;
constexpr size_t WS_CTL = 0;
constexpr size_t WS_W = 1 * MiB;
constexpr size_t WS_WLAYER = 59 * MiB;
constexpr size_t WS_WXKV = WS_W + 2 * WS_WLAYER;
constexpr size_t WS_HB = WS_WXKV + 4 * MiB;
constexpr size_t WS_PROJ = WS_HB + 64 * MiB;
constexpr size_t WS_XQ = WS_PROJ;
constexpr size_t WS_U = WS_PROJ + 32 * MiB;
constexpr size_t WS_XO8 = WS_U + 40 * MiB;
constexpr size_t WS_SM = WS_PROJ + 192 * MiB;
constexpr size_t WS_CB = WS_SM + 4 * MiB;
constexpr size_t WS_Y = WS_CB + 1 * MiB;
constexpr size_t WS_XKV = WS_Y + 64 * MiB;
constexpr size_t WS_MEMN = WS_XKV + 16 * MiB;
constexpr size_t WS_SSQ = WS_MEMN + 8 * MiB;
constexpr size_t WS_MOE = WS_SSQ + 2 * MiB;
constexpr size_t WS_END = WS_MOE + 2 * MiB;
static_assert(WS_END <= 512 * MiB, "workspace map");
constexpr size_t MO_TOKE = 0;
constexpr size_t MO_TOKG = 256 * 1024;
constexpr size_t MO_ROWTOK = 512 * 1024;
constexpr size_t MO_ROWGATE = 832 * 1024;
constexpr size_t MO_TILEE = 1152 * 1024;
constexpr size_t MO_NT = 1156 * 1024;
constexpr size_t MO_HIST = 1160 * 1024;
constexpr size_t MO_GCNT = 1160 * 1024;
constexpr int BCAP = 32768;
constexpr size_t MO_KN = 1280 * 1024;

struct P {
    const float *x, *mem, *mem_norm, *mix_norm, *w_in, *b_forget, *w_alpha_up, *b_alpha, *fox_gain, *gla_gain, *w_out, *cross_norm, *w_xq, *w_xk, *w_xv, *w_xo,
        *moe_norm, *w_rg, *b_rg, *w_re, *b_re, *w_eg, *w_eu, *w_ed, *final_norm;
    float* out; unsigned char* ws;
};
__host__ __device__ __forceinline__ unsigned char* ws_base(unsigned char* w) {
#if defined(__HIP_DEVICE_COMPILE__)
    size_t z = 0; asm volatile("" : "+s"(z));
    return w + z;
#else
    return w;
#endif
}
#define WSP(T, off) ((T*)(ws_base(p.ws) + (off)))

__device__ __forceinline__ float wave_sum(float v) {
#pragma unroll
    for (int o = 1; o < 64; o <<= 1) v += __shfl_xor(v, o);
    return v;
}
__device__ __forceinline__ float wave_min(float v) {
#pragma unroll
    for (int o = 1; o < 64; o <<= 1) v = fminf(v, __shfl_xor(v, o));
    return v;
}
__device__ __forceinline__ float wave_max(float v) {
#pragma unroll
    for (int o = 1; o < 64; o <<= 1) v = fmaxf(v, __shfl_xor(v, o));
    return v;
}
__device__ __forceinline__ void xpair32(float v, float& a, float& b) {
    a = v; b = v; asm volatile("s_nop 1\n\tv_permlane32_swap_b32 %0, %1" : "+v"(a), "+v"(b)); }
__device__ __forceinline__ float xmax32(float v) { float a, b; xpair32(v, a, b); return fmaxf(a, b); }
__device__ __forceinline__ float xadd32(float v) { float a, b; xpair32(v, a, b); return a + b; }
__device__ __forceinline__ float xadd16(float v) { float a = v, b = v; asm volatile("s_nop 1\n\tv_permlane16_swap_b32 %0, %1" : "+v"(a), "+v"(b)); return a + b; }
__device__ __forceinline__ float row_rs(const float* ssq, int row) {
    const float4* s = (const float4*)(ssq + (size_t)row * 16);
    float4 a = s[0], b = s[1], c = s[2], d = s[3];
    float t = ((a.x + a.y) + (a.z + a.w)) + ((b.x + b.y) + (b.z + b.w)) + ((c.x + c.y) + (c.z + c.w)) + ((d.x + d.y) + (d.z + d.w));
    return rsqrtf(t * (1.0f / DM) + EPS);
}
__device__ __forceinline__ float log_sigmoid(float z) { return fminf(z, 0.f) - log1pf(expf(-fabsf(z))); }
__device__ __forceinline__ float silu(float z) { return z / (1.f + expf(-z)); }

typedef unsigned st_v4u __attribute__((ext_vector_type(4)));
typedef unsigned st_v2u __attribute__((ext_vector_type(2)));
#ifndef WT_STORES
#define WT_STORES 0
#endif
__device__ __forceinline__ void st_b128(void* p, st_v4u v) {
#if WT_STORES
    asm volatile("global_store_dwordx4 %0, %1, off sc1\n\ts_nop 1" :: "v"(p), "v"(v) : "memory");
#else
    *(st_v4u*)p = v;
#endif
}
__device__ __forceinline__ void st_b128_wt(void* p, st_v4u v) { asm volatile("global_store_dwordx4 %0, %1, off sc1\n\ts_nop 1" :: "v"(p), "v"(v) : "memory"); }
__device__ __forceinline__ void st_b64(void* p, st_v2u v) {
#if WT_STORES
    asm volatile("global_store_dwordx2 %0, %1, off sc1" :: "v"(p), "v"(v) : "memory");
#else
    *(st_v2u*)p = v;
#endif
}
#define XB_TMO      128
#define XB_XCNT(j)  (256  + 64 * (j))
#define XB_XSUB(j)  (1280 + 64 * (j))
#define XB_XGEN(j)  (2304 + 64 * (j))
#define XB_TOP      3328
#define XB_TOPGEN   3392
#define XCD_BAR_WORDS 3456
#define XB_SPIN_CAP (1u << 18)
#define LAS __attribute__((address_space(3)))

__device__ __forceinline__ unsigned xb_ld(unsigned* p)              { return __hip_atomic_load(p, __ATOMIC_RELAXED, __HIP_MEMORY_SCOPE_AGENT); }
__device__ __forceinline__ unsigned xb_add(unsigned* p, unsigned v) { return __hip_atomic_fetch_add(p, v, __ATOMIC_RELAXED, __HIP_MEMORY_SCOPE_AGENT); }
__device__ __forceinline__ unsigned xb_xcc_id() { return (unsigned)__builtin_amdgcn_s_getreg((3 << 11) | 20) & 0xFu; }
#define XB_SPIN(cond, bar) do { unsigned _sp = 0; while (cond) { __builtin_amdgcn_s_sleep(1); \
    if ((++_sp & 255u) == 0u) { if (xb_ld(&(bar)[XB_TMO])) break; if (_sp > XB_SPIN_CAP) { atomicAdd(&(bar)[XB_TMO], 1u); break; } } } } while (0)

struct XcdBarrier {
    unsigned* bar; unsigned x;
    volatile LAS unsigned* st;
};

__device__ __forceinline__ XcdBarrier xcd_barrier_post(unsigned* bar, volatile LAS unsigned* st) {
    XcdBarrier b; b.bar = bar; b.x = xb_xcc_id(); b.st = st;
    if (threadIdx.x == 0) (void)xb_add(&bar[XB_XCNT(b.x)], 1u);
    return b;
}
__device__ __forceinline__ void xcd_barrier_complete(unsigned* bar, unsigned x, unsigned& nloc, unsigned& nx) {
    const unsigned G = gridDim.x * gridDim.y * gridDim.z;
    unsigned sum, cnt, mine, sp = 0u;
    for (;;) {
        sum = 0u; cnt = 0u; mine = 0u;
#pragma unroll
        for (unsigned j = 0; j < 16; ++j) { const unsigned c = xb_ld(&bar[XB_XCNT(j)]); sum += c; cnt += (c > 0u) ? 1u : 0u; mine = (j == x) ? c : mine; }
        if (sum == G) break;
        __builtin_amdgcn_s_sleep(1);
        if ((++sp & 255u) == 0u) { if (xb_ld(&bar[XB_TMO])) break; if (sp > XB_SPIN_CAP) { atomicAdd(&bar[XB_TMO], 1u); break; } }
    }
    nloc = mine > 0u ? mine : 1u; nx = cnt > 0u ? cnt : 1u;
}

__device__ __forceinline__ void xcd_barrier(const XcdBarrier& b) {
    asm volatile("s_waitcnt vmcnt(0)" ::: "memory");
    __syncthreads();
    if (threadIdx.x == 0) {
        unsigned* bar = b.bar;
        __builtin_amdgcn_s_waitcnt(0);
        unsigned nloc = b.st[0], nx = b.st[1];
        if (nloc == 0u) { xcd_barrier_complete(bar, b.x, nloc, nx); b.st[0] = nloc; b.st[1] = nx; }
        const unsigned old = xb_add(&bar[XB_XSUB(b.x)], 1u);
        const unsigned gen = old / nloc;
        if (old + 1u == (gen + 1u) * nloc) {
            __builtin_amdgcn_fence(__ATOMIC_RELEASE, "agent");
            asm volatile("s_waitcnt vmcnt(0)" ::: "memory");
            const unsigned og = xb_add(&bar[XB_TOP], 1u);
            const unsigned tg = og / nx;
            if (og + 1u == (tg + 1u) * nx) xb_add(&bar[XB_TOPGEN], 1u);
            else XB_SPIN(xb_ld(&bar[XB_TOPGEN]) == tg, bar);
            __builtin_amdgcn_fence(__ATOMIC_ACQUIRE, "agent");
            xb_add(&bar[XB_XGEN(b.x)], 1u);
            asm volatile("s_waitcnt vmcnt(0)" ::: "memory");
        } else {
            XB_SPIN(xb_ld(&bar[XB_XGEN(b.x)]) == gen, bar);
            __builtin_amdgcn_fence(__ATOMIC_ACQUIRE, "agent");
            asm volatile("s_waitcnt vmcnt(0)" ::: "memory");
        }
    }
    __syncthreads();
}

namespace pg8 {
#define PG8_LAS __attribute__((address_space(3)))
typedef unsigned short bf16_t;
typedef short bf16x8 __attribute__((ext_vector_type(8)));
typedef float f32x4 __attribute__((ext_vector_type(4)));
typedef unsigned u32x4 __attribute__((ext_vector_type(4)));
typedef unsigned u32x2 __attribute__((ext_vector_type(2)));
constexpr int BM = 256, BK = 64, HALF = 128, HTB = HALF * BK * 2, STAGE_BYTES = 8 * HTB, NXCD = 8, WGM = 8;

__host__ __device__ __forceinline__ int lds_byte(int r, int c) { const int st = (r >> 4) * 2 + (c >> 5), rr = r & 15, cc = c & 31, ob = rr * 64 + cc * 2; return st * 1024 + (ob ^ (((ob >> 9) & 1) << 5)); }
__host__ __device__ __forceinline__ void stage_rc(int b, int& R, int& C) { const int st = b / 1024, sb = b % 1024, swz = sb ^ (((sb >> 9) & 1) << 5); R = (st >> 1) * 16 + swz / 64; C = (st & 1) * 32 + (swz % 64) / 2; }
__host__ __device__ __forceinline__ int perm32(int rho) { const int n = rho >> 4, i = rho & 15; return 8 * (i >> 2) + 4 * n + (i & 3); }

struct Unit { int pm, pn, e; };

struct StaticOrder {
    static constexpr bool GATHER = false, SIGNAL = false, WAITS = false;
    static constexpr size_t KSTEP_A = 128;
    const char* A; const char* Bt; int K; int nM, nN, nwg, G, c;
    __device__ void init(const void* A_, const void* Bt_, int M, int N, int K_, int G_, int c_) { A = (const char*)A_; Bt = (const char*)Bt_; K = K_; nM = M / BM; nN = N / BM; nwg = nM * nN; G = G_; c = c_; }
    __device__ bool next(int i, Unit& u) const {
        const long L = (long)i * G + c; if (L >= nwg) return false;
        int wgid = (int)L; { const int q = nwg / NXCD, r = nwg % NXCD, xcd = wgid % NXCD, off = wgid / NXCD; wgid = (xcd < r ? xcd * (q + 1) : r * (q + 1) + (xcd - r) * q) + off; }
        const int nig = WGM * nN, gid = wgid / nig, fm = gid * WGM, gsz = (nM - fm) < WGM ? (nM - fm) : WGM;
        u.pm = fm + ((wgid % nig) % gsz); u.pn = (wgid % nig) / gsz; u.e = 0; return true;
    }
    __device__ __forceinline__ const char* a_base(const Unit& u) const { return A + (size_t)u.pm * (size_t)(BM * 2) * K; }
    __device__ __forceinline__ const char* b_base(const Unit& u) const { return Bt + (size_t)u.pn * (size_t)(BM * 2) * K; }
    __device__ __forceinline__ unsigned a_off(int, int, int, int) const { return 0u; }
};

struct PairOrder {
    static constexpr bool GATHER = false, SIGNAL = false, WAITS = false;
    static constexpr size_t KSTEP_A = 128;
    const char* A; const char* Bt; int K; int pm, pn0, n;
    __device__ bool next(int i, Unit& u) const { if (i >= n) return false; u.pm = pm; u.pn = pn0 + i; u.e = 0; return true; }
    __device__ __forceinline__ const char* a_base(const Unit& u) const { return A + (size_t)u.pm * (size_t)(BM * 2) * K; }
    __device__ __forceinline__ const char* b_base(const Unit& u) const { return Bt + (size_t)u.pn * (size_t)(BM * 2) * K; }
    __device__ __forceinline__ unsigned a_off(int, int, int, int) const { return 0u; }
};

__device__ __forceinline__ unsigned cvt_pk_bf16(float lo, float hi) { unsigned r; asm volatile("v_cvt_pk_bf16_f32 %0, %1, %2" : "=v"(r) : "v"(lo), "v"(hi)); return r; }

typedef int i32x8 __attribute__((ext_vector_type(8)));
typedef int i32x4 __attribute__((ext_vector_type(4)));
template <int K, class Epi, class Sched, bool ALIGN_EPI, bool FP8 = false, int SA = 127, int SB = 127, int KB = K, bool BSPLIT = false>
__device__ __forceinline__ void gemm_phase(PG8_LAS unsigned char* lds, const Sched& S, const Epi& E) {
    int tid_ = threadIdx.x; asm volatile("" : "+v"(tid_));
    const int tid = tid_, wid = __builtin_amdgcn_readfirstlane(tid >> 6), lane = tid & 63, wr = wid >> 2, wc = wid & 3, fr = lane & 15, fq = lane >> 4;
    constexpr int nt = K / BK;
    constexpr int NH = Sched::GATHER ? 2 : 1;
    unsigned voffB[2], cvA[NH][2], nvA[NH][2];
#pragma unroll
    for (int i = 0; i < 2; ++i) { int R, C; stage_rc(tid * 16 + i * 8192, R, C); const int Rb = Epi::PERM ? ((R & ~31) + perm32(R & 31)) : R;
        voffB[i] = (unsigned)(Rb * KB + C) * 2u;
        cvA[0][i] = nvA[0][i] = (unsigned)(R * K + C) * 2u; if constexpr (NH == 2) { cvA[NH - 1][i] = nvA[NH - 1][i] = cvA[0][i]; } }
    constexpr size_t kstep = (size_t)(BK * 2);
    constexpr size_t hstep = (size_t)HALF * K * 2;
    constexpr size_t hstepA = Sched::GATHER ? (size_t)0 : hstep;
    constexpr size_t hstepB = (size_t)HALF * KB * 2;
    constexpr size_t kstepA = Sched::KSTEP_A;
    const unsigned ldsw = (unsigned)wid * 1024u;
    const int aoff = lds_byte(wr * 64 + fr, fq * 8), boff = lds_byte(wc * 32 + fr, fq * 8);
#define PG8_SA(b, h) (((b) * 2 + (h)) * HTB)
#define PG8_SB(b, h) ((4 + (b) * 2 + (h)) * HTB)
#define PG8_STAGE(bufoff, gbase, voff) do { _Pragma("unroll") for (int _i = 0; _i < 2; ++_i) \
        __builtin_amdgcn_global_load_lds((const unsigned*)((const char*)(gbase) + (voff)[_i]), (PG8_LAS unsigned*)(lds + (bufoff) + ldsw + _i * 8192), 16, 0, 0); } while (0)
#define PG8_LD32(addr) __builtin_shufflevector(*(const PG8_LAS i32x4*)(addr), *(const PG8_LAS i32x4*)((addr) + 1024), 0, 1, 2, 3, 4, 5, 6, 7)
#define PG8_LDA(dst, b, h) do { _Pragma("unroll") for (int m = 0; m < 4; ++m) dst[m] = PG8_LD32(lds + PG8_SA(b, h) + aoff + m * 2048); } while (0)
#define PG8_LDB(dst, b, h) do { _Pragma("unroll") for (int n = 0; n < 2; ++n) dst[n] = PG8_LD32(lds + PG8_SB(b, h) + boff + n * 2048); } while (0)
#define PG8_H0(x) __builtin_bit_cast(bf16x8, __builtin_shufflevector((x), (x), 0, 1, 2, 3))
#define PG8_H1(x) __builtin_bit_cast(bf16x8, __builtin_shufflevector((x), (x), 4, 5, 6, 7))
#define PG8_MMA(ai, bj, At, Bt) do { __builtin_amdgcn_s_setprio(1); _Pragma("unroll") for (int m = 0; m < 4; ++m) _Pragma("unroll") for (int n = 0; n < 2; ++n) { \
        if constexpr (FP8) asm volatile("v_mfma_scale_f32_16x16x128_f8f6f4 %0, %1, %2, %0, %3, %4 op_sel_hi:[0,0,0]" : "+v"(acc[ai][bj][m][n]) : "v"(Bt[n]), "v"(At[m]), "v"(sbv), "v"(sav)); \
        else { acc[ai][bj][m][n] = __builtin_amdgcn_mfma_f32_16x16x32_bf16(PG8_H0(Bt[n]), PG8_H0(At[m]), acc[ai][bj][m][n], 0, 0, 0); \
               acc[ai][bj][m][n] = __builtin_amdgcn_mfma_f32_16x16x32_bf16(PG8_H1(Bt[n]), PG8_H1(At[m]), acc[ai][bj][m][n], 0, 0, 0); } } \
        __builtin_amdgcn_s_setprio(0); } while (0)
#define PG8_WAIT_V(n) asm volatile("s_waitcnt vmcnt(" #n ")" ::: "memory")
#define PG8_WAIT_L(n) asm volatile("s_waitcnt lgkmcnt(" #n ")" ::: "memory")
#define PG8_BAR __builtin_amdgcn_s_barrier()
#define PG8_SCHED __builtin_amdgcn_sched_barrier(0)
    int sav = SA, sbv = SB; asm volatile("" : "+v"(sav), "+v"(sbv));
    Unit cur, nxt; int ui = 0; int sig_pm = 0;
    if (!S.next(0, cur)) return;
    if constexpr (Sched::WAITS) { if (wid == 0) S.wait(cur); PG8_BAR; }
    f32x4 acc[2][2][4][2];
#pragma unroll
    for (int a = 0; a < 2; ++a)
#pragma unroll
        for (int b = 0; b < 2; ++b)
#pragma unroll
            for (int m = 0; m < 4; ++m)
#pragma unroll
                for (int n = 0; n < 2; ++n) acc[a][b][m][n] = (f32x4){0.f, 0.f, 0.f, 0.f};
    i32x8 At[4], B0[2], B1[2];
    const char* cA = S.a_base(cur); const char* cB = S.b_base(cur);
    if constexpr (Sched::GATHER) {
        int R0, C0, R1, C1; stage_rc(tid * 16, R0, C0); stage_rc(tid * 16 + 8192, R1, C1);
#pragma unroll
        for (int h = 0; h < 2; ++h) { cvA[h][0] = S.a_off(0, h, R0, C0 * 2); cvA[h][1] = S.a_off(0, h, R1, C1 * 2); }
    }
    PG8_STAGE(PG8_SB(0, 0), cB, voffB); PG8_STAGE(PG8_SB(0, 1), cB + hstepB, voffB); PG8_STAGE(PG8_SA(0, 0), cA, cvA[0]); PG8_STAGE(PG8_SA(0, 1), cA + hstepA, cvA[NH - 1]);
    if (wr == 1) PG8_BAR;
    PG8_WAIT_V(2); PG8_BAR;
    PG8_STAGE(PG8_SB(1, 0), cB + kstep, voffB); PG8_STAGE(PG8_SA(1, 0), cA + kstepA, cvA[0]); PG8_STAGE(PG8_SB(1, 1), cB + hstepB + kstep, voffB);
    PG8_WAIT_V(6); PG8_BAR;
    for (;;) {
        const bool has_next = S.next(ui + 1, nxt);
        if constexpr (Sched::WAITS) { if (has_next && wid == 0) S.wait(nxt); }
        const char* nA = has_next ? S.a_base(nxt) : cA; const char* nB = has_next ? S.b_base(nxt) : cB;
        if constexpr (Sched::GATHER) {
            if (has_next) {
                int t2 = threadIdx.x; asm volatile("" : "+v"(t2));
                int R0, C0, R1, C1; stage_rc(t2 * 16, R0, C0); stage_rc(t2 * 16 + 8192, R1, C1);
#pragma unroll
                for (int h = 0; h < 2; ++h) { nvA[h][0] = S.a_off(ui + 1, h, R0, C0 * 2); nvA[h][1] = S.a_off(ui + 1, h, R1, C1 * 2); }
            } else {
#pragma unroll
                for (int h = 0; h < 2; ++h) { nvA[h][0] = cvA[h][0]; nvA[h][1] = cvA[h][1]; }
            }
        }
#pragma unroll 1
        for (int t = 0; t < nt; t += 2) {
            const bool last = (t == nt - 2);
            const char* a1 = cA + (size_t)(t + 1) * kstepA;
            const char* a2 = last ? nA : cA + (size_t)(t + 2) * kstepA; const char* b2 = last ? nB : cB + (size_t)(t + 2) * kstep;
            if constexpr (BSPLIT) { if (!last && t + 2 >= nt / 2) b2 += S.b_delta(cur); }
            const char* a3 = a2 + kstepA; const char* b3 = b2 + kstep;
            unsigned v2[NH][2];
#pragma unroll
            for (int h = 0; h < NH; ++h) { if constexpr (Sched::GATHER) { v2[h][0] = last ? nvA[h][0] : cvA[h][0]; v2[h][1] = last ? nvA[h][1] : cvA[h][1]; } else { v2[h][0] = cvA[h][0]; v2[h][1] = cvA[h][1]; } }
            PG8_LDB(B0, 0, 0); PG8_LDB(B1, 0, 1); PG8_SCHED; PG8_LDA(At, 0, 0); PG8_STAGE(PG8_SA(1, 1), a1 + hstepA, cvA[NH - 1]);
            PG8_WAIT_V(8); PG8_WAIT_L(0); PG8_BAR; PG8_MMA(0, 0, At, B0); PG8_MMA(0, 1, At, B1); PG8_BAR; PG8_SCHED;
            PG8_LDA(At, 0, 1); PG8_STAGE(PG8_SB(0, 0), b2, voffB); PG8_STAGE(PG8_SB(0, 1), b2 + hstepB, voffB); PG8_STAGE(PG8_SA(0, 0), a2, v2[0]);
            PG8_WAIT_V(8); PG8_WAIT_L(0); PG8_BAR; PG8_MMA(1, 0, At, B0); PG8_MMA(1, 1, At, B1); PG8_BAR; PG8_SCHED;
            PG8_LDB(B0, 1, 0); PG8_LDB(B1, 1, 1); PG8_SCHED; PG8_LDA(At, 1, 0); PG8_STAGE(PG8_SA(0, 1), a2 + hstepA, v2[NH - 1]);
            PG8_WAIT_V(8); PG8_WAIT_L(0); PG8_BAR; PG8_MMA(0, 0, At, B0); PG8_MMA(0, 1, At, B1); PG8_BAR; PG8_SCHED;
            PG8_LDA(At, 1, 1); PG8_STAGE(PG8_SB(1, 0), b3, voffB); PG8_STAGE(PG8_SB(1, 1), b3 + hstepB, voffB); PG8_STAGE(PG8_SA(1, 0), a3, v2[0]);
            PG8_WAIT_V(8); PG8_WAIT_L(0); PG8_BAR; PG8_MMA(1, 0, At, B0); PG8_MMA(1, 1, At, B1); PG8_BAR; PG8_SCHED;
        }
        if constexpr (ALIGN_EPI) { if (wr == 0) PG8_BAR; }
        if constexpr (FP8) asm volatile("s_nop 15\n\ts_nop 15" ::: "memory");
        { Unit eu = cur; asm volatile("" : "+s"(eu.pm), "+s"(eu.pn));
          if constexpr (Sched::SIGNAL) { if (ui > 0) S.signal(sig_pm, lane); sig_pm = eu.pm; }
          E(acc, eu, ui, wr, wc, fr, fq); }
        if (!has_next) break;
#pragma unroll
        for (int a = 0; a < 2; ++a)
#pragma unroll
            for (int b = 0; b < 2; ++b)
#pragma unroll
                for (int m = 0; m < 4; ++m)
#pragma unroll
                    for (int n = 0; n < 2; ++n) acc[a][b][m][n] = (f32x4){0.f, 0.f, 0.f, 0.f};
        cur = nxt; cA = nA; cB = nB; ++ui;
        if constexpr (Sched::GATHER) {
#pragma unroll
            for (int h = 0; h < NH; ++h) { cvA[h][0] = nvA[h][0]; cvA[h][1] = nvA[h][1]; }
        }
        if constexpr (ALIGN_EPI) { if (wr == 1) PG8_BAR; }
    }
    PG8_WAIT_V(0);
    if constexpr (Sched::SIGNAL) S.signal(sig_pm, lane);
    if constexpr (!ALIGN_EPI) { if (wr == 0) PG8_BAR; }
    PG8_BAR;
#undef PG8_SA
#undef PG8_SB
#undef PG8_STAGE
#undef PG8_LDA
#undef PG8_LDB
#undef PG8_MMA
#undef PG8_LD32
#undef PG8_H0
#undef PG8_H1
#undef PG8_WAIT_V
#undef PG8_WAIT_L
#undef PG8_BAR
#undef PG8_SCHED
}
}
#define GAS __attribute__((address_space(1)))
typedef float f32x4 __attribute__((ext_vector_type(4)));
typedef float f32x16 __attribute__((ext_vector_type(16)));
typedef short bf16x8 __attribute__((ext_vector_type(8)));
typedef unsigned v4u __attribute__((ext_vector_type(4)));
typedef unsigned v2u __attribute__((ext_vector_type(2)));
#define LDS_WAIT() asm volatile("s_waitcnt lgkmcnt(0)" ::: "memory")
#define VM_WAIT() asm volatile("s_waitcnt vmcnt(0)" ::: "memory")
__device__ __forceinline__ unsigned pk2(float lo, float hi) { return f2bf(lo) | (f2bf(hi) << 16); }

constexpr int NWAVES = 8, NTHR = 512;
constexpr int LDS_STAGE = 0;
constexpr int LDS_RS = 131072;
constexpr int LDS_ROWTOK = LDS_RS + 8192;
constexpr int LDS_GATE = LDS_ROWTOK + 8192;
constexpr int LDS_MISC = LDS_GATE + 8192;
constexpr int LDS_MOET = LDS_MISC + 256;
constexpr int LDS_BYTES = LDS_MOET + 2048;
static_assert(LDS_BYTES <= 160 * 1024, "lds");
constexpr size_t WO_IN = 0, WO_SM = 6 * MiB, WO_RHI = 6 * MiB + 65536, WO_RLO = 6 * MiB + 131072, WO_OUT = 7 * MiB, WO_XQ = 9 * MiB, WO_XO = 10 * MiB, WO_GU = 11 * MiB, WO_D = 43 * MiB;
static_assert(WO_D + 16 * MiB <= WS_WLAYER, "weight block");
constexpr int CW_BAR = 4096;
constexpr int MAX_LAUNCH = 1;
constexpr int CW_XID = 8192;
constexpr int CW_PF = 16384;
constexpr int PF_WORDS = NLAYER * 3 * 128 * 16;
constexpr int CW_GF = CW_PF + PF_WORDS;
constexpr int GF_WORDS = NLAYER * MAXTILES * 16;
constexpr int CW_MF = CW_GF + GF_WORDS;
constexpr int MF_WORDS = NLAYER * 2 * 64 * 16;
constexpr int CW_XT = CW_MF + MF_WORDS;
static_assert(CW_BAR + MAX_LAUNCH * XCD_BAR_WORDS <= CW_XID && CW_XID + 1024 <= CW_PF && (CW_XT + 16) * 4 <= (int)(1 * MiB), "ctl");

enum { PH_PRO = 0, PH_XKV = 1, PH_L0 = 2, NPH = 13, PH_FINAL = PH_L0 + NLAYER * NPH, PH_END = PH_FINAL + 1 };
enum { LP_INPROJ = 0, LP_MIXA, LP_MIXB, LP_MIXC, LP_WOUT, LP_XQ, LP_XATTN, LP_XO, LP_ROUTE, LP_SORT, LP_GU, LP_DOWN0, LP_DOWN1 };

struct Args { P p; int ph_lo, ph_hi, li, pad; };

#ifndef WT_PROJ
#define WT_PROJ 0
#endif
template <bool HAS_RS> struct EpiBf16 {
    static constexpr bool PERM = true;
    bf16* O; int ldc; const LAS float* rstab;
    __device__ __forceinline__ void operator()(const pg8::f32x4 (&acc)[2][2][4][2], const pg8::Unit& u, int iu, int wr, int wc, int fr, int fq) const {
#pragma unroll
        for (int ai = 0; ai < 2; ++ai)
#pragma unroll
            for (int m = 0; m < 4; ++m) {
                const int lrow = ai * 128 + wr * 64 + m * 16 + fr;
                float sc = 1.f; if (HAS_RS) sc = rstab[iu * 256 + lrow];
                bf16* rowp = O + (size_t)(u.pm * 256 + lrow) * ldc + u.pn * 256 + wc * 32 + 8 * fq;
#pragma unroll
                for (int bj = 0; bj < 2; ++bj) { const pg8::f32x4 v0 = acc[ai][bj][m][0] * sc, v1 = acc[ai][bj][m][1] * sc;
                    pg8::u32x4 w; w.x = pg8::cvt_pk_bf16(v0[0], v0[1]); w.y = pg8::cvt_pk_bf16(v0[2], v0[3]); w.z = pg8::cvt_pk_bf16(v1[0], v1[1]); w.w = pg8::cvt_pk_bf16(v1[2], v1[3]);
                    if (WT_PROJ) st_b128_wt(rowp + bj * 128, w); else st_b128(rowp + bj * 128, w); }
            }
    }
};
__device__ __forceinline__ unsigned pk4_fp8(float a, float b, float c, float d) { int w = __builtin_amdgcn_cvt_pk_fp8_f32(a, b, 0, false); w = __builtin_amdgcn_cvt_pk_fp8_f32(c, d, w, true); return (unsigned)w; }
struct EpiGU {
    static constexpr bool PERM = true;
    unsigned char* U8; const LAS float* rstab; const LAS float* gatetab;
    __device__ __forceinline__ void operator()(const pg8::f32x4 (&acc)[2][2][4][2], const pg8::Unit& u, int iu, int wr, int wc, int fr, int fq) const {
#pragma unroll
        for (int ai = 0; ai < 2; ++ai)
#pragma unroll
            for (int m = 0; m < 4; ++m) {
                const int lrow = ai * 128 + wr * 64 + m * 16 + fr;
                const float sc = rstab[iu * 256 + lrow], gt = 4.f * gatetab[iu * 256 + lrow];
                float o[8];
#pragma unroll
                for (int n = 0; n < 2; ++n)
#pragma unroll
                    for (int j = 0; j < 4; ++j) { const float g = acc[ai][0][m][n][j] * sc, uu = acc[ai][1][m][n][j] * sc; o[n * 4 + j] = gt * g * uu * __builtin_amdgcn_rcpf(1.f + __expf(-g)); }
                pg8::u32x2 w; w.x = pk4_fp8(o[0], o[1], o[2], o[3]); w.y = pk4_fp8(o[4], o[5], o[6], o[7]);
                st_b64(U8 + (size_t)(u.pm * 256 + lrow) * 1024 + (u.pn >> 2) * 512 + (u.pn & 3) * 128 + wc * 32 + 8 * fq, w);
            }
    }
};
template <int MODE, bool W8 = false> struct EpiRes {
    static constexpr bool PERM = true;
    static constexpr bool MOE = MODE != 0;
    bf16* hb; float* ssq; const LAS int* rowtab; float gs; unsigned char* h8;
    static __device__ __forceinline__ void unpack8(const pg8::u32x4& w, float (&f)[8]) {
        f[0] = __builtin_bit_cast(float, w.x << 16); f[1] = __builtin_bit_cast(float, w.x & 0xffff0000u); f[2] = __builtin_bit_cast(float, w.y << 16); f[3] = __builtin_bit_cast(float, w.y & 0xffff0000u);
        f[4] = __builtin_bit_cast(float, w.z << 16); f[5] = __builtin_bit_cast(float, w.z & 0xffff0000u); f[6] = __builtin_bit_cast(float, w.w << 16); f[7] = __builtin_bit_cast(float, w.w & 0xffff0000u); }
    __device__ __forceinline__ void operator()(const pg8::f32x4 (&acc)[2][2][4][2], const pg8::Unit& u, int iu, int wr, int wc, int fr, int fq) const {
#pragma unroll
        for (int ai = 0; ai < 2; ++ai)
#pragma unroll
            for (int m = 0; m < 4; ++m) {
                const int lrow = ai * 128 + wr * 64 + m * 16 + fr;
                int row = u.pm * 256 + lrow; const float g = gs;
                if (MOE) row = rowtab[iu * 256 + lrow];
                const bool ok = !MOE || row >= 0;
                const size_t off = (size_t)(ok ? row : 0) * DM + u.pn * 256 + wc * 32 + 8 * fq;
                float q = 0.f;
                if (ok) {
#pragma unroll
                    for (int bj = 0; bj < 2; ++bj) {
                        float o[8];
#pragma unroll
                        for (int j = 0; j < 4; ++j) { o[j] = acc[ai][bj][m][0][j] * g; o[4 + j] = acc[ai][bj][m][1][j] * g; }
                        float bs[8]; unpack8(*(const pg8::u32x4*)(hb + off + bj * 128), bs);
#pragma unroll
                        for (int j = 0; j < 8; ++j) o[j] += bs[j];
                        pg8::u32x4 w; w.x = pg8::cvt_pk_bf16(o[0], o[1]); w.y = pg8::cvt_pk_bf16(o[2], o[3]); w.z = pg8::cvt_pk_bf16(o[4], o[5]); w.w = pg8::cvt_pk_bf16(o[6], o[7]);
                        float r[8]; unpack8(w, r);
#pragma unroll
                        for (int j = 0; j < 8; ++j) q += r[j] * r[j];
                        st_b128(hb + off + bj * 128, w);
                        if (W8) { pg8::u32x2 w8; w8.x = pk4_fp8(o[0], o[1], o[2], o[3]); w8.y = pk4_fp8(o[4], o[5], o[6], o[7]); st_b64(h8 + off + bj * 128, w8); }
                    }
                }
                q = xadd32(xadd16(q)); if (fq == 0 && ok) ssq[(size_t)row * 16 + u.pn * 4 + wc] = q;
            }
    }
};
template <int MODE> struct MoeOrder {
    static constexpr bool GATHER = MODE == 0, SIGNAL = MODE == 0, WAITS = MODE == 1;
    static constexpr size_t KSTEP_A = 128;
    const char* A; const char* Bt; int K; size_t estride; const LAS int* tile2e; const LAS int* rowtab; unsigned* flags; unsigned* barw; int same;
    int NG, x, w, Tx, r;
    int full4;
    __device__ void init_group(int T, int G, int c) { NG = G >> 5; x = c >> 5; w = c & 31; const int per = 4 * NG, full = T / per, R = T - full * per; full4 = 4 * full;
        Tx = full4 + (R > x ? (R - x + NG - 1) / NG : 0); r = (8 * Tx) & 31; }
    __device__ __forceinline__ int gtile(int tau) const { return tau < full4 ? 4 * NG * (tau >> 2) + 4 * x + (tau & 3) : NG * full4 + (tau - full4) * NG + x; }
    __device__ bool next(int i, pg8::Unit& u) const {
        if (MODE == 0) { const int L = i * 32 + w; if (L >= 8 * Tx) return false; u.pm = gtile(L >> 3); u.pn = L & 7; }
        else { const int L = w >= r ? (i == 0 ? w - r : (32 - r) + (i - 1) * 32 + w) : (32 - r) + i * 32 + w; if (L >= 4 * Tx) return false; u.pm = gtile(L >> 2); u.pn = L & 3; }
        u.e = __builtin_amdgcn_readfirstlane(tile2e[u.pm]); return true;
    }
    __device__ __forceinline__ const char* a_base(const pg8::Unit& u) const { return GATHER ? A : A + (size_t)u.pm * (size_t)512 * K; }
    __device__ __forceinline__ const char* b_base(const pg8::Unit& u) const {
        if (MODE == 0) { const int e = (u.pn < 4 ? u.e >> 8 : u.e >> 16) & 255; return Bt + (size_t)e * estride + (size_t)(u.pn & 3) * (size_t)512 * K; }
        return Bt + (size_t)((u.e >> 8) & 255) * estride + (size_t)u.pn * (size_t)(256 * 512);
    }
    __device__ __forceinline__ long b_delta(const pg8::Unit& u) const { return (long)(((u.e >> 16) & 255) - ((u.e >> 8) & 255)) * (long)estride - 512; }
    __device__ __forceinline__ unsigned a_off(int iu, int h, int R, int Cb) const { return (unsigned)rowtab[iu * 256 + h * 128 + R] * (unsigned)(K * 2) + (unsigned)Cb; }
    __device__ __forceinline__ void signal(int pm, int lane) const {
        if (!same) { asm volatile("s_waitcnt vmcnt(0)" ::: "memory"); __builtin_amdgcn_fence(__ATOMIC_RELEASE, "agent"); asm volatile("s_waitcnt vmcnt(0)" ::: "memory"); }
        if (lane == 0) (void)xb_add(flags + pm * 16, 1u);
    }
    __device__ __forceinline__ void wait(const pg8::Unit& u) const {
        unsigned* f = flags + u.pm * 16;
        XB_SPIN(xb_ld(f) < 64u, barw);
        __builtin_amdgcn_fence(__ATOMIC_ACQUIRE, "agent");
    }
};

__device__ __forceinline__ void router_weights(const P& p, int gtid, int gstride);
__device__ __forceinline__ void tr_item(const float* W, int N, int K, int k0, int n0, const float* gain, float scale, void* dstv, bool f8, LAS float* scr, int lane) {
    const int kr = lane >> 3, c4 = lane & 7;
    f32x4 v[8]; float gv[8];
#pragma unroll
    for (int i = 0; i < 8; ++i) v[i] = __builtin_nontemporal_load((const f32x4*)(W + (size_t)(k0 + 8 * i + kr) * N + n0 + 4 * c4));
#pragma unroll
    for (int i = 0; i < 8; ++i) gv[i] = gain ? gain[k0 + 8 * i + kr] * scale : scale;
#pragma unroll
    for (int i = 0; i < 8; ++i) { const int kk = 8 * i + kr; const float g = gv[i];
        LAS float* d = scr + kk * 33 + 4 * c4; d[0] = v[i].x * g; d[1] = v[i].y * g; d[2] = v[i].z * g; d[3] = v[i].w * g; }
    LDS_WAIT();
    const int c = lane & 7;
#pragma unroll
    for (int j = 0; j < 4; ++j) { const int n = (lane >> 3) + 8 * j; const LAS float* s = scr + (8 * c) * 33 + n;
        const float s0 = s[0 * 33], s1 = s[1 * 33], s2 = s[2 * 33], s3 = s[3 * 33], s4 = s[4 * 33], s5 = s[5 * 33], s6 = s[6 * 33], s7 = s[7 * 33];
        if (f8) { v2u o; o.x = pk4_fp8(s0, s1, s2, s3); o.y = pk4_fp8(s4, s5, s6, s7); st_b64((unsigned char*)dstv + (size_t)n * K + k0 + 8 * c, o); }
        else { v4u o; o.x = pk2(s0, s1); o.y = pk2(s2, s3); o.z = pk2(s4, s5); o.w = pk2(s6, s7); st_b128((bf16*)dstv + (size_t)n * K + k0 + 8 * c, o); } }
    LDS_WAIT();
}
constexpr int IT_LAYER = 15360;
__device__ __forceinline__ void prologue_item(const P& p, int it, LAS float* scr, int lane) {
    const int l = it / IT_LAYER; int r = it % IT_LAYER;
    unsigned char* wl = ws_base(p.ws) + WS_W + (size_t)l * WS_WLAYER;
    const float* W; int N, K, k0, n0; const float* gain = nullptr; float sc = 1.f; void* dst; bool f8 = false;
    if (r < 1536) {
        const int seg = r / 768; r %= 768; const int kb = r / 48, nb = r % 48; const int drow = seg * 1536 + 32 * nb;
        sc = drow < 512 ? 0.125f * LOG2E : ((drow >= C_GQ && drow < C_GK) ? 0.125f : 1.f);
        W = p.w_in + (size_t)l * DM * INW; N = INW; K = DM; k0 = 64 * kb; n0 = (seg ? 1544 : 0) + 32 * nb; gain = p.mix_norm + l * DM; dst = (bf16*)(wl + WO_IN) + (size_t)drow * DM; }
    else if ((r -= 1536) < 512) { const int kb = r / 32, nb = r % 32; W = p.w_out + (size_t)l * DM * DM; N = DM; K = DM; k0 = 64 * kb; n0 = 32 * nb; dst = (bf16*)(wl + WO_OUT) + (size_t)(32 * nb) * DM; }
    else if ((r -= 512) < 256) { const int kb = r / 16, nb = r % 16; W = p.w_xq + (size_t)l * DM * 512; N = 512; K = DM; k0 = 64 * kb; n0 = 32 * nb; gain = p.cross_norm + l * DM; sc = 0.08838834764831845f * LOG2E; dst = (bf16*)(wl + WO_XQ) + (size_t)(32 * nb) * DM; }
    else if ((r -= 256) < 256) { const int kb = r / 32, nb = r % 32; W = p.w_xo + (size_t)l * 512 * DM; N = DM; K = 512; k0 = 64 * kb; n0 = 32 * nb; sc = 32.f; dst = (unsigned char*)(wl + WO_XO) + (size_t)(32 * nb) * 512; f8 = true; }
    else if ((r -= 256) < 512) { const int kv = r / 256; r %= 256; const int kb = r / 16, nb = r % 16;
        W = (kv ? p.w_xv : p.w_xk) + (size_t)l * DM * 512; N = 512; K = DM; k0 = 64 * kb; n0 = 32 * nb; dst = (bf16*)(ws_base(p.ws) + WS_WXKV) + (size_t)(l * 1024 + kv * 512 + 32 * nb) * DM; }
    else if ((r -= 512) < 8192) { const int up = r / 4096; r %= 4096; const int e = r / 256; r %= 256; const int kb = r / 16, nb = r % 16; const int c0 = 32 * nb, drow = (c0 >> 7) * 256 + up * 128 + (c0 & 127);
        W = (up ? p.w_eu : p.w_eg) + ((size_t)l * 16 + e) * DM * 512; N = 512; K = DM; k0 = 64 * kb; n0 = c0; gain = p.moe_norm + l * DM; sc = 32.f; dst = (unsigned char*)(wl + WO_GU) + ((size_t)e * 1024 + drow) * DM; f8 = true; }
    else { r -= 8192; const int e = r / 256; r %= 256; const int kb = r / 32, nb = r % 32;
        W = p.w_ed + ((size_t)l * 16 + e) * 512 * DM; N = DM; K = 512; k0 = 64 * kb; n0 = 32 * nb; sc = 32.f; dst = (unsigned char*)(wl + WO_D) + ((size_t)e * 1024 + 32 * nb) * 512; f8 = true; }
    tr_item(W, N, K, k0, n0, gain, sc, dst, f8, scr, lane);
}
__device__ __forceinline__ bool item_early(int it) { const int l = it / IT_LAYER, r = it % IT_LAYER; return (l == 0 && (r < 2048 || r >= 14336)) || (r >= 2560 && r < 3072); }
constexpr int LDS_CURSOR = LDS_MISC + 64;
__device__ __forceinline__ void conv_items(const P& p, LAS unsigned char* lds, int gw, int mode, int n) {
    int lane = threadIdx.x & 63; asm volatile("" : "+v"(lane));
    const int wave = __builtin_amdgcn_readfirstlane(threadIdx.x >> 6);
    LAS float* scr = (LAS float*)(lds + LDS_STAGE + wave * 16384);
    volatile LAS int* cur = (volatile LAS int*)(lds + LDS_CURSOR);
    constexpr int NK = NLAYER * IT_LAYER / 2048;
    if (mode == 0) {
        prologue_item(p, gw, scr, lane);
        prologue_item(p, gw < 512 ? 2560 + gw : (gw < 1536 ? 14336 + (gw - 512) : IT_LAYER + 2560 + (gw - 1536)), scr, lane);
        return; }
    int k = cur[wave], done = 0;
    while (k < NK && done < n) { const int it = gw + 2048 * k; if (!item_early(it)) { prologue_item(p, it, scr, lane); ++done; } ++k; }
    if (lane == 0) cur[wave] = k;
}
__device__ __forceinline__ void row_to_bf16(const float* src, bf16* dst, float* ssq, const float* gain, int lane, int mode) {
    const f32x4* s = (const f32x4*)src + lane;
    f32x4 v[4]; float q = 0.f;
#pragma unroll
    for (int j = 0; j < 4; ++j) { v[j] = s[64 * j]; q += (v[j].x * v[j].x + v[j].y * v[j].y) + (v[j].z * v[j].z + v[j].w * v[j].w); }
    q = wave_sum(q);
    float sc = 1.f;
    if (mode == 1) sc = rsqrtf(q * (1.0f / DM) + EPS);
    v2u* d = (v2u*)dst + lane; float q2 = 0.f;
#pragma unroll
    for (int j = 0; j < 4; ++j) {
        f32x4 g = (f32x4){1.f, 1.f, 1.f, 1.f}; if (mode == 1) g = ((const f32x4*)gain)[lane + 64 * j];
        v2u o; o.x = pk2(v[j].x * sc * g.x, v[j].y * sc * g.y); o.y = pk2(v[j].z * sc * g.z, v[j].w * sc * g.w); st_b64(d + 64 * j, o);
        const float r0 = __builtin_bit_cast(float, o.x << 16), r1 = __builtin_bit_cast(float, o.x & 0xffff0000u), r2 = __builtin_bit_cast(float, o.y << 16), r3 = __builtin_bit_cast(float, o.y & 0xffff0000u);
        q2 += (r0 * r0 + r1 * r1) + (r2 * r2 + r3 * r3); }
    if (mode == 0) { q2 = wave_sum(q2); if (lane < 16) ssq[lane] = lane == 0 ? q2 : 0.f; }
}
__device__ __forceinline__ void prologue(const P& p, LAS unsigned char* lds, int vcu, int G, int wave, int lane) {
    asm volatile("" : "+v"(lane));
    if (vcu == 0 && wave == 0) WSP(int, WS_MOE + MO_GCNT)[lane] = 0;
    if (vcu == 1 % G) { unsigned* pf = (unsigned*)(ws_base(p.ws) + WS_CTL) + CW_PF; for (int i = wave * 64 + lane; i < PF_WORDS + GF_WORDS + MF_WORDS + 16; i += NTHR) pf[i] = 0u; }
    LAS float* scr = (LAS float*)(lds + LDS_STAGE + wave * 16384);
    const int gw = vcu * NWAVES + wave, NGW = G * NWAVES;
    conv_items(p, lds, gw, 0, 0);
    for (int idx = gw * 64 + lane; idx < NLAYER * 2 * 32768; idx += NGW * 64) {
        const int l = idx / 65536, r = idx % 65536, which = r / 32768, e = r % 32768, row = e & 31, k = e >> 5;
        unsigned char* wl = ws_base(p.ws) + WS_W + (size_t)l * WS_WLAYER;
        if (which == 0) {
            float v = 0.f;
            if (row < 8) v = p.w_in[((size_t)l * DM + k) * INW + 1536 + row]; else if (row < 24) v = p.w_in[((size_t)l * DM + k) * INW + 3080 + (row - 8)];
            ((bf16*)(wl + WO_SM))[row * 1024 + k] = (bf16)f2bf(v * p.mix_norm[l * DM + k]);
        }
    }
    router_weights(p, gw * 64 + lane, NGW * 64);
    for (int m = gw; m < 4096; m += NGW) row_to_bf16(p.mem + (size_t)m * DM, WSP(bf16, WS_MEMN) + (size_t)m * DM, nullptr, p.mem_norm, lane, 1);
    { bf16* hbp = WSP(bf16, WS_HB); float* sqp = WSP(float, WS_SSQ);
      for (int m0 = gw * 4; m0 < NTOK; m0 += NGW * 4) {
        f32x4 v[4][4];
#pragma unroll
        for (int r = 0; r < 4; ++r)
#pragma unroll
            for (int j = 0; j < 4; ++j) v[r][j] = __builtin_nontemporal_load((const f32x4*)(p.x + (size_t)(m0 + r) * DM) + lane + 64 * j);
#pragma unroll
        for (int r = 0; r < 4; ++r) { float q2 = 0.f; v2u* d = (v2u*)(hbp + (size_t)(m0 + r) * DM) + lane;
#pragma unroll
            for (int j = 0; j < 4; ++j) { v2u o; o.x = pk2(v[r][j].x, v[r][j].y); o.y = pk2(v[r][j].z, v[r][j].w); st_b64(d + 64 * j, o);
                const float r0 = __builtin_bit_cast(float, o.x << 16), r1 = __builtin_bit_cast(float, o.x & 0xffff0000u), r2 = __builtin_bit_cast(float, o.y << 16), r3 = __builtin_bit_cast(float, o.y & 0xffff0000u);
                q2 += (r0 * r0 + r1 * r1) + (r2 * r2 + r3 * r3); }
            q2 = wave_sum(q2); if (lane < 16) sqp[(size_t)(m0 + r) * 16 + lane] = lane == 0 ? q2 : 0.f; }
      } }
}
__device__ __forceinline__ void small_proj(const P& p, int l, LAS unsigned char* lds, int vcu, int G, int wave, int lane) {
    asm volatile("" : "+v"(lane));
    const bf16* wsm = (const bf16*)(ws_base(p.ws) + WS_W + (size_t)l * WS_WLAYER + WO_SM);
    const bf16* hb = WSP(bf16, WS_HB); const float* ssq = WSP(float, WS_SSQ); float* sm = WSP(float, WS_SM);
    constexpr int BST = 2048 + 16;
    { const int tid = wave * 64 + lane;
#pragma unroll
      for (int i = 0; i < 8; ++i) { const int idx = tid + NTHR * i, row = idx >> 7, c = idx & 127; *(LAS v4u*)(lds + row * BST + c * 16) = *(const v4u*)(wsm + row * 1024 + c * 8); } }
    __syncthreads();
    const int r = lane & 15, kq = lane >> 4;
    for (int blk = vcu * NWAVES + wave; blk < NTOK / 16; blk += G * NWAVES) {
        const int tok0 = blk * 16;
        const bf16x8* ap = (const bf16x8*)(hb + (size_t)(tok0 + r) * DM + kq * 32);
        pg8::f32x4 acc0 = {0.f, 0.f, 0.f, 0.f}, acc1 = {0.f, 0.f, 0.f, 0.f};
#pragma unroll
        for (int half = 0; half < 2; ++half) {
            bf16x8 af[16];
#pragma unroll
            for (int i = 0; i < 16; ++i) af[i] = ap[(half * 4 + (i >> 2)) * 16 + (i & 3)];
#pragma unroll
            for (int i = 0; i < 16; ++i) { const int s_ = half * 4 + (i >> 2), j = i & 3;
                const bf16x8 b0 = *(const LAS bf16x8*)(lds + r * BST + (128 * s_ + 32 * kq + 8 * j) * 2);
                const bf16x8 b1 = *(const LAS bf16x8*)(lds + (16 + r) * BST + (128 * s_ + 32 * kq + 8 * j) * 2);
                acc0 = __builtin_amdgcn_mfma_f32_16x16x32_bf16(af[i], b0, acc0, 0, 0, 0);
                acc1 = __builtin_amdgcn_mfma_f32_16x16x32_bf16(af[i], b1, acc1, 0, 0, 0);
                if ((i & 3) == 3) __builtin_amdgcn_sched_barrier(0); }
        }
        const float rsv = row_rs(ssq, tok0 + r);
#pragma unroll
        for (int g = 0; g < 4; ++g) { const int trow = 4 * kq + g; const float rs = __shfl(rsv, trow);
            sm[(size_t)(tok0 + trow) * 32 + r] = acc0[g] * rs; if (r < 8) sm[(size_t)(tok0 + trow) * 32 + 16 + r] = acc1[g] * rs; }
    }
    __syncthreads();
}
typedef short v4i16_t __attribute__((ext_vector_type(4)));
typedef __bf16 bf16x2_t __attribute__((ext_vector_type(2)));
typedef float f32x2_t __attribute__((ext_vector_type(2)));
__device__ __forceinline__ unsigned cvtpk(float lo, float hi) { f32x2_t v = {lo, hi}; bf16x2_t b = __builtin_convertvector(v, bf16x2_t); return __builtin_bit_cast(unsigned, b); }
__device__ __forceinline__ bf16x8 pack8(const f32x16& p, int o) {
    v4u w; w.x = cvtpk(p[o], p[o + 1]); w.y = cvtpk(p[o + 2], p[o + 3]); w.z = cvtpk(p[o + 4], p[o + 5]); w.w = cvtpk(p[o + 6], p[o + 7]);
    return __builtin_bit_cast(bf16x8, w);
}
__device__ __forceinline__ float max3f(float a, float b, float c) { float r; asm("v_max3_f32 %0, %1, %2, %3" : "=v"(r) : "v"(a), "v"(b), "v"(c)); return r; }
__device__ __forceinline__ float wave_min_dpp(float v) {
#define DPP_ROR(x, n) __builtin_bit_cast(float, __builtin_amdgcn_update_dpp(__builtin_bit_cast(int, x), __builtin_bit_cast(int, x), 0x120 + (n), 0xf, 0xf, false))
    v = fminf(v, DPP_ROR(v, 1)); v = fminf(v, DPP_ROR(v, 2)); v = fminf(v, DPP_ROR(v, 4)); v = fminf(v, DPP_ROR(v, 8));
#undef DPP_ROR
    const int iv = __builtin_bit_cast(int, v);
    const float r0 = __builtin_bit_cast(float, __builtin_amdgcn_readlane(iv, 0)), r1 = __builtin_bit_cast(float, __builtin_amdgcn_readlane(iv, 16)), r2 = __builtin_bit_cast(float, __builtin_amdgcn_readlane(iv, 32)), r3 = __builtin_bit_cast(float, __builtin_amdgcn_readlane(iv, 48));
    return fminf(fminf(r0, r1), fminf(r2, r3));
}
template <int D, bool FOX, bool OUT8 = false>
__device__ __forceinline__ void attn_unit(LAS unsigned char* lds, const bf16* Qg, int qpitch, const bf16* Kg, const bf16* Vg, int kvpitch, int NT,
                                          const float* cb, int q0, bf16* Og, int opitch, const float* gain, const float* kn) {
    constexpr int KS = D * 2 + 16, VS = D * 2 + 64;
    constexpr int KT = 2, KEYS = 64 * KT;
    constexpr int KBYTES = KEYS * KS, VBYTES = KEYS * VS;
    constexpr int CPR = D / 8, NCH = KEYS * CPR / NTHR, NS = D / 16, NDB = D / 32;
    constexpr int OFF_K = 0, OFF_V = 2 * KBYTES, OFF_CB = 2 * KBYTES + 2 * VBYTES, OFF_FX = OFF_CB + 2 * KEYS * 4;
    int tid = threadIdx.x; asm volatile("" : "+v"(tid));
    const int lane = tid & 63, wave = __builtin_amdgcn_readfirstlane(tid >> 6), r32 = lane & 31, hh = lane >> 5;
    bf16x8 qf[NS];
    { const bf16* qrow = Qg + (size_t)(wave * 32 + r32) * qpitch;
#pragma unroll
      for (int s = 0; s < NS; ++s) qf[s] = *(const bf16x8*)(qrow + 16 * s + 8 * hh); }
    v4u kreg[NCH], vreg[NCH]; f32x4 cbreg = {0.f, 0.f, 0.f, 0.f};
#define AT_GLOAD(t) do { _Pragma("unroll") for (int i_ = 0; i_ < NCH; ++i_) { const int idx_ = tid + NTHR * i_, key_ = idx_ / CPR, c_ = idx_ % CPR; \
        kreg[i_] = *(const v4u*)(Kg + (size_t)((t) * KEYS + key_) * kvpitch + c_ * 8); vreg[i_] = *(const v4u*)(Vg + (size_t)((t) * KEYS + key_) * kvpitch + c_ * 8); } \
        if (FOX && tid < KEYS / 4) cbreg = *(const f32x4*)(cb + (t) * KEYS + tid * 4); } while (0)
#define AT_LSTORE(b) do { _Pragma("unroll") for (int i_ = 0; i_ < NCH; ++i_) { const int idx_ = tid + NTHR * i_, key_ = idx_ / CPR, c_ = idx_ % CPR; \
        *(LAS v4u*)(lds + OFF_K + (b) * KBYTES + key_ * KS + c_ * 16) = kreg[i_]; *(LAS v4u*)(lds + OFF_V + (b) * VBYTES + key_ * VS + c_ * 16) = vreg[i_]; } \
        if (FOX && tid < KEYS / 4) *(LAS f32x4*)(lds + OFF_CB + (b) * (KEYS * 4) + tid * 16) = cbreg; } while (0)
    float m = -INFINITY, l = 0.f;
    f32x16 osum = f32x16{};
    f32x16 o[NDB];
#pragma unroll
    for (int d = 0; d < NDB; ++d) o[d] = f32x16{};
    const int qlo = q0 + wave * 32, qabs = qlo + r32;
    float knpre = 0.f, qkmax = 0.f;
    LAS float* fx = (LAS float*)(lds + OFF_FX);
    const int NTG = NT / KT;
    const int t_first = FOX ? NTG - 1 : 0;
    AT_GLOAD(t_first);
    __syncthreads();
    if (FOX) {
        float qn2 = 0.f;
#pragma unroll
        for (int s = 0; s < NS; ++s)
#pragma unroll
            for (int e = 0; e < 8; ++e) { const float v = __builtin_bit_cast(float, ((unsigned)(unsigned short)qf[s][e]) << 16); qn2 += v * v; }
        qn2 += __shfl_xor(qn2, 32);
        qn2 = wave_max(qn2);
        if (lane == 0) fx[wave] = qn2;
        knpre = lane < 32 ? kn[lane] : 0.f;
#pragma unroll
        for (int o_ = 1; o_ < 32; o_ <<= 1) { const float t_ = __shfl_up(knpre, o_); if (lane >= o_) knpre = fmaxf(knpre, t_); }
    }
    AT_LSTORE(0);
    __syncthreads();
    if (FOX) { float q2 = fx[0];
#pragma unroll
        for (int w_ = 1; w_ < 8; ++w_) q2 = fmaxf(q2, fx[w_]);
        qkmax = sqrtf(q2); }
#pragma unroll 1
    for (int it = 0; it < NTG; ++it) {
        const int b = it & 1;
        const int tg = FOX ? NTG - 1 - it : it;
        const int tn = FOX ? tg - 1 : tg + 1;
        if (it + 1 < NTG) AT_GLOAD(tn);
#pragma unroll
        for (int sub_ = 0; sub_ < KT; ++sub_) {
        const int sub = FOX ? KT - 1 - sub_ : sub_, koff = sub * 64;
        const int kt0 = (tg * KT + sub) * 64;
        if (!FOX || kt0 <= qlo + 31) {
            f32x16 p[2];
            bf16x8 kfa[2][NS];
            if (D == 64) {
#pragma unroll
                for (int kb = 0; kb < 2; ++kb) { const LAS unsigned char* kp = lds + OFF_K + b * KBYTES + (koff + kb * 32 + r32) * KS + hh * 16;
#pragma unroll
                    for (int s = 0; s < NS; ++s) kfa[kb][s] = *(const LAS bf16x8*)(kp + s * 32); }
            }
#pragma unroll
            for (int kb = 0; kb < 2; ++kb) {
                if (FOX) {
#pragma unroll
                    for (int g = 0; g < 4; ++g) { const f32x4 c4 = *(const LAS f32x4*)(lds + OFF_CB + b * (KEYS * 4) + (koff + kb * 32 + 8 * g + 4 * hh) * 4); p[kb][4 * g] = c4.x; p[kb][4 * g + 1] = c4.y; p[kb][4 * g + 2] = c4.z; p[kb][4 * g + 3] = c4.w; }
                } else p[kb] = f32x16{};
                const LAS unsigned char* kp = lds + OFF_K + b * KBYTES + (koff + kb * 32 + r32) * KS + hh * 16;
#pragma unroll
                for (int s = 0; s < NS; ++s) { const bf16x8 kf = D == 64 ? kfa[kb][s] : *(const LAS bf16x8*)(kp + s * 32); p[kb] = __builtin_amdgcn_mfma_f32_32x32x16_bf16(kf, qf[s], p[kb], 0, 0, 0); }
                if (D == 64 && kb == 0) __builtin_amdgcn_sched_barrier(0);
            }
            if (FOX && kt0 + 63 > qlo) {
#pragma unroll
                for (int kb = 0; kb < 2; ++kb)
#pragma unroll
                    for (int r = 0; r < 16; ++r) { const int key = kt0 + kb * 32 + (r & 3) + 8 * (r >> 2) + 4 * hh; if (key > qabs) p[kb][r] = -INFINITY; }
            }
            float mt = fmaxf(p[1][0], p[0][0]);
#pragma unroll
            for (int r = 1; r < 15; ++r) mt = max3f(mt, p[0][r], p[1][r]);
            mt = fmaxf(fmaxf(mt, p[0][15]), p[1][15]);
            mt = xmax32(mt);
            const float mnew = fmaxf(m, mt);
            float ls = 0.f;
#pragma unroll
            for (int kb = 0; kb < 2; ++kb)
#pragma unroll
                for (int r = 0; r < 16; ++r) { const float e = __builtin_amdgcn_exp2f(p[kb][r] - mnew); p[kb][r] = e; if (!FOX) ls += e; }
            if (!FOX || __builtin_amdgcn_ballot_w64(mnew > m) != 0ull) {
                const float alpha = __builtin_amdgcn_exp2f(m - mnew);
                l *= alpha; if (FOX) osum[0] *= alpha;
#pragma unroll
                for (int d = 0; d < NDB; ++d)
#pragma unroll
                    for (int r = 0; r < 16; ++r) o[d][r] *= alpha;
            }
            m = mnew; l += ls;
            bf16x8 pa[2][2];
#pragma unroll
            for (int kb = 0; kb < 2; ++kb) { pa[kb][0] = pack8(p[kb], 0); pa[kb][1] = pack8(p[kb], 8); }
            const LAS unsigned char* vp = lds + OFF_V + b * VBYTES + (koff + 4 * hh + ((lane & 15) >> 2)) * VS + (16 * ((lane >> 4) & 1) + 4 * (lane & 3)) * 2;
#pragma unroll
            for (int d = 0; d < NDB; ++d) {
#pragma unroll
                for (int kb = 0; kb < 2; ++kb)
#pragma unroll
                    for (int ks = 0; ks < 2; ++ks) {
                        const LAS unsigned char* a0 = vp + (kb * 32 + 16 * ks) * VS + d * 64;
                        const v4i16_t lo = __builtin_amdgcn_ds_read_tr16_b64_v4i16((LAS v4i16_t*)a0);
                        const v4i16_t hi = __builtin_amdgcn_ds_read_tr16_b64_v4i16((LAS v4i16_t*)(a0 + 8 * VS));
                        const bf16x8 vf = (bf16x8){lo[0], lo[1], lo[2], lo[3], hi[0], hi[1], hi[2], hi[3]};
                        o[d] = __builtin_amdgcn_mfma_f32_32x32x16_bf16(vf, pa[kb][ks], o[d], 0, 0, 0);
                    }
            }
            if (FOX) {
                const bf16x8 ones = __builtin_bit_cast(bf16x8, (v4u){0x3F803F80u, 0x3F803F80u, 0x3F803F80u, 0x3F803F80u});
#pragma unroll
                for (int kb = 0; kb < 2; ++kb)
#pragma unroll
                    for (int ks = 0; ks < 2; ++ks) osum = __builtin_amdgcn_mfma_f32_32x32x16_bf16(ones, pa[kb][ks], osum, 0, 0, 0);
            }
        }
        }
        if (FOX) { const float mm = wave_min_dpp(m); if (lane == 0) fx[8 + b * 8 + wave] = mm; }
        if (it + 1 < NTG) AT_LSTORE(b ^ 1);
        __syncthreads();
        if (FOX && tg > 0) {
            float M0 = fx[8 + b * 8];
#pragma unroll
            for (int w_ = 1; w_ < 8; ++w_) M0 = fminf(M0, fx[8 + b * 8 + w_]);
            const float cbl = *(const LAS float*)(lds + OFF_CB + (b ^ 1) * (KEYS * 4) + (KEYS - 1) * 4);
            const float knb = __builtin_bit_cast(float, __builtin_amdgcn_readlane(__builtin_bit_cast(int, knpre), tg * KT - 1));
            if (qkmax * knb + cbl < M0 - 40.f) break;
        }
    }
#undef AT_GLOAD
#undef AT_LSTORE
    if (FOX) l = osum[0]; else l = xadd32(l);
    const float inv = 1.0f / l;
    float rs = inv;
    if (FOX) {
        float ss = 0.f;
#pragma unroll
        for (int d = 0; d < NDB; ++d)
#pragma unroll
            for (int r = 0; r < 16; ++r) { const float v = o[d][r] * inv; ss += v * v; }
        ss = xadd32(ss);
        rs = inv * rsqrtf(ss * (1.0f / D) + EPS);
    }
    constexpr int SROW = 144;
    LAS unsigned char* stg = lds + OFF_K + wave * (32 * SROW);
#pragma unroll
    for (int d = 0; d < NDB; ++d)
#pragma unroll
        for (int g = 0; g < 4; ++g) {
            if (OUT8) { *(LAS unsigned*)(stg + r32 * SROW + 32 * d + 8 * g + 4 * hh) = pk4_fp8(o[d][4 * g] * rs, o[d][4 * g + 1] * rs, o[d][4 * g + 2] * rs, o[d][4 * g + 3] * rs); }
            else { f32x4 gn = {1.f, 1.f, 1.f, 1.f}; if (FOX) gn = *(const f32x4*)(gain + 32 * d + 8 * g + 4 * hh);
                v2u w; w.x = cvtpk(o[d][4 * g] * rs * gn.x, o[d][4 * g + 1] * rs * gn.y); w.y = cvtpk(o[d][4 * g + 2] * rs * gn.z, o[d][4 * g + 3] * rs * gn.w);
                *(LAS v2u*)(stg + r32 * SROW + (32 * d + 8 * g + 4 * hh) * 2) = w; }
        }
    static_assert((OUT8 ? D : D * 2) == 128, "stage rows are 128 bytes");
    { unsigned char* ob = (unsigned char*)Og; const size_t pitchb = (size_t)opitch * (OUT8 ? 1 : 2);
#pragma unroll
      for (int i = 0; i < 4; ++i) { const int row = i * 8 + (lane >> 3), ch = lane & 7;
          const v4u w = *(const LAS v4u*)(stg + row * SROW + ch * 16);
          st_b128(ob + (size_t)(wave * 32 + row) * pitchb + ch * 16, w); } }
}
__device__ __forceinline__ void fox_phase(const P& p, int l, LAS unsigned char* lds, int vcu, int G) {
    const bf16* proj = WSP(bf16, WS_PROJ); const float* cb = WSP(float, WS_CB); bf16* y = WSP(bf16, WS_Y);
    for (int pu = vcu; pu < 512; pu += G) {
        const int bh = pu >> 2, pr = pu < 256 ? (pu & 3) : 3 - (pu & 3), b = bh >> 3, h = bh & 7;
        for (int half = 0; half < 2; ++half) {
            const int qb = half ? pr : 7 - pr;
            const size_t row0 = (size_t)b * SEQ;
            attn_unit<64, true>(lds, proj + (row0 + qb * 256) * PW + C_FQ + h * 64, PW, proj + row0 * PW + C_FK + h * 64, proj + row0 * PW + C_FV + h * 64, PW, 4 * (qb + 1),
                                cb + ((size_t)b * 8 + h) * SEQ, qb * 256, y + (row0 + qb * 256) * DM + h * 64, DM, p.fox_gain + l * 512 + h * 64, WSP(const float, WS_MOE + MO_KN) + (b * 8 + h) * 32);
        }
    }
}
__device__ __forceinline__ void xattn_phase(const P& p, int l, LAS unsigned char* lds, int vcu, int G, bool dummy) {
    bf16* xq = WSP(bf16, WS_XQ); const bf16* xkv = WSP(bf16, WS_XKV);
    for (int u = vcu; u < 512; u += G) {
        const int b = u >> 5, h = (u >> 3) & 3, qb = u & 7;
        bf16* qp = xq + ((size_t)b * SEQ + qb * 256) * 512 + h * 128;
        const bf16* kp = xkv + (size_t)b * MEML * 2048 + l * 1024 + h * 128;
        attn_unit<128, false, true>(lds, qp, 512, kp, kp + 512, 2048, 4, nullptr, 0, (bf16*)((dummy ? WSP(unsigned char, WS_Y) : WSP(unsigned char, WS_XO8)) + ((size_t)b * SEQ + qb * 256) * 512 + h * 128), 512, nullptr, nullptr);
    }
}

__device__ __forceinline__ void xattn_pair(const P& p, int l, LAS unsigned char* lds, int pm, int pn, bool dummy) {
    const bf16* xq = WSP(bf16, WS_XQ); const bf16* xkv = WSP(bf16, WS_XKV);
    const int b = pm >> 3;
    for (int hh2 = 0; hh2 < 2; ++hh2) {
        const int h = 2 * pn + hh2;
        const bf16* qp = xq + (size_t)pm * 256 * 512 + h * 128;
        const bf16* kp = xkv + (size_t)b * MEML * 2048 + l * 1024 + h * 128;
        attn_unit<128, false, true>(lds, qp, 512, kp, kp + 512, 2048, 4, nullptr, 0, (bf16*)((dummy ? WSP(unsigned char, WS_Y) : WSP(unsigned char, WS_XO8)) + (size_t)pm * 256 * 512 + h * 128), 512, nullptr, nullptr);
    }
}
constexpr size_t WS_GB = WS_END;
constexpr size_t WS_RT2 = WS_GB + 16 * MiB;
constexpr size_t WS_RG2 = WS_GB + 20 * MiB;
constexpr size_t WS_GDEC = WS_GB + 32 * MiB;
constexpr size_t WS_END2 = WS_GDEC + 1 * MiB;
static_assert(WS_END2 <= 512 * MiB, "workspace map 2");
constexpr int GL_B = 0;
constexpr int GL_TOT = 16384;
constexpr int GL_Q1 = 18432, GL_Q2 = GL_Q1 + 64 * 144, GL_K2 = GL_Q2 + 64 * 144;
constexpr int GL_KD = GL_K2 + 64 * 144;
constexpr int GL_V = GL_KD + 64 * 192;
constexpr int GL_SSQ = GL_V + 64 * 320;
constexpr int GL_GA = GL_SSQ + 1024;
constexpr int GL_YST = GL_GA + 4096;
constexpr int GL_GG = GL_YST + 64 * 272;
constexpr int GL_END = GL_GG + 64 * 272;
static_assert(GL_END <= 131072, "gla lds");

__device__ __forceinline__ float fast_log_sigmoid(float z) { return fminf(z, 0.f) - __logf(1.f + __expf(-fabsf(z))); }
__device__ __forceinline__ void gla_load_v(const bf16* proj, size_t tok0, int h, LAS unsigned char* lds, int tid) {
#pragma unroll
    for (int i = 0; i < 2; ++i) { const int idx = tid + NTHR * i, t = idx >> 4, c = idx & 15;
        *(LAS v4u*)(lds + GL_V + t * 320 + c * 16) = *(const v4u*)(proj + (tok0 + t) * PW + C_GV + h * 128 + c * 8); }
}
__device__ __forceinline__ bf16x8 tr_frag(const LAS unsigned char* a0, int rowstride4) {
    const v4i16_t lo = __builtin_amdgcn_ds_read_tr16_b64_v4i16((LAS v4i16_t*)a0);
    const v4i16_t hi = __builtin_amdgcn_ds_read_tr16_b64_v4i16((LAS v4i16_t*)(a0 + rowstride4));
    return (bf16x8){lo[0], lo[1], lo[2], lo[3], hi[0], hi[1], hi[2], hi[3]};
}
constexpr int GA_WAVE = 19456, GA_SROW = 144;
static_assert(8 * GA_WAVE <= LDS_MISC && 128 * GA_SROW <= GA_WAVE, "gla phase A lds");
__device__ __forceinline__ void gla_phase_a(const P& p, int l, LAS unsigned char* lds, int vcu, int G) {
    int tid = threadIdx.x; asm volatile("" : "+v"(tid));
    const int lane = tid & 63, wave = __builtin_amdgcn_readfirstlane(tid >> 6), hh = lane >> 5;
    const bf16* proj = WSP(bf16, WS_PROJ); bf16* loc = ((bf16*)p.out); float* dec = WSP(float, WS_GDEC); const float* sm = WSP(float, WS_SM); _Float16* gb = WSP(_Float16, WS_GB);
    LAS unsigned char* kd = lds + wave * GA_WAVE; LAS unsigned char* vh = kd + 8192;
    const int crow8 = lane >> 3, cch = lane & 7;
    const int trow = (lane & 15) >> 2, tcol = 16 * ((lane >> 4) & 1) + 4 * (lane & 3);
    for (int u = vcu * NWAVES + wave; u < 2048; u += G * NWAVES) {
        const int c = u & 31, h = (u >> 5) & 3, b = u >> 7;
        const size_t tok0 = (size_t)b * SEQ + c * 64;
        v4u kreg[8], v0reg[8], v1reg[8];
#pragma unroll
        for (int i = 0; i < 8; ++i) { const bf16* rp = proj + (tok0 + i * 8 + crow8) * PW;
            kreg[i] = *(const v4u*)(rp + C_GK + h * 64 + cch * 8); v0reg[i] = *(const v4u*)(rp + C_GV + h * 128 + cch * 8); v1reg[i] = *(const v4u*)(rp + C_GV + h * 128 + 64 + cch * 8); }
        float w[16];
#pragma unroll
        for (int r = 0; r < 16; ++r) w[r] = p.w_alpha_up[((size_t)l * 16 + r) * 256 + h * 64 + lane];
        const float bias = p.b_alpha[l * 256 + h * 64 + lane];
        { LAS f32x4* gw = (LAS f32x4*)vh;
#pragma unroll
          for (int i = 0; i < 4; ++i) gw[lane * 4 + i] = *(const f32x4*)(sm + (tok0 + lane) * 32 + 8 + 4 * i); }
        float bt[64]; float run = 0.f;
#pragma unroll
        for (int t = 0; t < 64; ++t) {
            float z = bias;
#pragma unroll
            for (int r4 = 0; r4 < 4; ++r4) { const f32x4 g4 = ((const LAS f32x4*)vh)[t * 4 + r4]; z += g4.x * w[4 * r4] + g4.y * w[4 * r4 + 1] + g4.z * w[4 * r4 + 2] + g4.w * w[4 * r4 + 3]; }
            run += fast_log_sigmoid(z) * (1.0f / 16.0f); bt[t] = run; gb[(tok0 + t) * 256 + h * 64 + lane] = (_Float16)run;
        }
#pragma unroll
        for (int i = 0; i < 8; ++i) { *(LAS v4u*)(kd + (i * 8 + crow8) * 128 + cch * 16) = kreg[i]; *(LAS v4u*)(vh + (i * 8 + crow8) * 128 + cch * 16) = v0reg[i]; }
#pragma unroll
        for (int t = 0; t < 64; ++t) { LAS bf16* kp = (LAS bf16*)(kd + t * 128 + lane * 2); *kp = (bf16)f2bf(bf2f(*kp) * __expf(run - bt[t])); }
        dec[(size_t)u * 64 + lane] = __expf(run);
        f32x16 acc[2][2][2];
#pragma unroll
        for (int half = 0; half < 2; ++half) {
            if (half == 1) {
#pragma unroll
                for (int i = 0; i < 8; ++i) *(LAS v4u*)(vh + (i * 8 + crow8) * 128 + cch * 16) = v1reg[i];
            }
#pragma unroll
            for (int x = 0; x < 2; ++x)
#pragma unroll
                for (int y = 0; y < 2; ++y) acc[half][y][x] = f32x16{};
#pragma unroll
            for (int s = 0; s < 4; ++s) {
                bf16x8 af[2], bfr[2];
#pragma unroll
                for (int x = 0; x < 2; ++x) { af[x] = tr_frag(vh + (16 * s + 8 * hh + trow) * 128 + (32 * x + tcol) * 2, 4 * 128); bfr[x] = tr_frag(kd + (16 * s + 8 * hh + trow) * 128 + (32 * x + tcol) * 2, 4 * 128); }
#pragma unroll
                for (int x = 0; x < 2; ++x)
#pragma unroll
                    for (int y = 0; y < 2; ++y) acc[half][y][x] = __builtin_amdgcn_mfma_f32_32x32x16_bf16(bfr[y], af[x], acc[half][y][x], 0, 0, 0);
            }
        }
#pragma unroll
        for (int half = 0; half < 2; ++half)
#pragma unroll
            for (int x = 0; x < 2; ++x)
#pragma unroll
                for (int y = 0; y < 2; ++y)
#pragma unroll
                    for (int g = 0; g < 4; ++g) { const f32x16& a = acc[half][y][x];
                        v2u w2; w2.x = cvtpk(a[4 * g], a[4 * g + 1]); w2.y = cvtpk(a[4 * g + 2], a[4 * g + 3]);
                        *(LAS v2u*)(kd + (64 * half + 32 * x + (lane & 31)) * GA_SROW + (32 * y + 8 * g + 4 * hh) * 2) = w2; }
#pragma unroll
        for (int i = 0; i < 16; ++i) { const int idx = lane + 64 * i, row = idx >> 3, ch = idx & 7;
            st_b128(loc + (size_t)u * 8192 + row * 64 + ch * 8, *(const LAS v4u*)(kd + row * GA_SROW + ch * 16)); }
    }
}
__device__ __forceinline__ void gla_phase_b(const P& p, int vcu, int G) {
    int tid = threadIdx.x; asm volatile("" : "+v"(tid));
    const bf16* loc = ((const bf16*)p.out); const float* dec = WSP(float, WS_GDEC); bf16* gs = (bf16*)((unsigned char*)p.out + 96 * MiB);
    for (int u = vcu; u < 256; u += G) {
        const int bh = u >> 2, q4 = u & 3;
        const int e = q4 * 2048 + tid * 4, dk = e & 63;
        f32x4 st = {0.f, 0.f, 0.f, 0.f};
#pragma unroll 8
        for (int c = 0; c < 32; ++c) {
            const size_t cu = (size_t)bh * 32 + c;
            const v2u lw = *(const v2u*)(loc + cu * 8192 + e);
            const f32x4 lv = {__builtin_bit_cast(float, lw.x << 16), __builtin_bit_cast(float, lw.x & 0xffff0000u), __builtin_bit_cast(float, lw.y << 16), __builtin_bit_cast(float, lw.y & 0xffff0000u)};
            const f32x4 dv = *(const f32x4*)(dec + cu * 64 + dk);
            v2u w; w.x = pk2(st.x, st.y); w.y = pk2(st.z, st.w);
            *(v2u*)(gs + cu * 8192 + e) = w;
            st = dv * st + lv;
        }
    }
}
__device__ __forceinline__ void gla_phase_c(const P& p, int l, LAS unsigned char* lds, int u0, int ustep, int uend) {
    int tid = threadIdx.x; asm volatile("" : "+v"(tid));
    const int lane = tid & 63, wave = __builtin_amdgcn_readfirstlane(tid >> 6), hh = lane >> 5, r32 = lane & 31;
    const bf16* proj = WSP(bf16, WS_PROJ); const bf16* gs = (const bf16*)((const unsigned char*)p.out + 96 * MiB); bf16* y = WSP(bf16, WS_Y); const _Float16* gb = WSP(const _Float16, WS_GB);
    const int dvb = wave >> 1, tb = wave & 1;
    const int trow = (lane & 15) >> 2, tcol = 16 * ((lane >> 4) & 1) + 4 * (lane & 3);
    bf16 n_q[8], n_k[8]; v4u n_v[2], n_g[2]; bf16x8 n_s[4]; f32x4 n_n[4]; float n_b[8], n_r = 0.f;
#define GC_LOAD(uu) do { const int c_ = (uu) & 31, h_ = ((uu) >> 5) & 3, b_ = (uu) >> 7; const size_t t0_ = (size_t)b_ * SEQ + c_ * 64; \
        _Pragma("unroll") for (int j = 0; j < 8; ++j) { const bf16* rp = proj + (t0_ + wave * 8 + j) * PW + h_ * 64 + lane; n_q[j] = rp[C_GQ]; n_k[j] = rp[C_GK]; } \
        _Pragma("unroll") for (int i = 0; i < 2; ++i) { const int idx = tid + NTHR * i, t = idx >> 4, cc = idx & 15; n_v[i] = *(const v4u*)(proj + (t0_ + t) * PW + C_GV + h_ * 128 + cc * 8); n_g[i] = *(const v4u*)(proj + (t0_ + t) * PW + C_GG + h_ * 128 + cc * 8); } \
        { const bf16* sp = gs + (size_t)(uu) * 8192 + (size_t)(32 * dvb + r32) * 64 + 8 * hh; \
          _Pragma("unroll") for (int s2 = 0; s2 < 4; ++s2) n_s[s2] = *(const bf16x8*)(sp + 16 * s2); } \
        _Pragma("unroll") for (int j = 0; j < 8; ++j) n_b[j] = (float)gb[(t0_ + wave * 8 + j) * 256 + h_ * 64 + lane]; \
        n_r = (float)gb[(t0_ + 31) * 256 + h_ * 64 + lane]; \
        _Pragma("unroll") for (int g = 0; g < 4; ++g) { const int dv = 32 * dvb + 8 * g + 4 * hh; \
            n_n[g] = *(const f32x4*)(p.gla_gain + l * 512 + h_ * 128 + dv); } } while (0)
    if (u0 < uend) GC_LOAD(u0);
    __syncthreads();
    for (int u = u0; u < uend; u += ustep) {
        const int c = u & 31, h = (u >> 5) & 3, b = u >> 7;
        const size_t tok0 = (size_t)b * SEQ + c * 64;
        bf16x8 sfr[4]; f32x4 gnr[4];
#pragma unroll
        for (int i = 0; i < 4; ++i) { sfr[i] = n_s[i]; gnr[i] = n_n[i]; }
#pragma unroll
        for (int i = 0; i < 2; ++i) { const int idx = tid + NTHR * i, t = idx >> 4, cc = idx & 15; *(LAS v4u*)(lds + GL_V + t * 320 + cc * 16) = n_v[i]; *(LAS v4u*)(lds + GL_GG + t * 272 + cc * 16) = n_g[i]; }
        { const float rref = n_r;
#pragma unroll
          for (int j = 0; j < 8; ++j) { const int t = wave * 8 + j; const float bt = n_b[j];
            const float qv = bf2f(n_q[j]), kv = bf2f(n_k[j]);
            *(LAS bf16*)(lds + GL_Q1 + t * 144 + lane * 2) = (bf16)f2bf(qv * __expf(bt));
            *(LAS bf16*)(lds + GL_Q2 + t * 144 + lane * 2) = (bf16)f2bf(qv * __expf(bt - rref));
            *(LAS bf16*)(lds + GL_K2 + t * 144 + lane * 2) = (bf16)f2bf(kv * __expf(rref - bt)); } }
        __syncthreads();
        if (u + ustep < uend) GC_LOAD(u + ustep);
        f32x16 o = {};
        {
#pragma unroll
          for (int s = 0; s < 4; ++s) { const bf16x8 af = sfr[s]; const bf16x8 bq = *(const LAS bf16x8*)(lds + GL_Q1 + (32 * tb + r32) * 144 + (16 * s + 8 * hh) * 2);
              o = __builtin_amdgcn_mfma_f32_32x32x16_bf16(af, bq, o, 0, 0, 0); } }
#pragma unroll
        for (int sb = 0; sb < 2; ++sb) {
            if (sb <= tb) {
                f32x16 pt = {};
#pragma unroll
                for (int s = 0; s < 4; ++s) { const bf16x8 ak = *(const LAS bf16x8*)(lds + GL_K2 + (32 * sb + r32) * 144 + (16 * s + 8 * hh) * 2); const bf16x8 bq = *(const LAS bf16x8*)(lds + GL_Q2 + (32 * tb + r32) * 144 + (16 * s + 8 * hh) * 2);
                    pt = __builtin_amdgcn_mfma_f32_32x32x16_bf16(ak, bq, pt, 0, 0, 0); }
                if (sb == tb) {
#pragma unroll
                    for (int r = 0; r < 16; ++r) { const int s_ = (r & 3) + 8 * (r >> 2) + 4 * hh; if (s_ > r32) pt[r] = 0.f; }
                }
#pragma unroll
                for (int ks = 0; ks < 2; ++ks) {
                    const bf16x8 pa = pack8(pt, 8 * ks);
                    const bf16x8 vf = tr_frag(lds + GL_V + (32 * sb + 16 * ks + 4 * hh + trow) * 320 + (32 * dvb + tcol) * 2, 8 * 320);
                    o = __builtin_amdgcn_mfma_f32_32x32x16_bf16(vf, pa, o, 0, 0, 0);
                }
            }
        }
        float ss = 0.f;
#pragma unroll
        for (int r = 0; r < 16; ++r) ss += o[r] * o[r];
        ss = xadd32(ss);
        LAS float* sq = (LAS float*)(lds + GL_SSQ);
        if (hh == 0) sq[dvb * 64 + 32 * tb + r32] = ss;
        __syncthreads();
        const int t = 32 * tb + r32;
        const float tot = (sq[t] + sq[64 + t]) + (sq[128 + t] + sq[192 + t]);
        const float rs = rsqrtf(tot * (1.0f / 128.0f) + EPS);
#pragma unroll
        for (int g = 0; g < 4; ++g) {
            const int dv = 32 * dvb + 8 * g + 4 * hh;
            const f32x4 gn = gnr[g];
            const v2u gg = *(const LAS v2u*)(lds + GL_GG + t * 272 + dv * 2);
            const float g0 = bf2f((bf16)(gg.x & 0xffff)), g1 = bf2f((bf16)(gg.x >> 16)), g2 = bf2f((bf16)(gg.y & 0xffff)), g3 = bf2f((bf16)(gg.y >> 16));
            const float v0 = o[4 * g] * rs * gn.x * g0 * __builtin_amdgcn_rcpf(1.f + __expf(-g0)), v1 = o[4 * g + 1] * rs * gn.y * g1 * __builtin_amdgcn_rcpf(1.f + __expf(-g1));
            const float v2 = o[4 * g + 2] * rs * gn.z * g2 * __builtin_amdgcn_rcpf(1.f + __expf(-g2)), v3 = o[4 * g + 3] * rs * gn.w * g3 * __builtin_amdgcn_rcpf(1.f + __expf(-g3));
            v2u w; w.x = cvtpk(v0, v1); w.y = cvtpk(v2, v3);
            *(LAS v2u*)(lds + GL_YST + t * 272 + dv * 2) = w;
        }
        __syncthreads();
#pragma unroll
        for (int i = 0; i < 2; ++i) { const int idx = tid + NTHR * i, tr_ = idx >> 4, ch = idx & 15;
            st_b128(y + (tok0 + tr_) * DM + 512 + h * 128 + ch * 8, *(const LAS v4u*)(lds + GL_YST + tr_ * 272 + ch * 16)); }
    }
#undef GC_LOAD
}
__device__ __forceinline__ void fox_cumsum_phase(const P& p, int l, LAS unsigned char* lds, int u0, int ustep, int uend) {
    int tid = threadIdx.x; asm volatile("" : "+v"(tid));
    const int lane = tid & 63, wave = __builtin_amdgcn_readfirstlane(tid >> 6);
    const float* sm = WSP(float, WS_SM); float* cb = WSP(float, WS_CB);
    LAS float* tot = (LAS float*)(lds + 256);
    for (int u = u0; u < uend; u += ustep) {
        const int b = u >> 3, h = u & 7;
        const float bias = p.b_forget[l * 8 + h];
        const int s0 = wave * 256 + lane * 4;
        float v[4]; float run = 0.f;
#pragma unroll
        for (int j = 0; j < 4; ++j) v[j] = sm[((size_t)b * SEQ + s0 + j) * 32 + h];
#pragma unroll
        for (int j = 0; j < 4; ++j) { run += fast_log_sigmoid(v[j] + bias); v[j] = run; }
        float pre = run;
#pragma unroll
        for (int o = 1; o < 64; o <<= 1) { const float t = __shfl_up(pre, o); if (lane >= o) pre += t; }
        __syncthreads();
        if (lane == 63) tot[wave] = pre;
        __syncthreads();
        float base = pre - run;
#pragma unroll
        for (int w_ = 0; w_ < 8; ++w_) { const float t = tot[w_]; if (w_ < wave) base += t; }
        f32x4 o4; o4.x = -(v[0] + base) * LOG2E; o4.y = -(v[1] + base) * LOG2E; o4.z = -(v[2] + base) * LOG2E; o4.w = -(v[3] + base) * LOG2E;
        *(f32x4*)(cb + ((size_t)b * 8 + h) * SEQ + s0) = o4;
    }
}
__device__ __forceinline__ void fox_knorm_phase(const P& p, int t0, int tstep, int tend) {
    int tid = threadIdx.x; asm volatile("" : "+v"(tid));
    const int lane = tid & 63, wave = __builtin_amdgcn_readfirstlane(tid >> 6);
    const bf16* proj = WSP(bf16, WS_PROJ); float* kn = WSP(float, WS_MOE + MO_KN);
    for (int task = t0 + wave; task < tend; task += tstep) {
        const int j = task & 31, h = (task >> 5) & 7, b = task >> 8;
        float mx = 0.f;
#pragma unroll
        for (int i = 0; i < 8; ++i) {
            const v4u w = *(const v4u*)(proj + ((size_t)b * SEQ + j * 64 + i * 8 + (lane >> 3)) * PW + C_FK + h * 64 + (lane & 7) * 8);
            const unsigned ww[4] = {w.x, w.y, w.z, w.w}; float ss = 0.f;
#pragma unroll
            for (int e = 0; e < 4; ++e) { const float a = __builtin_bit_cast(float, ww[e] << 16), c = __builtin_bit_cast(float, ww[e] & 0xffff0000u); ss += a * a + c * c; }
            ss += __shfl_xor(ss, 1); ss += __shfl_xor(ss, 2); ss += __shfl_xor(ss, 4);
            mx = fmaxf(mx, ss);
        }
        mx = wave_max(mx);
        if (lane == 0) kn[task] = sqrtf(mx) * 1.0001f;
    }
}
__device__ __forceinline__ void router_weights(const P& p, int gtid, int gstride) {
    for (int idx = gtid; idx < NLAYER * 32768; idx += gstride) {
        const int l = idx >> 15, r = idx & 32767, k = r >> 5, n = r & 31;
        float v = 0.f;
        if (n < 16) v = p.w_re[((size_t)l * DM + k) * 16 + n]; else if (n < 20) v = p.w_rg[((size_t)l * DM + k) * 4 + (n - 16)];
        v *= p.moe_norm[l * DM + k];
        bf16* wr = (bf16*)(ws_base(p.ws) + WS_W + (size_t)l * WS_WLAYER + WO_RHI);
        const unsigned hi = f2bf(v); const float rem = v - bf2f((bf16)hi);
        const size_t o = ((size_t)n * 128 + ((k >> 3) ^ (n & 15))) * 8 + (k & 7);
        wr[o] = (bf16)hi; wr[32 * 1024 + o] = (bf16)f2bf(rem);
    }
}
__device__ __forceinline__ void route_phase(const P& p, int l, LAS unsigned char* lds, int t0, int tstep) {
    int tid = threadIdx.x; asm volatile("" : "+v"(tid));
    const int lane = tid & 63, wave = __builtin_amdgcn_readfirstlane(tid >> 6);
    { const v4u* src = (const v4u*)(ws_base(p.ws) + WS_W + (size_t)l * WS_WLAYER + WO_RHI);
#pragma unroll 4
      for (int i = 0; i < 16; ++i) *(LAS v4u*)(lds + LDS_STAGE + (tid + NTHR * i) * 16) = src[tid + NTHR * i]; }
    LAS int* hist = (LAS int*)(lds + LDS_GATE);
    LAS int* tokj = hist + 32; LAS f32x2_t* tokgl = (LAS f32x2_t*)(hist + 160); LAS int* basej = hist + 416;
    const bf16* HBp = WSP(const bf16, WS_HB);
    int* gcnt = WSP(int, WS_MOE + MO_GCNT) + l * 32; int* rowtok2 = WSP(int, WS_RT2); f32x2_t* rowg2 = WSP(f32x2_t, WS_RG2);
    LAS float* lgb = (LAS float*)(lds + LDS_RS + wave * 2048);
    const int r = lane & 15, kq = lane >> 4;
    for (int task0 = t0; task0 < NTOK / 16; task0 += tstep) {
        if (tid < 32) hist[tid] = 0;
        __syncthreads();
        const int tok0 = (task0 + wave) * 16;
        const v4u* hp = (const v4u*)(HBp + (size_t)(tok0 + r) * DM + 8 * kq);
        f32x4 acc0 = {0.f, 0.f, 0.f, 0.f}, acc1 = {0.f, 0.f, 0.f, 0.f}; float q = 0.f;
#pragma unroll 8
        for (int s = 0; s < 32; ++s) {
            const v4u aw = hp[4 * s];
            const unsigned ww[4] = {aw.x, aw.y, aw.z, aw.w};
#pragma unroll
            for (int e = 0; e < 4; ++e) { const float a0 = __builtin_bit_cast(float, ww[e] << 16), a1 = __builtin_bit_cast(float, ww[e] & 0xffff0000u); q += a0 * a0 + a1 * a1; }
            const bf16x8 af = __builtin_bit_cast(bf16x8, aw);
            const LAS unsigned char* bp = lds + LDS_STAGE + (r * 128 + ((4 * s + kq) ^ r)) * 16;
            const bf16x8 bh0 = *(const LAS bf16x8*)(bp), bh1 = *(const LAS bf16x8*)(bp + 16 * 2048), bl0 = *(const LAS bf16x8*)(bp + 32 * 2048), bl1 = *(const LAS bf16x8*)(bp + 48 * 2048);
            acc0 = __builtin_amdgcn_mfma_f32_16x16x32_bf16(af, bh0, acc0, 0, 0, 0); acc1 = __builtin_amdgcn_mfma_f32_16x16x32_bf16(af, bh1, acc1, 0, 0, 0);
            acc0 = __builtin_amdgcn_mfma_f32_16x16x32_bf16(af, bl0, acc0, 0, 0, 0); acc1 = __builtin_amdgcn_mfma_f32_16x16x32_bf16(af, bl1, acc1, 0, 0, 0);
        }
        q = xadd32(xadd16(q));
        const float rsv = rsqrtf(q * (1.0f / DM) + EPS);
        const float bias0 = p.b_re[l * 16 + r], bias1 = r < 4 ? p.b_rg[l * 4 + r] : 0.f;
#pragma unroll
        for (int g = 0; g < 4; ++g) { const int row = 4 * kq + g; const float rs = __shfl(rsv, row);
            lgb[row * 32 + r] = acc0[g] * rs + bias0; lgb[row * 32 + 16 + r] = acc1[g] * rs + bias1; }
        LDS_WAIT();
        if (lane < 16) {
            const int tok = tok0 + lane;
            const LAS f32x4* lr = (const LAS f32x4*)(lgb + lane * 32);
            const f32x4 e0 = lr[0], e1 = lr[1], e2 = lr[2], e3 = lr[3], gl = lr[4];
            int g = 0; float gm = gl.x;
            if (gl.y > gm) { gm = gl.y; g = 1; } if (gl.z > gm) { gm = gl.z; g = 2; } if (gl.w > gm) { gm = gl.w; g = 3; }
            const float den = (expf(gl.x - gm) + expf(gl.y - gm)) + (expf(gl.z - gm) + expf(gl.w - gm));
            const float pg = 1.0f / den;
            const f32x4 el = g == 0 ? e0 : (g == 1 ? e1 : (g == 2 ? e2 : e3));
            int i0 = 0; float m0 = el.x;
            if (el.y > m0) { m0 = el.y; i0 = 1; } if (el.z > m0) { m0 = el.z; i0 = 2; } if (el.w > m0) { m0 = el.w; i0 = 3; }
            int i1 = -1; float m1 = -INFINITY;
            if (i0 != 0 && el.x > m1) { m1 = el.x; i1 = 0; } if (i0 != 1 && el.y > m1) { m1 = el.y; i1 = 1; }
            if (i0 != 2 && el.z > m1) { m1 = el.z; i1 = 2; } if (i0 != 3 && el.w > m1) { m1 = el.w; i1 = 3; }
            const float ex = expf(m1 - m0), inv = 1.0f / (1.0f + ex);
            const int elo = i0 < i1 ? i0 : i1, ehi = i0 < i1 ? i1 : i0;
            const int j = g * 8 + (elo == 0 ? ehi - 1 : (elo == 1 ? ehi + 1 : 5));
            const float g0 = pg * inv, g1 = pg * ex * inv;
            tokj[wave * 16 + lane] = j; tokgl[wave * 16 + lane] = i0 < i1 ? (f32x2_t){g0, g1} : (f32x2_t){g1, g0};
            atomicAdd((int*)&hist[j], 1);
        }
        __syncthreads();
        if (tid < 32) { const int n = hist[tid]; basej[tid] = n > 0 ? atomicAdd(&gcnt[tid], n) : 0; }
        __syncthreads();
        if (wave == 0) {
            int run[32];
#pragma unroll
            for (int x = 0; x < 32; ++x) run[x] = 0;
#pragma unroll 1
            for (int half = 0; half < 2; ++half) {
                const int t = half * 64 + lane, j = tokj[t];
                int rank = 0;
#pragma unroll
                for (int x = 0; x < 32; ++x) { if ((x & 7) >= 6) continue; const unsigned long long mk = __ballot(j == x); if (j == x) rank = run[x] + __popcll(mk & ((1ull << lane) - 1ull)); run[x] += __popcll(mk); }
                const int pos = basej[j] + rank;
                rowtok2[(size_t)j * BCAP + pos] = task0 * 16 + t; rowg2[(size_t)j * BCAP + pos] = tokgl[t];
            }
        }
    }
}
__device__ __forceinline__ int moe_tables(const P& p, int l, LAS unsigned char* lds) {
    int tid = threadIdx.x; asm volatile("" : "+v"(tid));
    LAS int* mt = (LAS int*)(lds + LDS_MOET);
    const int* gcnt = WSP(const int, WS_MOE + MO_GCNT) + l * 32;
    if (tid < 32) mt[tid] = gcnt[tid];
    __syncthreads();
    if (tid == 0) { int t = 0; for (int j = 0; j < 32; ++j) { mt[32 + j] = t; t += (mt[j] + 255) >> 8; } mt[64] = t; }
    __syncthreads();
    if (tid < MAXTILES) { int j = 0;
        for (int x = 1; x < 32; ++x) if (mt[32 + x] <= tid) j = x;
        const int g = j >> 3, pi = j & 7, elo = pi < 3 ? 0 : (pi < 5 ? 1 : 2), ehi = pi < 3 ? pi + 1 : (pi < 5 ? pi - 1 : 3);
        mt[96 + tid] = j | ((g * 4 + elo) << 8) | ((g * 4 + ehi) << 16); }
    __syncthreads();
    return __builtin_amdgcn_readfirstlane(mt[64]);
}
__device__ __forceinline__ void final_phase(const P& p, int vcu, int G) {
    int tid = threadIdx.x; asm volatile("" : "+v"(tid));
    const int lane = tid & 63, wave = __builtin_amdgcn_readfirstlane(tid >> 6);
    const float* ssq = WSP(const float, WS_SSQ); const bf16* hb = WSP(const bf16, WS_HB);
    f32x4 g[4];
#pragma unroll
    for (int j = 0; j < 4; ++j) g[j] = ((const f32x4*)p.final_norm)[lane + 64 * j];
    for (int m0 = (vcu * NWAVES + wave) * 4; m0 < NTOK; m0 += G * NWAVES * 4) {
        v2u w[4][4]; float rs[4];
#pragma unroll
        for (int r = 0; r < 4; ++r) { rs[r] = row_rs(ssq, m0 + r);
#pragma unroll
            for (int j = 0; j < 4; ++j) w[r][j] = ((const v2u*)(hb + (size_t)(m0 + r) * DM))[lane + 64 * j]; }
#pragma unroll
        for (int r = 0; r < 4; ++r) { f32x4* s = (f32x4*)(p.out + (size_t)(m0 + r) * DM) + lane;
#pragma unroll
            for (int j = 0; j < 4; ++j) { f32x4 v; v.x = __builtin_bit_cast(float, w[r][j].x << 16); v.y = __builtin_bit_cast(float, w[r][j].x & 0xffff0000u); v.z = __builtin_bit_cast(float, w[r][j].y << 16); v.w = __builtin_bit_cast(float, w[r][j].y & 0xffff0000u);
                s[64 * j] = v * rs[r] * g[j]; } }
    }
}
#ifndef ENMASK
#define ENMASK 0xffffffffu
#endif
#define EN(b) (((ENMASK) >> (b)) & 1u)
#ifndef REPMASK
#define REPMASK 0u
#endif
#define REPN(b) ((((REPMASK) >> (b)) & 1u) ? 2 : 1)
__device__ __attribute__((noinline)) void grid_barrier(unsigned* barw, unsigned x, volatile LAS unsigned* st) { XcdBarrier b; b.bar = barw; b.x = x; b.st = st; xcd_barrier(b); }
__device__ __attribute__((noinline)) void grid_arrive(unsigned* bar, unsigned x, volatile LAS unsigned* st) {
    asm volatile("s_waitcnt vmcnt(0)" ::: "memory");
    __syncthreads();
    if (threadIdx.x == 0) {
        __builtin_amdgcn_s_waitcnt(0);
        unsigned nloc = st[0], nx = st[1];
        if (nloc == 0u) { xcd_barrier_complete(bar, x, nloc, nx); st[0] = nloc; st[1] = nx; }
        const unsigned old = xb_add(&bar[XB_XSUB(x)], 1u);
        const unsigned gen = old / nloc;
        unsigned role = 0u;
        if (old + 1u == (gen + 1u) * nloc) {
            __builtin_amdgcn_fence(__ATOMIC_RELEASE, "agent");
            asm volatile("s_waitcnt vmcnt(0)" ::: "memory");
            const unsigned og = xb_add(&bar[XB_TOP], 1u);
            const unsigned tg = og / nx;
            if (og + 1u == (tg + 1u) * nx) xb_add(&bar[XB_TOPGEN], 1u);
            role = 1u;
        }
        st[2] = role; st[3] = gen;
    }
}
__device__ __attribute__((noinline)) void grid_wait(unsigned* bar, unsigned x, volatile LAS unsigned* st) {
    if (threadIdx.x == 0) {
        const unsigned role = st[2], gen = st[3];
        if (role) {
            XB_SPIN(xb_ld(&bar[XB_TOPGEN]) <= gen, bar);
            __builtin_amdgcn_fence(__ATOMIC_ACQUIRE, "agent");
            xb_add(&bar[XB_XGEN(x)], 1u);
            asm volatile("s_waitcnt vmcnt(0)" ::: "memory");
        } else {
            XB_SPIN(xb_ld(&bar[XB_XGEN(x)]) <= gen && xb_ld(&bar[XB_TOPGEN]) <= gen, bar);
            __builtin_amdgcn_fence(__ATOMIC_ACQUIRE, "agent");
            asm volatile("s_waitcnt vmcnt(0)" ::: "memory");
        }
    }
    __syncthreads();
}
__device__ __attribute__((noinline)) void pair_sync(unsigned* flag, unsigned* barw, int same, unsigned n = 2u) {
    asm volatile("s_waitcnt vmcnt(0)" ::: "memory");
    __syncthreads();
    if (threadIdx.x == 0) {
        __builtin_amdgcn_s_waitcnt(0);
        if (!same) { __builtin_amdgcn_fence(__ATOMIC_RELEASE, "agent"); asm volatile("s_waitcnt vmcnt(0)" ::: "memory"); }
        (void)xb_add(flag, 1u);
        XB_SPIN(xb_ld(flag) < n, barw);
        __builtin_amdgcn_fence(__ATOMIC_ACQUIRE, "agent");
        asm volatile("s_waitcnt vmcnt(0)" ::: "memory");
    }
    __syncthreads();
}
__global__ void __launch_bounds__(NTHR, 2) fwd(Args args) {
    extern __shared__ __attribute__((aligned(16))) unsigned char lds_raw[];
    LAS unsigned char* lds = (LAS unsigned char*)lds_raw;
    const P& p = args.p;
    const int tid = threadIdx.x, lane = tid & 63, wave = __builtin_amdgcn_readfirstlane(tid >> 6);
    const int G = gridDim.x; const int bx = blockIdx.x; const int vcu = (G % 8 == 0) ? (bx % 8) * (G / 8) + bx / 8 : bx;
    volatile LAS unsigned* MISC = (volatile LAS unsigned*)(lds + LDS_MISC);
    if (tid < 64) MISC[tid] = 0u;
    __syncthreads();
    unsigned* ctl = (unsigned*)(p.ws + WS_CTL);
    const int lo = args.ph_lo, hi = args.ph_hi;
    XcdBarrier bar; bar.bar = ctl + CW_BAR + args.li * XCD_BAR_WORDS; bar.x = 0; bar.st = nullptr;
    if (hi - lo > 1) bar = xcd_barrier_post(ctl + CW_BAR + args.li * XCD_BAR_WORDS, MISC);
    if (tid == 0) __hip_atomic_store(ctl + CW_XID + vcu, xb_xcc_id(), __ATOMIC_RELAXED, __HIP_MEMORY_SCOPE_AGENT);
#define IN(k) (lo <= (k) && (k) < hi)
#define PHL int vcuL = vcu, GL = G, bxL = bx; asm volatile("" : "+s"(vcuL), "+s"(GL), "+s"(bxL)); (void)vcuL; (void)GL; (void)bxL;
#define LTID(v) int v = threadIdx.x; asm volatile("" : "+v"(v))
#define FILL_RS_DENSE() do { LTID(tq); const int rr_ = tq & 255, hf_ = tq >> 8; f32x4 sv_[4][4]; bool ok_[4]; \
        _Pragma("unroll") for (int k_ = 0; k_ < 4; ++k_) { pg8::Unit u_ = {0, 0, 0}; ok_[k_] = S.next(hf_ + 2 * k_, u_); const f32x4* sp_ = (const f32x4*)(SSQ + (size_t)(ok_[k_] ? u_.pm * 256 + rr_ : 0) * 16); \
            _Pragma("unroll") for (int j_ = 0; j_ < 4; ++j_) sv_[k_][j_] = sp_[j_]; } \
        _Pragma("unroll") for (int k_ = 0; k_ < 4; ++k_) if (ok_[k_]) { const f32x4 a_ = (sv_[k_][0] + sv_[k_][1]) + (sv_[k_][2] + sv_[k_][3]); rstab[(hf_ + 2 * k_) * 256 + rr_] = rsqrtf(((a_.x + a_.y) + (a_.z + a_.w)) * (1.0f / DM) + EPS); } } while (0)
#define MOE_ROW(k_) pg8::Unit u_ = {0, 0, 0}; ok_[k_] = S.next(hf_ + 2 * k_, u_); const int j_ = u_.e & 255, sl_ = (u_.pm - moet[32 + j_]) * 256 + rr_; const bool v_ = ok_[k_] && sl_ < moet[j_]; \
        const size_t ix_ = (size_t)j_ * BCAP + (v_ ? sl_ : 0);
#define FILL_GU() do { LTID(tq); const int rr_ = tq & 255, hf_ = tq >> 8; f32x4 sv_[4][4]; bool ok_[4]; int tk_[4]; float gt_[4]; \
        _Pragma("unroll") for (int k_ = 0; k_ < 4; ++k_) { MOE_ROW(k_) const int t_ = RT2[ix_]; const f32x2_t g2_ = RG2[ix_]; tk_[k_] = v_ ? t_ : -1; gt_[k_] = v_ ? (u_.pn < 4 ? g2_.x : g2_.y) : 0.f; } \
        _Pragma("unroll") for (int k_ = 0; k_ < 4; ++k_) { tk_[k_] = tk_[k_] < 0 ? 0 : tk_[k_]; const f32x4* sp_ = (const f32x4*)(SSQ + (size_t)tk_[k_] * 16); \
            _Pragma("unroll") for (int j_ = 0; j_ < 4; ++j_) sv_[k_][j_] = sp_[j_]; } \
        _Pragma("unroll") for (int k_ = 0; k_ < 4; ++k_) if (ok_[k_]) { const f32x4 a_ = (sv_[k_][0] + sv_[k_][1]) + (sv_[k_][2] + sv_[k_][3]); rowtab[(hf_ + 2 * k_) * 256 + rr_] = tk_[k_]; gatetab[(hf_ + 2 * k_) * 256 + rr_] = gt_[k_]; \
            rstab[(hf_ + 2 * k_) * 256 + rr_] = rsqrtf(((a_.x + a_.y) + (a_.z + a_.w)) * (1.0f / DM) + EPS); } } while (0)
#define FILL_DOWN() do { LTID(tq); const int rr_ = tq & 255, hf_ = tq >> 8; bool ok_[4]; int tk_[4]; \
        _Pragma("unroll") for (int k_ = 0; k_ < 4; ++k_) { MOE_ROW(k_) const int t_ = RT2[ix_]; tk_[k_] = v_ ? t_ : -1; } \
        _Pragma("unroll") for (int k_ = 0; k_ < 4; ++k_) if (ok_[k_]) { rowtab[(hf_ + 2 * k_) * 256 + rr_] = tk_[k_]; } } while (0)

#define SEAM(k) do { if (IN(k) && IN((k) + 1)) { grid_arrive(bar.bar, bar.x, bar.st); grid_wait(bar.bar, bar.x, bar.st); } } while (0)
#define SEAMF(k, nf_) do { if (IN(k) && IN((k) + 1)) { grid_arrive(bar.bar, bar.x, bar.st); { PHL conv_items(p, lds, vcuL * NWAVES + wave, 1, (nf_)); } grid_wait(bar.bar, bar.x, bar.st); } } while (0)
    LAS float* rstab = (LAS float*)(lds + LDS_RS); LAS int* rowtab = (LAS int*)(lds + LDS_ROWTOK); LAS float* gatetab = (LAS float*)(lds + LDS_GATE); const LAS int* moet = (const LAS int*)(lds + LDS_MOET);
#define HB WSP(bf16, WS_HB)
#define PROJ WSP(bf16, WS_PROJ)
#define Y WSP(bf16, WS_Y)
#define XKV WSP(bf16, WS_XKV)
#define MEMN WSP(bf16, WS_MEMN)
#define SSQ WSP(float, WS_SSQ)
#define XQ WSP(bf16, WS_XQ)
#define U WSP(bf16, WS_U)
#define RT2 WSP(const int, WS_RT2)
#define RG2 WSP(const f32x2_t, WS_RG2)
#define H (p.out)
#define HB8 ((unsigned char*)p.out + 64 * MiB)
#define U8 WSP(unsigned char, WS_U)

    if (EN(0) && IN(PH_PRO)) _Pragma("unroll 1") for (int rep_ = 0; rep_ < REPN(0); ++rep_) { PHL prologue(p, lds, vcuL, GL, wave, lane); }
    SEAMF(PH_PRO, 2);
    if (REPN(18) == 2 && IN(PH_XKV)) { PHL
        pg8::StaticOrder S; S.init(HB, ws_base(p.ws) + WS_W + WO_IN, NTOK, 3072, DM, GL, bxL);
        FILL_RS_DENSE();
        __syncthreads();
        EpiBf16<true> E{PROJ, PW, rstab};
        pg8::gemm_phase<DM, EpiBf16<true>, pg8::StaticOrder, true>(lds + LDS_STAGE, S, E);
    }
    for (int l = 0; l < NLAYER; ++l) {
        const int pb = PH_L0 + l * NPH;
        unsigned char* wl = ws_base(p.ws) + WS_W + (size_t)l * WS_WLAYER;
        if (EN(2) && IN(pb + LP_INPROJ)) _Pragma("unroll 1") for (int rep_ = 0; rep_ < REPN(2); ++rep_) { PHL
            pg8::StaticOrder S; S.init(HB, wl + WO_IN, NTOK, 3072, DM, GL, bxL);
            FILL_RS_DENSE();
            __syncthreads();
            EpiBf16<true> E{PROJ, PW, rstab};
            pg8::gemm_phase<DM, EpiBf16<true>, pg8::StaticOrder, true>(lds + LDS_STAGE, S, E);
            _Pragma("unroll 1") for (int r2_ = 0; r2_ < REPN(19); ++r2_) small_proj(p, l, lds + LDS_STAGE, vcuL, GL, wave, lane);
        }
        SEAMF(pb + LP_INPROJ, 2);
        if (IN(pb + LP_MIXA)) { PHL
            const int g4 = vcuL >> 2, q4 = vcuL & 3;
            int same4; { LTID(t4_); const unsigned idv = xb_ld(ctl + CW_XID + (vcuL & ~3) + (t4_ & 3)); same4 = (int)(__builtin_amdgcn_ballot_w64(idv != xb_xcc_id()) == 0ull); }
            unsigned* mf = ctl + CW_MF + (l * 2 * 64 + g4) * 16;
            gla_phase_a(p, l, lds + LDS_STAGE, vcuL, GL);
            fox_cumsum_phase(p, l, lds + LDS_STAGE, q4 * 64 + g4, 128, q4 < 2 ? 128 : 0);
            fox_knorm_phase(p, g4 * 32 + q4 * 8, 64 * 32, 128 * 32);
            pair_sync(mf, bar.bar, same4, 4u);
            gla_phase_b(p, vcuL, GL);
            pair_sync(mf + 64 * 16, bar.bar, same4, 4u);
            fox_phase(p, l, lds + LDS_STAGE, vcuL, GL);
            gla_phase_c(p, l, lds + LDS_STAGE, vcuL * 8, 1, vcuL * 8 + 8);
            if (l == 0) {
                for (;;) {
                    __syncthreads();
                    if (threadIdx.x == 0) MISC[32] = xb_add(ctl + CW_XT, 1u);
                    __syncthreads();
                    const int t_ = __builtin_amdgcn_readfirstlane((int)MISC[32]);
                    if (t_ >= 128) break;
                    pg8::PairOrder S{(const char*)MEMN, (const char*)(ws_base(p.ws) + WS_WXKV), DM, t_ >> 3, t_ & 7, 1};
                    EpiBf16<false> E{XKV, 2048, rstab};
                    pg8::gemm_phase<DM, EpiBf16<false>, pg8::PairOrder, true>(lds + LDS_STAGE, S, E);
                }
            }
        }
        SEAMF(pb + LP_MIXC, l == 0 ? 2 : 64);
        if (IN(pb + LP_WOUT)) { PHL
            const int side = vcuL & 1;
            const int same = (int)((unsigned)__builtin_amdgcn_readfirstlane((int)xb_ld(ctl + CW_XID + (vcuL ^ 1))) == xb_xcc_id());
            for (int pm = vcuL >> 1; pm < NTOK / 256; pm += GL >> 1) {
                unsigned* pf = ctl + CW_PF + ((l * 3) * 128 + pm) * 16;
                { pg8::PairOrder S{(const char*)Y, (const char*)(wl + WO_OUT), DM, pm, 2 * side, 2};
                  EpiRes<0> E{HB, SSQ, rowtab, 1.f, nullptr};
                  pg8::gemm_phase<DM, EpiRes<0>, pg8::PairOrder, true>(lds + LDS_STAGE, S, E); }
                pair_sync(pf, bar.bar, same);
                { pg8::PairOrder S{(const char*)HB, (const char*)(wl + WO_XQ), DM, pm, side, 1};
                  FILL_RS_DENSE();
                  __syncthreads();
                  EpiBf16<true> E{XQ, 512, rstab};
                  pg8::gemm_phase<DM, EpiBf16<true>, pg8::PairOrder, true>(lds + LDS_STAGE, S, E);
                  asm volatile("s_waitcnt vmcnt(0)" ::: "memory"); __syncthreads();
                  xattn_pair(p, l, lds + LDS_STAGE, pm, side, false); }
                pair_sync(pf + 128 * 16, bar.bar, same);
                { pg8::PairOrder S{(const char*)WSP(unsigned char, WS_XO8), (const char*)(wl + WO_XO), 256, pm, 2 * side, 2};
                  EpiRes<0, true> E{HB, SSQ, rowtab, 1.f, HB8};
                  pg8::gemm_phase<256, EpiRes<0, true>, pg8::PairOrder, true, true, 127, 122>(lds + LDS_STAGE, S, E); }
                pair_sync(pf + 2 * 128 * 16, bar.bar, same);
                route_phase(p, l, lds, (pm * 2 + side) * NWAVES, NTOK);
            }
        }
        if (l == 0) SEAMF(pb + LP_ROUTE, 2); else SEAM(pb + LP_ROUTE);
        if (IN(pb + LP_GU)) { PHL
            const int T_ = moe_tables(p, l, lds);
            int gsame;
            { LTID(t32_); const unsigned idv = xb_ld(ctl + CW_XID + (vcuL & ~31) + (t32_ & 31)); gsame = (int)(__builtin_amdgcn_ballot_w64(idv != xb_xcc_id()) == 0ull); }
            unsigned* gfl = ctl + CW_GF + l * MAXTILES * 16;
            { MoeOrder<0> S{(const char*)HB8, (const char*)(wl + WO_GU), 512, (size_t)1024 * 1024, moet + 96, rowtab, gfl, bar.bar, gsame}; S.init_group(T_, GL, vcuL);
              __syncthreads();
              FILL_GU();
              __syncthreads();
              EpiGU E{U8, rstab, gatetab};
              pg8::gemm_phase<512, EpiGU, MoeOrder<0>, true, true, 127, 122>(lds + LDS_STAGE, S, E); }
            { MoeOrder<1> S{(const char*)U8, (const char*)(wl + WO_D), 512, (size_t)1024 * 512, moet + 96, rowtab, gfl, bar.bar, gsame}; S.init_group(T_, GL, vcuL);
              __syncthreads();
              FILL_DOWN();
              __syncthreads();
              EpiRes<2> E{HB, SSQ, rowtab, 1.f, nullptr};
              pg8::gemm_phase<512, EpiRes<2>, MoeOrder<1>, true, true, 125, 122, 256, true>(lds + LDS_STAGE, S, E); }
        }
        if (l == 0) SEAMF(pb + LP_DOWN1, 2); else SEAM(pb + LP_DOWN1);
    }
    if (EN(15) && IN(PH_FINAL)) _Pragma("unroll 1") for (int rep_ = 0; rep_ < REPN(15); ++rep_) { PHL final_phase(p, vcuL, GL); }
#undef IN
#undef SEAM
#undef HB
#undef PROJ
#undef Y
#undef XKV
#undef MEMN
#undef SSQ
#undef XQ
#undef U
#undef RT2
#undef RG2
#undef H
#undef HB8
#undef U8
}

static int g_grid = 0;
static void launch_fast(const P& p, int lo, int hi, int& li, hipStream_t stream) {
    Args a{}; a.p = p; a.ph_lo = lo; a.ph_hi = hi; a.li = li++; a.pad = 0;
    hipLaunchKernelGGL(fwd, dim3(g_grid), dim3(NTHR), LDS_BYTES, stream, a);
    const hipError_t le = hipPeekAtLastError();
    if (le != hipSuccess) fprintf(stderr, "kernel_launch: fwd launch [%d,%d) failed: %s\n", lo, hi, hipGetErrorName(le));
}
extern "C" void kernel_launch(void* const* d_in, const int* in_sizes, int n_in, void* d_out, int out_size, void* d_ws, size_t ws_size, hipStream_t stream) {
    if (n_in != 25 || out_size != NTOK * DM || ws_size < WS_END2) { fprintf(stderr, "kernel_launch: unexpected sizes n_in %d out %d ws %zu (need %zu)\n", n_in, out_size, ws_size, (size_t)WS_END2); return; }
    if (g_grid == 0) {
        int dev = 0, cus = 0, per_cu = 0;
        if (hipGetDevice(&dev) != hipSuccess || hipDeviceGetAttribute(&cus, hipDeviceAttributeMultiprocessorCount, dev) != hipSuccess) { g_grid = -1; return; }
        if (hipFuncSetAttribute((const void*)fwd, hipFuncAttributeMaxDynamicSharedMemorySize, LDS_BYTES) != hipSuccess) { fprintf(stderr, "kernel_launch: hipFuncSetAttribute failed\n"); g_grid = -1; return; }
        if (hipOccupancyMaxActiveBlocksPerMultiprocessor(&per_cu, (const void*)fwd, NTHR, LDS_BYTES) != hipSuccess || per_cu < 1) { fprintf(stderr, "kernel_launch: occupancy query says %d\n", per_cu); }
        (void)hipGetLastError();
        g_grid = cus >= 256 ? 256 : -1; if (g_grid < 0) fprintf(stderr, "kernel_launch: needs 256 CUs, device has %d\n", cus);
    }
    if (g_grid < 0) return;
    P p{};
    const float** pp = (const float**)&p;
    for (int i = 0; i < 25; ++i) pp[i] = (const float*)d_in[i];
    p.out = (float*)d_out; p.ws = (unsigned char*)d_ws;
    if (hipMemsetAsync((char*)d_ws + WS_CTL + (size_t)CW_BAR * 4, 0, (size_t)XCD_BAR_WORDS * 4, stream) != hipSuccess) { fprintf(stderr, "kernel_launch: hipMemsetAsync failed\n"); return; }
    int li = 0;
    launch_fast(p, PH_PRO, PH_END, li, stream);
}
```
